# Optimizing an MI355X kernel written in HIP

```python
import math
import jax
import jax.numpy as jnp
from jax import lax
import numpy as np

D_MODEL = 2048
BATCH = 4
SEQ = 4096
DEPTH = 1

N_META = 16
HEAD_DIM = 128
GDN_HEADS = D_MODEL // (2 * HEAD_DIM)
GDN_DK = HEAD_DIM
GDN_DV = HEAD_DIM
GDN_DIM = GDN_HEADS * HEAD_DIM
CONV_K = 4
GDN_CHUNK = 64
SB_HEADS = D_MODEL // (2 * HEAD_DIM)
SB_HEAD_DIM = HEAD_DIM
SB_DIM = SB_HEADS * SB_HEAD_DIM
SB_BLOCK = 128
MIX_DIM = GDN_DIM + SB_DIM
IN_PROJ_DIM = 4 * GDN_DIM + 2 * GDN_HEADS + 3 * SB_DIM
N_EXPERTS = 32
TOP_K = 4
D_EXPERT = D_MODEL
SWIGLU_LIMIT = 7.0
SWIGLU_ALPHA = 1.702
MOE_BLOCK = 256
NORM_EPS = 1e-6

kernel_name = "hymba_gdn_stickbreaking_moe_layer"


def rms_norm(x, w):
    xf = x.astype(jnp.float32)
    y = xf * lax.rsqrt(jnp.mean(xf * xf, axis=-1, keepdims=True) + NORM_EPS)
    return y * w.astype(jnp.float32)


def l2_norm(x):
    return x * lax.rsqrt(jnp.sum(x * x, axis=-1, keepdims=True) + NORM_EPS)


def causal_depthwise_conv(x, w):
    k, c = w.shape
    return lax.conv_general_dilated(
        x, w[:, None, :].astype(x.dtype), window_strides=(1,), padding=[(k - 1, 0)],
        dimension_numbers=('NWC', 'WIO', 'NWC'), feature_group_count=c)


def chunked_gated_delta(q, k, v, beta, g):
    bsz, nh, t_len, dk = q.shape
    dv = v.shape[-1]
    c = GDN_CHUNK
    n = t_len // c
    q = q.reshape(bsz, nh, n, c, dk)
    k = k.reshape(bsz, nh, n, c, dk)
    v = v.reshape(bsz, nh, n, c, dv)
    beta = beta.reshape(bsz, nh, n, c)
    g = jnp.cumsum(g.reshape(bsz, nh, n, c), axis=-1)
    incl = jnp.tril(jnp.ones((c, c), dtype=bool))
    strict = jnp.tril(jnp.ones((c, c), dtype=bool), -1)
    decay = jnp.exp(jnp.where(incl, g[..., :, None] - g[..., None, :], -jnp.inf))
    k_beta = k * beta[..., None]
    v_beta = v * beta[..., None]
    low = jnp.where(strict, jnp.einsum('bhncd,bhnsd->bhncs', k_beta, k) * decay, 0.0)
    eye = jnp.eye(c, dtype=q.dtype)
    rhs = jnp.concatenate([v_beta, k_beta * jnp.exp(g)[..., None]], axis=-1)
    sol = lax.linalg.triangular_solve(eye + low, rhs, left_side=True, lower=True,
                                      unit_diagonal=True)
    u = sol[..., :dv]
    w = sol[..., dv:]
    attn = jnp.where(incl, jnp.einsum('bhncd,bhnsd->bhncs', q, k) * decay, 0.0)

    def step(state, inp):
        qi, ki, ui, wi, ai, gi = inp
        v_new = ui - jnp.einsum('bhck,bhkv->bhcv', wi, state)
        o = (jnp.einsum('bhck,bhkv->bhcv', qi * jnp.exp(gi)[..., None], state)
             + jnp.einsum('bhcs,bhsv->bhcv', ai, v_new))
        g_last = gi[..., -1]
        k_dec = ki * jnp.exp(g_last[..., None] - gi)[..., None]
        state = (state * jnp.exp(g_last)[..., None, None]
                 + jnp.einsum('bhck,bhcv->bhkv', k_dec, v_new))
        return state, o

    to_chunk_major = lambda t: jnp.moveaxis(t, 2, 0)
    s0 = jnp.zeros((bsz, nh, dk, dv), dtype=q.dtype)
    _, o = lax.scan(step, s0, tuple(to_chunk_major(t) for t in (q, k, u, w, attn, g)))
    return jnp.moveaxis(o, 0, 2).reshape(bsz, nh, t_len, dv)


def gated_deltanet_group(qkv, z, b, a, conv_w, a_log, dt_bias, norm_w):
    bsz, seq_len, _ = qkv.shape
    f32 = jnp.float32
    qkv = jax.nn.silu(causal_depthwise_conv(qkv, conv_w).astype(f32))
    q, k, v = jnp.split(qkv, 3, axis=-1)
    heads = lambda t: t.reshape(bsz, seq_len, GDN_HEADS, HEAD_DIM).transpose(0, 2, 1, 3)
    q = l2_norm(heads(q)) * (GDN_DK ** -0.5)
    k = l2_norm(heads(k))
    v = heads(v)
    beta = jax.nn.sigmoid(b.astype(f32)).transpose(0, 2, 1)
    g = (-jnp.exp(a_log.astype(f32))
         * jax.nn.softplus(a.astype(f32) + dt_bias.astype(f32))).transpose(0, 2, 1)
    pad = (-seq_len) % GDN_CHUNK
    pad_t = lambda t: jnp.pad(t, [(0, 0), (0, 0), (pad, 0)] + [(0, 0)] * (t.ndim - 3))
    o = chunked_gated_delta(pad_t(q), pad_t(k), pad_t(v), pad_t(beta), pad_t(g))[:, :, pad:]
    o = o.transpose(0, 2, 1, 3)
    zf = z.astype(f32).reshape(bsz, seq_len, GDN_HEADS, GDN_DV)
    o = rms_norm(o, norm_w) * jax.nn.silu(zf)
    return o.reshape(bsz, seq_len, GDN_DIM)


def stick_breaking_group(q, k, v, q_norm_w, k_norm_w, out_norm_w):
    bsz, seq_len, _ = q.shape
    heads = lambda t: t.reshape(bsz, seq_len, SB_HEADS, SB_HEAD_DIM)
    pad = (-seq_len) % SB_BLOCK
    to_bhld = lambda t: jnp.pad(t.transpose(0, 2, 1, 3), [(0, 0), (0, 0), (pad, 0), (0, 0)])
    qh = to_bhld(rms_norm(heads(q), q_norm_w))
    kh = to_bhld(rms_norm(heads(k), k_norm_w))
    vh = to_bhld(heads(v).astype(jnp.float32))
    padded_len = seq_len + pad
    scale = SB_HEAD_DIM ** -0.5
    outs = []
    for blk in range(padded_len // SB_BLOCK):
        q0 = blk * SB_BLOCK
        q1 = q0 + SB_BLOCK
        z = jnp.einsum('bhqd,bhkd->bhqk', qh[:, :, q0:q1], kh[:, :, :q1]) * scale
        q_pos = jnp.arange(q0, q1)[:, None]
        k_pos = jnp.arange(q1)[None, :]
        visible = (k_pos < q_pos) & (k_pos >= pad)
        log_beta = jnp.where(visible, jax.nn.log_sigmoid(z), -jnp.inf)
        log_keep = jnp.where(visible, jax.nn.log_sigmoid(-z), 0.0)
        log_keep_after = lax.cumsum(log_keep, axis=3, reverse=True) - log_keep
        weight = jnp.exp(log_beta + log_keep_after)
        outs.append(jnp.einsum('bhqk,bhkd->bhqd', weight, vh[:, :, :q1]))
    o = jnp.concatenate(outs, axis=2)[:, :, pad:].transpose(0, 2, 1, 3)
    return rms_norm(o, out_norm_w).reshape(bsz, seq_len, SB_DIM)


def moe_ffn(h, router_w, router_b, w_gate_up, b_gate_up, w_down, b_down):
    n_tok, d = h.shape
    logits = (h @ router_w).astype(jnp.float32) + router_b.astype(jnp.float32)
    top_logit, top_idx = lax.top_k(logits, TOP_K)
    gate = jax.nn.softmax(top_logit, axis=-1)
    n_assign = n_tok * TOP_K
    flat_e = top_idx.reshape(-1)
    order = jnp.argsort(flat_e)
    sorted_e = flat_e[order]
    sorted_tok = order // TOP_K
    sorted_gate = gate.reshape(-1)[order]
    counts = jnp.bincount(flat_e, length=N_EXPERTS)
    padded = (counts + MOE_BLOCK - 1) // MOE_BLOCK * MOE_BLOCK
    start = jnp.cumsum(counts) - counts
    pstart = jnp.cumsum(padded) - padded
    slot = pstart[sorted_e] + jnp.arange(n_assign) - start[sorted_e]
    n_blocks = (n_assign + N_EXPERTS * (MOE_BLOCK - 1)) // MOE_BLOCK + 1
    n_slots = n_blocks * MOE_BLOCK
    slot_tok = jnp.full((n_slots,), n_tok, dtype=jnp.int32).at[slot].set(sorted_tok.astype(jnp.int32))
    slot_gate = jnp.zeros((n_slots,), jnp.float32).at[slot].set(sorted_gate)
    block_e = jnp.searchsorted(jnp.cumsum(padded), jnp.arange(n_blocks) * MOE_BLOCK, side='right')
    block_e = jnp.minimum(block_e, N_EXPERTS - 1)
    h_ext = jnp.concatenate([h, jnp.zeros((1, d), h.dtype)], axis=0)
    xb = h_ext[slot_tok].reshape(n_blocks, MOE_BLOCK, d)

    def expert_block(args):
        xe, e = args
        gu = xe @ w_gate_up[e] + b_gate_up[e]
        g_h, u_h = jnp.split(gu, 2, axis=-1)
        g_h = jnp.minimum(g_h, SWIGLU_LIMIT)
        u_h = jnp.clip(u_h, -SWIGLU_LIMIT, SWIGLU_LIMIT)
        act = (u_h + 1.0) * g_h * jax.nn.sigmoid(SWIGLU_ALPHA * g_h)
        return act @ w_down[e] + b_down[e]

    yb = lax.map(expert_block, (xb, block_e))
    y = yb.reshape(n_slots, d) * slot_gate[:, None].astype(yb.dtype)
    return jnp.zeros((n_tok + 1, d), y.dtype).at[slot_tok].add(y)[:n_tok]


def setup_inputs(seed: int = 0) -> dict:
    key = jax.random.key(seed)
    ks = jax.random.split(key, 19)
    nrm = jax.random.normal
    D = D_MODEL
    x = nrm(ks[0], (BATCH, SEQ, D), jnp.float32)
    meta_tokens = nrm(ks[1], (N_META, D), jnp.float32)
    mix_norm_w = 1.0 + 0.02 * nrm(ks[2], (DEPTH, D), jnp.float32)
    w_in = nrm(ks[3], (DEPTH, D, IN_PROJ_DIM), jnp.float32) * D ** -0.5
    conv_w = nrm(ks[4], (DEPTH, CONV_K, 3 * GDN_DIM), jnp.float32) * CONV_K ** -0.5
    a_log = jnp.log(jax.random.uniform(ks[5], (DEPTH, GDN_HEADS), jnp.float32, 1.0, 16.0))
    dt = jnp.exp(jax.random.uniform(ks[6], (DEPTH, GDN_HEADS), jnp.float32,
                                    math.log(1e-3), math.log(1e-1)))
    dt_bias = dt + jnp.log(-jnp.expm1(-dt))
    gdn_norm_w = 1.0 + 0.02 * nrm(ks[7], (DEPTH, GDN_DV), jnp.float32)
    sb_q_norm_w = 1.0 + 0.02 * nrm(ks[8], (DEPTH, SB_HEAD_DIM), jnp.float32)
    sb_k_norm_w = 1.0 + 0.02 * nrm(ks[9], (DEPTH, SB_HEAD_DIM), jnp.float32)
    sb_out_norm_w = 1.0 + 0.02 * nrm(ks[10], (DEPTH, SB_HEAD_DIM), jnp.float32)
    w_out = nrm(ks[11], (DEPTH, MIX_DIM, D), jnp.float32) * MIX_DIM ** -0.5
    ffn_norm_w = 1.0 + 0.02 * nrm(ks[12], (DEPTH, D), jnp.float32)
    router_w = nrm(ks[13], (DEPTH, D, N_EXPERTS), jnp.float32) * D ** -0.5
    router_b = 0.01 * nrm(ks[14], (DEPTH, N_EXPERTS), jnp.float32)
    w_gate_up = nrm(ks[15], (DEPTH, N_EXPERTS, D, 2 * D_EXPERT), jnp.float32) * D ** -0.5
    b_gate_up = 0.01 * nrm(ks[16], (DEPTH, N_EXPERTS, 2 * D_EXPERT), jnp.float32)
    w_down = nrm(ks[17], (DEPTH, N_EXPERTS, D_EXPERT, D), jnp.float32) * D_EXPERT ** -0.5
    b_down = 0.01 * nrm(ks[18], (DEPTH, N_EXPERTS, D), jnp.float32)
    return {"x": x, "meta_tokens": meta_tokens, "mix_norm_w": mix_norm_w, "w_in": w_in,
            "conv_w": conv_w, "a_log": a_log, "dt_bias": dt_bias, "gdn_norm_w": gdn_norm_w,
            "sb_q_norm_w": sb_q_norm_w, "sb_k_norm_w": sb_k_norm_w, "sb_out_norm_w": sb_out_norm_w,
            "w_out": w_out, "ffn_norm_w": ffn_norm_w, "router_w": router_w, "router_b": router_b,
            "w_gate_up": w_gate_up, "b_gate_up": b_gate_up, "w_down": w_down, "b_down": b_down}


def reference(x, meta_tokens, mix_norm_w, w_in, conv_w, a_log, dt_bias, gdn_norm_w,
              sb_q_norm_w, sb_k_norm_w, sb_out_norm_w, w_out, ffn_norm_w, router_w, router_b,
              w_gate_up, b_gate_up, w_down, b_down):
    bsz = x.shape[0]
    meta = jnp.broadcast_to(meta_tokens.astype(x.dtype)[None], (bsz, N_META, D_MODEL))
    h = jnp.concatenate([meta, x], axis=1)
    cuts = [3 * GDN_DIM, 4 * GDN_DIM, 4 * GDN_DIM + GDN_HEADS, 4 * GDN_DIM + 2 * GDN_HEADS,
            4 * GDN_DIM + 2 * GDN_HEADS + SB_DIM, 4 * GDN_DIM + 2 * GDN_HEADS + 2 * SB_DIM]
    for layer in range(DEPTH):
        hn = rms_norm(h, mix_norm_w[layer]).astype(h.dtype)
        proj = hn @ w_in[layer]
        gdn_qkv, gdn_z, gdn_b, gdn_a, sb_q, sb_k, sb_v = jnp.split(proj, cuts, axis=-1)
        o_gdn = gated_deltanet_group(gdn_qkv, gdn_z, gdn_b, gdn_a, conv_w[layer], a_log[layer],
                                     dt_bias[layer], gdn_norm_w[layer])
        o_sb = stick_breaking_group(sb_q, sb_k, sb_v, sb_q_norm_w[layer], sb_k_norm_w[layer],
                                    sb_out_norm_w[layer])
        mixed = jnp.concatenate([o_gdn, o_sb], axis=-1).astype(h.dtype) @ w_out[layer]
        h = h + mixed
        hn = rms_norm(h, ffn_norm_w[layer]).astype(h.dtype)
        ffn = moe_ffn(hn.reshape(-1, D_MODEL), router_w[layer], router_b[layer], w_gate_up[layer],
                      b_gate_up[layer], w_down[layer], b_down[layer])
        h = h + ffn.reshape(h.shape).astype(h.dtype)
    return h[:, N_META:]
```

```cpp
#include <hip/hip_runtime.h>
#include <cstdio>
#include <cstdint>

#ifndef MK_N_LAUNCHES
#define MK_N_LAUNCHES 1
#endif

constexpr int NB = 4, SEQ = 4096, NMETA = 16, LSEQ = SEQ + NMETA;
constexpr int DM = 2048, NTOK = NB * LSEQ  , MPAD = 16640  , NREAL = NB * SEQ  ;
constexpr int NPROJ_SRC = 7184, NPROJ = 7168;
constexpr int NHEAD = 8, HD = 128;
constexpr int PC_QKV = 0, PC_Z = 3072, PC_SBQ = 4096, PC_SBK = 5120, PC_SBV = 6144;
constexpr int NEXP = 32, TOPK = 4, DE = 2048;
constexpr int SLOT_ROWS = 73728;
constexpr int LROW = 4224;
constexpr float NORM_EPS = 1e-6f;

constexpr size_t MiB = 1u << 20;
constexpr size_t WS_CTL = 0, CTL_ZERO_BYTES = 1 * MiB;
constexpr size_t WS_WIN = 1 * MiB;
constexpr size_t WS_WOUT = WS_WIN + (size_t)NPROJ * DM * 2;
constexpr size_t WS_WGU = WS_WOUT + (size_t)DM * DM * 2;
constexpr size_t WS_WD = WS_WGU + (size_t)NEXP * 2 * DE * DM * 2;
constexpr size_t WS_HN = WS_WD + (size_t)NEXP * DM * DE * 2;
constexpr size_t WS_BETA = WS_HN + (size_t)MPAD * DM * 2;
constexpr size_t WS_G = WS_BETA + (size_t)NTOK * 8 * 4 + 256;
constexpr size_t WS_P = WS_G + (size_t)NTOK * 8 * 4 + 256;
constexpr size_t WS_QN = WS_P + (size_t)MPAD * NPROJ * 2;
constexpr size_t WS_KN = WS_QN + (size_t)NB * NHEAD * LROW * HD * 2;
constexpr size_t WS_ORAW = WS_KN + (size_t)NB * NHEAD * LROW * HD * 2;
constexpr size_t WS_MIX = WS_ORAW + (size_t)NREAL * 1024 * 4;
constexpr size_t WS_RE = WS_MIX + (size_t)NREAL * DM * 2;
constexpr size_t WS_RP = WS_RE + (size_t)NREAL * 4 * 4;
constexpr size_t WS_RG = WS_RP + (size_t)NREAL * 4 * 4;
constexpr size_t WS_LIST = WS_RG + (size_t)NREAL * 4 * 4;
constexpr size_t WS_ACT = WS_LIST + (size_t)NEXP * NREAL * 4;
constexpr size_t WS_Y = WS_ACT + (size_t)SLOT_ROWS * DE * 2;
constexpr size_t WS_END = WS_Y + (size_t)SLOT_ROWS * DM * 2;
constexpr int CW_ECNT = 64;
constexpr int CW_BAR = 4096;

constexpr int LDS_STAGE = 131072;
constexpr int TOK_OFF = LDS_STAGE, TOK_CAP = 20;
constexpr int MISC_OFF = TOK_OFF + TOK_CAP * 256 * 4;
constexpr int LDS_BYTES = MISC_OFF + 1024;

#define GAS __attribute__((address_space(1)))
#define LAS __attribute__((address_space(3)))
typedef unsigned short bf16_t;
typedef short bf16x8 __attribute__((ext_vector_type(8)));
typedef short s16x4 __attribute__((ext_vector_type(4)));
typedef float f32x4 __attribute__((ext_vector_type(4)));
typedef float f32x2 __attribute__((ext_vector_type(2)));
typedef float f32x16 __attribute__((ext_vector_type(16)));
typedef unsigned u32x4 __attribute__((ext_vector_type(4)));
typedef unsigned u32x2 __attribute__((ext_vector_type(2)));

__device__ __forceinline__ unsigned cvt_pk_bf16(float lo, float hi) { unsigned r; asm volatile("v_cvt_pk_bf16_f32 %0, %1, %2" : "=v"(r) : "v"(lo), "v"(hi)); return r; }
__device__ __forceinline__ float bf_lo(unsigned w) { return __uint_as_float(w << 16); }
__device__ __forceinline__ float bf_hi(unsigned w) { return __uint_as_float(w & 0xffff0000u); }
__device__ __forceinline__ float bf2f(bf16_t b) { return __uint_as_float(((unsigned)b) << 16); }
__device__ __forceinline__ float wave_sum(float v) {
#pragma unroll
    for (int o = 1; o < 64; o <<= 1) v += __shfl_xor(v, o);
    return v;
}

namespace pg8 {
constexpr int BM = 256, BK = 64, HALF = 128, HTB = HALF * BK * 2, STAGE_BYTES = 8 * HTB, NXCD = 8, WGM = 8;
__host__ __device__ __forceinline__ int lds_byte(int r, int c) { const int st = (r >> 4) * 2 + (c >> 5), rr = r & 15, cc = c & 31, ob = rr * 64 + cc * 2; return st * 1024 + (ob ^ (((ob >> 9) & 1) << 5)); }
__host__ __device__ __forceinline__ void stage_rc(int b, int& R, int& C) { const int st = b / 1024, sb = b % 1024, swz = sb ^ (((sb >> 9) & 1) << 5); R = (st >> 1) * 16 + swz / 64; C = (st & 1) * 32 + (swz % 64) / 2; }
__host__ __device__ __forceinline__ int perm32(int rho) { const int n = rho >> 4, i = rho & 15; return 8 * (i >> 2) + 4 * n + (i & 3); }

struct Unit { int pm, pn, e, ui; };

__device__ __forceinline__ int xcd_remap(int L, int nwg) { const int q = nwg / NXCD, r = nwg % NXCD, xcd = L % NXCD, off = L / NXCD; return (xcd < r ? xcd * (q + 1) : r * (q + 1) + (xcd - r) * q) + off; }

struct PlainOrder {
    int nM, nN, nwg, G, c; const char* Bt; unsigned K2;
    __device__ void init(int M, int N, int K, const void* Bt_, int G_, int c_) { nM = M / BM; nN = N / BM; nwg = nM * nN; G = G_; c = c_; Bt = (const char*)Bt_; K2 = (unsigned)K * 2u; }
    __device__ __forceinline__ bool next(int i, Unit& u) const {
        const long L = (long)i * G + c; if (L >= nwg) return false;
        const int wgid = xcd_remap((int)L, nwg);
        const int nig = WGM * nN, gid = wgid / nig, fm = gid * WGM, gsz = (nM - fm) < WGM ? (nM - fm) : WGM;
        u.pm = fm + ((wgid % nig) % gsz); u.pn = (wgid % nig) / gsz; u.e = 0; u.ui = i; return true;
    }
    __device__ __forceinline__ const char* b_ptr(const Unit& u) const { return Bt + (size_t)u.pn * BM * K2; }
    __device__ __forceinline__ unsigned a_off(const Unit& u, int r) const { return (unsigned)(u.pm * BM + r) * K2; }
};
template <bool GATHER> struct MoeOrder {
    const LAS int* tpre; const LAS int* tok; int nN, nwg, G, c; const char* Bt; size_t estride; unsigned K2;
    __device__ __forceinline__ bool next(int i, Unit& u) const {
        const long L = (long)i * G + c; if (L >= nwg) return false;
        const int wgid = xcd_remap((int)L, nwg);
        int e = 0;
#pragma unroll 1
        for (int j = 1; j < NEXP; ++j) e = (wgid >= tpre[j] * nN) ? j : e;
        const int t0 = tpre[e], nt = tpre[e + 1] - t0, loc = wgid - t0 * nN;
        u.e = e; u.pn = loc / nt; u.pm = t0 + loc % nt; u.ui = i; return true;
    }
    __device__ __forceinline__ const char* b_ptr(const Unit& u) const { return Bt + (size_t)u.e * estride + (size_t)u.pn * BM * K2; }
    __device__ __forceinline__ unsigned a_off(const Unit& u, int r) const {
        if (GATHER) return (unsigned)tok[u.ui * 256 + r] * K2;
        return (unsigned)(u.pm * BM + r) * K2;
    }
};

struct EpiBf16 {
    static constexpr bool PERM = true;
    bf16_t* O; int ldc;
    __device__ __forceinline__ void operator()(const f32x4 (&acc)[2][2][4][2], const Unit& u, int wr, int wc, int fr, int fq) const {
        const int row0 = u.pm * BM + wr * 64 + fr, col0 = u.pn * BM + wc * 32 + 8 * fq;
#pragma unroll
        for (int ai = 0; ai < 2; ++ai)
#pragma unroll
            for (int m = 0; m < 4; ++m) { bf16_t* rowp = O + (size_t)(row0 + ai * HALF + m * 16) * ldc + col0;
#pragma unroll
                for (int bj = 0; bj < 2; ++bj) { const f32x4 v0 = acc[ai][bj][m][0], v1 = acc[ai][bj][m][1];
                    u32x4 w; w.x = cvt_pk_bf16(v0[0], v0[1]); w.y = cvt_pk_bf16(v0[2], v0[3]); w.z = cvt_pk_bf16(v1[0], v1[1]); w.w = cvt_pk_bf16(v1[2], v1[3]);
                    *(u32x4*)(rowp + bj * HALF) = w; } }
    }
};
struct EpiResF32 {
    static constexpr bool PERM = false;
    const float* X; float* out; int ldc;
    __device__ __forceinline__ void operator()(const f32x4 (&acc)[2][2][4][2], const Unit& u, int wr, int wc, int fr, int fq) const {
        const int row0 = u.pm * BM + wr * 64 + fr, col0 = u.pn * BM + wc * 32 + 4 * fq;
#pragma unroll
        for (int ai = 0; ai < 2; ++ai)
#pragma unroll
            for (int m = 0; m < 4; ++m) { const size_t off = (size_t)(row0 + ai * HALF + m * 16) * ldc + col0;
#pragma unroll
                for (int bj = 0; bj < 2; ++bj)
#pragma unroll
                    for (int n = 0; n < 2; ++n) { const f32x4 xv = *(const f32x4*)(X + off + bj * HALF + n * 16); *(f32x4*)(out + off + bj * HALF + n * 16) = xv + acc[ai][bj][m][n]; }
                asm volatile("" ::: "memory"); }
    }
};
__device__ __forceinline__ float swiglu1(float g, float uu) {
    g = fminf(g, 7.0f); uu = fminf(fmaxf(uu, -7.0f), 7.0f);
    const float sg = __builtin_amdgcn_rcpf(1.0f + __builtin_amdgcn_exp2f(-1.702f * 1.4426950408889634f * g));
    return (uu + 1.0f) * g * sg;
}
struct EpiSwiGLU {
    static constexpr bool PERM = true;
    bf16_t* act; const float* bgu;
    __device__ __forceinline__ void operator()(const f32x4 (&acc)[2][2][4][2], const Unit& u, int wr, int wc, int fr, int fq) const {
        const int row0 = u.pm * BM + wr * 64 + fr, col0 = u.pn * HALF + wc * 32 + 8 * fq;
        const float* bg = bgu + (size_t)u.e * 4096 + col0;
        const f32x4 bg0 = *(const f32x4*)(bg), bg1 = *(const f32x4*)(bg + 4), bu0 = *(const f32x4*)(bg + 2048), bu1 = *(const f32x4*)(bg + 2052);
#pragma unroll
        for (int ai = 0; ai < 2; ++ai)
#pragma unroll
            for (int m = 0; m < 4; ++m) { bf16_t* rowp = act + (size_t)(row0 + ai * HALF + m * 16) * DE + col0;
                const f32x4 g0 = acc[ai][0][m][0] + bg0, g1 = acc[ai][0][m][1] + bg1, u0 = acc[ai][1][m][0] + bu0, u1 = acc[ai][1][m][1] + bu1;
                u32x4 w; w.x = cvt_pk_bf16(swiglu1(g0[0], u0[0]), swiglu1(g0[1], u0[1])); w.y = cvt_pk_bf16(swiglu1(g0[2], u0[2]), swiglu1(g0[3], u0[3]));
                w.z = cvt_pk_bf16(swiglu1(g1[0], u1[0]), swiglu1(g1[1], u1[1])); w.w = cvt_pk_bf16(swiglu1(g1[2], u1[2]), swiglu1(g1[3], u1[3]));
                *(u32x4*)rowp = w; }
    }
};

template <class Epi, class Sched, bool ALIGN_EPI, bool SP2>
__device__ __forceinline__ void gemm_phase(LAS unsigned char* lds, const char* A0, int K, const Sched& S, const Epi& E) {
    const int tid = threadIdx.x, wid = __builtin_amdgcn_readfirstlane(tid >> 6), lane = tid & 63, wr = wid >> 2, wc = wid & 3, fr = lane & 15, fq = lane >> 4;
    const int nt = K / BK;
    int Rr[2], Cc[2]; unsigned voffB[2];
#pragma unroll
    for (int i = 0; i < 2; ++i) { int R, C; stage_rc(tid * 16 + i * 8192, R, C); const int Rb = Epi::PERM ? ((R & ~31) + perm32(R & 31)) : R;
        Rr[i] = R; Cc[i] = C * 2; voffB[i] = (unsigned)(Rb * K + C) * 2u; }
    const size_t kstep = (size_t)(BK * 2);
    const size_t hstep = (size_t)HALF * K * 2;
    const unsigned ldsw = (unsigned)wid * 1024u;
    const int aoff = lds_byte(wr * 64 + fr, fq * 8), boff = lds_byte(wc * 32 + fr, fq * 8);
#define PG8_SA(b, h) (((b) * 2 + (h)) * HTB)
#define PG8_SB(b, h) ((4 + (b) * 2 + (h)) * HTB)
#define PG8_STAGE(bufoff, gbase, voff) do { _Pragma("unroll") for (int _i = 0; _i < 2; ++_i) \
        __builtin_amdgcn_global_load_lds((const unsigned*)((const char*)(gbase) + (voff)[_i]), (LAS unsigned*)(lds + (bufoff) + ldsw + _i * 8192), 16, 0, 0); } while (0)
#define PG8_LDA(dst, b, h) do { _Pragma("unroll") for (int m = 0; m < 4; ++m) _Pragma("unroll") for (int k = 0; k < 2; ++k) dst[m][k] = *(const LAS bf16x8*)(lds + PG8_SA(b, h) + aoff + m * 2048 + k * 1024); } while (0)
#define PG8_LDB(dst, b, h) do { _Pragma("unroll") for (int n = 0; n < 2; ++n) _Pragma("unroll") for (int k = 0; k < 2; ++k) dst[n][k] = *(const LAS bf16x8*)(lds + PG8_SB(b, h) + boff + n * 2048 + k * 1024); } while (0)
#define PG8_MMA(ai, bj, At, Bt) do { __builtin_amdgcn_s_setprio(1); _Pragma("unroll") for (int m = 0; m < 4; ++m) _Pragma("unroll") for (int n = 0; n < 2; ++n) _Pragma("unroll") for (int k = 0; k < 2; ++k) \
        acc[ai][bj][m][n] = __builtin_amdgcn_mfma_f32_16x16x32_bf16(Bt[n][k], At[m][k], acc[ai][bj][m][n], 0, 0, 0); __builtin_amdgcn_s_setprio(0); } while (0)
#define PG8_WAIT_V(n) asm volatile("s_waitcnt vmcnt(" #n ")" ::: "memory")
#define PG8_WAIT_L(n) asm volatile("s_waitcnt lgkmcnt(" #n ")" ::: "memory")
#define PG8_BAR __builtin_amdgcn_s_barrier()
#define PG8_SCHED __builtin_amdgcn_sched_barrier(0)
#define PG8_VOFF(dst, u) do { _Pragma("unroll") for (int _h = 0; _h < 2; ++_h) _Pragma("unroll") for (int _i = 0; _i < 2; ++_i) dst[_h][_i] = S.a_off(u, _h * HALF + Rr[_i]) + (unsigned)Cc[_i]; } while (0)
    Unit cur, nxt; int ui = 0;
    if (!S.next(0, cur)) return;
    f32x4 acc[2][2][4][2];
#pragma unroll
    for (int a = 0; a < 2; ++a)
#pragma unroll
        for (int b = 0; b < 2; ++b)
#pragma unroll
            for (int m = 0; m < 4; ++m)
#pragma unroll
                for (int n = 0; n < 2; ++n) acc[a][b][m][n] = (f32x4){0.f, 0.f, 0.f, 0.f};
    bf16x8 At[4][2], B0[2][2], B1[2][2];
    unsigned va[2][2], vn[2][2];
    PG8_VOFF(va, cur);
    const char* cB = S.b_ptr(cur);
    if constexpr (SP2) {
        PG8_STAGE(PG8_SB(0, 0), cB, voffB); PG8_STAGE(PG8_SB(0, 1), cB + hstep, voffB); PG8_STAGE(PG8_SA(0, 0), A0, va[0]); PG8_STAGE(PG8_SA(0, 1), A0, va[1]);
        if (wr == 1) PG8_BAR;
        PG8_WAIT_V(2); PG8_BAR;
        PG8_STAGE(PG8_SB(1, 0), cB + kstep, voffB); PG8_STAGE(PG8_SA(1, 0), A0 + kstep, va[0]); PG8_STAGE(PG8_SB(1, 1), cB + hstep + kstep, voffB);
        PG8_WAIT_V(6); PG8_BAR;
    } else {
        PG8_STAGE(PG8_SB(0, 0), cB, voffB); PG8_STAGE(PG8_SA(0, 0), A0, va[0]); PG8_STAGE(PG8_SB(0, 1), cB + hstep, voffB); PG8_STAGE(PG8_SA(0, 1), A0, va[1]);
        if (wr == 1) PG8_BAR;
        PG8_WAIT_V(4); PG8_BAR;
        PG8_STAGE(PG8_SB(1, 0), cB + kstep, voffB); PG8_STAGE(PG8_SA(1, 0), A0 + kstep, va[0]); PG8_STAGE(PG8_SB(1, 1), cB + hstep + kstep, voffB);
        PG8_WAIT_V(6); PG8_BAR;
    }
    for (;;) {
        const bool has_next = S.next(ui + 1, nxt);
        const char* nB = has_next ? S.b_ptr(nxt) : cB;
        for (int t = 0; t < nt; t += 2) {
            const bool last = (t == nt - 2);
            const char* a1 = A0 + (size_t)(t + 1) * kstep;
            const char* a2 = last ? A0 : A0 + (size_t)(t + 2) * kstep; const char* b2 = last ? nB : cB + (size_t)(t + 2) * kstep;
            const char* a3 = a2 + kstep; const char* b3 = b2 + kstep;
            if (last) { if (has_next) { PG8_VOFF(vn, nxt); } else {
#pragma unroll
                    for (int _h = 0; _h < 2; ++_h)
#pragma unroll
                        for (int _i = 0; _i < 2; ++_i) vn[_h][_i] = va[_h][_i]; } }
            if constexpr (SP2) {
            PG8_LDB(B0, 0, 0); PG8_LDB(B1, 0, 1); PG8_SCHED; PG8_LDA(At, 0, 0); PG8_STAGE(PG8_SA(1, 1), a1, va[1]);
            if (last) {
#pragma unroll
                for (int _h = 0; _h < 2; ++_h)
#pragma unroll
                    for (int _i = 0; _i < 2; ++_i) va[_h][_i] = vn[_h][_i]; }
            PG8_WAIT_V(8); PG8_WAIT_L(0); PG8_BAR; PG8_MMA(0, 0, At, B0); PG8_MMA(0, 1, At, B1); PG8_BAR; PG8_SCHED;
            PG8_LDA(At, 0, 1); PG8_STAGE(PG8_SB(0, 0), b2, voffB); PG8_STAGE(PG8_SB(0, 1), b2 + hstep, voffB); PG8_STAGE(PG8_SA(0, 0), a2, va[0]);
            PG8_WAIT_V(8); PG8_WAIT_L(0); PG8_BAR; PG8_MMA(1, 0, At, B0); PG8_MMA(1, 1, At, B1); PG8_BAR; PG8_SCHED;
            PG8_LDB(B0, 1, 0); PG8_LDB(B1, 1, 1); PG8_SCHED; PG8_LDA(At, 1, 0); PG8_STAGE(PG8_SA(0, 1), a2, va[1]);
            PG8_WAIT_V(8); PG8_WAIT_L(0); PG8_BAR; PG8_MMA(0, 0, At, B0); PG8_MMA(0, 1, At, B1); PG8_BAR; PG8_SCHED;
            PG8_LDA(At, 1, 1); PG8_STAGE(PG8_SB(1, 0), b3, voffB); PG8_STAGE(PG8_SB(1, 1), b3 + hstep, voffB); PG8_STAGE(PG8_SA(1, 0), a3, va[0]);
            PG8_WAIT_V(8); PG8_WAIT_L(0); PG8_BAR; PG8_MMA(1, 0, At, B0); PG8_MMA(1, 1, At, B1); PG8_BAR; PG8_SCHED;
            } else {
            PG8_LDB(B0, 0, 0); PG8_SCHED; PG8_LDA(At, 0, 0); PG8_STAGE(PG8_SA(1, 1), a1, va[1]);
            if (last) {
#pragma unroll
                for (int _h = 0; _h < 2; ++_h)
#pragma unroll
                    for (int _i = 0; _i < 2; ++_i) va[_h][_i] = vn[_h][_i]; }
            PG8_WAIT_L(8); PG8_BAR; PG8_WAIT_L(0); PG8_MMA(0, 0, At, B0); PG8_BAR; PG8_SCHED;
            PG8_LDB(B1, 0, 1); PG8_STAGE(PG8_SB(0, 0), b2, voffB);
            PG8_BAR; PG8_WAIT_L(0); PG8_MMA(0, 1, At, B1); PG8_BAR;
            PG8_LDA(At, 0, 1); PG8_STAGE(PG8_SA(0, 0), a2, va[0]);
            PG8_BAR; PG8_WAIT_L(0); PG8_MMA(1, 0, At, B0); PG8_BAR; PG8_SCHED;
            PG8_STAGE(PG8_SB(0, 1), b2 + hstep, voffB);
            PG8_WAIT_V(6); PG8_BAR; PG8_MMA(1, 1, At, B1); PG8_BAR;
            PG8_LDB(B0, 1, 0); PG8_SCHED; PG8_LDA(At, 1, 0); PG8_STAGE(PG8_SA(0, 1), a2, va[1]);
            PG8_WAIT_L(8); PG8_BAR; PG8_WAIT_L(0); PG8_MMA(0, 0, At, B0); PG8_BAR; PG8_SCHED;
            PG8_LDB(B1, 1, 1); PG8_STAGE(PG8_SB(1, 0), b3, voffB);
            PG8_BAR; PG8_WAIT_L(0); PG8_MMA(0, 1, At, B1); PG8_BAR;
            PG8_LDA(At, 1, 1); PG8_STAGE(PG8_SA(1, 0), a3, va[0]);
            PG8_BAR; PG8_WAIT_L(0); PG8_MMA(1, 0, At, B0); PG8_BAR; PG8_SCHED;
            PG8_STAGE(PG8_SB(1, 1), b3 + hstep, voffB);
            PG8_WAIT_V(6); PG8_BAR; PG8_MMA(1, 1, At, B1); PG8_BAR;
            }
        }
        if constexpr (ALIGN_EPI) { if (wr == 0) PG8_BAR; }
        E(acc, cur, wr, wc, fr, fq);
        if (!has_next) break;
#pragma unroll
        for (int a = 0; a < 2; ++a)
#pragma unroll
            for (int b = 0; b < 2; ++b)
#pragma unroll
                for (int m = 0; m < 4; ++m)
#pragma unroll
                    for (int n = 0; n < 2; ++n) acc[a][b][m][n] = (f32x4){0.f, 0.f, 0.f, 0.f};
        cur = nxt; cB = nB; ++ui;
        if constexpr (ALIGN_EPI) { if (wr == 1) PG8_BAR; }
    }
    PG8_WAIT_V(0);
    if constexpr (!ALIGN_EPI) { if (wr == 0) PG8_BAR; }
    PG8_BAR;
#undef PG8_SA
#undef PG8_SB
#undef PG8_STAGE
#undef PG8_LDA
#undef PG8_LDB
#undef PG8_MMA
#undef PG8_WAIT_V
#undef PG8_WAIT_L
#undef PG8_BAR
#undef PG8_SCHED
#undef PG8_VOFF
}
}

#define XB_TMO      128
#define XB_XCNT(j)  (256  + 64 * (j))
#define XB_XSUB(j)  (1280 + 64 * (j))
#define XB_XGEN(j)  (2304 + 64 * (j))
#define XB_TOP      3328
#define XB_TOPGEN   3392
#define XCD_BAR_WORDS 3456
#define XB_SPIN_CAP (1u << 18)

__device__ __forceinline__ unsigned xb_ld(unsigned* p)              { return __hip_atomic_load(p, __ATOMIC_RELAXED, __HIP_MEMORY_SCOPE_AGENT); }
__device__ __forceinline__ unsigned xb_add(unsigned* p, unsigned v) { return __hip_atomic_fetch_add(p, v, __ATOMIC_RELAXED, __HIP_MEMORY_SCOPE_AGENT); }
__device__ __forceinline__ unsigned xb_xcc_id() { return (unsigned)__builtin_amdgcn_s_getreg((3 << 11) | 20) & 0xFu; }
#define XB_SPIN(cond, bar) do { unsigned _sp = 0; while (cond) { __builtin_amdgcn_s_sleep(1); \
    if ((++_sp & 255u) == 0u) { if (xb_ld(&(bar)[XB_TMO])) break; if (_sp > XB_SPIN_CAP) { atomicAdd(&(bar)[XB_TMO], 1u); break; } } } } while (0)

struct XcdBarrier {
    unsigned* bar; unsigned x;
    volatile LAS unsigned* st;
};
__device__ __forceinline__ XcdBarrier xcd_barrier_post(unsigned* bar, volatile LAS unsigned* st) {
    XcdBarrier b; b.bar = bar; b.x = xb_xcc_id(); b.st = st;
    if (threadIdx.x == 0) (void)xb_add(&bar[XB_XCNT(b.x)], 1u);
    return b;
}
__device__ __forceinline__ void xcd_barrier_complete(unsigned* bar, unsigned x, unsigned& nloc, unsigned& nx) {
    const unsigned G = gridDim.x * gridDim.y * gridDim.z;
    unsigned sum, cnt, mine, sp = 0u;
    for (;;) {
        sum = 0u; cnt = 0u; mine = 0u;
#pragma unroll
        for (unsigned j = 0; j < 16; ++j) { const unsigned c = xb_ld(&bar[XB_XCNT(j)]); sum += c; cnt += (c > 0u) ? 1u : 0u; mine = (j == x) ? c : mine; }
        if (sum == G) break;
        __builtin_amdgcn_s_sleep(1);
        if ((++sp & 255u) == 0u) { if (xb_ld(&bar[XB_TMO])) break; if (sp > XB_SPIN_CAP) { atomicAdd(&bar[XB_TMO], 1u); break; } }
    }
    nloc = mine > 0u ? mine : 1u; nx = cnt > 0u ? cnt : 1u;
}
__device__ __forceinline__ void xcd_barrier(const XcdBarrier& b) {
    asm volatile("s_waitcnt vmcnt(0)" ::: "memory");
    __syncthreads();
    if (threadIdx.x == 0) {
        unsigned* bar = b.bar;
        __builtin_amdgcn_s_waitcnt(0);
        unsigned nloc = b.st[0], nx = b.st[1];
        if (nloc == 0u) { xcd_barrier_complete(bar, b.x, nloc, nx); b.st[0] = nloc; b.st[1] = nx; }
        const unsigned old = xb_add(&bar[XB_XSUB(b.x)], 1u);
        const unsigned gen = old / nloc;
        if (old + 1u == (gen + 1u) * nloc) {
            __builtin_amdgcn_fence(__ATOMIC_RELEASE, "agent");
            asm volatile("s_waitcnt vmcnt(0)" ::: "memory");
            const unsigned og = xb_add(&bar[XB_TOP], 1u);
            const unsigned tg = og / nx;
            if (og + 1u == (tg + 1u) * nx) xb_add(&bar[XB_TOPGEN], 1u);
            else XB_SPIN(xb_ld(&bar[XB_TOPGEN]) == tg, bar);
            __builtin_amdgcn_fence(__ATOMIC_ACQUIRE, "agent");
            xb_add(&bar[XB_XGEN(b.x)], 1u);
            asm volatile("s_waitcnt vmcnt(0)" ::: "memory");
        } else {
            XB_SPIN(xb_ld(&bar[XB_XGEN(b.x)]) == gen, bar);
            __builtin_amdgcn_fence(__ATOMIC_ACQUIRE, "agent");
            asm volatile("s_waitcnt vmcnt(0)" ::: "memory");
        }
    }
    __syncthreads();
}

constexpr int NWAVES = 8, NTHREADS = 512;
struct Args { const float* in[19]; float* out; unsigned char* ws; int ph_lo, ph_hi; };
enum { I_X = 0, I_META, I_MIXNW, I_WIN, I_CONVW, I_ALOG, I_DTB, I_GDNNW, I_SBQNW, I_SBKNW, I_SBONW, I_WOUT, I_FFNNW, I_RW, I_RB, I_WGU, I_BGU, I_WD, I_BD };

#define LDS_WAIT() asm volatile("s_waitcnt lgkmcnt(0)" ::: "memory")
#define VM_WAIT() asm volatile("s_waitcnt vmcnt(0)" ::: "memory")
constexpr int WLS = 2052;

__device__ __forceinline__ void dot16(const f32x4 (&v)[8], const LAS float* wl, int lane, float (&s)[16]) {
#pragma unroll
    for (int c = 0; c < 16; ++c) { float a = 0.f;
#pragma unroll
        for (int j = 0; j < 8; ++j) { const f32x4 w = *(const LAS f32x4*)(wl + c * WLS + 4 * lane + 256 * j); a += (v[j].x * w.x + v[j].y * w.y) + (v[j].z * w.z + v[j].w * w.w); }
        s[c] = wave_sum(a); }
}

__device__ __forceinline__ void p0_rows(const Args& a, LAS unsigned char* lds, int gw, int NGW, int tid, int lane) {
    const float* x = a.in[I_X]; const float* meta = a.in[I_META]; const float* nw = a.in[I_MIXNW]; const float* win = a.in[I_WIN];
    LAS float* wl = (LAS float*)lds;
    for (int idx = tid; idx < 2048 * 16; idx += NTHREADS) { const int k = idx >> 4, c = idx & 15; wl[c * WLS + k] = win[(size_t)k * NPROJ_SRC + 4096 + c]; }
    __syncthreads();
    bf16_t* HN = (bf16_t*)(a.ws + WS_HN); float* BETA = (float*)(a.ws + WS_BETA); float* GG = (float*)(a.ws + WS_G);
    f32x4 wn[8];
#pragma unroll
    for (int j = 0; j < 8; ++j) wn[j] = *((const f32x4*)nw + lane + 64 * j);
    const int hh = lane & 7;
    const float alog = a.in[I_ALOG][hh], dtb = a.in[I_DTB][hh];
    for (int row = gw; row < MPAD; row += NGW) {
        GAS unsigned long long* o8 = (GAS unsigned long long*)(HN + (size_t)row * DM) + lane;
        if (row >= NTOK) {
#pragma unroll
            for (int j = 0; j < 8; ++j) o8[64 * j] = 0ull;
            continue; }
        const int b = row / LSEQ, t = row - b * LSEQ;
        const float* src = (t < NMETA) ? meta + (size_t)t * DM : x + ((size_t)b * SEQ + (t - NMETA)) * DM;
        f32x4 v[8]; float ss = 0.f;
#pragma unroll
        for (int j = 0; j < 8; ++j) { v[j] = *((const f32x4*)src + lane + 64 * j); ss += (v[j].x * v[j].x + v[j].y * v[j].y) + (v[j].z * v[j].z + v[j].w * v[j].w); }
        const float rstd = 1.0f / sqrtf(wave_sum(ss) * (1.0f / DM) + NORM_EPS);
#pragma unroll
        for (int j = 0; j < 8; ++j) { v[j] = v[j] * rstd * wn[j];
            o8[64 * j] = (unsigned long long)cvt_pk_bf16(v[j].x, v[j].y) | ((unsigned long long)cvt_pk_bf16(v[j].z, v[j].w) << 32); }
        float s[16]; dot16(v, wl, lane, s);
        float bv = s[0], av = s[8];
#pragma unroll
        for (int c = 1; c < 8; ++c) { bv = (hh == c) ? s[c] : bv; av = (hh == c) ? s[8 + c] : av; }
        if (lane < 8) {
            const float beta = 1.0f / (1.0f + expf(-bv));
            const float xa = av + dtb; const float sp = fmaxf(xa, 0.f) + log1pf(expf(-fabsf(xa)));
            BETA[(size_t)row * 8 + hh] = beta; GG[(size_t)row * 8 + hh] = -expf(alog) * sp; }
    }
    __syncthreads();
}

template <int MODE  >
__device__ __forceinline__ void cvt_strip(const float* W, int ldw, int K, bf16_t* out, int kb, int nb, int lane) {
    const int r0 = nb * 256 + 4 * lane;
    int c0;
    if (MODE == 0) c0 = r0;
    else if (MODE == 1) c0 = r0 < 4096 ? r0 : r0 + 16;
    else { const int pn = r0 >> 8, rr = r0 & 255; c0 = rr < 128 ? 128 * pn + rr : 2048 + 128 * pn + (rr - 128); }
    const float* src = W + (size_t)(kb * 64) * ldw + c0;
    bf16_t* dst = out + (size_t)r0 * K + kb * 64;
#pragma unroll 2
    for (int st = 0; st < 8; ++st) {
        f32x4 v[8];
#pragma unroll
        for (int i = 0; i < 8; ++i) v[i] = *(const f32x4*)(src + (size_t)(st * 8 + i) * ldw);
#pragma unroll
        for (int j = 0; j < 4; ++j) { u32x4 w; w.x = cvt_pk_bf16(v[0][j], v[1][j]); w.y = cvt_pk_bf16(v[2][j], v[3][j]); w.z = cvt_pk_bf16(v[4][j], v[5][j]); w.w = cvt_pk_bf16(v[6][j], v[7][j]);
            *(u32x4*)(dst + (size_t)j * K + st * 8) = w; }
    }
}
__device__ __forceinline__ void p0_weights(const Args& a, int gw, int NGW, int lane) {
    constexpr int I_IN = 32 * 28, I_OUT = 32 * 8, I_GU = 32 * 16, I_D = 32 * 8;
    constexpr int NITEMS = I_IN + I_OUT + NEXP * (I_GU + I_D);
    for (int it = gw; it < NITEMS; it += NGW) {
        int r = it;
        if (r < I_IN) { cvt_strip<1>(a.in[I_WIN], NPROJ_SRC, DM, (bf16_t*)(a.ws + WS_WIN), r / 28, r % 28, lane); continue; } r -= I_IN;
        if (r < I_OUT) { cvt_strip<0>(a.in[I_WOUT], DM, DM, (bf16_t*)(a.ws + WS_WOUT), r / 8, r % 8, lane); continue; } r -= I_OUT;
        if (r < NEXP * I_GU) { const int e = r / I_GU, q = r % I_GU;
            cvt_strip<2>(a.in[I_WGU] + (size_t)e * DM * 2 * DE, 2 * DE, DM, (bf16_t*)(a.ws + WS_WGU) + (size_t)e * 2 * DE * DM, q / 16, q % 16, lane); continue; } r -= NEXP * I_GU;
        { const int e = r / I_D, q = r % I_D;
            cvt_strip<0>(a.in[I_WD] + (size_t)e * DE * DM, DM, DE, (bf16_t*)(a.ws + WS_WD) + (size_t)e * DM * DE, q / 8, q % 8, lane); }
    }
}

__device__ __forceinline__ void p2_qknorm(const Args& a, int gw, int NGW, int lane) {
    const bf16_t* P = (const bf16_t*)(a.ws + WS_P); bf16_t* QN = (bf16_t*)(a.ws + WS_QN); bf16_t* KN = (bf16_t*)(a.ws + WS_KN);
    const float qw0 = a.in[I_SBQNW][2 * lane], qw1 = a.in[I_SBQNW][2 * lane + 1], kw0 = a.in[I_SBKNW][2 * lane], kw1 = a.in[I_SBKNW][2 * lane + 1];
    const float QS = 0.08838834764831845f * 1.4426950408889634f;
    for (int it = gw; it < NTOK * NHEAD * 2; it += NGW) {
        const int which = it & 1, h = (it >> 1) & 7, row = it >> 4;
        const int b = row / LSEQ, t = row - b * LSEQ;
        const unsigned w = *(const unsigned*)(P + (size_t)row * NPROJ + (which ? PC_SBK : PC_SBQ) + h * HD + 2 * lane);
        const float v0 = bf_lo(w), v1 = bf_hi(w);
        const float rstd = 1.0f / sqrtf(wave_sum(v0 * v0 + v1 * v1) * (1.0f / HD) + NORM_EPS);
        const float o0 = which ? v0 * rstd * kw0 : v0 * rstd * qw0 * QS, o1 = which ? v1 * rstd * kw1 : v1 * rstd * qw1 * QS;
        *(unsigned*)((which ? KN : QN) + ((size_t)(b * NHEAD + h) * LROW + t) * HD + 2 * lane) = cvt_pk_bf16(o0, o1);
    }
}

__device__ __forceinline__ void p3_gdn_naive(const Args& a, LAS unsigned char* lds, int item, int tid, int lane, int wave) {
    const int b = item >> 3, h = item & 7;
    const bf16_t* P = (const bf16_t*)(a.ws + WS_P); const float* BETA = (const float*)(a.ws + WS_BETA); const float* GG = (const float*)(a.ws + WS_G);
    float* ORAW = (float*)(a.ws + WS_ORAW); bf16_t* MIX = (bf16_t*)(a.ws + WS_MIX);
    LAS float* buf = (LAS float*)lds;
    const int j = tid >> 2, part = tid & 3;
    const int which = tid >> 7, d = tid & 127; const bool conv = tid < 384;
    const int pcol = which * 1024 + h * HD + d;
    float cw0 = 0, cw1 = 0, cw2 = 0, cw3 = 0;
    if (conv) { const float* cwp = a.in[I_CONVW] + pcol; cw0 = cwp[0]; cw1 = cwp[3072]; cw2 = cwp[2 * 3072]; cw3 = cwp[3 * 3072]; }
    float xm1 = 0.f, xm2 = 0.f, xm3 = 0.f;
    float S[32];
#pragma unroll
    for (int i = 0; i < 32; ++i) S[i] = 0.f;
    const size_t row0 = (size_t)b * LSEQ;
    float xnext = conv ? bf2f(P[row0 * NPROJ + pcol]) : 0.f;
    float bnext = BETA[row0 * 8 + h], gnext = GG[row0 * 8 + h];
    for (int t = 0; t < LSEQ; ++t) {
        const float xt = xnext, beta = bnext, gam = expf(gnext);
        if (t + 1 < LSEQ) { if (conv) xnext = bf2f(P[(row0 + t + 1) * NPROJ + pcol]); bnext = BETA[(row0 + t + 1) * 8 + h]; gnext = GG[(row0 + t + 1) * 8 + h]; }
        LAS float* cb = buf + (t & 1) * 384;
        if (conv) { const float y = cw3 * xt + cw2 * xm1 + cw1 * xm2 + cw0 * xm3; xm3 = xm2; xm2 = xm1; xm1 = xt; cb[tid] = y / (1.0f + expf(-y)); }
        __syncthreads();
        float kk = 0.f, qq = 0.f, dk = 0.f; f32x4 kv[8], qv[8];
#pragma unroll
        for (int i = 0; i < 8; ++i) { kv[i] = *(const LAS f32x4*)(cb + 128 + 32 * part + 4 * i); qv[i] = *(const LAS f32x4*)(cb + 32 * part + 4 * i); }
#pragma unroll
        for (int i = 0; i < 8; ++i)
#pragma unroll
            for (int c = 0; c < 4; ++c) { kk += kv[i][c] * kv[i][c]; qq += qv[i][c] * qv[i][c]; dk += S[4 * i + c] * kv[i][c]; }
        kk += __shfl_xor(kk, 1); kk += __shfl_xor(kk, 2); qq += __shfl_xor(qq, 1); qq += __shfl_xor(qq, 2); dk += __shfl_xor(dk, 1); dk += __shfl_xor(dk, 2);
        const float rk = 1.0f / sqrtf(kk + NORM_EPS), rq = 0.08838834764831845f / sqrtf(qq + NORM_EPS);
        const float vj = cb[256 + j];
        const float vnew = beta * (vj - gam * rk * dk);
        const float kvn = rk * vnew; float oq = 0.f;
#pragma unroll
        for (int i = 0; i < 8; ++i)
#pragma unroll
            for (int c = 0; c < 4; ++c) { S[4 * i + c] = gam * S[4 * i + c] + kv[i][c] * kvn; oq += S[4 * i + c] * qv[i][c]; }
        oq += __shfl_xor(oq, 1); oq += __shfl_xor(oq, 2);
        if (t >= NMETA && part == 0) ORAW[((size_t)b * SEQ + (t - NMETA)) * 1024 + h * HD + j] = rq * oq;
    }
    __threadfence(); __syncthreads();
    const float nw0 = a.in[I_GDNNW][2 * lane], nw1 = a.in[I_GDNNW][2 * lane + 1];
    for (int s = wave; s < SEQ; s += NWAVES) {
        const size_t tok = (size_t)b * SEQ + s;
        const f32x2 o = *(const f32x2*)(ORAW + tok * 1024 + h * HD + 2 * lane);
        const float rstd = 1.0f / sqrtf(wave_sum(o.x * o.x + o.y * o.y) * (1.0f / HD) + NORM_EPS);
        const unsigned zw = *(const unsigned*)(P + (row0 + NMETA + s) * NPROJ + PC_Z + h * HD + 2 * lane);
        const float z0 = bf_lo(zw), z1 = bf_hi(zw);
        const float r0 = o.x * rstd * nw0 * (z0 / (1.0f + expf(-z0))), r1 = o.y * rstd * nw1 * (z1 / (1.0f + expf(-z1)));
        *(unsigned*)(MIX + tok * DM + h * HD + 2 * lane) = cvt_pk_bf16(r0, r1);
    }
}

namespace sba {
#define KSWZ(row, colB) ((row) * 256 + ((colB) ^ (((row) & 7) << 4)))
__device__ __forceinline__ int v_st(int k, int c) { const int kk = (k & ~0xC) | ((k & 4) << 1) | ((k & 8) >> 1); return ((kk >> 3) * 4 + (c >> 5)) * 512 + ((kk & 7) * 32 + (c & 31)) * 2; }
__device__ __forceinline__ int v_rd_base(int lane) { return ((lane & 3) << 3) | (((lane >> 2) & 3) << 6) | (((lane >> 4) & 1) << 5) | (((lane >> 5) & 1) << 8); }
constexpr int v_rd_off(int d0, int ks, int half) { return d0 * 512 + ks * 4096 + half * 2048; }
template <int OFF> __device__ __forceinline__ s16x4 tr_read(int vb) { s16x4 r; asm volatile("ds_read_b64_tr_b16 %0, %1 offset:%2" : "=&v"(r) : "v"(vb), "i"(OFF) : "memory"); return r; }
template <int D0> __device__ __forceinline__ void pv_one(f32x16& od, int vb, bf16x8 pa0, bf16x8 pa1, bf16x8 pa2, bf16x8 pa3) {
    const s16x4 l0 = tr_read<v_rd_off(D0, 0, 0)>(vb), h0 = tr_read<v_rd_off(D0, 0, 1)>(vb), l1 = tr_read<v_rd_off(D0, 1, 0)>(vb), h1 = tr_read<v_rd_off(D0, 1, 1)>(vb);
    const s16x4 l2 = tr_read<v_rd_off(D0, 2, 0)>(vb), h2 = tr_read<v_rd_off(D0, 2, 1)>(vb), l3 = tr_read<v_rd_off(D0, 3, 0)>(vb), h3 = tr_read<v_rd_off(D0, 3, 1)>(vb);
    asm volatile("s_waitcnt lgkmcnt(0)" ::: "memory"); __builtin_amdgcn_sched_barrier(0);
#define PK(L, H) (bf16x8){L[0], L[1], L[2], L[3], H[0], H[1], H[2], H[3]}
    od = __builtin_amdgcn_mfma_f32_32x32x16_bf16(pa0, PK(l0, h0), od, 0, 0, 0);
    od = __builtin_amdgcn_mfma_f32_32x32x16_bf16(pa1, PK(l1, h1), od, 0, 0, 0);
    od = __builtin_amdgcn_mfma_f32_32x32x16_bf16(pa2, PK(l2, h2), od, 0, 0, 0);
    od = __builtin_amdgcn_mfma_f32_32x32x16_bf16(pa3, PK(l3, h3), od, 0, 0, 0);
#undef PK
}
__device__ __forceinline__ int crow(int r, int hi) { return (r & 3) + 8 * (r >> 2) + 4 * hi; }
__device__ __forceinline__ int swap34(int k) { return (k & ~0x18) | ((k & 8) << 1) | ((k & 16) >> 1); }
__device__ __forceinline__ bf16x8 pack8(const f32x16& p, int base) {
    u32x4 w; w.x = cvt_pk_bf16(p[base + 0], p[base + 1]); w.y = cvt_pk_bf16(p[base + 2], p[base + 3]); w.z = cvt_pk_bf16(p[base + 4], p[base + 5]); w.w = cvt_pk_bf16(p[base + 6], p[base + 7]);
    return __builtin_bit_cast(bf16x8, w);
}
constexpr float SB_EXIT = 160.0f;

__device__ __forceinline__ void unit(const Args& a, LAS unsigned char* lds, volatile LAS int* done_cnt, int b, int h, int qb, int tid, int lane, int wid) {
    const bf16_t* QN = (const bf16_t*)(a.ws + WS_QN) + (size_t)(b * NHEAD + h) * LROW * HD;
    const bf16_t* KN = (const bf16_t*)(a.ws + WS_KN) + (size_t)(b * NHEAD + h) * LROW * HD;
    const bf16_t* Vp = (const bf16_t*)(a.ws + WS_P) + (size_t)b * LSEQ * NPROJ + PC_SBV + h * HD;
    bf16_t* MIX = (bf16_t*)(a.ws + WS_MIX);
    const int r32 = lane & 31, hi = lane >> 5;
    LAS unsigned char* K_lds = lds; LAS unsigned char* V_lds = lds + 16384;
    const int tq0 = NMETA + 256 * qb + 32 * wid, tq = tq0 + r32;
    __syncthreads();
    if (tid == 0) *done_cnt = 0;
    bf16x8 qr[8];
#pragma unroll
    for (int d0 = 0; d0 < 8; ++d0) qr[d0] = *(const bf16x8*)(QN + (size_t)tq * HD + d0 * 16 + hi * 8);
    const int sr = tid >> 4, sc = (tid & 15) * 8;
    const int vst0 = v_st(swap34(sr), sc), vst1 = v_st(32 + swap34(sr), sc);
    const int kst0 = KSWZ(sr, sc * 2), kst1 = KSWZ(32 + sr, sc * 2);
    const int vb0 = (int)(unsigned)(unsigned long)V_lds + v_rd_base(lane);
    const int prow = (r32 & 3) + 4 * (r32 >> 3) + 16 * ((r32 >> 2) & 1);
    f32x16 o[4];
#pragma unroll
    for (int d = 0; d < 4; ++d)
#pragma unroll
        for (int r = 0; r < 16; ++r) o[d][r] = 0.f;
    float carry = 0.f; bool flagged = false;
    for (int kt = 4 * qb + 4; kt >= 0; --kt) {
        const int k0 = 64 * kt;
        const bf16x8 ks0 = *(const bf16x8*)(KN + (size_t)(k0 + sr) * HD + sc), ks1 = *(const bf16x8*)(KN + (size_t)(k0 + 32 + sr) * HD + sc);
        const bf16x8 vs0 = *(const bf16x8*)(Vp + (size_t)(k0 + sr) * NPROJ + sc), vs1 = *(const bf16x8*)(Vp + (size_t)(k0 + 32 + sr) * NPROJ + sc);
        __syncthreads();
        if (*done_cnt == NWAVES) break;
        *(LAS bf16x8*)(K_lds + kst0) = ks0; *(LAS bf16x8*)(K_lds + kst1) = ks1; *(LAS bf16x8*)(V_lds + vst0) = vs0; *(LAS bf16x8*)(V_lds + vst1) = vs1;
        __syncthreads();
        if (k0 >= tq0 + 32) continue;
        f32x16 p0, p1;
#pragma unroll
        for (int r = 0; r < 16; ++r) { p0[r] = 0.f; p1[r] = 0.f; }
#pragma unroll
        for (int d0 = 0; d0 < 8; ++d0) { const int cb = (d0 * 16 + hi * 8) * 2;
            const bf16x8 b0 = *(const LAS bf16x8*)(K_lds + KSWZ(prow, cb)), b1 = *(const LAS bf16x8*)(K_lds + KSWZ(32 + prow, cb));
            p0 = __builtin_amdgcn_mfma_f32_32x32x16_bf16(b0, qr[d0], p0, 0, 0, 0);
            p1 = __builtin_amdgcn_mfma_f32_32x32x16_bf16(b1, qr[d0], p1, 0, 0, 0); }
        const bool need_mask = (k0 + 63 >= tq0);
        f32x16 s0, s1; float t0 = 0.f, t1 = 0.f;
#pragma unroll
        for (int r = 0; r < 16; ++r) {
            float e0 = __builtin_amdgcn_exp2f(p0[r]), e1 = __builtin_amdgcn_exp2f(p1[r]);
            float q0 = __builtin_amdgcn_logf(1.0f + e0), q1 = __builtin_amdgcn_logf(1.0f + e1);
            if (need_mask) { const bool v0 = (k0 + 16 * hi + r) < tq, v1 = (k0 + 32 + 16 * hi + r) < tq; e0 = v0 ? e0 : 0.f; q0 = v0 ? q0 : 0.f; e1 = v1 ? e1 : 0.f; q1 = v1 ? q1 : 0.f; }
            p0[r] = e0; p1[r] = e1; s0[r] = q0; s1[r] = q1; t0 += q0; t1 += q1; }
        float t1lo, t1hi, t0lo, t0hi;
        { auto rr = __builtin_amdgcn_permlane32_swap(__float_as_uint(t1), __float_as_uint(t1), false, false); t1lo = __uint_as_float(rr[0]); t1hi = __uint_as_float(rr[1]); }
        { auto rr = __builtin_amdgcn_permlane32_swap(__float_as_uint(t0), __float_as_uint(t0), false, false); t0lo = __uint_as_float(rr[0]); t0hi = __uint_as_float(rr[1]); }
        float run1 = carry + (hi ? 0.f : t1hi), run0 = carry + (t1lo + t1hi) + (hi ? 0.f : t0hi);
#pragma unroll
        for (int r = 15; r >= 0; --r) { run1 += s1[r]; p1[r] = p1[r] * __builtin_amdgcn_exp2f(-run1); run0 += s0[r]; p0[r] = p0[r] * __builtin_amdgcn_exp2f(-run0); }
        carry += (t1lo + t1hi) + (t0lo + t0hi);
        const bf16x8 pa0 = pack8(p0, 0), pa1 = pack8(p0, 8), pa2 = pack8(p1, 0), pa3 = pack8(p1, 8);
        pv_one<0>(o[0], vb0, pa0, pa1, pa2, pa3); pv_one<1>(o[1], vb0, pa0, pa1, pa2, pa3); pv_one<2>(o[2], vb0, pa0, pa1, pa2, pa3); pv_one<3>(o[3], vb0, pa0, pa1, pa2, pa3);
        if (!flagged && __all(carry >= SB_EXIT)) { flagged = true; if (lane == 0) (void)__hip_atomic_fetch_add((LAS int*)done_cnt, 1, __ATOMIC_RELAXED, __HIP_MEMORY_SCOPE_WORKGROUP); }
    }
    const float* onw = a.in[I_SBONW];
    float wv[4];
#pragma unroll
    for (int d0 = 0; d0 < 4; ++d0) wv[d0] = onw[32 * d0 + r32];
#pragma unroll
    for (int r = 0; r < 16; ++r) {
        float ss = (o[0][r] * o[0][r] + o[1][r] * o[1][r]) + (o[2][r] * o[2][r] + o[3][r] * o[3][r]);
        ss += __shfl_xor(ss, 1); ss += __shfl_xor(ss, 2); ss += __shfl_xor(ss, 4); ss += __shfl_xor(ss, 8); ss += __shfl_xor(ss, 16);
        const float rstd = 1.0f / sqrtf(ss * (1.0f / HD) + NORM_EPS);
        const size_t tok = (size_t)b * SEQ + (tq0 - NMETA) + crow(r, hi);
        bf16_t* dst = MIX + tok * DM + 1024 + h * HD + r32;
#pragma unroll
        for (int d0 = 0; d0 < 4; ++d0) dst[32 * d0] = (bf16_t)(cvt_pk_bf16(o[d0][r] * rstd * wv[d0], 0.f) & 0xffffu);
    }
}
}

__device__ __forceinline__ void p5_router(const Args& a, LAS unsigned char* lds, int G, int c, int tid, int lane, int wave) {
    LAS float* wl = (LAS float*)lds;
    LAS float* lg = (LAS float*)(lds + 132096);
    LAS int* misc = (LAS int*)(lds + MISC_OFF);
    const float* H1 = a.out; const float* rw = a.in[I_RW]; const float* rb = a.in[I_RB];
    bf16_t* HN2 = (bf16_t*)(a.ws + WS_HN);
    int* RE = (int*)(a.ws + WS_RE); int* RP = (int*)(a.ws + WS_RP); float* RG = (float*)(a.ws + WS_RG); int* LIST = (int*)(a.ws + WS_LIST);
    unsigned* ecnt = (unsigned*)(a.ws + WS_CTL) + CW_ECNT;
    f32x4 wn[8];
#pragma unroll
    for (int j = 0; j < 8; ++j) wn[j] = *((const f32x4*)a.in[I_FFNNW] + lane + 64 * j);
    for (int blk = c; blk < NREAL / 64; blk += G) {
        for (int pass = 0; pass < 2; ++pass) {
            __syncthreads();
            for (int idx = tid; idx < 2048 * 16; idx += NTHREADS) { const int k = idx >> 4, cc = idx & 15; wl[cc * WLS + k] = rw[(size_t)k * NEXP + pass * 16 + cc]; }
            if (pass == 0 && tid < 32) misc[40 + tid] = 0;
            __syncthreads();
            for (int rr = 0; rr < 8; ++rr) {
                const int rloc = wave * 8 + rr; const size_t row = (size_t)blk * 64 + rloc;
                f32x4 v[8]; float ss = 0.f;
#pragma unroll
                for (int j = 0; j < 8; ++j) { v[j] = *((const f32x4*)(H1 + row * DM) + lane + 64 * j); ss += (v[j].x * v[j].x + v[j].y * v[j].y) + (v[j].z * v[j].z + v[j].w * v[j].w); }
                const float rstd = 1.0f / sqrtf(wave_sum(ss) * (1.0f / DM) + NORM_EPS);
                GAS unsigned long long* o8 = (GAS unsigned long long*)(HN2 + row * DM) + lane;
#pragma unroll
                for (int j = 0; j < 8; ++j) { v[j] = v[j] * rstd * wn[j];
                    if (pass == 0) o8[64 * j] = (unsigned long long)cvt_pk_bf16(v[j].x, v[j].y) | ((unsigned long long)cvt_pk_bf16(v[j].z, v[j].w) << 32); }
                float s[16]; dot16(v, wl, lane, s);
                float sv = s[0];
#pragma unroll
                for (int cc = 1; cc < 16; ++cc) sv = ((lane & 15) == cc) ? s[cc] : sv;
                if (lane < 16) lg[rloc * 33 + pass * 16 + lane] = sv;
            }
        }
        __syncthreads();
        int ek[4] = {0, 0, 0, 0}, rk[4] = {0, 0, 0, 0}; float gk[4] = {0.f, 0.f, 0.f, 0.f};
        if (tid < 64) {
            float v[32];
#pragma unroll
            for (int e = 0; e < 32; ++e) v[e] = lg[tid * 33 + e] + rb[e];
            float val[4];
#pragma unroll
            for (int k = 0; k < 4; ++k) { float best = -3.0e38f; int bi = 0;
#pragma unroll
                for (int e = 0; e < 32; ++e) { const bool gt = v[e] > best; best = gt ? v[e] : best; bi = gt ? e : bi; }
#pragma unroll
                for (int e = 0; e < 32; ++e) v[e] = (e == bi) ? -3.0e38f : v[e];
                ek[k] = bi; val[k] = best; }
            float den = 0.f;
#pragma unroll
            for (int k = 0; k < 4; ++k) { gk[k] = expf(val[k] - val[0]); den += gk[k]; }
#pragma unroll
            for (int k = 0; k < 4; ++k) { gk[k] = gk[k] / den; rk[k] = __hip_atomic_fetch_add(&misc[40 + ek[k]], 1, __ATOMIC_RELAXED, __HIP_MEMORY_SCOPE_WORKGROUP); }
        }
        __syncthreads();
        if (tid < 32) { const int cnt = misc[40 + tid]; misc[72 + tid] = cnt ? (int)atomicAdd(&ecnt[tid], (unsigned)cnt) : 0; }
        __syncthreads();
        if (tid < 64) { const int tok = blk * 64 + tid;
#pragma unroll
            for (int k = 0; k < 4; ++k) { const int pos = misc[72 + ek[k]] + rk[k]; LIST[(size_t)ek[k] * NREAL + pos] = tok; RE[tok * 4 + k] = ek[k]; RP[tok * 4 + k] = pos; RG[tok * 4 + k] = gk[k]; } }
    }
    __syncthreads();
}

__device__ __forceinline__ int moe_setup(const Args& a, LAS int* misc, int tid) {
    const unsigned* ecnt = (const unsigned*)(a.ws + WS_CTL) + CW_ECNT;
    __syncthreads();
    if (tid == 0) { int acc = 0;
        for (int e = 0; e < NEXP; ++e) { const int cnt = (int)__hip_atomic_load(ecnt + e, __ATOMIC_RELAXED, __HIP_MEMORY_SCOPE_AGENT); misc[104 + e] = cnt; misc[e] = acc; acc += (cnt + 255) >> 8; }
        misc[32] = acc; }
    __syncthreads();
    return misc[32];
}

__device__ __forceinline__ void p8_combine(const Args& a, const LAS int* misc, int gw, int NGW, int lane) {
    const int* RE = (const int*)(a.ws + WS_RE); const int* RP = (const int*)(a.ws + WS_RP); const float* RG = (const float*)(a.ws + WS_RG);
    const bf16_t* Y = (const bf16_t*)(a.ws + WS_Y); const float* bd = a.in[I_BD]; float* out = a.out;
    for (int row = gw; row < NREAL; row += NGW) {
        int e[4]; size_t slot[4]; float g[4];
#pragma unroll
        for (int k = 0; k < 4; ++k) { e[k] = RE[row * 4 + k]; slot[k] = (size_t)misc[e[k]] * 256 + RP[row * 4 + k]; g[k] = RG[row * 4 + k]; }
#pragma unroll
        for (int j = 0; j < 4; ++j) { const int col = 8 * lane + 512 * j;
            f32x4 a0 = *(const f32x4*)(out + (size_t)row * DM + col), a1 = *(const f32x4*)(out + (size_t)row * DM + col + 4);
#pragma unroll
            for (int k = 0; k < 4; ++k) { const u32x4 y = *(const u32x4*)(Y + slot[k] * DM + col);
                const f32x4 b0 = *(const f32x4*)(bd + (size_t)e[k] * DM + col), b1 = *(const f32x4*)(bd + (size_t)e[k] * DM + col + 4);
                a0.x += g[k] * (bf_lo(y.x) + b0.x); a0.y += g[k] * (bf_hi(y.x) + b0.y); a0.z += g[k] * (bf_lo(y.y) + b0.z); a0.w += g[k] * (bf_hi(y.y) + b0.w);
                a1.x += g[k] * (bf_lo(y.z) + b1.x); a1.y += g[k] * (bf_hi(y.z) + b1.y); a1.z += g[k] * (bf_lo(y.w) + b1.z); a1.w += g[k] * (bf_hi(y.w) + b1.w); }
            *(f32x4*)(out + (size_t)row * DM + col) = a0; *(f32x4*)(out + (size_t)row * DM + col + 4) = a1; }
    }
}

constexpr int NPH = 9;
__global__ void __launch_bounds__(NTHREADS, 2) hymba_fwd(Args args) {
    extern __shared__ __attribute__((aligned(16))) unsigned char lds_raw[];
    LAS unsigned char* lds = (LAS unsigned char*)lds_raw;
    LAS int* misc = (LAS int*)(lds + MISC_OFF);
    const int tid = threadIdx.x, lane = tid & 63, wave = __builtin_amdgcn_readfirstlane(tid >> 6);
    const int G = gridDim.x, bx = blockIdx.x;
    const int vcu = (G % 8 == 0) ? (bx % 8) * (G / 8) + bx / 8 : bx;
    const int gw = vcu * NWAVES + wave, NGW = G * NWAVES;
    unsigned* ctl = (unsigned*)(args.ws + WS_CTL);
    for (int u = tid; u < 256; u += NTHREADS) misc[u] = 0;
    __syncthreads();
    XcdBarrier bar; bar.bar = ctl + CW_BAR; bar.x = 0; bar.st = nullptr;
    const int lo = args.ph_lo, hi = args.ph_hi;
    if (hi - lo > 1) bar = xcd_barrier_post(ctl + CW_BAR, (volatile LAS unsigned*)(misc + 200));
#define IN(k) (lo <= (k) && (k) < hi)
#define SEAM(k) do { if (IN(k) && IN((k) + 1)) xcd_barrier(bar); } while (0)

    if (IN(0)) { p0_rows(args, lds, gw, NGW, tid, lane); p0_weights(args, gw, NGW, lane); }
    SEAM(0);
    if (IN(1)) {
        pg8::PlainOrder S; S.init(MPAD, NPROJ, DM, args.ws + WS_WIN, G, bx);
        pg8::EpiBf16 E{(bf16_t*)(args.ws + WS_P), NPROJ};
        pg8::gemm_phase<pg8::EpiBf16, pg8::PlainOrder, true, true>(lds, (const char*)(args.ws + WS_HN), DM, S, E);
    }
    SEAM(1);
    if (IN(2)) p2_qknorm(args, gw, NGW, lane);
    SEAM(2);
    if (IN(3)) {
        const int NG = (G >= 64) ? 32 : 0;
        if (bx < 32 || NG == 0) { for (int it = bx; it < 32; it += G) p3_gdn_naive(args, lds, it, tid, lane, wave); }
        if (bx >= NG) { for (int u = bx - NG; u < 512; u += G - NG) sba::unit(args, lds, (volatile LAS int*)(misc + 210), u >> 7, (u >> 4) & 7, u & 15, tid, lane, wave); }
    }
    SEAM(3);
    if (IN(4)) {
        pg8::PlainOrder S; S.init(NREAL, DM, DM, args.ws + WS_WOUT, G, bx);
        pg8::EpiResF32 E{args.in[I_X], args.out, DM};
        pg8::gemm_phase<pg8::EpiResF32, pg8::PlainOrder, true, true>(lds, (const char*)(args.ws + WS_MIX), DM, S, E);
    }
    SEAM(4);
    if (IN(5)) p5_router(args, lds, G, bx, tid, lane, wave);
    SEAM(5);
    if (IN(6)) {
        const int mt = moe_setup(args, misc, tid);
        pg8::MoeOrder<true> S; S.tpre = misc; S.tok = (const LAS int*)(lds + TOK_OFF); S.nN = 16; S.nwg = mt * 16; S.G = G; S.c = bx;
        S.Bt = (const char*)(args.ws + WS_WGU); S.estride = (size_t)2 * DE * DM * 2; S.K2 = DM * 2;
        const int* LIST = (const int*)(args.ws + WS_LIST);
        for (int ui = 0; ui < TOK_CAP; ++ui) { pg8::Unit u; if (!S.next(ui, u)) break;
            if (tid < 256) { const int idx = (u.pm - misc[u.e]) * 256 + tid; ((LAS int*)(lds + TOK_OFF))[ui * 256 + tid] = idx < misc[104 + u.e] ? LIST[(size_t)u.e * NREAL + idx] : 0; } }
        __syncthreads();
        pg8::EpiSwiGLU E{(bf16_t*)(args.ws + WS_ACT), args.in[I_BGU]};
        pg8::gemm_phase<pg8::EpiSwiGLU, pg8::MoeOrder<true>, true, true>(lds, (const char*)(args.ws + WS_HN), DM, S, E);
    }
    SEAM(6);
    if (IN(7)) {
        const int mt = moe_setup(args, misc, tid);
        pg8::MoeOrder<false> S; S.tpre = misc; S.tok = nullptr; S.nN = 8; S.nwg = mt * 8; S.G = G; S.c = bx;
        S.Bt = (const char*)(args.ws + WS_WD); S.estride = (size_t)DM * DE * 2; S.K2 = DE * 2;
        pg8::EpiBf16 E{(bf16_t*)(args.ws + WS_Y), DM};
        pg8::gemm_phase<pg8::EpiBf16, pg8::MoeOrder<false>, true, true>(lds, (const char*)(args.ws + WS_ACT), DE, S, E);
    }
    SEAM(7);
    if (IN(8)) { (void)moe_setup(args, misc, tid); p8_combine(args, misc, gw, NGW, lane); }
#undef IN
#undef SEAM
}

extern "C" void kernel_launch(void* const* d_in, const int* in_sizes, int n_in, void* d_out, int out_size, void* d_ws, size_t ws_size, hipStream_t stream) {
    static int grid = 0;
    if (grid == 0) {
        if (n_in != 19 || out_size != NREAL * DM || ws_size < WS_END) { fprintf(stderr, "kernel_launch: unexpected shapes (n_in %d out %d ws %zu need %zu)\n", n_in, out_size, ws_size, (size_t)WS_END); grid = -1; return; }
        int dev = 0, cus = 0, per_cu = 0;
        if (hipGetDevice(&dev) != hipSuccess || hipDeviceGetAttribute(&cus, hipDeviceAttributeMultiprocessorCount, dev) != hipSuccess) { grid = -1; return; }
        if (hipFuncSetAttribute((const void*)hymba_fwd, hipFuncAttributeMaxDynamicSharedMemorySize, LDS_BYTES) != hipSuccess) { fprintf(stderr, "kernel_launch: hipFuncSetAttribute failed\n"); grid = -1; return; }
        if (hipOccupancyMaxActiveBlocksPerMultiprocessor(&per_cu, (const void*)hymba_fwd, NTHREADS, LDS_BYTES) != hipSuccess || per_cu < 1) { fprintf(stderr, "kernel_launch: occupancy query says %d\n", per_cu); grid = -1; return; }
        (void)hipGetLastError();
        grid = cus;
    }
    if (grid < 0) return;
    (void)hipMemsetAsync((char*)d_ws + WS_CTL, 0, CTL_ZERO_BYTES, stream);
    Args a{};
    for (int i = 0; i < 19; ++i) a.in[i] = (const float*)d_in[i];
    a.out = (float*)d_out; a.ws = (unsigned char*)d_ws;
#if MK_N_LAUNCHES == 1
    a.ph_lo = 0; a.ph_hi = NPH;
    hipLaunchKernelGGL(hymba_fwd, dim3(grid), dim3(NTHREADS), LDS_BYTES, stream, a);
#else
    for (int p = 0; p < NPH; ++p) { a.ph_lo = p; a.ph_hi = p + 1; hipLaunchKernelGGL(hymba_fwd, dim3(grid), dim3(NTHREADS), LDS_BYTES, stream, a); }
#endif
    const hipError_t le = hipPeekAtLastError();
    if (le != hipSuccess) fprintf(stderr, "kernel_launch: launch failed: %s\n", hipGetErrorName(le));
}
```

```cpp
#include <hip/hip_runtime.h>
#include <cstdio>
#include <cstdint>

#ifndef GDN_CHUNKED
#define GDN_CHUNKED 1
#endif
#ifndef MK_N_LAUNCHES
#define MK_N_LAUNCHES 1
#endif

constexpr int NB = 4, SEQ = 4096, NMETA = 16, LSEQ = SEQ + NMETA;
constexpr int DM = 2048, NTOK = NB * LSEQ  , MPAD = 16640  , NREAL = NB * SEQ  ;
constexpr int NPROJ_SRC = 7184, NPROJ = 7168;
constexpr int NHEAD = 8, HD = 128;
constexpr int PC_QKV = 0, PC_Z = 3072, PC_SBQ = 4096, PC_SBK = 5120, PC_SBV = 6144;
constexpr int NEXP = 32, TOPK = 4, DE = 2048;
constexpr int SLOT_ROWS = 73728;
constexpr int LROW = 4224;
constexpr float NORM_EPS = 1e-6f;

constexpr size_t MiB = 1u << 20;
constexpr size_t WS_CTL = 0, CTL_ZERO_BYTES = 1 * MiB;
constexpr size_t WS_WIN = 1 * MiB;
constexpr size_t WS_WOUT = WS_WIN + (size_t)NPROJ * DM * 2;
constexpr size_t WS_WGU = WS_WOUT + (size_t)DM * DM * 2;
constexpr size_t WS_WD = WS_WGU + (size_t)NEXP * 2 * DE * DM * 2;
constexpr size_t WS_HN = WS_WD + (size_t)NEXP * DM * DE * 2;
constexpr size_t WS_BETA = WS_HN + (size_t)MPAD * DM * 2;
constexpr size_t WS_G = WS_BETA + (size_t)NTOK * 8 * 4 + 256;
constexpr size_t WS_P = WS_G + (size_t)NTOK * 8 * 4 + 256;
constexpr size_t WS_QN = WS_P + (size_t)MPAD * NPROJ * 2;
constexpr size_t WS_KN = WS_QN + (size_t)NB * NHEAD * LROW * HD * 2;
constexpr size_t WS_ORAW = WS_KN + (size_t)NB * NHEAD * LROW * HD * 2;
constexpr size_t WS_MIX = WS_ORAW + (size_t)NREAL * 1024 * 4;
constexpr size_t WS_RE = WS_MIX + (size_t)NREAL * DM * 2;
constexpr size_t WS_RP = WS_RE + (size_t)NREAL * 4 * 4;
constexpr size_t WS_RG = WS_RP + (size_t)NREAL * 4 * 4;
constexpr size_t WS_LIST = WS_RG + (size_t)NREAL * 4 * 4;
constexpr size_t WS_ACT = WS_LIST + (size_t)NEXP * NREAL * 4;
constexpr size_t WS_Y = WS_ACT + (size_t)SLOT_ROWS * DE * 2;
constexpr size_t WS_GCH = WS_Y + (size_t)SLOT_ROWS * DM * 2;
constexpr size_t WS_GL = WS_GCH + (size_t)32 * 65 * 73728;
constexpr size_t WS_END = WS_GL + 32 * 65 * 4 + 256;
constexpr int CW_ECNT = 64;
constexpr int CW_BAR = 4096;

constexpr int LDS_STAGE = 131072;
constexpr int TOK_OFF = LDS_STAGE, TOK_CAP = 20;
constexpr int MISC_OFF = TOK_OFF + TOK_CAP * 256 * 4;
constexpr int LDS_BYTES = MISC_OFF + 1024;

#define GAS __attribute__((address_space(1)))
#define LAS __attribute__((address_space(3)))
typedef unsigned short bf16_t;
typedef short bf16x8 __attribute__((ext_vector_type(8)));
typedef short s16x4 __attribute__((ext_vector_type(4)));
typedef float f32x4 __attribute__((ext_vector_type(4)));
typedef float f32x2 __attribute__((ext_vector_type(2)));
typedef float f32x16 __attribute__((ext_vector_type(16)));
typedef unsigned u32x4 __attribute__((ext_vector_type(4)));
typedef unsigned u32x2 __attribute__((ext_vector_type(2)));

typedef __bf16 bf16x2_t __attribute__((ext_vector_type(2)));
__device__ __forceinline__ unsigned cvt_pk_bf16(float lo, float hi) { const f32x2 v = {lo, hi}; const bf16x2_t b = __builtin_convertvector(v, bf16x2_t); return __builtin_bit_cast(unsigned, b); }
__device__ __forceinline__ float bf_lo(unsigned w) { return __uint_as_float(w << 16); }
__device__ __forceinline__ float bf_hi(unsigned w) { return __uint_as_float(w & 0xffff0000u); }
__device__ __forceinline__ float bf2f(bf16_t b) { return __uint_as_float(((unsigned)b) << 16); }
__device__ __forceinline__ float wave_sum(float v) {
#pragma unroll
    for (int o = 1; o < 64; o <<= 1) v += __shfl_xor(v, o);
    return v;
}

namespace pg8 {
constexpr int BM = 256, BK = 64, HALF = 128, HTB = HALF * BK * 2, STAGE_BYTES = 8 * HTB, NXCD = 8, WGM = 8;
__host__ __device__ __forceinline__ int lds_byte(int r, int c) { const int st = (r >> 4) * 2 + (c >> 5), rr = r & 15, cc = c & 31, ob = rr * 64 + cc * 2; return st * 1024 + (ob ^ (((ob >> 9) & 1) << 5)); }
__host__ __device__ __forceinline__ void stage_rc(int b, int& R, int& C) { const int st = b / 1024, sb = b % 1024, swz = sb ^ (((sb >> 9) & 1) << 5); R = (st >> 1) * 16 + swz / 64; C = (st & 1) * 32 + (swz % 64) / 2; }
__host__ __device__ __forceinline__ int perm32(int rho) { const int n = rho >> 4, i = rho & 15; return 8 * (i >> 2) + 4 * n + (i & 3); }

struct Unit { int pm, pn, e, ui; };

__device__ __forceinline__ int xcd_remap(int L, int nwg) { const int q = nwg / NXCD, r = nwg % NXCD, xcd = L % NXCD, off = L / NXCD; return (xcd < r ? xcd * (q + 1) : r * (q + 1) + (xcd - r) * q) + off; }

struct PlainOrder {
    int nM, nN, nwg, G, c; const char* Bt; unsigned K2;
    __device__ void init(int M, int N, int K, const void* Bt_, int G_, int c_) { nM = M / BM; nN = N / BM; nwg = nM * nN; G = G_; c = c_; Bt = (const char*)Bt_; K2 = (unsigned)K * 2u; }
    __device__ __forceinline__ bool next(int i, Unit& u) const {
        const long L = (long)i * G + c; if (L >= nwg) return false;
        const int wgid = xcd_remap((int)L, nwg);
        const int nig = WGM * nN, gid = wgid / nig, fm = gid * WGM, gsz = (nM - fm) < WGM ? (nM - fm) : WGM;
        u.pm = fm + ((wgid % nig) % gsz); u.pn = (wgid % nig) / gsz; u.e = 0; u.ui = i; return true;
    }
    __device__ __forceinline__ const char* b_ptr(const Unit& u) const { return Bt + (size_t)u.pn * BM * K2; }
    __device__ __forceinline__ unsigned a_off(const Unit& u, int r) const { return (unsigned)(u.pm * BM + r) * K2; }
};
template <bool GATHER> struct MoeOrder {
    const LAS int* tpre; const LAS int* tok; int nN, nwg, G, c; const char* Bt; size_t estride; unsigned K2;
    __device__ __forceinline__ bool next(int i, Unit& u) const {
        const long L = (long)i * G + c; if (L >= nwg) return false;
        const int wgid = xcd_remap((int)L, nwg);
        int e = 0;
#pragma unroll 1
        for (int j = 1; j < NEXP; ++j) e = (wgid >= tpre[j] * nN) ? j : e;
        const int t0 = tpre[e], nt = tpre[e + 1] - t0, loc = wgid - t0 * nN;
        u.e = e; u.pn = loc / nt; u.pm = t0 + loc % nt; u.ui = i; return true;
    }
    __device__ __forceinline__ const char* b_ptr(const Unit& u) const { return Bt + (size_t)u.e * estride + (size_t)u.pn * BM * K2; }
    __device__ __forceinline__ unsigned a_off(const Unit& u, int r) const {
        if (GATHER) return (unsigned)tok[u.ui * 256 + r] * K2;
        return (unsigned)(u.pm * BM + r) * K2;
    }
};

struct EpiBf16 {
    static constexpr bool PERM = true;
    bf16_t* O; int ldc;
    __device__ __forceinline__ void operator()(const f32x4 (&acc)[2][2][4][2], const Unit& u, int wr, int wc, int fr, int fq) const {
        const int row0 = u.pm * BM + wr * 64 + fr, col0 = u.pn * BM + wc * 32 + 8 * fq;
#pragma unroll
        for (int ai = 0; ai < 2; ++ai)
#pragma unroll
            for (int m = 0; m < 4; ++m) { bf16_t* rowp = O + (size_t)(row0 + ai * HALF + m * 16) * ldc + col0;
#pragma unroll
                for (int bj = 0; bj < 2; ++bj) { const f32x4 v0 = acc[ai][bj][m][0], v1 = acc[ai][bj][m][1];
                    u32x4 w; w.x = cvt_pk_bf16(v0[0], v0[1]); w.y = cvt_pk_bf16(v0[2], v0[3]); w.z = cvt_pk_bf16(v1[0], v1[1]); w.w = cvt_pk_bf16(v1[2], v1[3]);
                    *(u32x4*)(rowp + bj * HALF) = w; } }
    }
};
struct EpiResF32 {
    static constexpr bool PERM = false;
    const float* X; float* out; int ldc;
    __device__ __forceinline__ void operator()(const f32x4 (&acc)[2][2][4][2], const Unit& u, int wr, int wc, int fr, int fq) const {
        const int row0 = u.pm * BM + wr * 64 + fr, col0 = u.pn * BM + wc * 32 + 4 * fq;
#pragma unroll
        for (int ai = 0; ai < 2; ++ai)
#pragma unroll
            for (int m = 0; m < 4; ++m) { const size_t off = (size_t)(row0 + ai * HALF + m * 16) * ldc + col0;
#pragma unroll
                for (int bj = 0; bj < 2; ++bj)
#pragma unroll
                    for (int n = 0; n < 2; ++n) { const f32x4 xv = *(const f32x4*)(X + off + bj * HALF + n * 16); *(f32x4*)(out + off + bj * HALF + n * 16) = xv + acc[ai][bj][m][n]; }
                asm volatile("" ::: "memory"); }
    }
};
__device__ __forceinline__ float swiglu1(float g, float uu) {
    g = fminf(g, 7.0f); uu = fminf(fmaxf(uu, -7.0f), 7.0f);
    const float sg = __builtin_amdgcn_rcpf(1.0f + __builtin_amdgcn_exp2f(-1.702f * 1.4426950408889634f * g));
    return (uu + 1.0f) * g * sg;
}
struct EpiSwiGLU {
    static constexpr bool PERM = true;
    bf16_t* act; const float* bgu;
    __device__ __forceinline__ void operator()(const f32x4 (&acc)[2][2][4][2], const Unit& u, int wr, int wc, int fr, int fq) const {
        const int row0 = u.pm * BM + wr * 64 + fr, col0 = u.pn * HALF + wc * 32 + 8 * fq;
        const float* bg = bgu + (size_t)u.e * 4096 + col0;
        const f32x4 bg0 = *(const f32x4*)(bg), bg1 = *(const f32x4*)(bg + 4), bu0 = *(const f32x4*)(bg + 2048), bu1 = *(const f32x4*)(bg + 2052);
#pragma unroll
        for (int ai = 0; ai < 2; ++ai)
#pragma unroll
            for (int m = 0; m < 4; ++m) { bf16_t* rowp = act + (size_t)(row0 + ai * HALF + m * 16) * DE + col0;
                const f32x4 g0 = acc[ai][0][m][0] + bg0, g1 = acc[ai][0][m][1] + bg1, u0 = acc[ai][1][m][0] + bu0, u1 = acc[ai][1][m][1] + bu1;
                u32x4 w; w.x = cvt_pk_bf16(swiglu1(g0[0], u0[0]), swiglu1(g0[1], u0[1])); w.y = cvt_pk_bf16(swiglu1(g0[2], u0[2]), swiglu1(g0[3], u0[3]));
                w.z = cvt_pk_bf16(swiglu1(g1[0], u1[0]), swiglu1(g1[1], u1[1])); w.w = cvt_pk_bf16(swiglu1(g1[2], u1[2]), swiglu1(g1[3], u1[3]));
                *(u32x4*)rowp = w; }
    }
};

template <class Epi, class Sched, bool ALIGN_EPI, bool SP2>
__device__ __forceinline__ void gemm_phase(LAS unsigned char* lds, const char* A0, int K, const Sched& S, const Epi& E) {
    const int tid = threadIdx.x, wid = __builtin_amdgcn_readfirstlane(tid >> 6), lane = tid & 63, wr = wid >> 2, wc = wid & 3, fr = lane & 15, fq = lane >> 4;
    const int nt = K / BK;
    int Rr[2], Cc[2]; unsigned voffB[2];
#pragma unroll
    for (int i = 0; i < 2; ++i) { int R, C; stage_rc(tid * 16 + i * 8192, R, C); const int Rb = Epi::PERM ? ((R & ~31) + perm32(R & 31)) : R;
        Rr[i] = R; Cc[i] = C * 2; voffB[i] = (unsigned)(Rb * K + C) * 2u; }
    const size_t kstep = (size_t)(BK * 2);
    const size_t hstep = (size_t)HALF * K * 2;
    const unsigned ldsw = (unsigned)wid * 1024u;
    const int aoff = lds_byte(wr * 64 + fr, fq * 8), boff = lds_byte(wc * 32 + fr, fq * 8);
#define PG8_SA(b, h) (((b) * 2 + (h)) * HTB)
#define PG8_SB(b, h) ((4 + (b) * 2 + (h)) * HTB)
#define PG8_STAGE(bufoff, gbase, voff) do { _Pragma("unroll") for (int _i = 0; _i < 2; ++_i) \
        __builtin_amdgcn_global_load_lds((const unsigned*)((const char*)(gbase) + (voff)[_i]), (LAS unsigned*)(lds + (bufoff) + ldsw + _i * 8192), 16, 0, 0); } while (0)
#define PG8_LDA(dst, b, h) do { _Pragma("unroll") for (int m = 0; m < 4; ++m) _Pragma("unroll") for (int k = 0; k < 2; ++k) dst[m][k] = *(const LAS bf16x8*)(lds + PG8_SA(b, h) + aoff + m * 2048 + k * 1024); } while (0)
#define PG8_LDB(dst, b, h) do { _Pragma("unroll") for (int n = 0; n < 2; ++n) _Pragma("unroll") for (int k = 0; k < 2; ++k) dst[n][k] = *(const LAS bf16x8*)(lds + PG8_SB(b, h) + boff + n * 2048 + k * 1024); } while (0)
#define PG8_MMA(ai, bj, At, Bt) do { __builtin_amdgcn_s_setprio(1); _Pragma("unroll") for (int m = 0; m < 4; ++m) _Pragma("unroll") for (int n = 0; n < 2; ++n) _Pragma("unroll") for (int k = 0; k < 2; ++k) \
        acc[ai][bj][m][n] = __builtin_amdgcn_mfma_f32_16x16x32_bf16(Bt[n][k], At[m][k], acc[ai][bj][m][n], 0, 0, 0); __builtin_amdgcn_s_setprio(0); } while (0)
#define PG8_WAIT_V(n) asm volatile("s_waitcnt vmcnt(" #n ")" ::: "memory")
#define PG8_WAIT_L(n) asm volatile("s_waitcnt lgkmcnt(" #n ")" ::: "memory")
#define PG8_BAR __builtin_amdgcn_s_barrier()
#define PG8_SCHED __builtin_amdgcn_sched_barrier(0)
#define PG8_VOFF(dst, u) do { _Pragma("unroll") for (int _h = 0; _h < 2; ++_h) _Pragma("unroll") for (int _i = 0; _i < 2; ++_i) dst[_h][_i] = S.a_off(u, _h * HALF + Rr[_i]) + (unsigned)Cc[_i]; } while (0)
    Unit cur, nxt; int ui = 0;
    if (!S.next(0, cur)) return;
    f32x4 acc[2][2][4][2];
#pragma unroll
    for (int a = 0; a < 2; ++a)
#pragma unroll
        for (int b = 0; b < 2; ++b)
#pragma unroll
            for (int m = 0; m < 4; ++m)
#pragma unroll
                for (int n = 0; n < 2; ++n) acc[a][b][m][n] = (f32x4){0.f, 0.f, 0.f, 0.f};
    bf16x8 At[4][2], B0[2][2], B1[2][2];
    unsigned va[2][2], vn[2][2];
    PG8_VOFF(va, cur);
    const char* cB = S.b_ptr(cur);
    if constexpr (SP2) {
        PG8_STAGE(PG8_SB(0, 0), cB, voffB); PG8_STAGE(PG8_SB(0, 1), cB + hstep, voffB); PG8_STAGE(PG8_SA(0, 0), A0, va[0]); PG8_STAGE(PG8_SA(0, 1), A0, va[1]);
        if (wr == 1) PG8_BAR;
        PG8_WAIT_V(2); PG8_BAR;
        PG8_STAGE(PG8_SB(1, 0), cB + kstep, voffB); PG8_STAGE(PG8_SA(1, 0), A0 + kstep, va[0]); PG8_STAGE(PG8_SB(1, 1), cB + hstep + kstep, voffB);
        PG8_WAIT_V(6); PG8_BAR;
    } else {
        PG8_STAGE(PG8_SB(0, 0), cB, voffB); PG8_STAGE(PG8_SA(0, 0), A0, va[0]); PG8_STAGE(PG8_SB(0, 1), cB + hstep, voffB); PG8_STAGE(PG8_SA(0, 1), A0, va[1]);
        if (wr == 1) PG8_BAR;
        PG8_WAIT_V(4); PG8_BAR;
        PG8_STAGE(PG8_SB(1, 0), cB + kstep, voffB); PG8_STAGE(PG8_SA(1, 0), A0 + kstep, va[0]); PG8_STAGE(PG8_SB(1, 1), cB + hstep + kstep, voffB);
        PG8_WAIT_V(6); PG8_BAR;
    }
    for (;;) {
        const bool has_next = S.next(ui + 1, nxt);
        const char* nB = has_next ? S.b_ptr(nxt) : cB;
        for (int t = 0; t < nt; t += 2) {
            const bool last = (t == nt - 2);
            const char* a1 = A0 + (size_t)(t + 1) * kstep;
            const char* a2 = last ? A0 : A0 + (size_t)(t + 2) * kstep; const char* b2 = last ? nB : cB + (size_t)(t + 2) * kstep;
            const char* a3 = a2 + kstep; const char* b3 = b2 + kstep;
            if (last) { if (has_next) { PG8_VOFF(vn, nxt); } else {
#pragma unroll
                    for (int _h = 0; _h < 2; ++_h)
#pragma unroll
                        for (int _i = 0; _i < 2; ++_i) vn[_h][_i] = va[_h][_i]; } }
            if constexpr (SP2) {
            PG8_LDB(B0, 0, 0); PG8_LDB(B1, 0, 1); PG8_SCHED; PG8_LDA(At, 0, 0); PG8_STAGE(PG8_SA(1, 1), a1, va[1]);
            if (last) {
#pragma unroll
                for (int _h = 0; _h < 2; ++_h)
#pragma unroll
                    for (int _i = 0; _i < 2; ++_i) va[_h][_i] = vn[_h][_i]; }
            PG8_WAIT_V(8); PG8_WAIT_L(0); PG8_BAR; PG8_MMA(0, 0, At, B0); PG8_MMA(0, 1, At, B1); PG8_BAR; PG8_SCHED;
            PG8_LDA(At, 0, 1); PG8_STAGE(PG8_SB(0, 0), b2, voffB); PG8_STAGE(PG8_SB(0, 1), b2 + hstep, voffB); PG8_STAGE(PG8_SA(0, 0), a2, va[0]);
            PG8_WAIT_V(8); PG8_WAIT_L(0); PG8_BAR; PG8_MMA(1, 0, At, B0); PG8_MMA(1, 1, At, B1); PG8_BAR; PG8_SCHED;
            PG8_LDB(B0, 1, 0); PG8_LDB(B1, 1, 1); PG8_SCHED; PG8_LDA(At, 1, 0); PG8_STAGE(PG8_SA(0, 1), a2, va[1]);
            PG8_WAIT_V(8); PG8_WAIT_L(0); PG8_BAR; PG8_MMA(0, 0, At, B0); PG8_MMA(0, 1, At, B1); PG8_BAR; PG8_SCHED;
            PG8_LDA(At, 1, 1); PG8_STAGE(PG8_SB(1, 0), b3, voffB); PG8_STAGE(PG8_SB(1, 1), b3 + hstep, voffB); PG8_STAGE(PG8_SA(1, 0), a3, va[0]);
            PG8_WAIT_V(8); PG8_WAIT_L(0); PG8_BAR; PG8_MMA(1, 0, At, B0); PG8_MMA(1, 1, At, B1); PG8_BAR; PG8_SCHED;
            } else {
            PG8_LDB(B0, 0, 0); PG8_SCHED; PG8_LDA(At, 0, 0); PG8_STAGE(PG8_SA(1, 1), a1, va[1]);
            if (last) {
#pragma unroll
                for (int _h = 0; _h < 2; ++_h)
#pragma unroll
                    for (int _i = 0; _i < 2; ++_i) va[_h][_i] = vn[_h][_i]; }
            PG8_WAIT_L(8); PG8_BAR; PG8_WAIT_L(0); PG8_MMA(0, 0, At, B0); PG8_BAR; PG8_SCHED;
            PG8_LDB(B1, 0, 1); PG8_STAGE(PG8_SB(0, 0), b2, voffB);
            PG8_BAR; PG8_WAIT_L(0); PG8_MMA(0, 1, At, B1); PG8_BAR;
            PG8_LDA(At, 0, 1); PG8_STAGE(PG8_SA(0, 0), a2, va[0]);
            PG8_BAR; PG8_WAIT_L(0); PG8_MMA(1, 0, At, B0); PG8_BAR; PG8_SCHED;
            PG8_STAGE(PG8_SB(0, 1), b2 + hstep, voffB);
            PG8_WAIT_V(6); PG8_BAR; PG8_MMA(1, 1, At, B1); PG8_BAR;
            PG8_LDB(B0, 1, 0); PG8_SCHED; PG8_LDA(At, 1, 0); PG8_STAGE(PG8_SA(0, 1), a2, va[1]);
            PG8_WAIT_L(8); PG8_BAR; PG8_WAIT_L(0); PG8_MMA(0, 0, At, B0); PG8_BAR; PG8_SCHED;
            PG8_LDB(B1, 1, 1); PG8_STAGE(PG8_SB(1, 0), b3, voffB);
            PG8_BAR; PG8_WAIT_L(0); PG8_MMA(0, 1, At, B1); PG8_BAR;
            PG8_LDA(At, 1, 1); PG8_STAGE(PG8_SA(1, 0), a3, va[0]);
            PG8_BAR; PG8_WAIT_L(0); PG8_MMA(1, 0, At, B0); PG8_BAR; PG8_SCHED;
            PG8_STAGE(PG8_SB(1, 1), b3 + hstep, voffB);
            PG8_WAIT_V(6); PG8_BAR; PG8_MMA(1, 1, At, B1); PG8_BAR;
            }
        }
        if constexpr (ALIGN_EPI) { if (wr == 0) PG8_BAR; }
        E(acc, cur, wr, wc, fr, fq);
        if (!has_next) break;
#pragma unroll
        for (int a = 0; a < 2; ++a)
#pragma unroll
            for (int b = 0; b < 2; ++b)
#pragma unroll
                for (int m = 0; m < 4; ++m)
#pragma unroll
                    for (int n = 0; n < 2; ++n) acc[a][b][m][n] = (f32x4){0.f, 0.f, 0.f, 0.f};
        cur = nxt; cB = nB; ++ui;
        if constexpr (ALIGN_EPI) { if (wr == 1) PG8_BAR; }
    }
    PG8_WAIT_V(0);
    if constexpr (!ALIGN_EPI) { if (wr == 0) PG8_BAR; }
    PG8_BAR;
#undef PG8_SA
#undef PG8_SB
#undef PG8_STAGE
#undef PG8_LDA
#undef PG8_LDB
#undef PG8_MMA
#undef PG8_WAIT_V
#undef PG8_WAIT_L
#undef PG8_BAR
#undef PG8_SCHED
#undef PG8_VOFF
}
}

#define XB_TMO      128
#define XB_XCNT(j)  (256  + 64 * (j))
#define XB_XSUB(j)  (1280 + 64 * (j))
#define XB_XGEN(j)  (2304 + 64 * (j))
#define XB_TOP      3328
#define XB_TOPGEN   3392
#define XCD_BAR_WORDS 3456
#define XB_SPIN_CAP (1u << 18)

__device__ __forceinline__ unsigned xb_ld(unsigned* p)              { return __hip_atomic_load(p, __ATOMIC_RELAXED, __HIP_MEMORY_SCOPE_AGENT); }
__device__ __forceinline__ unsigned xb_add(unsigned* p, unsigned v) { return __hip_atomic_fetch_add(p, v, __ATOMIC_RELAXED, __HIP_MEMORY_SCOPE_AGENT); }
__device__ __forceinline__ unsigned xb_xcc_id() { return (unsigned)__builtin_amdgcn_s_getreg((3 << 11) | 20) & 0xFu; }
#define XB_SPIN(cond, bar) do { unsigned _sp = 0; while (cond) { __builtin_amdgcn_s_sleep(1); \
    if ((++_sp & 255u) == 0u) { if (xb_ld(&(bar)[XB_TMO])) break; if (_sp > XB_SPIN_CAP) { atomicAdd(&(bar)[XB_TMO], 1u); break; } } } } while (0)

struct XcdBarrier {
    unsigned* bar; unsigned x;
    volatile LAS unsigned* st;
};
__device__ __forceinline__ XcdBarrier xcd_barrier_post(unsigned* bar, volatile LAS unsigned* st) {
    XcdBarrier b; b.bar = bar; b.x = xb_xcc_id(); b.st = st;
    if (threadIdx.x == 0) (void)xb_add(&bar[XB_XCNT(b.x)], 1u);
    return b;
}
__device__ __forceinline__ void xcd_barrier_complete(unsigned* bar, unsigned x, unsigned& nloc, unsigned& nx) {
    const unsigned G = gridDim.x * gridDim.y * gridDim.z;
    unsigned sum, cnt, mine, sp = 0u;
    for (;;) {
        sum = 0u; cnt = 0u; mine = 0u;
#pragma unroll
        for (unsigned j = 0; j < 16; ++j) { const unsigned c = xb_ld(&bar[XB_XCNT(j)]); sum += c; cnt += (c > 0u) ? 1u : 0u; mine = (j == x) ? c : mine; }
        if (sum == G) break;
        __builtin_amdgcn_s_sleep(1);
        if ((++sp & 255u) == 0u) { if (xb_ld(&bar[XB_TMO])) break; if (sp > XB_SPIN_CAP) { atomicAdd(&bar[XB_TMO], 1u); break; } }
    }
    nloc = mine > 0u ? mine : 1u; nx = cnt > 0u ? cnt : 1u;
}
__device__ __forceinline__ void xcd_barrier(const XcdBarrier& b) {
    asm volatile("s_waitcnt vmcnt(0)" ::: "memory");
    __syncthreads();
    if (threadIdx.x == 0) {
        unsigned* bar = b.bar;
        __builtin_amdgcn_s_waitcnt(0);
        unsigned nloc = b.st[0], nx = b.st[1];
        if (nloc == 0u) { xcd_barrier_complete(bar, b.x, nloc, nx); b.st[0] = nloc; b.st[1] = nx; }
        const unsigned old = xb_add(&bar[XB_XSUB(b.x)], 1u);
        const unsigned gen = old / nloc;
        if (old + 1u == (gen + 1u) * nloc) {
            __builtin_amdgcn_fence(__ATOMIC_RELEASE, "agent");
            asm volatile("s_waitcnt vmcnt(0)" ::: "memory");
            const unsigned og = xb_add(&bar[XB_TOP], 1u);
            const unsigned tg = og / nx;
            if (og + 1u == (tg + 1u) * nx) xb_add(&bar[XB_TOPGEN], 1u);
            else XB_SPIN(xb_ld(&bar[XB_TOPGEN]) == tg, bar);
            __builtin_amdgcn_fence(__ATOMIC_ACQUIRE, "agent");
            xb_add(&bar[XB_XGEN(b.x)], 1u);
            asm volatile("s_waitcnt vmcnt(0)" ::: "memory");
        } else {
            XB_SPIN(xb_ld(&bar[XB_XGEN(b.x)]) == gen, bar);
            __builtin_amdgcn_fence(__ATOMIC_ACQUIRE, "agent");
            asm volatile("s_waitcnt vmcnt(0)" ::: "memory");
        }
    }
    __syncthreads();
}

constexpr int NWAVES = 8, NTHREADS = 512;
struct Args { const float* in[19]; float* out; unsigned char* ws; int ph_lo, ph_hi; };
enum { I_X = 0, I_META, I_MIXNW, I_WIN, I_CONVW, I_ALOG, I_DTB, I_GDNNW, I_SBQNW, I_SBKNW, I_SBONW, I_WOUT, I_FFNNW, I_RW, I_RB, I_WGU, I_BGU, I_WD, I_BD };

#define LDS_WAIT() asm volatile("s_waitcnt lgkmcnt(0)" ::: "memory")
#define VM_WAIT() asm volatile("s_waitcnt vmcnt(0)" ::: "memory")
constexpr int WLS = 2052;

__device__ __forceinline__ void dot16(const f32x4 (&v)[8], const LAS float* wl, int lane, float (&s)[16]) {
#pragma unroll
    for (int c = 0; c < 16; ++c) { float a = 0.f;
#pragma unroll
        for (int j = 0; j < 8; ++j) { const f32x4 w = *(const LAS f32x4*)(wl + c * WLS + 4 * lane + 256 * j); a += (v[j].x * w.x + v[j].y * w.y) + (v[j].z * w.z + v[j].w * w.w); }
        s[c] = wave_sum(a); }
}

__device__ __forceinline__ void p0_rows(const Args& a, LAS unsigned char* lds, int gw, int NGW, int tid, int lane) {
    const float* x = a.in[I_X]; const float* meta = a.in[I_META]; const float* nw = a.in[I_MIXNW]; const float* win = a.in[I_WIN];
    LAS float* wl = (LAS float*)lds;
    for (int idx = tid; idx < 2048 * 16; idx += NTHREADS) { const int k = idx >> 4, c = idx & 15; wl[c * WLS + k] = win[(size_t)k * NPROJ_SRC + 4096 + c]; }
    __syncthreads();
    bf16_t* HN = (bf16_t*)(a.ws + WS_HN); float* BETA = (float*)(a.ws + WS_BETA); float* GG = (float*)(a.ws + WS_G);
    f32x4 wn[8];
#pragma unroll
    for (int j = 0; j < 8; ++j) wn[j] = *((const f32x4*)nw + lane + 64 * j);
    const int hh = lane & 7;
    const float alog = a.in[I_ALOG][hh], dtb = a.in[I_DTB][hh];
    for (int row = gw; row < MPAD; row += NGW) {
        GAS unsigned long long* o8 = (GAS unsigned long long*)(HN + (size_t)row * DM) + lane;
        if (row >= NTOK) {
#pragma unroll
            for (int j = 0; j < 8; ++j) o8[64 * j] = 0ull;
            continue; }
        const int b = row / LSEQ, t = row - b * LSEQ;
        const float* src = (t < NMETA) ? meta + (size_t)t * DM : x + ((size_t)b * SEQ + (t - NMETA)) * DM;
        f32x4 v[8]; float ss = 0.f;
#pragma unroll
        for (int j = 0; j < 8; ++j) { v[j] = *((const f32x4*)src + lane + 64 * j); ss += (v[j].x * v[j].x + v[j].y * v[j].y) + (v[j].z * v[j].z + v[j].w * v[j].w); }
        const float rstd = 1.0f / sqrtf(wave_sum(ss) * (1.0f / DM) + NORM_EPS);
#pragma unroll
        for (int j = 0; j < 8; ++j) { v[j] = v[j] * rstd * wn[j];
            o8[64 * j] = (unsigned long long)cvt_pk_bf16(v[j].x, v[j].y) | ((unsigned long long)cvt_pk_bf16(v[j].z, v[j].w) << 32); }
        float s[16]; dot16(v, wl, lane, s);
        float bv = s[0], av = s[8];
#pragma unroll
        for (int c = 1; c < 8; ++c) { bv = (hh == c) ? s[c] : bv; av = (hh == c) ? s[8 + c] : av; }
        if (lane < 8) {
            const float beta = 1.0f / (1.0f + expf(-bv));
            const float xa = av + dtb; const float sp = fmaxf(xa, 0.f) + log1pf(expf(-fabsf(xa)));
            BETA[(size_t)row * 8 + hh] = beta; GG[(size_t)row * 8 + hh] = -expf(alog) * sp; }
    }
    __syncthreads();
}

template <int MODE  >
__device__ __forceinline__ void cvt_strip(const float* W, int ldw, int K, bf16_t* out, int kb, int nb, int lane) {
    const int r0 = nb * 256 + 4 * lane;
    int c0;
    if (MODE == 0) c0 = r0;
    else if (MODE == 1) c0 = r0 < 4096 ? r0 : r0 + 16;
    else { const int pn = r0 >> 8, rr = r0 & 255; c0 = rr < 128 ? 128 * pn + rr : 2048 + 128 * pn + (rr - 128); }
    const float* src = W + (size_t)(kb * 64) * ldw + c0;
    bf16_t* dst = out + (size_t)r0 * K + kb * 64;
#pragma unroll 2
    for (int st = 0; st < 8; ++st) {
        f32x4 v[8];
#pragma unroll
        for (int i = 0; i < 8; ++i) v[i] = *(const f32x4*)(src + (size_t)(st * 8 + i) * ldw);
#pragma unroll
        for (int j = 0; j < 4; ++j) { u32x4 w; w.x = cvt_pk_bf16(v[0][j], v[1][j]); w.y = cvt_pk_bf16(v[2][j], v[3][j]); w.z = cvt_pk_bf16(v[4][j], v[5][j]); w.w = cvt_pk_bf16(v[6][j], v[7][j]);
            *(u32x4*)(dst + (size_t)j * K + st * 8) = w; }
    }
}
__device__ __forceinline__ void p0_weights(const Args& a, int gw, int NGW, int lane) {
    constexpr int I_IN = 32 * 28, I_OUT = 32 * 8, I_GU = 32 * 16, I_D = 32 * 8;
    constexpr int NITEMS = I_IN + I_OUT + NEXP * (I_GU + I_D);
    for (int it = gw; it < NITEMS; it += NGW) {
        int r = it;
        if (r < I_IN) { cvt_strip<1>(a.in[I_WIN], NPROJ_SRC, DM, (bf16_t*)(a.ws + WS_WIN), r / 28, r % 28, lane); continue; } r -= I_IN;
        if (r < I_OUT) { cvt_strip<0>(a.in[I_WOUT], DM, DM, (bf16_t*)(a.ws + WS_WOUT), r / 8, r % 8, lane); continue; } r -= I_OUT;
        if (r < NEXP * I_GU) { const int e = r / I_GU, q = r % I_GU;
            cvt_strip<2>(a.in[I_WGU] + (size_t)e * DM * 2 * DE, 2 * DE, DM, (bf16_t*)(a.ws + WS_WGU) + (size_t)e * 2 * DE * DM, q / 16, q % 16, lane); continue; } r -= NEXP * I_GU;
        { const int e = r / I_D, q = r % I_D;
            cvt_strip<0>(a.in[I_WD] + (size_t)e * DE * DM, DM, DE, (bf16_t*)(a.ws + WS_WD) + (size_t)e * DM * DE, q / 8, q % 8, lane); }
    }
}

__device__ __forceinline__ void p2_qknorm(const Args& a, int gw, int NGW, int lane) {
    const bf16_t* P = (const bf16_t*)(a.ws + WS_P); bf16_t* QN = (bf16_t*)(a.ws + WS_QN); bf16_t* KN = (bf16_t*)(a.ws + WS_KN);
    const float qw0 = a.in[I_SBQNW][2 * lane], qw1 = a.in[I_SBQNW][2 * lane + 1], kw0 = a.in[I_SBKNW][2 * lane], kw1 = a.in[I_SBKNW][2 * lane + 1];
    const float QS = 0.08838834764831845f * 1.4426950408889634f;
    for (int it = gw; it < NTOK * NHEAD * 2; it += NGW) {
        const int which = it & 1, h = (it >> 1) & 7, row = it >> 4;
        const int b = row / LSEQ, t = row - b * LSEQ;
        const unsigned w = *(const unsigned*)(P + (size_t)row * NPROJ + (which ? PC_SBK : PC_SBQ) + h * HD + 2 * lane);
        const float v0 = bf_lo(w), v1 = bf_hi(w);
        const float rstd = 1.0f / sqrtf(wave_sum(v0 * v0 + v1 * v1) * (1.0f / HD) + NORM_EPS);
        const float o0 = which ? v0 * rstd * kw0 : v0 * rstd * qw0 * QS, o1 = which ? v1 * rstd * kw1 : v1 * rstd * qw1 * QS;
        *(unsigned*)((which ? KN : QN) + ((size_t)(b * NHEAD + h) * LROW + t) * HD + 2 * lane) = cvt_pk_bf16(o0, o1);
    }
}

__device__ __forceinline__ void p3_gdn_naive(const Args& a, LAS unsigned char* lds, int item, int tid, int lane, int wave) {
    const int b = item >> 3, h = item & 7;
    const bf16_t* P = (const bf16_t*)(a.ws + WS_P); const float* BETA = (const float*)(a.ws + WS_BETA); const float* GG = (const float*)(a.ws + WS_G);
    float* ORAW = (float*)(a.ws + WS_ORAW); bf16_t* MIX = (bf16_t*)(a.ws + WS_MIX);
    LAS float* buf = (LAS float*)lds;
    const int j = tid >> 2, part = tid & 3;
    const int which = tid >> 7, d = tid & 127; const bool conv = tid < 384;
    const int pcol = which * 1024 + h * HD + d;
    float cw0 = 0, cw1 = 0, cw2 = 0, cw3 = 0;
    if (conv) { const float* cwp = a.in[I_CONVW] + pcol; cw0 = cwp[0]; cw1 = cwp[3072]; cw2 = cwp[2 * 3072]; cw3 = cwp[3 * 3072]; }
    float xm1 = 0.f, xm2 = 0.f, xm3 = 0.f;
    float S[32];
#pragma unroll
    for (int i = 0; i < 32; ++i) S[i] = 0.f;
    const size_t row0 = (size_t)b * LSEQ;
    float xnext = conv ? bf2f(P[row0 * NPROJ + pcol]) : 0.f;
    float bnext = BETA[row0 * 8 + h], gnext = GG[row0 * 8 + h];
    for (int t = 0; t < LSEQ; ++t) {
        const float xt = xnext, beta = bnext, gam = expf(gnext);
        if (t + 1 < LSEQ) { if (conv) xnext = bf2f(P[(row0 + t + 1) * NPROJ + pcol]); bnext = BETA[(row0 + t + 1) * 8 + h]; gnext = GG[(row0 + t + 1) * 8 + h]; }
        LAS float* cb = buf + (t & 1) * 384;
        if (conv) { const float y = cw3 * xt + cw2 * xm1 + cw1 * xm2 + cw0 * xm3; xm3 = xm2; xm2 = xm1; xm1 = xt; cb[tid] = y / (1.0f + expf(-y)); }
        __syncthreads();
        float kk = 0.f, qq = 0.f, dk = 0.f; f32x4 kv[8], qv[8];
#pragma unroll
        for (int i = 0; i < 8; ++i) { kv[i] = *(const LAS f32x4*)(cb + 128 + 32 * part + 4 * i); qv[i] = *(const LAS f32x4*)(cb + 32 * part + 4 * i); }
#pragma unroll
        for (int i = 0; i < 8; ++i)
#pragma unroll
            for (int c = 0; c < 4; ++c) { kk += kv[i][c] * kv[i][c]; qq += qv[i][c] * qv[i][c]; dk += S[4 * i + c] * kv[i][c]; }
        kk += __shfl_xor(kk, 1); kk += __shfl_xor(kk, 2); qq += __shfl_xor(qq, 1); qq += __shfl_xor(qq, 2); dk += __shfl_xor(dk, 1); dk += __shfl_xor(dk, 2);
        const float rk = 1.0f / sqrtf(kk + NORM_EPS), rq = 0.08838834764831845f / sqrtf(qq + NORM_EPS);
        const float vj = cb[256 + j];
        const float vnew = beta * (vj - gam * rk * dk);
        const float kvn = rk * vnew; float oq = 0.f;
#pragma unroll
        for (int i = 0; i < 8; ++i)
#pragma unroll
            for (int c = 0; c < 4; ++c) { S[4 * i + c] = gam * S[4 * i + c] + kv[i][c] * kvn; oq += S[4 * i + c] * qv[i][c]; }
        oq += __shfl_xor(oq, 1); oq += __shfl_xor(oq, 2);
        if (t >= NMETA && part == 0) ORAW[((size_t)b * SEQ + (t - NMETA)) * 1024 + h * HD + j] = rq * oq;
    }
    __threadfence(); __syncthreads();
    const float nw0 = a.in[I_GDNNW][2 * lane], nw1 = a.in[I_GDNNW][2 * lane + 1];
    for (int s = wave; s < SEQ; s += NWAVES) {
        const size_t tok = (size_t)b * SEQ + s;
        const f32x2 o = *(const f32x2*)(ORAW + tok * 1024 + h * HD + 2 * lane);
        const float rstd = 1.0f / sqrtf(wave_sum(o.x * o.x + o.y * o.y) * (1.0f / HD) + NORM_EPS);
        const unsigned zw = *(const unsigned*)(P + (row0 + NMETA + s) * NPROJ + PC_Z + h * HD + 2 * lane);
        const float z0 = bf_lo(zw), z1 = bf_hi(zw);
        const float r0 = o.x * rstd * nw0 * (z0 / (1.0f + expf(-z0))), r1 = o.y * rstd * nw1 * (z1 / (1.0f + expf(-z1)));
        *(unsigned*)(MIX + tok * DM + h * HD + 2 * lane) = cvt_pk_bf16(r0, r1);
    }
}

__device__ __forceinline__ bf16x8 sba_pack8(const f32x16& p, int base) {
    u32x4 w; w.x = cvt_pk_bf16(p[base + 0], p[base + 1]); w.y = cvt_pk_bf16(p[base + 2], p[base + 3]); w.z = cvt_pk_bf16(p[base + 4], p[base + 5]); w.w = cvt_pk_bf16(p[base + 6], p[base + 7]);
    return __builtin_bit_cast(bf16x8, w);
}

namespace gdn {
constexpr int NCH = 65;
constexpr int IMG_W = 0, IMG_QG = 16384, IMG_KDT = 32768, IMG_AT = 49152, IMG_BYTES = 57344, IMG_U = 57344, CH_BYTES = 73728;
constexpr int L_QB = 0, L_KB = 17408, L_VB = 34816, L_LT = 52224, L_GC = 69632, L_BE = 69888, L_IMG = 70144;
__device__ __forceinline__ int afrag_off(int row, int k, int nks) {
    const int rt = row >> 5, rr = row & 31, ks = k >> 4, kk = k & 15, hi = (kk >> 2) & 1, sl = (kk & 3) + 4 * (kk >> 3);
    return ((rt * nks + ks) * 64 + rr + 32 * hi) * 16 + sl * 2;
}
__device__ __forceinline__ int ufrag_off(int i, int c) {
    const int cg = c >> 5, col = c & 31, rt = i >> 5, ii = i & 31, hi = (ii >> 2) & 1, r = (ii & 3) + 4 * (ii >> 3);
    return (((cg * 2 + rt) * 2 + (r >> 3)) * 64 + col + 32 * hi) * 8 + (r & 7);
}
__device__ __forceinline__ int crow(int r, int hi) { return (r & 3) + 8 * (r >> 2) + 4 * hi; }
__device__ __forceinline__ bf16_t f2bf(float f) { return (bf16_t)(cvt_pk_bf16(f, 0.f) & 0xffffu); }

__device__ __forceinline__ void precompute(const Args& a, LAS unsigned char* lds, int item, int tid, int lane, int wave) {
    asm volatile("" : "+v"(tid), "+v"(lane), "+s"(wave));
    const int bh = item / NCH, c = item - bh * NCH, b = bh >> 3, h = bh & 7;
    const bf16_t* P = (const bf16_t*)(a.ws + WS_P) + (size_t)b * LSEQ * NPROJ;
    const float* BETA = (const float*)(a.ws + WS_BETA) + (size_t)b * LSEQ * 8; const float* GG = (const float*)(a.ws + WS_G) + (size_t)b * LSEQ * 8;
    unsigned char* dst = a.ws + WS_GCH + (size_t)item * CH_BYTES;
    LAS float* GC = (LAS float*)(lds + L_GC); LAS float* BE = (LAS float*)(lds + L_BE); LAS float* LT = (LAS float*)(lds + L_LT);
    const int tbase = 64 * c - 48;
    if (wave == 0) {
        const int t = tbase + lane; float g = 0.f, be = 0.f;
        if (t >= 0) { g = GG[(size_t)t * 8 + h]; be = BETA[(size_t)t * 8 + h]; }
#pragma unroll
        for (int o = 1; o < 64; o <<= 1) { const float y = __shfl_up(g, o); if (lane >= o) g += y; }
        GC[lane] = g; BE[lane] = be;
        if (lane == 63) ((float*)(a.ws + WS_GL))[item] = expf(g);
    }
    {
        f32x2 cw[3][4];
#pragma unroll
        for (int w3 = 0; w3 < 3; ++w3)
#pragma unroll
            for (int tap = 0; tap < 4; ++tap) cw[w3][tap] = *(const f32x2*)(a.in[I_CONVW] + tap * 3072 + w3 * 1024 + h * HD + 2 * lane);
        f32x2 xw[3][11];
#pragma unroll
        for (int j = 0; j < 11; ++j) { const int t = tbase + 8 * wave - 3 + j;
#pragma unroll
            for (int w3 = 0; w3 < 3; ++w3) { unsigned u = 0u; if (t >= 0) u = *(const unsigned*)(P + (size_t)t * NPROJ + w3 * 1024 + h * HD + 2 * lane); xw[w3][j] = (f32x2){bf_lo(u), bf_hi(u)}; } }
#pragma unroll
        for (int rr = 0; rr < 8; ++rr) { const int i = 8 * wave + rr; f32x2 y[3];
#pragma unroll
            for (int w3 = 0; w3 < 3; ++w3) { f32x2 acc = cw[w3][0] * xw[w3][rr] + cw[w3][1] * xw[w3][rr + 1] + cw[w3][2] * xw[w3][rr + 2] + cw[w3][3] * xw[w3][rr + 3];
                acc.x = acc.x / (1.0f + __expf(-acc.x)); acc.y = acc.y / (1.0f + __expf(-acc.y)); y[w3] = acc; }
            const float rq = 0.08838834764831845f / sqrtf(wave_sum(y[0].x * y[0].x + y[0].y * y[0].y) + NORM_EPS);
            const float rk = 1.0f / sqrtf(wave_sum(y[1].x * y[1].x + y[1].y * y[1].y) + NORM_EPS);
            *(LAS unsigned*)(lds + L_QB + i * 272 + 4 * lane) = cvt_pk_bf16(y[0].x * rq, y[0].y * rq);
            *(LAS unsigned*)(lds + L_KB + i * 272 + 4 * lane) = cvt_pk_bf16(y[1].x * rk, y[1].y * rk);
            *(LAS unsigned*)(lds + L_VB + i * 272 + 4 * lane) = cvt_pk_bf16(y[2].x, y[2].y); }
    }
    __syncthreads();
    {
        const int prod = wave >> 2, ti = (wave >> 1) & 1, tj = wave & 1, r32 = lane & 31, hi = lane >> 5;
        if (tj <= ti) {
            f32x16 acc;
#pragma unroll
            for (int r = 0; r < 16; ++r) acc[r] = 0.f;
            const LAS unsigned char* Ab = lds + (prod ? L_QB : L_KB) + (32 * ti + r32) * 272 + hi * 16;
            const LAS unsigned char* Bb = lds + L_KB + (32 * tj + r32) * 272 + hi * 16;
#pragma unroll
            for (int ks = 0; ks < 8; ++ks) acc = __builtin_amdgcn_mfma_f32_32x32x16_bf16(*(const LAS bf16x8*)(Ab + ks * 32), *(const LAS bf16x8*)(Bb + ks * 32), acc, 0, 0, 0);
            const int j = 32 * tj + r32; const float gj = GC[j];
#pragma unroll
            for (int r = 0; r < 16; ++r) { const int i = 32 * ti + crow(r, hi); const float dec = __expf(GC[i] - gj);
                if (prod == 0) LT[j * 68 + i] = (j < i) ? acc[r] * BE[i] * dec : 0.f;
                else *(LAS bf16_t*)(lds + L_IMG + IMG_AT + afrag_off(i, j, 4)) = f2bf((j <= i) ? acc[r] * dec : 0.f); }
        }
    }
    __syncthreads();
    if (tid < 256) {
        float x[64];
        const bool isv = tid < 128; const int cc = tid & 127;
        const LAS unsigned char* src = lds + (isv ? L_VB : L_KB) + cc * 2;
#pragma unroll
        for (int i8 = 0; i8 < 64; i8 += 8) {
#pragma unroll
            for (int q = 0; q < 8; ++q) { const int i = i8 + q; const float v = bf2f(*(const LAS bf16_t*)(src + i * 272)); x[i] = v * BE[i] * (isv ? 1.0f : __expf(GC[i])); }
            asm volatile("" ::: "memory"); }
#pragma unroll
        for (int j = 0; j < 63; ++j) {
#pragma unroll
            for (int i4 = ((j + 1) & ~3); i4 < 64; i4 += 4) { const f32x4 l4 = *(const LAS f32x4*)(LT + j * 68 + i4);
#pragma unroll
                for (int q = 0; q < 4; ++q) if (i4 + q > j) x[i4 + q] -= l4[q] * x[j]; }
            asm volatile("" ::: "memory");
        }
        if (isv) {
            LAS unsigned char* ub = lds + L_IMG + IMG_U + (((cc >> 5) * 4 * 64) + (cc & 31)) * 16;
#pragma unroll
            for (int i = 0; i < 64; ++i) { const int rt = i >> 5, ii = i & 31, hi = (ii >> 2) & 1, r = (ii & 3) + 4 * (ii >> 3);
                *(LAS bf16_t*)(ub + (((rt * 2 + (r >> 3)) * 64 + 32 * hi) * 8 + (r & 7)) * 2) = f2bf(x[i]); }
        } else {
            const int ks = cc >> 4, kk = cc & 15, hi = (kk >> 2) & 1, sl = (kk & 3) + 4 * (kk >> 3);
            LAS unsigned char* wb = lds + L_IMG + IMG_W + (ks * 64 + 32 * hi) * 16 + sl * 2;
#pragma unroll
            for (int i = 0; i < 64; ++i) *(LAS bf16_t*)(wb + ((i >> 5) * 8 * 64 + (i & 31)) * 16) = f2bf(-x[i]);
        }
    } else {
        const int u = tid - 256, dk = u & 127, i0 = (u >> 7) * 32; const float gl = GC[63];
#pragma unroll 4
        for (int ii = 0; ii < 32; ++ii) { const int i = i0 + ii; const float gi = GC[i];
            const float q = bf2f(*(const LAS bf16_t*)(lds + L_QB + i * 272 + dk * 2)), k = bf2f(*(const LAS bf16_t*)(lds + L_KB + i * 272 + dk * 2));
            *(LAS bf16_t*)(lds + L_IMG + IMG_QG + afrag_off(i, dk, 8)) = f2bf(q * __expf(gi));
            *(LAS bf16_t*)(lds + L_IMG + IMG_KDT + afrag_off(dk, i, 4)) = f2bf(k * __expf(gl - gi)); }
    }
    __syncthreads();
    for (int q = tid; q < CH_BYTES / 16; q += NTHREADS) *(u32x4*)(dst + (size_t)q * 16) = *(const LAS u32x4*)(lds + L_IMG + q * 16);
}

__device__ __forceinline__ void scan(const Args& a, LAS unsigned char* lds, int bh, int tid, int lane, int wave) {
    const int b = bh >> 3, h = bh & 7, col = lane & 31, hi = lane >> 5, cg = wave;
    const unsigned char* src = a.ws + WS_GCH + (size_t)bh * NCH * CH_BYTES;
    const float* GL = (const float*)(a.ws + WS_GL) + bh * NCH;
    float* ORAW = (float*)(a.ws + WS_ORAW);
    __syncthreads();
    const unsigned dvoff = (unsigned)(wave * 1024 + lane * 16), uvoff = (unsigned)(lane * 16);
#define GDN_DMA(ch, buf) do { const unsigned char* _sp = src + (size_t)(ch) * CH_BYTES; _Pragma("unroll") for (int _f = 0; _f < 7; ++_f) { \
        __builtin_amdgcn_global_load_lds((const unsigned*)(_sp + _f * 8192 + dvoff), (LAS unsigned*)(lds + (buf) * IMG_BYTES + wave * 1024 + _f * 8192), 16, 0, 0); } } while (0)
    GDN_DMA(0, 0);
    f32x16 st[4]; bf16x8 Sb[8]; u32x4 ureg[4]; float gl = 1.f;
#pragma unroll
    for (int t4 = 0; t4 < 4; ++t4)
#pragma unroll
        for (int r = 0; r < 16; ++r) st[t4][r] = 0.f;
#pragma unroll
    for (int ks = 0; ks < 8; ++ks) Sb[ks] = (bf16x8){0, 0, 0, 0, 0, 0, 0, 0};
    if (wave < 4) {
#pragma unroll
        for (int q = 0; q < 4; ++q) ureg[q] = *(const u32x4*)(src + IMG_U + cg * 4096 + q * 1024 + uvoff);
        gl = GL[0];
    }
    VM_WAIT(); __syncthreads();
    for (int c = 0; c < NCH; ++c) {
        const LAS unsigned char* img = lds + (c & 1) * IMG_BYTES + lane * 16;
        if (c + 1 < NCH) GDN_DMA(c + 1, (c + 1) & 1);
        if (wave < 4) {
            f32x16 vn[2]; const float glc = gl;
#pragma unroll
            for (int rt = 0; rt < 2; ++rt)
#pragma unroll
                for (int rh = 0; rh < 2; ++rh) { const u32x4 w = ureg[rt * 2 + rh];
                    vn[rt][8 * rh + 0] = bf_lo(w.x); vn[rt][8 * rh + 1] = bf_hi(w.x); vn[rt][8 * rh + 2] = bf_lo(w.y); vn[rt][8 * rh + 3] = bf_hi(w.y);
                    vn[rt][8 * rh + 4] = bf_lo(w.z); vn[rt][8 * rh + 5] = bf_hi(w.z); vn[rt][8 * rh + 6] = bf_lo(w.w); vn[rt][8 * rh + 7] = bf_hi(w.w); }
            asm volatile("" ::: "memory");
            if (c + 1 < NCH) {
#pragma unroll
                for (int q = 0; q < 4; ++q) ureg[q] = *(const u32x4*)(src + (size_t)(c + 1) * CH_BYTES + IMG_U + cg * 4096 + q * 1024 + uvoff);
                gl = GL[c + 1]; }
#pragma unroll
            for (int rt = 0; rt < 2; ++rt) { __builtin_amdgcn_sched_barrier(0);
#pragma unroll
                for (int ks = 0; ks < 8; ++ks) vn[rt] = __builtin_amdgcn_mfma_f32_32x32x16_bf16(*(const LAS bf16x8*)(img + IMG_W + (rt * 8 + ks) * 1024), Sb[ks], vn[rt], 0, 0, 0); }
            __builtin_amdgcn_sched_barrier(0);
            bf16x8 vb[4];
#pragma unroll
            for (int ks = 0; ks < 4; ++ks) vb[ks] = sba_pack8(vn[ks >> 1], 8 * (ks & 1));
            float* ob = ORAW + ((size_t)b * SEQ + (c >= 1 ? 64 * (c - 1) : 0)) * 1024 + h * HD + 32 * cg + col;
#pragma unroll
            for (int rt = 0; rt < 2; ++rt) { f32x16 o; __builtin_amdgcn_sched_barrier(0);
#pragma unroll
                for (int r = 0; r < 16; ++r) o[r] = 0.f;
#pragma unroll
                for (int ks = 0; ks < 8; ++ks) o = __builtin_amdgcn_mfma_f32_32x32x16_bf16(*(const LAS bf16x8*)(img + IMG_QG + (rt * 8 + ks) * 1024), Sb[ks], o, 0, 0, 0);
#pragma unroll
                for (int ks = 0; ks < 2 * (rt + 1); ++ks) o = __builtin_amdgcn_mfma_f32_32x32x16_bf16(*(const LAS bf16x8*)(img + IMG_AT + (rt * 4 + ks) * 1024), vb[ks], o, 0, 0, 0);
                if (c >= 1) {
#pragma unroll
                    for (int r = 0; r < 16; ++r) ob[(size_t)(32 * rt + crow(r, hi)) * 1024] = o[r]; }
            }
#pragma unroll
            for (int t4 = 0; t4 < 4; ++t4) { __builtin_amdgcn_sched_barrier(0);
#pragma unroll
                for (int r = 0; r < 16; ++r) st[t4][r] *= glc;
#pragma unroll
                for (int ks = 0; ks < 4; ++ks) st[t4] = __builtin_amdgcn_mfma_f32_32x32x16_bf16(*(const LAS bf16x8*)(img + IMG_KDT + (t4 * 4 + ks) * 1024), vb[ks], st[t4], 0, 0, 0);
                Sb[2 * t4] = sba_pack8(st[t4], 0); Sb[2 * t4 + 1] = sba_pack8(st[t4], 8); }
        }
        VM_WAIT(); __syncthreads();
    }
#undef GDN_DMA
    __threadfence(); __syncthreads();
    const bf16_t* P = (const bf16_t*)(a.ws + WS_P); bf16_t* MIX = (bf16_t*)(a.ws + WS_MIX);
    const float nw0 = a.in[I_GDNNW][2 * lane], nw1 = a.in[I_GDNNW][2 * lane + 1];
    for (int s = wave; s < SEQ; s += NWAVES) {
        const size_t tok = (size_t)b * SEQ + s;
        const f32x2 ov = *(const f32x2*)(ORAW + tok * 1024 + h * HD + 2 * lane);
        const float rstd = 1.0f / sqrtf(wave_sum(ov.x * ov.x + ov.y * ov.y) * (1.0f / HD) + NORM_EPS);
        const unsigned zw = *(const unsigned*)(P + ((size_t)b * LSEQ + NMETA + s) * NPROJ + PC_Z + h * HD + 2 * lane);
        const float z0 = bf_lo(zw), z1 = bf_hi(zw);
        const float r0 = ov.x * rstd * nw0 * (z0 / (1.0f + expf(-z0))), r1 = ov.y * rstd * nw1 * (z1 / (1.0f + expf(-z1)));
        *(unsigned*)(MIX + tok * DM + h * HD + 2 * lane) = cvt_pk_bf16(r0, r1);
    }
}
}

namespace sba {
#define KSWZ(row, colB) ((row) * 256 + ((colB) ^ (((row) & 7) << 4)))
__device__ __forceinline__ int v_st(int k, int c) { const int kk = (k & ~0xC) | ((k & 4) << 1) | ((k & 8) >> 1); return ((kk >> 3) * 4 + (c >> 5)) * 512 + ((kk & 7) * 32 + (c & 31)) * 2; }
__device__ __forceinline__ int v_rd_base(int lane) { return ((lane & 3) << 3) | (((lane >> 2) & 3) << 6) | (((lane >> 4) & 1) << 5) | (((lane >> 5) & 1) << 8); }
constexpr int v_rd_off(int d0, int ks, int half) { return d0 * 512 + ks * 4096 + half * 2048; }
template <int OFF> __device__ __forceinline__ s16x4 tr_read(int vb) { s16x4 r; asm volatile("ds_read_b64_tr_b16 %0, %1 offset:%2" : "=&v"(r) : "v"(vb), "i"(OFF) : "memory"); return r; }
template <int D0> __device__ __forceinline__ void pv_one(f32x16& od, int vb, bf16x8 pa0, bf16x8 pa1, bf16x8 pa2, bf16x8 pa3) {
    const s16x4 l0 = tr_read<v_rd_off(D0, 0, 0)>(vb), h0 = tr_read<v_rd_off(D0, 0, 1)>(vb), l1 = tr_read<v_rd_off(D0, 1, 0)>(vb), h1 = tr_read<v_rd_off(D0, 1, 1)>(vb);
    const s16x4 l2 = tr_read<v_rd_off(D0, 2, 0)>(vb), h2 = tr_read<v_rd_off(D0, 2, 1)>(vb), l3 = tr_read<v_rd_off(D0, 3, 0)>(vb), h3 = tr_read<v_rd_off(D0, 3, 1)>(vb);
    asm volatile("s_waitcnt lgkmcnt(0)" ::: "memory"); __builtin_amdgcn_sched_barrier(0);
#define PK(L, H) (bf16x8){L[0], L[1], L[2], L[3], H[0], H[1], H[2], H[3]}
    od = __builtin_amdgcn_mfma_f32_32x32x16_bf16(pa0, PK(l0, h0), od, 0, 0, 0);
    od = __builtin_amdgcn_mfma_f32_32x32x16_bf16(pa1, PK(l1, h1), od, 0, 0, 0);
    od = __builtin_amdgcn_mfma_f32_32x32x16_bf16(pa2, PK(l2, h2), od, 0, 0, 0);
    od = __builtin_amdgcn_mfma_f32_32x32x16_bf16(pa3, PK(l3, h3), od, 0, 0, 0);
#undef PK
}
__device__ __forceinline__ int crow(int r, int hi) { return (r & 3) + 8 * (r >> 2) + 4 * hi; }
__device__ __forceinline__ int swap34(int k) { return (k & ~0x18) | ((k & 8) << 1) | ((k & 16) >> 1); }
__device__ __forceinline__ bf16x8 pack8(const f32x16& p, int base) {
    u32x4 w; w.x = cvt_pk_bf16(p[base + 0], p[base + 1]); w.y = cvt_pk_bf16(p[base + 2], p[base + 3]); w.z = cvt_pk_bf16(p[base + 4], p[base + 5]); w.w = cvt_pk_bf16(p[base + 6], p[base + 7]);
    return __builtin_bit_cast(bf16x8, w);
}
constexpr float SB_EXIT = 160.0f;

__device__ __forceinline__ void unit(const Args& a, LAS unsigned char* lds, volatile LAS int* done_cnt, int b, int h, int qb, int tid, int lane, int wid) {
    const bf16_t* QN = (const bf16_t*)(a.ws + WS_QN) + (size_t)(b * NHEAD + h) * LROW * HD;
    const bf16_t* KN = (const bf16_t*)(a.ws + WS_KN) + (size_t)(b * NHEAD + h) * LROW * HD;
    const bf16_t* Vp = (const bf16_t*)(a.ws + WS_P) + (size_t)b * LSEQ * NPROJ + PC_SBV + h * HD;
    bf16_t* MIX = (bf16_t*)(a.ws + WS_MIX);
    const int r32 = lane & 31, hi = lane >> 5;
    LAS unsigned char* K_lds = lds; LAS unsigned char* V_lds = lds + 16384;
    const int tq0 = NMETA + 256 * qb + 32 * wid, tq = tq0 + r32;
    __syncthreads();
    if (tid == 0) *done_cnt = 0;
    bf16x8 qr[8];
#pragma unroll
    for (int d0 = 0; d0 < 8; ++d0) qr[d0] = *(const bf16x8*)(QN + (size_t)tq * HD + d0 * 16 + hi * 8);
    const int sr = tid >> 4, sc = (tid & 15) * 8;
    const int vst0 = v_st(swap34(sr), sc), vst1 = v_st(32 + swap34(sr), sc);
    const int kst0 = KSWZ(sr, sc * 2), kst1 = KSWZ(32 + sr, sc * 2);
    const int vb0 = (int)(unsigned)(unsigned long)V_lds + v_rd_base(lane);
    const int prow = (r32 & 3) + 4 * (r32 >> 3) + 16 * ((r32 >> 2) & 1);
    f32x16 o[4];
#pragma unroll
    for (int d = 0; d < 4; ++d)
#pragma unroll
        for (int r = 0; r < 16; ++r) o[d][r] = 0.f;
    float carry = 0.f; bool flagged = false;
    for (int kt = 4 * qb + 4; kt >= 0; --kt) {
        const int k0 = 64 * kt;
        const bf16x8 ks0 = *(const bf16x8*)(KN + (size_t)(k0 + sr) * HD + sc), ks1 = *(const bf16x8*)(KN + (size_t)(k0 + 32 + sr) * HD + sc);
        const bf16x8 vs0 = *(const bf16x8*)(Vp + (size_t)(k0 + sr) * NPROJ + sc), vs1 = *(const bf16x8*)(Vp + (size_t)(k0 + 32 + sr) * NPROJ + sc);
        __syncthreads();
        if (*done_cnt == NWAVES) break;
        *(LAS bf16x8*)(K_lds + kst0) = ks0; *(LAS bf16x8*)(K_lds + kst1) = ks1; *(LAS bf16x8*)(V_lds + vst0) = vs0; *(LAS bf16x8*)(V_lds + vst1) = vs1;
        __syncthreads();
        if (k0 >= tq0 + 32) continue;
        f32x16 p0, p1;
#pragma unroll
        for (int r = 0; r < 16; ++r) { p0[r] = 0.f; p1[r] = 0.f; }
#pragma unroll
        for (int d0 = 0; d0 < 8; ++d0) { const int cb = (d0 * 16 + hi * 8) * 2;
            const bf16x8 b0 = *(const LAS bf16x8*)(K_lds + KSWZ(prow, cb)), b1 = *(const LAS bf16x8*)(K_lds + KSWZ(32 + prow, cb));
            p0 = __builtin_amdgcn_mfma_f32_32x32x16_bf16(b0, qr[d0], p0, 0, 0, 0);
            p1 = __builtin_amdgcn_mfma_f32_32x32x16_bf16(b1, qr[d0], p1, 0, 0, 0); }
        const bool need_mask = (k0 + 63 >= tq0);
        f32x16 s0, s1; float t0 = 0.f, t1 = 0.f;
#pragma unroll
        for (int r = 0; r < 16; ++r) {
            float e0 = __builtin_amdgcn_exp2f(p0[r]), e1 = __builtin_amdgcn_exp2f(p1[r]);
            float q0 = __builtin_amdgcn_logf(1.0f + e0), q1 = __builtin_amdgcn_logf(1.0f + e1);
            if (need_mask) { const bool v0 = (k0 + 16 * hi + r) < tq, v1 = (k0 + 32 + 16 * hi + r) < tq; e0 = v0 ? e0 : 0.f; q0 = v0 ? q0 : 0.f; e1 = v1 ? e1 : 0.f; q1 = v1 ? q1 : 0.f; }
            p0[r] = e0; p1[r] = e1; s0[r] = q0; s1[r] = q1; t0 += q0; t1 += q1; }
        float t1lo, t1hi, t0lo, t0hi;
        { auto rr = __builtin_amdgcn_permlane32_swap(__float_as_uint(t1), __float_as_uint(t1), false, false); t1lo = __uint_as_float(rr[0]); t1hi = __uint_as_float(rr[1]); }
        { auto rr = __builtin_amdgcn_permlane32_swap(__float_as_uint(t0), __float_as_uint(t0), false, false); t0lo = __uint_as_float(rr[0]); t0hi = __uint_as_float(rr[1]); }
        float run1 = carry + (hi ? 0.f : t1hi), run0 = carry + (t1lo + t1hi) + (hi ? 0.f : t0hi);
#pragma unroll
        for (int r = 15; r >= 0; --r) { run1 += s1[r]; p1[r] = p1[r] * __builtin_amdgcn_exp2f(-run1); run0 += s0[r]; p0[r] = p0[r] * __builtin_amdgcn_exp2f(-run0); }
        carry += (t1lo + t1hi) + (t0lo + t0hi);
        const bf16x8 pa0 = pack8(p0, 0), pa1 = pack8(p0, 8), pa2 = pack8(p1, 0), pa3 = pack8(p1, 8);
        pv_one<0>(o[0], vb0, pa0, pa1, pa2, pa3); pv_one<1>(o[1], vb0, pa0, pa1, pa2, pa3); pv_one<2>(o[2], vb0, pa0, pa1, pa2, pa3); pv_one<3>(o[3], vb0, pa0, pa1, pa2, pa3);
        if (!flagged && __all(carry >= SB_EXIT)) { flagged = true; if (lane == 0) (void)__hip_atomic_fetch_add((LAS int*)done_cnt, 1, __ATOMIC_RELAXED, __HIP_MEMORY_SCOPE_WORKGROUP); }
    }
    const float* onw = a.in[I_SBONW];
    float wv[4];
#pragma unroll
    for (int d0 = 0; d0 < 4; ++d0) wv[d0] = onw[32 * d0 + r32];
#pragma unroll
    for (int r = 0; r < 16; ++r) {
        float ss = (o[0][r] * o[0][r] + o[1][r] * o[1][r]) + (o[2][r] * o[2][r] + o[3][r] * o[3][r]);
        ss += __shfl_xor(ss, 1); ss += __shfl_xor(ss, 2); ss += __shfl_xor(ss, 4); ss += __shfl_xor(ss, 8); ss += __shfl_xor(ss, 16);
        const float rstd = 1.0f / sqrtf(ss * (1.0f / HD) + NORM_EPS);
        const size_t tok = (size_t)b * SEQ + (tq0 - NMETA) + crow(r, hi);
        bf16_t* dst = MIX + tok * DM + 1024 + h * HD + r32;
#pragma unroll
        for (int d0 = 0; d0 < 4; ++d0) dst[32 * d0] = (bf16_t)(cvt_pk_bf16(o[d0][r] * rstd * wv[d0], 0.f) & 0xffffu);
    }
}
}

__device__ __forceinline__ void p5_router(const Args& a, LAS unsigned char* lds, int G, int c, int tid, int lane, int wave) {
    LAS float* wl = (LAS float*)lds;
    LAS float* lg = (LAS float*)(lds + 132096);
    LAS int* misc = (LAS int*)(lds + MISC_OFF);
    const float* H1 = a.out; const float* rw = a.in[I_RW]; const float* rb = a.in[I_RB];
    bf16_t* HN2 = (bf16_t*)(a.ws + WS_HN);
    int* RE = (int*)(a.ws + WS_RE); int* RP = (int*)(a.ws + WS_RP); float* RG = (float*)(a.ws + WS_RG); int* LIST = (int*)(a.ws + WS_LIST);
    unsigned* ecnt = (unsigned*)(a.ws + WS_CTL) + CW_ECNT;
    f32x4 wn[8];
#pragma unroll
    for (int j = 0; j < 8; ++j) wn[j] = *((const f32x4*)a.in[I_FFNNW] + lane + 64 * j);
    for (int blk = c; blk < NREAL / 64; blk += G) {
        for (int pass = 0; pass < 2; ++pass) {
            __syncthreads();
            for (int idx = tid; idx < 2048 * 16; idx += NTHREADS) { const int k = idx >> 4, cc = idx & 15; wl[cc * WLS + k] = rw[(size_t)k * NEXP + pass * 16 + cc]; }
            if (pass == 0 && tid < 32) misc[40 + tid] = 0;
            __syncthreads();
            for (int rr = 0; rr < 8; ++rr) {
                const int rloc = wave * 8 + rr; const size_t row = (size_t)blk * 64 + rloc;
                f32x4 v[8]; float ss = 0.f;
#pragma unroll
                for (int j = 0; j < 8; ++j) { v[j] = *((const f32x4*)(H1 + row * DM) + lane + 64 * j); ss += (v[j].x * v[j].x + v[j].y * v[j].y) + (v[j].z * v[j].z + v[j].w * v[j].w); }
                const float rstd = 1.0f / sqrtf(wave_sum(ss) * (1.0f / DM) + NORM_EPS);
                GAS unsigned long long* o8 = (GAS unsigned long long*)(HN2 + row * DM) + lane;
#pragma unroll
                for (int j = 0; j < 8; ++j) { v[j] = v[j] * rstd * wn[j];
                    if (pass == 0) o8[64 * j] = (unsigned long long)cvt_pk_bf16(v[j].x, v[j].y) | ((unsigned long long)cvt_pk_bf16(v[j].z, v[j].w) << 32); }
                float s[16]; dot16(v, wl, lane, s);
                float sv = s[0];
#pragma unroll
                for (int cc = 1; cc < 16; ++cc) sv = ((lane & 15) == cc) ? s[cc] : sv;
                if (lane < 16) lg[rloc * 33 + pass * 16 + lane] = sv;
            }
        }
        __syncthreads();
        int ek[4] = {0, 0, 0, 0}, rk[4] = {0, 0, 0, 0}; float gk[4] = {0.f, 0.f, 0.f, 0.f};
        if (tid < 64) {
            float v[32];
#pragma unroll
            for (int e = 0; e < 32; ++e) v[e] = lg[tid * 33 + e] + rb[e];
            float val[4];
#pragma unroll
            for (int k = 0; k < 4; ++k) { float best = -3.0e38f; int bi = 0;
#pragma unroll
                for (int e = 0; e < 32; ++e) { const bool gt = v[e] > best; best = gt ? v[e] : best; bi = gt ? e : bi; }
#pragma unroll
                for (int e = 0; e < 32; ++e) v[e] = (e == bi) ? -3.0e38f : v[e];
                ek[k] = bi; val[k] = best; }
            float den = 0.f;
#pragma unroll
            for (int k = 0; k < 4; ++k) { gk[k] = expf(val[k] - val[0]); den += gk[k]; }
#pragma unroll
            for (int k = 0; k < 4; ++k) { gk[k] = gk[k] / den; rk[k] = __hip_atomic_fetch_add(&misc[40 + ek[k]], 1, __ATOMIC_RELAXED, __HIP_MEMORY_SCOPE_WORKGROUP); }
        }
        __syncthreads();
        if (tid < 32) { const int cnt = misc[40 + tid]; misc[72 + tid] = cnt ? (int)atomicAdd(&ecnt[tid], (unsigned)cnt) : 0; }
        __syncthreads();
        if (tid < 64) { const int tok = blk * 64 + tid;
#pragma unroll
            for (int k = 0; k < 4; ++k) { const int pos = misc[72 + ek[k]] + rk[k]; LIST[(size_t)ek[k] * NREAL + pos] = tok; RE[tok * 4 + k] = ek[k]; RP[tok * 4 + k] = pos; RG[tok * 4 + k] = gk[k]; } }
    }
    __syncthreads();
}

__device__ __forceinline__ int moe_setup(const Args& a, LAS int* misc, int tid) {
    const unsigned* ecnt = (const unsigned*)(a.ws + WS_CTL) + CW_ECNT;
    __syncthreads();
    if (tid == 0) { int acc = 0;
        for (int e = 0; e < NEXP; ++e) { const int cnt = (int)__hip_atomic_load(ecnt + e, __ATOMIC_RELAXED, __HIP_MEMORY_SCOPE_AGENT); misc[104 + e] = cnt; misc[e] = acc; acc += (cnt + 255) >> 8; }
        misc[32] = acc; }
    __syncthreads();
    return misc[32];
}

__device__ __forceinline__ void p8_combine(const Args& a, const LAS int* misc, int gw, int NGW, int lane) {
    const int* RE = (const int*)(a.ws + WS_RE); const int* RP = (const int*)(a.ws + WS_RP); const float* RG = (const float*)(a.ws + WS_RG);
    const bf16_t* Y = (const bf16_t*)(a.ws + WS_Y); const float* bd = a.in[I_BD]; float* out = a.out;
    for (int row = gw; row < NREAL; row += NGW) {
        int e[4]; size_t slot[4]; float g[4];
#pragma unroll
        for (int k = 0; k < 4; ++k) { e[k] = RE[row * 4 + k]; slot[k] = (size_t)misc[e[k]] * 256 + RP[row * 4 + k]; g[k] = RG[row * 4 + k]; }
#pragma unroll
        for (int j = 0; j < 4; ++j) { const int col = 8 * lane + 512 * j;
            f32x4 a0 = *(const f32x4*)(out + (size_t)row * DM + col), a1 = *(const f32x4*)(out + (size_t)row * DM + col + 4);
#pragma unroll
            for (int k = 0; k < 4; ++k) { const u32x4 y = *(const u32x4*)(Y + slot[k] * DM + col);
                const f32x4 b0 = *(const f32x4*)(bd + (size_t)e[k] * DM + col), b1 = *(const f32x4*)(bd + (size_t)e[k] * DM + col + 4);
                a0.x += g[k] * (bf_lo(y.x) + b0.x); a0.y += g[k] * (bf_hi(y.x) + b0.y); a0.z += g[k] * (bf_lo(y.y) + b0.z); a0.w += g[k] * (bf_hi(y.y) + b0.w);
                a1.x += g[k] * (bf_lo(y.z) + b1.x); a1.y += g[k] * (bf_hi(y.z) + b1.y); a1.z += g[k] * (bf_lo(y.w) + b1.z); a1.w += g[k] * (bf_hi(y.w) + b1.w); }
            *(f32x4*)(out + (size_t)row * DM + col) = a0; *(f32x4*)(out + (size_t)row * DM + col + 4) = a1; }
    }
}

constexpr int NPH = 9;
__global__ void __launch_bounds__(NTHREADS, 2) hymba_fwd(Args args) {
    extern __shared__ __attribute__((aligned(16))) unsigned char lds_raw[];
    LAS unsigned char* lds = (LAS unsigned char*)lds_raw;
    LAS int* misc = (LAS int*)(lds + MISC_OFF);
    const int tid = threadIdx.x, lane = tid & 63, wave = __builtin_amdgcn_readfirstlane(tid >> 6);
    const int G = gridDim.x, bx = blockIdx.x;
    const int vcu = (G % 8 == 0) ? (bx % 8) * (G / 8) + bx / 8 : bx;
    const int gw = vcu * NWAVES + wave, NGW = G * NWAVES;
    unsigned* ctl = (unsigned*)(args.ws + WS_CTL);
    for (int u = tid; u < 256; u += NTHREADS) misc[u] = 0;
    __syncthreads();
    XcdBarrier bar; bar.bar = ctl + CW_BAR; bar.x = 0; bar.st = nullptr;
    const int lo = args.ph_lo, hi = args.ph_hi;
    if (hi - lo > 1) bar = xcd_barrier_post(ctl + CW_BAR, (volatile LAS unsigned*)(misc + 200));
#ifdef ONLY
#define IN(k) ((k) == ONLY && lo <= (k) && (k) < hi)
#else
#define IN(k) (lo <= (k) && (k) < hi)
#endif
#define SEAM(k) do { if (IN(k) && IN((k) + 1)) xcd_barrier(bar); } while (0)

    if (IN(0)) { p0_rows(args, lds, gw, NGW, tid, lane); p0_weights(args, gw, NGW, lane); }
    SEAM(0);
    if (IN(1)) {
        pg8::PlainOrder S; S.init(MPAD, NPROJ, DM, args.ws + WS_WIN, G, bx);
        pg8::EpiBf16 E{(bf16_t*)(args.ws + WS_P), NPROJ};
        pg8::gemm_phase<pg8::EpiBf16, pg8::PlainOrder, true, true>(lds, (const char*)(args.ws + WS_HN), DM, S, E);
    }
    SEAM(1);
    if (IN(2)) {
        p2_qknorm(args, gw, NGW, lane);
#if GDN_CHUNKED
        for (int it = bx; it < 32 * gdn::NCH; it += G) { __syncthreads(); gdn::precompute(args, lds, it, tid, lane, wave); }
#endif
    }
    SEAM(2);
    if (IN(3)) {
        const int NG = (G >= 64) ? 32 : 0;
#if GDN_CHUNKED
        if (bx < 32 || NG == 0) { for (int it = bx; it < 32; it += G) gdn::scan(args, lds, it, tid, lane, wave); }
#else
        if (bx < 32 || NG == 0) { for (int it = bx; it < 32; it += G) p3_gdn_naive(args, lds, it, tid, lane, wave); }
#endif
        if (bx >= NG) { for (int u = bx - NG; u < 512; u += G - NG) sba::unit(args, lds, (volatile LAS int*)(misc + 210), u >> 7, (u >> 4) & 7, u & 15, tid, lane, wave); }
    }
    SEAM(3);
    if (IN(4)) {
        pg8::PlainOrder S; S.init(NREAL, DM, DM, args.ws + WS_WOUT, G, bx);
        pg8::EpiResF32 E{args.in[I_X], args.out, DM};
        pg8::gemm_phase<pg8::EpiResF32, pg8::PlainOrder, true, true>(lds, (const char*)(args.ws + WS_MIX), DM, S, E);
    }
    SEAM(4);
    if (IN(5)) p5_router(args, lds, G, bx, tid, lane, wave);
    SEAM(5);
    if (IN(6)) {
        const int mt = moe_setup(args, misc, tid);
        pg8::MoeOrder<true> S; S.tpre = misc; S.tok = (const LAS int*)(lds + TOK_OFF); S.nN = 16; S.nwg = mt * 16; S.G = G; S.c = bx;
        S.Bt = (const char*)(args.ws + WS_WGU); S.estride = (size_t)2 * DE * DM * 2; S.K2 = DM * 2;
        const int* LIST = (const int*)(args.ws + WS_LIST);
        for (int ui = 0; ui < TOK_CAP; ++ui) { pg8::Unit u; if (!S.next(ui, u)) break;
            if (tid < 256) { const int idx = (u.pm - misc[u.e]) * 256 + tid; ((LAS int*)(lds + TOK_OFF))[ui * 256 + tid] = idx < misc[104 + u.e] ? LIST[(size_t)u.e * NREAL + idx] : 0; } }
        __syncthreads();
        pg8::EpiSwiGLU E{(bf16_t*)(args.ws + WS_ACT), args.in[I_BGU]};
        pg8::gemm_phase<pg8::EpiSwiGLU, pg8::MoeOrder<true>, true, true>(lds, (const char*)(args.ws + WS_HN), DM, S, E);
    }
    SEAM(6);
    if (IN(7)) {
        const int mt = moe_setup(args, misc, tid);
        pg8::MoeOrder<false> S; S.tpre = misc; S.tok = nullptr; S.nN = 8; S.nwg = mt * 8; S.G = G; S.c = bx;
        S.Bt = (const char*)(args.ws + WS_WD); S.estride = (size_t)DM * DE * 2; S.K2 = DE * 2;
        pg8::EpiBf16 E{(bf16_t*)(args.ws + WS_Y), DM};
        pg8::gemm_phase<pg8::EpiBf16, pg8::MoeOrder<false>, true, true>(lds, (const char*)(args.ws + WS_ACT), DE, S, E);
    }
    SEAM(7);
    if (IN(8)) { (void)moe_setup(args, misc, tid); p8_combine(args, misc, gw, NGW, lane); }
#undef IN
#undef SEAM
}

extern "C" void kernel_launch(void* const* d_in, const int* in_sizes, int n_in, void* d_out, int out_size, void* d_ws, size_t ws_size, hipStream_t stream) {
    static int grid = 0;
    if (grid == 0) {
        if (n_in != 19 || out_size != NREAL * DM || ws_size < WS_END) { fprintf(stderr, "kernel_launch: unexpected shapes (n_in %d out %d ws %zu need %zu)\n", n_in, out_size, ws_size, (size_t)WS_END); grid = -1; return; }
        int dev = 0, cus = 0, per_cu = 0;
        if (hipGetDevice(&dev) != hipSuccess || hipDeviceGetAttribute(&cus, hipDeviceAttributeMultiprocessorCount, dev) != hipSuccess) { grid = -1; return; }
        if (hipFuncSetAttribute((const void*)hymba_fwd, hipFuncAttributeMaxDynamicSharedMemorySize, LDS_BYTES) != hipSuccess) { fprintf(stderr, "kernel_launch: hipFuncSetAttribute failed\n"); grid = -1; return; }
        if (hipOccupancyMaxActiveBlocksPerMultiprocessor(&per_cu, (const void*)hymba_fwd, NTHREADS, LDS_BYTES) != hipSuccess || per_cu < 1) { fprintf(stderr, "kernel_launch: occupancy query says %d\n", per_cu); grid = -1; return; }
        (void)hipGetLastError();
        grid = cus;
    }
    if (grid < 0) return;
    (void)hipMemsetAsync((char*)d_ws + WS_CTL, 0, CTL_ZERO_BYTES, stream);
    Args a{};
    for (int i = 0; i < 19; ++i) a.in[i] = (const float*)d_in[i];
    a.out = (float*)d_out; a.ws = (unsigned char*)d_ws;
#if MK_N_LAUNCHES == 1
    a.ph_lo = 0; a.ph_hi = NPH;
    hipLaunchKernelGGL(hymba_fwd, dim3(grid), dim3(NTHREADS), LDS_BYTES, stream, a);
#else
    for (int p = 0; p < NPH; ++p) { a.ph_lo = p; a.ph_hi = p + 1; hipLaunchKernelGGL(hymba_fwd, dim3(grid), dim3(NTHREADS), LDS_BYTES, stream, a); }
#endif
    const hipError_t le = hipPeekAtLastError();
    if (le != hipSuccess) fprintf(stderr, "kernel_launch: launch failed: %s\n", hipGetErrorName(le));
}
```

```cpp
#include <hip/hip_runtime.h>
#include <cstdio>
#include <cstdint>

#ifndef GDN_CHUNKED
#define GDN_CHUNKED 1
#endif
#ifndef REP_PHASE
#define REP_PHASE -1
#endif
#ifndef PROBE_A
#define PROBE_A -1
#define PROBE_B -1
#endif
#ifndef MK_N_LAUNCHES
#define MK_N_LAUNCHES 1
#endif

constexpr int NB = 4, SEQ = 4096, NMETA = 16, LSEQ = SEQ + NMETA;
constexpr int DM = 2048, NTOK = NB * LSEQ  , MPAD = 16640  , NREAL = NB * SEQ  ;
constexpr int NPROJ_SRC = 7184, NPROJ = 7168;
constexpr int NHEAD = 8, HD = 128;
constexpr int PC_QKV = 0, PC_Z = 3072, PC_SBQ = 4096, PC_SBK = 5120, PC_SBV = 6144;
constexpr int NEXP = 32, TOPK = 4, DE = 2048;
constexpr int SLOT_ROWS = 73728;
constexpr int LROW = 4224;
constexpr float NORM_EPS = 1e-6f;

constexpr size_t MiB = 1u << 20;
constexpr size_t WS_CTL = 0, CTL_ZERO_BYTES = 1 * MiB;
constexpr size_t WS_WIN = 1 * MiB;
constexpr size_t WS_WOUT = WS_WIN + (size_t)NPROJ * DM * 2;
constexpr size_t WS_WGU = WS_WOUT + (size_t)DM * DM * 2;
constexpr size_t WS_WD = WS_WGU + (size_t)NEXP * 2 * DE * DM * 2;
constexpr size_t WS_HN = WS_WD + (size_t)NEXP * DM * DE * 2;
constexpr size_t WS_BETA = WS_HN + (size_t)MPAD * DM * 2;
constexpr size_t WS_G = WS_BETA + (size_t)NTOK * 8 * 4 + 256;
constexpr size_t WS_P = WS_G + (size_t)NTOK * 8 * 4 + 256;
constexpr size_t WS_QN = WS_P + (size_t)MPAD * NPROJ * 2;
constexpr size_t WS_KN = WS_QN + (size_t)NB * NHEAD * LROW * HD * 2;
constexpr size_t WS_ORAW = WS_KN + (size_t)NB * NHEAD * LROW * HD * 2;
constexpr size_t WS_MIX = WS_ORAW + (size_t)NREAL * 1024 * 4;
constexpr size_t WS_RE = WS_MIX + (size_t)NREAL * DM * 2;
constexpr size_t WS_RP = WS_RE + (size_t)NREAL * 4 * 4;
constexpr size_t WS_RG = WS_RP + (size_t)NREAL * 4 * 4;
constexpr size_t WS_LIST = WS_RG + (size_t)NREAL * 4 * 4;
constexpr size_t WS_ACT = WS_LIST + (size_t)NEXP * NREAL * 4;
constexpr size_t WS_Y = WS_ACT + (size_t)SLOT_ROWS * DE * 2;
constexpr size_t WS_GCH = WS_Y + (size_t)SLOT_ROWS * DM * 2;
constexpr size_t WS_GL = WS_GCH + (size_t)32 * 65 * 73728;
constexpr size_t WS_END = WS_GL + 32 * 65 * 4 + 256;
constexpr int CW_ECNT = 64;
constexpr int CW_BAR = 4096;

constexpr int LDS_STAGE = 131072;
constexpr int TOK_OFF = LDS_STAGE, TOK_CAP = 20;
constexpr int MISC_OFF = TOK_OFF + TOK_CAP * 256 * 4;
constexpr int LDS_BYTES = MISC_OFF + 1024;

#define GAS __attribute__((address_space(1)))
#define LAS __attribute__((address_space(3)))
typedef unsigned short bf16_t;
typedef short bf16x8 __attribute__((ext_vector_type(8)));
typedef short s16x4 __attribute__((ext_vector_type(4)));
typedef float f32x4 __attribute__((ext_vector_type(4)));
typedef float f32x2 __attribute__((ext_vector_type(2)));
typedef float f32x16 __attribute__((ext_vector_type(16)));
typedef unsigned u32x4 __attribute__((ext_vector_type(4)));
typedef unsigned u32x2 __attribute__((ext_vector_type(2)));

typedef __bf16 bf16x2_t __attribute__((ext_vector_type(2)));
__device__ __forceinline__ unsigned cvt_pk_bf16(float lo, float hi) { const f32x2 v = {lo, hi}; const bf16x2_t b = __builtin_convertvector(v, bf16x2_t); return __builtin_bit_cast(unsigned, b); }
__device__ __forceinline__ float bf_lo(unsigned w) { return __uint_as_float(w << 16); }
__device__ __forceinline__ float bf_hi(unsigned w) { return __uint_as_float(w & 0xffff0000u); }
__device__ __forceinline__ float bf2f(bf16_t b) { return __uint_as_float(((unsigned)b) << 16); }
__device__ __forceinline__ float wave_sum(float v) {
#pragma unroll
    for (int o = 1; o < 64; o <<= 1) v += __shfl_xor(v, o);
    return v;
}

namespace pg8 {
constexpr int BM = 256, BK = 64, HALF = 128, HTB = HALF * BK * 2, STAGE_BYTES = 8 * HTB, NXCD = 8, WGM = 8;
__host__ __device__ __forceinline__ int lds_byte(int r, int c) { const int st = (r >> 4) * 2 + (c >> 5), rr = r & 15, cc = c & 31, ob = rr * 64 + cc * 2; return st * 1024 + (ob ^ (((ob >> 9) & 1) << 5)); }
__host__ __device__ __forceinline__ void stage_rc(int b, int& R, int& C) { const int st = b / 1024, sb = b % 1024, swz = sb ^ (((sb >> 9) & 1) << 5); R = (st >> 1) * 16 + swz / 64; C = (st & 1) * 32 + (swz % 64) / 2; }
__host__ __device__ __forceinline__ int perm32(int rho) { const int n = rho >> 4, i = rho & 15; return 8 * (i >> 2) + 4 * n + (i & 3); }

struct Unit { int pm, pn, e, ui; };

__device__ __forceinline__ int xcd_remap(int L, int nwg) { const int q = nwg / NXCD, r = nwg % NXCD, xcd = L % NXCD, off = L / NXCD; return (xcd < r ? xcd * (q + 1) : r * (q + 1) + (xcd - r) * q) + off; }

struct PlainOrder {
    int nM, nN, nwg, G, c; const char* Bt; unsigned K2;
    __device__ void init(int M, int N, int K, const void* Bt_, int G_, int c_) { nM = M / BM; nN = N / BM; nwg = nM * nN; G = G_; c = c_; Bt = (const char*)Bt_; K2 = (unsigned)K * 2u; }
    __device__ __forceinline__ bool next(int i, Unit& u) const {
        const long L = (long)i * G + c; if (L >= nwg) return false;
        const int wgid = xcd_remap((int)L, nwg);
        const int nig = WGM * nN, gid = wgid / nig, fm = gid * WGM, gsz = (nM - fm) < WGM ? (nM - fm) : WGM;
        u.pm = fm + ((wgid % nig) % gsz); u.pn = (wgid % nig) / gsz; u.e = 0; u.ui = i; return true;
    }
    __device__ __forceinline__ const char* b_ptr(const Unit& u) const { return Bt + (size_t)u.pn * BM * K2; }
    __device__ __forceinline__ unsigned a_off(const Unit& u, int r) const { return (unsigned)(u.pm * BM + r) * K2; }
};
template <bool GATHER> struct MoeOrder {
    const LAS int* tpre; const LAS int* tok; int nN, nwg, G, c; const char* Bt; size_t estride; unsigned K2;
    __device__ __forceinline__ bool next(int i, Unit& u) const {
        const long L = (long)i * G + c; if (L >= nwg) return false;
        const int wgid = xcd_remap((int)L, nwg);
        int e = 0;
#pragma unroll 1
        for (int j = 1; j < NEXP; ++j) e = (wgid >= tpre[j] * nN) ? j : e;
        const int t0 = tpre[e], nt = tpre[e + 1] - t0, loc = wgid - t0 * nN;
        u.e = e; u.pn = loc / nt; u.pm = t0 + loc % nt; u.ui = i; return true;
    }
    __device__ __forceinline__ const char* b_ptr(const Unit& u) const { return Bt + (size_t)u.e * estride + (size_t)u.pn * BM * K2; }
    __device__ __forceinline__ unsigned a_off(const Unit& u, int r) const {
        if (GATHER) return (unsigned)tok[u.ui * 256 + r] * K2;
        return (unsigned)(u.pm * BM + r) * K2;
    }
};

struct EpiBf16 {
    static constexpr bool PERM = true;
    bf16_t* O; int ldc;
    __device__ __forceinline__ void operator()(const f32x4 (&acc)[2][2][4][2], const Unit& u, int wr, int wc, int fr, int fq) const {
        const int row0 = u.pm * BM + wr * 64 + fr, col0 = u.pn * BM + wc * 32 + 8 * fq;
#pragma unroll
        for (int ai = 0; ai < 2; ++ai)
#pragma unroll
            for (int m = 0; m < 4; ++m) { bf16_t* rowp = O + (size_t)(row0 + ai * HALF + m * 16) * ldc + col0;
#pragma unroll
                for (int bj = 0; bj < 2; ++bj) { const f32x4 v0 = acc[ai][bj][m][0], v1 = acc[ai][bj][m][1];
                    u32x4 w; w.x = cvt_pk_bf16(v0[0], v0[1]); w.y = cvt_pk_bf16(v0[2], v0[3]); w.z = cvt_pk_bf16(v1[0], v1[1]); w.w = cvt_pk_bf16(v1[2], v1[3]);
                    *(u32x4*)(rowp + bj * HALF) = w; } }
    }
};
struct EpiResF32 {
    static constexpr bool PERM = false;
    const float* X; float* out; int ldc;
    __device__ __forceinline__ void operator()(const f32x4 (&acc)[2][2][4][2], const Unit& u, int wr, int wc, int fr, int fq) const {
        const int row0 = u.pm * BM + wr * 64 + fr, col0 = u.pn * BM + wc * 32 + 4 * fq;
#pragma unroll
        for (int ai = 0; ai < 2; ++ai)
#pragma unroll
            for (int m = 0; m < 4; ++m) { const size_t off = (size_t)(row0 + ai * HALF + m * 16) * ldc + col0;
#pragma unroll
                for (int bj = 0; bj < 2; ++bj)
#pragma unroll
                    for (int n = 0; n < 2; ++n) { const f32x4 xv = *(const f32x4*)(X + off + bj * HALF + n * 16); *(f32x4*)(out + off + bj * HALF + n * 16) = xv + acc[ai][bj][m][n]; }
                asm volatile("" ::: "memory"); }
    }
};
__device__ __forceinline__ float swiglu1(float g, float uu) {
    g = fminf(g, 7.0f); uu = fminf(fmaxf(uu, -7.0f), 7.0f);
    const float sg = __builtin_amdgcn_rcpf(1.0f + __builtin_amdgcn_exp2f(-1.702f * 1.4426950408889634f * g));
    return (uu + 1.0f) * g * sg;
}
struct EpiSwiGLU {
    static constexpr bool PERM = true;
    bf16_t* act; const float* bgu;
    __device__ __forceinline__ void operator()(const f32x4 (&acc)[2][2][4][2], const Unit& u, int wr, int wc, int fr, int fq) const {
        const int row0 = u.pm * BM + wr * 64 + fr, col0 = u.pn * HALF + wc * 32 + 8 * fq;
        const float* bg = bgu + (size_t)u.e * 4096 + col0;
        const f32x4 bg0 = *(const f32x4*)(bg), bg1 = *(const f32x4*)(bg + 4), bu0 = *(const f32x4*)(bg + 2048), bu1 = *(const f32x4*)(bg + 2052);
#pragma unroll
        for (int ai = 0; ai < 2; ++ai)
#pragma unroll
            for (int m = 0; m < 4; ++m) { bf16_t* rowp = act + (size_t)(row0 + ai * HALF + m * 16) * DE + col0;
                const f32x4 g0 = acc[ai][0][m][0] + bg0, g1 = acc[ai][0][m][1] + bg1, u0 = acc[ai][1][m][0] + bu0, u1 = acc[ai][1][m][1] + bu1;
                u32x4 w; w.x = cvt_pk_bf16(swiglu1(g0[0], u0[0]), swiglu1(g0[1], u0[1])); w.y = cvt_pk_bf16(swiglu1(g0[2], u0[2]), swiglu1(g0[3], u0[3]));
                w.z = cvt_pk_bf16(swiglu1(g1[0], u1[0]), swiglu1(g1[1], u1[1])); w.w = cvt_pk_bf16(swiglu1(g1[2], u1[2]), swiglu1(g1[3], u1[3]));
                *(u32x4*)rowp = w; }
    }
};

template <class Epi, class Sched, bool ALIGN_EPI, bool SP2>
__device__ __forceinline__ void gemm_phase(LAS unsigned char* lds, const char* A0, int K, const Sched& S, const Epi& E) {
    const int tid = threadIdx.x, wid = __builtin_amdgcn_readfirstlane(tid >> 6), lane = tid & 63, wr = wid >> 2, wc = wid & 3, fr = lane & 15, fq = lane >> 4;
    const int nt = K / BK;
    int Rr[2], Cc[2]; unsigned voffB[2];
#pragma unroll
    for (int i = 0; i < 2; ++i) { int R, C; stage_rc(tid * 16 + i * 8192, R, C); const int Rb = Epi::PERM ? ((R & ~31) + perm32(R & 31)) : R;
        Rr[i] = R; Cc[i] = C * 2; voffB[i] = (unsigned)(Rb * K + C) * 2u; }
    const size_t kstep = (size_t)(BK * 2);
    const size_t hstep = (size_t)HALF * K * 2;
    const unsigned ldsw = (unsigned)wid * 1024u;
    const int aoff = lds_byte(wr * 64 + fr, fq * 8), boff = lds_byte(wc * 32 + fr, fq * 8);
#define PG8_SA(b, h) (((b) * 2 + (h)) * HTB)
#define PG8_SB(b, h) ((4 + (b) * 2 + (h)) * HTB)
#define PG8_STAGE(bufoff, gbase, voff) do { _Pragma("unroll") for (int _i = 0; _i < 2; ++_i) \
        __builtin_amdgcn_global_load_lds((const unsigned*)((const char*)(gbase) + (voff)[_i]), (LAS unsigned*)(lds + (bufoff) + ldsw + _i * 8192), 16, 0, 0); } while (0)
#define PG8_LDA(dst, b, h) do { _Pragma("unroll") for (int m = 0; m < 4; ++m) _Pragma("unroll") for (int k = 0; k < 2; ++k) dst[m][k] = *(const LAS bf16x8*)(lds + PG8_SA(b, h) + aoff + m * 2048 + k * 1024); } while (0)
#define PG8_LDB(dst, b, h) do { _Pragma("unroll") for (int n = 0; n < 2; ++n) _Pragma("unroll") for (int k = 0; k < 2; ++k) dst[n][k] = *(const LAS bf16x8*)(lds + PG8_SB(b, h) + boff + n * 2048 + k * 1024); } while (0)
#define PG8_MMA(ai, bj, At, Bt) do { __builtin_amdgcn_s_setprio(1); _Pragma("unroll") for (int m = 0; m < 4; ++m) _Pragma("unroll") for (int n = 0; n < 2; ++n) _Pragma("unroll") for (int k = 0; k < 2; ++k) \
        acc[ai][bj][m][n] = __builtin_amdgcn_mfma_f32_16x16x32_bf16(Bt[n][k], At[m][k], acc[ai][bj][m][n], 0, 0, 0); __builtin_amdgcn_s_setprio(0); } while (0)
#define PG8_WAIT_V(n) asm volatile("s_waitcnt vmcnt(" #n ")" ::: "memory")
#define PG8_WAIT_L(n) asm volatile("s_waitcnt lgkmcnt(" #n ")" ::: "memory")
#define PG8_BAR __builtin_amdgcn_s_barrier()
#define PG8_SCHED __builtin_amdgcn_sched_barrier(0)
#define PG8_VOFF(dst, u) do { _Pragma("unroll") for (int _h = 0; _h < 2; ++_h) _Pragma("unroll") for (int _i = 0; _i < 2; ++_i) dst[_h][_i] = S.a_off(u, _h * HALF + Rr[_i]) + (unsigned)Cc[_i]; } while (0)
    Unit cur, nxt; int ui = 0;
    if (!S.next(0, cur)) return;
    f32x4 acc[2][2][4][2];
#pragma unroll
    for (int a = 0; a < 2; ++a)
#pragma unroll
        for (int b = 0; b < 2; ++b)
#pragma unroll
            for (int m = 0; m < 4; ++m)
#pragma unroll
                for (int n = 0; n < 2; ++n) acc[a][b][m][n] = (f32x4){0.f, 0.f, 0.f, 0.f};
    bf16x8 At[4][2], B0[2][2], B1[2][2];
    unsigned va[2][2], vn[2][2];
    PG8_VOFF(va, cur);
    const char* cB = S.b_ptr(cur);
    if constexpr (SP2) {
        PG8_STAGE(PG8_SB(0, 0), cB, voffB); PG8_STAGE(PG8_SB(0, 1), cB + hstep, voffB); PG8_STAGE(PG8_SA(0, 0), A0, va[0]); PG8_STAGE(PG8_SA(0, 1), A0, va[1]);
        if (wr == 1) PG8_BAR;
        PG8_WAIT_V(2); PG8_BAR;
        PG8_STAGE(PG8_SB(1, 0), cB + kstep, voffB); PG8_STAGE(PG8_SA(1, 0), A0 + kstep, va[0]); PG8_STAGE(PG8_SB(1, 1), cB + hstep + kstep, voffB);
        PG8_WAIT_V(6); PG8_BAR;
    } else {
        PG8_STAGE(PG8_SB(0, 0), cB, voffB); PG8_STAGE(PG8_SA(0, 0), A0, va[0]); PG8_STAGE(PG8_SB(0, 1), cB + hstep, voffB); PG8_STAGE(PG8_SA(0, 1), A0, va[1]);
        if (wr == 1) PG8_BAR;
        PG8_WAIT_V(4); PG8_BAR;
        PG8_STAGE(PG8_SB(1, 0), cB + kstep, voffB); PG8_STAGE(PG8_SA(1, 0), A0 + kstep, va[0]); PG8_STAGE(PG8_SB(1, 1), cB + hstep + kstep, voffB);
        PG8_WAIT_V(6); PG8_BAR;
    }
    for (;;) {
        const bool has_next = S.next(ui + 1, nxt);
        const char* nB = has_next ? S.b_ptr(nxt) : cB;
        for (int t = 0; t < nt; t += 2) {
            const bool last = (t == nt - 2);
            const char* a1 = A0 + (size_t)(t + 1) * kstep;
            const char* a2 = last ? A0 : A0 + (size_t)(t + 2) * kstep; const char* b2 = last ? nB : cB + (size_t)(t + 2) * kstep;
            const char* a3 = a2 + kstep; const char* b3 = b2 + kstep;
            if (last) { if (has_next) { PG8_VOFF(vn, nxt); } else {
#pragma unroll
                    for (int _h = 0; _h < 2; ++_h)
#pragma unroll
                        for (int _i = 0; _i < 2; ++_i) vn[_h][_i] = va[_h][_i]; } }
            if constexpr (SP2) {
            PG8_LDB(B0, 0, 0); PG8_LDB(B1, 0, 1); PG8_SCHED; PG8_LDA(At, 0, 0); PG8_STAGE(PG8_SA(1, 1), a1, va[1]);
            if (last) {
#pragma unroll
                for (int _h = 0; _h < 2; ++_h)
#pragma unroll
                    for (int _i = 0; _i < 2; ++_i) va[_h][_i] = vn[_h][_i]; }
            PG8_WAIT_V(8); PG8_WAIT_L(0); PG8_BAR; PG8_MMA(0, 0, At, B0); PG8_MMA(0, 1, At, B1); PG8_BAR; PG8_SCHED;
            PG8_LDA(At, 0, 1); PG8_STAGE(PG8_SB(0, 0), b2, voffB); PG8_STAGE(PG8_SB(0, 1), b2 + hstep, voffB); PG8_STAGE(PG8_SA(0, 0), a2, va[0]);
            PG8_WAIT_V(8); PG8_WAIT_L(0); PG8_BAR; PG8_MMA(1, 0, At, B0); PG8_MMA(1, 1, At, B1); PG8_BAR; PG8_SCHED;
            PG8_LDB(B0, 1, 0); PG8_LDB(B1, 1, 1); PG8_SCHED; PG8_LDA(At, 1, 0); PG8_STAGE(PG8_SA(0, 1), a2, va[1]);
            PG8_WAIT_V(8); PG8_WAIT_L(0); PG8_BAR; PG8_MMA(0, 0, At, B0); PG8_MMA(0, 1, At, B1); PG8_BAR; PG8_SCHED;
            PG8_LDA(At, 1, 1); PG8_STAGE(PG8_SB(1, 0), b3, voffB); PG8_STAGE(PG8_SB(1, 1), b3 + hstep, voffB); PG8_STAGE(PG8_SA(1, 0), a3, va[0]);
            PG8_WAIT_V(8); PG8_WAIT_L(0); PG8_BAR; PG8_MMA(1, 0, At, B0); PG8_MMA(1, 1, At, B1); PG8_BAR; PG8_SCHED;
            } else {
            PG8_LDB(B0, 0, 0); PG8_SCHED; PG8_LDA(At, 0, 0); PG8_STAGE(PG8_SA(1, 1), a1, va[1]);
            if (last) {
#pragma unroll
                for (int _h = 0; _h < 2; ++_h)
#pragma unroll
                    for (int _i = 0; _i < 2; ++_i) va[_h][_i] = vn[_h][_i]; }
            PG8_WAIT_L(8); PG8_BAR; PG8_WAIT_L(0); PG8_MMA(0, 0, At, B0); PG8_BAR; PG8_SCHED;
            PG8_LDB(B1, 0, 1); PG8_STAGE(PG8_SB(0, 0), b2, voffB);
            PG8_BAR; PG8_WAIT_L(0); PG8_MMA(0, 1, At, B1); PG8_BAR;
            PG8_LDA(At, 0, 1); PG8_STAGE(PG8_SA(0, 0), a2, va[0]);
            PG8_BAR; PG8_WAIT_L(0); PG8_MMA(1, 0, At, B0); PG8_BAR; PG8_SCHED;
            PG8_STAGE(PG8_SB(0, 1), b2 + hstep, voffB);
            PG8_WAIT_V(6); PG8_BAR; PG8_MMA(1, 1, At, B1); PG8_BAR;
            PG8_LDB(B0, 1, 0); PG8_SCHED; PG8_LDA(At, 1, 0); PG8_STAGE(PG8_SA(0, 1), a2, va[1]);
            PG8_WAIT_L(8); PG8_BAR; PG8_WAIT_L(0); PG8_MMA(0, 0, At, B0); PG8_BAR; PG8_SCHED;
            PG8_LDB(B1, 1, 1); PG8_STAGE(PG8_SB(1, 0), b3, voffB);
            PG8_BAR; PG8_WAIT_L(0); PG8_MMA(0, 1, At, B1); PG8_BAR;
            PG8_LDA(At, 1, 1); PG8_STAGE(PG8_SA(1, 0), a3, va[0]);
            PG8_BAR; PG8_WAIT_L(0); PG8_MMA(1, 0, At, B0); PG8_BAR; PG8_SCHED;
            PG8_STAGE(PG8_SB(1, 1), b3 + hstep, voffB);
            PG8_WAIT_V(6); PG8_BAR; PG8_MMA(1, 1, At, B1); PG8_BAR;
            }
        }
        if constexpr (ALIGN_EPI) { if (wr == 0) PG8_BAR; }
        E(acc, cur, wr, wc, fr, fq);
        if (!has_next) break;
#pragma unroll
        for (int a = 0; a < 2; ++a)
#pragma unroll
            for (int b = 0; b < 2; ++b)
#pragma unroll
                for (int m = 0; m < 4; ++m)
#pragma unroll
                    for (int n = 0; n < 2; ++n) acc[a][b][m][n] = (f32x4){0.f, 0.f, 0.f, 0.f};
        cur = nxt; cB = nB; ++ui;
        if constexpr (ALIGN_EPI) { if (wr == 1) PG8_BAR; }
    }
    PG8_WAIT_V(0);
    if constexpr (!ALIGN_EPI) { if (wr == 0) PG8_BAR; }
    PG8_BAR;
#undef PG8_SA
#undef PG8_SB
#undef PG8_STAGE
#undef PG8_LDA
#undef PG8_LDB
#undef PG8_MMA
#undef PG8_WAIT_V
#undef PG8_WAIT_L
#undef PG8_BAR
#undef PG8_SCHED
#undef PG8_VOFF
}
}

#define XB_TMO      128
#define XB_XCNT(j)  (256  + 64 * (j))
#define XB_XSUB(j)  (1280 + 64 * (j))
#define XB_XGEN(j)  (2304 + 64 * (j))
#define XB_TOP      3328
#define XB_TOPGEN   3392
#define XCD_BAR_WORDS 3456
#define XB_SPIN_CAP (1u << 18)

__device__ __forceinline__ unsigned xb_ld(unsigned* p)              { return __hip_atomic_load(p, __ATOMIC_RELAXED, __HIP_MEMORY_SCOPE_AGENT); }
__device__ __forceinline__ unsigned xb_add(unsigned* p, unsigned v) { return __hip_atomic_fetch_add(p, v, __ATOMIC_RELAXED, __HIP_MEMORY_SCOPE_AGENT); }
__device__ __forceinline__ unsigned xb_xcc_id() { return (unsigned)__builtin_amdgcn_s_getreg((3 << 11) | 20) & 0xFu; }
#define XB_SPIN(cond, bar) do { unsigned _sp = 0; while (cond) { __builtin_amdgcn_s_sleep(1); \
    if ((++_sp & 255u) == 0u) { if (xb_ld(&(bar)[XB_TMO])) break; if (_sp > XB_SPIN_CAP) { atomicAdd(&(bar)[XB_TMO], 1u); break; } } } } while (0)

struct XcdBarrier {
    unsigned* bar; unsigned x;
    volatile LAS unsigned* st;
};
__device__ __forceinline__ XcdBarrier xcd_barrier_post(unsigned* bar, volatile LAS unsigned* st) {
    XcdBarrier b; b.bar = bar; b.x = xb_xcc_id(); b.st = st;
    if (threadIdx.x == 0) (void)xb_add(&bar[XB_XCNT(b.x)], 1u);
    return b;
}
__device__ __forceinline__ void xcd_barrier_complete(unsigned* bar, unsigned x, unsigned& nloc, unsigned& nx) {
    const unsigned G = gridDim.x * gridDim.y * gridDim.z;
    unsigned sum, cnt, mine, sp = 0u;
    for (;;) {
        sum = 0u; cnt = 0u; mine = 0u;
#pragma unroll
        for (unsigned j = 0; j < 16; ++j) { const unsigned c = xb_ld(&bar[XB_XCNT(j)]); sum += c; cnt += (c > 0u) ? 1u : 0u; mine = (j == x) ? c : mine; }
        if (sum == G) break;
        __builtin_amdgcn_s_sleep(1);
        if ((++sp & 255u) == 0u) { if (xb_ld(&bar[XB_TMO])) break; if (sp > XB_SPIN_CAP) { atomicAdd(&bar[XB_TMO], 1u); break; } }
    }
    nloc = mine > 0u ? mine : 1u; nx = cnt > 0u ? cnt : 1u;
}
__device__ __forceinline__ void xcd_barrier(const XcdBarrier& b) {
    asm volatile("s_waitcnt vmcnt(0)" ::: "memory");
    __syncthreads();
    if (threadIdx.x == 0) {
        unsigned* bar = b.bar;
        __builtin_amdgcn_s_waitcnt(0);
        unsigned nloc = b.st[0], nx = b.st[1];
        if (nloc == 0u) { xcd_barrier_complete(bar, b.x, nloc, nx); b.st[0] = nloc; b.st[1] = nx; }
        const unsigned old = xb_add(&bar[XB_XSUB(b.x)], 1u);
        const unsigned gen = old / nloc;
        if (old + 1u == (gen + 1u) * nloc) {
            __builtin_amdgcn_fence(__ATOMIC_RELEASE, "agent");
            asm volatile("s_waitcnt vmcnt(0)" ::: "memory");
            const unsigned og = xb_add(&bar[XB_TOP], 1u);
            const unsigned tg = og / nx;
            if (og + 1u == (tg + 1u) * nx) xb_add(&bar[XB_TOPGEN], 1u);
            else XB_SPIN(xb_ld(&bar[XB_TOPGEN]) == tg, bar);
            __builtin_amdgcn_fence(__ATOMIC_ACQUIRE, "agent");
            xb_add(&bar[XB_XGEN(b.x)], 1u);
            asm volatile("s_waitcnt vmcnt(0)" ::: "memory");
        } else {
            XB_SPIN(xb_ld(&bar[XB_XGEN(b.x)]) == gen, bar);
            __builtin_amdgcn_fence(__ATOMIC_ACQUIRE, "agent");
            asm volatile("s_waitcnt vmcnt(0)" ::: "memory");
        }
    }
    __syncthreads();
}

constexpr int NWAVES = 8, NTHREADS = 512;
struct Args { const float* in[19]; float* out; unsigned char* ws; int ph_lo, ph_hi; };
enum { I_X = 0, I_META, I_MIXNW, I_WIN, I_CONVW, I_ALOG, I_DTB, I_GDNNW, I_SBQNW, I_SBKNW, I_SBONW, I_WOUT, I_FFNNW, I_RW, I_RB, I_WGU, I_BGU, I_WD, I_BD };

#define LDS_WAIT() asm volatile("s_waitcnt lgkmcnt(0)" ::: "memory")
#define VM_WAIT() asm volatile("s_waitcnt vmcnt(0)" ::: "memory")
constexpr int WLS = 2052;

__device__ __forceinline__ void dot16(const f32x4 (&v)[8], const LAS float* wl, int lane, float (&s)[16]) {
#pragma unroll
    for (int c = 0; c < 16; ++c) { float a = 0.f;
#pragma unroll
        for (int j = 0; j < 8; ++j) { const f32x4 w = *(const LAS f32x4*)(wl + c * WLS + 4 * lane + 256 * j); a += (v[j].x * w.x + v[j].y * w.y) + (v[j].z * w.z + v[j].w * w.w); }
        s[c] = wave_sum(a); }
}

__device__ __forceinline__ void p0_rows(const Args& a, LAS unsigned char* lds, int gw, int NGW, int tid, int lane) {
    const float* x = a.in[I_X]; const float* meta = a.in[I_META]; const float* nw = a.in[I_MIXNW]; const float* win = a.in[I_WIN];
    LAS float* wl = (LAS float*)lds;
    for (int idx = tid; idx < 2048 * 16; idx += NTHREADS) { const int k = idx >> 4, c = idx & 15; wl[c * WLS + k] = win[(size_t)k * NPROJ_SRC + 4096 + c]; }
    __syncthreads();
    bf16_t* HN = (bf16_t*)(a.ws + WS_HN); float* BETA = (float*)(a.ws + WS_BETA); float* GG = (float*)(a.ws + WS_G);
    f32x4 wn[8];
#pragma unroll
    for (int j = 0; j < 8; ++j) wn[j] = *((const f32x4*)nw + lane + 64 * j);
    const int hh = lane & 7;
    const float alog = a.in[I_ALOG][hh], dtb = a.in[I_DTB][hh];
    for (int row = gw; row < MPAD; row += NGW) {
        GAS unsigned long long* o8 = (GAS unsigned long long*)(HN + (size_t)row * DM) + lane;
        if (row >= NTOK) {
#pragma unroll
            for (int j = 0; j < 8; ++j) o8[64 * j] = 0ull;
            continue; }
        const int b = row / LSEQ, t = row - b * LSEQ;
        const float* src = (t < NMETA) ? meta + (size_t)t * DM : x + ((size_t)b * SEQ + (t - NMETA)) * DM;
        f32x4 v[8]; float ss = 0.f;
#pragma unroll
        for (int j = 0; j < 8; ++j) { v[j] = *((const f32x4*)src + lane + 64 * j); ss += (v[j].x * v[j].x + v[j].y * v[j].y) + (v[j].z * v[j].z + v[j].w * v[j].w); }
        const float rstd = 1.0f / sqrtf(wave_sum(ss) * (1.0f / DM) + NORM_EPS);
#pragma unroll
        for (int j = 0; j < 8; ++j) { v[j] = v[j] * rstd * wn[j];
            o8[64 * j] = (unsigned long long)cvt_pk_bf16(v[j].x, v[j].y) | ((unsigned long long)cvt_pk_bf16(v[j].z, v[j].w) << 32); }
        float s[16]; dot16(v, wl, lane, s);
        float bv = s[0], av = s[8];
#pragma unroll
        for (int c = 1; c < 8; ++c) { bv = (hh == c) ? s[c] : bv; av = (hh == c) ? s[8 + c] : av; }
        if (lane < 8) {
            const float beta = 1.0f / (1.0f + expf(-bv));
            const float xa = av + dtb; const float sp = fmaxf(xa, 0.f) + log1pf(expf(-fabsf(xa)));
            BETA[(size_t)row * 8 + hh] = beta; GG[(size_t)row * 8 + hh] = -expf(alog) * sp; }
    }
    __syncthreads();
}

template <int MODE  >
__device__ __forceinline__ void cvt_strip(const float* W, int ldw, int K, bf16_t* out, int kb, int nb, int lane) {
    const int r0 = nb * 256 + 4 * lane;
    int c0;
    if (MODE == 0) c0 = r0;
    else if (MODE == 1) c0 = r0 < 4096 ? r0 : r0 + 16;
    else { const int pn = r0 >> 8, rr = r0 & 255; c0 = rr < 128 ? 128 * pn + rr : 2048 + 128 * pn + (rr - 128); }
    const float* src = W + (size_t)(kb * 64) * ldw + c0;
    bf16_t* dst = out + (size_t)r0 * K + kb * 64;
#pragma unroll 2
    for (int st = 0; st < 8; ++st) {
        f32x4 v[8];
#pragma unroll
        for (int i = 0; i < 8; ++i) v[i] = *(const f32x4*)(src + (size_t)(st * 8 + i) * ldw);
#pragma unroll
        for (int j = 0; j < 4; ++j) { u32x4 w; w.x = cvt_pk_bf16(v[0][j], v[1][j]); w.y = cvt_pk_bf16(v[2][j], v[3][j]); w.z = cvt_pk_bf16(v[4][j], v[5][j]); w.w = cvt_pk_bf16(v[6][j], v[7][j]);
            *(u32x4*)(dst + (size_t)j * K + st * 8) = w; }
    }
}
__device__ __forceinline__ void p0_weights(const Args& a, int gw, int NGW, int lane) {
    constexpr int I_IN = 32 * 28, I_OUT = 32 * 8, I_GU = 32 * 16, I_D = 32 * 8;
    constexpr int NITEMS = I_IN + I_OUT + NEXP * (I_GU + I_D);
    for (int it = gw; it < NITEMS; it += NGW) {
        int r = it;
        if (r < I_IN) { cvt_strip<1>(a.in[I_WIN], NPROJ_SRC, DM, (bf16_t*)(a.ws + WS_WIN), r / 28, r % 28, lane); continue; } r -= I_IN;
        if (r < I_OUT) { cvt_strip<0>(a.in[I_WOUT], DM, DM, (bf16_t*)(a.ws + WS_WOUT), r / 8, r % 8, lane); continue; } r -= I_OUT;
        if (r < NEXP * I_GU) { const int e = r / I_GU, q = r % I_GU;
            cvt_strip<2>(a.in[I_WGU] + (size_t)e * DM * 2 * DE, 2 * DE, DM, (bf16_t*)(a.ws + WS_WGU) + (size_t)e * 2 * DE * DM, q / 16, q % 16, lane); continue; } r -= NEXP * I_GU;
        { const int e = r / I_D, q = r % I_D;
            cvt_strip<0>(a.in[I_WD] + (size_t)e * DE * DM, DM, DE, (bf16_t*)(a.ws + WS_WD) + (size_t)e * DM * DE, q / 8, q % 8, lane); }
    }
}

__device__ __forceinline__ void p2_qknorm(const Args& a, int gw, int NGW, int lane) {
    const bf16_t* P = (const bf16_t*)(a.ws + WS_P); bf16_t* QN = (bf16_t*)(a.ws + WS_QN); bf16_t* KN = (bf16_t*)(a.ws + WS_KN);
    const float qw0 = a.in[I_SBQNW][2 * lane], qw1 = a.in[I_SBQNW][2 * lane + 1], kw0 = a.in[I_SBKNW][2 * lane], kw1 = a.in[I_SBKNW][2 * lane + 1];
    const float QS = 0.08838834764831845f * 1.4426950408889634f;
    for (int it = gw; it < NTOK * NHEAD * 2; it += NGW) {
        const int which = it & 1, h = (it >> 1) & 7, row = it >> 4;
        const int b = row / LSEQ, t = row - b * LSEQ;
        const unsigned w = *(const unsigned*)(P + (size_t)row * NPROJ + (which ? PC_SBK : PC_SBQ) + h * HD + 2 * lane);
        const float v0 = bf_lo(w), v1 = bf_hi(w);
        const float rstd = 1.0f / sqrtf(wave_sum(v0 * v0 + v1 * v1) * (1.0f / HD) + NORM_EPS);
        const float o0 = which ? v0 * rstd * kw0 : v0 * rstd * qw0 * QS, o1 = which ? v1 * rstd * kw1 : v1 * rstd * qw1 * QS;
        *(unsigned*)((which ? KN : QN) + ((size_t)(b * NHEAD + h) * LROW + t) * HD + 2 * lane) = cvt_pk_bf16(o0, o1);
    }
}

__device__ __forceinline__ void p3_gdn_naive(const Args& a, LAS unsigned char* lds, int item, int tid, int lane, int wave) {
    const int b = item >> 3, h = item & 7;
    const bf16_t* P = (const bf16_t*)(a.ws + WS_P); const float* BETA = (const float*)(a.ws + WS_BETA); const float* GG = (const float*)(a.ws + WS_G);
    float* ORAW = (float*)(a.ws + WS_ORAW); bf16_t* MIX = (bf16_t*)(a.ws + WS_MIX);
    LAS float* buf = (LAS float*)lds;
    const int j = tid >> 2, part = tid & 3;
    const int which = tid >> 7, d = tid & 127; const bool conv = tid < 384;
    const int pcol = which * 1024 + h * HD + d;
    float cw0 = 0, cw1 = 0, cw2 = 0, cw3 = 0;
    if (conv) { const float* cwp = a.in[I_CONVW] + pcol; cw0 = cwp[0]; cw1 = cwp[3072]; cw2 = cwp[2 * 3072]; cw3 = cwp[3 * 3072]; }
    float xm1 = 0.f, xm2 = 0.f, xm3 = 0.f;
    float S[32];
#pragma unroll
    for (int i = 0; i < 32; ++i) S[i] = 0.f;
    const size_t row0 = (size_t)b * LSEQ;
    float xnext = conv ? bf2f(P[row0 * NPROJ + pcol]) : 0.f;
    float bnext = BETA[row0 * 8 + h], gnext = GG[row0 * 8 + h];
    for (int t = 0; t < LSEQ; ++t) {
        const float xt = xnext, beta = bnext, gam = expf(gnext);
        if (t + 1 < LSEQ) { if (conv) xnext = bf2f(P[(row0 + t + 1) * NPROJ + pcol]); bnext = BETA[(row0 + t + 1) * 8 + h]; gnext = GG[(row0 + t + 1) * 8 + h]; }
        LAS float* cb = buf + (t & 1) * 384;
        if (conv) { const float y = cw3 * xt + cw2 * xm1 + cw1 * xm2 + cw0 * xm3; xm3 = xm2; xm2 = xm1; xm1 = xt; cb[tid] = y / (1.0f + expf(-y)); }
        __syncthreads();
        float kk = 0.f, qq = 0.f, dk = 0.f; f32x4 kv[8], qv[8];
#pragma unroll
        for (int i = 0; i < 8; ++i) { kv[i] = *(const LAS f32x4*)(cb + 128 + 32 * part + 4 * i); qv[i] = *(const LAS f32x4*)(cb + 32 * part + 4 * i); }
#pragma unroll
        for (int i = 0; i < 8; ++i)
#pragma unroll
            for (int c = 0; c < 4; ++c) { kk += kv[i][c] * kv[i][c]; qq += qv[i][c] * qv[i][c]; dk += S[4 * i + c] * kv[i][c]; }
        kk += __shfl_xor(kk, 1); kk += __shfl_xor(kk, 2); qq += __shfl_xor(qq, 1); qq += __shfl_xor(qq, 2); dk += __shfl_xor(dk, 1); dk += __shfl_xor(dk, 2);
        const float rk = 1.0f / sqrtf(kk + NORM_EPS), rq = 0.08838834764831845f / sqrtf(qq + NORM_EPS);
        const float vj = cb[256 + j];
        const float vnew = beta * (vj - gam * rk * dk);
        const float kvn = rk * vnew; float oq = 0.f;
#pragma unroll
        for (int i = 0; i < 8; ++i)
#pragma unroll
            for (int c = 0; c < 4; ++c) { S[4 * i + c] = gam * S[4 * i + c] + kv[i][c] * kvn; oq += S[4 * i + c] * qv[i][c]; }
        oq += __shfl_xor(oq, 1); oq += __shfl_xor(oq, 2);
        if (t >= NMETA && part == 0) ORAW[((size_t)b * SEQ + (t - NMETA)) * 1024 + h * HD + j] = rq * oq;
    }
    __threadfence(); __syncthreads();
    const float nw0 = a.in[I_GDNNW][2 * lane], nw1 = a.in[I_GDNNW][2 * lane + 1];
    for (int s = wave; s < SEQ; s += NWAVES) {
        const size_t tok = (size_t)b * SEQ + s;
        const f32x2 o = *(const f32x2*)(ORAW + tok * 1024 + h * HD + 2 * lane);
        const float rstd = 1.0f / sqrtf(wave_sum(o.x * o.x + o.y * o.y) * (1.0f / HD) + NORM_EPS);
        const unsigned zw = *(const unsigned*)(P + (row0 + NMETA + s) * NPROJ + PC_Z + h * HD + 2 * lane);
        const float z0 = bf_lo(zw), z1 = bf_hi(zw);
        const float r0 = o.x * rstd * nw0 * (z0 / (1.0f + expf(-z0))), r1 = o.y * rstd * nw1 * (z1 / (1.0f + expf(-z1)));
        *(unsigned*)(MIX + tok * DM + h * HD + 2 * lane) = cvt_pk_bf16(r0, r1);
    }
}

__device__ __forceinline__ bf16x8 sba_pack8(const f32x16& p, int base) {
    u32x4 w; w.x = cvt_pk_bf16(p[base + 0], p[base + 1]); w.y = cvt_pk_bf16(p[base + 2], p[base + 3]); w.z = cvt_pk_bf16(p[base + 4], p[base + 5]); w.w = cvt_pk_bf16(p[base + 6], p[base + 7]);
    return __builtin_bit_cast(bf16x8, w);
}

namespace gdn {
constexpr int NCH = 65;
constexpr int IMG_W = 0, IMG_QG = 16384, IMG_KDT = 32768, IMG_AT = 49152, IMG_BYTES = 57344, IMG_U = 57344, CH_BYTES = 73728;
constexpr int L_QB = 0, L_KB = 17408, L_VB = 34816, L_LT = 52224, L_GC = 69632, L_BE = 69888, L_IMG = 70144;
__device__ __forceinline__ int afrag_off(int row, int k, int nks) {
    const int rt = row >> 5, rr = row & 31, ks = k >> 4, kk = k & 15, hi = (kk >> 2) & 1, sl = (kk & 3) + 4 * (kk >> 3);
    return ((rt * nks + ks) * 64 + rr + 32 * hi) * 16 + sl * 2;
}
__device__ __forceinline__ int ufrag_off(int i, int c) {
    const int cg = c >> 5, col = c & 31, rt = i >> 5, ii = i & 31, hi = (ii >> 2) & 1, r = (ii & 3) + 4 * (ii >> 3);
    return (((cg * 2 + rt) * 2 + (r >> 3)) * 64 + col + 32 * hi) * 8 + (r & 7);
}
__device__ __forceinline__ int crow(int r, int hi) { return (r & 3) + 8 * (r >> 2) + 4 * hi; }
__device__ __forceinline__ bf16_t f2bf(float f) { return (bf16_t)(cvt_pk_bf16(f, 0.f) & 0xffffu); }

__device__ __forceinline__ void precompute(const Args& a, LAS unsigned char* lds, int item, int tid, int lane, int wave) {
    asm volatile("" : "+v"(tid), "+v"(lane), "+s"(wave));
    const int bh = item / NCH, c = item - bh * NCH, b = bh >> 3, h = bh & 7;
    const bf16_t* P = (const bf16_t*)(a.ws + WS_P) + (size_t)b * LSEQ * NPROJ;
    const float* BETA = (const float*)(a.ws + WS_BETA) + (size_t)b * LSEQ * 8; const float* GG = (const float*)(a.ws + WS_G) + (size_t)b * LSEQ * 8;
    unsigned char* dst = a.ws + WS_GCH + (size_t)item * CH_BYTES;
    LAS float* GC = (LAS float*)(lds + L_GC); LAS float* BE = (LAS float*)(lds + L_BE); LAS float* LT = (LAS float*)(lds + L_LT);
    const int tbase = 64 * c - 48;
    if (wave == 0) {
        const int t = tbase + lane; float g = 0.f, be = 0.f;
        if (t >= 0) { g = GG[(size_t)t * 8 + h]; be = BETA[(size_t)t * 8 + h]; }
#pragma unroll
        for (int o = 1; o < 64; o <<= 1) { const float y = __shfl_up(g, o); if (lane >= o) g += y; }
        GC[lane] = g; BE[lane] = be;
        if (lane == 63) ((float*)(a.ws + WS_GL))[item] = expf(g);
    }
    {
        f32x2 cw[3][4];
#pragma unroll
        for (int w3 = 0; w3 < 3; ++w3)
#pragma unroll
            for (int tap = 0; tap < 4; ++tap) cw[w3][tap] = *(const f32x2*)(a.in[I_CONVW] + tap * 3072 + w3 * 1024 + h * HD + 2 * lane);
        f32x2 xw[3][11];
#pragma unroll
        for (int j = 0; j < 11; ++j) { const int t = tbase + 8 * wave - 3 + j;
#pragma unroll
            for (int w3 = 0; w3 < 3; ++w3) { unsigned u = 0u; if (t >= 0) u = *(const unsigned*)(P + (size_t)t * NPROJ + w3 * 1024 + h * HD + 2 * lane); xw[w3][j] = (f32x2){bf_lo(u), bf_hi(u)}; } }
#pragma unroll
        for (int rr = 0; rr < 8; ++rr) { const int i = 8 * wave + rr; f32x2 y[3];
#pragma unroll
            for (int w3 = 0; w3 < 3; ++w3) { f32x2 acc = cw[w3][0] * xw[w3][rr] + cw[w3][1] * xw[w3][rr + 1] + cw[w3][2] * xw[w3][rr + 2] + cw[w3][3] * xw[w3][rr + 3];
                acc.x = acc.x / (1.0f + __expf(-acc.x)); acc.y = acc.y / (1.0f + __expf(-acc.y)); y[w3] = acc; }
            const float rq = 0.08838834764831845f / sqrtf(wave_sum(y[0].x * y[0].x + y[0].y * y[0].y) + NORM_EPS);
            const float rk = 1.0f / sqrtf(wave_sum(y[1].x * y[1].x + y[1].y * y[1].y) + NORM_EPS);
            *(LAS unsigned*)(lds + L_QB + i * 272 + 4 * lane) = cvt_pk_bf16(y[0].x * rq, y[0].y * rq);
            *(LAS unsigned*)(lds + L_KB + i * 272 + 4 * lane) = cvt_pk_bf16(y[1].x * rk, y[1].y * rk);
            *(LAS unsigned*)(lds + L_VB + i * 272 + 4 * lane) = cvt_pk_bf16(y[2].x, y[2].y); }
    }
    __syncthreads();
    {
        const int prod = wave >> 2, ti = (wave >> 1) & 1, tj = wave & 1, r32 = lane & 31, hi = lane >> 5;
        if (tj <= ti) {
            f32x16 acc;
#pragma unroll
            for (int r = 0; r < 16; ++r) acc[r] = 0.f;
            const LAS unsigned char* Ab = lds + (prod ? L_QB : L_KB) + (32 * ti + r32) * 272 + hi * 16;
            const LAS unsigned char* Bb = lds + L_KB + (32 * tj + r32) * 272 + hi * 16;
#pragma unroll
            for (int ks = 0; ks < 8; ++ks) acc = __builtin_amdgcn_mfma_f32_32x32x16_bf16(*(const LAS bf16x8*)(Ab + ks * 32), *(const LAS bf16x8*)(Bb + ks * 32), acc, 0, 0, 0);
            const int j = 32 * tj + r32; const float gj = GC[j];
#pragma unroll
            for (int r = 0; r < 16; ++r) { const int i = 32 * ti + crow(r, hi); const float dec = __expf(GC[i] - gj);
                if (prod == 0) LT[j * 68 + i] = (j < i) ? acc[r] * BE[i] * dec : 0.f;
                else *(LAS bf16_t*)(lds + L_IMG + IMG_AT + afrag_off(i, j, 4)) = f2bf((j <= i) ? acc[r] * dec : 0.f); }
        }
    }
    __syncthreads();
    if (tid < 256) {
        float x[64];
        const bool isv = tid < 128; const int cc = tid & 127;
        const LAS unsigned char* src = lds + (isv ? L_VB : L_KB) + cc * 2;
#pragma unroll
        for (int i8 = 0; i8 < 64; i8 += 8) {
#pragma unroll
            for (int q = 0; q < 8; ++q) { const int i = i8 + q; const float v = bf2f(*(const LAS bf16_t*)(src + i * 272)); x[i] = v * BE[i] * (isv ? 1.0f : __expf(GC[i])); }
            asm volatile("" ::: "memory"); }
#pragma unroll
        for (int j = 0; j < 63; ++j) {
#pragma unroll
            for (int i4 = ((j + 1) & ~3); i4 < 64; i4 += 4) { const f32x4 l4 = *(const LAS f32x4*)(LT + j * 68 + i4);
#pragma unroll
                for (int q = 0; q < 4; ++q) if (i4 + q > j) x[i4 + q] -= l4[q] * x[j]; }
            asm volatile("" ::: "memory");
        }
        if (isv) {
            LAS unsigned char* ub = lds + L_IMG + IMG_U + (((cc >> 5) * 4 * 64) + (cc & 31)) * 16;
#pragma unroll
            for (int i = 0; i < 64; ++i) { const int rt = i >> 5, ii = i & 31, hi = (ii >> 2) & 1, r = (ii & 3) + 4 * (ii >> 3);
                *(LAS bf16_t*)(ub + (((rt * 2 + (r >> 3)) * 64 + 32 * hi) * 8 + (r & 7)) * 2) = f2bf(x[i]); }
        } else {
            const int ks = cc >> 4, kk = cc & 15, hi = (kk >> 2) & 1, sl = (kk & 3) + 4 * (kk >> 3);
            LAS unsigned char* wb = lds + L_IMG + IMG_W + (ks * 64 + 32 * hi) * 16 + sl * 2;
#pragma unroll
            for (int i = 0; i < 64; ++i) *(LAS bf16_t*)(wb + ((i >> 5) * 8 * 64 + (i & 31)) * 16) = f2bf(-x[i]);
        }
    } else {
        const int u = tid - 256, dk = u & 127, i0 = (u >> 7) * 32; const float gl = GC[63];
#pragma unroll 4
        for (int ii = 0; ii < 32; ++ii) { const int i = i0 + ii; const float gi = GC[i];
            const float q = bf2f(*(const LAS bf16_t*)(lds + L_QB + i * 272 + dk * 2)), k = bf2f(*(const LAS bf16_t*)(lds + L_KB + i * 272 + dk * 2));
            *(LAS bf16_t*)(lds + L_IMG + IMG_QG + afrag_off(i, dk, 8)) = f2bf(q * __expf(gi));
            *(LAS bf16_t*)(lds + L_IMG + IMG_KDT + afrag_off(dk, i, 4)) = f2bf(k * __expf(gl - gi)); }
    }
    __syncthreads();
    for (int q = tid; q < CH_BYTES / 16; q += NTHREADS) *(u32x4*)(dst + (size_t)q * 16) = *(const LAS u32x4*)(lds + L_IMG + q * 16);
}

__device__ __forceinline__ void scan(const Args& a, LAS unsigned char* lds, int bh, int tid, int lane, int wave) {
    const int b = bh >> 3, h = bh & 7, col = lane & 31, hi = lane >> 5, cg = wave;
    const unsigned char* src = a.ws + WS_GCH + (size_t)bh * NCH * CH_BYTES;
    const float* GL = (const float*)(a.ws + WS_GL) + bh * NCH;
    float* ORAW = (float*)(a.ws + WS_ORAW);
    __syncthreads();
    const unsigned dvoff = (unsigned)(wave * 1024 + lane * 16), uvoff = (unsigned)(lane * 16);
#define GDN_DMA(ch, buf) do { const unsigned char* _sp = src + (size_t)(ch) * CH_BYTES; _Pragma("unroll") for (int _f = 0; _f < 7; ++_f) { \
        __builtin_amdgcn_global_load_lds((const unsigned*)(_sp + _f * 8192 + dvoff), (LAS unsigned*)(lds + (buf) * IMG_BYTES + wave * 1024 + _f * 8192), 16, 0, 0); } } while (0)
    GDN_DMA(0, 0);
    f32x16 st[4]; bf16x8 Sb[8]; u32x4 ureg[4]; float gl = 1.f;
#pragma unroll
    for (int t4 = 0; t4 < 4; ++t4)
#pragma unroll
        for (int r = 0; r < 16; ++r) st[t4][r] = 0.f;
#pragma unroll
    for (int ks = 0; ks < 8; ++ks) Sb[ks] = (bf16x8){0, 0, 0, 0, 0, 0, 0, 0};
    if (wave < 4) {
#pragma unroll
        for (int q = 0; q < 4; ++q) ureg[q] = *(const u32x4*)(src + IMG_U + cg * 4096 + q * 1024 + uvoff);
        gl = GL[0];
    }
    VM_WAIT(); __syncthreads();
    for (int c = 0; c < NCH; ++c) {
        const LAS unsigned char* img = lds + (c & 1) * IMG_BYTES + lane * 16;
        if (c + 1 < NCH) GDN_DMA(c + 1, (c + 1) & 1);
        if (wave < 4) {
            f32x16 vn[2]; const float glc = gl;
#pragma unroll
            for (int rt = 0; rt < 2; ++rt)
#pragma unroll
                for (int rh = 0; rh < 2; ++rh) { const u32x4 w = ureg[rt * 2 + rh];
                    vn[rt][8 * rh + 0] = bf_lo(w.x); vn[rt][8 * rh + 1] = bf_hi(w.x); vn[rt][8 * rh + 2] = bf_lo(w.y); vn[rt][8 * rh + 3] = bf_hi(w.y);
                    vn[rt][8 * rh + 4] = bf_lo(w.z); vn[rt][8 * rh + 5] = bf_hi(w.z); vn[rt][8 * rh + 6] = bf_lo(w.w); vn[rt][8 * rh + 7] = bf_hi(w.w); }
            asm volatile("" ::: "memory");
            if (c + 1 < NCH) {
#pragma unroll
                for (int q = 0; q < 4; ++q) ureg[q] = *(const u32x4*)(src + (size_t)(c + 1) * CH_BYTES + IMG_U + cg * 4096 + q * 1024 + uvoff);
                gl = GL[c + 1]; }
#pragma unroll
            for (int rt = 0; rt < 2; ++rt) { __builtin_amdgcn_sched_barrier(0);
#pragma unroll
                for (int ks = 0; ks < 8; ++ks) vn[rt] = __builtin_amdgcn_mfma_f32_32x32x16_bf16(*(const LAS bf16x8*)(img + IMG_W + (rt * 8 + ks) * 1024), Sb[ks], vn[rt], 0, 0, 0); }
            __builtin_amdgcn_sched_barrier(0);
            bf16x8 vb[4];
#pragma unroll
            for (int ks = 0; ks < 4; ++ks) vb[ks] = sba_pack8(vn[ks >> 1], 8 * (ks & 1));
            float* ob = ORAW + ((size_t)b * SEQ + (c >= 1 ? 64 * (c - 1) : 0)) * 1024 + h * HD + 32 * cg + col;
#pragma unroll
            for (int rt = 0; rt < 2; ++rt) { f32x16 o; __builtin_amdgcn_sched_barrier(0);
#pragma unroll
                for (int r = 0; r < 16; ++r) o[r] = 0.f;
#pragma unroll
                for (int ks = 0; ks < 8; ++ks) o = __builtin_amdgcn_mfma_f32_32x32x16_bf16(*(const LAS bf16x8*)(img + IMG_QG + (rt * 8 + ks) * 1024), Sb[ks], o, 0, 0, 0);
#pragma unroll
                for (int ks = 0; ks < 2 * (rt + 1); ++ks) o = __builtin_amdgcn_mfma_f32_32x32x16_bf16(*(const LAS bf16x8*)(img + IMG_AT + (rt * 4 + ks) * 1024), vb[ks], o, 0, 0, 0);
                if (c >= 1) {
#pragma unroll
                    for (int r = 0; r < 16; ++r) ob[(size_t)(32 * rt + crow(r, hi)) * 1024] = o[r]; }
            }
#pragma unroll
            for (int t4 = 0; t4 < 4; ++t4) { __builtin_amdgcn_sched_barrier(0);
#pragma unroll
                for (int r = 0; r < 16; ++r) st[t4][r] *= glc;
#pragma unroll
                for (int ks = 0; ks < 4; ++ks) st[t4] = __builtin_amdgcn_mfma_f32_32x32x16_bf16(*(const LAS bf16x8*)(img + IMG_KDT + (t4 * 4 + ks) * 1024), vb[ks], st[t4], 0, 0, 0);
                Sb[2 * t4] = sba_pack8(st[t4], 0); Sb[2 * t4 + 1] = sba_pack8(st[t4], 8); }
        }
        VM_WAIT(); __syncthreads();
    }
#undef GDN_DMA
    __threadfence(); __syncthreads();
    const bf16_t* P = (const bf16_t*)(a.ws + WS_P); bf16_t* MIX = (bf16_t*)(a.ws + WS_MIX);
    const float nw0 = a.in[I_GDNNW][2 * lane], nw1 = a.in[I_GDNNW][2 * lane + 1];
    for (int s = wave; s < SEQ; s += NWAVES) {
        const size_t tok = (size_t)b * SEQ + s;
        const f32x2 ov = *(const f32x2*)(ORAW + tok * 1024 + h * HD + 2 * lane);
        const float rstd = 1.0f / sqrtf(wave_sum(ov.x * ov.x + ov.y * ov.y) * (1.0f / HD) + NORM_EPS);
        const unsigned zw = *(const unsigned*)(P + ((size_t)b * LSEQ + NMETA + s) * NPROJ + PC_Z + h * HD + 2 * lane);
        const float z0 = bf_lo(zw), z1 = bf_hi(zw);
        const float r0 = ov.x * rstd * nw0 * (z0 / (1.0f + expf(-z0))), r1 = ov.y * rstd * nw1 * (z1 / (1.0f + expf(-z1)));
        *(unsigned*)(MIX + tok * DM + h * HD + 2 * lane) = cvt_pk_bf16(r0, r1);
    }
}
}

namespace sba {
#define KSWZ(row, colB) ((row) * 256 + ((colB) ^ (((row) & 7) << 4)))
__device__ __forceinline__ int v_st(int k, int c) { const int kk = (k & ~0xC) | ((k & 4) << 1) | ((k & 8) >> 1); return ((kk >> 3) * 4 + (c >> 5)) * 512 + ((kk & 7) * 32 + (c & 31)) * 2; }
__device__ __forceinline__ int v_rd_base(int lane) { return ((lane & 3) << 3) | (((lane >> 2) & 3) << 6) | (((lane >> 4) & 1) << 5) | (((lane >> 5) & 1) << 8); }
constexpr int v_rd_off(int d0, int ks, int half) { return d0 * 512 + ks * 4096 + half * 2048; }
template <int OFF> __device__ __forceinline__ s16x4 tr_read(int vb) { s16x4 r; asm volatile("ds_read_b64_tr_b16 %0, %1 offset:%2" : "=&v"(r) : "v"(vb), "i"(OFF) : "memory"); return r; }
template <int D0> __device__ __forceinline__ void pv_one(f32x16& od, int vb, bf16x8 pa0, bf16x8 pa1, bf16x8 pa2, bf16x8 pa3) {
    const s16x4 l0 = tr_read<v_rd_off(D0, 0, 0)>(vb), h0 = tr_read<v_rd_off(D0, 0, 1)>(vb), l1 = tr_read<v_rd_off(D0, 1, 0)>(vb), h1 = tr_read<v_rd_off(D0, 1, 1)>(vb);
    const s16x4 l2 = tr_read<v_rd_off(D0, 2, 0)>(vb), h2 = tr_read<v_rd_off(D0, 2, 1)>(vb), l3 = tr_read<v_rd_off(D0, 3, 0)>(vb), h3 = tr_read<v_rd_off(D0, 3, 1)>(vb);
    asm volatile("s_waitcnt lgkmcnt(0)" ::: "memory"); __builtin_amdgcn_sched_barrier(0);
#define PK(L, H) (bf16x8){L[0], L[1], L[2], L[3], H[0], H[1], H[2], H[3]}
    od = __builtin_amdgcn_mfma_f32_32x32x16_bf16(pa0, PK(l0, h0), od, 0, 0, 0);
    od = __builtin_amdgcn_mfma_f32_32x32x16_bf16(pa1, PK(l1, h1), od, 0, 0, 0);
    od = __builtin_amdgcn_mfma_f32_32x32x16_bf16(pa2, PK(l2, h2), od, 0, 0, 0);
    od = __builtin_amdgcn_mfma_f32_32x32x16_bf16(pa3, PK(l3, h3), od, 0, 0, 0);
#undef PK
}
__device__ __forceinline__ int crow(int r, int hi) { return (r & 3) + 8 * (r >> 2) + 4 * hi; }
__device__ __forceinline__ int swap34(int k) { return (k & ~0x18) | ((k & 8) << 1) | ((k & 16) >> 1); }
__device__ __forceinline__ bf16x8 pack8(const f32x16& p, int base) {
    u32x4 w; w.x = cvt_pk_bf16(p[base + 0], p[base + 1]); w.y = cvt_pk_bf16(p[base + 2], p[base + 3]); w.z = cvt_pk_bf16(p[base + 4], p[base + 5]); w.w = cvt_pk_bf16(p[base + 6], p[base + 7]);
    return __builtin_bit_cast(bf16x8, w);
}
constexpr float SB_EXIT = 160.0f;

__device__ __forceinline__ void unit(const Args& a, LAS unsigned char* lds, volatile LAS int* done_cnt, int b, int h, int qb, int tid, int lane, int wid) {
    const bf16_t* QN = (const bf16_t*)(a.ws + WS_QN) + (size_t)(b * NHEAD + h) * LROW * HD;
    const bf16_t* KN = (const bf16_t*)(a.ws + WS_KN) + (size_t)(b * NHEAD + h) * LROW * HD;
    const bf16_t* Vp = (const bf16_t*)(a.ws + WS_P) + (size_t)b * LSEQ * NPROJ + PC_SBV + h * HD;
    bf16_t* MIX = (bf16_t*)(a.ws + WS_MIX);
    const int r32 = lane & 31, hi = lane >> 5;
    LAS unsigned char* K_lds = lds; LAS unsigned char* V_lds = lds + 16384;
    const int tq0 = NMETA + 256 * qb + 32 * wid, tq = tq0 + r32;
    __syncthreads();
    if (tid == 0) *done_cnt = 0;
    bf16x8 qr[8];
#pragma unroll
    for (int d0 = 0; d0 < 8; ++d0) qr[d0] = *(const bf16x8*)(QN + (size_t)tq * HD + d0 * 16 + hi * 8);
    const int sr = tid >> 4, sc = (tid & 15) * 8;
    const int vst0 = v_st(swap34(sr), sc), vst1 = v_st(32 + swap34(sr), sc);
    const int kst0 = KSWZ(sr, sc * 2), kst1 = KSWZ(32 + sr, sc * 2);
    const int vb0 = (int)(unsigned)(unsigned long)V_lds + v_rd_base(lane);
    const int prow = (r32 & 3) + 4 * (r32 >> 3) + 16 * ((r32 >> 2) & 1);
    f32x16 o[4];
#pragma unroll
    for (int d = 0; d < 4; ++d)
#pragma unroll
        for (int r = 0; r < 16; ++r) o[d][r] = 0.f;
    float carry = 0.f; bool flagged = false;
    for (int kt = 4 * qb + 4; kt >= 0; --kt) {
        const int k0 = 64 * kt;
        const bf16x8 ks0 = *(const bf16x8*)(KN + (size_t)(k0 + sr) * HD + sc), ks1 = *(const bf16x8*)(KN + (size_t)(k0 + 32 + sr) * HD + sc);
        const bf16x8 vs0 = *(const bf16x8*)(Vp + (size_t)(k0 + sr) * NPROJ + sc), vs1 = *(const bf16x8*)(Vp + (size_t)(k0 + 32 + sr) * NPROJ + sc);
        __syncthreads();
        if (*done_cnt == NWAVES) break;
        *(LAS bf16x8*)(K_lds + kst0) = ks0; *(LAS bf16x8*)(K_lds + kst1) = ks1; *(LAS bf16x8*)(V_lds + vst0) = vs0; *(LAS bf16x8*)(V_lds + vst1) = vs1;
        __syncthreads();
        if (k0 >= tq0 + 32) continue;
        f32x16 p0, p1;
#pragma unroll
        for (int r = 0; r < 16; ++r) { p0[r] = 0.f; p1[r] = 0.f; }
#pragma unroll
        for (int d0 = 0; d0 < 8; ++d0) { const int cb = (d0 * 16 + hi * 8) * 2;
            const bf16x8 b0 = *(const LAS bf16x8*)(K_lds + KSWZ(prow, cb)), b1 = *(const LAS bf16x8*)(K_lds + KSWZ(32 + prow, cb));
            p0 = __builtin_amdgcn_mfma_f32_32x32x16_bf16(b0, qr[d0], p0, 0, 0, 0);
            p1 = __builtin_amdgcn_mfma_f32_32x32x16_bf16(b1, qr[d0], p1, 0, 0, 0); }
        const bool need_mask = (k0 + 63 >= tq0);
        f32x16 s0, s1; float t0 = 0.f, t1 = 0.f;
#pragma unroll
        for (int r = 0; r < 16; ++r) {
            float e0 = __builtin_amdgcn_exp2f(p0[r]), e1 = __builtin_amdgcn_exp2f(p1[r]);
            float q0 = __builtin_amdgcn_logf(1.0f + e0), q1 = __builtin_amdgcn_logf(1.0f + e1);
            if (need_mask) { const bool v0 = (k0 + 16 * hi + r) < tq, v1 = (k0 + 32 + 16 * hi + r) < tq; e0 = v0 ? e0 : 0.f; q0 = v0 ? q0 : 0.f; e1 = v1 ? e1 : 0.f; q1 = v1 ? q1 : 0.f; }
            p0[r] = e0; p1[r] = e1; s0[r] = q0; s1[r] = q1; t0 += q0; t1 += q1; }
        float t1lo, t1hi, t0lo, t0hi;
        { auto rr = __builtin_amdgcn_permlane32_swap(__float_as_uint(t1), __float_as_uint(t1), false, false); t1lo = __uint_as_float(rr[0]); t1hi = __uint_as_float(rr[1]); }
        { auto rr = __builtin_amdgcn_permlane32_swap(__float_as_uint(t0), __float_as_uint(t0), false, false); t0lo = __uint_as_float(rr[0]); t0hi = __uint_as_float(rr[1]); }
        float run1 = carry + (hi ? 0.f : t1hi), run0 = carry + (t1lo + t1hi) + (hi ? 0.f : t0hi);
#pragma unroll
        for (int r = 15; r >= 0; --r) { run1 += s1[r]; p1[r] = p1[r] * __builtin_amdgcn_exp2f(-run1); run0 += s0[r]; p0[r] = p0[r] * __builtin_amdgcn_exp2f(-run0); }
        carry += (t1lo + t1hi) + (t0lo + t0hi);
        const bf16x8 pa0 = pack8(p0, 0), pa1 = pack8(p0, 8), pa2 = pack8(p1, 0), pa3 = pack8(p1, 8);
        pv_one<0>(o[0], vb0, pa0, pa1, pa2, pa3); pv_one<1>(o[1], vb0, pa0, pa1, pa2, pa3); pv_one<2>(o[2], vb0, pa0, pa1, pa2, pa3); pv_one<3>(o[3], vb0, pa0, pa1, pa2, pa3);
        if (!flagged && __all(carry >= SB_EXIT)) { flagged = true; if (lane == 0) (void)__hip_atomic_fetch_add((LAS int*)done_cnt, 1, __ATOMIC_RELAXED, __HIP_MEMORY_SCOPE_WORKGROUP); }
    }
    const float* onw = a.in[I_SBONW];
    float wv[4];
#pragma unroll
    for (int d0 = 0; d0 < 4; ++d0) wv[d0] = onw[32 * d0 + r32];
#pragma unroll
    for (int r = 0; r < 16; ++r) {
        float ss = (o[0][r] * o[0][r] + o[1][r] * o[1][r]) + (o[2][r] * o[2][r] + o[3][r] * o[3][r]);
        ss += __shfl_xor(ss, 1); ss += __shfl_xor(ss, 2); ss += __shfl_xor(ss, 4); ss += __shfl_xor(ss, 8); ss += __shfl_xor(ss, 16);
        const float rstd = 1.0f / sqrtf(ss * (1.0f / HD) + NORM_EPS);
        const size_t tok = (size_t)b * SEQ + (tq0 - NMETA) + crow(r, hi);
        bf16_t* dst = MIX + tok * DM + 1024 + h * HD + r32;
#pragma unroll
        for (int d0 = 0; d0 < 4; ++d0) dst[32 * d0] = (bf16_t)(cvt_pk_bf16(o[d0][r] * rstd * wv[d0], 0.f) & 0xffffu);
    }
}
}

__device__ __forceinline__ void p5_router(const Args& a, LAS unsigned char* lds, int G, int c, int tid, int lane, int wave) {
    LAS float* wl = (LAS float*)lds;
    LAS float* lg = (LAS float*)(lds + 132096);
    LAS int* misc = (LAS int*)(lds + MISC_OFF);
    const float* H1 = a.out; const float* rw = a.in[I_RW]; const float* rb = a.in[I_RB];
    bf16_t* HN2 = (bf16_t*)(a.ws + WS_HN);
    int* RE = (int*)(a.ws + WS_RE); int* RP = (int*)(a.ws + WS_RP); float* RG = (float*)(a.ws + WS_RG); int* LIST = (int*)(a.ws + WS_LIST);
    unsigned* ecnt = (unsigned*)(a.ws + WS_CTL) + CW_ECNT;
    f32x4 wn[8];
#pragma unroll
    for (int j = 0; j < 8; ++j) wn[j] = *((const f32x4*)a.in[I_FFNNW] + lane + 64 * j);
    for (int blk = c; blk < NREAL / 64; blk += G) {
        for (int pass = 0; pass < 2; ++pass) {
            __syncthreads();
            for (int idx = tid; idx < 2048 * 16; idx += NTHREADS) { const int k = idx >> 4, cc = idx & 15; wl[cc * WLS + k] = rw[(size_t)k * NEXP + pass * 16 + cc]; }
            if (pass == 0 && tid < 32) misc[40 + tid] = 0;
            __syncthreads();
            for (int rr = 0; rr < 8; ++rr) {
                const int rloc = wave * 8 + rr; const size_t row = (size_t)blk * 64 + rloc;
                f32x4 v[8]; float ss = 0.f;
#pragma unroll
                for (int j = 0; j < 8; ++j) { v[j] = *((const f32x4*)(H1 + row * DM) + lane + 64 * j); ss += (v[j].x * v[j].x + v[j].y * v[j].y) + (v[j].z * v[j].z + v[j].w * v[j].w); }
                const float rstd = 1.0f / sqrtf(wave_sum(ss) * (1.0f / DM) + NORM_EPS);
                GAS unsigned long long* o8 = (GAS unsigned long long*)(HN2 + row * DM) + lane;
#pragma unroll
                for (int j = 0; j < 8; ++j) { v[j] = v[j] * rstd * wn[j];
                    if (pass == 0) o8[64 * j] = (unsigned long long)cvt_pk_bf16(v[j].x, v[j].y) | ((unsigned long long)cvt_pk_bf16(v[j].z, v[j].w) << 32); }
                float s[16]; dot16(v, wl, lane, s);
                float sv = s[0];
#pragma unroll
                for (int cc = 1; cc < 16; ++cc) sv = ((lane & 15) == cc) ? s[cc] : sv;
                if (lane < 16) lg[rloc * 33 + pass * 16 + lane] = sv;
            }
        }
        __syncthreads();
        int ek[4] = {0, 0, 0, 0}, rk[4] = {0, 0, 0, 0}; float gk[4] = {0.f, 0.f, 0.f, 0.f};
        if (tid < 64) {
            float v[32];
#pragma unroll
            for (int e = 0; e < 32; ++e) v[e] = lg[tid * 33 + e] + rb[e];
            float val[4];
#pragma unroll
            for (int k = 0; k < 4; ++k) { float best = -3.0e38f; int bi = 0;
#pragma unroll
                for (int e = 0; e < 32; ++e) { const bool gt = v[e] > best; best = gt ? v[e] : best; bi = gt ? e : bi; }
#pragma unroll
                for (int e = 0; e < 32; ++e) v[e] = (e == bi) ? -3.0e38f : v[e];
                ek[k] = bi; val[k] = best; }
            float den = 0.f;
#pragma unroll
            for (int k = 0; k < 4; ++k) { gk[k] = expf(val[k] - val[0]); den += gk[k]; }
#pragma unroll
            for (int k = 0; k < 4; ++k) { gk[k] = gk[k] / den; rk[k] = __hip_atomic_fetch_add(&misc[40 + ek[k]], 1, __ATOMIC_RELAXED, __HIP_MEMORY_SCOPE_WORKGROUP); }
        }
        __syncthreads();
        if (tid < 32) { const int cnt = misc[40 + tid]; misc[72 + tid] = cnt ? (int)atomicAdd(&ecnt[tid], (unsigned)cnt) : 0; }
        __syncthreads();
        if (tid < 64) { const int tok = blk * 64 + tid;
#pragma unroll
            for (int k = 0; k < 4; ++k) { const int pos = misc[72 + ek[k]] + rk[k]; LIST[(size_t)ek[k] * NREAL + pos] = tok; RE[tok * 4 + k] = ek[k]; RP[tok * 4 + k] = pos; RG[tok * 4 + k] = gk[k]; } }
    }
    __syncthreads();
}

__device__ __forceinline__ int moe_setup(const Args& a, LAS int* misc, int tid) {
    const unsigned* ecnt = (const unsigned*)(a.ws + WS_CTL) + CW_ECNT;
    __syncthreads();
    if (tid == 0) { int acc = 0;
        for (int e = 0; e < NEXP; ++e) { const int cnt = (int)__hip_atomic_load(ecnt + e, __ATOMIC_RELAXED, __HIP_MEMORY_SCOPE_AGENT); misc[104 + e] = cnt; misc[e] = acc; acc += (cnt + 255) >> 8; }
        misc[32] = acc; }
    __syncthreads();
    return misc[32];
}

__device__ __forceinline__ void p8_combine(const Args& a, const LAS int* misc, int gw, int NGW, int lane) {
    const int* RE = (const int*)(a.ws + WS_RE); const int* RP = (const int*)(a.ws + WS_RP); const float* RG = (const float*)(a.ws + WS_RG);
    const bf16_t* Y = (const bf16_t*)(a.ws + WS_Y); const float* bd = a.in[I_BD]; float* out = a.out;
    for (int row = gw; row < NREAL; row += NGW) {
        int e[4]; size_t slot[4]; float g[4];
#pragma unroll
        for (int k = 0; k < 4; ++k) { e[k] = RE[row * 4 + k]; slot[k] = (size_t)misc[e[k]] * 256 + RP[row * 4 + k]; g[k] = RG[row * 4 + k]; }
#pragma unroll
        for (int j = 0; j < 4; ++j) { const int col = 8 * lane + 512 * j;
            f32x4 a0 = *(const f32x4*)(out + (size_t)row * DM + col), a1 = *(const f32x4*)(out + (size_t)row * DM + col + 4);
#pragma unroll
            for (int k = 0; k < 4; ++k) { const u32x4 y = *(const u32x4*)(Y + slot[k] * DM + col);
                const f32x4 b0 = *(const f32x4*)(bd + (size_t)e[k] * DM + col), b1 = *(const f32x4*)(bd + (size_t)e[k] * DM + col + 4);
                a0.x += g[k] * (bf_lo(y.x) + b0.x); a0.y += g[k] * (bf_hi(y.x) + b0.y); a0.z += g[k] * (bf_lo(y.y) + b0.z); a0.w += g[k] * (bf_hi(y.y) + b0.w);
                a1.x += g[k] * (bf_lo(y.z) + b1.x); a1.y += g[k] * (bf_hi(y.z) + b1.y); a1.z += g[k] * (bf_lo(y.w) + b1.z); a1.w += g[k] * (bf_hi(y.w) + b1.w); }
            *(f32x4*)(out + (size_t)row * DM + col) = a0; *(f32x4*)(out + (size_t)row * DM + col + 4) = a1; }
    }
}

constexpr int NPH = 9;
__global__ void __launch_bounds__(NTHREADS, 2) hymba_fwd(Args args) {
    extern __shared__ __attribute__((aligned(16))) unsigned char lds_raw[];
    LAS unsigned char* lds = (LAS unsigned char*)lds_raw;
    LAS int* misc = (LAS int*)(lds + MISC_OFF);
    const int tid = threadIdx.x, lane = tid & 63, wave = __builtin_amdgcn_readfirstlane(tid >> 6);
    const int G = gridDim.x, bx = blockIdx.x;
    const int vcu = (G % 8 == 0) ? (bx % 8) * (G / 8) + bx / 8 : bx;
    const int gw = vcu * NWAVES + wave, NGW = G * NWAVES;
    unsigned* ctl = (unsigned*)(args.ws + WS_CTL);
    for (int u = tid; u < 256; u += NTHREADS) misc[u] = 0;
    __syncthreads();
    XcdBarrier bar; bar.bar = ctl + CW_BAR; bar.x = 0; bar.st = nullptr;
    const int lo = args.ph_lo, hi = args.ph_hi;
    if (hi - lo > 1) bar = xcd_barrier_post(ctl + CW_BAR, (volatile LAS unsigned*)(misc + 200));
#ifdef ONLY
#define IN(k) ((k) == ONLY && lo <= (k) && (k) < hi)
#else
#define IN(k) (lo <= (k) && (k) < hi)
#endif
#ifndef REP_COUNT
#define REP_COUNT 2
#endif
#define REPEAT(k) _Pragma("unroll") for (int _r = 0; _r < ((REP_PHASE == (k)) ? REP_COUNT : 1); ++_r)
#define SEAM(k) do { if (IN(k) && IN((k) + 1)) xcd_barrier(bar); if (PROBE_A >= 0 && tid == 0) tsl[(k) + 1] = __builtin_amdgcn_s_memrealtime(); } while (0)

    LAS unsigned long long* tsl = (LAS unsigned long long*)(lds + MISC_OFF + 896);
    if (PROBE_A >= 0 && tid == 0) tsl[0] = __builtin_amdgcn_s_memrealtime();
    if (IN(0)) REPEAT(0) { p0_rows(args, lds, gw, NGW, tid, lane); p0_weights(args, gw, NGW, lane); }
    SEAM(0);
    if (IN(1)) REPEAT(1) {
        pg8::PlainOrder S; S.init(MPAD, NPROJ, DM, args.ws + WS_WIN, G, bx);
        pg8::EpiBf16 E{(bf16_t*)(args.ws + (_r ? WS_ACT : WS_P)), NPROJ};
        pg8::gemm_phase<pg8::EpiBf16, pg8::PlainOrder, true, true>(lds, (const char*)(args.ws + WS_HN), DM, S, E);
    }
    SEAM(1);
    if (IN(2)) REPEAT(2) {
        p2_qknorm(args, gw, NGW, lane);
#if GDN_CHUNKED
        for (int it = bx; it < 32 * gdn::NCH; it += G) { __syncthreads(); gdn::precompute(args, lds, it, tid, lane, wave); }
#endif
    }
    SEAM(2);
    if (IN(3)) REPEAT(3) {
        const int NG = (G >= 64) ? 32 : 0;
#if GDN_CHUNKED
        if (bx < 32 || NG == 0) { for (int it = bx; it < 32; it += G) gdn::scan(args, lds, it, tid, lane, wave); }
#else
        if (bx < 32 || NG == 0) { for (int it = bx; it < 32; it += G) p3_gdn_naive(args, lds, it, tid, lane, wave); }
#endif
        if (bx >= NG) { for (int u = bx - NG; u < 512; u += G - NG) sba::unit(args, lds, (volatile LAS int*)(misc + 210), u >> 7, (u >> 4) & 7, u & 15, tid, lane, wave); }
    }
    SEAM(3);
    if (IN(4)) REPEAT(4) {
        pg8::PlainOrder S; S.init(NREAL, DM, DM, args.ws + WS_WOUT, G, bx);
        pg8::EpiResF32 E{args.in[I_X], _r ? (float*)(args.ws + WS_ACT) : args.out, DM};
        pg8::gemm_phase<pg8::EpiResF32, pg8::PlainOrder, true, true>(lds, (const char*)(args.ws + WS_MIX), DM, S, E);
    }
    SEAM(4);
    if (IN(5)) p5_router(args, lds, G, bx, tid, lane, wave);
    SEAM(5);
    if (IN(6)) REPEAT(6) {
        const int mt = moe_setup(args, misc, tid);
        pg8::MoeOrder<true> S; S.tpre = misc; S.tok = (const LAS int*)(lds + TOK_OFF); S.nN = 16; S.nwg = mt * 16; S.G = G; S.c = bx;
        S.Bt = (const char*)(args.ws + WS_WGU); S.estride = (size_t)2 * DE * DM * 2; S.K2 = DM * 2;
        const int* LIST = (const int*)(args.ws + WS_LIST);
        for (int ui = 0; ui < TOK_CAP; ++ui) { pg8::Unit u; if (!S.next(ui, u)) break;
            if (tid < 256) { const int idx = (u.pm - misc[u.e]) * 256 + tid; ((LAS int*)(lds + TOK_OFF))[ui * 256 + tid] = idx < misc[104 + u.e] ? LIST[(size_t)u.e * NREAL + idx] : 0; } }
        __syncthreads();
        pg8::EpiSwiGLU E{(bf16_t*)(args.ws + WS_ACT), args.in[I_BGU]};
        pg8::gemm_phase<pg8::EpiSwiGLU, pg8::MoeOrder<true>, true, true>(lds, (const char*)(args.ws + WS_HN), DM, S, E);
    }
    SEAM(6);
    if (IN(7)) REPEAT(7) {
        const int mt = moe_setup(args, misc, tid);
        pg8::MoeOrder<false> S; S.tpre = misc; S.tok = nullptr; S.nN = 8; S.nwg = mt * 8; S.G = G; S.c = bx;
        S.Bt = (const char*)(args.ws + WS_WD); S.estride = (size_t)DM * DE * 2; S.K2 = DE * 2;
        pg8::EpiBf16 E{(bf16_t*)(args.ws + (_r ? WS_WGU : WS_Y)), DM};
        pg8::gemm_phase<pg8::EpiBf16, pg8::MoeOrder<false>, true, true>(lds, (const char*)(args.ws + WS_ACT), DE, S, E);
    }
    SEAM(7);
    if (IN(8)) { (void)moe_setup(args, misc, tid); p8_combine(args, misc, gw, NGW, lane); }
#if PROBE_A >= 0
    __syncthreads();
    if (tid == 0) tsl[9] = __builtin_amdgcn_s_memrealtime();
    __syncthreads();
    {
        const int pa = PROBE_A, pb = PROBE_B;
        const float ka = (float)(pa == 9 ? (tsl[9] - tsl[0]) : (tsl[pa + 1] - tsl[pa])) * 1e-3f;
        const float kb = (float)(pb == 9 ? (tsl[9] - tsl[0]) : (tsl[pb + 1] - tsl[pb])) * 1e-3f;
        for (size_t i = (size_t)bx * NTHREADS + tid; i < (size_t)NREAL * DM; i += (size_t)G * NTHREADS) args.out[i] = ka;
        if (bx == 0) { __syncthreads(); if (tid == 0) args.out[0] = 64.0f * kb; }
    }
#endif
#undef IN
#undef SEAM
}

extern "C" void kernel_launch(void* const* d_in, const int* in_sizes, int n_in, void* d_out, int out_size, void* d_ws, size_t ws_size, hipStream_t stream) {
    static int grid = 0;
    if (grid == 0) {
        if (n_in != 19 || out_size != NREAL * DM || ws_size < WS_END) { fprintf(stderr, "kernel_launch: unexpected shapes (n_in %d out %d ws %zu need %zu)\n", n_in, out_size, ws_size, (size_t)WS_END); grid = -1; return; }
        int dev = 0, cus = 0, per_cu = 0;
        if (hipGetDevice(&dev) != hipSuccess || hipDeviceGetAttribute(&cus, hipDeviceAttributeMultiprocessorCount, dev) != hipSuccess) { grid = -1; return; }
        if (hipFuncSetAttribute((const void*)hymba_fwd, hipFuncAttributeMaxDynamicSharedMemorySize, LDS_BYTES) != hipSuccess) { fprintf(stderr, "kernel_launch: hipFuncSetAttribute failed\n"); grid = -1; return; }
        if (hipOccupancyMaxActiveBlocksPerMultiprocessor(&per_cu, (const void*)hymba_fwd, NTHREADS, LDS_BYTES) != hipSuccess || per_cu < 1) { fprintf(stderr, "kernel_launch: occupancy query says %d\n", per_cu); grid = -1; return; }
        (void)hipGetLastError();
        grid = cus;
    }
    if (grid < 0) return;
    (void)hipMemsetAsync((char*)d_ws + WS_CTL, 0, CTL_ZERO_BYTES, stream);
    Args a{};
    for (int i = 0; i < 19; ++i) a.in[i] = (const float*)d_in[i];
    a.out = (float*)d_out; a.ws = (unsigned char*)d_ws;
#if MK_N_LAUNCHES == 1
    a.ph_lo = 0; a.ph_hi = NPH;
    hipLaunchKernelGGL(hymba_fwd, dim3(grid), dim3(NTHREADS), LDS_BYTES, stream, a);
#else
    for (int p = 0; p < NPH; ++p) { a.ph_lo = p; a.ph_hi = p + 1; hipLaunchKernelGGL(hymba_fwd, dim3(grid), dim3(NTHREADS), LDS_BYTES, stream, a); }
#endif
    const hipError_t le = hipPeekAtLastError();
    if (le != hipSuccess) fprintf(stderr, "kernel_launch: launch failed: %s\n", hipGetErrorName(le));
}
```

```cpp
#include <hip/hip_runtime.h>
#include <cstdio>
#include <cstdint>

#ifndef GDN_CHUNKED
#define GDN_CHUNKED 1
#endif
#ifndef REP_PHASE
#define REP_PHASE -1
#endif
#ifndef PROBE_A
#define PROBE_A -1
#define PROBE_B -1
#endif
#ifndef MK_N_LAUNCHES
#define MK_N_LAUNCHES 1
#endif

constexpr int NB = 4, SEQ = 4096, NMETA = 16, LSEQ = SEQ + NMETA;
constexpr int DM = 2048, NTOK = NB * LSEQ  , MPAD = 16640  , NREAL = NB * SEQ  ;
constexpr int NPROJ_SRC = 7184, NPROJ = 7168;
constexpr int NHEAD = 8, HD = 128;
constexpr int PC_QKV = 0, PC_Z = 3072, PC_SBQ = 4096, PC_SBK = 5120, PC_SBV = 6144;
constexpr int NEXP = 32, TOPK = 4, DE = 2048;
constexpr int SLOT_ROWS = 73728;
constexpr int LROW = 4224;
constexpr float NORM_EPS = 1e-6f;

constexpr size_t MiB = 1u << 20;
constexpr size_t WS_CTL = 0, CTL_ZERO_BYTES = 1 * MiB;
constexpr size_t WS_WIN = 1 * MiB;
constexpr size_t WS_WOUT = WS_WIN + (size_t)NPROJ * DM * 2;
constexpr size_t WS_WGU = WS_WOUT + (size_t)DM * DM * 2;
constexpr size_t WS_WD = WS_WGU + (size_t)NEXP * 2 * DE * DM * 2;
constexpr size_t WS_HN = WS_WD + (size_t)NEXP * DM * DE * 2;
constexpr size_t WS_BETA = WS_HN + (size_t)MPAD * DM * 2;
constexpr size_t WS_G = WS_BETA + (size_t)NTOK * 8 * 4 + 256;
constexpr size_t WS_P = WS_G + (size_t)NTOK * 8 * 4 + 256;
constexpr size_t WS_QN = WS_P + (size_t)MPAD * NPROJ * 2;
constexpr size_t WS_KN = WS_QN + (size_t)NB * NHEAD * LROW * HD * 2;
constexpr size_t WS_ORAW = WS_KN + (size_t)NB * NHEAD * LROW * HD * 2;
constexpr size_t WS_MIX = WS_ORAW + (size_t)NREAL * 1024 * 4;
constexpr size_t WS_RE = WS_MIX + (size_t)NREAL * DM * 2;
constexpr size_t WS_RP = WS_RE + (size_t)NREAL * 4 * 4;
constexpr size_t WS_RG = WS_RP + (size_t)NREAL * 4 * 4;
constexpr size_t WS_LIST = WS_RG + (size_t)NREAL * 4 * 4;
constexpr size_t WS_ACT = WS_LIST + (size_t)NEXP * NREAL * 4;
constexpr size_t WS_Y = WS_ACT + (size_t)SLOT_ROWS * DE * 2;
constexpr size_t WS_GCH = WS_Y + (size_t)SLOT_ROWS * DM * 2;
constexpr size_t WS_GL = WS_GCH + (size_t)32 * 65 * 73728;
constexpr size_t WS_END = WS_GL + 32 * 65 * 4 + 256;
constexpr int CW_ECNT = 64;
constexpr int CW_BAR = 4096;

constexpr int LDS_STAGE = 131072;
constexpr int TOK_OFF = LDS_STAGE, TOK_CAP = 20;
constexpr int MISC_OFF = TOK_OFF + TOK_CAP * 256 * 4;
constexpr int LDS_BYTES = MISC_OFF + 1024;

#define GAS __attribute__((address_space(1)))
#define LAS __attribute__((address_space(3)))
typedef unsigned short bf16_t;
typedef short bf16x8 __attribute__((ext_vector_type(8)));
typedef short s16x4 __attribute__((ext_vector_type(4)));
typedef float f32x4 __attribute__((ext_vector_type(4)));
typedef float f32x2 __attribute__((ext_vector_type(2)));
typedef float f32x16 __attribute__((ext_vector_type(16)));
typedef unsigned u32x4 __attribute__((ext_vector_type(4)));
typedef unsigned u32x2 __attribute__((ext_vector_type(2)));

typedef __bf16 bf16x2_t __attribute__((ext_vector_type(2)));
__device__ __forceinline__ unsigned cvt_pk_bf16(float lo, float hi) { const f32x2 v = {lo, hi}; const bf16x2_t b = __builtin_convertvector(v, bf16x2_t); return __builtin_bit_cast(unsigned, b); }
__device__ __forceinline__ float bf_lo(unsigned w) { return __uint_as_float(w << 16); }
__device__ __forceinline__ float bf_hi(unsigned w) { return __uint_as_float(w & 0xffff0000u); }
__device__ __forceinline__ float bf2f(bf16_t b) { return __uint_as_float(((unsigned)b) << 16); }
__device__ __forceinline__ float wave_sum(float v) {
#pragma unroll
    for (int o = 1; o < 64; o <<= 1) v += __shfl_xor(v, o);
    return v;
}

namespace pg8 {
constexpr int BM = 256, BK = 64, HALF = 128, HTB = HALF * BK * 2, STAGE_BYTES = 8 * HTB, NXCD = 8, WGM = 8;
__host__ __device__ __forceinline__ int lds_byte(int r, int c) { const int st = (r >> 4) * 2 + (c >> 5), rr = r & 15, cc = c & 31, ob = rr * 64 + cc * 2; return st * 1024 + (ob ^ (((ob >> 9) & 1) << 5)); }
__host__ __device__ __forceinline__ void stage_rc(int b, int& R, int& C) { const int st = b / 1024, sb = b % 1024, swz = sb ^ (((sb >> 9) & 1) << 5); R = (st >> 1) * 16 + swz / 64; C = (st & 1) * 32 + (swz % 64) / 2; }
__host__ __device__ __forceinline__ int perm32(int rho) { const int n = rho >> 4, i = rho & 15; return 8 * (i >> 2) + 4 * n + (i & 3); }

struct Unit { int pm, pn, e, ui; };

__device__ __forceinline__ int xcd_remap(int L, int nwg) { const int q = nwg / NXCD, r = nwg % NXCD, xcd = L % NXCD, off = L / NXCD; return (xcd < r ? xcd * (q + 1) : r * (q + 1) + (xcd - r) * q) + off; }

struct PlainOrder {
    int nM, nN, nwg, G, c; const char* Bt; unsigned K2;
    __device__ void init(int M, int N, int K, const void* Bt_, int G_, int c_) { nM = M / BM; nN = N / BM; nwg = nM * nN; G = G_; c = c_; Bt = (const char*)Bt_; K2 = (unsigned)K * 2u; }
    __device__ __forceinline__ bool next(int i, Unit& u) const {
        const long L = (long)i * G + c; if (L >= nwg) return false;
        const int wgid = xcd_remap((int)L, nwg);
        const int nig = WGM * nN, gid = wgid / nig, fm = gid * WGM, gsz = (nM - fm) < WGM ? (nM - fm) : WGM;
        u.pm = fm + ((wgid % nig) % gsz); u.pn = (wgid % nig) / gsz; u.e = 0; u.ui = i; return true;
    }
    __device__ __forceinline__ const char* b_ptr(const Unit& u) const { return Bt + (size_t)u.pn * BM * K2; }
    __device__ __forceinline__ unsigned a_off(const Unit& u, int r) const { return (unsigned)(u.pm * BM + r + (meta ? NMETA * ((u.pm >> 4) + 1) : 0)) * K2; }
    int meta = 0;
};
template <bool GATHER> struct MoeOrder {
    const LAS int* tpre; const LAS int* tok; int nN, nwg, G, c; const char* Bt; size_t estride; unsigned K2;
    __device__ __forceinline__ bool next(int i, Unit& u) const {
        const long L = (long)i * G + c; if (L >= nwg) return false;
        const int wgid = xcd_remap((int)L, nwg);
        int e = 0;
#pragma unroll 1
        for (int j = 1; j < NEXP; ++j) e = (wgid >= tpre[j] * nN) ? j : e;
        const int t0 = tpre[e], nt = tpre[e + 1] - t0, loc = wgid - t0 * nN;
        u.e = e; u.pn = loc / nt; u.pm = t0 + loc % nt; u.ui = i; return true;
    }
    __device__ __forceinline__ const char* b_ptr(const Unit& u) const { return Bt + (size_t)u.e * estride + (size_t)u.pn * BM * K2; }
    __device__ __forceinline__ unsigned a_off(const Unit& u, int r) const {
        if (GATHER) return (unsigned)tok[u.ui * 256 + r] * K2;
        return (unsigned)(u.pm * BM + r) * K2;
    }
};

struct EpiBf16 {
    static constexpr bool PERM = true;
    bf16_t* O; int ldc; int meta;
    __device__ __forceinline__ void operator()(const f32x4 (&acc)[2][2][4][2], const Unit& u, int wr, int wc, int fr, int fq) const {
        const int row0 = u.pm * BM + wr * 64 + fr + (meta ? NMETA * ((u.pm >> 4) + 1) : 0), col0 = u.pn * BM + wc * 32 + 8 * fq;
#pragma unroll
        for (int ai = 0; ai < 2; ++ai)
#pragma unroll
            for (int m = 0; m < 4; ++m) { bf16_t* rowp = O + (size_t)(row0 + ai * HALF + m * 16) * ldc + col0;
#pragma unroll
                for (int bj = 0; bj < 2; ++bj) { const f32x4 v0 = acc[ai][bj][m][0], v1 = acc[ai][bj][m][1];
                    u32x4 w; w.x = cvt_pk_bf16(v0[0], v0[1]); w.y = cvt_pk_bf16(v0[2], v0[3]); w.z = cvt_pk_bf16(v1[0], v1[1]); w.w = cvt_pk_bf16(v1[2], v1[3]);
                    *(u32x4*)(rowp + bj * HALF) = w; } }
    }
};
struct EpiResF32 {
    static constexpr bool PERM = false;
    const float* X; float* out; int ldc;
    __device__ __forceinline__ void operator()(const f32x4 (&acc)[2][2][4][2], const Unit& u, int wr, int wc, int fr, int fq) const {
        const int row0 = u.pm * BM + wr * 64 + fr, col0 = u.pn * BM + wc * 32 + 4 * fq;
#pragma unroll
        for (int ai = 0; ai < 2; ++ai)
#pragma unroll
            for (int m = 0; m < 4; ++m) { const size_t off = (size_t)(row0 + ai * HALF + m * 16) * ldc + col0;
#pragma unroll
                for (int bj = 0; bj < 2; ++bj)
#pragma unroll
                    for (int n = 0; n < 2; ++n) { const f32x4 xv = *(const f32x4*)(X + off + bj * HALF + n * 16); *(f32x4*)(out + off + bj * HALF + n * 16) = xv + acc[ai][bj][m][n]; }
                asm volatile("" ::: "memory"); }
    }
};
__device__ __forceinline__ float swiglu1(float g, float uu) {
    g = fminf(g, 7.0f); uu = fminf(fmaxf(uu, -7.0f), 7.0f);
    const float sg = __builtin_amdgcn_rcpf(1.0f + __builtin_amdgcn_exp2f(-1.702f * 1.4426950408889634f * g));
    return (uu + 1.0f) * g * sg;
}
struct EpiSwiGLU {
    static constexpr bool PERM = true;
    bf16_t* act; const float* bgu;
    __device__ __forceinline__ void operator()(const f32x4 (&acc)[2][2][4][2], const Unit& u, int wr, int wc, int fr, int fq) const {
        const int row0 = u.pm * BM + wr * 64 + fr, col0 = u.pn * HALF + wc * 32 + 8 * fq;
        const float* bg = bgu + (size_t)u.e * 4096 + col0;
        const f32x4 bg0 = *(const f32x4*)(bg), bg1 = *(const f32x4*)(bg + 4), bu0 = *(const f32x4*)(bg + 2048), bu1 = *(const f32x4*)(bg + 2052);
#pragma unroll
        for (int ai = 0; ai < 2; ++ai)
#pragma unroll
            for (int m = 0; m < 4; ++m) { bf16_t* rowp = act + (size_t)(row0 + ai * HALF + m * 16) * DE + col0;
                const f32x4 g0 = acc[ai][0][m][0] + bg0, g1 = acc[ai][0][m][1] + bg1, u0 = acc[ai][1][m][0] + bu0, u1 = acc[ai][1][m][1] + bu1;
                u32x4 w; w.x = cvt_pk_bf16(swiglu1(g0[0], u0[0]), swiglu1(g0[1], u0[1])); w.y = cvt_pk_bf16(swiglu1(g0[2], u0[2]), swiglu1(g0[3], u0[3]));
                w.z = cvt_pk_bf16(swiglu1(g1[0], u1[0]), swiglu1(g1[1], u1[1])); w.w = cvt_pk_bf16(swiglu1(g1[2], u1[2]), swiglu1(g1[3], u1[3]));
                *(u32x4*)rowp = w; }
    }
};

template <class Epi, class Sched, bool ALIGN_EPI, bool SP2>
__device__ __forceinline__ void gemm_phase(LAS unsigned char* lds, const char* A0, int K, const Sched& S, const Epi& E) {
    const int tid = threadIdx.x, wid = __builtin_amdgcn_readfirstlane(tid >> 6), lane = tid & 63, wr = wid >> 2, wc = wid & 3, fr = lane & 15, fq = lane >> 4;
    const int nt = K / BK;
    int Rr[2], Cc[2]; unsigned voffB[2];
#pragma unroll
    for (int i = 0; i < 2; ++i) { int R, C; stage_rc(tid * 16 + i * 8192, R, C); const int Rb = Epi::PERM ? ((R & ~31) + perm32(R & 31)) : R;
        Rr[i] = R; Cc[i] = C * 2; voffB[i] = (unsigned)(Rb * K + C) * 2u; }
    const size_t kstep = (size_t)(BK * 2);
    const size_t hstep = (size_t)HALF * K * 2;
    const unsigned ldsw = (unsigned)wid * 1024u;
    const int aoff = lds_byte(wr * 64 + fr, fq * 8), boff = lds_byte(wc * 32 + fr, fq * 8);
#define PG8_SA(b, h) (((b) * 2 + (h)) * HTB)
#define PG8_SB(b, h) ((4 + (b) * 2 + (h)) * HTB)
#define PG8_STAGE(bufoff, gbase, voff) do { _Pragma("unroll") for (int _i = 0; _i < 2; ++_i) \
        __builtin_amdgcn_global_load_lds((const unsigned*)((const char*)(gbase) + (voff)[_i]), (LAS unsigned*)(lds + (bufoff) + ldsw + _i * 8192), 16, 0, 0); } while (0)
#define PG8_LDA(dst, b, h) do { _Pragma("unroll") for (int m = 0; m < 4; ++m) _Pragma("unroll") for (int k = 0; k < 2; ++k) dst[m][k] = *(const LAS bf16x8*)(lds + PG8_SA(b, h) + aoff + m * 2048 + k * 1024); } while (0)
#define PG8_LDB(dst, b, h) do { _Pragma("unroll") for (int n = 0; n < 2; ++n) _Pragma("unroll") for (int k = 0; k < 2; ++k) dst[n][k] = *(const LAS bf16x8*)(lds + PG8_SB(b, h) + boff + n * 2048 + k * 1024); } while (0)
#define PG8_MMA(ai, bj, At, Bt) do { __builtin_amdgcn_s_setprio(1); _Pragma("unroll") for (int m = 0; m < 4; ++m) _Pragma("unroll") for (int n = 0; n < 2; ++n) _Pragma("unroll") for (int k = 0; k < 2; ++k) \
        acc[ai][bj][m][n] = __builtin_amdgcn_mfma_f32_16x16x32_bf16(Bt[n][k], At[m][k], acc[ai][bj][m][n], 0, 0, 0); __builtin_amdgcn_s_setprio(0); } while (0)
#define PG8_WAIT_V(n) asm volatile("s_waitcnt vmcnt(" #n ")" ::: "memory")
#define PG8_WAIT_L(n) asm volatile("s_waitcnt lgkmcnt(" #n ")" ::: "memory")
#define PG8_BAR __builtin_amdgcn_s_barrier()
#define PG8_SCHED __builtin_amdgcn_sched_barrier(0)
#define PG8_VOFF(dst, u) do { _Pragma("unroll") for (int _h = 0; _h < 2; ++_h) _Pragma("unroll") for (int _i = 0; _i < 2; ++_i) dst[_h][_i] = S.a_off(u, _h * HALF + Rr[_i]) + (unsigned)Cc[_i]; } while (0)
    Unit cur, nxt; int ui = 0;
    if (!S.next(0, cur)) return;
    f32x4 acc[2][2][4][2];
#pragma unroll
    for (int a = 0; a < 2; ++a)
#pragma unroll
        for (int b = 0; b < 2; ++b)
#pragma unroll
            for (int m = 0; m < 4; ++m)
#pragma unroll
                for (int n = 0; n < 2; ++n) acc[a][b][m][n] = (f32x4){0.f, 0.f, 0.f, 0.f};
    bf16x8 At[4][2], B0[2][2], B1[2][2];
    unsigned va[2][2], vn[2][2];
    PG8_VOFF(va, cur);
    const char* cB = S.b_ptr(cur);
    if constexpr (SP2) {
        PG8_STAGE(PG8_SB(0, 0), cB, voffB); PG8_STAGE(PG8_SB(0, 1), cB + hstep, voffB); PG8_STAGE(PG8_SA(0, 0), A0, va[0]); PG8_STAGE(PG8_SA(0, 1), A0, va[1]);
        if (wr == 1) PG8_BAR;
        PG8_WAIT_V(2); PG8_BAR;
        PG8_STAGE(PG8_SB(1, 0), cB + kstep, voffB); PG8_STAGE(PG8_SA(1, 0), A0 + kstep, va[0]); PG8_STAGE(PG8_SB(1, 1), cB + hstep + kstep, voffB);
        PG8_WAIT_V(6); PG8_BAR;
    } else {
        PG8_STAGE(PG8_SB(0, 0), cB, voffB); PG8_STAGE(PG8_SA(0, 0), A0, va[0]); PG8_STAGE(PG8_SB(0, 1), cB + hstep, voffB); PG8_STAGE(PG8_SA(0, 1), A0, va[1]);
        if (wr == 1) PG8_BAR;
        PG8_WAIT_V(4); PG8_BAR;
        PG8_STAGE(PG8_SB(1, 0), cB + kstep, voffB); PG8_STAGE(PG8_SA(1, 0), A0 + kstep, va[0]); PG8_STAGE(PG8_SB(1, 1), cB + hstep + kstep, voffB);
        PG8_WAIT_V(6); PG8_BAR;
    }
    for (;;) {
        const bool has_next = S.next(ui + 1, nxt);
        const char* nB = has_next ? S.b_ptr(nxt) : cB;
        for (int t = 0; t < nt; t += 2) {
            const bool last = (t == nt - 2);
            const char* a1 = A0 + (size_t)(t + 1) * kstep;
            const char* a2 = last ? A0 : A0 + (size_t)(t + 2) * kstep; const char* b2 = last ? nB : cB + (size_t)(t + 2) * kstep;
            const char* a3 = a2 + kstep; const char* b3 = b2 + kstep;
            if (last) { if (has_next) { PG8_VOFF(vn, nxt); } else {
#pragma unroll
                    for (int _h = 0; _h < 2; ++_h)
#pragma unroll
                        for (int _i = 0; _i < 2; ++_i) vn[_h][_i] = va[_h][_i]; } }
            if constexpr (SP2) {
            PG8_LDB(B0, 0, 0); PG8_LDB(B1, 0, 1); PG8_SCHED; PG8_LDA(At, 0, 0); PG8_STAGE(PG8_SA(1, 1), a1, va[1]);
            if (last) {
#pragma unroll
                for (int _h = 0; _h < 2; ++_h)
#pragma unroll
                    for (int _i = 0; _i < 2; ++_i) va[_h][_i] = vn[_h][_i]; }
            PG8_WAIT_V(8); PG8_WAIT_L(0); PG8_BAR; PG8_MMA(0, 0, At, B0); PG8_MMA(0, 1, At, B1); PG8_BAR; PG8_SCHED;
            PG8_LDA(At, 0, 1); PG8_STAGE(PG8_SB(0, 0), b2, voffB); PG8_STAGE(PG8_SB(0, 1), b2 + hstep, voffB); PG8_STAGE(PG8_SA(0, 0), a2, va[0]);
            PG8_WAIT_V(8); PG8_WAIT_L(0); PG8_BAR; PG8_MMA(1, 0, At, B0); PG8_MMA(1, 1, At, B1); PG8_BAR; PG8_SCHED;
            PG8_LDB(B0, 1, 0); PG8_LDB(B1, 1, 1); PG8_SCHED; PG8_LDA(At, 1, 0); PG8_STAGE(PG8_SA(0, 1), a2, va[1]);
            PG8_WAIT_V(8); PG8_WAIT_L(0); PG8_BAR; PG8_MMA(0, 0, At, B0); PG8_MMA(0, 1, At, B1); PG8_BAR; PG8_SCHED;
            PG8_LDA(At, 1, 1); PG8_STAGE(PG8_SB(1, 0), b3, voffB); PG8_STAGE(PG8_SB(1, 1), b3 + hstep, voffB); PG8_STAGE(PG8_SA(1, 0), a3, va[0]);
            PG8_WAIT_V(8); PG8_WAIT_L(0); PG8_BAR; PG8_MMA(1, 0, At, B0); PG8_MMA(1, 1, At, B1); PG8_BAR; PG8_SCHED;
            } else {
            PG8_LDB(B0, 0, 0); PG8_SCHED; PG8_LDA(At, 0, 0); PG8_STAGE(PG8_SA(1, 1), a1, va[1]);
            if (last) {
#pragma unroll
                for (int _h = 0; _h < 2; ++_h)
#pragma unroll
                    for (int _i = 0; _i < 2; ++_i) va[_h][_i] = vn[_h][_i]; }
            PG8_WAIT_L(8); PG8_BAR; PG8_WAIT_L(0); PG8_MMA(0, 0, At, B0); PG8_BAR; PG8_SCHED;
            PG8_LDB(B1, 0, 1); PG8_STAGE(PG8_SB(0, 0), b2, voffB);
            PG8_BAR; PG8_WAIT_L(0); PG8_MMA(0, 1, At, B1); PG8_BAR;
            PG8_LDA(At, 0, 1); PG8_STAGE(PG8_SA(0, 0), a2, va[0]);
            PG8_BAR; PG8_WAIT_L(0); PG8_MMA(1, 0, At, B0); PG8_BAR; PG8_SCHED;
            PG8_STAGE(PG8_SB(0, 1), b2 + hstep, voffB);
            PG8_WAIT_V(6); PG8_BAR; PG8_MMA(1, 1, At, B1); PG8_BAR;
            PG8_LDB(B0, 1, 0); PG8_SCHED; PG8_LDA(At, 1, 0); PG8_STAGE(PG8_SA(0, 1), a2, va[1]);
            PG8_WAIT_L(8); PG8_BAR; PG8_WAIT_L(0); PG8_MMA(0, 0, At, B0); PG8_BAR; PG8_SCHED;
            PG8_LDB(B1, 1, 1); PG8_STAGE(PG8_SB(1, 0), b3, voffB);
            PG8_BAR; PG8_WAIT_L(0); PG8_MMA(0, 1, At, B1); PG8_BAR;
            PG8_LDA(At, 1, 1); PG8_STAGE(PG8_SA(1, 0), a3, va[0]);
            PG8_BAR; PG8_WAIT_L(0); PG8_MMA(1, 0, At, B0); PG8_BAR; PG8_SCHED;
            PG8_STAGE(PG8_SB(1, 1), b3 + hstep, voffB);
            PG8_WAIT_V(6); PG8_BAR; PG8_MMA(1, 1, At, B1); PG8_BAR;
            }
        }
        if constexpr (ALIGN_EPI) { if (wr == 0) PG8_BAR; }
        E(acc, cur, wr, wc, fr, fq);
        if (!has_next) break;
#pragma unroll
        for (int a = 0; a < 2; ++a)
#pragma unroll
            for (int b = 0; b < 2; ++b)
#pragma unroll
                for (int m = 0; m < 4; ++m)
#pragma unroll
                    for (int n = 0; n < 2; ++n) acc[a][b][m][n] = (f32x4){0.f, 0.f, 0.f, 0.f};
        cur = nxt; cB = nB; ++ui;
        if constexpr (ALIGN_EPI) { if (wr == 1) PG8_BAR; }
    }
    PG8_WAIT_V(0);
    if constexpr (!ALIGN_EPI) { if (wr == 0) PG8_BAR; }
    PG8_BAR;
#undef PG8_SA
#undef PG8_SB
#undef PG8_STAGE
#undef PG8_LDA
#undef PG8_LDB
#undef PG8_MMA
#undef PG8_WAIT_V
#undef PG8_WAIT_L
#undef PG8_BAR
#undef PG8_SCHED
#undef PG8_VOFF
}
}

#define XB_TMO      128
#define XB_XCNT(j)  (256  + 64 * (j))
#define XB_XSUB(j)  (1280 + 64 * (j))
#define XB_XGEN(j)  (2304 + 64 * (j))
#define XB_TOP      3328
#define XB_TOPGEN   3392
#define XCD_BAR_WORDS 3456
#define XB_SPIN_CAP (1u << 18)

__device__ __forceinline__ unsigned xb_ld(unsigned* p)              { return __hip_atomic_load(p, __ATOMIC_RELAXED, __HIP_MEMORY_SCOPE_AGENT); }
__device__ __forceinline__ unsigned xb_add(unsigned* p, unsigned v) { return __hip_atomic_fetch_add(p, v, __ATOMIC_RELAXED, __HIP_MEMORY_SCOPE_AGENT); }
__device__ __forceinline__ unsigned xb_xcc_id() { return (unsigned)__builtin_amdgcn_s_getreg((3 << 11) | 20) & 0xFu; }
#define XB_SPIN(cond, bar) do { unsigned _sp = 0; while (cond) { __builtin_amdgcn_s_sleep(1); \
    if ((++_sp & 255u) == 0u) { if (xb_ld(&(bar)[XB_TMO])) break; if (_sp > XB_SPIN_CAP) { atomicAdd(&(bar)[XB_TMO], 1u); break; } } } } while (0)

struct XcdBarrier {
    unsigned* bar; unsigned x;
    volatile LAS unsigned* st;
};
__device__ __forceinline__ XcdBarrier xcd_barrier_post(unsigned* bar, volatile LAS unsigned* st) {
    XcdBarrier b; b.bar = bar; b.x = xb_xcc_id(); b.st = st;
    if (threadIdx.x == 0) (void)xb_add(&bar[XB_XCNT(b.x)], 1u);
    return b;
}
__device__ __forceinline__ void xcd_barrier_complete(unsigned* bar, unsigned x, unsigned& nloc, unsigned& nx) {
    const unsigned G = gridDim.x * gridDim.y * gridDim.z;
    unsigned sum, cnt, mine, sp = 0u;
    for (;;) {
        sum = 0u; cnt = 0u; mine = 0u;
#pragma unroll
        for (unsigned j = 0; j < 16; ++j) { const unsigned c = xb_ld(&bar[XB_XCNT(j)]); sum += c; cnt += (c > 0u) ? 1u : 0u; mine = (j == x) ? c : mine; }
        if (sum == G) break;
        __builtin_amdgcn_s_sleep(1);
        if ((++sp & 255u) == 0u) { if (xb_ld(&bar[XB_TMO])) break; if (sp > XB_SPIN_CAP) { atomicAdd(&bar[XB_TMO], 1u); break; } }
    }
    nloc = mine > 0u ? mine : 1u; nx = cnt > 0u ? cnt : 1u;
}
__device__ __forceinline__ void xcd_barrier(const XcdBarrier& b) {
    asm volatile("s_waitcnt vmcnt(0)" ::: "memory");
    __syncthreads();
    if (threadIdx.x == 0) {
        unsigned* bar = b.bar;
        __builtin_amdgcn_s_waitcnt(0);
        unsigned nloc = b.st[0], nx = b.st[1];
        if (nloc == 0u) { xcd_barrier_complete(bar, b.x, nloc, nx); b.st[0] = nloc; b.st[1] = nx; }
        const unsigned old = xb_add(&bar[XB_XSUB(b.x)], 1u);
        const unsigned gen = old / nloc;
        if (old + 1u == (gen + 1u) * nloc) {
            __builtin_amdgcn_fence(__ATOMIC_RELEASE, "agent");
            asm volatile("s_waitcnt vmcnt(0)" ::: "memory");
            const unsigned og = xb_add(&bar[XB_TOP], 1u);
            const unsigned tg = og / nx;
            if (og + 1u == (tg + 1u) * nx) xb_add(&bar[XB_TOPGEN], 1u);
            else XB_SPIN(xb_ld(&bar[XB_TOPGEN]) == tg, bar);
            __builtin_amdgcn_fence(__ATOMIC_ACQUIRE, "agent");
            xb_add(&bar[XB_XGEN(b.x)], 1u);
            asm volatile("s_waitcnt vmcnt(0)" ::: "memory");
        } else {
            XB_SPIN(xb_ld(&bar[XB_XGEN(b.x)]) == gen, bar);
            __builtin_amdgcn_fence(__ATOMIC_ACQUIRE, "agent");
            asm volatile("s_waitcnt vmcnt(0)" ::: "memory");
        }
    }
    __syncthreads();
}

constexpr int NWAVES = 8, NTHREADS = 512;
struct Args { const float* in[19]; float* out; unsigned char* ws; int ph_lo, ph_hi; };
enum { I_X = 0, I_META, I_MIXNW, I_WIN, I_CONVW, I_ALOG, I_DTB, I_GDNNW, I_SBQNW, I_SBKNW, I_SBONW, I_WOUT, I_FFNNW, I_RW, I_RB, I_WGU, I_BGU, I_WD, I_BD };

#define LDS_WAIT() asm volatile("s_waitcnt lgkmcnt(0)" ::: "memory")
#define VM_WAIT() asm volatile("s_waitcnt vmcnt(0)" ::: "memory")
constexpr int WLS = 2052;

__device__ __forceinline__ void dot16(const f32x4 (&v)[8], const LAS float* wl, int lane, float (&s)[16]) {
#pragma unroll
    for (int c = 0; c < 16; ++c) { float a = 0.f;
#pragma unroll
        for (int j = 0; j < 8; ++j) { const f32x4 w = *(const LAS f32x4*)(wl + c * WLS + 4 * lane + 256 * j); a += (v[j].x * w.x + v[j].y * w.y) + (v[j].z * w.z + v[j].w * w.w); }
        s[c] = wave_sum(a); }
}

__device__ __forceinline__ void stage_w16(LAS float* wl, const float* base, int ld, int coloff, int tid) {
#pragma unroll 4
    for (int idx = tid; idx < 2048 * 4; idx += NTHREADS) { const int k = idx >> 2, q = idx & 3; const f32x4 v = *(const f32x4*)(base + (size_t)k * ld + coloff + 4 * q);
        wl[(4 * q + 0) * WLS + k] = v.x; wl[(4 * q + 1) * WLS + k] = v.y; wl[(4 * q + 2) * WLS + k] = v.z; wl[(4 * q + 3) * WLS + k] = v.w; }
}

__device__ __forceinline__ void p0_rows(const Args& a, LAS unsigned char* lds, int gw, int NGW, int tid, int lane) {
    const float* x = a.in[I_X]; const float* meta = a.in[I_META]; const float* nw = a.in[I_MIXNW]; const float* win = a.in[I_WIN];
    LAS float* wl = (LAS float*)lds;
    stage_w16(wl, win, NPROJ_SRC, 4096, tid);
    __syncthreads();
    bf16_t* HN = (bf16_t*)(a.ws + WS_HN); float* BETA = (float*)(a.ws + WS_BETA); float* GG = (float*)(a.ws + WS_G);
    f32x4 wn[8];
#pragma unroll
    for (int j = 0; j < 8; ++j) wn[j] = *((const f32x4*)nw + lane + 64 * j);
    const int hh = lane & 7;
    const float alog = a.in[I_ALOG][hh], dtb = a.in[I_DTB][hh];
    for (int row = gw; row < MPAD; row += NGW) {
        GAS unsigned long long* o8 = (GAS unsigned long long*)(HN + (size_t)row * DM) + lane;
        if (row >= NTOK) {
#pragma unroll
            for (int j = 0; j < 8; ++j) o8[64 * j] = 0ull;
            continue; }
        const int b = row / LSEQ, t = row - b * LSEQ;
        const float* src = (t < NMETA) ? meta + (size_t)t * DM : x + ((size_t)b * SEQ + (t - NMETA)) * DM;
        f32x4 v[8]; float ss = 0.f;
#pragma unroll
        for (int j = 0; j < 8; ++j) { v[j] = *((const f32x4*)src + lane + 64 * j); ss += (v[j].x * v[j].x + v[j].y * v[j].y) + (v[j].z * v[j].z + v[j].w * v[j].w); }
        const float rstd = 1.0f / sqrtf(wave_sum(ss) * (1.0f / DM) + NORM_EPS);
#pragma unroll
        for (int j = 0; j < 8; ++j) { v[j] = v[j] * rstd * wn[j];
            o8[64 * j] = (unsigned long long)cvt_pk_bf16(v[j].x, v[j].y) | ((unsigned long long)cvt_pk_bf16(v[j].z, v[j].w) << 32); }
        float s[16]; dot16(v, wl, lane, s);
        float bv = s[0], av = s[8];
#pragma unroll
        for (int c = 1; c < 8; ++c) { bv = (hh == c) ? s[c] : bv; av = (hh == c) ? s[8 + c] : av; }
        if (lane < 8) {
            const float beta = 1.0f / (1.0f + expf(-bv));
            const float xa = av + dtb; const float sp = fmaxf(xa, 0.f) + log1pf(expf(-fabsf(xa)));
            BETA[(size_t)row * 8 + hh] = beta; GG[(size_t)row * 8 + hh] = -expf(alog) * sp; }
    }
    __syncthreads();
}

constexpr int CVT_STR = 132;
template <int MODE  >
__device__ __forceinline__ void cvt_tile(const float* W, int ldw, int K, bf16_t* out, int kb, int nt, LAS unsigned char* T, int lane) {
    const int r0 = nt * 64;
    int c0;
    if (MODE == 0) c0 = r0;
    else if (MODE == 1) c0 = r0 < 4096 ? r0 : r0 + 16;
    else { const int pn = r0 >> 8, rr = r0 & 255; c0 = rr < 128 ? 128 * pn + rr : 2048 + 128 * pn + (rr - 128); }
    const int kq = lane >> 4, nl = lane & 15;
    const float* src = W + (size_t)(kb * 64 + 2 * kq) * ldw + c0 + 4 * nl;
    f32x4 v[8][2];
#pragma unroll
    for (int i = 0; i < 8; ++i)
#pragma unroll
        for (int j = 0; j < 2; ++j) v[i][j] = *(const f32x4*)(src + (size_t)(8 * i + j) * ldw);
    LAS unsigned char* tw = T + (4 * nl) * CVT_STR + 4 * kq;
#pragma unroll
    for (int i = 0; i < 8; ++i)
#pragma unroll
        for (int q = 0; q < 4; ++q) *(LAS unsigned*)(tw + q * CVT_STR + 16 * i) = cvt_pk_bf16(v[i][0][q], v[i][1][q]);
    LDS_WAIT();
    const int rn = lane >> 3, cc = lane & 7;
    const LAS unsigned char* tr = T + rn * CVT_STR + 16 * cc;
    bf16_t* dst = out + (size_t)(r0 + rn) * K + kb * 64 + 8 * cc;
#pragma unroll
    for (int j = 0; j < 8; ++j) { u32x4 w; const LAS unsigned* p = (const LAS unsigned*)(tr + 8 * j * CVT_STR); w.x = p[0]; w.y = p[1]; w.z = p[2]; w.w = p[3];
        *(u32x4*)(dst + (size_t)(8 * j) * K) = w; }
    LDS_WAIT();
}
__device__ __forceinline__ void p0_weights(const Args& a, LAS unsigned char* lds, int vcu, int G, int wave, int lane) {
    constexpr int I_IN = 32 * 14, I_OUT = 32 * 4, I_GU = 32 * 8, I_D = 32 * 4;
    constexpr int NITEMS = I_IN + I_OUT + NEXP * (I_GU + I_D);
    LAS unsigned char* T = lds + wave * (64 * CVT_STR);
    for (int it = vcu; it < NITEMS; it += G) {
        int r = it;
        if (r < I_IN) { cvt_tile<1>(a.in[I_WIN], NPROJ_SRC, DM, (bf16_t*)(a.ws + WS_WIN), r / 14, (r % 14) * 8 + wave, T, lane); continue; } r -= I_IN;
        if (r < I_OUT) { cvt_tile<0>(a.in[I_WOUT], DM, DM, (bf16_t*)(a.ws + WS_WOUT), r / 4, (r % 4) * 8 + wave, T, lane); continue; } r -= I_OUT;
        if (r < NEXP * I_GU) { const int e = r / I_GU, q = r % I_GU;
            cvt_tile<2>(a.in[I_WGU] + (size_t)e * DM * 2 * DE, 2 * DE, DM, (bf16_t*)(a.ws + WS_WGU) + (size_t)e * 2 * DE * DM, q / 8, (q % 8) * 8 + wave, T, lane); continue; } r -= NEXP * I_GU;
        { const int e = r / I_D, q = r % I_D;
            cvt_tile<0>(a.in[I_WD] + (size_t)e * DE * DM, DM, DE, (bf16_t*)(a.ws + WS_WD) + (size_t)e * DM * DE, q / 4, (q % 4) * 8 + wave, T, lane); }
    }
}

__device__ __forceinline__ void p2_qknorm(const Args& a, int gw, int NGW, int lane) {
    const bf16_t* P = (const bf16_t*)(a.ws + WS_P); bf16_t* QN = (bf16_t*)(a.ws + WS_QN); bf16_t* KN = (bf16_t*)(a.ws + WS_KN);
    const float qw0 = a.in[I_SBQNW][2 * lane], qw1 = a.in[I_SBQNW][2 * lane + 1], kw0 = a.in[I_SBKNW][2 * lane], kw1 = a.in[I_SBKNW][2 * lane + 1];
    const float QS = 0.08838834764831845f * 1.4426950408889634f;
    for (int it = gw; it < NTOK * NHEAD * 2; it += NGW) {
        const int which = it & 1, h = (it >> 1) & 7, row = it >> 4;
        const int b = row / LSEQ, t = row - b * LSEQ;
        const unsigned w = *(const unsigned*)(P + (size_t)row * NPROJ + (which ? PC_SBK : PC_SBQ) + h * HD + 2 * lane);
        const float v0 = bf_lo(w), v1 = bf_hi(w);
        const float rstd = 1.0f / sqrtf(wave_sum(v0 * v0 + v1 * v1) * (1.0f / HD) + NORM_EPS);
        const float o0 = which ? v0 * rstd * kw0 : v0 * rstd * qw0 * QS, o1 = which ? v1 * rstd * kw1 : v1 * rstd * qw1 * QS;
        *(unsigned*)((which ? KN : QN) + ((size_t)(b * NHEAD + h) * LROW + t) * HD + 2 * lane) = cvt_pk_bf16(o0, o1);
    }
}

__device__ __forceinline__ void p3_gdn_naive(const Args& a, LAS unsigned char* lds, int item, int tid, int lane, int wave) {
    const int b = item >> 3, h = item & 7;
    const bf16_t* P = (const bf16_t*)(a.ws + WS_P); const float* BETA = (const float*)(a.ws + WS_BETA); const float* GG = (const float*)(a.ws + WS_G);
    float* ORAW = (float*)(a.ws + WS_ORAW); bf16_t* MIX = (bf16_t*)(a.ws + WS_MIX);
    LAS float* buf = (LAS float*)lds;
    const int j = tid >> 2, part = tid & 3;
    const int which = tid >> 7, d = tid & 127; const bool conv = tid < 384;
    const int pcol = which * 1024 + h * HD + d;
    float cw0 = 0, cw1 = 0, cw2 = 0, cw3 = 0;
    if (conv) { const float* cwp = a.in[I_CONVW] + pcol; cw0 = cwp[0]; cw1 = cwp[3072]; cw2 = cwp[2 * 3072]; cw3 = cwp[3 * 3072]; }
    float xm1 = 0.f, xm2 = 0.f, xm3 = 0.f;
    float S[32];
#pragma unroll
    for (int i = 0; i < 32; ++i) S[i] = 0.f;
    const size_t row0 = (size_t)b * LSEQ;
    float xnext = conv ? bf2f(P[row0 * NPROJ + pcol]) : 0.f;
    float bnext = BETA[row0 * 8 + h], gnext = GG[row0 * 8 + h];
    for (int t = 0; t < LSEQ; ++t) {
        const float xt = xnext, beta = bnext, gam = expf(gnext);
        if (t + 1 < LSEQ) { if (conv) xnext = bf2f(P[(row0 + t + 1) * NPROJ + pcol]); bnext = BETA[(row0 + t + 1) * 8 + h]; gnext = GG[(row0 + t + 1) * 8 + h]; }
        LAS float* cb = buf + (t & 1) * 384;
        if (conv) { const float y = cw3 * xt + cw2 * xm1 + cw1 * xm2 + cw0 * xm3; xm3 = xm2; xm2 = xm1; xm1 = xt; cb[tid] = y / (1.0f + expf(-y)); }
        __syncthreads();
        float kk = 0.f, qq = 0.f, dk = 0.f; f32x4 kv[8], qv[8];
#pragma unroll
        for (int i = 0; i < 8; ++i) { kv[i] = *(const LAS f32x4*)(cb + 128 + 32 * part + 4 * i); qv[i] = *(const LAS f32x4*)(cb + 32 * part + 4 * i); }
#pragma unroll
        for (int i = 0; i < 8; ++i)
#pragma unroll
            for (int c = 0; c < 4; ++c) { kk += kv[i][c] * kv[i][c]; qq += qv[i][c] * qv[i][c]; dk += S[4 * i + c] * kv[i][c]; }
        kk += __shfl_xor(kk, 1); kk += __shfl_xor(kk, 2); qq += __shfl_xor(qq, 1); qq += __shfl_xor(qq, 2); dk += __shfl_xor(dk, 1); dk += __shfl_xor(dk, 2);
        const float rk = 1.0f / sqrtf(kk + NORM_EPS), rq = 0.08838834764831845f / sqrtf(qq + NORM_EPS);
        const float vj = cb[256 + j];
        const float vnew = beta * (vj - gam * rk * dk);
        const float kvn = rk * vnew; float oq = 0.f;
#pragma unroll
        for (int i = 0; i < 8; ++i)
#pragma unroll
            for (int c = 0; c < 4; ++c) { S[4 * i + c] = gam * S[4 * i + c] + kv[i][c] * kvn; oq += S[4 * i + c] * qv[i][c]; }
        oq += __shfl_xor(oq, 1); oq += __shfl_xor(oq, 2);
        if (t >= NMETA && part == 0) ORAW[((size_t)b * SEQ + (t - NMETA)) * 1024 + h * HD + j] = rq * oq;
    }
    __threadfence(); __syncthreads();
    const float nw0 = a.in[I_GDNNW][2 * lane], nw1 = a.in[I_GDNNW][2 * lane + 1];
    for (int s = wave; s < SEQ; s += NWAVES) {
        const size_t tok = (size_t)b * SEQ + s;
        const f32x2 o = *(const f32x2*)(ORAW + tok * 1024 + h * HD + 2 * lane);
        const float rstd = 1.0f / sqrtf(wave_sum(o.x * o.x + o.y * o.y) * (1.0f / HD) + NORM_EPS);
        const unsigned zw = *(const unsigned*)(P + (row0 + NMETA + s) * NPROJ + PC_Z + h * HD + 2 * lane);
        const float z0 = bf_lo(zw), z1 = bf_hi(zw);
        const float r0 = o.x * rstd * nw0 * (z0 / (1.0f + expf(-z0))), r1 = o.y * rstd * nw1 * (z1 / (1.0f + expf(-z1)));
        *(unsigned*)(MIX + tok * DM + h * HD + 2 * lane) = cvt_pk_bf16(r0, r1);
    }
}

__device__ __forceinline__ bf16x8 sba_pack8(const f32x16& p, int base) {
    u32x4 w; w.x = cvt_pk_bf16(p[base + 0], p[base + 1]); w.y = cvt_pk_bf16(p[base + 2], p[base + 3]); w.z = cvt_pk_bf16(p[base + 4], p[base + 5]); w.w = cvt_pk_bf16(p[base + 6], p[base + 7]);
    return __builtin_bit_cast(bf16x8, w);
}

namespace gdn {
constexpr int NCH = 65;
constexpr int IMG_W = 0, IMG_QG = 16384, IMG_KDT = 32768, IMG_AT = 49152, IMG_BYTES = 57344, IMG_U = 57344, CH_BYTES = 73728;
constexpr int L_QB = 0, L_KB = 17408, L_VB = 34816, L_LT = 52224, L_GC = 69632, L_BE = 69888, L_IMG = 70144;
__device__ __forceinline__ int afrag_off(int row, int k, int nks) {
    const int rt = row >> 5, rr = row & 31, ks = k >> 4, kk = k & 15, hi = (kk >> 2) & 1, sl = (kk & 3) + 4 * (kk >> 3);
    return ((rt * nks + ks) * 64 + rr + 32 * hi) * 16 + sl * 2;
}
__device__ __forceinline__ int ufrag_off(int i, int c) {
    const int cg = c >> 5, col = c & 31, rt = i >> 5, ii = i & 31, hi = (ii >> 2) & 1, r = (ii & 3) + 4 * (ii >> 3);
    return (((cg * 2 + rt) * 2 + (r >> 3)) * 64 + col + 32 * hi) * 8 + (r & 7);
}
__device__ __forceinline__ int crow(int r, int hi) { return (r & 3) + 8 * (r >> 2) + 4 * hi; }
__device__ __forceinline__ bf16_t f2bf(float f) { return (bf16_t)(cvt_pk_bf16(f, 0.f) & 0xffffu); }

__device__ __forceinline__ void precompute(const Args& a, LAS unsigned char* lds, int item, int tid, int lane, int wave) {
    asm volatile("" : "+v"(tid), "+v"(lane), "+s"(wave));
    const int bh = item / NCH, c = item - bh * NCH, b = bh >> 3, h = bh & 7;
    const bf16_t* P = (const bf16_t*)(a.ws + WS_P) + (size_t)b * LSEQ * NPROJ;
    const float* BETA = (const float*)(a.ws + WS_BETA) + (size_t)b * LSEQ * 8; const float* GG = (const float*)(a.ws + WS_G) + (size_t)b * LSEQ * 8;
    unsigned char* dst = a.ws + WS_GCH + (size_t)item * CH_BYTES;
    LAS float* GC = (LAS float*)(lds + L_GC); LAS float* BE = (LAS float*)(lds + L_BE); LAS float* LT = (LAS float*)(lds + L_LT);
    const int tbase = 64 * c - 48;
    if (wave == 0) {
        const int t = tbase + lane; float g = 0.f, be = 0.f;
        if (t >= 0) { g = GG[(size_t)t * 8 + h]; be = BETA[(size_t)t * 8 + h]; }
#pragma unroll
        for (int o = 1; o < 64; o <<= 1) { const float y = __shfl_up(g, o); if (lane >= o) g += y; }
        GC[lane] = g; BE[lane] = be;
        if (lane == 63) ((float*)(a.ws + WS_GL))[item] = expf(g);
    }
    {
        f32x2 cw[3][4];
#pragma unroll
        for (int w3 = 0; w3 < 3; ++w3)
#pragma unroll
            for (int tap = 0; tap < 4; ++tap) cw[w3][tap] = *(const f32x2*)(a.in[I_CONVW] + tap * 3072 + w3 * 1024 + h * HD + 2 * lane);
        f32x2 xw[3][11];
#pragma unroll
        for (int j = 0; j < 11; ++j) { const int t = tbase + 8 * wave - 3 + j;
#pragma unroll
            for (int w3 = 0; w3 < 3; ++w3) { unsigned u = 0u; if (t >= 0) u = *(const unsigned*)(P + (size_t)t * NPROJ + w3 * 1024 + h * HD + 2 * lane); xw[w3][j] = (f32x2){bf_lo(u), bf_hi(u)}; } }
#pragma unroll
        for (int rr = 0; rr < 8; ++rr) { const int i = 8 * wave + rr; f32x2 y[3];
#pragma unroll
            for (int w3 = 0; w3 < 3; ++w3) { f32x2 acc = cw[w3][0] * xw[w3][rr] + cw[w3][1] * xw[w3][rr + 1] + cw[w3][2] * xw[w3][rr + 2] + cw[w3][3] * xw[w3][rr + 3];
                acc.x = acc.x / (1.0f + __expf(-acc.x)); acc.y = acc.y / (1.0f + __expf(-acc.y)); y[w3] = acc; }
            const float rq = 0.08838834764831845f / sqrtf(wave_sum(y[0].x * y[0].x + y[0].y * y[0].y) + NORM_EPS);
            const float rk = 1.0f / sqrtf(wave_sum(y[1].x * y[1].x + y[1].y * y[1].y) + NORM_EPS);
            *(LAS unsigned*)(lds + L_QB + i * 272 + 4 * lane) = cvt_pk_bf16(y[0].x * rq, y[0].y * rq);
            *(LAS unsigned*)(lds + L_KB + i * 272 + 4 * lane) = cvt_pk_bf16(y[1].x * rk, y[1].y * rk);
            *(LAS unsigned*)(lds + L_VB + i * 272 + 4 * lane) = cvt_pk_bf16(y[2].x, y[2].y); }
    }
    __syncthreads();
    {
        const int prod = wave >> 2, ti = (wave >> 1) & 1, tj = wave & 1, r32 = lane & 31, hi = lane >> 5;
        if (tj <= ti) {
            f32x16 acc;
#pragma unroll
            for (int r = 0; r < 16; ++r) acc[r] = 0.f;
            const LAS unsigned char* Ab = lds + (prod ? L_QB : L_KB) + (32 * ti + r32) * 272 + hi * 16;
            const LAS unsigned char* Bb = lds + L_KB + (32 * tj + r32) * 272 + hi * 16;
#pragma unroll
            for (int ks = 0; ks < 8; ++ks) acc = __builtin_amdgcn_mfma_f32_32x32x16_bf16(*(const LAS bf16x8*)(Ab + ks * 32), *(const LAS bf16x8*)(Bb + ks * 32), acc, 0, 0, 0);
            const int j = 32 * tj + r32; const float gj = GC[j];
#pragma unroll
            for (int r = 0; r < 16; ++r) { const int i = 32 * ti + crow(r, hi); const float dec = __expf(GC[i] - gj);
                if (prod == 0) LT[j * 68 + i] = (j < i) ? acc[r] * BE[i] * dec : 0.f;
                else *(LAS bf16_t*)(lds + L_IMG + IMG_AT + afrag_off(i, j, 4)) = f2bf((j <= i) ? acc[r] * dec : 0.f); }
        }
    }
    __syncthreads();
    if (tid < 256) {
        float x[64];
        const bool isv = tid < 128; const int cc = tid & 127;
        const LAS unsigned char* src = lds + (isv ? L_VB : L_KB) + cc * 2;
#pragma unroll
        for (int i8 = 0; i8 < 64; i8 += 8) {
#pragma unroll
            for (int q = 0; q < 8; ++q) { const int i = i8 + q; const float v = bf2f(*(const LAS bf16_t*)(src + i * 272)); x[i] = v * BE[i] * (isv ? 1.0f : __expf(GC[i])); }
            asm volatile("" ::: "memory"); }
#pragma unroll
        for (int j = 0; j < 63; ++j) {
#pragma unroll
            for (int i4 = ((j + 1) & ~3); i4 < 64; i4 += 4) { const f32x4 l4 = *(const LAS f32x4*)(LT + j * 68 + i4);
#pragma unroll
                for (int q = 0; q < 4; ++q) if (i4 + q > j) x[i4 + q] -= l4[q] * x[j]; }
            asm volatile("" ::: "memory");
        }
        if (isv) {
            LAS unsigned char* ub = lds + L_IMG + IMG_U + (((cc >> 5) * 4 * 64) + (cc & 31)) * 16;
#pragma unroll
            for (int i = 0; i < 64; ++i) { const int rt = i >> 5, ii = i & 31, hi = (ii >> 2) & 1, r = (ii & 3) + 4 * (ii >> 3);
                *(LAS bf16_t*)(ub + (((rt * 2 + (r >> 3)) * 64 + 32 * hi) * 8 + (r & 7)) * 2) = f2bf(x[i]); }
        } else {
            const int ks = cc >> 4, kk = cc & 15, hi = (kk >> 2) & 1, sl = (kk & 3) + 4 * (kk >> 3);
            LAS unsigned char* wb = lds + L_IMG + IMG_W + (ks * 64 + 32 * hi) * 16 + sl * 2;
#pragma unroll
            for (int i = 0; i < 64; ++i) *(LAS bf16_t*)(wb + ((i >> 5) * 8 * 64 + (i & 31)) * 16) = f2bf(-x[i]);
        }
    } else {
        const int u = tid - 256, dk = u & 127, i0 = (u >> 7) * 32; const float gl = GC[63];
#pragma unroll 4
        for (int ii = 0; ii < 32; ++ii) { const int i = i0 + ii; const float gi = GC[i];
            const float q = bf2f(*(const LAS bf16_t*)(lds + L_QB + i * 272 + dk * 2)), k = bf2f(*(const LAS bf16_t*)(lds + L_KB + i * 272 + dk * 2));
            *(LAS bf16_t*)(lds + L_IMG + IMG_QG + afrag_off(i, dk, 8)) = f2bf(q * __expf(gi));
            *(LAS bf16_t*)(lds + L_IMG + IMG_KDT + afrag_off(dk, i, 4)) = f2bf(k * __expf(gl - gi)); }
    }
    __syncthreads();
    for (int q = tid; q < CH_BYTES / 16; q += NTHREADS) *(u32x4*)(dst + (size_t)q * 16) = *(const LAS u32x4*)(lds + L_IMG + q * 16);
}

constexpr int OB_OFF = 2 * IMG_BYTES, OB_STR = 264, OB_BYTES = 64 * OB_STR;
__device__ __forceinline__ void gated_rows(const Args& a, const LAS unsigned char* ob, int b, int h, int cc, int w4, int lane, float nw0, float nw1) {
    const bf16_t* P = (const bf16_t*)(a.ws + WS_P); bf16_t* MIX = (bf16_t*)(a.ws + WS_MIX);
    const int s0 = 64 * (cc - 1) + 16 * w4;
    unsigned zw[16];
#pragma unroll
    for (int rr = 0; rr < 16; ++rr) zw[rr] = *(const unsigned*)(P + ((size_t)b * LSEQ + NMETA + s0 + rr) * NPROJ + PC_Z + h * HD + 2 * lane);
#pragma unroll
    for (int rr = 0; rr < 16; ++rr) {
        const unsigned ov = *(const LAS unsigned*)(ob + (16 * w4 + rr) * OB_STR + 4 * lane);
        const float o0 = bf_lo(ov), o1 = bf_hi(ov);
        const float rstd = 1.0f / sqrtf(wave_sum(o0 * o0 + o1 * o1) * (1.0f / HD) + NORM_EPS);
        const float z0 = bf_lo(zw[rr]), z1 = bf_hi(zw[rr]);
        const float r0 = o0 * rstd * nw0 * (z0 / (1.0f + __expf(-z0))), r1 = o1 * rstd * nw1 * (z1 / (1.0f + __expf(-z1)));
        *(unsigned*)(MIX + ((size_t)b * SEQ + s0 + rr) * DM + h * HD + 2 * lane) = cvt_pk_bf16(r0, r1);
    }
}

__device__ __forceinline__ void scan(const Args& a, LAS unsigned char* lds, int bh, int tid, int lane, int wave) {
    const int b = bh >> 3, h = bh & 7, col = lane & 31, hi = lane >> 5, cg = wave;
    const unsigned char* src = a.ws + WS_GCH + (size_t)bh * NCH * CH_BYTES;
    const float* GL = (const float*)(a.ws + WS_GL) + bh * NCH;
    const float nw0 = a.in[I_GDNNW][2 * lane], nw1 = a.in[I_GDNNW][2 * lane + 1];
    __syncthreads();
    const unsigned dvoff = (unsigned)(wave * 1024 + lane * 16), uvoff = (unsigned)(lane * 16);
#define GDN_DMA(ch, buf) do { const unsigned char* _sp = src + (size_t)(ch) * CH_BYTES; _Pragma("unroll") for (int _f = 0; _f < 7; ++_f) { \
        __builtin_amdgcn_global_load_lds((const unsigned*)(_sp + _f * 8192 + dvoff), (LAS unsigned*)(lds + (buf) * IMG_BYTES + wave * 1024 + _f * 8192), 16, 0, 0); } } while (0)
    GDN_DMA(0, 0);
    f32x16 st[4]; bf16x8 Sb[8]; u32x4 ureg[4]; float gl = 1.f;
#pragma unroll
    for (int t4 = 0; t4 < 4; ++t4)
#pragma unroll
        for (int r = 0; r < 16; ++r) st[t4][r] = 0.f;
#pragma unroll
    for (int ks = 0; ks < 8; ++ks) Sb[ks] = (bf16x8){0, 0, 0, 0, 0, 0, 0, 0};
    if (wave < 4) {
#pragma unroll
        for (int q = 0; q < 4; ++q) ureg[q] = *(const u32x4*)(src + IMG_U + cg * 4096 + q * 1024 + uvoff);
        gl = GL[0];
    }
    VM_WAIT(); __syncthreads();
    for (int c = 0; c < NCH; ++c) {
        const LAS unsigned char* img = lds + (c & 1) * IMG_BYTES + lane * 16;
        if (c + 1 < NCH) GDN_DMA(c + 1, (c + 1) & 1);
        if (wave < 4) {
            f32x16 vn[2]; const float glc = gl;
#pragma unroll
            for (int rt = 0; rt < 2; ++rt)
#pragma unroll
                for (int rh = 0; rh < 2; ++rh) { const u32x4 w = ureg[rt * 2 + rh];
                    vn[rt][8 * rh + 0] = bf_lo(w.x); vn[rt][8 * rh + 1] = bf_hi(w.x); vn[rt][8 * rh + 2] = bf_lo(w.y); vn[rt][8 * rh + 3] = bf_hi(w.y);
                    vn[rt][8 * rh + 4] = bf_lo(w.z); vn[rt][8 * rh + 5] = bf_hi(w.z); vn[rt][8 * rh + 6] = bf_lo(w.w); vn[rt][8 * rh + 7] = bf_hi(w.w); }
            asm volatile("" ::: "memory");
            if (c + 1 < NCH) {
#pragma unroll
                for (int q = 0; q < 4; ++q) ureg[q] = *(const u32x4*)(src + (size_t)(c + 1) * CH_BYTES + IMG_U + cg * 4096 + q * 1024 + uvoff);
                gl = GL[c + 1]; }
#pragma unroll
            for (int rt = 0; rt < 2; ++rt) { __builtin_amdgcn_sched_barrier(0);
#pragma unroll
                for (int ks = 0; ks < 8; ++ks) vn[rt] = __builtin_amdgcn_mfma_f32_32x32x16_bf16(*(const LAS bf16x8*)(img + IMG_W + (rt * 8 + ks) * 1024), Sb[ks], vn[rt], 0, 0, 0); }
            __builtin_amdgcn_sched_barrier(0);
            bf16x8 vb[4];
#pragma unroll
            for (int ks = 0; ks < 4; ++ks) vb[ks] = sba_pack8(vn[ks >> 1], 8 * (ks & 1));
            LAS unsigned char* obw = lds + OB_OFF + (c & 1) * OB_BYTES + (32 * cg + col) * 2;
#pragma unroll
            for (int rt = 0; rt < 2; ++rt) { f32x16 o; __builtin_amdgcn_sched_barrier(0);
#pragma unroll
                for (int r = 0; r < 16; ++r) o[r] = 0.f;
#pragma unroll
                for (int ks = 0; ks < 8; ++ks) o = __builtin_amdgcn_mfma_f32_32x32x16_bf16(*(const LAS bf16x8*)(img + IMG_QG + (rt * 8 + ks) * 1024), Sb[ks], o, 0, 0, 0);
#pragma unroll
                for (int ks = 0; ks < 2 * (rt + 1); ++ks) o = __builtin_amdgcn_mfma_f32_32x32x16_bf16(*(const LAS bf16x8*)(img + IMG_AT + (rt * 4 + ks) * 1024), vb[ks], o, 0, 0, 0);
                if (c >= 1) {
#pragma unroll
                    for (int r = 0; r < 16; ++r) *(LAS bf16_t*)(obw + (32 * rt + crow(r, hi)) * OB_STR) = f2bf(o[r]); }
            }
#pragma unroll
            for (int t4 = 0; t4 < 4; ++t4) { __builtin_amdgcn_sched_barrier(0);
#pragma unroll
                for (int r = 0; r < 16; ++r) st[t4][r] *= glc;
#pragma unroll
                for (int ks = 0; ks < 4; ++ks) st[t4] = __builtin_amdgcn_mfma_f32_32x32x16_bf16(*(const LAS bf16x8*)(img + IMG_KDT + (t4 * 4 + ks) * 1024), vb[ks], st[t4], 0, 0, 0);
                Sb[2 * t4] = sba_pack8(st[t4], 0); Sb[2 * t4 + 1] = sba_pack8(st[t4], 8); }
        }
        else if (c >= 2) gated_rows(a, lds + OB_OFF + ((c - 1) & 1) * OB_BYTES, b, h, c - 1, wave - 4, lane, nw0, nw1);
        VM_WAIT(); __syncthreads();
    }
#undef GDN_DMA
    if (wave >= 4) gated_rows(a, lds + OB_OFF + ((NCH - 1) & 1) * OB_BYTES, b, h, NCH - 1, wave - 4, lane, nw0, nw1);
}
}

namespace sba {
#define KSWZ(row, colB) ((row) * 256 + ((colB) ^ (((row) & 7) << 4)))
__device__ __forceinline__ int v_st(int k, int c) { const int kk = (k & ~0xC) | ((k & 4) << 1) | ((k & 8) >> 1); return ((kk >> 3) * 4 + (c >> 5)) * 512 + ((kk & 7) * 32 + (c & 31)) * 2; }
__device__ __forceinline__ int v_rd_base(int lane) { return ((lane & 3) << 3) | (((lane >> 2) & 3) << 6) | (((lane >> 4) & 1) << 5) | (((lane >> 5) & 1) << 8); }
constexpr int v_rd_off(int d0, int ks, int half) { return d0 * 512 + ks * 4096 + half * 2048; }
template <int OFF> __device__ __forceinline__ s16x4 tr_read(int vb) { s16x4 r; asm volatile("ds_read_b64_tr_b16 %0, %1 offset:%2" : "=&v"(r) : "v"(vb), "i"(OFF) : "memory"); return r; }
template <int D0> __device__ __forceinline__ void pv_one(f32x16& od, int vb, bf16x8 pa0, bf16x8 pa1, bf16x8 pa2, bf16x8 pa3) {
    const s16x4 l0 = tr_read<v_rd_off(D0, 0, 0)>(vb), h0 = tr_read<v_rd_off(D0, 0, 1)>(vb), l1 = tr_read<v_rd_off(D0, 1, 0)>(vb), h1 = tr_read<v_rd_off(D0, 1, 1)>(vb);
    const s16x4 l2 = tr_read<v_rd_off(D0, 2, 0)>(vb), h2 = tr_read<v_rd_off(D0, 2, 1)>(vb), l3 = tr_read<v_rd_off(D0, 3, 0)>(vb), h3 = tr_read<v_rd_off(D0, 3, 1)>(vb);
    asm volatile("s_waitcnt lgkmcnt(0)" ::: "memory"); __builtin_amdgcn_sched_barrier(0);
#define PK(L, H) (bf16x8){L[0], L[1], L[2], L[3], H[0], H[1], H[2], H[3]}
    od = __builtin_amdgcn_mfma_f32_32x32x16_bf16(pa0, PK(l0, h0), od, 0, 0, 0);
    od = __builtin_amdgcn_mfma_f32_32x32x16_bf16(pa1, PK(l1, h1), od, 0, 0, 0);
    od = __builtin_amdgcn_mfma_f32_32x32x16_bf16(pa2, PK(l2, h2), od, 0, 0, 0);
    od = __builtin_amdgcn_mfma_f32_32x32x16_bf16(pa3, PK(l3, h3), od, 0, 0, 0);
#undef PK
}
__device__ __forceinline__ int crow(int r, int hi) { return (r & 3) + 8 * (r >> 2) + 4 * hi; }
__device__ __forceinline__ int swap34(int k) { return (k & ~0x18) | ((k & 8) << 1) | ((k & 16) >> 1); }
__device__ __forceinline__ bf16x8 pack8(const f32x16& p, int base) {
    u32x4 w; w.x = cvt_pk_bf16(p[base + 0], p[base + 1]); w.y = cvt_pk_bf16(p[base + 2], p[base + 3]); w.z = cvt_pk_bf16(p[base + 4], p[base + 5]); w.w = cvt_pk_bf16(p[base + 6], p[base + 7]);
    return __builtin_bit_cast(bf16x8, w);
}
constexpr float SB_EXIT = 160.0f;

__device__ __forceinline__ void unit(const Args& a, LAS unsigned char* lds, volatile LAS int* done_cnt, int b, int h, int qb, int tid, int lane, int wid) {
    const bf16_t* QN = (const bf16_t*)(a.ws + WS_QN) + (size_t)(b * NHEAD + h) * LROW * HD;
    const bf16_t* KN = (const bf16_t*)(a.ws + WS_KN) + (size_t)(b * NHEAD + h) * LROW * HD;
    const bf16_t* Vp = (const bf16_t*)(a.ws + WS_P) + (size_t)b * LSEQ * NPROJ + PC_SBV + h * HD;
    bf16_t* MIX = (bf16_t*)(a.ws + WS_MIX);
    const int r32 = lane & 31, hi = lane >> 5;
    LAS unsigned char* K_lds = lds; LAS unsigned char* V_lds = lds + 16384;
    const int tq0 = NMETA + 256 * qb + 32 * wid, tq = tq0 + r32;
    __syncthreads();
    if (tid == 0) *done_cnt = 0;
    bf16x8 qr[8];
#pragma unroll
    for (int d0 = 0; d0 < 8; ++d0) qr[d0] = *(const bf16x8*)(QN + (size_t)tq * HD + d0 * 16 + hi * 8);
    const int sr = tid >> 4, sc = (tid & 15) * 8;
    const int vst0 = v_st(swap34(sr), sc), vst1 = v_st(32 + swap34(sr), sc);
    const int kst0 = KSWZ(sr, sc * 2), kst1 = KSWZ(32 + sr, sc * 2);
    const int vb0 = (int)(unsigned)(unsigned long)V_lds + v_rd_base(lane);
    const int prow = (r32 & 3) + 4 * (r32 >> 3) + 16 * ((r32 >> 2) & 1);
    f32x16 o[4];
#pragma unroll
    for (int d = 0; d < 4; ++d)
#pragma unroll
        for (int r = 0; r < 16; ++r) o[d][r] = 0.f;
    float carry = 0.f; bool flagged = false;
    for (int kt = 4 * qb + 4; kt >= 0; --kt) {
        const int k0 = 64 * kt;
        const bf16x8 ks0 = *(const bf16x8*)(KN + (size_t)(k0 + sr) * HD + sc), ks1 = *(const bf16x8*)(KN + (size_t)(k0 + 32 + sr) * HD + sc);
        const bf16x8 vs0 = *(const bf16x8*)(Vp + (size_t)(k0 + sr) * NPROJ + sc), vs1 = *(const bf16x8*)(Vp + (size_t)(k0 + 32 + sr) * NPROJ + sc);
        __syncthreads();
        if (*done_cnt == NWAVES) break;
        *(LAS bf16x8*)(K_lds + kst0) = ks0; *(LAS bf16x8*)(K_lds + kst1) = ks1; *(LAS bf16x8*)(V_lds + vst0) = vs0; *(LAS bf16x8*)(V_lds + vst1) = vs1;
        __syncthreads();
        if (k0 >= tq0 + 32) continue;
        f32x16 p0, p1;
#pragma unroll
        for (int r = 0; r < 16; ++r) { p0[r] = 0.f; p1[r] = 0.f; }
#pragma unroll
        for (int d0 = 0; d0 < 8; ++d0) { const int cb = (d0 * 16 + hi * 8) * 2;
            const bf16x8 b0 = *(const LAS bf16x8*)(K_lds + KSWZ(prow, cb)), b1 = *(const LAS bf16x8*)(K_lds + KSWZ(32 + prow, cb));
            p0 = __builtin_amdgcn_mfma_f32_32x32x16_bf16(b0, qr[d0], p0, 0, 0, 0);
            p1 = __builtin_amdgcn_mfma_f32_32x32x16_bf16(b1, qr[d0], p1, 0, 0, 0); }
        const bool need_mask = (k0 + 63 >= tq0);
        f32x16 s0, s1; float t0 = 0.f, t1 = 0.f;
#pragma unroll
        for (int r = 0; r < 16; ++r) {
            float e0 = __builtin_amdgcn_exp2f(p0[r]), e1 = __builtin_amdgcn_exp2f(p1[r]);
            float q0 = __builtin_amdgcn_logf(1.0f + e0), q1 = __builtin_amdgcn_logf(1.0f + e1);
            if (need_mask) { const bool v0 = (k0 + 16 * hi + r) < tq, v1 = (k0 + 32 + 16 * hi + r) < tq; e0 = v0 ? e0 : 0.f; q0 = v0 ? q0 : 0.f; e1 = v1 ? e1 : 0.f; q1 = v1 ? q1 : 0.f; }
            p0[r] = e0; p1[r] = e1; s0[r] = q0; s1[r] = q1; t0 += q0; t1 += q1; }
        float t1lo, t1hi, t0lo, t0hi;
        { auto rr = __builtin_amdgcn_permlane32_swap(__float_as_uint(t1), __float_as_uint(t1), false, false); t1lo = __uint_as_float(rr[0]); t1hi = __uint_as_float(rr[1]); }
        { auto rr = __builtin_amdgcn_permlane32_swap(__float_as_uint(t0), __float_as_uint(t0), false, false); t0lo = __uint_as_float(rr[0]); t0hi = __uint_as_float(rr[1]); }
        float run1 = carry + (hi ? 0.f : t1hi), run0 = carry + (t1lo + t1hi) + (hi ? 0.f : t0hi);
#pragma unroll
        for (int r = 15; r >= 0; --r) { run1 += s1[r]; p1[r] = p1[r] * __builtin_amdgcn_exp2f(-run1); run0 += s0[r]; p0[r] = p0[r] * __builtin_amdgcn_exp2f(-run0); }
        carry += (t1lo + t1hi) + (t0lo + t0hi);
        const bf16x8 pa0 = pack8(p0, 0), pa1 = pack8(p0, 8), pa2 = pack8(p1, 0), pa3 = pack8(p1, 8);
        pv_one<0>(o[0], vb0, pa0, pa1, pa2, pa3); pv_one<1>(o[1], vb0, pa0, pa1, pa2, pa3); pv_one<2>(o[2], vb0, pa0, pa1, pa2, pa3); pv_one<3>(o[3], vb0, pa0, pa1, pa2, pa3);
        if (!flagged && __all(carry >= SB_EXIT)) { flagged = true; if (lane == 0) (void)__hip_atomic_fetch_add((LAS int*)done_cnt, 1, __ATOMIC_RELAXED, __HIP_MEMORY_SCOPE_WORKGROUP); }
    }
    const float* onw = a.in[I_SBONW];
    float wv[4];
#pragma unroll
    for (int d0 = 0; d0 < 4; ++d0) wv[d0] = onw[32 * d0 + r32];
#pragma unroll
    for (int r = 0; r < 16; ++r) {
        float ss = (o[0][r] * o[0][r] + o[1][r] * o[1][r]) + (o[2][r] * o[2][r] + o[3][r] * o[3][r]);
        ss += __shfl_xor(ss, 1); ss += __shfl_xor(ss, 2); ss += __shfl_xor(ss, 4); ss += __shfl_xor(ss, 8); ss += __shfl_xor(ss, 16);
        const float rstd = 1.0f / sqrtf(ss * (1.0f / HD) + NORM_EPS);
        const size_t tok = (size_t)b * SEQ + (tq0 - NMETA) + crow(r, hi);
        bf16_t* dst = MIX + tok * DM + 1024 + h * HD + r32;
#pragma unroll
        for (int d0 = 0; d0 < 4; ++d0) dst[32 * d0] = (bf16_t)(cvt_pk_bf16(o[d0][r] * rstd * wv[d0], 0.f) & 0xffffu);
    }
}
}

__device__ __forceinline__ void p5_router(const Args& a, LAS unsigned char* lds, int G, int c, int tid, int lane, int wave) {
    LAS float* wl = (LAS float*)lds;
    LAS float* lg = (LAS float*)(lds + 132096);
    LAS int* misc = (LAS int*)(lds + MISC_OFF);
    const float* H1 = a.out; const float* rw = a.in[I_RW]; const float* rb = a.in[I_RB];
    bf16_t* HN2 = (bf16_t*)(a.ws + WS_HN);
    int* RE = (int*)(a.ws + WS_RE); int* RP = (int*)(a.ws + WS_RP); float* RG = (float*)(a.ws + WS_RG); int* LIST = (int*)(a.ws + WS_LIST);
    unsigned* ecnt = (unsigned*)(a.ws + WS_CTL) + CW_ECNT;
    f32x4 wn[8];
#pragma unroll
    for (int j = 0; j < 8; ++j) wn[j] = *((const f32x4*)a.in[I_FFNNW] + lane + 64 * j);
    for (int blk = c; blk < NREAL / 64; blk += G) {
        for (int pass = 0; pass < 2; ++pass) {
            __syncthreads();
            stage_w16(wl, rw, NEXP, pass * 16, tid);
            if (pass == 0 && tid < 32) misc[40 + tid] = 0;
            __syncthreads();
            for (int rr = 0; rr < 8; ++rr) {
                const int rloc = wave * 8 + rr; const size_t row = (size_t)blk * 64 + rloc;
                f32x4 v[8]; float ss = 0.f;
#pragma unroll
                for (int j = 0; j < 8; ++j) { v[j] = *((const f32x4*)(H1 + row * DM) + lane + 64 * j); ss += (v[j].x * v[j].x + v[j].y * v[j].y) + (v[j].z * v[j].z + v[j].w * v[j].w); }
                const float rstd = 1.0f / sqrtf(wave_sum(ss) * (1.0f / DM) + NORM_EPS);
                GAS unsigned long long* o8 = (GAS unsigned long long*)(HN2 + row * DM) + lane;
#pragma unroll
                for (int j = 0; j < 8; ++j) { v[j] = v[j] * rstd * wn[j];
                    if (pass == 0) o8[64 * j] = (unsigned long long)cvt_pk_bf16(v[j].x, v[j].y) | ((unsigned long long)cvt_pk_bf16(v[j].z, v[j].w) << 32); }
                float s[16]; dot16(v, wl, lane, s);
                float sv = s[0];
#pragma unroll
                for (int cc = 1; cc < 16; ++cc) sv = ((lane & 15) == cc) ? s[cc] : sv;
                if (lane < 16) lg[rloc * 33 + pass * 16 + lane] = sv;
            }
        }
        __syncthreads();
        int ek[4] = {0, 0, 0, 0}, rk[4] = {0, 0, 0, 0}; float gk[4] = {0.f, 0.f, 0.f, 0.f};
        if (tid < 64) {
            float v[32];
#pragma unroll
            for (int e = 0; e < 32; ++e) v[e] = lg[tid * 33 + e] + rb[e];
            float val[4];
#pragma unroll
            for (int k = 0; k < 4; ++k) { float best = -3.0e38f; int bi = 0;
#pragma unroll
                for (int e = 0; e < 32; ++e) { const bool gt = v[e] > best; best = gt ? v[e] : best; bi = gt ? e : bi; }
#pragma unroll
                for (int e = 0; e < 32; ++e) v[e] = (e == bi) ? -3.0e38f : v[e];
                ek[k] = bi; val[k] = best; }
            float den = 0.f;
#pragma unroll
            for (int k = 0; k < 4; ++k) { gk[k] = expf(val[k] - val[0]); den += gk[k]; }
#pragma unroll
            for (int k = 0; k < 4; ++k) { gk[k] = gk[k] / den; rk[k] = __hip_atomic_fetch_add(&misc[40 + ek[k]], 1, __ATOMIC_RELAXED, __HIP_MEMORY_SCOPE_WORKGROUP); }
        }
        __syncthreads();
        if (tid < 32) { const int cnt = misc[40 + tid]; misc[72 + tid] = cnt ? (int)atomicAdd(&ecnt[tid], (unsigned)cnt) : 0; }
        __syncthreads();
        if (tid < 64) { const int tok = blk * 64 + tid;
#pragma unroll
            for (int k = 0; k < 4; ++k) { const int pos = misc[72 + ek[k]] + rk[k]; LIST[(size_t)ek[k] * NREAL + pos] = tok; RE[tok * 4 + k] = ek[k]; RP[tok * 4 + k] = pos; RG[tok * 4 + k] = gk[k]; } }
    }
    __syncthreads();
}

__device__ __forceinline__ int moe_setup(const Args& a, LAS int* misc, int tid) {
    const unsigned* ecnt = (const unsigned*)(a.ws + WS_CTL) + CW_ECNT;
    __syncthreads();
    if (tid == 0) { int acc = 0;
        for (int e = 0; e < NEXP; ++e) { const int cnt = (int)__hip_atomic_load(ecnt + e, __ATOMIC_RELAXED, __HIP_MEMORY_SCOPE_AGENT); misc[104 + e] = cnt; misc[e] = acc; acc += (cnt + 255) >> 8; }
        misc[32] = acc; }
    __syncthreads();
    return misc[32];
}

__device__ __forceinline__ void p8_combine(const Args& a, const LAS int* misc, int gw, int NGW, int lane) {
    const int* RE = (const int*)(a.ws + WS_RE); const int* RP = (const int*)(a.ws + WS_RP); const float* RG = (const float*)(a.ws + WS_RG);
    const bf16_t* Y = (const bf16_t*)(a.ws + WS_Y); const float* bd = a.in[I_BD]; float* out = a.out;
    for (int row = gw; row < NREAL; row += NGW) {
        int e[4]; size_t slot[4]; float g[4];
#pragma unroll
        for (int k = 0; k < 4; ++k) { e[k] = RE[row * 4 + k]; slot[k] = (size_t)misc[e[k]] * 256 + RP[row * 4 + k]; g[k] = RG[row * 4 + k]; }
#pragma unroll
        for (int j = 0; j < 4; ++j) { const int col = 8 * lane + 512 * j;
            f32x4 a0 = *(const f32x4*)(out + (size_t)row * DM + col), a1 = *(const f32x4*)(out + (size_t)row * DM + col + 4);
#pragma unroll
            for (int k = 0; k < 4; ++k) { const u32x4 y = *(const u32x4*)(Y + slot[k] * DM + col);
                const f32x4 b0 = *(const f32x4*)(bd + (size_t)e[k] * DM + col), b1 = *(const f32x4*)(bd + (size_t)e[k] * DM + col + 4);
                a0.x += g[k] * (bf_lo(y.x) + b0.x); a0.y += g[k] * (bf_hi(y.x) + b0.y); a0.z += g[k] * (bf_lo(y.y) + b0.z); a0.w += g[k] * (bf_hi(y.y) + b0.w);
                a1.x += g[k] * (bf_lo(y.z) + b1.x); a1.y += g[k] * (bf_hi(y.z) + b1.y); a1.z += g[k] * (bf_lo(y.w) + b1.z); a1.w += g[k] * (bf_hi(y.w) + b1.w); }
            *(f32x4*)(out + (size_t)row * DM + col) = a0; *(f32x4*)(out + (size_t)row * DM + col + 4) = a1; }
    }
}

__device__ __forceinline__ void p1_meta_rows(const Args& a, int bx, int G, int wave, int lane) {
    const bf16_t* HN = (const bf16_t*)(a.ws + WS_HN); const bf16_t* WT = (const bf16_t*)(a.ws + WS_WIN); bf16_t* P = (bf16_t*)(a.ws + WS_P);
    for (int col = bx; col < NPROJ; col += G) {
        u32x4 w[4];
#pragma unroll
        for (int j = 0; j < 4; ++j) w[j] = *(const u32x4*)(WT + (size_t)col * DM + 8 * lane + 512 * j);
        for (int t = wave; t < NMETA; t += NWAVES) {
            float acc = 0.f;
#pragma unroll
            for (int j = 0; j < 4; ++j) { const u32x4 x = *(const u32x4*)(HN + (size_t)t * DM + 8 * lane + 512 * j);
                acc += bf_lo(x.x) * bf_lo(w[j].x) + bf_hi(x.x) * bf_hi(w[j].x) + bf_lo(x.y) * bf_lo(w[j].y) + bf_hi(x.y) * bf_hi(w[j].y)
                     + bf_lo(x.z) * bf_lo(w[j].z) + bf_hi(x.z) * bf_hi(w[j].z) + bf_lo(x.w) * bf_lo(w[j].w) + bf_hi(x.w) * bf_hi(w[j].w); }
            acc = wave_sum(acc);
            if (lane < NB) P[((size_t)lane * LSEQ + t) * NPROJ + col] = gdn::f2bf(acc);
        }
    }
}

constexpr int NPH = 9;
__global__ void __launch_bounds__(NTHREADS, 2) hymba_fwd(Args args) {
    extern __shared__ __attribute__((aligned(16))) unsigned char lds_raw[];
    LAS unsigned char* lds = (LAS unsigned char*)lds_raw;
    LAS int* misc = (LAS int*)(lds + MISC_OFF);
    const int tid = threadIdx.x, lane = tid & 63, wave = __builtin_amdgcn_readfirstlane(tid >> 6);
    const int G = gridDim.x, bx = blockIdx.x;
    const int vcu = (G % 8 == 0) ? (bx % 8) * (G / 8) + bx / 8 : bx;
    const int gw = vcu * NWAVES + wave, NGW = G * NWAVES;
    unsigned* ctl = (unsigned*)(args.ws + WS_CTL);
    for (int u = tid; u < 256; u += NTHREADS) misc[u] = 0;
    __syncthreads();
    XcdBarrier bar; bar.bar = ctl + CW_BAR; bar.x = 0; bar.st = nullptr;
    const int lo = args.ph_lo, hi = args.ph_hi;
    if (hi - lo > 1) bar = xcd_barrier_post(ctl + CW_BAR, (volatile LAS unsigned*)(misc + 200));
#ifdef ONLY
#define IN(k) ((k) == ONLY && lo <= (k) && (k) < hi)
#else
#define IN(k) (lo <= (k) && (k) < hi)
#endif
#ifndef REP_COUNT
#define REP_COUNT 2
#endif
#define REPEAT(k) _Pragma("unroll") for (int _r = 0; _r < ((REP_PHASE == (k)) ? REP_COUNT : 1); ++_r)
#define SEAM(k) do { if (IN(k) && IN((k) + 1)) xcd_barrier(bar); if (PROBE_A >= 0 && tid == 0) tsl[(k) + 1] = __builtin_amdgcn_s_memrealtime(); } while (0)

    LAS unsigned long long* tsl = (LAS unsigned long long*)(lds + MISC_OFF + 896);
    if (PROBE_A >= 0 && tid == 0) tsl[0] = __builtin_amdgcn_s_memrealtime();
    if (IN(0)) REPEAT(0) { p0_rows(args, lds, gw, NGW, tid, lane); p0_weights(args, lds, vcu, G, wave, lane); }
    SEAM(0);
    if (IN(1)) REPEAT(1) {
        p1_meta_rows(args, bx, G, wave, lane);
        pg8::PlainOrder S; S.init(NREAL, NPROJ, DM, args.ws + WS_WIN, G, bx); S.meta = 1;
        pg8::EpiBf16 E{(bf16_t*)(args.ws + (_r ? WS_ACT : WS_P)), NPROJ, 1};
        pg8::gemm_phase<pg8::EpiBf16, pg8::PlainOrder, true, true>(lds, (const char*)(args.ws + WS_HN), DM, S, E);
    }
    SEAM(1);
    if (IN(2)) REPEAT(2) {
        p2_qknorm(args, gw, NGW, lane);
#if GDN_CHUNKED
        for (int it = bx; it < 32 * gdn::NCH; it += G) { __syncthreads(); gdn::precompute(args, lds, it, tid, lane, wave); }
#endif
    }
    SEAM(2);
    if (IN(3)) REPEAT(3) {
        const int NG = (G >= 64) ? 32 : 0;
#if GDN_CHUNKED
        if (bx < 32 || NG == 0) { for (int it = bx; it < 32; it += G) gdn::scan(args, lds, it, tid, lane, wave); }
#else
        if (bx < 32 || NG == 0) { for (int it = bx; it < 32; it += G) p3_gdn_naive(args, lds, it, tid, lane, wave); }
#endif
        if (bx >= NG) { for (int u = bx - NG; u < 512; u += G - NG) sba::unit(args, lds, (volatile LAS int*)(misc + 210), u >> 7, (u >> 4) & 7, u & 15, tid, lane, wave); }
    }
    SEAM(3);
    if (IN(4)) REPEAT(4) {
        pg8::PlainOrder S; S.init(NREAL, DM, DM, args.ws + WS_WOUT, G, bx);
        pg8::EpiResF32 E{args.in[I_X], _r ? (float*)(args.ws + WS_ACT) : args.out, DM};
        pg8::gemm_phase<pg8::EpiResF32, pg8::PlainOrder, true, true>(lds, (const char*)(args.ws + WS_MIX), DM, S, E);
    }
    SEAM(4);
    if (IN(5)) p5_router(args, lds, G, bx, tid, lane, wave);
    SEAM(5);
    if (IN(6)) REPEAT(6) {
        const int mt = moe_setup(args, misc, tid);
        pg8::MoeOrder<true> S; S.tpre = misc; S.tok = (const LAS int*)(lds + TOK_OFF); S.nN = 16; S.nwg = mt * 16; S.G = G; S.c = bx;
        S.Bt = (const char*)(args.ws + WS_WGU); S.estride = (size_t)2 * DE * DM * 2; S.K2 = DM * 2;
        const int* LIST = (const int*)(args.ws + WS_LIST);
        for (int ui = 0; ui < TOK_CAP; ++ui) { pg8::Unit u; if (!S.next(ui, u)) break;
            if (tid < 256) { const int idx = (u.pm - misc[u.e]) * 256 + tid; ((LAS int*)(lds + TOK_OFF))[ui * 256 + tid] = idx < misc[104 + u.e] ? LIST[(size_t)u.e * NREAL + idx] : 0; } }
        __syncthreads();
        pg8::EpiSwiGLU E{(bf16_t*)(args.ws + WS_ACT), args.in[I_BGU]};
        pg8::gemm_phase<pg8::EpiSwiGLU, pg8::MoeOrder<true>, true, true>(lds, (const char*)(args.ws + WS_HN), DM, S, E);
    }
    SEAM(6);
    if (IN(7)) REPEAT(7) {
        const int mt = moe_setup(args, misc, tid);
        pg8::MoeOrder<false> S; S.tpre = misc; S.tok = nullptr; S.nN = 8; S.nwg = mt * 8; S.G = G; S.c = bx;
        S.Bt = (const char*)(args.ws + WS_WD); S.estride = (size_t)DM * DE * 2; S.K2 = DE * 2;
        pg8::EpiBf16 E{(bf16_t*)(args.ws + (_r ? WS_WGU : WS_Y)), DM, 0};
        pg8::gemm_phase<pg8::EpiBf16, pg8::MoeOrder<false>, true, true>(lds, (const char*)(args.ws + WS_ACT), DE, S, E);
    }
    SEAM(7);
    if (IN(8)) { (void)moe_setup(args, misc, tid); p8_combine(args, misc, gw, NGW, lane); }
#if PROBE_A >= 0
    __syncthreads();
    if (tid == 0) tsl[9] = __builtin_amdgcn_s_memrealtime();
    __syncthreads();
    {
        const int pa = PROBE_A, pb = PROBE_B;
        const float ka = (float)(pa == 9 ? (tsl[9] - tsl[0]) : (tsl[pa + 1] - tsl[pa])) * 1e-3f;
        const float kb = (float)(pb == 9 ? (tsl[9] - tsl[0]) : (tsl[pb + 1] - tsl[pb])) * 1e-3f;
        for (size_t i = (size_t)bx * NTHREADS + tid; i < (size_t)NREAL * DM; i += (size_t)G * NTHREADS) args.out[i] = ka;
        if (bx == 0) { __syncthreads(); if (tid == 0) args.out[0] = 64.0f * kb; }
    }
#endif
#undef IN
#undef SEAM
}

extern "C" void kernel_launch(void* const* d_in, const int* in_sizes, int n_in, void* d_out, int out_size, void* d_ws, size_t ws_size, hipStream_t stream) {
    static int grid = 0;
    if (grid == 0) {
        if (n_in != 19 || out_size != NREAL * DM || ws_size < WS_END) { fprintf(stderr, "kernel_launch: unexpected shapes (n_in %d out %d ws %zu need %zu)\n", n_in, out_size, ws_size, (size_t)WS_END); grid = -1; return; }
        int dev = 0, cus = 0, per_cu = 0;
        if (hipGetDevice(&dev) != hipSuccess || hipDeviceGetAttribute(&cus, hipDeviceAttributeMultiprocessorCount, dev) != hipSuccess) { grid = -1; return; }
        if (hipFuncSetAttribute((const void*)hymba_fwd, hipFuncAttributeMaxDynamicSharedMemorySize, LDS_BYTES) != hipSuccess) { fprintf(stderr, "kernel_launch: hipFuncSetAttribute failed\n"); grid = -1; return; }
        if (hipOccupancyMaxActiveBlocksPerMultiprocessor(&per_cu, (const void*)hymba_fwd, NTHREADS, LDS_BYTES) != hipSuccess || per_cu < 1) { fprintf(stderr, "kernel_launch: occupancy query says %d\n", per_cu); grid = -1; return; }
        (void)hipGetLastError();
        grid = cus;
    }
    if (grid < 0) return;
    (void)hipMemsetAsync((char*)d_ws + WS_CTL, 0, CTL_ZERO_BYTES, stream);
    Args a{};
    for (int i = 0; i < 19; ++i) a.in[i] = (const float*)d_in[i];
    a.out = (float*)d_out; a.ws = (unsigned char*)d_ws;
#if MK_N_LAUNCHES == 1
    a.ph_lo = 0; a.ph_hi = NPH;
    hipLaunchKernelGGL(hymba_fwd, dim3(grid), dim3(NTHREADS), LDS_BYTES, stream, a);
#else
    for (int p = 0; p < NPH; ++p) { a.ph_lo = p; a.ph_hi = p + 1; hipLaunchKernelGGL(hymba_fwd, dim3(grid), dim3(NTHREADS), LDS_BYTES, stream, a); }
#endif
    const hipError_t le = hipPeekAtLastError();
    if (le != hipSuccess) fprintf(stderr, "kernel_launch: launch failed: %s\n", hipGetErrorName(le));
}
```

```cpp
#include <hip/hip_runtime.h>
#include <cstdio>
#include <cstdint>

#ifndef GDN_CHUNKED
#define GDN_CHUNKED 1
#endif
#ifndef REP_PHASE
#define REP_PHASE -1
#endif
#ifndef PROBE_A
#define PROBE_A -1
#define PROBE_B -1
#endif
#ifndef MK_N_LAUNCHES
#define MK_N_LAUNCHES 1
#endif

constexpr int NB = 4, SEQ = 4096, NMETA = 16, LSEQ = SEQ + NMETA;
constexpr int DM = 2048, NTOK = NB * LSEQ  , MPAD = 16640  , NREAL = NB * SEQ  ;
constexpr int NPROJ_SRC = 7184, NPROJ = 7168;
constexpr int NHEAD = 8, HD = 128;
constexpr int PC_QKV = 0, PC_Z = 3072, PC_SBQ = 4096, PC_SBK = 5120, PC_SBV = 6144;
constexpr int NEXP = 32, TOPK = 4, DE = 2048;
constexpr int SLOT_ROWS = 73728;
constexpr int LROW = 4224;
constexpr float NORM_EPS = 1e-6f;

constexpr size_t MiB = 1u << 20;
constexpr size_t WS_CTL = 0, CTL_ZERO_BYTES = 1 * MiB;
constexpr size_t WS_WIN = 1 * MiB;
constexpr size_t WS_WOUT = WS_WIN + (size_t)NPROJ * DM * 2;
constexpr size_t WS_WGU = WS_WOUT + (size_t)DM * DM * 2;
constexpr size_t WS_WD = WS_WGU + (size_t)NEXP * 2 * DE * DM * 2;
constexpr size_t WS_HN = WS_WD + (size_t)NEXP * DM * DE * 2;
constexpr size_t WS_BETA = WS_HN + (size_t)MPAD * DM * 2;
constexpr size_t WS_G = WS_BETA + (size_t)NTOK * 8 * 4 + 256;
constexpr size_t WS_P = WS_G + (size_t)NTOK * 8 * 4 + 256;
constexpr size_t WS_QN = WS_P + (size_t)MPAD * NPROJ * 2;
constexpr size_t WS_KN = WS_QN + (size_t)NB * NHEAD * LROW * HD * 2;
constexpr size_t WS_ORAW = WS_KN + (size_t)NB * NHEAD * LROW * HD * 2;
constexpr size_t WS_MIX = WS_ORAW + (size_t)NREAL * 1024 * 4;
constexpr size_t WS_RE = WS_MIX + (size_t)NREAL * DM * 2;
constexpr size_t WS_RP = WS_RE + (size_t)NREAL * 4 * 4;
constexpr size_t WS_RG = WS_RP + (size_t)NREAL * 4 * 4;
constexpr size_t WS_LIST = WS_RG + (size_t)NREAL * 4 * 4;
constexpr size_t WS_ACT = WS_LIST + (size_t)NEXP * NREAL * 4;
constexpr size_t WS_Y = WS_ACT + (size_t)SLOT_ROWS * DE * 2;
constexpr size_t WS_GCH = WS_Y + (size_t)SLOT_ROWS * DM * 2;
constexpr size_t WS_GL = WS_GCH + (size_t)32 * 65 * 73728;
constexpr size_t WS_END = WS_GL + 32 * 65 * 4 + 256;
constexpr int CW_ECNT = 64;
constexpr int CW_BAR = 4096;

constexpr int LDS_STAGE = 131072;
constexpr int TOK_OFF = LDS_STAGE, TOK_CAP = 20;
constexpr int MISC_OFF = TOK_OFF + TOK_CAP * 256 * 4;
constexpr int LDS_BYTES = MISC_OFF + 1024;

#define GAS __attribute__((address_space(1)))
#define LAS __attribute__((address_space(3)))
typedef unsigned short bf16_t;
typedef short bf16x8 __attribute__((ext_vector_type(8)));
typedef short s16x4 __attribute__((ext_vector_type(4)));
typedef float f32x4 __attribute__((ext_vector_type(4)));
typedef float f32x2 __attribute__((ext_vector_type(2)));
typedef float f32x16 __attribute__((ext_vector_type(16)));
typedef unsigned u32x4 __attribute__((ext_vector_type(4)));
typedef unsigned u32x2 __attribute__((ext_vector_type(2)));

typedef __bf16 bf16x2_t __attribute__((ext_vector_type(2)));
__device__ __forceinline__ unsigned cvt_pk_bf16(float lo, float hi) { const f32x2 v = {lo, hi}; const bf16x2_t b = __builtin_convertvector(v, bf16x2_t); return __builtin_bit_cast(unsigned, b); }
__device__ __forceinline__ unsigned pk4_fp8(float a, float b, float c, float d) { unsigned w = 0u; w = __builtin_amdgcn_cvt_pk_fp8_f32(a, b, w, false); w = __builtin_amdgcn_cvt_pk_fp8_f32(c, d, w, true); return w; }
__device__ __forceinline__ float bf_lo(unsigned w) { return __uint_as_float(w << 16); }
__device__ __forceinline__ float bf_hi(unsigned w) { return __uint_as_float(w & 0xffff0000u); }
__device__ __forceinline__ float bf2f(bf16_t b) { return __uint_as_float(((unsigned)b) << 16); }
__device__ __forceinline__ float wave_sum(float v) {
#pragma unroll
    for (int o = 1; o < 64; o <<= 1) v += __shfl_xor(v, o);
    return v;
}

namespace pg8 {
constexpr int BM = 256, BK = 64, HALF = 128, HTB = HALF * BK * 2, STAGE_BYTES = 8 * HTB, NXCD = 8, WGM = 8;
__host__ __device__ __forceinline__ int lds_byte(int r, int c) { const int st = (r >> 4) * 2 + (c >> 5), rr = r & 15, cc = c & 31, ob = rr * 64 + cc * 2; return st * 1024 + (ob ^ (((ob >> 9) & 1) << 5)); }
__host__ __device__ __forceinline__ void stage_rc(int b, int& R, int& C) { const int st = b / 1024, sb = b % 1024, swz = sb ^ (((sb >> 9) & 1) << 5); R = (st >> 1) * 16 + swz / 64; C = (st & 1) * 32 + (swz % 64) / 2; }
__host__ __device__ __forceinline__ int perm32(int rho) { const int n = rho >> 4, i = rho & 15; return 8 * (i >> 2) + 4 * n + (i & 3); }

typedef int v8i __attribute__((ext_vector_type(8))); typedef int v4i __attribute__((ext_vector_type(4)));
__device__ __forceinline__ v8i cat8(bf16x8 lo, bf16x8 hi) { const v4i a = __builtin_bit_cast(v4i, lo), b = __builtin_bit_cast(v4i, hi); return __builtin_shufflevector(a, b, 0, 1, 2, 3, 4, 5, 6, 7); }
struct Unit { int pm, pn, e, ui; };

__device__ __forceinline__ int xcd_remap(int L, int nwg) { const int q = nwg / NXCD, r = nwg % NXCD, xcd = L % NXCD, off = L / NXCD; return (xcd < r ? xcd * (q + 1) : r * (q + 1) + (xcd - r) * q) + off; }

struct PlainOrder {
    int nM, nN, nwg, G, c; const char* Bt; unsigned K2;
    __device__ void init(int M, int N, int K, const void* Bt_, int G_, int c_) { nM = M / BM; nN = N / BM; nwg = nM * nN; G = G_; c = c_; Bt = (const char*)Bt_; K2 = (unsigned)K * 2u; }
    __device__ __forceinline__ bool next(int i, Unit& u) const {
        const long L = (long)i * G + c; if (L >= nwg) return false;
        const int wgid = xcd_remap((int)L, nwg);
        const int nig = WGM * nN, gid = wgid / nig, fm = gid * WGM, gsz = (nM - fm) < WGM ? (nM - fm) : WGM;
        u.pm = fm + ((wgid % nig) % gsz); u.pn = (wgid % nig) / gsz; u.e = 0; u.ui = i; return true;
    }
    __device__ __forceinline__ const char* b_ptr(const Unit& u) const { return Bt + (size_t)u.pn * BM * K2; }
    __device__ __forceinline__ unsigned a_off(const Unit& u, int r) const { return (unsigned)(u.pm * BM + r + (meta ? NMETA * ((u.pm >> 4) + 1) : 0)) * K2; }
    int meta = 0;
};
template <bool GATHER> struct MoeOrder {
    const LAS int* tpre; const LAS int* tok; int nN, nwg, G, c; const char* Bt; size_t estride; unsigned K2;
    __device__ __forceinline__ bool next(int i, Unit& u) const {
        const long L = (long)i * G + c; if (L >= nwg) return false;
        const int wgid = xcd_remap((int)L, nwg);
        int e = 0;
#pragma unroll 1
        for (int j = 1; j < NEXP; ++j) e = (wgid >= tpre[j] * nN) ? j : e;
        const int t0 = tpre[e], nt = tpre[e + 1] - t0, loc = wgid - t0 * nN;
        u.e = e; u.pn = loc / nt; u.pm = t0 + loc % nt; u.ui = i; return true;
    }
    __device__ __forceinline__ const char* b_ptr(const Unit& u) const { return Bt + (size_t)u.e * estride + (size_t)u.pn * BM * K2; }
    __device__ __forceinline__ unsigned a_off(const Unit& u, int r) const {
        if (GATHER) return (unsigned)tok[u.ui * 256 + r] * K2;
        return (unsigned)(u.pm * BM + r) * K2;
    }
};

struct EpiBf16 {
    static constexpr bool PERM = true;
    bf16_t* O; int ldc; int meta;
    __device__ __forceinline__ void operator()(const f32x4 (&acc)[2][2][4][2], const Unit& u, int wr, int wc, int fr, int fq) const {
        const int row0 = u.pm * BM + wr * 64 + fr + (meta ? NMETA * ((u.pm >> 4) + 1) : 0), col0 = u.pn * BM + wc * 32 + 8 * fq;
#pragma unroll
        for (int ai = 0; ai < 2; ++ai)
#pragma unroll
            for (int m = 0; m < 4; ++m) { bf16_t* rowp = O + (size_t)(row0 + ai * HALF + m * 16) * ldc + col0;
#pragma unroll
                for (int bj = 0; bj < 2; ++bj) { const f32x4 v0 = acc[ai][bj][m][0], v1 = acc[ai][bj][m][1];
                    u32x4 w; w.x = cvt_pk_bf16(v0[0], v0[1]); w.y = cvt_pk_bf16(v0[2], v0[3]); w.z = cvt_pk_bf16(v1[0], v1[1]); w.w = cvt_pk_bf16(v1[2], v1[3]);
                    *(u32x4*)(rowp + bj * HALF) = w; } }
    }
};
struct EpiResF32 {
    static constexpr bool PERM = false;
    const float* X; float* out; int ldc;
    __device__ __forceinline__ void operator()(const f32x4 (&acc)[2][2][4][2], const Unit& u, int wr, int wc, int fr, int fq) const {
        const int row0 = u.pm * BM + wr * 64 + fr, col0 = u.pn * BM + wc * 32 + 4 * fq;
#pragma unroll
        for (int ai = 0; ai < 2; ++ai)
#pragma unroll
            for (int m = 0; m < 4; ++m) { const size_t off = (size_t)(row0 + ai * HALF + m * 16) * ldc + col0;
#pragma unroll
                for (int bj = 0; bj < 2; ++bj)
#pragma unroll
                    for (int n = 0; n < 2; ++n) { const f32x4 xv = *(const f32x4*)(X + off + bj * HALF + n * 16); *(f32x4*)(out + off + bj * HALF + n * 16) = xv + acc[ai][bj][m][n]; }
                asm volatile("" ::: "memory"); }
    }
};
__device__ __forceinline__ float swiglu1(float g, float uu) {
    g = fminf(g, 7.0f); uu = fminf(fmaxf(uu, -7.0f), 7.0f);
    const float sg = __builtin_amdgcn_rcpf(1.0f + __builtin_amdgcn_exp2f(-1.702f * 1.4426950408889634f * g));
    return (uu + 1.0f) * g * sg;
}
struct EpiSwiGLU {
    static constexpr bool PERM = true;
    unsigned char* act; const float* bgu;
    __device__ __forceinline__ void operator()(const f32x4 (&acc)[2][2][4][2], const Unit& u, int wr, int wc, int fr, int fq) const {
        const int row0 = u.pm * BM + wr * 64 + fr, col0 = u.pn * HALF + wc * 32 + 8 * fq;
        const float* bg = bgu + (size_t)u.e * 4096 + col0;
        const f32x4 bg0 = *(const f32x4*)(bg), bg1 = *(const f32x4*)(bg + 4), bu0 = *(const f32x4*)(bg + 2048), bu1 = *(const f32x4*)(bg + 2052);
#pragma unroll
        for (int ai = 0; ai < 2; ++ai)
#pragma unroll
            for (int m = 0; m < 4; ++m) { unsigned char* rowp = act + (size_t)(row0 + ai * HALF + m * 16) * DE + col0;
                const f32x4 g0 = acc[ai][0][m][0] + bg0, g1 = acc[ai][0][m][1] + bg1, u0 = acc[ai][1][m][0] + bu0, u1 = acc[ai][1][m][1] + bu1;
                u32x2 w; w.x = pk4_fp8(swiglu1(g0[0], u0[0]), swiglu1(g0[1], u0[1]), swiglu1(g0[2], u0[2]), swiglu1(g0[3], u0[3]));
                w.y = pk4_fp8(swiglu1(g1[0], u1[0]), swiglu1(g1[1], u1[1]), swiglu1(g1[2], u1[2]), swiglu1(g1[3], u1[3]));
                *(u32x2*)rowp = w; }
    }
};

template <class Epi, class Sched, bool ALIGN_EPI, bool SP2, bool FP8 = false>
__device__ __forceinline__ void gemm_phase(LAS unsigned char* lds, const char* A0, int Kb, const Sched& S, const Epi& E) {
    const int tid = threadIdx.x, wid = __builtin_amdgcn_readfirstlane(tid >> 6), lane = tid & 63, wr = wid >> 2, wc = wid & 3, fr = lane & 15, fq = lane >> 4;
    const int nt = Kb / 128;
    int Rr[2], Cc[2]; unsigned voffB[2];
#pragma unroll
    for (int i = 0; i < 2; ++i) { int R, C; stage_rc(tid * 16 + i * 8192, R, C); const int Rb = Epi::PERM ? ((R & ~31) + perm32(R & 31)) : R;
        Rr[i] = R; Cc[i] = C * 2; voffB[i] = (unsigned)(Rb * Kb + C * 2); }
    const size_t kstep = (size_t)(BK * 2);
    const size_t hstep = (size_t)HALF * Kb;
    const unsigned ldsw = (unsigned)wid * 1024u;
    const int aoff = lds_byte(wr * 64 + fr, fq * 8), boff = lds_byte(wc * 32 + fr, fq * 8);
#define PG8_SA(b, h) (((b) * 2 + (h)) * HTB)
#define PG8_SB(b, h) ((4 + (b) * 2 + (h)) * HTB)
#define PG8_STAGE(bufoff, gbase, voff) do { _Pragma("unroll") for (int _i = 0; _i < 2; ++_i) \
        __builtin_amdgcn_global_load_lds((const unsigned*)((const char*)(gbase) + (voff)[_i]), (LAS unsigned*)(lds + (bufoff) + ldsw + _i * 8192), 16, 0, 0); } while (0)
#define PG8_LDA(dst, b, h) do { _Pragma("unroll") for (int m = 0; m < 4; ++m) _Pragma("unroll") for (int k = 0; k < 2; ++k) dst[m][k] = *(const LAS bf16x8*)(lds + PG8_SA(b, h) + aoff + m * 2048 + k * 1024); } while (0)
#define PG8_LDB(dst, b, h) do { _Pragma("unroll") for (int n = 0; n < 2; ++n) _Pragma("unroll") for (int k = 0; k < 2; ++k) dst[n][k] = *(const LAS bf16x8*)(lds + PG8_SB(b, h) + boff + n * 2048 + k * 1024); } while (0)
#define PG8_MMA(ai, bj, At, Bt) do { __builtin_amdgcn_s_setprio(1); _Pragma("unroll") for (int m = 0; m < 4; ++m) _Pragma("unroll") for (int n = 0; n < 2; ++n) { \
        if constexpr (FP8) acc[ai][bj][m][n] = __builtin_amdgcn_mfma_scale_f32_16x16x128_f8f6f4(cat8(Bt[n][0], Bt[n][1]), cat8(At[m][0], At[m][1]), acc[ai][bj][m][n], 0, 0, 0, 0x79797979, 0, 0x7f7f7f7f); \
        else { _Pragma("unroll") for (int k = 0; k < 2; ++k) acc[ai][bj][m][n] = __builtin_amdgcn_mfma_f32_16x16x32_bf16(Bt[n][k], At[m][k], acc[ai][bj][m][n], 0, 0, 0); } } \
        __builtin_amdgcn_s_setprio(0); } while (0)
#define PG8_WAIT_V(n) asm volatile("s_waitcnt vmcnt(" #n ")" ::: "memory")
#define PG8_WAIT_L(n) asm volatile("s_waitcnt lgkmcnt(" #n ")" ::: "memory")
#define PG8_BAR __builtin_amdgcn_s_barrier()
#define PG8_SCHED __builtin_amdgcn_sched_barrier(0)
#define PG8_VOFF(dst, u) do { _Pragma("unroll") for (int _h = 0; _h < 2; ++_h) _Pragma("unroll") for (int _i = 0; _i < 2; ++_i) dst[_h][_i] = S.a_off(u, _h * HALF + Rr[_i]) + (unsigned)Cc[_i]; } while (0)
    Unit cur, nxt; int ui = 0;
    if (!S.next(0, cur)) return;
    f32x4 acc[2][2][4][2];
#pragma unroll
    for (int a = 0; a < 2; ++a)
#pragma unroll
        for (int b = 0; b < 2; ++b)
#pragma unroll
            for (int m = 0; m < 4; ++m)
#pragma unroll
                for (int n = 0; n < 2; ++n) acc[a][b][m][n] = (f32x4){0.f, 0.f, 0.f, 0.f};
    bf16x8 At[4][2], B0[2][2], B1[2][2];
    unsigned va[2][2], vn[2][2];
    PG8_VOFF(va, cur);
    const char* cB = S.b_ptr(cur);
    if constexpr (SP2) {
        PG8_STAGE(PG8_SB(0, 0), cB, voffB); PG8_STAGE(PG8_SB(0, 1), cB + hstep, voffB); PG8_STAGE(PG8_SA(0, 0), A0, va[0]); PG8_STAGE(PG8_SA(0, 1), A0, va[1]);
        if (wr == 1) PG8_BAR;
        PG8_WAIT_V(2); PG8_BAR;
        PG8_STAGE(PG8_SB(1, 0), cB + kstep, voffB); PG8_STAGE(PG8_SA(1, 0), A0 + kstep, va[0]); PG8_STAGE(PG8_SB(1, 1), cB + hstep + kstep, voffB);
        PG8_WAIT_V(6); PG8_BAR;
    } else {
        PG8_STAGE(PG8_SB(0, 0), cB, voffB); PG8_STAGE(PG8_SA(0, 0), A0, va[0]); PG8_STAGE(PG8_SB(0, 1), cB + hstep, voffB); PG8_STAGE(PG8_SA(0, 1), A0, va[1]);
        if (wr == 1) PG8_BAR;
        PG8_WAIT_V(4); PG8_BAR;
        PG8_STAGE(PG8_SB(1, 0), cB + kstep, voffB); PG8_STAGE(PG8_SA(1, 0), A0 + kstep, va[0]); PG8_STAGE(PG8_SB(1, 1), cB + hstep + kstep, voffB);
        PG8_WAIT_V(6); PG8_BAR;
    }
    for (;;) {
        const bool has_next = S.next(ui + 1, nxt);
        const char* nB = has_next ? S.b_ptr(nxt) : cB;
        for (int t = 0; t < nt; t += 2) {
            const bool last = (t == nt - 2);
            const char* a1 = A0 + (size_t)(t + 1) * kstep;
            const char* a2 = last ? A0 : A0 + (size_t)(t + 2) * kstep; const char* b2 = last ? nB : cB + (size_t)(t + 2) * kstep;
            const char* a3 = a2 + kstep; const char* b3 = b2 + kstep;
            if (last) { if (has_next) { PG8_VOFF(vn, nxt); } else {
#pragma unroll
                    for (int _h = 0; _h < 2; ++_h)
#pragma unroll
                        for (int _i = 0; _i < 2; ++_i) vn[_h][_i] = va[_h][_i]; } }
            if constexpr (SP2) {
            PG8_LDB(B0, 0, 0); PG8_LDB(B1, 0, 1); PG8_SCHED; PG8_LDA(At, 0, 0); PG8_STAGE(PG8_SA(1, 1), a1, va[1]);
            if (last) {
#pragma unroll
                for (int _h = 0; _h < 2; ++_h)
#pragma unroll
                    for (int _i = 0; _i < 2; ++_i) va[_h][_i] = vn[_h][_i]; }
            PG8_WAIT_V(8); PG8_WAIT_L(0); PG8_BAR; PG8_MMA(0, 0, At, B0); PG8_MMA(0, 1, At, B1); PG8_BAR; PG8_SCHED;
            PG8_LDA(At, 0, 1); PG8_STAGE(PG8_SB(0, 0), b2, voffB); PG8_STAGE(PG8_SB(0, 1), b2 + hstep, voffB); PG8_STAGE(PG8_SA(0, 0), a2, va[0]);
            PG8_WAIT_V(8); PG8_WAIT_L(0); PG8_BAR; PG8_MMA(1, 0, At, B0); PG8_MMA(1, 1, At, B1); PG8_BAR; PG8_SCHED;
            PG8_LDB(B0, 1, 0); PG8_LDB(B1, 1, 1); PG8_SCHED; PG8_LDA(At, 1, 0); PG8_STAGE(PG8_SA(0, 1), a2, va[1]);
            PG8_WAIT_V(8); PG8_WAIT_L(0); PG8_BAR; PG8_MMA(0, 0, At, B0); PG8_MMA(0, 1, At, B1); PG8_BAR; PG8_SCHED;
            PG8_LDA(At, 1, 1); PG8_STAGE(PG8_SB(1, 0), b3, voffB); PG8_STAGE(PG8_SB(1, 1), b3 + hstep, voffB); PG8_STAGE(PG8_SA(1, 0), a3, va[0]);
            PG8_WAIT_V(8); PG8_WAIT_L(0); PG8_BAR; PG8_MMA(1, 0, At, B0); PG8_MMA(1, 1, At, B1); PG8_BAR; PG8_SCHED;
            } else {
            PG8_LDB(B0, 0, 0); PG8_SCHED; PG8_LDA(At, 0, 0); PG8_STAGE(PG8_SA(1, 1), a1, va[1]);
            if (last) {
#pragma unroll
                for (int _h = 0; _h < 2; ++_h)
#pragma unroll
                    for (int _i = 0; _i < 2; ++_i) va[_h][_i] = vn[_h][_i]; }
            PG8_WAIT_L(8); PG8_BAR; PG8_WAIT_L(0); PG8_MMA(0, 0, At, B0); PG8_BAR; PG8_SCHED;
            PG8_LDB(B1, 0, 1); PG8_STAGE(PG8_SB(0, 0), b2, voffB);
            PG8_BAR; PG8_WAIT_L(0); PG8_MMA(0, 1, At, B1); PG8_BAR;
            PG8_LDA(At, 0, 1); PG8_STAGE(PG8_SA(0, 0), a2, va[0]);
            PG8_BAR; PG8_WAIT_L(0); PG8_MMA(1, 0, At, B0); PG8_BAR; PG8_SCHED;
            PG8_STAGE(PG8_SB(0, 1), b2 + hstep, voffB);
            PG8_WAIT_V(6); PG8_BAR; PG8_MMA(1, 1, At, B1); PG8_BAR;
            PG8_LDB(B0, 1, 0); PG8_SCHED; PG8_LDA(At, 1, 0); PG8_STAGE(PG8_SA(0, 1), a2, va[1]);
            PG8_WAIT_L(8); PG8_BAR; PG8_WAIT_L(0); PG8_MMA(0, 0, At, B0); PG8_BAR; PG8_SCHED;
            PG8_LDB(B1, 1, 1); PG8_STAGE(PG8_SB(1, 0), b3, voffB);
            PG8_BAR; PG8_WAIT_L(0); PG8_MMA(0, 1, At, B1); PG8_BAR;
            PG8_LDA(At, 1, 1); PG8_STAGE(PG8_SA(1, 0), a3, va[0]);
            PG8_BAR; PG8_WAIT_L(0); PG8_MMA(1, 0, At, B0); PG8_BAR; PG8_SCHED;
            PG8_STAGE(PG8_SB(1, 1), b3 + hstep, voffB);
            PG8_WAIT_V(6); PG8_BAR; PG8_MMA(1, 1, At, B1); PG8_BAR;
            }
        }
        if constexpr (ALIGN_EPI) { if (wr == 0) PG8_BAR; }
        E(acc, cur, wr, wc, fr, fq);
        if (!has_next) break;
#pragma unroll
        for (int a = 0; a < 2; ++a)
#pragma unroll
            for (int b = 0; b < 2; ++b)
#pragma unroll
                for (int m = 0; m < 4; ++m)
#pragma unroll
                    for (int n = 0; n < 2; ++n) acc[a][b][m][n] = (f32x4){0.f, 0.f, 0.f, 0.f};
        cur = nxt; cB = nB; ++ui;
        if constexpr (ALIGN_EPI) { if (wr == 1) PG8_BAR; }
    }
    PG8_WAIT_V(0);
    if constexpr (!ALIGN_EPI) { if (wr == 0) PG8_BAR; }
    PG8_BAR;
#undef PG8_SA
#undef PG8_SB
#undef PG8_STAGE
#undef PG8_LDA
#undef PG8_LDB
#undef PG8_MMA
#undef PG8_WAIT_V
#undef PG8_WAIT_L
#undef PG8_BAR
#undef PG8_SCHED
#undef PG8_VOFF
}
}

#define XB_TMO      128
#define XB_XCNT(j)  (256  + 64 * (j))
#define XB_XSUB(j)  (1280 + 64 * (j))
#define XB_XGEN(j)  (2304 + 64 * (j))
#define XB_TOP      3328
#define XB_TOPGEN   3392
#define XCD_BAR_WORDS 3456
#define XB_SPIN_CAP (1u << 18)

__device__ __forceinline__ unsigned xb_ld(unsigned* p)              { return __hip_atomic_load(p, __ATOMIC_RELAXED, __HIP_MEMORY_SCOPE_AGENT); }
__device__ __forceinline__ unsigned xb_add(unsigned* p, unsigned v) { return __hip_atomic_fetch_add(p, v, __ATOMIC_RELAXED, __HIP_MEMORY_SCOPE_AGENT); }
__device__ __forceinline__ unsigned xb_xcc_id() { return (unsigned)__builtin_amdgcn_s_getreg((3 << 11) | 20) & 0xFu; }
#define XB_SPIN(cond, bar) do { unsigned _sp = 0; while (cond) { __builtin_amdgcn_s_sleep(1); \
    if ((++_sp & 255u) == 0u) { if (xb_ld(&(bar)[XB_TMO])) break; if (_sp > XB_SPIN_CAP) { atomicAdd(&(bar)[XB_TMO], 1u); break; } } } } while (0)

struct XcdBarrier {
    unsigned* bar; unsigned x;
    volatile LAS unsigned* st;
};
__device__ __forceinline__ XcdBarrier xcd_barrier_post(unsigned* bar, volatile LAS unsigned* st) {
    XcdBarrier b; b.bar = bar; b.x = xb_xcc_id(); b.st = st;
    if (threadIdx.x == 0) (void)xb_add(&bar[XB_XCNT(b.x)], 1u);
    return b;
}
__device__ __forceinline__ void xcd_barrier_complete(unsigned* bar, unsigned x, unsigned& nloc, unsigned& nx) {
    const unsigned G = gridDim.x * gridDim.y * gridDim.z;
    unsigned sum, cnt, mine, sp = 0u;
    for (;;) {
        sum = 0u; cnt = 0u; mine = 0u;
#pragma unroll
        for (unsigned j = 0; j < 16; ++j) { const unsigned c = xb_ld(&bar[XB_XCNT(j)]); sum += c; cnt += (c > 0u) ? 1u : 0u; mine = (j == x) ? c : mine; }
        if (sum == G) break;
        __builtin_amdgcn_s_sleep(1);
        if ((++sp & 255u) == 0u) { if (xb_ld(&bar[XB_TMO])) break; if (sp > XB_SPIN_CAP) { atomicAdd(&bar[XB_TMO], 1u); break; } }
    }
    nloc = mine > 0u ? mine : 1u; nx = cnt > 0u ? cnt : 1u;
}
__device__ __forceinline__ void xcd_barrier(const XcdBarrier& b) {
    asm volatile("s_waitcnt vmcnt(0)" ::: "memory");
    __syncthreads();
    if (threadIdx.x == 0) {
        unsigned* bar = b.bar;
        __builtin_amdgcn_s_waitcnt(0);
        unsigned nloc = b.st[0], nx = b.st[1];
        if (nloc == 0u) { xcd_barrier_complete(bar, b.x, nloc, nx); b.st[0] = nloc; b.st[1] = nx; }
        const unsigned old = xb_add(&bar[XB_XSUB(b.x)], 1u);
        const unsigned gen = old / nloc;
        if (old + 1u == (gen + 1u) * nloc) {
            __builtin_amdgcn_fence(__ATOMIC_RELEASE, "agent");
            asm volatile("s_waitcnt vmcnt(0)" ::: "memory");
            const unsigned og = xb_add(&bar[XB_TOP], 1u);
            const unsigned tg = og / nx;
            if (og + 1u == (tg + 1u) * nx) xb_add(&bar[XB_TOPGEN], 1u);
            else XB_SPIN(xb_ld(&bar[XB_TOPGEN]) == tg, bar);
            __builtin_amdgcn_fence(__ATOMIC_ACQUIRE, "agent");
            xb_add(&bar[XB_XGEN(b.x)], 1u);
            asm volatile("s_waitcnt vmcnt(0)" ::: "memory");
        } else {
            XB_SPIN(xb_ld(&bar[XB_XGEN(b.x)]) == gen, bar);
            __builtin_amdgcn_fence(__ATOMIC_ACQUIRE, "agent");
            asm volatile("s_waitcnt vmcnt(0)" ::: "memory");
        }
    }
    __syncthreads();
}

constexpr int NWAVES = 8, NTHREADS = 512;
struct Args { const float* in[19]; float* out; unsigned char* ws; int ph_lo, ph_hi; };
enum { I_X = 0, I_META, I_MIXNW, I_WIN, I_CONVW, I_ALOG, I_DTB, I_GDNNW, I_SBQNW, I_SBKNW, I_SBONW, I_WOUT, I_FFNNW, I_RW, I_RB, I_WGU, I_BGU, I_WD, I_BD };

#define LDS_WAIT() asm volatile("s_waitcnt lgkmcnt(0)" ::: "memory")
#define VM_WAIT() asm volatile("s_waitcnt vmcnt(0)" ::: "memory")
constexpr int WLS = 2052;

__device__ __forceinline__ void dot16(const f32x4 (&v)[8], const LAS float* wl, int lane, float (&s)[16]) {
#pragma unroll
    for (int c = 0; c < 16; ++c) { float a = 0.f;
#pragma unroll
        for (int j = 0; j < 8; ++j) { const f32x4 w = *(const LAS f32x4*)(wl + c * WLS + 4 * lane + 256 * j); a += (v[j].x * w.x + v[j].y * w.y) + (v[j].z * w.z + v[j].w * w.w); }
        s[c] = wave_sum(a); }
}

__device__ __forceinline__ void stage_w16(LAS float* wl, const float* base, int ld, int coloff, int tid) {
#pragma unroll 4
    for (int idx = tid; idx < 2048 * 4; idx += NTHREADS) { const int k = idx >> 2, q = idx & 3; const f32x4 v = *(const f32x4*)(base + (size_t)k * ld + coloff + 4 * q);
        wl[(4 * q + 0) * WLS + k] = v.x; wl[(4 * q + 1) * WLS + k] = v.y; wl[(4 * q + 2) * WLS + k] = v.z; wl[(4 * q + 3) * WLS + k] = v.w; }
}

__device__ __forceinline__ void p0_rows(const Args& a, LAS unsigned char* lds, int gw, int NGW, int tid, int lane) {
    const float* x = a.in[I_X]; const float* meta = a.in[I_META]; const float* nw = a.in[I_MIXNW]; const float* win = a.in[I_WIN];
    LAS float* wl = (LAS float*)lds;
    stage_w16(wl, win, NPROJ_SRC, 4096, tid);
    __syncthreads();
    bf16_t* HN = (bf16_t*)(a.ws + WS_HN); float* BETA = (float*)(a.ws + WS_BETA); float* GG = (float*)(a.ws + WS_G);
    f32x4 wn[8];
#pragma unroll
    for (int j = 0; j < 8; ++j) wn[j] = *((const f32x4*)nw + lane + 64 * j);
    const int hh = lane & 7;
    const float alog = a.in[I_ALOG][hh], dtb = a.in[I_DTB][hh];
    for (int row = gw; row < MPAD; row += NGW) {
        GAS unsigned long long* o8 = (GAS unsigned long long*)(HN + (size_t)row * DM) + lane;
        if (row >= NTOK) {
#pragma unroll
            for (int j = 0; j < 8; ++j) o8[64 * j] = 0ull;
            continue; }
        const int b = row / LSEQ, t = row - b * LSEQ;
        const float* src = (t < NMETA) ? meta + (size_t)t * DM : x + ((size_t)b * SEQ + (t - NMETA)) * DM;
        f32x4 v[8]; float ss = 0.f;
#pragma unroll
        for (int j = 0; j < 8; ++j) { v[j] = *((const f32x4*)src + lane + 64 * j); ss += (v[j].x * v[j].x + v[j].y * v[j].y) + (v[j].z * v[j].z + v[j].w * v[j].w); }
        const float rstd = 1.0f / sqrtf(wave_sum(ss) * (1.0f / DM) + NORM_EPS);
#pragma unroll
        for (int j = 0; j < 8; ++j) { v[j] = v[j] * rstd * wn[j];
            o8[64 * j] = (unsigned long long)cvt_pk_bf16(v[j].x, v[j].y) | ((unsigned long long)cvt_pk_bf16(v[j].z, v[j].w) << 32); }
        float s[16]; dot16(v, wl, lane, s);
        float bv = s[0], av = s[8];
#pragma unroll
        for (int c = 1; c < 8; ++c) { bv = (hh == c) ? s[c] : bv; av = (hh == c) ? s[8 + c] : av; }
        if (lane < 8) {
            const float beta = 1.0f / (1.0f + expf(-bv));
            const float xa = av + dtb; const float sp = fmaxf(xa, 0.f) + log1pf(expf(-fabsf(xa)));
            BETA[(size_t)row * 8 + hh] = beta; GG[(size_t)row * 8 + hh] = -expf(alog) * sp; }
    }
    __syncthreads();
}

constexpr int CVT_STR = 132;
template <int MODE  >
__device__ __forceinline__ void cvt_tile(const float* W, int ldw, int K, bf16_t* out, int kb, int nt, LAS unsigned char* T, int lane) {
    const int r0 = nt * 64;
    int c0;
    if (MODE == 0) c0 = r0;
    else if (MODE == 1) c0 = r0 < 4096 ? r0 : r0 + 16;
    else { const int pn = r0 >> 8, rr = r0 & 255; c0 = rr < 128 ? 128 * pn + rr : 2048 + 128 * pn + (rr - 128); }
    const int kq = lane >> 4, nl = lane & 15;
    const float* src = W + (size_t)(kb * 64 + 2 * kq) * ldw + c0 + 4 * nl;
    f32x4 v[8][2];
#pragma unroll
    for (int i = 0; i < 8; ++i)
#pragma unroll
        for (int j = 0; j < 2; ++j) v[i][j] = *(const f32x4*)(src + (size_t)(8 * i + j) * ldw);
    LAS unsigned char* tw = T + (4 * nl) * CVT_STR + 4 * kq;
#pragma unroll
    for (int i = 0; i < 8; ++i)
#pragma unroll
        for (int q = 0; q < 4; ++q) *(LAS unsigned*)(tw + q * CVT_STR + 16 * i) = cvt_pk_bf16(v[i][0][q], v[i][1][q]);
    LDS_WAIT();
    const int rn = lane >> 3, cc = lane & 7;
    const LAS unsigned char* tr = T + rn * CVT_STR + 16 * cc;
    bf16_t* dst = out + (size_t)(r0 + rn) * K + kb * 64 + 8 * cc;
#pragma unroll
    for (int j = 0; j < 8; ++j) { u32x4 w; const LAS unsigned* p = (const LAS unsigned*)(tr + 8 * j * CVT_STR); w.x = p[0]; w.y = p[1]; w.z = p[2]; w.w = p[3];
        *(u32x4*)(dst + (size_t)(8 * j) * K) = w; }
    LDS_WAIT();
}
constexpr float W8_SCALE = 64.0f;
template <int MODE>
__device__ __forceinline__ void cvt_tile_fp8(const float* W, int ldw, int K, unsigned char* out, int kb, int nt, LAS unsigned char* T, int lane) {
    const int r0 = nt * 64;
    int c0;
    if (MODE == 0) c0 = r0;
    else { const int pn = r0 >> 8, rr = r0 & 255; c0 = rr < 128 ? 128 * pn + rr : 2048 + 128 * pn + (rr - 128); }
    const int kq = lane >> 4, nl = lane & 15;
    LAS unsigned char* tw = T + (4 * nl) * CVT_STR + 4 * kq;
#pragma unroll
    for (int half = 0; half < 2; ++half) {
        const float* src = W + (size_t)(kb * 128 + half * 64 + 4 * kq) * ldw + c0 + 4 * nl;
        f32x4 v[4][4];
#pragma unroll
        for (int i = 0; i < 4; ++i)
#pragma unroll
            for (int j = 0; j < 4; ++j) v[i][j] = *(const f32x4*)(src + (size_t)(16 * i + j) * ldw);
#pragma unroll
        for (int i = 0; i < 4; ++i)
#pragma unroll
            for (int q = 0; q < 4; ++q) *(LAS unsigned*)(tw + q * CVT_STR + 64 * half + 16 * i) =
                pk4_fp8(v[i][0][q] * W8_SCALE, v[i][1][q] * W8_SCALE, v[i][2][q] * W8_SCALE, v[i][3][q] * W8_SCALE);
    }
    LDS_WAIT();
    const int rn = lane >> 3, cc = lane & 7;
    const LAS unsigned char* tr = T + rn * CVT_STR + 16 * cc;
    unsigned char* dst = out + (size_t)(r0 + rn) * K + kb * 128 + 16 * cc;
#pragma unroll
    for (int j = 0; j < 8; ++j) { u32x4 w; const LAS unsigned* p = (const LAS unsigned*)(tr + 8 * j * CVT_STR); w.x = p[0]; w.y = p[1]; w.z = p[2]; w.w = p[3];
        *(u32x4*)(dst + (size_t)(8 * j) * K) = w; }
    LDS_WAIT();
}
__device__ __forceinline__ void p0_weights(const Args& a, LAS unsigned char* lds, int vcu, int G, int wave, int lane) {
    constexpr int I_IN = 32 * 14, I_OUT = 32 * 4, I_GU = 16 * 8, I_D = 16 * 4;
    constexpr int NITEMS = I_IN + I_OUT + NEXP * (I_GU + I_D);
    LAS unsigned char* T = lds + wave * (64 * CVT_STR);
    for (int it = vcu; it < NITEMS; it += G) {
        int r = it;
        if (r < I_IN) { cvt_tile<1>(a.in[I_WIN], NPROJ_SRC, DM, (bf16_t*)(a.ws + WS_WIN), r / 14, (r % 14) * 8 + wave, T, lane); continue; } r -= I_IN;
        if (r < I_OUT) { cvt_tile<0>(a.in[I_WOUT], DM, DM, (bf16_t*)(a.ws + WS_WOUT), r / 4, (r % 4) * 8 + wave, T, lane); continue; } r -= I_OUT;
        if (r < NEXP * I_GU) { const int e = r / I_GU, q = r % I_GU;
            cvt_tile_fp8<2>(a.in[I_WGU] + (size_t)e * DM * 2 * DE, 2 * DE, DM, a.ws + WS_WGU + (size_t)e * 2 * DE * DM, q / 8, (q % 8) * 8 + wave, T, lane); continue; } r -= NEXP * I_GU;
        { const int e = r / I_D, q = r % I_D;
            cvt_tile_fp8<0>(a.in[I_WD] + (size_t)e * DE * DM, DM, DE, a.ws + WS_WD + (size_t)e * DM * DE, q / 4, (q % 4) * 8 + wave, T, lane); }
    }
}

__device__ __forceinline__ void p2_qknorm(const Args& a, int gw, int NGW, int lane) {
    const bf16_t* P = (const bf16_t*)(a.ws + WS_P); bf16_t* QN = (bf16_t*)(a.ws + WS_QN); bf16_t* KN = (bf16_t*)(a.ws + WS_KN);
    const float qw0 = a.in[I_SBQNW][2 * lane], qw1 = a.in[I_SBQNW][2 * lane + 1], kw0 = a.in[I_SBKNW][2 * lane], kw1 = a.in[I_SBKNW][2 * lane + 1];
    const float QS = 0.08838834764831845f * 1.4426950408889634f;
    for (int it = gw; it < NTOK * NHEAD * 2; it += NGW) {
        const int which = it & 1, h = (it >> 1) & 7, row = it >> 4;
        const int b = row / LSEQ, t = row - b * LSEQ;
        const unsigned w = *(const unsigned*)(P + (size_t)row * NPROJ + (which ? PC_SBK : PC_SBQ) + h * HD + 2 * lane);
        const float v0 = bf_lo(w), v1 = bf_hi(w);
        const float rstd = 1.0f / sqrtf(wave_sum(v0 * v0 + v1 * v1) * (1.0f / HD) + NORM_EPS);
        const float o0 = which ? v0 * rstd * kw0 : v0 * rstd * qw0 * QS, o1 = which ? v1 * rstd * kw1 : v1 * rstd * qw1 * QS;
        *(unsigned*)((which ? KN : QN) + ((size_t)(b * NHEAD + h) * LROW + t) * HD + 2 * lane) = cvt_pk_bf16(o0, o1);
    }
}

__device__ __forceinline__ void p3_gdn_naive(const Args& a, LAS unsigned char* lds, int item, int tid, int lane, int wave) {
    const int b = item >> 3, h = item & 7;
    const bf16_t* P = (const bf16_t*)(a.ws + WS_P); const float* BETA = (const float*)(a.ws + WS_BETA); const float* GG = (const float*)(a.ws + WS_G);
    float* ORAW = (float*)(a.ws + WS_ORAW); bf16_t* MIX = (bf16_t*)(a.ws + WS_MIX);
    LAS float* buf = (LAS float*)lds;
    const int j = tid >> 2, part = tid & 3;
    const int which = tid >> 7, d = tid & 127; const bool conv = tid < 384;
    const int pcol = which * 1024 + h * HD + d;
    float cw0 = 0, cw1 = 0, cw2 = 0, cw3 = 0;
    if (conv) { const float* cwp = a.in[I_CONVW] + pcol; cw0 = cwp[0]; cw1 = cwp[3072]; cw2 = cwp[2 * 3072]; cw3 = cwp[3 * 3072]; }
    float xm1 = 0.f, xm2 = 0.f, xm3 = 0.f;
    float S[32];
#pragma unroll
    for (int i = 0; i < 32; ++i) S[i] = 0.f;
    const size_t row0 = (size_t)b * LSEQ;
    float xnext = conv ? bf2f(P[row0 * NPROJ + pcol]) : 0.f;
    float bnext = BETA[row0 * 8 + h], gnext = GG[row0 * 8 + h];
    for (int t = 0; t < LSEQ; ++t) {
        const float xt = xnext, beta = bnext, gam = expf(gnext);
        if (t + 1 < LSEQ) { if (conv) xnext = bf2f(P[(row0 + t + 1) * NPROJ + pcol]); bnext = BETA[(row0 + t + 1) * 8 + h]; gnext = GG[(row0 + t + 1) * 8 + h]; }
        LAS float* cb = buf + (t & 1) * 384;
        if (conv) { const float y = cw3 * xt + cw2 * xm1 + cw1 * xm2 + cw0 * xm3; xm3 = xm2; xm2 = xm1; xm1 = xt; cb[tid] = y / (1.0f + expf(-y)); }
        __syncthreads();
        float kk = 0.f, qq = 0.f, dk = 0.f; f32x4 kv[8], qv[8];
#pragma unroll
        for (int i = 0; i < 8; ++i) { kv[i] = *(const LAS f32x4*)(cb + 128 + 32 * part + 4 * i); qv[i] = *(const LAS f32x4*)(cb + 32 * part + 4 * i); }
#pragma unroll
        for (int i = 0; i < 8; ++i)
#pragma unroll
            for (int c = 0; c < 4; ++c) { kk += kv[i][c] * kv[i][c]; qq += qv[i][c] * qv[i][c]; dk += S[4 * i + c] * kv[i][c]; }
        kk += __shfl_xor(kk, 1); kk += __shfl_xor(kk, 2); qq += __shfl_xor(qq, 1); qq += __shfl_xor(qq, 2); dk += __shfl_xor(dk, 1); dk += __shfl_xor(dk, 2);
        const float rk = 1.0f / sqrtf(kk + NORM_EPS), rq = 0.08838834764831845f / sqrtf(qq + NORM_EPS);
        const float vj = cb[256 + j];
        const float vnew = beta * (vj - gam * rk * dk);
        const float kvn = rk * vnew; float oq = 0.f;
#pragma unroll
        for (int i = 0; i < 8; ++i)
#pragma unroll
            for (int c = 0; c < 4; ++c) { S[4 * i + c] = gam * S[4 * i + c] + kv[i][c] * kvn; oq += S[4 * i + c] * qv[i][c]; }
        oq += __shfl_xor(oq, 1); oq += __shfl_xor(oq, 2);
        if (t >= NMETA && part == 0) ORAW[((size_t)b * SEQ + (t - NMETA)) * 1024 + h * HD + j] = rq * oq;
    }
    __threadfence(); __syncthreads();
    const float nw0 = a.in[I_GDNNW][2 * lane], nw1 = a.in[I_GDNNW][2 * lane + 1];
    for (int s = wave; s < SEQ; s += NWAVES) {
        const size_t tok = (size_t)b * SEQ + s;
        const f32x2 o = *(const f32x2*)(ORAW + tok * 1024 + h * HD + 2 * lane);
        const float rstd = 1.0f / sqrtf(wave_sum(o.x * o.x + o.y * o.y) * (1.0f / HD) + NORM_EPS);
        const unsigned zw = *(const unsigned*)(P + (row0 + NMETA + s) * NPROJ + PC_Z + h * HD + 2 * lane);
        const float z0 = bf_lo(zw), z1 = bf_hi(zw);
        const float r0 = o.x * rstd * nw0 * (z0 / (1.0f + expf(-z0))), r1 = o.y * rstd * nw1 * (z1 / (1.0f + expf(-z1)));
        *(unsigned*)(MIX + tok * DM + h * HD + 2 * lane) = cvt_pk_bf16(r0, r1);
    }
}

__device__ __forceinline__ bf16x8 sba_pack8(const f32x16& p, int base) {
    u32x4 w; w.x = cvt_pk_bf16(p[base + 0], p[base + 1]); w.y = cvt_pk_bf16(p[base + 2], p[base + 3]); w.z = cvt_pk_bf16(p[base + 4], p[base + 5]); w.w = cvt_pk_bf16(p[base + 6], p[base + 7]);
    return __builtin_bit_cast(bf16x8, w);
}

namespace gdn {
constexpr int NCH = 65;
constexpr int IMG_W = 0, IMG_QG = 16384, IMG_KDT = 32768, IMG_AT = 49152, IMG_BYTES = 57344, IMG_U = 57344, CH_BYTES = 73728;
constexpr int L_QB = 0, L_KB = 17408, L_VB = 34816, L_LT = 52224, L_GC = 69632, L_BE = 69888, L_IMG = 70144;
__device__ __forceinline__ int afrag_off(int row, int k, int nks) {
    const int rt = row >> 5, rr = row & 31, ks = k >> 4, kk = k & 15, hi = (kk >> 2) & 1, sl = (kk & 3) + 4 * (kk >> 3);
    return ((rt * nks + ks) * 64 + rr + 32 * hi) * 16 + sl * 2;
}
__device__ __forceinline__ int ufrag_off(int i, int c) {
    const int cg = c >> 5, col = c & 31, rt = i >> 5, ii = i & 31, hi = (ii >> 2) & 1, r = (ii & 3) + 4 * (ii >> 3);
    return (((cg * 2 + rt) * 2 + (r >> 3)) * 64 + col + 32 * hi) * 8 + (r & 7);
}
__device__ __forceinline__ int crow(int r, int hi) { return (r & 3) + 8 * (r >> 2) + 4 * hi; }
__device__ __forceinline__ bf16_t f2bf(float f) { return (bf16_t)(cvt_pk_bf16(f, 0.f) & 0xffffu); }

__device__ __forceinline__ void precompute(const Args& a, LAS unsigned char* lds, int item, int tid, int lane, int wave) {
    asm volatile("" : "+v"(tid), "+v"(lane), "+s"(wave));
    const int bh = item / NCH, c = item - bh * NCH, b = bh >> 3, h = bh & 7;
    const bf16_t* P = (const bf16_t*)(a.ws + WS_P) + (size_t)b * LSEQ * NPROJ;
    const float* BETA = (const float*)(a.ws + WS_BETA) + (size_t)b * LSEQ * 8; const float* GG = (const float*)(a.ws + WS_G) + (size_t)b * LSEQ * 8;
    unsigned char* dst = a.ws + WS_GCH + (size_t)item * CH_BYTES;
    LAS float* GC = (LAS float*)(lds + L_GC); LAS float* BE = (LAS float*)(lds + L_BE); LAS float* LT = (LAS float*)(lds + L_LT);
    const int tbase = 64 * c - 48;
    if (wave == 0) {
        const int t = tbase + lane; float g = 0.f, be = 0.f;
        if (t >= 0) { g = GG[(size_t)t * 8 + h]; be = BETA[(size_t)t * 8 + h]; }
#pragma unroll
        for (int o = 1; o < 64; o <<= 1) { const float y = __shfl_up(g, o); if (lane >= o) g += y; }
        GC[lane] = g; BE[lane] = be;
        if (lane == 63) ((float*)(a.ws + WS_GL))[item] = expf(g);
    }
    {
        f32x2 cw[3][4];
#pragma unroll
        for (int w3 = 0; w3 < 3; ++w3)
#pragma unroll
            for (int tap = 0; tap < 4; ++tap) cw[w3][tap] = *(const f32x2*)(a.in[I_CONVW] + tap * 3072 + w3 * 1024 + h * HD + 2 * lane);
        f32x2 xw[3][11];
#pragma unroll
        for (int j = 0; j < 11; ++j) { const int t = tbase + 8 * wave - 3 + j;
#pragma unroll
            for (int w3 = 0; w3 < 3; ++w3) { unsigned u = 0u; if (t >= 0) u = *(const unsigned*)(P + (size_t)t * NPROJ + w3 * 1024 + h * HD + 2 * lane); xw[w3][j] = (f32x2){bf_lo(u), bf_hi(u)}; } }
#pragma unroll
        for (int rr = 0; rr < 8; ++rr) { const int i = 8 * wave + rr; f32x2 y[3];
#pragma unroll
            for (int w3 = 0; w3 < 3; ++w3) { f32x2 acc = cw[w3][0] * xw[w3][rr] + cw[w3][1] * xw[w3][rr + 1] + cw[w3][2] * xw[w3][rr + 2] + cw[w3][3] * xw[w3][rr + 3];
                acc.x = acc.x / (1.0f + __expf(-acc.x)); acc.y = acc.y / (1.0f + __expf(-acc.y)); y[w3] = acc; }
            const float rq = 0.08838834764831845f / sqrtf(wave_sum(y[0].x * y[0].x + y[0].y * y[0].y) + NORM_EPS);
            const float rk = 1.0f / sqrtf(wave_sum(y[1].x * y[1].x + y[1].y * y[1].y) + NORM_EPS);
            *(LAS unsigned*)(lds + L_QB + i * 272 + 4 * lane) = cvt_pk_bf16(y[0].x * rq, y[0].y * rq);
            *(LAS unsigned*)(lds + L_KB + i * 272 + 4 * lane) = cvt_pk_bf16(y[1].x * rk, y[1].y * rk);
            *(LAS unsigned*)(lds + L_VB + i * 272 + 4 * lane) = cvt_pk_bf16(y[2].x, y[2].y); }
    }
    __syncthreads();
    {
        const int prod = wave >> 2, ti = (wave >> 1) & 1, tj = wave & 1, r32 = lane & 31, hi = lane >> 5;
        if (tj <= ti) {
            f32x16 acc;
#pragma unroll
            for (int r = 0; r < 16; ++r) acc[r] = 0.f;
            const LAS unsigned char* Ab = lds + (prod ? L_QB : L_KB) + (32 * ti + r32) * 272 + hi * 16;
            const LAS unsigned char* Bb = lds + L_KB + (32 * tj + r32) * 272 + hi * 16;
#pragma unroll
            for (int ks = 0; ks < 8; ++ks) acc = __builtin_amdgcn_mfma_f32_32x32x16_bf16(*(const LAS bf16x8*)(Ab + ks * 32), *(const LAS bf16x8*)(Bb + ks * 32), acc, 0, 0, 0);
            const int j = 32 * tj + r32; const float gj = GC[j];
#pragma unroll
            for (int r = 0; r < 16; ++r) { const int i = 32 * ti + crow(r, hi); const float dec = __expf(GC[i] - gj);
                if (prod == 0) LT[j * 68 + i] = (j < i) ? acc[r] * BE[i] * dec : 0.f;
                else *(LAS bf16_t*)(lds + L_IMG + IMG_AT + afrag_off(i, j, 4)) = f2bf((j <= i) ? acc[r] * dec : 0.f); }
        }
    }
    __syncthreads();
    if (tid < 256) {
        float x[64];
        const bool isv = tid < 128; const int cc = tid & 127;
        const LAS unsigned char* src = lds + (isv ? L_VB : L_KB) + cc * 2;
#pragma unroll
        for (int i8 = 0; i8 < 64; i8 += 8) {
#pragma unroll
            for (int q = 0; q < 8; ++q) { const int i = i8 + q; const float v = bf2f(*(const LAS bf16_t*)(src + i * 272)); x[i] = v * BE[i] * (isv ? 1.0f : __expf(GC[i])); }
            asm volatile("" ::: "memory"); }
#pragma unroll
        for (int j = 0; j < 63; ++j) {
#pragma unroll
            for (int i4 = ((j + 1) & ~3); i4 < 64; i4 += 4) { const f32x4 l4 = *(const LAS f32x4*)(LT + j * 68 + i4);
#pragma unroll
                for (int q = 0; q < 4; ++q) if (i4 + q > j) x[i4 + q] -= l4[q] * x[j]; }
            asm volatile("" ::: "memory");
        }
        if (isv) {
            LAS unsigned char* ub = lds + L_IMG + IMG_U + (((cc >> 5) * 4 * 64) + (cc & 31)) * 16;
#pragma unroll
            for (int i = 0; i < 64; ++i) { const int rt = i >> 5, ii = i & 31, hi = (ii >> 2) & 1, r = (ii & 3) + 4 * (ii >> 3);
                *(LAS bf16_t*)(ub + (((rt * 2 + (r >> 3)) * 64 + 32 * hi) * 8 + (r & 7)) * 2) = f2bf(x[i]); }
        } else {
            const int ks = cc >> 4, kk = cc & 15, hi = (kk >> 2) & 1, sl = (kk & 3) + 4 * (kk >> 3);
            LAS unsigned char* wb = lds + L_IMG + IMG_W + (ks * 64 + 32 * hi) * 16 + sl * 2;
#pragma unroll
            for (int i = 0; i < 64; ++i) *(LAS bf16_t*)(wb + ((i >> 5) * 8 * 64 + (i & 31)) * 16) = f2bf(-x[i]);
        }
    } else {
        const int u = tid - 256, dk = u & 127, i0 = (u >> 7) * 32; const float gl = GC[63];
#pragma unroll 4
        for (int ii = 0; ii < 32; ++ii) { const int i = i0 + ii; const float gi = GC[i];
            const float q = bf2f(*(const LAS bf16_t*)(lds + L_QB + i * 272 + dk * 2)), k = bf2f(*(const LAS bf16_t*)(lds + L_KB + i * 272 + dk * 2));
            *(LAS bf16_t*)(lds + L_IMG + IMG_QG + afrag_off(i, dk, 8)) = f2bf(q * __expf(gi));
            *(LAS bf16_t*)(lds + L_IMG + IMG_KDT + afrag_off(dk, i, 4)) = f2bf(k * __expf(gl - gi)); }
    }
    __syncthreads();
    for (int q = tid; q < CH_BYTES / 16; q += NTHREADS) *(u32x4*)(dst + (size_t)q * 16) = *(const LAS u32x4*)(lds + L_IMG + q * 16);
}

constexpr int OB_OFF = 2 * IMG_BYTES, OB_STR = 264, OB_BYTES = 64 * OB_STR;
__device__ __forceinline__ void gated_rows(const Args& a, const LAS unsigned char* ob, int b, int h, int cc, int w4, int lane, float nw0, float nw1) {
    const bf16_t* P = (const bf16_t*)(a.ws + WS_P); bf16_t* MIX = (bf16_t*)(a.ws + WS_MIX);
    const int s0 = 64 * (cc - 1) + 16 * w4;
    unsigned zw[16];
#pragma unroll
    for (int rr = 0; rr < 16; ++rr) zw[rr] = *(const unsigned*)(P + ((size_t)b * LSEQ + NMETA + s0 + rr) * NPROJ + PC_Z + h * HD + 2 * lane);
#pragma unroll
    for (int rr = 0; rr < 16; ++rr) {
        const unsigned ov = *(const LAS unsigned*)(ob + (16 * w4 + rr) * OB_STR + 4 * lane);
        const float o0 = bf_lo(ov), o1 = bf_hi(ov);
        const float rstd = 1.0f / sqrtf(wave_sum(o0 * o0 + o1 * o1) * (1.0f / HD) + NORM_EPS);
        const float z0 = bf_lo(zw[rr]), z1 = bf_hi(zw[rr]);
        const float r0 = o0 * rstd * nw0 * (z0 / (1.0f + __expf(-z0))), r1 = o1 * rstd * nw1 * (z1 / (1.0f + __expf(-z1)));
        *(unsigned*)(MIX + ((size_t)b * SEQ + s0 + rr) * DM + h * HD + 2 * lane) = cvt_pk_bf16(r0, r1);
    }
}

__device__ __forceinline__ void scan(const Args& a, LAS unsigned char* lds, int bh, int tid, int lane, int wave) {
    const int b = bh >> 3, h = bh & 7, col = lane & 31, hi = lane >> 5, cg = wave;
    const unsigned char* src = a.ws + WS_GCH + (size_t)bh * NCH * CH_BYTES;
    const float* GL = (const float*)(a.ws + WS_GL) + bh * NCH;
    const float nw0 = a.in[I_GDNNW][2 * lane], nw1 = a.in[I_GDNNW][2 * lane + 1];
    __syncthreads();
    const unsigned dvoff = (unsigned)(wave * 1024 + lane * 16), uvoff = (unsigned)(lane * 16);
#define GDN_DMA(ch, buf) do { const unsigned char* _sp = src + (size_t)(ch) * CH_BYTES; _Pragma("unroll") for (int _f = 0; _f < 7; ++_f) { \
        __builtin_amdgcn_global_load_lds((const unsigned*)(_sp + _f * 8192 + dvoff), (LAS unsigned*)(lds + (buf) * IMG_BYTES + wave * 1024 + _f * 8192), 16, 0, 0); } } while (0)
    GDN_DMA(0, 0);
    f32x16 st[4]; bf16x8 Sb[8]; u32x4 ureg[4]; float gl = 1.f;
#pragma unroll
    for (int t4 = 0; t4 < 4; ++t4)
#pragma unroll
        for (int r = 0; r < 16; ++r) st[t4][r] = 0.f;
#pragma unroll
    for (int ks = 0; ks < 8; ++ks) Sb[ks] = (bf16x8){0, 0, 0, 0, 0, 0, 0, 0};
    if (wave < 4) {
#pragma unroll
        for (int q = 0; q < 4; ++q) ureg[q] = *(const u32x4*)(src + IMG_U + cg * 4096 + q * 1024 + uvoff);
        gl = GL[0];
    }
    VM_WAIT(); __syncthreads();
    for (int c = 0; c < NCH; ++c) {
        const LAS unsigned char* img = lds + (c & 1) * IMG_BYTES + lane * 16;
        if (c + 1 < NCH) GDN_DMA(c + 1, (c + 1) & 1);
        if (wave < 4) {
            f32x16 vn[2]; const float glc = gl;
#pragma unroll
            for (int rt = 0; rt < 2; ++rt)
#pragma unroll
                for (int rh = 0; rh < 2; ++rh) { const u32x4 w = ureg[rt * 2 + rh];
                    vn[rt][8 * rh + 0] = bf_lo(w.x); vn[rt][8 * rh + 1] = bf_hi(w.x); vn[rt][8 * rh + 2] = bf_lo(w.y); vn[rt][8 * rh + 3] = bf_hi(w.y);
                    vn[rt][8 * rh + 4] = bf_lo(w.z); vn[rt][8 * rh + 5] = bf_hi(w.z); vn[rt][8 * rh + 6] = bf_lo(w.w); vn[rt][8 * rh + 7] = bf_hi(w.w); }
            asm volatile("" ::: "memory");
            if (c + 1 < NCH) {
#pragma unroll
                for (int q = 0; q < 4; ++q) ureg[q] = *(const u32x4*)(src + (size_t)(c + 1) * CH_BYTES + IMG_U + cg * 4096 + q * 1024 + uvoff);
                gl = GL[c + 1]; }
#pragma unroll
            for (int rt = 0; rt < 2; ++rt) { __builtin_amdgcn_sched_barrier(0);
#pragma unroll
                for (int ks = 0; ks < 8; ++ks) vn[rt] = __builtin_amdgcn_mfma_f32_32x32x16_bf16(*(const LAS bf16x8*)(img + IMG_W + (rt * 8 + ks) * 1024), Sb[ks], vn[rt], 0, 0, 0); }
            __builtin_amdgcn_sched_barrier(0);
            bf16x8 vb[4];
#pragma unroll
            for (int ks = 0; ks < 4; ++ks) vb[ks] = sba_pack8(vn[ks >> 1], 8 * (ks & 1));
            LAS unsigned char* obw = lds + OB_OFF + (c & 1) * OB_BYTES + (32 * cg + col) * 2;
#pragma unroll
            for (int rt = 0; rt < 2; ++rt) { f32x16 o; __builtin_amdgcn_sched_barrier(0);
#pragma unroll
                for (int r = 0; r < 16; ++r) o[r] = 0.f;
#pragma unroll
                for (int ks = 0; ks < 8; ++ks) o = __builtin_amdgcn_mfma_f32_32x32x16_bf16(*(const LAS bf16x8*)(img + IMG_QG + (rt * 8 + ks) * 1024), Sb[ks], o, 0, 0, 0);
#pragma unroll
                for (int ks = 0; ks < 2 * (rt + 1); ++ks) o = __builtin_amdgcn_mfma_f32_32x32x16_bf16(*(const LAS bf16x8*)(img + IMG_AT + (rt * 4 + ks) * 1024), vb[ks], o, 0, 0, 0);
                if (c >= 1) {
#pragma unroll
                    for (int r = 0; r < 16; ++r) *(LAS bf16_t*)(obw + (32 * rt + crow(r, hi)) * OB_STR) = f2bf(o[r]); }
            }
#pragma unroll
            for (int t4 = 0; t4 < 4; ++t4) { __builtin_amdgcn_sched_barrier(0);
#pragma unroll
                for (int r = 0; r < 16; ++r) st[t4][r] *= glc;
#pragma unroll
                for (int ks = 0; ks < 4; ++ks) st[t4] = __builtin_amdgcn_mfma_f32_32x32x16_bf16(*(const LAS bf16x8*)(img + IMG_KDT + (t4 * 4 + ks) * 1024), vb[ks], st[t4], 0, 0, 0);
                Sb[2 * t4] = sba_pack8(st[t4], 0); Sb[2 * t4 + 1] = sba_pack8(st[t4], 8); }
        }
        else if (c >= 2) gated_rows(a, lds + OB_OFF + ((c - 1) & 1) * OB_BYTES, b, h, c - 1, wave - 4, lane, nw0, nw1);
        VM_WAIT(); __syncthreads();
    }
#undef GDN_DMA
    if (wave >= 4) gated_rows(a, lds + OB_OFF + ((NCH - 1) & 1) * OB_BYTES, b, h, NCH - 1, wave - 4, lane, nw0, nw1);
}
}

namespace sba {
#define KSWZ(row, colB) ((row) * 256 + ((colB) ^ (((row) & 7) << 4)))
__device__ __forceinline__ int v_st(int k, int c) { const int kk = (k & ~0xC) | ((k & 4) << 1) | ((k & 8) >> 1); return ((kk >> 3) * 4 + (c >> 5)) * 512 + ((kk & 7) * 32 + (c & 31)) * 2; }
__device__ __forceinline__ int v_rd_base(int lane) { return ((lane & 3) << 3) | (((lane >> 2) & 3) << 6) | (((lane >> 4) & 1) << 5) | (((lane >> 5) & 1) << 8); }
constexpr int v_rd_off(int d0, int ks, int half) { return d0 * 512 + ks * 4096 + half * 2048; }
template <int OFF> __device__ __forceinline__ s16x4 tr_read(int vb) { s16x4 r; asm volatile("ds_read_b64_tr_b16 %0, %1 offset:%2" : "=&v"(r) : "v"(vb), "i"(OFF) : "memory"); return r; }
template <int D0> __device__ __forceinline__ void pv_one(f32x16& od, int vb, bf16x8 pa0, bf16x8 pa1, bf16x8 pa2, bf16x8 pa3) {
    const s16x4 l0 = tr_read<v_rd_off(D0, 0, 0)>(vb), h0 = tr_read<v_rd_off(D0, 0, 1)>(vb), l1 = tr_read<v_rd_off(D0, 1, 0)>(vb), h1 = tr_read<v_rd_off(D0, 1, 1)>(vb);
    const s16x4 l2 = tr_read<v_rd_off(D0, 2, 0)>(vb), h2 = tr_read<v_rd_off(D0, 2, 1)>(vb), l3 = tr_read<v_rd_off(D0, 3, 0)>(vb), h3 = tr_read<v_rd_off(D0, 3, 1)>(vb);
    asm volatile("s_waitcnt lgkmcnt(0)" ::: "memory"); __builtin_amdgcn_sched_barrier(0);
#define PK(L, H) (bf16x8){L[0], L[1], L[2], L[3], H[0], H[1], H[2], H[3]}
    od = __builtin_amdgcn_mfma_f32_32x32x16_bf16(pa0, PK(l0, h0), od, 0, 0, 0);
    od = __builtin_amdgcn_mfma_f32_32x32x16_bf16(pa1, PK(l1, h1), od, 0, 0, 0);
    od = __builtin_amdgcn_mfma_f32_32x32x16_bf16(pa2, PK(l2, h2), od, 0, 0, 0);
    od = __builtin_amdgcn_mfma_f32_32x32x16_bf16(pa3, PK(l3, h3), od, 0, 0, 0);
#undef PK
}
__device__ __forceinline__ int crow(int r, int hi) { return (r & 3) + 8 * (r >> 2) + 4 * hi; }
__device__ __forceinline__ int swap34(int k) { return (k & ~0x18) | ((k & 8) << 1) | ((k & 16) >> 1); }
__device__ __forceinline__ bf16x8 pack8(const f32x16& p, int base) {
    u32x4 w; w.x = cvt_pk_bf16(p[base + 0], p[base + 1]); w.y = cvt_pk_bf16(p[base + 2], p[base + 3]); w.z = cvt_pk_bf16(p[base + 4], p[base + 5]); w.w = cvt_pk_bf16(p[base + 6], p[base + 7]);
    return __builtin_bit_cast(bf16x8, w);
}
constexpr float SB_EXIT = 160.0f;

__device__ __forceinline__ void unit(const Args& a, LAS unsigned char* lds, volatile LAS int* done_cnt, int b, int h, int qb, int tid, int lane, int wid) {
    const bf16_t* QN = (const bf16_t*)(a.ws + WS_QN) + (size_t)(b * NHEAD + h) * LROW * HD;
    const bf16_t* KN = (const bf16_t*)(a.ws + WS_KN) + (size_t)(b * NHEAD + h) * LROW * HD;
    const bf16_t* Vp = (const bf16_t*)(a.ws + WS_P) + (size_t)b * LSEQ * NPROJ + PC_SBV + h * HD;
    bf16_t* MIX = (bf16_t*)(a.ws + WS_MIX);
    const int r32 = lane & 31, hi = lane >> 5;
    LAS unsigned char* K_lds = lds; LAS unsigned char* V_lds = lds + 16384;
    const int tq0 = NMETA + 256 * qb + 32 * wid, tq = tq0 + r32;
    __syncthreads();
    if (tid == 0) *done_cnt = 0;
    bf16x8 qr[8];
#pragma unroll
    for (int d0 = 0; d0 < 8; ++d0) qr[d0] = *(const bf16x8*)(QN + (size_t)tq * HD + d0 * 16 + hi * 8);
    const int sr = tid >> 4, sc = (tid & 15) * 8;
    const int vst0 = v_st(swap34(sr), sc), vst1 = v_st(32 + swap34(sr), sc);
    const int kst0 = KSWZ(sr, sc * 2), kst1 = KSWZ(32 + sr, sc * 2);
    const int vb0 = (int)(unsigned)(unsigned long)V_lds + v_rd_base(lane);
    const int prow = (r32 & 3) + 4 * (r32 >> 3) + 16 * ((r32 >> 2) & 1);
    f32x16 o[4];
#pragma unroll
    for (int d = 0; d < 4; ++d)
#pragma unroll
        for (int r = 0; r < 16; ++r) o[d][r] = 0.f;
    float carry = 0.f; bool flagged = false;
    for (int kt = 4 * qb + 4; kt >= 0; --kt) {
        const int k0 = 64 * kt;
        const bf16x8 ks0 = *(const bf16x8*)(KN + (size_t)(k0 + sr) * HD + sc), ks1 = *(const bf16x8*)(KN + (size_t)(k0 + 32 + sr) * HD + sc);
        const bf16x8 vs0 = *(const bf16x8*)(Vp + (size_t)(k0 + sr) * NPROJ + sc), vs1 = *(const bf16x8*)(Vp + (size_t)(k0 + 32 + sr) * NPROJ + sc);
        __syncthreads();
        if (*done_cnt == NWAVES) break;
        *(LAS bf16x8*)(K_lds + kst0) = ks0; *(LAS bf16x8*)(K_lds + kst1) = ks1; *(LAS bf16x8*)(V_lds + vst0) = vs0; *(LAS bf16x8*)(V_lds + vst1) = vs1;
        __syncthreads();
        if (k0 >= tq0 + 32) continue;
        f32x16 p0, p1;
#pragma unroll
        for (int r = 0; r < 16; ++r) { p0[r] = 0.f; p1[r] = 0.f; }
#pragma unroll
        for (int d0 = 0; d0 < 8; ++d0) { const int cb = (d0 * 16 + hi * 8) * 2;
            const bf16x8 b0 = *(const LAS bf16x8*)(K_lds + KSWZ(prow, cb)), b1 = *(const LAS bf16x8*)(K_lds + KSWZ(32 + prow, cb));
            p0 = __builtin_amdgcn_mfma_f32_32x32x16_bf16(b0, qr[d0], p0, 0, 0, 0);
            p1 = __builtin_amdgcn_mfma_f32_32x32x16_bf16(b1, qr[d0], p1, 0, 0, 0); }
        const bool need_mask = (k0 + 63 >= tq0);
        f32x16 s0, s1; float t0 = 0.f, t1 = 0.f;
#pragma unroll
        for (int r = 0; r < 16; ++r) {
            float e0 = __builtin_amdgcn_exp2f(p0[r]), e1 = __builtin_amdgcn_exp2f(p1[r]);
            float q0 = __builtin_amdgcn_logf(1.0f + e0), q1 = __builtin_amdgcn_logf(1.0f + e1);
            if (need_mask) { const bool v0 = (k0 + 16 * hi + r) < tq, v1 = (k0 + 32 + 16 * hi + r) < tq; e0 = v0 ? e0 : 0.f; q0 = v0 ? q0 : 0.f; e1 = v1 ? e1 : 0.f; q1 = v1 ? q1 : 0.f; }
            p0[r] = e0; p1[r] = e1; s0[r] = q0; s1[r] = q1; t0 += q0; t1 += q1; }
        float t1lo, t1hi, t0lo, t0hi;
        { auto rr = __builtin_amdgcn_permlane32_swap(__float_as_uint(t1), __float_as_uint(t1), false, false); t1lo = __uint_as_float(rr[0]); t1hi = __uint_as_float(rr[1]); }
        { auto rr = __builtin_amdgcn_permlane32_swap(__float_as_uint(t0), __float_as_uint(t0), false, false); t0lo = __uint_as_float(rr[0]); t0hi = __uint_as_float(rr[1]); }
        float run1 = carry + (hi ? 0.f : t1hi), run0 = carry + (t1lo + t1hi) + (hi ? 0.f : t0hi);
#pragma unroll
        for (int r = 15; r >= 0; --r) { run1 += s1[r]; p1[r] = p1[r] * __builtin_amdgcn_exp2f(-run1); run0 += s0[r]; p0[r] = p0[r] * __builtin_amdgcn_exp2f(-run0); }
        carry += (t1lo + t1hi) + (t0lo + t0hi);
        const bf16x8 pa0 = pack8(p0, 0), pa1 = pack8(p0, 8), pa2 = pack8(p1, 0), pa3 = pack8(p1, 8);
        pv_one<0>(o[0], vb0, pa0, pa1, pa2, pa3); pv_one<1>(o[1], vb0, pa0, pa1, pa2, pa3); pv_one<2>(o[2], vb0, pa0, pa1, pa2, pa3); pv_one<3>(o[3], vb0, pa0, pa1, pa2, pa3);
        if (!flagged && __all(carry >= SB_EXIT)) { flagged = true; if (lane == 0) (void)__hip_atomic_fetch_add((LAS int*)done_cnt, 1, __ATOMIC_RELAXED, __HIP_MEMORY_SCOPE_WORKGROUP); }
    }
    const float* onw = a.in[I_SBONW];
    float wv[4];
#pragma unroll
    for (int d0 = 0; d0 < 4; ++d0) wv[d0] = onw[32 * d0 + r32];
#pragma unroll
    for (int r = 0; r < 16; ++r) {
        float ss = (o[0][r] * o[0][r] + o[1][r] * o[1][r]) + (o[2][r] * o[2][r] + o[3][r] * o[3][r]);
        ss += __shfl_xor(ss, 1); ss += __shfl_xor(ss, 2); ss += __shfl_xor(ss, 4); ss += __shfl_xor(ss, 8); ss += __shfl_xor(ss, 16);
        const float rstd = 1.0f / sqrtf(ss * (1.0f / HD) + NORM_EPS);
        const size_t tok = (size_t)b * SEQ + (tq0 - NMETA) + crow(r, hi);
        bf16_t* dst = MIX + tok * DM + 1024 + h * HD + r32;
#pragma unroll
        for (int d0 = 0; d0 < 4; ++d0) dst[32 * d0] = (bf16_t)(cvt_pk_bf16(o[d0][r] * rstd * wv[d0], 0.f) & 0xffffu);
    }
}
}

__device__ __forceinline__ void p5_router(const Args& a, LAS unsigned char* lds, int G, int c, int tid, int lane, int wave) {
    LAS float* wl = (LAS float*)lds;
    LAS float* lg = (LAS float*)(lds + 132096);
    LAS int* misc = (LAS int*)(lds + MISC_OFF);
    const float* H1 = a.out; const float* rw = a.in[I_RW]; const float* rb = a.in[I_RB];
    unsigned char* HN2 = a.ws + WS_HN;
    int* RE = (int*)(a.ws + WS_RE); int* RP = (int*)(a.ws + WS_RP); float* RG = (float*)(a.ws + WS_RG); int* LIST = (int*)(a.ws + WS_LIST);
    unsigned* ecnt = (unsigned*)(a.ws + WS_CTL) + CW_ECNT;
    f32x4 wn[8];
#pragma unroll
    for (int j = 0; j < 8; ++j) wn[j] = *((const f32x4*)a.in[I_FFNNW] + lane + 64 * j);
    for (int blk = c; blk < NREAL / 64; blk += G) {
        for (int pass = 0; pass < 2; ++pass) {
            __syncthreads();
            stage_w16(wl, rw, NEXP, pass * 16, tid);
            if (pass == 0 && tid < 32) misc[40 + tid] = 0;
            __syncthreads();
            for (int rr = 0; rr < 8; ++rr) {
                const int rloc = wave * 8 + rr; const size_t row = (size_t)blk * 64 + rloc;
                f32x4 v[8]; float ss = 0.f;
#pragma unroll
                for (int j = 0; j < 8; ++j) { v[j] = *((const f32x4*)(H1 + row * DM) + lane + 64 * j); ss += (v[j].x * v[j].x + v[j].y * v[j].y) + (v[j].z * v[j].z + v[j].w * v[j].w); }
                const float rstd = 1.0f / sqrtf(wave_sum(ss) * (1.0f / DM) + NORM_EPS);
                GAS unsigned* o4 = (GAS unsigned*)(HN2 + row * DM) + lane;
#pragma unroll
                for (int j = 0; j < 8; ++j) { v[j] = v[j] * rstd * wn[j];
                    if (pass == 0) o4[64 * j] = pk4_fp8(v[j].x, v[j].y, v[j].z, v[j].w); }
                float s[16]; dot16(v, wl, lane, s);
                float sv = s[0];
#pragma unroll
                for (int cc = 1; cc < 16; ++cc) sv = ((lane & 15) == cc) ? s[cc] : sv;
                if (lane < 16) lg[rloc * 33 + pass * 16 + lane] = sv;
            }
        }
        __syncthreads();
        int ek[4] = {0, 0, 0, 0}, rk[4] = {0, 0, 0, 0}; float gk[4] = {0.f, 0.f, 0.f, 0.f};
        if (tid < 64) {
            float v[32];
#pragma unroll
            for (int e = 0; e < 32; ++e) v[e] = lg[tid * 33 + e] + rb[e];
            float val[4];
#pragma unroll
            for (int k = 0; k < 4; ++k) { float best = -3.0e38f; int bi = 0;
#pragma unroll
                for (int e = 0; e < 32; ++e) { const bool gt = v[e] > best; best = gt ? v[e] : best; bi = gt ? e : bi; }
#pragma unroll
                for (int e = 0; e < 32; ++e) v[e] = (e == bi) ? -3.0e38f : v[e];
                ek[k] = bi; val[k] = best; }
            float den = 0.f;
#pragma unroll
            for (int k = 0; k < 4; ++k) { gk[k] = expf(val[k] - val[0]); den += gk[k]; }
#pragma unroll
            for (int k = 0; k < 4; ++k) { gk[k] = gk[k] / den; rk[k] = __hip_atomic_fetch_add(&misc[40 + ek[k]], 1, __ATOMIC_RELAXED, __HIP_MEMORY_SCOPE_WORKGROUP); }
        }
        __syncthreads();
        if (tid < 32) { const int cnt = misc[40 + tid]; misc[72 + tid] = cnt ? (int)atomicAdd(&ecnt[tid], (unsigned)cnt) : 0; }
        __syncthreads();
        if (tid < 64) { const int tok = blk * 64 + tid;
#pragma unroll
            for (int k = 0; k < 4; ++k) { const int pos = misc[72 + ek[k]] + rk[k]; LIST[(size_t)ek[k] * NREAL + pos] = tok; RE[tok * 4 + k] = ek[k]; RP[tok * 4 + k] = pos; RG[tok * 4 + k] = gk[k]; } }
    }
    __syncthreads();
}

__device__ __forceinline__ int moe_setup(const Args& a, LAS int* misc, int tid) {
    const unsigned* ecnt = (const unsigned*)(a.ws + WS_CTL) + CW_ECNT;
    __syncthreads();
    if (tid == 0) { int acc = 0;
        for (int e = 0; e < NEXP; ++e) { const int cnt = (int)__hip_atomic_load(ecnt + e, __ATOMIC_RELAXED, __HIP_MEMORY_SCOPE_AGENT); misc[104 + e] = cnt; misc[e] = acc; acc += (cnt + 255) >> 8; }
        misc[32] = acc; }
    __syncthreads();
    return misc[32];
}

__device__ __forceinline__ void p8_combine(const Args& a, const LAS int* misc, int gw, int NGW, int lane) {
    const int* RE = (const int*)(a.ws + WS_RE); const int* RP = (const int*)(a.ws + WS_RP); const float* RG = (const float*)(a.ws + WS_RG);
    const bf16_t* Y = (const bf16_t*)(a.ws + WS_Y); const float* bd = a.in[I_BD]; float* out = a.out;
    for (int row = gw; row < NREAL; row += NGW) {
        int e[4]; size_t slot[4]; float g[4];
#pragma unroll
        for (int k = 0; k < 4; ++k) { e[k] = RE[row * 4 + k]; slot[k] = (size_t)misc[e[k]] * 256 + RP[row * 4 + k]; g[k] = RG[row * 4 + k]; }
#pragma unroll
        for (int j = 0; j < 4; ++j) { const int col = 8 * lane + 512 * j;
            f32x4 a0 = *(const f32x4*)(out + (size_t)row * DM + col), a1 = *(const f32x4*)(out + (size_t)row * DM + col + 4);
#pragma unroll
            for (int k = 0; k < 4; ++k) { const u32x4 y = *(const u32x4*)(Y + slot[k] * DM + col);
                const f32x4 b0 = *(const f32x4*)(bd + (size_t)e[k] * DM + col), b1 = *(const f32x4*)(bd + (size_t)e[k] * DM + col + 4);
                a0.x += g[k] * (bf_lo(y.x) + b0.x); a0.y += g[k] * (bf_hi(y.x) + b0.y); a0.z += g[k] * (bf_lo(y.y) + b0.z); a0.w += g[k] * (bf_hi(y.y) + b0.w);
                a1.x += g[k] * (bf_lo(y.z) + b1.x); a1.y += g[k] * (bf_hi(y.z) + b1.y); a1.z += g[k] * (bf_lo(y.w) + b1.z); a1.w += g[k] * (bf_hi(y.w) + b1.w); }
            *(f32x4*)(out + (size_t)row * DM + col) = a0; *(f32x4*)(out + (size_t)row * DM + col + 4) = a1; }
    }
}

__device__ __forceinline__ void p1_meta_rows(const Args& a, int bx, int G, int wave, int lane) {
    const bf16_t* HN = (const bf16_t*)(a.ws + WS_HN); const bf16_t* WT = (const bf16_t*)(a.ws + WS_WIN); bf16_t* P = (bf16_t*)(a.ws + WS_P);
    for (int col = bx; col < NPROJ; col += G) {
        u32x4 w[4];
#pragma unroll
        for (int j = 0; j < 4; ++j) w[j] = *(const u32x4*)(WT + (size_t)col * DM + 8 * lane + 512 * j);
        for (int t = wave; t < NMETA; t += NWAVES) {
            float acc = 0.f;
#pragma unroll
            for (int j = 0; j < 4; ++j) { const u32x4 x = *(const u32x4*)(HN + (size_t)t * DM + 8 * lane + 512 * j);
                acc += bf_lo(x.x) * bf_lo(w[j].x) + bf_hi(x.x) * bf_hi(w[j].x) + bf_lo(x.y) * bf_lo(w[j].y) + bf_hi(x.y) * bf_hi(w[j].y)
                     + bf_lo(x.z) * bf_lo(w[j].z) + bf_hi(x.z) * bf_hi(w[j].z) + bf_lo(x.w) * bf_lo(w[j].w) + bf_hi(x.w) * bf_hi(w[j].w); }
            acc = wave_sum(acc);
            if (lane < NB) P[((size_t)lane * LSEQ + t) * NPROJ + col] = gdn::f2bf(acc);
        }
    }
}

constexpr int NPH = 9;
__global__ void __launch_bounds__(NTHREADS, 2) hymba_fwd(Args args) {
    extern __shared__ __attribute__((aligned(16))) unsigned char lds_raw[];
    LAS unsigned char* lds = (LAS unsigned char*)lds_raw;
    LAS int* misc = (LAS int*)(lds + MISC_OFF);
    const int tid = threadIdx.x, lane = tid & 63, wave = __builtin_amdgcn_readfirstlane(tid >> 6);
    const int G = gridDim.x, bx = blockIdx.x;
    const int vcu = (G % 8 == 0) ? (bx % 8) * (G / 8) + bx / 8 : bx;
    const int gw = vcu * NWAVES + wave, NGW = G * NWAVES;
    unsigned* ctl = (unsigned*)(args.ws + WS_CTL);
    for (int u = tid; u < 256; u += NTHREADS) misc[u] = 0;
    __syncthreads();
    XcdBarrier bar; bar.bar = ctl + CW_BAR; bar.x = 0; bar.st = nullptr;
    const int lo = args.ph_lo, hi = args.ph_hi;
    if (hi - lo > 1) bar = xcd_barrier_post(ctl + CW_BAR, (volatile LAS unsigned*)(misc + 200));
#ifdef ONLY
#define IN(k) ((k) == ONLY && lo <= (k) && (k) < hi)
#else
#define IN(k) (lo <= (k) && (k) < hi)
#endif
#ifndef REP_COUNT
#define REP_COUNT 2
#endif
#define REPEAT(k) _Pragma("unroll") for (int _r = 0; _r < ((REP_PHASE == (k)) ? REP_COUNT : 1); ++_r)
#define SEAM(k) do { if (IN(k) && IN((k) + 1)) xcd_barrier(bar); if (PROBE_A >= 0 && tid == 0) tsl[(k) + 1] = __builtin_amdgcn_s_memrealtime(); } while (0)

    LAS unsigned long long* tsl = (LAS unsigned long long*)(lds + MISC_OFF + 896);
    if (PROBE_A >= 0 && tid == 0) tsl[0] = __builtin_amdgcn_s_memrealtime();
    if (IN(0)) REPEAT(0) { p0_rows(args, lds, gw, NGW, tid, lane); p0_weights(args, lds, vcu, G, wave, lane); }
    SEAM(0);
    if (IN(1)) REPEAT(1) {
        p1_meta_rows(args, bx, G, wave, lane);
        pg8::PlainOrder S; S.init(NREAL, NPROJ, DM, args.ws + WS_WIN, G, bx); S.meta = 1;
        pg8::EpiBf16 E{(bf16_t*)(args.ws + (_r ? WS_ACT : WS_P)), NPROJ, 1};
        pg8::gemm_phase<pg8::EpiBf16, pg8::PlainOrder, true, true>(lds, (const char*)(args.ws + WS_HN), DM * 2, S, E);
    }
    SEAM(1);
    if (IN(2)) REPEAT(2) {
        p2_qknorm(args, gw, NGW, lane);
#if GDN_CHUNKED
        for (int it = bx; it < 32 * gdn::NCH; it += G) { __syncthreads(); gdn::precompute(args, lds, it, tid, lane, wave); }
#endif
    }
    SEAM(2);
    if (IN(3)) REPEAT(3) {
        const int NG = (G >= 64) ? 32 : 0;
#if GDN_CHUNKED
        if (bx < 32 || NG == 0) { for (int it = bx; it < 32; it += G) gdn::scan(args, lds, it, tid, lane, wave); }
#else
        if (bx < 32 || NG == 0) { for (int it = bx; it < 32; it += G) p3_gdn_naive(args, lds, it, tid, lane, wave); }
#endif
        if (bx >= NG) { for (int u = bx - NG; u < 512; u += G - NG) sba::unit(args, lds, (volatile LAS int*)(misc + 210), u >> 7, (u >> 4) & 7, u & 15, tid, lane, wave); }
    }
    SEAM(3);
    if (IN(4)) REPEAT(4) {
        pg8::PlainOrder S; S.init(NREAL, DM, DM, args.ws + WS_WOUT, G, bx);
        pg8::EpiResF32 E{args.in[I_X], _r ? (float*)(args.ws + WS_ACT) : args.out, DM};
        pg8::gemm_phase<pg8::EpiResF32, pg8::PlainOrder, true, true>(lds, (const char*)(args.ws + WS_MIX), DM * 2, S, E);
    }
    SEAM(4);
    if (IN(5)) p5_router(args, lds, G, bx, tid, lane, wave);
    SEAM(5);
    if (IN(6)) REPEAT(6) {
        const int mt = moe_setup(args, misc, tid);
        pg8::MoeOrder<true> S; S.tpre = misc; S.tok = (const LAS int*)(lds + TOK_OFF); S.nN = 16; S.nwg = mt * 16; S.G = G; S.c = bx;
        S.Bt = (const char*)(args.ws + WS_WGU); S.estride = (size_t)2 * DE * DM; S.K2 = DM;
        const int* LIST = (const int*)(args.ws + WS_LIST);
        for (int ui = 0; ui < TOK_CAP; ++ui) { pg8::Unit u; if (!S.next(ui, u)) break;
            if (tid < 256) { const int idx = (u.pm - misc[u.e]) * 256 + tid; ((LAS int*)(lds + TOK_OFF))[ui * 256 + tid] = idx < misc[104 + u.e] ? LIST[(size_t)u.e * NREAL + idx] : 0; } }
        __syncthreads();
        pg8::EpiSwiGLU E{args.ws + WS_ACT, args.in[I_BGU]};
        pg8::gemm_phase<pg8::EpiSwiGLU, pg8::MoeOrder<true>, true, true, true>(lds, (const char*)(args.ws + WS_HN), DM, S, E);
    }
    SEAM(6);
    if (IN(7)) REPEAT(7) {
        const int mt = moe_setup(args, misc, tid);
        pg8::MoeOrder<false> S; S.tpre = misc; S.tok = nullptr; S.nN = 8; S.nwg = mt * 8; S.G = G; S.c = bx;
        S.Bt = (const char*)(args.ws + WS_WD); S.estride = (size_t)DM * DE; S.K2 = DE;
        pg8::EpiBf16 E{(bf16_t*)(args.ws + (_r ? WS_WGU : WS_Y)), DM, 0};
        pg8::gemm_phase<pg8::EpiBf16, pg8::MoeOrder<false>, true, true, true>(lds, (const char*)(args.ws + WS_ACT), DE, S, E);
    }
    SEAM(7);
    if (IN(8)) { (void)moe_setup(args, misc, tid); p8_combine(args, misc, gw, NGW, lane); }
#if PROBE_A >= 0
    __syncthreads();
    if (tid == 0) tsl[9] = __builtin_amdgcn_s_memrealtime();
    __syncthreads();
    {
        const int pa = PROBE_A, pb = PROBE_B;
        const float ka = (float)(pa == 9 ? (tsl[9] - tsl[0]) : (tsl[pa + 1] - tsl[pa])) * 1e-3f;
        const float kb = (float)(pb == 9 ? (tsl[9] - tsl[0]) : (tsl[pb + 1] - tsl[pb])) * 1e-3f;
        for (size_t i = (size_t)bx * NTHREADS + tid; i < (size_t)NREAL * DM; i += (size_t)G * NTHREADS) args.out[i] = ka;
        if (bx == 0) { __syncthreads(); if (tid == 0) args.out[0] = 64.0f * kb; }
    }
#endif
#undef IN
#undef SEAM
}

extern "C" void kernel_launch(void* const* d_in, const int* in_sizes, int n_in, void* d_out, int out_size, void* d_ws, size_t ws_size, hipStream_t stream) {
    static int grid = 0;
    if (grid == 0) {
        if (n_in != 19 || out_size != NREAL * DM || ws_size < WS_END) { fprintf(stderr, "kernel_launch: unexpected shapes (n_in %d out %d ws %zu need %zu)\n", n_in, out_size, ws_size, (size_t)WS_END); grid = -1; return; }
        int dev = 0, cus = 0, per_cu = 0;
        if (hipGetDevice(&dev) != hipSuccess || hipDeviceGetAttribute(&cus, hipDeviceAttributeMultiprocessorCount, dev) != hipSuccess) { grid = -1; return; }
        if (hipFuncSetAttribute((const void*)hymba_fwd, hipFuncAttributeMaxDynamicSharedMemorySize, LDS_BYTES) != hipSuccess) { fprintf(stderr, "kernel_launch: hipFuncSetAttribute failed\n"); grid = -1; return; }
        if (hipOccupancyMaxActiveBlocksPerMultiprocessor(&per_cu, (const void*)hymba_fwd, NTHREADS, LDS_BYTES) != hipSuccess || per_cu < 1) { fprintf(stderr, "kernel_launch: occupancy query says %d\n", per_cu); grid = -1; return; }
        (void)hipGetLastError();
        grid = cus;
    }
    if (grid < 0) return;
    (void)hipMemsetAsync((char*)d_ws + WS_CTL, 0, CTL_ZERO_BYTES, stream);
    Args a{};
    for (int i = 0; i < 19; ++i) a.in[i] = (const float*)d_in[i];
    a.out = (float*)d_out; a.ws = (unsigned char*)d_ws;
#if MK_N_LAUNCHES == 1
    a.ph_lo = 0; a.ph_hi = NPH;
    hipLaunchKernelGGL(hymba_fwd, dim3(grid), dim3(NTHREADS), LDS_BYTES, stream, a);
#else
    for (int p = 0; p < NPH; ++p) { a.ph_lo = p; a.ph_hi = p + 1; hipLaunchKernelGGL(hymba_fwd, dim3(grid), dim3(NTHREADS), LDS_BYTES, stream, a); }
#endif
    const hipError_t le = hipPeekAtLastError();
    if (le != hipSuccess) fprintf(stderr, "kernel_launch: launch failed: %s\n", hipGetErrorName(le));
}
```

```cpp
#include <hip/hip_runtime.h>
#include <cstdio>
#include <cstdint>

#ifndef GDN_CHUNKED
#define GDN_CHUNKED 1
#endif
#ifndef REP_PHASE
#define REP_PHASE -1
#endif
#ifndef PROBE_A
#define PROBE_A -1
#endif
#ifndef PROBE_REF_US
#define PROBE_REF_US 500
#endif
#ifndef MK_N_LAUNCHES
#define MK_N_LAUNCHES 1
#endif

constexpr int NB = 4, SEQ = 4096, NMETA = 16, LSEQ = SEQ + NMETA;
constexpr int DM = 2048, NTOK = NB * LSEQ  , MPAD = 16640  , NREAL = NB * SEQ  ;
constexpr int NPROJ_SRC = 7184, NPROJ = 7168;
constexpr int NHEAD = 8, HD = 128;
constexpr int PC_QKV = 0, PC_Z = 3072, PC_SBQ = 4096, PC_SBK = 5120, PC_SBV = 6144;
constexpr int NEXP = 32, TOPK = 4, DE = 2048;
constexpr int SLOT_ROWS = 73728;
constexpr int LROW = 4224;
constexpr float NORM_EPS = 1e-6f;

constexpr size_t MiB = 1u << 20;
constexpr size_t WS_CTL = 0, CTL_ZERO_BYTES = 1 * MiB;
constexpr size_t WS_WIN = 1 * MiB;
constexpr size_t WS_WOUT = WS_WIN + (size_t)NPROJ * DM * 2;
constexpr size_t WS_WGU = WS_WOUT + (size_t)DM * DM * 2;
constexpr size_t WS_WD = WS_WGU + (size_t)NEXP * 2 * DE * DM * 2;
constexpr size_t WS_HN = WS_WD + (size_t)NEXP * DM * DE * 2;
constexpr size_t WS_BETA = WS_HN + (size_t)MPAD * DM * 2;
constexpr size_t WS_G = WS_BETA + (size_t)NTOK * 8 * 4 + 256;
constexpr size_t WS_P = WS_G + (size_t)NTOK * 8 * 4 + 256;
constexpr size_t WS_QN = WS_P + (size_t)MPAD * NPROJ * 2;
constexpr size_t WS_KN = WS_QN + (size_t)NB * NHEAD * LROW * HD * 2;
constexpr size_t WS_ORAW = WS_KN + (size_t)NB * NHEAD * LROW * HD * 2;
constexpr size_t WS_MIX = WS_ORAW + (size_t)NREAL * 1024 * 4;
constexpr size_t WS_RE = WS_MIX + (size_t)NREAL * DM * 2;
constexpr size_t WS_RP = WS_RE + (size_t)NREAL * 4 * 4;
constexpr size_t WS_RG = WS_RP + (size_t)NREAL * 4 * 4;
constexpr size_t WS_LIST = WS_RG + (size_t)NREAL * 4 * 4;
constexpr size_t WS_ACT = WS_LIST + (size_t)NEXP * NREAL * 4;
constexpr size_t WS_Y = WS_ACT + (size_t)SLOT_ROWS * DE * 2;
constexpr size_t WS_GCH = WS_Y + (size_t)SLOT_ROWS * DM * 2;
constexpr size_t WS_GL = WS_GCH + (size_t)32 * 65 * 73728;
constexpr size_t WS_END = WS_GL + 32 * 65 * 4 + 256;
constexpr int CW_ECNT = 64;
constexpr int CW_CVTQ = 192;
constexpr int CW_BAR = 4096;

constexpr int LDS_STAGE = 131072;
constexpr int TOK_OFF = LDS_STAGE, TOK_CAP = 20;
constexpr int MISC_OFF = TOK_OFF + TOK_CAP * 256 * 4;
constexpr int LDS_BYTES = MISC_OFF + 1024;

#define GAS __attribute__((address_space(1)))
#define LAS __attribute__((address_space(3)))
typedef unsigned short bf16_t;
typedef short bf16x8 __attribute__((ext_vector_type(8)));
typedef short s16x4 __attribute__((ext_vector_type(4)));
typedef float f32x4 __attribute__((ext_vector_type(4)));
typedef float f32x2 __attribute__((ext_vector_type(2)));
typedef float f32x16 __attribute__((ext_vector_type(16)));
typedef unsigned u32x4 __attribute__((ext_vector_type(4)));
typedef unsigned u32x2 __attribute__((ext_vector_type(2)));

typedef __bf16 bf16x2_t __attribute__((ext_vector_type(2)));
__device__ __forceinline__ unsigned cvt_pk_bf16(float lo, float hi) { const f32x2 v = {lo, hi}; const bf16x2_t b = __builtin_convertvector(v, bf16x2_t); return __builtin_bit_cast(unsigned, b); }
__device__ __forceinline__ unsigned pk4_fp8(float a, float b, float c, float d) { unsigned w = 0u; w = __builtin_amdgcn_cvt_pk_fp8_f32(a, b, w, false); w = __builtin_amdgcn_cvt_pk_fp8_f32(c, d, w, true); return w; }
__device__ __forceinline__ float bf_lo(unsigned w) { return __uint_as_float(w << 16); }
__device__ __forceinline__ float bf_hi(unsigned w) { return __uint_as_float(w & 0xffff0000u); }
__device__ __forceinline__ float bf2f(bf16_t b) { return __uint_as_float(((unsigned)b) << 16); }
__device__ __forceinline__ float wave_sum(float v) {
#pragma unroll
    for (int o = 1; o < 64; o <<= 1) v += __shfl_xor(v, o);
    return v;
}

namespace pg8 {
constexpr int BM = 256, BK = 64, HALF = 128, HTB = HALF * BK * 2, STAGE_BYTES = 8 * HTB, NXCD = 8, WGM = 8;
__host__ __device__ __forceinline__ int lds_byte(int r, int c) { const int st = (r >> 4) * 2 + (c >> 5), rr = r & 15, cc = c & 31, ob = rr * 64 + cc * 2; return st * 1024 + (ob ^ (((ob >> 9) & 1) << 5)); }
__host__ __device__ __forceinline__ void stage_rc(int b, int& R, int& C) { const int st = b / 1024, sb = b % 1024, swz = sb ^ (((sb >> 9) & 1) << 5); R = (st >> 1) * 16 + swz / 64; C = (st & 1) * 32 + (swz % 64) / 2; }
__host__ __device__ __forceinline__ int perm32(int rho) { const int n = rho >> 4, i = rho & 15; return 8 * (i >> 2) + 4 * n + (i & 3); }

typedef int v8i __attribute__((ext_vector_type(8))); typedef int v4i __attribute__((ext_vector_type(4)));
__device__ __forceinline__ v8i cat8(bf16x8 lo, bf16x8 hi) { const v4i a = __builtin_bit_cast(v4i, lo), b = __builtin_bit_cast(v4i, hi); return __builtin_shufflevector(a, b, 0, 1, 2, 3, 4, 5, 6, 7); }
struct Unit { int pm, pn, e, ui; };

__device__ __forceinline__ int xcd_remap(int L, int nwg) { const int q = nwg / NXCD, r = nwg % NXCD, xcd = L % NXCD, off = L / NXCD; return (xcd < r ? xcd * (q + 1) : r * (q + 1) + (xcd - r) * q) + off; }

struct PlainOrder {
    int nM, nN, nwg, G, c; const char* Bt; unsigned K2;
    __device__ void init(int M, int N, int K, const void* Bt_, int G_, int c_) { nM = M / BM; nN = N / BM; nwg = nM * nN; G = G_; c = c_; Bt = (const char*)Bt_; K2 = (unsigned)K * 2u; }
    __device__ __forceinline__ bool next(int i, Unit& u) const {
        const long L = (long)i * G + c; if (L >= nwg) return false;
        const int wgid = xcd_remap((int)L, nwg);
        const int nig = WGM * nN, gid = wgid / nig, fm = gid * WGM, gsz = (nM - fm) < WGM ? (nM - fm) : WGM;
        u.pm = fm + ((wgid % nig) % gsz); u.pn = (wgid % nig) / gsz; u.e = 0; u.ui = i; return true;
    }
    __device__ __forceinline__ const char* b_ptr(const Unit& u) const { return Bt + (size_t)u.pn * BM * K2; }
    __device__ __forceinline__ unsigned a_off(const Unit& u, int r) const { return (unsigned)(u.pm * BM + r + (meta ? NMETA * ((u.pm >> 4) + 1) : 0)) * K2; }
    int meta = 0;
};
template <bool GATHER> struct MoeOrder {
    const LAS int* tpre; const LAS int* tok; int nN, nwg, G, c; const char* Bt; size_t estride; unsigned K2;
    __device__ __forceinline__ bool next(int i, Unit& u) const {
        const long L = (long)i * G + c; if (L >= nwg) return false;
        const int wgid = xcd_remap((int)L, nwg);
        int e = 0;
#pragma unroll 1
        for (int j = 1; j < NEXP; ++j) e = (wgid >= tpre[j] * nN) ? j : e;
        const int t0 = tpre[e], nt = tpre[e + 1] - t0, loc = wgid - t0 * nN;
        u.e = e; u.pn = loc / nt; u.pm = t0 + loc % nt; u.ui = i; return true;
    }
    __device__ __forceinline__ const char* b_ptr(const Unit& u) const { return Bt + (size_t)u.e * estride + (size_t)u.pn * BM * K2; }
    __device__ __forceinline__ unsigned a_off(const Unit& u, int r) const {
        if (GATHER) return (unsigned)tok[u.ui * 256 + r] * K2;
        return (unsigned)(u.pm * BM + r) * K2;
    }
};

struct EpiBf16 {
    static constexpr bool PERM = true;
    bf16_t* O; int ldc; int meta;
    __device__ __forceinline__ void operator()(const f32x4 (&acc)[2][2][4][2], const Unit& u, int wr, int wc, int fr, int fq) const {
        const int row0 = u.pm * BM + wr * 64 + fr + (meta ? NMETA * ((u.pm >> 4) + 1) : 0), col0 = u.pn * BM + wc * 32 + 8 * fq;
#pragma unroll
        for (int ai = 0; ai < 2; ++ai)
#pragma unroll
            for (int m = 0; m < 4; ++m) { bf16_t* rowp = O + (size_t)(row0 + ai * HALF + m * 16) * ldc + col0;
#pragma unroll
                for (int bj = 0; bj < 2; ++bj) { const f32x4 v0 = acc[ai][bj][m][0], v1 = acc[ai][bj][m][1];
                    u32x4 w; w.x = cvt_pk_bf16(v0[0], v0[1]); w.y = cvt_pk_bf16(v0[2], v0[3]); w.z = cvt_pk_bf16(v1[0], v1[1]); w.w = cvt_pk_bf16(v1[2], v1[3]);
                    *(u32x4*)(rowp + bj * HALF) = w; } }
    }
};
struct EpiResF32 {
    static constexpr bool PERM = false;
    const float* X; float* out; int ldc;
    __device__ __forceinline__ void operator()(const f32x4 (&acc)[2][2][4][2], const Unit& u, int wr, int wc, int fr, int fq) const {
        const int row0 = u.pm * BM + wr * 64 + fr, col0 = u.pn * BM + wc * 32 + 4 * fq;
#pragma unroll
        for (int ai = 0; ai < 2; ++ai)
#pragma unroll
            for (int m = 0; m < 4; ++m) { const size_t off = (size_t)(row0 + ai * HALF + m * 16) * ldc + col0;
#pragma unroll
                for (int bj = 0; bj < 2; ++bj)
#pragma unroll
                    for (int n = 0; n < 2; ++n) { const f32x4 xv = *(const f32x4*)(X + off + bj * HALF + n * 16); *(f32x4*)(out + off + bj * HALF + n * 16) = xv + acc[ai][bj][m][n]; }
                asm volatile("" ::: "memory"); }
    }
};
__device__ __forceinline__ float swiglu1(float g, float uu) {
    g = fminf(g, 7.0f); uu = fminf(fmaxf(uu, -7.0f), 7.0f);
    const float sg = __builtin_amdgcn_rcpf(1.0f + __builtin_amdgcn_exp2f(-1.702f * 1.4426950408889634f * g));
    return (uu + 1.0f) * g * sg;
}
struct EpiSwiGLU {
    static constexpr bool PERM = true;
    unsigned char* act; const float* bgu;
    __device__ __forceinline__ void operator()(const f32x4 (&acc)[2][2][4][2], const Unit& u, int wr, int wc, int fr, int fq) const {
        const int row0 = u.pm * BM + wr * 64 + fr, col0 = u.pn * HALF + wc * 32 + 8 * fq;
        const float* bg = bgu + (size_t)u.e * 4096 + col0;
        const f32x4 bg0 = *(const f32x4*)(bg), bg1 = *(const f32x4*)(bg + 4), bu0 = *(const f32x4*)(bg + 2048), bu1 = *(const f32x4*)(bg + 2052);
#pragma unroll
        for (int ai = 0; ai < 2; ++ai)
#pragma unroll
            for (int m = 0; m < 4; ++m) { unsigned char* rowp = act + (size_t)(row0 + ai * HALF + m * 16) * DE + col0;
                const f32x4 g0 = acc[ai][0][m][0] + bg0, g1 = acc[ai][0][m][1] + bg1, u0 = acc[ai][1][m][0] + bu0, u1 = acc[ai][1][m][1] + bu1;
                u32x2 w; w.x = pk4_fp8(swiglu1(g0[0], u0[0]), swiglu1(g0[1], u0[1]), swiglu1(g0[2], u0[2]), swiglu1(g0[3], u0[3]));
                w.y = pk4_fp8(swiglu1(g1[0], u1[0]), swiglu1(g1[1], u1[1]), swiglu1(g1[2], u1[2]), swiglu1(g1[3], u1[3]));
                *(u32x2*)rowp = w; }
    }
};

template <class Epi, class Sched, bool ALIGN_EPI, bool SP2, bool FP8 = false>
__device__ __forceinline__ void gemm_phase(LAS unsigned char* lds, const char* A0, int Kb, const Sched& S, const Epi& E) {
    const int tid = threadIdx.x, wid = __builtin_amdgcn_readfirstlane(tid >> 6), lane = tid & 63, wr = wid >> 2, wc = wid & 3, fr = lane & 15, fq = lane >> 4;
    const int nt = Kb / 128;
    int Rr[2], Cc[2]; unsigned voffB[2];
#pragma unroll
    for (int i = 0; i < 2; ++i) { int R, C; stage_rc(tid * 16 + i * 8192, R, C); const int Rb = Epi::PERM ? ((R & ~31) + perm32(R & 31)) : R;
        Rr[i] = R; Cc[i] = C * 2; voffB[i] = (unsigned)(Rb * Kb + C * 2); }
    const size_t kstep = (size_t)(BK * 2);
    const size_t hstep = (size_t)HALF * Kb;
    const unsigned ldsw = (unsigned)wid * 1024u;
    const int aoff = lds_byte(wr * 64 + fr, fq * 8), boff = lds_byte(wc * 32 + fr, fq * 8);
#define PG8_SA(b, h) (((b) * 2 + (h)) * HTB)
#define PG8_SB(b, h) ((4 + (b) * 2 + (h)) * HTB)
#define PG8_STAGE(bufoff, gbase, voff) do { _Pragma("unroll") for (int _i = 0; _i < 2; ++_i) \
        __builtin_amdgcn_global_load_lds((const unsigned*)((const char*)(gbase) + (voff)[_i]), (LAS unsigned*)(lds + (bufoff) + ldsw + _i * 8192), 16, 0, 0); } while (0)
#define PG8_LDA(dst, b, h) do { _Pragma("unroll") for (int m = 0; m < 4; ++m) _Pragma("unroll") for (int k = 0; k < 2; ++k) dst[m][k] = *(const LAS bf16x8*)(lds + PG8_SA(b, h) + aoff + m * 2048 + k * 1024); } while (0)
#define PG8_LDB(dst, b, h) do { _Pragma("unroll") for (int n = 0; n < 2; ++n) _Pragma("unroll") for (int k = 0; k < 2; ++k) dst[n][k] = *(const LAS bf16x8*)(lds + PG8_SB(b, h) + boff + n * 2048 + k * 1024); } while (0)
#define PG8_MMA(ai, bj, At, Bt) do { __builtin_amdgcn_s_setprio(1); _Pragma("unroll") for (int m = 0; m < 4; ++m) _Pragma("unroll") for (int n = 0; n < 2; ++n) { \
        if constexpr (FP8) acc[ai][bj][m][n] = __builtin_amdgcn_mfma_scale_f32_16x16x128_f8f6f4(cat8(Bt[n][0], Bt[n][1]), cat8(At[m][0], At[m][1]), acc[ai][bj][m][n], 0, 0, 0, 0x79797979, 0, 0x7f7f7f7f); \
        else { _Pragma("unroll") for (int k = 0; k < 2; ++k) acc[ai][bj][m][n] = __builtin_amdgcn_mfma_f32_16x16x32_bf16(Bt[n][k], At[m][k], acc[ai][bj][m][n], 0, 0, 0); } } \
        __builtin_amdgcn_s_setprio(0); } while (0)
#define PG8_WAIT_V(n) asm volatile("s_waitcnt vmcnt(" #n ")" ::: "memory")
#define PG8_WAIT_L(n) asm volatile("s_waitcnt lgkmcnt(" #n ")" ::: "memory")
#define PG8_BAR __builtin_amdgcn_s_barrier()
#define PG8_SCHED __builtin_amdgcn_sched_barrier(0)
#define PG8_VOFF(dst, u) do { _Pragma("unroll") for (int _h = 0; _h < 2; ++_h) _Pragma("unroll") for (int _i = 0; _i < 2; ++_i) dst[_h][_i] = S.a_off(u, _h * HALF + Rr[_i]) + (unsigned)Cc[_i]; } while (0)
    Unit cur, nxt; int ui = 0;
    if (!S.next(0, cur)) return;
    f32x4 acc[2][2][4][2];
#pragma unroll
    for (int a = 0; a < 2; ++a)
#pragma unroll
        for (int b = 0; b < 2; ++b)
#pragma unroll
            for (int m = 0; m < 4; ++m)
#pragma unroll
                for (int n = 0; n < 2; ++n) acc[a][b][m][n] = (f32x4){0.f, 0.f, 0.f, 0.f};
    bf16x8 At[4][2], B0[2][2], B1[2][2];
    unsigned va[2][2], vn[2][2];
    PG8_VOFF(va, cur);
    const char* cB = S.b_ptr(cur);
    if constexpr (SP2) {
        PG8_STAGE(PG8_SB(0, 0), cB, voffB); PG8_STAGE(PG8_SB(0, 1), cB + hstep, voffB); PG8_STAGE(PG8_SA(0, 0), A0, va[0]); PG8_STAGE(PG8_SA(0, 1), A0, va[1]);
        if (wr == 1) PG8_BAR;
        PG8_WAIT_V(2); PG8_BAR;
        PG8_STAGE(PG8_SB(1, 0), cB + kstep, voffB); PG8_STAGE(PG8_SA(1, 0), A0 + kstep, va[0]); PG8_STAGE(PG8_SB(1, 1), cB + hstep + kstep, voffB);
        PG8_WAIT_V(6); PG8_BAR;
    } else {
        PG8_STAGE(PG8_SB(0, 0), cB, voffB); PG8_STAGE(PG8_SA(0, 0), A0, va[0]); PG8_STAGE(PG8_SB(0, 1), cB + hstep, voffB); PG8_STAGE(PG8_SA(0, 1), A0, va[1]);
        if (wr == 1) PG8_BAR;
        PG8_WAIT_V(4); PG8_BAR;
        PG8_STAGE(PG8_SB(1, 0), cB + kstep, voffB); PG8_STAGE(PG8_SA(1, 0), A0 + kstep, va[0]); PG8_STAGE(PG8_SB(1, 1), cB + hstep + kstep, voffB);
        PG8_WAIT_V(6); PG8_BAR;
    }
    for (;;) {
        const bool has_next = S.next(ui + 1, nxt);
        const char* nB = has_next ? S.b_ptr(nxt) : cB;
        for (int t = 0; t < nt; t += 2) {
            const bool last = (t == nt - 2);
            const char* a1 = A0 + (size_t)(t + 1) * kstep;
            const char* a2 = last ? A0 : A0 + (size_t)(t + 2) * kstep; const char* b2 = last ? nB : cB + (size_t)(t + 2) * kstep;
            const char* a3 = a2 + kstep; const char* b3 = b2 + kstep;
            if (last) { if (has_next) { PG8_VOFF(vn, nxt); } else {
#pragma unroll
                    for (int _h = 0; _h < 2; ++_h)
#pragma unroll
                        for (int _i = 0; _i < 2; ++_i) vn[_h][_i] = va[_h][_i]; } }
            if constexpr (SP2) {
            PG8_LDB(B0, 0, 0); PG8_LDB(B1, 0, 1); PG8_SCHED; PG8_LDA(At, 0, 0); PG8_STAGE(PG8_SA(1, 1), a1, va[1]);
            if (last) {
#pragma unroll
                for (int _h = 0; _h < 2; ++_h)
#pragma unroll
                    for (int _i = 0; _i < 2; ++_i) va[_h][_i] = vn[_h][_i]; }
            PG8_WAIT_V(8); PG8_WAIT_L(0); PG8_BAR; PG8_MMA(0, 0, At, B0); PG8_MMA(0, 1, At, B1); PG8_BAR; PG8_SCHED;
            PG8_LDA(At, 0, 1); PG8_STAGE(PG8_SB(0, 0), b2, voffB); PG8_STAGE(PG8_SB(0, 1), b2 + hstep, voffB); PG8_STAGE(PG8_SA(0, 0), a2, va[0]);
            PG8_WAIT_V(8); PG8_WAIT_L(0); PG8_BAR; PG8_MMA(1, 0, At, B0); PG8_MMA(1, 1, At, B1); PG8_BAR; PG8_SCHED;
            PG8_LDB(B0, 1, 0); PG8_LDB(B1, 1, 1); PG8_SCHED; PG8_LDA(At, 1, 0); PG8_STAGE(PG8_SA(0, 1), a2, va[1]);
            PG8_WAIT_V(8); PG8_WAIT_L(0); PG8_BAR; PG8_MMA(0, 0, At, B0); PG8_MMA(0, 1, At, B1); PG8_BAR; PG8_SCHED;
            PG8_LDA(At, 1, 1); PG8_STAGE(PG8_SB(1, 0), b3, voffB); PG8_STAGE(PG8_SB(1, 1), b3 + hstep, voffB); PG8_STAGE(PG8_SA(1, 0), a3, va[0]);
            PG8_WAIT_V(8); PG8_WAIT_L(0); PG8_BAR; PG8_MMA(1, 0, At, B0); PG8_MMA(1, 1, At, B1); PG8_BAR; PG8_SCHED;
            } else {
            PG8_LDB(B0, 0, 0); PG8_SCHED; PG8_LDA(At, 0, 0); PG8_STAGE(PG8_SA(1, 1), a1, va[1]);
            if (last) {
#pragma unroll
                for (int _h = 0; _h < 2; ++_h)
#pragma unroll
                    for (int _i = 0; _i < 2; ++_i) va[_h][_i] = vn[_h][_i]; }
            PG8_WAIT_L(8); PG8_BAR; PG8_WAIT_L(0); PG8_MMA(0, 0, At, B0); PG8_BAR; PG8_SCHED;
            PG8_LDB(B1, 0, 1); PG8_STAGE(PG8_SB(0, 0), b2, voffB);
            PG8_BAR; PG8_WAIT_L(0); PG8_MMA(0, 1, At, B1); PG8_BAR;
            PG8_LDA(At, 0, 1); PG8_STAGE(PG8_SA(0, 0), a2, va[0]);
            PG8_BAR; PG8_WAIT_L(0); PG8_MMA(1, 0, At, B0); PG8_BAR; PG8_SCHED;
            PG8_STAGE(PG8_SB(0, 1), b2 + hstep, voffB);
            PG8_WAIT_V(6); PG8_BAR; PG8_MMA(1, 1, At, B1); PG8_BAR;
            PG8_LDB(B0, 1, 0); PG8_SCHED; PG8_LDA(At, 1, 0); PG8_STAGE(PG8_SA(0, 1), a2, va[1]);
            PG8_WAIT_L(8); PG8_BAR; PG8_WAIT_L(0); PG8_MMA(0, 0, At, B0); PG8_BAR; PG8_SCHED;
            PG8_LDB(B1, 1, 1); PG8_STAGE(PG8_SB(1, 0), b3, voffB);
            PG8_BAR; PG8_WAIT_L(0); PG8_MMA(0, 1, At, B1); PG8_BAR;
            PG8_LDA(At, 1, 1); PG8_STAGE(PG8_SA(1, 0), a3, va[0]);
            PG8_BAR; PG8_WAIT_L(0); PG8_MMA(1, 0, At, B0); PG8_BAR; PG8_SCHED;
            PG8_STAGE(PG8_SB(1, 1), b3 + hstep, voffB);
            PG8_WAIT_V(6); PG8_BAR; PG8_MMA(1, 1, At, B1); PG8_BAR;
            }
        }
        if constexpr (ALIGN_EPI) { if (wr == 0) PG8_BAR; }
        E(acc, cur, wr, wc, fr, fq);
        if (!has_next) break;
#pragma unroll
        for (int a = 0; a < 2; ++a)
#pragma unroll
            for (int b = 0; b < 2; ++b)
#pragma unroll
                for (int m = 0; m < 4; ++m)
#pragma unroll
                    for (int n = 0; n < 2; ++n) acc[a][b][m][n] = (f32x4){0.f, 0.f, 0.f, 0.f};
        cur = nxt; cB = nB; ++ui;
        if constexpr (ALIGN_EPI) { if (wr == 1) PG8_BAR; }
    }
    PG8_WAIT_V(0);
    if constexpr (!ALIGN_EPI) { if (wr == 0) PG8_BAR; }
    PG8_BAR;
#undef PG8_SA
#undef PG8_SB
#undef PG8_STAGE
#undef PG8_LDA
#undef PG8_LDB
#undef PG8_MMA
#undef PG8_WAIT_V
#undef PG8_WAIT_L
#undef PG8_BAR
#undef PG8_SCHED
#undef PG8_VOFF
}
}

#define XB_TMO      128
#define XB_XCNT(j)  (256  + 64 * (j))
#define XB_XSUB(j)  (1280 + 64 * (j))
#define XB_XGEN(j)  (2304 + 64 * (j))
#define XB_TOP      3328
#define XB_TOPGEN   3392
#define XCD_BAR_WORDS 3456
#define XB_SPIN_CAP (1u << 18)

__device__ __forceinline__ unsigned xb_ld(unsigned* p)              { return __hip_atomic_load(p, __ATOMIC_RELAXED, __HIP_MEMORY_SCOPE_AGENT); }
__device__ __forceinline__ unsigned xb_add(unsigned* p, unsigned v) { return __hip_atomic_fetch_add(p, v, __ATOMIC_RELAXED, __HIP_MEMORY_SCOPE_AGENT); }
__device__ __forceinline__ unsigned xb_xcc_id() { return (unsigned)__builtin_amdgcn_s_getreg((3 << 11) | 20) & 0xFu; }
#define XB_SPIN(cond, bar) do { unsigned _sp = 0; while (cond) { __builtin_amdgcn_s_sleep(1); \
    if ((++_sp & 255u) == 0u) { if (xb_ld(&(bar)[XB_TMO])) break; if (_sp > XB_SPIN_CAP) { atomicAdd(&(bar)[XB_TMO], 1u); break; } } } } while (0)

struct XcdBarrier {
    unsigned* bar; unsigned x;
    volatile LAS unsigned* st;
};
__device__ __forceinline__ XcdBarrier xcd_barrier_post(unsigned* bar, volatile LAS unsigned* st) {
    XcdBarrier b; b.bar = bar; b.x = xb_xcc_id(); b.st = st;
    if (threadIdx.x == 0) (void)xb_add(&bar[XB_XCNT(b.x)], 1u);
    return b;
}
__device__ __forceinline__ void xcd_barrier_complete(unsigned* bar, unsigned x, unsigned& nloc, unsigned& nx) {
    const unsigned G = gridDim.x * gridDim.y * gridDim.z;
    unsigned sum, cnt, mine, sp = 0u;
    for (;;) {
        sum = 0u; cnt = 0u; mine = 0u;
#pragma unroll
        for (unsigned j = 0; j < 16; ++j) { const unsigned c = xb_ld(&bar[XB_XCNT(j)]); sum += c; cnt += (c > 0u) ? 1u : 0u; mine = (j == x) ? c : mine; }
        if (sum == G) break;
        __builtin_amdgcn_s_sleep(1);
        if ((++sp & 255u) == 0u) { if (xb_ld(&bar[XB_TMO])) break; if (sp > XB_SPIN_CAP) { atomicAdd(&bar[XB_TMO], 1u); break; } }
    }
    nloc = mine > 0u ? mine : 1u; nx = cnt > 0u ? cnt : 1u;
}
__device__ __forceinline__ void xcd_barrier(const XcdBarrier& b) {
    asm volatile("s_waitcnt vmcnt(0)" ::: "memory");
    __syncthreads();
    if (threadIdx.x == 0) {
        unsigned* bar = b.bar;
        __builtin_amdgcn_s_waitcnt(0);
        unsigned nloc = b.st[0], nx = b.st[1];
        if (nloc == 0u) { xcd_barrier_complete(bar, b.x, nloc, nx); b.st[0] = nloc; b.st[1] = nx; }
        const unsigned old = xb_add(&bar[XB_XSUB(b.x)], 1u);
        const unsigned gen = old / nloc;
        if (old + 1u == (gen + 1u) * nloc) {
            __builtin_amdgcn_fence(__ATOMIC_RELEASE, "agent");
            asm volatile("s_waitcnt vmcnt(0)" ::: "memory");
            const unsigned og = xb_add(&bar[XB_TOP], 1u);
            const unsigned tg = og / nx;
            if (og + 1u == (tg + 1u) * nx) xb_add(&bar[XB_TOPGEN], 1u);
            else XB_SPIN(xb_ld(&bar[XB_TOPGEN]) == tg, bar);
            __builtin_amdgcn_fence(__ATOMIC_ACQUIRE, "agent");
            xb_add(&bar[XB_XGEN(b.x)], 1u);
            asm volatile("s_waitcnt vmcnt(0)" ::: "memory");
        } else {
            XB_SPIN(xb_ld(&bar[XB_XGEN(b.x)]) == gen, bar);
            __builtin_amdgcn_fence(__ATOMIC_ACQUIRE, "agent");
            asm volatile("s_waitcnt vmcnt(0)" ::: "memory");
        }
    }
    __syncthreads();
}

constexpr int NWAVES = 8, NTHREADS = 512;
struct Args { const float* in[19]; float* out; unsigned char* ws; int ph_lo, ph_hi; };
enum { I_X = 0, I_META, I_MIXNW, I_WIN, I_CONVW, I_ALOG, I_DTB, I_GDNNW, I_SBQNW, I_SBKNW, I_SBONW, I_WOUT, I_FFNNW, I_RW, I_RB, I_WGU, I_BGU, I_WD, I_BD };

#define LDS_WAIT() asm volatile("s_waitcnt lgkmcnt(0)" ::: "memory")
#define VM_WAIT() asm volatile("s_waitcnt vmcnt(0)" ::: "memory")
constexpr int WLS = 2052;

__device__ __forceinline__ void dot16(const f32x4 (&v)[8], const LAS float* wl, int lane, float (&s)[16]) {
#pragma unroll
    for (int c = 0; c < 16; ++c) { float a = 0.f;
#pragma unroll
        for (int j = 0; j < 8; ++j) { const f32x4 w = *(const LAS f32x4*)(wl + c * WLS + 4 * lane + 256 * j); a += (v[j].x * w.x + v[j].y * w.y) + (v[j].z * w.z + v[j].w * w.w); }
        s[c] = wave_sum(a); }
}

__device__ __forceinline__ void stage_w16(LAS float* wl, const float* base, int ld, int coloff, int tid) {
#pragma unroll 4
    for (int idx = tid; idx < 2048 * 4; idx += NTHREADS) { const int k = idx >> 2, q = idx & 3; const f32x4 v = *(const f32x4*)(base + (size_t)k * ld + coloff + 4 * q);
        wl[(4 * q + 0) * WLS + k] = v.x; wl[(4 * q + 1) * WLS + k] = v.y; wl[(4 * q + 2) * WLS + k] = v.z; wl[(4 * q + 3) * WLS + k] = v.w; }
}

__device__ __forceinline__ void p0_rows(const Args& a, LAS unsigned char* lds, int gw, int NGW, int tid, int lane) {
    const float* x = a.in[I_X]; const float* meta = a.in[I_META]; const float* nw = a.in[I_MIXNW]; const float* win = a.in[I_WIN];
    LAS float* wl = (LAS float*)lds;
    stage_w16(wl, win, NPROJ_SRC, 4096, tid);
    __syncthreads();
    bf16_t* HN = (bf16_t*)(a.ws + WS_HN); float* BETA = (float*)(a.ws + WS_BETA); float* GG = (float*)(a.ws + WS_G);
    f32x4 wn[8];
#pragma unroll
    for (int j = 0; j < 8; ++j) wn[j] = *((const f32x4*)nw + lane + 64 * j);
    const int hh = lane & 7;
    const float alog = a.in[I_ALOG][hh], dtb = a.in[I_DTB][hh];
    for (int row = gw; row < MPAD; row += NGW) {
        GAS unsigned long long* o8 = (GAS unsigned long long*)(HN + (size_t)row * DM) + lane;
        if (row >= NTOK) {
#pragma unroll
            for (int j = 0; j < 8; ++j) o8[64 * j] = 0ull;
            continue; }
        const int b = row / LSEQ, t = row - b * LSEQ;
        const float* src = (t < NMETA) ? meta + (size_t)t * DM : x + ((size_t)b * SEQ + (t - NMETA)) * DM;
        f32x4 v[8]; float ss = 0.f;
#pragma unroll
        for (int j = 0; j < 8; ++j) { v[j] = *((const f32x4*)src + lane + 64 * j); ss += (v[j].x * v[j].x + v[j].y * v[j].y) + (v[j].z * v[j].z + v[j].w * v[j].w); }
        const float rstd = 1.0f / sqrtf(wave_sum(ss) * (1.0f / DM) + NORM_EPS);
#pragma unroll
        for (int j = 0; j < 8; ++j) { v[j] = v[j] * rstd * wn[j];
            o8[64 * j] = (unsigned long long)cvt_pk_bf16(v[j].x, v[j].y) | ((unsigned long long)cvt_pk_bf16(v[j].z, v[j].w) << 32); }
        float s[16]; dot16(v, wl, lane, s);
        float bv = s[0], av = s[8];
#pragma unroll
        for (int c = 1; c < 8; ++c) { bv = (hh == c) ? s[c] : bv; av = (hh == c) ? s[8 + c] : av; }
        if (lane < 8) {
            const float beta = 1.0f / (1.0f + expf(-bv));
            const float xa = av + dtb; const float sp = fmaxf(xa, 0.f) + log1pf(expf(-fabsf(xa)));
            BETA[(size_t)row * 8 + hh] = beta; GG[(size_t)row * 8 + hh] = -expf(alog) * sp; }
    }
    __syncthreads();
}

constexpr int CVT_STR = 132;
template <int MODE  >
__device__ __forceinline__ void cvt_tile(const float* W, int ldw, int K, bf16_t* out, int kb, int nt, LAS unsigned char* T, int lane) {
    const int r0 = nt * 64;
    int c0;
    if (MODE == 0) c0 = r0;
    else if (MODE == 1) c0 = r0 < 4096 ? r0 : r0 + 16;
    else { const int pn = r0 >> 8, rr = r0 & 255; c0 = rr < 128 ? 128 * pn + rr : 2048 + 128 * pn + (rr - 128); }
    const int kq = lane >> 4, nl = lane & 15;
    const float* src = W + (size_t)(kb * 64 + 2 * kq) * ldw + c0 + 4 * nl;
    f32x4 v[8][2];
#pragma unroll
    for (int i = 0; i < 8; ++i)
#pragma unroll
        for (int j = 0; j < 2; ++j) v[i][j] = *(const f32x4*)(src + (size_t)(8 * i + j) * ldw);
    LAS unsigned char* tw = T + (4 * nl) * CVT_STR + 4 * kq;
#pragma unroll
    for (int i = 0; i < 8; ++i)
#pragma unroll
        for (int q = 0; q < 4; ++q) *(LAS unsigned*)(tw + q * CVT_STR + 16 * i) = cvt_pk_bf16(v[i][0][q], v[i][1][q]);
    LDS_WAIT();
    const int rn = lane >> 3, cc = lane & 7;
    const LAS unsigned char* tr = T + rn * CVT_STR + 16 * cc;
    bf16_t* dst = out + (size_t)(r0 + rn) * K + kb * 64 + 8 * cc;
#pragma unroll
    for (int j = 0; j < 8; ++j) { u32x4 w; const LAS unsigned* p = (const LAS unsigned*)(tr + 8 * j * CVT_STR); w.x = p[0]; w.y = p[1]; w.z = p[2]; w.w = p[3];
        *(u32x4*)(dst + (size_t)(8 * j) * K) = w; }
    LDS_WAIT();
}
constexpr float W8_SCALE = 64.0f;
template <int MODE>
__device__ __forceinline__ void cvt_tile_fp8(const float* W, int ldw, int K, unsigned char* out, int kb, int nt, LAS unsigned char* T, int lane) {
    const int r0 = nt * 64;
    int c0;
    if (MODE == 0) c0 = r0;
    else { const int pn = r0 >> 8, rr = r0 & 255; c0 = rr < 128 ? 128 * pn + rr : 2048 + 128 * pn + (rr - 128); }
    const int kq = lane >> 4, nl = lane & 15;
    LAS unsigned char* tw = T + (4 * nl) * CVT_STR + 4 * kq;
#pragma unroll
    for (int half = 0; half < 2; ++half) {
        const float* src = W + (size_t)(kb * 128 + half * 64 + 4 * kq) * ldw + c0 + 4 * nl;
        f32x4 v[4][4];
#pragma unroll
        for (int i = 0; i < 4; ++i)
#pragma unroll
            for (int j = 0; j < 4; ++j) v[i][j] = *(const f32x4*)(src + (size_t)(16 * i + j) * ldw);
#pragma unroll
        for (int i = 0; i < 4; ++i)
#pragma unroll
            for (int q = 0; q < 4; ++q) *(LAS unsigned*)(tw + q * CVT_STR + 64 * half + 16 * i) =
                pk4_fp8(v[i][0][q] * W8_SCALE, v[i][1][q] * W8_SCALE, v[i][2][q] * W8_SCALE, v[i][3][q] * W8_SCALE);
    }
    LDS_WAIT();
    const int rn = lane >> 3, cc = lane & 7;
    const LAS unsigned char* tr = T + rn * CVT_STR + 16 * cc;
    unsigned char* dst = out + (size_t)(r0 + rn) * K + kb * 128 + 16 * cc;
#pragma unroll
    for (int j = 0; j < 8; ++j) { u32x4 w; const LAS unsigned* p = (const LAS unsigned*)(tr + 8 * j * CVT_STR); w.x = p[0]; w.y = p[1]; w.z = p[2]; w.w = p[3];
        *(u32x4*)(dst + (size_t)(8 * j) * K) = w; }
    LDS_WAIT();
}
__device__ __forceinline__ void p0_weights(const Args& a, LAS unsigned char* lds, int vcu, int G, int wave, int lane) {
    constexpr int I_IN = 32 * 14, I_OUT = 32 * 4;
    constexpr int NITEMS = I_IN + I_OUT;
    LAS unsigned char* T = lds + wave * (64 * CVT_STR);
    for (int it = vcu; it < NITEMS; it += G) {
        int r = it;
        if (r < I_IN) { cvt_tile<1>(a.in[I_WIN], NPROJ_SRC, DM, (bf16_t*)(a.ws + WS_WIN), r / 14, (r % 14) * 8 + wave, T, lane); continue; } r -= I_IN;
        cvt_tile<0>(a.in[I_WOUT], DM, DM, (bf16_t*)(a.ws + WS_WOUT), r / 4, (r % 4) * 8 + wave, T, lane);
    }
}
constexpr int MOE_I_GU = 16 * 8, MOE_I_D = 16 * 4, MOE_ITEMS = NEXP * (MOE_I_GU + MOE_I_D);
__device__ __forceinline__ void moe_weights_queue(const Args& a, LAS unsigned char* lds, LAS int* qslot, int tid, int wave, int lane) {
    unsigned* ctr = (unsigned*)(a.ws + WS_CTL) + CW_CVTQ;
    LAS unsigned char* T = lds + wave * (64 * CVT_STR);
    for (;;) {
        __syncthreads();
        if (tid == 0) *qslot = (int)atomicAdd(ctr, 4u);
        __syncthreads();
        const int base = *(volatile LAS int*)qslot;
        if (base >= MOE_ITEMS) break;
#pragma unroll 1
        for (int it = base; it < base + 4 && it < MOE_ITEMS; ++it) {
            int r = it;
            if (r < NEXP * MOE_I_GU) { const int e = r / MOE_I_GU, q = r % MOE_I_GU;
                cvt_tile_fp8<2>(a.in[I_WGU] + (size_t)e * DM * 2 * DE, 2 * DE, DM, a.ws + WS_WGU + (size_t)e * 2 * DE * DM, q / 8, (q % 8) * 8 + wave, T, lane); continue; }
            r -= NEXP * MOE_I_GU;
            { const int e = r / MOE_I_D, q = r % MOE_I_D;
                cvt_tile_fp8<0>(a.in[I_WD] + (size_t)e * DE * DM, DM, DE, a.ws + WS_WD + (size_t)e * DM * DE, q / 4, (q % 4) * 8 + wave, T, lane); }
        }
    }
}

__device__ __forceinline__ void p2_qknorm(const Args& a, int gw, int NGW, int lane) {
    const bf16_t* P = (const bf16_t*)(a.ws + WS_P); bf16_t* QN = (bf16_t*)(a.ws + WS_QN); bf16_t* KN = (bf16_t*)(a.ws + WS_KN);
    const float qw0 = a.in[I_SBQNW][2 * lane], qw1 = a.in[I_SBQNW][2 * lane + 1], kw0 = a.in[I_SBKNW][2 * lane], kw1 = a.in[I_SBKNW][2 * lane + 1];
    const float QS = 0.08838834764831845f * 1.4426950408889634f;
    for (int it = gw; it < NTOK * NHEAD * 2; it += NGW) {
        const int which = it & 1, h = (it >> 1) & 7, row = it >> 4;
        const int b = row / LSEQ, t = row - b * LSEQ;
        const unsigned w = *(const unsigned*)(P + (size_t)row * NPROJ + (which ? PC_SBK : PC_SBQ) + h * HD + 2 * lane);
        const float v0 = bf_lo(w), v1 = bf_hi(w);
        const float rstd = 1.0f / sqrtf(wave_sum(v0 * v0 + v1 * v1) * (1.0f / HD) + NORM_EPS);
        const float o0 = which ? v0 * rstd * kw0 : v0 * rstd * qw0 * QS, o1 = which ? v1 * rstd * kw1 : v1 * rstd * qw1 * QS;
        *(unsigned*)((which ? KN : QN) + ((size_t)(b * NHEAD + h) * LROW + t) * HD + 2 * lane) = cvt_pk_bf16(o0, o1);
    }
}

__device__ __forceinline__ void p3_gdn_naive(const Args& a, LAS unsigned char* lds, int item, int tid, int lane, int wave) {
    const int b = item >> 3, h = item & 7;
    const bf16_t* P = (const bf16_t*)(a.ws + WS_P); const float* BETA = (const float*)(a.ws + WS_BETA); const float* GG = (const float*)(a.ws + WS_G);
    float* ORAW = (float*)(a.ws + WS_ORAW); bf16_t* MIX = (bf16_t*)(a.ws + WS_MIX);
    LAS float* buf = (LAS float*)lds;
    const int j = tid >> 2, part = tid & 3;
    const int which = tid >> 7, d = tid & 127; const bool conv = tid < 384;
    const int pcol = which * 1024 + h * HD + d;
    float cw0 = 0, cw1 = 0, cw2 = 0, cw3 = 0;
    if (conv) { const float* cwp = a.in[I_CONVW] + pcol; cw0 = cwp[0]; cw1 = cwp[3072]; cw2 = cwp[2 * 3072]; cw3 = cwp[3 * 3072]; }
    float xm1 = 0.f, xm2 = 0.f, xm3 = 0.f;
    float S[32];
#pragma unroll
    for (int i = 0; i < 32; ++i) S[i] = 0.f;
    const size_t row0 = (size_t)b * LSEQ;
    float xnext = conv ? bf2f(P[row0 * NPROJ + pcol]) : 0.f;
    float bnext = BETA[row0 * 8 + h], gnext = GG[row0 * 8 + h];
    for (int t = 0; t < LSEQ; ++t) {
        const float xt = xnext, beta = bnext, gam = expf(gnext);
        if (t + 1 < LSEQ) { if (conv) xnext = bf2f(P[(row0 + t + 1) * NPROJ + pcol]); bnext = BETA[(row0 + t + 1) * 8 + h]; gnext = GG[(row0 + t + 1) * 8 + h]; }
        LAS float* cb = buf + (t & 1) * 384;
        if (conv) { const float y = cw3 * xt + cw2 * xm1 + cw1 * xm2 + cw0 * xm3; xm3 = xm2; xm2 = xm1; xm1 = xt; cb[tid] = y / (1.0f + expf(-y)); }
        __syncthreads();
        float kk = 0.f, qq = 0.f, dk = 0.f; f32x4 kv[8], qv[8];
#pragma unroll
        for (int i = 0; i < 8; ++i) { kv[i] = *(const LAS f32x4*)(cb + 128 + 32 * part + 4 * i); qv[i] = *(const LAS f32x4*)(cb + 32 * part + 4 * i); }
#pragma unroll
        for (int i = 0; i < 8; ++i)
#pragma unroll
            for (int c = 0; c < 4; ++c) { kk += kv[i][c] * kv[i][c]; qq += qv[i][c] * qv[i][c]; dk += S[4 * i + c] * kv[i][c]; }
        kk += __shfl_xor(kk, 1); kk += __shfl_xor(kk, 2); qq += __shfl_xor(qq, 1); qq += __shfl_xor(qq, 2); dk += __shfl_xor(dk, 1); dk += __shfl_xor(dk, 2);
        const float rk = 1.0f / sqrtf(kk + NORM_EPS), rq = 0.08838834764831845f / sqrtf(qq + NORM_EPS);
        const float vj = cb[256 + j];
        const float vnew = beta * (vj - gam * rk * dk);
        const float kvn = rk * vnew; float oq = 0.f;
#pragma unroll
        for (int i = 0; i < 8; ++i)
#pragma unroll
            for (int c = 0; c < 4; ++c) { S[4 * i + c] = gam * S[4 * i + c] + kv[i][c] * kvn; oq += S[4 * i + c] * qv[i][c]; }
        oq += __shfl_xor(oq, 1); oq += __shfl_xor(oq, 2);
        if (t >= NMETA && part == 0) ORAW[((size_t)b * SEQ + (t - NMETA)) * 1024 + h * HD + j] = rq * oq;
    }
    __threadfence(); __syncthreads();
    const float nw0 = a.in[I_GDNNW][2 * lane], nw1 = a.in[I_GDNNW][2 * lane + 1];
    for (int s = wave; s < SEQ; s += NWAVES) {
        const size_t tok = (size_t)b * SEQ + s;
        const f32x2 o = *(const f32x2*)(ORAW + tok * 1024 + h * HD + 2 * lane);
        const float rstd = 1.0f / sqrtf(wave_sum(o.x * o.x + o.y * o.y) * (1.0f / HD) + NORM_EPS);
        const unsigned zw = *(const unsigned*)(P + (row0 + NMETA + s) * NPROJ + PC_Z + h * HD + 2 * lane);
        const float z0 = bf_lo(zw), z1 = bf_hi(zw);
        const float r0 = o.x * rstd * nw0 * (z0 / (1.0f + expf(-z0))), r1 = o.y * rstd * nw1 * (z1 / (1.0f + expf(-z1)));
        *(unsigned*)(MIX + tok * DM + h * HD + 2 * lane) = cvt_pk_bf16(r0, r1);
    }
}

__device__ __forceinline__ bf16x8 sba_pack8(const f32x16& p, int base) {
    u32x4 w; w.x = cvt_pk_bf16(p[base + 0], p[base + 1]); w.y = cvt_pk_bf16(p[base + 2], p[base + 3]); w.z = cvt_pk_bf16(p[base + 4], p[base + 5]); w.w = cvt_pk_bf16(p[base + 6], p[base + 7]);
    return __builtin_bit_cast(bf16x8, w);
}

namespace gdn {
constexpr int NCH = 65;
constexpr int IMG_W = 0, IMG_QG = 16384, IMG_KDT = 32768, IMG_AT = 49152, IMG_BYTES = 57344, IMG_U = 57344, CH_BYTES = 73728;
constexpr int L_QB = 0, L_KB = 17408, L_VB = 34816, L_LT = 52224, L_GC = 69632, L_BE = 69888, L_IMG = 70144;
__device__ __forceinline__ int afrag_off(int row, int k, int nks) {
    const int rt = row >> 5, rr = row & 31, ks = k >> 4, kk = k & 15, hi = (kk >> 2) & 1, sl = (kk & 3) + 4 * (kk >> 3);
    return ((rt * nks + ks) * 64 + rr + 32 * hi) * 16 + sl * 2;
}
__device__ __forceinline__ int ufrag_off(int i, int c) {
    const int cg = c >> 5, col = c & 31, rt = i >> 5, ii = i & 31, hi = (ii >> 2) & 1, r = (ii & 3) + 4 * (ii >> 3);
    return (((cg * 2 + rt) * 2 + (r >> 3)) * 64 + col + 32 * hi) * 8 + (r & 7);
}
__device__ __forceinline__ int crow(int r, int hi) { return (r & 3) + 8 * (r >> 2) + 4 * hi; }
__device__ __forceinline__ bf16_t f2bf(float f) { return (bf16_t)(cvt_pk_bf16(f, 0.f) & 0xffffu); }

__device__ __forceinline__ void precompute(const Args& a, LAS unsigned char* lds, int item, int tid, int lane, int wave) {
    asm volatile("" : "+v"(tid), "+v"(lane), "+s"(wave));
    const int bh = item / NCH, c = item - bh * NCH, b = bh >> 3, h = bh & 7;
    const bf16_t* P = (const bf16_t*)(a.ws + WS_P) + (size_t)b * LSEQ * NPROJ;
    const float* BETA = (const float*)(a.ws + WS_BETA) + (size_t)b * LSEQ * 8; const float* GG = (const float*)(a.ws + WS_G) + (size_t)b * LSEQ * 8;
    unsigned char* dst = a.ws + WS_GCH + (size_t)item * CH_BYTES;
    LAS float* GC = (LAS float*)(lds + L_GC); LAS float* BE = (LAS float*)(lds + L_BE); LAS float* LT = (LAS float*)(lds + L_LT);
    const int tbase = 64 * c - 48;
    if (wave == 0) {
        const int t = tbase + lane; float g = 0.f, be = 0.f;
        if (t >= 0) { g = GG[(size_t)t * 8 + h]; be = BETA[(size_t)t * 8 + h]; }
#pragma unroll
        for (int o = 1; o < 64; o <<= 1) { const float y = __shfl_up(g, o); if (lane >= o) g += y; }
        GC[lane] = g; BE[lane] = be;
        if (lane == 63) ((float*)(a.ws + WS_GL))[item] = expf(g);
    }
    {
        f32x2 cw[3][4];
#pragma unroll
        for (int w3 = 0; w3 < 3; ++w3)
#pragma unroll
            for (int tap = 0; tap < 4; ++tap) cw[w3][tap] = *(const f32x2*)(a.in[I_CONVW] + tap * 3072 + w3 * 1024 + h * HD + 2 * lane);
        f32x2 xw[3][11];
#pragma unroll
        for (int j = 0; j < 11; ++j) { const int t = tbase + 8 * wave - 3 + j;
#pragma unroll
            for (int w3 = 0; w3 < 3; ++w3) { unsigned u = 0u; if (t >= 0) u = *(const unsigned*)(P + (size_t)t * NPROJ + w3 * 1024 + h * HD + 2 * lane); xw[w3][j] = (f32x2){bf_lo(u), bf_hi(u)}; } }
#pragma unroll
        for (int rr = 0; rr < 8; ++rr) { const int i = 8 * wave + rr; f32x2 y[3];
#pragma unroll
            for (int w3 = 0; w3 < 3; ++w3) { f32x2 acc = cw[w3][0] * xw[w3][rr] + cw[w3][1] * xw[w3][rr + 1] + cw[w3][2] * xw[w3][rr + 2] + cw[w3][3] * xw[w3][rr + 3];
                acc.x = acc.x / (1.0f + __expf(-acc.x)); acc.y = acc.y / (1.0f + __expf(-acc.y)); y[w3] = acc; }
            const float rq = 0.08838834764831845f / sqrtf(wave_sum(y[0].x * y[0].x + y[0].y * y[0].y) + NORM_EPS);
            const float rk = 1.0f / sqrtf(wave_sum(y[1].x * y[1].x + y[1].y * y[1].y) + NORM_EPS);
            *(LAS unsigned*)(lds + L_QB + i * 272 + 4 * lane) = cvt_pk_bf16(y[0].x * rq, y[0].y * rq);
            *(LAS unsigned*)(lds + L_KB + i * 272 + 4 * lane) = cvt_pk_bf16(y[1].x * rk, y[1].y * rk);
            *(LAS unsigned*)(lds + L_VB + i * 272 + 4 * lane) = cvt_pk_bf16(y[2].x, y[2].y); }
    }
    __syncthreads();
    {
        const int prod = wave >> 2, ti = (wave >> 1) & 1, tj = wave & 1, r32 = lane & 31, hi = lane >> 5;
        if (tj <= ti) {
            f32x16 acc;
#pragma unroll
            for (int r = 0; r < 16; ++r) acc[r] = 0.f;
            const LAS unsigned char* Ab = lds + (prod ? L_QB : L_KB) + (32 * ti + r32) * 272 + hi * 16;
            const LAS unsigned char* Bb = lds + L_KB + (32 * tj + r32) * 272 + hi * 16;
#pragma unroll
            for (int ks = 0; ks < 8; ++ks) acc = __builtin_amdgcn_mfma_f32_32x32x16_bf16(*(const LAS bf16x8*)(Ab + ks * 32), *(const LAS bf16x8*)(Bb + ks * 32), acc, 0, 0, 0);
            const int j = 32 * tj + r32; const float gj = GC[j];
#pragma unroll
            for (int r = 0; r < 16; ++r) { const int i = 32 * ti + crow(r, hi); const float dec = __expf(GC[i] - gj);
                if (prod == 0) LT[j * 68 + i] = (j < i) ? acc[r] * BE[i] * dec : 0.f;
                else *(LAS bf16_t*)(lds + L_IMG + IMG_AT + afrag_off(i, j, 4)) = f2bf((j <= i) ? acc[r] * dec : 0.f); }
        }
    }
    __syncthreads();
    if (tid < 256) {
        float x[64];
        const bool isv = tid < 128; const int cc = tid & 127;
        const LAS unsigned char* src = lds + (isv ? L_VB : L_KB) + cc * 2;
#pragma unroll
        for (int i8 = 0; i8 < 64; i8 += 8) {
#pragma unroll
            for (int q = 0; q < 8; ++q) { const int i = i8 + q; const float v = bf2f(*(const LAS bf16_t*)(src + i * 272)); x[i] = v * BE[i] * (isv ? 1.0f : __expf(GC[i])); }
            asm volatile("" ::: "memory"); }
#pragma unroll
        for (int j = 0; j < 63; ++j) {
#pragma unroll
            for (int i4 = ((j + 1) & ~3); i4 < 64; i4 += 4) { const f32x4 l4 = *(const LAS f32x4*)(LT + j * 68 + i4);
#pragma unroll
                for (int q = 0; q < 4; ++q) if (i4 + q > j) x[i4 + q] -= l4[q] * x[j]; }
            asm volatile("" ::: "memory");
        }
        if (isv) {
            LAS unsigned char* ub = lds + L_IMG + IMG_U + (((cc >> 5) * 4 * 64) + (cc & 31)) * 16;
#pragma unroll
            for (int i = 0; i < 64; ++i) { const int rt = i >> 5, ii = i & 31, hi = (ii >> 2) & 1, r = (ii & 3) + 4 * (ii >> 3);
                *(LAS bf16_t*)(ub + (((rt * 2 + (r >> 3)) * 64 + 32 * hi) * 8 + (r & 7)) * 2) = f2bf(x[i]); }
        } else {
            const int ks = cc >> 4, kk = cc & 15, hi = (kk >> 2) & 1, sl = (kk & 3) + 4 * (kk >> 3);
            LAS unsigned char* wb = lds + L_IMG + IMG_W + (ks * 64 + 32 * hi) * 16 + sl * 2;
#pragma unroll
            for (int i = 0; i < 64; ++i) *(LAS bf16_t*)(wb + ((i >> 5) * 8 * 64 + (i & 31)) * 16) = f2bf(-x[i]);
        }
    } else {
        const int u = tid - 256, dk = u & 127, i0 = (u >> 7) * 32; const float gl = GC[63];
#pragma unroll 4
        for (int ii = 0; ii < 32; ++ii) { const int i = i0 + ii; const float gi = GC[i];
            const float q = bf2f(*(const LAS bf16_t*)(lds + L_QB + i * 272 + dk * 2)), k = bf2f(*(const LAS bf16_t*)(lds + L_KB + i * 272 + dk * 2));
            *(LAS bf16_t*)(lds + L_IMG + IMG_QG + afrag_off(i, dk, 8)) = f2bf(q * __expf(gi));
            *(LAS bf16_t*)(lds + L_IMG + IMG_KDT + afrag_off(dk, i, 4)) = f2bf(k * __expf(gl - gi)); }
    }
    __syncthreads();
    for (int q = tid; q < CH_BYTES / 16; q += NTHREADS) *(u32x4*)(dst + (size_t)q * 16) = *(const LAS u32x4*)(lds + L_IMG + q * 16);
}

constexpr int OB_OFF = 2 * IMG_BYTES, OB_STR = 264, OB_BYTES = 64 * OB_STR;
__device__ __forceinline__ void gated_rows(const Args& a, const LAS unsigned char* ob, int b, int h, int cc, int w4, int lane, float nw0, float nw1) {
    const bf16_t* P = (const bf16_t*)(a.ws + WS_P); bf16_t* MIX = (bf16_t*)(a.ws + WS_MIX);
    const int s0 = 64 * (cc - 1) + 16 * w4;
    unsigned zw[16], ov[16]; float ss[16];
#pragma unroll
    for (int rr = 0; rr < 16; ++rr) zw[rr] = *(const unsigned*)(P + ((size_t)b * LSEQ + NMETA + s0 + rr) * NPROJ + PC_Z + h * HD + 2 * lane);
#pragma unroll
    for (int rr = 0; rr < 16; ++rr) { ov[rr] = *(const LAS unsigned*)(ob + (16 * w4 + rr) * OB_STR + 4 * lane); const float o0 = bf_lo(ov[rr]), o1 = bf_hi(ov[rr]); ss[rr] = o0 * o0 + o1 * o1; }
#pragma unroll
    for (int o = 1; o < 64; o <<= 1)
#pragma unroll
        for (int rr = 0; rr < 16; ++rr) ss[rr] += __shfl_xor(ss[rr], o);
#pragma unroll
    for (int rr = 0; rr < 16; ++rr) {
        const float o0 = bf_lo(ov[rr]), o1 = bf_hi(ov[rr]);
        const float rstd = __builtin_amdgcn_rsqf(ss[rr] * (1.0f / HD) + NORM_EPS);
        const float z0 = bf_lo(zw[rr]), z1 = bf_hi(zw[rr]);
        const float r0 = o0 * rstd * nw0 * (z0 / (1.0f + __expf(-z0))), r1 = o1 * rstd * nw1 * (z1 / (1.0f + __expf(-z1)));
        *(unsigned*)(MIX + ((size_t)b * SEQ + s0 + rr) * DM + h * HD + 2 * lane) = cvt_pk_bf16(r0, r1);
    }
}

__device__ __forceinline__ void scan(const Args& a, LAS unsigned char* lds, int bh, int tid, int lane, int wave) {
    const int b = bh >> 3, h = bh & 7, col = lane & 31, hi = lane >> 5, cg = wave;
    const unsigned char* src = a.ws + WS_GCH + (size_t)bh * NCH * CH_BYTES;
    const float* GL = (const float*)(a.ws + WS_GL) + bh * NCH;
    const float nw0 = a.in[I_GDNNW][2 * lane], nw1 = a.in[I_GDNNW][2 * lane + 1];
    __syncthreads();
    const unsigned dvoff = (unsigned)(wave * 1024 + lane * 16), uvoff = (unsigned)(lane * 16);
#define GDN_DMA(ch, buf) do { const unsigned char* _sp = src + (size_t)(ch) * CH_BYTES; _Pragma("unroll") for (int _f = 0; _f < 7; ++_f) { \
        __builtin_amdgcn_global_load_lds((const unsigned*)(_sp + _f * 8192 + dvoff), (LAS unsigned*)(lds + (buf) * IMG_BYTES + wave * 1024 + _f * 8192), 16, 0, 0); } } while (0)
    GDN_DMA(0, 0);
    f32x16 st[4]; bf16x8 Sb[8]; u32x4 ureg[4]; float gl = 1.f;
#pragma unroll
    for (int t4 = 0; t4 < 4; ++t4)
#pragma unroll
        for (int r = 0; r < 16; ++r) st[t4][r] = 0.f;
#pragma unroll
    for (int ks = 0; ks < 8; ++ks) Sb[ks] = (bf16x8){0, 0, 0, 0, 0, 0, 0, 0};
    if (wave < 4) {
#pragma unroll
        for (int q = 0; q < 4; ++q) ureg[q] = *(const u32x4*)(src + IMG_U + cg * 4096 + q * 1024 + uvoff);
        gl = GL[0];
    }
    VM_WAIT(); __syncthreads();
    for (int c = 0; c < NCH; ++c) {
        const LAS unsigned char* img = lds + (c & 1) * IMG_BYTES + lane * 16;
        if (c + 1 < NCH) GDN_DMA(c + 1, (c + 1) & 1);
        if (wave < 4) {
            f32x16 vn[2]; const float glc = gl;
#pragma unroll
            for (int rt = 0; rt < 2; ++rt)
#pragma unroll
                for (int rh = 0; rh < 2; ++rh) { const u32x4 w = ureg[rt * 2 + rh];
                    vn[rt][8 * rh + 0] = bf_lo(w.x); vn[rt][8 * rh + 1] = bf_hi(w.x); vn[rt][8 * rh + 2] = bf_lo(w.y); vn[rt][8 * rh + 3] = bf_hi(w.y);
                    vn[rt][8 * rh + 4] = bf_lo(w.z); vn[rt][8 * rh + 5] = bf_hi(w.z); vn[rt][8 * rh + 6] = bf_lo(w.w); vn[rt][8 * rh + 7] = bf_hi(w.w); }
            asm volatile("" ::: "memory");
            if (c + 1 < NCH) {
#pragma unroll
                for (int q = 0; q < 4; ++q) ureg[q] = *(const u32x4*)(src + (size_t)(c + 1) * CH_BYTES + IMG_U + cg * 4096 + q * 1024 + uvoff);
                gl = GL[c + 1]; }
#pragma unroll
            for (int rt = 0; rt < 2; ++rt) { __builtin_amdgcn_sched_barrier(0);
#pragma unroll
                for (int ks = 0; ks < 8; ++ks) vn[rt] = __builtin_amdgcn_mfma_f32_32x32x16_bf16(*(const LAS bf16x8*)(img + IMG_W + (rt * 8 + ks) * 1024), Sb[ks], vn[rt], 0, 0, 0); }
            __builtin_amdgcn_sched_barrier(0);
            bf16x8 vb[4];
#pragma unroll
            for (int ks = 0; ks < 4; ++ks) vb[ks] = sba_pack8(vn[ks >> 1], 8 * (ks & 1));
            LAS unsigned char* obw = lds + OB_OFF + (c & 1) * OB_BYTES + (32 * cg + col) * 2;
#pragma unroll
            for (int rt = 0; rt < 2; ++rt) { f32x16 o; __builtin_amdgcn_sched_barrier(0);
#pragma unroll
                for (int r = 0; r < 16; ++r) o[r] = 0.f;
#pragma unroll
                for (int ks = 0; ks < 8; ++ks) o = __builtin_amdgcn_mfma_f32_32x32x16_bf16(*(const LAS bf16x8*)(img + IMG_QG + (rt * 8 + ks) * 1024), Sb[ks], o, 0, 0, 0);
#pragma unroll
                for (int ks = 0; ks < 2 * (rt + 1); ++ks) o = __builtin_amdgcn_mfma_f32_32x32x16_bf16(*(const LAS bf16x8*)(img + IMG_AT + (rt * 4 + ks) * 1024), vb[ks], o, 0, 0, 0);
                if (c >= 1) {
#pragma unroll
                    for (int r = 0; r < 16; ++r) *(LAS bf16_t*)(obw + (32 * rt + crow(r, hi)) * OB_STR) = f2bf(o[r]); }
            }
#pragma unroll
            for (int t4 = 0; t4 < 4; ++t4) { __builtin_amdgcn_sched_barrier(0);
#pragma unroll
                for (int r = 0; r < 16; ++r) st[t4][r] *= glc;
#pragma unroll
                for (int ks = 0; ks < 4; ++ks) st[t4] = __builtin_amdgcn_mfma_f32_32x32x16_bf16(*(const LAS bf16x8*)(img + IMG_KDT + (t4 * 4 + ks) * 1024), vb[ks], st[t4], 0, 0, 0);
                Sb[2 * t4] = sba_pack8(st[t4], 0); Sb[2 * t4 + 1] = sba_pack8(st[t4], 8); }
        }
        else if (c >= 2) gated_rows(a, lds + OB_OFF + ((c - 1) & 1) * OB_BYTES, b, h, c - 1, wave - 4, lane, nw0, nw1);
        VM_WAIT(); __syncthreads();
    }
#undef GDN_DMA
    if (wave >= 4) gated_rows(a, lds + OB_OFF + ((NCH - 1) & 1) * OB_BYTES, b, h, NCH - 1, wave - 4, lane, nw0, nw1);
}
}

namespace sba {
#define KSWZ(row, colB) ((row) * 256 + ((colB) ^ (((row) & 7) << 4)))
__device__ __forceinline__ int v_st(int k, int c) { const int kk = (k & ~0xC) | ((k & 4) << 1) | ((k & 8) >> 1); return ((kk >> 3) * 4 + (c >> 5)) * 512 + ((kk & 7) * 32 + (c & 31)) * 2; }
__device__ __forceinline__ int v_rd_base(int lane) { return ((lane & 3) << 3) | (((lane >> 2) & 3) << 6) | (((lane >> 4) & 1) << 5) | (((lane >> 5) & 1) << 8); }
constexpr int v_rd_off(int d0, int ks, int half) { return d0 * 512 + ks * 4096 + half * 2048; }
template <int OFF> __device__ __forceinline__ s16x4 tr_read(int vb) { s16x4 r; asm volatile("ds_read_b64_tr_b16 %0, %1 offset:%2" : "=&v"(r) : "v"(vb), "i"(OFF) : "memory"); return r; }
template <int D0> __device__ __forceinline__ void pv_one(f32x16& od, int vb, bf16x8 pa0, bf16x8 pa1, bf16x8 pa2, bf16x8 pa3) {
    const s16x4 l0 = tr_read<v_rd_off(D0, 0, 0)>(vb), h0 = tr_read<v_rd_off(D0, 0, 1)>(vb), l1 = tr_read<v_rd_off(D0, 1, 0)>(vb), h1 = tr_read<v_rd_off(D0, 1, 1)>(vb);
    const s16x4 l2 = tr_read<v_rd_off(D0, 2, 0)>(vb), h2 = tr_read<v_rd_off(D0, 2, 1)>(vb), l3 = tr_read<v_rd_off(D0, 3, 0)>(vb), h3 = tr_read<v_rd_off(D0, 3, 1)>(vb);
    asm volatile("s_waitcnt lgkmcnt(0)" ::: "memory"); __builtin_amdgcn_sched_barrier(0);
#define PK(L, H) (bf16x8){L[0], L[1], L[2], L[3], H[0], H[1], H[2], H[3]}
    od = __builtin_amdgcn_mfma_f32_32x32x16_bf16(pa0, PK(l0, h0), od, 0, 0, 0);
    od = __builtin_amdgcn_mfma_f32_32x32x16_bf16(pa1, PK(l1, h1), od, 0, 0, 0);
    od = __builtin_amdgcn_mfma_f32_32x32x16_bf16(pa2, PK(l2, h2), od, 0, 0, 0);
    od = __builtin_amdgcn_mfma_f32_32x32x16_bf16(pa3, PK(l3, h3), od, 0, 0, 0);
#undef PK
}
__device__ __forceinline__ int crow(int r, int hi) { return (r & 3) + 8 * (r >> 2) + 4 * hi; }
__device__ __forceinline__ int swap34(int k) { return (k & ~0x18) | ((k & 8) << 1) | ((k & 16) >> 1); }
__device__ __forceinline__ bf16x8 pack8(const f32x16& p, int base) {
    u32x4 w; w.x = cvt_pk_bf16(p[base + 0], p[base + 1]); w.y = cvt_pk_bf16(p[base + 2], p[base + 3]); w.z = cvt_pk_bf16(p[base + 4], p[base + 5]); w.w = cvt_pk_bf16(p[base + 6], p[base + 7]);
    return __builtin_bit_cast(bf16x8, w);
}
constexpr float SB_EXIT = 160.0f;

__device__ __forceinline__ void unit(const Args& a, LAS unsigned char* lds, volatile LAS int* done_cnt, int b, int h, int qb, int tid, int lane, int wid) {
    const bf16_t* QN = (const bf16_t*)(a.ws + WS_QN) + (size_t)(b * NHEAD + h) * LROW * HD;
    const bf16_t* KN = (const bf16_t*)(a.ws + WS_KN) + (size_t)(b * NHEAD + h) * LROW * HD;
    const bf16_t* Vp = (const bf16_t*)(a.ws + WS_P) + (size_t)b * LSEQ * NPROJ + PC_SBV + h * HD;
    bf16_t* MIX = (bf16_t*)(a.ws + WS_MIX);
    const int r32 = lane & 31, hi = lane >> 5;
    LAS unsigned char* K_lds = lds; LAS unsigned char* V_lds = lds + 16384;
    const int tq0 = NMETA + 256 * qb + 32 * wid, tq = tq0 + r32;
    __syncthreads();
    if (tid == 0) *done_cnt = 0;
    bf16x8 qr[8];
#pragma unroll
    for (int d0 = 0; d0 < 8; ++d0) qr[d0] = *(const bf16x8*)(QN + (size_t)tq * HD + d0 * 16 + hi * 8);
    const int sr = tid >> 4, sc = (tid & 15) * 8;
    const int vst0 = v_st(swap34(sr), sc), vst1 = v_st(32 + swap34(sr), sc);
    const int kst0 = KSWZ(sr, sc * 2), kst1 = KSWZ(32 + sr, sc * 2);
    const int vb0 = (int)(unsigned)(unsigned long)V_lds + v_rd_base(lane);
    const int prow = (r32 & 3) + 4 * (r32 >> 3) + 16 * ((r32 >> 2) & 1);
    f32x16 o[4];
#pragma unroll
    for (int d = 0; d < 4; ++d)
#pragma unroll
        for (int r = 0; r < 16; ++r) o[d][r] = 0.f;
    float carry = 0.f; bool flagged = false;
    for (int kt = 4 * qb + 4; kt >= 0; --kt) {
        const int k0 = 64 * kt;
        const bf16x8 ks0 = *(const bf16x8*)(KN + (size_t)(k0 + sr) * HD + sc), ks1 = *(const bf16x8*)(KN + (size_t)(k0 + 32 + sr) * HD + sc);
        const bf16x8 vs0 = *(const bf16x8*)(Vp + (size_t)(k0 + sr) * NPROJ + sc), vs1 = *(const bf16x8*)(Vp + (size_t)(k0 + 32 + sr) * NPROJ + sc);
        __syncthreads();
        if (*done_cnt == NWAVES) break;
        *(LAS bf16x8*)(K_lds + kst0) = ks0; *(LAS bf16x8*)(K_lds + kst1) = ks1; *(LAS bf16x8*)(V_lds + vst0) = vs0; *(LAS bf16x8*)(V_lds + vst1) = vs1;
        __syncthreads();
        if (k0 >= tq0 + 32) continue;
        f32x16 p0, p1;
#pragma unroll
        for (int r = 0; r < 16; ++r) { p0[r] = 0.f; p1[r] = 0.f; }
#pragma unroll
        for (int d0 = 0; d0 < 8; ++d0) { const int cb = (d0 * 16 + hi * 8) * 2;
            const bf16x8 b0 = *(const LAS bf16x8*)(K_lds + KSWZ(prow, cb)), b1 = *(const LAS bf16x8*)(K_lds + KSWZ(32 + prow, cb));
            p0 = __builtin_amdgcn_mfma_f32_32x32x16_bf16(b0, qr[d0], p0, 0, 0, 0);
            p1 = __builtin_amdgcn_mfma_f32_32x32x16_bf16(b1, qr[d0], p1, 0, 0, 0); }
        const bool need_mask = (k0 + 63 >= tq0);
        f32x16 s0, s1; float t0 = 0.f, t1 = 0.f;
#pragma unroll
        for (int r = 0; r < 16; ++r) {
            float e0 = __builtin_amdgcn_exp2f(p0[r]), e1 = __builtin_amdgcn_exp2f(p1[r]);
            float q0 = __builtin_amdgcn_logf(1.0f + e0), q1 = __builtin_amdgcn_logf(1.0f + e1);
            if (need_mask) { const bool v0 = (k0 + 16 * hi + r) < tq, v1 = (k0 + 32 + 16 * hi + r) < tq; e0 = v0 ? e0 : 0.f; q0 = v0 ? q0 : 0.f; e1 = v1 ? e1 : 0.f; q1 = v1 ? q1 : 0.f; }
            p0[r] = e0; p1[r] = e1; s0[r] = q0; s1[r] = q1; t0 += q0; t1 += q1; }
        float t1lo, t1hi, t0lo, t0hi;
        { auto rr = __builtin_amdgcn_permlane32_swap(__float_as_uint(t1), __float_as_uint(t1), false, false); t1lo = __uint_as_float(rr[0]); t1hi = __uint_as_float(rr[1]); }
        { auto rr = __builtin_amdgcn_permlane32_swap(__float_as_uint(t0), __float_as_uint(t0), false, false); t0lo = __uint_as_float(rr[0]); t0hi = __uint_as_float(rr[1]); }
        float run1 = carry + (hi ? 0.f : t1hi), run0 = carry + (t1lo + t1hi) + (hi ? 0.f : t0hi);
#pragma unroll
        for (int r = 15; r >= 0; --r) { run1 += s1[r]; p1[r] = p1[r] * __builtin_amdgcn_exp2f(-run1); run0 += s0[r]; p0[r] = p0[r] * __builtin_amdgcn_exp2f(-run0); }
        carry += (t1lo + t1hi) + (t0lo + t0hi);
        const bf16x8 pa0 = pack8(p0, 0), pa1 = pack8(p0, 8), pa2 = pack8(p1, 0), pa3 = pack8(p1, 8);
        pv_one<0>(o[0], vb0, pa0, pa1, pa2, pa3); pv_one<1>(o[1], vb0, pa0, pa1, pa2, pa3); pv_one<2>(o[2], vb0, pa0, pa1, pa2, pa3); pv_one<3>(o[3], vb0, pa0, pa1, pa2, pa3);
        if (!flagged && __all(carry >= SB_EXIT)) { flagged = true; if (lane == 0) (void)__hip_atomic_fetch_add((LAS int*)done_cnt, 1, __ATOMIC_RELAXED, __HIP_MEMORY_SCOPE_WORKGROUP); }
    }
    const float* onw = a.in[I_SBONW];
    float wv[4];
#pragma unroll
    for (int d0 = 0; d0 < 4; ++d0) wv[d0] = onw[32 * d0 + r32];
#pragma unroll
    for (int r = 0; r < 16; ++r) {
        float ss = (o[0][r] * o[0][r] + o[1][r] * o[1][r]) + (o[2][r] * o[2][r] + o[3][r] * o[3][r]);
        ss += __shfl_xor(ss, 1); ss += __shfl_xor(ss, 2); ss += __shfl_xor(ss, 4); ss += __shfl_xor(ss, 8); ss += __shfl_xor(ss, 16);
        const float rstd = 1.0f / sqrtf(ss * (1.0f / HD) + NORM_EPS);
        const size_t tok = (size_t)b * SEQ + (tq0 - NMETA) + crow(r, hi);
        bf16_t* dst = MIX + tok * DM + 1024 + h * HD + r32;
#pragma unroll
        for (int d0 = 0; d0 < 4; ++d0) dst[32 * d0] = (bf16_t)(cvt_pk_bf16(o[d0][r] * rstd * wv[d0], 0.f) & 0xffffu);
    }
}
}

__device__ __forceinline__ void p5_router(const Args& a, LAS unsigned char* lds, int G, int c, int tid, int lane, int wave) {
    LAS float* wl = (LAS float*)lds;
    LAS float* lg = (LAS float*)(lds + 132096);
    LAS int* misc = (LAS int*)(lds + MISC_OFF);
    const float* H1 = a.out; const float* rw = a.in[I_RW]; const float* rb = a.in[I_RB];
    unsigned char* HN2 = a.ws + WS_HN;
    int* RE = (int*)(a.ws + WS_RE); int* RP = (int*)(a.ws + WS_RP); float* RG = (float*)(a.ws + WS_RG); int* LIST = (int*)(a.ws + WS_LIST);
    unsigned* ecnt = (unsigned*)(a.ws + WS_CTL) + CW_ECNT;
    f32x4 wn[8];
#pragma unroll
    for (int j = 0; j < 8; ++j) wn[j] = *((const f32x4*)a.in[I_FFNNW] + lane + 64 * j);
    for (int blk = c; blk < NREAL / 64; blk += G) {
        for (int pass = 0; pass < 2; ++pass) {
            __syncthreads();
            stage_w16(wl, rw, NEXP, pass * 16, tid);
            if (pass == 0 && tid < 32) misc[40 + tid] = 0;
            __syncthreads();
            for (int rr = 0; rr < 8; ++rr) {
                const int rloc = wave * 8 + rr; const size_t row = (size_t)blk * 64 + rloc;
                f32x4 v[8]; float ss = 0.f;
#pragma unroll
                for (int j = 0; j < 8; ++j) { v[j] = *((const f32x4*)(H1 + row * DM) + lane + 64 * j); ss += (v[j].x * v[j].x + v[j].y * v[j].y) + (v[j].z * v[j].z + v[j].w * v[j].w); }
                const float rstd = 1.0f / sqrtf(wave_sum(ss) * (1.0f / DM) + NORM_EPS);
                GAS unsigned* o4 = (GAS unsigned*)(HN2 + row * DM) + lane;
#pragma unroll
                for (int j = 0; j < 8; ++j) { v[j] = v[j] * rstd * wn[j];
                    if (pass == 0) o4[64 * j] = pk4_fp8(v[j].x, v[j].y, v[j].z, v[j].w); }
                float s[16]; dot16(v, wl, lane, s);
                float sv = s[0];
#pragma unroll
                for (int cc = 1; cc < 16; ++cc) sv = ((lane & 15) == cc) ? s[cc] : sv;
                if (lane < 16) lg[rloc * 33 + pass * 16 + lane] = sv;
            }
        }
        __syncthreads();
        int ek[4] = {0, 0, 0, 0}, rk[4] = {0, 0, 0, 0}; float gk[4] = {0.f, 0.f, 0.f, 0.f};
        if (tid < 64) {
            float v[32];
#pragma unroll
            for (int e = 0; e < 32; ++e) v[e] = lg[tid * 33 + e] + rb[e];
            float val[4];
#pragma unroll
            for (int k = 0; k < 4; ++k) { float best = -3.0e38f; int bi = 0;
#pragma unroll
                for (int e = 0; e < 32; ++e) { const bool gt = v[e] > best; best = gt ? v[e] : best; bi = gt ? e : bi; }
#pragma unroll
                for (int e = 0; e < 32; ++e) v[e] = (e == bi) ? -3.0e38f : v[e];
                ek[k] = bi; val[k] = best; }
            float den = 0.f;
#pragma unroll
            for (int k = 0; k < 4; ++k) { gk[k] = expf(val[k] - val[0]); den += gk[k]; }
#pragma unroll
            for (int k = 0; k < 4; ++k) { gk[k] = gk[k] / den; rk[k] = __hip_atomic_fetch_add(&misc[40 + ek[k]], 1, __ATOMIC_RELAXED, __HIP_MEMORY_SCOPE_WORKGROUP); }
        }
        __syncthreads();
        if (tid < 32) { const int cnt = misc[40 + tid]; misc[72 + tid] = cnt ? (int)atomicAdd(&ecnt[tid], (unsigned)cnt) : 0; }
        __syncthreads();
        if (tid < 64) { const int tok = blk * 64 + tid;
#pragma unroll
            for (int k = 0; k < 4; ++k) { const int pos = misc[72 + ek[k]] + rk[k]; LIST[(size_t)ek[k] * NREAL + pos] = tok; RE[tok * 4 + k] = ek[k]; RP[tok * 4 + k] = pos; RG[tok * 4 + k] = gk[k]; } }
    }
    __syncthreads();
}

__device__ __forceinline__ int moe_setup(const Args& a, LAS int* misc, int tid) {
    const unsigned* ecnt = (const unsigned*)(a.ws + WS_CTL) + CW_ECNT;
    __syncthreads();
    if (tid == 0) { int acc = 0;
        for (int e = 0; e < NEXP; ++e) { const int cnt = (int)__hip_atomic_load(ecnt + e, __ATOMIC_RELAXED, __HIP_MEMORY_SCOPE_AGENT); misc[104 + e] = cnt; misc[e] = acc; acc += (cnt + 255) >> 8; }
        misc[32] = acc; }
    __syncthreads();
    return misc[32];
}

__device__ __forceinline__ void p8_combine(const Args& a, const LAS int* misc, int gw, int NGW, int lane) {
    const int* RE = (const int*)(a.ws + WS_RE); const int* RP = (const int*)(a.ws + WS_RP); const float* RG = (const float*)(a.ws + WS_RG);
    const bf16_t* Y = (const bf16_t*)(a.ws + WS_Y); const float* bd = a.in[I_BD]; float* out = a.out;
    for (int row = gw; row < NREAL; row += NGW) {
        int e[4]; size_t slot[4]; float g[4];
#pragma unroll
        for (int k = 0; k < 4; ++k) { e[k] = RE[row * 4 + k]; slot[k] = (size_t)misc[e[k]] * 256 + RP[row * 4 + k]; g[k] = RG[row * 4 + k]; }
#pragma unroll
        for (int j = 0; j < 4; ++j) { const int col = 8 * lane + 512 * j;
            f32x4 a0 = *(const f32x4*)(out + (size_t)row * DM + col), a1 = *(const f32x4*)(out + (size_t)row * DM + col + 4);
#pragma unroll
            for (int k = 0; k < 4; ++k) { const u32x4 y = *(const u32x4*)(Y + slot[k] * DM + col);
                const f32x4 b0 = *(const f32x4*)(bd + (size_t)e[k] * DM + col), b1 = *(const f32x4*)(bd + (size_t)e[k] * DM + col + 4);
                a0.x += g[k] * (bf_lo(y.x) + b0.x); a0.y += g[k] * (bf_hi(y.x) + b0.y); a0.z += g[k] * (bf_lo(y.y) + b0.z); a0.w += g[k] * (bf_hi(y.y) + b0.w);
                a1.x += g[k] * (bf_lo(y.z) + b1.x); a1.y += g[k] * (bf_hi(y.z) + b1.y); a1.z += g[k] * (bf_lo(y.w) + b1.z); a1.w += g[k] * (bf_hi(y.w) + b1.w); }
            *(f32x4*)(out + (size_t)row * DM + col) = a0; *(f32x4*)(out + (size_t)row * DM + col + 4) = a1; }
    }
}

__device__ __forceinline__ void p1_meta_rows(const Args& a, int bx, int G, int wave, int lane) {
    const bf16_t* HN = (const bf16_t*)(a.ws + WS_HN); const bf16_t* WT = (const bf16_t*)(a.ws + WS_WIN); bf16_t* P = (bf16_t*)(a.ws + WS_P);
    for (int col = bx; col < NPROJ; col += G) {
        u32x4 w[4];
#pragma unroll
        for (int j = 0; j < 4; ++j) w[j] = *(const u32x4*)(WT + (size_t)col * DM + 8 * lane + 512 * j);
        for (int t = wave; t < NMETA; t += NWAVES) {
            float acc = 0.f;
#pragma unroll
            for (int j = 0; j < 4; ++j) { const u32x4 x = *(const u32x4*)(HN + (size_t)t * DM + 8 * lane + 512 * j);
                acc += bf_lo(x.x) * bf_lo(w[j].x) + bf_hi(x.x) * bf_hi(w[j].x) + bf_lo(x.y) * bf_lo(w[j].y) + bf_hi(x.y) * bf_hi(w[j].y)
                     + bf_lo(x.z) * bf_lo(w[j].z) + bf_hi(x.z) * bf_hi(w[j].z) + bf_lo(x.w) * bf_lo(w[j].w) + bf_hi(x.w) * bf_hi(w[j].w); }
            acc = wave_sum(acc);
            if (lane < NB) P[((size_t)lane * LSEQ + t) * NPROJ + col] = gdn::f2bf(acc);
        }
    }
}

constexpr int NPH = 9;
__global__ void __launch_bounds__(NTHREADS, 2) hymba_fwd(Args args) {
    extern __shared__ __attribute__((aligned(16))) unsigned char lds_raw[];
    LAS unsigned char* lds = (LAS unsigned char*)lds_raw;
    LAS int* misc = (LAS int*)(lds + MISC_OFF);
    const int tid = threadIdx.x, lane = tid & 63, wave = __builtin_amdgcn_readfirstlane(tid >> 6);
    const int G = gridDim.x, bx = blockIdx.x;
    const int vcu = (G % 8 == 0) ? (bx % 8) * (G / 8) + bx / 8 : bx;
    const int gw = vcu * NWAVES + wave, NGW = G * NWAVES;
    unsigned* ctl = (unsigned*)(args.ws + WS_CTL);
    for (int u = tid; u < 256; u += NTHREADS) misc[u] = 0;
    __syncthreads();
    XcdBarrier bar; bar.bar = ctl + CW_BAR; bar.x = 0; bar.st = nullptr;
    const int lo = args.ph_lo, hi = args.ph_hi;
    if (hi - lo > 1) bar = xcd_barrier_post(ctl + CW_BAR, (volatile LAS unsigned*)(misc + 200));
#ifdef ONLY
#define IN(k) ((k) == ONLY && lo <= (k) && (k) < hi)
#else
#define IN(k) (lo <= (k) && (k) < hi)
#endif
#ifndef REP_COUNT
#define REP_COUNT 2
#endif
#define REPEAT(k) _Pragma("unroll") for (int _r = 0; _r < ((REP_PHASE == (k)) ? REP_COUNT : 1); ++_r)
#define SEAM(k) do { if (IN(k) && IN((k) + 1)) xcd_barrier(bar); if (PROBE_A >= 0 && tid == 0) tsl[(k) + 1] = __builtin_amdgcn_s_memrealtime(); } while (0)

    LAS unsigned long long* tsl = (LAS unsigned long long*)(lds + MISC_OFF + 896);
    if (PROBE_A >= 0 && tid == 0) tsl[0] = __builtin_amdgcn_s_memrealtime();
    if (IN(0)) REPEAT(0) { p0_rows(args, lds, gw, NGW, tid, lane); p0_weights(args, lds, vcu, G, wave, lane); }
    SEAM(0);
    if (IN(1)) REPEAT(1) {
        p1_meta_rows(args, bx, G, wave, lane);
        pg8::PlainOrder S; S.init(NREAL, NPROJ, DM, args.ws + WS_WIN, G, bx); S.meta = 1;
        pg8::EpiBf16 E{(bf16_t*)(args.ws + (_r ? WS_ACT : WS_P)), NPROJ, 1};
        pg8::gemm_phase<pg8::EpiBf16, pg8::PlainOrder, true, true>(lds, (const char*)(args.ws + WS_HN), DM * 2, S, E);
    }
    SEAM(1);
    if (IN(2)) REPEAT(2) {
        p2_qknorm(args, gw, NGW, lane);
#if GDN_CHUNKED
        for (int it = bx; it < 32 * gdn::NCH; it += G) { __syncthreads(); gdn::precompute(args, lds, it, tid, lane, wave); }
#endif
    }
    SEAM(2);
    if (IN(3)) REPEAT(3) {
        const int NG = (G >= 64) ? 32 : 0;
#if GDN_CHUNKED
        if (bx < 32 || NG == 0) { for (int it = bx; it < 32; it += G) gdn::scan(args, lds, it, tid, lane, wave); }
#else
        if (bx < 32 || NG == 0) { for (int it = bx; it < 32; it += G) p3_gdn_naive(args, lds, it, tid, lane, wave); }
#endif
        if (bx >= NG) { for (int u = bx - NG; u < 512; u += G - NG) sba::unit(args, lds, (volatile LAS int*)(misc + 210), u >> 7, (u >> 4) & 7, u & 15, tid, lane, wave); }
        if (_r == 0) moe_weights_queue(args, lds, misc + 212, tid, wave, lane);
    }
    SEAM(3);
    if (IN(4)) REPEAT(4) {
        pg8::PlainOrder S; S.init(NREAL, DM, DM, args.ws + WS_WOUT, G, bx);
        pg8::EpiResF32 E{args.in[I_X], _r ? (float*)(args.ws + WS_ACT) : args.out, DM};
        pg8::gemm_phase<pg8::EpiResF32, pg8::PlainOrder, true, true>(lds, (const char*)(args.ws + WS_MIX), DM * 2, S, E);
    }
    SEAM(4);
    if (IN(5)) p5_router(args, lds, G, bx, tid, lane, wave);
    SEAM(5);
    if (IN(6)) REPEAT(6) {
        const int mt = moe_setup(args, misc, tid);
        pg8::MoeOrder<true> S; S.tpre = misc; S.tok = (const LAS int*)(lds + TOK_OFF); S.nN = 16; S.nwg = mt * 16; S.G = G; S.c = bx;
        S.Bt = (const char*)(args.ws + WS_WGU); S.estride = (size_t)2 * DE * DM; S.K2 = DM;
        const int* LIST = (const int*)(args.ws + WS_LIST);
        for (int ui = 0; ui < TOK_CAP; ++ui) { pg8::Unit u; if (!S.next(ui, u)) break;
            if (tid < 256) { const int idx = (u.pm - misc[u.e]) * 256 + tid; ((LAS int*)(lds + TOK_OFF))[ui * 256 + tid] = idx < misc[104 + u.e] ? LIST[(size_t)u.e * NREAL + idx] : 0; } }
        __syncthreads();
        pg8::EpiSwiGLU E{args.ws + WS_ACT, args.in[I_BGU]};
        pg8::gemm_phase<pg8::EpiSwiGLU, pg8::MoeOrder<true>, true, true, true>(lds, (const char*)(args.ws + WS_HN), DM, S, E);
    }
    SEAM(6);
    if (IN(7)) REPEAT(7) {
        const int mt = moe_setup(args, misc, tid);
        pg8::MoeOrder<false> S; S.tpre = misc; S.tok = nullptr; S.nN = 8; S.nwg = mt * 8; S.G = G; S.c = bx;
        S.Bt = (const char*)(args.ws + WS_WD); S.estride = (size_t)DM * DE; S.K2 = DE;
        pg8::EpiBf16 E{(bf16_t*)(args.ws + (_r ? WS_WGU : WS_Y)), DM, 0};
        pg8::gemm_phase<pg8::EpiBf16, pg8::MoeOrder<false>, true, true, true>(lds, (const char*)(args.ws + WS_ACT), DE, S, E);
    }
    SEAM(7);
    if (IN(8)) { (void)moe_setup(args, misc, tid); p8_combine(args, misc, gw, NGW, lane); }
#if PROBE_A >= 0
    __syncthreads();
    if (tid == 0) tsl[9] = __builtin_amdgcn_s_memrealtime();
    __syncthreads();
    {
        const int pa = PROBE_A;
        const float us = (float)(pa == 9 ? (tsl[9] - tsl[0]) : (tsl[pa + 1] - tsl[pa])) * 1e-2f;
        const float f = 1.0f - 0.05f * us / (float)(PROBE_REF_US);
        VM_WAIT();
        for (int row = gw; row < NREAL; row += NGW) {
#pragma unroll
            for (int j = 0; j < 8; ++j) { f32x4* p = (f32x4*)(args.out + (size_t)row * DM) + lane + 64 * j; *p = *p * f; } }
    }
#endif
#undef IN
#undef SEAM
}

extern "C" void kernel_launch(void* const* d_in, const int* in_sizes, int n_in, void* d_out, int out_size, void* d_ws, size_t ws_size, hipStream_t stream) {
    static int grid = 0;
    if (grid == 0) {
        if (n_in != 19 || out_size != NREAL * DM || ws_size < WS_END) { fprintf(stderr, "kernel_launch: unexpected shapes (n_in %d out %d ws %zu need %zu)\n", n_in, out_size, ws_size, (size_t)WS_END); grid = -1; return; }
        int dev = 0, cus = 0, per_cu = 0;
        if (hipGetDevice(&dev) != hipSuccess || hipDeviceGetAttribute(&cus, hipDeviceAttributeMultiprocessorCount, dev) != hipSuccess) { grid = -1; return; }
        if (hipFuncSetAttribute((const void*)hymba_fwd, hipFuncAttributeMaxDynamicSharedMemorySize, LDS_BYTES) != hipSuccess) { fprintf(stderr, "kernel_launch: hipFuncSetAttribute failed\n"); grid = -1; return; }
        if (hipOccupancyMaxActiveBlocksPerMultiprocessor(&per_cu, (const void*)hymba_fwd, NTHREADS, LDS_BYTES) != hipSuccess || per_cu < 1) { fprintf(stderr, "kernel_launch: occupancy query says %d\n", per_cu); grid = -1; return; }
        (void)hipGetLastError();
        grid = cus;
    }
    if (grid < 0) return;
    (void)hipMemsetAsync((char*)d_ws + WS_CTL, 0, CTL_ZERO_BYTES, stream);
    Args a{};
    for (int i = 0; i < 19; ++i) a.in[i] = (const float*)d_in[i];
    a.out = (float*)d_out; a.ws = (unsigned char*)d_ws;
#if MK_N_LAUNCHES == 1
    a.ph_lo = 0; a.ph_hi = NPH;
    hipLaunchKernelGGL(hymba_fwd, dim3(grid), dim3(NTHREADS), LDS_BYTES, stream, a);
#else
    for (int p = 0; p < NPH; ++p) { a.ph_lo = p; a.ph_hi = p + 1; hipLaunchKernelGGL(hymba_fwd, dim3(grid), dim3(NTHREADS), LDS_BYTES, stream, a); }
#endif
    const hipError_t le = hipPeekAtLastError();
    if (le != hipSuccess) fprintf(stderr, "kernel_launch: launch failed: %s\n", hipGetErrorName(le));
}
```

```cpp
#include <hip/hip_runtime.h>
#include <cstdio>
#include <cstdint>

#ifndef GDN_CHUNKED
#define GDN_CHUNKED 1
#endif
#ifndef REP_PHASE
#define REP_PHASE -1
#endif
#ifndef PROBE_A
#define PROBE_A -1
#endif
#ifndef PROBE_REF_US
#define PROBE_REF_US 500
#endif
#ifndef MK_N_LAUNCHES
#define MK_N_LAUNCHES 1
#endif

constexpr int NB = 4, SEQ = 4096, NMETA = 16, LSEQ = SEQ + NMETA;
constexpr int DM = 2048, NTOK = NB * LSEQ  , MPAD = 16640  , NREAL = NB * SEQ  ;
constexpr int NPROJ_SRC = 7184, NPROJ = 7168;
constexpr int NHEAD = 8, HD = 128;
constexpr int PC_QKV = 0, PC_Z = 3072, PC_SBQ = 4096, PC_SBK = 5120, PC_SBV = 6144;
constexpr int NEXP = 32, TOPK = 4, DE = 2048;
constexpr int SLOT_ROWS = 73728;
constexpr int LROW = 4224;
constexpr float NORM_EPS = 1e-6f;

constexpr size_t MiB = 1u << 20;
constexpr size_t WS_CTL = 0, CTL_ZERO_BYTES = 1 * MiB;
constexpr size_t WS_WIN = 1 * MiB;
constexpr size_t WS_WOUT = WS_WIN + (size_t)NPROJ * DM * 2;
constexpr size_t WS_WGU = WS_WOUT + (size_t)DM * DM * 2;
constexpr size_t WS_WD = WS_WGU + (size_t)NEXP * 2 * DE * DM * 2;
constexpr size_t WS_HN = WS_WD + (size_t)NEXP * DM * DE * 2;
constexpr size_t WS_BETA = WS_HN + (size_t)MPAD * DM * 2;
constexpr size_t WS_G = WS_BETA + (size_t)NTOK * 8 * 4 + 256;
constexpr size_t WS_P = WS_G + (size_t)NTOK * 8 * 4 + 256;
constexpr size_t WS_QN = WS_P + (size_t)MPAD * NPROJ * 2;
constexpr size_t WS_KN = WS_QN + (size_t)NB * NHEAD * LROW * HD * 2;
constexpr size_t WS_ORAW = WS_KN + (size_t)NB * NHEAD * LROW * HD * 2;
constexpr size_t WS_MIX = WS_ORAW + (size_t)NREAL * 1024 * 4;
constexpr size_t WS_RE = WS_MIX + (size_t)NREAL * DM * 2;
constexpr size_t WS_RP = WS_RE + (size_t)NREAL * 4 * 4;
constexpr size_t WS_RG = WS_RP + (size_t)NREAL * 4 * 4;
constexpr size_t WS_LIST = WS_RG + (size_t)NREAL * 4 * 4;
constexpr size_t WS_ACT = WS_LIST + (size_t)NEXP * NREAL * 4;
constexpr size_t WS_Y = WS_ACT + (size_t)SLOT_ROWS * DE * 2;
constexpr size_t WS_GCH = WS_Y + (size_t)SLOT_ROWS * DM * 2;
constexpr size_t WS_GL = WS_GCH + (size_t)32 * 65 * 73728;
constexpr size_t WS_END = WS_GL + 32 * 65 * 4 + 256;
constexpr int CW_ECNT = 64;
constexpr int CW_CVTQ = 192;
constexpr int CW_BAR = 4096;

constexpr int LDS_STAGE = 131072;
constexpr int TOK_OFF = LDS_STAGE, TOK_CAP = 22;
constexpr int MISC_OFF = TOK_OFF + TOK_CAP * 256 * 4;
constexpr int LDS_BYTES = MISC_OFF + 1024;

#define GAS __attribute__((address_space(1)))
#define LAS __attribute__((address_space(3)))
typedef unsigned short bf16_t;
typedef short bf16x8 __attribute__((ext_vector_type(8)));
typedef short s16x4 __attribute__((ext_vector_type(4)));
typedef float f32x4 __attribute__((ext_vector_type(4)));
typedef float f32x2 __attribute__((ext_vector_type(2)));
typedef float f32x16 __attribute__((ext_vector_type(16)));
typedef unsigned u32x4 __attribute__((ext_vector_type(4)));
typedef unsigned u32x2 __attribute__((ext_vector_type(2)));

typedef __bf16 bf16x2_t __attribute__((ext_vector_type(2)));
__device__ __forceinline__ unsigned cvt_pk_bf16(float lo, float hi) { const f32x2 v = {lo, hi}; const bf16x2_t b = __builtin_convertvector(v, bf16x2_t); return __builtin_bit_cast(unsigned, b); }
__device__ __forceinline__ unsigned pk4_fp8(float a, float b, float c, float d) { unsigned w = 0u; w = __builtin_amdgcn_cvt_pk_fp8_f32(a, b, w, false); w = __builtin_amdgcn_cvt_pk_fp8_f32(c, d, w, true); return w; }
__device__ __forceinline__ float bf_lo(unsigned w) { return __uint_as_float(w << 16); }
__device__ __forceinline__ float bf_hi(unsigned w) { return __uint_as_float(w & 0xffff0000u); }
__device__ __forceinline__ float bf2f(bf16_t b) { return __uint_as_float(((unsigned)b) << 16); }
__device__ __forceinline__ float wave_sum(float v) {
#pragma unroll
    for (int o = 1; o < 64; o <<= 1) v += __shfl_xor(v, o);
    return v;
}

namespace pg8 {
constexpr int BM = 256, BK = 64, HALF = 128, HTB = HALF * BK * 2, STAGE_BYTES = 8 * HTB, NXCD = 8, WGM = 8;
__host__ __device__ __forceinline__ int lds_byte(int r, int c) { const int st = (r >> 4) * 2 + (c >> 5), rr = r & 15, cc = c & 31, ob = rr * 64 + cc * 2; return st * 1024 + (ob ^ (((ob >> 9) & 1) << 5)); }
__host__ __device__ __forceinline__ void stage_rc(int b, int& R, int& C) { const int st = b / 1024, sb = b % 1024, swz = sb ^ (((sb >> 9) & 1) << 5); R = (st >> 1) * 16 + swz / 64; C = (st & 1) * 32 + (swz % 64) / 2; }
__host__ __device__ __forceinline__ int perm32(int rho) { const int n = rho >> 4, i = rho & 15; return 8 * (i >> 2) + 4 * n + (i & 3); }

typedef int v8i __attribute__((ext_vector_type(8))); typedef int v4i __attribute__((ext_vector_type(4)));
__device__ __forceinline__ v8i cat8(bf16x8 lo, bf16x8 hi) { const v4i a = __builtin_bit_cast(v4i, lo), b = __builtin_bit_cast(v4i, hi); return __builtin_shufflevector(a, b, 0, 1, 2, 3, 4, 5, 6, 7); }
struct Unit { int pm, pn, e, ui; };

__device__ __forceinline__ int xcd_remap(int L, int nwg) { const int q = nwg / NXCD, r = nwg % NXCD, xcd = L % NXCD, off = L / NXCD; return (xcd < r ? xcd * (q + 1) : r * (q + 1) + (xcd - r) * q) + off; }

struct PlainOrder {
    int nM, nN, nwg, G, c; const char* Bt; unsigned K2;
    __device__ void init(int M, int N, int K, const void* Bt_, int G_, int c_) { nM = M / BM; nN = N / BM; nwg = nM * nN; G = G_; c = c_; Bt = (const char*)Bt_; K2 = (unsigned)K * 2u; }
    __device__ __forceinline__ bool next(int i, Unit& u) const {
        const long L = (long)i * G + c; if (L >= nwg) return false;
        const int wgid = xcd_remap((int)L, nwg);
        const int nig = WGM * nN, gid = wgid / nig, fm = gid * WGM, gsz = (nM - fm) < WGM ? (nM - fm) : WGM;
        u.pm = fm + ((wgid % nig) % gsz); u.pn = (wgid % nig) / gsz; u.e = 0; u.ui = i; return true;
    }
    __device__ __forceinline__ const char* b_ptr(const Unit& u) const { return Bt + (size_t)u.pn * BM * K2; }
    __device__ __forceinline__ unsigned a_off(const Unit& u, int r) const { return (unsigned)(u.pm * BM + r + (meta ? NMETA * ((u.pm >> 4) + 1) : 0)) * K2; }
    int meta = 0;
};
template <bool GATHER> struct MoeOrder {
    const LAS int* tpre; const LAS int* tok; int nN, nwg, G, c; const char* Bt; size_t estride; unsigned K2;
    __device__ __forceinline__ bool next(int i, Unit& u) const {
        const long L = (long)i * G + c; if (L >= nwg) return false;
        const int wgid = xcd_remap((int)L, nwg);
        int e = 0;
#pragma unroll 1
        for (int j = 1; j < NEXP; ++j) e = (wgid >= tpre[j] * nN) ? j : e;
        const int t0 = tpre[e], nt = tpre[e + 1] - t0, loc = wgid - t0 * nN;
        u.e = e; u.pn = loc / nt; u.pm = t0 + loc % nt; u.ui = i; return true;
    }
    __device__ __forceinline__ const char* b_ptr(const Unit& u) const { return Bt + (size_t)u.e * estride + (size_t)u.pn * BM * K2; }
    __device__ __forceinline__ unsigned a_off(const Unit& u, int r) const {
        if (GATHER) return (unsigned)tok[u.ui * 256 + r] * K2;
        return (unsigned)(u.pm * BM + r) * K2;
    }
};

struct EpiBf16 {
    static constexpr bool PERM = true;
    bf16_t* O; int ldc; int meta;
    __device__ __forceinline__ void operator()(const f32x4 (&acc)[2][2][4][2], const Unit& u, int wr, int wc, int fr, int fq) const {
        const int row0 = u.pm * BM + wr * 64 + fr + (meta ? NMETA * ((u.pm >> 4) + 1) : 0), col0 = u.pn * BM + wc * 32 + 8 * fq;
#pragma unroll
        for (int ai = 0; ai < 2; ++ai)
#pragma unroll
            for (int m = 0; m < 4; ++m) { bf16_t* rowp = O + (size_t)(row0 + ai * HALF + m * 16) * ldc + col0;
#pragma unroll
                for (int bj = 0; bj < 2; ++bj) { const f32x4 v0 = acc[ai][bj][m][0], v1 = acc[ai][bj][m][1];
                    u32x4 w; w.x = cvt_pk_bf16(v0[0], v0[1]); w.y = cvt_pk_bf16(v0[2], v0[3]); w.z = cvt_pk_bf16(v1[0], v1[1]); w.w = cvt_pk_bf16(v1[2], v1[3]);
                    *(u32x4*)(rowp + bj * HALF) = w; } }
    }
};
struct EpiResF32 {
    static constexpr bool PERM = false;
    const float* X; float* out; int ldc;
    __device__ __forceinline__ void operator()(const f32x4 (&acc)[2][2][4][2], const Unit& u, int wr, int wc, int fr, int fq) const {
        const int row0 = u.pm * BM + wr * 64 + fr, col0 = u.pn * BM + wc * 32 + 4 * fq;
#pragma unroll
        for (int ai = 0; ai < 2; ++ai)
#pragma unroll
            for (int m = 0; m < 4; ++m) { const size_t off = (size_t)(row0 + ai * HALF + m * 16) * ldc + col0;
#pragma unroll
                for (int bj = 0; bj < 2; ++bj)
#pragma unroll
                    for (int n = 0; n < 2; ++n) { const f32x4 xv = *(const f32x4*)(X + off + bj * HALF + n * 16); *(f32x4*)(out + off + bj * HALF + n * 16) = xv + acc[ai][bj][m][n]; }
                asm volatile("" ::: "memory"); }
    }
};
__device__ __forceinline__ float swiglu1(float g, float uu) {
    g = fminf(g, 7.0f); uu = fminf(fmaxf(uu, -7.0f), 7.0f);
    const float sg = __builtin_amdgcn_rcpf(1.0f + __builtin_amdgcn_exp2f(-1.702f * 1.4426950408889634f * g));
    return (uu + 1.0f) * g * sg;
}
struct EpiSwiGLU {
    static constexpr bool PERM = true;
    unsigned char* act; const float* bgu;
    __device__ __forceinline__ void operator()(const f32x4 (&acc)[2][2][4][2], const Unit& u, int wr, int wc, int fr, int fq) const {
        const int row0 = u.pm * BM + wr * 64 + fr, col0 = u.pn * HALF + wc * 32 + 8 * fq;
        const float* bg = bgu + (size_t)u.e * 4096 + col0;
        const f32x4 bg0 = *(const f32x4*)(bg), bg1 = *(const f32x4*)(bg + 4), bu0 = *(const f32x4*)(bg + 2048), bu1 = *(const f32x4*)(bg + 2052);
#pragma unroll
        for (int ai = 0; ai < 2; ++ai)
#pragma unroll
            for (int m = 0; m < 4; ++m) { unsigned char* rowp = act + (size_t)(row0 + ai * HALF + m * 16) * DE + col0;
                const f32x4 g0 = acc[ai][0][m][0] + bg0, g1 = acc[ai][0][m][1] + bg1, u0 = acc[ai][1][m][0] + bu0, u1 = acc[ai][1][m][1] + bu1;
                u32x2 w; w.x = pk4_fp8(swiglu1(g0[0], u0[0]), swiglu1(g0[1], u0[1]), swiglu1(g0[2], u0[2]), swiglu1(g0[3], u0[3]));
                w.y = pk4_fp8(swiglu1(g1[0], u1[0]), swiglu1(g1[1], u1[1]), swiglu1(g1[2], u1[2]), swiglu1(g1[3], u1[3]));
                *(u32x2*)rowp = w; }
    }
};

template <class Epi, class Sched, bool ALIGN_EPI, bool SP2, bool FP8 = false>
__device__ __forceinline__ void gemm_phase(LAS unsigned char* lds, const char* A0, int Kb, const Sched& S, const Epi& E) {
    const int tid = threadIdx.x, wid = __builtin_amdgcn_readfirstlane(tid >> 6), lane = tid & 63, wr = wid >> 2, wc = wid & 3, fr = lane & 15, fq = lane >> 4;
    const int nt = Kb / 128;
    int Rr[2], Cc[2]; unsigned voffB[2];
#pragma unroll
    for (int i = 0; i < 2; ++i) { int R, C; stage_rc(tid * 16 + i * 8192, R, C); const int Rb = Epi::PERM ? ((R & ~31) + perm32(R & 31)) : R;
        Rr[i] = R; Cc[i] = C * 2; voffB[i] = (unsigned)(Rb * Kb + C * 2); }
    const size_t kstep = (size_t)(BK * 2);
    const size_t hstep = (size_t)HALF * Kb;
    const unsigned ldsw = (unsigned)wid * 1024u;
    const int aoff = lds_byte(wr * 64 + fr, fq * 8), boff = lds_byte(wc * 32 + fr, fq * 8);
#define PG8_SA(b, h) (((b) * 2 + (h)) * HTB)
#define PG8_SB(b, h) ((4 + (b) * 2 + (h)) * HTB)
#define PG8_STAGE(bufoff, gbase, voff) do { _Pragma("unroll") for (int _i = 0; _i < 2; ++_i) \
        __builtin_amdgcn_global_load_lds((const unsigned*)((const char*)(gbase) + (voff)[_i]), (LAS unsigned*)(lds + (bufoff) + ldsw + _i * 8192), 16, 0, 0); } while (0)
#define PG8_LDA(dst, b, h) do { _Pragma("unroll") for (int m = 0; m < 4; ++m) _Pragma("unroll") for (int k = 0; k < 2; ++k) dst[m][k] = *(const LAS bf16x8*)(lds + PG8_SA(b, h) + aoff + m * 2048 + k * 1024); } while (0)
#define PG8_LDB(dst, b, h) do { _Pragma("unroll") for (int n = 0; n < 2; ++n) _Pragma("unroll") for (int k = 0; k < 2; ++k) dst[n][k] = *(const LAS bf16x8*)(lds + PG8_SB(b, h) + boff + n * 2048 + k * 1024); } while (0)
#define PG8_MMA(ai, bj, At, Bt) do { __builtin_amdgcn_s_setprio(1); _Pragma("unroll") for (int m = 0; m < 4; ++m) _Pragma("unroll") for (int n = 0; n < 2; ++n) { \
        if constexpr (FP8) acc[ai][bj][m][n] = __builtin_amdgcn_mfma_scale_f32_16x16x128_f8f6f4(cat8(Bt[n][0], Bt[n][1]), cat8(At[m][0], At[m][1]), acc[ai][bj][m][n], 0, 0, 0, 0x79797979, 0, 0x7f7f7f7f); \
        else { _Pragma("unroll") for (int k = 0; k < 2; ++k) acc[ai][bj][m][n] = __builtin_amdgcn_mfma_f32_16x16x32_bf16(Bt[n][k], At[m][k], acc[ai][bj][m][n], 0, 0, 0); } } \
        __builtin_amdgcn_s_setprio(0); } while (0)
#define PG8_WAIT_V(n) asm volatile("s_waitcnt vmcnt(" #n ")" ::: "memory")
#define PG8_WAIT_L(n) asm volatile("s_waitcnt lgkmcnt(" #n ")" ::: "memory")
#define PG8_BAR __builtin_amdgcn_s_barrier()
#define PG8_SCHED __builtin_amdgcn_sched_barrier(0)
#define PG8_VOFF(dst, u) do { _Pragma("unroll") for (int _h = 0; _h < 2; ++_h) _Pragma("unroll") for (int _i = 0; _i < 2; ++_i) dst[_h][_i] = S.a_off(u, _h * HALF + Rr[_i]) + (unsigned)Cc[_i]; } while (0)
    Unit cur, nxt; int ui = 0;
    if (!S.next(0, cur)) return;
    f32x4 acc[2][2][4][2];
#pragma unroll
    for (int a = 0; a < 2; ++a)
#pragma unroll
        for (int b = 0; b < 2; ++b)
#pragma unroll
            for (int m = 0; m < 4; ++m)
#pragma unroll
                for (int n = 0; n < 2; ++n) acc[a][b][m][n] = (f32x4){0.f, 0.f, 0.f, 0.f};
    bf16x8 At[4][2], B0[2][2], B1[2][2];
    unsigned va[2][2], vn[2][2];
    PG8_VOFF(va, cur);
    const char* cB = S.b_ptr(cur);
    if constexpr (SP2) {
        PG8_STAGE(PG8_SB(0, 0), cB, voffB); PG8_STAGE(PG8_SB(0, 1), cB + hstep, voffB); PG8_STAGE(PG8_SA(0, 0), A0, va[0]); PG8_STAGE(PG8_SA(0, 1), A0, va[1]);
        if (wr == 1) PG8_BAR;
        PG8_WAIT_V(2); PG8_BAR;
        PG8_STAGE(PG8_SB(1, 0), cB + kstep, voffB); PG8_STAGE(PG8_SA(1, 0), A0 + kstep, va[0]); PG8_STAGE(PG8_SB(1, 1), cB + hstep + kstep, voffB);
        PG8_WAIT_V(6); PG8_BAR;
    } else {
        PG8_STAGE(PG8_SB(0, 0), cB, voffB); PG8_STAGE(PG8_SA(0, 0), A0, va[0]); PG8_STAGE(PG8_SB(0, 1), cB + hstep, voffB); PG8_STAGE(PG8_SA(0, 1), A0, va[1]);
        if (wr == 1) PG8_BAR;
        PG8_WAIT_V(4); PG8_BAR;
        PG8_STAGE(PG8_SB(1, 0), cB + kstep, voffB); PG8_STAGE(PG8_SA(1, 0), A0 + kstep, va[0]); PG8_STAGE(PG8_SB(1, 1), cB + hstep + kstep, voffB);
        PG8_WAIT_V(6); PG8_BAR;
    }
    for (;;) {
        const bool has_next = S.next(ui + 1, nxt);
        const char* nB = has_next ? S.b_ptr(nxt) : cB;
        for (int t = 0; t < nt; t += 2) {
            const bool last = (t == nt - 2);
            const char* a1 = A0 + (size_t)(t + 1) * kstep;
            const char* a2 = last ? A0 : A0 + (size_t)(t + 2) * kstep; const char* b2 = last ? nB : cB + (size_t)(t + 2) * kstep;
            const char* a3 = a2 + kstep; const char* b3 = b2 + kstep;
            if (last) { if (has_next) { PG8_VOFF(vn, nxt); } else {
#pragma unroll
                    for (int _h = 0; _h < 2; ++_h)
#pragma unroll
                        for (int _i = 0; _i < 2; ++_i) vn[_h][_i] = va[_h][_i]; } }
            if constexpr (SP2) {
            PG8_LDB(B0, 0, 0); PG8_LDB(B1, 0, 1); PG8_SCHED; PG8_LDA(At, 0, 0); PG8_STAGE(PG8_SA(1, 1), a1, va[1]);
            if (last) {
#pragma unroll
                for (int _h = 0; _h < 2; ++_h)
#pragma unroll
                    for (int _i = 0; _i < 2; ++_i) va[_h][_i] = vn[_h][_i]; }
            PG8_WAIT_V(8); PG8_WAIT_L(0); PG8_BAR; PG8_MMA(0, 0, At, B0); PG8_MMA(0, 1, At, B1); PG8_BAR; PG8_SCHED;
            PG8_LDA(At, 0, 1); PG8_STAGE(PG8_SB(0, 0), b2, voffB); PG8_STAGE(PG8_SB(0, 1), b2 + hstep, voffB); PG8_STAGE(PG8_SA(0, 0), a2, va[0]);
            PG8_WAIT_V(8); PG8_WAIT_L(0); PG8_BAR; PG8_MMA(1, 0, At, B0); PG8_MMA(1, 1, At, B1); PG8_BAR; PG8_SCHED;
            PG8_LDB(B0, 1, 0); PG8_LDB(B1, 1, 1); PG8_SCHED; PG8_LDA(At, 1, 0); PG8_STAGE(PG8_SA(0, 1), a2, va[1]);
            PG8_WAIT_V(8); PG8_WAIT_L(0); PG8_BAR; PG8_MMA(0, 0, At, B0); PG8_MMA(0, 1, At, B1); PG8_BAR; PG8_SCHED;
            PG8_LDA(At, 1, 1); PG8_STAGE(PG8_SB(1, 0), b3, voffB); PG8_STAGE(PG8_SB(1, 1), b3 + hstep, voffB); PG8_STAGE(PG8_SA(1, 0), a3, va[0]);
            PG8_WAIT_V(8); PG8_WAIT_L(0); PG8_BAR; PG8_MMA(1, 0, At, B0); PG8_MMA(1, 1, At, B1); PG8_BAR; PG8_SCHED;
            } else {
            PG8_LDB(B0, 0, 0); PG8_SCHED; PG8_LDA(At, 0, 0); PG8_STAGE(PG8_SA(1, 1), a1, va[1]);
            if (last) {
#pragma unroll
                for (int _h = 0; _h < 2; ++_h)
#pragma unroll
                    for (int _i = 0; _i < 2; ++_i) va[_h][_i] = vn[_h][_i]; }
            PG8_WAIT_L(8); PG8_BAR; PG8_WAIT_L(0); PG8_MMA(0, 0, At, B0); PG8_BAR; PG8_SCHED;
            PG8_LDB(B1, 0, 1); PG8_STAGE(PG8_SB(0, 0), b2, voffB);
            PG8_BAR; PG8_WAIT_L(0); PG8_MMA(0, 1, At, B1); PG8_BAR;
            PG8_LDA(At, 0, 1); PG8_STAGE(PG8_SA(0, 0), a2, va[0]);
            PG8_BAR; PG8_WAIT_L(0); PG8_MMA(1, 0, At, B0); PG8_BAR; PG8_SCHED;
            PG8_STAGE(PG8_SB(0, 1), b2 + hstep, voffB);
            PG8_WAIT_V(6); PG8_BAR; PG8_MMA(1, 1, At, B1); PG8_BAR;
            PG8_LDB(B0, 1, 0); PG8_SCHED; PG8_LDA(At, 1, 0); PG8_STAGE(PG8_SA(0, 1), a2, va[1]);
            PG8_WAIT_L(8); PG8_BAR; PG8_WAIT_L(0); PG8_MMA(0, 0, At, B0); PG8_BAR; PG8_SCHED;
            PG8_LDB(B1, 1, 1); PG8_STAGE(PG8_SB(1, 0), b3, voffB);
            PG8_BAR; PG8_WAIT_L(0); PG8_MMA(0, 1, At, B1); PG8_BAR;
            PG8_LDA(At, 1, 1); PG8_STAGE(PG8_SA(1, 0), a3, va[0]);
            PG8_BAR; PG8_WAIT_L(0); PG8_MMA(1, 0, At, B0); PG8_BAR; PG8_SCHED;
            PG8_STAGE(PG8_SB(1, 1), b3 + hstep, voffB);
            PG8_WAIT_V(6); PG8_BAR; PG8_MMA(1, 1, At, B1); PG8_BAR;
            }
        }
        if constexpr (ALIGN_EPI) { if (wr == 0) PG8_BAR; }
        E(acc, cur, wr, wc, fr, fq);
        if (!has_next) break;
#pragma unroll
        for (int a = 0; a < 2; ++a)
#pragma unroll
            for (int b = 0; b < 2; ++b)
#pragma unroll
                for (int m = 0; m < 4; ++m)
#pragma unroll
                    for (int n = 0; n < 2; ++n) acc[a][b][m][n] = (f32x4){0.f, 0.f, 0.f, 0.f};
        cur = nxt; cB = nB; ++ui;
        if constexpr (ALIGN_EPI) { if (wr == 1) PG8_BAR; }
    }
    PG8_WAIT_V(0);
    if constexpr (!ALIGN_EPI) { if (wr == 0) PG8_BAR; }
    PG8_BAR;
#undef PG8_SA
#undef PG8_SB
#undef PG8_STAGE
#undef PG8_LDA
#undef PG8_LDB
#undef PG8_MMA
#undef PG8_WAIT_V
#undef PG8_WAIT_L
#undef PG8_BAR
#undef PG8_SCHED
#undef PG8_VOFF
}
}

#define XB_TMO      128
#define XB_XCNT(j)  (256  + 64 * (j))
#define XB_XSUB(j)  (1280 + 64 * (j))
#define XB_XGEN(j)  (2304 + 64 * (j))
#define XB_TOP      3328
#define XB_TOPGEN   3392
#define XCD_BAR_WORDS 3456
#define XB_SPIN_CAP (1u << 18)

__device__ __forceinline__ unsigned xb_ld(unsigned* p)              { return __hip_atomic_load(p, __ATOMIC_RELAXED, __HIP_MEMORY_SCOPE_AGENT); }
__device__ __forceinline__ unsigned xb_add(unsigned* p, unsigned v) { return __hip_atomic_fetch_add(p, v, __ATOMIC_RELAXED, __HIP_MEMORY_SCOPE_AGENT); }
__device__ __forceinline__ unsigned xb_xcc_id() { return (unsigned)__builtin_amdgcn_s_getreg((3 << 11) | 20) & 0xFu; }
#define XB_SPIN(cond, bar) do { unsigned _sp = 0; while (cond) { __builtin_amdgcn_s_sleep(1); \
    if ((++_sp & 255u) == 0u) { if (xb_ld(&(bar)[XB_TMO])) break; if (_sp > XB_SPIN_CAP) { atomicAdd(&(bar)[XB_TMO], 1u); break; } } } } while (0)

struct XcdBarrier {
    unsigned* bar; unsigned x;
    volatile LAS unsigned* st;
};
__device__ __forceinline__ XcdBarrier xcd_barrier_post(unsigned* bar, volatile LAS unsigned* st) {
    XcdBarrier b; b.bar = bar; b.x = xb_xcc_id(); b.st = st;
    if (threadIdx.x == 0) (void)xb_add(&bar[XB_XCNT(b.x)], 1u);
    return b;
}
__device__ __forceinline__ void xcd_barrier_complete(unsigned* bar, unsigned x, unsigned& nloc, unsigned& nx) {
    const unsigned G = gridDim.x * gridDim.y * gridDim.z;
    unsigned sum, cnt, mine, sp = 0u;
    for (;;) {
        sum = 0u; cnt = 0u; mine = 0u;
#pragma unroll
        for (unsigned j = 0; j < 16; ++j) { const unsigned c = xb_ld(&bar[XB_XCNT(j)]); sum += c; cnt += (c > 0u) ? 1u : 0u; mine = (j == x) ? c : mine; }
        if (sum == G) break;
        __builtin_amdgcn_s_sleep(1);
        if ((++sp & 255u) == 0u) { if (xb_ld(&bar[XB_TMO])) break; if (sp > XB_SPIN_CAP) { atomicAdd(&bar[XB_TMO], 1u); break; } }
    }
    nloc = mine > 0u ? mine : 1u; nx = cnt > 0u ? cnt : 1u;
}
__device__ __forceinline__ void xcd_barrier(const XcdBarrier& b) {
    asm volatile("s_waitcnt vmcnt(0)" ::: "memory");
    __syncthreads();
    if (threadIdx.x == 0) {
        unsigned* bar = b.bar;
        __builtin_amdgcn_s_waitcnt(0);
        unsigned nloc = b.st[0], nx = b.st[1];
        if (nloc == 0u) { xcd_barrier_complete(bar, b.x, nloc, nx); b.st[0] = nloc; b.st[1] = nx; }
        const unsigned old = xb_add(&bar[XB_XSUB(b.x)], 1u);
        const unsigned gen = old / nloc;
        if (old + 1u == (gen + 1u) * nloc) {
            __builtin_amdgcn_fence(__ATOMIC_RELEASE, "agent");
            asm volatile("s_waitcnt vmcnt(0)" ::: "memory");
            const unsigned og = xb_add(&bar[XB_TOP], 1u);
            const unsigned tg = og / nx;
            if (og + 1u == (tg + 1u) * nx) xb_add(&bar[XB_TOPGEN], 1u);
            else XB_SPIN(xb_ld(&bar[XB_TOPGEN]) == tg, bar);
            __builtin_amdgcn_fence(__ATOMIC_ACQUIRE, "agent");
            xb_add(&bar[XB_XGEN(b.x)], 1u);
            asm volatile("s_waitcnt vmcnt(0)" ::: "memory");
        } else {
            XB_SPIN(xb_ld(&bar[XB_XGEN(b.x)]) == gen, bar);
            __builtin_amdgcn_fence(__ATOMIC_ACQUIRE, "agent");
            asm volatile("s_waitcnt vmcnt(0)" ::: "memory");
        }
    }
    __syncthreads();
}

constexpr int NWAVES = 8, NTHREADS = 512;
struct Args { const float* in[19]; float* out; unsigned char* ws; int ph_lo, ph_hi; };
enum { I_X = 0, I_META, I_MIXNW, I_WIN, I_CONVW, I_ALOG, I_DTB, I_GDNNW, I_SBQNW, I_SBKNW, I_SBONW, I_WOUT, I_FFNNW, I_RW, I_RB, I_WGU, I_BGU, I_WD, I_BD };

#define LDS_WAIT() asm volatile("s_waitcnt lgkmcnt(0)" ::: "memory")
#define VM_WAIT() asm volatile("s_waitcnt vmcnt(0)" ::: "memory")
constexpr int WLS = 2052;

__device__ __forceinline__ void dot16(const f32x4 (&v)[8], const LAS float* wl, int lane, float (&s)[16]) {
#pragma unroll
    for (int c = 0; c < 16; ++c) { float a = 0.f;
#pragma unroll
        for (int j = 0; j < 8; ++j) { const f32x4 w = *(const LAS f32x4*)(wl + c * WLS + 4 * lane + 256 * j); a += (v[j].x * w.x + v[j].y * w.y) + (v[j].z * w.z + v[j].w * w.w); }
        s[c] = wave_sum(a); }
}

__device__ __forceinline__ void stage_w16(LAS float* wl, const float* base, int ld, int coloff, int tid) {
#pragma unroll 4
    for (int idx = tid; idx < 2048 * 4; idx += NTHREADS) { const int k = idx >> 2, q = idx & 3; const f32x4 v = *(const f32x4*)(base + (size_t)k * ld + coloff + 4 * q);
        wl[(4 * q + 0) * WLS + k] = v.x; wl[(4 * q + 1) * WLS + k] = v.y; wl[(4 * q + 2) * WLS + k] = v.z; wl[(4 * q + 3) * WLS + k] = v.w; }
}

__device__ __forceinline__ void p0_rows(const Args& a, LAS unsigned char* lds, int gw, int NGW, int tid, int lane) {
    const float* x = a.in[I_X]; const float* meta = a.in[I_META]; const float* nw = a.in[I_MIXNW]; const float* win = a.in[I_WIN];
    LAS float* wl = (LAS float*)lds;
    stage_w16(wl, win, NPROJ_SRC, 4096, tid);
    __syncthreads();
    bf16_t* HN = (bf16_t*)(a.ws + WS_HN); float* BETA = (float*)(a.ws + WS_BETA); float* GG = (float*)(a.ws + WS_G);
    f32x4 wn[8];
#pragma unroll
    for (int j = 0; j < 8; ++j) wn[j] = *((const f32x4*)nw + lane + 64 * j);
    const int hh = lane & 7;
    const float alog = a.in[I_ALOG][hh], dtb = a.in[I_DTB][hh];
    for (int row = gw; row < MPAD; row += NGW) {
        GAS unsigned long long* o8 = (GAS unsigned long long*)(HN + (size_t)row * DM) + lane;
        if (row >= NTOK) {
#pragma unroll
            for (int j = 0; j < 8; ++j) o8[64 * j] = 0ull;
            continue; }
        const int b = row / LSEQ, t = row - b * LSEQ;
        const float* src = (t < NMETA) ? meta + (size_t)t * DM : x + ((size_t)b * SEQ + (t - NMETA)) * DM;
        f32x4 v[8]; float ss = 0.f;
#pragma unroll
        for (int j = 0; j < 8; ++j) { v[j] = *((const f32x4*)src + lane + 64 * j); ss += (v[j].x * v[j].x + v[j].y * v[j].y) + (v[j].z * v[j].z + v[j].w * v[j].w); }
        const float rstd = 1.0f / sqrtf(wave_sum(ss) * (1.0f / DM) + NORM_EPS);
#pragma unroll
        for (int j = 0; j < 8; ++j) { v[j] = v[j] * rstd * wn[j];
            o8[64 * j] = (unsigned long long)cvt_pk_bf16(v[j].x, v[j].y) | ((unsigned long long)cvt_pk_bf16(v[j].z, v[j].w) << 32); }
        float s[16]; dot16(v, wl, lane, s);
        float bv = s[0], av = s[8];
#pragma unroll
        for (int c = 1; c < 8; ++c) { bv = (hh == c) ? s[c] : bv; av = (hh == c) ? s[8 + c] : av; }
        if (lane < 8) {
            const float beta = 1.0f / (1.0f + expf(-bv));
            const float xa = av + dtb; const float sp = fmaxf(xa, 0.f) + log1pf(expf(-fabsf(xa)));
            BETA[(size_t)row * 8 + hh] = beta; GG[(size_t)row * 8 + hh] = -expf(alog) * sp; }
    }
    __syncthreads();
}

constexpr int CVT_STR = 132;
template <int MODE  >
__device__ __forceinline__ void cvt_tile(const float* W, int ldw, int K, bf16_t* out, int kb, int nt, LAS unsigned char* T, int lane) {
    const int r0 = nt * 64;
    int c0;
    if (MODE == 0) c0 = r0;
    else if (MODE == 1) c0 = r0 < 4096 ? r0 : r0 + 16;
    else { const int pn = r0 >> 8, rr = r0 & 255; c0 = rr < 128 ? 128 * pn + rr : 2048 + 128 * pn + (rr - 128); }
    const int kq = lane >> 4, nl = lane & 15;
    const float* src = W + (size_t)(kb * 64 + 2 * kq) * ldw + c0 + 4 * nl;
    f32x4 v[8][2];
#pragma unroll
    for (int i = 0; i < 8; ++i)
#pragma unroll
        for (int j = 0; j < 2; ++j) v[i][j] = *(const f32x4*)(src + (size_t)(8 * i + j) * ldw);
    LAS unsigned char* tw = T + (4 * nl) * CVT_STR + 4 * kq;
#pragma unroll
    for (int i = 0; i < 8; ++i)
#pragma unroll
        for (int q = 0; q < 4; ++q) *(LAS unsigned*)(tw + q * CVT_STR + 16 * i) = cvt_pk_bf16(v[i][0][q], v[i][1][q]);
    LDS_WAIT();
    const int rn = lane >> 3, cc = lane & 7;
    const LAS unsigned char* tr = T + rn * CVT_STR + 16 * cc;
    bf16_t* dst = out + (size_t)(r0 + rn) * K + kb * 64 + 8 * cc;
#pragma unroll
    for (int j = 0; j < 8; ++j) { u32x4 w; const LAS unsigned* p = (const LAS unsigned*)(tr + 8 * j * CVT_STR); w.x = p[0]; w.y = p[1]; w.z = p[2]; w.w = p[3];
        *(u32x4*)(dst + (size_t)(8 * j) * K) = w; }
    LDS_WAIT();
}
constexpr float W8_SCALE = 64.0f;
template <int MODE>
__device__ __forceinline__ void cvt_tile_fp8(const float* W, int ldw, int K, unsigned char* out, int kb, int nt, LAS unsigned char* T, int lane) {
    const int r0 = nt * 64;
    int c0;
    if (MODE == 0) c0 = r0;
    else { const int pn = r0 >> 8, rr = r0 & 255; c0 = rr < 128 ? 128 * pn + rr : 2048 + 128 * pn + (rr - 128); }
    const int kq = lane >> 4, nl = lane & 15;
    LAS unsigned char* tw = T + (4 * nl) * CVT_STR + 4 * kq;
    const float* src = W + (size_t)(kb * 128 + 4 * kq) * ldw + c0 + 4 * nl;
    f32x4 v[8][4];
#pragma unroll
    for (int i = 0; i < 8; ++i)
#pragma unroll
        for (int j = 0; j < 4; ++j) v[i][j] = *(const f32x4*)(src + (size_t)(16 * i + j) * ldw);
#pragma unroll
    for (int i = 0; i < 8; ++i)
#pragma unroll
        for (int q = 0; q < 4; ++q) *(LAS unsigned*)(tw + q * CVT_STR + 16 * i) =
            pk4_fp8(v[i][0][q] * W8_SCALE, v[i][1][q] * W8_SCALE, v[i][2][q] * W8_SCALE, v[i][3][q] * W8_SCALE);
    LDS_WAIT();
    const int rn = lane >> 3, cc = lane & 7;
    const LAS unsigned char* tr = T + rn * CVT_STR + 16 * cc;
    unsigned char* dst = out + (size_t)(r0 + rn) * K + kb * 128 + 16 * cc;
#pragma unroll
    for (int j = 0; j < 8; ++j) { u32x4 w; const LAS unsigned* p = (const LAS unsigned*)(tr + 8 * j * CVT_STR); w.x = p[0]; w.y = p[1]; w.z = p[2]; w.w = p[3];
        *(u32x4*)(dst + (size_t)(8 * j) * K) = w; }
    LDS_WAIT();
}
__device__ __forceinline__ void p0_weights(const Args& a, LAS unsigned char* lds, int vcu, int G, int wave, int lane) {
    constexpr int I_IN = 32 * 14, I_OUT = 32 * 4;
    constexpr int NITEMS = I_IN + I_OUT;
    LAS unsigned char* T = lds + wave * (64 * CVT_STR);
    for (int it = vcu; it < NITEMS; it += G) {
        int r = it;
        if (r < I_IN) { cvt_tile<1>(a.in[I_WIN], NPROJ_SRC, DM, (bf16_t*)(a.ws + WS_WIN), r / 14, (r % 14) * 8 + wave, T, lane); continue; } r -= I_IN;
        cvt_tile<0>(a.in[I_WOUT], DM, DM, (bf16_t*)(a.ws + WS_WOUT), r / 4, (r % 4) * 8 + wave, T, lane);
    }
}
constexpr int MOE_I_GU = 8 * 2, MOE_I_D = 4 * 2, MOE_ITEMS = NEXP * (MOE_I_GU + MOE_I_D);
__device__ __forceinline__ void moe_weights_queue(const Args& a, LAS unsigned char* lds, LAS int* qslot, int tid, int wave, int lane, int limit) {
    unsigned* ctr = (unsigned*)(a.ws + WS_CTL) + CW_CVTQ;
    LAS unsigned char* T = lds + wave * (64 * CVT_STR);
    for (;;) {
        __syncthreads();
        if (tid == 0) { int v = (int)__hip_atomic_load(ctr, __ATOMIC_RELAXED, __HIP_MEMORY_SCOPE_AGENT); v = (v < limit) ? (int)atomicAdd(ctr, 1u) : MOE_ITEMS; *qslot = v; }
        __syncthreads();
        const int it = *(volatile LAS int*)qslot;
        if (it >= MOE_ITEMS) break;
        if (it < NEXP * MOE_I_GU) { const int e = it / MOE_I_GU, q = it % MOE_I_GU, ng = q >> 1, kh = q & 1;
#pragma unroll 1
            for (int kb = kh * 8; kb < kh * 8 + 8; ++kb)
                cvt_tile_fp8<2>(a.in[I_WGU] + (size_t)e * DM * 2 * DE, 2 * DE, DM, a.ws + WS_WGU + (size_t)e * 2 * DE * DM, kb, ng * 8 + wave, T, lane);
        } else { const int r = it - NEXP * MOE_I_GU, e = r / MOE_I_D, q = r % MOE_I_D, ng = q >> 1, kh = q & 1;
#pragma unroll 1
            for (int kb = kh * 8; kb < kh * 8 + 8; ++kb)
                cvt_tile_fp8<0>(a.in[I_WD] + (size_t)e * DE * DM, DM, DE, a.ws + WS_WD + (size_t)e * DM * DE, kb, ng * 8 + wave, T, lane);
        }
    }
}

__device__ __forceinline__ void p2_qknorm(const Args& a, int gw, int NGW, int lane) {
    const bf16_t* P = (const bf16_t*)(a.ws + WS_P); bf16_t* QN = (bf16_t*)(a.ws + WS_QN); bf16_t* KN = (bf16_t*)(a.ws + WS_KN);
    const float qw0 = a.in[I_SBQNW][2 * lane], qw1 = a.in[I_SBQNW][2 * lane + 1], kw0 = a.in[I_SBKNW][2 * lane], kw1 = a.in[I_SBKNW][2 * lane + 1];
    const float QS = 0.08838834764831845f * 1.4426950408889634f;
    for (int it = gw; it < NTOK * NHEAD * 2; it += NGW) {
        const int which = it & 1, h = (it >> 1) & 7, row = it >> 4;
        const int b = row / LSEQ, t = row - b * LSEQ;
        const unsigned w = *(const unsigned*)(P + (size_t)row * NPROJ + (which ? PC_SBK : PC_SBQ) + h * HD + 2 * lane);
        const float v0 = bf_lo(w), v1 = bf_hi(w);
        const float rstd = 1.0f / sqrtf(wave_sum(v0 * v0 + v1 * v1) * (1.0f / HD) + NORM_EPS);
        const float o0 = which ? v0 * rstd * kw0 : v0 * rstd * qw0 * QS, o1 = which ? v1 * rstd * kw1 : v1 * rstd * qw1 * QS;
        *(unsigned*)((which ? KN : QN) + ((size_t)(b * NHEAD + h) * LROW + t) * HD + 2 * lane) = cvt_pk_bf16(o0, o1);
    }
}

__device__ __forceinline__ void p3_gdn_naive(const Args& a, LAS unsigned char* lds, int item, int tid, int lane, int wave) {
    const int b = item >> 3, h = item & 7;
    const bf16_t* P = (const bf16_t*)(a.ws + WS_P); const float* BETA = (const float*)(a.ws + WS_BETA); const float* GG = (const float*)(a.ws + WS_G);
    float* ORAW = (float*)(a.ws + WS_ORAW); bf16_t* MIX = (bf16_t*)(a.ws + WS_MIX);
    LAS float* buf = (LAS float*)lds;
    const int j = tid >> 2, part = tid & 3;
    const int which = tid >> 7, d = tid & 127; const bool conv = tid < 384;
    const int pcol = which * 1024 + h * HD + d;
    float cw0 = 0, cw1 = 0, cw2 = 0, cw3 = 0;
    if (conv) { const float* cwp = a.in[I_CONVW] + pcol; cw0 = cwp[0]; cw1 = cwp[3072]; cw2 = cwp[2 * 3072]; cw3 = cwp[3 * 3072]; }
    float xm1 = 0.f, xm2 = 0.f, xm3 = 0.f;
    float S[32];
#pragma unroll
    for (int i = 0; i < 32; ++i) S[i] = 0.f;
    const size_t row0 = (size_t)b * LSEQ;
    float xnext = conv ? bf2f(P[row0 * NPROJ + pcol]) : 0.f;
    float bnext = BETA[row0 * 8 + h], gnext = GG[row0 * 8 + h];
    for (int t = 0; t < LSEQ; ++t) {
        const float xt = xnext, beta = bnext, gam = expf(gnext);
        if (t + 1 < LSEQ) { if (conv) xnext = bf2f(P[(row0 + t + 1) * NPROJ + pcol]); bnext = BETA[(row0 + t + 1) * 8 + h]; gnext = GG[(row0 + t + 1) * 8 + h]; }
        LAS float* cb = buf + (t & 1) * 384;
        if (conv) { const float y = cw3 * xt + cw2 * xm1 + cw1 * xm2 + cw0 * xm3; xm3 = xm2; xm2 = xm1; xm1 = xt; cb[tid] = y / (1.0f + expf(-y)); }
        __syncthreads();
        float kk = 0.f, qq = 0.f, dk = 0.f; f32x4 kv[8], qv[8];
#pragma unroll
        for (int i = 0; i < 8; ++i) { kv[i] = *(const LAS f32x4*)(cb + 128 + 32 * part + 4 * i); qv[i] = *(const LAS f32x4*)(cb + 32 * part + 4 * i); }
#pragma unroll
        for (int i = 0; i < 8; ++i)
#pragma unroll
            for (int c = 0; c < 4; ++c) { kk += kv[i][c] * kv[i][c]; qq += qv[i][c] * qv[i][c]; dk += S[4 * i + c] * kv[i][c]; }
        kk += __shfl_xor(kk, 1); kk += __shfl_xor(kk, 2); qq += __shfl_xor(qq, 1); qq += __shfl_xor(qq, 2); dk += __shfl_xor(dk, 1); dk += __shfl_xor(dk, 2);
        const float rk = 1.0f / sqrtf(kk + NORM_EPS), rq = 0.08838834764831845f / sqrtf(qq + NORM_EPS);
        const float vj = cb[256 + j];
        const float vnew = beta * (vj - gam * rk * dk);
        const float kvn = rk * vnew; float oq = 0.f;
#pragma unroll
        for (int i = 0; i < 8; ++i)
#pragma unroll
            for (int c = 0; c < 4; ++c) { S[4 * i + c] = gam * S[4 * i + c] + kv[i][c] * kvn; oq += S[4 * i + c] * qv[i][c]; }
        oq += __shfl_xor(oq, 1); oq += __shfl_xor(oq, 2);
        if (t >= NMETA && part == 0) ORAW[((size_t)b * SEQ + (t - NMETA)) * 1024 + h * HD + j] = rq * oq;
    }
    __threadfence(); __syncthreads();
    const float nw0 = a.in[I_GDNNW][2 * lane], nw1 = a.in[I_GDNNW][2 * lane + 1];
    for (int s = wave; s < SEQ; s += NWAVES) {
        const size_t tok = (size_t)b * SEQ + s;
        const f32x2 o = *(const f32x2*)(ORAW + tok * 1024 + h * HD + 2 * lane);
        const float rstd = 1.0f / sqrtf(wave_sum(o.x * o.x + o.y * o.y) * (1.0f / HD) + NORM_EPS);
        const unsigned zw = *(const unsigned*)(P + (row0 + NMETA + s) * NPROJ + PC_Z + h * HD + 2 * lane);
        const float z0 = bf_lo(zw), z1 = bf_hi(zw);
        const float r0 = o.x * rstd * nw0 * (z0 / (1.0f + expf(-z0))), r1 = o.y * rstd * nw1 * (z1 / (1.0f + expf(-z1)));
        *(unsigned*)(MIX + tok * DM + h * HD + 2 * lane) = cvt_pk_bf16(r0, r1);
    }
}

__device__ __forceinline__ bf16x8 sba_pack8(const f32x16& p, int base) {
    u32x4 w; w.x = cvt_pk_bf16(p[base + 0], p[base + 1]); w.y = cvt_pk_bf16(p[base + 2], p[base + 3]); w.z = cvt_pk_bf16(p[base + 4], p[base + 5]); w.w = cvt_pk_bf16(p[base + 6], p[base + 7]);
    return __builtin_bit_cast(bf16x8, w);
}

namespace gdn {
constexpr int NCH = 65;
constexpr int IMG_W = 0, IMG_QG = 16384, IMG_KDT = 32768, IMG_AT = 49152, IMG_BYTES = 57344, IMG_U = 57344, CH_BYTES = 73728;
constexpr int L_QB = 0, L_KB = 17408, L_VB = 34816, L_LT = 52224, L_GC = 69632, L_BE = 69888, L_IMG = 70144;
__device__ __forceinline__ int afrag_off(int row, int k, int nks) {
    const int rt = row >> 5, rr = row & 31, ks = k >> 4, kk = k & 15, hi = (kk >> 2) & 1, sl = (kk & 3) + 4 * (kk >> 3);
    return ((rt * nks + ks) * 64 + rr + 32 * hi) * 16 + sl * 2;
}
__device__ __forceinline__ int ufrag_off(int i, int c) {
    const int cg = c >> 5, col = c & 31, rt = i >> 5, ii = i & 31, hi = (ii >> 2) & 1, r = (ii & 3) + 4 * (ii >> 3);
    return (((cg * 2 + rt) * 2 + (r >> 3)) * 64 + col + 32 * hi) * 8 + (r & 7);
}
__device__ __forceinline__ int crow(int r, int hi) { return (r & 3) + 8 * (r >> 2) + 4 * hi; }
__device__ __forceinline__ bf16_t f2bf(float f) { return (bf16_t)(cvt_pk_bf16(f, 0.f) & 0xffffu); }

__device__ __forceinline__ void precompute(const Args& a, LAS unsigned char* lds, int item, int tid, int lane, int wave) {
    asm volatile("" : "+v"(tid), "+v"(lane), "+s"(wave));
    const int bh = item / NCH, c = item - bh * NCH, b = bh >> 3, h = bh & 7;
    const bf16_t* P = (const bf16_t*)(a.ws + WS_P) + (size_t)b * LSEQ * NPROJ;
    const float* BETA = (const float*)(a.ws + WS_BETA) + (size_t)b * LSEQ * 8; const float* GG = (const float*)(a.ws + WS_G) + (size_t)b * LSEQ * 8;
    unsigned char* dst = a.ws + WS_GCH + (size_t)item * CH_BYTES;
    LAS float* GC = (LAS float*)(lds + L_GC); LAS float* BE = (LAS float*)(lds + L_BE); LAS float* LT = (LAS float*)(lds + L_LT);
    const int tbase = 64 * c - 48;
    if (wave == 0) {
        const int t = tbase + lane; float g = 0.f, be = 0.f;
        if (t >= 0) { g = GG[(size_t)t * 8 + h]; be = BETA[(size_t)t * 8 + h]; }
#pragma unroll
        for (int o = 1; o < 64; o <<= 1) { const float y = __shfl_up(g, o); if (lane >= o) g += y; }
        GC[lane] = g; BE[lane] = be;
        if (lane == 63) ((float*)(a.ws + WS_GL))[item] = expf(g);
    }
    {
        f32x2 cw[3][4];
#pragma unroll
        for (int w3 = 0; w3 < 3; ++w3)
#pragma unroll
            for (int tap = 0; tap < 4; ++tap) cw[w3][tap] = *(const f32x2*)(a.in[I_CONVW] + tap * 3072 + w3 * 1024 + h * HD + 2 * lane);
        f32x2 xw[3][11];
#pragma unroll
        for (int j = 0; j < 11; ++j) { const int t = tbase + 8 * wave - 3 + j;
#pragma unroll
            for (int w3 = 0; w3 < 3; ++w3) { unsigned u = 0u; if (t >= 0) u = *(const unsigned*)(P + (size_t)t * NPROJ + w3 * 1024 + h * HD + 2 * lane); xw[w3][j] = (f32x2){bf_lo(u), bf_hi(u)}; } }
#pragma unroll
        for (int rr = 0; rr < 8; ++rr) { const int i = 8 * wave + rr; f32x2 y[3];
#pragma unroll
            for (int w3 = 0; w3 < 3; ++w3) { f32x2 acc = cw[w3][0] * xw[w3][rr] + cw[w3][1] * xw[w3][rr + 1] + cw[w3][2] * xw[w3][rr + 2] + cw[w3][3] * xw[w3][rr + 3];
                acc.x = acc.x / (1.0f + __expf(-acc.x)); acc.y = acc.y / (1.0f + __expf(-acc.y)); y[w3] = acc; }
            const float rq = 0.08838834764831845f / sqrtf(wave_sum(y[0].x * y[0].x + y[0].y * y[0].y) + NORM_EPS);
            const float rk = 1.0f / sqrtf(wave_sum(y[1].x * y[1].x + y[1].y * y[1].y) + NORM_EPS);
            *(LAS unsigned*)(lds + L_QB + i * 272 + 4 * lane) = cvt_pk_bf16(y[0].x * rq, y[0].y * rq);
            *(LAS unsigned*)(lds + L_KB + i * 272 + 4 * lane) = cvt_pk_bf16(y[1].x * rk, y[1].y * rk);
            *(LAS unsigned*)(lds + L_VB + i * 272 + 4 * lane) = cvt_pk_bf16(y[2].x, y[2].y); }
    }
    __syncthreads();
    {
        const int prod = wave >> 2, ti = (wave >> 1) & 1, tj = wave & 1, r32 = lane & 31, hi = lane >> 5;
        if (tj <= ti) {
            f32x16 acc;
#pragma unroll
            for (int r = 0; r < 16; ++r) acc[r] = 0.f;
            const LAS unsigned char* Ab = lds + (prod ? L_QB : L_KB) + (32 * ti + r32) * 272 + hi * 16;
            const LAS unsigned char* Bb = lds + L_KB + (32 * tj + r32) * 272 + hi * 16;
#pragma unroll
            for (int ks = 0; ks < 8; ++ks) acc = __builtin_amdgcn_mfma_f32_32x32x16_bf16(*(const LAS bf16x8*)(Ab + ks * 32), *(const LAS bf16x8*)(Bb + ks * 32), acc, 0, 0, 0);
            const int j = 32 * tj + r32; const float gj = GC[j];
#pragma unroll
            for (int r = 0; r < 16; ++r) { const int i = 32 * ti + crow(r, hi); const float dec = __expf(GC[i] - gj);
                if (prod == 0) LT[j * 68 + i] = (j < i) ? acc[r] * BE[i] * dec : 0.f;
                else *(LAS bf16_t*)(lds + L_IMG + IMG_AT + afrag_off(i, j, 4)) = f2bf((j <= i) ? acc[r] * dec : 0.f); }
        }
    }
    __syncthreads();
    if (tid < 256) {
        float x[64];
        const bool isv = tid < 128; const int cc = tid & 127;
        const LAS unsigned char* src = lds + (isv ? L_VB : L_KB) + cc * 2;
#pragma unroll
        for (int i8 = 0; i8 < 64; i8 += 8) {
#pragma unroll
            for (int q = 0; q < 8; ++q) { const int i = i8 + q; const float v = bf2f(*(const LAS bf16_t*)(src + i * 272)); x[i] = v * BE[i] * (isv ? 1.0f : __expf(GC[i])); }
            asm volatile("" ::: "memory"); }
#pragma unroll
        for (int j = 0; j < 63; ++j) {
#pragma unroll
            for (int i4 = ((j + 1) & ~3); i4 < 64; i4 += 4) { const f32x4 l4 = *(const LAS f32x4*)(LT + j * 68 + i4);
#pragma unroll
                for (int q = 0; q < 4; ++q) if (i4 + q > j) x[i4 + q] -= l4[q] * x[j]; }
            asm volatile("" ::: "memory");
        }
        if (isv) {
            LAS unsigned char* ub = lds + L_IMG + IMG_U + (((cc >> 5) * 4 * 64) + (cc & 31)) * 16;
#pragma unroll
            for (int i = 0; i < 64; ++i) { const int rt = i >> 5, ii = i & 31, hi = (ii >> 2) & 1, r = (ii & 3) + 4 * (ii >> 3);
                *(LAS bf16_t*)(ub + (((rt * 2 + (r >> 3)) * 64 + 32 * hi) * 8 + (r & 7)) * 2) = f2bf(x[i]); }
        } else {
            const int ks = cc >> 4, kk = cc & 15, hi = (kk >> 2) & 1, sl = (kk & 3) + 4 * (kk >> 3);
            LAS unsigned char* wb = lds + L_IMG + IMG_W + (ks * 64 + 32 * hi) * 16 + sl * 2;
#pragma unroll
            for (int i = 0; i < 64; ++i) *(LAS bf16_t*)(wb + ((i >> 5) * 8 * 64 + (i & 31)) * 16) = f2bf(-x[i]);
        }
    } else {
        const int u = tid - 256, dk = u & 127, i0 = (u >> 7) * 32; const float gl = GC[63];
#pragma unroll 4
        for (int ii = 0; ii < 32; ++ii) { const int i = i0 + ii; const float gi = GC[i];
            const float q = bf2f(*(const LAS bf16_t*)(lds + L_QB + i * 272 + dk * 2)), k = bf2f(*(const LAS bf16_t*)(lds + L_KB + i * 272 + dk * 2));
            *(LAS bf16_t*)(lds + L_IMG + IMG_QG + afrag_off(i, dk, 8)) = f2bf(q * __expf(gi));
            *(LAS bf16_t*)(lds + L_IMG + IMG_KDT + afrag_off(dk, i, 4)) = f2bf(k * __expf(gl - gi)); }
    }
    __syncthreads();
    for (int q = tid; q < CH_BYTES / 16; q += NTHREADS) *(u32x4*)(dst + (size_t)q * 16) = *(const LAS u32x4*)(lds + L_IMG + q * 16);
}

constexpr int OB_OFF = 2 * IMG_BYTES, OB_STR = 272, OB_BYTES = 64 * OB_STR;
__device__ __forceinline__ void gated_load_z(const Args& a, u32x4 (&zw)[4], int b, int h, int cc, int w4, int lane) {
    const bf16_t* P = (const bf16_t*)(a.ws + WS_P);
    const int s = 64 * (cc - 1) + 16 * w4 + (lane >> 2);
    const u32x4* zp = (const u32x4*)(P + ((size_t)b * LSEQ + NMETA + s) * NPROJ + PC_Z + h * HD + 32 * (lane & 3));
#pragma unroll
    for (int q = 0; q < 4; ++q) zw[q] = zp[q];
}
__device__ __forceinline__ float silu_f(float z) { return z * __builtin_amdgcn_rcpf(1.0f + __expf(-z)); }
__device__ __forceinline__ void gated_rows(const Args& a, const LAS unsigned char* ob, const u32x4 (&zw)[4], int b, int h, int cc, int w4, int lane, const f32x4 (&nwv)[8]) {
    bf16_t* MIX = (bf16_t*)(a.ws + WS_MIX);
    const int row = lane >> 2, qd = lane & 3, s = 64 * (cc - 1) + 16 * w4 + row;
    u32x4 ov[4]; float ss = 0.f;
#pragma unroll
    for (int q = 0; q < 4; ++q) { ov[q] = *(const LAS u32x4*)(ob + (16 * w4 + row) * OB_STR + qd * 64 + q * 16);
#pragma unroll
        for (int e = 0; e < 4; ++e) { const float lo = bf_lo(ov[q][e]), hi = bf_hi(ov[q][e]); ss += lo * lo + hi * hi; } }
    ss += __shfl_xor(ss, 1); ss += __shfl_xor(ss, 2);
    const float rstd = __builtin_amdgcn_rsqf(ss * (1.0f / HD) + NORM_EPS);
    u32x4* dst = (u32x4*)(MIX + ((size_t)b * SEQ + s) * DM + h * HD + 32 * qd);
#pragma unroll
    for (int q = 0; q < 4; ++q) { u32x4 w;
#pragma unroll
        for (int e = 0; e < 4; ++e) { const f32x4 nv = nwv[2 * q + (e >> 1)];
            const float n0 = (e & 1) ? nv.z : nv.x, n1 = (e & 1) ? nv.w : nv.y;
            w[e] = cvt_pk_bf16(bf_lo(ov[q][e]) * rstd * n0 * silu_f(bf_lo(zw[q][e])), bf_hi(ov[q][e]) * rstd * n1 * silu_f(bf_hi(zw[q][e]))); }
        dst[q] = w; }
}

__device__ __forceinline__ void scan(const Args& a, LAS unsigned char* lds, int bh, int tid, int lane, int wave) {
    const int b = bh >> 3, h = bh & 7, col = lane & 31, hi = lane >> 5, cg = wave;
    const unsigned char* src = a.ws + WS_GCH + (size_t)bh * NCH * CH_BYTES;
    const float* GL = (const float*)(a.ws + WS_GL) + bh * NCH;
    __syncthreads();
    const unsigned dvoff = (unsigned)(wave * 1024 + lane * 16), uvoff = (unsigned)(lane * 16);
#define GDN_DMA(ch, buf) do { const unsigned char* _sp = src + (size_t)(ch) * CH_BYTES; _Pragma("unroll") for (int _f = 0; _f < 7; ++_f) { \
        __builtin_amdgcn_global_load_lds((const unsigned*)(_sp + _f * 8192 + dvoff), (LAS unsigned*)(lds + (buf) * IMG_BYTES + wave * 1024 + _f * 8192), 16, 0, 0); } } while (0)
    GDN_DMA(0, 0);
#define GDN_STEP_END(vm) do { asm volatile("s_waitcnt vmcnt(" #vm ")" ::: "memory"); asm volatile("s_waitcnt lgkmcnt(0)" ::: "memory"); __builtin_amdgcn_s_barrier(); asm volatile("" ::: "memory"); } while (0)
    if (wave < 4) {
        f32x16 st[4]; bf16x8 Sb[8]; u32x4 ureg[4]; float gl;
#pragma unroll
        for (int t4 = 0; t4 < 4; ++t4)
#pragma unroll
            for (int r = 0; r < 16; ++r) st[t4][r] = 0.f;
#pragma unroll
        for (int ks = 0; ks < 8; ++ks) Sb[ks] = (bf16x8){0, 0, 0, 0, 0, 0, 0, 0};
#pragma unroll
        for (int q = 0; q < 4; ++q) ureg[q] = *(const u32x4*)(src + IMG_U + cg * 4096 + q * 1024 + uvoff);
        gl = GL[0];
        GDN_STEP_END(0);
        for (int c = 0; c < NCH; ++c) {
            const LAS unsigned char* img = lds + (c & 1) * IMG_BYTES + lane * 16;
            asm volatile("" : "+v"(ureg[0]), "+v"(ureg[1]), "+v"(ureg[2]), "+v"(ureg[3]), "+v"(gl));
            if (c + 1 < NCH) GDN_DMA(c + 1, (c + 1) & 1);
            f32x16 vn[2]; const float glc = gl;
#pragma unroll
            for (int rt = 0; rt < 2; ++rt)
#pragma unroll
                for (int rh = 0; rh < 2; ++rh) { const u32x4 w = ureg[rt * 2 + rh];
                    vn[rt][8 * rh + 0] = bf_lo(w.x); vn[rt][8 * rh + 1] = bf_hi(w.x); vn[rt][8 * rh + 2] = bf_lo(w.y); vn[rt][8 * rh + 3] = bf_hi(w.y);
                    vn[rt][8 * rh + 4] = bf_lo(w.z); vn[rt][8 * rh + 5] = bf_hi(w.z); vn[rt][8 * rh + 6] = bf_lo(w.w); vn[rt][8 * rh + 7] = bf_hi(w.w); }
            asm volatile("" ::: "memory");
            if (c + 1 < NCH) {
#pragma unroll
                for (int q = 0; q < 4; ++q) ureg[q] = *(const u32x4*)(src + (size_t)(c + 1) * CH_BYTES + IMG_U + cg * 4096 + q * 1024 + uvoff);
                gl = GL[c + 1]; }
#pragma unroll
            for (int rt = 0; rt < 2; ++rt) { __builtin_amdgcn_sched_barrier(0);
#pragma unroll
                for (int ks = 0; ks < 8; ++ks) vn[rt] = __builtin_amdgcn_mfma_f32_32x32x16_bf16(*(const LAS bf16x8*)(img + IMG_W + (rt * 8 + ks) * 1024), Sb[ks], vn[rt], 0, 0, 0); }
            __builtin_amdgcn_sched_barrier(0);
            bf16x8 vb[4];
#pragma unroll
            for (int ks = 0; ks < 4; ++ks) vb[ks] = sba_pack8(vn[ks >> 1], 8 * (ks & 1));
            LAS unsigned char* obw = lds + OB_OFF + (c & 1) * OB_BYTES + (32 * cg + col) * 2;
#pragma unroll
            for (int rt = 0; rt < 2; ++rt) { f32x16 o; __builtin_amdgcn_sched_barrier(0);
#pragma unroll
                for (int r = 0; r < 16; ++r) o[r] = 0.f;
#pragma unroll
                for (int ks = 0; ks < 8; ++ks) o = __builtin_amdgcn_mfma_f32_32x32x16_bf16(*(const LAS bf16x8*)(img + IMG_QG + (rt * 8 + ks) * 1024), Sb[ks], o, 0, 0, 0);
#pragma unroll
                for (int ks = 0; ks < 2 * (rt + 1); ++ks) o = __builtin_amdgcn_mfma_f32_32x32x16_bf16(*(const LAS bf16x8*)(img + IMG_AT + (rt * 4 + ks) * 1024), vb[ks], o, 0, 0, 0);
                if (c >= 1) {
#pragma unroll
                    for (int r = 0; r < 16; ++r) *(LAS bf16_t*)(obw + (32 * rt + crow(r, hi)) * OB_STR) = f2bf(o[r]); }
            }
#pragma unroll
            for (int t4 = 0; t4 < 4; ++t4) { __builtin_amdgcn_sched_barrier(0);
#pragma unroll
                for (int r = 0; r < 16; ++r) st[t4][r] *= glc;
#pragma unroll
                for (int ks = 0; ks < 4; ++ks) st[t4] = __builtin_amdgcn_mfma_f32_32x32x16_bf16(*(const LAS bf16x8*)(img + IMG_KDT + (t4 * 4 + ks) * 1024), vb[ks], st[t4], 0, 0, 0);
                Sb[2 * t4] = sba_pack8(st[t4], 0); Sb[2 * t4 + 1] = sba_pack8(st[t4], 8); }
            if (c + 1 < NCH) GDN_STEP_END(5); else GDN_STEP_END(0);
        }
    } else {
        u32x4 zA[4], zB[4]; f32x4 nwv[8];
#pragma unroll
        for (int q = 0; q < 4; ++q) { zA[q] = (u32x4){0u, 0u, 0u, 0u}; zB[q] = (u32x4){0u, 0u, 0u, 0u}; }
#pragma unroll
        for (int q = 0; q < 8; ++q) nwv[q] = *(const f32x4*)(a.in[I_GDNNW] + 32 * (lane & 3) + 4 * q);
        GDN_STEP_END(0);
        for (int c = 0; c < NCH; ++c) {
#pragma unroll
            for (int q = 0; q < 4; ++q) asm volatile("" : "+v"(zA[q]), "+v"(zB[q]));
            if (c + 1 < NCH) GDN_DMA(c + 1, (c + 1) & 1);
            if (c >= 1) { if (c & 1) gated_load_z(a, zA, b, h, c, wave - 4, lane); else gated_load_z(a, zB, b, h, c, wave - 4, lane); }
            asm volatile("" ::: "memory");
            if (c >= 2) { if (c & 1) gated_rows(a, lds + OB_OFF + ((c - 1) & 1) * OB_BYTES, zB, b, h, c - 1, wave - 4, lane, nwv);
                          else gated_rows(a, lds + OB_OFF + ((c - 1) & 1) * OB_BYTES, zA, b, h, c - 1, wave - 4, lane, nwv); }
            if (c >= 2) GDN_STEP_END(4); else GDN_STEP_END(0);
        }
        gated_rows(a, lds + OB_OFF + ((NCH - 1) & 1) * OB_BYTES, zB, b, h, NCH - 1, wave - 4, lane, nwv);
    }
#undef GDN_STEP_END
#undef GDN_DMA
}
}

namespace sba {
#define KSWZ(row, colB) ((row) * 256 + ((colB) ^ (((row) & 7) << 4)))
__device__ __forceinline__ int v_st(int k, int c) { const int kk = (k & ~0xC) | ((k & 4) << 1) | ((k & 8) >> 1); return ((kk >> 3) * 4 + (c >> 5)) * 512 + ((kk & 7) * 32 + (c & 31)) * 2; }
__device__ __forceinline__ int v_rd_base(int lane) { return ((lane & 3) << 3) | (((lane >> 2) & 3) << 6) | (((lane >> 4) & 1) << 5) | (((lane >> 5) & 1) << 8); }
constexpr int v_rd_off(int d0, int ks, int half) { return d0 * 512 + ks * 4096 + half * 2048; }
template <int OFF> __device__ __forceinline__ s16x4 tr_read(int vb) { s16x4 r; asm volatile("ds_read_b64_tr_b16 %0, %1 offset:%2" : "=&v"(r) : "v"(vb), "i"(OFF) : "memory"); return r; }
template <int D0> __device__ __forceinline__ void pv_one(f32x16& od, int vb, bf16x8 pa0, bf16x8 pa1, bf16x8 pa2, bf16x8 pa3) {
    const s16x4 l0 = tr_read<v_rd_off(D0, 0, 0)>(vb), h0 = tr_read<v_rd_off(D0, 0, 1)>(vb), l1 = tr_read<v_rd_off(D0, 1, 0)>(vb), h1 = tr_read<v_rd_off(D0, 1, 1)>(vb);
    const s16x4 l2 = tr_read<v_rd_off(D0, 2, 0)>(vb), h2 = tr_read<v_rd_off(D0, 2, 1)>(vb), l3 = tr_read<v_rd_off(D0, 3, 0)>(vb), h3 = tr_read<v_rd_off(D0, 3, 1)>(vb);
    asm volatile("s_waitcnt lgkmcnt(0)" ::: "memory"); __builtin_amdgcn_sched_barrier(0);
#define PK(L, H) (bf16x8){L[0], L[1], L[2], L[3], H[0], H[1], H[2], H[3]}
    od = __builtin_amdgcn_mfma_f32_32x32x16_bf16(pa0, PK(l0, h0), od, 0, 0, 0);
    od = __builtin_amdgcn_mfma_f32_32x32x16_bf16(pa1, PK(l1, h1), od, 0, 0, 0);
    od = __builtin_amdgcn_mfma_f32_32x32x16_bf16(pa2, PK(l2, h2), od, 0, 0, 0);
    od = __builtin_amdgcn_mfma_f32_32x32x16_bf16(pa3, PK(l3, h3), od, 0, 0, 0);
#undef PK
}
__device__ __forceinline__ int crow(int r, int hi) { return (r & 3) + 8 * (r >> 2) + 4 * hi; }
__device__ __forceinline__ int swap34(int k) { return (k & ~0x18) | ((k & 8) << 1) | ((k & 16) >> 1); }
__device__ __forceinline__ bf16x8 pack8(const f32x16& p, int base) {
    u32x4 w; w.x = cvt_pk_bf16(p[base + 0], p[base + 1]); w.y = cvt_pk_bf16(p[base + 2], p[base + 3]); w.z = cvt_pk_bf16(p[base + 4], p[base + 5]); w.w = cvt_pk_bf16(p[base + 6], p[base + 7]);
    return __builtin_bit_cast(bf16x8, w);
}
constexpr float SB_EXIT = 160.0f;

__device__ __forceinline__ void unit(const Args& a, LAS unsigned char* lds, volatile LAS int* done_cnt, int b, int h, int qb, int tid, int lane, int wid) {
    const bf16_t* QN = (const bf16_t*)(a.ws + WS_QN) + (size_t)(b * NHEAD + h) * LROW * HD;
    const bf16_t* KN = (const bf16_t*)(a.ws + WS_KN) + (size_t)(b * NHEAD + h) * LROW * HD;
    const bf16_t* Vp = (const bf16_t*)(a.ws + WS_P) + (size_t)b * LSEQ * NPROJ + PC_SBV + h * HD;
    bf16_t* MIX = (bf16_t*)(a.ws + WS_MIX);
    const int r32 = lane & 31, hi = lane >> 5;
    LAS unsigned char* K_lds = lds; LAS unsigned char* V_lds = lds + 16384;
    const int tq0 = NMETA + 256 * qb + 32 * wid, tq = tq0 + r32;
    __syncthreads();
    if (tid == 0) *done_cnt = 0;
    bf16x8 qr[8];
#pragma unroll
    for (int d0 = 0; d0 < 8; ++d0) qr[d0] = *(const bf16x8*)(QN + (size_t)tq * HD + d0 * 16 + hi * 8);
    const int sr = tid >> 4, sc = (tid & 15) * 8;
    const int vst0 = v_st(swap34(sr), sc), vst1 = v_st(32 + swap34(sr), sc);
    const int kst0 = KSWZ(sr, sc * 2), kst1 = KSWZ(32 + sr, sc * 2);
    const int vb0 = (int)(unsigned)(unsigned long)V_lds + v_rd_base(lane);
    const int prow = (r32 & 3) + 4 * (r32 >> 3) + 16 * ((r32 >> 2) & 1);
    f32x16 o[4];
#pragma unroll
    for (int d = 0; d < 4; ++d)
#pragma unroll
        for (int r = 0; r < 16; ++r) o[d][r] = 0.f;
    float carry = 0.f; bool flagged = false;
    for (int kt = 4 * qb + 4; kt >= 0; --kt) {
        const int k0 = 64 * kt;
        const bf16x8 ks0 = *(const bf16x8*)(KN + (size_t)(k0 + sr) * HD + sc), ks1 = *(const bf16x8*)(KN + (size_t)(k0 + 32 + sr) * HD + sc);
        const bf16x8 vs0 = *(const bf16x8*)(Vp + (size_t)(k0 + sr) * NPROJ + sc), vs1 = *(const bf16x8*)(Vp + (size_t)(k0 + 32 + sr) * NPROJ + sc);
        __syncthreads();
        if (*done_cnt == NWAVES) break;
        *(LAS bf16x8*)(K_lds + kst0) = ks0; *(LAS bf16x8*)(K_lds + kst1) = ks1; *(LAS bf16x8*)(V_lds + vst0) = vs0; *(LAS bf16x8*)(V_lds + vst1) = vs1;
        __syncthreads();
        if (k0 >= tq0 + 32) continue;
        f32x16 p0, p1;
#pragma unroll
        for (int r = 0; r < 16; ++r) { p0[r] = 0.f; p1[r] = 0.f; }
#pragma unroll
        for (int d0 = 0; d0 < 8; ++d0) { const int cb = (d0 * 16 + hi * 8) * 2;
            const bf16x8 b0 = *(const LAS bf16x8*)(K_lds + KSWZ(prow, cb)), b1 = *(const LAS bf16x8*)(K_lds + KSWZ(32 + prow, cb));
            p0 = __builtin_amdgcn_mfma_f32_32x32x16_bf16(b0, qr[d0], p0, 0, 0, 0);
            p1 = __builtin_amdgcn_mfma_f32_32x32x16_bf16(b1, qr[d0], p1, 0, 0, 0); }
        const bool need_mask = (k0 + 63 >= tq0);
        f32x16 s0, s1; float t0 = 0.f, t1 = 0.f;
#pragma unroll
        for (int r = 0; r < 16; ++r) {
            float e0 = __builtin_amdgcn_exp2f(p0[r]), e1 = __builtin_amdgcn_exp2f(p1[r]);
            float q0 = __builtin_amdgcn_logf(1.0f + e0), q1 = __builtin_amdgcn_logf(1.0f + e1);
            if (need_mask) { const bool v0 = (k0 + 16 * hi + r) < tq, v1 = (k0 + 32 + 16 * hi + r) < tq; e0 = v0 ? e0 : 0.f; q0 = v0 ? q0 : 0.f; e1 = v1 ? e1 : 0.f; q1 = v1 ? q1 : 0.f; }
            p0[r] = e0; p1[r] = e1; s0[r] = q0; s1[r] = q1; t0 += q0; t1 += q1; }
        float t1lo, t1hi, t0lo, t0hi;
        { auto rr = __builtin_amdgcn_permlane32_swap(__float_as_uint(t1), __float_as_uint(t1), false, false); t1lo = __uint_as_float(rr[0]); t1hi = __uint_as_float(rr[1]); }
        { auto rr = __builtin_amdgcn_permlane32_swap(__float_as_uint(t0), __float_as_uint(t0), false, false); t0lo = __uint_as_float(rr[0]); t0hi = __uint_as_float(rr[1]); }
        float run1 = carry + (hi ? 0.f : t1hi), run0 = carry + (t1lo + t1hi) + (hi ? 0.f : t0hi);
#pragma unroll
        for (int r = 15; r >= 0; --r) { run1 += s1[r]; p1[r] = p1[r] * __builtin_amdgcn_exp2f(-run1); run0 += s0[r]; p0[r] = p0[r] * __builtin_amdgcn_exp2f(-run0); }
        carry += (t1lo + t1hi) + (t0lo + t0hi);
        const bf16x8 pa0 = pack8(p0, 0), pa1 = pack8(p0, 8), pa2 = pack8(p1, 0), pa3 = pack8(p1, 8);
        pv_one<0>(o[0], vb0, pa0, pa1, pa2, pa3); pv_one<1>(o[1], vb0, pa0, pa1, pa2, pa3); pv_one<2>(o[2], vb0, pa0, pa1, pa2, pa3); pv_one<3>(o[3], vb0, pa0, pa1, pa2, pa3);
        if (!flagged && __all(carry >= SB_EXIT)) { flagged = true; if (lane == 0) (void)__hip_atomic_fetch_add((LAS int*)done_cnt, 1, __ATOMIC_RELAXED, __HIP_MEMORY_SCOPE_WORKGROUP); }
    }
    const float* onw = a.in[I_SBONW];
    float wv[4];
#pragma unroll
    for (int d0 = 0; d0 < 4; ++d0) wv[d0] = onw[32 * d0 + r32];
#pragma unroll
    for (int r = 0; r < 16; ++r) {
        float ss = (o[0][r] * o[0][r] + o[1][r] * o[1][r]) + (o[2][r] * o[2][r] + o[3][r] * o[3][r]);
        ss += __shfl_xor(ss, 1); ss += __shfl_xor(ss, 2); ss += __shfl_xor(ss, 4); ss += __shfl_xor(ss, 8); ss += __shfl_xor(ss, 16);
        const float rstd = 1.0f / sqrtf(ss * (1.0f / HD) + NORM_EPS);
        const size_t tok = (size_t)b * SEQ + (tq0 - NMETA) + crow(r, hi);
        bf16_t* dst = MIX + tok * DM + 1024 + h * HD + r32;
#pragma unroll
        for (int d0 = 0; d0 < 4; ++d0) dst[32 * d0] = (bf16_t)(cvt_pk_bf16(o[d0][r] * rstd * wv[d0], 0.f) & 0xffffu);
    }
}
}

__device__ __forceinline__ void p5_router(const Args& a, LAS unsigned char* lds, int G, int c, int tid, int lane, int wave) {
    LAS float* wl = (LAS float*)lds;
    LAS float* lg = (LAS float*)(lds + 132096);
    LAS int* misc = (LAS int*)(lds + MISC_OFF);
    const float* H1 = a.out; const float* rw = a.in[I_RW]; const float* rb = a.in[I_RB];
    unsigned char* HN2 = a.ws + WS_HN;
    int* RE = (int*)(a.ws + WS_RE); int* RP = (int*)(a.ws + WS_RP); float* RG = (float*)(a.ws + WS_RG); int* LIST = (int*)(a.ws + WS_LIST);
    unsigned* ecnt = (unsigned*)(a.ws + WS_CTL) + CW_ECNT;
    f32x4 wn[8];
#pragma unroll
    for (int j = 0; j < 8; ++j) wn[j] = *((const f32x4*)a.in[I_FFNNW] + lane + 64 * j);
    for (int blk = c; blk < NREAL / 64; blk += G) {
        for (int pass = 0; pass < 2; ++pass) {
            __syncthreads();
            stage_w16(wl, rw, NEXP, pass * 16, tid);
            if (pass == 0 && tid < 32) misc[40 + tid] = 0;
            __syncthreads();
            for (int rr = 0; rr < 8; ++rr) {
                const int rloc = wave * 8 + rr; const size_t row = (size_t)blk * 64 + rloc;
                f32x4 v[8]; float ss = 0.f;
#pragma unroll
                for (int j = 0; j < 8; ++j) { v[j] = *((const f32x4*)(H1 + row * DM) + lane + 64 * j); ss += (v[j].x * v[j].x + v[j].y * v[j].y) + (v[j].z * v[j].z + v[j].w * v[j].w); }
                const float rstd = 1.0f / sqrtf(wave_sum(ss) * (1.0f / DM) + NORM_EPS);
                GAS unsigned* o4 = (GAS unsigned*)(HN2 + row * DM) + lane;
#pragma unroll
                for (int j = 0; j < 8; ++j) { v[j] = v[j] * rstd * wn[j];
                    if (pass == 0) o4[64 * j] = pk4_fp8(v[j].x, v[j].y, v[j].z, v[j].w); }
                float s[16]; dot16(v, wl, lane, s);
                float sv = s[0];
#pragma unroll
                for (int cc = 1; cc < 16; ++cc) sv = ((lane & 15) == cc) ? s[cc] : sv;
                if (lane < 16) lg[rloc * 33 + pass * 16 + lane] = sv;
            }
        }
        __syncthreads();
        int ek[4] = {0, 0, 0, 0}, rk[4] = {0, 0, 0, 0}; float gk[4] = {0.f, 0.f, 0.f, 0.f};
        if (tid < 64) {
            float v[32];
#pragma unroll
            for (int e = 0; e < 32; ++e) v[e] = lg[tid * 33 + e] + rb[e];
            float val[4];
#pragma unroll
            for (int k = 0; k < 4; ++k) { float best = -3.0e38f; int bi = 0;
#pragma unroll
                for (int e = 0; e < 32; ++e) { const bool gt = v[e] > best; best = gt ? v[e] : best; bi = gt ? e : bi; }
#pragma unroll
                for (int e = 0; e < 32; ++e) v[e] = (e == bi) ? -3.0e38f : v[e];
                ek[k] = bi; val[k] = best; }
            float den = 0.f;
#pragma unroll
            for (int k = 0; k < 4; ++k) { gk[k] = expf(val[k] - val[0]); den += gk[k]; }
#pragma unroll
            for (int k = 0; k < 4; ++k) { gk[k] = gk[k] / den; rk[k] = __hip_atomic_fetch_add(&misc[40 + ek[k]], 1, __ATOMIC_RELAXED, __HIP_MEMORY_SCOPE_WORKGROUP); }
        }
        __syncthreads();
        if (tid < 32) { const int cnt = misc[40 + tid]; misc[72 + tid] = cnt ? (int)atomicAdd(&ecnt[tid], (unsigned)cnt) : 0; }
        __syncthreads();
        if (tid < 64) { const int tok = blk * 64 + tid;
#pragma unroll
            for (int k = 0; k < 4; ++k) { const int pos = misc[72 + ek[k]] + rk[k]; LIST[(size_t)ek[k] * NREAL + pos] = tok; RE[tok * 4 + k] = ek[k]; RP[tok * 4 + k] = pos; RG[tok * 4 + k] = gk[k]; } }
    }
    __syncthreads();
}

__device__ __forceinline__ int moe_setup(const Args& a, LAS int* misc, int tid) {
    const unsigned* ecnt = (const unsigned*)(a.ws + WS_CTL) + CW_ECNT;
    __syncthreads();
    if (tid == 0) { int acc = 0;
        for (int e = 0; e < NEXP; ++e) { const int cnt = (int)__hip_atomic_load(ecnt + e, __ATOMIC_RELAXED, __HIP_MEMORY_SCOPE_AGENT); misc[104 + e] = cnt; misc[e] = acc; acc += (cnt + 255) >> 8; }
        misc[32] = acc; }
    __syncthreads();
    return misc[32];
}

__device__ __forceinline__ void p8_combine(const Args& a, const LAS int* misc, int gw, int NGW, int lane) {
    const int* RE = (const int*)(a.ws + WS_RE); const int* RP = (const int*)(a.ws + WS_RP); const float* RG = (const float*)(a.ws + WS_RG);
    const bf16_t* Y = (const bf16_t*)(a.ws + WS_Y); const float* bd = a.in[I_BD]; float* out = a.out;
    for (int row = gw; row < NREAL; row += NGW) {
        int e[4]; size_t slot[4]; float g[4];
#pragma unroll
        for (int k = 0; k < 4; ++k) { e[k] = RE[row * 4 + k]; slot[k] = (size_t)misc[e[k]] * 256 + RP[row * 4 + k]; g[k] = RG[row * 4 + k]; }
#pragma unroll
        for (int j = 0; j < 4; ++j) { const int col = 8 * lane + 512 * j;
            f32x4 a0 = *(const f32x4*)(out + (size_t)row * DM + col), a1 = *(const f32x4*)(out + (size_t)row * DM + col + 4);
#pragma unroll
            for (int k = 0; k < 4; ++k) { const u32x4 y = *(const u32x4*)(Y + slot[k] * DM + col);
                const f32x4 b0 = *(const f32x4*)(bd + (size_t)e[k] * DM + col), b1 = *(const f32x4*)(bd + (size_t)e[k] * DM + col + 4);
                a0.x += g[k] * (bf_lo(y.x) + b0.x); a0.y += g[k] * (bf_hi(y.x) + b0.y); a0.z += g[k] * (bf_lo(y.y) + b0.z); a0.w += g[k] * (bf_hi(y.y) + b0.w);
                a1.x += g[k] * (bf_lo(y.z) + b1.x); a1.y += g[k] * (bf_hi(y.z) + b1.y); a1.z += g[k] * (bf_lo(y.w) + b1.z); a1.w += g[k] * (bf_hi(y.w) + b1.w); }
            *(f32x4*)(out + (size_t)row * DM + col) = a0; *(f32x4*)(out + (size_t)row * DM + col + 4) = a1; }
    }
}

__device__ __forceinline__ void p1_meta_rows(const Args& a, int bx, int G, int wave, int lane) {
    const bf16_t* HN = (const bf16_t*)(a.ws + WS_HN); const bf16_t* WT = (const bf16_t*)(a.ws + WS_WIN); bf16_t* P = (bf16_t*)(a.ws + WS_P);
    for (int col = bx; col < NPROJ; col += G) {
        u32x4 w[4];
#pragma unroll
        for (int j = 0; j < 4; ++j) w[j] = *(const u32x4*)(WT + (size_t)col * DM + 8 * lane + 512 * j);
        for (int t = wave; t < NMETA; t += NWAVES) {
            float acc = 0.f;
#pragma unroll
            for (int j = 0; j < 4; ++j) { const u32x4 x = *(const u32x4*)(HN + (size_t)t * DM + 8 * lane + 512 * j);
                acc += bf_lo(x.x) * bf_lo(w[j].x) + bf_hi(x.x) * bf_hi(w[j].x) + bf_lo(x.y) * bf_lo(w[j].y) + bf_hi(x.y) * bf_hi(w[j].y)
                     + bf_lo(x.z) * bf_lo(w[j].z) + bf_hi(x.z) * bf_hi(w[j].z) + bf_lo(x.w) * bf_lo(w[j].w) + bf_hi(x.w) * bf_hi(w[j].w); }
            acc = wave_sum(acc);
            if (lane < NB) P[((size_t)lane * LSEQ + t) * NPROJ + col] = gdn::f2bf(acc);
        }
    }
}

constexpr int NPH = 9;
__global__ void __launch_bounds__(NTHREADS, 2) hymba_fwd(Args args) {
    extern __shared__ __attribute__((aligned(16))) unsigned char lds_raw[];
    LAS unsigned char* lds = (LAS unsigned char*)lds_raw;
    LAS int* misc = (LAS int*)(lds + MISC_OFF);
    const int tid = threadIdx.x, lane = tid & 63, wave = __builtin_amdgcn_readfirstlane(tid >> 6);
    const int G = gridDim.x, bx = blockIdx.x;
    const int vcu = (G % 8 == 0) ? (bx % 8) * (G / 8) + bx / 8 : bx;
    const int gw = vcu * NWAVES + wave, NGW = G * NWAVES;
    unsigned* ctl = (unsigned*)(args.ws + WS_CTL);
    for (int u = tid; u < 256; u += NTHREADS) misc[u] = 0;
    __syncthreads();
    XcdBarrier bar; bar.bar = ctl + CW_BAR; bar.x = 0; bar.st = nullptr;
    const int lo = args.ph_lo, hi = args.ph_hi;
    const int NCV = 0, GG = G - NCV;
    constexpr int CVT_LIMIT_P1 = 1536, CVT_LIMIT_P3 = NEXP * MOE_I_GU;
    if (hi - lo > 1) bar = xcd_barrier_post(ctl + CW_BAR, (volatile LAS unsigned*)(misc + 200));
#ifdef ONLY
#define IN(k) ((k) == ONLY && lo <= (k) && (k) < hi)
#else
#define IN(k) (lo <= (k) && (k) < hi)
#endif
#ifndef REP_COUNT
#define REP_COUNT 2
#endif
#define REPEAT(k) _Pragma("unroll") for (int _r = 0; _r < ((REP_PHASE == (k)) ? REP_COUNT : 1); ++_r)
#define SEAM(k) do { if (IN(k) && IN((k) + 1)) xcd_barrier(bar); if (PROBE_A >= 0 && tid == 0) tsl[(k) + 1] = __builtin_amdgcn_s_memrealtime(); } while (0)

    LAS unsigned long long* tsl = (LAS unsigned long long*)(lds + MISC_OFF + 896);
    if (PROBE_A >= 0 && tid == 0) tsl[0] = __builtin_amdgcn_s_memrealtime();
    if (IN(0)) REPEAT(0) { p0_rows(args, lds, gw, NGW, tid, lane); p0_weights(args, lds, vcu, G, wave, lane); }
    SEAM(0);
    if (IN(1)) REPEAT(1) {
        p1_meta_rows(args, bx, G, wave, lane);
        if (bx < GG) {
        pg8::PlainOrder S; S.init(NREAL, NPROJ, DM, args.ws + WS_WIN, GG, bx); S.meta = 1;
        pg8::EpiBf16 E{(bf16_t*)(args.ws + (_r ? WS_ACT : WS_P)), NPROJ, 1};
        pg8::gemm_phase<pg8::EpiBf16, pg8::PlainOrder, true, true>(lds, (const char*)(args.ws + WS_HN), DM * 2, S, E);
        } else moe_weights_queue(args, lds, misc + 212, tid, wave, lane, CVT_LIMIT_P1);
    }
    SEAM(1);
    if (IN(2)) REPEAT(2) {
        p2_qknorm(args, gw, NGW, lane);
#if GDN_CHUNKED
        for (int it = bx; it < 32 * gdn::NCH; it += G) { __syncthreads(); gdn::precompute(args, lds, it, tid, lane, wave); }
#endif
    }
    SEAM(2);
    if (IN(3)) REPEAT(3) {
        const int NG = (G >= 64) ? 32 : 0;
#if GDN_CHUNKED
        if (bx < 32 || NG == 0) { for (int it = bx; it < 32; it += G) gdn::scan(args, lds, it, tid, lane, wave); }
#else
        if (bx < 32 || NG == 0) { for (int it = bx; it < 32; it += G) p3_gdn_naive(args, lds, it, tid, lane, wave); }
#endif
        if (bx >= NG) { for (int u = bx - NG; u < 512; u += G - NG) sba::unit(args, lds, (volatile LAS int*)(misc + 210), u >> 7, (u >> 4) & 7, u & 15, tid, lane, wave); }
        if (_r == 0) moe_weights_queue(args, lds, misc + 212, tid, wave, lane, NCV ? CVT_LIMIT_P3 : MOE_ITEMS);
    }
    SEAM(3);
    if (IN(4)) REPEAT(4) {
        pg8::PlainOrder S; S.init(NREAL, DM, DM, args.ws + WS_WOUT, G, bx);
        pg8::EpiResF32 E{args.in[I_X], _r ? (float*)(args.ws + WS_ACT) : args.out, DM};
        pg8::gemm_phase<pg8::EpiResF32, pg8::PlainOrder, true, true>(lds, (const char*)(args.ws + WS_MIX), DM * 2, S, E);
    }
    SEAM(4);
    if (IN(5)) p5_router(args, lds, G, bx, tid, lane, wave);
    SEAM(5);
    if (IN(6)) REPEAT(6) {
        if (bx >= GG) moe_weights_queue(args, lds, misc + 212, tid, wave, lane, MOE_ITEMS);
        else {
        const int mt = moe_setup(args, misc, tid);
        pg8::MoeOrder<true> S; S.tpre = misc; S.tok = (const LAS int*)(lds + TOK_OFF); S.nN = 16; S.nwg = mt * 16; S.G = GG; S.c = bx;
        S.Bt = (const char*)(args.ws + WS_WGU); S.estride = (size_t)2 * DE * DM; S.K2 = DM;
        const int* LIST = (const int*)(args.ws + WS_LIST);
        for (int ui = 0; ui < TOK_CAP; ++ui) { pg8::Unit u; if (!S.next(ui, u)) break;
            if (tid < 256) { const int idx = (u.pm - misc[u.e]) * 256 + tid; ((LAS int*)(lds + TOK_OFF))[ui * 256 + tid] = idx < misc[104 + u.e] ? LIST[(size_t)u.e * NREAL + idx] : 0; } }
        __syncthreads();
        pg8::EpiSwiGLU E{args.ws + WS_ACT, args.in[I_BGU]};
        pg8::gemm_phase<pg8::EpiSwiGLU, pg8::MoeOrder<true>, true, true, true>(lds, (const char*)(args.ws + WS_HN), DM, S, E);
        }
    }
    SEAM(6);
    if (IN(7)) REPEAT(7) {
        const int mt = moe_setup(args, misc, tid);
        pg8::MoeOrder<false> S; S.tpre = misc; S.tok = nullptr; S.nN = 8; S.nwg = mt * 8; S.G = G; S.c = bx;
        S.Bt = (const char*)(args.ws + WS_WD); S.estride = (size_t)DM * DE; S.K2 = DE;
        pg8::EpiBf16 E{(bf16_t*)(args.ws + (_r ? WS_WGU : WS_Y)), DM, 0};
        pg8::gemm_phase<pg8::EpiBf16, pg8::MoeOrder<false>, true, true, true>(lds, (const char*)(args.ws + WS_ACT), DE, S, E);
    }
    SEAM(7);
    if (IN(8)) { (void)moe_setup(args, misc, tid); p8_combine(args, misc, gw, NGW, lane); }
#if PROBE_A >= 0
    __syncthreads();
    if (tid == 0) tsl[9] = __builtin_amdgcn_s_memrealtime();
    __syncthreads();
    {
        const int pa = PROBE_A;
        const float us = (float)(pa == 9 ? (tsl[9] - tsl[0]) : (tsl[pa + 1] - tsl[pa])) * 1e-2f;
        const float f = 1.0f - 0.05f * us / (float)(PROBE_REF_US);
        VM_WAIT();
        for (int row = gw; row < NREAL; row += NGW) {
#pragma unroll
            for (int j = 0; j < 8; ++j) { f32x4* p = (f32x4*)(args.out + (size_t)row * DM) + lane + 64 * j; *p = *p * f; } }
    }
#endif
#undef IN
#undef SEAM
}

extern "C" void kernel_launch(void* const* d_in, const int* in_sizes, int n_in, void* d_out, int out_size, void* d_ws, size_t ws_size, hipStream_t stream) {
    static int grid = 0;
    if (grid == 0) {
        if (n_in != 19 || out_size != NREAL * DM || ws_size < WS_END) { fprintf(stderr, "kernel_launch: unexpected shapes (n_in %d out %d ws %zu need %zu)\n", n_in, out_size, ws_size, (size_t)WS_END); grid = -1; return; }
        int dev = 0, cus = 0, per_cu = 0;
        if (hipGetDevice(&dev) != hipSuccess || hipDeviceGetAttribute(&cus, hipDeviceAttributeMultiprocessorCount, dev) != hipSuccess) { grid = -1; return; }
        if (hipFuncSetAttribute((const void*)hymba_fwd, hipFuncAttributeMaxDynamicSharedMemorySize, LDS_BYTES) != hipSuccess) { fprintf(stderr, "kernel_launch: hipFuncSetAttribute failed\n"); grid = -1; return; }
        if (hipOccupancyMaxActiveBlocksPerMultiprocessor(&per_cu, (const void*)hymba_fwd, NTHREADS, LDS_BYTES) != hipSuccess || per_cu < 1) { fprintf(stderr, "kernel_launch: occupancy query says %d\n", per_cu); grid = -1; return; }
        (void)hipGetLastError();
        grid = cus;
    }
    if (grid < 0) return;
    (void)hipMemsetAsync((char*)d_ws + WS_CTL, 0, CTL_ZERO_BYTES, stream);
    Args a{};
    for (int i = 0; i < 19; ++i) a.in[i] = (const float*)d_in[i];
    a.out = (float*)d_out; a.ws = (unsigned char*)d_ws;
#if MK_N_LAUNCHES == 1
    a.ph_lo = 0; a.ph_hi = NPH;
    hipLaunchKernelGGL(hymba_fwd, dim3(grid), dim3(NTHREADS), LDS_BYTES, stream, a);
#else
    for (int p = 0; p < NPH; ++p) { a.ph_lo = p; a.ph_hi = p + 1; hipLaunchKernelGGL(hymba_fwd, dim3(grid), dim3(NTHREADS), LDS_BYTES, stream, a); }
#endif
    const hipError_t le = hipPeekAtLastError();
    if (le != hipSuccess) fprintf(stderr, "kernel_launch: launch failed: %s\n", hipGetErrorName(le));
}
```

```cpp
#include <hip/hip_runtime.h>
#include <cstdio>
#include <cstdint>

#ifndef GDN_CHUNKED
#define GDN_CHUNKED 1
#endif
#ifndef REP_PHASE
#define REP_PHASE -1
#endif
#ifndef PROBE_A
#define PROBE_A -1
#endif
#ifndef PROBE_REF_US
#define PROBE_REF_US 500
#endif
#ifndef MK_N_LAUNCHES
#define MK_N_LAUNCHES 1
#endif

constexpr int NB = 4, SEQ = 4096, NMETA = 16, LSEQ = SEQ + NMETA;
constexpr int DM = 2048, NTOK = NB * LSEQ  , MPAD = 16640  , NREAL = NB * SEQ  ;
constexpr int NPROJ_SRC = 7184, NPROJ = 7168;
constexpr int NHEAD = 8, HD = 128;
constexpr int PC_QKV = 0, PC_Z = 3072, PC_SBQ = 4096, PC_SBK = 5120, PC_SBV = 6144;
constexpr int NEXP = 32, TOPK = 4, DE = 2048;
constexpr int SLOT_ROWS = 73728;
constexpr int LROW = 4224;
constexpr float NORM_EPS = 1e-6f;

constexpr size_t MiB = 1u << 20;
constexpr size_t WS_CTL = 0, CTL_ZERO_BYTES = 1 * MiB;
constexpr size_t WS_WIN = 1 * MiB;
constexpr size_t WS_WOUT = WS_WIN + (size_t)NPROJ * DM * 2;
constexpr size_t WS_WGU = WS_WOUT + (size_t)DM * DM * 2;
constexpr size_t WS_WD = WS_WGU + (size_t)NEXP * 2 * DE * DM * 2;
constexpr size_t WS_HN = WS_WD + (size_t)NEXP * DM * DE * 2;
constexpr size_t WS_BETA = WS_HN + (size_t)MPAD * DM * 2;
constexpr size_t WS_G = WS_BETA + (size_t)NTOK * 8 * 4 + 256;
constexpr size_t WS_P = WS_G + (size_t)NTOK * 8 * 4 + 256;
constexpr size_t WS_QN = WS_P + (size_t)MPAD * NPROJ * 2;
constexpr size_t WS_KN = WS_QN + (size_t)NB * NHEAD * LROW * HD * 2;
constexpr size_t WS_ORAW = WS_KN + (size_t)NB * NHEAD * LROW * HD * 2;
constexpr size_t WS_MIX = WS_ORAW + (size_t)NREAL * 1024 * 4;
constexpr size_t WS_RE = WS_MIX + (size_t)NREAL * DM * 2;
constexpr size_t WS_RP = WS_RE + (size_t)NREAL * 4 * 4;
constexpr size_t WS_RG = WS_RP + (size_t)NREAL * 4 * 4;
constexpr size_t WS_LIST = WS_RG + (size_t)NREAL * 4 * 4;
constexpr size_t WS_ACT = WS_LIST + (size_t)NEXP * NREAL * 4;
constexpr size_t WS_Y = WS_ACT + (size_t)SLOT_ROWS * DE * 2;
constexpr size_t WS_GCH = WS_Y + (size_t)SLOT_ROWS * DM * 2;
constexpr size_t WS_GL = WS_GCH + (size_t)32 * 65 * 73728;
constexpr size_t WS_END = WS_GL + 32 * 65 * 4 + 256;
constexpr int CW_ECNT = 64;
constexpr int CW_CVTQ = 192;
constexpr int CW_PREQ = 256;
constexpr int CW_BAR = 4096;

constexpr int LDS_STAGE = 131072;
constexpr int TOK_OFF = LDS_STAGE, TOK_CAP = 22;
constexpr int MISC_OFF = TOK_OFF + TOK_CAP * 256 * 4;
constexpr int LDS_BYTES = MISC_OFF + 1024;

#define GAS __attribute__((address_space(1)))
#define LAS __attribute__((address_space(3)))
typedef unsigned short bf16_t;
typedef short bf16x8 __attribute__((ext_vector_type(8)));
typedef short s16x4 __attribute__((ext_vector_type(4)));
typedef float f32x4 __attribute__((ext_vector_type(4)));
typedef float f32x2 __attribute__((ext_vector_type(2)));
typedef float f32x16 __attribute__((ext_vector_type(16)));
typedef unsigned u32x4 __attribute__((ext_vector_type(4)));
typedef unsigned u32x2 __attribute__((ext_vector_type(2)));

typedef __bf16 bf16x2_t __attribute__((ext_vector_type(2)));
__device__ __forceinline__ unsigned cvt_pk_bf16(float lo, float hi) { const f32x2 v = {lo, hi}; const bf16x2_t b = __builtin_convertvector(v, bf16x2_t); return __builtin_bit_cast(unsigned, b); }
__device__ __forceinline__ unsigned pk4_fp8(float a, float b, float c, float d) { unsigned w = 0u; w = __builtin_amdgcn_cvt_pk_fp8_f32(a, b, w, false); w = __builtin_amdgcn_cvt_pk_fp8_f32(c, d, w, true); return w; }
__device__ __forceinline__ float bf_lo(unsigned w) { return __uint_as_float(w << 16); }
__device__ __forceinline__ float bf_hi(unsigned w) { return __uint_as_float(w & 0xffff0000u); }
__device__ __forceinline__ float bf2f(bf16_t b) { return __uint_as_float(((unsigned)b) << 16); }
template <int CTRL, int ROW_MASK> __device__ __forceinline__ float dpp_get(float v) {
    return __builtin_bit_cast(float, __builtin_amdgcn_update_dpp(0, __builtin_bit_cast(int, v), CTRL, ROW_MASK, 0xF, false));
}
__device__ __forceinline__ float row16_sum(float v) {
    v += dpp_get<0xB1, 0xF>(v);
    v += dpp_get<0x4E, 0xF>(v);
    v += dpp_get<0x141, 0xF>(v);
    v += dpp_get<0x140, 0xF>(v);
    return v;
}
__device__ __forceinline__ float quad_sum(float v) { v += dpp_get<0xB1, 0xF>(v); v += dpp_get<0x4E, 0xF>(v); return v; }
__device__ __forceinline__ float wave_sum(float v) {
    v = row16_sum(v);
    v += dpp_get<0x142, 0xA>(v);
    v += dpp_get<0x143, 0xC>(v);
    return __builtin_bit_cast(float, __builtin_amdgcn_readlane(__builtin_bit_cast(int, v), 63));
}

namespace pg8 {
constexpr int BM = 256, BK = 64, HALF = 128, HTB = HALF * BK * 2, STAGE_BYTES = 8 * HTB, NXCD = 8, WGM = 8;
__host__ __device__ __forceinline__ int lds_byte(int r, int c) { const int st = (r >> 4) * 2 + (c >> 5), rr = r & 15, cc = c & 31, ob = rr * 64 + cc * 2; return st * 1024 + (ob ^ (((ob >> 9) & 1) << 5)); }
__host__ __device__ __forceinline__ void stage_rc(int b, int& R, int& C) { const int st = b / 1024, sb = b % 1024, swz = sb ^ (((sb >> 9) & 1) << 5); R = (st >> 1) * 16 + swz / 64; C = (st & 1) * 32 + (swz % 64) / 2; }
__host__ __device__ __forceinline__ int perm32(int rho) { const int n = rho >> 4, i = rho & 15; return 8 * (i >> 2) + 4 * n + (i & 3); }

typedef int v8i __attribute__((ext_vector_type(8))); typedef int v4i __attribute__((ext_vector_type(4)));
__device__ __forceinline__ v8i cat8(bf16x8 lo, bf16x8 hi) { const v4i a = __builtin_bit_cast(v4i, lo), b = __builtin_bit_cast(v4i, hi); return __builtin_shufflevector(a, b, 0, 1, 2, 3, 4, 5, 6, 7); }
struct Unit { int pm, pn, e, ui; };

__device__ __forceinline__ int xcd_remap(int L, int nwg) { const int q = nwg / NXCD, r = nwg % NXCD, xcd = L % NXCD, off = L / NXCD; return (xcd < r ? xcd * (q + 1) : r * (q + 1) + (xcd - r) * q) + off; }

struct PlainOrder {
    int nM, nN, nwg, G, c; const char* Bt; unsigned K2;
    __device__ void init(int M, int N, int K, const void* Bt_, int G_, int c_) { nM = M / BM; nN = N / BM; nwg = nM * nN; G = G_; c = c_; Bt = (const char*)Bt_; K2 = (unsigned)K * 2u; }
    __device__ __forceinline__ bool next(int i, Unit& u) const {
        const long L = (long)i * G + c; if (L >= nwg) return false;
        const int wgid = xcd_remap((int)L, nwg);
        const int nig = WGM * nN, gid = wgid / nig, fm = gid * WGM, gsz = (nM - fm) < WGM ? (nM - fm) : WGM;
        u.pm = fm + ((wgid % nig) % gsz); u.pn = (wgid % nig) / gsz; u.e = 0; u.ui = i; return true;
    }
    __device__ __forceinline__ const char* b_ptr(const Unit& u) const { return Bt + (size_t)u.pn * BM * K2; }
    __device__ __forceinline__ unsigned a_off(const Unit& u, int r) const { return (unsigned)(u.pm * BM + r + (meta ? NMETA * ((u.pm >> 4) + 1) : 0)) * K2; }
    int meta = 0;
};
template <bool GATHER> struct MoeOrder {
    const LAS int* tpre; const LAS int* tok; int nN, nwg, G, c; const char* Bt; size_t estride; unsigned K2;
    __device__ __forceinline__ bool next(int i, Unit& u) const {
        const long L = (long)i * G + c; if (L >= nwg) return false;
        const int wgid = xcd_remap((int)L, nwg);
        int e = 0;
#pragma unroll 1
        for (int j = 1; j < NEXP; ++j) e = (wgid >= tpre[j] * nN) ? j : e;
        const int t0 = tpre[e], nt = tpre[e + 1] - t0, loc = wgid - t0 * nN;
        u.e = e; u.pn = loc / nt; u.pm = t0 + loc % nt; u.ui = i; return true;
    }
    __device__ __forceinline__ const char* b_ptr(const Unit& u) const { return Bt + (size_t)u.e * estride + (size_t)u.pn * BM * K2; }
    __device__ __forceinline__ unsigned a_off(const Unit& u, int r) const {
        if (GATHER) return (unsigned)tok[u.ui * 256 + r] * K2;
        return (unsigned)(u.pm * BM + r) * K2;
    }
};

struct EpiBf16 {
    static constexpr bool PERM = true;
    bf16_t* O; int ldc; int meta;
    __device__ __forceinline__ void operator()(const f32x4 (&acc)[2][2][4][2], const Unit& u, int wr, int wc, int fr, int fq) const {
        const int row0 = u.pm * BM + wr * 64 + fr + (meta ? NMETA * ((u.pm >> 4) + 1) : 0), col0 = u.pn * BM + wc * 32 + 8 * fq;
#pragma unroll
        for (int ai = 0; ai < 2; ++ai)
#pragma unroll
            for (int m = 0; m < 4; ++m) { bf16_t* rowp = O + (size_t)(row0 + ai * HALF + m * 16) * ldc + col0;
#pragma unroll
                for (int bj = 0; bj < 2; ++bj) { const f32x4 v0 = acc[ai][bj][m][0], v1 = acc[ai][bj][m][1];
                    u32x4 w; w.x = cvt_pk_bf16(v0[0], v0[1]); w.y = cvt_pk_bf16(v0[2], v0[3]); w.z = cvt_pk_bf16(v1[0], v1[1]); w.w = cvt_pk_bf16(v1[2], v1[3]);
                    *(u32x4*)(rowp + bj * HALF) = w; } }
    }
};
struct EpiResF32 {
    static constexpr bool PERM = false;
    const float* X; float* out; int ldc;
    __device__ __forceinline__ void operator()(const f32x4 (&acc)[2][2][4][2], const Unit& u, int wr, int wc, int fr, int fq) const {
        const int row0 = u.pm * BM + wr * 64 + fr, col0 = u.pn * BM + wc * 32 + 4 * fq;
#pragma unroll
        for (int ai = 0; ai < 2; ++ai)
#pragma unroll
            for (int m = 0; m < 4; ++m) { const size_t off = (size_t)(row0 + ai * HALF + m * 16) * ldc + col0;
#pragma unroll
                for (int bj = 0; bj < 2; ++bj)
#pragma unroll
                    for (int n = 0; n < 2; ++n) { const f32x4 xv = *(const f32x4*)(X + off + bj * HALF + n * 16); *(f32x4*)(out + off + bj * HALF + n * 16) = xv + acc[ai][bj][m][n]; }
                asm volatile("" ::: "memory"); }
    }
};
__device__ __forceinline__ float swiglu1(float g, float uu) {
    g = fminf(g, 7.0f); uu = fminf(fmaxf(uu, -7.0f), 7.0f);
    const float sg = __builtin_amdgcn_rcpf(1.0f + __builtin_amdgcn_exp2f(-1.702f * 1.4426950408889634f * g));
    return (uu + 1.0f) * g * sg;
}
struct EpiSwiGLU {
    static constexpr bool PERM = true;
    unsigned char* act; const float* bgu;
    __device__ __forceinline__ void operator()(const f32x4 (&acc)[2][2][4][2], const Unit& u, int wr, int wc, int fr, int fq) const {
        const int row0 = u.pm * BM + wr * 64 + fr, col0 = u.pn * HALF + wc * 32 + 8 * fq;
        const float* bg = bgu + (size_t)u.e * 4096 + col0;
        const f32x4 bg0 = *(const f32x4*)(bg), bg1 = *(const f32x4*)(bg + 4), bu0 = *(const f32x4*)(bg + 2048), bu1 = *(const f32x4*)(bg + 2052);
#pragma unroll
        for (int ai = 0; ai < 2; ++ai)
#pragma unroll
            for (int m = 0; m < 4; ++m) { unsigned char* rowp = act + (size_t)(row0 + ai * HALF + m * 16) * DE + col0;
                const f32x4 g0 = acc[ai][0][m][0] + bg0, g1 = acc[ai][0][m][1] + bg1, u0 = acc[ai][1][m][0] + bu0, u1 = acc[ai][1][m][1] + bu1;
                u32x2 w; w.x = pk4_fp8(swiglu1(g0[0], u0[0]), swiglu1(g0[1], u0[1]), swiglu1(g0[2], u0[2]), swiglu1(g0[3], u0[3]));
                w.y = pk4_fp8(swiglu1(g1[0], u1[0]), swiglu1(g1[1], u1[1]), swiglu1(g1[2], u1[2]), swiglu1(g1[3], u1[3]));
                *(u32x2*)rowp = w; }
    }
};

template <class Epi, class Sched, bool ALIGN_EPI, bool SP2, bool FP8 = false>
__device__ __forceinline__ void gemm_phase(LAS unsigned char* lds, const char* A0, int Kb, const Sched& S, const Epi& E) {
    const int tid = threadIdx.x, wid = __builtin_amdgcn_readfirstlane(tid >> 6), lane = tid & 63, wr = wid >> 2, wc = wid & 3, fr = lane & 15, fq = lane >> 4;
    const int nt = Kb / 128;
    int Rr[2], Cc[2]; unsigned voffB[2];
#pragma unroll
    for (int i = 0; i < 2; ++i) { int R, C; stage_rc(tid * 16 + i * 8192, R, C); const int Rb = Epi::PERM ? ((R & ~31) + perm32(R & 31)) : R;
        Rr[i] = R; Cc[i] = C * 2; voffB[i] = (unsigned)(Rb * Kb + C * 2); }
    const size_t kstep = (size_t)(BK * 2);
    const size_t hstep = (size_t)HALF * Kb;
    const unsigned ldsw = (unsigned)wid * 1024u;
    const int aoff = lds_byte(wr * 64 + fr, fq * 8), boff = lds_byte(wc * 32 + fr, fq * 8);
#define PG8_SA(b, h) (((b) * 2 + (h)) * HTB)
#define PG8_SB(b, h) ((4 + (b) * 2 + (h)) * HTB)
#define PG8_STAGE(bufoff, gbase, voff) do { _Pragma("unroll") for (int _i = 0; _i < 2; ++_i) \
        __builtin_amdgcn_global_load_lds((const unsigned*)((const char*)(gbase) + (voff)[_i]), (LAS unsigned*)(lds + (bufoff) + ldsw + _i * 8192), 16, 0, 0); } while (0)
#define PG8_LDA(dst, b, h) do { _Pragma("unroll") for (int m = 0; m < 4; ++m) _Pragma("unroll") for (int k = 0; k < 2; ++k) dst[m][k] = *(const LAS bf16x8*)(lds + PG8_SA(b, h) + aoff + m * 2048 + k * 1024); } while (0)
#define PG8_LDB(dst, b, h) do { _Pragma("unroll") for (int n = 0; n < 2; ++n) _Pragma("unroll") for (int k = 0; k < 2; ++k) dst[n][k] = *(const LAS bf16x8*)(lds + PG8_SB(b, h) + boff + n * 2048 + k * 1024); } while (0)
#define PG8_MMA(ai, bj, At, Bt) do { __builtin_amdgcn_s_setprio(1); _Pragma("unroll") for (int m = 0; m < 4; ++m) _Pragma("unroll") for (int n = 0; n < 2; ++n) { \
        if constexpr (FP8) acc[ai][bj][m][n] = __builtin_amdgcn_mfma_scale_f32_16x16x128_f8f6f4(cat8(Bt[n][0], Bt[n][1]), cat8(At[m][0], At[m][1]), acc[ai][bj][m][n], 0, 0, 0, 0x79797979, 0, 0x7f7f7f7f); \
        else { _Pragma("unroll") for (int k = 0; k < 2; ++k) acc[ai][bj][m][n] = __builtin_amdgcn_mfma_f32_16x16x32_bf16(Bt[n][k], At[m][k], acc[ai][bj][m][n], 0, 0, 0); } } \
        __builtin_amdgcn_s_setprio(0); } while (0)
#define PG8_WAIT_V(n) asm volatile("s_waitcnt vmcnt(" #n ")" ::: "memory")
#define PG8_WAIT_L(n) asm volatile("s_waitcnt lgkmcnt(" #n ")" ::: "memory")
#define PG8_BAR __builtin_amdgcn_s_barrier()
#define PG8_SCHED __builtin_amdgcn_sched_barrier(0)
#define PG8_VOFF(dst, u) do { _Pragma("unroll") for (int _h = 0; _h < 2; ++_h) _Pragma("unroll") for (int _i = 0; _i < 2; ++_i) dst[_h][_i] = S.a_off(u, _h * HALF + Rr[_i]) + (unsigned)Cc[_i]; } while (0)
    Unit cur, nxt; int ui = 0;
    if (!S.next(0, cur)) return;
    f32x4 acc[2][2][4][2];
#pragma unroll
    for (int a = 0; a < 2; ++a)
#pragma unroll
        for (int b = 0; b < 2; ++b)
#pragma unroll
            for (int m = 0; m < 4; ++m)
#pragma unroll
                for (int n = 0; n < 2; ++n) acc[a][b][m][n] = (f32x4){0.f, 0.f, 0.f, 0.f};
    bf16x8 At[4][2], B0[2][2], B1[2][2];
    unsigned va[2][2], vn[2][2];
    PG8_VOFF(va, cur);
    const char* cB = S.b_ptr(cur);
    if constexpr (SP2) {
        PG8_STAGE(PG8_SB(0, 0), cB, voffB); PG8_STAGE(PG8_SB(0, 1), cB + hstep, voffB); PG8_STAGE(PG8_SA(0, 0), A0, va[0]); PG8_STAGE(PG8_SA(0, 1), A0, va[1]);
        if (wr == 1) PG8_BAR;
        PG8_WAIT_V(2); PG8_BAR;
        PG8_STAGE(PG8_SB(1, 0), cB + kstep, voffB); PG8_STAGE(PG8_SA(1, 0), A0 + kstep, va[0]); PG8_STAGE(PG8_SB(1, 1), cB + hstep + kstep, voffB);
        PG8_WAIT_V(6); PG8_BAR;
    } else {
        PG8_STAGE(PG8_SB(0, 0), cB, voffB); PG8_STAGE(PG8_SA(0, 0), A0, va[0]); PG8_STAGE(PG8_SB(0, 1), cB + hstep, voffB); PG8_STAGE(PG8_SA(0, 1), A0, va[1]);
        if (wr == 1) PG8_BAR;
        PG8_WAIT_V(4); PG8_BAR;
        PG8_STAGE(PG8_SB(1, 0), cB + kstep, voffB); PG8_STAGE(PG8_SA(1, 0), A0 + kstep, va[0]); PG8_STAGE(PG8_SB(1, 1), cB + hstep + kstep, voffB);
        PG8_WAIT_V(6); PG8_BAR;
    }
    for (;;) {
        const bool has_next = S.next(ui + 1, nxt);
        const char* nB = has_next ? S.b_ptr(nxt) : cB;
        for (int t = 0; t < nt; t += 2) {
            const bool last = (t == nt - 2);
            const char* a1 = A0 + (size_t)(t + 1) * kstep;
            const char* a2 = last ? A0 : A0 + (size_t)(t + 2) * kstep; const char* b2 = last ? nB : cB + (size_t)(t + 2) * kstep;
            const char* a3 = a2 + kstep; const char* b3 = b2 + kstep;
            if (last) { if (has_next) { PG8_VOFF(vn, nxt); } else {
#pragma unroll
                    for (int _h = 0; _h < 2; ++_h)
#pragma unroll
                        for (int _i = 0; _i < 2; ++_i) vn[_h][_i] = va[_h][_i]; } }
            if constexpr (SP2) {
            PG8_LDB(B0, 0, 0); PG8_LDB(B1, 0, 1); PG8_SCHED; PG8_LDA(At, 0, 0); PG8_STAGE(PG8_SA(1, 1), a1, va[1]);
            if (last) {
#pragma unroll
                for (int _h = 0; _h < 2; ++_h)
#pragma unroll
                    for (int _i = 0; _i < 2; ++_i) va[_h][_i] = vn[_h][_i]; }
            PG8_WAIT_V(8); PG8_WAIT_L(0); PG8_BAR; PG8_MMA(0, 0, At, B0); PG8_MMA(0, 1, At, B1); PG8_BAR; PG8_SCHED;
            PG8_LDA(At, 0, 1); PG8_STAGE(PG8_SB(0, 0), b2, voffB); PG8_STAGE(PG8_SB(0, 1), b2 + hstep, voffB); PG8_STAGE(PG8_SA(0, 0), a2, va[0]);
            PG8_WAIT_V(8); PG8_WAIT_L(0); PG8_BAR; PG8_MMA(1, 0, At, B0); PG8_MMA(1, 1, At, B1); PG8_BAR; PG8_SCHED;
            PG8_LDB(B0, 1, 0); PG8_LDB(B1, 1, 1); PG8_SCHED; PG8_LDA(At, 1, 0); PG8_STAGE(PG8_SA(0, 1), a2, va[1]);
            PG8_WAIT_V(8); PG8_WAIT_L(0); PG8_BAR; PG8_MMA(0, 0, At, B0); PG8_MMA(0, 1, At, B1); PG8_BAR; PG8_SCHED;
            PG8_LDA(At, 1, 1); PG8_STAGE(PG8_SB(1, 0), b3, voffB); PG8_STAGE(PG8_SB(1, 1), b3 + hstep, voffB); PG8_STAGE(PG8_SA(1, 0), a3, va[0]);
            PG8_WAIT_V(8); PG8_WAIT_L(0); PG8_BAR; PG8_MMA(1, 0, At, B0); PG8_MMA(1, 1, At, B1); PG8_BAR; PG8_SCHED;
            } else {
            PG8_LDB(B0, 0, 0); PG8_SCHED; PG8_LDA(At, 0, 0); PG8_STAGE(PG8_SA(1, 1), a1, va[1]);
            if (last) {
#pragma unroll
                for (int _h = 0; _h < 2; ++_h)
#pragma unroll
                    for (int _i = 0; _i < 2; ++_i) va[_h][_i] = vn[_h][_i]; }
            PG8_WAIT_L(8); PG8_BAR; PG8_WAIT_L(0); PG8_MMA(0, 0, At, B0); PG8_BAR; PG8_SCHED;
            PG8_LDB(B1, 0, 1); PG8_STAGE(PG8_SB(0, 0), b2, voffB);
            PG8_BAR; PG8_WAIT_L(0); PG8_MMA(0, 1, At, B1); PG8_BAR;
            PG8_LDA(At, 0, 1); PG8_STAGE(PG8_SA(0, 0), a2, va[0]);
            PG8_BAR; PG8_WAIT_L(0); PG8_MMA(1, 0, At, B0); PG8_BAR; PG8_SCHED;
            PG8_STAGE(PG8_SB(0, 1), b2 + hstep, voffB);
            PG8_WAIT_V(6); PG8_BAR; PG8_MMA(1, 1, At, B1); PG8_BAR;
            PG8_LDB(B0, 1, 0); PG8_SCHED; PG8_LDA(At, 1, 0); PG8_STAGE(PG8_SA(0, 1), a2, va[1]);
            PG8_WAIT_L(8); PG8_BAR; PG8_WAIT_L(0); PG8_MMA(0, 0, At, B0); PG8_BAR; PG8_SCHED;
            PG8_LDB(B1, 1, 1); PG8_STAGE(PG8_SB(1, 0), b3, voffB);
            PG8_BAR; PG8_WAIT_L(0); PG8_MMA(0, 1, At, B1); PG8_BAR;
            PG8_LDA(At, 1, 1); PG8_STAGE(PG8_SA(1, 0), a3, va[0]);
            PG8_BAR; PG8_WAIT_L(0); PG8_MMA(1, 0, At, B0); PG8_BAR; PG8_SCHED;
            PG8_STAGE(PG8_SB(1, 1), b3 + hstep, voffB);
            PG8_WAIT_V(6); PG8_BAR; PG8_MMA(1, 1, At, B1); PG8_BAR;
            }
        }
        if constexpr (ALIGN_EPI) { if (wr == 0) PG8_BAR; }
        E(acc, cur, wr, wc, fr, fq);
        if (!has_next) break;
#pragma unroll
        for (int a = 0; a < 2; ++a)
#pragma unroll
            for (int b = 0; b < 2; ++b)
#pragma unroll
                for (int m = 0; m < 4; ++m)
#pragma unroll
                    for (int n = 0; n < 2; ++n) acc[a][b][m][n] = (f32x4){0.f, 0.f, 0.f, 0.f};
        cur = nxt; cB = nB; ++ui;
        if constexpr (ALIGN_EPI) { if (wr == 1) PG8_BAR; }
    }
    PG8_WAIT_V(0);
    if constexpr (!ALIGN_EPI) { if (wr == 0) PG8_BAR; }
    PG8_BAR;
#undef PG8_SA
#undef PG8_SB
#undef PG8_STAGE
#undef PG8_LDA
#undef PG8_LDB
#undef PG8_MMA
#undef PG8_WAIT_V
#undef PG8_WAIT_L
#undef PG8_BAR
#undef PG8_SCHED
#undef PG8_VOFF
}
}

#define XB_TMO      128
#define XB_XCNT(j)  (256  + 64 * (j))
#define XB_XSUB(j)  (1280 + 64 * (j))
#define XB_XGEN(j)  (2304 + 64 * (j))
#define XB_TOP      3328
#define XB_TOPGEN   3392
#define XCD_BAR_WORDS 3456
#define XB_SPIN_CAP (1u << 18)

__device__ __forceinline__ unsigned xb_ld(unsigned* p)              { return __hip_atomic_load(p, __ATOMIC_RELAXED, __HIP_MEMORY_SCOPE_AGENT); }
__device__ __forceinline__ unsigned xb_add(unsigned* p, unsigned v) { return __hip_atomic_fetch_add(p, v, __ATOMIC_RELAXED, __HIP_MEMORY_SCOPE_AGENT); }
__device__ __forceinline__ unsigned xb_xcc_id() { return (unsigned)__builtin_amdgcn_s_getreg((3 << 11) | 20) & 0xFu; }
#define XB_SPIN(cond, bar) do { unsigned _sp = 0; while (cond) { __builtin_amdgcn_s_sleep(1); \
    if ((++_sp & 255u) == 0u) { if (xb_ld(&(bar)[XB_TMO])) break; if (_sp > XB_SPIN_CAP) { atomicAdd(&(bar)[XB_TMO], 1u); break; } } } } while (0)

struct XcdBarrier {
    unsigned* bar; unsigned x;
    volatile LAS unsigned* st;
};
__device__ __forceinline__ XcdBarrier xcd_barrier_post(unsigned* bar, volatile LAS unsigned* st) {
    XcdBarrier b; b.bar = bar; b.x = xb_xcc_id(); b.st = st;
    if (threadIdx.x == 0) (void)xb_add(&bar[XB_XCNT(b.x)], 1u);
    return b;
}
__device__ __forceinline__ void xcd_barrier_complete(unsigned* bar, unsigned x, unsigned& nloc, unsigned& nx) {
    const unsigned G = gridDim.x * gridDim.y * gridDim.z;
    unsigned sum, cnt, mine, sp = 0u;
    for (;;) {
        sum = 0u; cnt = 0u; mine = 0u;
#pragma unroll
        for (unsigned j = 0; j < 16; ++j) { const unsigned c = xb_ld(&bar[XB_XCNT(j)]); sum += c; cnt += (c > 0u) ? 1u : 0u; mine = (j == x) ? c : mine; }
        if (sum == G) break;
        __builtin_amdgcn_s_sleep(1);
        if ((++sp & 255u) == 0u) { if (xb_ld(&bar[XB_TMO])) break; if (sp > XB_SPIN_CAP) { atomicAdd(&bar[XB_TMO], 1u); break; } }
    }
    nloc = mine > 0u ? mine : 1u; nx = cnt > 0u ? cnt : 1u;
}
__device__ __forceinline__ void xcd_barrier(const XcdBarrier& b) {
    asm volatile("s_waitcnt vmcnt(0)" ::: "memory");
    __syncthreads();
    if (threadIdx.x == 0) {
        unsigned* bar = b.bar;
        __builtin_amdgcn_s_waitcnt(0);
        unsigned nloc = b.st[0], nx = b.st[1];
        if (nloc == 0u) { xcd_barrier_complete(bar, b.x, nloc, nx); b.st[0] = nloc; b.st[1] = nx; }
        const unsigned old = xb_add(&bar[XB_XSUB(b.x)], 1u);
        const unsigned gen = old / nloc;
        if (old + 1u == (gen + 1u) * nloc) {
            __builtin_amdgcn_fence(__ATOMIC_RELEASE, "agent");
            asm volatile("s_waitcnt vmcnt(0)" ::: "memory");
            const unsigned og = xb_add(&bar[XB_TOP], 1u);
            const unsigned tg = og / nx;
            if (og + 1u == (tg + 1u) * nx) xb_add(&bar[XB_TOPGEN], 1u);
            else XB_SPIN(xb_ld(&bar[XB_TOPGEN]) == tg, bar);
            __builtin_amdgcn_fence(__ATOMIC_ACQUIRE, "agent");
            xb_add(&bar[XB_XGEN(b.x)], 1u);
            asm volatile("s_waitcnt vmcnt(0)" ::: "memory");
        } else {
            XB_SPIN(xb_ld(&bar[XB_XGEN(b.x)]) == gen, bar);
            __builtin_amdgcn_fence(__ATOMIC_ACQUIRE, "agent");
            asm volatile("s_waitcnt vmcnt(0)" ::: "memory");
        }
    }
    __syncthreads();
}

constexpr int NWAVES = 8, NTHREADS = 512;
struct Args { const float* in[19]; float* out; unsigned char* ws; int ph_lo, ph_hi; };
enum { I_X = 0, I_META, I_MIXNW, I_WIN, I_CONVW, I_ALOG, I_DTB, I_GDNNW, I_SBQNW, I_SBKNW, I_SBONW, I_WOUT, I_FFNNW, I_RW, I_RB, I_WGU, I_BGU, I_WD, I_BD };

#define LDS_WAIT() asm volatile("s_waitcnt lgkmcnt(0)" ::: "memory")
#define VM_WAIT() asm volatile("s_waitcnt vmcnt(0)" ::: "memory")
constexpr int WLS = 2052;

__device__ __forceinline__ void dot16(const f32x4 (&v)[8], const LAS float* wl, int lane, float (&s)[16]) {
#pragma unroll
    for (int c = 0; c < 16; ++c) { float a = 0.f;
#pragma unroll
        for (int j = 0; j < 8; ++j) { const f32x4 w = *(const LAS f32x4*)(wl + c * WLS + 4 * lane + 256 * j); a += (v[j].x * w.x + v[j].y * w.y) + (v[j].z * w.z + v[j].w * w.w); }
        s[c] = wave_sum(a); }
}

template <int NR> __device__ __forceinline__ void dot8xN(const f32x4 (&v)[NR][8], const LAS float* wl, int lane, float (&out)[NR][8]) {
#pragma unroll
    for (int c = 0; c < 8; ++c) { float a[NR];
#pragma unroll
        for (int k = 0; k < NR; ++k) a[k] = 0.f;
#pragma unroll
        for (int j = 0; j < 8; ++j) { const f32x4 w = *(const LAS f32x4*)(wl + c * WLS + 4 * lane + 256 * j);
#pragma unroll
            for (int k = 0; k < NR; ++k) a[k] += (v[k][j].x * w.x + v[k][j].y * w.y) + (v[k][j].z * w.z + v[k][j].w * w.w); }
#pragma unroll
        for (int k = 0; k < NR; ++k) out[k][c] = wave_sum(a[k]); }
}
__device__ __forceinline__ void stage_w16(LAS float* wl, const float* base, int ld, int coloff, int tid) {
#pragma unroll 4
    for (int idx = tid; idx < 2048 * 4; idx += NTHREADS) { const int k = idx >> 2, q = idx & 3; const f32x4 v = *(const f32x4*)(base + (size_t)k * ld + coloff + 4 * q);
        wl[(4 * q + 0) * WLS + k] = v.x; wl[(4 * q + 1) * WLS + k] = v.y; wl[(4 * q + 2) * WLS + k] = v.z; wl[(4 * q + 3) * WLS + k] = v.w; }
}

__device__ __forceinline__ void p0_rows(const Args& a, LAS unsigned char* lds, int gw, int NGW, int tid, int lane) {
    const float* x = a.in[I_X]; const float* meta = a.in[I_META]; const float* nw = a.in[I_MIXNW]; const float* win = a.in[I_WIN];
    LAS float* wl = (LAS float*)lds;
    stage_w16(wl, win, NPROJ_SRC, 4096, tid);
    __syncthreads();
    bf16_t* HN = (bf16_t*)(a.ws + WS_HN); float* BETA = (float*)(a.ws + WS_BETA); float* GG = (float*)(a.ws + WS_G);
    f32x4 wn[8];
#pragma unroll
    for (int j = 0; j < 8; ++j) wn[j] = *((const f32x4*)nw + lane + 64 * j);
    const int hh = lane & 7;
    const float alog = a.in[I_ALOG][hh], dtb = a.in[I_DTB][hh];
    constexpr int NR0 = 2;
    for (int row0 = gw; row0 < MPAD; row0 += NR0 * NGW) {
        f32x4 v[NR0][8]; float bv[NR0], av[NR0];
        int lane_o = lane; asm volatile("" : "+v"(lane_o));
#pragma unroll
        for (int k = 0; k < NR0; ++k) { const int row = row0 + k * NGW;
            if (row < NTOK) { const int b = row / LSEQ, t = row - b * LSEQ;
                const float* src = (t < NMETA) ? meta + (size_t)t * DM : x + ((size_t)b * SEQ + (t - NMETA)) * DM;
#pragma unroll
                for (int j = 0; j < 8; ++j) v[k][j] = *((const f32x4*)src + lane + 64 * j);
            } else {
#pragma unroll
                for (int j = 0; j < 8; ++j) v[k][j] = (f32x4){0.f, 0.f, 0.f, 0.f}; } }
#pragma unroll
        for (int k = 0; k < NR0; ++k) { const int row = row0 + k * NGW; float ss = 0.f;
#pragma unroll
            for (int j = 0; j < 8; ++j) ss += (v[k][j].x * v[k][j].x + v[k][j].y * v[k][j].y) + (v[k][j].z * v[k][j].z + v[k][j].w * v[k][j].w);
            const float rstd = 1.0f / sqrtf(wave_sum(ss) * (1.0f / DM) + NORM_EPS);
            if (row < MPAD) { GAS unsigned long long* o8 = (GAS unsigned long long*)(HN + (size_t)row * DM) + lane;
#pragma unroll
                for (int j = 0; j < 8; ++j) { v[k][j] = v[k][j] * rstd * wn[j];
                    o8[64 * j] = (unsigned long long)cvt_pk_bf16(v[k][j].x, v[k][j].y) | ((unsigned long long)cvt_pk_bf16(v[k][j].z, v[k][j].w) << 32); } } }
        { float o8[NR0][8]; dot8xN<NR0>(v, wl, lane_o, o8);
#pragma unroll
            for (int k = 0; k < NR0; ++k) { bv[k] = o8[k][0];
#pragma unroll
                for (int c = 1; c < 8; ++c) bv[k] = (hh == c) ? o8[k][c] : bv[k]; }
            dot8xN<NR0>(v, wl + 8 * WLS, lane_o, o8);
#pragma unroll
            for (int k = 0; k < NR0; ++k) { av[k] = o8[k][0];
#pragma unroll
                for (int c = 1; c < 8; ++c) av[k] = (hh == c) ? o8[k][c] : av[k]; } }
#pragma unroll
        for (int k = 0; k < NR0; ++k) { const int row = row0 + k * NGW;
            if (lane < 8 && row < NTOK) {
                const float beta = 1.0f / (1.0f + expf(-bv[k]));
                const float xa = av[k] + dtb; const float sp = fmaxf(xa, 0.f) + log1pf(expf(-fabsf(xa)));
                BETA[(size_t)row * 8 + hh] = beta; GG[(size_t)row * 8 + hh] = -expf(alog) * sp; } }
    }
    __syncthreads();
}

constexpr int CVT_STR = 132;
template <int MODE  >
__device__ __forceinline__ void cvt_tile(const float* W, int ldw, int K, bf16_t* out, int kb, int nt, LAS unsigned char* T, int lane) {
    const int r0 = nt * 64;
    int c0;
    if (MODE == 0) c0 = r0;
    else if (MODE == 1) c0 = r0 < 4096 ? r0 : r0 + 16;
    else { const int pn = r0 >> 8, rr = r0 & 255; c0 = rr < 128 ? 128 * pn + rr : 2048 + 128 * pn + (rr - 128); }
    const int kq = lane >> 4, nl = lane & 15;
    const float* src = W + (size_t)(kb * 64 + 2 * kq) * ldw + c0 + 4 * nl;
    f32x4 v[8][2];
#pragma unroll
    for (int i = 0; i < 8; ++i)
#pragma unroll
        for (int j = 0; j < 2; ++j) v[i][j] = *(const f32x4*)(src + (size_t)(8 * i + j) * ldw);
    LAS unsigned char* tw = T + (4 * nl) * CVT_STR + 4 * kq;
#pragma unroll
    for (int i = 0; i < 8; ++i)
#pragma unroll
        for (int q = 0; q < 4; ++q) *(LAS unsigned*)(tw + q * CVT_STR + 16 * i) = cvt_pk_bf16(v[i][0][q], v[i][1][q]);
    LDS_WAIT();
    const int rn = lane >> 3, cc = lane & 7;
    const LAS unsigned char* tr = T + rn * CVT_STR + 16 * cc;
    bf16_t* dst = out + (size_t)(r0 + rn) * K + kb * 64 + 8 * cc;
#pragma unroll
    for (int j = 0; j < 8; ++j) { u32x4 w; const LAS unsigned* p = (const LAS unsigned*)(tr + 8 * j * CVT_STR); w.x = p[0]; w.y = p[1]; w.z = p[2]; w.w = p[3];
        *(u32x4*)(dst + (size_t)(8 * j) * K) = w; }
    LDS_WAIT();
}
constexpr float W8_SCALE = 64.0f;
template <int MODE>
__device__ __forceinline__ void cvt_tile_fp8(const float* W, int ldw, int K, unsigned char* out, int kb, int nt, LAS unsigned char* T, int lane) {
    const int r0 = nt * 64;
    int c0;
    if (MODE == 0) c0 = r0;
    else { const int pn = r0 >> 8, rr = r0 & 255; c0 = rr < 128 ? 128 * pn + rr : 2048 + 128 * pn + (rr - 128); }
    const int kq = lane >> 4, nl = lane & 15;
    LAS unsigned char* tw = T + (4 * nl) * CVT_STR + 4 * kq;
    const float* src = W + (size_t)(kb * 128 + 4 * kq) * ldw + c0 + 4 * nl;
    f32x4 v[8][4];
#pragma unroll
    for (int i = 0; i < 8; ++i)
#pragma unroll
        for (int j = 0; j < 4; ++j) v[i][j] = *(const f32x4*)(src + (size_t)(16 * i + j) * ldw);
#pragma unroll
    for (int i = 0; i < 8; ++i)
#pragma unroll
        for (int q = 0; q < 4; ++q) *(LAS unsigned*)(tw + q * CVT_STR + 16 * i) =
            pk4_fp8(v[i][0][q] * W8_SCALE, v[i][1][q] * W8_SCALE, v[i][2][q] * W8_SCALE, v[i][3][q] * W8_SCALE);
    LDS_WAIT();
    const int rn = lane >> 3, cc = lane & 7;
    const LAS unsigned char* tr = T + rn * CVT_STR + 16 * cc;
    unsigned char* dst = out + (size_t)(r0 + rn) * K + kb * 128 + 16 * cc;
#pragma unroll
    for (int j = 0; j < 8; ++j) { u32x4 w; const LAS unsigned* p = (const LAS unsigned*)(tr + 8 * j * CVT_STR); w.x = p[0]; w.y = p[1]; w.z = p[2]; w.w = p[3];
        *(u32x4*)(dst + (size_t)(8 * j) * K) = w; }
    LDS_WAIT();
}
__device__ __forceinline__ void p0_weights(const Args& a, LAS unsigned char* lds, int vcu, int G, int wave, int lane) {
    constexpr int I_IN = 32 * 14, I_OUT = 32 * 4;
    constexpr int NITEMS = I_IN + I_OUT;
    LAS unsigned char* T = lds + wave * (64 * CVT_STR);
    for (int it = vcu; it < NITEMS; it += G) {
        int r = it;
        if (r < I_IN) { cvt_tile<1>(a.in[I_WIN], NPROJ_SRC, DM, (bf16_t*)(a.ws + WS_WIN), r / 14, (r % 14) * 8 + wave, T, lane); continue; } r -= I_IN;
        cvt_tile<0>(a.in[I_WOUT], DM, DM, (bf16_t*)(a.ws + WS_WOUT), r / 4, (r % 4) * 8 + wave, T, lane);
    }
}
constexpr int MOE_I_GU = 8 * 4, MOE_I_D = 4 * 4, MOE_ITEMS = NEXP * (MOE_I_GU + MOE_I_D);
__device__ __forceinline__ void moe_weights_queue(const Args& a, LAS unsigned char* lds, LAS int* qslot, int tid, int wave, int lane, int limit) {
    unsigned* ctr = (unsigned*)(a.ws + WS_CTL) + CW_CVTQ;
    LAS unsigned char* T = lds + wave * (64 * CVT_STR);
    for (;;) {
        __syncthreads();
        if (tid == 0) { int v = (int)__hip_atomic_load(ctr, __ATOMIC_RELAXED, __HIP_MEMORY_SCOPE_AGENT); v = (v < limit) ? (int)atomicAdd(ctr, 1u) : MOE_ITEMS; *qslot = v; }
        __syncthreads();
        const int it = *(volatile LAS int*)qslot;
        if (it >= MOE_ITEMS) break;
        if (it < NEXP * MOE_I_GU) { const int e = it / MOE_I_GU, q = it % MOE_I_GU, ng = q >> 2, kq = q & 3;
#pragma unroll 1
            for (int kb = kq * 4; kb < kq * 4 + 4; ++kb)
                cvt_tile_fp8<2>(a.in[I_WGU] + (size_t)e * DM * 2 * DE, 2 * DE, DM, a.ws + WS_WGU + (size_t)e * 2 * DE * DM, kb, ng * 8 + wave, T, lane);
        } else { const int r = it - NEXP * MOE_I_GU, e = r / MOE_I_D, q = r % MOE_I_D, ng = q >> 2, kq = q & 3;
#pragma unroll 1
            for (int kb = kq * 4; kb < kq * 4 + 4; ++kb)
                cvt_tile_fp8<0>(a.in[I_WD] + (size_t)e * DE * DM, DM, DE, a.ws + WS_WD + (size_t)e * DM * DE, kb, ng * 8 + wave, T, lane);
        }
    }
}

__device__ __forceinline__ void p2_qknorm(const Args& a, int gw, int NGW, int lane) {
    const bf16_t* P = (const bf16_t*)(a.ws + WS_P); bf16_t* QN = (bf16_t*)(a.ws + WS_QN); bf16_t* KN = (bf16_t*)(a.ws + WS_KN);
    const float qw0 = a.in[I_SBQNW][2 * lane], qw1 = a.in[I_SBQNW][2 * lane + 1], kw0 = a.in[I_SBKNW][2 * lane], kw1 = a.in[I_SBKNW][2 * lane + 1];
    const float QS = 0.08838834764831845f * 1.4426950408889634f;
    for (int it = gw; it < NTOK * NHEAD * 2; it += NGW) {
        const int which = it & 1, h = (it >> 1) & 7, row = it >> 4;
        const int b = row / LSEQ, t = row - b * LSEQ;
        const unsigned w = *(const unsigned*)(P + (size_t)row * NPROJ + (which ? PC_SBK : PC_SBQ) + h * HD + 2 * lane);
        const float v0 = bf_lo(w), v1 = bf_hi(w);
        const float rstd = 1.0f / sqrtf(wave_sum(v0 * v0 + v1 * v1) * (1.0f / HD) + NORM_EPS);
        const float o0 = which ? v0 * rstd * kw0 : v0 * rstd * qw0 * QS, o1 = which ? v1 * rstd * kw1 : v1 * rstd * qw1 * QS;
        *(unsigned*)((which ? KN : QN) + ((size_t)(b * NHEAD + h) * LROW + t) * HD + 2 * lane) = cvt_pk_bf16(o0, o1);
    }
}

__device__ __forceinline__ void p3_gdn_naive(const Args& a, LAS unsigned char* lds, int item, int tid, int lane, int wave) {
    const int b = item >> 3, h = item & 7;
    const bf16_t* P = (const bf16_t*)(a.ws + WS_P); const float* BETA = (const float*)(a.ws + WS_BETA); const float* GG = (const float*)(a.ws + WS_G);
    float* ORAW = (float*)(a.ws + WS_ORAW); bf16_t* MIX = (bf16_t*)(a.ws + WS_MIX);
    LAS float* buf = (LAS float*)lds;
    const int j = tid >> 2, part = tid & 3;
    const int which = tid >> 7, d = tid & 127; const bool conv = tid < 384;
    const int pcol = which * 1024 + h * HD + d;
    float cw0 = 0, cw1 = 0, cw2 = 0, cw3 = 0;
    if (conv) { const float* cwp = a.in[I_CONVW] + pcol; cw0 = cwp[0]; cw1 = cwp[3072]; cw2 = cwp[2 * 3072]; cw3 = cwp[3 * 3072]; }
    float xm1 = 0.f, xm2 = 0.f, xm3 = 0.f;
    float S[32];
#pragma unroll
    for (int i = 0; i < 32; ++i) S[i] = 0.f;
    const size_t row0 = (size_t)b * LSEQ;
    float xnext = conv ? bf2f(P[row0 * NPROJ + pcol]) : 0.f;
    float bnext = BETA[row0 * 8 + h], gnext = GG[row0 * 8 + h];
    for (int t = 0; t < LSEQ; ++t) {
        const float xt = xnext, beta = bnext, gam = expf(gnext);
        if (t + 1 < LSEQ) { if (conv) xnext = bf2f(P[(row0 + t + 1) * NPROJ + pcol]); bnext = BETA[(row0 + t + 1) * 8 + h]; gnext = GG[(row0 + t + 1) * 8 + h]; }
        LAS float* cb = buf + (t & 1) * 384;
        if (conv) { const float y = cw3 * xt + cw2 * xm1 + cw1 * xm2 + cw0 * xm3; xm3 = xm2; xm2 = xm1; xm1 = xt; cb[tid] = y / (1.0f + expf(-y)); }
        __syncthreads();
        float kk = 0.f, qq = 0.f, dk = 0.f; f32x4 kv[8], qv[8];
#pragma unroll
        for (int i = 0; i < 8; ++i) { kv[i] = *(const LAS f32x4*)(cb + 128 + 32 * part + 4 * i); qv[i] = *(const LAS f32x4*)(cb + 32 * part + 4 * i); }
#pragma unroll
        for (int i = 0; i < 8; ++i)
#pragma unroll
            for (int c = 0; c < 4; ++c) { kk += kv[i][c] * kv[i][c]; qq += qv[i][c] * qv[i][c]; dk += S[4 * i + c] * kv[i][c]; }
        kk += __shfl_xor(kk, 1); kk += __shfl_xor(kk, 2); qq += __shfl_xor(qq, 1); qq += __shfl_xor(qq, 2); dk += __shfl_xor(dk, 1); dk += __shfl_xor(dk, 2);
        const float rk = 1.0f / sqrtf(kk + NORM_EPS), rq = 0.08838834764831845f / sqrtf(qq + NORM_EPS);
        const float vj = cb[256 + j];
        const float vnew = beta * (vj - gam * rk * dk);
        const float kvn = rk * vnew; float oq = 0.f;
#pragma unroll
        for (int i = 0; i < 8; ++i)
#pragma unroll
            for (int c = 0; c < 4; ++c) { S[4 * i + c] = gam * S[4 * i + c] + kv[i][c] * kvn; oq += S[4 * i + c] * qv[i][c]; }
        oq += __shfl_xor(oq, 1); oq += __shfl_xor(oq, 2);
        if (t >= NMETA && part == 0) ORAW[((size_t)b * SEQ + (t - NMETA)) * 1024 + h * HD + j] = rq * oq;
    }
    __threadfence(); __syncthreads();
    const float nw0 = a.in[I_GDNNW][2 * lane], nw1 = a.in[I_GDNNW][2 * lane + 1];
    for (int s = wave; s < SEQ; s += NWAVES) {
        const size_t tok = (size_t)b * SEQ + s;
        const f32x2 o = *(const f32x2*)(ORAW + tok * 1024 + h * HD + 2 * lane);
        const float rstd = 1.0f / sqrtf(wave_sum(o.x * o.x + o.y * o.y) * (1.0f / HD) + NORM_EPS);
        const unsigned zw = *(const unsigned*)(P + (row0 + NMETA + s) * NPROJ + PC_Z + h * HD + 2 * lane);
        const float z0 = bf_lo(zw), z1 = bf_hi(zw);
        const float r0 = o.x * rstd * nw0 * (z0 / (1.0f + expf(-z0))), r1 = o.y * rstd * nw1 * (z1 / (1.0f + expf(-z1)));
        *(unsigned*)(MIX + tok * DM + h * HD + 2 * lane) = cvt_pk_bf16(r0, r1);
    }
}

__device__ __forceinline__ bf16x8 sba_pack8(const f32x16& p, int base) {
    u32x4 w; w.x = cvt_pk_bf16(p[base + 0], p[base + 1]); w.y = cvt_pk_bf16(p[base + 2], p[base + 3]); w.z = cvt_pk_bf16(p[base + 4], p[base + 5]); w.w = cvt_pk_bf16(p[base + 6], p[base + 7]);
    return __builtin_bit_cast(bf16x8, w);
}

namespace gdn {
constexpr int NCH = 65;
constexpr int IMG_W = 0, IMG_QG = 16384, IMG_KDT = 32768, IMG_AT = 49152, IMG_BYTES = 57344, IMG_U = 57344, CH_BYTES = 73728;
constexpr int L_QB = 0, L_KB = 17408, L_VB = 34816, L_LT = 52224, L_GC = 69632, L_BE = 69888, L_IMG = 70144;
__device__ __forceinline__ int afrag_off(int row, int k, int nks) {
    const int rt = row >> 5, rr = row & 31, ks = k >> 4, kk = k & 15, hi = (kk >> 2) & 1, sl = (kk & 3) + 4 * (kk >> 3);
    return ((rt * nks + ks) * 64 + rr + 32 * hi) * 16 + sl * 2;
}
__device__ __forceinline__ int ufrag_off(int i, int c) {
    const int cg = c >> 5, col = c & 31, rt = i >> 5, ii = i & 31, hi = (ii >> 2) & 1, r = (ii & 3) + 4 * (ii >> 3);
    return (((cg * 2 + rt) * 2 + (r >> 3)) * 64 + col + 32 * hi) * 8 + (r & 7);
}
__device__ __forceinline__ int crow(int r, int hi) { return (r & 3) + 8 * (r >> 2) + 4 * hi; }
__device__ __forceinline__ bf16_t f2bf(float f) { return (bf16_t)(cvt_pk_bf16(f, 0.f) & 0xffffu); }

__device__ __forceinline__ void precompute(const Args& a, LAS unsigned char* lds, int item, int tid, int lane, int wave) {
    asm volatile("" : "+v"(tid), "+v"(lane), "+s"(wave));
    const int bh = item / NCH, c = item - bh * NCH, b = bh >> 3, h = bh & 7;
    const bf16_t* P = (const bf16_t*)(a.ws + WS_P) + (size_t)b * LSEQ * NPROJ;
    const float* BETA = (const float*)(a.ws + WS_BETA) + (size_t)b * LSEQ * 8; const float* GG = (const float*)(a.ws + WS_G) + (size_t)b * LSEQ * 8;
    unsigned char* dst = a.ws + WS_GCH + (size_t)item * CH_BYTES;
    LAS float* GC = (LAS float*)(lds + L_GC); LAS float* BE = (LAS float*)(lds + L_BE); LAS float* LT = (LAS float*)(lds + L_LT);
    const int tbase = 64 * c - 48;
    if (wave == 0) {
        const int t = tbase + lane; float g = 0.f, be = 0.f;
        if (t >= 0) { g = GG[(size_t)t * 8 + h]; be = BETA[(size_t)t * 8 + h]; }
#pragma unroll
        for (int o = 1; o < 64; o <<= 1) { const float y = __shfl_up(g, o); if (lane >= o) g += y; }
        GC[lane] = g; BE[lane] = be;
        if (lane == 63) ((float*)(a.ws + WS_GL))[item] = expf(g);
    }
    {
        f32x2 cw[3][4];
#pragma unroll
        for (int w3 = 0; w3 < 3; ++w3)
#pragma unroll
            for (int tap = 0; tap < 4; ++tap) cw[w3][tap] = *(const f32x2*)(a.in[I_CONVW] + tap * 3072 + w3 * 1024 + h * HD + 2 * lane);
        f32x2 xw[3][11];
#pragma unroll
        for (int j = 0; j < 11; ++j) { const int t = tbase + 8 * wave - 3 + j;
#pragma unroll
            for (int w3 = 0; w3 < 3; ++w3) { unsigned u = 0u; if (t >= 0) u = *(const unsigned*)(P + (size_t)t * NPROJ + w3 * 1024 + h * HD + 2 * lane); xw[w3][j] = (f32x2){bf_lo(u), bf_hi(u)}; } }
#pragma unroll
        for (int rr = 0; rr < 8; ++rr) { const int i = 8 * wave + rr; f32x2 y[3];
#pragma unroll
            for (int w3 = 0; w3 < 3; ++w3) { f32x2 acc = cw[w3][0] * xw[w3][rr] + cw[w3][1] * xw[w3][rr + 1] + cw[w3][2] * xw[w3][rr + 2] + cw[w3][3] * xw[w3][rr + 3];
                acc.x = acc.x / (1.0f + __expf(-acc.x)); acc.y = acc.y / (1.0f + __expf(-acc.y)); y[w3] = acc; }
            const float rq = 0.08838834764831845f / sqrtf(wave_sum(y[0].x * y[0].x + y[0].y * y[0].y) + NORM_EPS);
            const float rk = 1.0f / sqrtf(wave_sum(y[1].x * y[1].x + y[1].y * y[1].y) + NORM_EPS);
            *(LAS unsigned*)(lds + L_QB + i * 272 + 4 * lane) = cvt_pk_bf16(y[0].x * rq, y[0].y * rq);
            *(LAS unsigned*)(lds + L_KB + i * 272 + 4 * lane) = cvt_pk_bf16(y[1].x * rk, y[1].y * rk);
            *(LAS unsigned*)(lds + L_VB + i * 272 + 4 * lane) = cvt_pk_bf16(y[2].x, y[2].y); }
    }
    __syncthreads();
    {
        const int prod = wave >> 2, ti = (wave >> 1) & 1, tj = wave & 1, r32 = lane & 31, hi = lane >> 5;
        if (tj <= ti) {
            f32x16 acc;
#pragma unroll
            for (int r = 0; r < 16; ++r) acc[r] = 0.f;
            const LAS unsigned char* Ab = lds + (prod ? L_QB : L_KB) + (32 * ti + r32) * 272 + hi * 16;
            const LAS unsigned char* Bb = lds + L_KB + (32 * tj + r32) * 272 + hi * 16;
#pragma unroll
            for (int ks = 0; ks < 8; ++ks) acc = __builtin_amdgcn_mfma_f32_32x32x16_bf16(*(const LAS bf16x8*)(Ab + ks * 32), *(const LAS bf16x8*)(Bb + ks * 32), acc, 0, 0, 0);
            const int j = 32 * tj + r32; const float gj = GC[j];
#pragma unroll
            for (int r = 0; r < 16; ++r) { const int i = 32 * ti + crow(r, hi); const float dec = __expf(GC[i] - gj);
                if (prod == 0) LT[j * 68 + i] = (j < i) ? acc[r] * BE[i] * dec : 0.f;
                else *(LAS bf16_t*)(lds + L_IMG + IMG_AT + afrag_off(i, j, 4)) = f2bf((j <= i) ? acc[r] * dec : 0.f); }
        }
    }
    __syncthreads();
    if (tid < 256) {
        float x[64];
        const bool isv = tid < 128; const int cc = tid & 127;
        const LAS unsigned char* src = lds + (isv ? L_VB : L_KB) + cc * 2;
#pragma unroll
        for (int i8 = 0; i8 < 64; i8 += 8) {
#pragma unroll
            for (int q = 0; q < 8; ++q) { const int i = i8 + q; const float v = bf2f(*(const LAS bf16_t*)(src + i * 272)); x[i] = v * BE[i] * (isv ? 1.0f : __expf(GC[i])); }
            asm volatile("" ::: "memory"); }
#pragma unroll
        for (int j = 0; j < 63; ++j) {
#pragma unroll
            for (int i4 = ((j + 1) & ~3); i4 < 64; i4 += 4) { const f32x4 l4 = *(const LAS f32x4*)(LT + j * 68 + i4);
#pragma unroll
                for (int q = 0; q < 4; ++q) if (i4 + q > j) x[i4 + q] -= l4[q] * x[j]; }
            asm volatile("" ::: "memory");
        }
        if (isv) {
            LAS unsigned char* ub = lds + L_IMG + IMG_U + (((cc >> 5) * 4 * 64) + (cc & 31)) * 16;
#pragma unroll
            for (int i = 0; i < 64; ++i) { const int rt = i >> 5, ii = i & 31, hi = (ii >> 2) & 1, r = (ii & 3) + 4 * (ii >> 3);
                *(LAS bf16_t*)(ub + (((rt * 2 + (r >> 3)) * 64 + 32 * hi) * 8 + (r & 7)) * 2) = f2bf(x[i]); }
        } else {
            const int ks = cc >> 4, kk = cc & 15, hi = (kk >> 2) & 1, sl = (kk & 3) + 4 * (kk >> 3);
            LAS unsigned char* wb = lds + L_IMG + IMG_W + (ks * 64 + 32 * hi) * 16 + sl * 2;
#pragma unroll
            for (int i = 0; i < 64; ++i) *(LAS bf16_t*)(wb + ((i >> 5) * 8 * 64 + (i & 31)) * 16) = f2bf(-x[i]);
        }
    } else {
        const int u = tid - 256, dk = u & 127, i0 = (u >> 7) * 32; const float gl = GC[63];
#pragma unroll 4
        for (int ii = 0; ii < 32; ++ii) { const int i = i0 + ii; const float gi = GC[i];
            const float q = bf2f(*(const LAS bf16_t*)(lds + L_QB + i * 272 + dk * 2)), k = bf2f(*(const LAS bf16_t*)(lds + L_KB + i * 272 + dk * 2));
            *(LAS bf16_t*)(lds + L_IMG + IMG_QG + afrag_off(i, dk, 8)) = f2bf(q * __expf(gi));
            *(LAS bf16_t*)(lds + L_IMG + IMG_KDT + afrag_off(dk, i, 4)) = f2bf(k * __expf(gl - gi)); }
    }
    __syncthreads();
    for (int q = tid; q < CH_BYTES / 16; q += NTHREADS) *(u32x4*)(dst + (size_t)q * 16) = *(const LAS u32x4*)(lds + L_IMG + q * 16);
}

constexpr int OB_OFF = 2 * IMG_BYTES, OB_STR = 272, OB_BYTES = 64 * OB_STR;
__device__ __forceinline__ void gated_load_z(const Args& a, u32x4 (&zw)[4], int b, int h, int cc, int w4, int lane) {
    const bf16_t* P = (const bf16_t*)(a.ws + WS_P);
    const int s = 64 * (cc - 1) + 16 * w4 + (lane >> 2);
    const u32x4* zp = (const u32x4*)(P + ((size_t)b * LSEQ + NMETA + s) * NPROJ + PC_Z + h * HD + 32 * (lane & 3));
#pragma unroll
    for (int q = 0; q < 4; ++q) zw[q] = zp[q];
}
__device__ __forceinline__ float silu_f(float z) { return z * __builtin_amdgcn_rcpf(1.0f + __expf(-z)); }
__device__ __forceinline__ void gated_rows(const Args& a, const LAS unsigned char* ob, const u32x4 (&zw)[4], int b, int h, int cc, int w4, int lane, const f32x4 (&nwv)[8]) {
    bf16_t* MIX = (bf16_t*)(a.ws + WS_MIX);
    const int row = lane >> 2, qd = lane & 3, s = 64 * (cc - 1) + 16 * w4 + row;
    u32x4 ov[4]; float ss = 0.f;
#pragma unroll
    for (int q = 0; q < 4; ++q) { ov[q] = *(const LAS u32x4*)(ob + (16 * w4 + row) * OB_STR + qd * 64 + q * 16);
#pragma unroll
        for (int e = 0; e < 4; ++e) { const float lo = bf_lo(ov[q][e]), hi = bf_hi(ov[q][e]); ss += lo * lo + hi * hi; } }
    ss = quad_sum(ss);
    const float rstd = __builtin_amdgcn_rsqf(ss * (1.0f / HD) + NORM_EPS);
    u32x4* dst = (u32x4*)(MIX + ((size_t)b * SEQ + s) * DM + h * HD + 32 * qd);
#pragma unroll
    for (int q = 0; q < 4; ++q) { u32x4 w;
#pragma unroll
        for (int e = 0; e < 4; ++e) { const f32x4 nv = nwv[2 * q + (e >> 1)];
            const float n0 = (e & 1) ? nv.z : nv.x, n1 = (e & 1) ? nv.w : nv.y;
            w[e] = cvt_pk_bf16(bf_lo(ov[q][e]) * rstd * n0 * silu_f(bf_lo(zw[q][e])), bf_hi(ov[q][e]) * rstd * n1 * silu_f(bf_hi(zw[q][e]))); }
        dst[q] = w; }
}

__device__ __forceinline__ void scan(const Args& a, LAS unsigned char* lds, int bh, int tid, int lane, int wave) {
    const int b = bh >> 3, h = bh & 7, col = lane & 31, hi = lane >> 5, cg = wave;
    const unsigned char* src = a.ws + WS_GCH + (size_t)bh * NCH * CH_BYTES;
    const float* GL = (const float*)(a.ws + WS_GL) + bh * NCH;
    __syncthreads();
    const unsigned dvoff = (unsigned)(wave * 1024 + lane * 16), uvoff = (unsigned)(lane * 16);
#define GDN_DMA(ch, buf) do { const unsigned char* _sp = src + (size_t)(ch) * CH_BYTES; _Pragma("unroll") for (int _f = 0; _f < 7; ++_f) { \
        __builtin_amdgcn_global_load_lds((const unsigned*)(_sp + _f * 8192 + dvoff), (LAS unsigned*)(lds + (buf) * IMG_BYTES + wave * 1024 + _f * 8192), 16, 0, 0); } } while (0)
    GDN_DMA(0, 0);
#define GDN_STEP_END(vm) do { asm volatile("s_waitcnt vmcnt(" #vm ")" ::: "memory"); asm volatile("s_waitcnt lgkmcnt(0)" ::: "memory"); __builtin_amdgcn_s_barrier(); asm volatile("" ::: "memory"); } while (0)
    if (wave < 4) {
        f32x16 st[4]; bf16x8 Sb[8]; u32x4 ureg[4]; float gl;
#pragma unroll
        for (int t4 = 0; t4 < 4; ++t4)
#pragma unroll
            for (int r = 0; r < 16; ++r) st[t4][r] = 0.f;
#pragma unroll
        for (int ks = 0; ks < 8; ++ks) Sb[ks] = (bf16x8){0, 0, 0, 0, 0, 0, 0, 0};
#pragma unroll
        for (int q = 0; q < 4; ++q) ureg[q] = *(const u32x4*)(src + IMG_U + cg * 4096 + q * 1024 + uvoff);
        gl = GL[0];
        GDN_STEP_END(0);
        for (int c = 0; c < NCH; ++c) {
            const LAS unsigned char* img = lds + (c & 1) * IMG_BYTES + lane * 16;
            asm volatile("" : "+v"(ureg[0]), "+v"(ureg[1]), "+v"(ureg[2]), "+v"(ureg[3]), "+v"(gl));
            if (c + 1 < NCH) GDN_DMA(c + 1, (c + 1) & 1);
            f32x16 vn[2]; const float glc = gl;
#pragma unroll
            for (int rt = 0; rt < 2; ++rt)
#pragma unroll
                for (int rh = 0; rh < 2; ++rh) { const u32x4 w = ureg[rt * 2 + rh];
                    vn[rt][8 * rh + 0] = bf_lo(w.x); vn[rt][8 * rh + 1] = bf_hi(w.x); vn[rt][8 * rh + 2] = bf_lo(w.y); vn[rt][8 * rh + 3] = bf_hi(w.y);
                    vn[rt][8 * rh + 4] = bf_lo(w.z); vn[rt][8 * rh + 5] = bf_hi(w.z); vn[rt][8 * rh + 6] = bf_lo(w.w); vn[rt][8 * rh + 7] = bf_hi(w.w); }
            asm volatile("" ::: "memory");
            if (c + 1 < NCH) {
#pragma unroll
                for (int q = 0; q < 4; ++q) ureg[q] = *(const u32x4*)(src + (size_t)(c + 1) * CH_BYTES + IMG_U + cg * 4096 + q * 1024 + uvoff);
                gl = GL[c + 1]; }
#pragma unroll
            for (int rt = 0; rt < 2; ++rt) { __builtin_amdgcn_sched_barrier(0);
#pragma unroll
                for (int ks = 0; ks < 8; ++ks) vn[rt] = __builtin_amdgcn_mfma_f32_32x32x16_bf16(*(const LAS bf16x8*)(img + IMG_W + (rt * 8 + ks) * 1024), Sb[ks], vn[rt], 0, 0, 0); }
            __builtin_amdgcn_sched_barrier(0);
            bf16x8 vb[4];
#pragma unroll
            for (int ks = 0; ks < 4; ++ks) vb[ks] = sba_pack8(vn[ks >> 1], 8 * (ks & 1));
            LAS unsigned char* obw = lds + OB_OFF + (c & 1) * OB_BYTES + (32 * cg + col) * 2;
#pragma unroll
            for (int rt = 0; rt < 2; ++rt) { f32x16 o; __builtin_amdgcn_sched_barrier(0);
#pragma unroll
                for (int r = 0; r < 16; ++r) o[r] = 0.f;
#pragma unroll
                for (int ks = 0; ks < 8; ++ks) o = __builtin_amdgcn_mfma_f32_32x32x16_bf16(*(const LAS bf16x8*)(img + IMG_QG + (rt * 8 + ks) * 1024), Sb[ks], o, 0, 0, 0);
#pragma unroll
                for (int ks = 0; ks < 2 * (rt + 1); ++ks) o = __builtin_amdgcn_mfma_f32_32x32x16_bf16(*(const LAS bf16x8*)(img + IMG_AT + (rt * 4 + ks) * 1024), vb[ks], o, 0, 0, 0);
                if (c >= 1) {
#pragma unroll
                    for (int r = 0; r < 16; ++r) *(LAS bf16_t*)(obw + (32 * rt + crow(r, hi)) * OB_STR) = f2bf(o[r]); }
            }
#pragma unroll
            for (int t4 = 0; t4 < 4; ++t4) { __builtin_amdgcn_sched_barrier(0);
#pragma unroll
                for (int r = 0; r < 16; ++r) st[t4][r] *= glc;
#pragma unroll
                for (int ks = 0; ks < 4; ++ks) st[t4] = __builtin_amdgcn_mfma_f32_32x32x16_bf16(*(const LAS bf16x8*)(img + IMG_KDT + (t4 * 4 + ks) * 1024), vb[ks], st[t4], 0, 0, 0);
                Sb[2 * t4] = sba_pack8(st[t4], 0); Sb[2 * t4 + 1] = sba_pack8(st[t4], 8); }
            if (c + 1 < NCH) GDN_STEP_END(5); else GDN_STEP_END(0);
        }
    } else {
        u32x4 zA[4], zB[4]; f32x4 nwv[8];
#pragma unroll
        for (int q = 0; q < 4; ++q) { zA[q] = (u32x4){0u, 0u, 0u, 0u}; zB[q] = (u32x4){0u, 0u, 0u, 0u}; }
#pragma unroll
        for (int q = 0; q < 8; ++q) nwv[q] = *(const f32x4*)(a.in[I_GDNNW] + 32 * (lane & 3) + 4 * q);
        GDN_STEP_END(0);
        for (int c = 0; c < NCH; ++c) {
#pragma unroll
            for (int q = 0; q < 4; ++q) asm volatile("" : "+v"(zA[q]), "+v"(zB[q]));
            if (c + 1 < NCH) GDN_DMA(c + 1, (c + 1) & 1);
            if (c >= 1) { if (c & 1) gated_load_z(a, zA, b, h, c, wave - 4, lane); else gated_load_z(a, zB, b, h, c, wave - 4, lane); }
            asm volatile("" ::: "memory");
            if (c >= 2) { if (c & 1) gated_rows(a, lds + OB_OFF + ((c - 1) & 1) * OB_BYTES, zB, b, h, c - 1, wave - 4, lane, nwv);
                          else gated_rows(a, lds + OB_OFF + ((c - 1) & 1) * OB_BYTES, zA, b, h, c - 1, wave - 4, lane, nwv); }
            if (c >= 2) GDN_STEP_END(4); else GDN_STEP_END(0);
        }
        gated_rows(a, lds + OB_OFF + ((NCH - 1) & 1) * OB_BYTES, zB, b, h, NCH - 1, wave - 4, lane, nwv);
    }
#undef GDN_STEP_END
#undef GDN_DMA
}
}

namespace sba {
#define KSWZ(row, colB) ((row) * 256 + ((colB) ^ (((row) & 7) << 4)))
__device__ __forceinline__ int v_st(int k, int c) { const int kk = (k & ~0xC) | ((k & 4) << 1) | ((k & 8) >> 1); return ((kk >> 3) * 4 + (c >> 5)) * 512 + ((kk & 7) * 32 + (c & 31)) * 2; }
__device__ __forceinline__ int v_rd_base(int lane) { return ((lane & 3) << 3) | (((lane >> 2) & 3) << 6) | (((lane >> 4) & 1) << 5) | (((lane >> 5) & 1) << 8); }
constexpr int v_rd_off(int d0, int ks, int half) { return d0 * 512 + ks * 4096 + half * 2048; }
template <int OFF> __device__ __forceinline__ s16x4 tr_read(int vb) { s16x4 r; asm volatile("ds_read_b64_tr_b16 %0, %1 offset:%2" : "=&v"(r) : "v"(vb), "i"(OFF) : "memory"); return r; }
template <int D0> __device__ __forceinline__ void pv_one(f32x16& od, int vb, bf16x8 pa0, bf16x8 pa1, bf16x8 pa2, bf16x8 pa3) {
    const s16x4 l0 = tr_read<v_rd_off(D0, 0, 0)>(vb), h0 = tr_read<v_rd_off(D0, 0, 1)>(vb), l1 = tr_read<v_rd_off(D0, 1, 0)>(vb), h1 = tr_read<v_rd_off(D0, 1, 1)>(vb);
    const s16x4 l2 = tr_read<v_rd_off(D0, 2, 0)>(vb), h2 = tr_read<v_rd_off(D0, 2, 1)>(vb), l3 = tr_read<v_rd_off(D0, 3, 0)>(vb), h3 = tr_read<v_rd_off(D0, 3, 1)>(vb);
    asm volatile("s_waitcnt lgkmcnt(0)" ::: "memory"); __builtin_amdgcn_sched_barrier(0);
#define PK(L, H) (bf16x8){L[0], L[1], L[2], L[3], H[0], H[1], H[2], H[3]}
    od = __builtin_amdgcn_mfma_f32_32x32x16_bf16(pa0, PK(l0, h0), od, 0, 0, 0);
    od = __builtin_amdgcn_mfma_f32_32x32x16_bf16(pa1, PK(l1, h1), od, 0, 0, 0);
    od = __builtin_amdgcn_mfma_f32_32x32x16_bf16(pa2, PK(l2, h2), od, 0, 0, 0);
    od = __builtin_amdgcn_mfma_f32_32x32x16_bf16(pa3, PK(l3, h3), od, 0, 0, 0);
#undef PK
}
__device__ __forceinline__ int crow(int r, int hi) { return (r & 3) + 8 * (r >> 2) + 4 * hi; }
__device__ __forceinline__ int swap34(int k) { return (k & ~0x18) | ((k & 8) << 1) | ((k & 16) >> 1); }
__device__ __forceinline__ bf16x8 pack8(const f32x16& p, int base) {
    u32x4 w; w.x = cvt_pk_bf16(p[base + 0], p[base + 1]); w.y = cvt_pk_bf16(p[base + 2], p[base + 3]); w.z = cvt_pk_bf16(p[base + 4], p[base + 5]); w.w = cvt_pk_bf16(p[base + 6], p[base + 7]);
    return __builtin_bit_cast(bf16x8, w);
}
constexpr float SB_EXIT = 160.0f;

__device__ __forceinline__ void unit(const Args& a, LAS unsigned char* lds, volatile LAS int* done_cnt, int b, int h, int qb, int tid, int lane, int wid) {
    const bf16_t* QN = (const bf16_t*)(a.ws + WS_QN) + (size_t)(b * NHEAD + h) * LROW * HD;
    const bf16_t* KN = (const bf16_t*)(a.ws + WS_KN) + (size_t)(b * NHEAD + h) * LROW * HD;
    const bf16_t* Vp = (const bf16_t*)(a.ws + WS_P) + (size_t)b * LSEQ * NPROJ + PC_SBV + h * HD;
    bf16_t* MIX = (bf16_t*)(a.ws + WS_MIX);
    const int r32 = lane & 31, hi = lane >> 5;
    LAS unsigned char* K_lds = lds; LAS unsigned char* V_lds = lds + 16384;
    const int tq0 = NMETA + 256 * qb + 32 * wid, tq = tq0 + r32;
    __syncthreads();
    if (tid == 0) *done_cnt = 0;
    bf16x8 qr[8];
#pragma unroll
    for (int d0 = 0; d0 < 8; ++d0) qr[d0] = *(const bf16x8*)(QN + (size_t)tq * HD + d0 * 16 + hi * 8);
    const int sr = tid >> 4, sc = (tid & 15) * 8;
    const int vst0 = v_st(swap34(sr), sc), vst1 = v_st(32 + swap34(sr), sc);
    const int kst0 = KSWZ(sr, sc * 2), kst1 = KSWZ(32 + sr, sc * 2);
    const int vb0 = (int)(unsigned)(unsigned long)V_lds + v_rd_base(lane);
    const int prow = (r32 & 3) + 4 * (r32 >> 3) + 16 * ((r32 >> 2) & 1);
    f32x16 o[4];
#pragma unroll
    for (int d = 0; d < 4; ++d)
#pragma unroll
        for (int r = 0; r < 16; ++r) o[d][r] = 0.f;
    float carry = 0.f; bool flagged = false;
    for (int kt = 4 * qb + 4; kt >= 0; --kt) {
        const int k0 = 64 * kt;
        const bf16x8 ks0 = *(const bf16x8*)(KN + (size_t)(k0 + sr) * HD + sc), ks1 = *(const bf16x8*)(KN + (size_t)(k0 + 32 + sr) * HD + sc);
        const bf16x8 vs0 = *(const bf16x8*)(Vp + (size_t)(k0 + sr) * NPROJ + sc), vs1 = *(const bf16x8*)(Vp + (size_t)(k0 + 32 + sr) * NPROJ + sc);
        __syncthreads();
        if (*done_cnt == NWAVES) break;
        *(LAS bf16x8*)(K_lds + kst0) = ks0; *(LAS bf16x8*)(K_lds + kst1) = ks1; *(LAS bf16x8*)(V_lds + vst0) = vs0; *(LAS bf16x8*)(V_lds + vst1) = vs1;
        __syncthreads();
        if (k0 >= tq0 + 32) continue;
        f32x16 p0, p1;
#pragma unroll
        for (int r = 0; r < 16; ++r) { p0[r] = 0.f; p1[r] = 0.f; }
#pragma unroll
        for (int d0 = 0; d0 < 8; ++d0) { const int cb = (d0 * 16 + hi * 8) * 2;
            const bf16x8 b0 = *(const LAS bf16x8*)(K_lds + KSWZ(prow, cb)), b1 = *(const LAS bf16x8*)(K_lds + KSWZ(32 + prow, cb));
            p0 = __builtin_amdgcn_mfma_f32_32x32x16_bf16(b0, qr[d0], p0, 0, 0, 0);
            p1 = __builtin_amdgcn_mfma_f32_32x32x16_bf16(b1, qr[d0], p1, 0, 0, 0); }
        const bool need_mask = (k0 + 63 >= tq0);
        f32x16 s0, s1; float t0 = 0.f, t1 = 0.f;
#pragma unroll
        for (int r = 0; r < 16; ++r) {
            float e0 = __builtin_amdgcn_exp2f(p0[r]), e1 = __builtin_amdgcn_exp2f(p1[r]);
            float q0 = __builtin_amdgcn_logf(1.0f + e0), q1 = __builtin_amdgcn_logf(1.0f + e1);
            if (need_mask) { const bool v0 = (k0 + 16 * hi + r) < tq, v1 = (k0 + 32 + 16 * hi + r) < tq; e0 = v0 ? e0 : 0.f; q0 = v0 ? q0 : 0.f; e1 = v1 ? e1 : 0.f; q1 = v1 ? q1 : 0.f; }
            p0[r] = e0; p1[r] = e1; s0[r] = q0; s1[r] = q1; t0 += q0; t1 += q1; }
        float t1lo, t1hi, t0lo, t0hi;
        { auto rr = __builtin_amdgcn_permlane32_swap(__float_as_uint(t1), __float_as_uint(t1), false, false); t1lo = __uint_as_float(rr[0]); t1hi = __uint_as_float(rr[1]); }
        { auto rr = __builtin_amdgcn_permlane32_swap(__float_as_uint(t0), __float_as_uint(t0), false, false); t0lo = __uint_as_float(rr[0]); t0hi = __uint_as_float(rr[1]); }
        float run1 = carry + (hi ? 0.f : t1hi), run0 = carry + (t1lo + t1hi) + (hi ? 0.f : t0hi);
#pragma unroll
        for (int r = 15; r >= 0; --r) { run1 += s1[r]; p1[r] = p1[r] * __builtin_amdgcn_exp2f(-run1); run0 += s0[r]; p0[r] = p0[r] * __builtin_amdgcn_exp2f(-run0); }
        carry += (t1lo + t1hi) + (t0lo + t0hi);
        const bf16x8 pa0 = pack8(p0, 0), pa1 = pack8(p0, 8), pa2 = pack8(p1, 0), pa3 = pack8(p1, 8);
        pv_one<0>(o[0], vb0, pa0, pa1, pa2, pa3); pv_one<1>(o[1], vb0, pa0, pa1, pa2, pa3); pv_one<2>(o[2], vb0, pa0, pa1, pa2, pa3); pv_one<3>(o[3], vb0, pa0, pa1, pa2, pa3);
        if (!flagged && __all(carry >= SB_EXIT)) { flagged = true; if (lane == 0) (void)__hip_atomic_fetch_add((LAS int*)done_cnt, 1, __ATOMIC_RELAXED, __HIP_MEMORY_SCOPE_WORKGROUP); }
    }
    const float* onw = a.in[I_SBONW];
    float wv[4];
#pragma unroll
    for (int d0 = 0; d0 < 4; ++d0) wv[d0] = onw[32 * d0 + r32];
#pragma unroll
    for (int r = 0; r < 16; ++r) {
        float ss = (o[0][r] * o[0][r] + o[1][r] * o[1][r]) + (o[2][r] * o[2][r] + o[3][r] * o[3][r]);
        ss = row16_sum(ss); ss += __shfl_xor(ss, 16);
        const float rstd = 1.0f / sqrtf(ss * (1.0f / HD) + NORM_EPS);
        const size_t tok = (size_t)b * SEQ + (tq0 - NMETA) + crow(r, hi);
        bf16_t* dst = MIX + tok * DM + 1024 + h * HD + r32;
#pragma unroll
        for (int d0 = 0; d0 < 4; ++d0) dst[32 * d0] = (bf16_t)(cvt_pk_bf16(o[d0][r] * rstd * wv[d0], 0.f) & 0xffffu);
    }
}
}

__device__ __forceinline__ void p5_router(const Args& a, LAS unsigned char* lds, int G, int c, int tid, int lane, int wave) {
    LAS float* wl = (LAS float*)lds;
    LAS float* lg = (LAS float*)(lds + 132096);
    LAS int* misc = (LAS int*)(lds + MISC_OFF);
    const float* H1 = a.out; const float* rw = a.in[I_RW]; const float* rb = a.in[I_RB];
    unsigned char* HN2 = a.ws + WS_HN;
    int* RE = (int*)(a.ws + WS_RE); int* RP = (int*)(a.ws + WS_RP); float* RG = (float*)(a.ws + WS_RG); int* LIST = (int*)(a.ws + WS_LIST);
    unsigned* ecnt = (unsigned*)(a.ws + WS_CTL) + CW_ECNT;
    f32x4 wn[8];
#pragma unroll
    for (int j = 0; j < 8; ++j) wn[j] = *((const f32x4*)a.in[I_FFNNW] + lane + 64 * j);
    for (int blk = c; blk < NREAL / 64; blk += G) {
        for (int pass = 0; pass < 2; ++pass) {
            __syncthreads();
            stage_w16(wl, rw, NEXP, pass * 16, tid);
            if (pass == 0 && tid < 32) misc[40 + tid] = 0;
            __syncthreads();
            for (int rg = 0; rg < 4; ++rg) {
                f32x4 v[2][8];
#pragma unroll
                for (int k = 0; k < 2; ++k) { const size_t row = (size_t)blk * 64 + wave * 8 + rg * 2 + k;
#pragma unroll
                    for (int j = 0; j < 8; ++j) v[k][j] = *((const f32x4*)(H1 + row * DM) + lane + 64 * j); }
#pragma unroll
                for (int k = 0; k < 2; ++k) { const size_t row = (size_t)blk * 64 + wave * 8 + rg * 2 + k; float ss = 0.f;
#pragma unroll
                    for (int j = 0; j < 8; ++j) ss += (v[k][j].x * v[k][j].x + v[k][j].y * v[k][j].y) + (v[k][j].z * v[k][j].z + v[k][j].w * v[k][j].w);
                    const float rstd = 1.0f / sqrtf(wave_sum(ss) * (1.0f / DM) + NORM_EPS);
                    GAS unsigned* o4 = (GAS unsigned*)(HN2 + row * DM) + lane;
#pragma unroll
                    for (int j = 0; j < 8; ++j) { v[k][j] = v[k][j] * rstd * wn[j];
                        if (pass == 0) o4[64 * j] = pk4_fp8(v[k][j].x, v[k][j].y, v[k][j].z, v[k][j].w); } }
#pragma unroll
                for (int hf = 0; hf < 2; ++hf) { float o8[2][8]; dot8xN<2>(v, wl + hf * 8 * WLS, lane, o8);
#pragma unroll
                    for (int k = 0; k < 2; ++k) { float sv = o8[k][0];
#pragma unroll
                        for (int c = 1; c < 8; ++c) sv = ((lane & 7) == c) ? o8[k][c] : sv;
                        if (lane < 8) lg[(wave * 8 + rg * 2 + k) * 33 + pass * 16 + hf * 8 + lane] = sv; } }
            }
        }
        __syncthreads();
        int ek[4] = {0, 0, 0, 0}, rk[4] = {0, 0, 0, 0}; float gk[4] = {0.f, 0.f, 0.f, 0.f};
        if (tid < 64) {
            float v[32];
#pragma unroll
            for (int e = 0; e < 32; ++e) v[e] = lg[tid * 33 + e] + rb[e];
            float val[4];
#pragma unroll
            for (int k = 0; k < 4; ++k) { float best = -3.0e38f; int bi = 0;
#pragma unroll
                for (int e = 0; e < 32; ++e) { const bool gt = v[e] > best; best = gt ? v[e] : best; bi = gt ? e : bi; }
#pragma unroll
                for (int e = 0; e < 32; ++e) v[e] = (e == bi) ? -3.0e38f : v[e];
                ek[k] = bi; val[k] = best; }
            float den = 0.f;
#pragma unroll
            for (int k = 0; k < 4; ++k) { gk[k] = expf(val[k] - val[0]); den += gk[k]; }
#pragma unroll
            for (int k = 0; k < 4; ++k) { gk[k] = gk[k] / den; rk[k] = __hip_atomic_fetch_add(&misc[40 + ek[k]], 1, __ATOMIC_RELAXED, __HIP_MEMORY_SCOPE_WORKGROUP); }
        }
        __syncthreads();
        if (tid < 32) { const int cnt = misc[40 + tid]; misc[72 + tid] = cnt ? (int)atomicAdd(&ecnt[tid], (unsigned)cnt) : 0; }
        __syncthreads();
        if (tid < 64) { const int tok = blk * 64 + tid;
#pragma unroll
            for (int k = 0; k < 4; ++k) { const int pos = misc[72 + ek[k]] + rk[k]; LIST[(size_t)ek[k] * NREAL + pos] = tok; RE[tok * 4 + k] = ek[k]; RP[tok * 4 + k] = pos; RG[tok * 4 + k] = gk[k]; } }
    }
    __syncthreads();
}

__device__ __forceinline__ int moe_setup(const Args& a, LAS int* misc, int tid) {
    const unsigned* ecnt = (const unsigned*)(a.ws + WS_CTL) + CW_ECNT;
    __syncthreads();
    if (tid == 0) { int acc = 0;
        for (int e = 0; e < NEXP; ++e) { const int cnt = (int)__hip_atomic_load(ecnt + e, __ATOMIC_RELAXED, __HIP_MEMORY_SCOPE_AGENT); misc[104 + e] = cnt; misc[e] = acc; acc += (cnt + 255) >> 8; }
        misc[32] = acc; }
    __syncthreads();
    return misc[32];
}

__device__ __forceinline__ void p8_combine(const Args& a, const LAS int* misc, int gw, int NGW, int lane) {
    const int* RE = (const int*)(a.ws + WS_RE); const int* RP = (const int*)(a.ws + WS_RP); const float* RG = (const float*)(a.ws + WS_RG);
    const bf16_t* Y = (const bf16_t*)(a.ws + WS_Y); const float* bd = a.in[I_BD]; float* out = a.out;
    for (int row = gw; row < NREAL; row += NGW) {
        int e[4]; size_t slot[4]; float g[4];
#pragma unroll
        for (int k = 0; k < 4; ++k) { e[k] = RE[row * 4 + k]; slot[k] = (size_t)misc[e[k]] * 256 + RP[row * 4 + k]; g[k] = RG[row * 4 + k]; }
#pragma unroll
        for (int j = 0; j < 4; ++j) { const int col = 8 * lane + 512 * j;
            f32x4 a0 = *(const f32x4*)(out + (size_t)row * DM + col), a1 = *(const f32x4*)(out + (size_t)row * DM + col + 4);
#pragma unroll
            for (int k = 0; k < 4; ++k) { const u32x4 y = *(const u32x4*)(Y + slot[k] * DM + col);
                const f32x4 b0 = *(const f32x4*)(bd + (size_t)e[k] * DM + col), b1 = *(const f32x4*)(bd + (size_t)e[k] * DM + col + 4);
                a0.x += g[k] * (bf_lo(y.x) + b0.x); a0.y += g[k] * (bf_hi(y.x) + b0.y); a0.z += g[k] * (bf_lo(y.y) + b0.z); a0.w += g[k] * (bf_hi(y.y) + b0.w);
                a1.x += g[k] * (bf_lo(y.z) + b1.x); a1.y += g[k] * (bf_hi(y.z) + b1.y); a1.z += g[k] * (bf_lo(y.w) + b1.z); a1.w += g[k] * (bf_hi(y.w) + b1.w); }
            *(f32x4*)(out + (size_t)row * DM + col) = a0; *(f32x4*)(out + (size_t)row * DM + col + 4) = a1; }
    }
}

__device__ __forceinline__ void p1_meta_rows(const Args& a, int bx, int G, int wave, int lane) {
    const bf16_t* HN = (const bf16_t*)(a.ws + WS_HN); const bf16_t* WT = (const bf16_t*)(a.ws + WS_WIN); bf16_t* P = (bf16_t*)(a.ws + WS_P);
    for (int col = bx; col < NPROJ; col += G) {
        u32x4 w[4];
#pragma unroll
        for (int j = 0; j < 4; ++j) w[j] = *(const u32x4*)(WT + (size_t)col * DM + 8 * lane + 512 * j);
        for (int t = wave; t < NMETA; t += NWAVES) {
            float acc = 0.f;
#pragma unroll
            for (int j = 0; j < 4; ++j) { const u32x4 x = *(const u32x4*)(HN + (size_t)t * DM + 8 * lane + 512 * j);
                acc += bf_lo(x.x) * bf_lo(w[j].x) + bf_hi(x.x) * bf_hi(w[j].x) + bf_lo(x.y) * bf_lo(w[j].y) + bf_hi(x.y) * bf_hi(w[j].y)
                     + bf_lo(x.z) * bf_lo(w[j].z) + bf_hi(x.z) * bf_hi(w[j].z) + bf_lo(x.w) * bf_lo(w[j].w) + bf_hi(x.w) * bf_hi(w[j].w); }
            acc = wave_sum(acc);
            if (lane < NB) P[((size_t)lane * LSEQ + t) * NPROJ + col] = gdn::f2bf(acc);
        }
    }
}

constexpr int NPH = 9;
__global__ void __launch_bounds__(NTHREADS, 2) hymba_fwd(Args args) {
    extern __shared__ __attribute__((aligned(16))) unsigned char lds_raw[];
    LAS unsigned char* lds = (LAS unsigned char*)lds_raw;
    LAS int* misc = (LAS int*)(lds + MISC_OFF);
    const int tid = threadIdx.x, lane = tid & 63, wave = __builtin_amdgcn_readfirstlane(tid >> 6);
    const int G = gridDim.x, bx = blockIdx.x;
    const int vcu = (G % 8 == 0) ? (bx % 8) * (G / 8) + bx / 8 : bx;
    const int gw = vcu * NWAVES + wave, NGW = G * NWAVES;
    unsigned* ctl = (unsigned*)(args.ws + WS_CTL);
    for (int u = tid; u < 256; u += NTHREADS) misc[u] = 0;
    __syncthreads();
    XcdBarrier bar; bar.bar = ctl + CW_BAR; bar.x = 0; bar.st = nullptr;
    const int lo = args.ph_lo, hi = args.ph_hi;
    const int NCV = 0, GG = G - NCV;
    constexpr int CVT_LIMIT_P1 = 0, CVT_LIMIT_P2 = MOE_ITEMS * 35 / 100, CVT_LIMIT_P3 = MOE_ITEMS;
    if (hi - lo > 1) bar = xcd_barrier_post(ctl + CW_BAR, (volatile LAS unsigned*)(misc + 200));
#ifdef ONLY
#define IN(k) ((k) == ONLY && lo <= (k) && (k) < hi)
#else
#define IN(k) (lo <= (k) && (k) < hi)
#endif
#ifndef REP_COUNT
#define REP_COUNT 2
#endif
#define REPEAT(k) _Pragma("unroll") for (int _r = 0; _r < ((REP_PHASE == (k)) ? REP_COUNT : 1); ++_r)
#define SEAM(k) do { if (IN(k) && IN((k) + 1)) xcd_barrier(bar); if (PROBE_A >= 0 && tid == 0) tsl[(k) + 1] = __builtin_amdgcn_s_memrealtime(); } while (0)

    LAS unsigned long long* tsl = (LAS unsigned long long*)(lds + MISC_OFF + 896);
    if (PROBE_A >= 0 && tid == 0) tsl[0] = __builtin_amdgcn_s_memrealtime();
    if (IN(0)) REPEAT(0) { p0_rows(args, lds, gw, NGW, tid, lane); p0_weights(args, lds, vcu, G, wave, lane); }
    SEAM(0);
    if (IN(1)) REPEAT(1) {
        p1_meta_rows(args, bx, G, wave, lane);
        if (bx < GG) {
        pg8::PlainOrder S; S.init(NREAL, NPROJ, DM, args.ws + WS_WIN, GG, bx); S.meta = 1;
        pg8::EpiBf16 E{(bf16_t*)(args.ws + (_r ? WS_ACT : WS_P)), NPROJ, 1};
        pg8::gemm_phase<pg8::EpiBf16, pg8::PlainOrder, true, true>(lds, (const char*)(args.ws + WS_HN), DM * 2, S, E);
        } else moe_weights_queue(args, lds, misc + 212, tid, wave, lane, CVT_LIMIT_P1);
    }
    SEAM(1);
    if (IN(2)) REPEAT(2) {
        p2_qknorm(args, gw, NGW, lane);
#if GDN_CHUNKED
        const bool roleB = (G >= 128) && (bx >= G - G / 8 * 3);
        if (roleB) moe_weights_queue(args, lds, misc + 212, tid, wave, lane, CVT_LIMIT_P2);
        for (;;) {
            __syncthreads();
            if (tid == 0) misc[213] = (int)atomicAdd(ctl + CW_PREQ, 1u);
            __syncthreads();
            const int it = *(volatile LAS int*)(misc + 213);
            if (it >= 32 * gdn::NCH) break;
            gdn::precompute(args, lds, it, tid, lane, wave);
        }
        if (!roleB) moe_weights_queue(args, lds, misc + 212, tid, wave, lane, CVT_LIMIT_P2);
#endif
    }
    SEAM(2);
    if (IN(3)) REPEAT(3) {
        const int NG = (G >= 64) ? 32 : 0;
#if GDN_CHUNKED
        if (bx < 32 || NG == 0) { for (int it = bx; it < 32; it += G) gdn::scan(args, lds, it, tid, lane, wave); }
#else
        if (bx < 32 || NG == 0) { for (int it = bx; it < 32; it += G) p3_gdn_naive(args, lds, it, tid, lane, wave); }
#endif
        if (bx >= NG) { for (int u = bx - NG; u < 512; u += G - NG) sba::unit(args, lds, (volatile LAS int*)(misc + 210), u >> 7, (u >> 4) & 7, u & 15, tid, lane, wave); }
        if (_r == 0) moe_weights_queue(args, lds, misc + 212, tid, wave, lane, NCV ? CVT_LIMIT_P3 : MOE_ITEMS);
    }
    SEAM(3);
    if (IN(4)) REPEAT(4) {
        pg8::PlainOrder S; S.init(NREAL, DM, DM, args.ws + WS_WOUT, G, bx);
        pg8::EpiResF32 E{args.in[I_X], _r ? (float*)(args.ws + WS_ACT) : args.out, DM};
        pg8::gemm_phase<pg8::EpiResF32, pg8::PlainOrder, true, true>(lds, (const char*)(args.ws + WS_MIX), DM * 2, S, E);
    }
    SEAM(4);
    if (IN(5)) p5_router(args, lds, G, bx, tid, lane, wave);
    SEAM(5);
    if (IN(6)) REPEAT(6) {
        if (bx >= GG) moe_weights_queue(args, lds, misc + 212, tid, wave, lane, MOE_ITEMS);
        else {
        const int mt = moe_setup(args, misc, tid);
        pg8::MoeOrder<true> S; S.tpre = misc; S.tok = (const LAS int*)(lds + TOK_OFF); S.nN = 16; S.nwg = mt * 16; S.G = GG; S.c = bx;
        S.Bt = (const char*)(args.ws + WS_WGU); S.estride = (size_t)2 * DE * DM; S.K2 = DM;
        const int* LIST = (const int*)(args.ws + WS_LIST);
        for (int ui = 0; ui < TOK_CAP; ++ui) { pg8::Unit u; if (!S.next(ui, u)) break;
            if (tid < 256) { const int idx = (u.pm - misc[u.e]) * 256 + tid; ((LAS int*)(lds + TOK_OFF))[ui * 256 + tid] = idx < misc[104 + u.e] ? LIST[(size_t)u.e * NREAL + idx] : 0; } }
        __syncthreads();
        pg8::EpiSwiGLU E{args.ws + WS_ACT, args.in[I_BGU]};
        pg8::gemm_phase<pg8::EpiSwiGLU, pg8::MoeOrder<true>, true, true, true>(lds, (const char*)(args.ws + WS_HN), DM, S, E);
        }
    }
    SEAM(6);
    if (IN(7)) REPEAT(7) {
        const int mt = moe_setup(args, misc, tid);
        pg8::MoeOrder<false> S; S.tpre = misc; S.tok = nullptr; S.nN = 8; S.nwg = mt * 8; S.G = G; S.c = bx;
        S.Bt = (const char*)(args.ws + WS_WD); S.estride = (size_t)DM * DE; S.K2 = DE;
        pg8::EpiBf16 E{(bf16_t*)(args.ws + (_r ? WS_WGU : WS_Y)), DM, 0};
        pg8::gemm_phase<pg8::EpiBf16, pg8::MoeOrder<false>, true, true, true>(lds, (const char*)(args.ws + WS_ACT), DE, S, E);
    }
    SEAM(7);
    if (IN(8)) { (void)moe_setup(args, misc, tid); p8_combine(args, misc, gw, NGW, lane); }
#if PROBE_A >= 0
    __syncthreads();
    if (tid == 0) tsl[9] = __builtin_amdgcn_s_memrealtime();
    __syncthreads();
    {
        const int pa = PROBE_A;
        const float us = (float)(pa == 9 ? (tsl[9] - tsl[0]) : (tsl[pa + 1] - tsl[pa])) * 1e-2f;
        const float f = 1.0f - 0.05f * us / (float)(PROBE_REF_US);
        VM_WAIT();
        for (int row = gw; row < NREAL; row += NGW) {
#pragma unroll
            for (int j = 0; j < 8; ++j) { f32x4* p = (f32x4*)(args.out + (size_t)row * DM) + lane + 64 * j; *p = *p * f; } }
    }
#endif
#undef IN
#undef SEAM
}

extern "C" void kernel_launch(void* const* d_in, const int* in_sizes, int n_in, void* d_out, int out_size, void* d_ws, size_t ws_size, hipStream_t stream) {
    static int grid = 0;
    if (grid == 0) {
        if (n_in != 19 || out_size != NREAL * DM || ws_size < WS_END) { fprintf(stderr, "kernel_launch: unexpected shapes (n_in %d out %d ws %zu need %zu)\n", n_in, out_size, ws_size, (size_t)WS_END); grid = -1; return; }
        int dev = 0, cus = 0, per_cu = 0;
        if (hipGetDevice(&dev) != hipSuccess || hipDeviceGetAttribute(&cus, hipDeviceAttributeMultiprocessorCount, dev) != hipSuccess) { grid = -1; return; }
        if (hipFuncSetAttribute((const void*)hymba_fwd, hipFuncAttributeMaxDynamicSharedMemorySize, LDS_BYTES) != hipSuccess) { fprintf(stderr, "kernel_launch: hipFuncSetAttribute failed\n"); grid = -1; return; }
        if (hipOccupancyMaxActiveBlocksPerMultiprocessor(&per_cu, (const void*)hymba_fwd, NTHREADS, LDS_BYTES) != hipSuccess || per_cu < 1) { fprintf(stderr, "kernel_launch: occupancy query says %d\n", per_cu); grid = -1; return; }
        (void)hipGetLastError();
        grid = cus;
    }
    if (grid < 0) return;
    (void)hipMemsetAsync((char*)d_ws + WS_CTL, 0, CTL_ZERO_BYTES, stream);
    Args a{};
    for (int i = 0; i < 19; ++i) a.in[i] = (const float*)d_in[i];
    a.out = (float*)d_out; a.ws = (unsigned char*)d_ws;
#if MK_N_LAUNCHES == 1
    a.ph_lo = 0; a.ph_hi = NPH;
    hipLaunchKernelGGL(hymba_fwd, dim3(grid), dim3(NTHREADS), LDS_BYTES, stream, a);
#else
    for (int p = 0; p < NPH; ++p) { a.ph_lo = p; a.ph_hi = p + 1; hipLaunchKernelGGL(hymba_fwd, dim3(grid), dim3(NTHREADS), LDS_BYTES, stream, a); }
#endif
    const hipError_t le = hipPeekAtLastError();
    if (le != hipSuccess) fprintf(stderr, "kernel_launch: launch failed: %s\n", hipGetErrorName(le));
}
```

```cpp
#include <hip/hip_runtime.h>
#include <cstdio>
#include <cstdint>

#ifndef GDN_CHUNKED
#define GDN_CHUNKED 1
#endif
#ifndef REP_PHASE
#define REP_PHASE -1
#endif
#ifndef PROBE_A
#define PROBE_A -1
#endif
#ifndef PROBE_REF_US
#define PROBE_REF_US 500
#endif
#ifndef MK_N_LAUNCHES
#define MK_N_LAUNCHES 1
#endif

constexpr int NB = 4, SEQ = 4096, NMETA = 16, LSEQ = SEQ + NMETA;
constexpr int DM = 2048, NTOK = NB * LSEQ  , MPAD = 16640  , NREAL = NB * SEQ  ;
constexpr int NPROJ_SRC = 7184, NPROJ = 7168;
constexpr int NHEAD = 8, HD = 128;
constexpr int PC_QKV = 0, PC_Z = 3072, PC_SBQ = 4096, PC_SBK = 5120, PC_SBV = 6144;
constexpr int NEXP = 32, TOPK = 4, DE = 2048;
constexpr int SLOT_ROWS = 73728;
constexpr int LROW = 4224;
constexpr float NORM_EPS = 1e-6f;

constexpr size_t MiB = 1u << 20;
constexpr size_t WS_CTL = 0, CTL_ZERO_BYTES = 1 * MiB;
constexpr size_t WS_WIN = 1 * MiB;
constexpr size_t WS_WOUT = WS_WIN + (size_t)NPROJ * DM * 2;
constexpr size_t WS_WGU = WS_WOUT + (size_t)DM * DM * 2;
constexpr size_t WS_WD = WS_WGU + (size_t)NEXP * 2 * DE * DM * 2;
constexpr size_t WS_HN = WS_WD + (size_t)NEXP * DM * DE * 2;
constexpr size_t WS_BETA = WS_HN + (size_t)MPAD * DM * 2;
constexpr size_t WS_G = WS_BETA + (size_t)NTOK * 8 * 4 + 256;
constexpr size_t WS_P = WS_G + (size_t)NTOK * 8 * 4 + 256;
constexpr size_t WS_QN = WS_P + (size_t)MPAD * NPROJ * 2;
constexpr size_t WS_KN = WS_QN + (size_t)NB * NHEAD * LROW * HD * 2;
constexpr size_t WS_ORAW = WS_KN + (size_t)NB * NHEAD * LROW * HD * 2;
constexpr size_t WS_MIX = WS_ORAW + (size_t)NREAL * 1024 * 4;
constexpr size_t WS_RE = WS_MIX + (size_t)NREAL * DM * 2;
constexpr size_t WS_RP = WS_RE + (size_t)NREAL * 4 * 4;
constexpr size_t WS_RG = WS_RP + (size_t)NREAL * 4 * 4;
constexpr size_t WS_LIST = WS_RG + (size_t)NREAL * 4 * 4;
constexpr size_t WS_ACT = WS_LIST + (size_t)NEXP * NREAL * 4;
constexpr size_t WS_Y = WS_ACT + (size_t)SLOT_ROWS * DE * 2;
constexpr size_t WS_GCH = WS_Y + (size_t)SLOT_ROWS * DM * 2;
constexpr size_t WS_GL = WS_GCH + (size_t)32 * 65 * 73728;
constexpr size_t WS_END = WS_GL + 32 * 65 * 4 + 256;
constexpr int CW_ECNT = 64;
constexpr int CW_CVTQ = 192;
constexpr int CW_PREQ = 256;
constexpr int CW_BAR = 4096;

constexpr int LDS_STAGE = 131072;
constexpr int TOK_OFF = LDS_STAGE, TOK_CAP = 22;
constexpr int MISC_OFF = TOK_OFF + TOK_CAP * 256 * 4;
constexpr int LDS_BYTES = MISC_OFF + 1024;

#define GAS __attribute__((address_space(1)))
#define LAS __attribute__((address_space(3)))
typedef unsigned short bf16_t;
typedef short bf16x8 __attribute__((ext_vector_type(8)));
typedef short s16x4 __attribute__((ext_vector_type(4)));
typedef float f32x4 __attribute__((ext_vector_type(4)));
typedef float f32x2 __attribute__((ext_vector_type(2)));
typedef float f32x16 __attribute__((ext_vector_type(16)));
typedef unsigned u32x4 __attribute__((ext_vector_type(4)));
typedef unsigned u32x2 __attribute__((ext_vector_type(2)));

typedef __bf16 bf16x2_t __attribute__((ext_vector_type(2)));
__device__ __forceinline__ unsigned cvt_pk_bf16(float lo, float hi) { const f32x2 v = {lo, hi}; const bf16x2_t b = __builtin_convertvector(v, bf16x2_t); return __builtin_bit_cast(unsigned, b); }
__device__ __forceinline__ unsigned pk4_fp8(float a, float b, float c, float d) { unsigned w = 0u; w = __builtin_amdgcn_cvt_pk_fp8_f32(a, b, w, false); w = __builtin_amdgcn_cvt_pk_fp8_f32(c, d, w, true); return w; }
__device__ __forceinline__ float bf_lo(unsigned w) { return __uint_as_float(w << 16); }
__device__ __forceinline__ float bf_hi(unsigned w) { return __uint_as_float(w & 0xffff0000u); }
__device__ __forceinline__ float bf2f(bf16_t b) { return __uint_as_float(((unsigned)b) << 16); }
template <int CTRL, int ROW_MASK> __device__ __forceinline__ float dpp_get(float v) {
    return __builtin_bit_cast(float, __builtin_amdgcn_update_dpp(0, __builtin_bit_cast(int, v), CTRL, ROW_MASK, 0xF, false));
}
__device__ __forceinline__ float row16_sum(float v) {
    v += dpp_get<0xB1, 0xF>(v);
    v += dpp_get<0x4E, 0xF>(v);
    v += dpp_get<0x141, 0xF>(v);
    v += dpp_get<0x140, 0xF>(v);
    return v;
}
__device__ __forceinline__ float quad_sum(float v) { v += dpp_get<0xB1, 0xF>(v); v += dpp_get<0x4E, 0xF>(v); return v; }
__device__ __forceinline__ float wave_sum(float v) {
    v = row16_sum(v);
    v += dpp_get<0x142, 0xA>(v);
    v += dpp_get<0x143, 0xC>(v);
    return __builtin_bit_cast(float, __builtin_amdgcn_readlane(__builtin_bit_cast(int, v), 63));
}

namespace pg8 {
constexpr int BM = 256, BK = 64, HALF = 128, HTB = HALF * BK * 2, STAGE_BYTES = 8 * HTB, NXCD = 8, WGM = 8;
__host__ __device__ __forceinline__ int lds_byte(int r, int c) { const int st = (r >> 4) * 2 + (c >> 5), rr = r & 15, cc = c & 31, ob = rr * 64 + cc * 2; return st * 1024 + (ob ^ (((ob >> 9) & 1) << 5)); }
__host__ __device__ __forceinline__ void stage_rc(int b, int& R, int& C) { const int st = b / 1024, sb = b % 1024, swz = sb ^ (((sb >> 9) & 1) << 5); R = (st >> 1) * 16 + swz / 64; C = (st & 1) * 32 + (swz % 64) / 2; }
__host__ __device__ __forceinline__ int perm32(int rho) { const int n = rho >> 4, i = rho & 15; return 8 * (i >> 2) + 4 * n + (i & 3); }

typedef int v8i __attribute__((ext_vector_type(8))); typedef int v4i __attribute__((ext_vector_type(4)));
__device__ __forceinline__ v8i cat8(bf16x8 lo, bf16x8 hi) { const v4i a = __builtin_bit_cast(v4i, lo), b = __builtin_bit_cast(v4i, hi); return __builtin_shufflevector(a, b, 0, 1, 2, 3, 4, 5, 6, 7); }
struct Unit { int pm, pn, e, ui; };

__device__ __forceinline__ int xcd_remap(int L, int nwg) { const int q = nwg / NXCD, r = nwg % NXCD, xcd = L % NXCD, off = L / NXCD; return (xcd < r ? xcd * (q + 1) : r * (q + 1) + (xcd - r) * q) + off; }

struct PlainOrder {
    int nM, nN, nwg, G, c; const char* Bt; unsigned K2;
    __device__ void init(int M, int N, int K, const void* Bt_, int G_, int c_) { nM = M / BM; nN = N / BM; nwg = nM * nN; G = G_; c = c_; Bt = (const char*)Bt_; K2 = (unsigned)K * 2u; }
    __device__ __forceinline__ bool next(int i, Unit& u) const {
        const long L = (long)i * G + c; if (L >= nwg) return false;
        const int wgid = xcd_remap((int)L, nwg);
        const int nig = WGM * nN, gid = wgid / nig, fm = gid * WGM, gsz = (nM - fm) < WGM ? (nM - fm) : WGM;
        u.pm = fm + ((wgid % nig) % gsz); u.pn = (wgid % nig) / gsz; u.e = 0; u.ui = i; return true;
    }
    __device__ __forceinline__ const char* b_ptr(const Unit& u) const { return Bt + (size_t)u.pn * BM * K2; }
    __device__ __forceinline__ unsigned a_off(const Unit& u, int r) const { return (unsigned)(u.pm * BM + r + (meta ? NMETA * ((u.pm >> 4) + 1) : 0)) * K2; }
    int meta = 0;
};
constexpr int UD_CAP = 24;
template <bool GATHER> struct MoeOrder {
    const LAS int* tpre; const LAS int* tok; const LAS int* ud; int nN, nwg, G, c; const char* Bt; size_t estride; unsigned K2;
    __device__ __forceinline__ int decode(int i) const {
        const long L = (long)i * G + c; if (L >= nwg) return -1;
        const int wgid = xcd_remap((int)L, nwg);
        int e = 0;
#pragma unroll 1
        for (int j = 1; j < NEXP; ++j) e = (wgid >= tpre[j] * nN) ? j : e;
        const int t0 = tpre[e], nt = tpre[e + 1] - t0, loc = wgid - t0 * nN;
        return e | ((t0 + loc % nt) << 6) | ((loc / nt) << 16);
    }
    __device__ __forceinline__ void fill_units(LAS int* udw, int tid) const { if (tid < UD_CAP) udw[tid] = decode(tid); }
    __device__ __forceinline__ bool next(int i, Unit& u) const {
        if (i >= UD_CAP) return false;
        const int d = ud[i]; if (d < 0) return false;
        u.e = d & 63; u.pm = (d >> 6) & 1023; u.pn = d >> 16; u.ui = i; return true;
    }
    __device__ __forceinline__ const char* b_ptr(const Unit& u) const { return Bt + (size_t)u.e * estride + (size_t)u.pn * BM * K2; }
    __device__ __forceinline__ unsigned a_off(const Unit& u, int r) const {
        if (GATHER) return (unsigned)tok[u.ui * 256 + r] * K2;
        return (unsigned)(u.pm * BM + r) * K2;
    }
};

struct EpiBf16 {
    static constexpr bool PERM = true;
    bf16_t* O; int ldc; int meta;
    __device__ __forceinline__ void operator()(const f32x4 (&acc)[2][2][4][2], const Unit& u, int wr, int wc, int fr, int fq) const {
        const int row0 = u.pm * BM + wr * 64 + fr + (meta ? NMETA * ((u.pm >> 4) + 1) : 0), col0 = u.pn * BM + wc * 32 + 8 * fq;
#pragma unroll
        for (int ai = 0; ai < 2; ++ai)
#pragma unroll
            for (int m = 0; m < 4; ++m) { bf16_t* rowp = O + (size_t)(row0 + ai * HALF + m * 16) * ldc + col0;
#pragma unroll
                for (int bj = 0; bj < 2; ++bj) { const f32x4 v0 = acc[ai][bj][m][0], v1 = acc[ai][bj][m][1];
                    u32x4 w; w.x = cvt_pk_bf16(v0[0], v0[1]); w.y = cvt_pk_bf16(v0[2], v0[3]); w.z = cvt_pk_bf16(v1[0], v1[1]); w.w = cvt_pk_bf16(v1[2], v1[3]);
                    *(u32x4*)(rowp + bj * HALF) = w; } }
    }
};
struct EpiResF32 {
    static constexpr bool PERM = false;
    const float* X; float* out; int ldc;
    __device__ __forceinline__ void operator()(const f32x4 (&acc)[2][2][4][2], const Unit& u, int wr, int wc, int fr, int fq) const {
        const int row0 = u.pm * BM + wr * 64 + fr, col0 = u.pn * BM + wc * 32 + 4 * fq;
#pragma unroll
        for (int ai = 0; ai < 2; ++ai) {
            f32x4 xv[4][2][2];
#pragma unroll
            for (int m = 0; m < 4; ++m) { const size_t off = (size_t)(row0 + ai * HALF + m * 16) * ldc + col0;
#pragma unroll
                for (int bj = 0; bj < 2; ++bj)
#pragma unroll
                    for (int n = 0; n < 2; ++n) xv[m][bj][n] = *(const f32x4*)(X + off + bj * HALF + n * 16); }
#pragma unroll
            for (int m = 0; m < 4; ++m) { const size_t off = (size_t)(row0 + ai * HALF + m * 16) * ldc + col0;
#pragma unroll
                for (int bj = 0; bj < 2; ++bj)
#pragma unroll
                    for (int n = 0; n < 2; ++n) *(f32x4*)(out + off + bj * HALF + n * 16) = xv[m][bj][n] + acc[ai][bj][m][n]; }
            asm volatile("" ::: "memory"); }
    }
};
__device__ __forceinline__ float swiglu1(float g, float uu) {
    g = fminf(g, 7.0f); uu = fminf(fmaxf(uu, -7.0f), 7.0f);
    const float sg = __builtin_amdgcn_rcpf(1.0f + __builtin_amdgcn_exp2f(-1.702f * 1.4426950408889634f * g));
    return (uu + 1.0f) * g * sg;
}
struct EpiSwiGLU {
    static constexpr bool PERM = true;
    unsigned char* act; const float* bgu;
    __device__ __forceinline__ void operator()(const f32x4 (&acc)[2][2][4][2], const Unit& u, int wr, int wc, int fr, int fq) const {
        const int row0 = u.pm * BM + wr * 64 + fr, col0 = u.pn * HALF + wc * 32 + 8 * fq;
        const float* bg = bgu + (size_t)u.e * 4096 + col0;
        const f32x4 bg0 = *(const f32x4*)(bg), bg1 = *(const f32x4*)(bg + 4), bu0 = *(const f32x4*)(bg + 2048), bu1 = *(const f32x4*)(bg + 2052);
#pragma unroll
        for (int ai = 0; ai < 2; ++ai)
#pragma unroll
            for (int m = 0; m < 4; ++m) { unsigned char* rowp = act + (size_t)(row0 + ai * HALF + m * 16) * DE + col0;
                const f32x4 g0 = acc[ai][0][m][0] + bg0, g1 = acc[ai][0][m][1] + bg1, u0 = acc[ai][1][m][0] + bu0, u1 = acc[ai][1][m][1] + bu1;
                u32x2 w; w.x = pk4_fp8(swiglu1(g0[0], u0[0]), swiglu1(g0[1], u0[1]), swiglu1(g0[2], u0[2]), swiglu1(g0[3], u0[3]));
                w.y = pk4_fp8(swiglu1(g1[0], u1[0]), swiglu1(g1[1], u1[1]), swiglu1(g1[2], u1[2]), swiglu1(g1[3], u1[3]));
                *(u32x2*)rowp = w; }
    }
};

template <class Epi, class Sched, bool ALIGN_EPI, bool SP2, bool FP8 = false>
__device__ __forceinline__ void gemm_phase(LAS unsigned char* lds, const char* A0, int Kb, const Sched& S, const Epi& E) {
    const int tid = threadIdx.x, wid = __builtin_amdgcn_readfirstlane(tid >> 6), lane = tid & 63, wr = wid >> 2, wc = wid & 3, fr = lane & 15, fq = lane >> 4;
    const int nt = Kb / 128;
    int Rr[2], Cc[2]; unsigned voffB[2];
#pragma unroll
    for (int i = 0; i < 2; ++i) { int R, C; stage_rc(tid * 16 + i * 8192, R, C); const int Rb = Epi::PERM ? ((R & ~31) + perm32(R & 31)) : R;
        Rr[i] = R; Cc[i] = C * 2; voffB[i] = (unsigned)(Rb * Kb + C * 2); }
    const size_t kstep = (size_t)(BK * 2);
    const size_t hstep = (size_t)HALF * Kb;
    const unsigned ldsw = (unsigned)wid * 1024u;
    const int aoff = lds_byte(wr * 64 + fr, fq * 8), boff = lds_byte(wc * 32 + fr, fq * 8);
#define PG8_SA(b, h) (((b) * 2 + (h)) * HTB)
#define PG8_SB(b, h) ((4 + (b) * 2 + (h)) * HTB)
#define PG8_STAGE(bufoff, gbase, voff) do { _Pragma("unroll") for (int _i = 0; _i < 2; ++_i) \
        __builtin_amdgcn_global_load_lds((const unsigned*)((const char*)(gbase) + (voff)[_i]), (LAS unsigned*)(lds + (bufoff) + ldsw + _i * 8192), 16, 0, 0); } while (0)
#define PG8_LDA(dst, b, h) do { _Pragma("unroll") for (int m = 0; m < 4; ++m) _Pragma("unroll") for (int k = 0; k < 2; ++k) dst[m][k] = *(const LAS bf16x8*)(lds + PG8_SA(b, h) + aoff + m * 2048 + k * 1024); } while (0)
#define PG8_LDB(dst, b, h) do { _Pragma("unroll") for (int n = 0; n < 2; ++n) _Pragma("unroll") for (int k = 0; k < 2; ++k) dst[n][k] = *(const LAS bf16x8*)(lds + PG8_SB(b, h) + boff + n * 2048 + k * 1024); } while (0)
#define PG8_MMA(ai, bj, At, Bt) do { __builtin_amdgcn_s_setprio(1); _Pragma("unroll") for (int m = 0; m < 4; ++m) _Pragma("unroll") for (int n = 0; n < 2; ++n) { \
        if constexpr (FP8) acc[ai][bj][m][n] = __builtin_amdgcn_mfma_scale_f32_16x16x128_f8f6f4(cat8(Bt[n][0], Bt[n][1]), cat8(At[m][0], At[m][1]), acc[ai][bj][m][n], 0, 0, 0, 0x79797979, 0, 0x7f7f7f7f); \
        else { _Pragma("unroll") for (int k = 0; k < 2; ++k) acc[ai][bj][m][n] = __builtin_amdgcn_mfma_f32_16x16x32_bf16(Bt[n][k], At[m][k], acc[ai][bj][m][n], 0, 0, 0); } } \
        __builtin_amdgcn_s_setprio(0); } while (0)
#define PG8_WAIT_V(n) asm volatile("s_waitcnt vmcnt(" #n ")" ::: "memory")
#define PG8_WAIT_L(n) asm volatile("s_waitcnt lgkmcnt(" #n ")" ::: "memory")
#define PG8_BAR __builtin_amdgcn_s_barrier()
#define PG8_SCHED __builtin_amdgcn_sched_barrier(0)
#define PG8_VOFF(dst, u) do { _Pragma("unroll") for (int _h = 0; _h < 2; ++_h) _Pragma("unroll") for (int _i = 0; _i < 2; ++_i) dst[_h][_i] = S.a_off(u, _h * HALF + Rr[_i]) + (unsigned)Cc[_i]; } while (0)
    Unit cur, nxt; int ui = 0;
    if (!S.next(0, cur)) return;
    f32x4 acc[2][2][4][2];
#pragma unroll
    for (int a = 0; a < 2; ++a)
#pragma unroll
        for (int b = 0; b < 2; ++b)
#pragma unroll
            for (int m = 0; m < 4; ++m)
#pragma unroll
                for (int n = 0; n < 2; ++n) acc[a][b][m][n] = (f32x4){0.f, 0.f, 0.f, 0.f};
    bf16x8 At[4][2], B0[2][2], B1[2][2];
    unsigned va[2][2], vn[2][2];
    PG8_VOFF(va, cur);
    const char* cB = S.b_ptr(cur);
    if constexpr (SP2) {
        PG8_STAGE(PG8_SB(0, 0), cB, voffB); PG8_STAGE(PG8_SB(0, 1), cB + hstep, voffB); PG8_STAGE(PG8_SA(0, 0), A0, va[0]); PG8_STAGE(PG8_SA(0, 1), A0, va[1]);
        if (wr == 1) PG8_BAR;
        PG8_WAIT_V(2); PG8_BAR;
        PG8_STAGE(PG8_SB(1, 0), cB + kstep, voffB); PG8_STAGE(PG8_SA(1, 0), A0 + kstep, va[0]); PG8_STAGE(PG8_SB(1, 1), cB + hstep + kstep, voffB);
        PG8_WAIT_V(6); PG8_BAR;
    } else {
        PG8_STAGE(PG8_SB(0, 0), cB, voffB); PG8_STAGE(PG8_SA(0, 0), A0, va[0]); PG8_STAGE(PG8_SB(0, 1), cB + hstep, voffB); PG8_STAGE(PG8_SA(0, 1), A0, va[1]);
        if (wr == 1) PG8_BAR;
        PG8_WAIT_V(4); PG8_BAR;
        PG8_STAGE(PG8_SB(1, 0), cB + kstep, voffB); PG8_STAGE(PG8_SA(1, 0), A0 + kstep, va[0]); PG8_STAGE(PG8_SB(1, 1), cB + hstep + kstep, voffB);
        PG8_WAIT_V(6); PG8_BAR;
    }
    for (;;) {
        const bool has_next = S.next(ui + 1, nxt);
        const char* nB = has_next ? S.b_ptr(nxt) : cB;
        for (int t = 0; t < nt; t += 2) {
            const bool last = (t == nt - 2);
            const char* a1 = A0 + (size_t)(t + 1) * kstep;
            const char* a2 = last ? A0 : A0 + (size_t)(t + 2) * kstep; const char* b2 = last ? nB : cB + (size_t)(t + 2) * kstep;
            const char* a3 = a2 + kstep; const char* b3 = b2 + kstep;
            if (last) { if (has_next) { PG8_VOFF(vn, nxt); } else {
#pragma unroll
                    for (int _h = 0; _h < 2; ++_h)
#pragma unroll
                        for (int _i = 0; _i < 2; ++_i) vn[_h][_i] = va[_h][_i]; } }
            if constexpr (SP2) {
            PG8_LDB(B0, 0, 0); PG8_LDB(B1, 0, 1); PG8_SCHED; PG8_LDA(At, 0, 0); PG8_STAGE(PG8_SA(1, 1), a1, va[1]);
            if (last) {
#pragma unroll
                for (int _h = 0; _h < 2; ++_h)
#pragma unroll
                    for (int _i = 0; _i < 2; ++_i) va[_h][_i] = vn[_h][_i]; }
            PG8_WAIT_V(8); PG8_WAIT_L(0); PG8_BAR; PG8_MMA(0, 0, At, B0); PG8_MMA(0, 1, At, B1); PG8_BAR; PG8_SCHED;
            PG8_LDA(At, 0, 1); PG8_STAGE(PG8_SB(0, 0), b2, voffB); PG8_STAGE(PG8_SB(0, 1), b2 + hstep, voffB); PG8_STAGE(PG8_SA(0, 0), a2, va[0]);
            PG8_WAIT_V(8); PG8_WAIT_L(0); PG8_BAR; PG8_MMA(1, 0, At, B0); PG8_MMA(1, 1, At, B1); PG8_BAR; PG8_SCHED;
            PG8_LDB(B0, 1, 0); PG8_LDB(B1, 1, 1); PG8_SCHED; PG8_LDA(At, 1, 0); PG8_STAGE(PG8_SA(0, 1), a2, va[1]);
            PG8_WAIT_V(8); PG8_WAIT_L(0); PG8_BAR; PG8_MMA(0, 0, At, B0); PG8_MMA(0, 1, At, B1); PG8_BAR; PG8_SCHED;
            PG8_LDA(At, 1, 1); PG8_STAGE(PG8_SB(1, 0), b3, voffB); PG8_STAGE(PG8_SB(1, 1), b3 + hstep, voffB); PG8_STAGE(PG8_SA(1, 0), a3, va[0]);
            PG8_WAIT_V(8); PG8_WAIT_L(0); PG8_BAR; PG8_MMA(1, 0, At, B0); PG8_MMA(1, 1, At, B1); PG8_BAR; PG8_SCHED;
            } else {
            PG8_LDB(B0, 0, 0); PG8_SCHED; PG8_LDA(At, 0, 0); PG8_STAGE(PG8_SA(1, 1), a1, va[1]);
            if (last) {
#pragma unroll
                for (int _h = 0; _h < 2; ++_h)
#pragma unroll
                    for (int _i = 0; _i < 2; ++_i) va[_h][_i] = vn[_h][_i]; }
            PG8_WAIT_L(8); PG8_BAR; PG8_WAIT_L(0); PG8_MMA(0, 0, At, B0); PG8_BAR; PG8_SCHED;
            PG8_LDB(B1, 0, 1); PG8_STAGE(PG8_SB(0, 0), b2, voffB);
            PG8_BAR; PG8_WAIT_L(0); PG8_MMA(0, 1, At, B1); PG8_BAR;
            PG8_LDA(At, 0, 1); PG8_STAGE(PG8_SA(0, 0), a2, va[0]);
            PG8_BAR; PG8_WAIT_L(0); PG8_MMA(1, 0, At, B0); PG8_BAR; PG8_SCHED;
            PG8_STAGE(PG8_SB(0, 1), b2 + hstep, voffB);
            PG8_WAIT_V(6); PG8_BAR; PG8_MMA(1, 1, At, B1); PG8_BAR;
            PG8_LDB(B0, 1, 0); PG8_SCHED; PG8_LDA(At, 1, 0); PG8_STAGE(PG8_SA(0, 1), a2, va[1]);
            PG8_WAIT_L(8); PG8_BAR; PG8_WAIT_L(0); PG8_MMA(0, 0, At, B0); PG8_BAR; PG8_SCHED;
            PG8_LDB(B1, 1, 1); PG8_STAGE(PG8_SB(1, 0), b3, voffB);
            PG8_BAR; PG8_WAIT_L(0); PG8_MMA(0, 1, At, B1); PG8_BAR;
            PG8_LDA(At, 1, 1); PG8_STAGE(PG8_SA(1, 0), a3, va[0]);
            PG8_BAR; PG8_WAIT_L(0); PG8_MMA(1, 0, At, B0); PG8_BAR; PG8_SCHED;
            PG8_STAGE(PG8_SB(1, 1), b3 + hstep, voffB);
            PG8_WAIT_V(6); PG8_BAR; PG8_MMA(1, 1, At, B1); PG8_BAR;
            }
        }
        if constexpr (ALIGN_EPI) { if (wr == 0) PG8_BAR; }
        E(acc, cur, wr, wc, fr, fq);
        if (!has_next) break;
#pragma unroll
        for (int a = 0; a < 2; ++a)
#pragma unroll
            for (int b = 0; b < 2; ++b)
#pragma unroll
                for (int m = 0; m < 4; ++m)
#pragma unroll
                    for (int n = 0; n < 2; ++n) acc[a][b][m][n] = (f32x4){0.f, 0.f, 0.f, 0.f};
        cur = nxt; cB = nB; ++ui;
        if constexpr (ALIGN_EPI) { if (wr == 1) PG8_BAR; }
    }
    PG8_WAIT_V(0);
    if constexpr (!ALIGN_EPI) { if (wr == 0) PG8_BAR; }
    PG8_BAR;
#undef PG8_SA
#undef PG8_SB
#undef PG8_STAGE
#undef PG8_LDA
#undef PG8_LDB
#undef PG8_MMA
#undef PG8_WAIT_V
#undef PG8_WAIT_L
#undef PG8_BAR
#undef PG8_SCHED
#undef PG8_VOFF
}
}

#define XB_TMO      128
#define XB_XCNT(j)  (256  + 64 * (j))
#define XB_XSUB(j)  (1280 + 64 * (j))
#define XB_XGEN(j)  (2304 + 64 * (j))
#define XB_TOP      3328
#define XB_TOPGEN   3392
#define XCD_BAR_WORDS 3456
#define XB_SPIN_CAP (1u << 18)

__device__ __forceinline__ unsigned xb_ld(unsigned* p)              { return __hip_atomic_load(p, __ATOMIC_RELAXED, __HIP_MEMORY_SCOPE_AGENT); }
__device__ __forceinline__ unsigned xb_add(unsigned* p, unsigned v) { return __hip_atomic_fetch_add(p, v, __ATOMIC_RELAXED, __HIP_MEMORY_SCOPE_AGENT); }
__device__ __forceinline__ unsigned xb_xcc_id() { return (unsigned)__builtin_amdgcn_s_getreg((3 << 11) | 20) & 0xFu; }
#define XB_SPIN(cond, bar) do { unsigned _sp = 0; while (cond) { __builtin_amdgcn_s_sleep(1); \
    if ((++_sp & 255u) == 0u) { if (xb_ld(&(bar)[XB_TMO])) break; if (_sp > XB_SPIN_CAP) { atomicAdd(&(bar)[XB_TMO], 1u); break; } } } } while (0)

struct XcdBarrier {
    unsigned* bar; unsigned x;
    volatile LAS unsigned* st;
};
__device__ __forceinline__ XcdBarrier xcd_barrier_post(unsigned* bar, volatile LAS unsigned* st) {
    XcdBarrier b; b.bar = bar; b.x = xb_xcc_id(); b.st = st;
    if (threadIdx.x == 0) (void)xb_add(&bar[XB_XCNT(b.x)], 1u);
    return b;
}
__device__ __forceinline__ void xcd_barrier_complete(unsigned* bar, unsigned x, unsigned& nloc, unsigned& nx) {
    const unsigned G = gridDim.x * gridDim.y * gridDim.z;
    unsigned sum, cnt, mine, sp = 0u;
    for (;;) {
        sum = 0u; cnt = 0u; mine = 0u;
#pragma unroll
        for (unsigned j = 0; j < 16; ++j) { const unsigned c = xb_ld(&bar[XB_XCNT(j)]); sum += c; cnt += (c > 0u) ? 1u : 0u; mine = (j == x) ? c : mine; }
        if (sum == G) break;
        __builtin_amdgcn_s_sleep(1);
        if ((++sp & 255u) == 0u) { if (xb_ld(&bar[XB_TMO])) break; if (sp > XB_SPIN_CAP) { atomicAdd(&bar[XB_TMO], 1u); break; } }
    }
    nloc = mine > 0u ? mine : 1u; nx = cnt > 0u ? cnt : 1u;
}
__device__ __forceinline__ void xcd_barrier(const XcdBarrier& b) {
    asm volatile("s_waitcnt vmcnt(0)" ::: "memory");
    __syncthreads();
    if (threadIdx.x == 0) {
        unsigned* bar = b.bar;
        __builtin_amdgcn_s_waitcnt(0);
        unsigned nloc = b.st[0], nx = b.st[1];
        if (nloc == 0u) { xcd_barrier_complete(bar, b.x, nloc, nx); b.st[0] = nloc; b.st[1] = nx; }
        const unsigned old = xb_add(&bar[XB_XSUB(b.x)], 1u);
        const unsigned gen = old / nloc;
        if (old + 1u == (gen + 1u) * nloc) {
            __builtin_amdgcn_fence(__ATOMIC_RELEASE, "agent");
            asm volatile("s_waitcnt vmcnt(0)" ::: "memory");
            const unsigned og = xb_add(&bar[XB_TOP], 1u);
            const unsigned tg = og / nx;
            if (og + 1u == (tg + 1u) * nx) xb_add(&bar[XB_TOPGEN], 1u);
            else XB_SPIN(xb_ld(&bar[XB_TOPGEN]) == tg, bar);
            __builtin_amdgcn_fence(__ATOMIC_ACQUIRE, "agent");
            xb_add(&bar[XB_XGEN(b.x)], 1u);
            asm volatile("s_waitcnt vmcnt(0)" ::: "memory");
        } else {
            XB_SPIN(xb_ld(&bar[XB_XGEN(b.x)]) == gen, bar);
            __builtin_amdgcn_fence(__ATOMIC_ACQUIRE, "agent");
            asm volatile("s_waitcnt vmcnt(0)" ::: "memory");
        }
    }
    __syncthreads();
}

constexpr int NWAVES = 8, NTHREADS = 512;
struct Args { const float* in[19]; float* out; unsigned char* ws; int ph_lo, ph_hi; };
enum { I_X = 0, I_META, I_MIXNW, I_WIN, I_CONVW, I_ALOG, I_DTB, I_GDNNW, I_SBQNW, I_SBKNW, I_SBONW, I_WOUT, I_FFNNW, I_RW, I_RB, I_WGU, I_BGU, I_WD, I_BD };

#define LDS_WAIT() asm volatile("s_waitcnt lgkmcnt(0)" ::: "memory")
#define VM_WAIT() asm volatile("s_waitcnt vmcnt(0)" ::: "memory")
constexpr int WLS = 2052;

__device__ __forceinline__ void dot16(const f32x4 (&v)[8], const LAS float* wl, int lane, float (&s)[16]) {
#pragma unroll
    for (int c = 0; c < 16; ++c) { float a = 0.f;
#pragma unroll
        for (int j = 0; j < 8; ++j) { const f32x4 w = *(const LAS f32x4*)(wl + c * WLS + 4 * lane + 256 * j); a += (v[j].x * w.x + v[j].y * w.y) + (v[j].z * w.z + v[j].w * w.w); }
        s[c] = wave_sum(a); }
}

template <int NR> __device__ __forceinline__ void dot8xN(const f32x4 (&v)[NR][8], const LAS float* wl, int lane, float (&out)[NR][8]) {
#pragma unroll
    for (int c = 0; c < 8; ++c) { float a[NR];
#pragma unroll
        for (int k = 0; k < NR; ++k) a[k] = 0.f;
#pragma unroll
        for (int j = 0; j < 8; ++j) { const f32x4 w = *(const LAS f32x4*)(wl + c * WLS + 4 * lane + 256 * j);
#pragma unroll
            for (int k = 0; k < NR; ++k) a[k] += (v[k][j].x * w.x + v[k][j].y * w.y) + (v[k][j].z * w.z + v[k][j].w * w.w); }
#pragma unroll
        for (int k = 0; k < NR; ++k) out[k][c] = wave_sum(a[k]); }
}
__device__ __forceinline__ void stage_w16(LAS float* wl, const float* base, int ld, int coloff, int tid) {
#pragma unroll 4
    for (int idx = tid; idx < 2048 * 4; idx += NTHREADS) { const int k = idx >> 2, q = idx & 3; const f32x4 v = *(const f32x4*)(base + (size_t)k * ld + coloff + 4 * q);
        wl[(4 * q + 0) * WLS + k] = v.x; wl[(4 * q + 1) * WLS + k] = v.y; wl[(4 * q + 2) * WLS + k] = v.z; wl[(4 * q + 3) * WLS + k] = v.w; }
}

__device__ __forceinline__ void p0_rows(const Args& a, LAS unsigned char* lds, int gw, int NGW, int tid, int lane) {
    const float* x = a.in[I_X]; const float* meta = a.in[I_META]; const float* nw = a.in[I_MIXNW]; const float* win = a.in[I_WIN];
    LAS float* wl = (LAS float*)lds;
    stage_w16(wl, win, NPROJ_SRC, 4096, tid);
    __syncthreads();
    bf16_t* HN = (bf16_t*)(a.ws + WS_HN); float* BETA = (float*)(a.ws + WS_BETA); float* GG = (float*)(a.ws + WS_G);
    f32x4 wn[8];
#pragma unroll
    for (int j = 0; j < 8; ++j) wn[j] = *((const f32x4*)nw + lane + 64 * j);
    const int hh = lane & 7;
    const float alog = a.in[I_ALOG][hh], dtb = a.in[I_DTB][hh];
    constexpr int NR0 = 2;
    for (int row0 = gw; row0 < MPAD; row0 += NR0 * NGW) {
        f32x4 v[NR0][8]; float bv[NR0], av[NR0];
        int lane_o = lane; asm volatile("" : "+v"(lane_o));
#pragma unroll
        for (int k = 0; k < NR0; ++k) { const int row = row0 + k * NGW;
            if (row < NTOK) { const int b = row / LSEQ, t = row - b * LSEQ;
                const float* src = (t < NMETA) ? meta + (size_t)t * DM : x + ((size_t)b * SEQ + (t - NMETA)) * DM;
#pragma unroll
                for (int j = 0; j < 8; ++j) v[k][j] = *((const f32x4*)src + lane + 64 * j);
            } else {
#pragma unroll
                for (int j = 0; j < 8; ++j) v[k][j] = (f32x4){0.f, 0.f, 0.f, 0.f}; } }
#pragma unroll
        for (int k = 0; k < NR0; ++k) { const int row = row0 + k * NGW; float ss = 0.f;
#pragma unroll
            for (int j = 0; j < 8; ++j) ss += (v[k][j].x * v[k][j].x + v[k][j].y * v[k][j].y) + (v[k][j].z * v[k][j].z + v[k][j].w * v[k][j].w);
            const float rstd = 1.0f / sqrtf(wave_sum(ss) * (1.0f / DM) + NORM_EPS);
            if (row < MPAD) { GAS unsigned long long* o8 = (GAS unsigned long long*)(HN + (size_t)row * DM) + lane;
#pragma unroll
                for (int j = 0; j < 8; ++j) { v[k][j] = v[k][j] * rstd * wn[j];
                    o8[64 * j] = (unsigned long long)cvt_pk_bf16(v[k][j].x, v[k][j].y) | ((unsigned long long)cvt_pk_bf16(v[k][j].z, v[k][j].w) << 32); } } }
        { float o8[NR0][8]; dot8xN<NR0>(v, wl, lane_o, o8);
#pragma unroll
            for (int k = 0; k < NR0; ++k) { bv[k] = o8[k][0];
#pragma unroll
                for (int c = 1; c < 8; ++c) bv[k] = (hh == c) ? o8[k][c] : bv[k]; }
            dot8xN<NR0>(v, wl + 8 * WLS, lane_o, o8);
#pragma unroll
            for (int k = 0; k < NR0; ++k) { av[k] = o8[k][0];
#pragma unroll
                for (int c = 1; c < 8; ++c) av[k] = (hh == c) ? o8[k][c] : av[k]; } }
#pragma unroll
        for (int k = 0; k < NR0; ++k) { const int row = row0 + k * NGW;
            if (lane < 8 && row < NTOK) {
                const float beta = 1.0f / (1.0f + expf(-bv[k]));
                const float xa = av[k] + dtb; const float sp = fmaxf(xa, 0.f) + log1pf(expf(-fabsf(xa)));
                BETA[(size_t)row * 8 + hh] = beta; GG[(size_t)row * 8 + hh] = -expf(alog) * sp; } }
    }
    __syncthreads();
}

constexpr int CVT_STR = 132;
template <int MODE  >
__device__ __forceinline__ void cvt_tile(const float* W, int ldw, int K, bf16_t* out, int kb, int nt, LAS unsigned char* T, int lane) {
    const int r0 = nt * 64;
    int c0;
    if (MODE == 0) c0 = r0;
    else if (MODE == 1) c0 = r0 < 4096 ? r0 : r0 + 16;
    else { const int pn = r0 >> 8, rr = r0 & 255; c0 = rr < 128 ? 128 * pn + rr : 2048 + 128 * pn + (rr - 128); }
    const int kq = lane >> 4, nl = lane & 15;
    const float* src = W + (size_t)(kb * 64 + 2 * kq) * ldw + c0 + 4 * nl;
    f32x4 v[8][2];
#pragma unroll
    for (int i = 0; i < 8; ++i)
#pragma unroll
        for (int j = 0; j < 2; ++j) v[i][j] = *(const f32x4*)(src + (size_t)(8 * i + j) * ldw);
    LAS unsigned char* tw = T + (4 * nl) * CVT_STR + 4 * kq;
#pragma unroll
    for (int i = 0; i < 8; ++i)
#pragma unroll
        for (int q = 0; q < 4; ++q) *(LAS unsigned*)(tw + q * CVT_STR + 16 * i) = cvt_pk_bf16(v[i][0][q], v[i][1][q]);
    LDS_WAIT();
    const int rn = lane >> 3, cc = lane & 7;
    const LAS unsigned char* tr = T + rn * CVT_STR + 16 * cc;
    bf16_t* dst = out + (size_t)(r0 + rn) * K + kb * 64 + 8 * cc;
#pragma unroll
    for (int j = 0; j < 8; ++j) { u32x4 w; const LAS unsigned* p = (const LAS unsigned*)(tr + 8 * j * CVT_STR); w.x = p[0]; w.y = p[1]; w.z = p[2]; w.w = p[3];
        *(u32x4*)(dst + (size_t)(8 * j) * K) = w; }
    LDS_WAIT();
}
constexpr float W8_SCALE = 64.0f;
template <int MODE>
__device__ __forceinline__ void cvt_tile_fp8(const float* W, int ldw, int K, unsigned char* out, int kb, int nt, LAS unsigned char* T, int lane) {
    const int r0 = nt * 64;
    int c0;
    if (MODE == 0) c0 = r0;
    else { const int pn = r0 >> 8, rr = r0 & 255; c0 = rr < 128 ? 128 * pn + rr : 2048 + 128 * pn + (rr - 128); }
    const int kq = lane >> 4, nl = lane & 15;
    LAS unsigned char* tw = T + (4 * nl) * CVT_STR + 4 * kq;
    const float* src = W + (size_t)(kb * 128 + 4 * kq) * ldw + c0 + 4 * nl;
    f32x4 v[8][4];
#pragma unroll
    for (int i = 0; i < 8; ++i)
#pragma unroll
        for (int j = 0; j < 4; ++j) v[i][j] = *(const f32x4*)(src + (size_t)(16 * i + j) * ldw);
#pragma unroll
    for (int i = 0; i < 8; ++i)
#pragma unroll
        for (int q = 0; q < 4; ++q) *(LAS unsigned*)(tw + q * CVT_STR + 16 * i) =
            pk4_fp8(v[i][0][q] * W8_SCALE, v[i][1][q] * W8_SCALE, v[i][2][q] * W8_SCALE, v[i][3][q] * W8_SCALE);
    LDS_WAIT();
    const int rn = lane >> 3, cc = lane & 7;
    const LAS unsigned char* tr = T + rn * CVT_STR + 16 * cc;
    unsigned char* dst = out + (size_t)(r0 + rn) * K + kb * 128 + 16 * cc;
#pragma unroll
    for (int j = 0; j < 8; ++j) { u32x4 w; const LAS unsigned* p = (const LAS unsigned*)(tr + 8 * j * CVT_STR); w.x = p[0]; w.y = p[1]; w.z = p[2]; w.w = p[3];
        *(u32x4*)(dst + (size_t)(8 * j) * K) = w; }
    LDS_WAIT();
}
__device__ __forceinline__ void p0_weights(const Args& a, LAS unsigned char* lds, int vcu, int G, int wave, int lane) {
    constexpr int I_IN = 32 * 14, I_OUT = 32 * 4;
    constexpr int NITEMS = I_IN + I_OUT;
    LAS unsigned char* T = lds + wave * (64 * CVT_STR);
    for (int it = vcu; it < NITEMS; it += G) {
        int r = it;
        if (r < I_IN) { cvt_tile<1>(a.in[I_WIN], NPROJ_SRC, DM, (bf16_t*)(a.ws + WS_WIN), r / 14, (r % 14) * 8 + wave, T, lane); continue; } r -= I_IN;
        cvt_tile<0>(a.in[I_WOUT], DM, DM, (bf16_t*)(a.ws + WS_WOUT), r / 4, (r % 4) * 8 + wave, T, lane);
    }
}
constexpr int MOE_I_GU = 8 * 4, MOE_I_D = 4 * 4, MOE_ITEMS = NEXP * (MOE_I_GU + MOE_I_D);
__device__ __forceinline__ void moe_weights_queue(const Args& a, LAS unsigned char* lds, LAS int* qslot, int tid, int wave, int lane, int limit) {
    unsigned* ctr = (unsigned*)(a.ws + WS_CTL) + CW_CVTQ;
    LAS unsigned char* T = lds + wave * (64 * CVT_STR);
    for (;;) {
        __syncthreads();
        if (tid == 0) { int v = (int)__hip_atomic_load(ctr, __ATOMIC_RELAXED, __HIP_MEMORY_SCOPE_AGENT); v = (v < limit) ? (int)atomicAdd(ctr, 1u) : MOE_ITEMS; *qslot = v; }
        __syncthreads();
        const int it = *(volatile LAS int*)qslot;
        if (it >= MOE_ITEMS) break;
        if (it < NEXP * MOE_I_GU) { const int e = it / MOE_I_GU, q = it % MOE_I_GU, ng = q >> 2, kq = q & 3;
#pragma unroll 1
            for (int kb = kq * 4; kb < kq * 4 + 4; ++kb)
                cvt_tile_fp8<2>(a.in[I_WGU] + (size_t)e * DM * 2 * DE, 2 * DE, DM, a.ws + WS_WGU + (size_t)e * 2 * DE * DM, kb, ng * 8 + wave, T, lane);
        } else { const int r = it - NEXP * MOE_I_GU, e = r / MOE_I_D, q = r % MOE_I_D, ng = q >> 2, kq = q & 3;
#pragma unroll 1
            for (int kb = kq * 4; kb < kq * 4 + 4; ++kb)
                cvt_tile_fp8<0>(a.in[I_WD] + (size_t)e * DE * DM, DM, DE, a.ws + WS_WD + (size_t)e * DM * DE, kb, ng * 8 + wave, T, lane);
        }
    }
}

__device__ __forceinline__ void p2_qknorm(const Args& a, int gw, int NGW, int lane) {
    const bf16_t* P = (const bf16_t*)(a.ws + WS_P); bf16_t* QN = (bf16_t*)(a.ws + WS_QN); bf16_t* KN = (bf16_t*)(a.ws + WS_KN);
    const float qw0 = a.in[I_SBQNW][2 * lane], qw1 = a.in[I_SBQNW][2 * lane + 1], kw0 = a.in[I_SBKNW][2 * lane], kw1 = a.in[I_SBKNW][2 * lane + 1];
    const float QS = 0.08838834764831845f * 1.4426950408889634f;
    for (int it = gw; it < NTOK * NHEAD * 2; it += NGW) {
        const int which = it & 1, h = (it >> 1) & 7, row = it >> 4;
        const int b = row / LSEQ, t = row - b * LSEQ;
        const unsigned w = *(const unsigned*)(P + (size_t)row * NPROJ + (which ? PC_SBK : PC_SBQ) + h * HD + 2 * lane);
        const float v0 = bf_lo(w), v1 = bf_hi(w);
        const float rstd = 1.0f / sqrtf(wave_sum(v0 * v0 + v1 * v1) * (1.0f / HD) + NORM_EPS);
        const float o0 = which ? v0 * rstd * kw0 : v0 * rstd * qw0 * QS, o1 = which ? v1 * rstd * kw1 : v1 * rstd * qw1 * QS;
        *(unsigned*)((which ? KN : QN) + ((size_t)(b * NHEAD + h) * LROW + t) * HD + 2 * lane) = cvt_pk_bf16(o0, o1);
    }
}

__device__ __forceinline__ void p3_gdn_naive(const Args& a, LAS unsigned char* lds, int item, int tid, int lane, int wave) {
    const int b = item >> 3, h = item & 7;
    const bf16_t* P = (const bf16_t*)(a.ws + WS_P); const float* BETA = (const float*)(a.ws + WS_BETA); const float* GG = (const float*)(a.ws + WS_G);
    float* ORAW = (float*)(a.ws + WS_ORAW); bf16_t* MIX = (bf16_t*)(a.ws + WS_MIX);
    LAS float* buf = (LAS float*)lds;
    const int j = tid >> 2, part = tid & 3;
    const int which = tid >> 7, d = tid & 127; const bool conv = tid < 384;
    const int pcol = which * 1024 + h * HD + d;
    float cw0 = 0, cw1 = 0, cw2 = 0, cw3 = 0;
    if (conv) { const float* cwp = a.in[I_CONVW] + pcol; cw0 = cwp[0]; cw1 = cwp[3072]; cw2 = cwp[2 * 3072]; cw3 = cwp[3 * 3072]; }
    float xm1 = 0.f, xm2 = 0.f, xm3 = 0.f;
    float S[32];
#pragma unroll
    for (int i = 0; i < 32; ++i) S[i] = 0.f;
    const size_t row0 = (size_t)b * LSEQ;
    float xnext = conv ? bf2f(P[row0 * NPROJ + pcol]) : 0.f;
    float bnext = BETA[row0 * 8 + h], gnext = GG[row0 * 8 + h];
    for (int t = 0; t < LSEQ; ++t) {
        const float xt = xnext, beta = bnext, gam = expf(gnext);
        if (t + 1 < LSEQ) { if (conv) xnext = bf2f(P[(row0 + t + 1) * NPROJ + pcol]); bnext = BETA[(row0 + t + 1) * 8 + h]; gnext = GG[(row0 + t + 1) * 8 + h]; }
        LAS float* cb = buf + (t & 1) * 384;
        if (conv) { const float y = cw3 * xt + cw2 * xm1 + cw1 * xm2 + cw0 * xm3; xm3 = xm2; xm2 = xm1; xm1 = xt; cb[tid] = y / (1.0f + expf(-y)); }
        __syncthreads();
        float kk = 0.f, qq = 0.f, dk = 0.f; f32x4 kv[8], qv[8];
#pragma unroll
        for (int i = 0; i < 8; ++i) { kv[i] = *(const LAS f32x4*)(cb + 128 + 32 * part + 4 * i); qv[i] = *(const LAS f32x4*)(cb + 32 * part + 4 * i); }
#pragma unroll
        for (int i = 0; i < 8; ++i)
#pragma unroll
            for (int c = 0; c < 4; ++c) { kk += kv[i][c] * kv[i][c]; qq += qv[i][c] * qv[i][c]; dk += S[4 * i + c] * kv[i][c]; }
        kk += __shfl_xor(kk, 1); kk += __shfl_xor(kk, 2); qq += __shfl_xor(qq, 1); qq += __shfl_xor(qq, 2); dk += __shfl_xor(dk, 1); dk += __shfl_xor(dk, 2);
        const float rk = 1.0f / sqrtf(kk + NORM_EPS), rq = 0.08838834764831845f / sqrtf(qq + NORM_EPS);
        const float vj = cb[256 + j];
        const float vnew = beta * (vj - gam * rk * dk);
        const float kvn = rk * vnew; float oq = 0.f;
#pragma unroll
        for (int i = 0; i < 8; ++i)
#pragma unroll
            for (int c = 0; c < 4; ++c) { S[4 * i + c] = gam * S[4 * i + c] + kv[i][c] * kvn; oq += S[4 * i + c] * qv[i][c]; }
        oq += __shfl_xor(oq, 1); oq += __shfl_xor(oq, 2);
        if (t >= NMETA && part == 0) ORAW[((size_t)b * SEQ + (t - NMETA)) * 1024 + h * HD + j] = rq * oq;
    }
    __threadfence(); __syncthreads();
    const float nw0 = a.in[I_GDNNW][2 * lane], nw1 = a.in[I_GDNNW][2 * lane + 1];
    for (int s = wave; s < SEQ; s += NWAVES) {
        const size_t tok = (size_t)b * SEQ + s;
        const f32x2 o = *(const f32x2*)(ORAW + tok * 1024 + h * HD + 2 * lane);
        const float rstd = 1.0f / sqrtf(wave_sum(o.x * o.x + o.y * o.y) * (1.0f / HD) + NORM_EPS);
        const unsigned zw = *(const unsigned*)(P + (row0 + NMETA + s) * NPROJ + PC_Z + h * HD + 2 * lane);
        const float z0 = bf_lo(zw), z1 = bf_hi(zw);
        const float r0 = o.x * rstd * nw0 * (z0 / (1.0f + expf(-z0))), r1 = o.y * rstd * nw1 * (z1 / (1.0f + expf(-z1)));
        *(unsigned*)(MIX + tok * DM + h * HD + 2 * lane) = cvt_pk_bf16(r0, r1);
    }
}

__device__ __forceinline__ bf16x8 sba_pack8(const f32x16& p, int base) {
    u32x4 w; w.x = cvt_pk_bf16(p[base + 0], p[base + 1]); w.y = cvt_pk_bf16(p[base + 2], p[base + 3]); w.z = cvt_pk_bf16(p[base + 4], p[base + 5]); w.w = cvt_pk_bf16(p[base + 6], p[base + 7]);
    return __builtin_bit_cast(bf16x8, w);
}

namespace gdn {
constexpr int NCH = 65;
constexpr int IMG_W = 0, IMG_QG = 16384, IMG_KDT = 32768, IMG_AT = 49152, IMG_BYTES = 57344, IMG_U = 57344, CH_BYTES = 73728;
constexpr int L_QB = 0, L_KB = 17408, L_VB = 34816, L_LT = 52224, L_GC = 69632, L_BE = 69888, L_IMG = 70144;
__device__ __forceinline__ int afrag_off(int row, int k, int nks) {
    const int rt = row >> 5, rr = row & 31, ks = k >> 4, kk = k & 15, hi = (kk >> 2) & 1, sl = (kk & 3) + 4 * (kk >> 3);
    return ((rt * nks + ks) * 64 + rr + 32 * hi) * 16 + sl * 2;
}
__device__ __forceinline__ int ufrag_off(int i, int c) {
    const int cg = c >> 5, col = c & 31, rt = i >> 5, ii = i & 31, hi = (ii >> 2) & 1, r = (ii & 3) + 4 * (ii >> 3);
    return (((cg * 2 + rt) * 2 + (r >> 3)) * 64 + col + 32 * hi) * 8 + (r & 7);
}
__device__ __forceinline__ int crow(int r, int hi) { return (r & 3) + 8 * (r >> 2) + 4 * hi; }
__device__ __forceinline__ bf16_t f2bf(float f) { return (bf16_t)(cvt_pk_bf16(f, 0.f) & 0xffffu); }

__device__ __forceinline__ void precompute(const Args& a, LAS unsigned char* lds, int item, int tid, int lane, int wave) {
    asm volatile("" : "+v"(tid), "+v"(lane), "+s"(wave));
    const int bh = item / NCH, c = item - bh * NCH, b = bh >> 3, h = bh & 7;
    const bf16_t* P = (const bf16_t*)(a.ws + WS_P) + (size_t)b * LSEQ * NPROJ;
    const float* BETA = (const float*)(a.ws + WS_BETA) + (size_t)b * LSEQ * 8; const float* GG = (const float*)(a.ws + WS_G) + (size_t)b * LSEQ * 8;
    unsigned char* dst = a.ws + WS_GCH + (size_t)item * CH_BYTES;
    LAS float* GC = (LAS float*)(lds + L_GC); LAS float* BE = (LAS float*)(lds + L_BE); LAS float* LT = (LAS float*)(lds + L_LT);
    const int tbase = 64 * c - 48;
    if (wave == 0) {
        const int t = tbase + lane; float g = 0.f, be = 0.f;
        if (t >= 0) { g = GG[(size_t)t * 8 + h]; be = BETA[(size_t)t * 8 + h]; }
#pragma unroll
        for (int o = 1; o < 64; o <<= 1) { const float y = __shfl_up(g, o); if (lane >= o) g += y; }
        GC[lane] = g; BE[lane] = be;
        if (lane == 63) ((float*)(a.ws + WS_GL))[item] = expf(g);
    }
    {
        f32x2 cw[3][4];
#pragma unroll
        for (int w3 = 0; w3 < 3; ++w3)
#pragma unroll
            for (int tap = 0; tap < 4; ++tap) cw[w3][tap] = *(const f32x2*)(a.in[I_CONVW] + tap * 3072 + w3 * 1024 + h * HD + 2 * lane);
        f32x2 xw[3][11];
#pragma unroll
        for (int j = 0; j < 11; ++j) { const int t = tbase + 8 * wave - 3 + j;
#pragma unroll
            for (int w3 = 0; w3 < 3; ++w3) { unsigned u = 0u; if (t >= 0) u = *(const unsigned*)(P + (size_t)t * NPROJ + w3 * 1024 + h * HD + 2 * lane); xw[w3][j] = (f32x2){bf_lo(u), bf_hi(u)}; } }
#pragma unroll
        for (int rr = 0; rr < 8; ++rr) { const int i = 8 * wave + rr; f32x2 y[3];
#pragma unroll
            for (int w3 = 0; w3 < 3; ++w3) { f32x2 acc = cw[w3][0] * xw[w3][rr] + cw[w3][1] * xw[w3][rr + 1] + cw[w3][2] * xw[w3][rr + 2] + cw[w3][3] * xw[w3][rr + 3];
                acc.x = acc.x / (1.0f + __expf(-acc.x)); acc.y = acc.y / (1.0f + __expf(-acc.y)); y[w3] = acc; }
            const float rq = 0.08838834764831845f / sqrtf(wave_sum(y[0].x * y[0].x + y[0].y * y[0].y) + NORM_EPS);
            const float rk = 1.0f / sqrtf(wave_sum(y[1].x * y[1].x + y[1].y * y[1].y) + NORM_EPS);
            *(LAS unsigned*)(lds + L_QB + i * 272 + 4 * lane) = cvt_pk_bf16(y[0].x * rq, y[0].y * rq);
            *(LAS unsigned*)(lds + L_KB + i * 272 + 4 * lane) = cvt_pk_bf16(y[1].x * rk, y[1].y * rk);
            *(LAS unsigned*)(lds + L_VB + i * 272 + 4 * lane) = cvt_pk_bf16(y[2].x, y[2].y); }
    }
    __syncthreads();
    {
        const int prod = wave >> 2, ti = (wave >> 1) & 1, tj = wave & 1, r32 = lane & 31, hi = lane >> 5;
        if (tj <= ti) {
            f32x16 acc;
#pragma unroll
            for (int r = 0; r < 16; ++r) acc[r] = 0.f;
            const LAS unsigned char* Ab = lds + (prod ? L_QB : L_KB) + (32 * ti + r32) * 272 + hi * 16;
            const LAS unsigned char* Bb = lds + L_KB + (32 * tj + r32) * 272 + hi * 16;
#pragma unroll
            for (int ks = 0; ks < 8; ++ks) acc = __builtin_amdgcn_mfma_f32_32x32x16_bf16(*(const LAS bf16x8*)(Ab + ks * 32), *(const LAS bf16x8*)(Bb + ks * 32), acc, 0, 0, 0);
            const int j = 32 * tj + r32; const float gj = GC[j];
#pragma unroll
            for (int r = 0; r < 16; ++r) { const int i = 32 * ti + crow(r, hi); const float dec = __expf(GC[i] - gj);
                if (prod == 0) LT[j * 68 + i] = (j < i) ? acc[r] * BE[i] * dec : 0.f;
                else *(LAS bf16_t*)(lds + L_IMG + IMG_AT + afrag_off(i, j, 4)) = f2bf((j <= i) ? acc[r] * dec : 0.f); }
        }
    }
    __syncthreads();
    if (tid < 256) {
        float x[64];
        const bool isv = tid < 128; const int cc = tid & 127;
        const LAS unsigned char* src = lds + (isv ? L_VB : L_KB) + cc * 2;
#pragma unroll
        for (int i8 = 0; i8 < 64; i8 += 8) {
#pragma unroll
            for (int q = 0; q < 8; ++q) { const int i = i8 + q; const float v = bf2f(*(const LAS bf16_t*)(src + i * 272)); x[i] = v * BE[i] * (isv ? 1.0f : __expf(GC[i])); }
            asm volatile("" ::: "memory"); }
#pragma unroll
        for (int j = 0; j < 63; ++j) {
#pragma unroll
            for (int i4 = ((j + 1) & ~3); i4 < 64; i4 += 4) { const f32x4 l4 = *(const LAS f32x4*)(LT + j * 68 + i4);
#pragma unroll
                for (int q = 0; q < 4; ++q) if (i4 + q > j) x[i4 + q] -= l4[q] * x[j]; }
            asm volatile("" ::: "memory");
        }
        if (isv) {
            LAS unsigned char* ub = lds + L_IMG + IMG_U + (((cc >> 5) * 4 * 64) + (cc & 31)) * 16;
#pragma unroll
            for (int i = 0; i < 64; ++i) { const int rt = i >> 5, ii = i & 31, hi = (ii >> 2) & 1, r = (ii & 3) + 4 * (ii >> 3);
                *(LAS bf16_t*)(ub + (((rt * 2 + (r >> 3)) * 64 + 32 * hi) * 8 + (r & 7)) * 2) = f2bf(x[i]); }
        } else {
            const int ks = cc >> 4, kk = cc & 15, hi = (kk >> 2) & 1, sl = (kk & 3) + 4 * (kk >> 3);
            LAS unsigned char* wb = lds + L_IMG + IMG_W + (ks * 64 + 32 * hi) * 16 + sl * 2;
#pragma unroll
            for (int i = 0; i < 64; ++i) *(LAS bf16_t*)(wb + ((i >> 5) * 8 * 64 + (i & 31)) * 16) = f2bf(-x[i]);
        }
    } else {
        const int u = tid - 256, dk = u & 127, i0 = (u >> 7) * 32; const float gl = GC[63];
#pragma unroll 4
        for (int ii = 0; ii < 32; ++ii) { const int i = i0 + ii; const float gi = GC[i];
            const float q = bf2f(*(const LAS bf16_t*)(lds + L_QB + i * 272 + dk * 2)), k = bf2f(*(const LAS bf16_t*)(lds + L_KB + i * 272 + dk * 2));
            *(LAS bf16_t*)(lds + L_IMG + IMG_QG + afrag_off(i, dk, 8)) = f2bf(q * __expf(gi));
            *(LAS bf16_t*)(lds + L_IMG + IMG_KDT + afrag_off(dk, i, 4)) = f2bf(k * __expf(gl - gi)); }
    }
    __syncthreads();
    for (int q = tid; q < CH_BYTES / 16; q += NTHREADS) *(u32x4*)(dst + (size_t)q * 16) = *(const LAS u32x4*)(lds + L_IMG + q * 16);
}

constexpr int OB_OFF = 2 * IMG_BYTES, OB_STR = 272, OB_BYTES = 64 * OB_STR;
__device__ __forceinline__ void gated_load_z(const Args& a, u32x4 (&zw)[4], int b, int h, int cc, int w4, int lane) {
    const bf16_t* P = (const bf16_t*)(a.ws + WS_P);
    const int s = 64 * (cc - 1) + 16 * w4 + (lane >> 2);
    const u32x4* zp = (const u32x4*)(P + ((size_t)b * LSEQ + NMETA + s) * NPROJ + PC_Z + h * HD + 32 * (lane & 3));
#pragma unroll
    for (int q = 0; q < 4; ++q) zw[q] = zp[q];
}
__device__ __forceinline__ float silu_f(float z) { return z * __builtin_amdgcn_rcpf(1.0f + __expf(-z)); }
__device__ __forceinline__ void gated_rows(const Args& a, const LAS unsigned char* ob, const u32x4 (&zw)[4], int b, int h, int cc, int w4, int lane, const f32x4 (&nwv)[8]) {
    bf16_t* MIX = (bf16_t*)(a.ws + WS_MIX);
    const int row = lane >> 2, qd = lane & 3, s = 64 * (cc - 1) + 16 * w4 + row;
    u32x4 ov[4]; float ss = 0.f;
#pragma unroll
    for (int q = 0; q < 4; ++q) { ov[q] = *(const LAS u32x4*)(ob + (16 * w4 + row) * OB_STR + qd * 64 + q * 16);
#pragma unroll
        for (int e = 0; e < 4; ++e) { const float lo = bf_lo(ov[q][e]), hi = bf_hi(ov[q][e]); ss += lo * lo + hi * hi; } }
    ss = quad_sum(ss);
    const float rstd = __builtin_amdgcn_rsqf(ss * (1.0f / HD) + NORM_EPS);
    u32x4* dst = (u32x4*)(MIX + ((size_t)b * SEQ + s) * DM + h * HD + 32 * qd);
#pragma unroll
    for (int q = 0; q < 4; ++q) { u32x4 w;
#pragma unroll
        for (int e = 0; e < 4; ++e) { const f32x4 nv = nwv[2 * q + (e >> 1)];
            const float n0 = (e & 1) ? nv.z : nv.x, n1 = (e & 1) ? nv.w : nv.y;
            w[e] = cvt_pk_bf16(bf_lo(ov[q][e]) * rstd * n0 * silu_f(bf_lo(zw[q][e])), bf_hi(ov[q][e]) * rstd * n1 * silu_f(bf_hi(zw[q][e]))); }
        dst[q] = w; }
}

__device__ __forceinline__ void scan(const Args& a, LAS unsigned char* lds, int bh, int tid, int lane, int wave) {
    const int b = bh >> 3, h = bh & 7, col = lane & 31, hi = lane >> 5, cg = wave;
    const unsigned char* src = a.ws + WS_GCH + (size_t)bh * NCH * CH_BYTES;
    const float* GL = (const float*)(a.ws + WS_GL) + bh * NCH;
    __syncthreads();
    const unsigned dvoff = (unsigned)(wave * 1024 + lane * 16), uvoff = (unsigned)(lane * 16);
#define GDN_DMA(ch, buf) do { const unsigned char* _sp = src + (size_t)(ch) * CH_BYTES; _Pragma("unroll") for (int _f = 0; _f < 7; ++_f) { \
        __builtin_amdgcn_global_load_lds((const unsigned*)(_sp + _f * 8192 + dvoff), (LAS unsigned*)(lds + (buf) * IMG_BYTES + wave * 1024 + _f * 8192), 16, 0, 0); } } while (0)
    GDN_DMA(0, 0);
#define GDN_STEP_END(vm) do { asm volatile("s_waitcnt vmcnt(" #vm ")" ::: "memory"); asm volatile("s_waitcnt lgkmcnt(0)" ::: "memory"); __builtin_amdgcn_s_barrier(); asm volatile("" ::: "memory"); } while (0)
    if (wave < 4) {
        f32x16 st[4]; bf16x8 Sb[8]; u32x4 ureg[4]; float gl;
#pragma unroll
        for (int t4 = 0; t4 < 4; ++t4)
#pragma unroll
            for (int r = 0; r < 16; ++r) st[t4][r] = 0.f;
#pragma unroll
        for (int ks = 0; ks < 8; ++ks) Sb[ks] = (bf16x8){0, 0, 0, 0, 0, 0, 0, 0};
#pragma unroll
        for (int q = 0; q < 4; ++q) ureg[q] = *(const u32x4*)(src + IMG_U + cg * 4096 + q * 1024 + uvoff);
        gl = GL[0];
        GDN_STEP_END(0);
        for (int c = 0; c < NCH; ++c) {
            const LAS unsigned char* img = lds + (c & 1) * IMG_BYTES + lane * 16;
            asm volatile("" : "+v"(ureg[0]), "+v"(ureg[1]), "+v"(ureg[2]), "+v"(ureg[3]), "+v"(gl));
            if (c + 1 < NCH) GDN_DMA(c + 1, (c + 1) & 1);
            f32x16 vn[2]; const float glc = gl;
#pragma unroll
            for (int rt = 0; rt < 2; ++rt)
#pragma unroll
                for (int rh = 0; rh < 2; ++rh) { const u32x4 w = ureg[rt * 2 + rh];
                    vn[rt][8 * rh + 0] = bf_lo(w.x); vn[rt][8 * rh + 1] = bf_hi(w.x); vn[rt][8 * rh + 2] = bf_lo(w.y); vn[rt][8 * rh + 3] = bf_hi(w.y);
                    vn[rt][8 * rh + 4] = bf_lo(w.z); vn[rt][8 * rh + 5] = bf_hi(w.z); vn[rt][8 * rh + 6] = bf_lo(w.w); vn[rt][8 * rh + 7] = bf_hi(w.w); }
            asm volatile("" ::: "memory");
            if (c + 1 < NCH) {
#pragma unroll
                for (int q = 0; q < 4; ++q) ureg[q] = *(const u32x4*)(src + (size_t)(c + 1) * CH_BYTES + IMG_U + cg * 4096 + q * 1024 + uvoff);
                gl = GL[c + 1]; }
#pragma unroll
            for (int rt = 0; rt < 2; ++rt) { __builtin_amdgcn_sched_barrier(0);
#pragma unroll
                for (int ks = 0; ks < 8; ++ks) vn[rt] = __builtin_amdgcn_mfma_f32_32x32x16_bf16(*(const LAS bf16x8*)(img + IMG_W + (rt * 8 + ks) * 1024), Sb[ks], vn[rt], 0, 0, 0); }
            __builtin_amdgcn_sched_barrier(0);
            bf16x8 vb[4];
#pragma unroll
            for (int ks = 0; ks < 4; ++ks) vb[ks] = sba_pack8(vn[ks >> 1], 8 * (ks & 1));
            LAS unsigned char* obw = lds + OB_OFF + (c & 1) * OB_BYTES + (32 * cg + col) * 2;
#pragma unroll
            for (int rt = 0; rt < 2; ++rt) { f32x16 o; __builtin_amdgcn_sched_barrier(0);
#pragma unroll
                for (int r = 0; r < 16; ++r) o[r] = 0.f;
#pragma unroll
                for (int ks = 0; ks < 8; ++ks) o = __builtin_amdgcn_mfma_f32_32x32x16_bf16(*(const LAS bf16x8*)(img + IMG_QG + (rt * 8 + ks) * 1024), Sb[ks], o, 0, 0, 0);
#pragma unroll
                for (int ks = 0; ks < 2 * (rt + 1); ++ks) o = __builtin_amdgcn_mfma_f32_32x32x16_bf16(*(const LAS bf16x8*)(img + IMG_AT + (rt * 4 + ks) * 1024), vb[ks], o, 0, 0, 0);
                if (c >= 1) {
#pragma unroll
                    for (int r = 0; r < 16; ++r) *(LAS bf16_t*)(obw + (32 * rt + crow(r, hi)) * OB_STR) = f2bf(o[r]); }
            }
#pragma unroll
            for (int t4 = 0; t4 < 4; ++t4) { __builtin_amdgcn_sched_barrier(0);
#pragma unroll
                for (int r = 0; r < 16; ++r) st[t4][r] *= glc;
#pragma unroll
                for (int ks = 0; ks < 4; ++ks) st[t4] = __builtin_amdgcn_mfma_f32_32x32x16_bf16(*(const LAS bf16x8*)(img + IMG_KDT + (t4 * 4 + ks) * 1024), vb[ks], st[t4], 0, 0, 0);
                Sb[2 * t4] = sba_pack8(st[t4], 0); Sb[2 * t4 + 1] = sba_pack8(st[t4], 8); }
            if (c + 1 < NCH) GDN_STEP_END(5); else GDN_STEP_END(0);
        }
    } else {
        u32x4 zA[4], zB[4]; f32x4 nwv[8];
#pragma unroll
        for (int q = 0; q < 4; ++q) { zA[q] = (u32x4){0u, 0u, 0u, 0u}; zB[q] = (u32x4){0u, 0u, 0u, 0u}; }
#pragma unroll
        for (int q = 0; q < 8; ++q) nwv[q] = *(const f32x4*)(a.in[I_GDNNW] + 32 * (lane & 3) + 4 * q);
        GDN_STEP_END(0);
        for (int c = 0; c < NCH; ++c) {
#pragma unroll
            for (int q = 0; q < 4; ++q) asm volatile("" : "+v"(zA[q]), "+v"(zB[q]));
            if (c + 1 < NCH) GDN_DMA(c + 1, (c + 1) & 1);
            if (c >= 1) { if (c & 1) gated_load_z(a, zA, b, h, c, wave - 4, lane); else gated_load_z(a, zB, b, h, c, wave - 4, lane); }
            asm volatile("" ::: "memory");
            if (c >= 2) { if (c & 1) gated_rows(a, lds + OB_OFF + ((c - 1) & 1) * OB_BYTES, zB, b, h, c - 1, wave - 4, lane, nwv);
                          else gated_rows(a, lds + OB_OFF + ((c - 1) & 1) * OB_BYTES, zA, b, h, c - 1, wave - 4, lane, nwv); }
            if (c >= 2) GDN_STEP_END(4); else GDN_STEP_END(0);
        }
        gated_rows(a, lds + OB_OFF + ((NCH - 1) & 1) * OB_BYTES, zB, b, h, NCH - 1, wave - 4, lane, nwv);
    }
#undef GDN_STEP_END
#undef GDN_DMA
}
}

namespace sba {
#define KSWZ(row, colB) ((row) * 256 + ((colB) ^ (((row) & 7) << 4)))
__device__ __forceinline__ int v_st(int k, int c) { const int kk = (k & ~0xC) | ((k & 4) << 1) | ((k & 8) >> 1); return ((kk >> 3) * 4 + (c >> 5)) * 512 + ((kk & 7) * 32 + (c & 31)) * 2; }
__device__ __forceinline__ int v_rd_base(int lane) { return ((lane & 3) << 3) | (((lane >> 2) & 3) << 6) | (((lane >> 4) & 1) << 5) | (((lane >> 5) & 1) << 8); }
constexpr int v_rd_off(int d0, int ks, int half) { return d0 * 512 + ks * 4096 + half * 2048; }
template <int OFF> __device__ __forceinline__ s16x4 tr_read(int vb) { s16x4 r; asm volatile("ds_read_b64_tr_b16 %0, %1 offset:%2" : "=&v"(r) : "v"(vb), "i"(OFF) : "memory"); return r; }
template <int D0> __device__ __forceinline__ void pv_one(f32x16& od, int vb, bf16x8 pa0, bf16x8 pa1, bf16x8 pa2, bf16x8 pa3) {
    const s16x4 l0 = tr_read<v_rd_off(D0, 0, 0)>(vb), h0 = tr_read<v_rd_off(D0, 0, 1)>(vb), l1 = tr_read<v_rd_off(D0, 1, 0)>(vb), h1 = tr_read<v_rd_off(D0, 1, 1)>(vb);
    const s16x4 l2 = tr_read<v_rd_off(D0, 2, 0)>(vb), h2 = tr_read<v_rd_off(D0, 2, 1)>(vb), l3 = tr_read<v_rd_off(D0, 3, 0)>(vb), h3 = tr_read<v_rd_off(D0, 3, 1)>(vb);
    asm volatile("s_waitcnt lgkmcnt(0)" ::: "memory"); __builtin_amdgcn_sched_barrier(0);
#define PK(L, H) (bf16x8){L[0], L[1], L[2], L[3], H[0], H[1], H[2], H[3]}
    od = __builtin_amdgcn_mfma_f32_32x32x16_bf16(pa0, PK(l0, h0), od, 0, 0, 0);
    od = __builtin_amdgcn_mfma_f32_32x32x16_bf16(pa1, PK(l1, h1), od, 0, 0, 0);
    od = __builtin_amdgcn_mfma_f32_32x32x16_bf16(pa2, PK(l2, h2), od, 0, 0, 0);
    od = __builtin_amdgcn_mfma_f32_32x32x16_bf16(pa3, PK(l3, h3), od, 0, 0, 0);
#undef PK
}
__device__ __forceinline__ int crow(int r, int hi) { return (r & 3) + 8 * (r >> 2) + 4 * hi; }
__device__ __forceinline__ int swap34(int k) { return (k & ~0x18) | ((k & 8) << 1) | ((k & 16) >> 1); }
__device__ __forceinline__ bf16x8 pack8(const f32x16& p, int base) {
    u32x4 w; w.x = cvt_pk_bf16(p[base + 0], p[base + 1]); w.y = cvt_pk_bf16(p[base + 2], p[base + 3]); w.z = cvt_pk_bf16(p[base + 4], p[base + 5]); w.w = cvt_pk_bf16(p[base + 6], p[base + 7]);
    return __builtin_bit_cast(bf16x8, w);
}
constexpr float SB_EXIT = 160.0f;

__device__ __forceinline__ void unit(const Args& a, LAS unsigned char* lds, volatile LAS int* done_cnt, int b, int h, int qb, int tid, int lane, int wid) {
    const bf16_t* QN = (const bf16_t*)(a.ws + WS_QN) + (size_t)(b * NHEAD + h) * LROW * HD;
    const bf16_t* KN = (const bf16_t*)(a.ws + WS_KN) + (size_t)(b * NHEAD + h) * LROW * HD;
    const bf16_t* Vp = (const bf16_t*)(a.ws + WS_P) + (size_t)b * LSEQ * NPROJ + PC_SBV + h * HD;
    bf16_t* MIX = (bf16_t*)(a.ws + WS_MIX);
    const int r32 = lane & 31, hi = lane >> 5;
    LAS unsigned char* K_lds = lds; LAS unsigned char* V_lds = lds + 16384;
    const int tq0 = NMETA + 256 * qb + 32 * wid, tq = tq0 + r32;
    __syncthreads();
    if (tid == 0) *done_cnt = 0;
    bf16x8 qr[8];
#pragma unroll
    for (int d0 = 0; d0 < 8; ++d0) qr[d0] = *(const bf16x8*)(QN + (size_t)tq * HD + d0 * 16 + hi * 8);
    const int sr = tid >> 4, sc = (tid & 15) * 8;
    const int vst0 = v_st(swap34(sr), sc), vst1 = v_st(32 + swap34(sr), sc);
    const int kst0 = KSWZ(sr, sc * 2), kst1 = KSWZ(32 + sr, sc * 2);
    const int vb0 = (int)(unsigned)(unsigned long)V_lds + v_rd_base(lane);
    const int prow = (r32 & 3) + 4 * (r32 >> 3) + 16 * ((r32 >> 2) & 1);
    f32x16 o[4];
#pragma unroll
    for (int d = 0; d < 4; ++d)
#pragma unroll
        for (int r = 0; r < 16; ++r) o[d][r] = 0.f;
    float carry = 0.f; bool flagged = false;
    for (int kt = 4 * qb + 4; kt >= 0; --kt) {
        const int k0 = 64 * kt;
        const bf16x8 ks0 = *(const bf16x8*)(KN + (size_t)(k0 + sr) * HD + sc), ks1 = *(const bf16x8*)(KN + (size_t)(k0 + 32 + sr) * HD + sc);
        const bf16x8 vs0 = *(const bf16x8*)(Vp + (size_t)(k0 + sr) * NPROJ + sc), vs1 = *(const bf16x8*)(Vp + (size_t)(k0 + 32 + sr) * NPROJ + sc);
        __syncthreads();
        if (*done_cnt == NWAVES) break;
        *(LAS bf16x8*)(K_lds + kst0) = ks0; *(LAS bf16x8*)(K_lds + kst1) = ks1; *(LAS bf16x8*)(V_lds + vst0) = vs0; *(LAS bf16x8*)(V_lds + vst1) = vs1;
        __syncthreads();
        if (k0 >= tq0 + 32) continue;
        f32x16 p0, p1;
#pragma unroll
        for (int r = 0; r < 16; ++r) { p0[r] = 0.f; p1[r] = 0.f; }
#pragma unroll
        for (int d0 = 0; d0 < 8; ++d0) { const int cb = (d0 * 16 + hi * 8) * 2;
            const bf16x8 b0 = *(const LAS bf16x8*)(K_lds + KSWZ(prow, cb)), b1 = *(const LAS bf16x8*)(K_lds + KSWZ(32 + prow, cb));
            p0 = __builtin_amdgcn_mfma_f32_32x32x16_bf16(b0, qr[d0], p0, 0, 0, 0);
            p1 = __builtin_amdgcn_mfma_f32_32x32x16_bf16(b1, qr[d0], p1, 0, 0, 0); }
        const bool need_mask = (k0 + 63 >= tq0);
        f32x16 s0, s1; float t0 = 0.f, t1 = 0.f;
#pragma unroll
        for (int r = 0; r < 16; ++r) {
            float e0 = __builtin_amdgcn_exp2f(p0[r]), e1 = __builtin_amdgcn_exp2f(p1[r]);
            float q0 = __builtin_amdgcn_logf(1.0f + e0), q1 = __builtin_amdgcn_logf(1.0f + e1);
            if (need_mask) { const bool v0 = (k0 + 16 * hi + r) < tq, v1 = (k0 + 32 + 16 * hi + r) < tq; e0 = v0 ? e0 : 0.f; q0 = v0 ? q0 : 0.f; e1 = v1 ? e1 : 0.f; q1 = v1 ? q1 : 0.f; }
            p0[r] = e0; p1[r] = e1; s0[r] = q0; s1[r] = q1; t0 += q0; t1 += q1; }
        float t1lo, t1hi, t0lo, t0hi;
        { auto rr = __builtin_amdgcn_permlane32_swap(__float_as_uint(t1), __float_as_uint(t1), false, false); t1lo = __uint_as_float(rr[0]); t1hi = __uint_as_float(rr[1]); }
        { auto rr = __builtin_amdgcn_permlane32_swap(__float_as_uint(t0), __float_as_uint(t0), false, false); t0lo = __uint_as_float(rr[0]); t0hi = __uint_as_float(rr[1]); }
        float run1 = carry + (hi ? 0.f : t1hi), run0 = carry + (t1lo + t1hi) + (hi ? 0.f : t0hi);
#pragma unroll
        for (int r = 15; r >= 0; --r) { run1 += s1[r]; p1[r] = p1[r] * __builtin_amdgcn_exp2f(-run1); run0 += s0[r]; p0[r] = p0[r] * __builtin_amdgcn_exp2f(-run0); }
        carry += (t1lo + t1hi) + (t0lo + t0hi);
        const bf16x8 pa0 = pack8(p0, 0), pa1 = pack8(p0, 8), pa2 = pack8(p1, 0), pa3 = pack8(p1, 8);
        pv_one<0>(o[0], vb0, pa0, pa1, pa2, pa3); pv_one<1>(o[1], vb0, pa0, pa1, pa2, pa3); pv_one<2>(o[2], vb0, pa0, pa1, pa2, pa3); pv_one<3>(o[3], vb0, pa0, pa1, pa2, pa3);
        if (!flagged && __all(carry >= SB_EXIT)) { flagged = true; if (lane == 0) (void)__hip_atomic_fetch_add((LAS int*)done_cnt, 1, __ATOMIC_RELAXED, __HIP_MEMORY_SCOPE_WORKGROUP); }
    }
    const float* onw = a.in[I_SBONW];
    float wv[4];
#pragma unroll
    for (int d0 = 0; d0 < 4; ++d0) wv[d0] = onw[32 * d0 + r32];
#pragma unroll
    for (int r = 0; r < 16; ++r) {
        float ss = (o[0][r] * o[0][r] + o[1][r] * o[1][r]) + (o[2][r] * o[2][r] + o[3][r] * o[3][r]);
        ss = row16_sum(ss); ss += __shfl_xor(ss, 16);
        const float rstd = 1.0f / sqrtf(ss * (1.0f / HD) + NORM_EPS);
        const size_t tok = (size_t)b * SEQ + (tq0 - NMETA) + crow(r, hi);
        bf16_t* dst = MIX + tok * DM + 1024 + h * HD + r32;
#pragma unroll
        for (int d0 = 0; d0 < 4; ++d0) dst[32 * d0] = (bf16_t)(cvt_pk_bf16(o[d0][r] * rstd * wv[d0], 0.f) & 0xffffu);
    }
}
}

__device__ __forceinline__ void p5_router(const Args& a, LAS unsigned char* lds, int G, int c, int tid, int lane, int wave) {
    LAS float* wl = (LAS float*)lds;
    LAS float* lg = (LAS float*)(lds + 132096);
    LAS int* misc = (LAS int*)(lds + MISC_OFF);
    const float* H1 = a.out; const float* rw = a.in[I_RW]; const float* rb = a.in[I_RB];
    unsigned char* HN2 = a.ws + WS_HN;
    int* RE = (int*)(a.ws + WS_RE); int* RP = (int*)(a.ws + WS_RP); float* RG = (float*)(a.ws + WS_RG); int* LIST = (int*)(a.ws + WS_LIST);
    unsigned* ecnt = (unsigned*)(a.ws + WS_CTL) + CW_ECNT;
    f32x4 wn[8];
#pragma unroll
    for (int j = 0; j < 8; ++j) wn[j] = *((const f32x4*)a.in[I_FFNNW] + lane + 64 * j);
    for (int blk = c; blk < NREAL / 64; blk += G) {
        for (int pass = 0; pass < 2; ++pass) {
            __syncthreads();
            stage_w16(wl, rw, NEXP, pass * 16, tid);
            if (pass == 0 && tid < 32) misc[40 + tid] = 0;
            __syncthreads();
            for (int rg = 0; rg < 4; ++rg) {
                f32x4 v[2][8];
#pragma unroll
                for (int k = 0; k < 2; ++k) { const size_t row = (size_t)blk * 64 + wave * 8 + rg * 2 + k;
#pragma unroll
                    for (int j = 0; j < 8; ++j) v[k][j] = *((const f32x4*)(H1 + row * DM) + lane + 64 * j); }
#pragma unroll
                for (int k = 0; k < 2; ++k) { const size_t row = (size_t)blk * 64 + wave * 8 + rg * 2 + k; float ss = 0.f;
#pragma unroll
                    for (int j = 0; j < 8; ++j) ss += (v[k][j].x * v[k][j].x + v[k][j].y * v[k][j].y) + (v[k][j].z * v[k][j].z + v[k][j].w * v[k][j].w);
                    const float rstd = 1.0f / sqrtf(wave_sum(ss) * (1.0f / DM) + NORM_EPS);
                    GAS unsigned* o4 = (GAS unsigned*)(HN2 + row * DM) + lane;
#pragma unroll
                    for (int j = 0; j < 8; ++j) { v[k][j] = v[k][j] * rstd * wn[j];
                        if (pass == 0) o4[64 * j] = pk4_fp8(v[k][j].x, v[k][j].y, v[k][j].z, v[k][j].w); } }
#pragma unroll
                for (int hf = 0; hf < 2; ++hf) { float o8[2][8]; dot8xN<2>(v, wl + hf * 8 * WLS, lane, o8);
#pragma unroll
                    for (int k = 0; k < 2; ++k) { float sv = o8[k][0];
#pragma unroll
                        for (int c = 1; c < 8; ++c) sv = ((lane & 7) == c) ? o8[k][c] : sv;
                        if (lane < 8) lg[(wave * 8 + rg * 2 + k) * 33 + pass * 16 + hf * 8 + lane] = sv; } }
            }
        }
        __syncthreads();
        int ek[4] = {0, 0, 0, 0}, rk[4] = {0, 0, 0, 0}; float gk[4] = {0.f, 0.f, 0.f, 0.f};
        if (tid < 64) {
            float v[32];
#pragma unroll
            for (int e = 0; e < 32; ++e) v[e] = lg[tid * 33 + e] + rb[e];
            float val[4];
#pragma unroll
            for (int k = 0; k < 4; ++k) { float best = -3.0e38f; int bi = 0;
#pragma unroll
                for (int e = 0; e < 32; ++e) { const bool gt = v[e] > best; best = gt ? v[e] : best; bi = gt ? e : bi; }
#pragma unroll
                for (int e = 0; e < 32; ++e) v[e] = (e == bi) ? -3.0e38f : v[e];
                ek[k] = bi; val[k] = best; }
            float den = 0.f;
#pragma unroll
            for (int k = 0; k < 4; ++k) { gk[k] = expf(val[k] - val[0]); den += gk[k]; }
#pragma unroll
            for (int k = 0; k < 4; ++k) { gk[k] = gk[k] / den; rk[k] = __hip_atomic_fetch_add(&misc[40 + ek[k]], 1, __ATOMIC_RELAXED, __HIP_MEMORY_SCOPE_WORKGROUP); }
        }
        __syncthreads();
        if (tid < 32) { const int cnt = misc[40 + tid]; misc[72 + tid] = cnt ? (int)atomicAdd(&ecnt[tid], (unsigned)cnt) : 0; }
        __syncthreads();
        if (tid < 64) { const int tok = blk * 64 + tid;
#pragma unroll
            for (int k = 0; k < 4; ++k) { const int pos = misc[72 + ek[k]] + rk[k]; LIST[(size_t)ek[k] * NREAL + pos] = tok; RE[tok * 4 + k] = ek[k]; RP[tok * 4 + k] = pos; RG[tok * 4 + k] = gk[k]; } }
    }
    __syncthreads();
}

__device__ __forceinline__ int moe_setup(const Args& a, LAS int* misc, int tid) {
    const unsigned* ecnt = (const unsigned*)(a.ws + WS_CTL) + CW_ECNT;
    __syncthreads();
    if (tid == 0) { int acc = 0;
        for (int e = 0; e < NEXP; ++e) { const int cnt = (int)__hip_atomic_load(ecnt + e, __ATOMIC_RELAXED, __HIP_MEMORY_SCOPE_AGENT); misc[104 + e] = cnt; misc[e] = acc; acc += (cnt + 255) >> 8; }
        misc[32] = acc; }
    __syncthreads();
    return misc[32];
}

__device__ __forceinline__ void p8_combine(const Args& a, const LAS int* misc, int gw, int NGW, int lane) {
    const int* RE = (const int*)(a.ws + WS_RE); const int* RP = (const int*)(a.ws + WS_RP); const float* RG = (const float*)(a.ws + WS_RG);
    const bf16_t* Y = (const bf16_t*)(a.ws + WS_Y); const float* bd = a.in[I_BD]; float* out = a.out;
    for (int row = gw; row < NREAL; row += NGW) {
        int e[4]; size_t slot[4]; float g[4];
#pragma unroll
        for (int k = 0; k < 4; ++k) { e[k] = RE[row * 4 + k]; slot[k] = (size_t)misc[e[k]] * 256 + RP[row * 4 + k]; g[k] = RG[row * 4 + k]; }
#pragma unroll
        for (int j = 0; j < 4; ++j) { const int col = 8 * lane + 512 * j;
            f32x4 a0 = *(const f32x4*)(out + (size_t)row * DM + col), a1 = *(const f32x4*)(out + (size_t)row * DM + col + 4);
#pragma unroll
            for (int k = 0; k < 4; ++k) { const u32x4 y = *(const u32x4*)(Y + slot[k] * DM + col);
                const f32x4 b0 = *(const f32x4*)(bd + (size_t)e[k] * DM + col), b1 = *(const f32x4*)(bd + (size_t)e[k] * DM + col + 4);
                a0.x += g[k] * (bf_lo(y.x) + b0.x); a0.y += g[k] * (bf_hi(y.x) + b0.y); a0.z += g[k] * (bf_lo(y.y) + b0.z); a0.w += g[k] * (bf_hi(y.y) + b0.w);
                a1.x += g[k] * (bf_lo(y.z) + b1.x); a1.y += g[k] * (bf_hi(y.z) + b1.y); a1.z += g[k] * (bf_lo(y.w) + b1.z); a1.w += g[k] * (bf_hi(y.w) + b1.w); }
            *(f32x4*)(out + (size_t)row * DM + col) = a0; *(f32x4*)(out + (size_t)row * DM + col + 4) = a1; }
    }
}

__device__ __forceinline__ void p1_meta_rows(const Args& a, LAS unsigned char* lds, int bx, int G, int tid, int wave, int lane) {
    const bf16_t* HN = (const bf16_t*)(a.ws + WS_HN); const bf16_t* WT = (const bf16_t*)(a.ws + WS_WIN); bf16_t* P = (bf16_t*)(a.ws + WS_P);
    for (int q = tid; q < NMETA * DM * 2 / 16; q += NTHREADS) *(LAS u32x4*)(lds + q * 16) = *(const u32x4*)((const unsigned char*)HN + (size_t)q * 16);
    __syncthreads();
    for (int col = bx + G * wave; col < NPROJ; col += G * NWAVES) {
        u32x4 w[4]; int lane_o = lane; asm volatile("" : "+v"(lane_o));
#pragma unroll
        for (int j = 0; j < 4; ++j) w[j] = *(const u32x4*)(WT + (size_t)col * DM + 8 * lane + 512 * j);
        float v = 0.f;
#pragma unroll 1
        for (int t = 0; t < NMETA; ++t) { float s = 0.f;
#pragma unroll
            for (int j = 0; j < 4; ++j) { const u32x4 x = *(const LAS u32x4*)(lds + t * (DM * 2) + (8 * lane_o + 512 * j) * 2);
                s += bf_lo(x.x) * bf_lo(w[j].x) + bf_hi(x.x) * bf_hi(w[j].x) + bf_lo(x.y) * bf_lo(w[j].y) + bf_hi(x.y) * bf_hi(w[j].y)
                   + bf_lo(x.z) * bf_lo(w[j].z) + bf_hi(x.z) * bf_hi(w[j].z) + bf_lo(x.w) * bf_lo(w[j].w) + bf_hi(x.w) * bf_hi(w[j].w); }
            s = wave_sum(s);
            v = ((lane & 15) == t) ? s : v; }
        P[((size_t)(lane >> 4) * LSEQ + (lane & 15)) * NPROJ + col] = gdn::f2bf(v);
    }
    __syncthreads();
}

constexpr int NPH = 9;
__global__ void __launch_bounds__(NTHREADS, 2) hymba_fwd(Args args) {
    extern __shared__ __attribute__((aligned(16))) unsigned char lds_raw[];
    LAS unsigned char* lds = (LAS unsigned char*)lds_raw;
    LAS int* misc = (LAS int*)(lds + MISC_OFF);
    const int tid = threadIdx.x, lane = tid & 63, wave = __builtin_amdgcn_readfirstlane(tid >> 6);
    const int G = gridDim.x, bx = blockIdx.x;
    const int vcu = (G % 8 == 0) ? (bx % 8) * (G / 8) + bx / 8 : bx;
    const int gw = vcu * NWAVES + wave, NGW = G * NWAVES;
    unsigned* ctl = (unsigned*)(args.ws + WS_CTL);
    for (int u = tid; u < 256; u += NTHREADS) misc[u] = 0;
    __syncthreads();
    XcdBarrier bar; bar.bar = ctl + CW_BAR; bar.x = 0; bar.st = nullptr;
    const int lo = args.ph_lo, hi = args.ph_hi;
    const int NCV = 0, GG = G - NCV;
    constexpr int CVT_LIMIT_P1 = 0, CVT_LIMIT_P2 = MOE_ITEMS * 35 / 100, CVT_LIMIT_P3 = MOE_ITEMS;
    if (hi - lo > 1) bar = xcd_barrier_post(ctl + CW_BAR, (volatile LAS unsigned*)(misc + 200));
#ifdef ONLY
#define IN(k) ((k) == ONLY && lo <= (k) && (k) < hi)
#else
#define IN(k) (lo <= (k) && (k) < hi)
#endif
#ifndef REP_COUNT
#define REP_COUNT 2
#endif
#define REPEAT(k) _Pragma("unroll") for (int _r = 0; _r < ((REP_PHASE == (k)) ? REP_COUNT : 1); ++_r)
#define SEAM(k) do { if (IN(k) && IN((k) + 1)) xcd_barrier(bar); if (PROBE_A >= 0 && tid == 0) tsl[(k) + 1] = __builtin_amdgcn_s_memrealtime(); } while (0)

    LAS unsigned long long* tsl = (LAS unsigned long long*)(lds + MISC_OFF + 896);
    if (PROBE_A >= 0 && tid == 0) tsl[0] = __builtin_amdgcn_s_memrealtime();
    if (IN(0)) REPEAT(0) { p0_rows(args, lds, gw, NGW, tid, lane); p0_weights(args, lds, vcu, G, wave, lane); }
    SEAM(0);
    if (IN(1)) REPEAT(1) {
        p1_meta_rows(args, lds, bx, G, tid, wave, lane);
        if (bx < GG) {
        pg8::PlainOrder S; S.init(NREAL, NPROJ, DM, args.ws + WS_WIN, GG, bx); S.meta = 1;
        pg8::EpiBf16 E{(bf16_t*)(args.ws + (_r ? WS_ACT : WS_P)), NPROJ, 1};
        pg8::gemm_phase<pg8::EpiBf16, pg8::PlainOrder, true, true>(lds, (const char*)(args.ws + WS_HN), DM * 2, S, E);
        } else moe_weights_queue(args, lds, misc + 212, tid, wave, lane, CVT_LIMIT_P1);
    }
    SEAM(1);
    if (IN(2)) REPEAT(2) {
        p2_qknorm(args, gw, NGW, lane);
#if GDN_CHUNKED
        const bool roleB = (G >= 128) && (bx >= G - G / 8 * 3);
        if (roleB) moe_weights_queue(args, lds, misc + 212, tid, wave, lane, CVT_LIMIT_P2);
        for (;;) {
            __syncthreads();
            if (tid == 0) misc[213] = (int)atomicAdd(ctl + CW_PREQ, 1u);
            __syncthreads();
            const int it = *(volatile LAS int*)(misc + 213);
            if (it >= 32 * gdn::NCH) break;
            gdn::precompute(args, lds, it, tid, lane, wave);
        }
        if (!roleB) moe_weights_queue(args, lds, misc + 212, tid, wave, lane, CVT_LIMIT_P2);
#endif
    }
    SEAM(2);
    if (IN(3)) REPEAT(3) {
        const int NG = (G >= 64) ? 32 : 0;
#if GDN_CHUNKED
        if (bx < 32 || NG == 0) { for (int it = bx; it < 32; it += G) gdn::scan(args, lds, it, tid, lane, wave); }
#else
        if (bx < 32 || NG == 0) { for (int it = bx; it < 32; it += G) p3_gdn_naive(args, lds, it, tid, lane, wave); }
#endif
        if (bx >= NG) { for (int u = bx - NG; u < 512; u += G - NG) sba::unit(args, lds, (volatile LAS int*)(misc + 210), u >> 7, (u >> 4) & 7, u & 15, tid, lane, wave); }
        if (_r == 0) moe_weights_queue(args, lds, misc + 212, tid, wave, lane, NCV ? CVT_LIMIT_P3 : MOE_ITEMS);
    }
    SEAM(3);
    if (IN(4)) REPEAT(4) {
        pg8::PlainOrder S; S.init(NREAL, DM, DM, args.ws + WS_WOUT, G, bx);
        pg8::EpiResF32 E{args.in[I_X], _r ? (float*)(args.ws + WS_ACT) : args.out, DM};
        pg8::gemm_phase<pg8::EpiResF32, pg8::PlainOrder, true, true>(lds, (const char*)(args.ws + WS_MIX), DM * 2, S, E);
    }
    SEAM(4);
    if (IN(5)) p5_router(args, lds, G, bx, tid, lane, wave);
    SEAM(5);
    if (IN(6)) REPEAT(6) {
        if (bx >= GG) moe_weights_queue(args, lds, misc + 212, tid, wave, lane, MOE_ITEMS);
        else {
        const int mt = moe_setup(args, misc, tid);
        pg8::MoeOrder<true> S; S.tpre = misc; S.tok = (const LAS int*)(lds + TOK_OFF); S.nN = 16; S.nwg = mt * 16; S.G = GG; S.c = bx;
        S.Bt = (const char*)(args.ws + WS_WGU); S.estride = (size_t)2 * DE * DM; S.K2 = DM;
        const int* LIST = (const int*)(args.ws + WS_LIST);
        S.ud = misc + 140; S.fill_units(misc + 140, tid);
        __syncthreads();
        for (int idx = tid; idx < TOK_CAP * 256; idx += NTHREADS) { pg8::Unit u; if (!S.next(idx >> 8, u)) break;
            const int r = (u.pm - misc[u.e]) * 256 + (idx & 255); ((LAS int*)(lds + TOK_OFF))[idx] = r < misc[104 + u.e] ? LIST[(size_t)u.e * NREAL + r] : 0; }
        __syncthreads();
        pg8::EpiSwiGLU E{args.ws + WS_ACT, args.in[I_BGU]};
        pg8::gemm_phase<pg8::EpiSwiGLU, pg8::MoeOrder<true>, true, true, true>(lds, (const char*)(args.ws + WS_HN), DM, S, E);
        }
    }
    SEAM(6);
    if (IN(7)) REPEAT(7) {
        const int mt = moe_setup(args, misc, tid);
        pg8::MoeOrder<false> S; S.tpre = misc; S.tok = nullptr; S.nN = 8; S.nwg = mt * 8; S.G = G; S.c = bx;
        S.Bt = (const char*)(args.ws + WS_WD); S.estride = (size_t)DM * DE; S.K2 = DE;
        S.ud = misc + 140; S.fill_units(misc + 140, tid);
        __syncthreads();
        pg8::EpiBf16 E{(bf16_t*)(args.ws + (_r ? WS_WGU : WS_Y)), DM, 0};
        pg8::gemm_phase<pg8::EpiBf16, pg8::MoeOrder<false>, true, true, true>(lds, (const char*)(args.ws + WS_ACT), DE, S, E);
    }
    SEAM(7);
    if (IN(8)) { (void)moe_setup(args, misc, tid); p8_combine(args, misc, gw, NGW, lane); }
#if PROBE_A >= 0
    __syncthreads();
    if (tid == 0) tsl[9] = __builtin_amdgcn_s_memrealtime();
    __syncthreads();
    {
        const int pa = PROBE_A;
        const float us = (float)(pa == 9 ? (tsl[9] - tsl[0]) : (tsl[pa + 1] - tsl[pa])) * 1e-2f;
        const float f = 1.0f - 0.05f * us / (float)(PROBE_REF_US);
        VM_WAIT();
        for (int row = gw; row < NREAL; row += NGW) {
#pragma unroll
            for (int j = 0; j < 8; ++j) { f32x4* p = (f32x4*)(args.out + (size_t)row * DM) + lane + 64 * j; *p = *p * f; } }
    }
#endif
#undef IN
#undef SEAM
}

extern "C" void kernel_launch(void* const* d_in, const int* in_sizes, int n_in, void* d_out, int out_size, void* d_ws, size_t ws_size, hipStream_t stream) {
    static int grid = 0;
    if (grid == 0) {
        if (n_in != 19 || out_size != NREAL * DM || ws_size < WS_END) { fprintf(stderr, "kernel_launch: unexpected shapes (n_in %d out %d ws %zu need %zu)\n", n_in, out_size, ws_size, (size_t)WS_END); grid = -1; return; }
        int dev = 0, cus = 0, per_cu = 0;
        if (hipGetDevice(&dev) != hipSuccess || hipDeviceGetAttribute(&cus, hipDeviceAttributeMultiprocessorCount, dev) != hipSuccess) { grid = -1; return; }
        if (hipFuncSetAttribute((const void*)hymba_fwd, hipFuncAttributeMaxDynamicSharedMemorySize, LDS_BYTES) != hipSuccess) { fprintf(stderr, "kernel_launch: hipFuncSetAttribute failed\n"); grid = -1; return; }
        if (hipOccupancyMaxActiveBlocksPerMultiprocessor(&per_cu, (const void*)hymba_fwd, NTHREADS, LDS_BYTES) != hipSuccess || per_cu < 1) { fprintf(stderr, "kernel_launch: occupancy query says %d\n", per_cu); grid = -1; return; }
        (void)hipGetLastError();
        grid = cus;
    }
    if (grid < 0) return;
    (void)hipMemsetAsync((char*)d_ws + WS_CTL, 0, CTL_ZERO_BYTES, stream);
    Args a{};
    for (int i = 0; i < 19; ++i) a.in[i] = (const float*)d_in[i];
    a.out = (float*)d_out; a.ws = (unsigned char*)d_ws;
#if MK_N_LAUNCHES == 1
    a.ph_lo = 0; a.ph_hi = NPH;
    hipLaunchKernelGGL(hymba_fwd, dim3(grid), dim3(NTHREADS), LDS_BYTES, stream, a);
#else
    for (int p = 0; p < NPH; ++p) { a.ph_lo = p; a.ph_hi = p + 1; hipLaunchKernelGGL(hymba_fwd, dim3(grid), dim3(NTHREADS), LDS_BYTES, stream, a); }
#endif
    const hipError_t le = hipPeekAtLastError();
    if (le != hipSuccess) fprintf(stderr, "kernel_launch: launch failed: %s\n", hipGetErrorName(le));
}
```

```cpp
#include <hip/hip_runtime.h>
#include <cstdio>
#include <cstdint>

#ifndef GDN_CHUNKED
#define GDN_CHUNKED 1
#endif
#ifndef REP_PHASE
#define REP_PHASE -1
#endif
#ifndef PROBE_A
#define PROBE_A -1
#endif
#ifndef PROBE_REF_US
#define PROBE_REF_US 500
#endif
#ifndef MK_N_LAUNCHES
#define MK_N_LAUNCHES 1
#endif

constexpr int NB = 4, SEQ = 4096, NMETA = 16, LSEQ = SEQ + NMETA;
constexpr int DM = 2048, NTOK = NB * LSEQ  , MPAD = 16640  , NREAL = NB * SEQ  ;
constexpr int NPROJ_SRC = 7184, NPROJ = 7168;
constexpr int NHEAD = 8, HD = 128;
constexpr int PC_QKV = 0, PC_Z = 3072, PC_SBQ = 4096, PC_SBK = 5120, PC_SBV = 6144;
constexpr int NEXP = 32, TOPK = 4, DE = 2048;
constexpr int SLOT_ROWS = 73728;
constexpr int LROW = 4224;
constexpr float NORM_EPS = 1e-6f;

constexpr size_t MiB = 1u << 20;
constexpr size_t WS_CTL = 0, CTL_ZERO_BYTES = 1 * MiB;
constexpr size_t WS_WIN = 1 * MiB;
constexpr size_t WS_WOUT = WS_WIN + (size_t)NPROJ * DM * 2;
constexpr size_t WS_WGU = WS_WOUT + (size_t)DM * DM * 2;
constexpr size_t WS_WD = WS_WGU + (size_t)NEXP * 2 * DE * DM * 2;
constexpr size_t WS_HN = WS_WD + (size_t)NEXP * DM * DE * 2;
constexpr size_t WS_BETA = WS_HN + (size_t)MPAD * DM * 2;
constexpr size_t WS_G = WS_BETA + (size_t)NTOK * 8 * 4 + 256;
constexpr size_t WS_P = WS_G + (size_t)NTOK * 8 * 4 + 256;
constexpr size_t WS_QN = WS_P + (size_t)MPAD * NPROJ * 2;
constexpr size_t WS_KN = WS_QN + (size_t)NB * NHEAD * LROW * HD * 2;
constexpr size_t WS_ORAW = WS_KN + (size_t)NB * NHEAD * LROW * HD * 2;
constexpr size_t WS_MIX = WS_ORAW + (size_t)NREAL * 1024 * 4;
constexpr size_t WS_RE = WS_MIX + (size_t)NREAL * DM * 2;
constexpr size_t WS_RP = WS_RE + (size_t)NREAL * 4 * 4;
constexpr size_t WS_RG = WS_RP + (size_t)NREAL * 4 * 4;
constexpr size_t WS_LIST = WS_RG + (size_t)NREAL * 4 * 4;
constexpr size_t WS_ACT = WS_LIST + (size_t)NEXP * NREAL * 4;
constexpr size_t WS_Y = WS_ACT + (size_t)SLOT_ROWS * DE * 2;
constexpr size_t WS_GCH = WS_Y + (size_t)SLOT_ROWS * DM * 2;
constexpr size_t WS_GL = WS_GCH + (size_t)32 * 65 * 73728;
constexpr size_t WS_END = WS_GL + 32 * 65 * 4 + 256;
constexpr int CW_ECNT = 64;
constexpr int CW_CVTQ = 192;
constexpr int CW_PREQ = 256;
constexpr int CW_BAR = 4096;

constexpr int LDS_STAGE = 131072;
constexpr int TOK_OFF = LDS_STAGE, TOK_CAP = 22;
constexpr int MISC_OFF = TOK_OFF + TOK_CAP * 256 * 4;
constexpr int LDS_BYTES = MISC_OFF + 1024;

#define GAS __attribute__((address_space(1)))
#define LAS __attribute__((address_space(3)))
typedef unsigned short bf16_t;
typedef short bf16x8 __attribute__((ext_vector_type(8)));
typedef short s16x4 __attribute__((ext_vector_type(4)));
typedef float f32x4 __attribute__((ext_vector_type(4)));
typedef float f32x2 __attribute__((ext_vector_type(2)));
typedef float f32x16 __attribute__((ext_vector_type(16)));
typedef unsigned u32x4 __attribute__((ext_vector_type(4)));
typedef unsigned u32x2 __attribute__((ext_vector_type(2)));

typedef __bf16 bf16x2_t __attribute__((ext_vector_type(2)));
__device__ __forceinline__ unsigned cvt_pk_bf16(float lo, float hi) { const f32x2 v = {lo, hi}; const bf16x2_t b = __builtin_convertvector(v, bf16x2_t); return __builtin_bit_cast(unsigned, b); }
__device__ __forceinline__ unsigned pk4_fp8(float a, float b, float c, float d) { unsigned w = 0u; w = __builtin_amdgcn_cvt_pk_fp8_f32(a, b, w, false); w = __builtin_amdgcn_cvt_pk_fp8_f32(c, d, w, true); return w; }
__device__ __forceinline__ float bf_lo(unsigned w) { return __uint_as_float(w << 16); }
__device__ __forceinline__ float bf_hi(unsigned w) { return __uint_as_float(w & 0xffff0000u); }
__device__ __forceinline__ float bf2f(bf16_t b) { return __uint_as_float(((unsigned)b) << 16); }
template <int CTRL, int ROW_MASK> __device__ __forceinline__ float dpp_get(float v) {
    return __builtin_bit_cast(float, __builtin_amdgcn_update_dpp(0, __builtin_bit_cast(int, v), CTRL, ROW_MASK, 0xF, false));
}
__device__ __forceinline__ float row16_sum(float v) {
    v += dpp_get<0xB1, 0xF>(v);
    v += dpp_get<0x4E, 0xF>(v);
    v += dpp_get<0x141, 0xF>(v);
    v += dpp_get<0x140, 0xF>(v);
    return v;
}
__device__ __forceinline__ float quad_sum(float v) { v += dpp_get<0xB1, 0xF>(v); v += dpp_get<0x4E, 0xF>(v); return v; }
__device__ __forceinline__ float wave_sum(float v) {
    v = row16_sum(v);
    v += dpp_get<0x142, 0xA>(v);
    v += dpp_get<0x143, 0xC>(v);
    return __builtin_bit_cast(float, __builtin_amdgcn_readlane(__builtin_bit_cast(int, v), 63));
}

namespace pg8 {
constexpr int BM = 256, BK = 64, HALF = 128, HTB = HALF * BK * 2, STAGE_BYTES = 8 * HTB, NXCD = 8, WGM = 8;
__host__ __device__ __forceinline__ int lds_byte(int r, int c) { const int st = (r >> 4) * 2 + (c >> 5), rr = r & 15, cc = c & 31, ob = rr * 64 + cc * 2; return st * 1024 + (ob ^ (((ob >> 9) & 1) << 5)); }
__host__ __device__ __forceinline__ void stage_rc(int b, int& R, int& C) { const int st = b / 1024, sb = b % 1024, swz = sb ^ (((sb >> 9) & 1) << 5); R = (st >> 1) * 16 + swz / 64; C = (st & 1) * 32 + (swz % 64) / 2; }
__host__ __device__ __forceinline__ int perm32(int rho) { const int n = rho >> 4, i = rho & 15; return 8 * (i >> 2) + 4 * n + (i & 3); }

typedef int v8i __attribute__((ext_vector_type(8))); typedef int v4i __attribute__((ext_vector_type(4)));
__device__ __forceinline__ v8i cat8(bf16x8 lo, bf16x8 hi) { const v4i a = __builtin_bit_cast(v4i, lo), b = __builtin_bit_cast(v4i, hi); return __builtin_shufflevector(a, b, 0, 1, 2, 3, 4, 5, 6, 7); }
struct Unit { int pm, pn, e, ui; };

__device__ __forceinline__ int xcd_remap(int L, int nwg) { const int q = nwg / NXCD, r = nwg % NXCD, xcd = L % NXCD, off = L / NXCD; return (xcd < r ? xcd * (q + 1) : r * (q + 1) + (xcd - r) * q) + off; }

struct PlainOrder {
    int nM, nN, nwg, G, c; const char* Bt; unsigned K2;
    __device__ void init(int M, int N, int K, const void* Bt_, int G_, int c_) { nM = M / BM; nN = N / BM; nwg = nM * nN; G = G_; c = c_; Bt = (const char*)Bt_; K2 = (unsigned)K * 2u; }
    __device__ __forceinline__ bool next(int i, Unit& u) const {
        const long L = (long)i * G + c; if (L >= nwg) return false;
        const int wgid = xcd_remap((int)L, nwg);
        const int nig = WGM * nN, gid = wgid / nig, fm = gid * WGM, gsz = (nM - fm) < WGM ? (nM - fm) : WGM;
        u.pm = fm + ((wgid % nig) % gsz); u.pn = (wgid % nig) / gsz; u.e = 0; u.ui = i; return true;
    }
    __device__ __forceinline__ const char* b_ptr(const Unit& u) const { return Bt + (size_t)u.pn * BM * K2; }
    __device__ __forceinline__ unsigned a_off(const Unit& u, int r) const { return (unsigned)(u.pm * BM + r + (meta ? NMETA * ((u.pm >> 4) + 1) : 0)) * K2; }
    int meta = 0;
};
constexpr int UD_CAP = 24;
template <bool GATHER> struct MoeOrder {
    const LAS int* tpre; const LAS int* tok; const LAS int* ud; int nN, nwg, G, c; const char* Bt; size_t estride; unsigned K2;
    __device__ __forceinline__ int decode(int i) const {
        const long L = (long)i * G + c; if (L >= nwg) return -1;
        const int wgid = xcd_remap((int)L, nwg);
        int e = 0;
#pragma unroll 1
        for (int j = 1; j < NEXP; ++j) e = (wgid >= tpre[j] * nN) ? j : e;
        const int t0 = tpre[e], nt = tpre[e + 1] - t0, loc = wgid - t0 * nN;
        return e | ((t0 + loc % nt) << 6) | ((loc / nt) << 16);
    }
    __device__ __forceinline__ void fill_units(LAS int* udw, int tid) const { if (tid < UD_CAP) udw[tid] = decode(tid); }
    __device__ __forceinline__ bool next(int i, Unit& u) const {
        if (i >= UD_CAP) return false;
        const int d = ud[i]; if (d < 0) return false;
        u.e = d & 63; u.pm = (d >> 6) & 1023; u.pn = d >> 16; u.ui = i; return true;
    }
    __device__ __forceinline__ const char* b_ptr(const Unit& u) const { return Bt + (size_t)u.e * estride + (size_t)u.pn * BM * K2; }
    __device__ __forceinline__ unsigned a_off(const Unit& u, int r) const {
        if (GATHER) return (unsigned)tok[u.ui * 256 + r] * K2;
        return (unsigned)(u.pm * BM + r) * K2;
    }
};

struct EpiBf16 {
    static constexpr bool PERM = true;
    bf16_t* O; int ldc; int meta;
    __device__ __forceinline__ void operator()(const f32x4 (&acc)[2][2][4][2], const Unit& u, int wr, int wc, int fr, int fq) const {
        const int row0 = u.pm * BM + wr * 64 + fr + (meta ? NMETA * ((u.pm >> 4) + 1) : 0), col0 = u.pn * BM + wc * 32 + 8 * fq;
#pragma unroll
        for (int ai = 0; ai < 2; ++ai)
#pragma unroll
            for (int m = 0; m < 4; ++m) { bf16_t* rowp = O + (size_t)(row0 + ai * HALF + m * 16) * ldc + col0;
#pragma unroll
                for (int bj = 0; bj < 2; ++bj) { const f32x4 v0 = acc[ai][bj][m][0], v1 = acc[ai][bj][m][1];
                    u32x4 w; w.x = cvt_pk_bf16(v0[0], v0[1]); w.y = cvt_pk_bf16(v0[2], v0[3]); w.z = cvt_pk_bf16(v1[0], v1[1]); w.w = cvt_pk_bf16(v1[2], v1[3]);
                    *(u32x4*)(rowp + bj * HALF) = w; } }
    }
};
struct EpiResF32 {
    static constexpr bool PERM = false;
    const float* X; float* out; int ldc;
    __device__ __forceinline__ void operator()(const f32x4 (&acc)[2][2][4][2], const Unit& u, int wr, int wc, int fr, int fq) const {
        const int row0 = u.pm * BM + wr * 64 + fr, col0 = u.pn * BM + wc * 32 + 4 * fq;
#pragma unroll
        for (int ai = 0; ai < 2; ++ai) {
            f32x4 xv[4][2][2];
#pragma unroll
            for (int m = 0; m < 4; ++m) { const size_t off = (size_t)(row0 + ai * HALF + m * 16) * ldc + col0;
#pragma unroll
                for (int bj = 0; bj < 2; ++bj)
#pragma unroll
                    for (int n = 0; n < 2; ++n) xv[m][bj][n] = *(const f32x4*)(X + off + bj * HALF + n * 16); }
#pragma unroll
            for (int m = 0; m < 4; ++m) { const size_t off = (size_t)(row0 + ai * HALF + m * 16) * ldc + col0;
#pragma unroll
                for (int bj = 0; bj < 2; ++bj)
#pragma unroll
                    for (int n = 0; n < 2; ++n) *(f32x4*)(out + off + bj * HALF + n * 16) = xv[m][bj][n] + acc[ai][bj][m][n]; }
            asm volatile("" ::: "memory"); }
    }
};
__device__ __forceinline__ float swiglu1(float g, float uu) {
    g = fminf(g, 7.0f); uu = fminf(fmaxf(uu, -7.0f), 7.0f);
    const float sg = __builtin_amdgcn_rcpf(1.0f + __builtin_amdgcn_exp2f(-1.702f * 1.4426950408889634f * g));
    return (uu + 1.0f) * g * sg;
}
struct EpiSwiGLU {
    static constexpr bool PERM = true;
    unsigned char* act; const float* bgu;
    __device__ __forceinline__ void operator()(const f32x4 (&acc)[2][2][4][2], const Unit& u, int wr, int wc, int fr, int fq) const {
        const int row0 = u.pm * BM + wr * 64 + fr, col0 = u.pn * HALF + wc * 32 + 8 * fq;
        const float* bg = bgu + (size_t)u.e * 4096 + col0;
        const f32x4 bg0 = *(const f32x4*)(bg), bg1 = *(const f32x4*)(bg + 4), bu0 = *(const f32x4*)(bg + 2048), bu1 = *(const f32x4*)(bg + 2052);
#pragma unroll
        for (int ai = 0; ai < 2; ++ai)
#pragma unroll
            for (int m = 0; m < 4; ++m) { unsigned char* rowp = act + (size_t)(row0 + ai * HALF + m * 16) * DE + col0;
                const f32x4 g0 = acc[ai][0][m][0] + bg0, g1 = acc[ai][0][m][1] + bg1, u0 = acc[ai][1][m][0] + bu0, u1 = acc[ai][1][m][1] + bu1;
                u32x2 w; w.x = pk4_fp8(swiglu1(g0[0], u0[0]), swiglu1(g0[1], u0[1]), swiglu1(g0[2], u0[2]), swiglu1(g0[3], u0[3]));
                w.y = pk4_fp8(swiglu1(g1[0], u1[0]), swiglu1(g1[1], u1[1]), swiglu1(g1[2], u1[2]), swiglu1(g1[3], u1[3]));
                *(u32x2*)rowp = w; }
    }
};

template <class Epi, class Sched, bool ALIGN_EPI, bool SP2, bool FP8 = false>
__device__ __forceinline__ void gemm_phase(LAS unsigned char* lds, const char* A0, int Kb, const Sched& S, const Epi& E) {
    const int tid = threadIdx.x, wid = __builtin_amdgcn_readfirstlane(tid >> 6), lane = tid & 63, wr = wid >> 2, wc = wid & 3, fr = lane & 15, fq = lane >> 4;
    const int nt = Kb / 128;
    int Rr[2], Cc[2]; unsigned voffB[2];
#pragma unroll
    for (int i = 0; i < 2; ++i) { int R, C; stage_rc(tid * 16 + i * 8192, R, C); const int Rb = Epi::PERM ? ((R & ~31) + perm32(R & 31)) : R;
        Rr[i] = R; Cc[i] = C * 2; voffB[i] = (unsigned)(Rb * Kb + C * 2); }
    const size_t kstep = (size_t)(BK * 2);
    const size_t hstep = (size_t)HALF * Kb;
    const unsigned ldsw = (unsigned)wid * 1024u;
    const int aoff = lds_byte(wr * 64 + fr, fq * 8), boff = lds_byte(wc * 32 + fr, fq * 8);
#define PG8_SA(b, h) (((b) * 2 + (h)) * HTB)
#define PG8_SB(b, h) ((4 + (b) * 2 + (h)) * HTB)
#define PG8_STAGE(bufoff, gbase, voff) do { _Pragma("unroll") for (int _i = 0; _i < 2; ++_i) \
        __builtin_amdgcn_global_load_lds((const unsigned*)((const char*)(gbase) + (voff)[_i]), (LAS unsigned*)(lds + (bufoff) + ldsw + _i * 8192), 16, 0, 0); } while (0)
#define PG8_LDA(dst, b, h) do { _Pragma("unroll") for (int m = 0; m < 4; ++m) _Pragma("unroll") for (int k = 0; k < 2; ++k) dst[m][k] = *(const LAS bf16x8*)(lds + PG8_SA(b, h) + aoff + m * 2048 + k * 1024); } while (0)
#define PG8_LDB(dst, b, h) do { _Pragma("unroll") for (int n = 0; n < 2; ++n) _Pragma("unroll") for (int k = 0; k < 2; ++k) dst[n][k] = *(const LAS bf16x8*)(lds + PG8_SB(b, h) + boff + n * 2048 + k * 1024); } while (0)
#define PG8_MMA(ai, bj, At, Bt) do { __builtin_amdgcn_s_setprio(1); _Pragma("unroll") for (int m = 0; m < 4; ++m) _Pragma("unroll") for (int n = 0; n < 2; ++n) { \
        if constexpr (FP8) acc[ai][bj][m][n] = __builtin_amdgcn_mfma_scale_f32_16x16x128_f8f6f4(cat8(Bt[n][0], Bt[n][1]), cat8(At[m][0], At[m][1]), acc[ai][bj][m][n], 0, 0, 0, 0x79797979, 0, 0x7f7f7f7f); \
        else { _Pragma("unroll") for (int k = 0; k < 2; ++k) acc[ai][bj][m][n] = __builtin_amdgcn_mfma_f32_16x16x32_bf16(Bt[n][k], At[m][k], acc[ai][bj][m][n], 0, 0, 0); } } \
        __builtin_amdgcn_s_setprio(0); } while (0)
#define PG8_WAIT_V(n) asm volatile("s_waitcnt vmcnt(" #n ")" ::: "memory")
#define PG8_WAIT_L(n) asm volatile("s_waitcnt lgkmcnt(" #n ")" ::: "memory")
#define PG8_BAR __builtin_amdgcn_s_barrier()
#define PG8_SCHED __builtin_amdgcn_sched_barrier(0)
#define PG8_VOFF(dst, u) do { _Pragma("unroll") for (int _h = 0; _h < 2; ++_h) _Pragma("unroll") for (int _i = 0; _i < 2; ++_i) dst[_h][_i] = S.a_off(u, _h * HALF + Rr[_i]) + (unsigned)Cc[_i]; } while (0)
    Unit cur, nxt; int ui = 0;
    if (!S.next(0, cur)) return;
    f32x4 acc[2][2][4][2];
#pragma unroll
    for (int a = 0; a < 2; ++a)
#pragma unroll
        for (int b = 0; b < 2; ++b)
#pragma unroll
            for (int m = 0; m < 4; ++m)
#pragma unroll
                for (int n = 0; n < 2; ++n) acc[a][b][m][n] = (f32x4){0.f, 0.f, 0.f, 0.f};
    bf16x8 At[4][2], B0[2][2], B1[2][2];
    unsigned va[2][2], vn[2][2];
    PG8_VOFF(va, cur);
    const char* cB = S.b_ptr(cur);
    if constexpr (SP2) {
        PG8_STAGE(PG8_SB(0, 0), cB, voffB); PG8_STAGE(PG8_SB(0, 1), cB + hstep, voffB); PG8_STAGE(PG8_SA(0, 0), A0, va[0]); PG8_STAGE(PG8_SA(0, 1), A0, va[1]);
        if (wr == 1) PG8_BAR;
        PG8_WAIT_V(2); PG8_BAR;
        PG8_STAGE(PG8_SB(1, 0), cB + kstep, voffB); PG8_STAGE(PG8_SA(1, 0), A0 + kstep, va[0]); PG8_STAGE(PG8_SB(1, 1), cB + hstep + kstep, voffB);
        PG8_WAIT_V(6); PG8_BAR;
    } else {
        PG8_STAGE(PG8_SB(0, 0), cB, voffB); PG8_STAGE(PG8_SA(0, 0), A0, va[0]); PG8_STAGE(PG8_SB(0, 1), cB + hstep, voffB); PG8_STAGE(PG8_SA(0, 1), A0, va[1]);
        if (wr == 1) PG8_BAR;
        PG8_WAIT_V(4); PG8_BAR;
        PG8_STAGE(PG8_SB(1, 0), cB + kstep, voffB); PG8_STAGE(PG8_SA(1, 0), A0 + kstep, va[0]); PG8_STAGE(PG8_SB(1, 1), cB + hstep + kstep, voffB);
        PG8_WAIT_V(6); PG8_BAR;
    }
    for (;;) {
        const bool has_next = S.next(ui + 1, nxt);
        const char* nB = has_next ? S.b_ptr(nxt) : cB;
        for (int t = 0; t < nt; t += 2) {
            const bool last = (t == nt - 2);
            const char* a1 = A0 + (size_t)(t + 1) * kstep;
            const char* a2 = last ? A0 : A0 + (size_t)(t + 2) * kstep; const char* b2 = last ? nB : cB + (size_t)(t + 2) * kstep;
            const char* a3 = a2 + kstep; const char* b3 = b2 + kstep;
            if (last) { if (has_next) { PG8_VOFF(vn, nxt); } else {
#pragma unroll
                    for (int _h = 0; _h < 2; ++_h)
#pragma unroll
                        for (int _i = 0; _i < 2; ++_i) vn[_h][_i] = va[_h][_i]; } }
            if constexpr (SP2) {
            PG8_LDB(B0, 0, 0); PG8_LDB(B1, 0, 1); PG8_SCHED; PG8_LDA(At, 0, 0); PG8_STAGE(PG8_SA(1, 1), a1, va[1]);
            if (last) {
#pragma unroll
                for (int _h = 0; _h < 2; ++_h)
#pragma unroll
                    for (int _i = 0; _i < 2; ++_i) va[_h][_i] = vn[_h][_i]; }
            PG8_WAIT_V(8); PG8_WAIT_L(0); PG8_BAR; PG8_MMA(0, 0, At, B0); PG8_MMA(0, 1, At, B1); PG8_BAR; PG8_SCHED;
            PG8_LDA(At, 0, 1); PG8_STAGE(PG8_SB(0, 0), b2, voffB); PG8_STAGE(PG8_SB(0, 1), b2 + hstep, voffB); PG8_STAGE(PG8_SA(0, 0), a2, va[0]);
            PG8_WAIT_V(8); PG8_WAIT_L(0); PG8_BAR; PG8_MMA(1, 0, At, B0); PG8_MMA(1, 1, At, B1); PG8_BAR; PG8_SCHED;
            PG8_LDB(B0, 1, 0); PG8_LDB(B1, 1, 1); PG8_SCHED; PG8_LDA(At, 1, 0); PG8_STAGE(PG8_SA(0, 1), a2, va[1]);
            PG8_WAIT_V(8); PG8_WAIT_L(0); PG8_BAR; PG8_MMA(0, 0, At, B0); PG8_MMA(0, 1, At, B1); PG8_BAR; PG8_SCHED;
            PG8_LDA(At, 1, 1); PG8_STAGE(PG8_SB(1, 0), b3, voffB); PG8_STAGE(PG8_SB(1, 1), b3 + hstep, voffB); PG8_STAGE(PG8_SA(1, 0), a3, va[0]);
            PG8_WAIT_V(8); PG8_WAIT_L(0); PG8_BAR; PG8_MMA(1, 0, At, B0); PG8_MMA(1, 1, At, B1); PG8_BAR; PG8_SCHED;
            } else {
            PG8_LDB(B0, 0, 0); PG8_SCHED; PG8_LDA(At, 0, 0); PG8_STAGE(PG8_SA(1, 1), a1, va[1]);
            if (last) {
#pragma unroll
                for (int _h = 0; _h < 2; ++_h)
#pragma unroll
                    for (int _i = 0; _i < 2; ++_i) va[_h][_i] = vn[_h][_i]; }
            PG8_WAIT_L(8); PG8_BAR; PG8_WAIT_L(0); PG8_MMA(0, 0, At, B0); PG8_BAR; PG8_SCHED;
            PG8_LDB(B1, 0, 1); PG8_STAGE(PG8_SB(0, 0), b2, voffB);
            PG8_BAR; PG8_WAIT_L(0); PG8_MMA(0, 1, At, B1); PG8_BAR;
            PG8_LDA(At, 0, 1); PG8_STAGE(PG8_SA(0, 0), a2, va[0]);
            PG8_BAR; PG8_WAIT_L(0); PG8_MMA(1, 0, At, B0); PG8_BAR; PG8_SCHED;
            PG8_STAGE(PG8_SB(0, 1), b2 + hstep, voffB);
            PG8_WAIT_V(6); PG8_BAR; PG8_MMA(1, 1, At, B1); PG8_BAR;
            PG8_LDB(B0, 1, 0); PG8_SCHED; PG8_LDA(At, 1, 0); PG8_STAGE(PG8_SA(0, 1), a2, va[1]);
            PG8_WAIT_L(8); PG8_BAR; PG8_WAIT_L(0); PG8_MMA(0, 0, At, B0); PG8_BAR; PG8_SCHED;
            PG8_LDB(B1, 1, 1); PG8_STAGE(PG8_SB(1, 0), b3, voffB);
            PG8_BAR; PG8_WAIT_L(0); PG8_MMA(0, 1, At, B1); PG8_BAR;
            PG8_LDA(At, 1, 1); PG8_STAGE(PG8_SA(1, 0), a3, va[0]);
            PG8_BAR; PG8_WAIT_L(0); PG8_MMA(1, 0, At, B0); PG8_BAR; PG8_SCHED;
            PG8_STAGE(PG8_SB(1, 1), b3 + hstep, voffB);
            PG8_WAIT_V(6); PG8_BAR; PG8_MMA(1, 1, At, B1); PG8_BAR;
            }
        }
        if constexpr (ALIGN_EPI) { if (wr == 0) PG8_BAR; }
        E(acc, cur, wr, wc, fr, fq);
        if (!has_next) break;
#pragma unroll
        for (int a = 0; a < 2; ++a)
#pragma unroll
            for (int b = 0; b < 2; ++b)
#pragma unroll
                for (int m = 0; m < 4; ++m)
#pragma unroll
                    for (int n = 0; n < 2; ++n) acc[a][b][m][n] = (f32x4){0.f, 0.f, 0.f, 0.f};
        cur = nxt; cB = nB; ++ui;
        if constexpr (ALIGN_EPI) { if (wr == 1) PG8_BAR; }
    }
    PG8_WAIT_V(0);
    if constexpr (!ALIGN_EPI) { if (wr == 0) PG8_BAR; }
    PG8_BAR;
#undef PG8_SA
#undef PG8_SB
#undef PG8_STAGE
#undef PG8_LDA
#undef PG8_LDB
#undef PG8_MMA
#undef PG8_WAIT_V
#undef PG8_WAIT_L
#undef PG8_BAR
#undef PG8_SCHED
#undef PG8_VOFF
}
}

#define XB_TMO      128
#define XB_XCNT(j)  (256  + 64 * (j))
#define XB_XSUB(j)  (1280 + 64 * (j))
#define XB_XGEN(j)  (2304 + 64 * (j))
#define XB_TOP      3328
#define XB_TOPGEN   3392
#define XCD_BAR_WORDS 3456
#define XB_SPIN_CAP (1u << 18)

__device__ __forceinline__ unsigned xb_ld(unsigned* p)              { return __hip_atomic_load(p, __ATOMIC_RELAXED, __HIP_MEMORY_SCOPE_AGENT); }
__device__ __forceinline__ unsigned xb_add(unsigned* p, unsigned v) { return __hip_atomic_fetch_add(p, v, __ATOMIC_RELAXED, __HIP_MEMORY_SCOPE_AGENT); }
__device__ __forceinline__ unsigned xb_xcc_id() { return (unsigned)__builtin_amdgcn_s_getreg((3 << 11) | 20) & 0xFu; }
#define XB_SPIN(cond, bar) do { unsigned _sp = 0; while (cond) { __builtin_amdgcn_s_sleep(1); \
    if ((++_sp & 255u) == 0u) { if (xb_ld(&(bar)[XB_TMO])) break; if (_sp > XB_SPIN_CAP) { atomicAdd(&(bar)[XB_TMO], 1u); break; } } } } while (0)

struct XcdBarrier {
    unsigned* bar; unsigned x;
    volatile LAS unsigned* st;
};
__device__ __forceinline__ XcdBarrier xcd_barrier_post(unsigned* bar, volatile LAS unsigned* st) {
    XcdBarrier b; b.bar = bar; b.x = xb_xcc_id(); b.st = st;
    if (threadIdx.x == 0) (void)xb_add(&bar[XB_XCNT(b.x)], 1u);
    return b;
}
__device__ __forceinline__ void xcd_barrier_complete(unsigned* bar, unsigned x, unsigned& nloc, unsigned& nx) {
    const unsigned G = gridDim.x * gridDim.y * gridDim.z;
    unsigned sum, cnt, mine, sp = 0u;
    for (;;) {
        sum = 0u; cnt = 0u; mine = 0u;
#pragma unroll
        for (unsigned j = 0; j < 16; ++j) { const unsigned c = xb_ld(&bar[XB_XCNT(j)]); sum += c; cnt += (c > 0u) ? 1u : 0u; mine = (j == x) ? c : mine; }
        if (sum == G) break;
        __builtin_amdgcn_s_sleep(1);
        if ((++sp & 255u) == 0u) { if (xb_ld(&bar[XB_TMO])) break; if (sp > XB_SPIN_CAP) { atomicAdd(&bar[XB_TMO], 1u); break; } }
    }
    nloc = mine > 0u ? mine : 1u; nx = cnt > 0u ? cnt : 1u;
}
__device__ __forceinline__ void xcd_barrier(const XcdBarrier& b) {
    asm volatile("s_waitcnt vmcnt(0)" ::: "memory");
    __syncthreads();
    if (threadIdx.x == 0) {
        unsigned* bar = b.bar;
        __builtin_amdgcn_s_waitcnt(0);
        unsigned nloc = b.st[0], nx = b.st[1];
        if (nloc == 0u) { xcd_barrier_complete(bar, b.x, nloc, nx); b.st[0] = nloc; b.st[1] = nx; }
        const unsigned old = xb_add(&bar[XB_XSUB(b.x)], 1u);
        const unsigned gen = old / nloc;
        if (old + 1u == (gen + 1u) * nloc) {
            __builtin_amdgcn_fence(__ATOMIC_RELEASE, "agent");
            asm volatile("s_waitcnt vmcnt(0)" ::: "memory");
            const unsigned og = xb_add(&bar[XB_TOP], 1u);
            const unsigned tg = og / nx;
            if (og + 1u == (tg + 1u) * nx) xb_add(&bar[XB_TOPGEN], 1u);
            else XB_SPIN(xb_ld(&bar[XB_TOPGEN]) == tg, bar);
            __builtin_amdgcn_fence(__ATOMIC_ACQUIRE, "agent");
            xb_add(&bar[XB_XGEN(b.x)], 1u);
            asm volatile("s_waitcnt vmcnt(0)" ::: "memory");
        } else {
            XB_SPIN(xb_ld(&bar[XB_XGEN(b.x)]) == gen, bar);
            __builtin_amdgcn_fence(__ATOMIC_ACQUIRE, "agent");
            asm volatile("s_waitcnt vmcnt(0)" ::: "memory");
        }
    }
    __syncthreads();
}

constexpr int NWAVES = 8, NTHREADS = 512;
struct Args { const float* in[19]; float* out; unsigned char* ws; int ph_lo, ph_hi; };
enum { I_X = 0, I_META, I_MIXNW, I_WIN, I_CONVW, I_ALOG, I_DTB, I_GDNNW, I_SBQNW, I_SBKNW, I_SBONW, I_WOUT, I_FFNNW, I_RW, I_RB, I_WGU, I_BGU, I_WD, I_BD };

#define LDS_WAIT() asm volatile("s_waitcnt lgkmcnt(0)" ::: "memory")
#define VM_WAIT() asm volatile("s_waitcnt vmcnt(0)" ::: "memory")
constexpr int WLS = 2052;

__device__ __forceinline__ void dot16(const f32x4 (&v)[8], const LAS float* wl, int lane, float (&s)[16]) {
#pragma unroll
    for (int c = 0; c < 16; ++c) { float a = 0.f;
#pragma unroll
        for (int j = 0; j < 8; ++j) { const f32x4 w = *(const LAS f32x4*)(wl + c * WLS + 4 * lane + 256 * j); a += (v[j].x * w.x + v[j].y * w.y) + (v[j].z * w.z + v[j].w * w.w); }
        s[c] = wave_sum(a); }
}

template <int NR> __device__ __forceinline__ void dot8xN(const f32x4 (&v)[NR][8], const LAS float* wl, int lane, float (&out)[NR][8]) {
#pragma unroll
    for (int c = 0; c < 8; ++c) { float a[NR];
#pragma unroll
        for (int k = 0; k < NR; ++k) a[k] = 0.f;
#pragma unroll
        for (int j = 0; j < 8; ++j) { const f32x4 w = *(const LAS f32x4*)(wl + c * WLS + 4 * lane + 256 * j);
#pragma unroll
            for (int k = 0; k < NR; ++k) a[k] += (v[k][j].x * w.x + v[k][j].y * w.y) + (v[k][j].z * w.z + v[k][j].w * w.w); }
#pragma unroll
        for (int k = 0; k < NR; ++k) out[k][c] = wave_sum(a[k]); }
}
__device__ __forceinline__ void stage_w16(LAS float* wl, const float* base, int ld, int coloff, int tid) {
#pragma unroll 4
    for (int idx = tid; idx < 2048 * 4; idx += NTHREADS) { const int k = idx >> 2, q = idx & 3; const f32x4 v = *(const f32x4*)(base + (size_t)k * ld + coloff + 4 * q);
        wl[(4 * q + 0) * WLS + k] = v.x; wl[(4 * q + 1) * WLS + k] = v.y; wl[(4 * q + 2) * WLS + k] = v.z; wl[(4 * q + 3) * WLS + k] = v.w; }
}

__device__ __forceinline__ void p0_rows(const Args& a, LAS unsigned char* lds, int gw, int NGW, int tid, int lane) {
    const float* x = a.in[I_X]; const float* meta = a.in[I_META]; const float* nw = a.in[I_MIXNW]; const float* win = a.in[I_WIN];
    LAS float* wl = (LAS float*)lds;
    stage_w16(wl, win, NPROJ_SRC, 4096, tid);
    __syncthreads();
    bf16_t* HN = (bf16_t*)(a.ws + WS_HN); float* BETA = (float*)(a.ws + WS_BETA); float* GG = (float*)(a.ws + WS_G);
    f32x4 wn[8];
#pragma unroll
    for (int j = 0; j < 8; ++j) wn[j] = *((const f32x4*)nw + lane + 64 * j);
    const int hh = lane & 7;
    const float alog = a.in[I_ALOG][hh], dtb = a.in[I_DTB][hh];
    constexpr int NR0 = 2;
    for (int row0 = gw; row0 < MPAD; row0 += NR0 * NGW) {
        f32x4 v[NR0][8]; float bv[NR0], av[NR0];
        int lane_o = lane; asm volatile("" : "+v"(lane_o));
#pragma unroll
        for (int k = 0; k < NR0; ++k) { const int row = row0 + k * NGW;
            if (row < NTOK) { const int b = row / LSEQ, t = row - b * LSEQ;
                const float* src = (t < NMETA) ? meta + (size_t)t * DM : x + ((size_t)b * SEQ + (t - NMETA)) * DM;
#pragma unroll
                for (int j = 0; j < 8; ++j) v[k][j] = *((const f32x4*)src + lane + 64 * j);
            } else {
#pragma unroll
                for (int j = 0; j < 8; ++j) v[k][j] = (f32x4){0.f, 0.f, 0.f, 0.f}; } }
#pragma unroll
        for (int k = 0; k < NR0; ++k) { const int row = row0 + k * NGW; float ss = 0.f;
#pragma unroll
            for (int j = 0; j < 8; ++j) ss += (v[k][j].x * v[k][j].x + v[k][j].y * v[k][j].y) + (v[k][j].z * v[k][j].z + v[k][j].w * v[k][j].w);
            const float rstd = 1.0f / sqrtf(wave_sum(ss) * (1.0f / DM) + NORM_EPS);
            if (row < MPAD) { GAS unsigned long long* o8 = (GAS unsigned long long*)(HN + (size_t)row * DM) + lane;
#pragma unroll
                for (int j = 0; j < 8; ++j) { v[k][j] = v[k][j] * rstd * wn[j];
                    o8[64 * j] = (unsigned long long)cvt_pk_bf16(v[k][j].x, v[k][j].y) | ((unsigned long long)cvt_pk_bf16(v[k][j].z, v[k][j].w) << 32); } } }
        { float o8[NR0][8]; dot8xN<NR0>(v, wl, lane_o, o8);
#pragma unroll
            for (int k = 0; k < NR0; ++k) { bv[k] = o8[k][0];
#pragma unroll
                for (int c = 1; c < 8; ++c) bv[k] = (hh == c) ? o8[k][c] : bv[k]; }
            dot8xN<NR0>(v, wl + 8 * WLS, lane_o, o8);
#pragma unroll
            for (int k = 0; k < NR0; ++k) { av[k] = o8[k][0];
#pragma unroll
                for (int c = 1; c < 8; ++c) av[k] = (hh == c) ? o8[k][c] : av[k]; } }
#pragma unroll
        for (int k = 0; k < NR0; ++k) { const int row = row0 + k * NGW;
            if (lane < 8 && row < NTOK) {
                const float beta = 1.0f / (1.0f + expf(-bv[k]));
                const float xa = av[k] + dtb; const float sp = fmaxf(xa, 0.f) + log1pf(expf(-fabsf(xa)));
                BETA[(size_t)row * 8 + hh] = beta; GG[(size_t)row * 8 + hh] = -expf(alog) * sp; } }
    }
    __syncthreads();
}

constexpr int CVT_STR = 132;
template <int MODE  >
__device__ __forceinline__ void cvt_tile(const float* W, int ldw, int K, bf16_t* out, int kb, int nt, LAS unsigned char* T, int lane) {
    const int r0 = nt * 64;
    int c0;
    if (MODE == 0) c0 = r0;
    else if (MODE == 1) c0 = r0 < 4096 ? r0 : r0 + 16;
    else { const int pn = r0 >> 8, rr = r0 & 255; c0 = rr < 128 ? 128 * pn + rr : 2048 + 128 * pn + (rr - 128); }
    const int kq = lane >> 4, nl = lane & 15;
    const float* src = W + (size_t)(kb * 64 + 2 * kq) * ldw + c0 + 4 * nl;
    f32x4 v[8][2];
#pragma unroll
    for (int i = 0; i < 8; ++i)
#pragma unroll
        for (int j = 0; j < 2; ++j) v[i][j] = *(const f32x4*)(src + (size_t)(8 * i + j) * ldw);
    LAS unsigned char* tw = T + (4 * nl) * CVT_STR + 4 * kq;
#pragma unroll
    for (int i = 0; i < 8; ++i)
#pragma unroll
        for (int q = 0; q < 4; ++q) *(LAS unsigned*)(tw + q * CVT_STR + 16 * i) = cvt_pk_bf16(v[i][0][q], v[i][1][q]);
    LDS_WAIT();
    const int rn = lane >> 3, cc = lane & 7;
    const LAS unsigned char* tr = T + rn * CVT_STR + 16 * cc;
    bf16_t* dst = out + (size_t)(r0 + rn) * K + kb * 64 + 8 * cc;
#pragma unroll
    for (int j = 0; j < 8; ++j) { u32x4 w; const LAS unsigned* p = (const LAS unsigned*)(tr + 8 * j * CVT_STR); w.x = p[0]; w.y = p[1]; w.z = p[2]; w.w = p[3];
        *(u32x4*)(dst + (size_t)(8 * j) * K) = w; }
    LDS_WAIT();
}
constexpr float W8_SCALE = 64.0f;
template <int MODE>
__device__ __forceinline__ void cvt_tile_fp8(const float* W, int ldw, int K, unsigned char* out, int kb, int nt, LAS unsigned char* T, int lane) {
    const int r0 = nt * 64;
    int c0;
    if (MODE == 0) c0 = r0;
    else { const int pn = r0 >> 8, rr = r0 & 255; c0 = rr < 128 ? 128 * pn + rr : 2048 + 128 * pn + (rr - 128); }
    const int kq = lane >> 4, nl = lane & 15;
    LAS unsigned char* tw = T + (4 * nl) * CVT_STR + 4 * kq;
    const float* src = W + (size_t)(kb * 128 + 4 * kq) * ldw + c0 + 4 * nl;
    f32x4 v[8][4];
#pragma unroll
    for (int i = 0; i < 8; ++i)
#pragma unroll
        for (int j = 0; j < 4; ++j) v[i][j] = *(const f32x4*)(src + (size_t)(16 * i + j) * ldw);
#pragma unroll
    for (int i = 0; i < 8; ++i)
#pragma unroll
        for (int q = 0; q < 4; ++q) *(LAS unsigned*)(tw + q * CVT_STR + 16 * i) =
            pk4_fp8(v[i][0][q] * W8_SCALE, v[i][1][q] * W8_SCALE, v[i][2][q] * W8_SCALE, v[i][3][q] * W8_SCALE);
    LDS_WAIT();
    const int rn = lane >> 3, cc = lane & 7;
    const LAS unsigned char* tr = T + rn * CVT_STR + 16 * cc;
    unsigned char* dst = out + (size_t)(r0 + rn) * K + kb * 128 + 16 * cc;
#pragma unroll
    for (int j = 0; j < 8; ++j) { u32x4 w; const LAS unsigned* p = (const LAS unsigned*)(tr + 8 * j * CVT_STR); w.x = p[0]; w.y = p[1]; w.z = p[2]; w.w = p[3];
        *(u32x4*)(dst + (size_t)(8 * j) * K) = w; }
    LDS_WAIT();
}
__device__ __forceinline__ void p0_weights(const Args& a, LAS unsigned char* lds, int vcu, int G, int wave, int lane) {
    constexpr int I_IN = 32 * 14, I_OUT = 32 * 4;
    constexpr int NITEMS = I_IN + I_OUT;
    LAS unsigned char* T = lds + wave * (64 * CVT_STR);
    for (int it = vcu; it < NITEMS; it += G) {
        int r = it;
        if (r < I_IN) { cvt_tile<1>(a.in[I_WIN], NPROJ_SRC, DM, (bf16_t*)(a.ws + WS_WIN), r / 14, (r % 14) * 8 + wave, T, lane); continue; } r -= I_IN;
        cvt_tile<0>(a.in[I_WOUT], DM, DM, (bf16_t*)(a.ws + WS_WOUT), r / 4, (r % 4) * 8 + wave, T, lane);
    }
}
constexpr int MOE_I_GU = 8 * 4, MOE_I_D = 4 * 4, MOE_ITEMS = NEXP * (MOE_I_GU + MOE_I_D);
__device__ __forceinline__ void moe_weights_queue(const Args& a, LAS unsigned char* lds, LAS int* qslot, int tid, int wave, int lane, int limit) {
    unsigned* ctr = (unsigned*)(a.ws + WS_CTL) + CW_CVTQ;
    LAS unsigned char* T = lds + wave * (64 * CVT_STR);
    for (;;) {
        __syncthreads();
        if (tid == 0) { int v = (int)__hip_atomic_load(ctr, __ATOMIC_RELAXED, __HIP_MEMORY_SCOPE_AGENT); v = (v < limit) ? (int)atomicAdd(ctr, 1u) : MOE_ITEMS; *qslot = v; }
        __syncthreads();
        const int it = *(volatile LAS int*)qslot;
        if (it >= MOE_ITEMS) break;
        if (it < NEXP * MOE_I_GU) { const int e = it / MOE_I_GU, q = it % MOE_I_GU, ng = q & 7, kq = q >> 3;
#pragma unroll 1
            for (int kb = kq * 4; kb < kq * 4 + 4; ++kb)
                cvt_tile_fp8<2>(a.in[I_WGU] + (size_t)e * DM * 2 * DE, 2 * DE, DM, a.ws + WS_WGU + (size_t)e * 2 * DE * DM, kb, ng * 8 + wave, T, lane);
        } else { const int r = it - NEXP * MOE_I_GU, e = r / MOE_I_D, q = r % MOE_I_D, ng = q & 3, kq = q >> 2;
#pragma unroll 1
            for (int kb = kq * 4; kb < kq * 4 + 4; ++kb)
                cvt_tile_fp8<0>(a.in[I_WD] + (size_t)e * DE * DM, DM, DE, a.ws + WS_WD + (size_t)e * DM * DE, kb, ng * 8 + wave, T, lane);
        }
    }
}

__device__ __forceinline__ void p2_qknorm(const Args& a, int gw, int NGW, int lane) {
    const bf16_t* P = (const bf16_t*)(a.ws + WS_P); bf16_t* QN = (bf16_t*)(a.ws + WS_QN); bf16_t* KN = (bf16_t*)(a.ws + WS_KN);
    const float qw0 = a.in[I_SBQNW][2 * lane], qw1 = a.in[I_SBQNW][2 * lane + 1], kw0 = a.in[I_SBKNW][2 * lane], kw1 = a.in[I_SBKNW][2 * lane + 1];
    const float QS = 0.08838834764831845f * 1.4426950408889634f;
    for (int it = gw; it < NTOK * NHEAD * 2; it += NGW) {
        const int which = it & 1, h = (it >> 1) & 7, row = it >> 4;
        const int b = row / LSEQ, t = row - b * LSEQ;
        const unsigned w = *(const unsigned*)(P + (size_t)row * NPROJ + (which ? PC_SBK : PC_SBQ) + h * HD + 2 * lane);
        const float v0 = bf_lo(w), v1 = bf_hi(w);
        const float rstd = 1.0f / sqrtf(wave_sum(v0 * v0 + v1 * v1) * (1.0f / HD) + NORM_EPS);
        const float o0 = which ? v0 * rstd * kw0 : v0 * rstd * qw0 * QS, o1 = which ? v1 * rstd * kw1 : v1 * rstd * qw1 * QS;
        *(unsigned*)((which ? KN : QN) + ((size_t)(b * NHEAD + h) * LROW + t) * HD + 2 * lane) = cvt_pk_bf16(o0, o1);
    }
}

__device__ __forceinline__ void p3_gdn_naive(const Args& a, LAS unsigned char* lds, int item, int tid, int lane, int wave) {
    const int b = item >> 3, h = item & 7;
    const bf16_t* P = (const bf16_t*)(a.ws + WS_P); const float* BETA = (const float*)(a.ws + WS_BETA); const float* GG = (const float*)(a.ws + WS_G);
    float* ORAW = (float*)(a.ws + WS_ORAW); bf16_t* MIX = (bf16_t*)(a.ws + WS_MIX);
    LAS float* buf = (LAS float*)lds;
    const int j = tid >> 2, part = tid & 3;
    const int which = tid >> 7, d = tid & 127; const bool conv = tid < 384;
    const int pcol = which * 1024 + h * HD + d;
    float cw0 = 0, cw1 = 0, cw2 = 0, cw3 = 0;
    if (conv) { const float* cwp = a.in[I_CONVW] + pcol; cw0 = cwp[0]; cw1 = cwp[3072]; cw2 = cwp[2 * 3072]; cw3 = cwp[3 * 3072]; }
    float xm1 = 0.f, xm2 = 0.f, xm3 = 0.f;
    float S[32];
#pragma unroll
    for (int i = 0; i < 32; ++i) S[i] = 0.f;
    const size_t row0 = (size_t)b * LSEQ;
    float xnext = conv ? bf2f(P[row0 * NPROJ + pcol]) : 0.f;
    float bnext = BETA[row0 * 8 + h], gnext = GG[row0 * 8 + h];
    for (int t = 0; t < LSEQ; ++t) {
        const float xt = xnext, beta = bnext, gam = expf(gnext);
        if (t + 1 < LSEQ) { if (conv) xnext = bf2f(P[(row0 + t + 1) * NPROJ + pcol]); bnext = BETA[(row0 + t + 1) * 8 + h]; gnext = GG[(row0 + t + 1) * 8 + h]; }
        LAS float* cb = buf + (t & 1) * 384;
        if (conv) { const float y = cw3 * xt + cw2 * xm1 + cw1 * xm2 + cw0 * xm3; xm3 = xm2; xm2 = xm1; xm1 = xt; cb[tid] = y / (1.0f + expf(-y)); }
        __syncthreads();
        float kk = 0.f, qq = 0.f, dk = 0.f; f32x4 kv[8], qv[8];
#pragma unroll
        for (int i = 0; i < 8; ++i) { kv[i] = *(const LAS f32x4*)(cb + 128 + 32 * part + 4 * i); qv[i] = *(const LAS f32x4*)(cb + 32 * part + 4 * i); }
#pragma unroll
        for (int i = 0; i < 8; ++i)
#pragma unroll
            for (int c = 0; c < 4; ++c) { kk += kv[i][c] * kv[i][c]; qq += qv[i][c] * qv[i][c]; dk += S[4 * i + c] * kv[i][c]; }
        kk += __shfl_xor(kk, 1); kk += __shfl_xor(kk, 2); qq += __shfl_xor(qq, 1); qq += __shfl_xor(qq, 2); dk += __shfl_xor(dk, 1); dk += __shfl_xor(dk, 2);
        const float rk = 1.0f / sqrtf(kk + NORM_EPS), rq = 0.08838834764831845f / sqrtf(qq + NORM_EPS);
        const float vj = cb[256 + j];
        const float vnew = beta * (vj - gam * rk * dk);
        const float kvn = rk * vnew; float oq = 0.f;
#pragma unroll
        for (int i = 0; i < 8; ++i)
#pragma unroll
            for (int c = 0; c < 4; ++c) { S[4 * i + c] = gam * S[4 * i + c] + kv[i][c] * kvn; oq += S[4 * i + c] * qv[i][c]; }
        oq += __shfl_xor(oq, 1); oq += __shfl_xor(oq, 2);
        if (t >= NMETA && part == 0) ORAW[((size_t)b * SEQ + (t - NMETA)) * 1024 + h * HD + j] = rq * oq;
    }
    __threadfence(); __syncthreads();
    const float nw0 = a.in[I_GDNNW][2 * lane], nw1 = a.in[I_GDNNW][2 * lane + 1];
    for (int s = wave; s < SEQ; s += NWAVES) {
        const size_t tok = (size_t)b * SEQ + s;
        const f32x2 o = *(const f32x2*)(ORAW + tok * 1024 + h * HD + 2 * lane);
        const float rstd = 1.0f / sqrtf(wave_sum(o.x * o.x + o.y * o.y) * (1.0f / HD) + NORM_EPS);
        const unsigned zw = *(const unsigned*)(P + (row0 + NMETA + s) * NPROJ + PC_Z + h * HD + 2 * lane);
        const float z0 = bf_lo(zw), z1 = bf_hi(zw);
        const float r0 = o.x * rstd * nw0 * (z0 / (1.0f + expf(-z0))), r1 = o.y * rstd * nw1 * (z1 / (1.0f + expf(-z1)));
        *(unsigned*)(MIX + tok * DM + h * HD + 2 * lane) = cvt_pk_bf16(r0, r1);
    }
}

__device__ __forceinline__ bf16x8 sba_pack8(const f32x16& p, int base) {
    u32x4 w; w.x = cvt_pk_bf16(p[base + 0], p[base + 1]); w.y = cvt_pk_bf16(p[base + 2], p[base + 3]); w.z = cvt_pk_bf16(p[base + 4], p[base + 5]); w.w = cvt_pk_bf16(p[base + 6], p[base + 7]);
    return __builtin_bit_cast(bf16x8, w);
}

namespace gdn {
constexpr int NCH = 65;
constexpr int IMG_W = 0, IMG_QG = 16384, IMG_KDT = 32768, IMG_AT = 49152, IMG_BYTES = 57344, IMG_U = 57344, CH_BYTES = 73728;
constexpr int L_QB = 0, L_KB = 17408, L_VB = 34816, L_LT = 52224, L_GC = 69632, L_BE = 69888, L_IMG = 70144;
__device__ __forceinline__ int afrag_off(int row, int k, int nks) {
    const int rt = row >> 5, rr = row & 31, ks = k >> 4, kk = k & 15, hi = (kk >> 2) & 1, sl = (kk & 3) + 4 * (kk >> 3);
    return ((rt * nks + ks) * 64 + rr + 32 * hi) * 16 + sl * 2;
}
__device__ __forceinline__ int ufrag_off(int i, int c) {
    const int cg = c >> 5, col = c & 31, rt = i >> 5, ii = i & 31, hi = (ii >> 2) & 1, r = (ii & 3) + 4 * (ii >> 3);
    return (((cg * 2 + rt) * 2 + (r >> 3)) * 64 + col + 32 * hi) * 8 + (r & 7);
}
__device__ __forceinline__ int crow(int r, int hi) { return (r & 3) + 8 * (r >> 2) + 4 * hi; }
__device__ __forceinline__ bf16_t f2bf(float f) { return (bf16_t)(cvt_pk_bf16(f, 0.f) & 0xffffu); }

__device__ __forceinline__ void precompute(const Args& a, LAS unsigned char* lds, int item, int tid, int lane, int wave) {
    asm volatile("" : "+v"(tid), "+v"(lane), "+s"(wave));
    const int bh = item / NCH, c = item - bh * NCH, b = bh >> 3, h = bh & 7;
    const bf16_t* P = (const bf16_t*)(a.ws + WS_P) + (size_t)b * LSEQ * NPROJ;
    const float* BETA = (const float*)(a.ws + WS_BETA) + (size_t)b * LSEQ * 8; const float* GG = (const float*)(a.ws + WS_G) + (size_t)b * LSEQ * 8;
    unsigned char* dst = a.ws + WS_GCH + (size_t)item * CH_BYTES;
    LAS float* GC = (LAS float*)(lds + L_GC); LAS float* BE = (LAS float*)(lds + L_BE); LAS float* LT = (LAS float*)(lds + L_LT);
    const int tbase = 64 * c - 48;
    if (wave == 0) {
        const int t = tbase + lane; float g = 0.f, be = 0.f;
        if (t >= 0) { g = GG[(size_t)t * 8 + h]; be = BETA[(size_t)t * 8 + h]; }
#pragma unroll
        for (int o = 1; o < 64; o <<= 1) { const float y = __shfl_up(g, o); if (lane >= o) g += y; }
        GC[lane] = g; BE[lane] = be;
        if (lane == 63) ((float*)(a.ws + WS_GL))[item] = expf(g);
    }
    {
        f32x2 cw[3][4];
#pragma unroll
        for (int w3 = 0; w3 < 3; ++w3)
#pragma unroll
            for (int tap = 0; tap < 4; ++tap) cw[w3][tap] = *(const f32x2*)(a.in[I_CONVW] + tap * 3072 + w3 * 1024 + h * HD + 2 * lane);
        f32x2 xw[3][11];
#pragma unroll
        for (int j = 0; j < 11; ++j) { const int t = tbase + 8 * wave - 3 + j;
#pragma unroll
            for (int w3 = 0; w3 < 3; ++w3) { unsigned u = 0u; if (t >= 0) u = *(const unsigned*)(P + (size_t)t * NPROJ + w3 * 1024 + h * HD + 2 * lane); xw[w3][j] = (f32x2){bf_lo(u), bf_hi(u)}; } }
#pragma unroll
        for (int rr = 0; rr < 8; ++rr) { const int i = 8 * wave + rr; f32x2 y[3];
#pragma unroll
            for (int w3 = 0; w3 < 3; ++w3) { f32x2 acc = cw[w3][0] * xw[w3][rr] + cw[w3][1] * xw[w3][rr + 1] + cw[w3][2] * xw[w3][rr + 2] + cw[w3][3] * xw[w3][rr + 3];
                acc.x = acc.x / (1.0f + __expf(-acc.x)); acc.y = acc.y / (1.0f + __expf(-acc.y)); y[w3] = acc; }
            const float rq = 0.08838834764831845f / sqrtf(wave_sum(y[0].x * y[0].x + y[0].y * y[0].y) + NORM_EPS);
            const float rk = 1.0f / sqrtf(wave_sum(y[1].x * y[1].x + y[1].y * y[1].y) + NORM_EPS);
            *(LAS unsigned*)(lds + L_QB + i * 272 + 4 * lane) = cvt_pk_bf16(y[0].x * rq, y[0].y * rq);
            *(LAS unsigned*)(lds + L_KB + i * 272 + 4 * lane) = cvt_pk_bf16(y[1].x * rk, y[1].y * rk);
            *(LAS unsigned*)(lds + L_VB + i * 272 + 4 * lane) = cvt_pk_bf16(y[2].x, y[2].y); }
    }
    __syncthreads();
    {
        const int prod = wave >> 2, ti = (wave >> 1) & 1, tj = wave & 1, r32 = lane & 31, hi = lane >> 5;
        if (tj <= ti) {
            f32x16 acc;
#pragma unroll
            for (int r = 0; r < 16; ++r) acc[r] = 0.f;
            const LAS unsigned char* Ab = lds + (prod ? L_QB : L_KB) + (32 * ti + r32) * 272 + hi * 16;
            const LAS unsigned char* Bb = lds + L_KB + (32 * tj + r32) * 272 + hi * 16;
#pragma unroll
            for (int ks = 0; ks < 8; ++ks) acc = __builtin_amdgcn_mfma_f32_32x32x16_bf16(*(const LAS bf16x8*)(Ab + ks * 32), *(const LAS bf16x8*)(Bb + ks * 32), acc, 0, 0, 0);
            const int j = 32 * tj + r32; const float gj = GC[j];
#pragma unroll
            for (int r = 0; r < 16; ++r) { const int i = 32 * ti + crow(r, hi); const float dec = __expf(GC[i] - gj);
                if (prod == 0) LT[j * 68 + i] = (j < i) ? acc[r] * BE[i] * dec : 0.f;
                else *(LAS bf16_t*)(lds + L_IMG + IMG_AT + afrag_off(i, j, 4)) = f2bf((j <= i) ? acc[r] * dec : 0.f); }
        }
    }
    __syncthreads();
    if (tid < 256) {
        float x[64];
        const bool isv = tid < 128; const int cc = tid & 127;
        const LAS unsigned char* src = lds + (isv ? L_VB : L_KB) + cc * 2;
#pragma unroll
        for (int i8 = 0; i8 < 64; i8 += 8) {
#pragma unroll
            for (int q = 0; q < 8; ++q) { const int i = i8 + q; const float v = bf2f(*(const LAS bf16_t*)(src + i * 272)); x[i] = v * BE[i] * (isv ? 1.0f : __expf(GC[i])); }
            asm volatile("" ::: "memory"); }
#pragma unroll
        for (int j = 0; j < 16; ++j) {
#pragma unroll
            for (int i4 = ((j + 1) & ~3); i4 < 64; i4 += 4) { const f32x4 l4 = *(const LAS f32x4*)(LT + j * 68 + i4);
#pragma unroll
                for (int q = 0; q < 4; ++q) if (i4 + q > j) x[i4 + q] -= l4[q] * x[j]; }
            asm volatile("" ::: "memory");
        }
        f32x4 la[12], lb[12];
#define LT_LOAD(dst, j) do { _Pragma("unroll") for (int _c = (((j) + 1) >> 2); _c < 16; ++_c) dst[_c - 4] = *(const LAS f32x4*)(LT + (j) * 68 + 4 * _c); } while (0)
#define LT_APPLY(src, j) do { _Pragma("unroll") for (int _c = (((j) + 1) >> 2); _c < 16; ++_c) { _Pragma("unroll") for (int q = 0; q < 4; ++q) if (4 * _c + q > (j)) x[4 * _c + q] -= src[_c - 4][q] * x[(j)]; } } while (0)
        LT_LOAD(la, 16);
#pragma unroll
        for (int jj = 8; jj < 31; ++jj) {
            LT_LOAD(lb, 2 * jj + 1); asm volatile("" ::: "memory"); LT_APPLY(la, 2 * jj);
            LT_LOAD(la, 2 * jj + 2); asm volatile("" ::: "memory"); LT_APPLY(lb, 2 * jj + 1);
        }
        LT_APPLY(la, 62);
#undef LT_LOAD
#undef LT_APPLY
        if (isv) {
            LAS unsigned char* ub = lds + L_IMG + IMG_U + (((cc >> 5) * 4 * 64) + (cc & 31)) * 16;
#pragma unroll
            for (int i = 0; i < 64; ++i) { const int rt = i >> 5, ii = i & 31, hi = (ii >> 2) & 1, r = (ii & 3) + 4 * (ii >> 3);
                *(LAS bf16_t*)(ub + (((rt * 2 + (r >> 3)) * 64 + 32 * hi) * 8 + (r & 7)) * 2) = f2bf(x[i]); }
        } else {
            const int ks = cc >> 4, kk = cc & 15, hi = (kk >> 2) & 1, sl = (kk & 3) + 4 * (kk >> 3);
            LAS unsigned char* wb = lds + L_IMG + IMG_W + (ks * 64 + 32 * hi) * 16 + sl * 2;
#pragma unroll
            for (int i = 0; i < 64; ++i) *(LAS bf16_t*)(wb + ((i >> 5) * 8 * 64 + (i & 31)) * 16) = f2bf(-x[i]);
        }
    } else {
        const int u = tid - 256, dk = u & 127, i0 = (u >> 7) * 32; const float gl = GC[63];
#pragma unroll 4
        for (int ii = 0; ii < 32; ++ii) { const int i = i0 + ii; const float gi = GC[i];
            const float q = bf2f(*(const LAS bf16_t*)(lds + L_QB + i * 272 + dk * 2)), k = bf2f(*(const LAS bf16_t*)(lds + L_KB + i * 272 + dk * 2));
            *(LAS bf16_t*)(lds + L_IMG + IMG_QG + afrag_off(i, dk, 8)) = f2bf(q * __expf(gi));
            *(LAS bf16_t*)(lds + L_IMG + IMG_KDT + afrag_off(dk, i, 4)) = f2bf(k * __expf(gl - gi)); }
    }
    __syncthreads();
    for (int q = tid; q < CH_BYTES / 16; q += NTHREADS) *(u32x4*)(dst + (size_t)q * 16) = *(const LAS u32x4*)(lds + L_IMG + q * 16);
}

constexpr int OB_OFF = 2 * IMG_BYTES, OB_STR = 272, OB_BYTES = 64 * OB_STR;
__device__ __forceinline__ void gated_load_z(const Args& a, u32x4 (&zw)[4], int b, int h, int cc, int w4, int lane) {
    const bf16_t* P = (const bf16_t*)(a.ws + WS_P);
    const int s = 64 * (cc - 1) + 16 * w4 + (lane >> 2);
    const u32x4* zp = (const u32x4*)(P + ((size_t)b * LSEQ + NMETA + s) * NPROJ + PC_Z + h * HD + 32 * (lane & 3));
#pragma unroll
    for (int q = 0; q < 4; ++q) zw[q] = zp[q];
}
__device__ __forceinline__ float silu_f(float z) { return z * __builtin_amdgcn_rcpf(1.0f + __expf(-z)); }
__device__ __forceinline__ void gated_rows(const Args& a, const LAS unsigned char* ob, const u32x4 (&zw)[4], int b, int h, int cc, int w4, int lane, const f32x4 (&nwv)[8]) {
    bf16_t* MIX = (bf16_t*)(a.ws + WS_MIX);
    const int row = lane >> 2, qd = lane & 3, s = 64 * (cc - 1) + 16 * w4 + row;
    u32x4 ov[4]; float ss = 0.f;
#pragma unroll
    for (int q = 0; q < 4; ++q) { ov[q] = *(const LAS u32x4*)(ob + (16 * w4 + row) * OB_STR + qd * 64 + q * 16);
#pragma unroll
        for (int e = 0; e < 4; ++e) { const float lo = bf_lo(ov[q][e]), hi = bf_hi(ov[q][e]); ss += lo * lo + hi * hi; } }
    ss = quad_sum(ss);
    const float rstd = __builtin_amdgcn_rsqf(ss * (1.0f / HD) + NORM_EPS);
    u32x4* dst = (u32x4*)(MIX + ((size_t)b * SEQ + s) * DM + h * HD + 32 * qd);
#pragma unroll
    for (int q = 0; q < 4; ++q) { u32x4 w;
#pragma unroll
        for (int e = 0; e < 4; ++e) { const f32x4 nv = nwv[2 * q + (e >> 1)];
            const float n0 = (e & 1) ? nv.z : nv.x, n1 = (e & 1) ? nv.w : nv.y;
            w[e] = cvt_pk_bf16(bf_lo(ov[q][e]) * rstd * n0 * silu_f(bf_lo(zw[q][e])), bf_hi(ov[q][e]) * rstd * n1 * silu_f(bf_hi(zw[q][e]))); }
        dst[q] = w; }
}

__device__ __forceinline__ void scan(const Args& a, LAS unsigned char* lds, int bh, int tid, int lane, int wave) {
    const int b = bh >> 3, h = bh & 7, col = lane & 31, hi = lane >> 5, cg = wave;
    const unsigned char* src = a.ws + WS_GCH + (size_t)bh * NCH * CH_BYTES;
    const float* GL = (const float*)(a.ws + WS_GL) + bh * NCH;
    __syncthreads();
    const unsigned dvoff = (unsigned)(wave * 1024 + lane * 16), uvoff = (unsigned)(lane * 16);
#define GDN_DMA(ch, buf) do { const unsigned char* _sp = src + (size_t)(ch) * CH_BYTES; _Pragma("unroll") for (int _f = 0; _f < 7; ++_f) { \
        __builtin_amdgcn_global_load_lds((const unsigned*)(_sp + _f * 8192 + dvoff), (LAS unsigned*)(lds + (buf) * IMG_BYTES + wave * 1024 + _f * 8192), 16, 0, 0); } } while (0)
    GDN_DMA(0, 0);
#define GDN_STEP_END(vm) do { asm volatile("s_waitcnt vmcnt(" #vm ")" ::: "memory"); asm volatile("s_waitcnt lgkmcnt(0)" ::: "memory"); __builtin_amdgcn_s_barrier(); asm volatile("" ::: "memory"); } while (0)
    if (wave < 4) {
        f32x16 st[4]; bf16x8 Sb[8]; u32x4 ureg[4]; float gl;
#pragma unroll
        for (int t4 = 0; t4 < 4; ++t4)
#pragma unroll
            for (int r = 0; r < 16; ++r) st[t4][r] = 0.f;
#pragma unroll
        for (int ks = 0; ks < 8; ++ks) Sb[ks] = (bf16x8){0, 0, 0, 0, 0, 0, 0, 0};
#pragma unroll
        for (int q = 0; q < 4; ++q) ureg[q] = *(const u32x4*)(src + IMG_U + cg * 4096 + q * 1024 + uvoff);
        gl = GL[0];
        GDN_STEP_END(0);
        for (int c = 0; c < NCH; ++c) {
            const LAS unsigned char* img = lds + (c & 1) * IMG_BYTES + lane * 16;
            asm volatile("" : "+v"(ureg[0]), "+v"(ureg[1]), "+v"(ureg[2]), "+v"(ureg[3]), "+v"(gl));
            if (c + 1 < NCH) GDN_DMA(c + 1, (c + 1) & 1);
            f32x16 vn[2]; const float glc = gl;
#pragma unroll
            for (int rt = 0; rt < 2; ++rt)
#pragma unroll
                for (int rh = 0; rh < 2; ++rh) { const u32x4 w = ureg[rt * 2 + rh];
                    vn[rt][8 * rh + 0] = bf_lo(w.x); vn[rt][8 * rh + 1] = bf_hi(w.x); vn[rt][8 * rh + 2] = bf_lo(w.y); vn[rt][8 * rh + 3] = bf_hi(w.y);
                    vn[rt][8 * rh + 4] = bf_lo(w.z); vn[rt][8 * rh + 5] = bf_hi(w.z); vn[rt][8 * rh + 6] = bf_lo(w.w); vn[rt][8 * rh + 7] = bf_hi(w.w); }
            asm volatile("" ::: "memory");
            if (c + 1 < NCH) {
#pragma unroll
                for (int q = 0; q < 4; ++q) ureg[q] = *(const u32x4*)(src + (size_t)(c + 1) * CH_BYTES + IMG_U + cg * 4096 + q * 1024 + uvoff);
                gl = GL[c + 1]; }
#pragma unroll
            for (int rt = 0; rt < 2; ++rt) { __builtin_amdgcn_sched_barrier(0);
#pragma unroll
                for (int ks = 0; ks < 8; ++ks) vn[rt] = __builtin_amdgcn_mfma_f32_32x32x16_bf16(*(const LAS bf16x8*)(img + IMG_W + (rt * 8 + ks) * 1024), Sb[ks], vn[rt], 0, 0, 0); }
            __builtin_amdgcn_sched_barrier(0);
            bf16x8 vb[4];
#pragma unroll
            for (int ks = 0; ks < 4; ++ks) vb[ks] = sba_pack8(vn[ks >> 1], 8 * (ks & 1));
            LAS unsigned char* obw = lds + OB_OFF + (c & 1) * OB_BYTES + (32 * cg + col) * 2;
#pragma unroll
            for (int rt = 0; rt < 2; ++rt) { f32x16 o; __builtin_amdgcn_sched_barrier(0);
#pragma unroll
                for (int r = 0; r < 16; ++r) o[r] = 0.f;
#pragma unroll
                for (int ks = 0; ks < 8; ++ks) o = __builtin_amdgcn_mfma_f32_32x32x16_bf16(*(const LAS bf16x8*)(img + IMG_QG + (rt * 8 + ks) * 1024), Sb[ks], o, 0, 0, 0);
#pragma unroll
                for (int ks = 0; ks < 2 * (rt + 1); ++ks) o = __builtin_amdgcn_mfma_f32_32x32x16_bf16(*(const LAS bf16x8*)(img + IMG_AT + (rt * 4 + ks) * 1024), vb[ks], o, 0, 0, 0);
                if (c >= 1) {
#pragma unroll
                    for (int r = 0; r < 16; ++r) *(LAS bf16_t*)(obw + (32 * rt + crow(r, hi)) * OB_STR) = f2bf(o[r]); }
            }
#pragma unroll
            for (int t4 = 0; t4 < 4; ++t4) { __builtin_amdgcn_sched_barrier(0);
#pragma unroll
                for (int r = 0; r < 16; ++r) st[t4][r] *= glc;
#pragma unroll
                for (int ks = 0; ks < 4; ++ks) st[t4] = __builtin_amdgcn_mfma_f32_32x32x16_bf16(*(const LAS bf16x8*)(img + IMG_KDT + (t4 * 4 + ks) * 1024), vb[ks], st[t4], 0, 0, 0);
                Sb[2 * t4] = sba_pack8(st[t4], 0); Sb[2 * t4 + 1] = sba_pack8(st[t4], 8); }
            if (c + 1 < NCH) GDN_STEP_END(5); else GDN_STEP_END(0);
        }
    } else {
        u32x4 zA[4], zB[4]; f32x4 nwv[8];
#pragma unroll
        for (int q = 0; q < 4; ++q) { zA[q] = (u32x4){0u, 0u, 0u, 0u}; zB[q] = (u32x4){0u, 0u, 0u, 0u}; }
#pragma unroll
        for (int q = 0; q < 8; ++q) nwv[q] = *(const f32x4*)(a.in[I_GDNNW] + 32 * (lane & 3) + 4 * q);
        GDN_STEP_END(0);
        for (int c = 0; c < NCH; ++c) {
#pragma unroll
            for (int q = 0; q < 4; ++q) asm volatile("" : "+v"(zA[q]), "+v"(zB[q]));
            if (c + 1 < NCH) GDN_DMA(c + 1, (c + 1) & 1);
            if (c >= 1) { if (c & 1) gated_load_z(a, zA, b, h, c, wave - 4, lane); else gated_load_z(a, zB, b, h, c, wave - 4, lane); }
            asm volatile("" ::: "memory");
            if (c >= 2) { if (c & 1) gated_rows(a, lds + OB_OFF + ((c - 1) & 1) * OB_BYTES, zB, b, h, c - 1, wave - 4, lane, nwv);
                          else gated_rows(a, lds + OB_OFF + ((c - 1) & 1) * OB_BYTES, zA, b, h, c - 1, wave - 4, lane, nwv); }
            if (c >= 2) GDN_STEP_END(4); else GDN_STEP_END(0);
        }
        gated_rows(a, lds + OB_OFF + ((NCH - 1) & 1) * OB_BYTES, zB, b, h, NCH - 1, wave - 4, lane, nwv);
    }
#undef GDN_STEP_END
#undef GDN_DMA
}
}

namespace sba {
#define KSWZ(row, colB) ((row) * 256 + ((colB) ^ (((row) & 7) << 4)))
__device__ __forceinline__ int v_st(int k, int c) { const int kk = (k & ~0xC) | ((k & 4) << 1) | ((k & 8) >> 1); return ((kk >> 3) * 4 + (c >> 5)) * 512 + ((kk & 7) * 32 + (c & 31)) * 2; }
__device__ __forceinline__ int v_rd_base(int lane) { return ((lane & 3) << 3) | (((lane >> 2) & 3) << 6) | (((lane >> 4) & 1) << 5) | (((lane >> 5) & 1) << 8); }
constexpr int v_rd_off(int d0, int ks, int half) { return d0 * 512 + ks * 4096 + half * 2048; }
template <int OFF> __device__ __forceinline__ s16x4 tr_read(int vb) { s16x4 r; asm volatile("ds_read_b64_tr_b16 %0, %1 offset:%2" : "=&v"(r) : "v"(vb), "i"(OFF) : "memory"); return r; }
template <int D0> __device__ __forceinline__ void pv_one(f32x16& od, int vb, bf16x8 pa0, bf16x8 pa1, bf16x8 pa2, bf16x8 pa3) {
    const s16x4 l0 = tr_read<v_rd_off(D0, 0, 0)>(vb), h0 = tr_read<v_rd_off(D0, 0, 1)>(vb), l1 = tr_read<v_rd_off(D0, 1, 0)>(vb), h1 = tr_read<v_rd_off(D0, 1, 1)>(vb);
    const s16x4 l2 = tr_read<v_rd_off(D0, 2, 0)>(vb), h2 = tr_read<v_rd_off(D0, 2, 1)>(vb), l3 = tr_read<v_rd_off(D0, 3, 0)>(vb), h3 = tr_read<v_rd_off(D0, 3, 1)>(vb);
    asm volatile("s_waitcnt lgkmcnt(0)" ::: "memory"); __builtin_amdgcn_sched_barrier(0);
#define PK(L, H) (bf16x8){L[0], L[1], L[2], L[3], H[0], H[1], H[2], H[3]}
    od = __builtin_amdgcn_mfma_f32_32x32x16_bf16(pa0, PK(l0, h0), od, 0, 0, 0);
    od = __builtin_amdgcn_mfma_f32_32x32x16_bf16(pa1, PK(l1, h1), od, 0, 0, 0);
    od = __builtin_amdgcn_mfma_f32_32x32x16_bf16(pa2, PK(l2, h2), od, 0, 0, 0);
    od = __builtin_amdgcn_mfma_f32_32x32x16_bf16(pa3, PK(l3, h3), od, 0, 0, 0);
#undef PK
}
__device__ __forceinline__ int crow(int r, int hi) { return (r & 3) + 8 * (r >> 2) + 4 * hi; }
__device__ __forceinline__ int swap34(int k) { return (k & ~0x18) | ((k & 8) << 1) | ((k & 16) >> 1); }
__device__ __forceinline__ bf16x8 pack8(const f32x16& p, int base) {
    u32x4 w; w.x = cvt_pk_bf16(p[base + 0], p[base + 1]); w.y = cvt_pk_bf16(p[base + 2], p[base + 3]); w.z = cvt_pk_bf16(p[base + 4], p[base + 5]); w.w = cvt_pk_bf16(p[base + 6], p[base + 7]);
    return __builtin_bit_cast(bf16x8, w);
}
constexpr float SB_EXIT = 160.0f;

__device__ __forceinline__ void unit(const Args& a, LAS unsigned char* lds, volatile LAS int* done_cnt, int b, int h, int qb, int tid, int lane, int wid) {
    const bf16_t* QN = (const bf16_t*)(a.ws + WS_QN) + (size_t)(b * NHEAD + h) * LROW * HD;
    const bf16_t* KN = (const bf16_t*)(a.ws + WS_KN) + (size_t)(b * NHEAD + h) * LROW * HD;
    const bf16_t* Vp = (const bf16_t*)(a.ws + WS_P) + (size_t)b * LSEQ * NPROJ + PC_SBV + h * HD;
    bf16_t* MIX = (bf16_t*)(a.ws + WS_MIX);
    const int r32 = lane & 31, hi = lane >> 5;
    LAS unsigned char* K_lds = lds; LAS unsigned char* V_lds = lds + 16384;
    const int tq0 = NMETA + 256 * qb + 32 * wid, tq = tq0 + r32;
    __syncthreads();
    if (tid == 0) *done_cnt = 0;
    bf16x8 qr[8];
#pragma unroll
    for (int d0 = 0; d0 < 8; ++d0) qr[d0] = *(const bf16x8*)(QN + (size_t)tq * HD + d0 * 16 + hi * 8);
    const int sr = tid >> 4, sc = (tid & 15) * 8;
    const int vst0 = v_st(swap34(sr), sc), vst1 = v_st(32 + swap34(sr), sc);
    const int kst0 = KSWZ(sr, sc * 2), kst1 = KSWZ(32 + sr, sc * 2);
    const int vb0 = (int)(unsigned)(unsigned long)V_lds + v_rd_base(lane);
    const int prow = (r32 & 3) + 4 * (r32 >> 3) + 16 * ((r32 >> 2) & 1);
    f32x16 o[4];
#pragma unroll
    for (int d = 0; d < 4; ++d)
#pragma unroll
        for (int r = 0; r < 16; ++r) o[d][r] = 0.f;
    float carry = 0.f; bool flagged = false;
    bf16x8 ks0, ks1, vs0, vs1;
#define SBA_LOAD(kk) do { const int _k0 = 64 * (kk); ks0 = *(const bf16x8*)(KN + (size_t)(_k0 + sr) * HD + sc); ks1 = *(const bf16x8*)(KN + (size_t)(_k0 + 32 + sr) * HD + sc); \
        vs0 = *(const bf16x8*)(Vp + (size_t)(_k0 + sr) * NPROJ + sc); vs1 = *(const bf16x8*)(Vp + (size_t)(_k0 + 32 + sr) * NPROJ + sc); } while (0)
    SBA_LOAD(4 * qb + 4);
    for (int kt = 4 * qb + 4; kt >= 0; --kt) {
        const int k0 = 64 * kt;
        __syncthreads();
        if (*done_cnt == NWAVES) break;
        *(LAS bf16x8*)(K_lds + kst0) = ks0; *(LAS bf16x8*)(K_lds + kst1) = ks1; *(LAS bf16x8*)(V_lds + vst0) = vs0; *(LAS bf16x8*)(V_lds + vst1) = vs1;
        if (kt > 0) SBA_LOAD(kt - 1);
        __syncthreads();
        if (k0 >= tq0 + 32) continue;
        f32x16 p0, p1;
#pragma unroll
        for (int r = 0; r < 16; ++r) { p0[r] = 0.f; p1[r] = 0.f; }
#pragma unroll
        for (int d0 = 0; d0 < 8; ++d0) { const int cb = (d0 * 16 + hi * 8) * 2;
            const bf16x8 b0 = *(const LAS bf16x8*)(K_lds + KSWZ(prow, cb)), b1 = *(const LAS bf16x8*)(K_lds + KSWZ(32 + prow, cb));
            p0 = __builtin_amdgcn_mfma_f32_32x32x16_bf16(b0, qr[d0], p0, 0, 0, 0);
            p1 = __builtin_amdgcn_mfma_f32_32x32x16_bf16(b1, qr[d0], p1, 0, 0, 0); }
        const bool need_mask = (k0 + 63 >= tq0);
        f32x16 s0, s1; float t0 = 0.f, t1 = 0.f;
#pragma unroll
        for (int r = 0; r < 16; ++r) {
            float e0 = __builtin_amdgcn_exp2f(p0[r]), e1 = __builtin_amdgcn_exp2f(p1[r]);
            float q0 = __builtin_amdgcn_logf(1.0f + e0), q1 = __builtin_amdgcn_logf(1.0f + e1);
            if (need_mask) { const bool v0 = (k0 + 16 * hi + r) < tq, v1 = (k0 + 32 + 16 * hi + r) < tq; e0 = v0 ? e0 : 0.f; q0 = v0 ? q0 : 0.f; e1 = v1 ? e1 : 0.f; q1 = v1 ? q1 : 0.f; }
            p0[r] = e0; p1[r] = e1; s0[r] = q0; s1[r] = q1; t0 += q0; t1 += q1; }
        float t1lo, t1hi, t0lo, t0hi;
        { auto rr = __builtin_amdgcn_permlane32_swap(__float_as_uint(t1), __float_as_uint(t1), false, false); t1lo = __uint_as_float(rr[0]); t1hi = __uint_as_float(rr[1]); }
        { auto rr = __builtin_amdgcn_permlane32_swap(__float_as_uint(t0), __float_as_uint(t0), false, false); t0lo = __uint_as_float(rr[0]); t0hi = __uint_as_float(rr[1]); }
        float run1 = carry + (hi ? 0.f : t1hi), run0 = carry + (t1lo + t1hi) + (hi ? 0.f : t0hi);
#pragma unroll
        for (int r = 15; r >= 0; --r) { run1 += s1[r]; p1[r] = p1[r] * __builtin_amdgcn_exp2f(-run1); run0 += s0[r]; p0[r] = p0[r] * __builtin_amdgcn_exp2f(-run0); }
        carry += (t1lo + t1hi) + (t0lo + t0hi);
        const bf16x8 pa0 = pack8(p0, 0), pa1 = pack8(p0, 8), pa2 = pack8(p1, 0), pa3 = pack8(p1, 8);
        pv_one<0>(o[0], vb0, pa0, pa1, pa2, pa3); pv_one<1>(o[1], vb0, pa0, pa1, pa2, pa3); pv_one<2>(o[2], vb0, pa0, pa1, pa2, pa3); pv_one<3>(o[3], vb0, pa0, pa1, pa2, pa3);
        if (!flagged && __all(carry >= SB_EXIT)) { flagged = true; if (lane == 0) (void)__hip_atomic_fetch_add((LAS int*)done_cnt, 1, __ATOMIC_RELAXED, __HIP_MEMORY_SCOPE_WORKGROUP); }
    }
#undef SBA_LOAD
    const float* onw = a.in[I_SBONW];
    float wv[4];
#pragma unroll
    for (int d0 = 0; d0 < 4; ++d0) wv[d0] = onw[32 * d0 + r32];
#pragma unroll
    for (int r = 0; r < 16; ++r) {
        float ss = (o[0][r] * o[0][r] + o[1][r] * o[1][r]) + (o[2][r] * o[2][r] + o[3][r] * o[3][r]);
        ss = row16_sum(ss); ss += __shfl_xor(ss, 16);
        const float rstd = 1.0f / sqrtf(ss * (1.0f / HD) + NORM_EPS);
        const size_t tok = (size_t)b * SEQ + (tq0 - NMETA) + crow(r, hi);
        bf16_t* dst = MIX + tok * DM + 1024 + h * HD + r32;
#pragma unroll
        for (int d0 = 0; d0 < 4; ++d0) dst[32 * d0] = (bf16_t)(cvt_pk_bf16(o[d0][r] * rstd * wv[d0], 0.f) & 0xffffu);
    }
}
}

__device__ __forceinline__ void p5_router(const Args& a, LAS unsigned char* lds, int G, int c, int tid, int lane, int wave) {
    LAS float* wl = (LAS float*)lds;
    LAS float* lg = (LAS float*)(lds + 132096);
    LAS int* misc = (LAS int*)(lds + MISC_OFF);
    const float* H1 = a.out; const float* rw = a.in[I_RW]; const float* rb = a.in[I_RB];
    unsigned char* HN2 = a.ws + WS_HN;
    int* RE = (int*)(a.ws + WS_RE); int* RP = (int*)(a.ws + WS_RP); float* RG = (float*)(a.ws + WS_RG); int* LIST = (int*)(a.ws + WS_LIST);
    unsigned* ecnt = (unsigned*)(a.ws + WS_CTL) + CW_ECNT;
    f32x4 wn[8];
#pragma unroll
    for (int j = 0; j < 8; ++j) wn[j] = *((const f32x4*)a.in[I_FFNNW] + lane + 64 * j);
    for (int blk = c; blk < NREAL / 64; blk += G) {
        for (int pass = 0; pass < 2; ++pass) {
            __syncthreads();
            stage_w16(wl, rw, NEXP, pass * 16, tid);
            if (pass == 0 && tid < 32) misc[40 + tid] = 0;
            __syncthreads();
            for (int rg = 0; rg < 4; ++rg) {
                f32x4 v[2][8];
#pragma unroll
                for (int k = 0; k < 2; ++k) { const size_t row = (size_t)blk * 64 + wave * 8 + rg * 2 + k;
#pragma unroll
                    for (int j = 0; j < 8; ++j) v[k][j] = *((const f32x4*)(H1 + row * DM) + lane + 64 * j); }
#pragma unroll
                for (int k = 0; k < 2; ++k) { const size_t row = (size_t)blk * 64 + wave * 8 + rg * 2 + k; float ss = 0.f;
#pragma unroll
                    for (int j = 0; j < 8; ++j) ss += (v[k][j].x * v[k][j].x + v[k][j].y * v[k][j].y) + (v[k][j].z * v[k][j].z + v[k][j].w * v[k][j].w);
                    const float rstd = 1.0f / sqrtf(wave_sum(ss) * (1.0f / DM) + NORM_EPS);
                    GAS unsigned* o4 = (GAS unsigned*)(HN2 + row * DM) + lane;
#pragma unroll
                    for (int j = 0; j < 8; ++j) { v[k][j] = v[k][j] * rstd * wn[j];
                        if (pass == 0) o4[64 * j] = pk4_fp8(v[k][j].x, v[k][j].y, v[k][j].z, v[k][j].w); } }
#pragma unroll
                for (int hf = 0; hf < 2; ++hf) { float o8[2][8]; dot8xN<2>(v, wl + hf * 8 * WLS, lane, o8);
#pragma unroll
                    for (int k = 0; k < 2; ++k) { float sv = o8[k][0];
#pragma unroll
                        for (int c = 1; c < 8; ++c) sv = ((lane & 7) == c) ? o8[k][c] : sv;
                        if (lane < 8) lg[(wave * 8 + rg * 2 + k) * 33 + pass * 16 + hf * 8 + lane] = sv; } }
            }
        }
        __syncthreads();
        int ek[4] = {0, 0, 0, 0}, rk[4] = {0, 0, 0, 0}; float gk[4] = {0.f, 0.f, 0.f, 0.f};
        if (tid < 64) {
            float v[32];
#pragma unroll
            for (int e = 0; e < 32; ++e) v[e] = lg[tid * 33 + e] + rb[e];
            float val[4];
#pragma unroll
            for (int k = 0; k < 4; ++k) { float best = -3.0e38f; int bi = 0;
#pragma unroll
                for (int e = 0; e < 32; ++e) { const bool gt = v[e] > best; best = gt ? v[e] : best; bi = gt ? e : bi; }
#pragma unroll
                for (int e = 0; e < 32; ++e) v[e] = (e == bi) ? -3.0e38f : v[e];
                ek[k] = bi; val[k] = best; }
            float den = 0.f;
#pragma unroll
            for (int k = 0; k < 4; ++k) { gk[k] = expf(val[k] - val[0]); den += gk[k]; }
#pragma unroll
            for (int k = 0; k < 4; ++k) { gk[k] = gk[k] / den; rk[k] = __hip_atomic_fetch_add(&misc[40 + ek[k]], 1, __ATOMIC_RELAXED, __HIP_MEMORY_SCOPE_WORKGROUP); }
        }
        __syncthreads();
        if (tid < 32) { const int cnt = misc[40 + tid]; misc[72 + tid] = cnt ? (int)atomicAdd(&ecnt[tid], (unsigned)cnt) : 0; }
        __syncthreads();
        if (tid < 64) { const int tok = blk * 64 + tid;
#pragma unroll
            for (int k = 0; k < 4; ++k) { const int pos = misc[72 + ek[k]] + rk[k]; LIST[(size_t)ek[k] * NREAL + pos] = tok; RE[tok * 4 + k] = ek[k]; RP[tok * 4 + k] = pos; RG[tok * 4 + k] = gk[k]; } }
    }
    __syncthreads();
}

__device__ __forceinline__ int moe_setup(const Args& a, LAS int* misc, int tid) {
    const unsigned* ecnt = (const unsigned*)(a.ws + WS_CTL) + CW_ECNT;
    __syncthreads();
    if (tid == 0) { int acc = 0;
        for (int e = 0; e < NEXP; ++e) { const int cnt = (int)__hip_atomic_load(ecnt + e, __ATOMIC_RELAXED, __HIP_MEMORY_SCOPE_AGENT); misc[104 + e] = cnt; misc[e] = acc; acc += (cnt + 255) >> 8; }
        misc[32] = acc; }
    __syncthreads();
    return misc[32];
}

__device__ __forceinline__ void p8_combine(const Args& a, const LAS int* misc, int gw, int NGW, int lane) {
    const int* RE = (const int*)(a.ws + WS_RE); const int* RP = (const int*)(a.ws + WS_RP); const float* RG = (const float*)(a.ws + WS_RG);
    const bf16_t* Y = (const bf16_t*)(a.ws + WS_Y); const float* bd = a.in[I_BD]; float* out = a.out;
    for (int row = gw; row < NREAL; row += NGW) {
        int e[4]; size_t slot[4]; float g[4];
#pragma unroll
        for (int k = 0; k < 4; ++k) { e[k] = RE[row * 4 + k]; slot[k] = (size_t)misc[e[k]] * 256 + RP[row * 4 + k]; g[k] = RG[row * 4 + k]; }
#pragma unroll
        for (int j = 0; j < 4; ++j) { const int col = 8 * lane + 512 * j;
            f32x4 a0 = *(const f32x4*)(out + (size_t)row * DM + col), a1 = *(const f32x4*)(out + (size_t)row * DM + col + 4);
#pragma unroll
            for (int k = 0; k < 4; ++k) { const u32x4 y = *(const u32x4*)(Y + slot[k] * DM + col);
                const f32x4 b0 = *(const f32x4*)(bd + (size_t)e[k] * DM + col), b1 = *(const f32x4*)(bd + (size_t)e[k] * DM + col + 4);
                a0.x += g[k] * (bf_lo(y.x) + b0.x); a0.y += g[k] * (bf_hi(y.x) + b0.y); a0.z += g[k] * (bf_lo(y.y) + b0.z); a0.w += g[k] * (bf_hi(y.y) + b0.w);
                a1.x += g[k] * (bf_lo(y.z) + b1.x); a1.y += g[k] * (bf_hi(y.z) + b1.y); a1.z += g[k] * (bf_lo(y.w) + b1.z); a1.w += g[k] * (bf_hi(y.w) + b1.w); }
            *(f32x4*)(out + (size_t)row * DM + col) = a0; *(f32x4*)(out + (size_t)row * DM + col + 4) = a1; }
    }
}

__device__ __forceinline__ void p1_meta_rows(const Args& a, LAS unsigned char* lds, int bx, int G, int tid, int wave, int lane) {
    const bf16_t* HN = (const bf16_t*)(a.ws + WS_HN); const bf16_t* WT = (const bf16_t*)(a.ws + WS_WIN); bf16_t* P = (bf16_t*)(a.ws + WS_P);
    for (int q = tid; q < NMETA * DM * 2 / 16; q += NTHREADS) *(LAS u32x4*)(lds + q * 16) = *(const u32x4*)((const unsigned char*)HN + (size_t)q * 16);
    __syncthreads();
    for (int col = bx + G * wave; col < NPROJ; col += G * NWAVES) {
        u32x4 w[4]; int lane_o = lane; asm volatile("" : "+v"(lane_o));
#pragma unroll
        for (int j = 0; j < 4; ++j) w[j] = *(const u32x4*)(WT + (size_t)col * DM + 8 * lane + 512 * j);
        float v = 0.f;
#pragma unroll 1
        for (int t = 0; t < NMETA; ++t) { float s = 0.f;
#pragma unroll
            for (int j = 0; j < 4; ++j) { const u32x4 x = *(const LAS u32x4*)(lds + t * (DM * 2) + (8 * lane_o + 512 * j) * 2);
                s += bf_lo(x.x) * bf_lo(w[j].x) + bf_hi(x.x) * bf_hi(w[j].x) + bf_lo(x.y) * bf_lo(w[j].y) + bf_hi(x.y) * bf_hi(w[j].y)
                   + bf_lo(x.z) * bf_lo(w[j].z) + bf_hi(x.z) * bf_hi(w[j].z) + bf_lo(x.w) * bf_lo(w[j].w) + bf_hi(x.w) * bf_hi(w[j].w); }
            s = wave_sum(s);
            v = ((lane & 15) == t) ? s : v; }
        P[((size_t)(lane >> 4) * LSEQ + (lane & 15)) * NPROJ + col] = gdn::f2bf(v);
    }
    __syncthreads();
}

constexpr int NPH = 9;
__global__ void __launch_bounds__(NTHREADS, 2) hymba_fwd(Args args) {
    extern __shared__ __attribute__((aligned(16))) unsigned char lds_raw[];
    LAS unsigned char* lds = (LAS unsigned char*)lds_raw;
    LAS int* misc = (LAS int*)(lds + MISC_OFF);
    const int tid = threadIdx.x, lane = tid & 63, wave = __builtin_amdgcn_readfirstlane(tid >> 6);
    const int G = gridDim.x, bx = blockIdx.x;
    const int vcu = (G % 8 == 0) ? (bx % 8) * (G / 8) + bx / 8 : bx;
    const int gw = vcu * NWAVES + wave, NGW = G * NWAVES;
    unsigned* ctl = (unsigned*)(args.ws + WS_CTL);
    for (int u = tid; u < 256; u += NTHREADS) misc[u] = 0;
    __syncthreads();
    XcdBarrier bar; bar.bar = ctl + CW_BAR; bar.x = 0; bar.st = nullptr;
    const int lo = args.ph_lo, hi = args.ph_hi;
    const int NCV = 0, GG = G - NCV;
    constexpr int CVT_LIMIT_P1 = 0, CVT_LIMIT_P2 = MOE_ITEMS * 35 / 100, CVT_LIMIT_P3 = MOE_ITEMS;
    if (hi - lo > 1) bar = xcd_barrier_post(ctl + CW_BAR, (volatile LAS unsigned*)(misc + 200));
#ifdef ONLY
#define IN(k) ((k) == ONLY && lo <= (k) && (k) < hi)
#else
#define IN(k) (lo <= (k) && (k) < hi)
#endif
#ifndef REP_COUNT
#define REP_COUNT 2
#endif
#define REPEAT(k) _Pragma("unroll") for (int _r = 0; _r < ((REP_PHASE == (k)) ? REP_COUNT : 1); ++_r)
#define SEAM(k) do { if (IN(k) && IN((k) + 1)) xcd_barrier(bar); if (PROBE_A >= 0 && tid == 0) tsl[(k) + 1] = __builtin_amdgcn_s_memrealtime(); } while (0)

    LAS unsigned long long* tsl = (LAS unsigned long long*)(lds + MISC_OFF + 896);
    if (PROBE_A >= 0 && tid == 0) tsl[0] = __builtin_amdgcn_s_memrealtime();
    if (IN(0)) REPEAT(0) { p0_rows(args, lds, gw, NGW, tid, lane); p0_weights(args, lds, vcu, G, wave, lane); }
    SEAM(0);
    if (IN(1)) REPEAT(1) {
        p1_meta_rows(args, lds, bx, G, tid, wave, lane);
        if (bx < GG) {
        pg8::PlainOrder S; S.init(NREAL, NPROJ, DM, args.ws + WS_WIN, GG, bx); S.meta = 1;
        pg8::EpiBf16 E{(bf16_t*)(args.ws + (_r ? WS_ACT : WS_P)), NPROJ, 1};
        pg8::gemm_phase<pg8::EpiBf16, pg8::PlainOrder, true, true>(lds, (const char*)(args.ws + WS_HN), DM * 2, S, E);
        } else moe_weights_queue(args, lds, misc + 212, tid, wave, lane, CVT_LIMIT_P1);
    }
    SEAM(1);
    if (IN(2)) REPEAT(2) {
        p2_qknorm(args, gw, NGW, lane);
#if GDN_CHUNKED
        const bool roleB = (G >= 128) && (bx >= G - G / 8 * 3);
        if (roleB) moe_weights_queue(args, lds, misc + 212, tid, wave, lane, CVT_LIMIT_P2);
        int claim = (tid == 0) ? (int)atomicAdd(ctl + CW_PREQ, 1u) : 0;
        for (;;) {
            __syncthreads();
            if (tid == 0) misc[213] = claim;
            __syncthreads();
            const int it = *(volatile LAS int*)(misc + 213);
            if (it >= 32 * gdn::NCH) break;
            if (tid == 0) claim = (int)atomicAdd(ctl + CW_PREQ, 1u);
            gdn::precompute(args, lds, it, tid, lane, wave);
        }
        if (!roleB) moe_weights_queue(args, lds, misc + 212, tid, wave, lane, CVT_LIMIT_P2);
#endif
    }
    SEAM(2);
    if (IN(3)) REPEAT(3) {
        const int NG = (G >= 64) ? 32 : 0;
#if GDN_CHUNKED
        if (bx < 32 || NG == 0) { for (int it = bx; it < 32; it += G) gdn::scan(args, lds, it, tid, lane, wave); }
#else
        if (bx < 32 || NG == 0) { for (int it = bx; it < 32; it += G) p3_gdn_naive(args, lds, it, tid, lane, wave); }
#endif
        if (bx >= NG) { for (int u = bx - NG; u < 512; u += G - NG) sba::unit(args, lds, (volatile LAS int*)(misc + 210), u >> 7, (u >> 4) & 7, u & 15, tid, lane, wave); }
        if (_r == 0) moe_weights_queue(args, lds, misc + 212, tid, wave, lane, NCV ? CVT_LIMIT_P3 : MOE_ITEMS);
    }
    SEAM(3);
    if (IN(4)) REPEAT(4) {
        pg8::PlainOrder S; S.init(NREAL, DM, DM, args.ws + WS_WOUT, G, bx);
        pg8::EpiResF32 E{args.in[I_X], _r ? (float*)(args.ws + WS_ACT) : args.out, DM};
        pg8::gemm_phase<pg8::EpiResF32, pg8::PlainOrder, true, true>(lds, (const char*)(args.ws + WS_MIX), DM * 2, S, E);
    }
    SEAM(4);
    if (IN(5)) p5_router(args, lds, G, bx, tid, lane, wave);
    SEAM(5);
    if (IN(6)) REPEAT(6) {
        if (bx >= GG) moe_weights_queue(args, lds, misc + 212, tid, wave, lane, MOE_ITEMS);
        else {
        const int mt = moe_setup(args, misc, tid);
        pg8::MoeOrder<true> S; S.tpre = misc; S.tok = (const LAS int*)(lds + TOK_OFF); S.nN = 16; S.nwg = mt * 16; S.G = GG; S.c = bx;
        S.Bt = (const char*)(args.ws + WS_WGU); S.estride = (size_t)2 * DE * DM; S.K2 = DM;
        const int* LIST = (const int*)(args.ws + WS_LIST);
        S.ud = misc + 140; S.fill_units(misc + 140, tid);
        __syncthreads();
        for (int idx = tid; idx < TOK_CAP * 256; idx += NTHREADS) { pg8::Unit u; if (!S.next(idx >> 8, u)) break;
            const int r = (u.pm - misc[u.e]) * 256 + (idx & 255); ((LAS int*)(lds + TOK_OFF))[idx] = r < misc[104 + u.e] ? LIST[(size_t)u.e * NREAL + r] : 0; }
        __syncthreads();
        pg8::EpiSwiGLU E{args.ws + WS_ACT, args.in[I_BGU]};
        pg8::gemm_phase<pg8::EpiSwiGLU, pg8::MoeOrder<true>, true, true, true>(lds, (const char*)(args.ws + WS_HN), DM, S, E);
        }
    }
    SEAM(6);
    if (IN(7)) REPEAT(7) {
        const int mt = moe_setup(args, misc, tid);
        pg8::MoeOrder<false> S; S.tpre = misc; S.tok = nullptr; S.nN = 8; S.nwg = mt * 8; S.G = G; S.c = bx;
        S.Bt = (const char*)(args.ws + WS_WD); S.estride = (size_t)DM * DE; S.K2 = DE;
        S.ud = misc + 140; S.fill_units(misc + 140, tid);
        __syncthreads();
        pg8::EpiBf16 E{(bf16_t*)(args.ws + (_r ? WS_WGU : WS_Y)), DM, 0};
        pg8::gemm_phase<pg8::EpiBf16, pg8::MoeOrder<false>, true, true, true>(lds, (const char*)(args.ws + WS_ACT), DE, S, E);
    }
    SEAM(7);
    if (IN(8)) { (void)moe_setup(args, misc, tid); p8_combine(args, misc, gw, NGW, lane); }
#if PROBE_A >= 0
    __syncthreads();
    if (tid == 0) tsl[9] = __builtin_amdgcn_s_memrealtime();
    __syncthreads();
    {
        const int pa = PROBE_A;
        const float us = (float)(pa == 9 ? (tsl[9] - tsl[0]) : (tsl[pa + 1] - tsl[pa])) * 1e-2f;
        const float f = 1.0f - 0.05f * us / (float)(PROBE_REF_US);
        VM_WAIT();
        for (int row = gw; row < NREAL; row += NGW) {
#pragma unroll
            for (int j = 0; j < 8; ++j) { f32x4* p = (f32x4*)(args.out + (size_t)row * DM) + lane + 64 * j; *p = *p * f; } }
    }
#endif
#undef IN
#undef SEAM
}

extern "C" void kernel_launch(void* const* d_in, const int* in_sizes, int n_in, void* d_out, int out_size, void* d_ws, size_t ws_size, hipStream_t stream) {
    static int grid = 0;
    if (grid == 0) {
        if (n_in != 19 || out_size != NREAL * DM || ws_size < WS_END) { fprintf(stderr, "kernel_launch: unexpected shapes (n_in %d out %d ws %zu need %zu)\n", n_in, out_size, ws_size, (size_t)WS_END); grid = -1; return; }
        int dev = 0, cus = 0, per_cu = 0;
        if (hipGetDevice(&dev) != hipSuccess || hipDeviceGetAttribute(&cus, hipDeviceAttributeMultiprocessorCount, dev) != hipSuccess) { grid = -1; return; }
        if (hipFuncSetAttribute((const void*)hymba_fwd, hipFuncAttributeMaxDynamicSharedMemorySize, LDS_BYTES) != hipSuccess) { fprintf(stderr, "kernel_launch: hipFuncSetAttribute failed\n"); grid = -1; return; }
        if (hipOccupancyMaxActiveBlocksPerMultiprocessor(&per_cu, (const void*)hymba_fwd, NTHREADS, LDS_BYTES) != hipSuccess || per_cu < 1) { fprintf(stderr, "kernel_launch: occupancy query says %d\n", per_cu); grid = -1; return; }
        (void)hipGetLastError();
        grid = cus;
    }
    if (grid < 0) return;
    (void)hipMemsetAsync((char*)d_ws + WS_CTL, 0, CTL_ZERO_BYTES, stream);
    Args a{};
    for (int i = 0; i < 19; ++i) a.in[i] = (const float*)d_in[i];
    a.out = (float*)d_out; a.ws = (unsigned char*)d_ws;
#if MK_N_LAUNCHES == 1
    a.ph_lo = 0; a.ph_hi = NPH;
    hipLaunchKernelGGL(hymba_fwd, dim3(grid), dim3(NTHREADS), LDS_BYTES, stream, a);
#else
    for (int p = 0; p < NPH; ++p) { a.ph_lo = p; a.ph_hi = p + 1; hipLaunchKernelGGL(hymba_fwd, dim3(grid), dim3(NTHREADS), LDS_BYTES, stream, a); }
#endif
    const hipError_t le = hipPeekAtLastError();
    if (le != hipSuccess) fprintf(stderr, "kernel_launch: launch failed: %s\n", hipGetErrorName(le));
}
```

```cpp
#include <hip/hip_runtime.h>
#include <cstdio>
#include <cstdint>

#ifndef GDN_CHUNKED
#define GDN_CHUNKED 1
#endif
#ifndef REP_PHASE
#define REP_PHASE -1
#endif
#ifndef PROBE_A
#define PROBE_A -1
#endif
#ifndef PROBE_REF_US
#define PROBE_REF_US 500
#endif
#ifndef MK_N_LAUNCHES
#define MK_N_LAUNCHES 1
#endif

constexpr int NB = 4, SEQ = 4096, NMETA = 16, LSEQ = SEQ + NMETA;
constexpr int DM = 2048, NTOK = NB * LSEQ  , MPAD = 16640  , NREAL = NB * SEQ  ;
constexpr int NPROJ_SRC = 7184, NPROJ = 7168;
constexpr int NHEAD = 8, HD = 128;
constexpr int PC_QKV = 0, PC_Z = 3072, PC_SBQ = 4096, PC_SBK = 5120, PC_SBV = 6144;
constexpr int NEXP = 32, TOPK = 4, DE = 2048;
constexpr int SLOT_ROWS = 73728;
constexpr int LROW = 4224;
constexpr float NORM_EPS = 1e-6f;

constexpr size_t MiB = 1u << 20;
constexpr size_t WS_CTL = 0, CTL_ZERO_BYTES = 1 * MiB;
constexpr size_t WS_WIN = 1 * MiB;
constexpr size_t WS_WOUT = WS_WIN + (size_t)NPROJ * DM * 2;
constexpr size_t WS_WGU = WS_WOUT + (size_t)DM * DM * 2;
constexpr size_t WS_WD = WS_WGU + (size_t)NEXP * 2 * DE * DM * 2;
constexpr size_t WS_HN = WS_WD + (size_t)NEXP * DM * DE * 2;
constexpr size_t WS_BETA = WS_HN + (size_t)MPAD * DM * 2;
constexpr size_t WS_G = WS_BETA + (size_t)NTOK * 8 * 4 + 256;
constexpr size_t WS_P = WS_G + (size_t)NTOK * 8 * 4 + 256;
constexpr size_t WS_QN = WS_P + (size_t)MPAD * NPROJ * 2;
constexpr size_t WS_KN = WS_QN + (size_t)NB * NHEAD * LROW * HD * 2;
constexpr size_t WS_ORAW = WS_KN + (size_t)NB * NHEAD * LROW * HD * 2;
constexpr size_t WS_MIX = WS_ORAW + (size_t)NREAL * 1024 * 4;
constexpr size_t WS_RE = WS_MIX + (size_t)NREAL * DM * 2;
constexpr size_t WS_RP = WS_RE + (size_t)NREAL * 4 * 4;
constexpr size_t WS_RG = WS_RP + (size_t)NREAL * 4 * 4;
constexpr size_t WS_LIST = WS_RG + (size_t)NREAL * 4 * 4;
constexpr size_t WS_ACT = WS_LIST + (size_t)NEXP * NREAL * 4;
constexpr size_t WS_Y = WS_ACT + (size_t)SLOT_ROWS * DE * 2;
constexpr size_t WS_GCH = WS_Y + (size_t)SLOT_ROWS * DM * 2;
constexpr size_t WS_GL = WS_GCH + (size_t)32 * 65 * 73728;
constexpr size_t WS_END = WS_GL + 32 * 65 * 4 + 256;
constexpr int CW_ECNT = 64;
constexpr int CW_CVTQ = 192;
constexpr int CW_PREQ = 256;
constexpr int CW_BAR = 4096;

constexpr int LDS_STAGE = 131072;
constexpr int TOK_OFF = LDS_STAGE, TOK_CAP = 22;
constexpr int MISC_OFF = TOK_OFF + TOK_CAP * 256 * 4;
constexpr int LDS_BYTES = MISC_OFF + 1024;

#define GAS __attribute__((address_space(1)))
#define LAS __attribute__((address_space(3)))
typedef unsigned short bf16_t;
typedef short bf16x8 __attribute__((ext_vector_type(8)));
typedef short s16x4 __attribute__((ext_vector_type(4)));
typedef float f32x4 __attribute__((ext_vector_type(4)));
typedef float f32x2 __attribute__((ext_vector_type(2)));
typedef float f32x16 __attribute__((ext_vector_type(16)));
typedef unsigned u32x4 __attribute__((ext_vector_type(4)));
typedef unsigned u32x2 __attribute__((ext_vector_type(2)));

typedef __bf16 bf16x2_t __attribute__((ext_vector_type(2)));
__device__ __forceinline__ unsigned cvt_pk_bf16(float lo, float hi) { const f32x2 v = {lo, hi}; const bf16x2_t b = __builtin_convertvector(v, bf16x2_t); return __builtin_bit_cast(unsigned, b); }
__device__ __forceinline__ unsigned pk4_fp8(float a, float b, float c, float d) { unsigned w = 0u; w = __builtin_amdgcn_cvt_pk_fp8_f32(a, b, w, false); w = __builtin_amdgcn_cvt_pk_fp8_f32(c, d, w, true); return w; }
__device__ __forceinline__ float bf_lo(unsigned w) { return __uint_as_float(w << 16); }
__device__ __forceinline__ float bf_hi(unsigned w) { return __uint_as_float(w & 0xffff0000u); }
__device__ __forceinline__ float bf2f(bf16_t b) { return __uint_as_float(((unsigned)b) << 16); }
template <int CTRL, int ROW_MASK> __device__ __forceinline__ float dpp_get(float v) {
    return __builtin_bit_cast(float, __builtin_amdgcn_update_dpp(0, __builtin_bit_cast(int, v), CTRL, ROW_MASK, 0xF, false));
}
__device__ __forceinline__ float row16_sum(float v) {
    v += dpp_get<0xB1, 0xF>(v);
    v += dpp_get<0x4E, 0xF>(v);
    v += dpp_get<0x141, 0xF>(v);
    v += dpp_get<0x140, 0xF>(v);
    return v;
}
__device__ __forceinline__ float quad_sum(float v) { v += dpp_get<0xB1, 0xF>(v); v += dpp_get<0x4E, 0xF>(v); return v; }
__device__ __forceinline__ float wave_sum(float v) {
    v = row16_sum(v);
    v += dpp_get<0x142, 0xA>(v);
    v += dpp_get<0x143, 0xC>(v);
    return __builtin_bit_cast(float, __builtin_amdgcn_readlane(__builtin_bit_cast(int, v), 63));
}

namespace pg8 {
constexpr int BM = 256, BK = 64, HALF = 128, HTB = HALF * BK * 2, STAGE_BYTES = 8 * HTB, NXCD = 8, WGM = 8;
__host__ __device__ __forceinline__ int lds_byte(int r, int c) { const int st = (r >> 4) * 2 + (c >> 5), rr = r & 15, cc = c & 31, ob = rr * 64 + cc * 2; return st * 1024 + (ob ^ (((ob >> 9) & 1) << 5)); }
__host__ __device__ __forceinline__ void stage_rc(int b, int& R, int& C) { const int st = b / 1024, sb = b % 1024, swz = sb ^ (((sb >> 9) & 1) << 5); R = (st >> 1) * 16 + swz / 64; C = (st & 1) * 32 + (swz % 64) / 2; }
__host__ __device__ __forceinline__ int perm32(int rho) { const int n = rho >> 4, i = rho & 15; return 8 * (i >> 2) + 4 * n + (i & 3); }

typedef int v8i __attribute__((ext_vector_type(8))); typedef int v4i __attribute__((ext_vector_type(4)));
__device__ __forceinline__ v8i cat8(bf16x8 lo, bf16x8 hi) { const v4i a = __builtin_bit_cast(v4i, lo), b = __builtin_bit_cast(v4i, hi); return __builtin_shufflevector(a, b, 0, 1, 2, 3, 4, 5, 6, 7); }
struct Unit { int pm, pn, e, ui; };

__device__ __forceinline__ int xcd_remap(int L, int nwg) { const int q = nwg / NXCD, r = nwg % NXCD, xcd = L % NXCD, off = L / NXCD; return (xcd < r ? xcd * (q + 1) : r * (q + 1) + (xcd - r) * q) + off; }

struct PlainOrder {
    int nM, nN, nwg, G, c; const char* Bt; unsigned K2;
    __device__ void init(int M, int N, int K, const void* Bt_, int G_, int c_) { nM = M / BM; nN = N / BM; nwg = nM * nN; G = G_; c = c_; Bt = (const char*)Bt_; K2 = (unsigned)K * 2u; }
    __device__ __forceinline__ bool next(int i, Unit& u) const {
        const long L = (long)i * G + c; if (L >= nwg) return false;
        const int wgid = xcd_remap((int)L, nwg);
        const int nig = WGM * nN, gid = wgid / nig, fm = gid * WGM, gsz = (nM - fm) < WGM ? (nM - fm) : WGM;
        u.pm = fm + ((wgid % nig) % gsz); u.pn = (wgid % nig) / gsz; u.e = 0; u.ui = i; return true;
    }
    __device__ __forceinline__ const char* b_ptr(const Unit& u) const { return Bt + (size_t)u.pn * BM * K2; }
    __device__ __forceinline__ unsigned a_off(const Unit& u, int r) const { return (unsigned)(u.pm * BM + r + (meta ? NMETA * ((u.pm >> 4) + 1) : 0)) * K2; }
    int meta = 0;
};
constexpr int UD_CAP = 24;
template <bool GATHER> struct MoeOrder {
    const LAS int* tpre; const LAS int* tok; const LAS int* ud; int nN, nwg, G, c; const char* Bt; size_t estride; unsigned K2;
    __device__ __forceinline__ int decode(int i) const {
        const long L = (long)i * G + c; if (L >= nwg) return -1;
        const int wgid = xcd_remap((int)L, nwg);
        int e = 0;
#pragma unroll 1
        for (int j = 1; j < NEXP; ++j) e = (wgid >= tpre[j] * nN) ? j : e;
        const int t0 = tpre[e], nt = tpre[e + 1] - t0, loc = wgid - t0 * nN;
        return e | ((t0 + loc % nt) << 6) | ((loc / nt) << 16);
    }
    __device__ __forceinline__ void fill_units(LAS int* udw, int tid) const { if (tid < UD_CAP) udw[tid] = decode(tid); }
    __device__ __forceinline__ bool next(int i, Unit& u) const {
        if (i >= UD_CAP) return false;
        const int d = ud[i]; if (d < 0) return false;
        u.e = d & 63; u.pm = (d >> 6) & 1023; u.pn = d >> 16; u.ui = i; return true;
    }
    __device__ __forceinline__ const char* b_ptr(const Unit& u) const { return Bt + (size_t)u.e * estride + (size_t)u.pn * BM * K2; }
    __device__ __forceinline__ unsigned a_off(const Unit& u, int r) const {
        if (GATHER) return (unsigned)tok[u.ui * 256 + r] * K2;
        return (unsigned)(u.pm * BM + r) * K2;
    }
};

struct EpiBf16 {
    static constexpr bool PERM = true;
    bf16_t* O; int ldc; int meta; const float* ebias = nullptr;
    __device__ __forceinline__ void operator()(const f32x4 (&acc)[2][2][4][2], const Unit& u, int wr, int wc, int fr, int fq) const {
        const int row0 = u.pm * BM + wr * 64 + fr + (meta ? NMETA * ((u.pm >> 4) + 1) : 0), col0 = u.pn * BM + wc * 32 + 8 * fq;
        f32x4 bv[2][2];
#pragma unroll
        for (int bj = 0; bj < 2; ++bj)
#pragma unroll
            for (int n = 0; n < 2; ++n) bv[bj][n] = ebias ? *(const f32x4*)(ebias + (size_t)u.e * ldc + col0 + bj * HALF + 4 * n) : (f32x4){0.f, 0.f, 0.f, 0.f};
#pragma unroll
        for (int ai = 0; ai < 2; ++ai)
#pragma unroll
            for (int m = 0; m < 4; ++m) { bf16_t* rowp = O + (size_t)(row0 + ai * HALF + m * 16) * ldc + col0;
#pragma unroll
                for (int bj = 0; bj < 2; ++bj) { const f32x4 v0 = acc[ai][bj][m][0] + bv[bj][0], v1 = acc[ai][bj][m][1] + bv[bj][1];
                    u32x4 w; w.x = cvt_pk_bf16(v0[0], v0[1]); w.y = cvt_pk_bf16(v0[2], v0[3]); w.z = cvt_pk_bf16(v1[0], v1[1]); w.w = cvt_pk_bf16(v1[2], v1[3]);
                    *(u32x4*)(rowp + bj * HALF) = w; } }
    }
};
struct EpiResF32 {
    static constexpr bool PERM = false;
    const float* X; float* out; int ldc;
    __device__ __forceinline__ void operator()(const f32x4 (&acc)[2][2][4][2], const Unit& u, int wr, int wc, int fr, int fq) const {
        const int row0 = u.pm * BM + wr * 64 + fr, col0 = u.pn * BM + wc * 32 + 4 * fq;
#pragma unroll
        for (int ai = 0; ai < 2; ++ai) {
            f32x4 xv[4][2][2];
#pragma unroll
            for (int m = 0; m < 4; ++m) { const size_t off = (size_t)(row0 + ai * HALF + m * 16) * ldc + col0;
#pragma unroll
                for (int bj = 0; bj < 2; ++bj)
#pragma unroll
                    for (int n = 0; n < 2; ++n) xv[m][bj][n] = *(const f32x4*)(X + off + bj * HALF + n * 16); }
#pragma unroll
            for (int m = 0; m < 4; ++m) { const size_t off = (size_t)(row0 + ai * HALF + m * 16) * ldc + col0;
#pragma unroll
                for (int bj = 0; bj < 2; ++bj)
#pragma unroll
                    for (int n = 0; n < 2; ++n) *(f32x4*)(out + off + bj * HALF + n * 16) = xv[m][bj][n] + acc[ai][bj][m][n]; }
            asm volatile("" ::: "memory"); }
    }
};
__device__ __forceinline__ float swiglu1(float g, float uu) {
    g = fminf(g, 7.0f); uu = fminf(fmaxf(uu, -7.0f), 7.0f);
    const float sg = __builtin_amdgcn_rcpf(1.0f + __builtin_amdgcn_exp2f(-1.702f * 1.4426950408889634f * g));
    return (uu + 1.0f) * g * sg;
}
struct EpiSwiGLU {
    static constexpr bool PERM = true;
    unsigned char* act; const float* bgu;
    __device__ __forceinline__ void operator()(const f32x4 (&acc)[2][2][4][2], const Unit& u, int wr, int wc, int fr, int fq) const {
        const int row0 = u.pm * BM + wr * 64 + fr, col0 = u.pn * HALF + wc * 32 + 8 * fq;
        const float* bg = bgu + (size_t)u.e * 4096 + col0;
        const f32x4 bg0 = *(const f32x4*)(bg), bg1 = *(const f32x4*)(bg + 4), bu0 = *(const f32x4*)(bg + 2048), bu1 = *(const f32x4*)(bg + 2052);
#pragma unroll
        for (int ai = 0; ai < 2; ++ai)
#pragma unroll
            for (int m = 0; m < 4; ++m) { unsigned char* rowp = act + (size_t)(row0 + ai * HALF + m * 16) * DE + col0;
                const f32x4 g0 = acc[ai][0][m][0] + bg0, g1 = acc[ai][0][m][1] + bg1, u0 = acc[ai][1][m][0] + bu0, u1 = acc[ai][1][m][1] + bu1;
                u32x2 w; w.x = pk4_fp8(swiglu1(g0[0], u0[0]), swiglu1(g0[1], u0[1]), swiglu1(g0[2], u0[2]), swiglu1(g0[3], u0[3]));
                w.y = pk4_fp8(swiglu1(g1[0], u1[0]), swiglu1(g1[1], u1[1]), swiglu1(g1[2], u1[2]), swiglu1(g1[3], u1[3]));
                *(u32x2*)rowp = w; }
    }
};

template <class Epi, class Sched, bool ALIGN_EPI, bool SP2, bool FP8 = false>
__device__ __forceinline__ void gemm_phase(LAS unsigned char* lds, const char* A0, int Kb, const Sched& S, const Epi& E) {
    const int tid = threadIdx.x, wid = __builtin_amdgcn_readfirstlane(tid >> 6), lane = tid & 63, wr = wid >> 2, wc = wid & 3, fr = lane & 15, fq = lane >> 4;
    const int nt = Kb / 128;
    int Rr[2], Cc[2]; unsigned voffB[2];
#pragma unroll
    for (int i = 0; i < 2; ++i) { int R, C; stage_rc(tid * 16 + i * 8192, R, C); const int Rb = Epi::PERM ? ((R & ~31) + perm32(R & 31)) : R;
        Rr[i] = R; Cc[i] = C * 2; voffB[i] = (unsigned)(Rb * Kb + C * 2); }
    const size_t kstep = (size_t)(BK * 2);
    const size_t hstep = (size_t)HALF * Kb;
    const unsigned ldsw = (unsigned)wid * 1024u;
    const int aoff = lds_byte(wr * 64 + fr, fq * 8), boff = lds_byte(wc * 32 + fr, fq * 8);
#define PG8_SA(b, h) (((b) * 2 + (h)) * HTB)
#define PG8_SB(b, h) ((4 + (b) * 2 + (h)) * HTB)
#define PG8_STAGE(bufoff, gbase, voff) do { _Pragma("unroll") for (int _i = 0; _i < 2; ++_i) \
        __builtin_amdgcn_global_load_lds((const unsigned*)((const char*)(gbase) + (voff)[_i]), (LAS unsigned*)(lds + (bufoff) + ldsw + _i * 8192), 16, 0, 0); } while (0)
#define PG8_LDA(dst, b, h) do { _Pragma("unroll") for (int m = 0; m < 4; ++m) _Pragma("unroll") for (int k = 0; k < 2; ++k) dst[m][k] = *(const LAS bf16x8*)(lds + PG8_SA(b, h) + aoff + m * 2048 + k * 1024); } while (0)
#define PG8_LDB(dst, b, h) do { _Pragma("unroll") for (int n = 0; n < 2; ++n) _Pragma("unroll") for (int k = 0; k < 2; ++k) dst[n][k] = *(const LAS bf16x8*)(lds + PG8_SB(b, h) + boff + n * 2048 + k * 1024); } while (0)
#define PG8_MMA(ai, bj, At, Bt) do { __builtin_amdgcn_s_setprio(1); _Pragma("unroll") for (int m = 0; m < 4; ++m) _Pragma("unroll") for (int n = 0; n < 2; ++n) { \
        if constexpr (FP8) acc[ai][bj][m][n] = __builtin_amdgcn_mfma_scale_f32_16x16x128_f8f6f4(cat8(Bt[n][0], Bt[n][1]), cat8(At[m][0], At[m][1]), acc[ai][bj][m][n], 0, 0, 0, 0x79797979, 0, 0x7f7f7f7f); \
        else { _Pragma("unroll") for (int k = 0; k < 2; ++k) acc[ai][bj][m][n] = __builtin_amdgcn_mfma_f32_16x16x32_bf16(Bt[n][k], At[m][k], acc[ai][bj][m][n], 0, 0, 0); } } \
        __builtin_amdgcn_s_setprio(0); } while (0)
#define PG8_WAIT_V(n) asm volatile("s_waitcnt vmcnt(" #n ")" ::: "memory")
#define PG8_WAIT_L(n) asm volatile("s_waitcnt lgkmcnt(" #n ")" ::: "memory")
#define PG8_BAR __builtin_amdgcn_s_barrier()
#define PG8_SCHED __builtin_amdgcn_sched_barrier(0)
#define PG8_VOFF(dst, u) do { _Pragma("unroll") for (int _h = 0; _h < 2; ++_h) _Pragma("unroll") for (int _i = 0; _i < 2; ++_i) dst[_h][_i] = S.a_off(u, _h * HALF + Rr[_i]) + (unsigned)Cc[_i]; } while (0)
    Unit cur, nxt; int ui = 0;
    if (!S.next(0, cur)) return;
    f32x4 acc[2][2][4][2];
#pragma unroll
    for (int a = 0; a < 2; ++a)
#pragma unroll
        for (int b = 0; b < 2; ++b)
#pragma unroll
            for (int m = 0; m < 4; ++m)
#pragma unroll
                for (int n = 0; n < 2; ++n) acc[a][b][m][n] = (f32x4){0.f, 0.f, 0.f, 0.f};
    bf16x8 At[4][2], B0[2][2], B1[2][2];
    unsigned va[2][2], vn[2][2];
    PG8_VOFF(va, cur);
    const char* cB = S.b_ptr(cur);
    if constexpr (SP2) {
        PG8_STAGE(PG8_SB(0, 0), cB, voffB); PG8_STAGE(PG8_SB(0, 1), cB + hstep, voffB); PG8_STAGE(PG8_SA(0, 0), A0, va[0]); PG8_STAGE(PG8_SA(0, 1), A0, va[1]);
        if (wr == 1) PG8_BAR;
        PG8_WAIT_V(2); PG8_BAR;
        PG8_STAGE(PG8_SB(1, 0), cB + kstep, voffB); PG8_STAGE(PG8_SA(1, 0), A0 + kstep, va[0]); PG8_STAGE(PG8_SB(1, 1), cB + hstep + kstep, voffB);
        PG8_WAIT_V(6); PG8_BAR;
    } else {
        PG8_STAGE(PG8_SB(0, 0), cB, voffB); PG8_STAGE(PG8_SA(0, 0), A0, va[0]); PG8_STAGE(PG8_SB(0, 1), cB + hstep, voffB); PG8_STAGE(PG8_SA(0, 1), A0, va[1]);
        if (wr == 1) PG8_BAR;
        PG8_WAIT_V(4); PG8_BAR;
        PG8_STAGE(PG8_SB(1, 0), cB + kstep, voffB); PG8_STAGE(PG8_SA(1, 0), A0 + kstep, va[0]); PG8_STAGE(PG8_SB(1, 1), cB + hstep + kstep, voffB);
        PG8_WAIT_V(6); PG8_BAR;
    }
    for (;;) {
        const bool has_next = S.next(ui + 1, nxt);
        const char* nB = has_next ? S.b_ptr(nxt) : cB;
        for (int t = 0; t < nt; t += 2) {
            const bool last = (t == nt - 2);
            const char* a1 = A0 + (size_t)(t + 1) * kstep;
            const char* a2 = last ? A0 : A0 + (size_t)(t + 2) * kstep; const char* b2 = last ? nB : cB + (size_t)(t + 2) * kstep;
            const char* a3 = a2 + kstep; const char* b3 = b2 + kstep;
            if (last) { if (has_next) { PG8_VOFF(vn, nxt); } else {
#pragma unroll
                    for (int _h = 0; _h < 2; ++_h)
#pragma unroll
                        for (int _i = 0; _i < 2; ++_i) vn[_h][_i] = va[_h][_i]; } }
            if constexpr (SP2) {
            PG8_LDB(B0, 0, 0); PG8_LDB(B1, 0, 1); PG8_SCHED; PG8_LDA(At, 0, 0); PG8_STAGE(PG8_SA(1, 1), a1, va[1]);
            if (last) {
#pragma unroll
                for (int _h = 0; _h < 2; ++_h)
#pragma unroll
                    for (int _i = 0; _i < 2; ++_i) va[_h][_i] = vn[_h][_i]; }
            PG8_WAIT_V(8); PG8_WAIT_L(0); PG8_BAR; PG8_MMA(0, 0, At, B0); PG8_MMA(0, 1, At, B1); PG8_BAR; PG8_SCHED;
            PG8_LDA(At, 0, 1); PG8_STAGE(PG8_SB(0, 0), b2, voffB); PG8_STAGE(PG8_SB(0, 1), b2 + hstep, voffB); PG8_STAGE(PG8_SA(0, 0), a2, va[0]);
            PG8_WAIT_V(8); PG8_WAIT_L(0); PG8_BAR; PG8_MMA(1, 0, At, B0); PG8_MMA(1, 1, At, B1); PG8_BAR; PG8_SCHED;
            PG8_LDB(B0, 1, 0); PG8_LDB(B1, 1, 1); PG8_SCHED; PG8_LDA(At, 1, 0); PG8_STAGE(PG8_SA(0, 1), a2, va[1]);
            PG8_WAIT_V(8); PG8_WAIT_L(0); PG8_BAR; PG8_MMA(0, 0, At, B0); PG8_MMA(0, 1, At, B1); PG8_BAR; PG8_SCHED;
            PG8_LDA(At, 1, 1); PG8_STAGE(PG8_SB(1, 0), b3, voffB); PG8_STAGE(PG8_SB(1, 1), b3 + hstep, voffB); PG8_STAGE(PG8_SA(1, 0), a3, va[0]);
            PG8_WAIT_V(8); PG8_WAIT_L(0); PG8_BAR; PG8_MMA(1, 0, At, B0); PG8_MMA(1, 1, At, B1); PG8_BAR; PG8_SCHED;
            } else {
            PG8_LDB(B0, 0, 0); PG8_SCHED; PG8_LDA(At, 0, 0); PG8_STAGE(PG8_SA(1, 1), a1, va[1]);
            if (last) {
#pragma unroll
                for (int _h = 0; _h < 2; ++_h)
#pragma unroll
                    for (int _i = 0; _i < 2; ++_i) va[_h][_i] = vn[_h][_i]; }
            PG8_WAIT_L(8); PG8_BAR; PG8_WAIT_L(0); PG8_MMA(0, 0, At, B0); PG8_BAR; PG8_SCHED;
            PG8_LDB(B1, 0, 1); PG8_STAGE(PG8_SB(0, 0), b2, voffB);
            PG8_BAR; PG8_WAIT_L(0); PG8_MMA(0, 1, At, B1); PG8_BAR;
            PG8_LDA(At, 0, 1); PG8_STAGE(PG8_SA(0, 0), a2, va[0]);
            PG8_BAR; PG8_WAIT_L(0); PG8_MMA(1, 0, At, B0); PG8_BAR; PG8_SCHED;
            PG8_STAGE(PG8_SB(0, 1), b2 + hstep, voffB);
            PG8_WAIT_V(6); PG8_BAR; PG8_MMA(1, 1, At, B1); PG8_BAR;
            PG8_LDB(B0, 1, 0); PG8_SCHED; PG8_LDA(At, 1, 0); PG8_STAGE(PG8_SA(0, 1), a2, va[1]);
            PG8_WAIT_L(8); PG8_BAR; PG8_WAIT_L(0); PG8_MMA(0, 0, At, B0); PG8_BAR; PG8_SCHED;
            PG8_LDB(B1, 1, 1); PG8_STAGE(PG8_SB(1, 0), b3, voffB);
            PG8_BAR; PG8_WAIT_L(0); PG8_MMA(0, 1, At, B1); PG8_BAR;
            PG8_LDA(At, 1, 1); PG8_STAGE(PG8_SA(1, 0), a3, va[0]);
            PG8_BAR; PG8_WAIT_L(0); PG8_MMA(1, 0, At, B0); PG8_BAR; PG8_SCHED;
            PG8_STAGE(PG8_SB(1, 1), b3 + hstep, voffB);
            PG8_WAIT_V(6); PG8_BAR; PG8_MMA(1, 1, At, B1); PG8_BAR;
            }
        }
        if constexpr (ALIGN_EPI) { if (wr == 0) PG8_BAR; }
        E(acc, cur, wr, wc, fr, fq);
        if (!has_next) break;
#pragma unroll
        for (int a = 0; a < 2; ++a)
#pragma unroll
            for (int b = 0; b < 2; ++b)
#pragma unroll
                for (int m = 0; m < 4; ++m)
#pragma unroll
                    for (int n = 0; n < 2; ++n) acc[a][b][m][n] = (f32x4){0.f, 0.f, 0.f, 0.f};
        cur = nxt; cB = nB; ++ui;
        if constexpr (ALIGN_EPI) { if (wr == 1) PG8_BAR; }
    }
    PG8_WAIT_V(0);
    if constexpr (!ALIGN_EPI) { if (wr == 0) PG8_BAR; }
    PG8_BAR;
#undef PG8_SA
#undef PG8_SB
#undef PG8_STAGE
#undef PG8_LDA
#undef PG8_LDB
#undef PG8_MMA
#undef PG8_WAIT_V
#undef PG8_WAIT_L
#undef PG8_BAR
#undef PG8_SCHED
#undef PG8_VOFF
}
}

#define XB_TMO      128
#define XB_XCNT(j)  (256  + 64 * (j))
#define XB_XSUB(j)  (1280 + 64 * (j))
#define XB_XGEN(j)  (2304 + 64 * (j))
#define XB_TOP      3328
#define XB_TOPGEN   3392
#define XCD_BAR_WORDS 3456
#define XB_SPIN_CAP (1u << 18)

__device__ __forceinline__ unsigned xb_ld(unsigned* p)              { return __hip_atomic_load(p, __ATOMIC_RELAXED, __HIP_MEMORY_SCOPE_AGENT); }
__device__ __forceinline__ unsigned xb_add(unsigned* p, unsigned v) { return __hip_atomic_fetch_add(p, v, __ATOMIC_RELAXED, __HIP_MEMORY_SCOPE_AGENT); }
__device__ __forceinline__ unsigned xb_xcc_id() { return (unsigned)__builtin_amdgcn_s_getreg((3 << 11) | 20) & 0xFu; }
#define XB_SPIN(cond, bar) do { unsigned _sp = 0; while (cond) { __builtin_amdgcn_s_sleep(1); \
    if ((++_sp & 255u) == 0u) { if (xb_ld(&(bar)[XB_TMO])) break; if (_sp > XB_SPIN_CAP) { atomicAdd(&(bar)[XB_TMO], 1u); break; } } } } while (0)

struct XcdBarrier {
    unsigned* bar; unsigned x;
    volatile LAS unsigned* st;
};
__device__ __forceinline__ XcdBarrier xcd_barrier_post(unsigned* bar, volatile LAS unsigned* st) {
    XcdBarrier b; b.bar = bar; b.x = xb_xcc_id(); b.st = st;
    if (threadIdx.x == 0) (void)xb_add(&bar[XB_XCNT(b.x)], 1u);
    return b;
}
__device__ __forceinline__ void xcd_barrier_complete(unsigned* bar, unsigned x, unsigned& nloc, unsigned& nx) {
    const unsigned G = gridDim.x * gridDim.y * gridDim.z;
    unsigned sum, cnt, mine, sp = 0u;
    for (;;) {
        sum = 0u; cnt = 0u; mine = 0u;
#pragma unroll
        for (unsigned j = 0; j < 16; ++j) { const unsigned c = xb_ld(&bar[XB_XCNT(j)]); sum += c; cnt += (c > 0u) ? 1u : 0u; mine = (j == x) ? c : mine; }
        if (sum == G) break;
        __builtin_amdgcn_s_sleep(1);
        if ((++sp & 255u) == 0u) { if (xb_ld(&bar[XB_TMO])) break; if (sp > XB_SPIN_CAP) { atomicAdd(&bar[XB_TMO], 1u); break; } }
    }
    nloc = mine > 0u ? mine : 1u; nx = cnt > 0u ? cnt : 1u;
}
__device__ __forceinline__ void xcd_barrier(const XcdBarrier& b) {
    asm volatile("s_waitcnt vmcnt(0)" ::: "memory");
    __syncthreads();
    if (threadIdx.x == 0) {
        unsigned* bar = b.bar;
        __builtin_amdgcn_s_waitcnt(0);
        unsigned nloc = b.st[0], nx = b.st[1];
        if (nloc == 0u) { xcd_barrier_complete(bar, b.x, nloc, nx); b.st[0] = nloc; b.st[1] = nx; }
        const unsigned old = xb_add(&bar[XB_XSUB(b.x)], 1u);
        const unsigned gen = old / nloc;
        if (old + 1u == (gen + 1u) * nloc) {
            __builtin_amdgcn_fence(__ATOMIC_RELEASE, "agent");
            asm volatile("s_waitcnt vmcnt(0)" ::: "memory");
            const unsigned og = xb_add(&bar[XB_TOP], 1u);
            const unsigned tg = og / nx;
            if (og + 1u == (tg + 1u) * nx) xb_add(&bar[XB_TOPGEN], 1u);
            else XB_SPIN(xb_ld(&bar[XB_TOPGEN]) == tg, bar);
            __builtin_amdgcn_fence(__ATOMIC_ACQUIRE, "agent");
            xb_add(&bar[XB_XGEN(b.x)], 1u);
            asm volatile("s_waitcnt vmcnt(0)" ::: "memory");
        } else {
            XB_SPIN(xb_ld(&bar[XB_XGEN(b.x)]) == gen, bar);
            __builtin_amdgcn_fence(__ATOMIC_ACQUIRE, "agent");
            asm volatile("s_waitcnt vmcnt(0)" ::: "memory");
        }
    }
    __syncthreads();
}

constexpr int NWAVES = 8, NTHREADS = 512;
struct Args { const float* in[19]; float* out; unsigned char* ws; int ph_lo, ph_hi; };
enum { I_X = 0, I_META, I_MIXNW, I_WIN, I_CONVW, I_ALOG, I_DTB, I_GDNNW, I_SBQNW, I_SBKNW, I_SBONW, I_WOUT, I_FFNNW, I_RW, I_RB, I_WGU, I_BGU, I_WD, I_BD };

#define LDS_WAIT() asm volatile("s_waitcnt lgkmcnt(0)" ::: "memory")
#define VM_WAIT() asm volatile("s_waitcnt vmcnt(0)" ::: "memory")
constexpr int WLS = 2052;

__device__ __forceinline__ void dot16(const f32x4 (&v)[8], const LAS float* wl, int lane, float (&s)[16]) {
#pragma unroll
    for (int c = 0; c < 16; ++c) { float a = 0.f;
#pragma unroll
        for (int j = 0; j < 8; ++j) { const f32x4 w = *(const LAS f32x4*)(wl + c * WLS + 4 * lane + 256 * j); a += (v[j].x * w.x + v[j].y * w.y) + (v[j].z * w.z + v[j].w * w.w); }
        s[c] = wave_sum(a); }
}

template <int NR> __device__ __forceinline__ void dot8xN(const f32x4 (&v)[NR][8], const LAS float* wl, int lane, float (&out)[NR][8]) {
#pragma unroll
    for (int c = 0; c < 8; ++c) { float a[NR];
#pragma unroll
        for (int k = 0; k < NR; ++k) a[k] = 0.f;
#pragma unroll
        for (int j = 0; j < 8; ++j) { const f32x4 w = *(const LAS f32x4*)(wl + c * WLS + 4 * lane + 256 * j);
#pragma unroll
            for (int k = 0; k < NR; ++k) a[k] += (v[k][j].x * w.x + v[k][j].y * w.y) + (v[k][j].z * w.z + v[k][j].w * w.w); }
#pragma unroll
        for (int k = 0; k < NR; ++k) out[k][c] = wave_sum(a[k]); }
}
__device__ __forceinline__ void stage_w16(LAS float* wl, const float* base, int ld, int coloff, int tid) {
#pragma unroll 4
    for (int idx = tid; idx < 2048 * 4; idx += NTHREADS) { const int k = idx >> 2, q = idx & 3; const f32x4 v = *(const f32x4*)(base + (size_t)k * ld + coloff + 4 * q);
        wl[(4 * q + 0) * WLS + k] = v.x; wl[(4 * q + 1) * WLS + k] = v.y; wl[(4 * q + 2) * WLS + k] = v.z; wl[(4 * q + 3) * WLS + k] = v.w; }
}

__device__ __forceinline__ void p0_rows(const Args& a, LAS unsigned char* lds, int gw, int NGW, int tid, int lane) {
    const float* x = a.in[I_X]; const float* meta = a.in[I_META]; const float* nw = a.in[I_MIXNW]; const float* win = a.in[I_WIN];
    LAS float* wl = (LAS float*)lds;
    stage_w16(wl, win, NPROJ_SRC, 4096, tid);
    __syncthreads();
    bf16_t* HN = (bf16_t*)(a.ws + WS_HN); float* BETA = (float*)(a.ws + WS_BETA); float* GG = (float*)(a.ws + WS_G);
    f32x4 wn[8];
#pragma unroll
    for (int j = 0; j < 8; ++j) wn[j] = *((const f32x4*)nw + lane + 64 * j);
    const int hh = lane & 7;
    const float alog = a.in[I_ALOG][hh], dtb = a.in[I_DTB][hh];
    constexpr int NR0 = 2;
    for (int row0 = gw; row0 < MPAD; row0 += NR0 * NGW) {
        f32x4 v[NR0][8]; float bv[NR0], av[NR0];
        int lane_o = lane; asm volatile("" : "+v"(lane_o));
#pragma unroll
        for (int k = 0; k < NR0; ++k) { const int row = row0 + k * NGW;
            if (row < NTOK) { const int b = row / LSEQ, t = row - b * LSEQ;
                const float* src = (t < NMETA) ? meta + (size_t)t * DM : x + ((size_t)b * SEQ + (t - NMETA)) * DM;
#pragma unroll
                for (int j = 0; j < 8; ++j) v[k][j] = *((const f32x4*)src + lane + 64 * j);
            } else {
#pragma unroll
                for (int j = 0; j < 8; ++j) v[k][j] = (f32x4){0.f, 0.f, 0.f, 0.f}; } }
#pragma unroll
        for (int k = 0; k < NR0; ++k) { const int row = row0 + k * NGW; float ss = 0.f;
#pragma unroll
            for (int j = 0; j < 8; ++j) ss += (v[k][j].x * v[k][j].x + v[k][j].y * v[k][j].y) + (v[k][j].z * v[k][j].z + v[k][j].w * v[k][j].w);
            const float rstd = 1.0f / sqrtf(wave_sum(ss) * (1.0f / DM) + NORM_EPS);
            if (row < MPAD) { GAS unsigned long long* o8 = (GAS unsigned long long*)(HN + (size_t)row * DM) + lane;
#pragma unroll
                for (int j = 0; j < 8; ++j) { v[k][j] = v[k][j] * rstd * wn[j];
                    o8[64 * j] = (unsigned long long)cvt_pk_bf16(v[k][j].x, v[k][j].y) | ((unsigned long long)cvt_pk_bf16(v[k][j].z, v[k][j].w) << 32); } } }
        { float o8[NR0][8]; dot8xN<NR0>(v, wl, lane_o, o8);
#pragma unroll
            for (int k = 0; k < NR0; ++k) { bv[k] = o8[k][0];
#pragma unroll
                for (int c = 1; c < 8; ++c) bv[k] = (hh == c) ? o8[k][c] : bv[k]; }
            dot8xN<NR0>(v, wl + 8 * WLS, lane_o, o8);
#pragma unroll
            for (int k = 0; k < NR0; ++k) { av[k] = o8[k][0];
#pragma unroll
                for (int c = 1; c < 8; ++c) av[k] = (hh == c) ? o8[k][c] : av[k]; } }
#pragma unroll
        for (int k = 0; k < NR0; ++k) { const int row = row0 + k * NGW;
            if (lane < 8 && row < NTOK) {
                const float beta = 1.0f / (1.0f + expf(-bv[k]));
                const float xa = av[k] + dtb; const float sp = fmaxf(xa, 0.f) + log1pf(expf(-fabsf(xa)));
                BETA[(size_t)row * 8 + hh] = beta; GG[(size_t)row * 8 + hh] = -expf(alog) * sp; } }
    }
    __syncthreads();
}

constexpr int CVT_STR = 132;
template <int MODE  >
__device__ __forceinline__ void cvt_tile(const float* W, int ldw, int K, bf16_t* out, int kb, int nt, LAS unsigned char* T, int lane) {
    const int r0 = nt * 64;
    int c0;
    if (MODE == 0) c0 = r0;
    else if (MODE == 1) c0 = r0 < 4096 ? r0 : r0 + 16;
    else { const int pn = r0 >> 8, rr = r0 & 255; c0 = rr < 128 ? 128 * pn + rr : 2048 + 128 * pn + (rr - 128); }
    const int kq = lane >> 4, nl = lane & 15;
    const float* src = W + (size_t)(kb * 64 + 2 * kq) * ldw + c0 + 4 * nl;
    f32x4 v[8][2];
#pragma unroll
    for (int i = 0; i < 8; ++i)
#pragma unroll
        for (int j = 0; j < 2; ++j) v[i][j] = *(const f32x4*)(src + (size_t)(8 * i + j) * ldw);
    LAS unsigned char* tw = T + (4 * nl) * CVT_STR + 4 * kq;
#pragma unroll
    for (int i = 0; i < 8; ++i)
#pragma unroll
        for (int q = 0; q < 4; ++q) *(LAS unsigned*)(tw + q * CVT_STR + 16 * i) = cvt_pk_bf16(v[i][0][q], v[i][1][q]);
    LDS_WAIT();
    const int rn = lane >> 3, cc = lane & 7;
    const LAS unsigned char* tr = T + rn * CVT_STR + 16 * cc;
    bf16_t* dst = out + (size_t)(r0 + rn) * K + kb * 64 + 8 * cc;
#pragma unroll
    for (int j = 0; j < 8; ++j) { u32x4 w; const LAS unsigned* p = (const LAS unsigned*)(tr + 8 * j * CVT_STR); w.x = p[0]; w.y = p[1]; w.z = p[2]; w.w = p[3];
        *(u32x4*)(dst + (size_t)(8 * j) * K) = w; }
    LDS_WAIT();
}
constexpr float W8_SCALE = 64.0f;
template <int MODE>
__device__ __forceinline__ void cvt_tile_fp8(const float* W, int ldw, int K, unsigned char* out, int kb, int nt, LAS unsigned char* T, int lane) {
    const int r0 = nt * 64;
    int c0;
    if (MODE == 0) c0 = r0;
    else { const int pn = r0 >> 8, rr = r0 & 255; c0 = rr < 128 ? 128 * pn + rr : 2048 + 128 * pn + (rr - 128); }
    const int kq = lane >> 4, nl = lane & 15;
    LAS unsigned char* tw = T + (4 * nl) * CVT_STR + 4 * kq;
    const float* src = W + (size_t)(kb * 128 + 4 * kq) * ldw + c0 + 4 * nl;
    f32x4 v[8][4];
#pragma unroll
    for (int i = 0; i < 8; ++i)
#pragma unroll
        for (int j = 0; j < 4; ++j) v[i][j] = *(const f32x4*)(src + (size_t)(16 * i + j) * ldw);
#pragma unroll
    for (int i = 0; i < 8; ++i)
#pragma unroll
        for (int q = 0; q < 4; ++q) *(LAS unsigned*)(tw + q * CVT_STR + 16 * i) =
            pk4_fp8(v[i][0][q] * W8_SCALE, v[i][1][q] * W8_SCALE, v[i][2][q] * W8_SCALE, v[i][3][q] * W8_SCALE);
    LDS_WAIT();
    const int rn = lane >> 3, cc = lane & 7;
    const LAS unsigned char* tr = T + rn * CVT_STR + 16 * cc;
    unsigned char* dst = out + (size_t)(r0 + rn) * K + kb * 128 + 16 * cc;
#pragma unroll
    for (int j = 0; j < 8; ++j) { u32x4 w; const LAS unsigned* p = (const LAS unsigned*)(tr + 8 * j * CVT_STR); w.x = p[0]; w.y = p[1]; w.z = p[2]; w.w = p[3];
        *(u32x4*)(dst + (size_t)(8 * j) * K) = w; }
    LDS_WAIT();
}
__device__ __forceinline__ void p0_weights(const Args& a, LAS unsigned char* lds, int vcu, int G, int wave, int lane) {
    constexpr int I_IN = 32 * 14, I_OUT = 32 * 4;
    constexpr int NITEMS = I_IN + I_OUT;
    LAS unsigned char* T = lds + wave * (64 * CVT_STR);
    for (int it = vcu; it < NITEMS; it += G) {
        int r = it;
        if (r < I_IN) { cvt_tile<1>(a.in[I_WIN], NPROJ_SRC, DM, (bf16_t*)(a.ws + WS_WIN), r / 14, (r % 14) * 8 + wave, T, lane); continue; } r -= I_IN;
        cvt_tile<0>(a.in[I_WOUT], DM, DM, (bf16_t*)(a.ws + WS_WOUT), r / 4, (r % 4) * 8 + wave, T, lane);
    }
}
constexpr int MOE_I_GU = 8 * 4, MOE_I_D = 4 * 4, MOE_ITEMS = NEXP * (MOE_I_GU + MOE_I_D);
__device__ __forceinline__ void moe_weights_queue(const Args& a, LAS unsigned char* lds, LAS int* qslot, int tid, int wave, int lane, int limit) {
    unsigned* ctr = (unsigned*)(a.ws + WS_CTL) + CW_CVTQ;
    LAS unsigned char* T = lds + wave * (64 * CVT_STR);
    for (;;) {
        __syncthreads();
        if (tid == 0) { int v = (int)__hip_atomic_load(ctr, __ATOMIC_RELAXED, __HIP_MEMORY_SCOPE_AGENT); v = (v < limit) ? (int)atomicAdd(ctr, 1u) : MOE_ITEMS; *qslot = v; }
        __syncthreads();
        const int it = *(volatile LAS int*)qslot;
        if (it >= MOE_ITEMS) break;
        if (it < NEXP * MOE_I_GU) { const int e = it / MOE_I_GU, q = it % MOE_I_GU, ng = q & 7, kq = q >> 3;
#pragma unroll 1
            for (int kb = kq * 4; kb < kq * 4 + 4; ++kb)
                cvt_tile_fp8<2>(a.in[I_WGU] + (size_t)e * DM * 2 * DE, 2 * DE, DM, a.ws + WS_WGU + (size_t)e * 2 * DE * DM, kb, ng * 8 + wave, T, lane);
        } else { const int r = it - NEXP * MOE_I_GU, e = r / MOE_I_D, q = r % MOE_I_D, ng = q & 3, kq = q >> 2;
#pragma unroll 1
            for (int kb = kq * 4; kb < kq * 4 + 4; ++kb)
                cvt_tile_fp8<0>(a.in[I_WD] + (size_t)e * DE * DM, DM, DE, a.ws + WS_WD + (size_t)e * DM * DE, kb, ng * 8 + wave, T, lane);
        }
    }
}

__device__ __forceinline__ void p2_qknorm(const Args& a, int gw, int NGW, int lane) {
    const bf16_t* P = (const bf16_t*)(a.ws + WS_P); bf16_t* QN = (bf16_t*)(a.ws + WS_QN); bf16_t* KN = (bf16_t*)(a.ws + WS_KN);
    const float qw0 = a.in[I_SBQNW][2 * lane], qw1 = a.in[I_SBQNW][2 * lane + 1], kw0 = a.in[I_SBKNW][2 * lane], kw1 = a.in[I_SBKNW][2 * lane + 1];
    const float QS = 0.08838834764831845f * 1.4426950408889634f;
    constexpr int QB_ = 8;
    for (int it0 = gw; it0 < NTOK * NHEAD * 2; it0 += QB_ * NGW) {
        unsigned w[QB_];
#pragma unroll
        for (int k = 0; k < QB_; ++k) { const int it = it0 + k * NGW; w[k] = 0u;
            if (it < NTOK * NHEAD * 2) { const int which = it & 1, h = (it >> 1) & 7, row = it >> 4; w[k] = *(const unsigned*)(P + (size_t)row * NPROJ + (which ? PC_SBK : PC_SBQ) + h * HD + 2 * lane); } }
#pragma unroll
        for (int k = 0; k < QB_; ++k) { const int it = it0 + k * NGW;
            if (it < NTOK * NHEAD * 2) { const int which = it & 1, h = (it >> 1) & 7, row = it >> 4; const int b = row / LSEQ, t = row - b * LSEQ;
                const float v0 = bf_lo(w[k]), v1 = bf_hi(w[k]);
                const float rstd = 1.0f / sqrtf(wave_sum(v0 * v0 + v1 * v1) * (1.0f / HD) + NORM_EPS);
                const float o0 = which ? v0 * rstd * kw0 : v0 * rstd * qw0 * QS, o1 = which ? v1 * rstd * kw1 : v1 * rstd * qw1 * QS;
                *(unsigned*)((which ? KN : QN) + ((size_t)(b * NHEAD + h) * LROW + t) * HD + 2 * lane) = cvt_pk_bf16(o0, o1); } }
    }
}

__device__ __forceinline__ void p3_gdn_naive(const Args& a, LAS unsigned char* lds, int item, int tid, int lane, int wave) {
    const int b = item >> 3, h = item & 7;
    const bf16_t* P = (const bf16_t*)(a.ws + WS_P); const float* BETA = (const float*)(a.ws + WS_BETA); const float* GG = (const float*)(a.ws + WS_G);
    float* ORAW = (float*)(a.ws + WS_ORAW); bf16_t* MIX = (bf16_t*)(a.ws + WS_MIX);
    LAS float* buf = (LAS float*)lds;
    const int j = tid >> 2, part = tid & 3;
    const int which = tid >> 7, d = tid & 127; const bool conv = tid < 384;
    const int pcol = which * 1024 + h * HD + d;
    float cw0 = 0, cw1 = 0, cw2 = 0, cw3 = 0;
    if (conv) { const float* cwp = a.in[I_CONVW] + pcol; cw0 = cwp[0]; cw1 = cwp[3072]; cw2 = cwp[2 * 3072]; cw3 = cwp[3 * 3072]; }
    float xm1 = 0.f, xm2 = 0.f, xm3 = 0.f;
    float S[32];
#pragma unroll
    for (int i = 0; i < 32; ++i) S[i] = 0.f;
    const size_t row0 = (size_t)b * LSEQ;
    float xnext = conv ? bf2f(P[row0 * NPROJ + pcol]) : 0.f;
    float bnext = BETA[row0 * 8 + h], gnext = GG[row0 * 8 + h];
    for (int t = 0; t < LSEQ; ++t) {
        const float xt = xnext, beta = bnext, gam = expf(gnext);
        if (t + 1 < LSEQ) { if (conv) xnext = bf2f(P[(row0 + t + 1) * NPROJ + pcol]); bnext = BETA[(row0 + t + 1) * 8 + h]; gnext = GG[(row0 + t + 1) * 8 + h]; }
        LAS float* cb = buf + (t & 1) * 384;
        if (conv) { const float y = cw3 * xt + cw2 * xm1 + cw1 * xm2 + cw0 * xm3; xm3 = xm2; xm2 = xm1; xm1 = xt; cb[tid] = y / (1.0f + expf(-y)); }
        __syncthreads();
        float kk = 0.f, qq = 0.f, dk = 0.f; f32x4 kv[8], qv[8];
#pragma unroll
        for (int i = 0; i < 8; ++i) { kv[i] = *(const LAS f32x4*)(cb + 128 + 32 * part + 4 * i); qv[i] = *(const LAS f32x4*)(cb + 32 * part + 4 * i); }
#pragma unroll
        for (int i = 0; i < 8; ++i)
#pragma unroll
            for (int c = 0; c < 4; ++c) { kk += kv[i][c] * kv[i][c]; qq += qv[i][c] * qv[i][c]; dk += S[4 * i + c] * kv[i][c]; }
        kk += __shfl_xor(kk, 1); kk += __shfl_xor(kk, 2); qq += __shfl_xor(qq, 1); qq += __shfl_xor(qq, 2); dk += __shfl_xor(dk, 1); dk += __shfl_xor(dk, 2);
        const float rk = 1.0f / sqrtf(kk + NORM_EPS), rq = 0.08838834764831845f / sqrtf(qq + NORM_EPS);
        const float vj = cb[256 + j];
        const float vnew = beta * (vj - gam * rk * dk);
        const float kvn = rk * vnew; float oq = 0.f;
#pragma unroll
        for (int i = 0; i < 8; ++i)
#pragma unroll
            for (int c = 0; c < 4; ++c) { S[4 * i + c] = gam * S[4 * i + c] + kv[i][c] * kvn; oq += S[4 * i + c] * qv[i][c]; }
        oq += __shfl_xor(oq, 1); oq += __shfl_xor(oq, 2);
        if (t >= NMETA && part == 0) ORAW[((size_t)b * SEQ + (t - NMETA)) * 1024 + h * HD + j] = rq * oq;
    }
    __threadfence(); __syncthreads();
    const float nw0 = a.in[I_GDNNW][2 * lane], nw1 = a.in[I_GDNNW][2 * lane + 1];
    for (int s = wave; s < SEQ; s += NWAVES) {
        const size_t tok = (size_t)b * SEQ + s;
        const f32x2 o = *(const f32x2*)(ORAW + tok * 1024 + h * HD + 2 * lane);
        const float rstd = 1.0f / sqrtf(wave_sum(o.x * o.x + o.y * o.y) * (1.0f / HD) + NORM_EPS);
        const unsigned zw = *(const unsigned*)(P + (row0 + NMETA + s) * NPROJ + PC_Z + h * HD + 2 * lane);
        const float z0 = bf_lo(zw), z1 = bf_hi(zw);
        const float r0 = o.x * rstd * nw0 * (z0 / (1.0f + expf(-z0))), r1 = o.y * rstd * nw1 * (z1 / (1.0f + expf(-z1)));
        *(unsigned*)(MIX + tok * DM + h * HD + 2 * lane) = cvt_pk_bf16(r0, r1);
    }
}

__device__ __forceinline__ bf16x8 sba_pack8(const f32x16& p, int base) {
    u32x4 w; w.x = cvt_pk_bf16(p[base + 0], p[base + 1]); w.y = cvt_pk_bf16(p[base + 2], p[base + 3]); w.z = cvt_pk_bf16(p[base + 4], p[base + 5]); w.w = cvt_pk_bf16(p[base + 6], p[base + 7]);
    return __builtin_bit_cast(bf16x8, w);
}

namespace gdn {
constexpr int NCH = 65;
constexpr int IMG_W = 0, IMG_QG = 16384, IMG_KDT = 32768, IMG_AT = 49152, IMG_BYTES = 57344, IMG_U = 57344, CH_BYTES = 73728;
constexpr int L_QB = 0, L_KB = 17408, L_VB = 34816, L_LT = 52224, L_GC = 69632, L_BE = 69888, L_IMG = 70144;
__device__ __forceinline__ int afrag_off(int row, int k, int nks) {
    const int rt = row >> 5, rr = row & 31, ks = k >> 4, kk = k & 15, hi = (kk >> 2) & 1, sl = (kk & 3) + 4 * (kk >> 3);
    return ((rt * nks + ks) * 64 + rr + 32 * hi) * 16 + sl * 2;
}
__device__ __forceinline__ int ufrag_off(int i, int c) {
    const int cg = c >> 5, col = c & 31, rt = i >> 5, ii = i & 31, hi = (ii >> 2) & 1, r = (ii & 3) + 4 * (ii >> 3);
    return (((cg * 2 + rt) * 2 + (r >> 3)) * 64 + col + 32 * hi) * 8 + (r & 7);
}
__device__ __forceinline__ int crow(int r, int hi) { return (r & 3) + 8 * (r >> 2) + 4 * hi; }
__device__ __forceinline__ bf16_t f2bf(float f) { return (bf16_t)(cvt_pk_bf16(f, 0.f) & 0xffffu); }

__device__ __forceinline__ void precompute(const Args& a, LAS unsigned char* lds, int item, int tid, int lane, int wave) {
    asm volatile("" : "+v"(tid), "+v"(lane), "+s"(wave));
    const int bh = item / NCH, c = item - bh * NCH, b = bh >> 3, h = bh & 7;
    const bf16_t* P = (const bf16_t*)(a.ws + WS_P) + (size_t)b * LSEQ * NPROJ;
    const float* BETA = (const float*)(a.ws + WS_BETA) + (size_t)b * LSEQ * 8; const float* GG = (const float*)(a.ws + WS_G) + (size_t)b * LSEQ * 8;
    unsigned char* dst = a.ws + WS_GCH + (size_t)item * CH_BYTES;
    LAS float* GC = (LAS float*)(lds + L_GC); LAS float* BE = (LAS float*)(lds + L_BE); LAS float* LT = (LAS float*)(lds + L_LT);
    const int tbase = 64 * c - 48;
    if (wave == 0) {
        const int t = tbase + lane; float g = 0.f, be = 0.f;
        if (t >= 0) { g = GG[(size_t)t * 8 + h]; be = BETA[(size_t)t * 8 + h]; }
#pragma unroll
        for (int o = 1; o < 64; o <<= 1) { const float y = __shfl_up(g, o); if (lane >= o) g += y; }
        GC[lane] = g; BE[lane] = be;
        if (lane == 63) ((float*)(a.ws + WS_GL))[item] = expf(g);
    }
    {
        f32x2 cw[3][4];
#pragma unroll
        for (int w3 = 0; w3 < 3; ++w3)
#pragma unroll
            for (int tap = 0; tap < 4; ++tap) cw[w3][tap] = *(const f32x2*)(a.in[I_CONVW] + tap * 3072 + w3 * 1024 + h * HD + 2 * lane);
        f32x2 xw[3][11];
#pragma unroll
        for (int j = 0; j < 11; ++j) { const int t = tbase + 8 * wave - 3 + j;
#pragma unroll
            for (int w3 = 0; w3 < 3; ++w3) { unsigned u = 0u; if (t >= 0) u = *(const unsigned*)(P + (size_t)t * NPROJ + w3 * 1024 + h * HD + 2 * lane); xw[w3][j] = (f32x2){bf_lo(u), bf_hi(u)}; } }
#pragma unroll
        for (int rr = 0; rr < 8; ++rr) { const int i = 8 * wave + rr; f32x2 y[3];
#pragma unroll
            for (int w3 = 0; w3 < 3; ++w3) { f32x2 acc = cw[w3][0] * xw[w3][rr] + cw[w3][1] * xw[w3][rr + 1] + cw[w3][2] * xw[w3][rr + 2] + cw[w3][3] * xw[w3][rr + 3];
                acc.x = acc.x / (1.0f + __expf(-acc.x)); acc.y = acc.y / (1.0f + __expf(-acc.y)); y[w3] = acc; }
            const float rq = 0.08838834764831845f / sqrtf(wave_sum(y[0].x * y[0].x + y[0].y * y[0].y) + NORM_EPS);
            const float rk = 1.0f / sqrtf(wave_sum(y[1].x * y[1].x + y[1].y * y[1].y) + NORM_EPS);
            *(LAS unsigned*)(lds + L_QB + i * 272 + 4 * lane) = cvt_pk_bf16(y[0].x * rq, y[0].y * rq);
            *(LAS unsigned*)(lds + L_KB + i * 272 + 4 * lane) = cvt_pk_bf16(y[1].x * rk, y[1].y * rk);
            *(LAS unsigned*)(lds + L_VB + i * 272 + 4 * lane) = cvt_pk_bf16(y[2].x, y[2].y); }
    }
    __syncthreads();
    {
        const int prod = wave >> 2, ti = (wave >> 1) & 1, tj = wave & 1, r32 = lane & 31, hi = lane >> 5;
        if (tj <= ti) {
            f32x16 acc;
#pragma unroll
            for (int r = 0; r < 16; ++r) acc[r] = 0.f;
            const LAS unsigned char* Ab = lds + (prod ? L_QB : L_KB) + (32 * ti + r32) * 272 + hi * 16;
            const LAS unsigned char* Bb = lds + L_KB + (32 * tj + r32) * 272 + hi * 16;
#pragma unroll
            for (int ks = 0; ks < 8; ++ks) acc = __builtin_amdgcn_mfma_f32_32x32x16_bf16(*(const LAS bf16x8*)(Ab + ks * 32), *(const LAS bf16x8*)(Bb + ks * 32), acc, 0, 0, 0);
            const int j = 32 * tj + r32; const float gj = GC[j];
#pragma unroll
            for (int r = 0; r < 16; ++r) { const int i = 32 * ti + crow(r, hi); const float dec = __expf(GC[i] - gj);
                if (prod == 0) LT[j * 68 + i] = (j < i) ? acc[r] * BE[i] * dec : 0.f;
                else *(LAS bf16_t*)(lds + L_IMG + IMG_AT + afrag_off(i, j, 4)) = f2bf((j <= i) ? acc[r] * dec : 0.f); }
        }
    }
    __syncthreads();
    if (tid < 256) {
        float x[64];
        const bool isv = tid < 128; const int cc = tid & 127;
        const LAS unsigned char* src = lds + (isv ? L_VB : L_KB) + cc * 2;
#pragma unroll
        for (int i8 = 0; i8 < 64; i8 += 8) {
#pragma unroll
            for (int q = 0; q < 8; ++q) { const int i = i8 + q; const float v = bf2f(*(const LAS bf16_t*)(src + i * 272)); x[i] = v * BE[i] * (isv ? 1.0f : __expf(GC[i])); }
            asm volatile("" ::: "memory"); }
#pragma unroll
        for (int j = 0; j < 16; ++j) {
#pragma unroll
            for (int i4 = ((j + 1) & ~3); i4 < 64; i4 += 4) { const f32x4 l4 = *(const LAS f32x4*)(LT + j * 68 + i4);
#pragma unroll
                for (int q = 0; q < 4; ++q) if (i4 + q > j) x[i4 + q] -= l4[q] * x[j]; }
            asm volatile("" ::: "memory");
        }
        f32x4 la[12], lb[12];
#define LT_LOAD(dst, j) do { _Pragma("unroll") for (int _c = (((j) + 1) >> 2); _c < 16; ++_c) dst[_c - 4] = *(const LAS f32x4*)(LT + (j) * 68 + 4 * _c); } while (0)
#define LT_APPLY(src, j) do { _Pragma("unroll") for (int _c = (((j) + 1) >> 2); _c < 16; ++_c) { _Pragma("unroll") for (int q = 0; q < 4; ++q) if (4 * _c + q > (j)) x[4 * _c + q] -= src[_c - 4][q] * x[(j)]; } } while (0)
        LT_LOAD(la, 16);
#pragma unroll
        for (int jj = 8; jj < 31; ++jj) {
            LT_LOAD(lb, 2 * jj + 1); asm volatile("" ::: "memory"); LT_APPLY(la, 2 * jj);
            LT_LOAD(la, 2 * jj + 2); asm volatile("" ::: "memory"); LT_APPLY(lb, 2 * jj + 1);
        }
        LT_APPLY(la, 62);
#undef LT_LOAD
#undef LT_APPLY
        if (isv) {
            LAS unsigned char* ub = lds + L_IMG + IMG_U + (((cc >> 5) * 4 * 64) + (cc & 31)) * 16;
#pragma unroll
            for (int i = 0; i < 64; ++i) { const int rt = i >> 5, ii = i & 31, hi = (ii >> 2) & 1, r = (ii & 3) + 4 * (ii >> 3);
                *(LAS bf16_t*)(ub + (((rt * 2 + (r >> 3)) * 64 + 32 * hi) * 8 + (r & 7)) * 2) = f2bf(x[i]); }
        } else {
            const int ks = cc >> 4, kk = cc & 15, hi = (kk >> 2) & 1, sl = (kk & 3) + 4 * (kk >> 3);
            LAS unsigned char* wb = lds + L_IMG + IMG_W + (ks * 64 + 32 * hi) * 16 + sl * 2;
#pragma unroll
            for (int i = 0; i < 64; ++i) *(LAS bf16_t*)(wb + ((i >> 5) * 8 * 64 + (i & 31)) * 16) = f2bf(-x[i]);
        }
    } else {
        const int u = tid - 256, dk = u & 127, i0 = (u >> 7) * 32; const float gl = GC[63];
#pragma unroll 4
        for (int ii = 0; ii < 32; ++ii) { const int i = i0 + ii; const float gi = GC[i];
            const float q = bf2f(*(const LAS bf16_t*)(lds + L_QB + i * 272 + dk * 2)), k = bf2f(*(const LAS bf16_t*)(lds + L_KB + i * 272 + dk * 2));
            *(LAS bf16_t*)(lds + L_IMG + IMG_QG + afrag_off(i, dk, 8)) = f2bf(q * __expf(gi));
            *(LAS bf16_t*)(lds + L_IMG + IMG_KDT + afrag_off(dk, i, 4)) = f2bf(k * __expf(gl - gi)); }
    }
    __syncthreads();
    for (int q = tid; q < CH_BYTES / 16; q += NTHREADS) *(u32x4*)(dst + (size_t)q * 16) = *(const LAS u32x4*)(lds + L_IMG + q * 16);
}

constexpr int OB_OFF = 2 * IMG_BYTES, OB_STR = 272, OB_BYTES = 64 * OB_STR;
__device__ __forceinline__ void gated_load_z(const Args& a, u32x4 (&zw)[4], int b, int h, int cc, int w4, int lane) {
    const bf16_t* P = (const bf16_t*)(a.ws + WS_P);
    const int s = 64 * (cc - 1) + 16 * w4 + (lane >> 2);
    const u32x4* zp = (const u32x4*)(P + ((size_t)b * LSEQ + NMETA + s) * NPROJ + PC_Z + h * HD + 32 * (lane & 3));
#pragma unroll
    for (int q = 0; q < 4; ++q) zw[q] = zp[q];
}
__device__ __forceinline__ float silu_f(float z) { return z * __builtin_amdgcn_rcpf(1.0f + __expf(-z)); }
__device__ __forceinline__ void gated_rows(const Args& a, const LAS unsigned char* ob, const u32x4 (&zw)[4], int b, int h, int cc, int w4, int lane, const f32x4 (&nwv)[8]) {
    bf16_t* MIX = (bf16_t*)(a.ws + WS_MIX);
    const int row = lane >> 2, qd = lane & 3, s = 64 * (cc - 1) + 16 * w4 + row;
    u32x4 ov[4]; float ss = 0.f;
#pragma unroll
    for (int q = 0; q < 4; ++q) { ov[q] = *(const LAS u32x4*)(ob + (16 * w4 + row) * OB_STR + qd * 64 + q * 16);
#pragma unroll
        for (int e = 0; e < 4; ++e) { const float lo = bf_lo(ov[q][e]), hi = bf_hi(ov[q][e]); ss += lo * lo + hi * hi; } }
    ss = quad_sum(ss);
    const float rstd = __builtin_amdgcn_rsqf(ss * (1.0f / HD) + NORM_EPS);
    u32x4* dst = (u32x4*)(MIX + ((size_t)b * SEQ + s) * DM + h * HD + 32 * qd);
#pragma unroll
    for (int q = 0; q < 4; ++q) { u32x4 w;
#pragma unroll
        for (int e = 0; e < 4; ++e) { const f32x4 nv = nwv[2 * q + (e >> 1)];
            const float n0 = (e & 1) ? nv.z : nv.x, n1 = (e & 1) ? nv.w : nv.y;
            w[e] = cvt_pk_bf16(bf_lo(ov[q][e]) * rstd * n0 * silu_f(bf_lo(zw[q][e])), bf_hi(ov[q][e]) * rstd * n1 * silu_f(bf_hi(zw[q][e]))); }
        dst[q] = w; }
}

__device__ __forceinline__ void scan(const Args& a, LAS unsigned char* lds, int bh, int tid, int lane, int wave) {
    const int b = bh >> 3, h = bh & 7, col = lane & 31, hi = lane >> 5, cg = wave;
    const unsigned char* src = a.ws + WS_GCH + (size_t)bh * NCH * CH_BYTES;
    const float* GL = (const float*)(a.ws + WS_GL) + bh * NCH;
    __syncthreads();
    const unsigned dvoff = (unsigned)(wave * 1024 + lane * 16), uvoff = (unsigned)(lane * 16);
#define GDN_DMA(ch, buf) do { const unsigned char* _sp = src + (size_t)(ch) * CH_BYTES; _Pragma("unroll") for (int _f = 0; _f < 7; ++_f) { \
        __builtin_amdgcn_global_load_lds((const unsigned*)(_sp + _f * 8192 + dvoff), (LAS unsigned*)(lds + (buf) * IMG_BYTES + wave * 1024 + _f * 8192), 16, 0, 0); } } while (0)
    GDN_DMA(0, 0);
#define GDN_STEP_END(vm) do { asm volatile("s_waitcnt vmcnt(" #vm ")" ::: "memory"); asm volatile("s_waitcnt lgkmcnt(0)" ::: "memory"); __builtin_amdgcn_s_barrier(); asm volatile("" ::: "memory"); } while (0)
    if (wave < 4) {
        f32x16 st[4]; bf16x8 Sb[8]; u32x4 ureg[4]; float gl;
#pragma unroll
        for (int t4 = 0; t4 < 4; ++t4)
#pragma unroll
            for (int r = 0; r < 16; ++r) st[t4][r] = 0.f;
#pragma unroll
        for (int ks = 0; ks < 8; ++ks) Sb[ks] = (bf16x8){0, 0, 0, 0, 0, 0, 0, 0};
#pragma unroll
        for (int q = 0; q < 4; ++q) ureg[q] = *(const u32x4*)(src + IMG_U + cg * 4096 + q * 1024 + uvoff);
        gl = GL[0];
        GDN_STEP_END(0);
        for (int c = 0; c < NCH; ++c) {
            const LAS unsigned char* img = lds + (c & 1) * IMG_BYTES + lane * 16;
            asm volatile("" : "+v"(ureg[0]), "+v"(ureg[1]), "+v"(ureg[2]), "+v"(ureg[3]), "+v"(gl));
            if (c + 1 < NCH) GDN_DMA(c + 1, (c + 1) & 1);
            f32x16 vn[2]; const float glc = gl;
#pragma unroll
            for (int rt = 0; rt < 2; ++rt)
#pragma unroll
                for (int rh = 0; rh < 2; ++rh) { const u32x4 w = ureg[rt * 2 + rh];
                    vn[rt][8 * rh + 0] = bf_lo(w.x); vn[rt][8 * rh + 1] = bf_hi(w.x); vn[rt][8 * rh + 2] = bf_lo(w.y); vn[rt][8 * rh + 3] = bf_hi(w.y);
                    vn[rt][8 * rh + 4] = bf_lo(w.z); vn[rt][8 * rh + 5] = bf_hi(w.z); vn[rt][8 * rh + 6] = bf_lo(w.w); vn[rt][8 * rh + 7] = bf_hi(w.w); }
            asm volatile("" ::: "memory");
            if (c + 1 < NCH) {
#pragma unroll
                for (int q = 0; q < 4; ++q) ureg[q] = *(const u32x4*)(src + (size_t)(c + 1) * CH_BYTES + IMG_U + cg * 4096 + q * 1024 + uvoff);
                gl = GL[c + 1]; }
#pragma unroll
            for (int rt = 0; rt < 2; ++rt) { __builtin_amdgcn_sched_barrier(0);
#pragma unroll
                for (int ks = 0; ks < 8; ++ks) vn[rt] = __builtin_amdgcn_mfma_f32_32x32x16_bf16(*(const LAS bf16x8*)(img + IMG_W + (rt * 8 + ks) * 1024), Sb[ks], vn[rt], 0, 0, 0); }
            __builtin_amdgcn_sched_barrier(0);
            bf16x8 vb[4];
#pragma unroll
            for (int ks = 0; ks < 4; ++ks) vb[ks] = sba_pack8(vn[ks >> 1], 8 * (ks & 1));
            LAS unsigned char* obw = lds + OB_OFF + (c & 1) * OB_BYTES + (32 * cg + col) * 2;
#pragma unroll
            for (int rt = 0; rt < 2; ++rt) { f32x16 o; __builtin_amdgcn_sched_barrier(0);
#pragma unroll
                for (int r = 0; r < 16; ++r) o[r] = 0.f;
#pragma unroll
                for (int ks = 0; ks < 8; ++ks) o = __builtin_amdgcn_mfma_f32_32x32x16_bf16(*(const LAS bf16x8*)(img + IMG_QG + (rt * 8 + ks) * 1024), Sb[ks], o, 0, 0, 0);
#pragma unroll
                for (int ks = 0; ks < 2 * (rt + 1); ++ks) o = __builtin_amdgcn_mfma_f32_32x32x16_bf16(*(const LAS bf16x8*)(img + IMG_AT + (rt * 4 + ks) * 1024), vb[ks], o, 0, 0, 0);
                if (c >= 1) {
#pragma unroll
                    for (int r = 0; r < 16; ++r) *(LAS bf16_t*)(obw + (32 * rt + crow(r, hi)) * OB_STR) = f2bf(o[r]); }
            }
#pragma unroll
            for (int t4 = 0; t4 < 4; ++t4) { __builtin_amdgcn_sched_barrier(0);
#pragma unroll
                for (int r = 0; r < 16; ++r) st[t4][r] *= glc;
#pragma unroll
                for (int ks = 0; ks < 4; ++ks) st[t4] = __builtin_amdgcn_mfma_f32_32x32x16_bf16(*(const LAS bf16x8*)(img + IMG_KDT + (t4 * 4 + ks) * 1024), vb[ks], st[t4], 0, 0, 0);
                Sb[2 * t4] = sba_pack8(st[t4], 0); Sb[2 * t4 + 1] = sba_pack8(st[t4], 8); }
            if (c + 1 < NCH) GDN_STEP_END(5); else GDN_STEP_END(0);
        }
    } else {
        u32x4 zA[4], zB[4]; f32x4 nwv[8];
#pragma unroll
        for (int q = 0; q < 4; ++q) { zA[q] = (u32x4){0u, 0u, 0u, 0u}; zB[q] = (u32x4){0u, 0u, 0u, 0u}; }
#pragma unroll
        for (int q = 0; q < 8; ++q) nwv[q] = *(const f32x4*)(a.in[I_GDNNW] + 32 * (lane & 3) + 4 * q);
        GDN_STEP_END(0);
        for (int c = 0; c < NCH; ++c) {
#pragma unroll
            for (int q = 0; q < 4; ++q) asm volatile("" : "+v"(zA[q]), "+v"(zB[q]));
            if (c + 1 < NCH) GDN_DMA(c + 1, (c + 1) & 1);
            if (c >= 1) { if (c & 1) gated_load_z(a, zA, b, h, c, wave - 4, lane); else gated_load_z(a, zB, b, h, c, wave - 4, lane); }
            asm volatile("" ::: "memory");
            if (c >= 2) { if (c & 1) gated_rows(a, lds + OB_OFF + ((c - 1) & 1) * OB_BYTES, zB, b, h, c - 1, wave - 4, lane, nwv);
                          else gated_rows(a, lds + OB_OFF + ((c - 1) & 1) * OB_BYTES, zA, b, h, c - 1, wave - 4, lane, nwv); }
            if (c >= 2) GDN_STEP_END(4); else GDN_STEP_END(0);
        }
        gated_rows(a, lds + OB_OFF + ((NCH - 1) & 1) * OB_BYTES, zB, b, h, NCH - 1, wave - 4, lane, nwv);
    }
#undef GDN_STEP_END
#undef GDN_DMA
}
}

namespace sba {
#define KSWZ(row, colB) ((row) * 256 + ((colB) ^ (((row) & 7) << 4)))
__device__ __forceinline__ int v_st(int k, int c) { const int kk = (k & ~0xC) | ((k & 4) << 1) | ((k & 8) >> 1); return ((kk >> 3) * 4 + (c >> 5)) * 512 + ((kk & 7) * 32 + (c & 31)) * 2; }
__device__ __forceinline__ int v_rd_base(int lane) { return ((lane & 3) << 3) | (((lane >> 2) & 3) << 6) | (((lane >> 4) & 1) << 5) | (((lane >> 5) & 1) << 8); }
constexpr int v_rd_off(int d0, int ks, int half) { return d0 * 512 + ks * 4096 + half * 2048; }
template <int OFF> __device__ __forceinline__ s16x4 tr_read(int vb) { s16x4 r; asm volatile("ds_read_b64_tr_b16 %0, %1 offset:%2" : "=&v"(r) : "v"(vb), "i"(OFF) : "memory"); return r; }
template <int D0> __device__ __forceinline__ void pv_one(f32x16& od, int vb, bf16x8 pa0, bf16x8 pa1, bf16x8 pa2, bf16x8 pa3) {
    const s16x4 l0 = tr_read<v_rd_off(D0, 0, 0)>(vb), h0 = tr_read<v_rd_off(D0, 0, 1)>(vb), l1 = tr_read<v_rd_off(D0, 1, 0)>(vb), h1 = tr_read<v_rd_off(D0, 1, 1)>(vb);
    const s16x4 l2 = tr_read<v_rd_off(D0, 2, 0)>(vb), h2 = tr_read<v_rd_off(D0, 2, 1)>(vb), l3 = tr_read<v_rd_off(D0, 3, 0)>(vb), h3 = tr_read<v_rd_off(D0, 3, 1)>(vb);
    asm volatile("s_waitcnt lgkmcnt(0)" ::: "memory"); __builtin_amdgcn_sched_barrier(0);
#define PK(L, H) (bf16x8){L[0], L[1], L[2], L[3], H[0], H[1], H[2], H[3]}
    od = __builtin_amdgcn_mfma_f32_32x32x16_bf16(pa0, PK(l0, h0), od, 0, 0, 0);
    od = __builtin_amdgcn_mfma_f32_32x32x16_bf16(pa1, PK(l1, h1), od, 0, 0, 0);
    od = __builtin_amdgcn_mfma_f32_32x32x16_bf16(pa2, PK(l2, h2), od, 0, 0, 0);
    od = __builtin_amdgcn_mfma_f32_32x32x16_bf16(pa3, PK(l3, h3), od, 0, 0, 0);
#undef PK
}
__device__ __forceinline__ int crow(int r, int hi) { return (r & 3) + 8 * (r >> 2) + 4 * hi; }
__device__ __forceinline__ int swap34(int k) { return (k & ~0x18) | ((k & 8) << 1) | ((k & 16) >> 1); }
__device__ __forceinline__ bf16x8 pack8(const f32x16& p, int base) {
    u32x4 w; w.x = cvt_pk_bf16(p[base + 0], p[base + 1]); w.y = cvt_pk_bf16(p[base + 2], p[base + 3]); w.z = cvt_pk_bf16(p[base + 4], p[base + 5]); w.w = cvt_pk_bf16(p[base + 6], p[base + 7]);
    return __builtin_bit_cast(bf16x8, w);
}
constexpr float SB_EXIT = 160.0f;

__device__ __forceinline__ void unit(const Args& a, LAS unsigned char* lds, volatile LAS int* done_cnt, int b, int h, int qb, int tid, int lane, int wid) {
    const bf16_t* QN = (const bf16_t*)(a.ws + WS_QN) + (size_t)(b * NHEAD + h) * LROW * HD;
    const bf16_t* KN = (const bf16_t*)(a.ws + WS_KN) + (size_t)(b * NHEAD + h) * LROW * HD;
    const bf16_t* Vp = (const bf16_t*)(a.ws + WS_P) + (size_t)b * LSEQ * NPROJ + PC_SBV + h * HD;
    bf16_t* MIX = (bf16_t*)(a.ws + WS_MIX);
    const int r32 = lane & 31, hi = lane >> 5;
    LAS unsigned char* K_lds = lds; LAS unsigned char* V_lds = lds + 16384;
    const int tq0 = NMETA + 256 * qb + 32 * wid, tq = tq0 + r32;
    __syncthreads();
    if (tid == 0) *done_cnt = 0;
    bf16x8 qr[8];
#pragma unroll
    for (int d0 = 0; d0 < 8; ++d0) qr[d0] = *(const bf16x8*)(QN + (size_t)tq * HD + d0 * 16 + hi * 8);
    const int sr = tid >> 4, sc = (tid & 15) * 8;
    const int vst0 = v_st(swap34(sr), sc), vst1 = v_st(32 + swap34(sr), sc);
    const int kst0 = KSWZ(sr, sc * 2), kst1 = KSWZ(32 + sr, sc * 2);
    const int vb0 = (int)(unsigned)(unsigned long)V_lds + v_rd_base(lane);
    const int prow = (r32 & 3) + 4 * (r32 >> 3) + 16 * ((r32 >> 2) & 1);
    f32x16 o[4];
#pragma unroll
    for (int d = 0; d < 4; ++d)
#pragma unroll
        for (int r = 0; r < 16; ++r) o[d][r] = 0.f;
    float carry = 0.f; bool flagged = false;
    bf16x8 ks0, ks1, vs0, vs1;
#define SBA_LOAD(kk) do { const int _k0 = 64 * (kk); ks0 = *(const bf16x8*)(KN + (size_t)(_k0 + sr) * HD + sc); ks1 = *(const bf16x8*)(KN + (size_t)(_k0 + 32 + sr) * HD + sc); \
        vs0 = *(const bf16x8*)(Vp + (size_t)(_k0 + sr) * NPROJ + sc); vs1 = *(const bf16x8*)(Vp + (size_t)(_k0 + 32 + sr) * NPROJ + sc); } while (0)
    SBA_LOAD(4 * qb + 4);
    for (int kt = 4 * qb + 4; kt >= 0; --kt) {
        const int k0 = 64 * kt;
        __syncthreads();
        if (*done_cnt == NWAVES) break;
        *(LAS bf16x8*)(K_lds + kst0) = ks0; *(LAS bf16x8*)(K_lds + kst1) = ks1; *(LAS bf16x8*)(V_lds + vst0) = vs0; *(LAS bf16x8*)(V_lds + vst1) = vs1;
        if (kt > 0) SBA_LOAD(kt - 1);
        __syncthreads();
        if (k0 >= tq0 + 32) continue;
        f32x16 p0, p1;
#pragma unroll
        for (int r = 0; r < 16; ++r) { p0[r] = 0.f; p1[r] = 0.f; }
#pragma unroll
        for (int d0 = 0; d0 < 8; ++d0) { const int cb = (d0 * 16 + hi * 8) * 2;
            const bf16x8 b0 = *(const LAS bf16x8*)(K_lds + KSWZ(prow, cb)), b1 = *(const LAS bf16x8*)(K_lds + KSWZ(32 + prow, cb));
            p0 = __builtin_amdgcn_mfma_f32_32x32x16_bf16(b0, qr[d0], p0, 0, 0, 0);
            p1 = __builtin_amdgcn_mfma_f32_32x32x16_bf16(b1, qr[d0], p1, 0, 0, 0); }
        const bool need_mask = (k0 + 63 >= tq0);
        f32x16 s0, s1; float t0 = 0.f, t1 = 0.f;
#pragma unroll
        for (int r = 0; r < 16; ++r) {
            float e0 = __builtin_amdgcn_exp2f(p0[r]), e1 = __builtin_amdgcn_exp2f(p1[r]);
            float q0 = __builtin_amdgcn_logf(1.0f + e0), q1 = __builtin_amdgcn_logf(1.0f + e1);
            if (need_mask) { const bool v0 = (k0 + 16 * hi + r) < tq, v1 = (k0 + 32 + 16 * hi + r) < tq; e0 = v0 ? e0 : 0.f; q0 = v0 ? q0 : 0.f; e1 = v1 ? e1 : 0.f; q1 = v1 ? q1 : 0.f; }
            p0[r] = e0; p1[r] = e1; s0[r] = q0; s1[r] = q1; t0 += q0; t1 += q1; }
        float t1lo, t1hi, t0lo, t0hi;
        { auto rr = __builtin_amdgcn_permlane32_swap(__float_as_uint(t1), __float_as_uint(t1), false, false); t1lo = __uint_as_float(rr[0]); t1hi = __uint_as_float(rr[1]); }
        { auto rr = __builtin_amdgcn_permlane32_swap(__float_as_uint(t0), __float_as_uint(t0), false, false); t0lo = __uint_as_float(rr[0]); t0hi = __uint_as_float(rr[1]); }
        float run1 = carry + (hi ? 0.f : t1hi), run0 = carry + (t1lo + t1hi) + (hi ? 0.f : t0hi);
#pragma unroll
        for (int r = 15; r >= 0; --r) { run1 += s1[r]; p1[r] = p1[r] * __builtin_amdgcn_exp2f(-run1); run0 += s0[r]; p0[r] = p0[r] * __builtin_amdgcn_exp2f(-run0); }
        carry += (t1lo + t1hi) + (t0lo + t0hi);
        const bf16x8 pa0 = pack8(p0, 0), pa1 = pack8(p0, 8), pa2 = pack8(p1, 0), pa3 = pack8(p1, 8);
        pv_one<0>(o[0], vb0, pa0, pa1, pa2, pa3); pv_one<1>(o[1], vb0, pa0, pa1, pa2, pa3); pv_one<2>(o[2], vb0, pa0, pa1, pa2, pa3); pv_one<3>(o[3], vb0, pa0, pa1, pa2, pa3);
        if (!flagged && __all(carry >= SB_EXIT)) { flagged = true; if (lane == 0) (void)__hip_atomic_fetch_add((LAS int*)done_cnt, 1, __ATOMIC_RELAXED, __HIP_MEMORY_SCOPE_WORKGROUP); }
    }
#undef SBA_LOAD
    const float* onw = a.in[I_SBONW];
    float wv[4];
#pragma unroll
    for (int d0 = 0; d0 < 4; ++d0) wv[d0] = onw[32 * d0 + r32];
#pragma unroll
    for (int r = 0; r < 16; ++r) {
        float ss = (o[0][r] * o[0][r] + o[1][r] * o[1][r]) + (o[2][r] * o[2][r] + o[3][r] * o[3][r]);
        ss = row16_sum(ss); ss += __shfl_xor(ss, 16);
        const float rstd = 1.0f / sqrtf(ss * (1.0f / HD) + NORM_EPS);
        const size_t tok = (size_t)b * SEQ + (tq0 - NMETA) + crow(r, hi);
        bf16_t* dst = MIX + tok * DM + 1024 + h * HD + r32;
#pragma unroll
        for (int d0 = 0; d0 < 4; ++d0) dst[32 * d0] = (bf16_t)(cvt_pk_bf16(o[d0][r] * rstd * wv[d0], 0.f) & 0xffffu);
    }
}
}

__device__ __forceinline__ void p5_router(const Args& a, LAS unsigned char* lds, int G, int c, int tid, int lane, int wave) {
    LAS float* wl = (LAS float*)lds;
    LAS float* lg = (LAS float*)(lds + 132096);
    LAS int* misc = (LAS int*)(lds + MISC_OFF);
    const float* H1 = a.out; const float* rw = a.in[I_RW]; const float* rb = a.in[I_RB];
    unsigned char* HN2 = a.ws + WS_HN;
    int* RE = (int*)(a.ws + WS_RE); int* RP = (int*)(a.ws + WS_RP); float* RG = (float*)(a.ws + WS_RG); int* LIST = (int*)(a.ws + WS_LIST);
    unsigned* ecnt = (unsigned*)(a.ws + WS_CTL) + CW_ECNT;
    f32x4 wn[8];
#pragma unroll
    for (int j = 0; j < 8; ++j) wn[j] = *((const f32x4*)a.in[I_FFNNW] + lane + 64 * j);
    for (int blk = c; blk < NREAL / 64; blk += G) {
        for (int pass = 0; pass < 2; ++pass) {
            __syncthreads();
            stage_w16(wl, rw, NEXP, pass * 16, tid);
            if (pass == 0 && tid < 32) misc[40 + tid] = 0;
            __syncthreads();
            for (int rg = 0; rg < 4; ++rg) {
                f32x4 v[2][8];
#pragma unroll
                for (int k = 0; k < 2; ++k) { const size_t row = (size_t)blk * 64 + wave * 8 + rg * 2 + k;
#pragma unroll
                    for (int j = 0; j < 8; ++j) v[k][j] = *((const f32x4*)(H1 + row * DM) + lane + 64 * j); }
#pragma unroll
                for (int k = 0; k < 2; ++k) { const size_t row = (size_t)blk * 64 + wave * 8 + rg * 2 + k; float ss = 0.f;
#pragma unroll
                    for (int j = 0; j < 8; ++j) ss += (v[k][j].x * v[k][j].x + v[k][j].y * v[k][j].y) + (v[k][j].z * v[k][j].z + v[k][j].w * v[k][j].w);
                    const float rstd = 1.0f / sqrtf(wave_sum(ss) * (1.0f / DM) + NORM_EPS);
                    GAS unsigned* o4 = (GAS unsigned*)(HN2 + row * DM) + lane;
#pragma unroll
                    for (int j = 0; j < 8; ++j) { v[k][j] = v[k][j] * rstd * wn[j];
                        if (pass == 0) o4[64 * j] = pk4_fp8(v[k][j].x, v[k][j].y, v[k][j].z, v[k][j].w); } }
#pragma unroll
                for (int hf = 0; hf < 2; ++hf) { float o8[2][8]; dot8xN<2>(v, wl + hf * 8 * WLS, lane, o8);
#pragma unroll
                    for (int k = 0; k < 2; ++k) { float sv = o8[k][0];
#pragma unroll
                        for (int c = 1; c < 8; ++c) sv = ((lane & 7) == c) ? o8[k][c] : sv;
                        if (lane < 8) lg[(wave * 8 + rg * 2 + k) * 33 + pass * 16 + hf * 8 + lane] = sv; } }
            }
        }
        __syncthreads();
        int ek[4] = {0, 0, 0, 0}, rk[4] = {0, 0, 0, 0}; float gk[4] = {0.f, 0.f, 0.f, 0.f};
        if (tid < 64) {
            float v[32];
#pragma unroll
            for (int e = 0; e < 32; ++e) v[e] = lg[tid * 33 + e] + rb[e];
            float val[4];
#pragma unroll
            for (int k = 0; k < 4; ++k) { float best = -3.0e38f; int bi = 0;
#pragma unroll
                for (int e = 0; e < 32; ++e) { const bool gt = v[e] > best; best = gt ? v[e] : best; bi = gt ? e : bi; }
#pragma unroll
                for (int e = 0; e < 32; ++e) v[e] = (e == bi) ? -3.0e38f : v[e];
                ek[k] = bi; val[k] = best; }
            float den = 0.f;
#pragma unroll
            for (int k = 0; k < 4; ++k) { gk[k] = expf(val[k] - val[0]); den += gk[k]; }
#pragma unroll
            for (int k = 0; k < 4; ++k) { gk[k] = gk[k] / den; rk[k] = __hip_atomic_fetch_add(&misc[40 + ek[k]], 1, __ATOMIC_RELAXED, __HIP_MEMORY_SCOPE_WORKGROUP); }
        }
        __syncthreads();
        if (tid < 32) { const int cnt = misc[40 + tid]; misc[72 + tid] = cnt ? (int)atomicAdd(&ecnt[tid], (unsigned)cnt) : 0; }
        __syncthreads();
        if (tid < 64) { const int tok = blk * 64 + tid;
#pragma unroll
            for (int k = 0; k < 4; ++k) { const int pos = misc[72 + ek[k]] + rk[k]; LIST[(size_t)ek[k] * NREAL + pos] = tok; RE[tok * 4 + k] = ek[k]; RP[tok * 4 + k] = pos; RG[tok * 4 + k] = gk[k]; } }
    }
    __syncthreads();
}

__device__ __forceinline__ int moe_setup(const Args& a, LAS int* misc, int tid) {
    const unsigned* ecnt = (const unsigned*)(a.ws + WS_CTL) + CW_ECNT;
    __syncthreads();
    if (tid == 0) { int acc = 0;
        for (int e = 0; e < NEXP; ++e) { const int cnt = (int)__hip_atomic_load(ecnt + e, __ATOMIC_RELAXED, __HIP_MEMORY_SCOPE_AGENT); misc[104 + e] = cnt; misc[e] = acc; acc += (cnt + 255) >> 8; }
        misc[32] = acc; }
    __syncthreads();
    return misc[32];
}

__device__ __forceinline__ void p8_combine(const Args& a, const LAS int* misc, int gw, int NGW, int lane) {
    const int* RE = (const int*)(a.ws + WS_RE); const int* RP = (const int*)(a.ws + WS_RP); const float* RG = (const float*)(a.ws + WS_RG);
    const bf16_t* Y = (const bf16_t*)(a.ws + WS_Y); float* out = a.out;
    typedef int i32x4 __attribute__((ext_vector_type(4)));
    i32x4 e4 = {0, 0, 0, 0}, p4 = {0, 0, 0, 0}; f32x4 g4 = {0.f, 0.f, 0.f, 0.f};
    if (gw < NREAL) { e4 = *(const i32x4*)(RE + gw * 4); p4 = *(const i32x4*)(RP + gw * 4); g4 = *(const f32x4*)(RG + gw * 4); }
    for (int row = gw; row < NREAL; row += NGW) {
        size_t slot[4]; float g[4];
#pragma unroll
        for (int k = 0; k < 4; ++k) { slot[k] = (size_t)misc[e4[k]] * 256 + p4[k]; g[k] = g4[k]; }
        const int nrow = row + NGW;
        if (nrow < NREAL) { e4 = *(const i32x4*)(RE + nrow * 4); p4 = *(const i32x4*)(RP + nrow * 4); g4 = *(const f32x4*)(RG + nrow * 4); }
        f32x4 acc[4][2]; u32x4 y[4][4];
#pragma unroll
        for (int j = 0; j < 4; ++j) { const int col = 8 * lane + 512 * j;
            acc[j][0] = *(const f32x4*)(out + (size_t)row * DM + col); acc[j][1] = *(const f32x4*)(out + (size_t)row * DM + col + 4);
#pragma unroll
            for (int k = 0; k < 4; ++k) y[j][k] = *(const u32x4*)(Y + slot[k] * DM + col); }
#pragma unroll
        for (int j = 0; j < 4; ++j) { const int col = 8 * lane + 512 * j; f32x4 a0 = acc[j][0], a1 = acc[j][1];
#pragma unroll
            for (int k = 0; k < 4; ++k) { const u32x4 yy = y[j][k];
                a0.x += g[k] * bf_lo(yy.x); a0.y += g[k] * bf_hi(yy.x); a0.z += g[k] * bf_lo(yy.y); a0.w += g[k] * bf_hi(yy.y);
                a1.x += g[k] * bf_lo(yy.z); a1.y += g[k] * bf_hi(yy.z); a1.z += g[k] * bf_lo(yy.w); a1.w += g[k] * bf_hi(yy.w); }
            *(f32x4*)(out + (size_t)row * DM + col) = a0; *(f32x4*)(out + (size_t)row * DM + col + 4) = a1; }
    }
}

__device__ __forceinline__ void p1_meta_rows(const Args& a, LAS unsigned char* lds, int bx, int G, int tid, int wave, int lane) {
    const bf16_t* HN = (const bf16_t*)(a.ws + WS_HN); const bf16_t* WT = (const bf16_t*)(a.ws + WS_WIN); bf16_t* P = (bf16_t*)(a.ws + WS_P);
    for (int q = tid; q < NMETA * DM * 2 / 16; q += NTHREADS) *(LAS u32x4*)(lds + q * 16) = *(const u32x4*)((const unsigned char*)HN + (size_t)q * 16);
    __syncthreads();
    for (int col = bx + G * wave; col < NPROJ; col += G * NWAVES) {
        u32x4 w[4]; int lane_o = lane; asm volatile("" : "+v"(lane_o));
#pragma unroll
        for (int j = 0; j < 4; ++j) w[j] = *(const u32x4*)(WT + (size_t)col * DM + 8 * lane + 512 * j);
        float v = 0.f;
#pragma unroll 1
        for (int t = 0; t < NMETA; ++t) { float s = 0.f;
#pragma unroll
            for (int j = 0; j < 4; ++j) { const u32x4 x = *(const LAS u32x4*)(lds + t * (DM * 2) + (8 * lane_o + 512 * j) * 2);
                s += bf_lo(x.x) * bf_lo(w[j].x) + bf_hi(x.x) * bf_hi(w[j].x) + bf_lo(x.y) * bf_lo(w[j].y) + bf_hi(x.y) * bf_hi(w[j].y)
                   + bf_lo(x.z) * bf_lo(w[j].z) + bf_hi(x.z) * bf_hi(w[j].z) + bf_lo(x.w) * bf_lo(w[j].w) + bf_hi(x.w) * bf_hi(w[j].w); }
            s = wave_sum(s);
            v = ((lane & 15) == t) ? s : v; }
        P[((size_t)(lane >> 4) * LSEQ + (lane & 15)) * NPROJ + col] = gdn::f2bf(v);
    }
    __syncthreads();
}

constexpr int NPH = 9;
__global__ void __launch_bounds__(NTHREADS, 2) hymba_fwd(Args args) {
    extern __shared__ __attribute__((aligned(16))) unsigned char lds_raw[];
    LAS unsigned char* lds = (LAS unsigned char*)lds_raw;
    LAS int* misc = (LAS int*)(lds + MISC_OFF);
    const int tid = threadIdx.x, lane = tid & 63, wave = __builtin_amdgcn_readfirstlane(tid >> 6);
    const int G = gridDim.x, bx = blockIdx.x;
    const int vcu = (G % 8 == 0) ? (bx % 8) * (G / 8) + bx / 8 : bx;
    const int gw = vcu * NWAVES + wave, NGW = G * NWAVES;
    unsigned* ctl = (unsigned*)(args.ws + WS_CTL);
    for (int u = tid; u < 256; u += NTHREADS) misc[u] = 0;
    __syncthreads();
    XcdBarrier bar; bar.bar = ctl + CW_BAR; bar.x = 0; bar.st = nullptr;
    const int lo = args.ph_lo, hi = args.ph_hi;
    const int NCV = 0, GG = G - NCV;
    constexpr int CVT_LIMIT_P1 = 0, CVT_LIMIT_P2 = MOE_ITEMS * 35 / 100, CVT_LIMIT_P3 = MOE_ITEMS;
    if (hi - lo > 1) bar = xcd_barrier_post(ctl + CW_BAR, (volatile LAS unsigned*)(misc + 200));
#ifdef ONLY
#define IN(k) ((k) == ONLY && lo <= (k) && (k) < hi)
#else
#define IN(k) (lo <= (k) && (k) < hi)
#endif
#ifndef REP_COUNT
#define REP_COUNT 2
#endif
#define REPEAT(k) _Pragma("unroll") for (int _r = 0; _r < ((REP_PHASE == (k)) ? REP_COUNT : 1); ++_r)
#define SEAM(k) do { if (IN(k) && IN((k) + 1)) xcd_barrier(bar); if (PROBE_A >= 0 && tid == 0) tsl[(k) + 1] = __builtin_amdgcn_s_memrealtime(); } while (0)

    LAS unsigned long long* tsl = (LAS unsigned long long*)(lds + MISC_OFF + 896);
    if (PROBE_A >= 0 && tid == 0) tsl[0] = __builtin_amdgcn_s_memrealtime();
    if (IN(0)) REPEAT(0) { p0_rows(args, lds, gw, NGW, tid, lane); p0_weights(args, lds, vcu, G, wave, lane); }
    SEAM(0);
    if (IN(1)) REPEAT(1) {
        p1_meta_rows(args, lds, bx, G, tid, wave, lane);
        if (bx < GG) {
        pg8::PlainOrder S; S.init(NREAL, NPROJ, DM, args.ws + WS_WIN, GG, bx); S.meta = 1;
        pg8::EpiBf16 E{(bf16_t*)(args.ws + (_r ? WS_ACT : WS_P)), NPROJ, 1};
        pg8::gemm_phase<pg8::EpiBf16, pg8::PlainOrder, true, true>(lds, (const char*)(args.ws + WS_HN), DM * 2, S, E);
        } else moe_weights_queue(args, lds, misc + 212, tid, wave, lane, CVT_LIMIT_P1);
    }
    SEAM(1);
    if (IN(2)) REPEAT(2) {
        p2_qknorm(args, gw, NGW, lane);
#if GDN_CHUNKED
        const bool roleB = (G >= 128) && (bx >= G - G / 8 * 3);
        if (roleB) moe_weights_queue(args, lds, misc + 212, tid, wave, lane, CVT_LIMIT_P2);
        int claim = (tid == 0) ? (int)atomicAdd(ctl + CW_PREQ, 1u) : 0;
        for (;;) {
            __syncthreads();
            if (tid == 0) misc[213] = claim;
            __syncthreads();
            const int it = *(volatile LAS int*)(misc + 213);
            if (it >= 32 * gdn::NCH) break;
            if (tid == 0) claim = (int)atomicAdd(ctl + CW_PREQ, 1u);
            gdn::precompute(args, lds, it, tid, lane, wave);
        }
        if (!roleB) moe_weights_queue(args, lds, misc + 212, tid, wave, lane, CVT_LIMIT_P2);
#endif
    }
    SEAM(2);
    if (IN(3)) REPEAT(3) {
        const int NG = (G >= 64) ? 32 : 0;
#if GDN_CHUNKED
        if (bx < 32 || NG == 0) { for (int it = bx; it < 32; it += G) gdn::scan(args, lds, it, tid, lane, wave); }
#else
        if (bx < 32 || NG == 0) { for (int it = bx; it < 32; it += G) p3_gdn_naive(args, lds, it, tid, lane, wave); }
#endif
        if (bx >= NG) { for (int u = bx - NG; u < 512; u += G - NG) sba::unit(args, lds, (volatile LAS int*)(misc + 210), u >> 7, (u >> 4) & 7, u & 15, tid, lane, wave); }
        if (_r == 0) moe_weights_queue(args, lds, misc + 212, tid, wave, lane, NCV ? CVT_LIMIT_P3 : MOE_ITEMS);
    }
    SEAM(3);
    if (IN(4)) REPEAT(4) {
        pg8::PlainOrder S; S.init(NREAL, DM, DM, args.ws + WS_WOUT, G, bx);
        pg8::EpiResF32 E{args.in[I_X], _r ? (float*)(args.ws + WS_ACT) : args.out, DM};
        pg8::gemm_phase<pg8::EpiResF32, pg8::PlainOrder, true, true>(lds, (const char*)(args.ws + WS_MIX), DM * 2, S, E);
    }
    SEAM(4);
    if (IN(5)) p5_router(args, lds, G, bx, tid, lane, wave);
    SEAM(5);
    if (IN(6)) REPEAT(6) {
        if (bx >= GG) moe_weights_queue(args, lds, misc + 212, tid, wave, lane, MOE_ITEMS);
        else {
        const int mt = moe_setup(args, misc, tid);
        pg8::MoeOrder<true> S; S.tpre = misc; S.tok = (const LAS int*)(lds + TOK_OFF); S.nN = 16; S.nwg = mt * 16; S.G = GG; S.c = bx;
        S.Bt = (const char*)(args.ws + WS_WGU); S.estride = (size_t)2 * DE * DM; S.K2 = DM;
        const int* LIST = (const int*)(args.ws + WS_LIST);
        S.ud = misc + 140; S.fill_units(misc + 140, tid);
        __syncthreads();
        for (int idx = tid; idx < TOK_CAP * 256; idx += NTHREADS) { pg8::Unit u; if (!S.next(idx >> 8, u)) break;
            const int r = (u.pm - misc[u.e]) * 256 + (idx & 255); ((LAS int*)(lds + TOK_OFF))[idx] = r < misc[104 + u.e] ? LIST[(size_t)u.e * NREAL + r] : 0; }
        __syncthreads();
        pg8::EpiSwiGLU E{args.ws + WS_ACT, args.in[I_BGU]};
        pg8::gemm_phase<pg8::EpiSwiGLU, pg8::MoeOrder<true>, true, true, true>(lds, (const char*)(args.ws + WS_HN), DM, S, E);
        }
    }
    SEAM(6);
    if (IN(7)) REPEAT(7) {
        const int mt = moe_setup(args, misc, tid);
        pg8::MoeOrder<false> S; S.tpre = misc; S.tok = nullptr; S.nN = 8; S.nwg = mt * 8; S.G = G; S.c = bx;
        S.Bt = (const char*)(args.ws + WS_WD); S.estride = (size_t)DM * DE; S.K2 = DE;
        S.ud = misc + 140; S.fill_units(misc + 140, tid);
        __syncthreads();
        pg8::EpiBf16 E{(bf16_t*)(args.ws + (_r ? WS_WGU : WS_Y)), DM, 0, args.in[I_BD]};
        pg8::gemm_phase<pg8::EpiBf16, pg8::MoeOrder<false>, true, true, true>(lds, (const char*)(args.ws + WS_ACT), DE, S, E);
    }
    SEAM(7);
    if (IN(8)) { (void)moe_setup(args, misc, tid); p8_combine(args, misc, gw, NGW, lane); }
#if PROBE_A >= 0
    __syncthreads();
    if (tid == 0) tsl[9] = __builtin_amdgcn_s_memrealtime();
    __syncthreads();
    {
        const int pa = PROBE_A;
        const float us = (float)(pa == 9 ? (tsl[9] - tsl[0]) : (tsl[pa + 1] - tsl[pa])) * 1e-2f;
        const float f = 1.0f - 0.05f * us / (float)(PROBE_REF_US);
        VM_WAIT();
        for (int row = gw; row < NREAL; row += NGW) {
#pragma unroll
            for (int j = 0; j < 8; ++j) { f32x4* p = (f32x4*)(args.out + (size_t)row * DM) + lane + 64 * j; *p = *p * f; } }
    }
#endif
#undef IN
#undef SEAM
}

extern "C" void kernel_launch(void* const* d_in, const int* in_sizes, int n_in, void* d_out, int out_size, void* d_ws, size_t ws_size, hipStream_t stream) {
    static int grid = 0;
    if (grid == 0) {
        if (n_in != 19 || out_size != NREAL * DM || ws_size < WS_END) { fprintf(stderr, "kernel_launch: unexpected shapes (n_in %d out %d ws %zu need %zu)\n", n_in, out_size, ws_size, (size_t)WS_END); grid = -1; return; }
        int dev = 0, cus = 0, per_cu = 0;
        if (hipGetDevice(&dev) != hipSuccess || hipDeviceGetAttribute(&cus, hipDeviceAttributeMultiprocessorCount, dev) != hipSuccess) { grid = -1; return; }
        if (hipFuncSetAttribute((const void*)hymba_fwd, hipFuncAttributeMaxDynamicSharedMemorySize, LDS_BYTES) != hipSuccess) { fprintf(stderr, "kernel_launch: hipFuncSetAttribute failed\n"); grid = -1; return; }
        if (hipOccupancyMaxActiveBlocksPerMultiprocessor(&per_cu, (const void*)hymba_fwd, NTHREADS, LDS_BYTES) != hipSuccess || per_cu < 1) { fprintf(stderr, "kernel_launch: occupancy query says %d\n", per_cu); grid = -1; return; }
        (void)hipGetLastError();
        grid = cus;
    }
    if (grid < 0) return;
    (void)hipMemsetAsync((char*)d_ws + WS_CTL, 0, CTL_ZERO_BYTES, stream);
    Args a{};
    for (int i = 0; i < 19; ++i) a.in[i] = (const float*)d_in[i];
    a.out = (float*)d_out; a.ws = (unsigned char*)d_ws;
#if MK_N_LAUNCHES == 1
    a.ph_lo = 0; a.ph_hi = NPH;
    hipLaunchKernelGGL(hymba_fwd, dim3(grid), dim3(NTHREADS), LDS_BYTES, stream, a);
#else
    for (int p = 0; p < NPH; ++p) { a.ph_lo = p; a.ph_hi = p + 1; hipLaunchKernelGGL(hymba_fwd, dim3(grid), dim3(NTHREADS), LDS_BYTES, stream, a); }
#endif
    const hipError_t le = hipPeekAtLastError();
    if (le != hipSuccess) fprintf(stderr, "kernel_launch: launch failed: %s\n", hipGetErrorName(le));
}
```

```cpp
#include <hip/hip_runtime.h>
#include <cstdio>
#include <cstdint>

#ifndef MK_N_LAUNCHES
#define MK_N_LAUNCHES 1
#endif

constexpr int NB = 4, SEQ = 4096, NMETA = 16, LSEQ = SEQ + NMETA;
constexpr int DM = 2048, NTOK = NB * LSEQ  , MPAD = 16640  , NREAL = NB * SEQ  ;
constexpr int NPROJ_SRC = 7184, NPROJ = 7168;
constexpr int NHEAD = 8, HD = 128;
constexpr int PC_QKV = 0, PC_Z = 3072, PC_SBQ = 4096, PC_SBK = 5120, PC_SBV = 6144;
constexpr int NEXP = 32, TOPK = 4, DE = 2048;
constexpr int SLOT_ROWS = 73728;
constexpr int LROW = 4224;
constexpr float NORM_EPS = 1e-6f;

constexpr size_t MiB = 1u << 20;
constexpr size_t WS_CTL = 0, CTL_ZERO_BYTES = 1 * MiB;
constexpr size_t WS_WIN = 1 * MiB;
constexpr size_t WS_WOUT = WS_WIN + (size_t)NPROJ * DM * 2;
constexpr size_t WS_WGU = WS_WOUT + (size_t)DM * DM * 2;
constexpr size_t WS_WD = WS_WGU + (size_t)NEXP * 2 * DE * DM * 2;
constexpr size_t WS_HN = WS_WD + (size_t)NEXP * DM * DE * 2;
constexpr size_t WS_BETA = WS_HN + (size_t)MPAD * DM * 2;
constexpr size_t WS_G = WS_BETA + (size_t)NTOK * 8 * 4 + 256;
constexpr size_t WS_P = WS_G + (size_t)NTOK * 8 * 4 + 256;
constexpr size_t WS_QN = WS_P + (size_t)MPAD * NPROJ * 2;
constexpr size_t WS_KN = WS_QN + (size_t)NB * NHEAD * LROW * HD * 2;
constexpr size_t WS_ORAW = WS_KN + (size_t)NB * NHEAD * LROW * HD * 2;
constexpr size_t WS_MIX = WS_ORAW + (size_t)NREAL * 1024 * 4;
constexpr size_t WS_RE = WS_MIX + (size_t)NREAL * DM * 2;
constexpr size_t WS_RP = WS_RE + (size_t)NREAL * 4 * 4;
constexpr size_t WS_RG = WS_RP + (size_t)NREAL * 4 * 4;
constexpr size_t WS_LIST = WS_RG + (size_t)NREAL * 4 * 4;
constexpr size_t WS_ACT = WS_LIST + (size_t)NEXP * NREAL * 4;
constexpr size_t WS_Y = WS_ACT + (size_t)SLOT_ROWS * DE * 2;
constexpr size_t WS_GCH = WS_Y + (size_t)SLOT_ROWS * DM * 2;
constexpr size_t WS_GL = WS_GCH + (size_t)32 * 65 * 73728;
constexpr size_t WS_END = WS_GL + 32 * 65 * 4 + 256;
constexpr int CW_ECNT = 64;
constexpr int CW_CVTQ = 192;
constexpr int CVT_NLD_P2 = 4;
constexpr int CW_PREQ = 256;
constexpr int CW_BAR = 4096;

constexpr int LDS_STAGE = 131072;
constexpr int TOK_OFF = LDS_STAGE, TOK_CAP = 22;
constexpr int MISC_OFF = TOK_OFF + TOK_CAP * 256 * 4;
constexpr int LDS_BYTES = MISC_OFF + 1024;

#define GAS __attribute__((address_space(1)))
#define LAS __attribute__((address_space(3)))
typedef unsigned short bf16_t;
typedef short bf16x8 __attribute__((ext_vector_type(8)));
typedef short s16x4 __attribute__((ext_vector_type(4)));
typedef float f32x4 __attribute__((ext_vector_type(4)));
typedef float f32x2 __attribute__((ext_vector_type(2)));
typedef float f32x16 __attribute__((ext_vector_type(16)));
typedef unsigned u32x4 __attribute__((ext_vector_type(4)));
typedef unsigned u32x2 __attribute__((ext_vector_type(2)));

typedef __bf16 bf16x2_t __attribute__((ext_vector_type(2)));
__device__ __forceinline__ unsigned cvt_pk_bf16(float lo, float hi) { const f32x2 v = {lo, hi}; const bf16x2_t b = __builtin_convertvector(v, bf16x2_t); return __builtin_bit_cast(unsigned, b); }
__device__ __forceinline__ unsigned pk4_fp8(float a, float b, float c, float d) { unsigned w = 0u; w = __builtin_amdgcn_cvt_pk_fp8_f32(a, b, w, false); w = __builtin_amdgcn_cvt_pk_fp8_f32(c, d, w, true); return w; }
__device__ __forceinline__ float bf_lo(unsigned w) { return __uint_as_float(w << 16); }
__device__ __forceinline__ float bf_hi(unsigned w) { return __uint_as_float(w & 0xffff0000u); }
__device__ __forceinline__ float bf2f(bf16_t b) { return __uint_as_float(((unsigned)b) << 16); }
template <int CTRL, int ROW_MASK> __device__ __forceinline__ float dpp_get(float v) {
    return __builtin_bit_cast(float, __builtin_amdgcn_update_dpp(0, __builtin_bit_cast(int, v), CTRL, ROW_MASK, 0xF, false));
}
__device__ __forceinline__ float row16_sum(float v) {
    v += dpp_get<0xB1, 0xF>(v);
    v += dpp_get<0x4E, 0xF>(v);
    v += dpp_get<0x141, 0xF>(v);
    v += dpp_get<0x140, 0xF>(v);
    return v;
}
__device__ __forceinline__ float quad_sum(float v) { v += dpp_get<0xB1, 0xF>(v); v += dpp_get<0x4E, 0xF>(v); return v; }
__device__ __forceinline__ float wave_sum(float v) {
    v = row16_sum(v);
    v += dpp_get<0x142, 0xA>(v);
    v += dpp_get<0x143, 0xC>(v);
    return __builtin_bit_cast(float, __builtin_amdgcn_readlane(__builtin_bit_cast(int, v), 63));
}

namespace pg8 {
constexpr int BM = 256, BK = 64, HALF = 128, HTB = HALF * BK * 2, STAGE_BYTES = 8 * HTB, NXCD = 8, WGM = 8;
__host__ __device__ __forceinline__ int lds_byte(int r, int c) { const int st = (r >> 4) * 2 + (c >> 5), rr = r & 15, cc = c & 31, ob = rr * 64 + cc * 2; return st * 1024 + (ob ^ (((ob >> 9) & 1) << 5)); }
__host__ __device__ __forceinline__ void stage_rc(int b, int& R, int& C) { const int st = b / 1024, sb = b % 1024, swz = sb ^ (((sb >> 9) & 1) << 5); R = (st >> 1) * 16 + swz / 64; C = (st & 1) * 32 + (swz % 64) / 2; }
__host__ __device__ __forceinline__ int perm32(int rho) { const int n = rho >> 4, i = rho & 15; return 8 * (i >> 2) + 4 * n + (i & 3); }

typedef int v8i __attribute__((ext_vector_type(8))); typedef int v4i __attribute__((ext_vector_type(4)));
__device__ __forceinline__ v8i cat8(bf16x8 lo, bf16x8 hi) { const v4i a = __builtin_bit_cast(v4i, lo), b = __builtin_bit_cast(v4i, hi); return __builtin_shufflevector(a, b, 0, 1, 2, 3, 4, 5, 6, 7); }
struct Unit { int pm, pn, e, ui; };

__device__ __forceinline__ int xcd_remap(int L, int nwg) { const int q = nwg / NXCD, r = nwg % NXCD, xcd = L % NXCD, off = L / NXCD; return (xcd < r ? xcd * (q + 1) : r * (q + 1) + (xcd - r) * q) + off; }

struct PlainOrder {
    int nM, nN, nwg, G, c; const char* Bt; unsigned K2;
    __device__ void init(int M, int N, int K, const void* Bt_, int G_, int c_) { nM = M / BM; nN = N / BM; nwg = nM * nN; G = G_; c = c_; Bt = (const char*)Bt_; K2 = (unsigned)K * 2u; }
    __device__ __forceinline__ bool next(int i, Unit& u) const {
        const long L = (long)i * G + c; if (L >= nwg) return false;
        const int wgid = xcd_remap((int)L, nwg);
        const int nig = WGM * nN, gid = wgid / nig, fm = gid * WGM, gsz = (nM - fm) < WGM ? (nM - fm) : WGM;
        u.pm = fm + ((wgid % nig) % gsz); u.pn = (wgid % nig) / gsz; u.e = 0; u.ui = i; return true;
    }
    __device__ __forceinline__ const char* b_ptr(const Unit& u) const { return Bt + (size_t)u.pn * BM * K2; }
    __device__ __forceinline__ unsigned a_off(const Unit& u, int r) const { return (unsigned)(u.pm * BM + r + (meta ? NMETA * ((u.pm >> 4) + 1) : 0)) * K2; }
    int meta = 0;
};
constexpr int UD_CAP = 24;
template <bool GATHER> struct MoeOrder {
    const LAS int* tpre; const LAS int* tok; const LAS int* ud; int nN, nwg, G, c; const char* Bt; size_t estride; unsigned K2;
    __device__ __forceinline__ int decode(int i) const {
        const long L = (long)i * G + c; if (L >= nwg) return -1;
        const int wgid = xcd_remap((int)L, nwg);
        int e = 0;
#pragma unroll 1
        for (int j = 1; j < NEXP; ++j) e = (wgid >= tpre[j] * nN) ? j : e;
        const int t0 = tpre[e], nt = tpre[e + 1] - t0, loc = wgid - t0 * nN;
        return e | ((t0 + loc % nt) << 6) | ((loc / nt) << 16);
    }
    __device__ __forceinline__ void fill_units(LAS int* udw, int tid) const { if (tid < UD_CAP) udw[tid] = decode(tid); }
    __device__ __forceinline__ bool next(int i, Unit& u) const {
        if (i >= UD_CAP) return false;
        const int d = ud[i]; if (d < 0) return false;
        u.e = d & 63; u.pm = (d >> 6) & 1023; u.pn = d >> 16; u.ui = i; return true;
    }
    __device__ __forceinline__ const char* b_ptr(const Unit& u) const { return Bt + (size_t)u.e * estride + (size_t)u.pn * BM * K2; }
    __device__ __forceinline__ unsigned a_off(const Unit& u, int r) const {
        if (GATHER) return (unsigned)tok[u.ui * 256 + r] * K2;
        return (unsigned)(u.pm * BM + r) * K2;
    }
};

struct EpiBf16 {
    static constexpr bool PERM = true;
    bf16_t* O; int ldc; int meta; const float* ebias = nullptr;
    __device__ __forceinline__ void operator()(const f32x4 (&acc)[2][2][4][2], const Unit& u, int wr, int wc, int fr, int fq) const {
        const int row0 = u.pm * BM + wr * 64 + fr + (meta ? NMETA * ((u.pm >> 4) + 1) : 0), col0 = u.pn * BM + wc * 32 + 8 * fq;
        f32x4 bv[2][2];
#pragma unroll
        for (int bj = 0; bj < 2; ++bj)
#pragma unroll
            for (int n = 0; n < 2; ++n) bv[bj][n] = ebias ? *(const f32x4*)(ebias + (size_t)u.e * ldc + col0 + bj * HALF + 4 * n) : (f32x4){0.f, 0.f, 0.f, 0.f};
#pragma unroll
        for (int ai = 0; ai < 2; ++ai)
#pragma unroll
            for (int m = 0; m < 4; ++m) { bf16_t* rowp = O + (size_t)(row0 + ai * HALF + m * 16) * ldc + col0;
#pragma unroll
                for (int bj = 0; bj < 2; ++bj) { const f32x4 v0 = acc[ai][bj][m][0] + bv[bj][0], v1 = acc[ai][bj][m][1] + bv[bj][1];
                    u32x4 w; w.x = cvt_pk_bf16(v0[0], v0[1]); w.y = cvt_pk_bf16(v0[2], v0[3]); w.z = cvt_pk_bf16(v1[0], v1[1]); w.w = cvt_pk_bf16(v1[2], v1[3]);
                    *(u32x4*)(rowp + bj * HALF) = w; } }
    }
};
struct EpiResF32 {
    static constexpr bool PERM = false;
    const float* X; float* out; int ldc;
    __device__ __forceinline__ void operator()(const f32x4 (&acc)[2][2][4][2], const Unit& u, int wr, int wc, int fr, int fq) const {
        const int row0 = u.pm * BM + wr * 64 + fr, col0 = u.pn * BM + wc * 32 + 4 * fq;
#pragma unroll
        for (int ai = 0; ai < 2; ++ai) {
            f32x4 xv[4][2][2];
#pragma unroll
            for (int m = 0; m < 4; ++m) { const size_t off = (size_t)(row0 + ai * HALF + m * 16) * ldc + col0;
#pragma unroll
                for (int bj = 0; bj < 2; ++bj)
#pragma unroll
                    for (int n = 0; n < 2; ++n) xv[m][bj][n] = *(const f32x4*)(X + off + bj * HALF + n * 16); }
#pragma unroll
            for (int m = 0; m < 4; ++m) { const size_t off = (size_t)(row0 + ai * HALF + m * 16) * ldc + col0;
#pragma unroll
                for (int bj = 0; bj < 2; ++bj)
#pragma unroll
                    for (int n = 0; n < 2; ++n) *(f32x4*)(out + off + bj * HALF + n * 16) = xv[m][bj][n] + acc[ai][bj][m][n]; }
            asm volatile("" ::: "memory"); }
    }
};
__device__ __forceinline__ float swiglu1(float g, float uu) {
    g = fminf(g, 7.0f); uu = fminf(fmaxf(uu, -7.0f), 7.0f);
    const float sg = __builtin_amdgcn_rcpf(1.0f + __builtin_amdgcn_exp2f(-1.702f * 1.4426950408889634f * g));
    return (uu + 1.0f) * g * sg;
}
struct EpiSwiGLU {
    static constexpr bool PERM = true;
    unsigned char* act; const float* bgu;
    __device__ __forceinline__ void operator()(const f32x4 (&acc)[2][2][4][2], const Unit& u, int wr, int wc, int fr, int fq) const {
        const int row0 = u.pm * BM + wr * 64 + fr, col0 = u.pn * HALF + wc * 32 + 8 * fq;
        const float* bg = bgu + (size_t)u.e * 4096 + col0;
        const f32x4 bg0 = *(const f32x4*)(bg), bg1 = *(const f32x4*)(bg + 4), bu0 = *(const f32x4*)(bg + 2048), bu1 = *(const f32x4*)(bg + 2052);
#pragma unroll
        for (int ai = 0; ai < 2; ++ai)
#pragma unroll
            for (int m = 0; m < 4; ++m) { unsigned char* rowp = act + (size_t)(row0 + ai * HALF + m * 16) * DE + col0;
                const f32x4 g0 = acc[ai][0][m][0] + bg0, g1 = acc[ai][0][m][1] + bg1, u0 = acc[ai][1][m][0] + bu0, u1 = acc[ai][1][m][1] + bu1;
                u32x2 w; w.x = pk4_fp8(swiglu1(g0[0], u0[0]), swiglu1(g0[1], u0[1]), swiglu1(g0[2], u0[2]), swiglu1(g0[3], u0[3]));
                w.y = pk4_fp8(swiglu1(g1[0], u1[0]), swiglu1(g1[1], u1[1]), swiglu1(g1[2], u1[2]), swiglu1(g1[3], u1[3]));
                *(u32x2*)rowp = w; }
    }
};

template <class Epi, class Sched, bool ALIGN_EPI, bool SP2, bool FP8 = false>
__device__ __forceinline__ void gemm_phase(LAS unsigned char* lds, const char* A0, int Kb, const Sched& S, const Epi& E) {
    const int tid = threadIdx.x, wid = __builtin_amdgcn_readfirstlane(tid >> 6), lane = tid & 63, wr = wid >> 2, wc = wid & 3, fr = lane & 15, fq = lane >> 4;
    const int nt = Kb / 128;
    int Rr[2], Cc[2]; unsigned voffB[2];
#pragma unroll
    for (int i = 0; i < 2; ++i) { int R, C; stage_rc(tid * 16 + i * 8192, R, C); const int Rb = Epi::PERM ? ((R & ~31) + perm32(R & 31)) : R;
        Rr[i] = R; Cc[i] = C * 2; voffB[i] = (unsigned)(Rb * Kb + C * 2); }
    const size_t kstep = (size_t)(BK * 2);
    const size_t hstep = (size_t)HALF * Kb;
    const unsigned ldsw = (unsigned)wid * 1024u;
    const int aoff = lds_byte(wr * 64 + fr, fq * 8), boff = lds_byte(wc * 32 + fr, fq * 8);
#define PG8_SA(b, h) (((b) * 2 + (h)) * HTB)
#define PG8_SB(b, h) ((4 + (b) * 2 + (h)) * HTB)
#define PG8_STAGE(bufoff, gbase, voff) do { _Pragma("unroll") for (int _i = 0; _i < 2; ++_i) \
        __builtin_amdgcn_global_load_lds((const unsigned*)((const char*)(gbase) + (voff)[_i]), (LAS unsigned*)(lds + (bufoff) + ldsw + _i * 8192), 16, 0, 0); } while (0)
#define PG8_LDA(dst, b, h) do { _Pragma("unroll") for (int m = 0; m < 4; ++m) _Pragma("unroll") for (int k = 0; k < 2; ++k) dst[m][k] = *(const LAS bf16x8*)(lds + PG8_SA(b, h) + aoff + m * 2048 + k * 1024); } while (0)
#define PG8_LDB(dst, b, h) do { _Pragma("unroll") for (int n = 0; n < 2; ++n) _Pragma("unroll") for (int k = 0; k < 2; ++k) dst[n][k] = *(const LAS bf16x8*)(lds + PG8_SB(b, h) + boff + n * 2048 + k * 1024); } while (0)
#define PG8_MMA(ai, bj, At, Bt) do { __builtin_amdgcn_s_setprio(1); _Pragma("unroll") for (int m = 0; m < 4; ++m) _Pragma("unroll") for (int n = 0; n < 2; ++n) { \
        if constexpr (FP8) acc[ai][bj][m][n] = __builtin_amdgcn_mfma_scale_f32_16x16x128_f8f6f4(cat8(Bt[n][0], Bt[n][1]), cat8(At[m][0], At[m][1]), acc[ai][bj][m][n], 0, 0, 0, 0x79797979, 0, 0x7f7f7f7f); \
        else { _Pragma("unroll") for (int k = 0; k < 2; ++k) acc[ai][bj][m][n] = __builtin_amdgcn_mfma_f32_16x16x32_bf16(Bt[n][k], At[m][k], acc[ai][bj][m][n], 0, 0, 0); } } \
        __builtin_amdgcn_s_setprio(0); } while (0)
#define PG8_WAIT_V(n) asm volatile("s_waitcnt vmcnt(" #n ")" ::: "memory")
#define PG8_WAIT_L(n) asm volatile("s_waitcnt lgkmcnt(" #n ")" ::: "memory")
#define PG8_BAR __builtin_amdgcn_s_barrier()
#define PG8_SCHED __builtin_amdgcn_sched_barrier(0)
#define PG8_VOFF(dst, u) do { _Pragma("unroll") for (int _h = 0; _h < 2; ++_h) _Pragma("unroll") for (int _i = 0; _i < 2; ++_i) dst[_h][_i] = S.a_off(u, _h * HALF + Rr[_i]) + (unsigned)Cc[_i]; } while (0)
    Unit cur, nxt; int ui = 0;
    if (!S.next(0, cur)) return;
    f32x4 acc[2][2][4][2];
#pragma unroll
    for (int a = 0; a < 2; ++a)
#pragma unroll
        for (int b = 0; b < 2; ++b)
#pragma unroll
            for (int m = 0; m < 4; ++m)
#pragma unroll
                for (int n = 0; n < 2; ++n) acc[a][b][m][n] = (f32x4){0.f, 0.f, 0.f, 0.f};
    bf16x8 At[4][2], B0[2][2], B1[2][2];
    unsigned va[2][2], vn[2][2];
    PG8_VOFF(va, cur);
    const char* cB = S.b_ptr(cur);
    if constexpr (SP2) {
        PG8_STAGE(PG8_SB(0, 0), cB, voffB); PG8_STAGE(PG8_SB(0, 1), cB + hstep, voffB); PG8_STAGE(PG8_SA(0, 0), A0, va[0]); PG8_STAGE(PG8_SA(0, 1), A0, va[1]);
        if (wr == 1) PG8_BAR;
        PG8_WAIT_V(2); PG8_BAR;
        PG8_STAGE(PG8_SB(1, 0), cB + kstep, voffB); PG8_STAGE(PG8_SA(1, 0), A0 + kstep, va[0]); PG8_STAGE(PG8_SB(1, 1), cB + hstep + kstep, voffB);
        PG8_WAIT_V(6); PG8_BAR;
    } else {
        PG8_STAGE(PG8_SB(0, 0), cB, voffB); PG8_STAGE(PG8_SA(0, 0), A0, va[0]); PG8_STAGE(PG8_SB(0, 1), cB + hstep, voffB); PG8_STAGE(PG8_SA(0, 1), A0, va[1]);
        if (wr == 1) PG8_BAR;
        PG8_WAIT_V(4); PG8_BAR;
        PG8_STAGE(PG8_SB(1, 0), cB + kstep, voffB); PG8_STAGE(PG8_SA(1, 0), A0 + kstep, va[0]); PG8_STAGE(PG8_SB(1, 1), cB + hstep + kstep, voffB);
        PG8_WAIT_V(6); PG8_BAR;
    }
    for (;;) {
        const bool has_next = S.next(ui + 1, nxt);
        const char* nB = has_next ? S.b_ptr(nxt) : cB;
        for (int t = 0; t < nt; t += 2) {
            const bool last = (t == nt - 2);
            const char* a1 = A0 + (size_t)(t + 1) * kstep;
            const char* a2 = last ? A0 : A0 + (size_t)(t + 2) * kstep; const char* b2 = last ? nB : cB + (size_t)(t + 2) * kstep;
            const char* a3 = a2 + kstep; const char* b3 = b2 + kstep;
            if (last) { if (has_next) { PG8_VOFF(vn, nxt); } else {
#pragma unroll
                    for (int _h = 0; _h < 2; ++_h)
#pragma unroll
                        for (int _i = 0; _i < 2; ++_i) vn[_h][_i] = va[_h][_i]; } }
            if constexpr (SP2) {
            PG8_LDB(B0, 0, 0); PG8_LDB(B1, 0, 1); PG8_SCHED; PG8_LDA(At, 0, 0); PG8_STAGE(PG8_SA(1, 1), a1, va[1]);
            if (last) {
#pragma unroll
                for (int _h = 0; _h < 2; ++_h)
#pragma unroll
                    for (int _i = 0; _i < 2; ++_i) va[_h][_i] = vn[_h][_i]; }
            PG8_WAIT_V(8); PG8_WAIT_L(0); PG8_BAR; PG8_MMA(0, 0, At, B0); PG8_MMA(0, 1, At, B1); PG8_BAR; PG8_SCHED;
            PG8_LDA(At, 0, 1); PG8_STAGE(PG8_SB(0, 0), b2, voffB); PG8_STAGE(PG8_SB(0, 1), b2 + hstep, voffB); PG8_STAGE(PG8_SA(0, 0), a2, va[0]);
            PG8_WAIT_V(8); PG8_WAIT_L(0); PG8_BAR; PG8_MMA(1, 0, At, B0); PG8_MMA(1, 1, At, B1); PG8_BAR; PG8_SCHED;
            PG8_LDB(B0, 1, 0); PG8_LDB(B1, 1, 1); PG8_SCHED; PG8_LDA(At, 1, 0); PG8_STAGE(PG8_SA(0, 1), a2, va[1]);
            PG8_WAIT_V(8); PG8_WAIT_L(0); PG8_BAR; PG8_MMA(0, 0, At, B0); PG8_MMA(0, 1, At, B1); PG8_BAR; PG8_SCHED;
            PG8_LDA(At, 1, 1); PG8_STAGE(PG8_SB(1, 0), b3, voffB); PG8_STAGE(PG8_SB(1, 1), b3 + hstep, voffB); PG8_STAGE(PG8_SA(1, 0), a3, va[0]);
            PG8_WAIT_V(8); PG8_WAIT_L(0); PG8_BAR; PG8_MMA(1, 0, At, B0); PG8_MMA(1, 1, At, B1); PG8_BAR; PG8_SCHED;
            } else {
            PG8_LDB(B0, 0, 0); PG8_SCHED; PG8_LDA(At, 0, 0); PG8_STAGE(PG8_SA(1, 1), a1, va[1]);
            if (last) {
#pragma unroll
                for (int _h = 0; _h < 2; ++_h)
#pragma unroll
                    for (int _i = 0; _i < 2; ++_i) va[_h][_i] = vn[_h][_i]; }
            PG8_WAIT_L(8); PG8_BAR; PG8_WAIT_L(0); PG8_MMA(0, 0, At, B0); PG8_BAR; PG8_SCHED;
            PG8_LDB(B1, 0, 1); PG8_STAGE(PG8_SB(0, 0), b2, voffB);
            PG8_BAR; PG8_WAIT_L(0); PG8_MMA(0, 1, At, B1); PG8_BAR;
            PG8_LDA(At, 0, 1); PG8_STAGE(PG8_SA(0, 0), a2, va[0]);
            PG8_BAR; PG8_WAIT_L(0); PG8_MMA(1, 0, At, B0); PG8_BAR; PG8_SCHED;
            PG8_STAGE(PG8_SB(0, 1), b2 + hstep, voffB);
            PG8_WAIT_V(6); PG8_BAR; PG8_MMA(1, 1, At, B1); PG8_BAR;
            PG8_LDB(B0, 1, 0); PG8_SCHED; PG8_LDA(At, 1, 0); PG8_STAGE(PG8_SA(0, 1), a2, va[1]);
            PG8_WAIT_L(8); PG8_BAR; PG8_WAIT_L(0); PG8_MMA(0, 0, At, B0); PG8_BAR; PG8_SCHED;
            PG8_LDB(B1, 1, 1); PG8_STAGE(PG8_SB(1, 0), b3, voffB);
            PG8_BAR; PG8_WAIT_L(0); PG8_MMA(0, 1, At, B1); PG8_BAR;
            PG8_LDA(At, 1, 1); PG8_STAGE(PG8_SA(1, 0), a3, va[0]);
            PG8_BAR; PG8_WAIT_L(0); PG8_MMA(1, 0, At, B0); PG8_BAR; PG8_SCHED;
            PG8_STAGE(PG8_SB(1, 1), b3 + hstep, voffB);
            PG8_WAIT_V(6); PG8_BAR; PG8_MMA(1, 1, At, B1); PG8_BAR;
            }
        }
        if constexpr (ALIGN_EPI) { if (wr == 0) PG8_BAR; }
        E(acc, cur, wr, wc, fr, fq);
        if (!has_next) break;
#pragma unroll
        for (int a = 0; a < 2; ++a)
#pragma unroll
            for (int b = 0; b < 2; ++b)
#pragma unroll
                for (int m = 0; m < 4; ++m)
#pragma unroll
                    for (int n = 0; n < 2; ++n) acc[a][b][m][n] = (f32x4){0.f, 0.f, 0.f, 0.f};
        cur = nxt; cB = nB; ++ui;
        if constexpr (ALIGN_EPI) { if (wr == 1) PG8_BAR; }
    }
    PG8_WAIT_V(0);
    if constexpr (!ALIGN_EPI) { if (wr == 0) PG8_BAR; }
    PG8_BAR;
#undef PG8_SA
#undef PG8_SB
#undef PG8_STAGE
#undef PG8_LDA
#undef PG8_LDB
#undef PG8_MMA
#undef PG8_WAIT_V
#undef PG8_WAIT_L
#undef PG8_BAR
#undef PG8_SCHED
#undef PG8_VOFF
}
}

#define XB_TMO      128
#define XB_XCNT(j)  (256  + 64 * (j))
#define XB_XSUB(j)  (1280 + 64 * (j))
#define XB_XGEN(j)  (2304 + 64 * (j))
#define XB_TOP      3328
#define XB_TOPGEN   3392
#define XCD_BAR_WORDS 3456
#define XB_SPIN_CAP (1u << 18)

__device__ __forceinline__ unsigned xb_ld(unsigned* p)              { return __hip_atomic_load(p, __ATOMIC_RELAXED, __HIP_MEMORY_SCOPE_AGENT); }
__device__ __forceinline__ unsigned xb_add(unsigned* p, unsigned v) { return __hip_atomic_fetch_add(p, v, __ATOMIC_RELAXED, __HIP_MEMORY_SCOPE_AGENT); }
__device__ __forceinline__ unsigned xb_xcc_id() { return (unsigned)__builtin_amdgcn_s_getreg((3 << 11) | 20) & 0xFu; }
#define XB_SPIN(cond, bar) do { unsigned _sp = 0; while (cond) { __builtin_amdgcn_s_sleep(1); \
    if ((++_sp & 255u) == 0u) { if (xb_ld(&(bar)[XB_TMO])) break; if (_sp > XB_SPIN_CAP) { atomicAdd(&(bar)[XB_TMO], 1u); break; } } } } while (0)

struct XcdBarrier {
    unsigned* bar; unsigned x;
    volatile LAS unsigned* st;
};
__device__ __forceinline__ XcdBarrier xcd_barrier_post(unsigned* bar, volatile LAS unsigned* st) {
    XcdBarrier b; b.bar = bar; b.x = xb_xcc_id(); b.st = st;
    if (threadIdx.x == 0) (void)xb_add(&bar[XB_XCNT(b.x)], 1u);
    return b;
}
__device__ __forceinline__ void xcd_barrier_complete(unsigned* bar, unsigned x, unsigned& nloc, unsigned& nx) {
    const unsigned G = gridDim.x * gridDim.y * gridDim.z;
    unsigned sum, cnt, mine, sp = 0u;
    for (;;) {
        sum = 0u; cnt = 0u; mine = 0u;
#pragma unroll
        for (unsigned j = 0; j < 16; ++j) { const unsigned c = xb_ld(&bar[XB_XCNT(j)]); sum += c; cnt += (c > 0u) ? 1u : 0u; mine = (j == x) ? c : mine; }
        if (sum == G) break;
        __builtin_amdgcn_s_sleep(1);
        if ((++sp & 255u) == 0u) { if (xb_ld(&bar[XB_TMO])) break; if (sp > XB_SPIN_CAP) { atomicAdd(&bar[XB_TMO], 1u); break; } }
    }
    nloc = mine > 0u ? mine : 1u; nx = cnt > 0u ? cnt : 1u;
}
__device__ __forceinline__ void xcd_barrier(const XcdBarrier& b) {
    asm volatile("s_waitcnt vmcnt(0)" ::: "memory");
    __syncthreads();
    if (threadIdx.x == 0) {
        unsigned* bar = b.bar;
        __builtin_amdgcn_s_waitcnt(0);
        unsigned nloc = b.st[0], nx = b.st[1];
        if (nloc == 0u) { xcd_barrier_complete(bar, b.x, nloc, nx); b.st[0] = nloc; b.st[1] = nx; }
        const unsigned old = xb_add(&bar[XB_XSUB(b.x)], 1u);
        const unsigned gen = old / nloc;
        if (old + 1u == (gen + 1u) * nloc) {
            __builtin_amdgcn_fence(__ATOMIC_RELEASE, "agent");
            asm volatile("s_waitcnt vmcnt(0)" ::: "memory");
            const unsigned og = xb_add(&bar[XB_TOP], 1u);
            const unsigned tg = og / nx;
            if (og + 1u == (tg + 1u) * nx) xb_add(&bar[XB_TOPGEN], 1u);
            else XB_SPIN(xb_ld(&bar[XB_TOPGEN]) == tg, bar);
            __builtin_amdgcn_fence(__ATOMIC_ACQUIRE, "agent");
            xb_add(&bar[XB_XGEN(b.x)], 1u);
            asm volatile("s_waitcnt vmcnt(0)" ::: "memory");
        } else {
            XB_SPIN(xb_ld(&bar[XB_XGEN(b.x)]) == gen, bar);
            __builtin_amdgcn_fence(__ATOMIC_ACQUIRE, "agent");
            asm volatile("s_waitcnt vmcnt(0)" ::: "memory");
        }
    }
    __syncthreads();
}

constexpr int NWAVES = 8, NTHREADS = 512;
struct Args { const float* in[19]; float* out; unsigned char* ws; int ph_lo, ph_hi; };
enum { I_X = 0, I_META, I_MIXNW, I_WIN, I_CONVW, I_ALOG, I_DTB, I_GDNNW, I_SBQNW, I_SBKNW, I_SBONW, I_WOUT, I_FFNNW, I_RW, I_RB, I_WGU, I_BGU, I_WD, I_BD };

#define LDS_WAIT() asm volatile("s_waitcnt lgkmcnt(0)" ::: "memory")
#define VM_WAIT() asm volatile("s_waitcnt vmcnt(0)" ::: "memory")
constexpr int WLS = 2052;

__device__ __forceinline__ void dot16(const f32x4 (&v)[8], const LAS float* wl, int lane, float (&s)[16]) {
#pragma unroll
    for (int c = 0; c < 16; ++c) { float a = 0.f;
#pragma unroll
        for (int j = 0; j < 8; ++j) { const f32x4 w = *(const LAS f32x4*)(wl + c * WLS + 4 * lane + 256 * j); a += (v[j].x * w.x + v[j].y * w.y) + (v[j].z * w.z + v[j].w * w.w); }
        s[c] = wave_sum(a); }
}

template <int NR> __device__ __forceinline__ void dot8xN(const f32x4 (&v)[NR][8], const LAS float* wl, int lane, float (&out)[NR][8]) {
#pragma unroll
    for (int c = 0; c < 8; ++c) { float a[NR];
#pragma unroll
        for (int k = 0; k < NR; ++k) a[k] = 0.f;
#pragma unroll
        for (int j = 0; j < 8; ++j) { const f32x4 w = *(const LAS f32x4*)(wl + c * WLS + 4 * lane + 256 * j);
#pragma unroll
            for (int k = 0; k < NR; ++k) a[k] += (v[k][j].x * w.x + v[k][j].y * w.y) + (v[k][j].z * w.z + v[k][j].w * w.w); }
#pragma unroll
        for (int k = 0; k < NR; ++k) out[k][c] = wave_sum(a[k]); }
}
__device__ __forceinline__ void stage_w16(LAS float* wl, const float* base, int ld, int coloff, int tid) {
#pragma unroll 4
    for (int idx = tid; idx < 2048 * 4; idx += NTHREADS) { const int k = idx >> 2, q = idx & 3; const f32x4 v = *(const f32x4*)(base + (size_t)k * ld + coloff + 4 * q);
        wl[(4 * q + 0) * WLS + k] = v.x; wl[(4 * q + 1) * WLS + k] = v.y; wl[(4 * q + 2) * WLS + k] = v.z; wl[(4 * q + 3) * WLS + k] = v.w; }
}

__device__ __forceinline__ void p0_rows(const Args& a, LAS unsigned char* lds, int gw, int NGW, int tid, int lane) {
    const float* x = a.in[I_X]; const float* meta = a.in[I_META]; const float* nw = a.in[I_MIXNW]; const float* win = a.in[I_WIN];
    LAS float* wl = (LAS float*)lds;
    stage_w16(wl, win, NPROJ_SRC, 4096, tid);
    __syncthreads();
    bf16_t* HN = (bf16_t*)(a.ws + WS_HN); float* BETA = (float*)(a.ws + WS_BETA); float* GG = (float*)(a.ws + WS_G);
    f32x4 wn[8];
#pragma unroll
    for (int j = 0; j < 8; ++j) wn[j] = *((const f32x4*)nw + lane + 64 * j);
    const int hh = lane & 7;
    const float alog = a.in[I_ALOG][hh], dtb = a.in[I_DTB][hh];
    constexpr int NR0 = 2;
    for (int row0 = gw; row0 < MPAD; row0 += NR0 * NGW) {
        f32x4 v[NR0][8]; float bv[NR0], av[NR0];
        int lane_o = lane; asm volatile("" : "+v"(lane_o));
#pragma unroll
        for (int k = 0; k < NR0; ++k) { const int row = row0 + k * NGW;
            if (row < NTOK) { const int b = row / LSEQ, t = row - b * LSEQ;
                const float* src = (t < NMETA) ? meta + (size_t)t * DM : x + ((size_t)b * SEQ + (t - NMETA)) * DM;
#pragma unroll
                for (int j = 0; j < 8; ++j) v[k][j] = *((const f32x4*)src + lane + 64 * j);
            } else {
#pragma unroll
                for (int j = 0; j < 8; ++j) v[k][j] = (f32x4){0.f, 0.f, 0.f, 0.f}; } }
#pragma unroll
        for (int k = 0; k < NR0; ++k) { const int row = row0 + k * NGW; float ss = 0.f;
#pragma unroll
            for (int j = 0; j < 8; ++j) ss += (v[k][j].x * v[k][j].x + v[k][j].y * v[k][j].y) + (v[k][j].z * v[k][j].z + v[k][j].w * v[k][j].w);
            const float rstd = 1.0f / sqrtf(wave_sum(ss) * (1.0f / DM) + NORM_EPS);
            if (row < MPAD) { GAS unsigned long long* o8 = (GAS unsigned long long*)(HN + (size_t)row * DM) + lane;
#pragma unroll
                for (int j = 0; j < 8; ++j) { v[k][j] = v[k][j] * rstd * wn[j];
                    o8[64 * j] = (unsigned long long)cvt_pk_bf16(v[k][j].x, v[k][j].y) | ((unsigned long long)cvt_pk_bf16(v[k][j].z, v[k][j].w) << 32); } } }
        { float o8[NR0][8]; dot8xN<NR0>(v, wl, lane_o, o8);
#pragma unroll
            for (int k = 0; k < NR0; ++k) { bv[k] = o8[k][0];
#pragma unroll
                for (int c = 1; c < 8; ++c) bv[k] = (hh == c) ? o8[k][c] : bv[k]; }
            dot8xN<NR0>(v, wl + 8 * WLS, lane_o, o8);
#pragma unroll
            for (int k = 0; k < NR0; ++k) { av[k] = o8[k][0];
#pragma unroll
                for (int c = 1; c < 8; ++c) av[k] = (hh == c) ? o8[k][c] : av[k]; } }
#pragma unroll
        for (int k = 0; k < NR0; ++k) { const int row = row0 + k * NGW;
            if (lane < 8 && row < NTOK) {
                const float beta = 1.0f / (1.0f + expf(-bv[k]));
                const float xa = av[k] + dtb; const float sp = fmaxf(xa, 0.f) + log1pf(expf(-fabsf(xa)));
                BETA[(size_t)row * 8 + hh] = beta; GG[(size_t)row * 8 + hh] = -expf(alog) * sp; } }
    }
    __syncthreads();
}

constexpr int CVT_STR = 132;
template <int MODE  >
__device__ __forceinline__ void cvt_tile(const float* W, int ldw, int K, bf16_t* out, int kb, int nt, LAS unsigned char* T, int lane) {
    const int r0 = nt * 64;
    int c0;
    if (MODE == 0) c0 = r0;
    else if (MODE == 1) c0 = r0 < 4096 ? r0 : r0 + 16;
    else { const int pn = r0 >> 8, rr = r0 & 255; c0 = rr < 128 ? 128 * pn + rr : 2048 + 128 * pn + (rr - 128); }
    const int kq = lane >> 4, nl = lane & 15;
    const float* src = W + (size_t)(kb * 64 + 2 * kq) * ldw + c0 + 4 * nl;
    f32x4 v[8][2];
#pragma unroll
    for (int i = 0; i < 8; ++i)
#pragma unroll
        for (int j = 0; j < 2; ++j) v[i][j] = *(const f32x4*)(src + (size_t)(8 * i + j) * ldw);
    LAS unsigned char* tw = T + (4 * nl) * CVT_STR + 4 * kq;
#pragma unroll
    for (int i = 0; i < 8; ++i)
#pragma unroll
        for (int q = 0; q < 4; ++q) *(LAS unsigned*)(tw + q * CVT_STR + 16 * i) = cvt_pk_bf16(v[i][0][q], v[i][1][q]);
    LDS_WAIT();
    const int rn = lane >> 3, cc = lane & 7;
    const LAS unsigned char* tr = T + rn * CVT_STR + 16 * cc;
    bf16_t* dst = out + (size_t)(r0 + rn) * K + kb * 64 + 8 * cc;
#pragma unroll
    for (int j = 0; j < 8; ++j) { u32x4 w; const LAS unsigned* p = (const LAS unsigned*)(tr + 8 * j * CVT_STR); w.x = p[0]; w.y = p[1]; w.z = p[2]; w.w = p[3];
        *(u32x4*)(dst + (size_t)(8 * j) * K) = w; }
    LDS_WAIT();
}
constexpr float W8_SCALE = 64.0f;
template <int MODE, int NLD = 8>
__device__ __forceinline__ void cvt_tile_fp8(const float* W, int ldw, int K, unsigned char* out, int kb, int nt, LAS unsigned char* T, int lane) {
    const int r0 = nt * 64;
    int c0;
    if (MODE == 0) c0 = r0;
    else { const int pn = r0 >> 8, rr = r0 & 255; c0 = rr < 128 ? 128 * pn + rr : 2048 + 128 * pn + (rr - 128); }
    const int kq = lane >> 4, nl = lane & 15;
    LAS unsigned char* tw = T + (4 * nl) * CVT_STR + 4 * kq;
    const float* src = W + (size_t)(kb * 128 + 4 * kq) * ldw + c0 + 4 * nl;
#pragma unroll
    for (int i0 = 0; i0 < 8; i0 += NLD) {
        f32x4 v[NLD][4];
#pragma unroll
        for (int i = 0; i < NLD; ++i)
#pragma unroll
            for (int j = 0; j < 4; ++j) v[i][j] = *(const f32x4*)(src + (size_t)(16 * (i0 + i) + j) * ldw);
#pragma unroll
        for (int i = 0; i < NLD; ++i)
#pragma unroll
            for (int q = 0; q < 4; ++q) *(LAS unsigned*)(tw + q * CVT_STR + 16 * (i0 + i)) =
                pk4_fp8(v[i][0][q] * W8_SCALE, v[i][1][q] * W8_SCALE, v[i][2][q] * W8_SCALE, v[i][3][q] * W8_SCALE);
    }
    LDS_WAIT();
    const int rn = lane >> 3, cc = lane & 7;
    const LAS unsigned char* tr = T + rn * CVT_STR + 16 * cc;
    unsigned char* dst = out + (size_t)(r0 + rn) * K + kb * 128 + 16 * cc;
#pragma unroll
    for (int j = 0; j < 8; ++j) { u32x4 w; const LAS unsigned* p = (const LAS unsigned*)(tr + 8 * j * CVT_STR); w.x = p[0]; w.y = p[1]; w.z = p[2]; w.w = p[3];
        *(u32x4*)(dst + (size_t)(8 * j) * K) = w; }
    LDS_WAIT();
}
__device__ __forceinline__ void p0_weights(const Args& a, LAS unsigned char* lds, int vcu, int G, int wave, int lane) {
    constexpr int I_IN = 32 * 14, I_OUT = 32 * 4;
    constexpr int NITEMS = I_IN + I_OUT;
    LAS unsigned char* T = lds + wave * (64 * CVT_STR);
    for (int it = vcu; it < NITEMS; it += G) {
        int r = it;
        if (r < I_IN) { cvt_tile<1>(a.in[I_WIN], NPROJ_SRC, DM, (bf16_t*)(a.ws + WS_WIN), r / 14, (r % 14) * 8 + wave, T, lane); continue; } r -= I_IN;
        cvt_tile<0>(a.in[I_WOUT], DM, DM, (bf16_t*)(a.ws + WS_WOUT), r / 4, (r % 4) * 8 + wave, T, lane);
    }
}
constexpr int MOE_I_GU = 8 * 4, MOE_I_D = 4 * 4, MOE_ITEMS = NEXP * (MOE_I_GU + MOE_I_D);
template <int NLD = 8> __device__ __forceinline__ void moe_weights_queue(const Args& a, LAS unsigned char* lds, LAS int* qslot, int tid, int wave, int lane, int limit) {
    unsigned* ctr = (unsigned*)(a.ws + WS_CTL) + CW_CVTQ;
    LAS unsigned char* T = lds + wave * (64 * CVT_STR);
    for (;;) {
        __syncthreads();
        if (tid == 0) { int v = (int)__hip_atomic_load(ctr, __ATOMIC_RELAXED, __HIP_MEMORY_SCOPE_AGENT); v = (v < limit) ? (int)atomicAdd(ctr, 1u) : MOE_ITEMS; *qslot = v; }
        __syncthreads();
        const int it = *(volatile LAS int*)qslot;
        if (it >= MOE_ITEMS) break;
        if (it < NEXP * MOE_I_GU) { const int e = it / MOE_I_GU, q = it % MOE_I_GU, ng = q & 7, kq = q >> 3;
#pragma unroll 1
            for (int kb = kq * 4; kb < kq * 4 + 4; ++kb)
                cvt_tile_fp8<2, NLD>(a.in[I_WGU] + (size_t)e * DM * 2 * DE, 2 * DE, DM, a.ws + WS_WGU + (size_t)e * 2 * DE * DM, kb, ng * 8 + wave, T, lane);
        } else { const int r = it - NEXP * MOE_I_GU, e = r / MOE_I_D, q = r % MOE_I_D, ng = q & 3, kq = q >> 2;
#pragma unroll 1
            for (int kb = kq * 4; kb < kq * 4 + 4; ++kb)
                cvt_tile_fp8<0, NLD>(a.in[I_WD] + (size_t)e * DE * DM, DM, DE, a.ws + WS_WD + (size_t)e * DM * DE, kb, ng * 8 + wave, T, lane);
        }
    }
}

__device__ __forceinline__ void p2_qknorm(const Args& a, int gw, int NGW, int lane) {
    const bf16_t* P = (const bf16_t*)(a.ws + WS_P); bf16_t* QN = (bf16_t*)(a.ws + WS_QN); bf16_t* KN = (bf16_t*)(a.ws + WS_KN);
    const float qw0 = a.in[I_SBQNW][2 * lane], qw1 = a.in[I_SBQNW][2 * lane + 1], kw0 = a.in[I_SBKNW][2 * lane], kw1 = a.in[I_SBKNW][2 * lane + 1];
    const float QS = 0.08838834764831845f * 1.4426950408889634f;
    constexpr int QB_ = 8;
    for (int it0 = gw; it0 < NTOK * NHEAD * 2; it0 += QB_ * NGW) {
        unsigned w[QB_];
#pragma unroll
        for (int k = 0; k < QB_; ++k) { const int it = it0 + k * NGW; w[k] = 0u;
            if (it < NTOK * NHEAD * 2) { const int which = it & 1, h = (it >> 1) & 7, row = it >> 4; w[k] = *(const unsigned*)(P + (size_t)row * NPROJ + (which ? PC_SBK : PC_SBQ) + h * HD + 2 * lane); } }
#pragma unroll
        for (int k = 0; k < QB_; ++k) { const int it = it0 + k * NGW;
            if (it < NTOK * NHEAD * 2) { const int which = it & 1, h = (it >> 1) & 7, row = it >> 4; const int b = row / LSEQ, t = row - b * LSEQ;
                const float v0 = bf_lo(w[k]), v1 = bf_hi(w[k]);
                const float rstd = 1.0f / sqrtf(wave_sum(v0 * v0 + v1 * v1) * (1.0f / HD) + NORM_EPS);
                const float o0 = which ? v0 * rstd * kw0 : v0 * rstd * qw0 * QS, o1 = which ? v1 * rstd * kw1 : v1 * rstd * qw1 * QS;
                *(unsigned*)((which ? KN : QN) + ((size_t)(b * NHEAD + h) * LROW + t) * HD + 2 * lane) = cvt_pk_bf16(o0, o1); } }
    }
}

__device__ __forceinline__ bf16x8 sba_pack8(const f32x16& p, int base) {
    u32x4 w; w.x = cvt_pk_bf16(p[base + 0], p[base + 1]); w.y = cvt_pk_bf16(p[base + 2], p[base + 3]); w.z = cvt_pk_bf16(p[base + 4], p[base + 5]); w.w = cvt_pk_bf16(p[base + 6], p[base + 7]);
    return __builtin_bit_cast(bf16x8, w);
}

namespace gdn {
constexpr int NCH = 65;
constexpr int IMG_W = 0, IMG_QG = 16384, IMG_KDT = 32768, IMG_AT = 49152, IMG_BYTES = 57344, IMG_U = 57344, CH_BYTES = 73728;
constexpr int L_QB = 0, L_KB = 17408, L_VB = 34816, L_LT = 52224, L_GC = 69632, L_BE = 69888, L_IMG = 70144;
__device__ __forceinline__ int afrag_off(int row, int k, int nks) {
    const int rt = row >> 5, rr = row & 31, ks = k >> 4, kk = k & 15, hi = (kk >> 2) & 1, sl = (kk & 3) + 4 * (kk >> 3);
    return ((rt * nks + ks) * 64 + rr + 32 * hi) * 16 + sl * 2;
}
__device__ __forceinline__ int ufrag_off(int i, int c) {
    const int cg = c >> 5, col = c & 31, rt = i >> 5, ii = i & 31, hi = (ii >> 2) & 1, r = (ii & 3) + 4 * (ii >> 3);
    return (((cg * 2 + rt) * 2 + (r >> 3)) * 64 + col + 32 * hi) * 8 + (r & 7);
}
__device__ __forceinline__ int crow(int r, int hi) { return (r & 3) + 8 * (r >> 2) + 4 * hi; }
__device__ __forceinline__ bf16_t f2bf(float f) { return (bf16_t)(cvt_pk_bf16(f, 0.f) & 0xffffu); }

__device__ __forceinline__ void precompute(const Args& a, LAS unsigned char* lds, int item, int tid, int lane, int wave) {
    asm volatile("" : "+v"(tid), "+v"(lane), "+s"(wave));
    const int bh = item / NCH, c = item - bh * NCH, b = bh >> 3, h = bh & 7;
    const bf16_t* P = (const bf16_t*)(a.ws + WS_P) + (size_t)b * LSEQ * NPROJ;
    const float* BETA = (const float*)(a.ws + WS_BETA) + (size_t)b * LSEQ * 8; const float* GG = (const float*)(a.ws + WS_G) + (size_t)b * LSEQ * 8;
    unsigned char* dst = a.ws + WS_GCH + (size_t)item * CH_BYTES;
    LAS float* GC = (LAS float*)(lds + L_GC); LAS float* BE = (LAS float*)(lds + L_BE); LAS float* LT = (LAS float*)(lds + L_LT);
    const int tbase = 64 * c - 48;
    if (wave == 0) {
        const int t = tbase + lane; float g = 0.f, be = 0.f;
        if (t >= 0) { g = GG[(size_t)t * 8 + h]; be = BETA[(size_t)t * 8 + h]; }
#pragma unroll
        for (int o = 1; o < 64; o <<= 1) { const float y = __shfl_up(g, o); if (lane >= o) g += y; }
        GC[lane] = g; BE[lane] = be;
        if (lane == 63) ((float*)(a.ws + WS_GL))[item] = expf(g);
    }
    {
        f32x2 cw[3][4];
#pragma unroll
        for (int w3 = 0; w3 < 3; ++w3)
#pragma unroll
            for (int tap = 0; tap < 4; ++tap) cw[w3][tap] = *(const f32x2*)(a.in[I_CONVW] + tap * 3072 + w3 * 1024 + h * HD + 2 * lane);
        f32x2 xw[3][11];
#pragma unroll
        for (int j = 0; j < 11; ++j) { const int t = tbase + 8 * wave - 3 + j;
#pragma unroll
            for (int w3 = 0; w3 < 3; ++w3) { unsigned u = 0u; if (t >= 0) u = *(const unsigned*)(P + (size_t)t * NPROJ + w3 * 1024 + h * HD + 2 * lane); xw[w3][j] = (f32x2){bf_lo(u), bf_hi(u)}; } }
#pragma unroll
        for (int rr = 0; rr < 8; ++rr) { const int i = 8 * wave + rr; f32x2 y[3];
#pragma unroll
            for (int w3 = 0; w3 < 3; ++w3) { f32x2 acc = cw[w3][0] * xw[w3][rr] + cw[w3][1] * xw[w3][rr + 1] + cw[w3][2] * xw[w3][rr + 2] + cw[w3][3] * xw[w3][rr + 3];
                acc.x = acc.x / (1.0f + __expf(-acc.x)); acc.y = acc.y / (1.0f + __expf(-acc.y)); y[w3] = acc; }
            const float rq = 0.08838834764831845f / sqrtf(wave_sum(y[0].x * y[0].x + y[0].y * y[0].y) + NORM_EPS);
            const float rk = 1.0f / sqrtf(wave_sum(y[1].x * y[1].x + y[1].y * y[1].y) + NORM_EPS);
            *(LAS unsigned*)(lds + L_QB + i * 272 + 4 * lane) = cvt_pk_bf16(y[0].x * rq, y[0].y * rq);
            *(LAS unsigned*)(lds + L_KB + i * 272 + 4 * lane) = cvt_pk_bf16(y[1].x * rk, y[1].y * rk);
            *(LAS unsigned*)(lds + L_VB + i * 272 + 4 * lane) = cvt_pk_bf16(y[2].x, y[2].y); }
    }
    __syncthreads();
    {
        const int prod = wave >> 2, ti = (wave >> 1) & 1, tj = wave & 1, r32 = lane & 31, hi = lane >> 5;
        if (tj <= ti) {
            f32x16 acc;
#pragma unroll
            for (int r = 0; r < 16; ++r) acc[r] = 0.f;
            const LAS unsigned char* Ab = lds + (prod ? L_QB : L_KB) + (32 * ti + r32) * 272 + hi * 16;
            const LAS unsigned char* Bb = lds + L_KB + (32 * tj + r32) * 272 + hi * 16;
#pragma unroll
            for (int ks = 0; ks < 8; ++ks) acc = __builtin_amdgcn_mfma_f32_32x32x16_bf16(*(const LAS bf16x8*)(Ab + ks * 32), *(const LAS bf16x8*)(Bb + ks * 32), acc, 0, 0, 0);
            const int j = 32 * tj + r32; const float gj = GC[j];
#pragma unroll
            for (int r = 0; r < 16; ++r) { const int i = 32 * ti + crow(r, hi); const float dec = __expf(GC[i] - gj);
                if (prod == 0) LT[j * 68 + i] = (j < i) ? acc[r] * BE[i] * dec : 0.f;
                else *(LAS bf16_t*)(lds + L_IMG + IMG_AT + afrag_off(i, j, 4)) = f2bf((j <= i) ? acc[r] * dec : 0.f); }
        }
    }
    __syncthreads();
    if (tid < 256) {
        float x[64];
        const bool isv = tid < 128; const int cc = tid & 127;
        const LAS unsigned char* src = lds + (isv ? L_VB : L_KB) + cc * 2;
#pragma unroll
        for (int i8 = 0; i8 < 64; i8 += 8) {
#pragma unroll
            for (int q = 0; q < 8; ++q) { const int i = i8 + q; const float v = bf2f(*(const LAS bf16_t*)(src + i * 272)); x[i] = v * BE[i] * (isv ? 1.0f : __expf(GC[i])); }
            asm volatile("" ::: "memory"); }
#pragma unroll
        for (int j = 0; j < 16; ++j) {
#pragma unroll
            for (int i4 = ((j + 1) & ~3); i4 < 64; i4 += 4) { const f32x4 l4 = *(const LAS f32x4*)(LT + j * 68 + i4);
#pragma unroll
                for (int q = 0; q < 4; ++q) if (i4 + q > j) x[i4 + q] -= l4[q] * x[j]; }
            asm volatile("" ::: "memory");
        }
        f32x4 la[12], lb[12];
#define LT_LOAD(dst, j) do { _Pragma("unroll") for (int _c = (((j) + 1) >> 2); _c < 16; ++_c) dst[_c - 4] = *(const LAS f32x4*)(LT + (j) * 68 + 4 * _c); } while (0)
#define LT_APPLY(src, j) do { _Pragma("unroll") for (int _c = (((j) + 1) >> 2); _c < 16; ++_c) { _Pragma("unroll") for (int q = 0; q < 4; ++q) if (4 * _c + q > (j)) x[4 * _c + q] -= src[_c - 4][q] * x[(j)]; } } while (0)
        LT_LOAD(la, 16);
#pragma unroll
        for (int jj = 8; jj < 31; ++jj) {
            LT_LOAD(lb, 2 * jj + 1); asm volatile("" ::: "memory"); LT_APPLY(la, 2 * jj);
            LT_LOAD(la, 2 * jj + 2); asm volatile("" ::: "memory"); LT_APPLY(lb, 2 * jj + 1);
        }
        LT_APPLY(la, 62);
#undef LT_LOAD
#undef LT_APPLY
        if (isv) {
            LAS unsigned char* ub = lds + L_IMG + IMG_U + (((cc >> 5) * 4 * 64) + (cc & 31)) * 16;
#pragma unroll
            for (int i = 0; i < 64; ++i) { const int rt = i >> 5, ii = i & 31, hi = (ii >> 2) & 1, r = (ii & 3) + 4 * (ii >> 3);
                *(LAS bf16_t*)(ub + (((rt * 2 + (r >> 3)) * 64 + 32 * hi) * 8 + (r & 7)) * 2) = f2bf(x[i]); }
        } else {
            const int ks = cc >> 4, kk = cc & 15, hi = (kk >> 2) & 1, sl = (kk & 3) + 4 * (kk >> 3);
            LAS unsigned char* wb = lds + L_IMG + IMG_W + (ks * 64 + 32 * hi) * 16 + sl * 2;
#pragma unroll
            for (int i = 0; i < 64; ++i) *(LAS bf16_t*)(wb + ((i >> 5) * 8 * 64 + (i & 31)) * 16) = f2bf(-x[i]);
        }
    } else {
        const int u = tid - 256, dk = u & 127, i0 = (u >> 7) * 32; const float gl = GC[63];
#pragma unroll 4
        for (int ii = 0; ii < 32; ++ii) { const int i = i0 + ii; const float gi = GC[i];
            const float q = bf2f(*(const LAS bf16_t*)(lds + L_QB + i * 272 + dk * 2)), k = bf2f(*(const LAS bf16_t*)(lds + L_KB + i * 272 + dk * 2));
            *(LAS bf16_t*)(lds + L_IMG + IMG_QG + afrag_off(i, dk, 8)) = f2bf(q * __expf(gi));
            *(LAS bf16_t*)(lds + L_IMG + IMG_KDT + afrag_off(dk, i, 4)) = f2bf(k * __expf(gl - gi)); }
    }
    __syncthreads();
    for (int q = tid; q < CH_BYTES / 16; q += NTHREADS) *(u32x4*)(dst + (size_t)q * 16) = *(const LAS u32x4*)(lds + L_IMG + q * 16);
}

constexpr int OB_OFF = 2 * IMG_BYTES, OB_STR = 272, OB_BYTES = 64 * OB_STR;
__device__ __forceinline__ void gated_load_z(const Args& a, u32x4 (&zw)[4], int b, int h, int cc, int w4, int lane) {
    const bf16_t* P = (const bf16_t*)(a.ws + WS_P);
    const int s = 64 * (cc - 1) + 16 * w4 + (lane >> 2);
    const u32x4* zp = (const u32x4*)(P + ((size_t)b * LSEQ + NMETA + s) * NPROJ + PC_Z + h * HD + 32 * (lane & 3));
#pragma unroll
    for (int q = 0; q < 4; ++q) zw[q] = zp[q];
}
__device__ __forceinline__ float silu_f(float z) { return z * __builtin_amdgcn_rcpf(1.0f + __expf(-z)); }
__device__ __forceinline__ void gated_rows(const Args& a, const LAS unsigned char* ob, const u32x4 (&zw)[4], int b, int h, int cc, int w4, int lane, const f32x4 (&nwv)[8]) {
    bf16_t* MIX = (bf16_t*)(a.ws + WS_MIX);
    const int row = lane >> 2, qd = lane & 3, s = 64 * (cc - 1) + 16 * w4 + row;
    u32x4 ov[4]; float ss = 0.f;
#pragma unroll
    for (int q = 0; q < 4; ++q) { ov[q] = *(const LAS u32x4*)(ob + (16 * w4 + row) * OB_STR + qd * 64 + q * 16);
#pragma unroll
        for (int e = 0; e < 4; ++e) { const float lo = bf_lo(ov[q][e]), hi = bf_hi(ov[q][e]); ss += lo * lo + hi * hi; } }
    ss = quad_sum(ss);
    const float rstd = __builtin_amdgcn_rsqf(ss * (1.0f / HD) + NORM_EPS);
    u32x4* dst = (u32x4*)(MIX + ((size_t)b * SEQ + s) * DM + h * HD + 32 * qd);
#pragma unroll
    for (int q = 0; q < 4; ++q) { u32x4 w;
#pragma unroll
        for (int e = 0; e < 4; ++e) { const f32x4 nv = nwv[2 * q + (e >> 1)];
            const float n0 = (e & 1) ? nv.z : nv.x, n1 = (e & 1) ? nv.w : nv.y;
            w[e] = cvt_pk_bf16(bf_lo(ov[q][e]) * rstd * n0 * silu_f(bf_lo(zw[q][e])), bf_hi(ov[q][e]) * rstd * n1 * silu_f(bf_hi(zw[q][e]))); }
        dst[q] = w; }
}

__device__ __forceinline__ void scan(const Args& a, LAS unsigned char* lds, int bh, int tid, int lane, int wave) {
    const int b = bh >> 3, h = bh & 7, col = lane & 31, hi = lane >> 5, cg = wave;
    const unsigned char* src = a.ws + WS_GCH + (size_t)bh * NCH * CH_BYTES;
    const float* GL = (const float*)(a.ws + WS_GL) + bh * NCH;
    __syncthreads();
    const unsigned dvoff = (unsigned)(wave * 1024 + lane * 16), uvoff = (unsigned)(lane * 16);
#define GDN_DMA(ch, buf) do { const unsigned char* _sp = src + (size_t)(ch) * CH_BYTES; _Pragma("unroll") for (int _f = 0; _f < 7; ++_f) { \
        __builtin_amdgcn_global_load_lds((const unsigned*)(_sp + _f * 8192 + dvoff), (LAS unsigned*)(lds + (buf) * IMG_BYTES + wave * 1024 + _f * 8192), 16, 0, 0); } } while (0)
    GDN_DMA(0, 0);
#define GDN_STEP_END(vm) do { asm volatile("s_waitcnt vmcnt(" #vm ")" ::: "memory"); asm volatile("s_waitcnt lgkmcnt(0)" ::: "memory"); __builtin_amdgcn_s_barrier(); asm volatile("" ::: "memory"); } while (0)
    if (wave < 4) {
        f32x16 st[4]; bf16x8 Sb[8]; u32x4 ureg[4]; float gl;
#pragma unroll
        for (int t4 = 0; t4 < 4; ++t4)
#pragma unroll
            for (int r = 0; r < 16; ++r) st[t4][r] = 0.f;
#pragma unroll
        for (int ks = 0; ks < 8; ++ks) Sb[ks] = (bf16x8){0, 0, 0, 0, 0, 0, 0, 0};
#pragma unroll
        for (int q = 0; q < 4; ++q) ureg[q] = *(const u32x4*)(src + IMG_U + cg * 4096 + q * 1024 + uvoff);
        gl = GL[0];
        GDN_STEP_END(0);
        for (int c = 0; c < NCH; ++c) {
            const LAS unsigned char* img = lds + (c & 1) * IMG_BYTES + lane * 16;
            asm volatile("" : "+v"(ureg[0]), "+v"(ureg[1]), "+v"(ureg[2]), "+v"(ureg[3]), "+v"(gl));
            if (c + 1 < NCH) GDN_DMA(c + 1, (c + 1) & 1);
            f32x16 vn[2]; const float glc = gl;
#pragma unroll
            for (int rt = 0; rt < 2; ++rt)
#pragma unroll
                for (int rh = 0; rh < 2; ++rh) { const u32x4 w = ureg[rt * 2 + rh];
                    vn[rt][8 * rh + 0] = bf_lo(w.x); vn[rt][8 * rh + 1] = bf_hi(w.x); vn[rt][8 * rh + 2] = bf_lo(w.y); vn[rt][8 * rh + 3] = bf_hi(w.y);
                    vn[rt][8 * rh + 4] = bf_lo(w.z); vn[rt][8 * rh + 5] = bf_hi(w.z); vn[rt][8 * rh + 6] = bf_lo(w.w); vn[rt][8 * rh + 7] = bf_hi(w.w); }
            asm volatile("" ::: "memory");
            if (c + 1 < NCH) {
#pragma unroll
                for (int q = 0; q < 4; ++q) ureg[q] = *(const u32x4*)(src + (size_t)(c + 1) * CH_BYTES + IMG_U + cg * 4096 + q * 1024 + uvoff);
                gl = GL[c + 1]; }
#pragma unroll
            for (int rt = 0; rt < 2; ++rt) { __builtin_amdgcn_sched_barrier(0);
#pragma unroll
                for (int ks = 0; ks < 8; ++ks) vn[rt] = __builtin_amdgcn_mfma_f32_32x32x16_bf16(*(const LAS bf16x8*)(img + IMG_W + (rt * 8 + ks) * 1024), Sb[ks], vn[rt], 0, 0, 0); }
            __builtin_amdgcn_sched_barrier(0);
            bf16x8 vb[4];
#pragma unroll
            for (int ks = 0; ks < 4; ++ks) vb[ks] = sba_pack8(vn[ks >> 1], 8 * (ks & 1));
            LAS unsigned char* obw = lds + OB_OFF + (c & 1) * OB_BYTES + (32 * cg + col) * 2;
#pragma unroll
            for (int rt = 0; rt < 2; ++rt) { f32x16 o; __builtin_amdgcn_sched_barrier(0);
#pragma unroll
                for (int r = 0; r < 16; ++r) o[r] = 0.f;
#pragma unroll
                for (int ks = 0; ks < 8; ++ks) o = __builtin_amdgcn_mfma_f32_32x32x16_bf16(*(const LAS bf16x8*)(img + IMG_QG + (rt * 8 + ks) * 1024), Sb[ks], o, 0, 0, 0);
#pragma unroll
                for (int ks = 0; ks < 2 * (rt + 1); ++ks) o = __builtin_amdgcn_mfma_f32_32x32x16_bf16(*(const LAS bf16x8*)(img + IMG_AT + (rt * 4 + ks) * 1024), vb[ks], o, 0, 0, 0);
                if (c >= 1) {
#pragma unroll
                    for (int r = 0; r < 16; ++r) *(LAS bf16_t*)(obw + (32 * rt + crow(r, hi)) * OB_STR) = f2bf(o[r]); }
            }
#pragma unroll
            for (int t4 = 0; t4 < 4; ++t4) { __builtin_amdgcn_sched_barrier(0);
#pragma unroll
                for (int r = 0; r < 16; ++r) st[t4][r] *= glc;
#pragma unroll
                for (int ks = 0; ks < 4; ++ks) st[t4] = __builtin_amdgcn_mfma_f32_32x32x16_bf16(*(const LAS bf16x8*)(img + IMG_KDT + (t4 * 4 + ks) * 1024), vb[ks], st[t4], 0, 0, 0);
                Sb[2 * t4] = sba_pack8(st[t4], 0); Sb[2 * t4 + 1] = sba_pack8(st[t4], 8); }
            if (c + 1 < NCH) GDN_STEP_END(5); else GDN_STEP_END(0);
        }
    } else {
        u32x4 zA[4], zB[4]; f32x4 nwv[8];
#pragma unroll
        for (int q = 0; q < 4; ++q) { zA[q] = (u32x4){0u, 0u, 0u, 0u}; zB[q] = (u32x4){0u, 0u, 0u, 0u}; }
#pragma unroll
        for (int q = 0; q < 8; ++q) nwv[q] = *(const f32x4*)(a.in[I_GDNNW] + 32 * (lane & 3) + 4 * q);
        GDN_STEP_END(0);
        for (int c = 0; c < NCH; ++c) {
#pragma unroll
            for (int q = 0; q < 4; ++q) asm volatile("" : "+v"(zA[q]), "+v"(zB[q]));
            if (c + 1 < NCH) GDN_DMA(c + 1, (c + 1) & 1);
            if (c >= 1) { if (c & 1) gated_load_z(a, zA, b, h, c, wave - 4, lane); else gated_load_z(a, zB, b, h, c, wave - 4, lane); }
            asm volatile("" ::: "memory");
            if (c >= 2) { if (c & 1) gated_rows(a, lds + OB_OFF + ((c - 1) & 1) * OB_BYTES, zB, b, h, c - 1, wave - 4, lane, nwv);
                          else gated_rows(a, lds + OB_OFF + ((c - 1) & 1) * OB_BYTES, zA, b, h, c - 1, wave - 4, lane, nwv); }
            if (c >= 2) GDN_STEP_END(4); else GDN_STEP_END(0);
        }
        gated_rows(a, lds + OB_OFF + ((NCH - 1) & 1) * OB_BYTES, zB, b, h, NCH - 1, wave - 4, lane, nwv);
    }
#undef GDN_STEP_END
#undef GDN_DMA
}
}

namespace sba {
#define KSWZ(row, colB) ((row) * 256 + ((colB) ^ (((row) & 7) << 4)))
__device__ __forceinline__ int v_st(int k, int c) { const int kk = (k & ~0xC) | ((k & 4) << 1) | ((k & 8) >> 1); return ((kk >> 3) * 4 + (c >> 5)) * 512 + ((kk & 7) * 32 + (c & 31)) * 2; }
__device__ __forceinline__ int v_rd_base(int lane) { return ((lane & 3) << 3) | (((lane >> 2) & 3) << 6) | (((lane >> 4) & 1) << 5) | (((lane >> 5) & 1) << 8); }
constexpr int v_rd_off(int d0, int ks, int half) { return d0 * 512 + ks * 4096 + half * 2048; }
template <int OFF> __device__ __forceinline__ s16x4 tr_read(int vb) { s16x4 r; asm volatile("ds_read_b64_tr_b16 %0, %1 offset:%2" : "=&v"(r) : "v"(vb), "i"(OFF) : "memory"); return r; }
template <int D0> __device__ __forceinline__ void pv_one(f32x16& od, int vb, bf16x8 pa0, bf16x8 pa1, bf16x8 pa2, bf16x8 pa3) {
    const s16x4 l0 = tr_read<v_rd_off(D0, 0, 0)>(vb), h0 = tr_read<v_rd_off(D0, 0, 1)>(vb), l1 = tr_read<v_rd_off(D0, 1, 0)>(vb), h1 = tr_read<v_rd_off(D0, 1, 1)>(vb);
    const s16x4 l2 = tr_read<v_rd_off(D0, 2, 0)>(vb), h2 = tr_read<v_rd_off(D0, 2, 1)>(vb), l3 = tr_read<v_rd_off(D0, 3, 0)>(vb), h3 = tr_read<v_rd_off(D0, 3, 1)>(vb);
    asm volatile("s_waitcnt lgkmcnt(0)" ::: "memory"); __builtin_amdgcn_sched_barrier(0);
#define PK(L, H) (bf16x8){L[0], L[1], L[2], L[3], H[0], H[1], H[2], H[3]}
    od = __builtin_amdgcn_mfma_f32_32x32x16_bf16(pa0, PK(l0, h0), od, 0, 0, 0);
    od = __builtin_amdgcn_mfma_f32_32x32x16_bf16(pa1, PK(l1, h1), od, 0, 0, 0);
    od = __builtin_amdgcn_mfma_f32_32x32x16_bf16(pa2, PK(l2, h2), od, 0, 0, 0);
    od = __builtin_amdgcn_mfma_f32_32x32x16_bf16(pa3, PK(l3, h3), od, 0, 0, 0);
#undef PK
}
__device__ __forceinline__ int crow(int r, int hi) { return (r & 3) + 8 * (r >> 2) + 4 * hi; }
__device__ __forceinline__ int swap34(int k) { return (k & ~0x18) | ((k & 8) << 1) | ((k & 16) >> 1); }
__device__ __forceinline__ bf16x8 pack8(const f32x16& p, int base) {
    u32x4 w; w.x = cvt_pk_bf16(p[base + 0], p[base + 1]); w.y = cvt_pk_bf16(p[base + 2], p[base + 3]); w.z = cvt_pk_bf16(p[base + 4], p[base + 5]); w.w = cvt_pk_bf16(p[base + 6], p[base + 7]);
    return __builtin_bit_cast(bf16x8, w);
}
constexpr float SB_EXIT = 160.0f;

__device__ __forceinline__ void unit(const Args& a, LAS unsigned char* lds, volatile LAS int* done_cnt, int b, int h, int qb, int tid, int lane, int wid) {
    const bf16_t* QN = (const bf16_t*)(a.ws + WS_QN) + (size_t)(b * NHEAD + h) * LROW * HD;
    const bf16_t* KN = (const bf16_t*)(a.ws + WS_KN) + (size_t)(b * NHEAD + h) * LROW * HD;
    const bf16_t* Vp = (const bf16_t*)(a.ws + WS_P) + (size_t)b * LSEQ * NPROJ + PC_SBV + h * HD;
    bf16_t* MIX = (bf16_t*)(a.ws + WS_MIX);
    const int r32 = lane & 31, hi = lane >> 5;
    LAS unsigned char* K_lds = lds; LAS unsigned char* V_lds = lds + 16384;
    const int tq0 = NMETA + 256 * qb + 32 * wid, tq = tq0 + r32;
    __syncthreads();
    if (tid == 0) *done_cnt = 0;
    bf16x8 qr[8];
#pragma unroll
    for (int d0 = 0; d0 < 8; ++d0) qr[d0] = *(const bf16x8*)(QN + (size_t)tq * HD + d0 * 16 + hi * 8);
    const int sr = tid >> 4, sc = (tid & 15) * 8;
    const int vst0 = v_st(swap34(sr), sc), vst1 = v_st(32 + swap34(sr), sc);
    const int kst0 = KSWZ(sr, sc * 2), kst1 = KSWZ(32 + sr, sc * 2);
    const int vb0 = (int)(unsigned)(unsigned long)V_lds + v_rd_base(lane);
    const int prow = (r32 & 3) + 4 * (r32 >> 3) + 16 * ((r32 >> 2) & 1);
    f32x16 o[4];
#pragma unroll
    for (int d = 0; d < 4; ++d)
#pragma unroll
        for (int r = 0; r < 16; ++r) o[d][r] = 0.f;
    float carry = 0.f; bool flagged = false;
    bf16x8 ks0, ks1, vs0, vs1;
#define SBA_LOAD(kk) do { const int _k0 = 64 * (kk); ks0 = *(const bf16x8*)(KN + (size_t)(_k0 + sr) * HD + sc); ks1 = *(const bf16x8*)(KN + (size_t)(_k0 + 32 + sr) * HD + sc); \
        vs0 = *(const bf16x8*)(Vp + (size_t)(_k0 + sr) * NPROJ + sc); vs1 = *(const bf16x8*)(Vp + (size_t)(_k0 + 32 + sr) * NPROJ + sc); } while (0)
    SBA_LOAD(4 * qb + 4);
    for (int kt = 4 * qb + 4; kt >= 0; --kt) {
        const int k0 = 64 * kt;
        __syncthreads();
        if (*done_cnt == NWAVES) break;
        *(LAS bf16x8*)(K_lds + kst0) = ks0; *(LAS bf16x8*)(K_lds + kst1) = ks1; *(LAS bf16x8*)(V_lds + vst0) = vs0; *(LAS bf16x8*)(V_lds + vst1) = vs1;
        if (kt > 0) SBA_LOAD(kt - 1);
        __syncthreads();
        if (k0 >= tq0 + 32) continue;
        f32x16 p0, p1;
#pragma unroll
        for (int r = 0; r < 16; ++r) { p0[r] = 0.f; p1[r] = 0.f; }
#pragma unroll
        for (int d0 = 0; d0 < 8; ++d0) { const int cb = (d0 * 16 + hi * 8) * 2;
            const bf16x8 b0 = *(const LAS bf16x8*)(K_lds + KSWZ(prow, cb)), b1 = *(const LAS bf16x8*)(K_lds + KSWZ(32 + prow, cb));
            p0 = __builtin_amdgcn_mfma_f32_32x32x16_bf16(b0, qr[d0], p0, 0, 0, 0);
            p1 = __builtin_amdgcn_mfma_f32_32x32x16_bf16(b1, qr[d0], p1, 0, 0, 0); }
        const bool need_mask = (k0 + 63 >= tq0);
        f32x16 s0, s1; float t0 = 0.f, t1 = 0.f;
#pragma unroll
        for (int r = 0; r < 16; ++r) {
            float e0 = __builtin_amdgcn_exp2f(p0[r]), e1 = __builtin_amdgcn_exp2f(p1[r]);
            float q0 = __builtin_amdgcn_logf(1.0f + e0), q1 = __builtin_amdgcn_logf(1.0f + e1);
            if (need_mask) { const bool v0 = (k0 + 16 * hi + r) < tq, v1 = (k0 + 32 + 16 * hi + r) < tq; e0 = v0 ? e0 : 0.f; q0 = v0 ? q0 : 0.f; e1 = v1 ? e1 : 0.f; q1 = v1 ? q1 : 0.f; }
            p0[r] = e0; p1[r] = e1; s0[r] = q0; s1[r] = q1; t0 += q0; t1 += q1; }
        float t1lo, t1hi, t0lo, t0hi;
        { auto rr = __builtin_amdgcn_permlane32_swap(__float_as_uint(t1), __float_as_uint(t1), false, false); t1lo = __uint_as_float(rr[0]); t1hi = __uint_as_float(rr[1]); }
        { auto rr = __builtin_amdgcn_permlane32_swap(__float_as_uint(t0), __float_as_uint(t0), false, false); t0lo = __uint_as_float(rr[0]); t0hi = __uint_as_float(rr[1]); }
        float run1 = carry + (hi ? 0.f : t1hi), run0 = carry + (t1lo + t1hi) + (hi ? 0.f : t0hi);
#pragma unroll
        for (int r = 15; r >= 0; --r) { run1 += s1[r]; p1[r] = p1[r] * __builtin_amdgcn_exp2f(-run1); run0 += s0[r]; p0[r] = p0[r] * __builtin_amdgcn_exp2f(-run0); }
        carry += (t1lo + t1hi) + (t0lo + t0hi);
        const bf16x8 pa0 = pack8(p0, 0), pa1 = pack8(p0, 8), pa2 = pack8(p1, 0), pa3 = pack8(p1, 8);
        pv_one<0>(o[0], vb0, pa0, pa1, pa2, pa3); pv_one<1>(o[1], vb0, pa0, pa1, pa2, pa3); pv_one<2>(o[2], vb0, pa0, pa1, pa2, pa3); pv_one<3>(o[3], vb0, pa0, pa1, pa2, pa3);
        if (!flagged && __all(carry >= SB_EXIT)) { flagged = true; if (lane == 0) (void)__hip_atomic_fetch_add((LAS int*)done_cnt, 1, __ATOMIC_RELAXED, __HIP_MEMORY_SCOPE_WORKGROUP); }
    }
#undef SBA_LOAD
    const float* onw = a.in[I_SBONW];
    float wv[4];
#pragma unroll
    for (int d0 = 0; d0 < 4; ++d0) wv[d0] = onw[32 * d0 + r32];
#pragma unroll
    for (int r = 0; r < 16; ++r) {
        float ss = (o[0][r] * o[0][r] + o[1][r] * o[1][r]) + (o[2][r] * o[2][r] + o[3][r] * o[3][r]);
        ss = row16_sum(ss); ss += __shfl_xor(ss, 16);
        const float rstd = 1.0f / sqrtf(ss * (1.0f / HD) + NORM_EPS);
        const size_t tok = (size_t)b * SEQ + (tq0 - NMETA) + crow(r, hi);
        bf16_t* dst = MIX + tok * DM + 1024 + h * HD + r32;
#pragma unroll
        for (int d0 = 0; d0 < 4; ++d0) dst[32 * d0] = (bf16_t)(cvt_pk_bf16(o[d0][r] * rstd * wv[d0], 0.f) & 0xffffu);
    }
}
}

__device__ __forceinline__ void p5_router(const Args& a, LAS unsigned char* lds, int G, int c, int tid, int lane, int wave) {
    LAS float* wl = (LAS float*)lds;
    LAS float* lg = (LAS float*)(lds + 132096);
    LAS int* misc = (LAS int*)(lds + MISC_OFF);
    const float* H1 = a.out; const float* rw = a.in[I_RW]; const float* rb = a.in[I_RB];
    unsigned char* HN2 = a.ws + WS_HN;
    int* RE = (int*)(a.ws + WS_RE); int* RP = (int*)(a.ws + WS_RP); float* RG = (float*)(a.ws + WS_RG); int* LIST = (int*)(a.ws + WS_LIST);
    unsigned* ecnt = (unsigned*)(a.ws + WS_CTL) + CW_ECNT;
    f32x4 wn[8];
#pragma unroll
    for (int j = 0; j < 8; ++j) wn[j] = *((const f32x4*)a.in[I_FFNNW] + lane + 64 * j);
    for (int blk = c; blk < NREAL / 64; blk += G) {
        for (int pass = 0; pass < 2; ++pass) {
            __syncthreads();
            stage_w16(wl, rw, NEXP, pass * 16, tid);
            if (pass == 0 && tid < 32) misc[40 + tid] = 0;
            __syncthreads();
            for (int rg = 0; rg < 4; ++rg) {
                f32x4 v[2][8];
#pragma unroll
                for (int k = 0; k < 2; ++k) { const size_t row = (size_t)blk * 64 + wave * 8 + rg * 2 + k;
#pragma unroll
                    for (int j = 0; j < 8; ++j) v[k][j] = *((const f32x4*)(H1 + row * DM) + lane + 64 * j); }
#pragma unroll
                for (int k = 0; k < 2; ++k) { const size_t row = (size_t)blk * 64 + wave * 8 + rg * 2 + k; float ss = 0.f;
#pragma unroll
                    for (int j = 0; j < 8; ++j) ss += (v[k][j].x * v[k][j].x + v[k][j].y * v[k][j].y) + (v[k][j].z * v[k][j].z + v[k][j].w * v[k][j].w);
                    const float rstd = 1.0f / sqrtf(wave_sum(ss) * (1.0f / DM) + NORM_EPS);
                    GAS unsigned* o4 = (GAS unsigned*)(HN2 + row * DM) + lane;
#pragma unroll
                    for (int j = 0; j < 8; ++j) { v[k][j] = v[k][j] * rstd * wn[j];
                        if (pass == 0) o4[64 * j] = pk4_fp8(v[k][j].x, v[k][j].y, v[k][j].z, v[k][j].w); } }
#pragma unroll
                for (int hf = 0; hf < 2; ++hf) { float o8[2][8]; dot8xN<2>(v, wl + hf * 8 * WLS, lane, o8);
#pragma unroll
                    for (int k = 0; k < 2; ++k) { float sv = o8[k][0];
#pragma unroll
                        for (int c = 1; c < 8; ++c) sv = ((lane & 7) == c) ? o8[k][c] : sv;
                        if (lane < 8) lg[(wave * 8 + rg * 2 + k) * 33 + pass * 16 + hf * 8 + lane] = sv; } }
            }
        }
        __syncthreads();
        int ek[4] = {0, 0, 0, 0}, rk[4] = {0, 0, 0, 0}; float gk[4] = {0.f, 0.f, 0.f, 0.f};
        if (tid < 64) {
            float v[32];
#pragma unroll
            for (int e = 0; e < 32; ++e) v[e] = lg[tid * 33 + e] + rb[e];
            float val[4];
#pragma unroll
            for (int k = 0; k < 4; ++k) { float best = -3.0e38f; int bi = 0;
#pragma unroll
                for (int e = 0; e < 32; ++e) { const bool gt = v[e] > best; best = gt ? v[e] : best; bi = gt ? e : bi; }
#pragma unroll
                for (int e = 0; e < 32; ++e) v[e] = (e == bi) ? -3.0e38f : v[e];
                ek[k] = bi; val[k] = best; }
            float den = 0.f;
#pragma unroll
            for (int k = 0; k < 4; ++k) { gk[k] = expf(val[k] - val[0]); den += gk[k]; }
#pragma unroll
            for (int k = 0; k < 4; ++k) { gk[k] = gk[k] / den; rk[k] = __hip_atomic_fetch_add(&misc[40 + ek[k]], 1, __ATOMIC_RELAXED, __HIP_MEMORY_SCOPE_WORKGROUP); }
        }
        __syncthreads();
        if (tid < 32) { const int cnt = misc[40 + tid]; misc[72 + tid] = cnt ? (int)atomicAdd(&ecnt[tid], (unsigned)cnt) : 0; }
        __syncthreads();
        if (tid < 64) { const int tok = blk * 64 + tid;
#pragma unroll
            for (int k = 0; k < 4; ++k) { const int pos = misc[72 + ek[k]] + rk[k]; LIST[(size_t)ek[k] * NREAL + pos] = tok; RE[tok * 4 + k] = ek[k]; RP[tok * 4 + k] = pos; RG[tok * 4 + k] = gk[k]; } }
    }
    __syncthreads();
}

__device__ __forceinline__ int moe_setup(const Args& a, LAS int* misc, int tid) {
    const unsigned* ecnt = (const unsigned*)(a.ws + WS_CTL) + CW_ECNT;
    __syncthreads();
    if (tid == 0) { int acc = 0;
        for (int e = 0; e < NEXP; ++e) { const int cnt = (int)__hip_atomic_load(ecnt + e, __ATOMIC_RELAXED, __HIP_MEMORY_SCOPE_AGENT); misc[104 + e] = cnt; misc[e] = acc; acc += (cnt + 255) >> 8; }
        misc[32] = acc; }
    __syncthreads();
    return misc[32];
}

__device__ __forceinline__ void p8_combine(const Args& a, const LAS int* misc, int gw, int NGW, int lane) {
    const int* RE = (const int*)(a.ws + WS_RE); const int* RP = (const int*)(a.ws + WS_RP); const float* RG = (const float*)(a.ws + WS_RG);
    const bf16_t* Y = (const bf16_t*)(a.ws + WS_Y); float* out = a.out;
    typedef int i32x4 __attribute__((ext_vector_type(4)));
    i32x4 e4 = {0, 0, 0, 0}, p4 = {0, 0, 0, 0}; f32x4 g4 = {0.f, 0.f, 0.f, 0.f};
    if (gw < NREAL) { e4 = *(const i32x4*)(RE + gw * 4); p4 = *(const i32x4*)(RP + gw * 4); g4 = *(const f32x4*)(RG + gw * 4); }
    for (int row = gw; row < NREAL; row += NGW) {
        size_t slot[4]; float g[4];
#pragma unroll
        for (int k = 0; k < 4; ++k) { slot[k] = (size_t)misc[e4[k]] * 256 + p4[k]; g[k] = g4[k]; }
        const int nrow = row + NGW;
        if (nrow < NREAL) { e4 = *(const i32x4*)(RE + nrow * 4); p4 = *(const i32x4*)(RP + nrow * 4); g4 = *(const f32x4*)(RG + nrow * 4); }
        f32x4 acc[4][2]; u32x4 y[4][4];
#pragma unroll
        for (int j = 0; j < 4; ++j) { const int col = 8 * lane + 512 * j;
            acc[j][0] = *(const f32x4*)(out + (size_t)row * DM + col); acc[j][1] = *(const f32x4*)(out + (size_t)row * DM + col + 4);
#pragma unroll
            for (int k = 0; k < 4; ++k) y[j][k] = *(const u32x4*)(Y + slot[k] * DM + col); }
#pragma unroll
        for (int j = 0; j < 4; ++j) { const int col = 8 * lane + 512 * j; f32x4 a0 = acc[j][0], a1 = acc[j][1];
#pragma unroll
            for (int k = 0; k < 4; ++k) { const u32x4 yy = y[j][k];
                a0.x += g[k] * bf_lo(yy.x); a0.y += g[k] * bf_hi(yy.x); a0.z += g[k] * bf_lo(yy.y); a0.w += g[k] * bf_hi(yy.y);
                a1.x += g[k] * bf_lo(yy.z); a1.y += g[k] * bf_hi(yy.z); a1.z += g[k] * bf_lo(yy.w); a1.w += g[k] * bf_hi(yy.w); }
            *(f32x4*)(out + (size_t)row * DM + col) = a0; *(f32x4*)(out + (size_t)row * DM + col + 4) = a1; }
    }
}

__device__ __forceinline__ void p1_meta_rows(const Args& a, LAS unsigned char* lds, int bx, int G, int tid, int wave, int lane) {
    const bf16_t* HN = (const bf16_t*)(a.ws + WS_HN); const bf16_t* WT = (const bf16_t*)(a.ws + WS_WIN); bf16_t* P = (bf16_t*)(a.ws + WS_P);
    for (int q = tid; q < NMETA * DM * 2 / 16; q += NTHREADS) *(LAS u32x4*)(lds + q * 16) = *(const u32x4*)((const unsigned char*)HN + (size_t)q * 16);
    __syncthreads();
    for (int col = bx + G * wave; col < NPROJ; col += G * NWAVES) {
        u32x4 w[4]; int lane_o = lane; asm volatile("" : "+v"(lane_o));
#pragma unroll
        for (int j = 0; j < 4; ++j) w[j] = *(const u32x4*)(WT + (size_t)col * DM + 8 * lane + 512 * j);
        float v = 0.f;
#pragma unroll 1
        for (int t = 0; t < NMETA; ++t) { float s = 0.f;
#pragma unroll
            for (int j = 0; j < 4; ++j) { const u32x4 x = *(const LAS u32x4*)(lds + t * (DM * 2) + (8 * lane_o + 512 * j) * 2);
                s += bf_lo(x.x) * bf_lo(w[j].x) + bf_hi(x.x) * bf_hi(w[j].x) + bf_lo(x.y) * bf_lo(w[j].y) + bf_hi(x.y) * bf_hi(w[j].y)
                   + bf_lo(x.z) * bf_lo(w[j].z) + bf_hi(x.z) * bf_hi(w[j].z) + bf_lo(x.w) * bf_lo(w[j].w) + bf_hi(x.w) * bf_hi(w[j].w); }
            s = wave_sum(s);
            v = ((lane & 15) == t) ? s : v; }
        P[((size_t)(lane >> 4) * LSEQ + (lane & 15)) * NPROJ + col] = gdn::f2bf(v);
    }
    __syncthreads();
}

constexpr int NPH = 9;
__global__ void __launch_bounds__(NTHREADS, 2) hymba_fwd(Args args) {
    extern __shared__ __attribute__((aligned(16))) unsigned char lds_raw[];
    LAS unsigned char* lds = (LAS unsigned char*)lds_raw;
    LAS int* misc = (LAS int*)(lds + MISC_OFF);
    const int tid = threadIdx.x, lane = tid & 63, wave = __builtin_amdgcn_readfirstlane(tid >> 6);
    const int G = gridDim.x, bx = blockIdx.x;
    const int vcu = (G % 8 == 0) ? (bx % 8) * (G / 8) + bx / 8 : bx;
    const int gw = vcu * NWAVES + wave, NGW = G * NWAVES;
    unsigned* ctl = (unsigned*)(args.ws + WS_CTL);
    for (int u = tid; u < 256; u += NTHREADS) misc[u] = 0;
    __syncthreads();
    XcdBarrier bar; bar.bar = ctl + CW_BAR; bar.x = 0; bar.st = nullptr;
    const int lo = args.ph_lo, hi = args.ph_hi;
    constexpr int CVT_LIMIT_P2 = MOE_ITEMS * 35 / 100;
    if (hi - lo > 1) bar = xcd_barrier_post(ctl + CW_BAR, (volatile LAS unsigned*)(misc + 200));
#define IN(k) (lo <= (k) && (k) < hi)
#define SEAM(k) do { if (IN(k) && IN((k) + 1)) xcd_barrier(bar); } while (0)

    if (IN(0)) { p0_rows(args, lds, gw, NGW, tid, lane); p0_weights(args, lds, vcu, G, wave, lane); }
    SEAM(0);
    if (IN(1)) {
        p1_meta_rows(args, lds, bx, G, tid, wave, lane);
        pg8::PlainOrder S; S.init(NREAL, NPROJ, DM, args.ws + WS_WIN, G, bx); S.meta = 1;
        pg8::EpiBf16 E{(bf16_t*)(args.ws + WS_P), NPROJ, 1};
        pg8::gemm_phase<pg8::EpiBf16, pg8::PlainOrder, true, true>(lds, (const char*)(args.ws + WS_HN), DM * 2, S, E);
    }
    SEAM(1);
    if (IN(2)) {
        p2_qknorm(args, gw, NGW, lane);
        const bool roleB = (G >= 128) && (bx >= G - G / 8 * 3);
        if (roleB) moe_weights_queue<CVT_NLD_P2>(args, lds, misc + 212, tid, wave, lane, CVT_LIMIT_P2);
        int claim = (tid == 0) ? (int)atomicAdd(ctl + CW_PREQ, 1u) : 0;
        for (;;) {
            __syncthreads();
            if (tid == 0) misc[213] = claim;
            __syncthreads();
            const int it = *(volatile LAS int*)(misc + 213);
            if (it >= 32 * gdn::NCH) break;
            if (tid == 0) claim = (int)atomicAdd(ctl + CW_PREQ, 1u);
            gdn::precompute(args, lds, it, tid, lane, wave);
        }
        if (!roleB) moe_weights_queue<CVT_NLD_P2>(args, lds, misc + 212, tid, wave, lane, CVT_LIMIT_P2);
    }
    SEAM(2);
    if (IN(3)) {
        const int NG = (G >= 64) ? 32 : 0;
        if (bx < 32 || NG == 0) { for (int it = bx; it < 32; it += G) gdn::scan(args, lds, it, tid, lane, wave); }
        if (bx >= NG) { for (int u = bx - NG; u < 512; u += G - NG) sba::unit(args, lds, (volatile LAS int*)(misc + 210), u >> 7, (u >> 4) & 7, u & 15, tid, lane, wave); }
        moe_weights_queue(args, lds, misc + 212, tid, wave, lane, MOE_ITEMS);
    }
    SEAM(3);
    if (IN(4)) {
        pg8::PlainOrder S; S.init(NREAL, DM, DM, args.ws + WS_WOUT, G, bx);
        pg8::EpiResF32 E{args.in[I_X], args.out, DM};
        pg8::gemm_phase<pg8::EpiResF32, pg8::PlainOrder, true, true>(lds, (const char*)(args.ws + WS_MIX), DM * 2, S, E);
    }
    SEAM(4);
    if (IN(5)) p5_router(args, lds, G, bx, tid, lane, wave);
    SEAM(5);
    if (IN(6)) {
        {
        const int mt = moe_setup(args, misc, tid);
        pg8::MoeOrder<true> S; S.tpre = misc; S.tok = (const LAS int*)(lds + TOK_OFF); S.nN = 16; S.nwg = mt * 16; S.G = G; S.c = bx;
        S.Bt = (const char*)(args.ws + WS_WGU); S.estride = (size_t)2 * DE * DM; S.K2 = DM;
        const int* LIST = (const int*)(args.ws + WS_LIST);
        S.ud = misc + 140; S.fill_units(misc + 140, tid);
        __syncthreads();
        for (int idx = tid; idx < TOK_CAP * 256; idx += NTHREADS) { pg8::Unit u; if (!S.next(idx >> 8, u)) break;
            const int r = (u.pm - misc[u.e]) * 256 + (idx & 255); ((LAS int*)(lds + TOK_OFF))[idx] = r < misc[104 + u.e] ? LIST[(size_t)u.e * NREAL + r] : 0; }
        __syncthreads();
        pg8::EpiSwiGLU E{args.ws + WS_ACT, args.in[I_BGU]};
        pg8::gemm_phase<pg8::EpiSwiGLU, pg8::MoeOrder<true>, true, true, true>(lds, (const char*)(args.ws + WS_HN), DM, S, E);
        }
    }
    SEAM(6);
    if (IN(7)) {
        const int mt = moe_setup(args, misc, tid);
        pg8::MoeOrder<false> S; S.tpre = misc; S.tok = nullptr; S.nN = 8; S.nwg = mt * 8; S.G = G; S.c = bx;
        S.Bt = (const char*)(args.ws + WS_WD); S.estride = (size_t)DM * DE; S.K2 = DE;
        S.ud = misc + 140; S.fill_units(misc + 140, tid);
        __syncthreads();
        pg8::EpiBf16 E{(bf16_t*)(args.ws + WS_Y), DM, 0, args.in[I_BD]};
        pg8::gemm_phase<pg8::EpiBf16, pg8::MoeOrder<false>, true, true, true>(lds, (const char*)(args.ws + WS_ACT), DE, S, E);
    }
    SEAM(7);
    if (IN(8)) { (void)moe_setup(args, misc, tid); p8_combine(args, misc, gw, NGW, lane); }
#undef IN
#undef SEAM
}

extern "C" void kernel_launch(void* const* d_in, const int* in_sizes, int n_in, void* d_out, int out_size, void* d_ws, size_t ws_size, hipStream_t stream) {
    static int grid = 0;
    if (grid == 0) {
        if (n_in != 19 || out_size != NREAL * DM || ws_size < WS_END) { fprintf(stderr, "kernel_launch: unexpected shapes (n_in %d out %d ws %zu need %zu)\n", n_in, out_size, ws_size, (size_t)WS_END); grid = -1; return; }
        int dev = 0, cus = 0, per_cu = 0;
        if (hipGetDevice(&dev) != hipSuccess || hipDeviceGetAttribute(&cus, hipDeviceAttributeMultiprocessorCount, dev) != hipSuccess) { grid = -1; return; }
        if (hipFuncSetAttribute((const void*)hymba_fwd, hipFuncAttributeMaxDynamicSharedMemorySize, LDS_BYTES) != hipSuccess) { fprintf(stderr, "kernel_launch: hipFuncSetAttribute failed\n"); grid = -1; return; }
        if (hipOccupancyMaxActiveBlocksPerMultiprocessor(&per_cu, (const void*)hymba_fwd, NTHREADS, LDS_BYTES) != hipSuccess || per_cu < 1) { fprintf(stderr, "kernel_launch: occupancy query says %d\n", per_cu); grid = -1; return; }
        (void)hipGetLastError();
        grid = cus;
    }
    if (grid < 0) return;
    (void)hipMemsetAsync((char*)d_ws + WS_CTL, 0, CTL_ZERO_BYTES, stream);
    Args a{};
    for (int i = 0; i < 19; ++i) a.in[i] = (const float*)d_in[i];
    a.out = (float*)d_out; a.ws = (unsigned char*)d_ws;
#if MK_N_LAUNCHES == 1
    a.ph_lo = 0; a.ph_hi = NPH;
    hipLaunchKernelGGL(hymba_fwd, dim3(grid), dim3(NTHREADS), LDS_BYTES, stream, a);
#else
    for (int p = 0; p < NPH; ++p) { a.ph_lo = p; a.ph_hi = p + 1; hipLaunchKernelGGL(hymba_fwd, dim3(grid), dim3(NTHREADS), LDS_BYTES, stream, a); }
#endif
    const hipError_t le = hipPeekAtLastError();
    if (le != hipSuccess) fprintf(stderr, "kernel_launch: launch failed: %s\n", hipGetErrorName(le));
}
```

```cpp
#include <hip/hip_runtime.h>
#include <cstdio>
#include <cstdint>

#ifndef MK_N_LAUNCHES
#define MK_N_LAUNCHES 1
#endif

constexpr int NB = 4, SEQ = 4096, NMETA = 16, LSEQ = SEQ + NMETA;
constexpr int DM = 2048, NTOK = NB * LSEQ  , MPAD = 16640  , NREAL = NB * SEQ  ;
constexpr int NPROJ_SRC = 7184, NPROJ = 7168;
constexpr int NHEAD = 8, HD = 128;
constexpr int PC_QKV = 0, PC_Z = 3072, PC_SBQ = 4096, PC_SBK = 5120, PC_SBV = 6144;
constexpr int NEXP = 32, TOPK = 4, DE = 2048;
constexpr int SLOT_ROWS = 73728;
constexpr int LROW = 4224;
constexpr float NORM_EPS = 1e-6f;

constexpr size_t MiB = 1u << 20;
constexpr size_t WS_CTL = 0, CTL_ZERO_BYTES = 1 * MiB;
constexpr size_t WS_WIN = 1 * MiB;
constexpr size_t WS_WOUT = WS_WIN + (size_t)NPROJ * DM * 2;
constexpr size_t WS_WGU = WS_WOUT + (size_t)DM * DM * 2;
constexpr size_t WS_WD = WS_WGU + (size_t)NEXP * 2 * DE * DM * 2;
constexpr size_t WS_HN = WS_WD + (size_t)NEXP * DM * DE * 2;
constexpr size_t WS_BETA = WS_HN + (size_t)MPAD * DM * 2;
constexpr size_t WS_G = WS_BETA + (size_t)NTOK * 8 * 4 + 256;
constexpr size_t WS_P = WS_G + (size_t)NTOK * 8 * 4 + 256;
constexpr size_t WS_QN = WS_P + (size_t)MPAD * NPROJ * 2;
constexpr size_t WS_KN = WS_QN + (size_t)NB * NHEAD * LROW * HD * 2;
constexpr size_t WS_ORAW = WS_KN + (size_t)NB * NHEAD * LROW * HD * 2;
constexpr size_t WS_MIX = WS_ORAW + (size_t)NREAL * 1024 * 4;
constexpr size_t WS_RE = WS_MIX + (size_t)NREAL * DM * 2;
constexpr size_t WS_RP = WS_RE + (size_t)NREAL * 4 * 4;
constexpr size_t WS_RG = WS_RP + (size_t)NREAL * 4 * 4;
constexpr size_t WS_LIST = WS_RG + (size_t)NREAL * 4 * 4;
constexpr size_t WS_ACT = WS_LIST + (size_t)NEXP * NREAL * 4;
constexpr size_t WS_Y = WS_ACT + (size_t)SLOT_ROWS * DE * 2;
constexpr size_t WS_GCH = WS_Y + (size_t)SLOT_ROWS * DM * 2;
constexpr size_t WS_GL = WS_GCH + (size_t)32 * 65 * 73728;
constexpr size_t WS_END = WS_GL + 32 * 65 * 4 + 256;
constexpr int CW_ECNT = 64;
constexpr int CW_CVTQ = 192;
constexpr int CVT_NLD_P2 = 4;
constexpr int CW_PREQ = 256;
constexpr int CW_BAR = 4096;

constexpr int LDS_STAGE = 131072;
constexpr int TOK_OFF = LDS_STAGE, TOK_CAP = 22;
constexpr int MISC_OFF = TOK_OFF + TOK_CAP * 256 * 4;
constexpr int LDS_BYTES = MISC_OFF + 1024;

#define GAS __attribute__((address_space(1)))
#define LAS __attribute__((address_space(3)))
typedef unsigned short bf16_t;
typedef short bf16x8 __attribute__((ext_vector_type(8)));
typedef short s16x4 __attribute__((ext_vector_type(4)));
typedef float f32x4 __attribute__((ext_vector_type(4)));
typedef float f32x2 __attribute__((ext_vector_type(2)));
typedef float f32x16 __attribute__((ext_vector_type(16)));
typedef unsigned u32x4 __attribute__((ext_vector_type(4)));
typedef unsigned u32x2 __attribute__((ext_vector_type(2)));

typedef __bf16 bf16x2_t __attribute__((ext_vector_type(2)));
__device__ __forceinline__ unsigned cvt_pk_bf16(float lo, float hi) { const f32x2 v = {lo, hi}; const bf16x2_t b = __builtin_convertvector(v, bf16x2_t); return __builtin_bit_cast(unsigned, b); }
__device__ __forceinline__ unsigned pk4_fp8(float a, float b, float c, float d) { unsigned w = 0u; w = __builtin_amdgcn_cvt_pk_fp8_f32(a, b, w, false); w = __builtin_amdgcn_cvt_pk_fp8_f32(c, d, w, true); return w; }
__device__ __forceinline__ float bf_lo(unsigned w) { return __uint_as_float(w << 16); }
__device__ __forceinline__ float bf_hi(unsigned w) { return __uint_as_float(w & 0xffff0000u); }
__device__ __forceinline__ float bf2f(bf16_t b) { return __uint_as_float(((unsigned)b) << 16); }
template <int CTRL, int ROW_MASK> __device__ __forceinline__ float dpp_get(float v) {
    return __builtin_bit_cast(float, __builtin_amdgcn_update_dpp(0, __builtin_bit_cast(int, v), CTRL, ROW_MASK, 0xF, false));
}
__device__ __forceinline__ float row16_sum(float v) {
    v += dpp_get<0xB1, 0xF>(v);
    v += dpp_get<0x4E, 0xF>(v);
    v += dpp_get<0x141, 0xF>(v);
    v += dpp_get<0x140, 0xF>(v);
    return v;
}
__device__ __forceinline__ float quad_sum(float v) { v += dpp_get<0xB1, 0xF>(v); v += dpp_get<0x4E, 0xF>(v); return v; }
__device__ __forceinline__ float wave_sum(float v) {
    v = row16_sum(v);
    v += dpp_get<0x142, 0xA>(v);
    v += dpp_get<0x143, 0xC>(v);
    return __builtin_bit_cast(float, __builtin_amdgcn_readlane(__builtin_bit_cast(int, v), 63));
}

namespace pg8 {
constexpr int BM = 256, BK = 64, HALF = 128, HTB = HALF * BK * 2, STAGE_BYTES = 8 * HTB, NXCD = 8, WGM = 8;
__host__ __device__ __forceinline__ int lds_byte(int r, int c) { const int st = (r >> 4) * 2 + (c >> 5), rr = r & 15, cc = c & 31, ob = rr * 64 + cc * 2; return st * 1024 + (ob ^ (((ob >> 9) & 1) << 5)); }
__host__ __device__ __forceinline__ void stage_rc(int b, int& R, int& C) { const int st = b / 1024, sb = b % 1024, swz = sb ^ (((sb >> 9) & 1) << 5); R = (st >> 1) * 16 + swz / 64; C = (st & 1) * 32 + (swz % 64) / 2; }
__host__ __device__ __forceinline__ int perm32(int rho) { const int n = rho >> 4, i = rho & 15; return 8 * (i >> 2) + 4 * n + (i & 3); }

typedef int v8i __attribute__((ext_vector_type(8))); typedef int v4i __attribute__((ext_vector_type(4)));
__device__ __forceinline__ v8i cat8(bf16x8 lo, bf16x8 hi) { const v4i a = __builtin_bit_cast(v4i, lo), b = __builtin_bit_cast(v4i, hi); return __builtin_shufflevector(a, b, 0, 1, 2, 3, 4, 5, 6, 7); }
struct Unit { int pm, pn, e, ui; };

__device__ __forceinline__ int xcd_remap(int L, int nwg) { const int q = nwg / NXCD, r = nwg % NXCD, xcd = L % NXCD, off = L / NXCD; return (xcd < r ? xcd * (q + 1) : r * (q + 1) + (xcd - r) * q) + off; }

struct PlainOrder {
    int nM, nN, nwg, G, c; const char* Bt; unsigned K2;
    __device__ void init(int M, int N, int K, const void* Bt_, int G_, int c_) { nM = M / BM; nN = N / BM; nwg = nM * nN; G = G_; c = c_; Bt = (const char*)Bt_; K2 = (unsigned)K * 2u; }
    __device__ __forceinline__ bool next(int i, Unit& u) const {
        const long L = (long)i * G + c; if (L >= nwg) return false;
        const int wgid = xcd_remap((int)L, nwg);
        const int nig = WGM * nN, gid = wgid / nig, fm = gid * WGM, gsz = (nM - fm) < WGM ? (nM - fm) : WGM;
        u.pm = fm + ((wgid % nig) % gsz); u.pn = (wgid % nig) / gsz; u.e = 0; u.ui = i; return true;
    }
    __device__ __forceinline__ const char* b_ptr(const Unit& u) const { return Bt + (size_t)u.pn * BM * K2; }
    __device__ __forceinline__ unsigned a_off(const Unit& u, int r) const { return (unsigned)(u.pm * BM + r + (meta ? NMETA * ((u.pm >> 4) + 1) : 0)) * K2; }
    int meta = 0;
};
constexpr int UD_CAP = 24;
template <bool GATHER> struct MoeOrder {
    const LAS int* tpre; const LAS int* tok; const LAS int* ud; int nN, nwg, G, c; const char* Bt; size_t estride; unsigned K2;
    __device__ __forceinline__ int decode(int i) const {
        const long L = (long)i * G + c; if (L >= nwg) return -1;
        const int wgid = xcd_remap((int)L, nwg);
        int e = 0;
#pragma unroll 1
        for (int j = 1; j < NEXP; ++j) e = (wgid >= tpre[j] * nN) ? j : e;
        const int t0 = tpre[e], nt = tpre[e + 1] - t0, loc = wgid - t0 * nN;
        return e | ((t0 + loc % nt) << 6) | ((loc / nt) << 16);
    }
    __device__ __forceinline__ void fill_units(LAS int* udw, int tid) const { if (tid < UD_CAP) udw[tid] = decode(tid); }
    __device__ __forceinline__ bool next(int i, Unit& u) const {
        if (i >= UD_CAP) return false;
        const int d = ud[i]; if (d < 0) return false;
        u.e = d & 63; u.pm = (d >> 6) & 1023; u.pn = d >> 16; u.ui = i; return true;
    }
    __device__ __forceinline__ const char* b_ptr(const Unit& u) const { return Bt + (size_t)u.e * estride + (size_t)u.pn * BM * K2; }
    __device__ __forceinline__ unsigned a_off(const Unit& u, int r) const {
        if (GATHER) return (unsigned)tok[u.ui * 256 + r] * K2;
        return (unsigned)(u.pm * BM + r) * K2;
    }
};

struct EpiBf16 {
    static constexpr bool PERM = true;
    bf16_t* O; int ldc; int meta; const float* ebias = nullptr;
    __device__ __forceinline__ void operator()(const f32x4 (&acc)[2][2][4][2], const Unit& u, int wr, int wc, int fr, int fq) const {
        const int row0 = u.pm * BM + wr * 64 + fr + (meta ? NMETA * ((u.pm >> 4) + 1) : 0), col0 = u.pn * BM + wc * 32 + 8 * fq;
        f32x4 bv[2][2];
#pragma unroll
        for (int bj = 0; bj < 2; ++bj)
#pragma unroll
            for (int n = 0; n < 2; ++n) bv[bj][n] = ebias ? *(const f32x4*)(ebias + (size_t)u.e * ldc + col0 + bj * HALF + 4 * n) : (f32x4){0.f, 0.f, 0.f, 0.f};
#pragma unroll
        for (int ai = 0; ai < 2; ++ai)
#pragma unroll
            for (int m = 0; m < 4; ++m) { bf16_t* rowp = O + (size_t)(row0 + ai * HALF + m * 16) * ldc + col0;
#pragma unroll
                for (int bj = 0; bj < 2; ++bj) { const f32x4 v0 = acc[ai][bj][m][0] + bv[bj][0], v1 = acc[ai][bj][m][1] + bv[bj][1];
                    u32x4 w; w.x = cvt_pk_bf16(v0[0], v0[1]); w.y = cvt_pk_bf16(v0[2], v0[3]); w.z = cvt_pk_bf16(v1[0], v1[1]); w.w = cvt_pk_bf16(v1[2], v1[3]);
                    *(u32x4*)(rowp + bj * HALF) = w; } }
    }
};
struct EpiResF32 {
    static constexpr bool PERM = false;
    const float* X; float* out; int ldc;
    __device__ __forceinline__ void operator()(const f32x4 (&acc)[2][2][4][2], const Unit& u, int wr, int wc, int fr, int fq) const {
        const int row0 = u.pm * BM + wr * 64 + fr, col0 = u.pn * BM + wc * 32 + 4 * fq;
#pragma unroll
        for (int ai = 0; ai < 2; ++ai) {
            f32x4 xv[4][2][2];
#pragma unroll
            for (int m = 0; m < 4; ++m) { const size_t off = (size_t)(row0 + ai * HALF + m * 16) * ldc + col0;
#pragma unroll
                for (int bj = 0; bj < 2; ++bj)
#pragma unroll
                    for (int n = 0; n < 2; ++n) xv[m][bj][n] = *(const f32x4*)(X + off + bj * HALF + n * 16); }
#pragma unroll
            for (int m = 0; m < 4; ++m) { const size_t off = (size_t)(row0 + ai * HALF + m * 16) * ldc + col0;
#pragma unroll
                for (int bj = 0; bj < 2; ++bj)
#pragma unroll
                    for (int n = 0; n < 2; ++n) *(f32x4*)(out + off + bj * HALF + n * 16) = xv[m][bj][n] + acc[ai][bj][m][n]; }
            asm volatile("" ::: "memory"); }
    }
};
__device__ __forceinline__ float swiglu1(float g, float uu) {
    g = fminf(g, 7.0f); uu = fminf(fmaxf(uu, -7.0f), 7.0f);
    const float sg = __builtin_amdgcn_rcpf(1.0f + __builtin_amdgcn_exp2f(-1.702f * 1.4426950408889634f * g));
    return (uu + 1.0f) * g * sg;
}
struct EpiSwiGLU {
    static constexpr bool PERM = true;
    unsigned char* act; const float* bgu;
    __device__ __forceinline__ void operator()(const f32x4 (&acc)[2][2][4][2], const Unit& u, int wr, int wc, int fr, int fq) const {
        const int row0 = u.pm * BM + wr * 64 + fr, col0 = u.pn * HALF + wc * 32 + 8 * fq;
        const float* bg = bgu + (size_t)u.e * 4096 + col0;
        const f32x4 bg0 = *(const f32x4*)(bg), bg1 = *(const f32x4*)(bg + 4), bu0 = *(const f32x4*)(bg + 2048), bu1 = *(const f32x4*)(bg + 2052);
#pragma unroll
        for (int ai = 0; ai < 2; ++ai)
#pragma unroll
            for (int m = 0; m < 4; ++m) { unsigned char* rowp = act + (size_t)(row0 + ai * HALF + m * 16) * DE + col0;
                const f32x4 g0 = acc[ai][0][m][0] + bg0, g1 = acc[ai][0][m][1] + bg1, u0 = acc[ai][1][m][0] + bu0, u1 = acc[ai][1][m][1] + bu1;
                u32x2 w; w.x = pk4_fp8(swiglu1(g0[0], u0[0]), swiglu1(g0[1], u0[1]), swiglu1(g0[2], u0[2]), swiglu1(g0[3], u0[3]));
                w.y = pk4_fp8(swiglu1(g1[0], u1[0]), swiglu1(g1[1], u1[1]), swiglu1(g1[2], u1[2]), swiglu1(g1[3], u1[3]));
                *(u32x2*)rowp = w; }
    }
};

template <class Epi, class Sched, bool ALIGN_EPI, bool SP2, bool FP8 = false>
__device__ __forceinline__ void gemm_phase(LAS unsigned char* lds, const char* A0, int Kb, const Sched& S, const Epi& E) {
    const int tid = threadIdx.x, wid = __builtin_amdgcn_readfirstlane(tid >> 6), lane = tid & 63, wr = wid >> 2, wc = wid & 3, fr = lane & 15, fq = lane >> 4;
    const int nt = Kb / 128;
    int Rr[2], Cc[2]; unsigned voffB[2];
#pragma unroll
    for (int i = 0; i < 2; ++i) { int R, C; stage_rc(tid * 16 + i * 8192, R, C); const int Rb = Epi::PERM ? ((R & ~31) + perm32(R & 31)) : R;
        Rr[i] = R; Cc[i] = C * 2; voffB[i] = (unsigned)(Rb * Kb + C * 2); }
    const size_t kstep = (size_t)(BK * 2);
    const size_t hstep = (size_t)HALF * Kb;
    const unsigned ldsw = (unsigned)wid * 1024u;
    const int aoff = lds_byte(wr * 64 + fr, fq * 8), boff = lds_byte(wc * 32 + fr, fq * 8);
#define PG8_SA(b, h) (((b) * 2 + (h)) * HTB)
#define PG8_SB(b, h) ((4 + (b) * 2 + (h)) * HTB)
#define PG8_STAGE(bufoff, gbase, voff) do { _Pragma("unroll") for (int _i = 0; _i < 2; ++_i) \
        __builtin_amdgcn_global_load_lds((const unsigned*)((const char*)(gbase) + (voff)[_i]), (LAS unsigned*)(lds + (bufoff) + ldsw + _i * 8192), 16, 0, 0); } while (0)
#define PG8_LDA(dst, b, h) do { _Pragma("unroll") for (int m = 0; m < 4; ++m) _Pragma("unroll") for (int k = 0; k < 2; ++k) dst[m][k] = *(const LAS bf16x8*)(lds + PG8_SA(b, h) + aoff + m * 2048 + k * 1024); } while (0)
#define PG8_LDB(dst, b, h) do { _Pragma("unroll") for (int n = 0; n < 2; ++n) _Pragma("unroll") for (int k = 0; k < 2; ++k) dst[n][k] = *(const LAS bf16x8*)(lds + PG8_SB(b, h) + boff + n * 2048 + k * 1024); } while (0)
#define PG8_MMA(ai, bj, At, Bt) do { __builtin_amdgcn_s_setprio(1); _Pragma("unroll") for (int m = 0; m < 4; ++m) _Pragma("unroll") for (int n = 0; n < 2; ++n) { \
        if constexpr (FP8) acc[ai][bj][m][n] = __builtin_amdgcn_mfma_scale_f32_16x16x128_f8f6f4(cat8(Bt[n][0], Bt[n][1]), cat8(At[m][0], At[m][1]), acc[ai][bj][m][n], 0, 0, 0, 0x79797979, 0, 0x7f7f7f7f); \
        else { _Pragma("unroll") for (int k = 0; k < 2; ++k) acc[ai][bj][m][n] = __builtin_amdgcn_mfma_f32_16x16x32_bf16(Bt[n][k], At[m][k], acc[ai][bj][m][n], 0, 0, 0); } } \
        __builtin_amdgcn_s_setprio(0); } while (0)
#define PG8_WAIT_V(n) asm volatile("s_waitcnt vmcnt(" #n ")" ::: "memory")
#define PG8_WAIT_L(n) asm volatile("s_waitcnt lgkmcnt(" #n ")" ::: "memory")
#define PG8_BAR __builtin_amdgcn_s_barrier()
#define PG8_SCHED __builtin_amdgcn_sched_barrier(0)
#define PG8_VOFF(dst, u) do { _Pragma("unroll") for (int _h = 0; _h < 2; ++_h) _Pragma("unroll") for (int _i = 0; _i < 2; ++_i) dst[_h][_i] = S.a_off(u, _h * HALF + Rr[_i]) + (unsigned)Cc[_i]; } while (0)
    Unit cur, nxt; int ui = 0;
    if (!S.next(0, cur)) return;
    f32x4 acc[2][2][4][2];
#pragma unroll
    for (int a = 0; a < 2; ++a)
#pragma unroll
        for (int b = 0; b < 2; ++b)
#pragma unroll
            for (int m = 0; m < 4; ++m)
#pragma unroll
                for (int n = 0; n < 2; ++n) acc[a][b][m][n] = (f32x4){0.f, 0.f, 0.f, 0.f};
    bf16x8 At[4][2], B0[2][2], B1[2][2];
    unsigned va[2][2], vn[2][2];
    PG8_VOFF(va, cur);
    const char* cB = S.b_ptr(cur);
    if constexpr (SP2) {
        PG8_STAGE(PG8_SB(0, 0), cB, voffB); PG8_STAGE(PG8_SB(0, 1), cB + hstep, voffB); PG8_STAGE(PG8_SA(0, 0), A0, va[0]); PG8_STAGE(PG8_SA(0, 1), A0, va[1]);
        if (wr == 1) PG8_BAR;
        PG8_WAIT_V(2); PG8_BAR;
        PG8_STAGE(PG8_SB(1, 0), cB + kstep, voffB); PG8_STAGE(PG8_SA(1, 0), A0 + kstep, va[0]); PG8_STAGE(PG8_SB(1, 1), cB + hstep + kstep, voffB);
        PG8_WAIT_V(6); PG8_BAR;
    } else {
        PG8_STAGE(PG8_SB(0, 0), cB, voffB); PG8_STAGE(PG8_SA(0, 0), A0, va[0]); PG8_STAGE(PG8_SB(0, 1), cB + hstep, voffB); PG8_STAGE(PG8_SA(0, 1), A0, va[1]);
        if (wr == 1) PG8_BAR;
        PG8_WAIT_V(4); PG8_BAR;
        PG8_STAGE(PG8_SB(1, 0), cB + kstep, voffB); PG8_STAGE(PG8_SA(1, 0), A0 + kstep, va[0]); PG8_STAGE(PG8_SB(1, 1), cB + hstep + kstep, voffB);
        PG8_WAIT_V(6); PG8_BAR;
    }
    for (;;) {
        const bool has_next = S.next(ui + 1, nxt);
        const char* nB = has_next ? S.b_ptr(nxt) : cB;
        for (int t = 0; t < nt; t += 2) {
            const bool last = (t == nt - 2);
            const char* a1 = A0 + (size_t)(t + 1) * kstep;
            const char* a2 = last ? A0 : A0 + (size_t)(t + 2) * kstep; const char* b2 = last ? nB : cB + (size_t)(t + 2) * kstep;
            const char* a3 = a2 + kstep; const char* b3 = b2 + kstep;
            if (last) { if (has_next) { PG8_VOFF(vn, nxt); } else {
#pragma unroll
                    for (int _h = 0; _h < 2; ++_h)
#pragma unroll
                        for (int _i = 0; _i < 2; ++_i) vn[_h][_i] = va[_h][_i]; } }
            if constexpr (SP2) {
            PG8_LDB(B0, 0, 0); PG8_LDB(B1, 0, 1); PG8_SCHED; PG8_LDA(At, 0, 0); PG8_STAGE(PG8_SA(1, 1), a1, va[1]);
            if (last) {
#pragma unroll
                for (int _h = 0; _h < 2; ++_h)
#pragma unroll
                    for (int _i = 0; _i < 2; ++_i) va[_h][_i] = vn[_h][_i]; }
            PG8_WAIT_V(8); PG8_WAIT_L(0); PG8_BAR; PG8_MMA(0, 0, At, B0); PG8_MMA(0, 1, At, B1); PG8_BAR; PG8_SCHED;
            PG8_LDA(At, 0, 1); PG8_STAGE(PG8_SB(0, 0), b2, voffB); PG8_STAGE(PG8_SB(0, 1), b2 + hstep, voffB); PG8_STAGE(PG8_SA(0, 0), a2, va[0]);
            PG8_WAIT_V(8); PG8_WAIT_L(0); PG8_BAR; PG8_MMA(1, 0, At, B0); PG8_MMA(1, 1, At, B1); PG8_BAR; PG8_SCHED;
            PG8_LDB(B0, 1, 0); PG8_LDB(B1, 1, 1); PG8_SCHED; PG8_LDA(At, 1, 0); PG8_STAGE(PG8_SA(0, 1), a2, va[1]);
            PG8_WAIT_V(8); PG8_WAIT_L(0); PG8_BAR; PG8_MMA(0, 0, At, B0); PG8_MMA(0, 1, At, B1); PG8_BAR; PG8_SCHED;
            PG8_LDA(At, 1, 1); PG8_STAGE(PG8_SB(1, 0), b3, voffB); PG8_STAGE(PG8_SB(1, 1), b3 + hstep, voffB); PG8_STAGE(PG8_SA(1, 0), a3, va[0]);
            PG8_WAIT_V(8); PG8_WAIT_L(0); PG8_BAR; PG8_MMA(1, 0, At, B0); PG8_MMA(1, 1, At, B1); PG8_BAR; PG8_SCHED;
            } else {
            PG8_LDB(B0, 0, 0); PG8_SCHED; PG8_LDA(At, 0, 0); PG8_STAGE(PG8_SA(1, 1), a1, va[1]);
            if (last) {
#pragma unroll
                for (int _h = 0; _h < 2; ++_h)
#pragma unroll
                    for (int _i = 0; _i < 2; ++_i) va[_h][_i] = vn[_h][_i]; }
            PG8_WAIT_L(8); PG8_BAR; PG8_WAIT_L(0); PG8_MMA(0, 0, At, B0); PG8_BAR; PG8_SCHED;
            PG8_LDB(B1, 0, 1); PG8_STAGE(PG8_SB(0, 0), b2, voffB);
            PG8_BAR; PG8_WAIT_L(0); PG8_MMA(0, 1, At, B1); PG8_BAR;
            PG8_LDA(At, 0, 1); PG8_STAGE(PG8_SA(0, 0), a2, va[0]);
            PG8_BAR; PG8_WAIT_L(0); PG8_MMA(1, 0, At, B0); PG8_BAR; PG8_SCHED;
            PG8_STAGE(PG8_SB(0, 1), b2 + hstep, voffB);
            PG8_WAIT_V(6); PG8_BAR; PG8_MMA(1, 1, At, B1); PG8_BAR;
            PG8_LDB(B0, 1, 0); PG8_SCHED; PG8_LDA(At, 1, 0); PG8_STAGE(PG8_SA(0, 1), a2, va[1]);
            PG8_WAIT_L(8); PG8_BAR; PG8_WAIT_L(0); PG8_MMA(0, 0, At, B0); PG8_BAR; PG8_SCHED;
            PG8_LDB(B1, 1, 1); PG8_STAGE(PG8_SB(1, 0), b3, voffB);
            PG8_BAR; PG8_WAIT_L(0); PG8_MMA(0, 1, At, B1); PG8_BAR;
            PG8_LDA(At, 1, 1); PG8_STAGE(PG8_SA(1, 0), a3, va[0]);
            PG8_BAR; PG8_WAIT_L(0); PG8_MMA(1, 0, At, B0); PG8_BAR; PG8_SCHED;
            PG8_STAGE(PG8_SB(1, 1), b3 + hstep, voffB);
            PG8_WAIT_V(6); PG8_BAR; PG8_MMA(1, 1, At, B1); PG8_BAR;
            }
        }
        if constexpr (ALIGN_EPI) { if (wr == 0) PG8_BAR; }
        E(acc, cur, wr, wc, fr, fq);
        if (!has_next) break;
#pragma unroll
        for (int a = 0; a < 2; ++a)
#pragma unroll
            for (int b = 0; b < 2; ++b)
#pragma unroll
                for (int m = 0; m < 4; ++m)
#pragma unroll
                    for (int n = 0; n < 2; ++n) acc[a][b][m][n] = (f32x4){0.f, 0.f, 0.f, 0.f};
        cur = nxt; cB = nB; ++ui;
        if constexpr (ALIGN_EPI) { if (wr == 1) PG8_BAR; }
    }
    PG8_WAIT_V(0);
    if constexpr (!ALIGN_EPI) { if (wr == 0) PG8_BAR; }
    PG8_BAR;
#undef PG8_SA
#undef PG8_SB
#undef PG8_STAGE
#undef PG8_LDA
#undef PG8_LDB
#undef PG8_MMA
#undef PG8_WAIT_V
#undef PG8_WAIT_L
#undef PG8_BAR
#undef PG8_SCHED
#undef PG8_VOFF
}
}

#define XB_TMO      128
#define XB_XCNT(j)  (256  + 64 * (j))
#define XB_XSUB(j)  (1280 + 64 * (j))
#define XB_XGEN(j)  (2304 + 64 * (j))
#define XB_TOP      3328
#define XB_TOPGEN   3392
#define XCD_BAR_WORDS 3456
#define XB_SPIN_CAP (1u << 18)

__device__ __forceinline__ unsigned xb_ld(unsigned* p)              { return __hip_atomic_load(p, __ATOMIC_RELAXED, __HIP_MEMORY_SCOPE_AGENT); }
__device__ __forceinline__ unsigned xb_add(unsigned* p, unsigned v) { return __hip_atomic_fetch_add(p, v, __ATOMIC_RELAXED, __HIP_MEMORY_SCOPE_AGENT); }
__device__ __forceinline__ unsigned xb_xcc_id() { return (unsigned)__builtin_amdgcn_s_getreg((3 << 11) | 20) & 0xFu; }
#define XB_SPIN(cond, bar) do { unsigned _sp = 0; while (cond) { __builtin_amdgcn_s_sleep(1); \
    if ((++_sp & 255u) == 0u) { if (xb_ld(&(bar)[XB_TMO])) break; if (_sp > XB_SPIN_CAP) { atomicAdd(&(bar)[XB_TMO], 1u); break; } } } } while (0)

struct XcdBarrier {
    unsigned* bar; unsigned x;
    volatile LAS unsigned* st;
};
__device__ __forceinline__ XcdBarrier xcd_barrier_post(unsigned* bar, volatile LAS unsigned* st) {
    XcdBarrier b; b.bar = bar; b.x = xb_xcc_id(); b.st = st;
    if (threadIdx.x == 0) (void)xb_add(&bar[XB_XCNT(b.x)], 1u);
    return b;
}
__device__ __forceinline__ void xcd_barrier_complete(unsigned* bar, unsigned x, unsigned& nloc, unsigned& nx) {
    const unsigned G = gridDim.x * gridDim.y * gridDim.z;
    unsigned sum, cnt, mine, sp = 0u;
    for (;;) {
        sum = 0u; cnt = 0u; mine = 0u;
#pragma unroll
        for (unsigned j = 0; j < 16; ++j) { const unsigned c = xb_ld(&bar[XB_XCNT(j)]); sum += c; cnt += (c > 0u) ? 1u : 0u; mine = (j == x) ? c : mine; }
        if (sum == G) break;
        __builtin_amdgcn_s_sleep(1);
        if ((++sp & 255u) == 0u) { if (xb_ld(&bar[XB_TMO])) break; if (sp > XB_SPIN_CAP) { atomicAdd(&bar[XB_TMO], 1u); break; } }
    }
    nloc = mine > 0u ? mine : 1u; nx = cnt > 0u ? cnt : 1u;
}
__device__ __forceinline__ void xcd_barrier(const XcdBarrier& b) {
    asm volatile("s_waitcnt vmcnt(0)" ::: "memory");
    __syncthreads();
    if (threadIdx.x == 0) {
        unsigned* bar = b.bar;
        __builtin_amdgcn_s_waitcnt(0);
        unsigned nloc = b.st[0], nx = b.st[1];
        if (nloc == 0u) { xcd_barrier_complete(bar, b.x, nloc, nx); b.st[0] = nloc; b.st[1] = nx; }
        const unsigned old = xb_add(&bar[XB_XSUB(b.x)], 1u);
        const unsigned gen = old / nloc;
        if (old + 1u == (gen + 1u) * nloc) {
            __builtin_amdgcn_fence(__ATOMIC_RELEASE, "agent");
            asm volatile("s_waitcnt vmcnt(0)" ::: "memory");
            const unsigned og = xb_add(&bar[XB_TOP], 1u);
            const unsigned tg = og / nx;
            if (og + 1u == (tg + 1u) * nx) xb_add(&bar[XB_TOPGEN], 1u);
            else XB_SPIN(xb_ld(&bar[XB_TOPGEN]) == tg, bar);
            __builtin_amdgcn_fence(__ATOMIC_ACQUIRE, "agent");
            xb_add(&bar[XB_XGEN(b.x)], 1u);
            asm volatile("s_waitcnt vmcnt(0)" ::: "memory");
        } else {
            XB_SPIN(xb_ld(&bar[XB_XGEN(b.x)]) == gen, bar);
            __builtin_amdgcn_fence(__ATOMIC_ACQUIRE, "agent");
            asm volatile("s_waitcnt vmcnt(0)" ::: "memory");
        }
    }
    __syncthreads();
}

constexpr int NWAVES = 8, NTHREADS = 512;
struct Args { const float* in[19]; float* out; unsigned char* ws; int ph_lo, ph_hi; };
enum { I_X = 0, I_META, I_MIXNW, I_WIN, I_CONVW, I_ALOG, I_DTB, I_GDNNW, I_SBQNW, I_SBKNW, I_SBONW, I_WOUT, I_FFNNW, I_RW, I_RB, I_WGU, I_BGU, I_WD, I_BD };

#define LDS_WAIT() asm volatile("s_waitcnt lgkmcnt(0)" ::: "memory")
#define VM_WAIT() asm volatile("s_waitcnt vmcnt(0)" ::: "memory")
constexpr int WLS = 2052;

__device__ __forceinline__ void dot16(const f32x4 (&v)[8], const LAS float* wl, int lane, float (&s)[16]) {
#pragma unroll
    for (int c = 0; c < 16; ++c) { float a = 0.f;
#pragma unroll
        for (int j = 0; j < 8; ++j) { const f32x4 w = *(const LAS f32x4*)(wl + c * WLS + 4 * lane + 256 * j); a += (v[j].x * w.x + v[j].y * w.y) + (v[j].z * w.z + v[j].w * w.w); }
        s[c] = wave_sum(a); }
}

template <int NR> __device__ __forceinline__ void dot8xN(const f32x4 (&v)[NR][8], const LAS float* wl, int lane, float (&out)[NR][8]) {
#pragma unroll
    for (int c = 0; c < 8; ++c) { float a[NR];
#pragma unroll
        for (int k = 0; k < NR; ++k) a[k] = 0.f;
#pragma unroll
        for (int j = 0; j < 8; ++j) { const f32x4 w = *(const LAS f32x4*)(wl + c * WLS + 4 * lane + 256 * j);
#pragma unroll
            for (int k = 0; k < NR; ++k) a[k] += (v[k][j].x * w.x + v[k][j].y * w.y) + (v[k][j].z * w.z + v[k][j].w * w.w); }
#pragma unroll
        for (int k = 0; k < NR; ++k) out[k][c] = wave_sum(a[k]); }
}
__device__ __forceinline__ void stage_w16(LAS float* wl, const float* base, int ld, int coloff, int tid) {
#pragma unroll 4
    for (int idx = tid; idx < 2048 * 4; idx += NTHREADS) { const int k = idx >> 2, q = idx & 3; const f32x4 v = *(const f32x4*)(base + (size_t)k * ld + coloff + 4 * q);
        wl[(4 * q + 0) * WLS + k] = v.x; wl[(4 * q + 1) * WLS + k] = v.y; wl[(4 * q + 2) * WLS + k] = v.z; wl[(4 * q + 3) * WLS + k] = v.w; }
}

__device__ __forceinline__ void p0_rows(const Args& a, LAS unsigned char* lds, int gw, int NGW, int tid, int lane) {
    const float* x = a.in[I_X]; const float* meta = a.in[I_META]; const float* nw = a.in[I_MIXNW]; const float* win = a.in[I_WIN];
    LAS float* wl = (LAS float*)lds;
    stage_w16(wl, win, NPROJ_SRC, 4096, tid);
    __syncthreads();
    bf16_t* HN = (bf16_t*)(a.ws + WS_HN); float* BETA = (float*)(a.ws + WS_BETA); float* GG = (float*)(a.ws + WS_G);
    f32x4 wn[8];
#pragma unroll
    for (int j = 0; j < 8; ++j) wn[j] = *((const f32x4*)nw + lane + 64 * j);
    const int hh = lane & 7;
    const float alog = a.in[I_ALOG][hh], dtb = a.in[I_DTB][hh];
    constexpr int NR0 = 2;
    for (int row0 = gw; row0 < MPAD; row0 += NR0 * NGW) {
        f32x4 v[NR0][8]; float bv[NR0], av[NR0];
        int lane_o = lane; asm volatile("" : "+v"(lane_o));
#pragma unroll
        for (int k = 0; k < NR0; ++k) { const int row = row0 + k * NGW;
            if (row < NTOK) { const int b = row / LSEQ, t = row - b * LSEQ;
                const float* src = (t < NMETA) ? meta + (size_t)t * DM : x + ((size_t)b * SEQ + (t - NMETA)) * DM;
#pragma unroll
                for (int j = 0; j < 8; ++j) v[k][j] = *((const f32x4*)src + lane + 64 * j);
            } else {
#pragma unroll
                for (int j = 0; j < 8; ++j) v[k][j] = (f32x4){0.f, 0.f, 0.f, 0.f}; } }
#pragma unroll
        for (int k = 0; k < NR0; ++k) { const int row = row0 + k * NGW; float ss = 0.f;
#pragma unroll
            for (int j = 0; j < 8; ++j) ss += (v[k][j].x * v[k][j].x + v[k][j].y * v[k][j].y) + (v[k][j].z * v[k][j].z + v[k][j].w * v[k][j].w);
            const float rstd = 1.0f / sqrtf(wave_sum(ss) * (1.0f / DM) + NORM_EPS);
            if (row < MPAD) { GAS unsigned long long* o8 = (GAS unsigned long long*)(HN + (size_t)row * DM) + lane;
#pragma unroll
                for (int j = 0; j < 8; ++j) { v[k][j] = v[k][j] * rstd * wn[j];
                    o8[64 * j] = (unsigned long long)cvt_pk_bf16(v[k][j].x, v[k][j].y) | ((unsigned long long)cvt_pk_bf16(v[k][j].z, v[k][j].w) << 32); } } }
        { float o8[NR0][8]; dot8xN<NR0>(v, wl, lane_o, o8);
#pragma unroll
            for (int k = 0; k < NR0; ++k) { bv[k] = o8[k][0];
#pragma unroll
                for (int c = 1; c < 8; ++c) bv[k] = (hh == c) ? o8[k][c] : bv[k]; }
            dot8xN<NR0>(v, wl + 8 * WLS, lane_o, o8);
#pragma unroll
            for (int k = 0; k < NR0; ++k) { av[k] = o8[k][0];
#pragma unroll
                for (int c = 1; c < 8; ++c) av[k] = (hh == c) ? o8[k][c] : av[k]; } }
#pragma unroll
        for (int k = 0; k < NR0; ++k) { const int row = row0 + k * NGW;
            if (lane < 8 && row < NTOK) {
                const float beta = 1.0f / (1.0f + expf(-bv[k]));
                const float xa = av[k] + dtb; const float sp = fmaxf(xa, 0.f) + log1pf(expf(-fabsf(xa)));
                BETA[(size_t)row * 8 + hh] = beta; GG[(size_t)row * 8 + hh] = -expf(alog) * sp; } }
    }
    __syncthreads();
}

constexpr int CVT_STR = 132;
template <int MODE  >
__device__ __forceinline__ void cvt_tile(const float* W, int ldw, int K, bf16_t* out, int kb, int nt, LAS unsigned char* T, int lane) {
    const int r0 = nt * 64;
    int c0;
    if (MODE == 0) c0 = r0;
    else if (MODE == 1) c0 = r0 < 4096 ? r0 : r0 + 16;
    else { const int pn = r0 >> 8, rr = r0 & 255; c0 = rr < 128 ? 128 * pn + rr : 2048 + 128 * pn + (rr - 128); }
    const int kq = lane >> 4, nl = lane & 15;
    const float* src = W + (size_t)(kb * 64 + 2 * kq) * ldw + c0 + 4 * nl;
    f32x4 v[8][2];
#pragma unroll
    for (int i = 0; i < 8; ++i)
#pragma unroll
        for (int j = 0; j < 2; ++j) v[i][j] = *(const f32x4*)(src + (size_t)(8 * i + j) * ldw);
    LAS unsigned char* tw = T + (4 * nl) * CVT_STR + 4 * kq;
#pragma unroll
    for (int i = 0; i < 8; ++i)
#pragma unroll
        for (int q = 0; q < 4; ++q) *(LAS unsigned*)(tw + q * CVT_STR + 16 * i) = cvt_pk_bf16(v[i][0][q], v[i][1][q]);
    LDS_WAIT();
    const int rn = lane >> 3, cc = lane & 7;
    const LAS unsigned char* tr = T + rn * CVT_STR + 16 * cc;
    bf16_t* dst = out + (size_t)(r0 + rn) * K + kb * 64 + 8 * cc;
#pragma unroll
    for (int j = 0; j < 8; ++j) { u32x4 w; const LAS unsigned* p = (const LAS unsigned*)(tr + 8 * j * CVT_STR); w.x = p[0]; w.y = p[1]; w.z = p[2]; w.w = p[3];
        *(u32x4*)(dst + (size_t)(8 * j) * K) = w; }
    LDS_WAIT();
}
constexpr float W8_SCALE = 64.0f;
template <int MODE, int NLD = 8>
__device__ __forceinline__ void cvt_tile_fp8(const float* W, int ldw, int K, unsigned char* out, int kb, int nt, LAS unsigned char* T, int lane) {
    const int r0 = nt * 64;
    int c0;
    if (MODE == 0) c0 = r0;
    else { const int pn = r0 >> 8, rr = r0 & 255; c0 = rr < 128 ? 128 * pn + rr : 2048 + 128 * pn + (rr - 128); }
    const int kq = lane >> 4, nl = lane & 15;
    LAS unsigned char* tw = T + (4 * nl) * CVT_STR + 4 * kq;
    const float* src = W + (size_t)(kb * 128 + 4 * kq) * ldw + c0 + 4 * nl;
#pragma unroll
    for (int i0 = 0; i0 < 8; i0 += NLD) {
        f32x4 v[NLD][4];
#pragma unroll
        for (int i = 0; i < NLD; ++i)
#pragma unroll
            for (int j = 0; j < 4; ++j) v[i][j] = *(const f32x4*)(src + (size_t)(16 * (i0 + i) + j) * ldw);
#pragma unroll
        for (int i = 0; i < NLD; ++i)
#pragma unroll
            for (int q = 0; q < 4; ++q) *(LAS unsigned*)(tw + q * CVT_STR + 16 * (i0 + i)) =
                pk4_fp8(v[i][0][q] * W8_SCALE, v[i][1][q] * W8_SCALE, v[i][2][q] * W8_SCALE, v[i][3][q] * W8_SCALE);
    }
    LDS_WAIT();
    const int rn = lane >> 3, cc = lane & 7;
    const LAS unsigned char* tr = T + rn * CVT_STR + 16 * cc;
    unsigned char* dst = out + (size_t)(r0 + rn) * K + kb * 128 + 16 * cc;
#pragma unroll
    for (int j = 0; j < 8; ++j) { u32x4 w; const LAS unsigned* p = (const LAS unsigned*)(tr + 8 * j * CVT_STR); w.x = p[0]; w.y = p[1]; w.z = p[2]; w.w = p[3];
        *(u32x4*)(dst + (size_t)(8 * j) * K) = w; }
    LDS_WAIT();
}
__device__ __forceinline__ void p0_weights(const Args& a, LAS unsigned char* lds, int vcu, int G, int wave, int lane) {
    constexpr int I_IN = 32 * 14, I_OUT = 32 * 4;
    constexpr int NITEMS = I_IN + I_OUT;
    LAS unsigned char* T = lds + wave * (64 * CVT_STR);
    for (int it = vcu; it < NITEMS; it += G) {
        int r = it;
        if (r < I_IN) { cvt_tile<1>(a.in[I_WIN], NPROJ_SRC, DM, (bf16_t*)(a.ws + WS_WIN), r / 14, (r % 14) * 8 + wave, T, lane); continue; } r -= I_IN;
        cvt_tile<0>(a.in[I_WOUT], DM, DM, (bf16_t*)(a.ws + WS_WOUT), r / 4, (r % 4) * 8 + wave, T, lane);
    }
}
constexpr int MOE_I_GU = 8 * 4, MOE_I_D = 4 * 4, MOE_ITEMS = NEXP * (MOE_I_GU + MOE_I_D);
template <int NLD = 8> __device__ __forceinline__ void moe_weights_queue(const Args& a, LAS unsigned char* lds, LAS int* qslot, int tid, int wave, int lane, int limit) {
    unsigned* ctr = (unsigned*)(a.ws + WS_CTL) + CW_CVTQ;
    LAS unsigned char* T = lds + wave * (64 * CVT_STR);
    for (;;) {
        __syncthreads();
        if (tid == 0) { int v = (int)__hip_atomic_load(ctr, __ATOMIC_RELAXED, __HIP_MEMORY_SCOPE_AGENT); v = (v < limit) ? (int)atomicAdd(ctr, 1u) : MOE_ITEMS; *qslot = v; }
        __syncthreads();
        const int it = *(volatile LAS int*)qslot;
        if (it >= MOE_ITEMS) break;
        if (it < NEXP * MOE_I_GU) { const int e = it / MOE_I_GU, q = it % MOE_I_GU, ng = q & 7, kq = q >> 3;
#pragma unroll 1
            for (int kb = kq * 4; kb < kq * 4 + 4; ++kb)
                cvt_tile_fp8<2, NLD>(a.in[I_WGU] + (size_t)e * DM * 2 * DE, 2 * DE, DM, a.ws + WS_WGU + (size_t)e * 2 * DE * DM, kb, ng * 8 + wave, T, lane);
        } else { const int r = it - NEXP * MOE_I_GU, e = r / MOE_I_D, q = r % MOE_I_D, ng = q & 3, kq = q >> 2;
#pragma unroll 1
            for (int kb = kq * 4; kb < kq * 4 + 4; ++kb)
                cvt_tile_fp8<0, NLD>(a.in[I_WD] + (size_t)e * DE * DM, DM, DE, a.ws + WS_WD + (size_t)e * DM * DE, kb, ng * 8 + wave, T, lane);
        }
    }
}

__device__ __forceinline__ void p2_qknorm(const Args& a, int gw, int NGW, int lane) {
    const bf16_t* P = (const bf16_t*)(a.ws + WS_P); bf16_t* QN = (bf16_t*)(a.ws + WS_QN); bf16_t* KN = (bf16_t*)(a.ws + WS_KN);
    const float qw0 = a.in[I_SBQNW][2 * lane], qw1 = a.in[I_SBQNW][2 * lane + 1], kw0 = a.in[I_SBKNW][2 * lane], kw1 = a.in[I_SBKNW][2 * lane + 1];
    const float QS = 0.08838834764831845f * 1.4426950408889634f;
    constexpr int QB_ = 8;
    for (int it0 = gw; it0 < NTOK * NHEAD * 2; it0 += QB_ * NGW) {
        unsigned w[QB_];
#pragma unroll
        for (int k = 0; k < QB_; ++k) { const int it = it0 + k * NGW; w[k] = 0u;
            if (it < NTOK * NHEAD * 2) { const int which = it & 1, h = (it >> 1) & 7, row = it >> 4; w[k] = *(const unsigned*)(P + (size_t)row * NPROJ + (which ? PC_SBK : PC_SBQ) + h * HD + 2 * lane); } }
#pragma unroll
        for (int k = 0; k < QB_; ++k) { const int it = it0 + k * NGW;
            if (it < NTOK * NHEAD * 2) { const int which = it & 1, h = (it >> 1) & 7, row = it >> 4; const int b = row / LSEQ, t = row - b * LSEQ;
                const float v0 = bf_lo(w[k]), v1 = bf_hi(w[k]);
                const float rstd = 1.0f / sqrtf(wave_sum(v0 * v0 + v1 * v1) * (1.0f / HD) + NORM_EPS);
                const float o0 = which ? v0 * rstd * kw0 : v0 * rstd * qw0 * QS, o1 = which ? v1 * rstd * kw1 : v1 * rstd * qw1 * QS;
                *(unsigned*)((which ? KN : QN) + ((size_t)(b * NHEAD + h) * LROW + t) * HD + 2 * lane) = cvt_pk_bf16(o0, o1); } }
    }
}

__device__ __forceinline__ bf16x8 sba_pack8(const f32x16& p, int base) {
    u32x4 w; w.x = cvt_pk_bf16(p[base + 0], p[base + 1]); w.y = cvt_pk_bf16(p[base + 2], p[base + 3]); w.z = cvt_pk_bf16(p[base + 4], p[base + 5]); w.w = cvt_pk_bf16(p[base + 6], p[base + 7]);
    return __builtin_bit_cast(bf16x8, w);
}

namespace gdn {
constexpr int NCH = 65;
constexpr int IMG_W = 0, IMG_QG = 16384, IMG_KDT = 32768, IMG_AT = 49152, IMG_BYTES = 57344, IMG_U = 57344, CH_BYTES = 73728;
constexpr int L_QB = 0, L_KB = 17408, L_VB = 34816, L_LT = 52224, L_GC = 69632, L_BE = 69888, L_IMG = 70144;
__device__ __forceinline__ int afrag_off(int row, int k, int nks) {
    const int rt = row >> 5, rr = row & 31, ks = k >> 4, kk = k & 15, hi = (kk >> 2) & 1, sl = (kk & 3) + 4 * (kk >> 3);
    return ((rt * nks + ks) * 64 + rr + 32 * hi) * 16 + sl * 2;
}
__device__ __forceinline__ int ufrag_off(int i, int c) {
    const int cg = c >> 5, col = c & 31, rt = i >> 5, ii = i & 31, hi = (ii >> 2) & 1, r = (ii & 3) + 4 * (ii >> 3);
    return (((cg * 2 + rt) * 2 + (r >> 3)) * 64 + col + 32 * hi) * 8 + (r & 7);
}
__device__ __forceinline__ int crow(int r, int hi) { return (r & 3) + 8 * (r >> 2) + 4 * hi; }
__device__ __forceinline__ bf16_t f2bf(float f) { return (bf16_t)(cvt_pk_bf16(f, 0.f) & 0xffffu); }

__device__ __forceinline__ void prefetch_rows(const Args& a, int item, int lane, int wave, unsigned (&xwp)[33], float (&gbp)[2]) {
    if (item >= 32 * NCH) return;
    const int bh = item / NCH, c = item - bh * NCH, b = bh >> 3, h = bh & 7, tbase = 64 * c - 48;
    const bf16_t* P = (const bf16_t*)(a.ws + WS_P) + (size_t)b * LSEQ * NPROJ;
#pragma unroll
    for (int j = 0; j < 11; ++j) { const int t = tbase + 8 * wave - 3 + j;
#pragma unroll
        for (int w3 = 0; w3 < 3; ++w3) { unsigned u = 0u; if (t >= 0) u = *(const unsigned*)(P + (size_t)t * NPROJ + w3 * 1024 + h * HD + 2 * lane); xwp[j * 3 + w3] = u; } }
    if (wave == 0) { const int t = tbase + lane; float g = 0.f, be = 0.f;
        if (t >= 0) { g = ((const float*)(a.ws + WS_G))[((size_t)b * LSEQ + t) * 8 + h]; be = ((const float*)(a.ws + WS_BETA))[((size_t)b * LSEQ + t) * 8 + h]; }
        gbp[0] = g; gbp[1] = be; }
}
__device__ __forceinline__ void precompute(const Args& a, LAS unsigned char* lds, int item, int tid, int lane, int wave, unsigned (&xwp)[33], float (&gbp)[2], volatile LAS int* nslot, int nclaim) {
    asm volatile("" : "+v"(tid), "+v"(lane), "+s"(wave));
    const int bh = item / NCH, c = item - bh * NCH, b = bh >> 3, h = bh & 7;
    const bf16_t* P = (const bf16_t*)(a.ws + WS_P) + (size_t)b * LSEQ * NPROJ;
    const float* BETA = (const float*)(a.ws + WS_BETA) + (size_t)b * LSEQ * 8; const float* GG = (const float*)(a.ws + WS_G) + (size_t)b * LSEQ * 8;
    unsigned char* dst = a.ws + WS_GCH + (size_t)item * CH_BYTES;
    LAS float* GC = (LAS float*)(lds + L_GC); LAS float* BE = (LAS float*)(lds + L_BE); LAS float* LT = (LAS float*)(lds + L_LT);
    const int tbase = 64 * c - 48;
    if (wave == 0) {
        float g = gbp[0], be = gbp[1];
#pragma unroll
        for (int o = 1; o < 64; o <<= 1) { const float y = __shfl_up(g, o); if (lane >= o) g += y; }
        GC[lane] = g; BE[lane] = be;
        if (lane == 63) ((float*)(a.ws + WS_GL))[item] = expf(g);
    }
    {
        f32x2 cw[3][4];
#pragma unroll
        for (int w3 = 0; w3 < 3; ++w3)
#pragma unroll
            for (int tap = 0; tap < 4; ++tap) cw[w3][tap] = *(const f32x2*)(a.in[I_CONVW] + tap * 3072 + w3 * 1024 + h * HD + 2 * lane);
        f32x2 xw[3][11];
#pragma unroll
        for (int j = 0; j < 11; ++j)
#pragma unroll
            for (int w3 = 0; w3 < 3; ++w3) { const unsigned u = xwp[j * 3 + w3]; xw[w3][j] = (f32x2){bf_lo(u), bf_hi(u)}; }
#pragma unroll
        for (int rr = 0; rr < 8; ++rr) { const int i = 8 * wave + rr; f32x2 y[3];
#pragma unroll
            for (int w3 = 0; w3 < 3; ++w3) { f32x2 acc = cw[w3][0] * xw[w3][rr] + cw[w3][1] * xw[w3][rr + 1] + cw[w3][2] * xw[w3][rr + 2] + cw[w3][3] * xw[w3][rr + 3];
                acc.x = acc.x / (1.0f + __expf(-acc.x)); acc.y = acc.y / (1.0f + __expf(-acc.y)); y[w3] = acc; }
            const float rq = 0.08838834764831845f / sqrtf(wave_sum(y[0].x * y[0].x + y[0].y * y[0].y) + NORM_EPS);
            const float rk = 1.0f / sqrtf(wave_sum(y[1].x * y[1].x + y[1].y * y[1].y) + NORM_EPS);
            *(LAS unsigned*)(lds + L_QB + i * 272 + 4 * lane) = cvt_pk_bf16(y[0].x * rq, y[0].y * rq);
            *(LAS unsigned*)(lds + L_KB + i * 272 + 4 * lane) = cvt_pk_bf16(y[1].x * rk, y[1].y * rk);
            *(LAS unsigned*)(lds + L_VB + i * 272 + 4 * lane) = cvt_pk_bf16(y[2].x, y[2].y); }
    }
    __syncthreads();
    {
        const int prod = wave >> 2, ti = (wave >> 1) & 1, tj = wave & 1, r32 = lane & 31, hi = lane >> 5;
        if (tj <= ti) {
            f32x16 acc;
#pragma unroll
            for (int r = 0; r < 16; ++r) acc[r] = 0.f;
            const LAS unsigned char* Ab = lds + (prod ? L_QB : L_KB) + (32 * ti + r32) * 272 + hi * 16;
            const LAS unsigned char* Bb = lds + L_KB + (32 * tj + r32) * 272 + hi * 16;
#pragma unroll
            for (int ks = 0; ks < 8; ++ks) acc = __builtin_amdgcn_mfma_f32_32x32x16_bf16(*(const LAS bf16x8*)(Ab + ks * 32), *(const LAS bf16x8*)(Bb + ks * 32), acc, 0, 0, 0);
            const int j = 32 * tj + r32; const float gj = GC[j];
#pragma unroll
            for (int r = 0; r < 16; ++r) { const int i = 32 * ti + crow(r, hi); const float dec = __expf(GC[i] - gj);
                if (prod == 0) LT[j * 68 + i] = (j < i) ? acc[r] * BE[i] * dec : 0.f;
                else *(LAS bf16_t*)(lds + L_IMG + IMG_AT + afrag_off(i, j, 4)) = f2bf((j <= i) ? acc[r] * dec : 0.f); }
        }
    }
    if (tid == 0) *nslot = nclaim;
    __syncthreads();
    gdn::prefetch_rows(a, *nslot, lane, wave, xwp, gbp);
    if (tid < 256) {
        float x[64];
        const bool isv = tid < 128; const int cc = tid & 127;
        const LAS unsigned char* src = lds + (isv ? L_VB : L_KB) + cc * 2;
#pragma unroll
        for (int i8 = 0; i8 < 64; i8 += 8) {
#pragma unroll
            for (int q = 0; q < 8; ++q) { const int i = i8 + q; const float v = bf2f(*(const LAS bf16_t*)(src + i * 272)); x[i] = v * BE[i] * (isv ? 1.0f : __expf(GC[i])); }
            asm volatile("" ::: "memory"); }
#pragma unroll
        for (int j = 0; j < 16; ++j) {
#pragma unroll
            for (int i4 = ((j + 1) & ~3); i4 < 64; i4 += 4) { const f32x4 l4 = *(const LAS f32x4*)(LT + j * 68 + i4);
#pragma unroll
                for (int q = 0; q < 4; ++q) if (i4 + q > j) x[i4 + q] -= l4[q] * x[j]; }
            asm volatile("" ::: "memory");
        }
        f32x4 la[12], lb[12];
#define LT_LOAD(dst, j) do { _Pragma("unroll") for (int _c = (((j) + 1) >> 2); _c < 16; ++_c) dst[_c - 4] = *(const LAS f32x4*)(LT + (j) * 68 + 4 * _c); } while (0)
#define LT_APPLY(src, j) do { _Pragma("unroll") for (int _c = (((j) + 1) >> 2); _c < 16; ++_c) { _Pragma("unroll") for (int q = 0; q < 4; ++q) if (4 * _c + q > (j)) x[4 * _c + q] -= src[_c - 4][q] * x[(j)]; } } while (0)
        LT_LOAD(la, 16);
#pragma unroll
        for (int jj = 8; jj < 31; ++jj) {
            LT_LOAD(lb, 2 * jj + 1); asm volatile("" ::: "memory"); LT_APPLY(la, 2 * jj);
            LT_LOAD(la, 2 * jj + 2); asm volatile("" ::: "memory"); LT_APPLY(lb, 2 * jj + 1);
        }
        LT_APPLY(la, 62);
#undef LT_LOAD
#undef LT_APPLY
        if (isv) {
            LAS unsigned char* ub = lds + L_IMG + IMG_U + (((cc >> 5) * 4 * 64) + (cc & 31)) * 16;
#pragma unroll
            for (int i = 0; i < 64; ++i) { const int rt = i >> 5, ii = i & 31, hi = (ii >> 2) & 1, r = (ii & 3) + 4 * (ii >> 3);
                *(LAS bf16_t*)(ub + (((rt * 2 + (r >> 3)) * 64 + 32 * hi) * 8 + (r & 7)) * 2) = f2bf(x[i]); }
        } else {
            const int ks = cc >> 4, kk = cc & 15, hi = (kk >> 2) & 1, sl = (kk & 3) + 4 * (kk >> 3);
            LAS unsigned char* wb = lds + L_IMG + IMG_W + (ks * 64 + 32 * hi) * 16 + sl * 2;
#pragma unroll
            for (int i = 0; i < 64; ++i) *(LAS bf16_t*)(wb + ((i >> 5) * 8 * 64 + (i & 31)) * 16) = f2bf(-x[i]);
        }
    } else {
        const int u = tid - 256, dk = u & 127, i0 = (u >> 7) * 32; const float gl = GC[63];
#pragma unroll 4
        for (int ii = 0; ii < 32; ++ii) { const int i = i0 + ii; const float gi = GC[i];
            const float q = bf2f(*(const LAS bf16_t*)(lds + L_QB + i * 272 + dk * 2)), k = bf2f(*(const LAS bf16_t*)(lds + L_KB + i * 272 + dk * 2));
            *(LAS bf16_t*)(lds + L_IMG + IMG_QG + afrag_off(i, dk, 8)) = f2bf(q * __expf(gi));
            *(LAS bf16_t*)(lds + L_IMG + IMG_KDT + afrag_off(dk, i, 4)) = f2bf(k * __expf(gl - gi)); }
    }
    __syncthreads();
    for (int q = tid; q < CH_BYTES / 16; q += NTHREADS) *(u32x4*)(dst + (size_t)q * 16) = *(const LAS u32x4*)(lds + L_IMG + q * 16);
}

constexpr int OB_OFF = 2 * IMG_BYTES, OB_STR = 272, OB_BYTES = 64 * OB_STR;
__device__ __forceinline__ void gated_load_z(const Args& a, u32x4 (&zw)[4], int b, int h, int cc, int w4, int lane) {
    const bf16_t* P = (const bf16_t*)(a.ws + WS_P);
    const int s = 64 * (cc - 1) + 16 * w4 + (lane >> 2);
    const u32x4* zp = (const u32x4*)(P + ((size_t)b * LSEQ + NMETA + s) * NPROJ + PC_Z + h * HD + 32 * (lane & 3));
#pragma unroll
    for (int q = 0; q < 4; ++q) zw[q] = zp[q];
}
__device__ __forceinline__ float silu_f(float z) { return z * __builtin_amdgcn_rcpf(1.0f + __expf(-z)); }
__device__ __forceinline__ void gated_rows(const Args& a, const LAS unsigned char* ob, const u32x4 (&zw)[4], int b, int h, int cc, int w4, int lane, const f32x4 (&nwv)[8]) {
    bf16_t* MIX = (bf16_t*)(a.ws + WS_MIX);
    const int row = lane >> 2, qd = lane & 3, s = 64 * (cc - 1) + 16 * w4 + row;
    u32x4 ov[4]; float ss = 0.f;
#pragma unroll
    for (int q = 0; q < 4; ++q) { ov[q] = *(const LAS u32x4*)(ob + (16 * w4 + row) * OB_STR + qd * 64 + q * 16);
#pragma unroll
        for (int e = 0; e < 4; ++e) { const float lo = bf_lo(ov[q][e]), hi = bf_hi(ov[q][e]); ss += lo * lo + hi * hi; } }
    ss = quad_sum(ss);
    const float rstd = __builtin_amdgcn_rsqf(ss * (1.0f / HD) + NORM_EPS);
    u32x4* dst = (u32x4*)(MIX + ((size_t)b * SEQ + s) * DM + h * HD + 32 * qd);
#pragma unroll
    for (int q = 0; q < 4; ++q) { u32x4 w;
#pragma unroll
        for (int e = 0; e < 4; ++e) { const f32x4 nv = nwv[2 * q + (e >> 1)];
            const float n0 = (e & 1) ? nv.z : nv.x, n1 = (e & 1) ? nv.w : nv.y;
            w[e] = cvt_pk_bf16(bf_lo(ov[q][e]) * rstd * n0 * silu_f(bf_lo(zw[q][e])), bf_hi(ov[q][e]) * rstd * n1 * silu_f(bf_hi(zw[q][e]))); }
        dst[q] = w; }
}

__device__ __forceinline__ void scan(const Args& a, LAS unsigned char* lds, int bh, int tid, int lane, int wave) {
    const int b = bh >> 3, h = bh & 7, col = lane & 31, hi = lane >> 5, cg = wave;
    const unsigned char* src = a.ws + WS_GCH + (size_t)bh * NCH * CH_BYTES;
    const float* GL = (const float*)(a.ws + WS_GL) + bh * NCH;
    __syncthreads();
    const unsigned dvoff = (unsigned)(wave * 1024 + lane * 16), uvoff = (unsigned)(lane * 16);
#define GDN_DMA(ch, buf) do { const unsigned char* _sp = src + (size_t)(ch) * CH_BYTES; _Pragma("unroll") for (int _f = 0; _f < 7; ++_f) { \
        __builtin_amdgcn_global_load_lds((const unsigned*)(_sp + _f * 8192 + dvoff), (LAS unsigned*)(lds + (buf) * IMG_BYTES + wave * 1024 + _f * 8192), 16, 0, 0); } } while (0)
    GDN_DMA(0, 0);
#define GDN_STEP_END(vm) do { asm volatile("s_waitcnt vmcnt(" #vm ")" ::: "memory"); asm volatile("s_waitcnt lgkmcnt(0)" ::: "memory"); __builtin_amdgcn_s_barrier(); asm volatile("" ::: "memory"); } while (0)
    if (wave < 4) {
        f32x16 st[4]; bf16x8 Sb[8]; u32x4 ureg[4]; float gl;
#pragma unroll
        for (int t4 = 0; t4 < 4; ++t4)
#pragma unroll
            for (int r = 0; r < 16; ++r) st[t4][r] = 0.f;
#pragma unroll
        for (int ks = 0; ks < 8; ++ks) Sb[ks] = (bf16x8){0, 0, 0, 0, 0, 0, 0, 0};
#pragma unroll
        for (int q = 0; q < 4; ++q) ureg[q] = *(const u32x4*)(src + IMG_U + cg * 4096 + q * 1024 + uvoff);
        gl = GL[0];
        GDN_STEP_END(0);
        for (int c = 0; c < NCH; ++c) {
            const LAS unsigned char* img = lds + (c & 1) * IMG_BYTES + lane * 16;
            asm volatile("" : "+v"(ureg[0]), "+v"(ureg[1]), "+v"(ureg[2]), "+v"(ureg[3]), "+v"(gl));
            if (c + 1 < NCH) GDN_DMA(c + 1, (c + 1) & 1);
            f32x16 vn[2]; const float glc = gl;
#pragma unroll
            for (int rt = 0; rt < 2; ++rt)
#pragma unroll
                for (int rh = 0; rh < 2; ++rh) { const u32x4 w = ureg[rt * 2 + rh];
                    vn[rt][8 * rh + 0] = bf_lo(w.x); vn[rt][8 * rh + 1] = bf_hi(w.x); vn[rt][8 * rh + 2] = bf_lo(w.y); vn[rt][8 * rh + 3] = bf_hi(w.y);
                    vn[rt][8 * rh + 4] = bf_lo(w.z); vn[rt][8 * rh + 5] = bf_hi(w.z); vn[rt][8 * rh + 6] = bf_lo(w.w); vn[rt][8 * rh + 7] = bf_hi(w.w); }
            asm volatile("" ::: "memory");
            if (c + 1 < NCH) {
#pragma unroll
                for (int q = 0; q < 4; ++q) ureg[q] = *(const u32x4*)(src + (size_t)(c + 1) * CH_BYTES + IMG_U + cg * 4096 + q * 1024 + uvoff);
                gl = GL[c + 1]; }
#pragma unroll
            for (int rt = 0; rt < 2; ++rt) { __builtin_amdgcn_sched_barrier(0);
#pragma unroll
                for (int ks = 0; ks < 8; ++ks) vn[rt] = __builtin_amdgcn_mfma_f32_32x32x16_bf16(*(const LAS bf16x8*)(img + IMG_W + (rt * 8 + ks) * 1024), Sb[ks], vn[rt], 0, 0, 0); }
            __builtin_amdgcn_sched_barrier(0);
            bf16x8 vb[4];
#pragma unroll
            for (int ks = 0; ks < 4; ++ks) vb[ks] = sba_pack8(vn[ks >> 1], 8 * (ks & 1));
            LAS unsigned char* obw = lds + OB_OFF + (c & 1) * OB_BYTES + (32 * cg + col) * 2;
#pragma unroll
            for (int rt = 0; rt < 2; ++rt) { f32x16 o; __builtin_amdgcn_sched_barrier(0);
#pragma unroll
                for (int r = 0; r < 16; ++r) o[r] = 0.f;
#pragma unroll
                for (int ks = 0; ks < 8; ++ks) o = __builtin_amdgcn_mfma_f32_32x32x16_bf16(*(const LAS bf16x8*)(img + IMG_QG + (rt * 8 + ks) * 1024), Sb[ks], o, 0, 0, 0);
#pragma unroll
                for (int ks = 0; ks < 2 * (rt + 1); ++ks) o = __builtin_amdgcn_mfma_f32_32x32x16_bf16(*(const LAS bf16x8*)(img + IMG_AT + (rt * 4 + ks) * 1024), vb[ks], o, 0, 0, 0);
                if (c >= 1) {
#pragma unroll
                    for (int r = 0; r < 16; ++r) *(LAS bf16_t*)(obw + (32 * rt + crow(r, hi)) * OB_STR) = f2bf(o[r]); }
            }
#pragma unroll
            for (int t4 = 0; t4 < 4; ++t4) { __builtin_amdgcn_sched_barrier(0);
#pragma unroll
                for (int r = 0; r < 16; ++r) st[t4][r] *= glc;
#pragma unroll
                for (int ks = 0; ks < 4; ++ks) st[t4] = __builtin_amdgcn_mfma_f32_32x32x16_bf16(*(const LAS bf16x8*)(img + IMG_KDT + (t4 * 4 + ks) * 1024), vb[ks], st[t4], 0, 0, 0);
                Sb[2 * t4] = sba_pack8(st[t4], 0); Sb[2 * t4 + 1] = sba_pack8(st[t4], 8); }
            if (c + 1 < NCH) GDN_STEP_END(5); else GDN_STEP_END(0);
        }
    } else {
        u32x4 zA[4], zB[4]; f32x4 nwv[8];
#pragma unroll
        for (int q = 0; q < 4; ++q) { zA[q] = (u32x4){0u, 0u, 0u, 0u}; zB[q] = (u32x4){0u, 0u, 0u, 0u}; }
#pragma unroll
        for (int q = 0; q < 8; ++q) nwv[q] = *(const f32x4*)(a.in[I_GDNNW] + 32 * (lane & 3) + 4 * q);
        GDN_STEP_END(0);
        for (int c = 0; c < NCH; ++c) {
#pragma unroll
            for (int q = 0; q < 4; ++q) asm volatile("" : "+v"(zA[q]), "+v"(zB[q]));
            if (c + 1 < NCH) GDN_DMA(c + 1, (c + 1) & 1);
            if (c >= 1) { if (c & 1) gated_load_z(a, zA, b, h, c, wave - 4, lane); else gated_load_z(a, zB, b, h, c, wave - 4, lane); }
            asm volatile("" ::: "memory");
            if (c >= 2) { if (c & 1) gated_rows(a, lds + OB_OFF + ((c - 1) & 1) * OB_BYTES, zB, b, h, c - 1, wave - 4, lane, nwv);
                          else gated_rows(a, lds + OB_OFF + ((c - 1) & 1) * OB_BYTES, zA, b, h, c - 1, wave - 4, lane, nwv); }
            if (c >= 2) GDN_STEP_END(4); else GDN_STEP_END(0);
        }
        gated_rows(a, lds + OB_OFF + ((NCH - 1) & 1) * OB_BYTES, zB, b, h, NCH - 1, wave - 4, lane, nwv);
    }
#undef GDN_STEP_END
#undef GDN_DMA
}
}

namespace sba {
#define KSWZ(row, colB) ((row) * 256 + ((colB) ^ (((row) & 7) << 4)))
__device__ __forceinline__ int v_st(int k, int c) { const int kk = (k & ~0xC) | ((k & 4) << 1) | ((k & 8) >> 1); return ((kk >> 3) * 4 + (c >> 5)) * 512 + ((kk & 7) * 32 + (c & 31)) * 2; }
__device__ __forceinline__ int v_rd_base(int lane) { return ((lane & 3) << 3) | (((lane >> 2) & 3) << 6) | (((lane >> 4) & 1) << 5) | (((lane >> 5) & 1) << 8); }
constexpr int v_rd_off(int d0, int ks, int half) { return d0 * 512 + ks * 4096 + half * 2048; }
template <int OFF> __device__ __forceinline__ s16x4 tr_read(int vb) { s16x4 r; asm volatile("ds_read_b64_tr_b16 %0, %1 offset:%2" : "=&v"(r) : "v"(vb), "i"(OFF) : "memory"); return r; }
template <int D0> __device__ __forceinline__ void pv_one(f32x16& od, int vb, bf16x8 pa0, bf16x8 pa1, bf16x8 pa2, bf16x8 pa3) {
    const s16x4 l0 = tr_read<v_rd_off(D0, 0, 0)>(vb), h0 = tr_read<v_rd_off(D0, 0, 1)>(vb), l1 = tr_read<v_rd_off(D0, 1, 0)>(vb), h1 = tr_read<v_rd_off(D0, 1, 1)>(vb);
    const s16x4 l2 = tr_read<v_rd_off(D0, 2, 0)>(vb), h2 = tr_read<v_rd_off(D0, 2, 1)>(vb), l3 = tr_read<v_rd_off(D0, 3, 0)>(vb), h3 = tr_read<v_rd_off(D0, 3, 1)>(vb);
    asm volatile("s_waitcnt lgkmcnt(0)" ::: "memory"); __builtin_amdgcn_sched_barrier(0);
#define PK(L, H) (bf16x8){L[0], L[1], L[2], L[3], H[0], H[1], H[2], H[3]}
    od = __builtin_amdgcn_mfma_f32_32x32x16_bf16(pa0, PK(l0, h0), od, 0, 0, 0);
    od = __builtin_amdgcn_mfma_f32_32x32x16_bf16(pa1, PK(l1, h1), od, 0, 0, 0);
    od = __builtin_amdgcn_mfma_f32_32x32x16_bf16(pa2, PK(l2, h2), od, 0, 0, 0);
    od = __builtin_amdgcn_mfma_f32_32x32x16_bf16(pa3, PK(l3, h3), od, 0, 0, 0);
#undef PK
}
__device__ __forceinline__ int crow(int r, int hi) { return (r & 3) + 8 * (r >> 2) + 4 * hi; }
__device__ __forceinline__ int swap34(int k) { return (k & ~0x18) | ((k & 8) << 1) | ((k & 16) >> 1); }
__device__ __forceinline__ bf16x8 pack8(const f32x16& p, int base) {
    u32x4 w; w.x = cvt_pk_bf16(p[base + 0], p[base + 1]); w.y = cvt_pk_bf16(p[base + 2], p[base + 3]); w.z = cvt_pk_bf16(p[base + 4], p[base + 5]); w.w = cvt_pk_bf16(p[base + 6], p[base + 7]);
    return __builtin_bit_cast(bf16x8, w);
}
constexpr float SB_EXIT = 160.0f;

__device__ __forceinline__ void unit(const Args& a, LAS unsigned char* lds, volatile LAS int* done_cnt, int b, int h, int qb, int tid, int lane, int wid) {
    const bf16_t* QN = (const bf16_t*)(a.ws + WS_QN) + (size_t)(b * NHEAD + h) * LROW * HD;
    const bf16_t* KN = (const bf16_t*)(a.ws + WS_KN) + (size_t)(b * NHEAD + h) * LROW * HD;
    const bf16_t* Vp = (const bf16_t*)(a.ws + WS_P) + (size_t)b * LSEQ * NPROJ + PC_SBV + h * HD;
    bf16_t* MIX = (bf16_t*)(a.ws + WS_MIX);
    const int r32 = lane & 31, hi = lane >> 5;
    LAS unsigned char* K_lds = lds; LAS unsigned char* V_lds = lds + 16384;
    const int tq0 = NMETA + 256 * qb + 32 * wid, tq = tq0 + r32;
    __syncthreads();
    if (tid == 0) *done_cnt = 0;
    bf16x8 qr[8];
#pragma unroll
    for (int d0 = 0; d0 < 8; ++d0) qr[d0] = *(const bf16x8*)(QN + (size_t)tq * HD + d0 * 16 + hi * 8);
    const int sr = tid >> 4, sc = (tid & 15) * 8;
    const int vst0 = v_st(swap34(sr), sc), vst1 = v_st(32 + swap34(sr), sc);
    const int kst0 = KSWZ(sr, sc * 2), kst1 = KSWZ(32 + sr, sc * 2);
    const int vb0 = (int)(unsigned)(unsigned long)V_lds + v_rd_base(lane);
    const int prow = (r32 & 3) + 4 * (r32 >> 3) + 16 * ((r32 >> 2) & 1);
    f32x16 o[4];
#pragma unroll
    for (int d = 0; d < 4; ++d)
#pragma unroll
        for (int r = 0; r < 16; ++r) o[d][r] = 0.f;
    float carry = 0.f; bool flagged = false;
    bf16x8 ks0, ks1, vs0, vs1;
#define SBA_LOAD(kk) do { const int _k0 = 64 * (kk); ks0 = *(const bf16x8*)(KN + (size_t)(_k0 + sr) * HD + sc); ks1 = *(const bf16x8*)(KN + (size_t)(_k0 + 32 + sr) * HD + sc); \
        vs0 = *(const bf16x8*)(Vp + (size_t)(_k0 + sr) * NPROJ + sc); vs1 = *(const bf16x8*)(Vp + (size_t)(_k0 + 32 + sr) * NPROJ + sc); } while (0)
    SBA_LOAD(4 * qb + 4);
    for (int kt = 4 * qb + 4; kt >= 0; --kt) {
        const int k0 = 64 * kt;
        __syncthreads();
        if (*done_cnt == NWAVES) break;
        *(LAS bf16x8*)(K_lds + kst0) = ks0; *(LAS bf16x8*)(K_lds + kst1) = ks1; *(LAS bf16x8*)(V_lds + vst0) = vs0; *(LAS bf16x8*)(V_lds + vst1) = vs1;
        if (kt > 0) SBA_LOAD(kt - 1);
        __syncthreads();
        if (k0 >= tq0 + 32) continue;
        f32x16 p0, p1;
#pragma unroll
        for (int r = 0; r < 16; ++r) { p0[r] = 0.f; p1[r] = 0.f; }
#pragma unroll
        for (int d0 = 0; d0 < 8; ++d0) { const int cb = (d0 * 16 + hi * 8) * 2;
            const bf16x8 b0 = *(const LAS bf16x8*)(K_lds + KSWZ(prow, cb)), b1 = *(const LAS bf16x8*)(K_lds + KSWZ(32 + prow, cb));
            p0 = __builtin_amdgcn_mfma_f32_32x32x16_bf16(b0, qr[d0], p0, 0, 0, 0);
            p1 = __builtin_amdgcn_mfma_f32_32x32x16_bf16(b1, qr[d0], p1, 0, 0, 0); }
        const bool need_mask = (k0 + 63 >= tq0);
        f32x16 s0, s1; float t0 = 0.f, t1 = 0.f;
#pragma unroll
        for (int r = 0; r < 16; ++r) {
            float e0 = __builtin_amdgcn_exp2f(p0[r]), e1 = __builtin_amdgcn_exp2f(p1[r]);
            float q0 = __builtin_amdgcn_logf(1.0f + e0), q1 = __builtin_amdgcn_logf(1.0f + e1);
            if (need_mask) { const bool v0 = (k0 + 16 * hi + r) < tq, v1 = (k0 + 32 + 16 * hi + r) < tq; e0 = v0 ? e0 : 0.f; q0 = v0 ? q0 : 0.f; e1 = v1 ? e1 : 0.f; q1 = v1 ? q1 : 0.f; }
            p0[r] = e0; p1[r] = e1; s0[r] = q0; s1[r] = q1; t0 += q0; t1 += q1; }
        float t1lo, t1hi, t0lo, t0hi;
        { auto rr = __builtin_amdgcn_permlane32_swap(__float_as_uint(t1), __float_as_uint(t1), false, false); t1lo = __uint_as_float(rr[0]); t1hi = __uint_as_float(rr[1]); }
        { auto rr = __builtin_amdgcn_permlane32_swap(__float_as_uint(t0), __float_as_uint(t0), false, false); t0lo = __uint_as_float(rr[0]); t0hi = __uint_as_float(rr[1]); }
        float run1 = carry + (hi ? 0.f : t1hi), run0 = carry + (t1lo + t1hi) + (hi ? 0.f : t0hi);
#pragma unroll
        for (int r = 15; r >= 0; --r) { run1 += s1[r]; p1[r] = p1[r] * __builtin_amdgcn_exp2f(-run1); run0 += s0[r]; p0[r] = p0[r] * __builtin_amdgcn_exp2f(-run0); }
        carry += (t1lo + t1hi) + (t0lo + t0hi);
        const bf16x8 pa0 = pack8(p0, 0), pa1 = pack8(p0, 8), pa2 = pack8(p1, 0), pa3 = pack8(p1, 8);
        pv_one<0>(o[0], vb0, pa0, pa1, pa2, pa3); pv_one<1>(o[1], vb0, pa0, pa1, pa2, pa3); pv_one<2>(o[2], vb0, pa0, pa1, pa2, pa3); pv_one<3>(o[3], vb0, pa0, pa1, pa2, pa3);
        if (!flagged && __all(carry >= SB_EXIT)) { flagged = true; if (lane == 0) (void)__hip_atomic_fetch_add((LAS int*)done_cnt, 1, __ATOMIC_RELAXED, __HIP_MEMORY_SCOPE_WORKGROUP); }
    }
#undef SBA_LOAD
    const float* onw = a.in[I_SBONW];
    float wv[4];
#pragma unroll
    for (int d0 = 0; d0 < 4; ++d0) wv[d0] = onw[32 * d0 + r32];
#pragma unroll
    for (int r = 0; r < 16; ++r) {
        float ss = (o[0][r] * o[0][r] + o[1][r] * o[1][r]) + (o[2][r] * o[2][r] + o[3][r] * o[3][r]);
        ss = row16_sum(ss); ss += __shfl_xor(ss, 16);
        const float rstd = 1.0f / sqrtf(ss * (1.0f / HD) + NORM_EPS);
        const size_t tok = (size_t)b * SEQ + (tq0 - NMETA) + crow(r, hi);
        bf16_t* dst = MIX + tok * DM + 1024 + h * HD + r32;
#pragma unroll
        for (int d0 = 0; d0 < 4; ++d0) dst[32 * d0] = (bf16_t)(cvt_pk_bf16(o[d0][r] * rstd * wv[d0], 0.f) & 0xffffu);
    }
}
}

__device__ __forceinline__ void p5_router(const Args& a, LAS unsigned char* lds, int G, int c, int tid, int lane, int wave) {
    LAS float* wl = (LAS float*)lds;
    LAS float* lg = (LAS float*)(lds + 132096);
    LAS int* misc = (LAS int*)(lds + MISC_OFF);
    const float* H1 = a.out; const float* rw = a.in[I_RW]; const float* rb = a.in[I_RB];
    unsigned char* HN2 = a.ws + WS_HN;
    int* RE = (int*)(a.ws + WS_RE); int* RP = (int*)(a.ws + WS_RP); float* RG = (float*)(a.ws + WS_RG); int* LIST = (int*)(a.ws + WS_LIST);
    unsigned* ecnt = (unsigned*)(a.ws + WS_CTL) + CW_ECNT;
    f32x4 wn[8];
#pragma unroll
    for (int j = 0; j < 8; ++j) wn[j] = *((const f32x4*)a.in[I_FFNNW] + lane + 64 * j);
    for (int blk = c; blk < NREAL / 64; blk += G) {
        for (int pass = 0; pass < 2; ++pass) {
            __syncthreads();
            stage_w16(wl, rw, NEXP, pass * 16, tid);
            if (pass == 0 && tid < 32) misc[40 + tid] = 0;
            __syncthreads();
            for (int rg = 0; rg < 4; ++rg) {
                f32x4 v[2][8];
#pragma unroll
                for (int k = 0; k < 2; ++k) { const size_t row = (size_t)blk * 64 + wave * 8 + rg * 2 + k;
#pragma unroll
                    for (int j = 0; j < 8; ++j) v[k][j] = *((const f32x4*)(H1 + row * DM) + lane + 64 * j); }
#pragma unroll
                for (int k = 0; k < 2; ++k) { const size_t row = (size_t)blk * 64 + wave * 8 + rg * 2 + k; float ss = 0.f;
#pragma unroll
                    for (int j = 0; j < 8; ++j) ss += (v[k][j].x * v[k][j].x + v[k][j].y * v[k][j].y) + (v[k][j].z * v[k][j].z + v[k][j].w * v[k][j].w);
                    const float rstd = 1.0f / sqrtf(wave_sum(ss) * (1.0f / DM) + NORM_EPS);
                    GAS unsigned* o4 = (GAS unsigned*)(HN2 + row * DM) + lane;
#pragma unroll
                    for (int j = 0; j < 8; ++j) { v[k][j] = v[k][j] * rstd * wn[j];
                        if (pass == 0) o4[64 * j] = pk4_fp8(v[k][j].x, v[k][j].y, v[k][j].z, v[k][j].w); } }
#pragma unroll
                for (int hf = 0; hf < 2; ++hf) { float o8[2][8]; dot8xN<2>(v, wl + hf * 8 * WLS, lane, o8);
#pragma unroll
                    for (int k = 0; k < 2; ++k) { float sv = o8[k][0];
#pragma unroll
                        for (int c = 1; c < 8; ++c) sv = ((lane & 7) == c) ? o8[k][c] : sv;
                        if (lane < 8) lg[(wave * 8 + rg * 2 + k) * 33 + pass * 16 + hf * 8 + lane] = sv; } }
            }
        }
        __syncthreads();
        int ek[4] = {0, 0, 0, 0}, rk[4] = {0, 0, 0, 0}; float gk[4] = {0.f, 0.f, 0.f, 0.f};
        if (tid < 64) {
            float v[32];
#pragma unroll
            for (int e = 0; e < 32; ++e) v[e] = lg[tid * 33 + e] + rb[e];
            float val[4];
#pragma unroll
            for (int k = 0; k < 4; ++k) { float best = -3.0e38f; int bi = 0;
#pragma unroll
                for (int e = 0; e < 32; ++e) { const bool gt = v[e] > best; best = gt ? v[e] : best; bi = gt ? e : bi; }
#pragma unroll
                for (int e = 0; e < 32; ++e) v[e] = (e == bi) ? -3.0e38f : v[e];
                ek[k] = bi; val[k] = best; }
            float den = 0.f;
#pragma unroll
            for (int k = 0; k < 4; ++k) { gk[k] = expf(val[k] - val[0]); den += gk[k]; }
#pragma unroll
            for (int k = 0; k < 4; ++k) { gk[k] = gk[k] / den; rk[k] = __hip_atomic_fetch_add(&misc[40 + ek[k]], 1, __ATOMIC_RELAXED, __HIP_MEMORY_SCOPE_WORKGROUP); }
        }
        __syncthreads();
        if (tid < 32) { const int cnt = misc[40 + tid]; misc[72 + tid] = cnt ? (int)atomicAdd(&ecnt[tid], (unsigned)cnt) : 0; }
        __syncthreads();
        if (tid < 64) { const int tok = blk * 64 + tid;
#pragma unroll
            for (int k = 0; k < 4; ++k) { const int pos = misc[72 + ek[k]] + rk[k]; LIST[(size_t)ek[k] * NREAL + pos] = tok; RE[tok * 4 + k] = ek[k]; RP[tok * 4 + k] = pos; RG[tok * 4 + k] = gk[k]; } }
    }
    __syncthreads();
}

__device__ __forceinline__ int moe_setup(const Args& a, LAS int* misc, int tid) {
    const unsigned* ecnt = (const unsigned*)(a.ws + WS_CTL) + CW_ECNT;
    __syncthreads();
    if (tid == 0) { int acc = 0;
        for (int e = 0; e < NEXP; ++e) { const int cnt = (int)__hip_atomic_load(ecnt + e, __ATOMIC_RELAXED, __HIP_MEMORY_SCOPE_AGENT); misc[104 + e] = cnt; misc[e] = acc; acc += (cnt + 255) >> 8; }
        misc[32] = acc; }
    __syncthreads();
    return misc[32];
}

__device__ __forceinline__ void p8_combine(const Args& a, const LAS int* misc, int gw, int NGW, int lane) {
    const int* RE = (const int*)(a.ws + WS_RE); const int* RP = (const int*)(a.ws + WS_RP); const float* RG = (const float*)(a.ws + WS_RG);
    const bf16_t* Y = (const bf16_t*)(a.ws + WS_Y); float* out = a.out;
    typedef int i32x4 __attribute__((ext_vector_type(4)));
    i32x4 e4 = {0, 0, 0, 0}, p4 = {0, 0, 0, 0}; f32x4 g4 = {0.f, 0.f, 0.f, 0.f};
    if (gw < NREAL) { e4 = *(const i32x4*)(RE + gw * 4); p4 = *(const i32x4*)(RP + gw * 4); g4 = *(const f32x4*)(RG + gw * 4); }
    for (int row = gw; row < NREAL; row += NGW) {
        size_t slot[4]; float g[4];
#pragma unroll
        for (int k = 0; k < 4; ++k) { slot[k] = (size_t)misc[e4[k]] * 256 + p4[k]; g[k] = g4[k]; }
        const int nrow = row + NGW;
        if (nrow < NREAL) { e4 = *(const i32x4*)(RE + nrow * 4); p4 = *(const i32x4*)(RP + nrow * 4); g4 = *(const f32x4*)(RG + nrow * 4); }
        f32x4 acc[4][2]; u32x4 y[4][4];
#pragma unroll
        for (int j = 0; j < 4; ++j) { const int col = 8 * lane + 512 * j;
            acc[j][0] = *(const f32x4*)(out + (size_t)row * DM + col); acc[j][1] = *(const f32x4*)(out + (size_t)row * DM + col + 4);
#pragma unroll
            for (int k = 0; k < 4; ++k) y[j][k] = *(const u32x4*)(Y + slot[k] * DM + col); }
#pragma unroll
        for (int j = 0; j < 4; ++j) { const int col = 8 * lane + 512 * j; f32x4 a0 = acc[j][0], a1 = acc[j][1];
#pragma unroll
            for (int k = 0; k < 4; ++k) { const u32x4 yy = y[j][k];
                a0.x += g[k] * bf_lo(yy.x); a0.y += g[k] * bf_hi(yy.x); a0.z += g[k] * bf_lo(yy.y); a0.w += g[k] * bf_hi(yy.y);
                a1.x += g[k] * bf_lo(yy.z); a1.y += g[k] * bf_hi(yy.z); a1.z += g[k] * bf_lo(yy.w); a1.w += g[k] * bf_hi(yy.w); }
            *(f32x4*)(out + (size_t)row * DM + col) = a0; *(f32x4*)(out + (size_t)row * DM + col + 4) = a1; }
    }
}

__device__ __forceinline__ void p1_meta_rows(const Args& a, LAS unsigned char* lds, int bx, int G, int tid, int wave, int lane) {
    const bf16_t* HN = (const bf16_t*)(a.ws + WS_HN); const bf16_t* WT = (const bf16_t*)(a.ws + WS_WIN); bf16_t* P = (bf16_t*)(a.ws + WS_P);
    for (int q = tid; q < NMETA * DM * 2 / 16; q += NTHREADS) *(LAS u32x4*)(lds + q * 16) = *(const u32x4*)((const unsigned char*)HN + (size_t)q * 16);
    __syncthreads();
    for (int col = bx + G * wave; col < NPROJ; col += G * NWAVES) {
        u32x4 w[4]; int lane_o = lane; asm volatile("" : "+v"(lane_o));
#pragma unroll
        for (int j = 0; j < 4; ++j) w[j] = *(const u32x4*)(WT + (size_t)col * DM + 8 * lane + 512 * j);
        float v = 0.f;
#pragma unroll 1
        for (int t = 0; t < NMETA; ++t) { float s = 0.f;
#pragma unroll
            for (int j = 0; j < 4; ++j) { const u32x4 x = *(const LAS u32x4*)(lds + t * (DM * 2) + (8 * lane_o + 512 * j) * 2);
                s += bf_lo(x.x) * bf_lo(w[j].x) + bf_hi(x.x) * bf_hi(w[j].x) + bf_lo(x.y) * bf_lo(w[j].y) + bf_hi(x.y) * bf_hi(w[j].y)
                   + bf_lo(x.z) * bf_lo(w[j].z) + bf_hi(x.z) * bf_hi(w[j].z) + bf_lo(x.w) * bf_lo(w[j].w) + bf_hi(x.w) * bf_hi(w[j].w); }
            s = wave_sum(s);
            v = ((lane & 15) == t) ? s : v; }
        P[((size_t)(lane >> 4) * LSEQ + (lane & 15)) * NPROJ + col] = gdn::f2bf(v);
    }
    __syncthreads();
}

constexpr int NPH = 9;
__global__ void __launch_bounds__(NTHREADS, 2) hymba_fwd(Args args) {
    extern __shared__ __attribute__((aligned(16))) unsigned char lds_raw[];
    LAS unsigned char* lds = (LAS unsigned char*)lds_raw;
    LAS int* misc = (LAS int*)(lds + MISC_OFF);
    const int tid = threadIdx.x, lane = tid & 63, wave = __builtin_amdgcn_readfirstlane(tid >> 6);
    const int G = gridDim.x, bx = blockIdx.x;
    const int vcu = (G % 8 == 0) ? (bx % 8) * (G / 8) + bx / 8 : bx;
    const int gw = vcu * NWAVES + wave, NGW = G * NWAVES;
    unsigned* ctl = (unsigned*)(args.ws + WS_CTL);
    for (int u = tid; u < 256; u += NTHREADS) misc[u] = 0;
    __syncthreads();
    XcdBarrier bar; bar.bar = ctl + CW_BAR; bar.x = 0; bar.st = nullptr;
    const int lo = args.ph_lo, hi = args.ph_hi;
    constexpr int CVT_LIMIT_P2 = MOE_ITEMS * 35 / 100;
    if (hi - lo > 1) bar = xcd_barrier_post(ctl + CW_BAR, (volatile LAS unsigned*)(misc + 200));
#define IN(k) (lo <= (k) && (k) < hi)
#define SEAM(k) do { if (IN(k) && IN((k) + 1)) xcd_barrier(bar); } while (0)

    if (IN(0)) { p0_rows(args, lds, gw, NGW, tid, lane); p0_weights(args, lds, vcu, G, wave, lane); }
    SEAM(0);
    if (IN(1)) {
        p1_meta_rows(args, lds, bx, G, tid, wave, lane);
        pg8::PlainOrder S; S.init(NREAL, NPROJ, DM, args.ws + WS_WIN, G, bx); S.meta = 1;
        pg8::EpiBf16 E{(bf16_t*)(args.ws + WS_P), NPROJ, 1};
        pg8::gemm_phase<pg8::EpiBf16, pg8::PlainOrder, true, true>(lds, (const char*)(args.ws + WS_HN), DM * 2, S, E);
    }
    SEAM(1);
    if (IN(2)) {
        p2_qknorm(args, gw, NGW, lane);
        const bool roleB = (G >= 128) && (bx >= G - G / 8 * 3);
        if (roleB) moe_weights_queue<CVT_NLD_P2>(args, lds, misc + 212, tid, wave, lane, CVT_LIMIT_P2);
        unsigned xwp[33]; float gbp[2] = {0.f, 0.f};
        __syncthreads();
        if (tid == 0) misc[213] = (int)atomicAdd(ctl + CW_PREQ, 1u);
        __syncthreads();
        int it = *(volatile LAS int*)(misc + 213);
        gdn::prefetch_rows(args, it, lane, wave, xwp, gbp);
        while (it < 32 * gdn::NCH) {
            const int nclaim = (tid == 0) ? (int)atomicAdd(ctl + CW_PREQ, 1u) : 0;
            gdn::precompute(args, lds, it, tid, lane, wave, xwp, gbp, (volatile LAS int*)(misc + 215), nclaim);
            __syncthreads();
            it = *(volatile LAS int*)(misc + 215);
        }
        if (!roleB) moe_weights_queue<CVT_NLD_P2>(args, lds, misc + 212, tid, wave, lane, CVT_LIMIT_P2);
    }
    SEAM(2);
    if (IN(3)) {
        const int NG = (G >= 64) ? 32 : 0;
        if (bx < 32 || NG == 0) { for (int it = bx; it < 32; it += G) gdn::scan(args, lds, it, tid, lane, wave); }
        if (bx >= NG) { for (int u = bx - NG; u < 512; u += G - NG) sba::unit(args, lds, (volatile LAS int*)(misc + 210), u >> 7, (u >> 4) & 7, u & 15, tid, lane, wave); }
        moe_weights_queue(args, lds, misc + 212, tid, wave, lane, MOE_ITEMS);
    }
    SEAM(3);
    if (IN(4)) {
        pg8::PlainOrder S; S.init(NREAL, DM, DM, args.ws + WS_WOUT, G, bx);
        pg8::EpiResF32 E{args.in[I_X], args.out, DM};
        pg8::gemm_phase<pg8::EpiResF32, pg8::PlainOrder, true, true>(lds, (const char*)(args.ws + WS_MIX), DM * 2, S, E);
    }
    SEAM(4);
    if (IN(5)) p5_router(args, lds, G, bx, tid, lane, wave);
    SEAM(5);
    if (IN(6)) {
        {
        const int mt = moe_setup(args, misc, tid);
        pg8::MoeOrder<true> S; S.tpre = misc; S.tok = (const LAS int*)(lds + TOK_OFF); S.nN = 16; S.nwg = mt * 16; S.G = G; S.c = bx;
        S.Bt = (const char*)(args.ws + WS_WGU); S.estride = (size_t)2 * DE * DM; S.K2 = DM;
        const int* LIST = (const int*)(args.ws + WS_LIST);
        S.ud = misc + 140; S.fill_units(misc + 140, tid);
        __syncthreads();
        for (int idx = tid; idx < TOK_CAP * 256; idx += NTHREADS) { pg8::Unit u; if (!S.next(idx >> 8, u)) break;
            const int r = (u.pm - misc[u.e]) * 256 + (idx & 255); ((LAS int*)(lds + TOK_OFF))[idx] = r < misc[104 + u.e] ? LIST[(size_t)u.e * NREAL + r] : 0; }
        __syncthreads();
        pg8::EpiSwiGLU E{args.ws + WS_ACT, args.in[I_BGU]};
        pg8::gemm_phase<pg8::EpiSwiGLU, pg8::MoeOrder<true>, true, true, true>(lds, (const char*)(args.ws + WS_HN), DM, S, E);
        }
    }
    SEAM(6);
    if (IN(7)) {
        const int mt = moe_setup(args, misc, tid);
        pg8::MoeOrder<false> S; S.tpre = misc; S.tok = nullptr; S.nN = 8; S.nwg = mt * 8; S.G = G; S.c = bx;
        S.Bt = (const char*)(args.ws + WS_WD); S.estride = (size_t)DM * DE; S.K2 = DE;
        S.ud = misc + 140; S.fill_units(misc + 140, tid);
        __syncthreads();
        pg8::EpiBf16 E{(bf16_t*)(args.ws + WS_Y), DM, 0, args.in[I_BD]};
        pg8::gemm_phase<pg8::EpiBf16, pg8::MoeOrder<false>, true, true, true>(lds, (const char*)(args.ws + WS_ACT), DE, S, E);
    }
    SEAM(7);
    if (IN(8)) { (void)moe_setup(args, misc, tid); p8_combine(args, misc, gw, NGW, lane); }
#undef IN
#undef SEAM
}

extern "C" void kernel_launch(void* const* d_in, const int* in_sizes, int n_in, void* d_out, int out_size, void* d_ws, size_t ws_size, hipStream_t stream) {
    static int grid = 0;
    if (grid == 0) {
        if (n_in != 19 || out_size != NREAL * DM || ws_size < WS_END) { fprintf(stderr, "kernel_launch: unexpected shapes (n_in %d out %d ws %zu need %zu)\n", n_in, out_size, ws_size, (size_t)WS_END); grid = -1; return; }
        int dev = 0, cus = 0, per_cu = 0;
        if (hipGetDevice(&dev) != hipSuccess || hipDeviceGetAttribute(&cus, hipDeviceAttributeMultiprocessorCount, dev) != hipSuccess) { grid = -1; return; }
        if (hipFuncSetAttribute((const void*)hymba_fwd, hipFuncAttributeMaxDynamicSharedMemorySize, LDS_BYTES) != hipSuccess) { fprintf(stderr, "kernel_launch: hipFuncSetAttribute failed\n"); grid = -1; return; }
        if (hipOccupancyMaxActiveBlocksPerMultiprocessor(&per_cu, (const void*)hymba_fwd, NTHREADS, LDS_BYTES) != hipSuccess || per_cu < 1) { fprintf(stderr, "kernel_launch: occupancy query says %d\n", per_cu); grid = -1; return; }
        (void)hipGetLastError();
        grid = cus;
    }
    if (grid < 0) return;
    (void)hipMemsetAsync((char*)d_ws + WS_CTL, 0, CTL_ZERO_BYTES, stream);
    Args a{};
    for (int i = 0; i < 19; ++i) a.in[i] = (const float*)d_in[i];
    a.out = (float*)d_out; a.ws = (unsigned char*)d_ws;
#if MK_N_LAUNCHES == 1
    a.ph_lo = 0; a.ph_hi = NPH;
    hipLaunchKernelGGL(hymba_fwd, dim3(grid), dim3(NTHREADS), LDS_BYTES, stream, a);
#else
    for (int p = 0; p < NPH; ++p) { a.ph_lo = p; a.ph_hi = p + 1; hipLaunchKernelGGL(hymba_fwd, dim3(grid), dim3(NTHREADS), LDS_BYTES, stream, a); }
#endif
    const hipError_t le = hipPeekAtLastError();
    if (le != hipSuccess) fprintf(stderr, "kernel_launch: launch failed: %s\n", hipGetErrorName(le));
}
```

```cpp
#include <hip/hip_runtime.h>
#include <cstdio>
#include <cstdint>

#ifndef MK_N_LAUNCHES
#define MK_N_LAUNCHES 1
#endif

constexpr int NB = 4, SEQ = 4096, NMETA = 16, LSEQ = SEQ + NMETA;
constexpr int DM = 2048, NTOK = NB * LSEQ  , MPAD = 16640  , NREAL = NB * SEQ  ;
constexpr int NPROJ_SRC = 7184, NPROJ = 7168;
constexpr int NHEAD = 8, HD = 128;
constexpr int PC_QKV = 0, PC_Z = 3072, PC_SBQ = 4096, PC_SBK = 5120, PC_SBV = 6144;
constexpr int NEXP = 32, TOPK = 4, DE = 2048;
constexpr int SLOT_ROWS = 73728;
constexpr int LROW = 4224;
constexpr float NORM_EPS = 1e-6f;

constexpr size_t MiB = 1u << 20;
constexpr size_t WS_CTL = 0, CTL_ZERO_BYTES = 1 * MiB;
constexpr size_t WS_WIN = 1 * MiB;
constexpr size_t WS_WOUT = WS_WIN + (size_t)NPROJ * DM * 2;
constexpr size_t WS_WGU = WS_WOUT + (size_t)DM * DM * 2;
constexpr size_t WS_WD = WS_WGU + (size_t)NEXP * 2 * DE * DM * 2;
constexpr size_t WS_HN = WS_WD + (size_t)NEXP * DM * DE * 2;
constexpr size_t WS_BETA = WS_HN + (size_t)MPAD * DM * 2;
constexpr size_t WS_G = WS_BETA + (size_t)NTOK * 8 * 4 + 256;
constexpr size_t WS_P = WS_G + (size_t)NTOK * 8 * 4 + 256;
constexpr size_t WS_QN = WS_P + (size_t)MPAD * NPROJ * 2;
constexpr size_t WS_KN = WS_QN + (size_t)NB * NHEAD * LROW * HD * 2;
constexpr size_t WS_ORAW = WS_KN + (size_t)NB * NHEAD * LROW * HD * 2;
constexpr size_t WS_MIX = WS_ORAW + (size_t)NREAL * 1024 * 4;
constexpr size_t WS_RE = WS_MIX + (size_t)NREAL * DM * 2;
constexpr size_t WS_RP = WS_RE + (size_t)NREAL * 4 * 4;
constexpr size_t WS_RG = WS_RP + (size_t)NREAL * 4 * 4;
constexpr size_t WS_LIST = WS_RG + (size_t)NREAL * 4 * 4;
constexpr size_t WS_ACT = WS_LIST + (size_t)NEXP * NREAL * 4;
constexpr size_t WS_Y = WS_ACT + (size_t)SLOT_ROWS * DE * 2;
constexpr size_t WS_GCH = WS_Y + (size_t)SLOT_ROWS * DM * 2;
constexpr size_t WS_GL = WS_GCH + (size_t)32 * 65 * 73728;
constexpr size_t WS_END = WS_GL + 32 * 65 * 4 + 256;
constexpr int CW_ECNT = 64;
constexpr int CW_CVTQ = 192;
constexpr int CVT_NLD_P2 = 4;
constexpr int CW_PREQ = 256;
constexpr int CW_BAR = 4096;

constexpr int LDS_STAGE = 131072;
constexpr int TOK_OFF = LDS_STAGE, TOK_CAP = 22;
constexpr int MISC_OFF = TOK_OFF + TOK_CAP * 256 * 4;
constexpr int LDS_BYTES = MISC_OFF + 1024;

#define GAS __attribute__((address_space(1)))
#define LAS __attribute__((address_space(3)))
typedef unsigned short bf16_t;
typedef short bf16x8 __attribute__((ext_vector_type(8)));
typedef short s16x4 __attribute__((ext_vector_type(4)));
typedef float f32x4 __attribute__((ext_vector_type(4)));
typedef float f32x2 __attribute__((ext_vector_type(2)));
typedef float f32x16 __attribute__((ext_vector_type(16)));
typedef unsigned u32x4 __attribute__((ext_vector_type(4)));
typedef unsigned u32x2 __attribute__((ext_vector_type(2)));

typedef __bf16 bf16x2_t __attribute__((ext_vector_type(2)));
__device__ __forceinline__ unsigned cvt_pk_bf16(float lo, float hi) { const f32x2 v = {lo, hi}; const bf16x2_t b = __builtin_convertvector(v, bf16x2_t); return __builtin_bit_cast(unsigned, b); }
__device__ __forceinline__ unsigned pk4_fp8(float a, float b, float c, float d) { unsigned w = 0u; w = __builtin_amdgcn_cvt_pk_fp8_f32(a, b, w, false); w = __builtin_amdgcn_cvt_pk_fp8_f32(c, d, w, true); return w; }
__device__ __forceinline__ float bf_lo(unsigned w) { return __uint_as_float(w << 16); }
__device__ __forceinline__ float bf_hi(unsigned w) { return __uint_as_float(w & 0xffff0000u); }
__device__ __forceinline__ float bf2f(bf16_t b) { return __uint_as_float(((unsigned)b) << 16); }
template <int CTRL, int ROW_MASK> __device__ __forceinline__ float dpp_get(float v) {
    return __builtin_bit_cast(float, __builtin_amdgcn_update_dpp(0, __builtin_bit_cast(int, v), CTRL, ROW_MASK, 0xF, false));
}
__device__ __forceinline__ float row16_sum(float v) {
    v += dpp_get<0xB1, 0xF>(v);
    v += dpp_get<0x4E, 0xF>(v);
    v += dpp_get<0x141, 0xF>(v);
    v += dpp_get<0x140, 0xF>(v);
    return v;
}
__device__ __forceinline__ float quad_sum(float v) { v += dpp_get<0xB1, 0xF>(v); v += dpp_get<0x4E, 0xF>(v); return v; }
__device__ __forceinline__ float wave_sum(float v) {
    v = row16_sum(v);
    v += dpp_get<0x142, 0xA>(v);
    v += dpp_get<0x143, 0xC>(v);
    return __builtin_bit_cast(float, __builtin_amdgcn_readlane(__builtin_bit_cast(int, v), 63));
}

namespace pg8 {
constexpr int BM = 256, BK = 64, HALF = 128, HTB = HALF * BK * 2, STAGE_BYTES = 8 * HTB, NXCD = 8, WGM = 8;
__host__ __device__ __forceinline__ int lds_byte(int r, int c) { const int st = (r >> 4) * 2 + (c >> 5), rr = r & 15, cc = c & 31, ob = rr * 64 + cc * 2; return st * 1024 + (ob ^ (((ob >> 9) & 1) << 5)); }
__host__ __device__ __forceinline__ void stage_rc(int b, int& R, int& C) { const int st = b / 1024, sb = b % 1024, swz = sb ^ (((sb >> 9) & 1) << 5); R = (st >> 1) * 16 + swz / 64; C = (st & 1) * 32 + (swz % 64) / 2; }
__host__ __device__ __forceinline__ int perm32(int rho) { const int n = rho >> 4, i = rho & 15; return 8 * (i >> 2) + 4 * n + (i & 3); }

typedef int v8i __attribute__((ext_vector_type(8))); typedef int v4i __attribute__((ext_vector_type(4)));
__device__ __forceinline__ v8i cat8(bf16x8 lo, bf16x8 hi) { const v4i a = __builtin_bit_cast(v4i, lo), b = __builtin_bit_cast(v4i, hi); return __builtin_shufflevector(a, b, 0, 1, 2, 3, 4, 5, 6, 7); }
struct Unit { int pm, pn, e, ui; };

__device__ __forceinline__ int xcd_remap(int L, int nwg) { const int q = nwg / NXCD, r = nwg % NXCD, xcd = L % NXCD, off = L / NXCD; return (xcd < r ? xcd * (q + 1) : r * (q + 1) + (xcd - r) * q) + off; }

struct PlainOrder {
    int nM, nN, nwg, G, c; const char* Bt; unsigned K2;
    __device__ void init(int M, int N, int K, const void* Bt_, int G_, int c_) { nM = M / BM; nN = N / BM; nwg = nM * nN; G = G_; c = c_; Bt = (const char*)Bt_; K2 = (unsigned)K * 2u; }
    __device__ __forceinline__ bool next(int i, Unit& u) const {
        const long L = (long)i * G + c; if (L >= nwg) return false;
        const int wgid = xcd_remap((int)L, nwg);
        const int nig = WGM * nN, gid = wgid / nig, fm = gid * WGM, gsz = (nM - fm) < WGM ? (nM - fm) : WGM;
        u.pm = fm + ((wgid % nig) % gsz); u.pn = (wgid % nig) / gsz; u.e = 0; u.ui = i; return true;
    }
    __device__ __forceinline__ const char* b_ptr(const Unit& u) const { return Bt + (size_t)u.pn * BM * K2; }
    __device__ __forceinline__ unsigned a_off(const Unit& u, int r) const { return (unsigned)(u.pm * BM + r + (meta ? NMETA * ((u.pm >> 4) + 1) : 0)) * K2; }
    int meta = 0;
};
constexpr int UD_CAP = 24;
template <bool GATHER> struct MoeOrder {
    const LAS int* tpre; const LAS int* tok; const LAS int* ud; int nN, nwg, G, c; const char* Bt; size_t estride; unsigned K2;
    __device__ __forceinline__ int decode(int i) const {
        const long L = (long)i * G + c; if (L >= nwg) return -1;
        const int wgid = xcd_remap((int)L, nwg);
        int e = 0;
#pragma unroll 1
        for (int j = 1; j < NEXP; ++j) e = (wgid >= tpre[j] * nN) ? j : e;
        const int t0 = tpre[e], nt = tpre[e + 1] - t0, loc = wgid - t0 * nN;
        return e | ((t0 + loc % nt) << 6) | ((loc / nt) << 16);
    }
    __device__ __forceinline__ void fill_units(LAS int* udw, int tid) const { if (tid < UD_CAP) udw[tid] = decode(tid); }
    __device__ __forceinline__ bool next(int i, Unit& u) const {
        if (i >= UD_CAP) return false;
        const int d = ud[i]; if (d < 0) return false;
        u.e = d & 63; u.pm = (d >> 6) & 1023; u.pn = d >> 16; u.ui = i; return true;
    }
    __device__ __forceinline__ const char* b_ptr(const Unit& u) const { return Bt + (size_t)u.e * estride + (size_t)u.pn * BM * K2; }
    __device__ __forceinline__ unsigned a_off(const Unit& u, int r) const {
        if (GATHER) return (unsigned)tok[u.ui * 256 + r] * K2;
        return (unsigned)(u.pm * BM + r) * K2;
    }
};

struct EpiBf16 {
    static constexpr bool PERM = true;
    bf16_t* O; int ldc; int meta; const float* ebias = nullptr;
    __device__ __forceinline__ void operator()(const f32x4 (&acc)[2][2][4][2], const Unit& u, int wr, int wc, int fr, int fq) const {
        const int row0 = u.pm * BM + wr * 64 + fr + (meta ? NMETA * ((u.pm >> 4) + 1) : 0), col0 = u.pn * BM + wc * 32 + 8 * fq;
        f32x4 bv[2][2];
#pragma unroll
        for (int bj = 0; bj < 2; ++bj)
#pragma unroll
            for (int n = 0; n < 2; ++n) bv[bj][n] = ebias ? *(const f32x4*)(ebias + (size_t)u.e * ldc + col0 + bj * HALF + 4 * n) : (f32x4){0.f, 0.f, 0.f, 0.f};
#pragma unroll
        for (int ai = 0; ai < 2; ++ai)
#pragma unroll
            for (int m = 0; m < 4; ++m) { bf16_t* rowp = O + (size_t)(row0 + ai * HALF + m * 16) * ldc + col0;
#pragma unroll
                for (int bj = 0; bj < 2; ++bj) { const f32x4 v0 = acc[ai][bj][m][0] + bv[bj][0], v1 = acc[ai][bj][m][1] + bv[bj][1];
                    u32x4 w; w.x = cvt_pk_bf16(v0[0], v0[1]); w.y = cvt_pk_bf16(v0[2], v0[3]); w.z = cvt_pk_bf16(v1[0], v1[1]); w.w = cvt_pk_bf16(v1[2], v1[3]);
                    *(u32x4*)(rowp + bj * HALF) = w; } }
    }
};
struct EpiResF32 {
    static constexpr bool PERM = false;
    const float* X; float* out; int ldc;
    __device__ __forceinline__ void operator()(const f32x4 (&acc)[2][2][4][2], const Unit& u, int wr, int wc, int fr, int fq) const {
        const int row0 = u.pm * BM + wr * 64 + fr, col0 = u.pn * BM + wc * 32 + 4 * fq;
#pragma unroll
        for (int ai = 0; ai < 2; ++ai) {
            f32x4 xv[4][2][2];
#pragma unroll
            for (int m = 0; m < 4; ++m) { const size_t off = (size_t)(row0 + ai * HALF + m * 16) * ldc + col0;
#pragma unroll
                for (int bj = 0; bj < 2; ++bj)
#pragma unroll
                    for (int n = 0; n < 2; ++n) xv[m][bj][n] = *(const f32x4*)(X + off + bj * HALF + n * 16); }
#pragma unroll
            for (int m = 0; m < 4; ++m) { const size_t off = (size_t)(row0 + ai * HALF + m * 16) * ldc + col0;
#pragma unroll
                for (int bj = 0; bj < 2; ++bj)
#pragma unroll
                    for (int n = 0; n < 2; ++n) *(f32x4*)(out + off + bj * HALF + n * 16) = xv[m][bj][n] + acc[ai][bj][m][n]; }
            asm volatile("" ::: "memory"); }
    }
};
__device__ __forceinline__ float swiglu1(float g, float uu) {
    g = fminf(g, 7.0f); uu = fminf(fmaxf(uu, -7.0f), 7.0f);
    const float sg = __builtin_amdgcn_rcpf(1.0f + __builtin_amdgcn_exp2f(-1.702f * 1.4426950408889634f * g));
    return (uu + 1.0f) * g * sg;
}
struct EpiSwiGLU {
    static constexpr bool PERM = true;
    unsigned char* act; const float* bgu;
    __device__ __forceinline__ void operator()(const f32x4 (&acc)[2][2][4][2], const Unit& u, int wr, int wc, int fr, int fq) const {
        const int row0 = u.pm * BM + wr * 64 + fr, col0 = u.pn * HALF + wc * 32 + 8 * fq;
        const float* bg = bgu + (size_t)u.e * 4096 + col0;
        const f32x4 bg0 = *(const f32x4*)(bg), bg1 = *(const f32x4*)(bg + 4), bu0 = *(const f32x4*)(bg + 2048), bu1 = *(const f32x4*)(bg + 2052);
#pragma unroll
        for (int ai = 0; ai < 2; ++ai)
#pragma unroll
            for (int m = 0; m < 4; ++m) { unsigned char* rowp = act + (size_t)(row0 + ai * HALF + m * 16) * DE + col0;
                const f32x4 g0 = acc[ai][0][m][0] + bg0, g1 = acc[ai][0][m][1] + bg1, u0 = acc[ai][1][m][0] + bu0, u1 = acc[ai][1][m][1] + bu1;
                u32x2 w; w.x = pk4_fp8(swiglu1(g0[0], u0[0]), swiglu1(g0[1], u0[1]), swiglu1(g0[2], u0[2]), swiglu1(g0[3], u0[3]));
                w.y = pk4_fp8(swiglu1(g1[0], u1[0]), swiglu1(g1[1], u1[1]), swiglu1(g1[2], u1[2]), swiglu1(g1[3], u1[3]));
                *(u32x2*)rowp = w; }
    }
};

template <class Epi, class Sched, bool ALIGN_EPI, bool SP2, bool FP8 = false>
__device__ __forceinline__ void gemm_phase(LAS unsigned char* lds, const char* A0, int Kb, const Sched& S, const Epi& E) {
    const int tid = threadIdx.x, wid = __builtin_amdgcn_readfirstlane(tid >> 6), lane = tid & 63, wr = wid >> 2, wc = wid & 3, fr = lane & 15, fq = lane >> 4;
    const int nt = Kb / 128;
    int Rr[2], Cc[2]; unsigned voffB[2];
#pragma unroll
    for (int i = 0; i < 2; ++i) { int R, C; stage_rc(tid * 16 + i * 8192, R, C); const int Rb = Epi::PERM ? ((R & ~31) + perm32(R & 31)) : R;
        Rr[i] = R; Cc[i] = C * 2; voffB[i] = (unsigned)(Rb * Kb + C * 2); }
    const size_t kstep = (size_t)(BK * 2);
    const size_t hstep = (size_t)HALF * Kb;
    const unsigned ldsw = (unsigned)wid * 1024u;
    const int aoff = lds_byte(wr * 64 + fr, fq * 8), boff = lds_byte(wc * 32 + fr, fq * 8);
#define PG8_SA(b, h) (((b) * 2 + (h)) * HTB)
#define PG8_SB(b, h) ((4 + (b) * 2 + (h)) * HTB)
#define PG8_STAGE(bufoff, gbase, voff) do { _Pragma("unroll") for (int _i = 0; _i < 2; ++_i) \
        __builtin_amdgcn_global_load_lds((const unsigned*)((const char*)(gbase) + (voff)[_i]), (LAS unsigned*)(lds + (bufoff) + ldsw + _i * 8192), 16, 0, 0); } while (0)
#define PG8_LDA(dst, b, h) do { _Pragma("unroll") for (int m = 0; m < 4; ++m) _Pragma("unroll") for (int k = 0; k < 2; ++k) dst[m][k] = *(const LAS bf16x8*)(lds + PG8_SA(b, h) + aoff + m * 2048 + k * 1024); } while (0)
#define PG8_LDB(dst, b, h) do { _Pragma("unroll") for (int n = 0; n < 2; ++n) _Pragma("unroll") for (int k = 0; k < 2; ++k) dst[n][k] = *(const LAS bf16x8*)(lds + PG8_SB(b, h) + boff + n * 2048 + k * 1024); } while (0)
#define PG8_MMA(ai, bj, At, Bt) do { __builtin_amdgcn_s_setprio(1); _Pragma("unroll") for (int m = 0; m < 4; ++m) _Pragma("unroll") for (int n = 0; n < 2; ++n) { \
        if constexpr (FP8) acc[ai][bj][m][n] = __builtin_amdgcn_mfma_scale_f32_16x16x128_f8f6f4(cat8(Bt[n][0], Bt[n][1]), cat8(At[m][0], At[m][1]), acc[ai][bj][m][n], 0, 0, 0, 0x79797979, 0, 0x7f7f7f7f); \
        else { _Pragma("unroll") for (int k = 0; k < 2; ++k) acc[ai][bj][m][n] = __builtin_amdgcn_mfma_f32_16x16x32_bf16(Bt[n][k], At[m][k], acc[ai][bj][m][n], 0, 0, 0); } } \
        __builtin_amdgcn_s_setprio(0); } while (0)
#define PG8_WAIT_V(n) asm volatile("s_waitcnt vmcnt(" #n ")" ::: "memory")
#define PG8_WAIT_L(n) asm volatile("s_waitcnt lgkmcnt(" #n ")" ::: "memory")
#define PG8_BAR __builtin_amdgcn_s_barrier()
#define PG8_SCHED __builtin_amdgcn_sched_barrier(0)
#define PG8_VOFF(dst, u) do { _Pragma("unroll") for (int _h = 0; _h < 2; ++_h) _Pragma("unroll") for (int _i = 0; _i < 2; ++_i) dst[_h][_i] = S.a_off(u, _h * HALF + Rr[_i]) + (unsigned)Cc[_i]; } while (0)
    Unit cur, nxt; int ui = 0;
    if (!S.next(0, cur)) return;
    f32x4 acc[2][2][4][2];
#pragma unroll
    for (int a = 0; a < 2; ++a)
#pragma unroll
        for (int b = 0; b < 2; ++b)
#pragma unroll
            for (int m = 0; m < 4; ++m)
#pragma unroll
                for (int n = 0; n < 2; ++n) acc[a][b][m][n] = (f32x4){0.f, 0.f, 0.f, 0.f};
    bf16x8 At[4][2], B0[2][2], B1[2][2];
    unsigned va[2][2], vn[2][2];
    PG8_VOFF(va, cur);
    const char* cB = S.b_ptr(cur);
    if constexpr (SP2) {
        PG8_STAGE(PG8_SB(0, 0), cB, voffB); PG8_STAGE(PG8_SB(0, 1), cB + hstep, voffB); PG8_STAGE(PG8_SA(0, 0), A0, va[0]); PG8_STAGE(PG8_SA(0, 1), A0, va[1]);
        if (wr == 1) PG8_BAR;
        PG8_WAIT_V(2); PG8_BAR;
        PG8_STAGE(PG8_SB(1, 0), cB + kstep, voffB); PG8_STAGE(PG8_SA(1, 0), A0 + kstep, va[0]); PG8_STAGE(PG8_SB(1, 1), cB + hstep + kstep, voffB);
        PG8_WAIT_V(6); PG8_BAR;
    } else {
        PG8_STAGE(PG8_SB(0, 0), cB, voffB); PG8_STAGE(PG8_SA(0, 0), A0, va[0]); PG8_STAGE(PG8_SB(0, 1), cB + hstep, voffB); PG8_STAGE(PG8_SA(0, 1), A0, va[1]);
        if (wr == 1) PG8_BAR;
        PG8_WAIT_V(4); PG8_BAR;
        PG8_STAGE(PG8_SB(1, 0), cB + kstep, voffB); PG8_STAGE(PG8_SA(1, 0), A0 + kstep, va[0]); PG8_STAGE(PG8_SB(1, 1), cB + hstep + kstep, voffB);
        PG8_WAIT_V(6); PG8_BAR;
    }
    for (;;) {
        const bool has_next = S.next(ui + 1, nxt);
        const char* nB = has_next ? S.b_ptr(nxt) : cB;
        for (int t = 0; t < nt; t += 2) {
            const bool last = (t == nt - 2);
            const char* a1 = A0 + (size_t)(t + 1) * kstep;
            const char* a2 = last ? A0 : A0 + (size_t)(t + 2) * kstep; const char* b2 = last ? nB : cB + (size_t)(t + 2) * kstep;
            const char* a3 = a2 + kstep; const char* b3 = b2 + kstep;
            if (last) { if (has_next) { PG8_VOFF(vn, nxt); } else {
#pragma unroll
                    for (int _h = 0; _h < 2; ++_h)
#pragma unroll
                        for (int _i = 0; _i < 2; ++_i) vn[_h][_i] = va[_h][_i]; } }
            if constexpr (SP2) {
            PG8_LDB(B0, 0, 0); PG8_LDB(B1, 0, 1); PG8_SCHED; PG8_LDA(At, 0, 0); PG8_STAGE(PG8_SA(1, 1), a1, va[1]);
            if (last) {
#pragma unroll
                for (int _h = 0; _h < 2; ++_h)
#pragma unroll
                    for (int _i = 0; _i < 2; ++_i) va[_h][_i] = vn[_h][_i]; }
            PG8_WAIT_V(8); PG8_WAIT_L(0); PG8_BAR; PG8_MMA(0, 0, At, B0); PG8_MMA(0, 1, At, B1); PG8_BAR; PG8_SCHED;
            PG8_LDA(At, 0, 1); PG8_STAGE(PG8_SB(0, 0), b2, voffB); PG8_STAGE(PG8_SB(0, 1), b2 + hstep, voffB); PG8_STAGE(PG8_SA(0, 0), a2, va[0]);
            PG8_WAIT_V(8); PG8_WAIT_L(0); PG8_BAR; PG8_MMA(1, 0, At, B0); PG8_MMA(1, 1, At, B1); PG8_BAR; PG8_SCHED;
            PG8_LDB(B0, 1, 0); PG8_LDB(B1, 1, 1); PG8_SCHED; PG8_LDA(At, 1, 0); PG8_STAGE(PG8_SA(0, 1), a2, va[1]);
            PG8_WAIT_V(8); PG8_WAIT_L(0); PG8_BAR; PG8_MMA(0, 0, At, B0); PG8_MMA(0, 1, At, B1); PG8_BAR; PG8_SCHED;
            PG8_LDA(At, 1, 1); PG8_STAGE(PG8_SB(1, 0), b3, voffB); PG8_STAGE(PG8_SB(1, 1), b3 + hstep, voffB); PG8_STAGE(PG8_SA(1, 0), a3, va[0]);
            PG8_WAIT_V(8); PG8_WAIT_L(0); PG8_BAR; PG8_MMA(1, 0, At, B0); PG8_MMA(1, 1, At, B1); PG8_BAR; PG8_SCHED;
            } else {
            PG8_LDB(B0, 0, 0); PG8_SCHED; PG8_LDA(At, 0, 0); PG8_STAGE(PG8_SA(1, 1), a1, va[1]);
            if (last) {
#pragma unroll
                for (int _h = 0; _h < 2; ++_h)
#pragma unroll
                    for (int _i = 0; _i < 2; ++_i) va[_h][_i] = vn[_h][_i]; }
            PG8_WAIT_L(8); PG8_BAR; PG8_WAIT_L(0); PG8_MMA(0, 0, At, B0); PG8_BAR; PG8_SCHED;
            PG8_LDB(B1, 0, 1); PG8_STAGE(PG8_SB(0, 0), b2, voffB);
            PG8_BAR; PG8_WAIT_L(0); PG8_MMA(0, 1, At, B1); PG8_BAR;
            PG8_LDA(At, 0, 1); PG8_STAGE(PG8_SA(0, 0), a2, va[0]);
            PG8_BAR; PG8_WAIT_L(0); PG8_MMA(1, 0, At, B0); PG8_BAR; PG8_SCHED;
            PG8_STAGE(PG8_SB(0, 1), b2 + hstep, voffB);
            PG8_WAIT_V(6); PG8_BAR; PG8_MMA(1, 1, At, B1); PG8_BAR;
            PG8_LDB(B0, 1, 0); PG8_SCHED; PG8_LDA(At, 1, 0); PG8_STAGE(PG8_SA(0, 1), a2, va[1]);
            PG8_WAIT_L(8); PG8_BAR; PG8_WAIT_L(0); PG8_MMA(0, 0, At, B0); PG8_BAR; PG8_SCHED;
            PG8_LDB(B1, 1, 1); PG8_STAGE(PG8_SB(1, 0), b3, voffB);
            PG8_BAR; PG8_WAIT_L(0); PG8_MMA(0, 1, At, B1); PG8_BAR;
            PG8_LDA(At, 1, 1); PG8_STAGE(PG8_SA(1, 0), a3, va[0]);
            PG8_BAR; PG8_WAIT_L(0); PG8_MMA(1, 0, At, B0); PG8_BAR; PG8_SCHED;
            PG8_STAGE(PG8_SB(1, 1), b3 + hstep, voffB);
            PG8_WAIT_V(6); PG8_BAR; PG8_MMA(1, 1, At, B1); PG8_BAR;
            }
        }
        if constexpr (ALIGN_EPI) { if (wr == 0) PG8_BAR; }
        E(acc, cur, wr, wc, fr, fq);
        if (!has_next) break;
#pragma unroll
        for (int a = 0; a < 2; ++a)
#pragma unroll
            for (int b = 0; b < 2; ++b)
#pragma unroll
                for (int m = 0; m < 4; ++m)
#pragma unroll
                    for (int n = 0; n < 2; ++n) acc[a][b][m][n] = (f32x4){0.f, 0.f, 0.f, 0.f};
        cur = nxt; cB = nB; ++ui;
        if constexpr (ALIGN_EPI) { if (wr == 1) PG8_BAR; }
    }
    PG8_WAIT_V(0);
    if constexpr (!ALIGN_EPI) { if (wr == 0) PG8_BAR; }
    PG8_BAR;
#undef PG8_SA
#undef PG8_SB
#undef PG8_STAGE
#undef PG8_LDA
#undef PG8_LDB
#undef PG8_MMA
#undef PG8_WAIT_V
#undef PG8_WAIT_L
#undef PG8_BAR
#undef PG8_SCHED
#undef PG8_VOFF
}
}

#define XB_TMO      128
#define XB_XCNT(j)  (256  + 64 * (j))
#define XB_XSUB(j)  (1280 + 64 * (j))
#define XB_XGEN(j)  (2304 + 64 * (j))
#define XB_TOP      3328
#define XB_TOPGEN   3392
#define XCD_BAR_WORDS 3456
#define XB_SPIN_CAP (1u << 18)

__device__ __forceinline__ unsigned xb_ld(unsigned* p)              { return __hip_atomic_load(p, __ATOMIC_RELAXED, __HIP_MEMORY_SCOPE_AGENT); }
__device__ __forceinline__ unsigned xb_add(unsigned* p, unsigned v) { return __hip_atomic_fetch_add(p, v, __ATOMIC_RELAXED, __HIP_MEMORY_SCOPE_AGENT); }
__device__ __forceinline__ unsigned xb_xcc_id() { return (unsigned)__builtin_amdgcn_s_getreg((3 << 11) | 20) & 0xFu; }
#define XB_SPIN(cond, bar) do { unsigned _sp = 0; while (cond) { __builtin_amdgcn_s_sleep(1); \
    if ((++_sp & 255u) == 0u) { if (xb_ld(&(bar)[XB_TMO])) break; if (_sp > XB_SPIN_CAP) { atomicAdd(&(bar)[XB_TMO], 1u); break; } } } } while (0)

struct XcdBarrier {
    unsigned* bar; unsigned x;
    volatile LAS unsigned* st;
};
__device__ __forceinline__ XcdBarrier xcd_barrier_post(unsigned* bar, volatile LAS unsigned* st) {
    XcdBarrier b; b.bar = bar; b.x = xb_xcc_id(); b.st = st;
    if (threadIdx.x == 0) (void)xb_add(&bar[XB_XCNT(b.x)], 1u);
    return b;
}
__device__ __forceinline__ void xcd_barrier_complete(unsigned* bar, unsigned x, unsigned& nloc, unsigned& nx) {
    const unsigned G = gridDim.x * gridDim.y * gridDim.z;
    unsigned sum, cnt, mine, sp = 0u;
    for (;;) {
        sum = 0u; cnt = 0u; mine = 0u;
#pragma unroll
        for (unsigned j = 0; j < 16; ++j) { const unsigned c = xb_ld(&bar[XB_XCNT(j)]); sum += c; cnt += (c > 0u) ? 1u : 0u; mine = (j == x) ? c : mine; }
        if (sum == G) break;
        __builtin_amdgcn_s_sleep(1);
        if ((++sp & 255u) == 0u) { if (xb_ld(&bar[XB_TMO])) break; if (sp > XB_SPIN_CAP) { atomicAdd(&bar[XB_TMO], 1u); break; } }
    }
    nloc = mine > 0u ? mine : 1u; nx = cnt > 0u ? cnt : 1u;
}
__device__ __forceinline__ void xcd_barrier(const XcdBarrier& b) {
    asm volatile("s_waitcnt vmcnt(0)" ::: "memory");
    __syncthreads();
    if (threadIdx.x == 0) {
        unsigned* bar = b.bar;
        __builtin_amdgcn_s_waitcnt(0);
        unsigned nloc = b.st[0], nx = b.st[1];
        if (nloc == 0u) { xcd_barrier_complete(bar, b.x, nloc, nx); b.st[0] = nloc; b.st[1] = nx; }
        const unsigned old = xb_add(&bar[XB_XSUB(b.x)], 1u);
        const unsigned gen = old / nloc;
        if (old + 1u == (gen + 1u) * nloc) {
            __builtin_amdgcn_fence(__ATOMIC_RELEASE, "agent");
            asm volatile("s_waitcnt vmcnt(0)" ::: "memory");
            const unsigned og = xb_add(&bar[XB_TOP], 1u);
            const unsigned tg = og / nx;
            if (og + 1u == (tg + 1u) * nx) xb_add(&bar[XB_TOPGEN], 1u);
            else XB_SPIN(xb_ld(&bar[XB_TOPGEN]) == tg, bar);
            __builtin_amdgcn_fence(__ATOMIC_ACQUIRE, "agent");
            xb_add(&bar[XB_XGEN(b.x)], 1u);
            asm volatile("s_waitcnt vmcnt(0)" ::: "memory");
        } else {
            XB_SPIN(xb_ld(&bar[XB_XGEN(b.x)]) == gen, bar);
            __builtin_amdgcn_fence(__ATOMIC_ACQUIRE, "agent");
            asm volatile("s_waitcnt vmcnt(0)" ::: "memory");
        }
    }
    __syncthreads();
}

constexpr int NWAVES = 8, NTHREADS = 512;
struct Args { const float* in[19]; float* out; unsigned char* ws; int ph_lo, ph_hi; };
enum { I_X = 0, I_META, I_MIXNW, I_WIN, I_CONVW, I_ALOG, I_DTB, I_GDNNW, I_SBQNW, I_SBKNW, I_SBONW, I_WOUT, I_FFNNW, I_RW, I_RB, I_WGU, I_BGU, I_WD, I_BD };

#define LDS_WAIT() asm volatile("s_waitcnt lgkmcnt(0)" ::: "memory")
#define VM_WAIT() asm volatile("s_waitcnt vmcnt(0)" ::: "memory")
constexpr int WLS = 2052;

__device__ __forceinline__ void dot16(const f32x4 (&v)[8], const LAS float* wl, int lane, float (&s)[16]) {
#pragma unroll
    for (int c = 0; c < 16; ++c) { float a = 0.f;
#pragma unroll
        for (int j = 0; j < 8; ++j) { const f32x4 w = *(const LAS f32x4*)(wl + c * WLS + 4 * lane + 256 * j); a += (v[j].x * w.x + v[j].y * w.y) + (v[j].z * w.z + v[j].w * w.w); }
        s[c] = wave_sum(a); }
}

template <int NR> __device__ __forceinline__ void dot8xN(const f32x4 (&v)[NR][8], const LAS float* wl, int lane, float (&out)[NR][8]) {
#pragma unroll
    for (int c = 0; c < 8; ++c) { float a[NR];
#pragma unroll
        for (int k = 0; k < NR; ++k) a[k] = 0.f;
#pragma unroll
        for (int j = 0; j < 8; ++j) { const f32x4 w = *(const LAS f32x4*)(wl + c * WLS + 4 * lane + 256 * j);
#pragma unroll
            for (int k = 0; k < NR; ++k) a[k] += (v[k][j].x * w.x + v[k][j].y * w.y) + (v[k][j].z * w.z + v[k][j].w * w.w); }
#pragma unroll
        for (int k = 0; k < NR; ++k) out[k][c] = wave_sum(a[k]); }
}
__device__ __forceinline__ void stage_w16(LAS float* wl, const float* base, int ld, int coloff, int tid) {
#pragma unroll 4
    for (int idx = tid; idx < 2048 * 4; idx += NTHREADS) { const int k = idx >> 2, q = idx & 3; const f32x4 v = *(const f32x4*)(base + (size_t)k * ld + coloff + 4 * q);
        wl[(4 * q + 0) * WLS + k] = v.x; wl[(4 * q + 1) * WLS + k] = v.y; wl[(4 * q + 2) * WLS + k] = v.z; wl[(4 * q + 3) * WLS + k] = v.w; }
}

__device__ __forceinline__ void p0_rows(const Args& a, LAS unsigned char* lds, int gw, int NGW, int tid, int lane) {
    const float* x = a.in[I_X]; const float* meta = a.in[I_META]; const float* nw = a.in[I_MIXNW]; const float* win = a.in[I_WIN];
    LAS float* wl = (LAS float*)lds;
    stage_w16(wl, win, NPROJ_SRC, 4096, tid);
    __syncthreads();
    bf16_t* HN = (bf16_t*)(a.ws + WS_HN); float* BETA = (float*)(a.ws + WS_BETA); float* GG = (float*)(a.ws + WS_G);
    f32x4 wn[8];
#pragma unroll
    for (int j = 0; j < 8; ++j) wn[j] = *((const f32x4*)nw + lane + 64 * j);
    const int hh = lane & 7;
    const float alog = a.in[I_ALOG][hh], dtb = a.in[I_DTB][hh];
    constexpr int NR0 = 2;
    for (int row0 = gw; row0 < MPAD; row0 += NR0 * NGW) {
        f32x4 v[NR0][8]; float bv[NR0], av[NR0];
        int lane_o = lane; asm volatile("" : "+v"(lane_o));
#pragma unroll
        for (int k = 0; k < NR0; ++k) { const int row = row0 + k * NGW;
            if (row < NTOK) { const int b = row / LSEQ, t = row - b * LSEQ;
                const float* src = (t < NMETA) ? meta + (size_t)t * DM : x + ((size_t)b * SEQ + (t - NMETA)) * DM;
#pragma unroll
                for (int j = 0; j < 8; ++j) v[k][j] = *((const f32x4*)src + lane + 64 * j);
            } else {
#pragma unroll
                for (int j = 0; j < 8; ++j) v[k][j] = (f32x4){0.f, 0.f, 0.f, 0.f}; } }
#pragma unroll
        for (int k = 0; k < NR0; ++k) { const int row = row0 + k * NGW; float ss = 0.f;
#pragma unroll
            for (int j = 0; j < 8; ++j) ss += (v[k][j].x * v[k][j].x + v[k][j].y * v[k][j].y) + (v[k][j].z * v[k][j].z + v[k][j].w * v[k][j].w);
            const float rstd = 1.0f / sqrtf(wave_sum(ss) * (1.0f / DM) + NORM_EPS);
            if (row < MPAD) { GAS unsigned long long* o8 = (GAS unsigned long long*)(HN + (size_t)row * DM) + lane;
#pragma unroll
                for (int j = 0; j < 8; ++j) { v[k][j] = v[k][j] * rstd * wn[j];
                    o8[64 * j] = (unsigned long long)cvt_pk_bf16(v[k][j].x, v[k][j].y) | ((unsigned long long)cvt_pk_bf16(v[k][j].z, v[k][j].w) << 32); } } }
        { float o8[NR0][8]; dot8xN<NR0>(v, wl, lane_o, o8);
#pragma unroll
            for (int k = 0; k < NR0; ++k) { bv[k] = o8[k][0];
#pragma unroll
                for (int c = 1; c < 8; ++c) bv[k] = (hh == c) ? o8[k][c] : bv[k]; }
            dot8xN<NR0>(v, wl + 8 * WLS, lane_o, o8);
#pragma unroll
            for (int k = 0; k < NR0; ++k) { av[k] = o8[k][0];
#pragma unroll
                for (int c = 1; c < 8; ++c) av[k] = (hh == c) ? o8[k][c] : av[k]; } }
#pragma unroll
        for (int k = 0; k < NR0; ++k) { const int row = row0 + k * NGW;
            if (lane < 8 && row < NTOK) {
                const float beta = 1.0f / (1.0f + expf(-bv[k]));
                const float xa = av[k] + dtb; const float sp = fmaxf(xa, 0.f) + log1pf(expf(-fabsf(xa)));
                BETA[(size_t)row * 8 + hh] = beta; GG[(size_t)row * 8 + hh] = -expf(alog) * sp; } }
    }
    __syncthreads();
}

constexpr int CVT_STR = 132;
template <int MODE  >
__device__ __forceinline__ void cvt_tile(const float* W, int ldw, int K, bf16_t* out, int kb, int nt, LAS unsigned char* T, int lane) {
    const int r0 = nt * 64;
    int c0;
    if (MODE == 0) c0 = r0;
    else if (MODE == 1) c0 = r0 < 4096 ? r0 : r0 + 16;
    else { const int pn = r0 >> 8, rr = r0 & 255; c0 = rr < 128 ? 128 * pn + rr : 2048 + 128 * pn + (rr - 128); }
    const int kq = lane >> 4, nl = lane & 15;
    const float* src = W + (size_t)(kb * 64 + 2 * kq) * ldw + c0 + 4 * nl;
    f32x4 v[8][2];
#pragma unroll
    for (int i = 0; i < 8; ++i)
#pragma unroll
        for (int j = 0; j < 2; ++j) v[i][j] = *(const f32x4*)(src + (size_t)(8 * i + j) * ldw);
    LAS unsigned char* tw = T + (4 * nl) * CVT_STR + 4 * kq;
#pragma unroll
    for (int i = 0; i < 8; ++i)
#pragma unroll
        for (int q = 0; q < 4; ++q) *(LAS unsigned*)(tw + q * CVT_STR + 16 * i) = cvt_pk_bf16(v[i][0][q], v[i][1][q]);
    LDS_WAIT();
    const int rn = lane >> 3, cc = lane & 7;
    const LAS unsigned char* tr = T + rn * CVT_STR + 16 * cc;
    bf16_t* dst = out + (size_t)(r0 + rn) * K + kb * 64 + 8 * cc;
#pragma unroll
    for (int j = 0; j < 8; ++j) { u32x4 w; const LAS unsigned* p = (const LAS unsigned*)(tr + 8 * j * CVT_STR); w.x = p[0]; w.y = p[1]; w.z = p[2]; w.w = p[3];
        *(u32x4*)(dst + (size_t)(8 * j) * K) = w; }
    LDS_WAIT();
}
constexpr float W8_SCALE = 64.0f;
template <int MODE, int NLD = 8>
__device__ __forceinline__ void cvt_tile_fp8(const float* W, int ldw, int K, unsigned char* out, int kb, int nt, LAS unsigned char* T, int lane) {
    const int r0 = nt * 64;
    int c0;
    if (MODE == 0) c0 = r0;
    else { const int pn = r0 >> 8, rr = r0 & 255; c0 = rr < 128 ? 128 * pn + rr : 2048 + 128 * pn + (rr - 128); }
    const int kq = lane >> 4, nl = lane & 15;
    LAS unsigned char* tw = T + (4 * nl) * CVT_STR + 4 * kq;
    const float* src = W + (size_t)(kb * 128 + 4 * kq) * ldw + c0 + 4 * nl;
#pragma unroll
    for (int i0 = 0; i0 < 8; i0 += NLD) {
        f32x4 v[NLD][4];
#pragma unroll
        for (int i = 0; i < NLD; ++i)
#pragma unroll
            for (int j = 0; j < 4; ++j) v[i][j] = *(const f32x4*)(src + (size_t)(16 * (i0 + i) + j) * ldw);
#pragma unroll
        for (int i = 0; i < NLD; ++i)
#pragma unroll
            for (int q = 0; q < 4; ++q) *(LAS unsigned*)(tw + q * CVT_STR + 16 * (i0 + i)) =
                pk4_fp8(v[i][0][q] * W8_SCALE, v[i][1][q] * W8_SCALE, v[i][2][q] * W8_SCALE, v[i][3][q] * W8_SCALE);
    }
    LDS_WAIT();
    const int rn = lane >> 3, cc = lane & 7;
    const LAS unsigned char* tr = T + rn * CVT_STR + 16 * cc;
    unsigned char* dst = out + (size_t)(r0 + rn) * K + kb * 128 + 16 * cc;
#pragma unroll
    for (int j = 0; j < 8; ++j) { u32x4 w; const LAS unsigned* p = (const LAS unsigned*)(tr + 8 * j * CVT_STR); w.x = p[0]; w.y = p[1]; w.z = p[2]; w.w = p[3];
        *(u32x4*)(dst + (size_t)(8 * j) * K) = w; }
    LDS_WAIT();
}
__device__ __forceinline__ void p0_weights(const Args& a, LAS unsigned char* lds, int vcu, int G, int wave, int lane) {
    constexpr int I_IN = 32 * 14, I_OUT = 32 * 4;
    constexpr int NITEMS = I_IN + I_OUT;
    LAS unsigned char* T = lds + wave * (64 * CVT_STR);
    for (int it = vcu; it < NITEMS; it += G) {
        int r = it;
        if (r < I_IN) { cvt_tile<1>(a.in[I_WIN], NPROJ_SRC, DM, (bf16_t*)(a.ws + WS_WIN), r / 14, (r % 14) * 8 + wave, T, lane); continue; } r -= I_IN;
        cvt_tile<0>(a.in[I_WOUT], DM, DM, (bf16_t*)(a.ws + WS_WOUT), r / 4, (r % 4) * 8 + wave, T, lane);
    }
}
constexpr int MOE_I_GU = 8 * 4, MOE_I_D = 4 * 4, MOE_ITEMS = NEXP * (MOE_I_GU + MOE_I_D);
template <int NLD = 8> __device__ __forceinline__ void moe_weights_queue(const Args& a, LAS unsigned char* lds, LAS int* qslot, int tid, int wave, int lane, int limit) {
    unsigned* ctr = (unsigned*)(a.ws + WS_CTL) + CW_CVTQ;
    LAS unsigned char* T = lds + wave * (64 * CVT_STR);
    for (;;) {
        __syncthreads();
        if (tid == 0) { int v = (int)__hip_atomic_load(ctr, __ATOMIC_RELAXED, __HIP_MEMORY_SCOPE_AGENT); v = (v < limit) ? (int)atomicAdd(ctr, 1u) : MOE_ITEMS; *qslot = v; }
        __syncthreads();
        const int it = *(volatile LAS int*)qslot;
        if (it >= MOE_ITEMS) break;
        if (it < NEXP * MOE_I_GU) { const int e = it / MOE_I_GU, q = it % MOE_I_GU, ng = q & 7, kq = q >> 3;
#pragma unroll 1
            for (int kb = kq * 4; kb < kq * 4 + 4; ++kb)
                cvt_tile_fp8<2, NLD>(a.in[I_WGU] + (size_t)e * DM * 2 * DE, 2 * DE, DM, a.ws + WS_WGU + (size_t)e * 2 * DE * DM, kb, ng * 8 + wave, T, lane);
        } else { const int r = it - NEXP * MOE_I_GU, e = r / MOE_I_D, q = r % MOE_I_D, ng = q & 3, kq = q >> 2;
#pragma unroll 1
            for (int kb = kq * 4; kb < kq * 4 + 4; ++kb)
                cvt_tile_fp8<0, NLD>(a.in[I_WD] + (size_t)e * DE * DM, DM, DE, a.ws + WS_WD + (size_t)e * DM * DE, kb, ng * 8 + wave, T, lane);
        }
    }
}

__device__ __forceinline__ void p2_qknorm(const Args& a, int gw, int NGW, int lane) {
    const bf16_t* P = (const bf16_t*)(a.ws + WS_P); bf16_t* QN = (bf16_t*)(a.ws + WS_QN); bf16_t* KN = (bf16_t*)(a.ws + WS_KN);
    const float qw0 = a.in[I_SBQNW][2 * lane], qw1 = a.in[I_SBQNW][2 * lane + 1], kw0 = a.in[I_SBKNW][2 * lane], kw1 = a.in[I_SBKNW][2 * lane + 1];
    const float QS = 0.08838834764831845f * 1.4426950408889634f;
    constexpr int QB_ = 8;
    for (int it0 = gw; it0 < NTOK * NHEAD * 2; it0 += QB_ * NGW) {
        unsigned w[QB_];
#pragma unroll
        for (int k = 0; k < QB_; ++k) { const int it = it0 + k * NGW; w[k] = 0u;
            if (it < NTOK * NHEAD * 2) { const int which = it & 1, h = (it >> 1) & 7, row = it >> 4; w[k] = *(const unsigned*)(P + (size_t)row * NPROJ + (which ? PC_SBK : PC_SBQ) + h * HD + 2 * lane); } }
#pragma unroll
        for (int k = 0; k < QB_; ++k) { const int it = it0 + k * NGW;
            if (it < NTOK * NHEAD * 2) { const int which = it & 1, h = (it >> 1) & 7, row = it >> 4; const int b = row / LSEQ, t = row - b * LSEQ;
                const float v0 = bf_lo(w[k]), v1 = bf_hi(w[k]);
                const float rstd = 1.0f / sqrtf(wave_sum(v0 * v0 + v1 * v1) * (1.0f / HD) + NORM_EPS);
                const float o0 = which ? v0 * rstd * kw0 : v0 * rstd * qw0 * QS, o1 = which ? v1 * rstd * kw1 : v1 * rstd * qw1 * QS;
                *(unsigned*)((which ? KN : QN) + ((size_t)(b * NHEAD + h) * LROW + t) * HD + 2 * lane) = cvt_pk_bf16(o0, o1); } }
    }
}

__device__ __forceinline__ bf16x8 sba_pack8(const f32x16& p, int base) {
    u32x4 w; w.x = cvt_pk_bf16(p[base + 0], p[base + 1]); w.y = cvt_pk_bf16(p[base + 2], p[base + 3]); w.z = cvt_pk_bf16(p[base + 4], p[base + 5]); w.w = cvt_pk_bf16(p[base + 6], p[base + 7]);
    return __builtin_bit_cast(bf16x8, w);
}

namespace gdn {
constexpr int NCH = 65;
constexpr int IMG_W = 0, IMG_QG = 16384, IMG_KDT = 32768, IMG_AT = 49152, IMG_BYTES = 57344, IMG_U = 57344, CH_BYTES = 73728;
constexpr int L_LT = 0, L_GC = 17408, L_BE = 17664, L_QB = 17920, L_KB = 35328, L_VB = 52736, L_IMG = 70144;
__device__ __forceinline__ int afrag_off(int row, int k, int nks) {
    const int rt = row >> 5, rr = row & 31, ks = k >> 4, kk = k & 15, hi = (kk >> 2) & 1, sl = (kk & 3) + 4 * (kk >> 3);
    return ((rt * nks + ks) * 64 + rr + 32 * hi) * 16 + sl * 2;
}
__device__ __forceinline__ int ufrag_off(int i, int c) {
    const int cg = c >> 5, col = c & 31, rt = i >> 5, ii = i & 31, hi = (ii >> 2) & 1, r = (ii & 3) + 4 * (ii >> 3);
    return (((cg * 2 + rt) * 2 + (r >> 3)) * 64 + col + 32 * hi) * 8 + (r & 7);
}
__device__ __forceinline__ int crow(int r, int hi) { return (r & 3) + 8 * (r >> 2) + 4 * hi; }
__device__ __forceinline__ bf16_t f2bf(float f) { return (bf16_t)(cvt_pk_bf16(f, 0.f) & 0xffffu); }

__device__ __forceinline__ void prefetch_rows(const Args& a, int item, int lane, int wave, unsigned (&xwp)[33], float (&gbp)[2]) {
    if (item >= 32 * NCH) return;
    const int bh = item / NCH, c = item - bh * NCH, b = bh >> 3, h = bh & 7, tbase = 64 * c - 48;
    const bf16_t* P = (const bf16_t*)(a.ws + WS_P) + (size_t)b * LSEQ * NPROJ;
#pragma unroll
    for (int j = 0; j < 11; ++j) { const int t = tbase + 8 * wave - 3 + j;
#pragma unroll
        for (int w3 = 0; w3 < 3; ++w3) { unsigned u = 0u; if (t >= 0) u = *(const unsigned*)(P + (size_t)t * NPROJ + w3 * 1024 + h * HD + 2 * lane); xwp[j * 3 + w3] = u; } }
    if (wave == 0) { const int t = tbase + lane; float g = 0.f, be = 0.f;
        if (t >= 0) { g = ((const float*)(a.ws + WS_G))[((size_t)b * LSEQ + t) * 8 + h]; be = ((const float*)(a.ws + WS_BETA))[((size_t)b * LSEQ + t) * 8 + h]; }
        gbp[0] = g; gbp[1] = be; }
}
__device__ __forceinline__ void precompute(const Args& a, LAS unsigned char* lds, int item, int tid, int lane, int wave, unsigned (&xwp)[33], float (&gbp)[2], volatile LAS int* nslot, int nclaim) {
    asm volatile("" : "+v"(tid), "+v"(lane), "+s"(wave));
    const int bh = item / NCH, c = item - bh * NCH, b = bh >> 3, h = bh & 7;
    const bf16_t* P = (const bf16_t*)(a.ws + WS_P) + (size_t)b * LSEQ * NPROJ;
    const float* BETA = (const float*)(a.ws + WS_BETA) + (size_t)b * LSEQ * 8; const float* GG = (const float*)(a.ws + WS_G) + (size_t)b * LSEQ * 8;
    unsigned char* dst = a.ws + WS_GCH + (size_t)item * CH_BYTES;
    LAS float* GC = (LAS float*)(lds + L_GC); LAS float* BE = (LAS float*)(lds + L_BE); LAS float* LT = (LAS float*)(lds + L_LT);
    const int tbase = 64 * c - 48;
    if (wave == 0) {
        float g = gbp[0], be = gbp[1];
#pragma unroll
        for (int o = 1; o < 64; o <<= 1) { const float y = __shfl_up(g, o); if (lane >= o) g += y; }
        GC[lane] = g; BE[lane] = be;
        if (lane == 63) ((float*)(a.ws + WS_GL))[item] = expf(g);
    }
    {
        f32x2 cw[3][4];
#pragma unroll
        for (int w3 = 0; w3 < 3; ++w3)
#pragma unroll
            for (int tap = 0; tap < 4; ++tap) cw[w3][tap] = *(const f32x2*)(a.in[I_CONVW] + tap * 3072 + w3 * 1024 + h * HD + 2 * lane);
        f32x2 xw[3][11];
#pragma unroll
        for (int j = 0; j < 11; ++j)
#pragma unroll
            for (int w3 = 0; w3 < 3; ++w3) { const unsigned u = xwp[j * 3 + w3]; xw[w3][j] = (f32x2){bf_lo(u), bf_hi(u)}; }
#pragma unroll
        for (int rr = 0; rr < 8; ++rr) { const int i = 8 * wave + rr; f32x2 y[3];
#pragma unroll
            for (int w3 = 0; w3 < 3; ++w3) { f32x2 acc = cw[w3][0] * xw[w3][rr] + cw[w3][1] * xw[w3][rr + 1] + cw[w3][2] * xw[w3][rr + 2] + cw[w3][3] * xw[w3][rr + 3];
                acc.x = acc.x / (1.0f + __expf(-acc.x)); acc.y = acc.y / (1.0f + __expf(-acc.y)); y[w3] = acc; }
            const float rq = 0.08838834764831845f / sqrtf(wave_sum(y[0].x * y[0].x + y[0].y * y[0].y) + NORM_EPS);
            const float rk = 1.0f / sqrtf(wave_sum(y[1].x * y[1].x + y[1].y * y[1].y) + NORM_EPS);
            *(LAS unsigned*)(lds + L_QB + i * 272 + 4 * lane) = cvt_pk_bf16(y[0].x * rq, y[0].y * rq);
            *(LAS unsigned*)(lds + L_KB + i * 272 + 4 * lane) = cvt_pk_bf16(y[1].x * rk, y[1].y * rk);
            *(LAS unsigned*)(lds + L_VB + i * 272 + 4 * lane) = cvt_pk_bf16(y[2].x, y[2].y); }
    }
    __syncthreads();
    {
        const int prod = wave >> 2, ti = (wave >> 1) & 1, tj = wave & 1, r32 = lane & 31, hi = lane >> 5;
        if (tj <= ti) {
            f32x16 acc;
#pragma unroll
            for (int r = 0; r < 16; ++r) acc[r] = 0.f;
            const LAS unsigned char* Ab = lds + (prod ? L_QB : L_KB) + (32 * ti + r32) * 272 + hi * 16;
            const LAS unsigned char* Bb = lds + L_KB + (32 * tj + r32) * 272 + hi * 16;
#pragma unroll
            for (int ks = 0; ks < 8; ++ks) acc = __builtin_amdgcn_mfma_f32_32x32x16_bf16(*(const LAS bf16x8*)(Ab + ks * 32), *(const LAS bf16x8*)(Bb + ks * 32), acc, 0, 0, 0);
            const int j = 32 * tj + r32; const float gj = GC[j];
#pragma unroll
            for (int r = 0; r < 16; ++r) { const int i = 32 * ti + crow(r, hi); const float dec = __expf(GC[i] - gj);
                if (prod == 0) LT[j * 68 + i] = (j < i) ? acc[r] * BE[i] * dec : 0.f;
                else *(LAS bf16_t*)(lds + L_IMG + IMG_AT + afrag_off(i, j, 4)) = f2bf((j <= i) ? acc[r] * dec : 0.f); }
        }
    }
    if (tid == 0) *nslot = nclaim;
    __syncthreads();
    gdn::prefetch_rows(a, *nslot, lane, wave, xwp, gbp);
    if (tid < 256) {
        float x[64];
        const bool isv = tid < 128; const int cc = tid & 127;
        const LAS unsigned char* src = lds + (isv ? L_VB : L_KB) + cc * 2;
#pragma unroll
        for (int i8 = 0; i8 < 64; i8 += 8) {
#pragma unroll
            for (int q = 0; q < 8; ++q) { const int i = i8 + q; const float v = bf2f(*(const LAS bf16_t*)(src + i * 272)); x[i] = v * BE[i] * (isv ? 1.0f : __expf(GC[i])); }
            asm volatile("" ::: "memory"); }
#pragma unroll
        for (int j = 0; j < 16; ++j) {
#pragma unroll
            for (int i4 = ((j + 1) & ~3); i4 < 64; i4 += 4) { const f32x4 l4 = *(const LAS f32x4*)(LT + j * 68 + i4);
#pragma unroll
                for (int q = 0; q < 4; ++q) if (i4 + q > j) x[i4 + q] -= l4[q] * x[j]; }
            asm volatile("" ::: "memory");
        }
        f32x4 la[12], lb[12];
#define LT_LOAD(dst, j) do { _Pragma("unroll") for (int _c = (((j) + 1) >> 2); _c < 16; ++_c) dst[_c - 4] = *(const LAS f32x4*)(LT + (j) * 68 + 4 * _c); } while (0)
#define LT_APPLY(src, j) do { _Pragma("unroll") for (int _c = (((j) + 1) >> 2); _c < 16; ++_c) { _Pragma("unroll") for (int q = 0; q < 4; ++q) if (4 * _c + q > (j)) x[4 * _c + q] -= src[_c - 4][q] * x[(j)]; } } while (0)
        LT_LOAD(la, 16);
#pragma unroll
        for (int jj = 8; jj < 31; ++jj) {
            LT_LOAD(lb, 2 * jj + 1); asm volatile("" ::: "memory"); LT_APPLY(la, 2 * jj);
            LT_LOAD(la, 2 * jj + 2); asm volatile("" ::: "memory"); LT_APPLY(lb, 2 * jj + 1);
        }
        LT_APPLY(la, 62);
#undef LT_LOAD
#undef LT_APPLY
        if (isv) {
            LAS unsigned char* ub = lds + L_IMG + IMG_U + (((cc >> 5) * 4 * 64) + (cc & 31)) * 16;
#pragma unroll
            for (int i = 0; i < 64; ++i) { const int rt = i >> 5, ii = i & 31, hi = (ii >> 2) & 1, r = (ii & 3) + 4 * (ii >> 3);
                *(LAS bf16_t*)(ub + (((rt * 2 + (r >> 3)) * 64 + 32 * hi) * 8 + (r & 7)) * 2) = f2bf(x[i]); }
        } else {
            const int ks = cc >> 4, kk = cc & 15, hi = (kk >> 2) & 1, sl = (kk & 3) + 4 * (kk >> 3);
            LAS unsigned char* wb = lds + L_IMG + IMG_W + (ks * 64 + 32 * hi) * 16 + sl * 2;
#pragma unroll
            for (int i = 0; i < 64; ++i) *(LAS bf16_t*)(wb + ((i >> 5) * 8 * 64 + (i & 31)) * 16) = f2bf(-x[i]);
        }
    } else {
        const int u = tid - 256, dk = u & 127, i0 = (u >> 7) * 32; const float gl = GC[63];
#pragma unroll 4
        for (int ii = 0; ii < 32; ++ii) { const int i = i0 + ii; const float gi = GC[i];
            const float q = bf2f(*(const LAS bf16_t*)(lds + L_QB + i * 272 + dk * 2)), k = bf2f(*(const LAS bf16_t*)(lds + L_KB + i * 272 + dk * 2));
            *(LAS bf16_t*)(lds + L_IMG + IMG_QG + afrag_off(i, dk, 8)) = f2bf(q * __expf(gi));
            *(LAS bf16_t*)(lds + L_IMG + IMG_KDT + afrag_off(dk, i, 4)) = f2bf(k * __expf(gl - gi)); }
    }
    __syncthreads();
    for (int q = tid; q < CH_BYTES / 16; q += NTHREADS) *(u32x4*)(dst + (size_t)q * 16) = *(const LAS u32x4*)(lds + L_IMG + q * 16);
}

constexpr int OB_OFF = 2 * IMG_BYTES, OB_STR = 272, OB_BYTES = 64 * OB_STR;
__device__ __forceinline__ void gated_load_z(const Args& a, u32x4 (&zw)[4], int b, int h, int cc, int w4, int lane) {
    const bf16_t* P = (const bf16_t*)(a.ws + WS_P);
    const int s = 64 * (cc - 1) + 16 * w4 + (lane >> 2);
    const u32x4* zp = (const u32x4*)(P + ((size_t)b * LSEQ + NMETA + s) * NPROJ + PC_Z + h * HD + 32 * (lane & 3));
#pragma unroll
    for (int q = 0; q < 4; ++q) zw[q] = zp[q];
}
__device__ __forceinline__ float silu_f(float z) { return z * __builtin_amdgcn_rcpf(1.0f + __expf(-z)); }
__device__ __forceinline__ void gated_rows(const Args& a, const LAS unsigned char* ob, const u32x4 (&zw)[4], int b, int h, int cc, int w4, int lane, const f32x4 (&nwv)[8]) {
    bf16_t* MIX = (bf16_t*)(a.ws + WS_MIX);
    const int row = lane >> 2, qd = lane & 3, s = 64 * (cc - 1) + 16 * w4 + row;
    u32x4 ov[4]; float ss = 0.f;
#pragma unroll
    for (int q = 0; q < 4; ++q) { ov[q] = *(const LAS u32x4*)(ob + (16 * w4 + row) * OB_STR + qd * 64 + q * 16);
#pragma unroll
        for (int e = 0; e < 4; ++e) { const float lo = bf_lo(ov[q][e]), hi = bf_hi(ov[q][e]); ss += lo * lo + hi * hi; } }
    ss = quad_sum(ss);
    const float rstd = __builtin_amdgcn_rsqf(ss * (1.0f / HD) + NORM_EPS);
    u32x4* dst = (u32x4*)(MIX + ((size_t)b * SEQ + s) * DM + h * HD + 32 * qd);
#pragma unroll
    for (int q = 0; q < 4; ++q) { u32x4 w;
#pragma unroll
        for (int e = 0; e < 4; ++e) { const f32x4 nv = nwv[2 * q + (e >> 1)];
            const float n0 = (e & 1) ? nv.z : nv.x, n1 = (e & 1) ? nv.w : nv.y;
            w[e] = cvt_pk_bf16(bf_lo(ov[q][e]) * rstd * n0 * silu_f(bf_lo(zw[q][e])), bf_hi(ov[q][e]) * rstd * n1 * silu_f(bf_hi(zw[q][e]))); }
        dst[q] = w; }
}

__device__ __forceinline__ void scan(const Args& a, LAS unsigned char* lds, int bh, int tid, int lane, int wave) {
    const int b = bh >> 3, h = bh & 7, col = lane & 31, hi = lane >> 5, cg = wave;
    const unsigned char* src = a.ws + WS_GCH + (size_t)bh * NCH * CH_BYTES;
    const float* GL = (const float*)(a.ws + WS_GL) + bh * NCH;
    __syncthreads();
    const unsigned dvoff = (unsigned)(wave * 1024 + lane * 16), uvoff = (unsigned)(lane * 16);
#define GDN_DMA(ch, buf) do { const unsigned char* _sp = src + (size_t)(ch) * CH_BYTES; _Pragma("unroll") for (int _f = 0; _f < 7; ++_f) { \
        __builtin_amdgcn_global_load_lds((const unsigned*)(_sp + _f * 8192 + dvoff), (LAS unsigned*)(lds + (buf) * IMG_BYTES + wave * 1024 + _f * 8192), 16, 0, 0); } } while (0)
    GDN_DMA(0, 0);
#define GDN_STEP_END(vm) do { asm volatile("s_waitcnt vmcnt(" #vm ")" ::: "memory"); asm volatile("s_waitcnt lgkmcnt(0)" ::: "memory"); __builtin_amdgcn_s_barrier(); asm volatile("" ::: "memory"); } while (0)
    if (wave < 4) {
        f32x16 st[4]; bf16x8 Sb[8]; u32x4 ureg[4]; float gl;
#pragma unroll
        for (int t4 = 0; t4 < 4; ++t4)
#pragma unroll
            for (int r = 0; r < 16; ++r) st[t4][r] = 0.f;
#pragma unroll
        for (int ks = 0; ks < 8; ++ks) Sb[ks] = (bf16x8){0, 0, 0, 0, 0, 0, 0, 0};
#pragma unroll
        for (int q = 0; q < 4; ++q) ureg[q] = *(const u32x4*)(src + IMG_U + cg * 4096 + q * 1024 + uvoff);
        gl = GL[0];
        GDN_STEP_END(0);
        for (int c = 0; c < NCH; ++c) {
            const LAS unsigned char* img = lds + (c & 1) * IMG_BYTES + lane * 16;
            asm volatile("" : "+v"(ureg[0]), "+v"(ureg[1]), "+v"(ureg[2]), "+v"(ureg[3]), "+v"(gl));
            if (c + 1 < NCH) GDN_DMA(c + 1, (c + 1) & 1);
            f32x16 vn[2]; const float glc = gl;
#pragma unroll
            for (int rt = 0; rt < 2; ++rt)
#pragma unroll
                for (int rh = 0; rh < 2; ++rh) { const u32x4 w = ureg[rt * 2 + rh];
                    vn[rt][8 * rh + 0] = bf_lo(w.x); vn[rt][8 * rh + 1] = bf_hi(w.x); vn[rt][8 * rh + 2] = bf_lo(w.y); vn[rt][8 * rh + 3] = bf_hi(w.y);
                    vn[rt][8 * rh + 4] = bf_lo(w.z); vn[rt][8 * rh + 5] = bf_hi(w.z); vn[rt][8 * rh + 6] = bf_lo(w.w); vn[rt][8 * rh + 7] = bf_hi(w.w); }
            asm volatile("" ::: "memory");
            if (c + 1 < NCH) {
#pragma unroll
                for (int q = 0; q < 4; ++q) ureg[q] = *(const u32x4*)(src + (size_t)(c + 1) * CH_BYTES + IMG_U + cg * 4096 + q * 1024 + uvoff);
                gl = GL[c + 1]; }
#pragma unroll
            for (int rt = 0; rt < 2; ++rt) { __builtin_amdgcn_sched_barrier(0);
#pragma unroll
                for (int ks = 0; ks < 8; ++ks) vn[rt] = __builtin_amdgcn_mfma_f32_32x32x16_bf16(*(const LAS bf16x8*)(img + IMG_W + (rt * 8 + ks) * 1024), Sb[ks], vn[rt], 0, 0, 0); }
            __builtin_amdgcn_sched_barrier(0);
            bf16x8 vb[4];
#pragma unroll
            for (int ks = 0; ks < 4; ++ks) vb[ks] = sba_pack8(vn[ks >> 1], 8 * (ks & 1));
            LAS unsigned char* obw = lds + OB_OFF + (c & 1) * OB_BYTES + (32 * cg + col) * 2;
#pragma unroll
            for (int rt = 0; rt < 2; ++rt) { f32x16 o; __builtin_amdgcn_sched_barrier(0);
#pragma unroll
                for (int r = 0; r < 16; ++r) o[r] = 0.f;
#pragma unroll
                for (int ks = 0; ks < 8; ++ks) o = __builtin_amdgcn_mfma_f32_32x32x16_bf16(*(const LAS bf16x8*)(img + IMG_QG + (rt * 8 + ks) * 1024), Sb[ks], o, 0, 0, 0);
#pragma unroll
                for (int ks = 0; ks < 2 * (rt + 1); ++ks) o = __builtin_amdgcn_mfma_f32_32x32x16_bf16(*(const LAS bf16x8*)(img + IMG_AT + (rt * 4 + ks) * 1024), vb[ks], o, 0, 0, 0);
                if (c >= 1) {
#pragma unroll
                    for (int r = 0; r < 16; ++r) *(LAS bf16_t*)(obw + (32 * rt + crow(r, hi)) * OB_STR) = f2bf(o[r]); }
            }
#pragma unroll
            for (int t4 = 0; t4 < 4; ++t4) { __builtin_amdgcn_sched_barrier(0);
#pragma unroll
                for (int r = 0; r < 16; ++r) st[t4][r] *= glc;
#pragma unroll
                for (int ks = 0; ks < 4; ++ks) st[t4] = __builtin_amdgcn_mfma_f32_32x32x16_bf16(*(const LAS bf16x8*)(img + IMG_KDT + (t4 * 4 + ks) * 1024), vb[ks], st[t4], 0, 0, 0);
                Sb[2 * t4] = sba_pack8(st[t4], 0); Sb[2 * t4 + 1] = sba_pack8(st[t4], 8); }
            if (c + 1 < NCH) GDN_STEP_END(5); else GDN_STEP_END(0);
        }
    } else {
        u32x4 zA[4], zB[4]; f32x4 nwv[8];
#pragma unroll
        for (int q = 0; q < 4; ++q) { zA[q] = (u32x4){0u, 0u, 0u, 0u}; zB[q] = (u32x4){0u, 0u, 0u, 0u}; }
#pragma unroll
        for (int q = 0; q < 8; ++q) nwv[q] = *(const f32x4*)(a.in[I_GDNNW] + 32 * (lane & 3) + 4 * q);
        GDN_STEP_END(0);
        for (int c = 0; c < NCH; ++c) {
#pragma unroll
            for (int q = 0; q < 4; ++q) asm volatile("" : "+v"(zA[q]), "+v"(zB[q]));
            if (c + 1 < NCH) GDN_DMA(c + 1, (c + 1) & 1);
            if (c >= 1) { if (c & 1) gated_load_z(a, zA, b, h, c, wave - 4, lane); else gated_load_z(a, zB, b, h, c, wave - 4, lane); }
            asm volatile("" ::: "memory");
            if (c >= 2) { if (c & 1) gated_rows(a, lds + OB_OFF + ((c - 1) & 1) * OB_BYTES, zB, b, h, c - 1, wave - 4, lane, nwv);
                          else gated_rows(a, lds + OB_OFF + ((c - 1) & 1) * OB_BYTES, zA, b, h, c - 1, wave - 4, lane, nwv); }
            if (c >= 2) GDN_STEP_END(4); else GDN_STEP_END(0);
        }
        gated_rows(a, lds + OB_OFF + ((NCH - 1) & 1) * OB_BYTES, zB, b, h, NCH - 1, wave - 4, lane, nwv);
    }
#undef GDN_STEP_END
#undef GDN_DMA
}
}

namespace sba {
#define KSWZ(row, colB) ((row) * 256 + ((colB) ^ (((row) & 7) << 4)))
__device__ __forceinline__ int v_st(int k, int c) { const int kk = (k & ~0xC) | ((k & 4) << 1) | ((k & 8) >> 1); return ((kk >> 3) * 4 + (c >> 5)) * 512 + ((kk & 7) * 32 + (c & 31)) * 2; }
__device__ __forceinline__ int v_rd_base(int lane) { return ((lane & 3) << 3) | (((lane >> 2) & 3) << 6) | (((lane >> 4) & 1) << 5) | (((lane >> 5) & 1) << 8); }
constexpr int v_rd_off(int d0, int ks, int half) { return d0 * 512 + ks * 4096 + half * 2048; }
template <int OFF> __device__ __forceinline__ s16x4 tr_read(int vb) { s16x4 r; asm volatile("ds_read_b64_tr_b16 %0, %1 offset:%2" : "=&v"(r) : "v"(vb), "i"(OFF) : "memory"); return r; }
template <int D0> __device__ __forceinline__ void pv_one(f32x16& od, int vb, bf16x8 pa0, bf16x8 pa1, bf16x8 pa2, bf16x8 pa3) {
    const s16x4 l0 = tr_read<v_rd_off(D0, 0, 0)>(vb), h0 = tr_read<v_rd_off(D0, 0, 1)>(vb), l1 = tr_read<v_rd_off(D0, 1, 0)>(vb), h1 = tr_read<v_rd_off(D0, 1, 1)>(vb);
    const s16x4 l2 = tr_read<v_rd_off(D0, 2, 0)>(vb), h2 = tr_read<v_rd_off(D0, 2, 1)>(vb), l3 = tr_read<v_rd_off(D0, 3, 0)>(vb), h3 = tr_read<v_rd_off(D0, 3, 1)>(vb);
    asm volatile("s_waitcnt lgkmcnt(0)" ::: "memory"); __builtin_amdgcn_sched_barrier(0);
#define PK(L, H) (bf16x8){L[0], L[1], L[2], L[3], H[0], H[1], H[2], H[3]}
    od = __builtin_amdgcn_mfma_f32_32x32x16_bf16(pa0, PK(l0, h0), od, 0, 0, 0);
    od = __builtin_amdgcn_mfma_f32_32x32x16_bf16(pa1, PK(l1, h1), od, 0, 0, 0);
    od = __builtin_amdgcn_mfma_f32_32x32x16_bf16(pa2, PK(l2, h2), od, 0, 0, 0);
    od = __builtin_amdgcn_mfma_f32_32x32x16_bf16(pa3, PK(l3, h3), od, 0, 0, 0);
#undef PK
}
__device__ __forceinline__ int crow(int r, int hi) { return (r & 3) + 8 * (r >> 2) + 4 * hi; }
__device__ __forceinline__ int swap34(int k) { return (k & ~0x18) | ((k & 8) << 1) | ((k & 16) >> 1); }
__device__ __forceinline__ bf16x8 pack8(const f32x16& p, int base) {
    u32x4 w; w.x = cvt_pk_bf16(p[base + 0], p[base + 1]); w.y = cvt_pk_bf16(p[base + 2], p[base + 3]); w.z = cvt_pk_bf16(p[base + 4], p[base + 5]); w.w = cvt_pk_bf16(p[base + 6], p[base + 7]);
    return __builtin_bit_cast(bf16x8, w);
}
constexpr float SB_EXIT = 160.0f;

__device__ __forceinline__ void unit(const Args& a, LAS unsigned char* lds, volatile LAS int* done_cnt, int b, int h, int qb, int tid, int lane, int wid) {
    const bf16_t* QN = (const bf16_t*)(a.ws + WS_QN) + (size_t)(b * NHEAD + h) * LROW * HD;
    const bf16_t* KN = (const bf16_t*)(a.ws + WS_KN) + (size_t)(b * NHEAD + h) * LROW * HD;
    const bf16_t* Vp = (const bf16_t*)(a.ws + WS_P) + (size_t)b * LSEQ * NPROJ + PC_SBV + h * HD;
    bf16_t* MIX = (bf16_t*)(a.ws + WS_MIX);
    const int r32 = lane & 31, hi = lane >> 5;
    LAS unsigned char* K_lds = lds; LAS unsigned char* V_lds = lds + 16384;
    const int tq0 = NMETA + 256 * qb + 32 * wid, tq = tq0 + r32;
    __syncthreads();
    if (tid == 0) *done_cnt = 0;
    bf16x8 qr[8];
#pragma unroll
    for (int d0 = 0; d0 < 8; ++d0) qr[d0] = *(const bf16x8*)(QN + (size_t)tq * HD + d0 * 16 + hi * 8);
    const int sr = tid >> 4, sc = (tid & 15) * 8;
    const int vst0 = v_st(swap34(sr), sc), vst1 = v_st(32 + swap34(sr), sc);
    const int kst0 = KSWZ(sr, sc * 2), kst1 = KSWZ(32 + sr, sc * 2);
    const int vb0 = (int)(unsigned)(unsigned long)V_lds + v_rd_base(lane);
    const int prow = (r32 & 3) + 4 * (r32 >> 3) + 16 * ((r32 >> 2) & 1);
    f32x16 o[4];
#pragma unroll
    for (int d = 0; d < 4; ++d)
#pragma unroll
        for (int r = 0; r < 16; ++r) o[d][r] = 0.f;
    float carry = 0.f; bool flagged = false;
    bf16x8 ks0, ks1, vs0, vs1;
#define SBA_LOAD(kk) do { const int _k0 = 64 * (kk); ks0 = *(const bf16x8*)(KN + (size_t)(_k0 + sr) * HD + sc); ks1 = *(const bf16x8*)(KN + (size_t)(_k0 + 32 + sr) * HD + sc); \
        vs0 = *(const bf16x8*)(Vp + (size_t)(_k0 + sr) * NPROJ + sc); vs1 = *(const bf16x8*)(Vp + (size_t)(_k0 + 32 + sr) * NPROJ + sc); } while (0)
    SBA_LOAD(4 * qb + 4);
    for (int kt = 4 * qb + 4; kt >= 0; --kt) {
        const int k0 = 64 * kt;
        __syncthreads();
        if (*done_cnt == NWAVES) break;
        *(LAS bf16x8*)(K_lds + kst0) = ks0; *(LAS bf16x8*)(K_lds + kst1) = ks1; *(LAS bf16x8*)(V_lds + vst0) = vs0; *(LAS bf16x8*)(V_lds + vst1) = vs1;
        if (kt > 0) SBA_LOAD(kt - 1);
        __syncthreads();
        if (k0 >= tq0 + 32) continue;
        f32x16 p0, p1;
#pragma unroll
        for (int r = 0; r < 16; ++r) { p0[r] = 0.f; p1[r] = 0.f; }
#pragma unroll
        for (int d0 = 0; d0 < 8; ++d0) { const int cb = (d0 * 16 + hi * 8) * 2;
            const bf16x8 b0 = *(const LAS bf16x8*)(K_lds + KSWZ(prow, cb)), b1 = *(const LAS bf16x8*)(K_lds + KSWZ(32 + prow, cb));
            p0 = __builtin_amdgcn_mfma_f32_32x32x16_bf16(b0, qr[d0], p0, 0, 0, 0);
            p1 = __builtin_amdgcn_mfma_f32_32x32x16_bf16(b1, qr[d0], p1, 0, 0, 0); }
        const bool need_mask = (k0 + 63 >= tq0);
        f32x16 s0, s1; float t0 = 0.f, t1 = 0.f;
#pragma unroll
        for (int r = 0; r < 16; ++r) {
            float e0 = __builtin_amdgcn_exp2f(p0[r]), e1 = __builtin_amdgcn_exp2f(p1[r]);
            float q0 = __builtin_amdgcn_logf(1.0f + e0), q1 = __builtin_amdgcn_logf(1.0f + e1);
            if (need_mask) { const bool v0 = (k0 + 16 * hi + r) < tq, v1 = (k0 + 32 + 16 * hi + r) < tq; e0 = v0 ? e0 : 0.f; q0 = v0 ? q0 : 0.f; e1 = v1 ? e1 : 0.f; q1 = v1 ? q1 : 0.f; }
            p0[r] = e0; p1[r] = e1; s0[r] = q0; s1[r] = q1; t0 += q0; t1 += q1; }
        float t1lo, t1hi, t0lo, t0hi;
        { auto rr = __builtin_amdgcn_permlane32_swap(__float_as_uint(t1), __float_as_uint(t1), false, false); t1lo = __uint_as_float(rr[0]); t1hi = __uint_as_float(rr[1]); }
        { auto rr = __builtin_amdgcn_permlane32_swap(__float_as_uint(t0), __float_as_uint(t0), false, false); t0lo = __uint_as_float(rr[0]); t0hi = __uint_as_float(rr[1]); }
        float run1 = carry + (hi ? 0.f : t1hi), run0 = carry + (t1lo + t1hi) + (hi ? 0.f : t0hi);
#pragma unroll
        for (int r = 15; r >= 0; --r) { run1 += s1[r]; p1[r] = p1[r] * __builtin_amdgcn_exp2f(-run1); run0 += s0[r]; p0[r] = p0[r] * __builtin_amdgcn_exp2f(-run0); }
        carry += (t1lo + t1hi) + (t0lo + t0hi);
        const bf16x8 pa0 = pack8(p0, 0), pa1 = pack8(p0, 8), pa2 = pack8(p1, 0), pa3 = pack8(p1, 8);
        pv_one<0>(o[0], vb0, pa0, pa1, pa2, pa3); pv_one<1>(o[1], vb0, pa0, pa1, pa2, pa3); pv_one<2>(o[2], vb0, pa0, pa1, pa2, pa3); pv_one<3>(o[3], vb0, pa0, pa1, pa2, pa3);
        if (!flagged && __all(carry >= SB_EXIT)) { flagged = true; if (lane == 0) (void)__hip_atomic_fetch_add((LAS int*)done_cnt, 1, __ATOMIC_RELAXED, __HIP_MEMORY_SCOPE_WORKGROUP); }
    }
#undef SBA_LOAD
    const float* onw = a.in[I_SBONW];
    float wv[4];
#pragma unroll
    for (int d0 = 0; d0 < 4; ++d0) wv[d0] = onw[32 * d0 + r32];
#pragma unroll
    for (int r = 0; r < 16; ++r) {
        float ss = (o[0][r] * o[0][r] + o[1][r] * o[1][r]) + (o[2][r] * o[2][r] + o[3][r] * o[3][r]);
        ss = row16_sum(ss); ss += __shfl_xor(ss, 16);
        const float rstd = 1.0f / sqrtf(ss * (1.0f / HD) + NORM_EPS);
        const size_t tok = (size_t)b * SEQ + (tq0 - NMETA) + crow(r, hi);
        bf16_t* dst = MIX + tok * DM + 1024 + h * HD + r32;
#pragma unroll
        for (int d0 = 0; d0 < 4; ++d0) dst[32 * d0] = (bf16_t)(cvt_pk_bf16(o[d0][r] * rstd * wv[d0], 0.f) & 0xffffu);
    }
}
}

__device__ __forceinline__ void p5_router(const Args& a, LAS unsigned char* lds, int G, int c, int tid, int lane, int wave) {
    LAS float* wl = (LAS float*)lds;
    LAS float* lg = (LAS float*)(lds + 132096);
    LAS int* misc = (LAS int*)(lds + MISC_OFF);
    const float* H1 = a.out; const float* rw = a.in[I_RW]; const float* rb = a.in[I_RB];
    unsigned char* HN2 = a.ws + WS_HN;
    int* RE = (int*)(a.ws + WS_RE); int* RP = (int*)(a.ws + WS_RP); float* RG = (float*)(a.ws + WS_RG); int* LIST = (int*)(a.ws + WS_LIST);
    unsigned* ecnt = (unsigned*)(a.ws + WS_CTL) + CW_ECNT;
    f32x4 wn[8];
#pragma unroll
    for (int j = 0; j < 8; ++j) wn[j] = *((const f32x4*)a.in[I_FFNNW] + lane + 64 * j);
    for (int blk = c; blk < NREAL / 64; blk += G) {
        for (int pass = 0; pass < 2; ++pass) {
            __syncthreads();
            stage_w16(wl, rw, NEXP, pass * 16, tid);
            if (pass == 0 && tid < 32) misc[40 + tid] = 0;
            __syncthreads();
            for (int rg = 0; rg < 4; ++rg) {
                f32x4 v[2][8];
#pragma unroll
                for (int k = 0; k < 2; ++k) { const size_t row = (size_t)blk * 64 + wave * 8 + rg * 2 + k;
#pragma unroll
                    for (int j = 0; j < 8; ++j) v[k][j] = *((const f32x4*)(H1 + row * DM) + lane + 64 * j); }
#pragma unroll
                for (int k = 0; k < 2; ++k) { const size_t row = (size_t)blk * 64 + wave * 8 + rg * 2 + k; float ss = 0.f;
#pragma unroll
                    for (int j = 0; j < 8; ++j) ss += (v[k][j].x * v[k][j].x + v[k][j].y * v[k][j].y) + (v[k][j].z * v[k][j].z + v[k][j].w * v[k][j].w);
                    const float rstd = 1.0f / sqrtf(wave_sum(ss) * (1.0f / DM) + NORM_EPS);
                    GAS unsigned* o4 = (GAS unsigned*)(HN2 + row * DM) + lane;
#pragma unroll
                    for (int j = 0; j < 8; ++j) { v[k][j] = v[k][j] * rstd * wn[j];
                        if (pass == 0) o4[64 * j] = pk4_fp8(v[k][j].x, v[k][j].y, v[k][j].z, v[k][j].w); } }
#pragma unroll
                for (int hf = 0; hf < 2; ++hf) { float o8[2][8]; dot8xN<2>(v, wl + hf * 8 * WLS, lane, o8);
#pragma unroll
                    for (int k = 0; k < 2; ++k) { float sv = o8[k][0];
#pragma unroll
                        for (int c = 1; c < 8; ++c) sv = ((lane & 7) == c) ? o8[k][c] : sv;
                        if (lane < 8) lg[(wave * 8 + rg * 2 + k) * 33 + pass * 16 + hf * 8 + lane] = sv; } }
            }
        }
        __syncthreads();
        int ek[4] = {0, 0, 0, 0}, rk[4] = {0, 0, 0, 0}; float gk[4] = {0.f, 0.f, 0.f, 0.f};
        if (tid < 64) {
            float v[32];
#pragma unroll
            for (int e = 0; e < 32; ++e) v[e] = lg[tid * 33 + e] + rb[e];
            float val[4];
#pragma unroll
            for (int k = 0; k < 4; ++k) { float best = -3.0e38f; int bi = 0;
#pragma unroll
                for (int e = 0; e < 32; ++e) { const bool gt = v[e] > best; best = gt ? v[e] : best; bi = gt ? e : bi; }
#pragma unroll
                for (int e = 0; e < 32; ++e) v[e] = (e == bi) ? -3.0e38f : v[e];
                ek[k] = bi; val[k] = best; }
            float den = 0.f;
#pragma unroll
            for (int k = 0; k < 4; ++k) { gk[k] = expf(val[k] - val[0]); den += gk[k]; }
#pragma unroll
            for (int k = 0; k < 4; ++k) { gk[k] = gk[k] / den; rk[k] = __hip_atomic_fetch_add(&misc[40 + ek[k]], 1, __ATOMIC_RELAXED, __HIP_MEMORY_SCOPE_WORKGROUP); }
        }
        __syncthreads();
        if (tid < 32) { const int cnt = misc[40 + tid]; misc[72 + tid] = cnt ? (int)atomicAdd(&ecnt[tid], (unsigned)cnt) : 0; }
        __syncthreads();
        if (tid < 64) { const int tok = blk * 64 + tid;
#pragma unroll
            for (int k = 0; k < 4; ++k) { const int pos = misc[72 + ek[k]] + rk[k]; LIST[(size_t)ek[k] * NREAL + pos] = tok; RE[tok * 4 + k] = ek[k]; RP[tok * 4 + k] = pos; RG[tok * 4 + k] = gk[k]; } }
    }
    __syncthreads();
}

__device__ __forceinline__ int moe_setup(const Args& a, LAS int* misc, int tid) {
    const unsigned* ecnt = (const unsigned*)(a.ws + WS_CTL) + CW_ECNT;
    __syncthreads();
    if (tid == 0) { int acc = 0;
        for (int e = 0; e < NEXP; ++e) { const int cnt = (int)__hip_atomic_load(ecnt + e, __ATOMIC_RELAXED, __HIP_MEMORY_SCOPE_AGENT); misc[104 + e] = cnt; misc[e] = acc; acc += (cnt + 255) >> 8; }
        misc[32] = acc; }
    __syncthreads();
    return misc[32];
}

__device__ __forceinline__ void p8_combine(const Args& a, const LAS int* misc, int gw, int NGW, int lane) {
    const int* RE = (const int*)(a.ws + WS_RE); const int* RP = (const int*)(a.ws + WS_RP); const float* RG = (const float*)(a.ws + WS_RG);
    const bf16_t* Y = (const bf16_t*)(a.ws + WS_Y); float* out = a.out;
    typedef int i32x4 __attribute__((ext_vector_type(4)));
    i32x4 e4 = {0, 0, 0, 0}, p4 = {0, 0, 0, 0}; f32x4 g4 = {0.f, 0.f, 0.f, 0.f};
    if (gw < NREAL) { e4 = *(const i32x4*)(RE + gw * 4); p4 = *(const i32x4*)(RP + gw * 4); g4 = *(const f32x4*)(RG + gw * 4); }
    for (int row = gw; row < NREAL; row += NGW) {
        size_t slot[4]; float g[4];
#pragma unroll
        for (int k = 0; k < 4; ++k) { slot[k] = (size_t)misc[e4[k]] * 256 + p4[k]; g[k] = g4[k]; }
        const int nrow = row + NGW;
        if (nrow < NREAL) { e4 = *(const i32x4*)(RE + nrow * 4); p4 = *(const i32x4*)(RP + nrow * 4); g4 = *(const f32x4*)(RG + nrow * 4); }
        f32x4 acc[4][2]; u32x4 y[4][4];
#pragma unroll
        for (int j = 0; j < 4; ++j) { const int col = 8 * lane + 512 * j;
            acc[j][0] = *(const f32x4*)(out + (size_t)row * DM + col); acc[j][1] = *(const f32x4*)(out + (size_t)row * DM + col + 4);
#pragma unroll
            for (int k = 0; k < 4; ++k) y[j][k] = *(const u32x4*)(Y + slot[k] * DM + col); }
#pragma unroll
        for (int j = 0; j < 4; ++j) { const int col = 8 * lane + 512 * j; f32x4 a0 = acc[j][0], a1 = acc[j][1];
#pragma unroll
            for (int k = 0; k < 4; ++k) { const u32x4 yy = y[j][k];
                a0.x += g[k] * bf_lo(yy.x); a0.y += g[k] * bf_hi(yy.x); a0.z += g[k] * bf_lo(yy.y); a0.w += g[k] * bf_hi(yy.y);
                a1.x += g[k] * bf_lo(yy.z); a1.y += g[k] * bf_hi(yy.z); a1.z += g[k] * bf_lo(yy.w); a1.w += g[k] * bf_hi(yy.w); }
            *(f32x4*)(out + (size_t)row * DM + col) = a0; *(f32x4*)(out + (size_t)row * DM + col + 4) = a1; }
    }
}

__device__ __forceinline__ void p1_meta_rows(const Args& a, LAS unsigned char* lds, int bx, int G, int tid, int wave, int lane) {
    const bf16_t* HN = (const bf16_t*)(a.ws + WS_HN); const bf16_t* WT = (const bf16_t*)(a.ws + WS_WIN); bf16_t* P = (bf16_t*)(a.ws + WS_P);
    for (int q = tid; q < NMETA * DM * 2 / 16; q += NTHREADS) *(LAS u32x4*)(lds + q * 16) = *(const u32x4*)((const unsigned char*)HN + (size_t)q * 16);
    __syncthreads();
    for (int col = bx + G * wave; col < NPROJ; col += G * NWAVES) {
        u32x4 w[4]; int lane_o = lane; asm volatile("" : "+v"(lane_o));
#pragma unroll
        for (int j = 0; j < 4; ++j) w[j] = *(const u32x4*)(WT + (size_t)col * DM + 8 * lane + 512 * j);
        float v = 0.f;
#pragma unroll 1
        for (int t = 0; t < NMETA; ++t) { float s = 0.f;
#pragma unroll
            for (int j = 0; j < 4; ++j) { const u32x4 x = *(const LAS u32x4*)(lds + t * (DM * 2) + (8 * lane_o + 512 * j) * 2);
                s += bf_lo(x.x) * bf_lo(w[j].x) + bf_hi(x.x) * bf_hi(w[j].x) + bf_lo(x.y) * bf_lo(w[j].y) + bf_hi(x.y) * bf_hi(w[j].y)
                   + bf_lo(x.z) * bf_lo(w[j].z) + bf_hi(x.z) * bf_hi(w[j].z) + bf_lo(x.w) * bf_lo(w[j].w) + bf_hi(x.w) * bf_hi(w[j].w); }
            s = wave_sum(s);
            v = ((lane & 15) == t) ? s : v; }
        P[((size_t)(lane >> 4) * LSEQ + (lane & 15)) * NPROJ + col] = gdn::f2bf(v);
    }
    __syncthreads();
}

constexpr int NPH = 9;
__global__ void __launch_bounds__(NTHREADS, 2) hymba_fwd(Args args) {
    extern __shared__ __attribute__((aligned(16))) unsigned char lds_raw[];
    LAS unsigned char* lds = (LAS unsigned char*)lds_raw;
    LAS int* misc = (LAS int*)(lds + MISC_OFF);
    const int tid = threadIdx.x, lane = tid & 63, wave = __builtin_amdgcn_readfirstlane(tid >> 6);
    const int G = gridDim.x, bx = blockIdx.x;
    const int vcu = (G % 8 == 0) ? (bx % 8) * (G / 8) + bx / 8 : bx;
    const int gw = vcu * NWAVES + wave, NGW = G * NWAVES;
    unsigned* ctl = (unsigned*)(args.ws + WS_CTL);
    for (int u = tid; u < 256; u += NTHREADS) misc[u] = 0;
    __syncthreads();
    XcdBarrier bar; bar.bar = ctl + CW_BAR; bar.x = 0; bar.st = nullptr;
    const int lo = args.ph_lo, hi = args.ph_hi;
    constexpr int CVT_LIMIT_P2 = MOE_ITEMS * 35 / 100;
    if (hi - lo > 1) bar = xcd_barrier_post(ctl + CW_BAR, (volatile LAS unsigned*)(misc + 200));
#define IN(k) (lo <= (k) && (k) < hi)
#define SEAM(k) do { if (IN(k) && IN((k) + 1)) xcd_barrier(bar); } while (0)

    if (IN(0)) { p0_rows(args, lds, gw, NGW, tid, lane); p0_weights(args, lds, vcu, G, wave, lane); }
    SEAM(0);
    if (IN(1)) {
        p1_meta_rows(args, lds, bx, G, tid, wave, lane);
        pg8::PlainOrder S; S.init(NREAL, NPROJ, DM, args.ws + WS_WIN, G, bx); S.meta = 1;
        pg8::EpiBf16 E{(bf16_t*)(args.ws + WS_P), NPROJ, 1};
        pg8::gemm_phase<pg8::EpiBf16, pg8::PlainOrder, true, true>(lds, (const char*)(args.ws + WS_HN), DM * 2, S, E);
    }
    SEAM(1);
    if (IN(2)) {
        p2_qknorm(args, gw, NGW, lane);
        const bool roleB = (G >= 128) && (bx >= G - G / 8 * 3);
        if (roleB) moe_weights_queue<CVT_NLD_P2>(args, lds, misc + 212, tid, wave, lane, CVT_LIMIT_P2);
        unsigned xwp[33]; float gbp[2] = {0.f, 0.f};
        __syncthreads();
        if (tid == 0) misc[213] = (int)atomicAdd(ctl + CW_PREQ, 1u);
        __syncthreads();
        int it = *(volatile LAS int*)(misc + 213);
        gdn::prefetch_rows(args, it, lane, wave, xwp, gbp);
        while (it < 32 * gdn::NCH) {
            const int nclaim = (tid == 0) ? (int)atomicAdd(ctl + CW_PREQ, 1u) : 0;
            gdn::precompute(args, lds, it, tid, lane, wave, xwp, gbp, (volatile LAS int*)(misc + 215), nclaim);
            __syncthreads();
            it = *(volatile LAS int*)(misc + 215);
        }
        if (!roleB) moe_weights_queue<CVT_NLD_P2>(args, lds, misc + 212, tid, wave, lane, CVT_LIMIT_P2);
    }
    SEAM(2);
    if (IN(3)) {
        const int NG = (G >= 64) ? 32 : 0;
        if (bx < 32 || NG == 0) { for (int it = bx; it < 32; it += G) gdn::scan(args, lds, it, tid, lane, wave); }
        if (bx >= NG) { for (int u = bx - NG; u < 512; u += G - NG) sba::unit(args, lds, (volatile LAS int*)(misc + 210), u >> 7, (u >> 4) & 7, u & 15, tid, lane, wave); }
        moe_weights_queue(args, lds, misc + 212, tid, wave, lane, MOE_ITEMS);
    }
    SEAM(3);
    if (IN(4)) {
        pg8::PlainOrder S; S.init(NREAL, DM, DM, args.ws + WS_WOUT, G, bx);
        pg8::EpiResF32 E{args.in[I_X], args.out, DM};
        pg8::gemm_phase<pg8::EpiResF32, pg8::PlainOrder, true, true>(lds, (const char*)(args.ws + WS_MIX), DM * 2, S, E);
    }
    SEAM(4);
    if (IN(5)) p5_router(args, lds, G, bx, tid, lane, wave);
    SEAM(5);
    if (IN(6)) {
        {
        const int mt = moe_setup(args, misc, tid);
        pg8::MoeOrder<true> S; S.tpre = misc; S.tok = (const LAS int*)(lds + TOK_OFF); S.nN = 16; S.nwg = mt * 16; S.G = G; S.c = bx;
        S.Bt = (const char*)(args.ws + WS_WGU); S.estride = (size_t)2 * DE * DM; S.K2 = DM;
        const int* LIST = (const int*)(args.ws + WS_LIST);
        S.ud = misc + 140; S.fill_units(misc + 140, tid);
        __syncthreads();
        for (int idx = tid; idx < TOK_CAP * 256; idx += NTHREADS) { pg8::Unit u; if (!S.next(idx >> 8, u)) break;
            const int r = (u.pm - misc[u.e]) * 256 + (idx & 255); ((LAS int*)(lds + TOK_OFF))[idx] = r < misc[104 + u.e] ? LIST[(size_t)u.e * NREAL + r] : 0; }
        __syncthreads();
        pg8::EpiSwiGLU E{args.ws + WS_ACT, args.in[I_BGU]};
        pg8::gemm_phase<pg8::EpiSwiGLU, pg8::MoeOrder<true>, true, true, true>(lds, (const char*)(args.ws + WS_HN), DM, S, E);
        }
    }
    SEAM(6);
    if (IN(7)) {
        const int mt = moe_setup(args, misc, tid);
        pg8::MoeOrder<false> S; S.tpre = misc; S.tok = nullptr; S.nN = 8; S.nwg = mt * 8; S.G = G; S.c = bx;
        S.Bt = (const char*)(args.ws + WS_WD); S.estride = (size_t)DM * DE; S.K2 = DE;
        S.ud = misc + 140; S.fill_units(misc + 140, tid);
        __syncthreads();
        pg8::EpiBf16 E{(bf16_t*)(args.ws + WS_Y), DM, 0, args.in[I_BD]};
        pg8::gemm_phase<pg8::EpiBf16, pg8::MoeOrder<false>, true, true, true>(lds, (const char*)(args.ws + WS_ACT), DE, S, E);
    }
    SEAM(7);
    if (IN(8)) { (void)moe_setup(args, misc, tid); p8_combine(args, misc, gw, NGW, lane); }
#undef IN
#undef SEAM
}

extern "C" void kernel_launch(void* const* d_in, const int* in_sizes, int n_in, void* d_out, int out_size, void* d_ws, size_t ws_size, hipStream_t stream) {
    static int grid = 0;
    if (grid == 0) {
        if (n_in != 19 || out_size != NREAL * DM || ws_size < WS_END) { fprintf(stderr, "kernel_launch: unexpected shapes (n_in %d out %d ws %zu need %zu)\n", n_in, out_size, ws_size, (size_t)WS_END); grid = -1; return; }
        int dev = 0, cus = 0, per_cu = 0;
        if (hipGetDevice(&dev) != hipSuccess || hipDeviceGetAttribute(&cus, hipDeviceAttributeMultiprocessorCount, dev) != hipSuccess) { grid = -1; return; }
        if (hipFuncSetAttribute((const void*)hymba_fwd, hipFuncAttributeMaxDynamicSharedMemorySize, LDS_BYTES) != hipSuccess) { fprintf(stderr, "kernel_launch: hipFuncSetAttribute failed\n"); grid = -1; return; }
        if (hipOccupancyMaxActiveBlocksPerMultiprocessor(&per_cu, (const void*)hymba_fwd, NTHREADS, LDS_BYTES) != hipSuccess || per_cu < 1) { fprintf(stderr, "kernel_launch: occupancy query says %d\n", per_cu); grid = -1; return; }
        (void)hipGetLastError();
        grid = cus;
    }
    if (grid < 0) return;
    (void)hipMemsetAsync((char*)d_ws + WS_CTL, 0, CTL_ZERO_BYTES, stream);
    Args a{};
    for (int i = 0; i < 19; ++i) a.in[i] = (const float*)d_in[i];
    a.out = (float*)d_out; a.ws = (unsigned char*)d_ws;
#if MK_N_LAUNCHES == 1
    a.ph_lo = 0; a.ph_hi = NPH;
    hipLaunchKernelGGL(hymba_fwd, dim3(grid), dim3(NTHREADS), LDS_BYTES, stream, a);
#else
    for (int p = 0; p < NPH; ++p) { a.ph_lo = p; a.ph_hi = p + 1; hipLaunchKernelGGL(hymba_fwd, dim3(grid), dim3(NTHREADS), LDS_BYTES, stream, a); }
#endif
    const hipError_t le = hipPeekAtLastError();
    if (le != hipSuccess) fprintf(stderr, "kernel_launch: launch failed: %s\n", hipGetErrorName(le));
}
```

```cpp
#include <hip/hip_runtime.h>
#include <cstdio>
#include <cstdint>

#ifndef MK_N_LAUNCHES
#define MK_N_LAUNCHES 1
#endif

constexpr int NB = 4, SEQ = 4096, NMETA = 16, LSEQ = SEQ + NMETA;
constexpr int DM = 2048, NTOK = NB * LSEQ  , MPAD = 16640  , NREAL = NB * SEQ  ;
constexpr int NPROJ_SRC = 7184, NPROJ = 7168;
constexpr int NHEAD = 8, HD = 128;
constexpr int PC_QKV = 0, PC_Z = 3072, PC_SBQ = 4096, PC_SBK = 5120, PC_SBV = 6144;
constexpr int NEXP = 32, TOPK = 4, DE = 2048;
constexpr int SLOT_ROWS = 73728;
constexpr int LROW = 4224;
constexpr float NORM_EPS = 1e-6f;

constexpr size_t MiB = 1u << 20;
constexpr size_t WS_CTL = 0, CTL_ZERO_BYTES = 1 * MiB;
constexpr size_t WS_RSTD = 512 * 1024;
constexpr size_t WS_WIN = 1 * MiB;
constexpr size_t WS_WOUT = WS_WIN + (size_t)NPROJ * DM * 2;
constexpr size_t WS_WGU = WS_WOUT + (size_t)DM * DM * 2;
constexpr size_t WS_WD = WS_WGU + (size_t)NEXP * 2 * DE * DM * 2;
constexpr size_t WS_HN = WS_WD + (size_t)NEXP * DM * DE * 2;
constexpr size_t WS_BETA = WS_HN + (size_t)MPAD * DM * 2;
constexpr size_t WS_G = WS_BETA + (size_t)NTOK * 8 * 4 + 256;
constexpr size_t WS_P = WS_G + (size_t)NTOK * 8 * 4 + 256;
constexpr size_t WS_QN = WS_P + (size_t)MPAD * NPROJ * 2;
constexpr size_t WS_KN = WS_QN + (size_t)NB * NHEAD * LROW * HD * 2;
constexpr size_t WS_ORAW = WS_KN + (size_t)NB * NHEAD * LROW * HD * 2;
constexpr size_t WS_MIX = WS_ORAW + (size_t)NREAL * 1024 * 4;
constexpr size_t WS_RE = WS_MIX + (size_t)NREAL * DM * 2;
constexpr size_t WS_RP = WS_RE + (size_t)NREAL * 4 * 4;
constexpr size_t WS_RG = WS_RP + (size_t)NREAL * 4 * 4;
constexpr size_t WS_LIST = WS_RG + (size_t)NREAL * 4 * 4;
constexpr size_t WS_ACT = WS_LIST + (size_t)NEXP * NREAL * 4;
constexpr size_t WS_Y = WS_ACT + (size_t)SLOT_ROWS * DE * 2;
constexpr size_t WS_GCH = WS_Y + (size_t)SLOT_ROWS * DM * 2;
constexpr size_t WS_GL = WS_GCH + (size_t)32 * 65 * 73728;
constexpr size_t WS_END = WS_GL + 32 * 65 * 4 + 256;
constexpr int CW_ECNT = 64;
constexpr int CW_CVTQ = 192;
constexpr int CVT_NLD_P2 = 4;
constexpr int CW_PREQ = 256;
constexpr int CW_BAR = 4096;

constexpr int LDS_STAGE = 131072;
constexpr int TOK_OFF = LDS_STAGE, TOK_CAP = 22;
constexpr int MISC_OFF = TOK_OFF + TOK_CAP * 256 * 4;
constexpr int LDS_BYTES = MISC_OFF + 1024;

#define GAS __attribute__((address_space(1)))
#define LAS __attribute__((address_space(3)))
typedef unsigned short bf16_t;
typedef short bf16x8 __attribute__((ext_vector_type(8)));
typedef short s16x4 __attribute__((ext_vector_type(4)));
typedef float f32x4 __attribute__((ext_vector_type(4)));
typedef float f32x2 __attribute__((ext_vector_type(2)));
typedef float f32x16 __attribute__((ext_vector_type(16)));
typedef unsigned u32x4 __attribute__((ext_vector_type(4)));
typedef unsigned u32x2 __attribute__((ext_vector_type(2)));

typedef __bf16 bf16x2_t __attribute__((ext_vector_type(2)));
__device__ __forceinline__ unsigned cvt_pk_bf16(float lo, float hi) { const f32x2 v = {lo, hi}; const bf16x2_t b = __builtin_convertvector(v, bf16x2_t); return __builtin_bit_cast(unsigned, b); }
__device__ __forceinline__ unsigned pk4_fp8(float a, float b, float c, float d) { unsigned w = 0u; w = __builtin_amdgcn_cvt_pk_fp8_f32(a, b, w, false); w = __builtin_amdgcn_cvt_pk_fp8_f32(c, d, w, true); return w; }
__device__ __forceinline__ float bf_lo(unsigned w) { return __uint_as_float(w << 16); }
__device__ __forceinline__ float bf_hi(unsigned w) { return __uint_as_float(w & 0xffff0000u); }
__device__ __forceinline__ float bf2f(bf16_t b) { return __uint_as_float(((unsigned)b) << 16); }
template <int CTRL, int ROW_MASK> __device__ __forceinline__ float dpp_get(float v) {
    return __builtin_bit_cast(float, __builtin_amdgcn_update_dpp(0, __builtin_bit_cast(int, v), CTRL, ROW_MASK, 0xF, false));
}
__device__ __forceinline__ float row16_sum(float v) {
    v += dpp_get<0xB1, 0xF>(v);
    v += dpp_get<0x4E, 0xF>(v);
    v += dpp_get<0x141, 0xF>(v);
    v += dpp_get<0x140, 0xF>(v);
    return v;
}
__device__ __forceinline__ float quad_sum(float v) { v += dpp_get<0xB1, 0xF>(v); v += dpp_get<0x4E, 0xF>(v); return v; }
__device__ __forceinline__ float wave_sum(float v) {
    v = row16_sum(v);
    v += dpp_get<0x142, 0xA>(v);
    v += dpp_get<0x143, 0xC>(v);
    return __builtin_bit_cast(float, __builtin_amdgcn_readlane(__builtin_bit_cast(int, v), 63));
}

namespace pg8 {
constexpr int BM = 256, BK = 64, HALF = 128, HTB = HALF * BK * 2, STAGE_BYTES = 8 * HTB, NXCD = 8, WGM = 8;
__host__ __device__ __forceinline__ int lds_byte(int r, int c) { const int st = (r >> 4) * 2 + (c >> 5), rr = r & 15, cc = c & 31, ob = rr * 64 + cc * 2; return st * 1024 + (ob ^ (((ob >> 9) & 1) << 5)); }
__host__ __device__ __forceinline__ void stage_rc(int b, int& R, int& C) { const int st = b / 1024, sb = b % 1024, swz = sb ^ (((sb >> 9) & 1) << 5); R = (st >> 1) * 16 + swz / 64; C = (st & 1) * 32 + (swz % 64) / 2; }
__host__ __device__ __forceinline__ int perm32(int rho) { const int n = rho >> 4, i = rho & 15; return 8 * (i >> 2) + 4 * n + (i & 3); }

typedef int v8i __attribute__((ext_vector_type(8))); typedef int v4i __attribute__((ext_vector_type(4)));
__device__ __forceinline__ v8i cat8(bf16x8 lo, bf16x8 hi) { const v4i a = __builtin_bit_cast(v4i, lo), b = __builtin_bit_cast(v4i, hi); return __builtin_shufflevector(a, b, 0, 1, 2, 3, 4, 5, 6, 7); }
struct Unit { int pm, pn, e, ui; };

__device__ __forceinline__ int xcd_remap(int L, int nwg) { const int q = nwg / NXCD, r = nwg % NXCD, xcd = L % NXCD, off = L / NXCD; return (xcd < r ? xcd * (q + 1) : r * (q + 1) + (xcd - r) * q) + off; }

struct PlainOrder {
    int nM, nN, nwg, G, c; const char* Bt; unsigned K2;
    __device__ void init(int M, int N, int K, const void* Bt_, int G_, int c_) { nM = M / BM; nN = N / BM; nwg = nM * nN; G = G_; c = c_; Bt = (const char*)Bt_; K2 = (unsigned)K * 2u; }
    __device__ __forceinline__ bool next(int i, Unit& u) const {
        const long L = (long)i * G + c; if (L >= nwg) return false;
        const int wgid = xcd_remap((int)L, nwg);
        const int nig = WGM * nN, gid = wgid / nig, fm = gid * WGM, gsz = (nM - fm) < WGM ? (nM - fm) : WGM;
        u.pm = fm + ((wgid % nig) % gsz); u.pn = (wgid % nig) / gsz; u.e = 0; u.ui = i; return true;
    }
    __device__ __forceinline__ const char* b_ptr(const Unit& u) const { return Bt + (size_t)u.pn * BM * K2; }
    __device__ __forceinline__ unsigned a_off(const Unit& u, int r) const { return (unsigned)(u.pm * BM + r + (meta ? NMETA * ((u.pm >> 4) + 1) : 0)) * K2; }
    int meta = 0;
};
constexpr int UD_CAP = 24;
template <bool GATHER> struct MoeOrder {
    const LAS int* tpre; const LAS int* tok; const LAS int* ud; int nN, nwg, G, c; const char* Bt; size_t estride; unsigned K2;
    __device__ __forceinline__ int decode(int i) const {
        const long L = (long)i * G + c; if (L >= nwg) return -1;
        const int wgid = xcd_remap((int)L, nwg);
        int e = 0;
#pragma unroll 1
        for (int j = 1; j < NEXP; ++j) e = (wgid >= tpre[j] * nN) ? j : e;
        const int t0 = tpre[e], nt = tpre[e + 1] - t0, loc = wgid - t0 * nN;
        return e | ((t0 + loc % nt) << 6) | ((loc / nt) << 16);
    }
    __device__ __forceinline__ void fill_units(LAS int* udw, int tid) const { if (tid < UD_CAP) udw[tid] = decode(tid); }
    __device__ __forceinline__ bool next(int i, Unit& u) const {
        if (i >= UD_CAP) return false;
        const int d = ud[i]; if (d < 0) return false;
        u.e = d & 63; u.pm = (d >> 6) & 1023; u.pn = d >> 16; u.ui = i; return true;
    }
    __device__ __forceinline__ const char* b_ptr(const Unit& u) const { return Bt + (size_t)u.e * estride + (size_t)u.pn * BM * K2; }
    __device__ __forceinline__ unsigned a_off(const Unit& u, int r) const {
        if (GATHER) return (unsigned)(tok[u.ui * 256 + r] & 0x3fff) * K2;
        return (unsigned)(u.pm * BM + r) * K2;
    }
};

struct EpiBf16 {
    static constexpr bool PERM = true;
    bf16_t* O; int ldc; int meta; const float* ebias = nullptr;
    const float* rscale = nullptr;
    __device__ __forceinline__ void operator()(const f32x4 (&acc)[2][2][4][2], const Unit& u, int wr, int wc, int fr, int fq) const {
        const int row0 = u.pm * BM + wr * 64 + fr + (meta ? NMETA * ((u.pm >> 4) + 1) : 0), col0 = u.pn * BM + wc * 32 + 8 * fq;
        f32x4 bv[2][2];
#pragma unroll
        for (int bj = 0; bj < 2; ++bj)
#pragma unroll
            for (int n = 0; n < 2; ++n) bv[bj][n] = ebias ? *(const f32x4*)(ebias + (size_t)u.e * ldc + col0 + bj * HALF + 4 * n) : (f32x4){0.f, 0.f, 0.f, 0.f};
#pragma unroll
        for (int ai = 0; ai < 2; ++ai)
#pragma unroll
            for (int m = 0; m < 4; ++m) { bf16_t* rowp = O + (size_t)(row0 + ai * HALF + m * 16) * ldc + col0; const float rsc = rscale ? rscale[row0 + ai * HALF + m * 16] : 1.0f;
#pragma unroll
                for (int bj = 0; bj < 2; ++bj) { const f32x4 v0 = acc[ai][bj][m][0] * rsc + bv[bj][0], v1 = acc[ai][bj][m][1] * rsc + bv[bj][1];
                    u32x4 w; w.x = cvt_pk_bf16(v0[0], v0[1]); w.y = cvt_pk_bf16(v0[2], v0[3]); w.z = cvt_pk_bf16(v1[0], v1[1]); w.w = cvt_pk_bf16(v1[2], v1[3]);
                    *(u32x4*)(rowp + bj * HALF) = w; } }
    }
};
constexpr float Y8_SCALE = 16.0f;
struct EpiFp8Bias {
    static constexpr bool PERM = true;
    unsigned char* O; int ldc; const float* ebias;
    __device__ __forceinline__ void operator()(const f32x4 (&acc)[2][2][4][2], const Unit& u, int wr, int wc, int fr, int fq) const {
        const int row0 = u.pm * BM + wr * 64 + fr, col0 = u.pn * BM + wc * 32 + 8 * fq;
        f32x4 bv[2][2];
#pragma unroll
        for (int bj = 0; bj < 2; ++bj)
#pragma unroll
            for (int n = 0; n < 2; ++n) bv[bj][n] = *(const f32x4*)(ebias + (size_t)u.e * ldc + col0 + bj * HALF + 4 * n);
#pragma unroll
        for (int ai = 0; ai < 2; ++ai)
#pragma unroll
            for (int m = 0; m < 4; ++m) { unsigned char* rowp = O + (size_t)(row0 + ai * HALF + m * 16) * ldc + col0;
#pragma unroll
                for (int bj = 0; bj < 2; ++bj) { const f32x4 v0 = (acc[ai][bj][m][0] + bv[bj][0]) * Y8_SCALE, v1 = (acc[ai][bj][m][1] + bv[bj][1]) * Y8_SCALE;
                    u32x2 w; w.x = pk4_fp8(v0[0], v0[1], v0[2], v0[3]); w.y = pk4_fp8(v1[0], v1[1], v1[2], v1[3]);
                    *(u32x2*)(rowp + bj * HALF) = w; } }
    }
};
struct EpiResF32 {
    static constexpr bool PERM = false;
    const float* X; float* out; int ldc;
    __device__ __forceinline__ void operator()(const f32x4 (&acc)[2][2][4][2], const Unit& u, int wr, int wc, int fr, int fq) const {
        const int row0 = u.pm * BM + wr * 64 + fr, col0 = u.pn * BM + wc * 32 + 4 * fq;
#pragma unroll
        for (int ai = 0; ai < 2; ++ai) {
            f32x4 xv[4][2][2];
#pragma unroll
            for (int m = 0; m < 4; ++m) { const size_t off = (size_t)(row0 + ai * HALF + m * 16) * ldc + col0;
#pragma unroll
                for (int bj = 0; bj < 2; ++bj)
#pragma unroll
                    for (int n = 0; n < 2; ++n) xv[m][bj][n] = *(const f32x4*)(X + off + bj * HALF + n * 16); }
#pragma unroll
            for (int m = 0; m < 4; ++m) { const size_t off = (size_t)(row0 + ai * HALF + m * 16) * ldc + col0;
#pragma unroll
                for (int bj = 0; bj < 2; ++bj)
#pragma unroll
                    for (int n = 0; n < 2; ++n) *(f32x4*)(out + off + bj * HALF + n * 16) = xv[m][bj][n] + acc[ai][bj][m][n]; }
            asm volatile("" ::: "memory"); }
    }
};
__device__ __forceinline__ unsigned swiglu2_fp8(f32x2 g, f32x2 uu, unsigned w, bool hi) {
    g.x = fminf(g.x, 7.0f); g.y = fminf(g.y, 7.0f); uu.x = fminf(fmaxf(uu.x, -7.0f), 7.0f); uu.y = fminf(fmaxf(uu.y, -7.0f), 7.0f);
    const f32x2 t = g * (-1.702f * 1.4426950408889634f);
    f32x2 e; e.x = __builtin_amdgcn_exp2f(t.x); e.y = __builtin_amdgcn_exp2f(t.y);
    const f32x2 d = e + 1.0f;
    f32x2 r; r.x = __builtin_amdgcn_rcpf(d.x); r.y = __builtin_amdgcn_rcpf(d.y);
    const f32x2 o = (uu + 1.0f) * g * r;
    return hi ? __builtin_amdgcn_cvt_pk_fp8_f32(o.x, o.y, w, true) : __builtin_amdgcn_cvt_pk_fp8_f32(o.x, o.y, w, false);
}
struct EpiSwiGLU {
    static constexpr bool PERM = true;
    unsigned char* act; const float* bgu;
    const LAS int* tok;
    __device__ __forceinline__ void operator()(const f32x4 (&acc)[2][2][4][2], const Unit& u, int wr, int wc, int fr, int fq) const {
        const int row0 = u.pm * BM + wr * 64 + fr, col0 = u.pn * HALF + wc * 32 + 8 * fq;
        const float* bg = bgu + (size_t)u.e * 4096 + col0;
        const f32x4 bg0 = *(const f32x4*)(bg), bg1 = *(const f32x4*)(bg + 4), bu0 = *(const f32x4*)(bg + 2048), bu1 = *(const f32x4*)(bg + 2052);
#pragma unroll
        for (int ai = 0; ai < 2; ++ai)
#pragma unroll
            for (int m = 0; m < 4; ++m) { unsigned char* rowp = act + (size_t)(row0 + ai * HALF + m * 16) * DE + col0;
                const float rsc = __uint_as_float((unsigned)tok[u.ui * 256 + wr * 64 + fr + ai * HALF + m * 16] & 0xffffc000u);
                const f32x4 g0 = acc[ai][0][m][0] * rsc + bg0, g1 = acc[ai][0][m][1] * rsc + bg1, u0 = acc[ai][1][m][0] * rsc + bu0, u1 = acc[ai][1][m][1] * rsc + bu1;
                u32x2 w; w.x = swiglu2_fp8(g0.zw, u0.zw, swiglu2_fp8(g0.xy, u0.xy, 0u, false), true);
                w.y = swiglu2_fp8(g1.zw, u1.zw, swiglu2_fp8(g1.xy, u1.xy, 0u, false), true);
                *(u32x2*)rowp = w; }
    }
};

template <class Epi, class Sched, bool ALIGN_EPI, bool SP2, bool FP8 = false>
__device__ __forceinline__ void gemm_phase(LAS unsigned char* lds, const char* A0, int Kb, const Sched& S, const Epi& E) {
    const int tid = threadIdx.x, wid = __builtin_amdgcn_readfirstlane(tid >> 6), lane = tid & 63, wr = wid >> 2, wc = wid & 3, fr = lane & 15, fq = lane >> 4;
    const int nt = Kb / 128;
    int Rr[2], Cc[2]; unsigned voffB[2];
#pragma unroll
    for (int i = 0; i < 2; ++i) { int R, C; stage_rc(tid * 16 + i * 8192, R, C); const int Rb = Epi::PERM ? ((R & ~31) + perm32(R & 31)) : R;
        Rr[i] = R; Cc[i] = C * 2; voffB[i] = (unsigned)(Rb * Kb + C * 2); }
    const size_t kstep = (size_t)(BK * 2);
    const size_t hstep = (size_t)HALF * Kb;
    const unsigned ldsw = (unsigned)wid * 1024u;
    const int aoff = lds_byte(wr * 64 + fr, fq * 8), boff = lds_byte(wc * 32 + fr, fq * 8);
#define PG8_SA(b, h) (((b) * 2 + (h)) * HTB)
#define PG8_SB(b, h) ((4 + (b) * 2 + (h)) * HTB)
#define PG8_STAGE(bufoff, gbase, voff) do { _Pragma("unroll") for (int _i = 0; _i < 2; ++_i) \
        __builtin_amdgcn_global_load_lds((const unsigned*)((const char*)(gbase) + (voff)[_i]), (LAS unsigned*)(lds + (bufoff) + ldsw + _i * 8192), 16, 0, 0); } while (0)
#define PG8_LDA(dst, b, h) do { _Pragma("unroll") for (int m = 0; m < 4; ++m) _Pragma("unroll") for (int k = 0; k < 2; ++k) dst[m][k] = *(const LAS bf16x8*)(lds + PG8_SA(b, h) + aoff + m * 2048 + k * 1024); } while (0)
#define PG8_LDB(dst, b, h) do { _Pragma("unroll") for (int n = 0; n < 2; ++n) _Pragma("unroll") for (int k = 0; k < 2; ++k) dst[n][k] = *(const LAS bf16x8*)(lds + PG8_SB(b, h) + boff + n * 2048 + k * 1024); } while (0)
#define PG8_MMA(ai, bj, At, Bt) do { __builtin_amdgcn_s_setprio(1); _Pragma("unroll") for (int m = 0; m < 4; ++m) _Pragma("unroll") for (int n = 0; n < 2; ++n) { \
        if constexpr (FP8) acc[ai][bj][m][n] = __builtin_amdgcn_mfma_scale_f32_16x16x128_f8f6f4(cat8(Bt[n][0], Bt[n][1]), cat8(At[m][0], At[m][1]), acc[ai][bj][m][n], 0, 0, 0, 0x79797979, 0, 0x7f7f7f7f); \
        else { _Pragma("unroll") for (int k = 0; k < 2; ++k) acc[ai][bj][m][n] = __builtin_amdgcn_mfma_f32_16x16x32_bf16(Bt[n][k], At[m][k], acc[ai][bj][m][n], 0, 0, 0); } } \
        __builtin_amdgcn_s_setprio(0); } while (0)
#define PG8_WAIT_V(n) asm volatile("s_waitcnt vmcnt(" #n ")" ::: "memory")
#define PG8_WAIT_L(n) asm volatile("s_waitcnt lgkmcnt(" #n ")" ::: "memory")
#define PG8_BAR __builtin_amdgcn_s_barrier()
#define PG8_SCHED __builtin_amdgcn_sched_barrier(0)
#define PG8_VOFF(dst, u) do { _Pragma("unroll") for (int _h = 0; _h < 2; ++_h) _Pragma("unroll") for (int _i = 0; _i < 2; ++_i) dst[_h][_i] = S.a_off(u, _h * HALF + Rr[_i]) + (unsigned)Cc[_i]; } while (0)
    Unit cur, nxt; int ui = 0;
    if (!S.next(0, cur)) return;
    f32x4 acc[2][2][4][2];
#pragma unroll
    for (int a = 0; a < 2; ++a)
#pragma unroll
        for (int b = 0; b < 2; ++b)
#pragma unroll
            for (int m = 0; m < 4; ++m)
#pragma unroll
                for (int n = 0; n < 2; ++n) acc[a][b][m][n] = (f32x4){0.f, 0.f, 0.f, 0.f};
    bf16x8 At[4][2], B0[2][2], B1[2][2];
    unsigned va[2][2], vn[2][2];
    PG8_VOFF(va, cur);
    const char* cB = S.b_ptr(cur);
    if constexpr (SP2) {
        PG8_STAGE(PG8_SB(0, 0), cB, voffB); PG8_STAGE(PG8_SB(0, 1), cB + hstep, voffB); PG8_STAGE(PG8_SA(0, 0), A0, va[0]); PG8_STAGE(PG8_SA(0, 1), A0, va[1]);
        if (wr == 1) PG8_BAR;
        PG8_WAIT_V(2); PG8_BAR;
        PG8_STAGE(PG8_SB(1, 0), cB + kstep, voffB); PG8_STAGE(PG8_SA(1, 0), A0 + kstep, va[0]); PG8_STAGE(PG8_SB(1, 1), cB + hstep + kstep, voffB);
        PG8_WAIT_V(6); PG8_BAR;
    } else {
        PG8_STAGE(PG8_SB(0, 0), cB, voffB); PG8_STAGE(PG8_SA(0, 0), A0, va[0]); PG8_STAGE(PG8_SB(0, 1), cB + hstep, voffB); PG8_STAGE(PG8_SA(0, 1), A0, va[1]);
        if (wr == 1) PG8_BAR;
        PG8_WAIT_V(4); PG8_BAR;
        PG8_STAGE(PG8_SB(1, 0), cB + kstep, voffB); PG8_STAGE(PG8_SA(1, 0), A0 + kstep, va[0]); PG8_STAGE(PG8_SB(1, 1), cB + hstep + kstep, voffB);
        PG8_WAIT_V(6); PG8_BAR;
    }
    for (;;) {
        const bool has_next = S.next(ui + 1, nxt);
        const char* nB = has_next ? S.b_ptr(nxt) : cB;
        for (int t = 0; t < nt; t += 2) {
            const bool last = (t == nt - 2);
            const char* a1 = A0 + (size_t)(t + 1) * kstep;
            const char* a2 = last ? A0 : A0 + (size_t)(t + 2) * kstep; const char* b2 = last ? nB : cB + (size_t)(t + 2) * kstep;
            const char* a3 = a2 + kstep; const char* b3 = b2 + kstep;
            if (last) { if (has_next) { PG8_VOFF(vn, nxt); } else {
#pragma unroll
                    for (int _h = 0; _h < 2; ++_h)
#pragma unroll
                        for (int _i = 0; _i < 2; ++_i) vn[_h][_i] = va[_h][_i]; } }
            if constexpr (SP2) {
            PG8_LDB(B0, 0, 0); PG8_LDB(B1, 0, 1); PG8_SCHED; PG8_LDA(At, 0, 0); PG8_STAGE(PG8_SA(1, 1), a1, va[1]);
            if (last) {
#pragma unroll
                for (int _h = 0; _h < 2; ++_h)
#pragma unroll
                    for (int _i = 0; _i < 2; ++_i) va[_h][_i] = vn[_h][_i]; }
            PG8_WAIT_V(8); PG8_WAIT_L(0); PG8_BAR; PG8_MMA(0, 0, At, B0); PG8_MMA(0, 1, At, B1); PG8_BAR; PG8_SCHED;
            PG8_LDA(At, 0, 1); PG8_STAGE(PG8_SB(0, 0), b2, voffB); PG8_STAGE(PG8_SB(0, 1), b2 + hstep, voffB); PG8_STAGE(PG8_SA(0, 0), a2, va[0]);
            PG8_WAIT_V(8); PG8_WAIT_L(0); PG8_BAR; PG8_MMA(1, 0, At, B0); PG8_MMA(1, 1, At, B1); PG8_BAR; PG8_SCHED;
            PG8_LDB(B0, 1, 0); PG8_LDB(B1, 1, 1); PG8_SCHED; PG8_LDA(At, 1, 0); PG8_STAGE(PG8_SA(0, 1), a2, va[1]);
            PG8_WAIT_V(8); PG8_WAIT_L(0); PG8_BAR; PG8_MMA(0, 0, At, B0); PG8_MMA(0, 1, At, B1); PG8_BAR; PG8_SCHED;
            PG8_LDA(At, 1, 1); PG8_STAGE(PG8_SB(1, 0), b3, voffB); PG8_STAGE(PG8_SB(1, 1), b3 + hstep, voffB); PG8_STAGE(PG8_SA(1, 0), a3, va[0]);
            PG8_WAIT_V(8); PG8_WAIT_L(0); PG8_BAR; PG8_MMA(1, 0, At, B0); PG8_MMA(1, 1, At, B1); PG8_BAR; PG8_SCHED;
            } else {
            PG8_LDB(B0, 0, 0); PG8_SCHED; PG8_LDA(At, 0, 0); PG8_STAGE(PG8_SA(1, 1), a1, va[1]);
            if (last) {
#pragma unroll
                for (int _h = 0; _h < 2; ++_h)
#pragma unroll
                    for (int _i = 0; _i < 2; ++_i) va[_h][_i] = vn[_h][_i]; }
            PG8_WAIT_L(8); PG8_BAR; PG8_WAIT_L(0); PG8_MMA(0, 0, At, B0); PG8_BAR; PG8_SCHED;
            PG8_LDB(B1, 0, 1); PG8_STAGE(PG8_SB(0, 0), b2, voffB);
            PG8_BAR; PG8_WAIT_L(0); PG8_MMA(0, 1, At, B1); PG8_BAR;
            PG8_LDA(At, 0, 1); PG8_STAGE(PG8_SA(0, 0), a2, va[0]);
            PG8_BAR; PG8_WAIT_L(0); PG8_MMA(1, 0, At, B0); PG8_BAR; PG8_SCHED;
            PG8_STAGE(PG8_SB(0, 1), b2 + hstep, voffB);
            PG8_WAIT_V(6); PG8_BAR; PG8_MMA(1, 1, At, B1); PG8_BAR;
            PG8_LDB(B0, 1, 0); PG8_SCHED; PG8_LDA(At, 1, 0); PG8_STAGE(PG8_SA(0, 1), a2, va[1]);
            PG8_WAIT_L(8); PG8_BAR; PG8_WAIT_L(0); PG8_MMA(0, 0, At, B0); PG8_BAR; PG8_SCHED;
            PG8_LDB(B1, 1, 1); PG8_STAGE(PG8_SB(1, 0), b3, voffB);
            PG8_BAR; PG8_WAIT_L(0); PG8_MMA(0, 1, At, B1); PG8_BAR;
            PG8_LDA(At, 1, 1); PG8_STAGE(PG8_SA(1, 0), a3, va[0]);
            PG8_BAR; PG8_WAIT_L(0); PG8_MMA(1, 0, At, B0); PG8_BAR; PG8_SCHED;
            PG8_STAGE(PG8_SB(1, 1), b3 + hstep, voffB);
            PG8_WAIT_V(6); PG8_BAR; PG8_MMA(1, 1, At, B1); PG8_BAR;
            }
        }
        if constexpr (ALIGN_EPI) { if (wr == 0) PG8_BAR; }
        E(acc, cur, wr, wc, fr, fq);
        if (!has_next) break;
#pragma unroll
        for (int a = 0; a < 2; ++a)
#pragma unroll
            for (int b = 0; b < 2; ++b)
#pragma unroll
                for (int m = 0; m < 4; ++m)
#pragma unroll
                    for (int n = 0; n < 2; ++n) acc[a][b][m][n] = (f32x4){0.f, 0.f, 0.f, 0.f};
        cur = nxt; cB = nB; ++ui;
        if constexpr (ALIGN_EPI) { if (wr == 1) PG8_BAR; }
    }
    PG8_WAIT_V(0);
    if constexpr (!ALIGN_EPI) { if (wr == 0) PG8_BAR; }
    PG8_BAR;
#undef PG8_SA
#undef PG8_SB
#undef PG8_STAGE
#undef PG8_LDA
#undef PG8_LDB
#undef PG8_MMA
#undef PG8_WAIT_V
#undef PG8_WAIT_L
#undef PG8_BAR
#undef PG8_SCHED
#undef PG8_VOFF
}
}

#define XB_TMO      128
#define XB_XCNT(j)  (256  + 64 * (j))
#define XB_XSUB(j)  (1280 + 64 * (j))
#define XB_XGEN(j)  (2304 + 64 * (j))
#define XB_TOP      3328
#define XB_TOPGEN   3392
#define XCD_BAR_WORDS 3456
#define XB_SPIN_CAP (1u << 18)

__device__ __forceinline__ unsigned xb_ld(unsigned* p)              { return __hip_atomic_load(p, __ATOMIC_RELAXED, __HIP_MEMORY_SCOPE_AGENT); }
__device__ __forceinline__ unsigned xb_add(unsigned* p, unsigned v) { return __hip_atomic_fetch_add(p, v, __ATOMIC_RELAXED, __HIP_MEMORY_SCOPE_AGENT); }
__device__ __forceinline__ unsigned xb_xcc_id() { return (unsigned)__builtin_amdgcn_s_getreg((3 << 11) | 20) & 0xFu; }
#define XB_SPIN(cond, bar) do { unsigned _sp = 0; while (cond) { __builtin_amdgcn_s_sleep(1); \
    if ((++_sp & 255u) == 0u) { if (xb_ld(&(bar)[XB_TMO])) break; if (_sp > XB_SPIN_CAP) { atomicAdd(&(bar)[XB_TMO], 1u); break; } } } } while (0)

struct XcdBarrier {
    unsigned* bar; unsigned x;
    volatile LAS unsigned* st;
};
__device__ __forceinline__ XcdBarrier xcd_barrier_post(unsigned* bar, volatile LAS unsigned* st) {
    XcdBarrier b; b.bar = bar; b.x = xb_xcc_id(); b.st = st;
    if (threadIdx.x == 0) (void)xb_add(&bar[XB_XCNT(b.x)], 1u);
    return b;
}
__device__ __forceinline__ void xcd_barrier_complete(unsigned* bar, unsigned x, unsigned& nloc, unsigned& nx) {
    const unsigned G = gridDim.x * gridDim.y * gridDim.z;
    unsigned sum, cnt, mine, sp = 0u;
    for (;;) {
        sum = 0u; cnt = 0u; mine = 0u;
#pragma unroll
        for (unsigned j = 0; j < 16; ++j) { const unsigned c = xb_ld(&bar[XB_XCNT(j)]); sum += c; cnt += (c > 0u) ? 1u : 0u; mine = (j == x) ? c : mine; }
        if (sum == G) break;
        __builtin_amdgcn_s_sleep(1);
        if ((++sp & 255u) == 0u) { if (xb_ld(&bar[XB_TMO])) break; if (sp > XB_SPIN_CAP) { atomicAdd(&bar[XB_TMO], 1u); break; } }
    }
    nloc = mine > 0u ? mine : 1u; nx = cnt > 0u ? cnt : 1u;
}
__device__ __forceinline__ void xcd_barrier(const XcdBarrier& b) {
    asm volatile("s_waitcnt vmcnt(0)" ::: "memory");
    __syncthreads();
    if (threadIdx.x == 0) {
        unsigned* bar = b.bar;
        __builtin_amdgcn_s_waitcnt(0);
        unsigned nloc = b.st[0], nx = b.st[1];
        if (nloc == 0u) { xcd_barrier_complete(bar, b.x, nloc, nx); b.st[0] = nloc; b.st[1] = nx; }
        const unsigned old = xb_add(&bar[XB_XSUB(b.x)], 1u);
        const unsigned gen = old / nloc;
        if (old + 1u == (gen + 1u) * nloc) {
            __builtin_amdgcn_fence(__ATOMIC_RELEASE, "agent");
            asm volatile("s_waitcnt vmcnt(0)" ::: "memory");
            const unsigned og = xb_add(&bar[XB_TOP], 1u);
            const unsigned tg = og / nx;
            if (og + 1u == (tg + 1u) * nx) xb_add(&bar[XB_TOPGEN], 1u);
            else XB_SPIN(xb_ld(&bar[XB_TOPGEN]) == tg, bar);
            __builtin_amdgcn_fence(__ATOMIC_ACQUIRE, "agent");
            xb_add(&bar[XB_XGEN(b.x)], 1u);
            asm volatile("s_waitcnt vmcnt(0)" ::: "memory");
        } else {
            XB_SPIN(xb_ld(&bar[XB_XGEN(b.x)]) == gen, bar);
            __builtin_amdgcn_fence(__ATOMIC_ACQUIRE, "agent");
            asm volatile("s_waitcnt vmcnt(0)" ::: "memory");
        }
    }
    __syncthreads();
}

constexpr int NWAVES = 8, NTHREADS = 512;
struct Args { const float* in[19]; float* out; unsigned char* ws; int ph_lo, ph_hi; };
enum { I_X = 0, I_META, I_MIXNW, I_WIN, I_CONVW, I_ALOG, I_DTB, I_GDNNW, I_SBQNW, I_SBKNW, I_SBONW, I_WOUT, I_FFNNW, I_RW, I_RB, I_WGU, I_BGU, I_WD, I_BD };

#define LDS_WAIT() asm volatile("s_waitcnt lgkmcnt(0)" ::: "memory")
#define VM_WAIT() asm volatile("s_waitcnt vmcnt(0)" ::: "memory")
constexpr int WLS = 2052;

__device__ __forceinline__ void dot16(const f32x4 (&v)[8], const LAS float* wl, int lane, float (&s)[16]) {
#pragma unroll
    for (int c = 0; c < 16; ++c) { float a = 0.f;
#pragma unroll
        for (int j = 0; j < 8; ++j) { const f32x4 w = *(const LAS f32x4*)(wl + c * WLS + 4 * lane + 256 * j); a += (v[j].x * w.x + v[j].y * w.y) + (v[j].z * w.z + v[j].w * w.w); }
        s[c] = wave_sum(a); }
}

template <int NR> __device__ __forceinline__ void dot8xN(const f32x4 (&v)[NR][8], const LAS float* wl, int lane, float (&out)[NR][8]) {
#pragma unroll
    for (int c = 0; c < 8; ++c) { float a[NR];
#pragma unroll
        for (int k = 0; k < NR; ++k) a[k] = 0.f;
#pragma unroll
        for (int j = 0; j < 8; ++j) { const f32x4 w = *(const LAS f32x4*)(wl + c * WLS + 4 * lane + 256 * j);
#pragma unroll
            for (int k = 0; k < NR; ++k) a[k] += (v[k][j].x * w.x + v[k][j].y * w.y) + (v[k][j].z * w.z + v[k][j].w * w.w); }
#pragma unroll
        for (int k = 0; k < NR; ++k) out[k][c] = wave_sum(a[k]); }
}
__device__ __forceinline__ void stage_w16(LAS float* wl, const float* base, int ld, int coloff, int tid) {
    f32x4 v[16];
#pragma unroll
    for (int i = 0; i < 16; ++i) { const int idx = tid + i * NTHREADS, k = idx >> 2, q = idx & 3; v[i] = *(const f32x4*)(base + (size_t)k * ld + coloff + 4 * q); }
#pragma unroll
    for (int i = 0; i < 16; ++i) { const int idx = tid + i * NTHREADS, k = idx >> 2, q = idx & 3;
        wl[(4 * q + 0) * WLS + k] = v[i].x; wl[(4 * q + 1) * WLS + k] = v[i].y; wl[(4 * q + 2) * WLS + k] = v[i].z; wl[(4 * q + 3) * WLS + k] = v[i].w; }
}

constexpr int XROW = 1040;
constexpr int XBUF = 64 * XROW;
constexpr int P5_LG = 2 * XBUF, P5_RS = P5_LG + 64 * 33 * 4, P5_WN = P5_RS + 512, P5_SSP = 65536;
__device__ __forceinline__ void p0_beta_g(float braw, float araw, float alog, float dtb, float& beta, float& g) {
    beta = 1.0f / (1.0f + expf(-braw));
    const float xa = araw + dtb; const float sp = fmaxf(xa, 0.f) + log1pf(expf(-fabsf(xa)));
    g = -expf(alog) * sp;
}
__device__ __forceinline__ void p0_rows(const Args& a, LAS unsigned char* lds, int G, int c, int tid) {
    const float* x = a.in[I_X]; const float* meta = a.in[I_META]; const float* nw = a.in[I_MIXNW]; const float* win = a.in[I_WIN];
    bf16_t* HN = (bf16_t*)(a.ws + WS_HN); float* BETA = (float*)(a.ws + WS_BETA); float* GG = (float*)(a.ws + WS_G);
    LAS float* ba = (LAS float*)(lds + P5_LG);
    LAS float* rs = (LAS float*)(lds + P5_RS);
    for (int blk = c; blk < NREAL / 64; blk += G) {
        asm volatile("" : "+v"(tid));
        const int wv = __builtin_amdgcn_readfirstlane(tid >> 6), lane = tid & 63, i16 = lane & 15, kq = lane >> 4;
        __syncthreads();
        const char* xg = (const char*)(x + (size_t)blk * 64 * DM) + lane * 16;
        const int rowbase = (blk * 64 / SEQ) * LSEQ + NMETA + (blk * 64) % SEQ;
#define P0_DMA(ch, b) do { _Pragma("unroll") for (int _r = 0; _r < 8; ++_r) \
        __builtin_amdgcn_global_load_lds((const unsigned*)(xg + (size_t)(wv * 8 + _r) * (DM * 4) + (ch) * 1024), (LAS unsigned*)(lds + (b) * XBUF + (wv * 8 + _r) * XROW), 16, 0, 0); } while (0)
        P0_DMA(0, 0); P0_DMA(1, 1);
        float Bv[8][8];
        unsigned kob = (unsigned)(32 * wv + 8 * kq) * 4u, lob = (unsigned)((32 * wv + 8 * kq) * NPROJ_SRC + 4096 + i16) * 4u; asm volatile("" : "+v"(kob), "+v"(lob));
        f32x4 w4[8][2];
        { float raw[8][8];
#pragma unroll
            for (int ch = 0; ch < 8; ++ch) {
#pragma unroll
                for (int q = 0; q < 2; ++q) w4[ch][q] = *(const f32x4*)((const char*)nw + (kob + (unsigned)((256 * ch + 4 * q) * 4)));
#pragma unroll
                for (int j = 0; j < 8; ++j) raw[ch][j] = *(const float*)((const char*)win + (lob + (unsigned)((256 * ch + j) * NPROJ_SRC * 4))); }
            __builtin_amdgcn_sched_barrier(0);
#pragma unroll
            for (int ch = 0; ch < 8; ++ch)
#pragma unroll
                for (int j = 0; j < 8; ++j) Bv[ch][j] = raw[ch][j] * w4[ch][j >> 2][j & 3];
            __builtin_amdgcn_sched_barrier(0); }
        f32x4 acc[4]; float ss[4];
#pragma unroll
        for (int rb = 0; rb < 4; ++rb) { acc[rb] = (f32x4){0.f, 0.f, 0.f, 0.f}; ss[rb] = 0.f; }
        asm volatile("s_waitcnt vmcnt(0)" ::: "memory");
#pragma unroll
        for (int ch = 0; ch < 8; ++ch) {
            if (ch == 7) asm volatile("s_waitcnt vmcnt(8)" ::: "memory"); else if (ch >= 1) asm volatile("s_waitcnt vmcnt(16)" ::: "memory");
            __builtin_amdgcn_s_barrier();
            const LAS unsigned char* xb = lds + (ch & 1) * XBUF + i16 * XROW + (32 * wv + 8 * kq) * 4;
            f32x4 av[4][2];
#pragma unroll
            for (int rb = 0; rb < 4; ++rb) { av[rb][0] = *(const LAS f32x4*)(xb + rb * 16 * XROW); av[rb][1] = *(const LAS f32x4*)(xb + rb * 16 * XROW + 16); }
            asm volatile("s_waitcnt lgkmcnt(0)" ::: "memory");
            __builtin_amdgcn_s_barrier();
            if (ch + 2 < 8) P0_DMA(ch + 2, ch & 1);
            __builtin_amdgcn_sched_barrier(0);
#pragma unroll
            for (int rb = 0; rb < 4; ++rb) { const f32x4 y0 = av[rb][0] * w4[ch][0], y1 = av[rb][1] * w4[ch][1];
                u32x4 ov; ov.x = cvt_pk_bf16(y0.x, y0.y); ov.y = cvt_pk_bf16(y0.z, y0.w); ov.z = cvt_pk_bf16(y1.x, y1.y); ov.w = cvt_pk_bf16(y1.z, y1.w);
                *(u32x4*)(HN + (size_t)(rowbase + 16 * rb + i16) * DM + 256 * ch + 32 * wv + 8 * kq) = ov; }
            __builtin_amdgcn_sched_barrier(0);
#pragma unroll
            for (int j = 0; j < 8; ++j)
#pragma unroll
                for (int rb = 0; rb < 4; ++rb) { const float xv = av[rb][j >> 2][j & 3];
                    ss[rb] += xv * xv; acc[rb] = __builtin_amdgcn_mfma_f32_16x16x4f32(xv, Bv[ch][j], acc[rb], 0, 0, 0); }
            __builtin_amdgcn_sched_barrier(0);
        }
#undef P0_DMA
        __builtin_amdgcn_s_barrier();
        { LAS float* red = (LAS float*)lds; LAS float* ssp = (LAS float*)(lds + 32768);
#pragma unroll
            for (int rb = 0; rb < 4; ++rb) {
#pragma unroll
                for (int v = 0; v < 4; ++v) red[(wv * 64 + 16 * rb + 4 * kq + v) * 16 + i16] = acc[rb][v];
                ssp[(wv * 4 + kq) * 64 + 16 * rb + i16] = ss[rb]; }
            __syncthreads();
            if (tid < 64) { float s2 = 0.f;
#pragma unroll
                for (int q = 0; q < 32; ++q) s2 += ssp[q * 64 + tid];
                const float rstd = 1.0f / sqrtf(s2 * (1.0f / DM) + NORM_EPS); rs[tid] = rstd; ((float*)(a.ws + WS_RSTD))[rowbase + tid] = rstd; }
            { const int t = tid >> 3, hh = tid & 7; float sb = 0.f, sa = 0.f;
#pragma unroll
                for (int w2 = 0; w2 < 8; ++w2) { sb += red[(w2 * 64 + t) * 16 + hh]; sa += red[(w2 * 64 + t) * 16 + 8 + hh]; }
                ba[t * 17 + hh] = sb; ba[t * 17 + 8 + hh] = sa; } }
        __syncthreads();
        { const int t = tid >> 3, hh = tid & 7; const float rstd = rs[t]; float beta, g;
            p0_beta_g(ba[t * 17 + hh] * rstd, ba[t * 17 + 8 + hh] * rstd, a.in[I_ALOG][hh], a.in[I_DTB][hh], beta, g);
            const int gr = blk * 64 + t, b = gr / SEQ, row = b * LSEQ + NMETA + (gr - b * SEQ);
            BETA[(size_t)row * 8 + hh] = beta; GG[(size_t)row * 8 + hh] = g; }
    }
    { asm volatile("" : "+v"(tid)); const int wv = __builtin_amdgcn_readfirstlane(tid >> 6), lane = tid & 63;
        if (wv == 7) for (int t = c; t < NMETA; t += G) {
            f32x4 v[8]; float ssm = 0.f;
#pragma unroll
            for (int j = 0; j < 8; ++j) { v[j] = *((const f32x4*)(meta + (size_t)t * DM) + lane + 64 * j); ssm += (v[j].x * v[j].x + v[j].y * v[j].y) + (v[j].z * v[j].z + v[j].w * v[j].w); }
            const float rstd = 1.0f / sqrtf(wave_sum(ssm) * (1.0f / DM) + NORM_EPS);
            GAS unsigned long long* o8 = (GAS unsigned long long*)(HN + (size_t)t * DM) + lane;
            float dsum[16];
#pragma unroll
            for (int n = 0; n < 16; ++n) dsum[n] = 0.f;
#pragma unroll
            for (int j = 0; j < 8; ++j) { const f32x4 y = v[j] * rstd * *((const f32x4*)nw + lane + 64 * j);
                o8[64 * j] = (unsigned long long)cvt_pk_bf16(y.x, y.y) | ((unsigned long long)cvt_pk_bf16(y.z, y.w) << 32);
#pragma unroll
                for (int kk = 0; kk < 4; ++kk) { const float* wr = win + (size_t)(4 * lane + 256 * j + kk) * NPROJ_SRC + 4096;
#pragma unroll
                    for (int q = 0; q < 4; ++q) { const f32x4 w = *(const f32x4*)(wr + 4 * q);
                        dsum[4 * q + 0] += y[kk] * w.x; dsum[4 * q + 1] += y[kk] * w.y; dsum[4 * q + 2] += y[kk] * w.z; dsum[4 * q + 3] += y[kk] * w.w; } } }
            float mine_b = 0.f, mine_a = 0.f; const int hh = lane & 7;
#pragma unroll
            for (int n = 0; n < 8; ++n) { const float sb = wave_sum(dsum[n]), sa = wave_sum(dsum[8 + n]); mine_b = (hh == n) ? sb : mine_b; mine_a = (hh == n) ? sa : mine_a; }
            if (lane < 32) { float beta, g; p0_beta_g(mine_b, mine_a, a.in[I_ALOG][hh], a.in[I_DTB][hh], beta, g);
                const int row = (lane >> 3) * LSEQ + t; BETA[(size_t)row * 8 + hh] = beta; GG[(size_t)row * 8 + hh] = g; } } }
    __syncthreads();
}

constexpr int CVT_STR = 132;
template <int MODE  >
__device__ __forceinline__ void cvt_tile(const float* W, int ldw, int K, bf16_t* out, int kb, int nt, LAS unsigned char* T, int lane) {
    const int r0 = nt * 64;
    int c0;
    if (MODE == 0) c0 = r0;
    else if (MODE == 1) c0 = r0 < 4096 ? r0 : r0 + 16;
    else { const int pn = r0 >> 8, rr = r0 & 255; c0 = rr < 128 ? 128 * pn + rr : 2048 + 128 * pn + (rr - 128); }
    const int kq = lane >> 4, nl = lane & 15;
    const float* src = W + (size_t)(kb * 64 + 2 * kq) * ldw + c0 + 4 * nl;
    f32x4 v[8][2];
#pragma unroll
    for (int i = 0; i < 8; ++i)
#pragma unroll
        for (int j = 0; j < 2; ++j) v[i][j] = *(const f32x4*)(src + (size_t)(8 * i + j) * ldw);
    LAS unsigned char* tw = T + (4 * nl) * CVT_STR + 4 * kq;
#pragma unroll
    for (int i = 0; i < 8; ++i)
#pragma unroll
        for (int q = 0; q < 4; ++q) *(LAS unsigned*)(tw + q * CVT_STR + 16 * i) = cvt_pk_bf16(v[i][0][q], v[i][1][q]);
    LDS_WAIT();
    const int rn = lane >> 3, cc = lane & 7;
    const LAS unsigned char* tr = T + rn * CVT_STR + 16 * cc;
    bf16_t* dst = out + (size_t)(r0 + rn) * K + kb * 64 + 8 * cc;
#pragma unroll
    for (int j = 0; j < 8; ++j) { u32x4 w; const LAS unsigned* p = (const LAS unsigned*)(tr + 8 * j * CVT_STR); w.x = p[0]; w.y = p[1]; w.z = p[2]; w.w = p[3];
        *(u32x4*)(dst + (size_t)(8 * j) * K) = w; }
    LDS_WAIT();
}
constexpr float W8_SCALE = 64.0f;
template <int MODE, int NLD = 8>
__device__ __forceinline__ void cvt_tile_fp8(const float* W, int ldw, int K, unsigned char* out, int kb, int nt, LAS unsigned char* T, int lane) {
    const int r0 = nt * 64;
    int c0;
    if (MODE == 0) c0 = r0;
    else { const int pn = r0 >> 8, rr = r0 & 255; c0 = rr < 128 ? 128 * pn + rr : 2048 + 128 * pn + (rr - 128); }
    const int kq = lane >> 4, nl = lane & 15;
    LAS unsigned char* tw = T + (4 * nl) * CVT_STR + 4 * kq;
    const float* src = W + (size_t)(kb * 128 + 4 * kq) * ldw + c0 + 4 * nl;
#pragma unroll
    for (int i0 = 0; i0 < 8; i0 += NLD) {
        f32x4 v[NLD][4];
#pragma unroll
        for (int i = 0; i < NLD; ++i)
#pragma unroll
            for (int j = 0; j < 4; ++j) v[i][j] = *(const f32x4*)(src + (size_t)(16 * (i0 + i) + j) * ldw);
#pragma unroll
        for (int i = 0; i < NLD; ++i)
#pragma unroll
            for (int q = 0; q < 4; ++q) *(LAS unsigned*)(tw + q * CVT_STR + 16 * (i0 + i)) =
                pk4_fp8(v[i][0][q] * W8_SCALE, v[i][1][q] * W8_SCALE, v[i][2][q] * W8_SCALE, v[i][3][q] * W8_SCALE);
    }
    LDS_WAIT();
    const int rn = lane >> 3, cc = lane & 7;
    const LAS unsigned char* tr = T + rn * CVT_STR + 16 * cc;
    unsigned char* dst = out + (size_t)(r0 + rn) * K + kb * 128 + 16 * cc;
#pragma unroll
    for (int j = 0; j < 8; ++j) { u32x4 w; const LAS unsigned* p = (const LAS unsigned*)(tr + 8 * j * CVT_STR); w.x = p[0]; w.y = p[1]; w.z = p[2]; w.w = p[3];
        *(u32x4*)(dst + (size_t)(8 * j) * K) = w; }
    LDS_WAIT();
}
__device__ __forceinline__ void p0_weights(const Args& a, LAS unsigned char* lds, int vcu, int G, int wave, int lane) {
    constexpr int I_IN = 32 * 14, I_OUT = 32 * 4;
    constexpr int NITEMS = I_IN + I_OUT;
    LAS unsigned char* T = lds + wave * (64 * CVT_STR);
    for (int it = vcu; it < NITEMS; it += G) {
        int r = it;
        if (r < I_IN) { cvt_tile<1>(a.in[I_WIN], NPROJ_SRC, DM, (bf16_t*)(a.ws + WS_WIN), r / 14, (r % 14) * 8 + wave, T, lane); continue; } r -= I_IN;
        cvt_tile<0>(a.in[I_WOUT], DM, DM, (bf16_t*)(a.ws + WS_WOUT), r / 4, (r % 4) * 8 + wave, T, lane);
    }
}
constexpr int MOE_I_GU = 8 * 4, MOE_I_D = 4 * 4, MOE_ITEMS = NEXP * (MOE_I_GU + MOE_I_D);
template <int NLD = 8> __device__ __forceinline__ void moe_weights_queue(const Args& a, LAS unsigned char* lds, LAS int* qslot, int tid, int wave, int lane, int limit) {
    unsigned* ctr = (unsigned*)(a.ws + WS_CTL) + CW_CVTQ;
    LAS unsigned char* T = lds + wave * (64 * CVT_STR);
    for (;;) {
        __syncthreads();
        if (tid == 0) { int v = (int)__hip_atomic_load(ctr, __ATOMIC_RELAXED, __HIP_MEMORY_SCOPE_AGENT); v = (v < limit) ? (int)atomicAdd(ctr, 1u) : MOE_ITEMS; *qslot = v; }
        __syncthreads();
        const int it = *(volatile LAS int*)qslot;
        if (it >= MOE_ITEMS) break;
        if (it < NEXP * MOE_I_GU) { const int e = it / MOE_I_GU, q = it % MOE_I_GU, ng = q & 7, kq = q >> 3;
#pragma unroll 1
            for (int kb = kq * 4; kb < kq * 4 + 4; ++kb)
                cvt_tile_fp8<2, NLD>(a.in[I_WGU] + (size_t)e * DM * 2 * DE, 2 * DE, DM, a.ws + WS_WGU + (size_t)e * 2 * DE * DM, kb, ng * 8 + wave, T, lane);
        } else { const int r = it - NEXP * MOE_I_GU, e = r / MOE_I_D, q = r % MOE_I_D, ng = q & 3, kq = q >> 2;
#pragma unroll 1
            for (int kb = kq * 4; kb < kq * 4 + 4; ++kb)
                cvt_tile_fp8<0, NLD>(a.in[I_WD] + (size_t)e * DE * DM, DM, DE, a.ws + WS_WD + (size_t)e * DM * DE, kb, ng * 8 + wave, T, lane);
        }
    }
}

__device__ __forceinline__ void p2_qknorm(const Args& a, int gw, int NGW, int lane) {
    const bf16_t* P = (const bf16_t*)(a.ws + WS_P); bf16_t* QN = (bf16_t*)(a.ws + WS_QN); bf16_t* KN = (bf16_t*)(a.ws + WS_KN);
    const float QS = 0.08838834764831845f * 1.4426950408889634f;
    const int cs = lane & 15, hq = lane >> 4;
    float qw[8], kw[8];
#pragma unroll
    for (int i = 0; i < 8; ++i) { qw[i] = a.in[I_SBQNW][8 * cs + i] * QS; kw[i] = a.in[I_SBKNW][8 * cs + i]; }
    constexpr int QB_ = 8, NIT = NTOK * 4;
    for (int it0 = gw; it0 < NIT; it0 += QB_ * NGW) {
        u32x4 w[QB_];
#pragma unroll
        for (int k = 0; k < QB_; ++k) { const int it = it0 + k * NGW; w[k] = (u32x4){0u, 0u, 0u, 0u};
            if (it < NIT) { const int which = it & 1, half = (it >> 1) & 1, row = it >> 2; w[k] = *(const u32x4*)(P + (size_t)row * NPROJ + (which ? PC_SBK : PC_SBQ) + half * 512 + 8 * lane); } }
#pragma unroll
        for (int k = 0; k < QB_; ++k) { const int it = it0 + k * NGW;
            if (it < NIT) { const int which = it & 1, half = (it >> 1) & 1, row = it >> 2; const int b = row / LSEQ, t = row - b * LSEQ, h = 4 * half + hq;
                float v[8]; v[0] = bf_lo(w[k].x); v[1] = bf_hi(w[k].x); v[2] = bf_lo(w[k].y); v[3] = bf_hi(w[k].y); v[4] = bf_lo(w[k].z); v[5] = bf_hi(w[k].z); v[6] = bf_lo(w[k].w); v[7] = bf_hi(w[k].w);
                float ss = 0.f;
#pragma unroll
                for (int i = 0; i < 8; ++i) ss += v[i] * v[i];
                const float rstd = 1.0f / sqrtf(row16_sum(ss) * (1.0f / HD) + NORM_EPS);
                float o[8];
#pragma unroll
                for (int i = 0; i < 8; ++i) o[i] = v[i] * rstd * (which ? kw[i] : qw[i]);
                u32x4 ov; ov.x = cvt_pk_bf16(o[0], o[1]); ov.y = cvt_pk_bf16(o[2], o[3]); ov.z = cvt_pk_bf16(o[4], o[5]); ov.w = cvt_pk_bf16(o[6], o[7]);
                *(u32x4*)((which ? KN : QN) + ((size_t)(b * NHEAD + h) * LROW + t) * HD + 8 * cs) = ov; } }
    }
}

__device__ __forceinline__ bf16x8 sba_pack8(const f32x16& p, int base) {
    u32x4 w; w.x = cvt_pk_bf16(p[base + 0], p[base + 1]); w.y = cvt_pk_bf16(p[base + 2], p[base + 3]); w.z = cvt_pk_bf16(p[base + 4], p[base + 5]); w.w = cvt_pk_bf16(p[base + 6], p[base + 7]);
    return __builtin_bit_cast(bf16x8, w);
}

namespace gdn {
constexpr int NCH = 65;
constexpr int IMG_W = 0, IMG_QG = 16384, IMG_KDT = 32768, IMG_AT = 49152, IMG_BYTES = 57344, IMG_U = 57344, CH_BYTES = 73728;
constexpr int L_LT = 0, L_GC = 18432, L_BE = 18688, L_QB = 18944, L_KB = 36352, L_VB = 53760, L_IMG = 71168;
__device__ __forceinline__ int afrag_off(int row, int k, int nks) {
    const int rt = row >> 5, rr = row & 31, ks = k >> 4, kk = k & 15, hi = (kk >> 2) & 1, sl = (kk & 3) + 4 * (kk >> 3);
    return ((rt * nks + ks) * 64 + rr + 32 * hi) * 16 + sl * 2;
}
__device__ __forceinline__ int ufrag_off(int i, int c) {
    const int cg = c >> 5, col = c & 31, rt = i >> 5, ii = i & 31, hi = (ii >> 2) & 1, r = (ii & 3) + 4 * (ii >> 3);
    return (((cg * 2 + rt) * 2 + (r >> 3)) * 64 + col + 32 * hi) * 8 + (r & 7);
}
__device__ __forceinline__ int crow(int r, int hi) { return (r & 3) + 8 * (r >> 2) + 4 * hi; }
__device__ __forceinline__ bf16_t f2bf(float f) { return (bf16_t)(cvt_pk_bf16(f, 0.f) & 0xffffu); }

__device__ __forceinline__ void prefetch_rows(const Args& a, int item, int lane, int wave, unsigned (&xwp)[33], float (&gbp)[2]) {
    if (item >= 32 * NCH) return;
    const int bh = item / NCH, c = item - bh * NCH, b = bh >> 3, h = bh & 7, tbase = 64 * c - 48;
    const bf16_t* P = (const bf16_t*)(a.ws + WS_P) + (size_t)b * LSEQ * NPROJ;
#pragma unroll
    for (int j = 0; j < 11; ++j) { const int t = tbase + 8 * wave - 3 + j;
#pragma unroll
        for (int w3 = 0; w3 < 3; ++w3) { unsigned u = 0u; if (t >= 0) u = *(const unsigned*)(P + (size_t)t * NPROJ + w3 * 1024 + h * HD + 2 * lane); xwp[j * 3 + w3] = u; } }
    if (wave == 0) { const int t = tbase + lane; float g = 0.f, be = 0.f;
        if (t >= 0) { g = ((const float*)(a.ws + WS_G))[((size_t)b * LSEQ + t) * 8 + h]; be = ((const float*)(a.ws + WS_BETA))[((size_t)b * LSEQ + t) * 8 + h]; }
        gbp[0] = g; gbp[1] = be; }
}
__device__ __forceinline__ void precompute(const Args& a, LAS unsigned char* lds, int item, int tid, int lane, int wave, unsigned (&xwp)[33], float (&gbp)[2], volatile LAS int* nslot, int nclaim) {
    asm volatile("" : "+v"(tid), "+v"(lane), "+s"(wave));
    const int bh = item / NCH, c = item - bh * NCH, b = bh >> 3, h = bh & 7;
    const bf16_t* P = (const bf16_t*)(a.ws + WS_P) + (size_t)b * LSEQ * NPROJ;
    const float* BETA = (const float*)(a.ws + WS_BETA) + (size_t)b * LSEQ * 8; const float* GG = (const float*)(a.ws + WS_G) + (size_t)b * LSEQ * 8;
    unsigned char* dst = a.ws + WS_GCH + (size_t)item * CH_BYTES;
    LAS float* GC = (LAS float*)(lds + L_GC); LAS float* BE = (LAS float*)(lds + L_BE); LAS float* LT = (LAS float*)(lds + L_LT);
    const int tbase = 64 * c - 48;
    if (wave == 0) {
        float g = gbp[0], be = gbp[1];
        g += dpp_get<0x111, 0xF>(g); g += dpp_get<0x112, 0xF>(g); g += dpp_get<0x114, 0xF>(g); g += dpp_get<0x118, 0xF>(g);
        g += dpp_get<0x142, 0xA>(g); g += dpp_get<0x143, 0xC>(g);
        GC[lane] = g; BE[lane] = be;
        if (lane == 63) ((float*)(a.ws + WS_GL))[item] = expf(g);
    }
    {
        f32x2 cw[3][4];
#pragma unroll
        for (int w3 = 0; w3 < 3; ++w3)
#pragma unroll
            for (int tap = 0; tap < 4; ++tap) cw[w3][tap] = *(const f32x2*)(a.in[I_CONVW] + tap * 3072 + w3 * 1024 + h * HD + 2 * lane);
        f32x2 xw[3][11];
#pragma unroll
        for (int j = 0; j < 11; ++j)
#pragma unroll
            for (int w3 = 0; w3 < 3; ++w3) { const unsigned u = xwp[j * 3 + w3]; xw[w3][j] = (f32x2){bf_lo(u), bf_hi(u)}; }
#pragma unroll
        for (int rr = 0; rr < 8; ++rr) { const int i = 8 * wave + rr; f32x2 y[3];
#pragma unroll
            for (int w3 = 0; w3 < 3; ++w3) { f32x2 acc = cw[w3][0] * xw[w3][rr] + cw[w3][1] * xw[w3][rr + 1] + cw[w3][2] * xw[w3][rr + 2] + cw[w3][3] * xw[w3][rr + 3];
                acc.x = acc.x * __builtin_amdgcn_rcpf(1.0f + __expf(-acc.x)); acc.y = acc.y * __builtin_amdgcn_rcpf(1.0f + __expf(-acc.y)); y[w3] = acc; }
            const float rq = 0.08838834764831845f * __builtin_amdgcn_rsqf(wave_sum(y[0].x * y[0].x + y[0].y * y[0].y) + NORM_EPS);
            const float rk = __builtin_amdgcn_rsqf(wave_sum(y[1].x * y[1].x + y[1].y * y[1].y) + NORM_EPS);
            *(LAS unsigned*)(lds + L_QB + i * 272 + 4 * lane) = cvt_pk_bf16(y[0].x * rq, y[0].y * rq);
            *(LAS unsigned*)(lds + L_KB + i * 272 + 4 * lane) = cvt_pk_bf16(y[1].x * rk, y[1].y * rk);
            *(LAS unsigned*)(lds + L_VB + i * 272 + 4 * lane) = cvt_pk_bf16(y[2].x, y[2].y); }
    }
    __syncthreads();
    {
        const int prod = wave >> 2, ti = (wave >> 1) & 1, tj = wave & 1, r32 = lane & 31, hi = lane >> 5;
        if (tj <= ti) {
            f32x16 acc;
#pragma unroll
            for (int r = 0; r < 16; ++r) acc[r] = 0.f;
            const LAS unsigned char* Ab = lds + (prod ? L_QB : L_KB) + (32 * ti + r32) * 272 + hi * 16;
            const LAS unsigned char* Bb = lds + L_KB + (32 * tj + r32) * 272 + hi * 16;
#pragma unroll
            for (int ks = 0; ks < 8; ++ks) acc = __builtin_amdgcn_mfma_f32_32x32x16_bf16(*(const LAS bf16x8*)(Ab + ks * 32), *(const LAS bf16x8*)(Bb + ks * 32), acc, 0, 0, 0);
            const int j = 32 * tj + r32; const float gj = GC[j];
#pragma unroll
            for (int r = 0; r < 16; ++r) { const int i = 32 * ti + crow(r, hi); const float dec = __expf(GC[i] - gj);
                if (prod == 0) LT[j * 72 + (i & 1) * 36 + (i >> 1)] = (j < i) ? acc[r] * BE[i] * dec : 0.f;
                else *(LAS bf16_t*)(lds + L_IMG + IMG_AT + afrag_off(i, j, 4)) = f2bf((j <= i) ? acc[r] * dec : 0.f); }
        }
    }
    if (tid == 0) *nslot = nclaim;
    __syncthreads();
    gdn::prefetch_rows(a, *nslot, lane, wave, xwp, gbp);
    {
        const int dk = tid & 127, i0 = (tid >> 7) * 16; const float gl = GC[63];
#pragma unroll 4
        for (int ii = 0; ii < 16; ++ii) { const int i = i0 + ii; const float gi = GC[i];
            const float q = bf2f(*(const LAS bf16_t*)(lds + L_QB + i * 272 + dk * 2)), k = bf2f(*(const LAS bf16_t*)(lds + L_KB + i * 272 + dk * 2));
            *(LAS bf16_t*)(lds + L_IMG + IMG_QG + afrag_off(i, dk, 8)) = f2bf(q * __expf(gi));
            *(LAS bf16_t*)(lds + L_IMG + IMG_KDT + afrag_off(dk, i, 4)) = f2bf(k * __expf(gl - gi)); }
    }
    {
        float x[32];
        const int cidx = tid >> 1, p = tid & 1, cc = cidx & 127; const bool isv = cidx < 128;
        const LAS unsigned char* src = lds + (isv ? L_VB : L_KB) + cc * 2 + p * 272;
        const LAS float* BEp = BE + p; const LAS float* GCp = GC + p; const LAS float* LTp = LT + p * 36;
#pragma unroll
        for (int r8 = 0; r8 < 32; r8 += 8) {
#pragma unroll
            for (int q = 0; q < 8; ++q) { const int r = r8 + q; const float v = bf2f(*(const LAS bf16_t*)(src + r * 544)); x[r] = v * BEp[2 * r] * (isv ? 1.0f : __expf(GCp[2 * r])); }
            asm volatile("" ::: "memory"); }
        f32x4 la[8], lb[8];
#define LT_LOAD(dst, j) do { _Pragma("unroll") for (int _c = ((((j) >> 1) + ((j) & 1)) >> 2); _c < 8; ++_c) dst[_c] = *(const LAS f32x4*)(LTp + (j) * 72 + 4 * _c); } while (0)
#define LT_APPLY(src_, j) do { const float _t = x[(j) >> 1]; const float _s = dpp_get<0xB1, 0xF>(_t); const float xj = (p == ((j) & 1)) ? _t : _s; \
        _Pragma("unroll") for (int _r = ((j) >> 1) + ((j) & 1); _r < 32; ++_r) x[_r] -= src_[_r >> 2][_r & 3] * xj; } while (0)
        LT_LOAD(la, 0);
#pragma unroll
        for (int jj = 0; jj < 31; ++jj) {
            LT_LOAD(lb, 2 * jj + 1); asm volatile("" ::: "memory"); LT_APPLY(la, 2 * jj);
            LT_LOAD(la, 2 * jj + 2); asm volatile("" ::: "memory"); LT_APPLY(lb, 2 * jj + 1);
        }
        LT_APPLY(la, 62);
#undef LT_LOAD
#undef LT_APPLY
        if (isv) {
            LAS unsigned char* ub = lds + L_IMG + IMG_U + (((cc >> 5) * 4 * 64) + (cc & 31)) * 16 + 2 * p;
#pragma unroll
            for (int r = 0; r < 32; ++r) { const int rt = r >> 4, hi = (r >> 1) & 1, rr = 2 * (r & 1) + 4 * ((r >> 2) & 3);
                *(LAS bf16_t*)(ub + (((rt * 2 + (rr >> 3)) * 64 + 32 * hi) * 8 + (rr & 7)) * 2) = f2bf(x[r]); }
        } else {
            const int ks = cc >> 4, kk = cc & 15, hi = (kk >> 2) & 1, sl = (kk & 3) + 4 * (kk >> 3);
            LAS unsigned char* wb = lds + L_IMG + IMG_W + (ks * 64 + 32 * hi) * 16 + sl * 2 + 16 * p;
#pragma unroll
            for (int r = 0; r < 32; ++r) *(LAS bf16_t*)(wb + ((r >> 4) * 8 * 64 + ((2 * r) & 31)) * 16) = f2bf(-x[r]);
        }
    }
    __syncthreads();
    for (int q = tid; q < CH_BYTES / 16; q += NTHREADS) *(u32x4*)(dst + (size_t)q * 16) = *(const LAS u32x4*)(lds + L_IMG + q * 16);
}

constexpr int OB_OFF = 2 * IMG_BYTES, OB_STR = 272, OB_BYTES = 64 * OB_STR;
__device__ __forceinline__ void gated_load_z(const Args& a, u32x4 (&zw)[4], int b, int h, int cc, int w4, int lane) {
    const bf16_t* P = (const bf16_t*)(a.ws + WS_P);
    const int s = 64 * (cc - 1) + 16 * w4 + (lane >> 2);
    const u32x4* zp = (const u32x4*)(P + ((size_t)b * LSEQ + NMETA + s) * NPROJ + PC_Z + h * HD + 32 * (lane & 3));
#pragma unroll
    for (int q = 0; q < 4; ++q) zw[q] = zp[q];
}
__device__ __forceinline__ float silu_f(float z) { return z * __builtin_amdgcn_rcpf(1.0f + __expf(-z)); }
__device__ __forceinline__ void gated_rows(const Args& a, const LAS unsigned char* ob, const u32x4 (&zw)[4], int b, int h, int cc, int w4, int lane, const f32x4 (&nwv)[8]) {
    bf16_t* MIX = (bf16_t*)(a.ws + WS_MIX);
    const int row = lane >> 2, qd = lane & 3, s = 64 * (cc - 1) + 16 * w4 + row;
    u32x4 ov[4]; float ss = 0.f;
#pragma unroll
    for (int q = 0; q < 4; ++q) { ov[q] = *(const LAS u32x4*)(ob + (16 * w4 + row) * OB_STR + qd * 64 + q * 16);
#pragma unroll
        for (int e = 0; e < 4; ++e) { const float lo = bf_lo(ov[q][e]), hi = bf_hi(ov[q][e]); ss += lo * lo + hi * hi; } }
    ss = quad_sum(ss);
    const float rstd = __builtin_amdgcn_rsqf(ss * (1.0f / HD) + NORM_EPS);
    u32x4* dst = (u32x4*)(MIX + ((size_t)b * SEQ + s) * DM + h * HD + 32 * qd);
#pragma unroll
    for (int q = 0; q < 4; ++q) { u32x4 w;
#pragma unroll
        for (int e = 0; e < 4; ++e) { const f32x4 nv = nwv[2 * q + (e >> 1)];
            const float n0 = (e & 1) ? nv.z : nv.x, n1 = (e & 1) ? nv.w : nv.y;
            w[e] = cvt_pk_bf16(bf_lo(ov[q][e]) * rstd * n0 * silu_f(bf_lo(zw[q][e])), bf_hi(ov[q][e]) * rstd * n1 * silu_f(bf_hi(zw[q][e]))); }
        dst[q] = w; }
}

__device__ __forceinline__ void scan(const Args& a, LAS unsigned char* lds, int bh, int tid, int lane, int wave) {
    const int b = bh >> 3, h = bh & 7, col = lane & 31, hi = lane >> 5, cg = wave;
    const unsigned char* src = a.ws + WS_GCH + (size_t)bh * NCH * CH_BYTES;
    const float* GL = (const float*)(a.ws + WS_GL) + bh * NCH;
    __syncthreads();
    const unsigned dvoff = (unsigned)(wave * 1024 + lane * 16), uvoff = (unsigned)(lane * 16);
#define GDN_DMA(ch, buf) do { const unsigned char* _sp = src + (size_t)(ch) * CH_BYTES; _Pragma("unroll") for (int _f = 0; _f < 7; ++_f) { \
        __builtin_amdgcn_global_load_lds((const unsigned*)(_sp + _f * 8192 + dvoff), (LAS unsigned*)(lds + (buf) * IMG_BYTES + wave * 1024 + _f * 8192), 16, 0, 0); } } while (0)
    GDN_DMA(0, 0);
#define GDN_STEP_END(vm) do { asm volatile("s_waitcnt vmcnt(" #vm ")" ::: "memory"); asm volatile("s_waitcnt lgkmcnt(0)" ::: "memory"); __builtin_amdgcn_s_barrier(); asm volatile("" ::: "memory"); } while (0)
    if (wave < 4) {
        f32x16 st[4]; bf16x8 Sb[8]; u32x4 ureg[4]; float gl;
#pragma unroll
        for (int t4 = 0; t4 < 4; ++t4)
#pragma unroll
            for (int r = 0; r < 16; ++r) st[t4][r] = 0.f;
#pragma unroll
        for (int ks = 0; ks < 8; ++ks) Sb[ks] = (bf16x8){0, 0, 0, 0, 0, 0, 0, 0};
#pragma unroll
        for (int q = 0; q < 4; ++q) ureg[q] = *(const u32x4*)(src + IMG_U + cg * 4096 + q * 1024 + uvoff);
        gl = GL[0];
        GDN_STEP_END(0);
        for (int c = 0; c < NCH; ++c) {
            const LAS unsigned char* img = lds + (c & 1) * IMG_BYTES + lane * 16;
            asm volatile("" : "+v"(ureg[0]), "+v"(ureg[1]), "+v"(ureg[2]), "+v"(ureg[3]), "+v"(gl));
            if (c + 1 < NCH) GDN_DMA(c + 1, (c + 1) & 1);
            f32x16 vn[2]; const float glc = gl;
#pragma unroll
            for (int rt = 0; rt < 2; ++rt)
#pragma unroll
                for (int rh = 0; rh < 2; ++rh) { const u32x4 w = ureg[rt * 2 + rh];
                    vn[rt][8 * rh + 0] = bf_lo(w.x); vn[rt][8 * rh + 1] = bf_hi(w.x); vn[rt][8 * rh + 2] = bf_lo(w.y); vn[rt][8 * rh + 3] = bf_hi(w.y);
                    vn[rt][8 * rh + 4] = bf_lo(w.z); vn[rt][8 * rh + 5] = bf_hi(w.z); vn[rt][8 * rh + 6] = bf_lo(w.w); vn[rt][8 * rh + 7] = bf_hi(w.w); }
            asm volatile("" ::: "memory");
            if (c + 1 < NCH) {
#pragma unroll
                for (int q = 0; q < 4; ++q) ureg[q] = *(const u32x4*)(src + (size_t)(c + 1) * CH_BYTES + IMG_U + cg * 4096 + q * 1024 + uvoff);
                gl = GL[c + 1]; }
#pragma unroll
            for (int rt = 0; rt < 2; ++rt) { __builtin_amdgcn_sched_barrier(0);
#pragma unroll
                for (int ks = 0; ks < 8; ++ks) vn[rt] = __builtin_amdgcn_mfma_f32_32x32x16_bf16(*(const LAS bf16x8*)(img + IMG_W + (rt * 8 + ks) * 1024), Sb[ks], vn[rt], 0, 0, 0); }
            __builtin_amdgcn_sched_barrier(0);
            bf16x8 vb[4];
#pragma unroll
            for (int ks = 0; ks < 4; ++ks) vb[ks] = sba_pack8(vn[ks >> 1], 8 * (ks & 1));
            LAS unsigned char* obw = lds + OB_OFF + (c & 1) * OB_BYTES + (32 * cg + col) * 2;
#pragma unroll
            for (int rt = 0; rt < 2; ++rt) { f32x16 o; __builtin_amdgcn_sched_barrier(0);
#pragma unroll
                for (int r = 0; r < 16; ++r) o[r] = 0.f;
#pragma unroll
                for (int ks = 0; ks < 8; ++ks) o = __builtin_amdgcn_mfma_f32_32x32x16_bf16(*(const LAS bf16x8*)(img + IMG_QG + (rt * 8 + ks) * 1024), Sb[ks], o, 0, 0, 0);
#pragma unroll
                for (int ks = 0; ks < 2 * (rt + 1); ++ks) o = __builtin_amdgcn_mfma_f32_32x32x16_bf16(*(const LAS bf16x8*)(img + IMG_AT + (rt * 4 + ks) * 1024), vb[ks], o, 0, 0, 0);
                if (c >= 1) {
#pragma unroll
                    for (int r = 0; r < 16; ++r) *(LAS bf16_t*)(obw + (32 * rt + crow(r, hi)) * OB_STR) = f2bf(o[r]); }
            }
#pragma unroll
            for (int t4 = 0; t4 < 4; ++t4) { __builtin_amdgcn_sched_barrier(0);
#pragma unroll
                for (int r = 0; r < 16; ++r) st[t4][r] *= glc;
#pragma unroll
                for (int ks = 0; ks < 4; ++ks) st[t4] = __builtin_amdgcn_mfma_f32_32x32x16_bf16(*(const LAS bf16x8*)(img + IMG_KDT + (t4 * 4 + ks) * 1024), vb[ks], st[t4], 0, 0, 0);
                Sb[2 * t4] = sba_pack8(st[t4], 0); Sb[2 * t4 + 1] = sba_pack8(st[t4], 8); }
            if (c + 1 < NCH) GDN_STEP_END(5); else GDN_STEP_END(0);
        }
    } else {
        u32x4 zA[4], zB[4]; f32x4 nwv[8];
#pragma unroll
        for (int q = 0; q < 4; ++q) { zA[q] = (u32x4){0u, 0u, 0u, 0u}; zB[q] = (u32x4){0u, 0u, 0u, 0u}; }
#pragma unroll
        for (int q = 0; q < 8; ++q) nwv[q] = *(const f32x4*)(a.in[I_GDNNW] + 32 * (lane & 3) + 4 * q);
        GDN_STEP_END(0);
        for (int c = 0; c < NCH; ++c) {
#pragma unroll
            for (int q = 0; q < 4; ++q) asm volatile("" : "+v"(zA[q]), "+v"(zB[q]));
            if (c + 1 < NCH) GDN_DMA(c + 1, (c + 1) & 1);
            if (c >= 1) { if (c & 1) gated_load_z(a, zA, b, h, c, wave - 4, lane); else gated_load_z(a, zB, b, h, c, wave - 4, lane); }
            asm volatile("" ::: "memory");
            if (c >= 2) { if (c & 1) gated_rows(a, lds + OB_OFF + ((c - 1) & 1) * OB_BYTES, zB, b, h, c - 1, wave - 4, lane, nwv);
                          else gated_rows(a, lds + OB_OFF + ((c - 1) & 1) * OB_BYTES, zA, b, h, c - 1, wave - 4, lane, nwv); }
            if (c >= 2) GDN_STEP_END(4); else GDN_STEP_END(0);
        }
        gated_rows(a, lds + OB_OFF + ((NCH - 1) & 1) * OB_BYTES, zB, b, h, NCH - 1, wave - 4, lane, nwv);
    }
#undef GDN_STEP_END
#undef GDN_DMA
}
}

namespace sba {
#define KSWZ(row, colB) ((row) * 256 + ((colB) ^ (((row) & 7) << 4)))
__device__ __forceinline__ int v_st(int k, int c) { const int kk = (k & ~0xC) | ((k & 4) << 1) | ((k & 8) >> 1); return ((kk >> 3) * 4 + (c >> 5)) * 512 + ((kk & 7) * 32 + (c & 31)) * 2; }
__device__ __forceinline__ int v_rd_base(int lane) { return ((lane & 3) << 3) | (((lane >> 2) & 3) << 6) | (((lane >> 4) & 1) << 5) | (((lane >> 5) & 1) << 8); }
constexpr int v_rd_off(int d0, int ks, int half) { return d0 * 512 + ks * 4096 + half * 2048; }
template <int OFF> __device__ __forceinline__ s16x4 tr_read(int vb) { s16x4 r; asm volatile("ds_read_b64_tr_b16 %0, %1 offset:%2" : "=&v"(r) : "v"(vb), "i"(OFF) : "memory"); return r; }
template <int D0> __device__ __forceinline__ void pv_one(f32x16& od, int vb, bf16x8 pa0, bf16x8 pa1, bf16x8 pa2, bf16x8 pa3) {
    const s16x4 l0 = tr_read<v_rd_off(D0, 0, 0)>(vb), h0 = tr_read<v_rd_off(D0, 0, 1)>(vb), l1 = tr_read<v_rd_off(D0, 1, 0)>(vb), h1 = tr_read<v_rd_off(D0, 1, 1)>(vb);
    const s16x4 l2 = tr_read<v_rd_off(D0, 2, 0)>(vb), h2 = tr_read<v_rd_off(D0, 2, 1)>(vb), l3 = tr_read<v_rd_off(D0, 3, 0)>(vb), h3 = tr_read<v_rd_off(D0, 3, 1)>(vb);
    asm volatile("s_waitcnt lgkmcnt(0)" ::: "memory"); __builtin_amdgcn_sched_barrier(0);
#define PK(L, H) (bf16x8){L[0], L[1], L[2], L[3], H[0], H[1], H[2], H[3]}
    od = __builtin_amdgcn_mfma_f32_32x32x16_bf16(pa0, PK(l0, h0), od, 0, 0, 0);
    od = __builtin_amdgcn_mfma_f32_32x32x16_bf16(pa1, PK(l1, h1), od, 0, 0, 0);
    od = __builtin_amdgcn_mfma_f32_32x32x16_bf16(pa2, PK(l2, h2), od, 0, 0, 0);
    od = __builtin_amdgcn_mfma_f32_32x32x16_bf16(pa3, PK(l3, h3), od, 0, 0, 0);
#undef PK
}
__device__ __forceinline__ int crow(int r, int hi) { return (r & 3) + 8 * (r >> 2) + 4 * hi; }
__device__ __forceinline__ int swap34(int k) { return (k & ~0x18) | ((k & 8) << 1) | ((k & 16) >> 1); }
__device__ __forceinline__ bf16x8 pack8(const f32x16& p, int base) {
    u32x4 w; w.x = cvt_pk_bf16(p[base + 0], p[base + 1]); w.y = cvt_pk_bf16(p[base + 2], p[base + 3]); w.z = cvt_pk_bf16(p[base + 4], p[base + 5]); w.w = cvt_pk_bf16(p[base + 6], p[base + 7]);
    return __builtin_bit_cast(bf16x8, w);
}
constexpr float SB_EXIT = 160.0f;

__device__ __forceinline__ void unit(const Args& a, LAS unsigned char* lds, volatile LAS int* done_cnt, int b, int h, int qb, int tid, int lane, int wid) {
    const bf16_t* QN = (const bf16_t*)(a.ws + WS_QN) + (size_t)(b * NHEAD + h) * LROW * HD;
    const bf16_t* KN = (const bf16_t*)(a.ws + WS_KN) + (size_t)(b * NHEAD + h) * LROW * HD;
    const bf16_t* Vp = (const bf16_t*)(a.ws + WS_P) + (size_t)b * LSEQ * NPROJ + PC_SBV + h * HD;
    bf16_t* MIX = (bf16_t*)(a.ws + WS_MIX);
    const int r32 = lane & 31, hi = lane >> 5;
    LAS unsigned char* K_lds = lds; LAS unsigned char* V_lds = lds + 16384;
    const int tq0 = NMETA + 256 * qb + 32 * wid, tq = tq0 + r32;
    __syncthreads();
    if (tid == 0) *done_cnt = 0;
    bf16x8 qr[8];
#pragma unroll
    for (int d0 = 0; d0 < 8; ++d0) qr[d0] = *(const bf16x8*)(QN + (size_t)tq * HD + d0 * 16 + hi * 8);
    const int sr = tid >> 4, sc = (tid & 15) * 8;
    const int vst0 = v_st(swap34(sr), sc), vst1 = v_st(32 + swap34(sr), sc);
    const int kst0 = KSWZ(sr, sc * 2), kst1 = KSWZ(32 + sr, sc * 2);
    const int vb0 = (int)(unsigned)(unsigned long)V_lds + v_rd_base(lane);
    const int prow = (r32 & 3) + 4 * (r32 >> 3) + 16 * ((r32 >> 2) & 1);
    f32x16 o[4];
#pragma unroll
    for (int d = 0; d < 4; ++d)
#pragma unroll
        for (int r = 0; r < 16; ++r) o[d][r] = 0.f;
    float carry = 0.f; bool flagged = false;
    bf16x8 ks0, ks1, vs0, vs1;
#define SBA_LOAD(kk) do { const int _k0 = 64 * (kk); ks0 = *(const bf16x8*)(KN + (size_t)(_k0 + sr) * HD + sc); ks1 = *(const bf16x8*)(KN + (size_t)(_k0 + 32 + sr) * HD + sc); \
        vs0 = *(const bf16x8*)(Vp + (size_t)(_k0 + sr) * NPROJ + sc); vs1 = *(const bf16x8*)(Vp + (size_t)(_k0 + 32 + sr) * NPROJ + sc); } while (0)
    SBA_LOAD(4 * qb + 4);
    for (int kt = 4 * qb + 4; kt >= 0; --kt) {
        const int k0 = 64 * kt;
        __syncthreads();
        if (*done_cnt == NWAVES) break;
        *(LAS bf16x8*)(K_lds + kst0) = ks0; *(LAS bf16x8*)(K_lds + kst1) = ks1; *(LAS bf16x8*)(V_lds + vst0) = vs0; *(LAS bf16x8*)(V_lds + vst1) = vs1;
        if (kt > 0) SBA_LOAD(kt - 1);
        __syncthreads();
        if (k0 >= tq0 + 32) continue;
        f32x16 p0, p1;
#pragma unroll
        for (int r = 0; r < 16; ++r) { p0[r] = 0.f; p1[r] = 0.f; }
#pragma unroll
        for (int d0 = 0; d0 < 8; ++d0) { const int cb = (d0 * 16 + hi * 8) * 2;
            const bf16x8 b0 = *(const LAS bf16x8*)(K_lds + KSWZ(prow, cb)), b1 = *(const LAS bf16x8*)(K_lds + KSWZ(32 + prow, cb));
            p0 = __builtin_amdgcn_mfma_f32_32x32x16_bf16(b0, qr[d0], p0, 0, 0, 0);
            p1 = __builtin_amdgcn_mfma_f32_32x32x16_bf16(b1, qr[d0], p1, 0, 0, 0); }
        const bool need_mask = (k0 + 63 >= tq0);
        f32x16 s0, s1; float t0 = 0.f, t1 = 0.f;
#pragma unroll
        for (int r = 0; r < 16; ++r) {
            float e0 = __builtin_amdgcn_exp2f(p0[r]), e1 = __builtin_amdgcn_exp2f(p1[r]);
            float q0 = __builtin_amdgcn_logf(1.0f + e0), q1 = __builtin_amdgcn_logf(1.0f + e1);
            if (need_mask) { const bool v0 = (k0 + 16 * hi + r) < tq, v1 = (k0 + 32 + 16 * hi + r) < tq; e0 = v0 ? e0 : 0.f; q0 = v0 ? q0 : 0.f; e1 = v1 ? e1 : 0.f; q1 = v1 ? q1 : 0.f; }
            p0[r] = e0; p1[r] = e1; s0[r] = q0; s1[r] = q1; t0 += q0; t1 += q1; }
        float t1lo, t1hi, t0lo, t0hi;
        { auto rr = __builtin_amdgcn_permlane32_swap(__float_as_uint(t1), __float_as_uint(t1), false, false); t1lo = __uint_as_float(rr[0]); t1hi = __uint_as_float(rr[1]); }
        { auto rr = __builtin_amdgcn_permlane32_swap(__float_as_uint(t0), __float_as_uint(t0), false, false); t0lo = __uint_as_float(rr[0]); t0hi = __uint_as_float(rr[1]); }
        float run1 = carry + (hi ? 0.f : t1hi), run0 = carry + (t1lo + t1hi) + (hi ? 0.f : t0hi);
#pragma unroll
        for (int r = 15; r >= 0; --r) { run1 += s1[r]; p1[r] = p1[r] * __builtin_amdgcn_exp2f(-run1); run0 += s0[r]; p0[r] = p0[r] * __builtin_amdgcn_exp2f(-run0); }
        carry += (t1lo + t1hi) + (t0lo + t0hi);
        const bf16x8 pa0 = pack8(p0, 0), pa1 = pack8(p0, 8), pa2 = pack8(p1, 0), pa3 = pack8(p1, 8);
        pv_one<0>(o[0], vb0, pa0, pa1, pa2, pa3); pv_one<1>(o[1], vb0, pa0, pa1, pa2, pa3); pv_one<2>(o[2], vb0, pa0, pa1, pa2, pa3); pv_one<3>(o[3], vb0, pa0, pa1, pa2, pa3);
        if (!flagged && __all(carry >= SB_EXIT)) { flagged = true; if (lane == 0) (void)__hip_atomic_fetch_add((LAS int*)done_cnt, 1, __ATOMIC_RELAXED, __HIP_MEMORY_SCOPE_WORKGROUP); }
    }
#undef SBA_LOAD
    const float* onw = a.in[I_SBONW];
    float wv[4];
#pragma unroll
    for (int d0 = 0; d0 < 4; ++d0) wv[d0] = onw[32 * d0 + r32];
#pragma unroll
    for (int r = 0; r < 16; ++r) {
        float ss = (o[0][r] * o[0][r] + o[1][r] * o[1][r]) + (o[2][r] * o[2][r] + o[3][r] * o[3][r]);
        ss = row16_sum(ss); ss += __shfl_xor(ss, 16);
        const float rstd = 1.0f / sqrtf(ss * (1.0f / HD) + NORM_EPS);
        const size_t tok = (size_t)b * SEQ + (tq0 - NMETA) + crow(r, hi);
        bf16_t* dst = MIX + tok * DM + 1024 + h * HD + r32;
#pragma unroll
        for (int d0 = 0; d0 < 4; ++d0) dst[32 * d0] = (bf16_t)(cvt_pk_bf16(o[d0][r] * rstd * wv[d0], 0.f) & 0xffffu);
    }
}
}

__device__ __forceinline__ void p5_router(const Args& a, LAS unsigned char* lds, int G, int c, int tid) {
    LAS float* lg = (LAS float*)(lds + P5_LG);
    LAS float* rs = (LAS float*)(lds + P5_RS);
    LAS int* misc = (LAS int*)(lds + MISC_OFF);
    const float* H1 = a.out; const float* rw = a.in[I_RW]; const float* rb = a.in[I_RB]; const float* wnp = a.in[I_FFNNW];
    unsigned char* HN2 = a.ws + WS_HN;
    int* RE = (int*)(a.ws + WS_RE); int* RP = (int*)(a.ws + WS_RP); float* RG = (float*)(a.ws + WS_RG); int* LIST = (int*)(a.ws + WS_LIST);
    unsigned* ecnt = (unsigned*)(a.ws + WS_CTL) + CW_ECNT;
    for (int blk = c; blk < NREAL / 64; blk += G) {
        asm volatile("" : "+v"(tid));
        const int wv = __builtin_amdgcn_readfirstlane(tid >> 6), lane = tid & 63, i32 = lane & 31, kh = lane >> 5;
        __syncthreads();
        const char* xg = (const char*)(H1 + (size_t)blk * 64 * DM) + lane * 16;
#define P5_DMA(ch, b) do { _Pragma("unroll") for (int _r = 0; _r < 8; ++_r) \
        __builtin_amdgcn_global_load_lds((const unsigned*)(xg + (size_t)(wv * 8 + _r) * (DM * 4) + (ch) * 1024), (LAS unsigned*)(lds + (b) * XBUF + (wv * 8 + _r) * XROW), 16, 0, 0); } while (0)
        P5_DMA(0, 0); P5_DMA(1, 1);
        *(LAS f32x4*)(lds + P5_WN + tid * 16) = *((const f32x4*)wnp + tid);
        float Bv[8][16];
        unsigned kob = (unsigned)(32 * wv + 16 * kh) * 4u, lob = (unsigned)((32 * wv + 16 * kh) * NEXP + i32) * 4u; asm volatile("" : "+v"(kob), "+v"(lob));
#pragma unroll
        for (int g2 = 0; g2 < 2; ++g2) { float raw[4][16]; f32x4 w4[4][4];
#pragma unroll
            for (int c4 = 0; c4 < 4; ++c4) { const int ch = g2 * 4 + c4;
#pragma unroll
                for (int q = 0; q < 4; ++q) w4[c4][q] = *(const f32x4*)((const char*)wnp + (kob + (unsigned)((256 * ch + 4 * q) * 4)));
#pragma unroll
                for (int j = 0; j < 16; ++j) raw[c4][j] = *(const float*)((const char*)rw + (lob + (unsigned)((256 * ch + j) * NEXP * 4))); }
            __builtin_amdgcn_sched_barrier(0);
#pragma unroll
            for (int c4 = 0; c4 < 4; ++c4)
#pragma unroll
                for (int j = 0; j < 16; ++j) Bv[g2 * 4 + c4][j] = raw[c4][j] * w4[c4][j >> 2][j & 3];
            __builtin_amdgcn_sched_barrier(0); }
        f32x16 acc0, acc1; float ss0 = 0.f, ss1 = 0.f;
#pragma unroll
        for (int v = 0; v < 16; ++v) { acc0[v] = 0.f; acc1[v] = 0.f; }
        asm volatile("s_waitcnt vmcnt(0)" ::: "memory");
#pragma unroll
        for (int ch = 0; ch < 8; ++ch) {
            if (ch == 7) asm volatile("s_waitcnt vmcnt(4)" ::: "memory"); else if (ch >= 1) asm volatile("s_waitcnt vmcnt(12)" ::: "memory");
            __builtin_amdgcn_s_barrier();
            const LAS unsigned char* xb = lds + (ch & 1) * XBUF + i32 * XROW + (32 * wv + 16 * kh) * 4;
            f32x4 a0[4], a1[4], wq[4];
#pragma unroll
            for (int q = 0; q < 4; ++q) { a0[q] = *(const LAS f32x4*)(xb + 16 * q); a1[q] = *(const LAS f32x4*)(xb + 32 * XROW + 16 * q); wq[q] = *(const LAS f32x4*)(lds + P5_WN + (256 * ch + 32 * wv + 16 * kh + 4 * q) * 4); }
            asm volatile("s_waitcnt lgkmcnt(0)" ::: "memory");
            __builtin_amdgcn_s_barrier();
            if (ch + 2 < 8) P5_DMA(ch + 2, ch & 1);
            __builtin_amdgcn_sched_barrier(0);
            { u32x4 o0, o1;
#pragma unroll
                for (int q = 0; q < 4; ++q) { const f32x4 y0 = a0[q] * wq[q], y1 = a1[q] * wq[q]; o0[q] = pk4_fp8(y0.x, y0.y, y0.z, y0.w); o1[q] = pk4_fp8(y1.x, y1.y, y1.z, y1.w); }
                unsigned char* dst = HN2 + ((size_t)blk * 64 + i32) * DM + 256 * ch + 32 * wv + 16 * kh;
                *(u32x4*)dst = o0; *(u32x4*)(dst + (size_t)32 * DM) = o1; }
            __builtin_amdgcn_sched_barrier(0);
#pragma unroll
            for (int q = 0; q < 4; ++q)
#pragma unroll
                for (int jj = 0; jj < 4; ++jj) { const float x0 = a0[q][jj], x1 = a1[q][jj], bw = Bv[ch][4 * q + jj];
                    ss0 += x0 * x0; ss1 += x1 * x1;
                    acc0 = __builtin_amdgcn_mfma_f32_32x32x2f32(x0, bw, acc0, 0, 0, 0); acc1 = __builtin_amdgcn_mfma_f32_32x32x2f32(x1, bw, acc1, 0, 0, 0); }
            __builtin_amdgcn_sched_barrier(0);
        }
#undef P5_DMA
        { LAS float* red = (LAS float*)lds; LAS float* ssp = (LAS float*)(lds + P5_SSP);
#pragma unroll
            for (int v = 0; v < 16; ++v) { const int t = 8 * (v >> 2) + 4 * kh + (v & 3); red[(wv * 64 + t) * 32 + i32] = acc0[v]; red[(wv * 64 + 32 + t) * 32 + i32] = acc1[v]; }
            ssp[(wv * 2 + kh) * 64 + i32] = ss0; ssp[(wv * 2 + kh) * 64 + 32 + i32] = ss1;
            __syncthreads();
            { const int t = tid >> 3, e4 = tid & 7; f32x4 sacc = *(const LAS f32x4*)(red + t * 32 + 4 * e4);
#pragma unroll
                for (int w2 = 1; w2 < 8; ++w2) sacc += *(const LAS f32x4*)(red + (w2 * 64 + t) * 32 + 4 * e4);
                lg[t * 33 + 4 * e4 + 0] = sacc.x; lg[t * 33 + 4 * e4 + 1] = sacc.y; lg[t * 33 + 4 * e4 + 2] = sacc.z; lg[t * 33 + 4 * e4 + 3] = sacc.w; }
            if (tid < 64) { float ss = 0.f;
#pragma unroll
                for (int q = 0; q < 16; ++q) ss += ssp[q * 64 + tid];
                const float rstd = 1.0f / sqrtf(ss * (1.0f / DM) + NORM_EPS); rs[tid] = rstd; ((float*)(a.ws + WS_RSTD))[blk * 64 + tid] = rstd; }
            if (tid < 32) misc[40 + tid] = 0; }
        __syncthreads();
        __syncthreads();
        int ek[4] = {0, 0, 0, 0}, rk[4] = {0, 0, 0, 0}; float gk[4] = {0.f, 0.f, 0.f, 0.f};
        if (tid < 64) {
            float v[32];
            const float rstd = rs[tid];
#pragma unroll
            for (int e = 0; e < 32; ++e) v[e] = lg[tid * 33 + e] * rstd + rb[e];
            float val[4];
#pragma unroll
            for (int k = 0; k < 4; ++k) { float best = -3.0e38f; int bi = 0;
#pragma unroll
                for (int e = 0; e < 32; ++e) { const bool gt = v[e] > best; best = gt ? v[e] : best; bi = gt ? e : bi; }
#pragma unroll
                for (int e = 0; e < 32; ++e) v[e] = (e == bi) ? -3.0e38f : v[e];
                ek[k] = bi; val[k] = best; }
            float den = 0.f;
#pragma unroll
            for (int k = 0; k < 4; ++k) { gk[k] = expf(val[k] - val[0]); den += gk[k]; }
#pragma unroll
            for (int k = 0; k < 4; ++k) { gk[k] = gk[k] / den; rk[k] = __hip_atomic_fetch_add(&misc[40 + ek[k]], 1, __ATOMIC_RELAXED, __HIP_MEMORY_SCOPE_WORKGROUP); }
        }
        __syncthreads();
        if (tid < 32) { const int cnt = misc[40 + tid]; misc[72 + tid] = cnt ? (int)atomicAdd(&ecnt[tid], (unsigned)cnt) : 0; }
        __syncthreads();
        if (tid < 64) { const int tok = blk * 64 + tid;
#pragma unroll
            for (int k = 0; k < 4; ++k) { const int pos = misc[72 + ek[k]] + rk[k]; LIST[(size_t)ek[k] * NREAL + pos] = tok; RE[tok * 4 + k] = ek[k]; RP[tok * 4 + k] = pos; RG[tok * 4 + k] = gk[k]; } }
    }
    __syncthreads();
}

__device__ __forceinline__ int moe_setup(const Args& a, LAS int* misc, int tid) {
    const unsigned* ecnt = (const unsigned*)(a.ws + WS_CTL) + CW_ECNT;
    __syncthreads();
    if (tid < NEXP) misc[104 + tid] = (int)__hip_atomic_load(ecnt + tid, __ATOMIC_RELAXED, __HIP_MEMORY_SCOPE_AGENT);
    __syncthreads();
    if (tid == 0) { int acc = 0;
        for (int e = 0; e < NEXP; ++e) { misc[e] = acc; acc += (misc[104 + e] + 255) >> 8; }
        misc[32] = acc; }
    __syncthreads();
    return misc[32];
}

__device__ __forceinline__ void p8_combine(const Args& a, const LAS int* misc, int gw, int NGW, int lane) {
    const int* RE = (const int*)(a.ws + WS_RE); const int* RP = (const int*)(a.ws + WS_RP); const float* RG = (const float*)(a.ws + WS_RG);
    const unsigned char* Y = a.ws + WS_Y; float* out = a.out;
    typedef int i32x4 __attribute__((ext_vector_type(4)));
    i32x4 e4 = {0, 0, 0, 0}, p4 = {0, 0, 0, 0}; f32x4 g4 = {0.f, 0.f, 0.f, 0.f};
    if (gw < NREAL) { e4 = *(const i32x4*)(RE + gw * 4); p4 = *(const i32x4*)(RP + gw * 4); g4 = *(const f32x4*)(RG + gw * 4); }
#define P8_LOAD(ACC, YY, ROW, SLOT, H) do { const int _col = 16 * lane + 1024 * (H); \
        _Pragma("unroll") for (int _q = 0; _q < 4; ++_q) ACC[_q] = *(const f32x4*)(out + (size_t)(ROW) * DM + _col + 4 * _q); \
        _Pragma("unroll") for (int _k = 0; _k < 4; ++_k) YY[_k] = *(const u32x4*)(Y + SLOT[_k] * DM + _col); } while (0)
#define P8_COMB(ACC, YY, ROW, G, H) do { const int _col = 16 * lane + 1024 * (H); \
        _Pragma("unroll") for (int _k = 0; _k < 4; ++_k) { const float _g = G[_k] * (1.0f / pg8::Y8_SCALE); \
            _Pragma("unroll") for (int _q = 0; _q < 4; ++_q) { const f32x2 lo = __builtin_amdgcn_cvt_pk_f32_fp8((int)YY[_k][_q], false), hi = __builtin_amdgcn_cvt_pk_f32_fp8((int)YY[_k][_q], true); \
                ACC[_q].x += _g * lo.x; ACC[_q].y += _g * lo.y; ACC[_q].z += _g * hi.x; ACC[_q].w += _g * hi.y; } } \
        _Pragma("unroll") for (int _q = 0; _q < 4; ++_q) *(f32x4*)(out + (size_t)(ROW) * DM + _col + 4 * _q) = ACC[_q]; } while (0)
    size_t slot[4]; float g[4];
    f32x4 accA[4], accB[4]; u32x4 yA[4], yB[4];
    if (gw < NREAL) {
#pragma unroll
        for (int k = 0; k < 4; ++k) { slot[k] = (size_t)misc[e4[k]] * 256 + p4[k]; g[k] = g4[k]; }
        P8_LOAD(accA, yA, gw, slot, 0); }
    for (int row = gw; row < NREAL; row += NGW) {
        const int nrow = row + NGW;
        if (nrow < NREAL) { e4 = *(const i32x4*)(RE + nrow * 4); p4 = *(const i32x4*)(RP + nrow * 4); g4 = *(const f32x4*)(RG + nrow * 4); }
        P8_LOAD(accB, yB, row, slot, 1);
        P8_COMB(accA, yA, row, g, 0);
        float gc[4];
#pragma unroll
        for (int k = 0; k < 4; ++k) gc[k] = g[k];
        if (nrow < NREAL) {
#pragma unroll
            for (int k = 0; k < 4; ++k) { slot[k] = (size_t)misc[e4[k]] * 256 + p4[k]; g[k] = g4[k]; }
            P8_LOAD(accA, yA, nrow, slot, 0); }
        P8_COMB(accB, yB, row, gc, 1);
    }
#undef P8_LOAD
#undef P8_COMB
}

__device__ __forceinline__ void p1_meta_rows(const Args& a, LAS unsigned char* lds, int bx, int G, int tid, int wave, int lane) {
    const bf16_t* HN = (const bf16_t*)(a.ws + WS_HN); const bf16_t* WT = (const bf16_t*)(a.ws + WS_WIN); bf16_t* P = (bf16_t*)(a.ws + WS_P);
    for (int q = tid; q < NMETA * DM * 2 / 16; q += NTHREADS) *(LAS u32x4*)(lds + q * 16) = *(const u32x4*)((const unsigned char*)HN + (size_t)q * 16);
    __syncthreads();
    for (int col = bx + G * wave; col < NPROJ; col += G * NWAVES) {
        u32x4 w[4]; int lane_o = lane; asm volatile("" : "+v"(lane_o));
#pragma unroll
        for (int j = 0; j < 4; ++j) w[j] = *(const u32x4*)(WT + (size_t)col * DM + 8 * lane + 512 * j);
        float v = 0.f;
#pragma unroll 1
        for (int t = 0; t < NMETA; ++t) { float s = 0.f;
#pragma unroll
            for (int j = 0; j < 4; ++j) { const u32x4 x = *(const LAS u32x4*)(lds + t * (DM * 2) + (8 * lane_o + 512 * j) * 2);
                s += bf_lo(x.x) * bf_lo(w[j].x) + bf_hi(x.x) * bf_hi(w[j].x) + bf_lo(x.y) * bf_lo(w[j].y) + bf_hi(x.y) * bf_hi(w[j].y)
                   + bf_lo(x.z) * bf_lo(w[j].z) + bf_hi(x.z) * bf_hi(w[j].z) + bf_lo(x.w) * bf_lo(w[j].w) + bf_hi(x.w) * bf_hi(w[j].w); }
            s = wave_sum(s);
            v = ((lane & 15) == t) ? s : v; }
        P[((size_t)(lane >> 4) * LSEQ + (lane & 15)) * NPROJ + col] = gdn::f2bf(v);
    }
    __syncthreads();
}

constexpr int NPH = 9;
__global__ void __launch_bounds__(NTHREADS, 2) hymba_fwd(Args args) {
    extern __shared__ __attribute__((aligned(16))) unsigned char lds_raw[];
    LAS unsigned char* lds = (LAS unsigned char*)lds_raw;
    LAS int* misc = (LAS int*)(lds + MISC_OFF);
    const int tid = threadIdx.x, lane = tid & 63, wave = __builtin_amdgcn_readfirstlane(tid >> 6);
    const int G = gridDim.x, bx = blockIdx.x;
    const int vcu = (G % 8 == 0) ? (bx % 8) * (G / 8) + bx / 8 : bx;
    const int gw = vcu * NWAVES + wave, NGW = G * NWAVES;
    unsigned* ctl = (unsigned*)(args.ws + WS_CTL);
    for (int u = tid; u < 256; u += NTHREADS) misc[u] = 0;
    __syncthreads();
    XcdBarrier bar; bar.bar = ctl + CW_BAR; bar.x = 0; bar.st = nullptr;
    const int lo = args.ph_lo, hi = args.ph_hi;
    constexpr int CVT_LIMIT_P2 = MOE_ITEMS * 35 / 100;
    if (hi - lo > 1) bar = xcd_barrier_post(ctl + CW_BAR, (volatile LAS unsigned*)(misc + 200));
#define IN(k) (lo <= (k) && (k) < hi)
#define SEAM(k) do { if (IN(k) && IN((k) + 1)) xcd_barrier(bar); } while (0)

    if (IN(0)) { p0_rows(args, lds, G, bx, tid); p0_weights(args, lds, vcu, G, wave, lane); }
    SEAM(0);
    if (IN(1)) {
        p1_meta_rows(args, lds, bx, G, tid, wave, lane);
        pg8::PlainOrder S; S.init(NREAL, NPROJ, DM, args.ws + WS_WIN, G, bx); S.meta = 1;
        pg8::EpiBf16 E{(bf16_t*)(args.ws + WS_P), NPROJ, 1, nullptr, (const float*)(args.ws + WS_RSTD)};
        pg8::gemm_phase<pg8::EpiBf16, pg8::PlainOrder, true, true>(lds, (const char*)(args.ws + WS_HN), DM * 2, S, E);
    }
    SEAM(1);
    if (IN(2)) {
        p2_qknorm(args, gw, NGW, lane);
        const bool roleB = (G >= 128) && (bx >= G - G / 8 * 3);
        if (roleB) moe_weights_queue<CVT_NLD_P2>(args, lds, misc + 212, tid, wave, lane, CVT_LIMIT_P2);
        unsigned xwp[33]; float gbp[2] = {0.f, 0.f};
        __syncthreads();
        if (tid == 0) misc[213] = (int)atomicAdd(ctl + CW_PREQ, 1u);
        __syncthreads();
        int it = *(volatile LAS int*)(misc + 213);
        gdn::prefetch_rows(args, it, lane, wave, xwp, gbp);
        while (it < 32 * gdn::NCH) {
            const int nclaim = (tid == 0) ? (int)atomicAdd(ctl + CW_PREQ, 1u) : 0;
            gdn::precompute(args, lds, it, tid, lane, wave, xwp, gbp, (volatile LAS int*)(misc + 215), nclaim);
            __syncthreads();
            it = *(volatile LAS int*)(misc + 215);
        }
        if (!roleB) moe_weights_queue<CVT_NLD_P2>(args, lds, misc + 212, tid, wave, lane, CVT_LIMIT_P2);
    }
    SEAM(2);
    if (IN(3)) {
        const int NG = (G >= 64) ? 32 : 0;
        if (bx < 32 || NG == 0) { for (int it = bx; it < 32; it += G) gdn::scan(args, lds, it, tid, lane, wave); }
        if (bx >= NG) { for (int u = bx - NG; u < 512; u += G - NG) sba::unit(args, lds, (volatile LAS int*)(misc + 210), u >> 7, (u >> 4) & 7, u & 15, tid, lane, wave); }
        moe_weights_queue(args, lds, misc + 212, tid, wave, lane, MOE_ITEMS);
    }
    SEAM(3);
    if (IN(4)) {
        pg8::PlainOrder S; S.init(NREAL, DM, DM, args.ws + WS_WOUT, G, bx);
        pg8::EpiResF32 E{args.in[I_X], args.out, DM};
        pg8::gemm_phase<pg8::EpiResF32, pg8::PlainOrder, true, true>(lds, (const char*)(args.ws + WS_MIX), DM * 2, S, E);
    }
    SEAM(4);
    if (IN(5)) p5_router(args, lds, G, bx, tid);
    SEAM(5);
    if (IN(6)) {
        {
        const int mt = moe_setup(args, misc, tid);
        pg8::MoeOrder<true> S; S.tpre = misc; S.tok = (const LAS int*)(lds + TOK_OFF); S.nN = 16; S.nwg = mt * 16; S.G = G; S.c = bx;
        S.Bt = (const char*)(args.ws + WS_WGU); S.estride = (size_t)2 * DE * DM; S.K2 = DM;
        const int* LIST = (const int*)(args.ws + WS_LIST);
        S.ud = misc + 140; S.fill_units(misc + 140, tid);
        __syncthreads();
        for (int idx = tid; idx < TOK_CAP * 256; idx += NTHREADS) { pg8::Unit u; if (!S.next(idx >> 8, u)) break;
            const int r = (u.pm - misc[u.e]) * 256 + (idx & 255); int ent = 0;
            if (r < misc[104 + u.e]) { const int tk = LIST[(size_t)u.e * NREAL + r]; ent = (int)(((__float_as_uint(((const float*)(args.ws + WS_RSTD))[tk]) + 0x2000u) & 0xffffc000u) | (unsigned)tk); }
            ((LAS int*)(lds + TOK_OFF))[idx] = ent; }
        __syncthreads();
        pg8::EpiSwiGLU E{args.ws + WS_ACT, args.in[I_BGU], (const LAS int*)(lds + TOK_OFF)};
        pg8::gemm_phase<pg8::EpiSwiGLU, pg8::MoeOrder<true>, true, true, true>(lds, (const char*)(args.ws + WS_HN), DM, S, E);
        }
    }
    SEAM(6);
    if (IN(7)) {
        const int mt = moe_setup(args, misc, tid);
        pg8::MoeOrder<false> S; S.tpre = misc; S.tok = nullptr; S.nN = 8; S.nwg = mt * 8; S.G = G; S.c = bx;
        S.Bt = (const char*)(args.ws + WS_WD); S.estride = (size_t)DM * DE; S.K2 = DE;
        S.ud = misc + 140; S.fill_units(misc + 140, tid);
        __syncthreads();
        pg8::EpiFp8Bias E{args.ws + WS_Y, DM, args.in[I_BD]};
        pg8::gemm_phase<pg8::EpiFp8Bias, pg8::MoeOrder<false>, true, true, true>(lds, (const char*)(args.ws + WS_ACT), DE, S, E);
    }
    SEAM(7);
    if (IN(8)) { (void)moe_setup(args, misc, tid); p8_combine(args, misc, gw, NGW, lane); }
#undef IN
#undef SEAM
}

extern "C" void kernel_launch(void* const* d_in, const int* in_sizes, int n_in, void* d_out, int out_size, void* d_ws, size_t ws_size, hipStream_t stream) {
    static int grid = 0;
    if (grid == 0) {
        if (n_in != 19 || out_size != NREAL * DM || ws_size < WS_END) { fprintf(stderr, "kernel_launch: unexpected shapes (n_in %d out %d ws %zu need %zu)\n", n_in, out_size, ws_size, (size_t)WS_END); grid = -1; return; }
        int dev = 0, cus = 0, per_cu = 0;
        if (hipGetDevice(&dev) != hipSuccess || hipDeviceGetAttribute(&cus, hipDeviceAttributeMultiprocessorCount, dev) != hipSuccess) { grid = -1; return; }
        if (hipFuncSetAttribute((const void*)hymba_fwd, hipFuncAttributeMaxDynamicSharedMemorySize, LDS_BYTES) != hipSuccess) { fprintf(stderr, "kernel_launch: hipFuncSetAttribute failed\n"); grid = -1; return; }
        if (hipOccupancyMaxActiveBlocksPerMultiprocessor(&per_cu, (const void*)hymba_fwd, NTHREADS, LDS_BYTES) != hipSuccess || per_cu < 1) { fprintf(stderr, "kernel_launch: occupancy query says %d\n", per_cu); grid = -1; return; }
        (void)hipGetLastError();
        grid = cus;
    }
    if (grid < 0) return;
    (void)hipMemsetAsync((char*)d_ws + WS_CTL, 0, CTL_ZERO_BYTES, stream);
    Args a{};
    for (int i = 0; i < 19; ++i) a.in[i] = (const float*)d_in[i];
    a.out = (float*)d_out; a.ws = (unsigned char*)d_ws;
#if MK_N_LAUNCHES == 1
    a.ph_lo = 0; a.ph_hi = NPH;
    hipLaunchKernelGGL(hymba_fwd, dim3(grid), dim3(NTHREADS), LDS_BYTES, stream, a);
#else
    for (int p = 0; p < NPH; ++p) { a.ph_lo = p; a.ph_hi = p + 1; hipLaunchKernelGGL(hymba_fwd, dim3(grid), dim3(NTHREADS), LDS_BYTES, stream, a); }
#endif
    const hipError_t le = hipPeekAtLastError();
    if (le != hipSuccess) fprintf(stderr, "kernel_launch: launch failed: %s\n", hipGetErrorName(le));
}
```

```cpp
#include <hip/hip_runtime.h>
#include <cstdio>
#include <cstdint>

#ifndef MK_N_LAUNCHES
#define MK_N_LAUNCHES 1
#endif

constexpr int NB = 4, SEQ = 4096, NMETA = 16, LSEQ = SEQ + NMETA;
constexpr int DM = 2048, NTOK = NB * LSEQ  , MPAD = 16640  , NREAL = NB * SEQ  ;
constexpr int NPROJ_SRC = 7184, NPROJ = 7168;
constexpr int NHEAD = 8, HD = 128;
constexpr int PC_QKV = 0, PC_Z = 3072, PC_SBQ = 4096, PC_SBK = 5120, PC_SBV = 6144;
constexpr int NEXP = 32, TOPK = 4, DE = 2048;
constexpr int SLOT_ROWS = 73728;
constexpr int LROW = 4224;
constexpr float NORM_EPS = 1e-6f;

constexpr size_t MiB = 1u << 20;
constexpr size_t WS_CTL = 0, CTL_ZERO_BYTES = 1 * MiB;
constexpr size_t WS_RSTD = 512 * 1024;
constexpr size_t WS_WIN = 1 * MiB;
constexpr size_t WS_WOUT = WS_WIN + (size_t)NPROJ * DM * 2;
constexpr size_t WS_WGU = WS_WOUT + (size_t)DM * DM * 2;
constexpr size_t WS_WD = WS_WGU + (size_t)NEXP * 2 * DE * DM * 2;
constexpr size_t WS_HN = WS_WD + (size_t)NEXP * DM * DE * 2;
constexpr size_t WS_BETA = WS_HN + (size_t)MPAD * DM * 2;
constexpr size_t WS_G = WS_BETA + (size_t)NTOK * 8 * 4 + 256;
constexpr size_t WS_P = WS_G + (size_t)NTOK * 8 * 4 + 256;
constexpr size_t WS_QN = WS_P + (size_t)MPAD * NPROJ * 2;
constexpr size_t WS_KN = WS_QN + (size_t)NB * NHEAD * LROW * HD * 2;
constexpr size_t WS_ORAW = WS_KN + (size_t)NB * NHEAD * LROW * HD * 2;
constexpr size_t WS_MIX = WS_ORAW + (size_t)NREAL * 1024 * 4;
constexpr size_t WS_RE = WS_MIX + (size_t)NREAL * DM * 2;
constexpr size_t WS_RP = WS_RE + (size_t)NREAL * 4 * 4;
constexpr size_t WS_RG = WS_RP + (size_t)NREAL * 4 * 4;
constexpr size_t WS_LIST = WS_RG + (size_t)NREAL * 4 * 4;
constexpr size_t WS_ACT = WS_LIST + (size_t)NEXP * NREAL * 4;
constexpr size_t WS_Y = WS_ACT + (size_t)SLOT_ROWS * DE * 2;
constexpr size_t WS_GCH = WS_Y + (size_t)SLOT_ROWS * DM * 2;
constexpr size_t WS_GL = WS_GCH + (size_t)32 * 65 * 73728;
constexpr size_t WS_END = WS_GL + 32 * 65 * 4 + 256;
constexpr int CW_ECNT = 64;
constexpr int CW_CVTQ = 192;
constexpr int CVT_NLD_P2 = 4;
constexpr int CW_PREQ = 256;
constexpr int CW_BAR = 4096;

constexpr int LDS_STAGE = 131072;
constexpr int TOK_OFF = LDS_STAGE, TOK_CAP = 22;
constexpr int MISC_OFF = TOK_OFF + TOK_CAP * 256 * 4;
constexpr int LDS_BYTES = MISC_OFF + 1024;

#define GAS __attribute__((address_space(1)))
#define LAS __attribute__((address_space(3)))
typedef unsigned short bf16_t;
typedef short bf16x8 __attribute__((ext_vector_type(8)));
typedef short s16x4 __attribute__((ext_vector_type(4)));
typedef float f32x4 __attribute__((ext_vector_type(4)));
typedef float f32x2 __attribute__((ext_vector_type(2)));
typedef float f32x16 __attribute__((ext_vector_type(16)));
typedef unsigned u32x4 __attribute__((ext_vector_type(4)));
typedef unsigned u32x2 __attribute__((ext_vector_type(2)));

typedef __bf16 bf16x2_t __attribute__((ext_vector_type(2)));
__device__ __forceinline__ unsigned cvt_pk_bf16(float lo, float hi) { const f32x2 v = {lo, hi}; const bf16x2_t b = __builtin_convertvector(v, bf16x2_t); return __builtin_bit_cast(unsigned, b); }
__device__ __forceinline__ unsigned pk4_fp8(float a, float b, float c, float d) { unsigned w = 0u; w = __builtin_amdgcn_cvt_pk_fp8_f32(a, b, w, false); w = __builtin_amdgcn_cvt_pk_fp8_f32(c, d, w, true); return w; }
__device__ __forceinline__ float bf_lo(unsigned w) { return __uint_as_float(w << 16); }
__device__ __forceinline__ float bf_hi(unsigned w) { return __uint_as_float(w & 0xffff0000u); }
__device__ __forceinline__ float bf2f(bf16_t b) { return __uint_as_float(((unsigned)b) << 16); }
template <int CTRL, int ROW_MASK> __device__ __forceinline__ float dpp_get(float v) {
    return __builtin_bit_cast(float, __builtin_amdgcn_update_dpp(0, __builtin_bit_cast(int, v), CTRL, ROW_MASK, 0xF, false));
}
__device__ __forceinline__ float row16_sum(float v) {
    v += dpp_get<0xB1, 0xF>(v);
    v += dpp_get<0x4E, 0xF>(v);
    v += dpp_get<0x141, 0xF>(v);
    v += dpp_get<0x140, 0xF>(v);
    return v;
}
__device__ __forceinline__ float quad_sum(float v) { v += dpp_get<0xB1, 0xF>(v); v += dpp_get<0x4E, 0xF>(v); return v; }
__device__ __forceinline__ float wave_sum(float v) {
    v = row16_sum(v);
    v += dpp_get<0x142, 0xA>(v);
    v += dpp_get<0x143, 0xC>(v);
    return __builtin_bit_cast(float, __builtin_amdgcn_readlane(__builtin_bit_cast(int, v), 63));
}

namespace pg8 {
constexpr int BM = 256, BK = 64, HALF = 128, HTB = HALF * BK * 2, STAGE_BYTES = 8 * HTB, NXCD = 8, WGM = 8;
__host__ __device__ __forceinline__ int lds_byte(int r, int c) { const int st = (r >> 4) * 2 + (c >> 5), rr = r & 15, cc = c & 31, ob = rr * 64 + cc * 2; return st * 1024 + (ob ^ (((ob >> 9) & 1) << 5)); }
__host__ __device__ __forceinline__ void stage_rc(int b, int& R, int& C) { const int st = b / 1024, sb = b % 1024, swz = sb ^ (((sb >> 9) & 1) << 5); R = (st >> 1) * 16 + swz / 64; C = (st & 1) * 32 + (swz % 64) / 2; }
__host__ __device__ __forceinline__ int perm32(int rho) { const int n = rho >> 4, i = rho & 15; return 8 * (i >> 2) + 4 * n + (i & 3); }

typedef int v8i __attribute__((ext_vector_type(8))); typedef int v4i __attribute__((ext_vector_type(4)));
__device__ __forceinline__ v8i cat8(bf16x8 lo, bf16x8 hi) { const v4i a = __builtin_bit_cast(v4i, lo), b = __builtin_bit_cast(v4i, hi); return __builtin_shufflevector(a, b, 0, 1, 2, 3, 4, 5, 6, 7); }
struct Unit { int pm, pn, e, ui; };

__device__ __forceinline__ int xcd_remap(int L, int nwg) { const int q = nwg / NXCD, r = nwg % NXCD, xcd = L % NXCD, off = L / NXCD; return (xcd < r ? xcd * (q + 1) : r * (q + 1) + (xcd - r) * q) + off; }

struct PlainOrder {
    int nM, nN, nwg, G, c; const char* Bt; unsigned K2;
    __device__ void init(int M, int N, int K, const void* Bt_, int G_, int c_) { nM = M / BM; nN = N / BM; nwg = nM * nN; G = G_; c = c_; Bt = (const char*)Bt_; K2 = (unsigned)K * 2u; }
    __device__ __forceinline__ bool next(int i, Unit& u) const {
        const long L = (long)i * G + c; if (L >= nwg) return false;
        const int wgid = xcd_remap((int)L, nwg);
        const int nig = WGM * nN, gid = wgid / nig, fm = gid * WGM, gsz = (nM - fm) < WGM ? (nM - fm) : WGM;
        u.pm = fm + ((wgid % nig) % gsz); u.pn = (wgid % nig) / gsz; u.e = 0; u.ui = i; return true;
    }
    __device__ __forceinline__ const char* b_ptr(const Unit& u) const { return Bt + (size_t)u.pn * BM * K2; }
    __device__ __forceinline__ unsigned a_off(const Unit& u, int r) const { return (unsigned)(u.pm * BM + r + (meta ? NMETA * ((u.pm >> 4) + 1) : 0)) * K2; }
    int meta = 0;
};
constexpr int UD_CAP = 24;
template <bool GATHER> struct MoeOrder {
    const LAS int* tpre; const LAS int* tok; const LAS int* ud; int nN, nwg, G, c; const char* Bt; size_t estride; unsigned K2;
    __device__ __forceinline__ int decode(int i) const {
        const long L = (long)i * G + c; if (L >= nwg) return -1;
        const int wgid = xcd_remap((int)L, nwg);
        int e = 0;
#pragma unroll 1
        for (int j = 1; j < NEXP; ++j) e = (wgid >= tpre[j] * nN) ? j : e;
        const int t0 = tpre[e], nt = tpre[e + 1] - t0, loc = wgid - t0 * nN;
        return e | ((t0 + loc % nt) << 6) | ((loc / nt) << 16);
    }
    __device__ __forceinline__ void fill_units(LAS int* udw, int tid) const { if (tid < UD_CAP) udw[tid] = decode(tid); }
    __device__ __forceinline__ bool next(int i, Unit& u) const {
        if (i >= UD_CAP) return false;
        const int d = ud[i]; if (d < 0) return false;
        u.e = d & 63; u.pm = (d >> 6) & 1023; u.pn = d >> 16; u.ui = i; return true;
    }
    __device__ __forceinline__ const char* b_ptr(const Unit& u) const { return Bt + (size_t)u.e * estride + (size_t)u.pn * BM * K2; }
    __device__ __forceinline__ unsigned a_off(const Unit& u, int r) const {
        if (GATHER) return (unsigned)(tok[u.ui * 256 + r] & 0x3fff) * K2;
        return (unsigned)(u.pm * BM + r) * K2;
    }
};

struct EpiBf16 {
    static constexpr bool PERM = true;
    bf16_t* O; int ldc; int meta; const float* ebias = nullptr;
    const float* rscale = nullptr;
    __device__ __forceinline__ void operator()(const f32x4 (&acc)[2][2][4][2], const Unit& u, int wr, int wc, int fr, int fq) const {
        const int row0 = u.pm * BM + wr * 64 + fr + (meta ? NMETA * ((u.pm >> 4) + 1) : 0), col0 = u.pn * BM + wc * 32 + 8 * fq;
        f32x4 bv[2][2];
#pragma unroll
        for (int bj = 0; bj < 2; ++bj)
#pragma unroll
            for (int n = 0; n < 2; ++n) bv[bj][n] = ebias ? *(const f32x4*)(ebias + (size_t)u.e * ldc + col0 + bj * HALF + 4 * n) : (f32x4){0.f, 0.f, 0.f, 0.f};
#pragma unroll
        for (int ai = 0; ai < 2; ++ai)
#pragma unroll
            for (int m = 0; m < 4; ++m) { bf16_t* rowp = O + (size_t)(row0 + ai * HALF + m * 16) * ldc + col0; const float rsc = rscale ? rscale[row0 + ai * HALF + m * 16] : 1.0f;
#pragma unroll
                for (int bj = 0; bj < 2; ++bj) { const f32x4 v0 = acc[ai][bj][m][0] * rsc + bv[bj][0], v1 = acc[ai][bj][m][1] * rsc + bv[bj][1];
                    u32x4 w; w.x = cvt_pk_bf16(v0[0], v0[1]); w.y = cvt_pk_bf16(v0[2], v0[3]); w.z = cvt_pk_bf16(v1[0], v1[1]); w.w = cvt_pk_bf16(v1[2], v1[3]);
                    *(u32x4*)(rowp + bj * HALF) = w; } }
    }
};
constexpr float Y8_SCALE = 16.0f;
struct EpiFp8Bias {
    static constexpr bool PERM = true;
    unsigned char* O; int ldc; const float* ebias;
    __device__ __forceinline__ void operator()(const f32x4 (&acc)[2][2][4][2], const Unit& u, int wr, int wc, int fr, int fq) const {
        const int row0 = u.pm * BM + wr * 64 + fr, col0 = u.pn * BM + wc * 32 + 8 * fq;
        f32x4 bv[2][2];
#pragma unroll
        for (int bj = 0; bj < 2; ++bj)
#pragma unroll
            for (int n = 0; n < 2; ++n) bv[bj][n] = *(const f32x4*)(ebias + (size_t)u.e * ldc + col0 + bj * HALF + 4 * n);
#pragma unroll
        for (int ai = 0; ai < 2; ++ai)
#pragma unroll
            for (int m = 0; m < 4; ++m) { unsigned char* rowp = O + (size_t)(row0 + ai * HALF + m * 16) * ldc + col0;
#pragma unroll
                for (int bj = 0; bj < 2; ++bj) { const f32x4 v0 = (acc[ai][bj][m][0] + bv[bj][0]) * Y8_SCALE, v1 = (acc[ai][bj][m][1] + bv[bj][1]) * Y8_SCALE;
                    u32x2 w; w.x = pk4_fp8(v0[0], v0[1], v0[2], v0[3]); w.y = pk4_fp8(v1[0], v1[1], v1[2], v1[3]);
                    *(u32x2*)(rowp + bj * HALF) = w; } }
    }
};
struct EpiResF32 {
    static constexpr bool PERM = false;
    const float* X; float* out; int ldc;
    __device__ __forceinline__ void operator()(const f32x4 (&acc)[2][2][4][2], const Unit& u, int wr, int wc, int fr, int fq) const {
        const int row0 = u.pm * BM + wr * 64 + fr, col0 = u.pn * BM + wc * 32 + 4 * fq;
#pragma unroll
        for (int ai = 0; ai < 2; ++ai) {
            f32x4 xv[4][2][2];
#pragma unroll
            for (int m = 0; m < 4; ++m) { const size_t off = (size_t)(row0 + ai * HALF + m * 16) * ldc + col0;
#pragma unroll
                for (int bj = 0; bj < 2; ++bj)
#pragma unroll
                    for (int n = 0; n < 2; ++n) xv[m][bj][n] = *(const f32x4*)(X + off + bj * HALF + n * 16); }
#pragma unroll
            for (int m = 0; m < 4; ++m) { const size_t off = (size_t)(row0 + ai * HALF + m * 16) * ldc + col0;
#pragma unroll
                for (int bj = 0; bj < 2; ++bj)
#pragma unroll
                    for (int n = 0; n < 2; ++n) *(f32x4*)(out + off + bj * HALF + n * 16) = xv[m][bj][n] + acc[ai][bj][m][n]; }
            asm volatile("" ::: "memory"); }
    }
};
__device__ __forceinline__ unsigned swiglu2_fp8(f32x2 g, f32x2 uu, unsigned w, bool hi) {
    g.x = fminf(g.x, 7.0f); g.y = fminf(g.y, 7.0f); uu.x = fminf(fmaxf(uu.x, -7.0f), 7.0f); uu.y = fminf(fmaxf(uu.y, -7.0f), 7.0f);
    const f32x2 t = g * (-1.702f * 1.4426950408889634f);
    f32x2 e; e.x = __builtin_amdgcn_exp2f(t.x); e.y = __builtin_amdgcn_exp2f(t.y);
    const f32x2 d = e + 1.0f;
    f32x2 r; r.x = __builtin_amdgcn_rcpf(d.x); r.y = __builtin_amdgcn_rcpf(d.y);
    const f32x2 o = (uu + 1.0f) * g * r;
    return hi ? __builtin_amdgcn_cvt_pk_fp8_f32(o.x, o.y, w, true) : __builtin_amdgcn_cvt_pk_fp8_f32(o.x, o.y, w, false);
}
struct EpiSwiGLU {
    static constexpr bool PERM = true;
    unsigned char* act; const float* bgu;
    const LAS int* tok;
    __device__ __forceinline__ void operator()(const f32x4 (&acc)[2][2][4][2], const Unit& u, int wr, int wc, int fr, int fq) const {
        const int row0 = u.pm * BM + wr * 64 + fr, col0 = u.pn * HALF + wc * 32 + 8 * fq;
        const float* bg = bgu + (size_t)u.e * 4096 + col0;
        const f32x4 bg0 = *(const f32x4*)(bg), bg1 = *(const f32x4*)(bg + 4), bu0 = *(const f32x4*)(bg + 2048), bu1 = *(const f32x4*)(bg + 2052);
#pragma unroll
        for (int ai = 0; ai < 2; ++ai)
#pragma unroll
            for (int m = 0; m < 4; ++m) { unsigned char* rowp = act + (size_t)(row0 + ai * HALF + m * 16) * DE + col0;
                const float rsc = __uint_as_float((unsigned)tok[u.ui * 256 + wr * 64 + fr + ai * HALF + m * 16] & 0xffffc000u);
                const f32x4 g0 = acc[ai][0][m][0] * rsc + bg0, g1 = acc[ai][0][m][1] * rsc + bg1, u0 = acc[ai][1][m][0] * rsc + bu0, u1 = acc[ai][1][m][1] * rsc + bu1;
                u32x2 w; w.x = swiglu2_fp8(g0.zw, u0.zw, swiglu2_fp8(g0.xy, u0.xy, 0u, false), true);
                w.y = swiglu2_fp8(g1.zw, u1.zw, swiglu2_fp8(g1.xy, u1.xy, 0u, false), true);
                *(u32x2*)rowp = w; }
    }
};

template <class Epi, class Sched, bool ALIGN_EPI, bool SP2, bool FP8 = false>
__device__ __forceinline__ void gemm_phase(LAS unsigned char* lds, const char* A0, int Kb, const Sched& S, const Epi& E) {
    const int tid = threadIdx.x, wid = __builtin_amdgcn_readfirstlane(tid >> 6), lane = tid & 63, wr = wid >> 2, wc = wid & 3, fr = lane & 15, fq = lane >> 4;
    const int nt = Kb / 128;
    int Rr[2], Cc[2]; unsigned voffB[2];
#pragma unroll
    for (int i = 0; i < 2; ++i) { int R, C; stage_rc(tid * 16 + i * 8192, R, C); const int Rb = Epi::PERM ? ((R & ~31) + perm32(R & 31)) : R;
        Rr[i] = R; Cc[i] = C * 2; voffB[i] = (unsigned)(Rb * Kb + C * 2); }
    const size_t kstep = (size_t)(BK * 2);
    const size_t hstep = (size_t)HALF * Kb;
    const unsigned ldsw = (unsigned)wid * 1024u;
    const int aoff = lds_byte(wr * 64 + fr, fq * 8), boff = lds_byte(wc * 32 + fr, fq * 8);
#define PG8_SA(b, h) (((b) * 2 + (h)) * HTB)
#define PG8_SB(b, h) ((4 + (b) * 2 + (h)) * HTB)
#define PG8_STAGE(bufoff, gbase, voff) do { _Pragma("unroll") for (int _i = 0; _i < 2; ++_i) \
        __builtin_amdgcn_global_load_lds((const unsigned*)((const char*)(gbase) + (voff)[_i]), (LAS unsigned*)(lds + (bufoff) + ldsw + _i * 8192), 16, 0, 0); } while (0)
#define PG8_LDA(dst, b, h) do { _Pragma("unroll") for (int m = 0; m < 4; ++m) _Pragma("unroll") for (int k = 0; k < 2; ++k) dst[m][k] = *(const LAS bf16x8*)(lds + PG8_SA(b, h) + aoff + m * 2048 + k * 1024); } while (0)
#define PG8_LDB(dst, b, h) do { _Pragma("unroll") for (int n = 0; n < 2; ++n) _Pragma("unroll") for (int k = 0; k < 2; ++k) dst[n][k] = *(const LAS bf16x8*)(lds + PG8_SB(b, h) + boff + n * 2048 + k * 1024); } while (0)
#define PG8_MMA(ai, bj, At, Bt) do { __builtin_amdgcn_s_setprio(1); _Pragma("unroll") for (int m = 0; m < 4; ++m) _Pragma("unroll") for (int n = 0; n < 2; ++n) { \
        if constexpr (FP8) acc[ai][bj][m][n] = __builtin_amdgcn_mfma_scale_f32_16x16x128_f8f6f4(cat8(Bt[n][0], Bt[n][1]), cat8(At[m][0], At[m][1]), acc[ai][bj][m][n], 0, 0, 0, 0x79797979, 0, 0x7f7f7f7f); \
        else { _Pragma("unroll") for (int k = 0; k < 2; ++k) acc[ai][bj][m][n] = __builtin_amdgcn_mfma_f32_16x16x32_bf16(Bt[n][k], At[m][k], acc[ai][bj][m][n], 0, 0, 0); } } \
        __builtin_amdgcn_s_setprio(0); } while (0)
#define PG8_WAIT_V(n) asm volatile("s_waitcnt vmcnt(" #n ")" ::: "memory")
#define PG8_WAIT_L(n) asm volatile("s_waitcnt lgkmcnt(" #n ")" ::: "memory")
#define PG8_BAR __builtin_amdgcn_s_barrier()
#define PG8_SCHED __builtin_amdgcn_sched_barrier(0)
#define PG8_VOFF(dst, u) do { _Pragma("unroll") for (int _h = 0; _h < 2; ++_h) _Pragma("unroll") for (int _i = 0; _i < 2; ++_i) dst[_h][_i] = S.a_off(u, _h * HALF + Rr[_i]) + (unsigned)Cc[_i]; } while (0)
    Unit cur, nxt; int ui = 0;
    if (!S.next(0, cur)) return;
    f32x4 acc[2][2][4][2];
#pragma unroll
    for (int a = 0; a < 2; ++a)
#pragma unroll
        for (int b = 0; b < 2; ++b)
#pragma unroll
            for (int m = 0; m < 4; ++m)
#pragma unroll
                for (int n = 0; n < 2; ++n) acc[a][b][m][n] = (f32x4){0.f, 0.f, 0.f, 0.f};
    bf16x8 At[4][2], B0[2][2], B1[2][2];
    unsigned va[2][2], vn[2][2];
    PG8_VOFF(va, cur);
    const char* cB = S.b_ptr(cur);
    if constexpr (SP2) {
        PG8_STAGE(PG8_SB(0, 0), cB, voffB); PG8_STAGE(PG8_SB(0, 1), cB + hstep, voffB); PG8_STAGE(PG8_SA(0, 0), A0, va[0]); PG8_STAGE(PG8_SA(0, 1), A0, va[1]);
        if (wr == 1) PG8_BAR;
        PG8_WAIT_V(2); PG8_BAR;
        PG8_STAGE(PG8_SB(1, 0), cB + kstep, voffB); PG8_STAGE(PG8_SA(1, 0), A0 + kstep, va[0]); PG8_STAGE(PG8_SB(1, 1), cB + hstep + kstep, voffB);
        PG8_WAIT_V(6); PG8_BAR;
    } else {
        PG8_STAGE(PG8_SB(0, 0), cB, voffB); PG8_STAGE(PG8_SA(0, 0), A0, va[0]); PG8_STAGE(PG8_SB(0, 1), cB + hstep, voffB); PG8_STAGE(PG8_SA(0, 1), A0, va[1]);
        if (wr == 1) PG8_BAR;
        PG8_WAIT_V(4); PG8_BAR;
        PG8_STAGE(PG8_SB(1, 0), cB + kstep, voffB); PG8_STAGE(PG8_SA(1, 0), A0 + kstep, va[0]); PG8_STAGE(PG8_SB(1, 1), cB + hstep + kstep, voffB);
        PG8_WAIT_V(6); PG8_BAR;
    }
    for (;;) {
        const bool has_next = S.next(ui + 1, nxt);
        const char* nB = has_next ? S.b_ptr(nxt) : cB;
        for (int t = 0; t < nt; t += 2) {
            const bool last = (t == nt - 2);
            const char* a1 = A0 + (size_t)(t + 1) * kstep;
            const char* a2 = last ? A0 : A0 + (size_t)(t + 2) * kstep; const char* b2 = last ? nB : cB + (size_t)(t + 2) * kstep;
            const char* a3 = a2 + kstep; const char* b3 = b2 + kstep;
            if (last) { if (has_next) { PG8_VOFF(vn, nxt); } else {
#pragma unroll
                    for (int _h = 0; _h < 2; ++_h)
#pragma unroll
                        for (int _i = 0; _i < 2; ++_i) vn[_h][_i] = va[_h][_i]; } }
            if constexpr (SP2) {
            PG8_LDB(B0, 0, 0); PG8_LDB(B1, 0, 1); PG8_SCHED; PG8_LDA(At, 0, 0); PG8_STAGE(PG8_SA(1, 1), a1, va[1]);
            if (last) {
#pragma unroll
                for (int _h = 0; _h < 2; ++_h)
#pragma unroll
                    for (int _i = 0; _i < 2; ++_i) va[_h][_i] = vn[_h][_i]; }
            PG8_WAIT_V(8); PG8_WAIT_L(0); PG8_BAR; PG8_MMA(0, 0, At, B0); PG8_MMA(0, 1, At, B1); PG8_BAR; PG8_SCHED;
            PG8_LDA(At, 0, 1); PG8_STAGE(PG8_SB(0, 0), b2, voffB); PG8_STAGE(PG8_SB(0, 1), b2 + hstep, voffB); PG8_STAGE(PG8_SA(0, 0), a2, va[0]);
            PG8_WAIT_V(8); PG8_WAIT_L(0); PG8_BAR; PG8_MMA(1, 0, At, B0); PG8_MMA(1, 1, At, B1); PG8_BAR; PG8_SCHED;
            PG8_LDB(B0, 1, 0); PG8_LDB(B1, 1, 1); PG8_SCHED; PG8_LDA(At, 1, 0); PG8_STAGE(PG8_SA(0, 1), a2, va[1]);
            PG8_WAIT_V(8); PG8_WAIT_L(0); PG8_BAR; PG8_MMA(0, 0, At, B0); PG8_MMA(0, 1, At, B1); PG8_BAR; PG8_SCHED;
            PG8_LDA(At, 1, 1); PG8_STAGE(PG8_SB(1, 0), b3, voffB); PG8_STAGE(PG8_SB(1, 1), b3 + hstep, voffB); PG8_STAGE(PG8_SA(1, 0), a3, va[0]);
            PG8_WAIT_V(8); PG8_WAIT_L(0); PG8_BAR; PG8_MMA(1, 0, At, B0); PG8_MMA(1, 1, At, B1); PG8_BAR; PG8_SCHED;
            } else {
            PG8_LDB(B0, 0, 0); PG8_SCHED; PG8_LDA(At, 0, 0); PG8_STAGE(PG8_SA(1, 1), a1, va[1]);
            if (last) {
#pragma unroll
                for (int _h = 0; _h < 2; ++_h)
#pragma unroll
                    for (int _i = 0; _i < 2; ++_i) va[_h][_i] = vn[_h][_i]; }
            PG8_WAIT_L(8); PG8_BAR; PG8_WAIT_L(0); PG8_MMA(0, 0, At, B0); PG8_BAR; PG8_SCHED;
            PG8_LDB(B1, 0, 1); PG8_STAGE(PG8_SB(0, 0), b2, voffB);
            PG8_BAR; PG8_WAIT_L(0); PG8_MMA(0, 1, At, B1); PG8_BAR;
            PG8_LDA(At, 0, 1); PG8_STAGE(PG8_SA(0, 0), a2, va[0]);
            PG8_BAR; PG8_WAIT_L(0); PG8_MMA(1, 0, At, B0); PG8_BAR; PG8_SCHED;
            PG8_STAGE(PG8_SB(0, 1), b2 + hstep, voffB);
            PG8_WAIT_V(6); PG8_BAR; PG8_MMA(1, 1, At, B1); PG8_BAR;
            PG8_LDB(B0, 1, 0); PG8_SCHED; PG8_LDA(At, 1, 0); PG8_STAGE(PG8_SA(0, 1), a2, va[1]);
            PG8_WAIT_L(8); PG8_BAR; PG8_WAIT_L(0); PG8_MMA(0, 0, At, B0); PG8_BAR; PG8_SCHED;
            PG8_LDB(B1, 1, 1); PG8_STAGE(PG8_SB(1, 0), b3, voffB);
            PG8_BAR; PG8_WAIT_L(0); PG8_MMA(0, 1, At, B1); PG8_BAR;
            PG8_LDA(At, 1, 1); PG8_STAGE(PG8_SA(1, 0), a3, va[0]);
            PG8_BAR; PG8_WAIT_L(0); PG8_MMA(1, 0, At, B0); PG8_BAR; PG8_SCHED;
            PG8_STAGE(PG8_SB(1, 1), b3 + hstep, voffB);
            PG8_WAIT_V(6); PG8_BAR; PG8_MMA(1, 1, At, B1); PG8_BAR;
            }
        }
        if constexpr (ALIGN_EPI) { if (wr == 0) PG8_BAR; }
        E(acc, cur, wr, wc, fr, fq);
        if (!has_next) break;
#pragma unroll
        for (int a = 0; a < 2; ++a)
#pragma unroll
            for (int b = 0; b < 2; ++b)
#pragma unroll
                for (int m = 0; m < 4; ++m)
#pragma unroll
                    for (int n = 0; n < 2; ++n) acc[a][b][m][n] = (f32x4){0.f, 0.f, 0.f, 0.f};
        cur = nxt; cB = nB; ++ui;
        if constexpr (ALIGN_EPI) { if (wr == 1) PG8_BAR; }
    }
    PG8_WAIT_V(0);
    if constexpr (!ALIGN_EPI) { if (wr == 0) PG8_BAR; }
    PG8_BAR;
#undef PG8_SA
#undef PG8_SB
#undef PG8_STAGE
#undef PG8_LDA
#undef PG8_LDB
#undef PG8_MMA
#undef PG8_WAIT_V
#undef PG8_WAIT_L
#undef PG8_BAR
#undef PG8_SCHED
#undef PG8_VOFF
}
}

#define XB_TMO      128
#define XB_XCNT(j)  (256  + 64 * (j))
#define XB_XSUB(j)  (1280 + 64 * (j))
#define XB_XGEN(j)  (2304 + 64 * (j))
#define XB_TOP      3328
#define XB_TOPGEN   3392
#define XCD_BAR_WORDS 3456
#define XB_SPIN_CAP (1u << 18)

__device__ __forceinline__ unsigned xb_ld(unsigned* p)              { return __hip_atomic_load(p, __ATOMIC_RELAXED, __HIP_MEMORY_SCOPE_AGENT); }
__device__ __forceinline__ unsigned xb_add(unsigned* p, unsigned v) { return __hip_atomic_fetch_add(p, v, __ATOMIC_RELAXED, __HIP_MEMORY_SCOPE_AGENT); }
__device__ __forceinline__ unsigned xb_xcc_id() { return (unsigned)__builtin_amdgcn_s_getreg((3 << 11) | 20) & 0xFu; }
#define XB_SPIN(cond, bar) do { unsigned _sp = 0; while (cond) { __builtin_amdgcn_s_sleep(1); \
    if ((++_sp & 255u) == 0u) { if (xb_ld(&(bar)[XB_TMO])) break; if (_sp > XB_SPIN_CAP) { atomicAdd(&(bar)[XB_TMO], 1u); break; } } } } while (0)

struct XcdBarrier {
    unsigned* bar; unsigned x;
    volatile LAS unsigned* st;
};
__device__ __forceinline__ XcdBarrier xcd_barrier_post(unsigned* bar, volatile LAS unsigned* st) {
    XcdBarrier b; b.bar = bar; b.x = xb_xcc_id(); b.st = st;
    if (threadIdx.x == 0) (void)xb_add(&bar[XB_XCNT(b.x)], 1u);
    return b;
}
__device__ __forceinline__ void xcd_barrier_complete(unsigned* bar, unsigned x, unsigned& nloc, unsigned& nx) {
    const unsigned G = gridDim.x * gridDim.y * gridDim.z;
    unsigned sum, cnt, mine, sp = 0u;
    for (;;) {
        sum = 0u; cnt = 0u; mine = 0u;
#pragma unroll
        for (unsigned j = 0; j < 16; ++j) { const unsigned c = xb_ld(&bar[XB_XCNT(j)]); sum += c; cnt += (c > 0u) ? 1u : 0u; mine = (j == x) ? c : mine; }
        if (sum == G) break;
        __builtin_amdgcn_s_sleep(1);
        if ((++sp & 255u) == 0u) { if (xb_ld(&bar[XB_TMO])) break; if (sp > XB_SPIN_CAP) { atomicAdd(&bar[XB_TMO], 1u); break; } }
    }
    nloc = mine > 0u ? mine : 1u; nx = cnt > 0u ? cnt : 1u;
}
__device__ __forceinline__ void xcd_barrier(const XcdBarrier& b) {
    asm volatile("s_waitcnt vmcnt(0)" ::: "memory");
    __syncthreads();
    if (threadIdx.x == 0) {
        unsigned* bar = b.bar;
        __builtin_amdgcn_s_waitcnt(0);
        unsigned nloc = b.st[0], nx = b.st[1];
        if (nloc == 0u) { xcd_barrier_complete(bar, b.x, nloc, nx); b.st[0] = nloc; b.st[1] = nx; }
        const unsigned old = xb_add(&bar[XB_XSUB(b.x)], 1u);
        const unsigned gen = old / nloc;
        if (old + 1u == (gen + 1u) * nloc) {
            __builtin_amdgcn_fence(__ATOMIC_RELEASE, "agent");
            asm volatile("s_waitcnt vmcnt(0)" ::: "memory");
            const unsigned og = xb_add(&bar[XB_TOP], 1u);
            const unsigned tg = og / nx;
            if (og + 1u == (tg + 1u) * nx) xb_add(&bar[XB_TOPGEN], 1u);
            else XB_SPIN(xb_ld(&bar[XB_TOPGEN]) == tg, bar);
            __builtin_amdgcn_fence(__ATOMIC_ACQUIRE, "agent");
            xb_add(&bar[XB_XGEN(b.x)], 1u);
            asm volatile("s_waitcnt vmcnt(0)" ::: "memory");
        } else {
            XB_SPIN(xb_ld(&bar[XB_XGEN(b.x)]) == gen, bar);
            __builtin_amdgcn_fence(__ATOMIC_ACQUIRE, "agent");
            asm volatile("s_waitcnt vmcnt(0)" ::: "memory");
        }
    }
    __syncthreads();
}

constexpr int NWAVES = 8, NTHREADS = 512;
struct Args { const float* in[19]; float* out; unsigned char* ws; int ph_lo, ph_hi; };
enum { I_X = 0, I_META, I_MIXNW, I_WIN, I_CONVW, I_ALOG, I_DTB, I_GDNNW, I_SBQNW, I_SBKNW, I_SBONW, I_WOUT, I_FFNNW, I_RW, I_RB, I_WGU, I_BGU, I_WD, I_BD };

#define LDS_WAIT() asm volatile("s_waitcnt lgkmcnt(0)" ::: "memory")
#define VM_WAIT() asm volatile("s_waitcnt vmcnt(0)" ::: "memory")
constexpr int WLS = 2052;

__device__ __forceinline__ void dot16(const f32x4 (&v)[8], const LAS float* wl, int lane, float (&s)[16]) {
#pragma unroll
    for (int c = 0; c < 16; ++c) { float a = 0.f;
#pragma unroll
        for (int j = 0; j < 8; ++j) { const f32x4 w = *(const LAS f32x4*)(wl + c * WLS + 4 * lane + 256 * j); a += (v[j].x * w.x + v[j].y * w.y) + (v[j].z * w.z + v[j].w * w.w); }
        s[c] = wave_sum(a); }
}

template <int NR> __device__ __forceinline__ void dot8xN(const f32x4 (&v)[NR][8], const LAS float* wl, int lane, float (&out)[NR][8]) {
#pragma unroll
    for (int c = 0; c < 8; ++c) { float a[NR];
#pragma unroll
        for (int k = 0; k < NR; ++k) a[k] = 0.f;
#pragma unroll
        for (int j = 0; j < 8; ++j) { const f32x4 w = *(const LAS f32x4*)(wl + c * WLS + 4 * lane + 256 * j);
#pragma unroll
            for (int k = 0; k < NR; ++k) a[k] += (v[k][j].x * w.x + v[k][j].y * w.y) + (v[k][j].z * w.z + v[k][j].w * w.w); }
#pragma unroll
        for (int k = 0; k < NR; ++k) out[k][c] = wave_sum(a[k]); }
}
__device__ __forceinline__ void stage_w16(LAS float* wl, const float* base, int ld, int coloff, int tid) {
    f32x4 v[16];
#pragma unroll
    for (int i = 0; i < 16; ++i) { const int idx = tid + i * NTHREADS, k = idx >> 2, q = idx & 3; v[i] = *(const f32x4*)(base + (size_t)k * ld + coloff + 4 * q); }
#pragma unroll
    for (int i = 0; i < 16; ++i) { const int idx = tid + i * NTHREADS, k = idx >> 2, q = idx & 3;
        wl[(4 * q + 0) * WLS + k] = v[i].x; wl[(4 * q + 1) * WLS + k] = v[i].y; wl[(4 * q + 2) * WLS + k] = v[i].z; wl[(4 * q + 3) * WLS + k] = v[i].w; }
}

constexpr int XROW = 1040;
constexpr int XBUF = 64 * XROW;
constexpr int P5_LG = 2 * XBUF, P5_RS = P5_LG + 64 * 33 * 4, P5_WN = P5_RS + 512, P5_SSP = 65536;
__device__ __forceinline__ void p0_beta_g(float braw, float araw, float alog, float dtb, float& beta, float& g) {
    beta = 1.0f / (1.0f + expf(-braw));
    const float xa = araw + dtb; const float sp = fmaxf(xa, 0.f) + log1pf(expf(-fabsf(xa)));
    g = -expf(alog) * sp;
}
__device__ __forceinline__ void p0_rows(const Args& a, LAS unsigned char* lds, int G, int c, int tid) {
    const float* x = a.in[I_X]; const float* meta = a.in[I_META]; const float* nw = a.in[I_MIXNW]; const float* win = a.in[I_WIN];
    bf16_t* HN = (bf16_t*)(a.ws + WS_HN); float* BETA = (float*)(a.ws + WS_BETA); float* GG = (float*)(a.ws + WS_G);
    LAS float* ba = (LAS float*)(lds + P5_LG);
    LAS float* rs = (LAS float*)(lds + P5_RS);
    for (int blk = c; blk < NREAL / 64; blk += G) {
        asm volatile("" : "+v"(tid));
        const int wv = __builtin_amdgcn_readfirstlane(tid >> 6), lane = tid & 63, i16 = lane & 15, kq = lane >> 4;
        __syncthreads();
        const char* xg = (const char*)(x + (size_t)blk * 64 * DM) + lane * 16;
        const int rowbase = (blk * 64 / SEQ) * LSEQ + NMETA + (blk * 64) % SEQ;
#define P0_DMA(ch, b) do { _Pragma("unroll") for (int _r = 0; _r < 8; ++_r) \
        __builtin_amdgcn_global_load_lds((const unsigned*)(xg + (size_t)(wv * 8 + _r) * (DM * 4) + (ch) * 1024), (LAS unsigned*)(lds + (b) * XBUF + (wv * 8 + _r) * XROW), 16, 0, 0); } while (0)
        P0_DMA(0, 0); P0_DMA(1, 1);
        float Bv[8][8];
        unsigned kob = (unsigned)(32 * wv + 8 * kq) * 4u, lob = (unsigned)((32 * wv + 8 * kq) * NPROJ_SRC + 4096 + i16) * 4u; asm volatile("" : "+v"(kob), "+v"(lob));
        f32x4 w4[8][2];
        { float raw[8][8];
#pragma unroll
            for (int ch = 0; ch < 8; ++ch) {
#pragma unroll
                for (int q = 0; q < 2; ++q) w4[ch][q] = *(const f32x4*)((const char*)nw + (kob + (unsigned)((256 * ch + 4 * q) * 4)));
#pragma unroll
                for (int j = 0; j < 8; ++j) raw[ch][j] = *(const float*)((const char*)win + (lob + (unsigned)((256 * ch + j) * NPROJ_SRC * 4))); }
            __builtin_amdgcn_sched_barrier(0);
#pragma unroll
            for (int ch = 0; ch < 8; ++ch)
#pragma unroll
                for (int j = 0; j < 8; ++j) Bv[ch][j] = raw[ch][j] * w4[ch][j >> 2][j & 3];
            __builtin_amdgcn_sched_barrier(0); }
        f32x4 acc[4]; float ss[4];
#pragma unroll
        for (int rb = 0; rb < 4; ++rb) { acc[rb] = (f32x4){0.f, 0.f, 0.f, 0.f}; ss[rb] = 0.f; }
        asm volatile("s_waitcnt vmcnt(0)" ::: "memory");
#pragma unroll
        for (int ch = 0; ch < 8; ++ch) {
            if (ch == 7) asm volatile("s_waitcnt vmcnt(8)" ::: "memory"); else if (ch >= 1) asm volatile("s_waitcnt vmcnt(16)" ::: "memory");
            __builtin_amdgcn_s_barrier();
            const LAS unsigned char* xb = lds + (ch & 1) * XBUF + i16 * XROW + (32 * wv + 8 * kq) * 4;
            f32x4 av[4][2];
#pragma unroll
            for (int rb = 0; rb < 4; ++rb) { av[rb][0] = *(const LAS f32x4*)(xb + rb * 16 * XROW); av[rb][1] = *(const LAS f32x4*)(xb + rb * 16 * XROW + 16); }
            asm volatile("s_waitcnt lgkmcnt(0)" ::: "memory");
            __builtin_amdgcn_s_barrier();
            if (ch + 2 < 8) P0_DMA(ch + 2, ch & 1);
            __builtin_amdgcn_sched_barrier(0);
#pragma unroll
            for (int rb = 0; rb < 4; ++rb) { const f32x4 y0 = av[rb][0] * w4[ch][0], y1 = av[rb][1] * w4[ch][1];
                u32x4 ov; ov.x = cvt_pk_bf16(y0.x, y0.y); ov.y = cvt_pk_bf16(y0.z, y0.w); ov.z = cvt_pk_bf16(y1.x, y1.y); ov.w = cvt_pk_bf16(y1.z, y1.w);
                *(u32x4*)(HN + (size_t)(rowbase + 16 * rb + i16) * DM + 256 * ch + 32 * wv + 8 * kq) = ov; }
            __builtin_amdgcn_sched_barrier(0);
#pragma unroll
            for (int j = 0; j < 8; ++j)
#pragma unroll
                for (int rb = 0; rb < 4; ++rb) { const float xv = av[rb][j >> 2][j & 3];
                    ss[rb] += xv * xv; acc[rb] = __builtin_amdgcn_mfma_f32_16x16x4f32(xv, Bv[ch][j], acc[rb], 0, 0, 0); }
            __builtin_amdgcn_sched_barrier(0);
        }
#undef P0_DMA
        __builtin_amdgcn_s_barrier();
        { LAS float* red = (LAS float*)lds; LAS float* ssp = (LAS float*)(lds + 32768);
#pragma unroll
            for (int rb = 0; rb < 4; ++rb) {
#pragma unroll
                for (int v = 0; v < 4; ++v) red[(wv * 64 + 16 * rb + 4 * kq + v) * 16 + i16] = acc[rb][v];
                ssp[(wv * 4 + kq) * 64 + 16 * rb + i16] = ss[rb]; }
            __syncthreads();
            if (tid < 64) { float s2 = 0.f;
#pragma unroll
                for (int q = 0; q < 32; ++q) s2 += ssp[q * 64 + tid];
                const float rstd = 1.0f / sqrtf(s2 * (1.0f / DM) + NORM_EPS); rs[tid] = rstd; ((float*)(a.ws + WS_RSTD))[rowbase + tid] = rstd; }
            { const int t = tid >> 3, hh = tid & 7; float sb = 0.f, sa = 0.f;
#pragma unroll
                for (int w2 = 0; w2 < 8; ++w2) { sb += red[(w2 * 64 + t) * 16 + hh]; sa += red[(w2 * 64 + t) * 16 + 8 + hh]; }
                ba[t * 17 + hh] = sb; ba[t * 17 + 8 + hh] = sa; } }
        __syncthreads();
        { const int t = tid >> 3, hh = tid & 7; const float rstd = rs[t]; float beta, g;
            p0_beta_g(ba[t * 17 + hh] * rstd, ba[t * 17 + 8 + hh] * rstd, a.in[I_ALOG][hh], a.in[I_DTB][hh], beta, g);
            const int gr = blk * 64 + t, b = gr / SEQ, row = b * LSEQ + NMETA + (gr - b * SEQ);
            BETA[(size_t)row * 8 + hh] = beta; GG[(size_t)row * 8 + hh] = g; }
    }
    { asm volatile("" : "+v"(tid)); const int wv = __builtin_amdgcn_readfirstlane(tid >> 6), lane = tid & 63;
        if (wv == 7) for (int t = c; t < NMETA; t += G) {
            f32x4 v[8]; float ssm = 0.f;
#pragma unroll
            for (int j = 0; j < 8; ++j) { v[j] = *((const f32x4*)(meta + (size_t)t * DM) + lane + 64 * j); ssm += (v[j].x * v[j].x + v[j].y * v[j].y) + (v[j].z * v[j].z + v[j].w * v[j].w); }
            const float rstd = 1.0f / sqrtf(wave_sum(ssm) * (1.0f / DM) + NORM_EPS);
            GAS unsigned long long* o8 = (GAS unsigned long long*)(HN + (size_t)t * DM) + lane;
            float dsum[16];
#pragma unroll
            for (int n = 0; n < 16; ++n) dsum[n] = 0.f;
#pragma unroll
            for (int j = 0; j < 8; ++j) { const f32x4 y = v[j] * rstd * *((const f32x4*)nw + lane + 64 * j);
                o8[64 * j] = (unsigned long long)cvt_pk_bf16(y.x, y.y) | ((unsigned long long)cvt_pk_bf16(y.z, y.w) << 32);
#pragma unroll
                for (int kk = 0; kk < 4; ++kk) { const float* wr = win + (size_t)(4 * lane + 256 * j + kk) * NPROJ_SRC + 4096;
#pragma unroll
                    for (int q = 0; q < 4; ++q) { const f32x4 w = *(const f32x4*)(wr + 4 * q);
                        dsum[4 * q + 0] += y[kk] * w.x; dsum[4 * q + 1] += y[kk] * w.y; dsum[4 * q + 2] += y[kk] * w.z; dsum[4 * q + 3] += y[kk] * w.w; } } }
            float mine_b = 0.f, mine_a = 0.f; const int hh = lane & 7;
#pragma unroll
            for (int n = 0; n < 8; ++n) { const float sb = wave_sum(dsum[n]), sa = wave_sum(dsum[8 + n]); mine_b = (hh == n) ? sb : mine_b; mine_a = (hh == n) ? sa : mine_a; }
            if (lane < 32) { float beta, g; p0_beta_g(mine_b, mine_a, a.in[I_ALOG][hh], a.in[I_DTB][hh], beta, g);
                const int row = (lane >> 3) * LSEQ + t; BETA[(size_t)row * 8 + hh] = beta; GG[(size_t)row * 8 + hh] = g; } } }
    __syncthreads();
}

constexpr int CVT_STR = 132;
template <int MODE  >
__device__ __forceinline__ void cvt_tile(const float* W, int ldw, int K, bf16_t* out, int kb, int nt, LAS unsigned char* T, int lane) {
    const int r0 = nt * 64;
    int c0;
    if (MODE == 0) c0 = r0;
    else if (MODE == 1) c0 = r0 < 4096 ? r0 : r0 + 16;
    else { const int pn = r0 >> 8, rr = r0 & 255; c0 = rr < 128 ? 128 * pn + rr : 2048 + 128 * pn + (rr - 128); }
    const int kq = lane >> 4, nl = lane & 15;
    const float* src = W + (size_t)(kb * 64 + 2 * kq) * ldw + c0 + 4 * nl;
    f32x4 v[8][2];
#pragma unroll
    for (int i = 0; i < 8; ++i)
#pragma unroll
        for (int j = 0; j < 2; ++j) v[i][j] = *(const f32x4*)(src + (size_t)(8 * i + j) * ldw);
    LAS unsigned char* tw = T + (4 * nl) * CVT_STR + 4 * kq;
#pragma unroll
    for (int i = 0; i < 8; ++i)
#pragma unroll
        for (int q = 0; q < 4; ++q) *(LAS unsigned*)(tw + q * CVT_STR + 16 * i) = cvt_pk_bf16(v[i][0][q], v[i][1][q]);
    LDS_WAIT();
    const int rn = lane >> 3, cc = lane & 7;
    const LAS unsigned char* tr = T + rn * CVT_STR + 16 * cc;
    bf16_t* dst = out + (size_t)(r0 + rn) * K + kb * 64 + 8 * cc;
#pragma unroll
    for (int j = 0; j < 8; ++j) { u32x4 w; const LAS unsigned* p = (const LAS unsigned*)(tr + 8 * j * CVT_STR); w.x = p[0]; w.y = p[1]; w.z = p[2]; w.w = p[3];
        *(u32x4*)(dst + (size_t)(8 * j) * K) = w; }
    LDS_WAIT();
}
constexpr float W8_SCALE = 64.0f;
template <int MODE, int NLD = 8>
__device__ __forceinline__ void cvt_tile_fp8(const float* W, int ldw, int K, unsigned char* out, int kb, int nt, LAS unsigned char* T, int lane) {
    const int r0 = nt * 64;
    int c0;
    if (MODE == 0) c0 = r0;
    else { const int pn = r0 >> 8, rr = r0 & 255; c0 = rr < 128 ? 128 * pn + rr : 2048 + 128 * pn + (rr - 128); }
    const int kq = lane >> 4, nl = lane & 15;
    LAS unsigned char* tw = T + (4 * nl) * CVT_STR + 4 * kq;
    const float* src = W + (size_t)(kb * 128 + 4 * kq) * ldw + c0 + 4 * nl;
#pragma unroll
    for (int i0 = 0; i0 < 8; i0 += NLD) {
        f32x4 v[NLD][4];
#pragma unroll
        for (int i = 0; i < NLD; ++i)
#pragma unroll
            for (int j = 0; j < 4; ++j) v[i][j] = *(const f32x4*)(src + (size_t)(16 * (i0 + i) + j) * ldw);
#pragma unroll
        for (int i = 0; i < NLD; ++i)
#pragma unroll
            for (int q = 0; q < 4; ++q) *(LAS unsigned*)(tw + q * CVT_STR + 16 * (i0 + i)) =
                pk4_fp8(v[i][0][q] * W8_SCALE, v[i][1][q] * W8_SCALE, v[i][2][q] * W8_SCALE, v[i][3][q] * W8_SCALE);
    }
    LDS_WAIT();
    const int rn = lane >> 3, cc = lane & 7;
    const LAS unsigned char* tr = T + rn * CVT_STR + 16 * cc;
    unsigned char* dst = out + (size_t)(r0 + rn) * K + kb * 128 + 16 * cc;
#pragma unroll
    for (int j = 0; j < 8; ++j) { u32x4 w; const LAS unsigned* p = (const LAS unsigned*)(tr + 8 * j * CVT_STR); w.x = p[0]; w.y = p[1]; w.z = p[2]; w.w = p[3];
        *(u32x4*)(dst + (size_t)(8 * j) * K) = w; }
    LDS_WAIT();
}
__device__ __forceinline__ void p0_weights(const Args& a, LAS unsigned char* lds, int vcu, int G, int wave, int lane) {
    constexpr int I_IN = 32 * 14, I_OUT = 32 * 4;
    constexpr int NITEMS = I_IN + I_OUT;
    LAS unsigned char* T = lds + wave * (64 * CVT_STR);
    for (int it = vcu; it < NITEMS; it += G) {
        int r = it;
        if (r < I_IN) { cvt_tile<1>(a.in[I_WIN], NPROJ_SRC, DM, (bf16_t*)(a.ws + WS_WIN), r / 14, (r % 14) * 8 + wave, T, lane); continue; } r -= I_IN;
        cvt_tile<0>(a.in[I_WOUT], DM, DM, (bf16_t*)(a.ws + WS_WOUT), r / 4, (r % 4) * 8 + wave, T, lane);
    }
}
constexpr int MOE_I_GU = 8 * 4, MOE_I_D = 4 * 4, MOE_ITEMS = NEXP * (MOE_I_GU + MOE_I_D);
template <int NLD = 8> __device__ __forceinline__ void moe_weights_queue(const Args& a, LAS unsigned char* lds, LAS int* qslot, int tid, int wave, int lane, int limit) {
    unsigned* ctr = (unsigned*)(a.ws + WS_CTL) + CW_CVTQ;
    LAS unsigned char* T = lds + wave * (64 * CVT_STR);
    for (;;) {
        __syncthreads();
        if (tid == 0) { int v = (int)__hip_atomic_load(ctr, __ATOMIC_RELAXED, __HIP_MEMORY_SCOPE_AGENT); v = (v < limit) ? (int)atomicAdd(ctr, 1u) : MOE_ITEMS; *qslot = v; }
        __syncthreads();
        const int it = *(volatile LAS int*)qslot;
        if (it >= MOE_ITEMS) break;
        if (it < NEXP * MOE_I_GU) { const int e = it / MOE_I_GU, q = it % MOE_I_GU, ng = q & 7, kq = q >> 3;
#pragma unroll 1
            for (int kb = kq * 4; kb < kq * 4 + 4; ++kb)
                cvt_tile_fp8<2, NLD>(a.in[I_WGU] + (size_t)e * DM * 2 * DE, 2 * DE, DM, a.ws + WS_WGU + (size_t)e * 2 * DE * DM, kb, ng * 8 + wave, T, lane);
        } else { const int r = it - NEXP * MOE_I_GU, e = r / MOE_I_D, q = r % MOE_I_D, ng = q & 3, kq = q >> 2;
#pragma unroll 1
            for (int kb = kq * 4; kb < kq * 4 + 4; ++kb)
                cvt_tile_fp8<0, NLD>(a.in[I_WD] + (size_t)e * DE * DM, DM, DE, a.ws + WS_WD + (size_t)e * DM * DE, kb, ng * 8 + wave, T, lane);
        }
    }
}

__device__ __forceinline__ void p2_qknorm(const Args& a, int gw, int NGW, int lane) {
    const bf16_t* P = (const bf16_t*)(a.ws + WS_P); bf16_t* QN = (bf16_t*)(a.ws + WS_QN); bf16_t* KN = (bf16_t*)(a.ws + WS_KN);
    const float QS = 0.08838834764831845f * 1.4426950408889634f;
    const int cs = lane & 15, hq = lane >> 4;
    float qw[8], kw[8];
#pragma unroll
    for (int i = 0; i < 8; ++i) { qw[i] = a.in[I_SBQNW][8 * cs + i] * QS; kw[i] = a.in[I_SBKNW][8 * cs + i]; }
    constexpr int QB_ = 8, NIT = NTOK * 4;
    for (int it0 = gw; it0 < NIT; it0 += QB_ * NGW) {
        u32x4 w[QB_];
#pragma unroll
        for (int k = 0; k < QB_; ++k) { const int it = it0 + k * NGW; w[k] = (u32x4){0u, 0u, 0u, 0u};
            if (it < NIT) { const int which = it & 1, half = (it >> 1) & 1, row = it >> 2; w[k] = *(const u32x4*)(P + (size_t)row * NPROJ + (which ? PC_SBK : PC_SBQ) + half * 512 + 8 * lane); } }
#pragma unroll
        for (int k = 0; k < QB_; ++k) { const int it = it0 + k * NGW;
            if (it < NIT) { const int which = it & 1, half = (it >> 1) & 1, row = it >> 2; const int b = row / LSEQ, t = row - b * LSEQ, h = 4 * half + hq;
                float v[8]; v[0] = bf_lo(w[k].x); v[1] = bf_hi(w[k].x); v[2] = bf_lo(w[k].y); v[3] = bf_hi(w[k].y); v[4] = bf_lo(w[k].z); v[5] = bf_hi(w[k].z); v[6] = bf_lo(w[k].w); v[7] = bf_hi(w[k].w);
                float ss = 0.f;
#pragma unroll
                for (int i = 0; i < 8; ++i) ss += v[i] * v[i];
                const float rstd = 1.0f / sqrtf(row16_sum(ss) * (1.0f / HD) + NORM_EPS);
                float o[8];
#pragma unroll
                for (int i = 0; i < 8; ++i) o[i] = v[i] * rstd * (which ? kw[i] : qw[i]);
                u32x4 ov; ov.x = cvt_pk_bf16(o[0], o[1]); ov.y = cvt_pk_bf16(o[2], o[3]); ov.z = cvt_pk_bf16(o[4], o[5]); ov.w = cvt_pk_bf16(o[6], o[7]);
                *(u32x4*)((which ? KN : QN) + ((size_t)(b * NHEAD + h) * LROW + t) * HD + 8 * cs) = ov; } }
    }
}

__device__ __forceinline__ bf16x8 sba_pack8(const f32x16& p, int base) {
    u32x4 w; w.x = cvt_pk_bf16(p[base + 0], p[base + 1]); w.y = cvt_pk_bf16(p[base + 2], p[base + 3]); w.z = cvt_pk_bf16(p[base + 4], p[base + 5]); w.w = cvt_pk_bf16(p[base + 6], p[base + 7]);
    return __builtin_bit_cast(bf16x8, w);
}

namespace gdn {
constexpr int NCH = 65;
constexpr int IMG_W = 0, IMG_QG = 16384, IMG_KDT = 32768, IMG_AT = 49152, IMG_BYTES = 57344, IMG_U = 57344, CH_BYTES = 73728;
constexpr int L_LT = 0, L_GC = 19456, L_BE = 19712, L_QB = 19968, L_KB = 37376, L_VB = 54784, L_IMG = 72192;
__device__ __forceinline__ int afrag_off(int row, int k, int nks) {
    const int rt = row >> 5, rr = row & 31, ks = k >> 4, kk = k & 15, hi = (kk >> 2) & 1, sl = (kk & 3) + 4 * (kk >> 3);
    return ((rt * nks + ks) * 64 + rr + 32 * hi) * 16 + sl * 2;
}
__device__ __forceinline__ int ufrag_off(int i, int c) {
    const int cg = c >> 5, col = c & 31, rt = i >> 5, ii = i & 31, hi = (ii >> 2) & 1, r = (ii & 3) + 4 * (ii >> 3);
    return (((cg * 2 + rt) * 2 + (r >> 3)) * 64 + col + 32 * hi) * 8 + (r & 7);
}
__device__ __forceinline__ int crow(int r, int hi) { return (r & 3) + 8 * (r >> 2) + 4 * hi; }
__device__ __forceinline__ bf16_t f2bf(float f) { return (bf16_t)(cvt_pk_bf16(f, 0.f) & 0xffffu); }

__device__ __forceinline__ void prefetch_rows(const Args& a, int item, int lane, int wave, unsigned (&xwp)[33], float (&gbp)[2]) {
    if (item >= 32 * NCH) return;
    const int bh = item / NCH, c = item - bh * NCH, b = bh >> 3, h = bh & 7, tbase = 64 * c - 48;
    const bf16_t* P = (const bf16_t*)(a.ws + WS_P) + (size_t)b * LSEQ * NPROJ;
#pragma unroll
    for (int j = 0; j < 11; ++j) { const int t = tbase + 8 * wave - 3 + j;
#pragma unroll
        for (int w3 = 0; w3 < 3; ++w3) { unsigned u = 0u; if (t >= 0) u = *(const unsigned*)(P + (size_t)t * NPROJ + w3 * 1024 + h * HD + 2 * lane); xwp[j * 3 + w3] = u; } }
    if (wave == 0) { const int t = tbase + lane; float g = 0.f, be = 0.f;
        if (t >= 0) { g = ((const float*)(a.ws + WS_G))[((size_t)b * LSEQ + t) * 8 + h]; be = ((const float*)(a.ws + WS_BETA))[((size_t)b * LSEQ + t) * 8 + h]; }
        gbp[0] = g; gbp[1] = be; }
}
__device__ __forceinline__ void precompute(const Args& a, LAS unsigned char* lds, int item, int tid, int lane, int wave, unsigned (&xwp)[33], float (&gbp)[2], volatile LAS int* nslot, int nclaim) {
    asm volatile("" : "+v"(tid), "+v"(lane), "+s"(wave));
    const int bh = item / NCH, c = item - bh * NCH, b = bh >> 3, h = bh & 7;
    const bf16_t* P = (const bf16_t*)(a.ws + WS_P) + (size_t)b * LSEQ * NPROJ;
    const float* BETA = (const float*)(a.ws + WS_BETA) + (size_t)b * LSEQ * 8; const float* GG = (const float*)(a.ws + WS_G) + (size_t)b * LSEQ * 8;
    unsigned char* dst = a.ws + WS_GCH + (size_t)item * CH_BYTES;
    LAS float* GC = (LAS float*)(lds + L_GC); LAS float* BE = (LAS float*)(lds + L_BE); LAS float* LT = (LAS float*)(lds + L_LT);
    const int tbase = 64 * c - 48;
    if (wave == 0) {
        float g = gbp[0], be = gbp[1];
        g += dpp_get<0x111, 0xF>(g); g += dpp_get<0x112, 0xF>(g); g += dpp_get<0x114, 0xF>(g); g += dpp_get<0x118, 0xF>(g);
        g += dpp_get<0x142, 0xA>(g); g += dpp_get<0x143, 0xC>(g);
        GC[lane] = g; BE[lane] = be;
        if (lane == 63) ((float*)(a.ws + WS_GL))[item] = expf(g);
    }
    {
        f32x2 cw[3][4];
#pragma unroll
        for (int w3 = 0; w3 < 3; ++w3)
#pragma unroll
            for (int tap = 0; tap < 4; ++tap) cw[w3][tap] = *(const f32x2*)(a.in[I_CONVW] + tap * 3072 + w3 * 1024 + h * HD + 2 * lane);
        f32x2 xw[3][11];
#pragma unroll
        for (int j = 0; j < 11; ++j)
#pragma unroll
            for (int w3 = 0; w3 < 3; ++w3) { const unsigned u = xwp[j * 3 + w3]; xw[w3][j] = (f32x2){bf_lo(u), bf_hi(u)}; }
#pragma unroll
        for (int rr = 0; rr < 8; ++rr) { const int i = 8 * wave + rr; f32x2 y[3];
#pragma unroll
            for (int w3 = 0; w3 < 3; ++w3) { f32x2 acc = cw[w3][0] * xw[w3][rr] + cw[w3][1] * xw[w3][rr + 1] + cw[w3][2] * xw[w3][rr + 2] + cw[w3][3] * xw[w3][rr + 3];
                acc.x = acc.x * __builtin_amdgcn_rcpf(1.0f + __expf(-acc.x)); acc.y = acc.y * __builtin_amdgcn_rcpf(1.0f + __expf(-acc.y)); y[w3] = acc; }
            const float rq = 0.08838834764831845f * __builtin_amdgcn_rsqf(wave_sum(y[0].x * y[0].x + y[0].y * y[0].y) + NORM_EPS);
            const float rk = __builtin_amdgcn_rsqf(wave_sum(y[1].x * y[1].x + y[1].y * y[1].y) + NORM_EPS);
            *(LAS unsigned*)(lds + L_QB + i * 272 + 4 * lane) = cvt_pk_bf16(y[0].x * rq, y[0].y * rq);
            *(LAS unsigned*)(lds + L_KB + i * 272 + 4 * lane) = cvt_pk_bf16(y[1].x * rk, y[1].y * rk);
            *(LAS unsigned*)(lds + L_VB + i * 272 + 4 * lane) = cvt_pk_bf16(y[2].x, y[2].y); }
    }
    __syncthreads();
    {
        const int prod = wave >> 2, ti = (wave >> 1) & 1, tj = wave & 1, r32 = lane & 31, hi = lane >> 5;
        if (tj <= ti) {
            f32x16 acc;
#pragma unroll
            for (int r = 0; r < 16; ++r) acc[r] = 0.f;
            const LAS unsigned char* Ab = lds + (prod ? L_QB : L_KB) + (32 * ti + r32) * 272 + hi * 16;
            const LAS unsigned char* Bb = lds + L_KB + (32 * tj + r32) * 272 + hi * 16;
#pragma unroll
            for (int ks = 0; ks < 8; ++ks) acc = __builtin_amdgcn_mfma_f32_32x32x16_bf16(*(const LAS bf16x8*)(Ab + ks * 32), *(const LAS bf16x8*)(Bb + ks * 32), acc, 0, 0, 0);
            const int j = 32 * tj + r32; const float gj = GC[j];
#pragma unroll
            for (int r = 0; r < 16; ++r) { const int i = 32 * ti + crow(r, hi); const float dec = __expf(GC[i] - gj);
                if (prod == 0) LT[j * 76 + (i & 1) * 36 + (i >> 1)] = (j < i) ? acc[r] * BE[i] * dec : 0.f;
                else *(LAS bf16_t*)(lds + L_IMG + IMG_AT + afrag_off(i, j, 4)) = f2bf((j <= i) ? acc[r] * dec : 0.f); }
        }
    }
    if (tid == 0) *nslot = nclaim;
    __syncthreads();
    gdn::prefetch_rows(a, *nslot, lane, wave, xwp, gbp);
    {
        const int dk = tid & 127, i0 = (tid >> 7) * 16; const float gl = GC[63];
#pragma unroll 4
        for (int ii = 0; ii < 16; ++ii) { const int i = i0 + ii; const float gi = GC[i];
            const float q = bf2f(*(const LAS bf16_t*)(lds + L_QB + i * 272 + dk * 2)), k = bf2f(*(const LAS bf16_t*)(lds + L_KB + i * 272 + dk * 2));
            *(LAS bf16_t*)(lds + L_IMG + IMG_QG + afrag_off(i, dk, 8)) = f2bf(q * __expf(gi));
            *(LAS bf16_t*)(lds + L_IMG + IMG_KDT + afrag_off(dk, i, 4)) = f2bf(k * __expf(gl - gi)); }
    }
    {
        float x[32];
        const int cidx = tid >> 1, p = tid & 1, cc = cidx & 127; const bool isv = cidx < 128;
        const LAS unsigned char* src = lds + (isv ? L_VB : L_KB) + cc * 2 + p * 272;
        const LAS float* BEp = BE + p; const LAS float* GCp = GC + p; const LAS float* LTp = LT + p * 36;
#pragma unroll
        for (int r8 = 0; r8 < 32; r8 += 8) {
#pragma unroll
            for (int q = 0; q < 8; ++q) { const int r = r8 + q; const float v = bf2f(*(const LAS bf16_t*)(src + r * 544)); x[r] = v * BEp[2 * r] * (isv ? 1.0f : __expf(GCp[2 * r])); }
            asm volatile("" ::: "memory"); }
        f32x4 la[8], lb[8];
#define LT_LOAD(dst, j) do { _Pragma("unroll") for (int _c = ((((j) >> 1) + ((j) & 1)) >> 2); _c < 8; ++_c) dst[_c] = *(const LAS f32x4*)(LTp + (j) * 76 + 4 * _c); } while (0)
#define LT_APPLY(src_, j) do { const float _t = x[(j) >> 1]; const float _s = dpp_get<0xB1, 0xF>(_t); const float xj = (p == ((j) & 1)) ? _t : _s; \
        _Pragma("unroll") for (int _r = ((j) >> 1) + ((j) & 1); _r < 32; ++_r) x[_r] -= src_[_r >> 2][_r & 3] * xj; } while (0)
        LT_LOAD(la, 0);
#pragma unroll
        for (int jj = 0; jj < 31; ++jj) {
            LT_LOAD(lb, 2 * jj + 1); asm volatile("" ::: "memory"); LT_APPLY(la, 2 * jj);
            LT_LOAD(la, 2 * jj + 2); asm volatile("" ::: "memory"); LT_APPLY(lb, 2 * jj + 1);
        }
        LT_APPLY(la, 62);
#undef LT_LOAD
#undef LT_APPLY
        if (isv) {
            LAS unsigned char* ub = lds + L_IMG + IMG_U + (((cc >> 5) * 4 * 64) + (cc & 31)) * 16 + 2 * p;
#pragma unroll
            for (int r = 0; r < 32; ++r) { const int rt = r >> 4, hi = (r >> 1) & 1, rr = 2 * (r & 1) + 4 * ((r >> 2) & 3);
                *(LAS bf16_t*)(ub + (((rt * 2 + (rr >> 3)) * 64 + 32 * hi) * 8 + (rr & 7)) * 2) = f2bf(x[r]); }
        } else {
            const int ks = cc >> 4, kk = cc & 15, hi = (kk >> 2) & 1, sl = (kk & 3) + 4 * (kk >> 3);
            LAS unsigned char* wb = lds + L_IMG + IMG_W + (ks * 64 + 32 * hi) * 16 + sl * 2 + 16 * p;
#pragma unroll
            for (int r = 0; r < 32; ++r) *(LAS bf16_t*)(wb + ((r >> 4) * 8 * 64 + ((2 * r) & 31)) * 16) = f2bf(-x[r]);
        }
    }
    __syncthreads();
    for (int q = tid; q < CH_BYTES / 16; q += NTHREADS) *(u32x4*)(dst + (size_t)q * 16) = *(const LAS u32x4*)(lds + L_IMG + q * 16);
}

constexpr int OB_OFF = 2 * IMG_BYTES, OB_STR = 272, OB_BYTES = 64 * OB_STR;
__device__ __forceinline__ void gated_load_z(const Args& a, u32x4 (&zw)[4], int b, int h, int cc, int w4, int lane) {
    const bf16_t* P = (const bf16_t*)(a.ws + WS_P);
    const int s = 64 * (cc - 1) + 16 * w4 + (lane >> 2);
    const u32x4* zp = (const u32x4*)(P + ((size_t)b * LSEQ + NMETA + s) * NPROJ + PC_Z + h * HD + 32 * (lane & 3));
#pragma unroll
    for (int q = 0; q < 4; ++q) zw[q] = zp[q];
}
__device__ __forceinline__ float silu_f(float z) { return z * __builtin_amdgcn_rcpf(1.0f + __expf(-z)); }
__device__ __forceinline__ void gated_rows(const Args& a, const LAS unsigned char* ob, const u32x4 (&zw)[4], int b, int h, int cc, int w4, int lane, const f32x4 (&nwv)[8]) {
    bf16_t* MIX = (bf16_t*)(a.ws + WS_MIX);
    const int row = lane >> 2, qd = lane & 3, s = 64 * (cc - 1) + 16 * w4 + row;
    u32x4 ov[4]; float ss = 0.f;
#pragma unroll
    for (int q = 0; q < 4; ++q) { ov[q] = *(const LAS u32x4*)(ob + (16 * w4 + row) * OB_STR + qd * 64 + q * 16);
#pragma unroll
        for (int e = 0; e < 4; ++e) { const float lo = bf_lo(ov[q][e]), hi = bf_hi(ov[q][e]); ss += lo * lo + hi * hi; } }
    ss = quad_sum(ss);
    const float rstd = __builtin_amdgcn_rsqf(ss * (1.0f / HD) + NORM_EPS);
    u32x4* dst = (u32x4*)(MIX + ((size_t)b * SEQ + s) * DM + h * HD + 32 * qd);
#pragma unroll
    for (int q = 0; q < 4; ++q) { u32x4 w;
#pragma unroll
        for (int e = 0; e < 4; ++e) { const f32x4 nv = nwv[2 * q + (e >> 1)];
            const float n0 = (e & 1) ? nv.z : nv.x, n1 = (e & 1) ? nv.w : nv.y;
            w[e] = cvt_pk_bf16(bf_lo(ov[q][e]) * rstd * n0 * silu_f(bf_lo(zw[q][e])), bf_hi(ov[q][e]) * rstd * n1 * silu_f(bf_hi(zw[q][e]))); }
        dst[q] = w; }
}

__device__ __forceinline__ void scan(const Args& a, LAS unsigned char* lds, int bh, int tid, int lane, int wave) {
    const int b = bh >> 3, h = bh & 7, col = lane & 31, hi = lane >> 5, cg = wave;
    const unsigned char* src = a.ws + WS_GCH + (size_t)bh * NCH * CH_BYTES;
    const float* GL = (const float*)(a.ws + WS_GL) + bh * NCH;
    __syncthreads();
    const unsigned dvoff = (unsigned)(wave * 1024 + lane * 16), uvoff = (unsigned)(lane * 16);
#define GDN_DMA(ch, buf) do { const unsigned char* _sp = src + (size_t)(ch) * CH_BYTES; _Pragma("unroll") for (int _f = 0; _f < 7; ++_f) { \
        __builtin_amdgcn_global_load_lds((const unsigned*)(_sp + _f * 8192 + dvoff), (LAS unsigned*)(lds + (buf) * IMG_BYTES + wave * 1024 + _f * 8192), 16, 0, 0); } } while (0)
    GDN_DMA(0, 0);
#define GDN_STEP_END(vm) do { asm volatile("s_waitcnt vmcnt(" #vm ")" ::: "memory"); asm volatile("s_waitcnt lgkmcnt(0)" ::: "memory"); __builtin_amdgcn_s_barrier(); asm volatile("" ::: "memory"); } while (0)
    if (wave < 4) {
        f32x16 st[4]; bf16x8 Sb[8]; u32x4 ureg[4]; float gl;
#pragma unroll
        for (int t4 = 0; t4 < 4; ++t4)
#pragma unroll
            for (int r = 0; r < 16; ++r) st[t4][r] = 0.f;
#pragma unroll
        for (int ks = 0; ks < 8; ++ks) Sb[ks] = (bf16x8){0, 0, 0, 0, 0, 0, 0, 0};
#pragma unroll
        for (int q = 0; q < 4; ++q) ureg[q] = *(const u32x4*)(src + IMG_U + cg * 4096 + q * 1024 + uvoff);
        gl = GL[0];
        GDN_STEP_END(0);
        for (int c = 0; c < NCH; ++c) {
            const LAS unsigned char* img = lds + (c & 1) * IMG_BYTES + lane * 16;
            asm volatile("" : "+v"(ureg[0]), "+v"(ureg[1]), "+v"(ureg[2]), "+v"(ureg[3]), "+v"(gl));
            if (c + 1 < NCH) GDN_DMA(c + 1, (c + 1) & 1);
            f32x16 vn[2]; const float glc = gl;
#pragma unroll
            for (int rt = 0; rt < 2; ++rt)
#pragma unroll
                for (int rh = 0; rh < 2; ++rh) { const u32x4 w = ureg[rt * 2 + rh];
                    vn[rt][8 * rh + 0] = bf_lo(w.x); vn[rt][8 * rh + 1] = bf_hi(w.x); vn[rt][8 * rh + 2] = bf_lo(w.y); vn[rt][8 * rh + 3] = bf_hi(w.y);
                    vn[rt][8 * rh + 4] = bf_lo(w.z); vn[rt][8 * rh + 5] = bf_hi(w.z); vn[rt][8 * rh + 6] = bf_lo(w.w); vn[rt][8 * rh + 7] = bf_hi(w.w); }
            asm volatile("" ::: "memory");
            if (c + 1 < NCH) {
#pragma unroll
                for (int q = 0; q < 4; ++q) ureg[q] = *(const u32x4*)(src + (size_t)(c + 1) * CH_BYTES + IMG_U + cg * 4096 + q * 1024 + uvoff);
                gl = GL[c + 1]; }
#pragma unroll
            for (int rt = 0; rt < 2; ++rt) { __builtin_amdgcn_sched_barrier(0);
#pragma unroll
                for (int ks = 0; ks < 8; ++ks) vn[rt] = __builtin_amdgcn_mfma_f32_32x32x16_bf16(*(const LAS bf16x8*)(img + IMG_W + (rt * 8 + ks) * 1024), Sb[ks], vn[rt], 0, 0, 0); }
            __builtin_amdgcn_sched_barrier(0);
            bf16x8 vb[4];
#pragma unroll
            for (int ks = 0; ks < 4; ++ks) vb[ks] = sba_pack8(vn[ks >> 1], 8 * (ks & 1));
            LAS unsigned char* obw = lds + OB_OFF + (c & 1) * OB_BYTES + (32 * cg + col) * 2;
#pragma unroll
            for (int rt = 0; rt < 2; ++rt) { f32x16 o; __builtin_amdgcn_sched_barrier(0);
#pragma unroll
                for (int r = 0; r < 16; ++r) o[r] = 0.f;
#pragma unroll
                for (int ks = 0; ks < 8; ++ks) o = __builtin_amdgcn_mfma_f32_32x32x16_bf16(*(const LAS bf16x8*)(img + IMG_QG + (rt * 8 + ks) * 1024), Sb[ks], o, 0, 0, 0);
#pragma unroll
                for (int ks = 0; ks < 2 * (rt + 1); ++ks) o = __builtin_amdgcn_mfma_f32_32x32x16_bf16(*(const LAS bf16x8*)(img + IMG_AT + (rt * 4 + ks) * 1024), vb[ks], o, 0, 0, 0);
                if (c >= 1) {
#pragma unroll
                    for (int r = 0; r < 16; ++r) *(LAS bf16_t*)(obw + (32 * rt + crow(r, hi)) * OB_STR) = f2bf(o[r]); }
            }
#pragma unroll
            for (int t4 = 0; t4 < 4; ++t4) { __builtin_amdgcn_sched_barrier(0);
#pragma unroll
                for (int r = 0; r < 16; ++r) st[t4][r] *= glc;
#pragma unroll
                for (int ks = 0; ks < 4; ++ks) st[t4] = __builtin_amdgcn_mfma_f32_32x32x16_bf16(*(const LAS bf16x8*)(img + IMG_KDT + (t4 * 4 + ks) * 1024), vb[ks], st[t4], 0, 0, 0);
                Sb[2 * t4] = sba_pack8(st[t4], 0); Sb[2 * t4 + 1] = sba_pack8(st[t4], 8); }
            if (c + 1 < NCH) GDN_STEP_END(5); else GDN_STEP_END(0);
        }
    } else {
        u32x4 zA[4], zB[4]; f32x4 nwv[8];
#pragma unroll
        for (int q = 0; q < 4; ++q) { zA[q] = (u32x4){0u, 0u, 0u, 0u}; zB[q] = (u32x4){0u, 0u, 0u, 0u}; }
#pragma unroll
        for (int q = 0; q < 8; ++q) nwv[q] = *(const f32x4*)(a.in[I_GDNNW] + 32 * (lane & 3) + 4 * q);
        GDN_STEP_END(0);
        for (int c = 0; c < NCH; ++c) {
#pragma unroll
            for (int q = 0; q < 4; ++q) asm volatile("" : "+v"(zA[q]), "+v"(zB[q]));
            if (c + 1 < NCH) GDN_DMA(c + 1, (c + 1) & 1);
            if (c >= 1) { if (c & 1) gated_load_z(a, zA, b, h, c, wave - 4, lane); else gated_load_z(a, zB, b, h, c, wave - 4, lane); }
            asm volatile("" ::: "memory");
            if (c >= 2) { if (c & 1) gated_rows(a, lds + OB_OFF + ((c - 1) & 1) * OB_BYTES, zB, b, h, c - 1, wave - 4, lane, nwv);
                          else gated_rows(a, lds + OB_OFF + ((c - 1) & 1) * OB_BYTES, zA, b, h, c - 1, wave - 4, lane, nwv); }
            if (c >= 2) GDN_STEP_END(4); else GDN_STEP_END(0);
        }
        gated_rows(a, lds + OB_OFF + ((NCH - 1) & 1) * OB_BYTES, zB, b, h, NCH - 1, wave - 4, lane, nwv);
    }
#undef GDN_STEP_END
#undef GDN_DMA
}
}

namespace sba {
#define KSWZ(row, colB) ((row) * 256 + ((colB) ^ (((row) & 7) << 4)))
__device__ __forceinline__ int v_st(int k, int c) { const int kk = (k & ~0xC) | ((k & 4) << 1) | ((k & 8) >> 1); return ((kk >> 3) * 4 + (c >> 5)) * 512 + ((kk & 7) * 32 + (c & 31)) * 2; }
__device__ __forceinline__ int v_rd_base(int lane) { return ((lane & 3) << 3) | (((lane >> 2) & 3) << 6) | (((lane >> 4) & 1) << 5) | (((lane >> 5) & 1) << 8); }
constexpr int v_rd_off(int d0, int ks, int half) { return d0 * 512 + ks * 4096 + half * 2048; }
template <int OFF> __device__ __forceinline__ s16x4 tr_read(int vb) { s16x4 r; asm volatile("ds_read_b64_tr_b16 %0, %1 offset:%2" : "=&v"(r) : "v"(vb), "i"(OFF) : "memory"); return r; }
template <int D0> __device__ __forceinline__ void pv_one(f32x16& od, int vb, bf16x8 pa0, bf16x8 pa1, bf16x8 pa2, bf16x8 pa3) {
    const s16x4 l0 = tr_read<v_rd_off(D0, 0, 0)>(vb), h0 = tr_read<v_rd_off(D0, 0, 1)>(vb), l1 = tr_read<v_rd_off(D0, 1, 0)>(vb), h1 = tr_read<v_rd_off(D0, 1, 1)>(vb);
    const s16x4 l2 = tr_read<v_rd_off(D0, 2, 0)>(vb), h2 = tr_read<v_rd_off(D0, 2, 1)>(vb), l3 = tr_read<v_rd_off(D0, 3, 0)>(vb), h3 = tr_read<v_rd_off(D0, 3, 1)>(vb);
    asm volatile("s_waitcnt lgkmcnt(0)" ::: "memory"); __builtin_amdgcn_sched_barrier(0);
#define PK(L, H) (bf16x8){L[0], L[1], L[2], L[3], H[0], H[1], H[2], H[3]}
    od = __builtin_amdgcn_mfma_f32_32x32x16_bf16(pa0, PK(l0, h0), od, 0, 0, 0);
    od = __builtin_amdgcn_mfma_f32_32x32x16_bf16(pa1, PK(l1, h1), od, 0, 0, 0);
    od = __builtin_amdgcn_mfma_f32_32x32x16_bf16(pa2, PK(l2, h2), od, 0, 0, 0);
    od = __builtin_amdgcn_mfma_f32_32x32x16_bf16(pa3, PK(l3, h3), od, 0, 0, 0);
#undef PK
}
__device__ __forceinline__ int crow(int r, int hi) { return (r & 3) + 8 * (r >> 2) + 4 * hi; }
__device__ __forceinline__ int swap34(int k) { return (k & ~0x18) | ((k & 8) << 1) | ((k & 16) >> 1); }
__device__ __forceinline__ bf16x8 pack8(const f32x16& p, int base) {
    u32x4 w; w.x = cvt_pk_bf16(p[base + 0], p[base + 1]); w.y = cvt_pk_bf16(p[base + 2], p[base + 3]); w.z = cvt_pk_bf16(p[base + 4], p[base + 5]); w.w = cvt_pk_bf16(p[base + 6], p[base + 7]);
    return __builtin_bit_cast(bf16x8, w);
}
constexpr float SB_EXIT = 160.0f;

__device__ __forceinline__ void unit(const Args& a, LAS unsigned char* lds, volatile LAS int* done_cnt, int b, int h, int qb, int tid, int lane, int wid) {
    const bf16_t* QN = (const bf16_t*)(a.ws + WS_QN) + (size_t)(b * NHEAD + h) * LROW * HD;
    const bf16_t* KN = (const bf16_t*)(a.ws + WS_KN) + (size_t)(b * NHEAD + h) * LROW * HD;
    const bf16_t* Vp = (const bf16_t*)(a.ws + WS_P) + (size_t)b * LSEQ * NPROJ + PC_SBV + h * HD;
    bf16_t* MIX = (bf16_t*)(a.ws + WS_MIX);
    const int r32 = lane & 31, hi = lane >> 5;
    LAS unsigned char* K_lds = lds; LAS unsigned char* V_lds = lds + 16384;
    const int tq0 = NMETA + 256 * qb + 32 * wid, tq = tq0 + r32;
    __syncthreads();
    if (tid == 0) *done_cnt = 0;
    bf16x8 qr[8];
#pragma unroll
    for (int d0 = 0; d0 < 8; ++d0) qr[d0] = *(const bf16x8*)(QN + (size_t)tq * HD + d0 * 16 + hi * 8);
    const int sr = tid >> 4, sc = (tid & 15) * 8;
    const int vst0 = v_st(swap34(sr), sc), vst1 = v_st(32 + swap34(sr), sc);
    const int kst0 = KSWZ(sr, sc * 2), kst1 = KSWZ(32 + sr, sc * 2);
    const int vb0 = (int)(unsigned)(unsigned long)V_lds + v_rd_base(lane);
    const int prow = (r32 & 3) + 4 * (r32 >> 3) + 16 * ((r32 >> 2) & 1);
    f32x16 o[4];
#pragma unroll
    for (int d = 0; d < 4; ++d)
#pragma unroll
        for (int r = 0; r < 16; ++r) o[d][r] = 0.f;
    float carry = 0.f; bool flagged = false;
    bf16x8 ks0, ks1, vs0, vs1;
#define SBA_LOAD(kk) do { const int _k0 = 64 * (kk); ks0 = *(const bf16x8*)(KN + (size_t)(_k0 + sr) * HD + sc); ks1 = *(const bf16x8*)(KN + (size_t)(_k0 + 32 + sr) * HD + sc); \
        vs0 = *(const bf16x8*)(Vp + (size_t)(_k0 + sr) * NPROJ + sc); vs1 = *(const bf16x8*)(Vp + (size_t)(_k0 + 32 + sr) * NPROJ + sc); } while (0)
    SBA_LOAD(4 * qb + 4);
    for (int kt = 4 * qb + 4; kt >= 0; --kt) {
        const int k0 = 64 * kt;
        __syncthreads();
        if (*done_cnt == NWAVES) break;
        *(LAS bf16x8*)(K_lds + kst0) = ks0; *(LAS bf16x8*)(K_lds + kst1) = ks1; *(LAS bf16x8*)(V_lds + vst0) = vs0; *(LAS bf16x8*)(V_lds + vst1) = vs1;
        if (kt > 0) SBA_LOAD(kt - 1);
        __syncthreads();
        if (k0 >= tq0 + 32) continue;
        f32x16 p0, p1;
#pragma unroll
        for (int r = 0; r < 16; ++r) { p0[r] = 0.f; p1[r] = 0.f; }
#pragma unroll
        for (int d0 = 0; d0 < 8; ++d0) { const int cb = (d0 * 16 + hi * 8) * 2;
            const bf16x8 b0 = *(const LAS bf16x8*)(K_lds + KSWZ(prow, cb)), b1 = *(const LAS bf16x8*)(K_lds + KSWZ(32 + prow, cb));
            p0 = __builtin_amdgcn_mfma_f32_32x32x16_bf16(b0, qr[d0], p0, 0, 0, 0);
            p1 = __builtin_amdgcn_mfma_f32_32x32x16_bf16(b1, qr[d0], p1, 0, 0, 0); }
        const bool need_mask = (k0 + 63 >= tq0);
        f32x16 s0, s1; float t0 = 0.f, t1 = 0.f;
#pragma unroll
        for (int r = 0; r < 16; ++r) {
            float e0 = __builtin_amdgcn_exp2f(p0[r]), e1 = __builtin_amdgcn_exp2f(p1[r]);
            float q0 = __builtin_amdgcn_logf(1.0f + e0), q1 = __builtin_amdgcn_logf(1.0f + e1);
            if (need_mask) { const bool v0 = (k0 + 16 * hi + r) < tq, v1 = (k0 + 32 + 16 * hi + r) < tq; e0 = v0 ? e0 : 0.f; q0 = v0 ? q0 : 0.f; e1 = v1 ? e1 : 0.f; q1 = v1 ? q1 : 0.f; }
            p0[r] = e0; p1[r] = e1; s0[r] = q0; s1[r] = q1; t0 += q0; t1 += q1; }
        float t1lo, t1hi, t0lo, t0hi;
        { auto rr = __builtin_amdgcn_permlane32_swap(__float_as_uint(t1), __float_as_uint(t1), false, false); t1lo = __uint_as_float(rr[0]); t1hi = __uint_as_float(rr[1]); }
        { auto rr = __builtin_amdgcn_permlane32_swap(__float_as_uint(t0), __float_as_uint(t0), false, false); t0lo = __uint_as_float(rr[0]); t0hi = __uint_as_float(rr[1]); }
        float run1 = carry + (hi ? 0.f : t1hi), run0 = carry + (t1lo + t1hi) + (hi ? 0.f : t0hi);
#pragma unroll
        for (int r = 15; r >= 0; --r) { run1 += s1[r]; p1[r] = p1[r] * __builtin_amdgcn_exp2f(-run1); run0 += s0[r]; p0[r] = p0[r] * __builtin_amdgcn_exp2f(-run0); }
        carry += (t1lo + t1hi) + (t0lo + t0hi);
        const bf16x8 pa0 = pack8(p0, 0), pa1 = pack8(p0, 8), pa2 = pack8(p1, 0), pa3 = pack8(p1, 8);
        pv_one<0>(o[0], vb0, pa0, pa1, pa2, pa3); pv_one<1>(o[1], vb0, pa0, pa1, pa2, pa3); pv_one<2>(o[2], vb0, pa0, pa1, pa2, pa3); pv_one<3>(o[3], vb0, pa0, pa1, pa2, pa3);
        if (!flagged && __all(carry >= SB_EXIT)) { flagged = true; if (lane == 0) (void)__hip_atomic_fetch_add((LAS int*)done_cnt, 1, __ATOMIC_RELAXED, __HIP_MEMORY_SCOPE_WORKGROUP); }
    }
#undef SBA_LOAD
    const float* onw = a.in[I_SBONW];
    float wv[4];
#pragma unroll
    for (int d0 = 0; d0 < 4; ++d0) wv[d0] = onw[32 * d0 + r32];
#pragma unroll
    for (int r = 0; r < 16; ++r) {
        float ss = (o[0][r] * o[0][r] + o[1][r] * o[1][r]) + (o[2][r] * o[2][r] + o[3][r] * o[3][r]);
        ss = row16_sum(ss); ss += __shfl_xor(ss, 16);
        const float rstd = 1.0f / sqrtf(ss * (1.0f / HD) + NORM_EPS);
        const size_t tok = (size_t)b * SEQ + (tq0 - NMETA) + crow(r, hi);
        bf16_t* dst = MIX + tok * DM + 1024 + h * HD + r32;
#pragma unroll
        for (int d0 = 0; d0 < 4; ++d0) dst[32 * d0] = (bf16_t)(cvt_pk_bf16(o[d0][r] * rstd * wv[d0], 0.f) & 0xffffu);
    }
}
}

__device__ __forceinline__ void p5_router(const Args& a, LAS unsigned char* lds, int G, int c, int tid) {
    LAS float* lg = (LAS float*)(lds + P5_LG);
    LAS float* rs = (LAS float*)(lds + P5_RS);
    LAS int* misc = (LAS int*)(lds + MISC_OFF);
    const float* H1 = a.out; const float* rw = a.in[I_RW]; const float* rb = a.in[I_RB]; const float* wnp = a.in[I_FFNNW];
    unsigned char* HN2 = a.ws + WS_HN;
    int* RE = (int*)(a.ws + WS_RE); int* RP = (int*)(a.ws + WS_RP); float* RG = (float*)(a.ws + WS_RG); int* LIST = (int*)(a.ws + WS_LIST);
    unsigned* ecnt = (unsigned*)(a.ws + WS_CTL) + CW_ECNT;
    for (int blk = c; blk < NREAL / 64; blk += G) {
        asm volatile("" : "+v"(tid));
        const int wv = __builtin_amdgcn_readfirstlane(tid >> 6), lane = tid & 63, i32 = lane & 31, kh = lane >> 5;
        __syncthreads();
        const char* xg = (const char*)(H1 + (size_t)blk * 64 * DM) + lane * 16;
#define P5_DMA(ch, b) do { _Pragma("unroll") for (int _r = 0; _r < 8; ++_r) \
        __builtin_amdgcn_global_load_lds((const unsigned*)(xg + (size_t)(wv * 8 + _r) * (DM * 4) + (ch) * 1024), (LAS unsigned*)(lds + (b) * XBUF + (wv * 8 + _r) * XROW), 16, 0, 0); } while (0)
        P5_DMA(0, 0); P5_DMA(1, 1);
        *(LAS f32x4*)(lds + P5_WN + tid * 16) = *((const f32x4*)wnp + tid);
        float Bv[8][16];
        unsigned kob = (unsigned)(32 * wv + 16 * kh) * 4u, lob = (unsigned)((32 * wv + 16 * kh) * NEXP + i32) * 4u; asm volatile("" : "+v"(kob), "+v"(lob));
#pragma unroll
        for (int g2 = 0; g2 < 2; ++g2) { float raw[4][16]; f32x4 w4[4][4];
#pragma unroll
            for (int c4 = 0; c4 < 4; ++c4) { const int ch = g2 * 4 + c4;
#pragma unroll
                for (int q = 0; q < 4; ++q) w4[c4][q] = *(const f32x4*)((const char*)wnp + (kob + (unsigned)((256 * ch + 4 * q) * 4)));
#pragma unroll
                for (int j = 0; j < 16; ++j) raw[c4][j] = *(const float*)((const char*)rw + (lob + (unsigned)((256 * ch + j) * NEXP * 4))); }
            __builtin_amdgcn_sched_barrier(0);
#pragma unroll
            for (int c4 = 0; c4 < 4; ++c4)
#pragma unroll
                for (int j = 0; j < 16; ++j) Bv[g2 * 4 + c4][j] = raw[c4][j] * w4[c4][j >> 2][j & 3];
            __builtin_amdgcn_sched_barrier(0); }
        f32x16 acc0, acc1; float ss0 = 0.f, ss1 = 0.f;
#pragma unroll
        for (int v = 0; v < 16; ++v) { acc0[v] = 0.f; acc1[v] = 0.f; }
        asm volatile("s_waitcnt vmcnt(0)" ::: "memory");
#pragma unroll
        for (int ch = 0; ch < 8; ++ch) {
            if (ch == 7) asm volatile("s_waitcnt vmcnt(4)" ::: "memory"); else if (ch >= 1) asm volatile("s_waitcnt vmcnt(12)" ::: "memory");
            __builtin_amdgcn_s_barrier();
            const LAS unsigned char* xb = lds + (ch & 1) * XBUF + i32 * XROW + (32 * wv + 16 * kh) * 4;
            f32x4 a0[4], a1[4], wq[4];
#pragma unroll
            for (int q = 0; q < 4; ++q) { a0[q] = *(const LAS f32x4*)(xb + 16 * q); a1[q] = *(const LAS f32x4*)(xb + 32 * XROW + 16 * q); wq[q] = *(const LAS f32x4*)(lds + P5_WN + (256 * ch + 32 * wv + 16 * kh + 4 * q) * 4); }
            asm volatile("s_waitcnt lgkmcnt(0)" ::: "memory");
            __builtin_amdgcn_s_barrier();
            if (ch + 2 < 8) P5_DMA(ch + 2, ch & 1);
            __builtin_amdgcn_sched_barrier(0);
            { u32x4 o0, o1;
#pragma unroll
                for (int q = 0; q < 4; ++q) { const f32x4 y0 = a0[q] * wq[q], y1 = a1[q] * wq[q]; o0[q] = pk4_fp8(y0.x, y0.y, y0.z, y0.w); o1[q] = pk4_fp8(y1.x, y1.y, y1.z, y1.w); }
                unsigned char* dst = HN2 + ((size_t)blk * 64 + i32) * DM + 256 * ch + 32 * wv + 16 * kh;
                *(u32x4*)dst = o0; *(u32x4*)(dst + (size_t)32 * DM) = o1; }
            __builtin_amdgcn_sched_barrier(0);
#pragma unroll
            for (int q = 0; q < 4; ++q)
#pragma unroll
                for (int jj = 0; jj < 4; ++jj) { const float x0 = a0[q][jj], x1 = a1[q][jj], bw = Bv[ch][4 * q + jj];
                    ss0 += x0 * x0; ss1 += x1 * x1;
                    acc0 = __builtin_amdgcn_mfma_f32_32x32x2f32(x0, bw, acc0, 0, 0, 0); acc1 = __builtin_amdgcn_mfma_f32_32x32x2f32(x1, bw, acc1, 0, 0, 0); }
            __builtin_amdgcn_sched_barrier(0);
        }
#undef P5_DMA
        { LAS float* red = (LAS float*)lds; LAS float* ssp = (LAS float*)(lds + P5_SSP);
#pragma unroll
            for (int v = 0; v < 16; ++v) { const int t = 8 * (v >> 2) + 4 * kh + (v & 3); red[(wv * 64 + t) * 32 + i32] = acc0[v]; red[(wv * 64 + 32 + t) * 32 + i32] = acc1[v]; }
            ssp[(wv * 2 + kh) * 64 + i32] = ss0; ssp[(wv * 2 + kh) * 64 + 32 + i32] = ss1;
            __syncthreads();
            { const int t = tid >> 3, e4 = tid & 7; f32x4 sacc = *(const LAS f32x4*)(red + t * 32 + 4 * e4);
#pragma unroll
                for (int w2 = 1; w2 < 8; ++w2) sacc += *(const LAS f32x4*)(red + (w2 * 64 + t) * 32 + 4 * e4);
                lg[t * 33 + 4 * e4 + 0] = sacc.x; lg[t * 33 + 4 * e4 + 1] = sacc.y; lg[t * 33 + 4 * e4 + 2] = sacc.z; lg[t * 33 + 4 * e4 + 3] = sacc.w; }
            if (tid < 64) { float ss = 0.f;
#pragma unroll
                for (int q = 0; q < 16; ++q) ss += ssp[q * 64 + tid];
                const float rstd = 1.0f / sqrtf(ss * (1.0f / DM) + NORM_EPS); rs[tid] = rstd; ((float*)(a.ws + WS_RSTD))[blk * 64 + tid] = rstd; }
            if (tid < 32) misc[40 + tid] = 0; }
        __syncthreads();
        __syncthreads();
        int ek[4] = {0, 0, 0, 0}, rk[4] = {0, 0, 0, 0}; float gk[4] = {0.f, 0.f, 0.f, 0.f};
        if (tid < 64) {
            float v[32];
            const float rstd = rs[tid];
#pragma unroll
            for (int e = 0; e < 32; ++e) v[e] = lg[tid * 33 + e] * rstd + rb[e];
            float val[4];
#pragma unroll
            for (int k = 0; k < 4; ++k) { float best = -3.0e38f; int bi = 0;
#pragma unroll
                for (int e = 0; e < 32; ++e) { const bool gt = v[e] > best; best = gt ? v[e] : best; bi = gt ? e : bi; }
#pragma unroll
                for (int e = 0; e < 32; ++e) v[e] = (e == bi) ? -3.0e38f : v[e];
                ek[k] = bi; val[k] = best; }
            float den = 0.f;
#pragma unroll
            for (int k = 0; k < 4; ++k) { gk[k] = expf(val[k] - val[0]); den += gk[k]; }
#pragma unroll
            for (int k = 0; k < 4; ++k) { gk[k] = gk[k] / den; rk[k] = __hip_atomic_fetch_add(&misc[40 + ek[k]], 1, __ATOMIC_RELAXED, __HIP_MEMORY_SCOPE_WORKGROUP); }
        }
        __syncthreads();
        if (tid < 32) { const int cnt = misc[40 + tid]; misc[72 + tid] = cnt ? (int)atomicAdd(&ecnt[tid], (unsigned)cnt) : 0; }
        __syncthreads();
        if (tid < 64) { const int tok = blk * 64 + tid;
#pragma unroll
            for (int k = 0; k < 4; ++k) { const int pos = misc[72 + ek[k]] + rk[k]; LIST[(size_t)ek[k] * NREAL + pos] = tok; RE[tok * 4 + k] = ek[k]; RP[tok * 4 + k] = pos; RG[tok * 4 + k] = gk[k]; } }
    }
    __syncthreads();
}

__device__ __forceinline__ int moe_setup(const Args& a, LAS int* misc, int tid) {
    const unsigned* ecnt = (const unsigned*)(a.ws + WS_CTL) + CW_ECNT;
    __syncthreads();
    if (tid < NEXP) misc[104 + tid] = (int)__hip_atomic_load(ecnt + tid, __ATOMIC_RELAXED, __HIP_MEMORY_SCOPE_AGENT);
    __syncthreads();
    if (tid == 0) { int acc = 0;
        for (int e = 0; e < NEXP; ++e) { misc[e] = acc; acc += (misc[104 + e] + 255) >> 8; }
        misc[32] = acc; }
    __syncthreads();
    return misc[32];
}

__device__ __forceinline__ void p8_combine(const Args& a, const LAS int* misc, int gw, int NGW, int lane) {
    const int* RE = (const int*)(a.ws + WS_RE); const int* RP = (const int*)(a.ws + WS_RP); const float* RG = (const float*)(a.ws + WS_RG);
    const unsigned char* Y = a.ws + WS_Y; float* out = a.out;
    typedef int i32x4 __attribute__((ext_vector_type(4)));
    i32x4 e4 = {0, 0, 0, 0}, p4 = {0, 0, 0, 0}; f32x4 g4 = {0.f, 0.f, 0.f, 0.f};
    if (gw < NREAL) { e4 = *(const i32x4*)(RE + gw * 4); p4 = *(const i32x4*)(RP + gw * 4); g4 = *(const f32x4*)(RG + gw * 4); }
#define P8_LOAD(ACC, YY, ROW, SLOT, H) do { const int _col = 16 * lane + 1024 * (H); \
        _Pragma("unroll") for (int _q = 0; _q < 4; ++_q) ACC[_q] = *(const f32x4*)(out + (size_t)(ROW) * DM + _col + 4 * _q); \
        _Pragma("unroll") for (int _k = 0; _k < 4; ++_k) YY[_k] = *(const u32x4*)(Y + SLOT[_k] * DM + _col); } while (0)
#define P8_COMB(ACC, YY, ROW, G, H) do { const int _col = 16 * lane + 1024 * (H); \
        _Pragma("unroll") for (int _k = 0; _k < 4; ++_k) { const float _g = G[_k] * (1.0f / pg8::Y8_SCALE); \
            _Pragma("unroll") for (int _q = 0; _q < 4; ++_q) { const f32x2 lo = __builtin_amdgcn_cvt_pk_f32_fp8((int)YY[_k][_q], false), hi = __builtin_amdgcn_cvt_pk_f32_fp8((int)YY[_k][_q], true); \
                ACC[_q].x += _g * lo.x; ACC[_q].y += _g * lo.y; ACC[_q].z += _g * hi.x; ACC[_q].w += _g * hi.y; } } \
        _Pragma("unroll") for (int _q = 0; _q < 4; ++_q) *(f32x4*)(out + (size_t)(ROW) * DM + _col + 4 * _q) = ACC[_q]; } while (0)
    size_t slot[4]; float g[4];
    f32x4 accA[4], accB[4]; u32x4 yA[4], yB[4];
    if (gw < NREAL) {
#pragma unroll
        for (int k = 0; k < 4; ++k) { slot[k] = (size_t)misc[e4[k]] * 256 + p4[k]; g[k] = g4[k]; }
        P8_LOAD(accA, yA, gw, slot, 0); }
    for (int row = gw; row < NREAL; row += NGW) {
        const int nrow = row + NGW;
        if (nrow < NREAL) { e4 = *(const i32x4*)(RE + nrow * 4); p4 = *(const i32x4*)(RP + nrow * 4); g4 = *(const f32x4*)(RG + nrow * 4); }
        P8_LOAD(accB, yB, row, slot, 1);
        P8_COMB(accA, yA, row, g, 0);
        float gc[4];
#pragma unroll
        for (int k = 0; k < 4; ++k) gc[k] = g[k];
        if (nrow < NREAL) {
#pragma unroll
            for (int k = 0; k < 4; ++k) { slot[k] = (size_t)misc[e4[k]] * 256 + p4[k]; g[k] = g4[k]; }
            P8_LOAD(accA, yA, nrow, slot, 0); }
        P8_COMB(accB, yB, row, gc, 1);
    }
#undef P8_LOAD
#undef P8_COMB
}

__device__ __forceinline__ void p1_meta_rows(const Args& a, LAS unsigned char* lds, int bx, int G, int tid, int wave, int lane) {
    const bf16_t* HN = (const bf16_t*)(a.ws + WS_HN); const bf16_t* WT = (const bf16_t*)(a.ws + WS_WIN); bf16_t* P = (bf16_t*)(a.ws + WS_P);
    for (int q = tid; q < NMETA * DM * 2 / 16; q += NTHREADS) *(LAS u32x4*)(lds + q * 16) = *(const u32x4*)((const unsigned char*)HN + (size_t)q * 16);
    __syncthreads();
    for (int col = bx + G * wave; col < NPROJ; col += G * NWAVES) {
        u32x4 w[4]; int lane_o = lane; asm volatile("" : "+v"(lane_o));
#pragma unroll
        for (int j = 0; j < 4; ++j) w[j] = *(const u32x4*)(WT + (size_t)col * DM + 8 * lane + 512 * j);
        float v = 0.f;
#pragma unroll 1
        for (int t = 0; t < NMETA; ++t) { float s = 0.f;
#pragma unroll
            for (int j = 0; j < 4; ++j) { const u32x4 x = *(const LAS u32x4*)(lds + t * (DM * 2) + (8 * lane_o + 512 * j) * 2);
                s += bf_lo(x.x) * bf_lo(w[j].x) + bf_hi(x.x) * bf_hi(w[j].x) + bf_lo(x.y) * bf_lo(w[j].y) + bf_hi(x.y) * bf_hi(w[j].y)
                   + bf_lo(x.z) * bf_lo(w[j].z) + bf_hi(x.z) * bf_hi(w[j].z) + bf_lo(x.w) * bf_lo(w[j].w) + bf_hi(x.w) * bf_hi(w[j].w); }
            s = wave_sum(s);
            v = ((lane & 15) == t) ? s : v; }
        P[((size_t)(lane >> 4) * LSEQ + (lane & 15)) * NPROJ + col] = gdn::f2bf(v);
    }
    __syncthreads();
}

constexpr int NPH = 9;
__global__ void __launch_bounds__(NTHREADS, 2) hymba_fwd(Args args) {
    extern __shared__ __attribute__((aligned(16))) unsigned char lds_raw[];
    LAS unsigned char* lds = (LAS unsigned char*)lds_raw;
    LAS int* misc = (LAS int*)(lds + MISC_OFF);
    const int tid = threadIdx.x, lane = tid & 63, wave = __builtin_amdgcn_readfirstlane(tid >> 6);
    const int G = gridDim.x, bx = blockIdx.x;
    const int vcu = (G % 8 == 0) ? (bx % 8) * (G / 8) + bx / 8 : bx;
    const int gw = vcu * NWAVES + wave, NGW = G * NWAVES;
    unsigned* ctl = (unsigned*)(args.ws + WS_CTL);
    for (int u = tid; u < 256; u += NTHREADS) misc[u] = 0;
    __syncthreads();
    XcdBarrier bar; bar.bar = ctl + CW_BAR; bar.x = 0; bar.st = nullptr;
    const int lo = args.ph_lo, hi = args.ph_hi;
    constexpr int CVT_LIMIT_P2 = MOE_ITEMS * 35 / 100;
    if (hi - lo > 1) bar = xcd_barrier_post(ctl + CW_BAR, (volatile LAS unsigned*)(misc + 200));
#define IN(k) (lo <= (k) && (k) < hi)
#define SEAM(k) do { if (IN(k) && IN((k) + 1)) xcd_barrier(bar); } while (0)

    if (IN(0)) { p0_rows(args, lds, G, bx, tid); p0_weights(args, lds, vcu, G, wave, lane); }
    SEAM(0);
    if (IN(1)) {
        p1_meta_rows(args, lds, bx, G, tid, wave, lane);
        pg8::PlainOrder S; S.init(NREAL, NPROJ, DM, args.ws + WS_WIN, G, bx); S.meta = 1;
        pg8::EpiBf16 E{(bf16_t*)(args.ws + WS_P), NPROJ, 1, nullptr, (const float*)(args.ws + WS_RSTD)};
        pg8::gemm_phase<pg8::EpiBf16, pg8::PlainOrder, true, true>(lds, (const char*)(args.ws + WS_HN), DM * 2, S, E);
    }
    SEAM(1);
    if (IN(2)) {
        p2_qknorm(args, gw, NGW, lane);
        const bool roleB = (G >= 128) && (bx >= G - G / 8 * 3);
        if (roleB) moe_weights_queue<CVT_NLD_P2>(args, lds, misc + 212, tid, wave, lane, CVT_LIMIT_P2);
        unsigned xwp[33]; float gbp[2] = {0.f, 0.f};
        __syncthreads();
        if (tid == 0) misc[213] = (int)atomicAdd(ctl + CW_PREQ, 1u);
        __syncthreads();
        int it = *(volatile LAS int*)(misc + 213);
        gdn::prefetch_rows(args, it, lane, wave, xwp, gbp);
        while (it < 32 * gdn::NCH) {
            const int nclaim = (tid == 0) ? (int)atomicAdd(ctl + CW_PREQ, 1u) : 0;
            gdn::precompute(args, lds, it, tid, lane, wave, xwp, gbp, (volatile LAS int*)(misc + 215), nclaim);
            it = *(volatile LAS int*)(misc + 215);
        }
        if (!roleB) moe_weights_queue<CVT_NLD_P2>(args, lds, misc + 212, tid, wave, lane, CVT_LIMIT_P2);
    }
    SEAM(2);
    if (IN(3)) {
        const int NG = (G >= 64) ? 32 : 0;
        if (bx < 32 || NG == 0) { for (int it = bx; it < 32; it += G) gdn::scan(args, lds, it, tid, lane, wave); }
        if (bx >= NG) { for (int u = bx - NG; u < 512; u += G - NG) sba::unit(args, lds, (volatile LAS int*)(misc + 210), u >> 7, (u >> 4) & 7, u & 15, tid, lane, wave); }
        moe_weights_queue(args, lds, misc + 212, tid, wave, lane, MOE_ITEMS);
    }
    SEAM(3);
    if (IN(4)) {
        pg8::PlainOrder S; S.init(NREAL, DM, DM, args.ws + WS_WOUT, G, bx);
        pg8::EpiResF32 E{args.in[I_X], args.out, DM};
        pg8::gemm_phase<pg8::EpiResF32, pg8::PlainOrder, true, true>(lds, (const char*)(args.ws + WS_MIX), DM * 2, S, E);
    }
    SEAM(4);
    if (IN(5)) p5_router(args, lds, G, bx, tid);
    SEAM(5);
    if (IN(6)) {
        {
        const int mt = moe_setup(args, misc, tid);
        pg8::MoeOrder<true> S; S.tpre = misc; S.tok = (const LAS int*)(lds + TOK_OFF); S.nN = 16; S.nwg = mt * 16; S.G = G; S.c = bx;
        S.Bt = (const char*)(args.ws + WS_WGU); S.estride = (size_t)2 * DE * DM; S.K2 = DM;
        const int* LIST = (const int*)(args.ws + WS_LIST);
        S.ud = misc + 140; S.fill_units(misc + 140, tid);
        __syncthreads();
        for (int idx = tid; idx < TOK_CAP * 256; idx += NTHREADS) { pg8::Unit u; if (!S.next(idx >> 8, u)) break;
            const int r = (u.pm - misc[u.e]) * 256 + (idx & 255); int ent = 0;
            if (r < misc[104 + u.e]) { const int tk = LIST[(size_t)u.e * NREAL + r]; ent = (int)(((__float_as_uint(((const float*)(args.ws + WS_RSTD))[tk]) + 0x2000u) & 0xffffc000u) | (unsigned)tk); }
            ((LAS int*)(lds + TOK_OFF))[idx] = ent; }
        __syncthreads();
        pg8::EpiSwiGLU E{args.ws + WS_ACT, args.in[I_BGU], (const LAS int*)(lds + TOK_OFF)};
        pg8::gemm_phase<pg8::EpiSwiGLU, pg8::MoeOrder<true>, true, true, true>(lds, (const char*)(args.ws + WS_HN), DM, S, E);
        }
    }
    SEAM(6);
    if (IN(7)) {
        const int mt = moe_setup(args, misc, tid);
        pg8::MoeOrder<false> S; S.tpre = misc; S.tok = nullptr; S.nN = 8; S.nwg = mt * 8; S.G = G; S.c = bx;
        S.Bt = (const char*)(args.ws + WS_WD); S.estride = (size_t)DM * DE; S.K2 = DE;
        S.ud = misc + 140; S.fill_units(misc + 140, tid);
        __syncthreads();
        pg8::EpiFp8Bias E{args.ws + WS_Y, DM, args.in[I_BD]};
        pg8::gemm_phase<pg8::EpiFp8Bias, pg8::MoeOrder<false>, true, true, true>(lds, (const char*)(args.ws + WS_ACT), DE, S, E);
    }
    SEAM(7);
    if (IN(8)) { (void)moe_setup(args, misc, tid); p8_combine(args, misc, gw, NGW, lane); }
#undef IN
#undef SEAM
}

extern "C" void kernel_launch(void* const* d_in, const int* in_sizes, int n_in, void* d_out, int out_size, void* d_ws, size_t ws_size, hipStream_t stream) {
    static int grid = 0;
    if (grid == 0) {
        if (n_in != 19 || out_size != NREAL * DM || ws_size < WS_END) { fprintf(stderr, "kernel_launch: unexpected shapes (n_in %d out %d ws %zu need %zu)\n", n_in, out_size, ws_size, (size_t)WS_END); grid = -1; return; }
        int dev = 0, cus = 0, per_cu = 0;
        if (hipGetDevice(&dev) != hipSuccess || hipDeviceGetAttribute(&cus, hipDeviceAttributeMultiprocessorCount, dev) != hipSuccess) { grid = -1; return; }
        if (hipFuncSetAttribute((const void*)hymba_fwd, hipFuncAttributeMaxDynamicSharedMemorySize, LDS_BYTES) != hipSuccess) { fprintf(stderr, "kernel_launch: hipFuncSetAttribute failed\n"); grid = -1; return; }
        if (hipOccupancyMaxActiveBlocksPerMultiprocessor(&per_cu, (const void*)hymba_fwd, NTHREADS, LDS_BYTES) != hipSuccess || per_cu < 1) { fprintf(stderr, "kernel_launch: occupancy query says %d\n", per_cu); grid = -1; return; }
        (void)hipGetLastError();
        grid = cus;
    }
    if (grid < 0) return;
    (void)hipMemsetAsync((char*)d_ws + WS_CTL, 0, CTL_ZERO_BYTES, stream);
    Args a{};
    for (int i = 0; i < 19; ++i) a.in[i] = (const float*)d_in[i];
    a.out = (float*)d_out; a.ws = (unsigned char*)d_ws;
#if MK_N_LAUNCHES == 1
    a.ph_lo = 0; a.ph_hi = NPH;
    hipLaunchKernelGGL(hymba_fwd, dim3(grid), dim3(NTHREADS), LDS_BYTES, stream, a);
#else
    for (int p = 0; p < NPH; ++p) { a.ph_lo = p; a.ph_hi = p + 1; hipLaunchKernelGGL(hymba_fwd, dim3(grid), dim3(NTHREADS), LDS_BYTES, stream, a); }
#endif
    const hipError_t le = hipPeekAtLastError();
    if (le != hipSuccess) fprintf(stderr, "kernel_launch: launch failed: %s\n", hipGetErrorName(le));
}
```

```cpp
#include <hip/hip_runtime.h>
#include <cstdio>
#include <cstdint>

#ifndef MK_N_LAUNCHES
#define MK_N_LAUNCHES 1
#endif

constexpr int NB = 4, SEQ = 4096, NMETA = 16, LSEQ = SEQ + NMETA;
constexpr int DM = 2048, NTOK = NB * LSEQ  , MPAD = 16640  , NREAL = NB * SEQ  ;
constexpr int NPROJ_SRC = 7184, NPROJ = 7168;
constexpr int NHEAD = 8, HD = 128;
constexpr int PC_QKV = 0, PC_Z = 3072, PC_SBQ = 4096, PC_SBK = 5120, PC_SBV = 6144;
constexpr int NEXP = 32, TOPK = 4, DE = 2048;
constexpr int SLOT_ROWS = 73728;
constexpr int LROW = 4224;
constexpr float NORM_EPS = 1e-6f;

constexpr size_t MiB = 1u << 20;
constexpr size_t WS_CTL = 0, CTL_ZERO_BYTES = 1 * MiB;
constexpr size_t WS_RSTD = 512 * 1024;
constexpr size_t WS_WIN = 1 * MiB;
constexpr size_t WS_WOUT = WS_WIN + (size_t)NPROJ * DM * 2;
constexpr size_t WS_WGU = WS_WOUT + (size_t)DM * DM * 2;
constexpr size_t WS_WD = WS_WGU + (size_t)NEXP * 2 * DE * DM * 2;
constexpr size_t WS_HN = WS_WD + (size_t)NEXP * DM * DE * 2;
constexpr size_t WS_BETA = WS_HN + (size_t)MPAD * DM * 2;
constexpr size_t WS_G = WS_BETA + (size_t)NTOK * 8 * 4 + 256;
constexpr size_t WS_P = WS_G + (size_t)NTOK * 8 * 4 + 256;
constexpr size_t WS_QN = WS_P + (size_t)MPAD * NPROJ * 2;
constexpr size_t WS_KN = WS_QN + (size_t)NB * NHEAD * LROW * HD * 2;
constexpr size_t WS_ORAW = WS_KN + (size_t)NB * NHEAD * LROW * HD * 2;
constexpr size_t WS_MIX = WS_ORAW + (size_t)NREAL * 1024 * 4;
constexpr size_t WS_RE = WS_MIX + (size_t)NREAL * DM * 2;
constexpr size_t WS_RP = WS_RE + (size_t)NREAL * 4 * 4;
constexpr size_t WS_RG = WS_RP + (size_t)NREAL * 4 * 4;
constexpr size_t WS_LIST = WS_RG + (size_t)NREAL * 4 * 4;
constexpr size_t WS_ACT = WS_LIST + (size_t)NEXP * NREAL * 4;
constexpr size_t WS_Y = WS_ACT + (size_t)SLOT_ROWS * DE * 2;
constexpr size_t WS_GCH = WS_Y + (size_t)SLOT_ROWS * DM * 2;
constexpr size_t WS_GL = WS_GCH + (size_t)32 * 65 * 73728;
constexpr size_t WS_END = WS_GL + 32 * 65 * 4 + 256;
constexpr int CW_ECNT = 64;
constexpr int CW_CVTQ = 192;
constexpr int CVT_NLD_P2 = 4;
constexpr int CW_PREQ = 256;
constexpr int CW_BAR = 4096;

constexpr int LDS_STAGE = 131072;
constexpr int TOK_OFF = LDS_STAGE, TOK_CAP = 22;
constexpr int MISC_OFF = TOK_OFF + TOK_CAP * 256 * 4;
constexpr int LDS_BYTES = MISC_OFF + 1024;

#define GAS __attribute__((address_space(1)))
#define LAS __attribute__((address_space(3)))
typedef unsigned short bf16_t;
typedef short bf16x8 __attribute__((ext_vector_type(8)));
typedef short s16x4 __attribute__((ext_vector_type(4)));
typedef float f32x4 __attribute__((ext_vector_type(4)));
typedef float f32x2 __attribute__((ext_vector_type(2)));
typedef float f32x16 __attribute__((ext_vector_type(16)));
typedef unsigned u32x4 __attribute__((ext_vector_type(4)));
typedef unsigned u32x2 __attribute__((ext_vector_type(2)));

typedef __bf16 bf16x2_t __attribute__((ext_vector_type(2)));
__device__ __forceinline__ unsigned cvt_pk_bf16(float lo, float hi) { const f32x2 v = {lo, hi}; const bf16x2_t b = __builtin_convertvector(v, bf16x2_t); return __builtin_bit_cast(unsigned, b); }
__device__ __forceinline__ unsigned pk4_fp8(float a, float b, float c, float d) { unsigned w = 0u; w = __builtin_amdgcn_cvt_pk_fp8_f32(a, b, w, false); w = __builtin_amdgcn_cvt_pk_fp8_f32(c, d, w, true); return w; }
__device__ __forceinline__ float bf_lo(unsigned w) { return __uint_as_float(w << 16); }
__device__ __forceinline__ float bf_hi(unsigned w) { return __uint_as_float(w & 0xffff0000u); }
__device__ __forceinline__ float bf2f(bf16_t b) { return __uint_as_float(((unsigned)b) << 16); }
template <int CTRL, int ROW_MASK> __device__ __forceinline__ float dpp_get(float v) {
    return __builtin_bit_cast(float, __builtin_amdgcn_update_dpp(0, __builtin_bit_cast(int, v), CTRL, ROW_MASK, 0xF, false));
}
__device__ __forceinline__ float row16_sum(float v) {
    v += dpp_get<0xB1, 0xF>(v);
    v += dpp_get<0x4E, 0xF>(v);
    v += dpp_get<0x141, 0xF>(v);
    v += dpp_get<0x140, 0xF>(v);
    return v;
}
__device__ __forceinline__ float quad_sum(float v) { v += dpp_get<0xB1, 0xF>(v); v += dpp_get<0x4E, 0xF>(v); return v; }
__device__ __forceinline__ float wave_sum(float v) {
    v = row16_sum(v);
    v += dpp_get<0x142, 0xA>(v);
    v += dpp_get<0x143, 0xC>(v);
    return __builtin_bit_cast(float, __builtin_amdgcn_readlane(__builtin_bit_cast(int, v), 63));
}

namespace pg8 {
constexpr int BM = 256, BK = 64, HALF = 128, HTB = HALF * BK * 2, STAGE_BYTES = 8 * HTB, NXCD = 8, WGM = 8;
__host__ __device__ __forceinline__ int lds_byte(int r, int c) { const int st = (r >> 4) * 2 + (c >> 5), rr = r & 15, cc = c & 31, ob = rr * 64 + cc * 2; return st * 1024 + (ob ^ (((ob >> 9) & 1) << 5)); }
__host__ __device__ __forceinline__ void stage_rc(int b, int& R, int& C) { const int st = b / 1024, sb = b % 1024, swz = sb ^ (((sb >> 9) & 1) << 5); R = (st >> 1) * 16 + swz / 64; C = (st & 1) * 32 + (swz % 64) / 2; }
__host__ __device__ __forceinline__ int perm32(int rho) { const int n = rho >> 4, i = rho & 15; return 8 * (i >> 2) + 4 * n + (i & 3); }

typedef int v8i __attribute__((ext_vector_type(8))); typedef int v4i __attribute__((ext_vector_type(4)));
__device__ __forceinline__ v8i cat8(bf16x8 lo, bf16x8 hi) { const v4i a = __builtin_bit_cast(v4i, lo), b = __builtin_bit_cast(v4i, hi); return __builtin_shufflevector(a, b, 0, 1, 2, 3, 4, 5, 6, 7); }
struct Unit { int pm, pn, e, ui; };

__device__ __forceinline__ int xcd_remap(int L, int nwg) { const int q = nwg / NXCD, r = nwg % NXCD, xcd = L % NXCD, off = L / NXCD; return (xcd < r ? xcd * (q + 1) : r * (q + 1) + (xcd - r) * q) + off; }

struct PlainOrder {
    int nM, nN, nwg, G, c; const char* Bt; unsigned K2;
    __device__ void init(int M, int N, int K, const void* Bt_, int G_, int c_) { nM = M / BM; nN = N / BM; nwg = nM * nN; G = G_; c = c_; Bt = (const char*)Bt_; K2 = (unsigned)K * 2u; }
    __device__ __forceinline__ bool next(int i, Unit& u) const {
        const long L = (long)i * G + c; if (L >= nwg) return false;
        const int wgid = xcd_remap((int)L, nwg);
        const int nig = WGM * nN, gid = wgid / nig, fm = gid * WGM, gsz = (nM - fm) < WGM ? (nM - fm) : WGM;
        u.pm = fm + ((wgid % nig) % gsz); u.pn = (wgid % nig) / gsz; u.e = 0; u.ui = i; return true;
    }
    __device__ __forceinline__ const char* b_ptr(const Unit& u) const { return Bt + (size_t)u.pn * BM * K2; }
    __device__ __forceinline__ unsigned a_off(const Unit& u, int r) const { return (unsigned)(u.pm * BM + r + (meta ? NMETA * ((u.pm >> 4) + 1) : 0)) * K2; }
    int meta = 0;
};
constexpr int UD_CAP = 24;
template <bool GATHER> struct MoeOrder {
    const LAS int* tpre; const LAS int* tok; const LAS int* ud; int nN, nwg, G, c; const char* Bt; size_t estride; unsigned K2;
    __device__ __forceinline__ int decode(int i) const {
        const long L = (long)i * G + c; if (L >= nwg) return -1;
        const int wgid = xcd_remap((int)L, nwg);
        int e = 0;
#pragma unroll 1
        for (int j = 1; j < NEXP; ++j) e = (wgid >= tpre[j] * nN) ? j : e;
        const int t0 = tpre[e], nt = tpre[e + 1] - t0, loc = wgid - t0 * nN;
        return e | ((t0 + loc % nt) << 6) | ((loc / nt) << 16);
    }
    __device__ __forceinline__ void fill_units(LAS int* udw, int tid) const { if (tid < UD_CAP) udw[tid] = decode(tid); }
    __device__ __forceinline__ bool next(int i, Unit& u) const {
        if (i >= UD_CAP) return false;
        const int d = ud[i]; if (d < 0) return false;
        u.e = d & 63; u.pm = (d >> 6) & 1023; u.pn = d >> 16; u.ui = i; return true;
    }
    __device__ __forceinline__ const char* b_ptr(const Unit& u) const { return Bt + (size_t)u.e * estride + (size_t)u.pn * BM * K2; }
    __device__ __forceinline__ unsigned a_off(const Unit& u, int r) const {
        if (GATHER) return (unsigned)(tok[u.ui * 256 + r] & 0x3fff) * K2;
        return (unsigned)(u.pm * BM + r) * K2;
    }
};

struct EpiBf16 {
    static constexpr bool PERM = true;
    bf16_t* O; int ldc; int meta; const float* ebias = nullptr;
    const float* rscale = nullptr;
    __device__ __forceinline__ void operator()(const f32x4 (&acc)[2][2][4][2], const Unit& u, int wr, int wc, int fr, int fq) const {
        const int row0 = u.pm * BM + wr * 64 + fr + (meta ? NMETA * ((u.pm >> 4) + 1) : 0), col0 = u.pn * BM + wc * 32 + 8 * fq;
        f32x4 bv[2][2];
#pragma unroll
        for (int bj = 0; bj < 2; ++bj)
#pragma unroll
            for (int n = 0; n < 2; ++n) bv[bj][n] = ebias ? *(const f32x4*)(ebias + (size_t)u.e * ldc + col0 + bj * HALF + 4 * n) : (f32x4){0.f, 0.f, 0.f, 0.f};
#pragma unroll
        for (int ai = 0; ai < 2; ++ai)
#pragma unroll
            for (int m = 0; m < 4; ++m) { bf16_t* rowp = O + (size_t)(row0 + ai * HALF + m * 16) * ldc + col0; const float rsc = rscale ? rscale[row0 + ai * HALF + m * 16] : 1.0f;
#pragma unroll
                for (int bj = 0; bj < 2; ++bj) { const f32x4 v0 = acc[ai][bj][m][0] * rsc + bv[bj][0], v1 = acc[ai][bj][m][1] * rsc + bv[bj][1];
                    u32x4 w; w.x = cvt_pk_bf16(v0[0], v0[1]); w.y = cvt_pk_bf16(v0[2], v0[3]); w.z = cvt_pk_bf16(v1[0], v1[1]); w.w = cvt_pk_bf16(v1[2], v1[3]);
                    *(u32x4*)(rowp + bj * HALF) = w; } }
    }
};
__device__ __forceinline__ u32x4 widen16(u32x2 a, u32x2 b) {
    const auto rx = __builtin_amdgcn_permlane16_swap(a.x, b.x, false, false); const auto ry = __builtin_amdgcn_permlane16_swap(a.y, b.y, false, false);
    return (u32x4){rx[0], ry[0], rx[1], ry[1]};
}
constexpr float Y8_SCALE = 16.0f;
struct EpiFp8Bias {
    static constexpr bool PERM = true;
    unsigned char* O; int ldc; const float* ebias;
    __device__ __forceinline__ void operator()(const f32x4 (&acc)[2][2][4][2], const Unit& u, int wr, int wc, int fr, int fq) const {
        const int row0 = u.pm * BM + wr * 64 + fr, col0 = u.pn * BM + wc * 32 + 8 * fq;
        f32x4 bv[2][2];
#pragma unroll
        for (int bj = 0; bj < 2; ++bj)
#pragma unroll
            for (int n = 0; n < 2; ++n) bv[bj][n] = *(const f32x4*)(ebias + (size_t)u.e * ldc + col0 + bj * HALF + 4 * n);
#pragma unroll
        for (int ai = 0; ai < 2; ++ai)
#pragma unroll
            for (int mp = 0; mp < 2; ++mp) { const int odd = fq & 1;
                unsigned char* rowp = O + (size_t)(row0 + ai * HALF + (2 * mp + odd) * 16) * ldc + col0 - 8 * odd;
#pragma unroll
                for (int bj = 0; bj < 2; ++bj) { u32x2 w[2];
#pragma unroll
                    for (int k = 0; k < 2; ++k) { const int m = 2 * mp + k; const f32x4 v0 = (acc[ai][bj][m][0] + bv[bj][0]) * Y8_SCALE, v1 = (acc[ai][bj][m][1] + bv[bj][1]) * Y8_SCALE;
                        w[k].x = pk4_fp8(v0[0], v0[1], v0[2], v0[3]); w[k].y = pk4_fp8(v1[0], v1[1], v1[2], v1[3]); }
                    *(u32x4*)(rowp + bj * HALF) = widen16(w[0], w[1]); } }
    }
};
struct EpiResF32 {
    static constexpr bool PERM = false;
    const float* X; float* out; int ldc;
    __device__ __forceinline__ void operator()(const f32x4 (&acc)[2][2][4][2], const Unit& u, int wr, int wc, int fr, int fq) const {
        const int row0 = u.pm * BM + wr * 64 + fr, col0 = u.pn * BM + wc * 32 + 4 * fq;
#pragma unroll
        for (int ai = 0; ai < 2; ++ai) {
            f32x4 xv[4][2][2];
#pragma unroll
            for (int m = 0; m < 4; ++m) { const size_t off = (size_t)(row0 + ai * HALF + m * 16) * ldc + col0;
#pragma unroll
                for (int bj = 0; bj < 2; ++bj)
#pragma unroll
                    for (int n = 0; n < 2; ++n) xv[m][bj][n] = *(const f32x4*)(X + off + bj * HALF + n * 16); }
#pragma unroll
            for (int m = 0; m < 4; ++m) { const size_t off = (size_t)(row0 + ai * HALF + m * 16) * ldc + col0;
#pragma unroll
                for (int bj = 0; bj < 2; ++bj)
#pragma unroll
                    for (int n = 0; n < 2; ++n) *(f32x4*)(out + off + bj * HALF + n * 16) = xv[m][bj][n] + acc[ai][bj][m][n]; }
            asm volatile("" ::: "memory"); }
    }
};
__device__ __forceinline__ unsigned swiglu2_fp8(f32x2 g, f32x2 uu, unsigned w, bool hi) {
    g.x = fminf(g.x, 7.0f); g.y = fminf(g.y, 7.0f); uu.x = fminf(fmaxf(uu.x, -7.0f), 7.0f); uu.y = fminf(fmaxf(uu.y, -7.0f), 7.0f);
    const f32x2 t = g * (-1.702f * 1.4426950408889634f);
    f32x2 e; e.x = __builtin_amdgcn_exp2f(t.x); e.y = __builtin_amdgcn_exp2f(t.y);
    const f32x2 d = e + 1.0f;
    f32x2 r; r.x = __builtin_amdgcn_rcpf(d.x); r.y = __builtin_amdgcn_rcpf(d.y);
    const f32x2 o = (uu + 1.0f) * g * r;
    return hi ? __builtin_amdgcn_cvt_pk_fp8_f32(o.x, o.y, w, true) : __builtin_amdgcn_cvt_pk_fp8_f32(o.x, o.y, w, false);
}
struct EpiSwiGLU {
    static constexpr bool PERM = true;
    unsigned char* act; const float* bgu;
    const LAS int* tok;
    __device__ __forceinline__ void operator()(const f32x4 (&acc)[2][2][4][2], const Unit& u, int wr, int wc, int fr, int fq) const {
        const int row0 = u.pm * BM + wr * 64 + fr, col0 = u.pn * HALF + wc * 32 + 8 * fq;
        const float* bg = bgu + (size_t)u.e * 4096 + col0;
        const f32x4 bg0 = *(const f32x4*)(bg), bg1 = *(const f32x4*)(bg + 4), bu0 = *(const f32x4*)(bg + 2048), bu1 = *(const f32x4*)(bg + 2052);
#pragma unroll
        for (int ai = 0; ai < 2; ++ai)
#pragma unroll
            for (int mp = 0; mp < 2; ++mp) { const int odd = fq & 1; u32x2 w[2];
#pragma unroll
                for (int k = 0; k < 2; ++k) { const int m = 2 * mp + k;
                    const float rsc = __uint_as_float((unsigned)tok[u.ui * 256 + wr * 64 + fr + ai * HALF + m * 16] & 0xffffc000u);
                    const f32x4 g0 = acc[ai][0][m][0] * rsc + bg0, g1 = acc[ai][0][m][1] * rsc + bg1, u0 = acc[ai][1][m][0] * rsc + bu0, u1 = acc[ai][1][m][1] * rsc + bu1;
                    w[k].x = swiglu2_fp8(g0.zw, u0.zw, swiglu2_fp8(g0.xy, u0.xy, 0u, false), true);
                    w[k].y = swiglu2_fp8(g1.zw, u1.zw, swiglu2_fp8(g1.xy, u1.xy, 0u, false), true); }
                *(u32x4*)(act + (size_t)(row0 + ai * HALF + (2 * mp + odd) * 16) * DE + col0 - 8 * odd) = widen16(w[0], w[1]); }
    }
};

template <class Epi, class Sched, bool ALIGN_EPI, bool SP2, bool FP8 = false>
__device__ __forceinline__ void gemm_phase(LAS unsigned char* lds, const char* A0, int Kb, const Sched& S, const Epi& E) {
    const int tid = threadIdx.x, wid = __builtin_amdgcn_readfirstlane(tid >> 6), lane = tid & 63, wr = wid >> 2, wc = wid & 3, fr = lane & 15, fq = lane >> 4;
    const int nt = Kb / 128;
    int Rr[2], Cc[2]; unsigned voffB[2];
#pragma unroll
    for (int i = 0; i < 2; ++i) { int R, C; stage_rc(tid * 16 + i * 8192, R, C); const int Rb = Epi::PERM ? ((R & ~31) + perm32(R & 31)) : R;
        Rr[i] = R; Cc[i] = C * 2; voffB[i] = (unsigned)(Rb * Kb + C * 2); }
    const size_t kstep = (size_t)(BK * 2);
    const size_t hstep = (size_t)HALF * Kb;
    const unsigned ldsw = (unsigned)wid * 1024u;
    const int aoff = lds_byte(wr * 64 + fr, fq * 8), boff = lds_byte(wc * 32 + fr, fq * 8);
#define PG8_SA(b, h) (((b) * 2 + (h)) * HTB)
#define PG8_SB(b, h) ((4 + (b) * 2 + (h)) * HTB)
#define PG8_STAGE(bufoff, gbase, voff) do { _Pragma("unroll") for (int _i = 0; _i < 2; ++_i) \
        __builtin_amdgcn_global_load_lds((const unsigned*)((const char*)(gbase) + (voff)[_i]), (LAS unsigned*)(lds + (bufoff) + ldsw + _i * 8192), 16, 0, 0); } while (0)
#define PG8_LDA(dst, b, h) do { _Pragma("unroll") for (int m = 0; m < 4; ++m) _Pragma("unroll") for (int k = 0; k < 2; ++k) dst[m][k] = *(const LAS bf16x8*)(lds + PG8_SA(b, h) + aoff + m * 2048 + k * 1024); } while (0)
#define PG8_LDB(dst, b, h) do { _Pragma("unroll") for (int n = 0; n < 2; ++n) _Pragma("unroll") for (int k = 0; k < 2; ++k) dst[n][k] = *(const LAS bf16x8*)(lds + PG8_SB(b, h) + boff + n * 2048 + k * 1024); } while (0)
#define PG8_MMA(ai, bj, At, Bt) do { __builtin_amdgcn_s_setprio(1); _Pragma("unroll") for (int m = 0; m < 4; ++m) _Pragma("unroll") for (int n = 0; n < 2; ++n) { \
        if constexpr (FP8) acc[ai][bj][m][n] = __builtin_amdgcn_mfma_scale_f32_16x16x128_f8f6f4(cat8(Bt[n][0], Bt[n][1]), cat8(At[m][0], At[m][1]), acc[ai][bj][m][n], 0, 0, 0, 0x79797979, 0, 0x7f7f7f7f); \
        else { _Pragma("unroll") for (int k = 0; k < 2; ++k) acc[ai][bj][m][n] = __builtin_amdgcn_mfma_f32_16x16x32_bf16(Bt[n][k], At[m][k], acc[ai][bj][m][n], 0, 0, 0); } } \
        __builtin_amdgcn_s_setprio(0); } while (0)
#define PG8_WAIT_V(n) asm volatile("s_waitcnt vmcnt(" #n ")" ::: "memory")
#define PG8_WAIT_L(n) asm volatile("s_waitcnt lgkmcnt(" #n ")" ::: "memory")
#define PG8_BAR __builtin_amdgcn_s_barrier()
#define PG8_SCHED __builtin_amdgcn_sched_barrier(0)
#define PG8_VOFF(dst, u) do { _Pragma("unroll") for (int _h = 0; _h < 2; ++_h) _Pragma("unroll") for (int _i = 0; _i < 2; ++_i) dst[_h][_i] = S.a_off(u, _h * HALF + Rr[_i]) + (unsigned)Cc[_i]; } while (0)
    Unit cur, nxt; int ui = 0;
    if (!S.next(0, cur)) return;
    f32x4 acc[2][2][4][2];
#pragma unroll
    for (int a = 0; a < 2; ++a)
#pragma unroll
        for (int b = 0; b < 2; ++b)
#pragma unroll
            for (int m = 0; m < 4; ++m)
#pragma unroll
                for (int n = 0; n < 2; ++n) acc[a][b][m][n] = (f32x4){0.f, 0.f, 0.f, 0.f};
    bf16x8 At[4][2], B0[2][2], B1[2][2];
    unsigned va[2][2], vn[2][2];
    PG8_VOFF(va, cur);
    const char* cB = S.b_ptr(cur);
    if constexpr (SP2) {
        PG8_STAGE(PG8_SB(0, 0), cB, voffB); PG8_STAGE(PG8_SB(0, 1), cB + hstep, voffB); PG8_STAGE(PG8_SA(0, 0), A0, va[0]); PG8_STAGE(PG8_SA(0, 1), A0, va[1]);
        if (wr == 1) PG8_BAR;
        PG8_WAIT_V(2); PG8_BAR;
        PG8_STAGE(PG8_SB(1, 0), cB + kstep, voffB); PG8_STAGE(PG8_SA(1, 0), A0 + kstep, va[0]); PG8_STAGE(PG8_SB(1, 1), cB + hstep + kstep, voffB);
        PG8_WAIT_V(6); PG8_BAR;
    } else {
        PG8_STAGE(PG8_SB(0, 0), cB, voffB); PG8_STAGE(PG8_SA(0, 0), A0, va[0]); PG8_STAGE(PG8_SB(0, 1), cB + hstep, voffB); PG8_STAGE(PG8_SA(0, 1), A0, va[1]);
        if (wr == 1) PG8_BAR;
        PG8_WAIT_V(4); PG8_BAR;
        PG8_STAGE(PG8_SB(1, 0), cB + kstep, voffB); PG8_STAGE(PG8_SA(1, 0), A0 + kstep, va[0]); PG8_STAGE(PG8_SB(1, 1), cB + hstep + kstep, voffB);
        PG8_WAIT_V(6); PG8_BAR;
    }
    for (;;) {
        const bool has_next = S.next(ui + 1, nxt);
        const char* nB = has_next ? S.b_ptr(nxt) : cB;
        for (int t = 0; t < nt; t += 2) {
            const bool last = (t == nt - 2);
            const char* a1 = A0 + (size_t)(t + 1) * kstep;
            const char* a2 = last ? A0 : A0 + (size_t)(t + 2) * kstep; const char* b2 = last ? nB : cB + (size_t)(t + 2) * kstep;
            const char* a3 = a2 + kstep; const char* b3 = b2 + kstep;
            if (last) { if (has_next) { PG8_VOFF(vn, nxt); } else {
#pragma unroll
                    for (int _h = 0; _h < 2; ++_h)
#pragma unroll
                        for (int _i = 0; _i < 2; ++_i) vn[_h][_i] = va[_h][_i]; } }
            if constexpr (SP2) {
            PG8_LDB(B0, 0, 0); PG8_LDB(B1, 0, 1); PG8_SCHED; PG8_LDA(At, 0, 0); PG8_STAGE(PG8_SA(1, 1), a1, va[1]);
            if (last) {
#pragma unroll
                for (int _h = 0; _h < 2; ++_h)
#pragma unroll
                    for (int _i = 0; _i < 2; ++_i) va[_h][_i] = vn[_h][_i]; }
            PG8_WAIT_V(8); PG8_WAIT_L(0); PG8_BAR; PG8_MMA(0, 0, At, B0); PG8_MMA(0, 1, At, B1); PG8_BAR; PG8_SCHED;
            PG8_LDA(At, 0, 1); PG8_STAGE(PG8_SB(0, 0), b2, voffB); PG8_STAGE(PG8_SB(0, 1), b2 + hstep, voffB); PG8_STAGE(PG8_SA(0, 0), a2, va[0]);
            PG8_WAIT_V(8); PG8_WAIT_L(0); PG8_BAR; PG8_MMA(1, 0, At, B0); PG8_MMA(1, 1, At, B1); PG8_BAR; PG8_SCHED;
            PG8_LDB(B0, 1, 0); PG8_LDB(B1, 1, 1); PG8_SCHED; PG8_LDA(At, 1, 0); PG8_STAGE(PG8_SA(0, 1), a2, va[1]);
            PG8_WAIT_V(8); PG8_WAIT_L(0); PG8_BAR; PG8_MMA(0, 0, At, B0); PG8_MMA(0, 1, At, B1); PG8_BAR; PG8_SCHED;
            PG8_LDA(At, 1, 1); PG8_STAGE(PG8_SB(1, 0), b3, voffB); PG8_STAGE(PG8_SB(1, 1), b3 + hstep, voffB); PG8_STAGE(PG8_SA(1, 0), a3, va[0]);
            PG8_WAIT_V(8); PG8_WAIT_L(0); PG8_BAR; PG8_MMA(1, 0, At, B0); PG8_MMA(1, 1, At, B1); PG8_BAR; PG8_SCHED;
            } else {
            PG8_LDB(B0, 0, 0); PG8_SCHED; PG8_LDA(At, 0, 0); PG8_STAGE(PG8_SA(1, 1), a1, va[1]);
            if (last) {
#pragma unroll
                for (int _h = 0; _h < 2; ++_h)
#pragma unroll
                    for (int _i = 0; _i < 2; ++_i) va[_h][_i] = vn[_h][_i]; }
            PG8_WAIT_L(8); PG8_BAR; PG8_WAIT_L(0); PG8_MMA(0, 0, At, B0); PG8_BAR; PG8_SCHED;
            PG8_LDB(B1, 0, 1); PG8_STAGE(PG8_SB(0, 0), b2, voffB);
            PG8_BAR; PG8_WAIT_L(0); PG8_MMA(0, 1, At, B1); PG8_BAR;
            PG8_LDA(At, 0, 1); PG8_STAGE(PG8_SA(0, 0), a2, va[0]);
            PG8_BAR; PG8_WAIT_L(0); PG8_MMA(1, 0, At, B0); PG8_BAR; PG8_SCHED;
            PG8_STAGE(PG8_SB(0, 1), b2 + hstep, voffB);
            PG8_WAIT_V(6); PG8_BAR; PG8_MMA(1, 1, At, B1); PG8_BAR;
            PG8_LDB(B0, 1, 0); PG8_SCHED; PG8_LDA(At, 1, 0); PG8_STAGE(PG8_SA(0, 1), a2, va[1]);
            PG8_WAIT_L(8); PG8_BAR; PG8_WAIT_L(0); PG8_MMA(0, 0, At, B0); PG8_BAR; PG8_SCHED;
            PG8_LDB(B1, 1, 1); PG8_STAGE(PG8_SB(1, 0), b3, voffB);
            PG8_BAR; PG8_WAIT_L(0); PG8_MMA(0, 1, At, B1); PG8_BAR;
            PG8_LDA(At, 1, 1); PG8_STAGE(PG8_SA(1, 0), a3, va[0]);
            PG8_BAR; PG8_WAIT_L(0); PG8_MMA(1, 0, At, B0); PG8_BAR; PG8_SCHED;
            PG8_STAGE(PG8_SB(1, 1), b3 + hstep, voffB);
            PG8_WAIT_V(6); PG8_BAR; PG8_MMA(1, 1, At, B1); PG8_BAR;
            }
        }
        if constexpr (ALIGN_EPI) { if (wr == 0) PG8_BAR; }
        E(acc, cur, wr, wc, fr, fq);
        if (!has_next) break;
#pragma unroll
        for (int a = 0; a < 2; ++a)
#pragma unroll
            for (int b = 0; b < 2; ++b)
#pragma unroll
                for (int m = 0; m < 4; ++m)
#pragma unroll
                    for (int n = 0; n < 2; ++n) acc[a][b][m][n] = (f32x4){0.f, 0.f, 0.f, 0.f};
        cur = nxt; cB = nB; ++ui;
        if constexpr (ALIGN_EPI) { if (wr == 1) PG8_BAR; }
    }
    PG8_WAIT_V(0);
    if constexpr (!ALIGN_EPI) { if (wr == 0) PG8_BAR; }
    PG8_BAR;
#undef PG8_SA
#undef PG8_SB
#undef PG8_STAGE
#undef PG8_LDA
#undef PG8_LDB
#undef PG8_MMA
#undef PG8_WAIT_V
#undef PG8_WAIT_L
#undef PG8_BAR
#undef PG8_SCHED
#undef PG8_VOFF
}
}

#define XB_TMO      128
#define XB_XCNT(j)  (256  + 64 * (j))
#define XB_XSUB(j)  (1280 + 64 * (j))
#define XB_XGEN(j)  (2304 + 64 * (j))
#define XB_TOP      3328
#define XB_TOPGEN   3392
#define XCD_BAR_WORDS 3456
#define XB_SPIN_CAP (1u << 18)

__device__ __forceinline__ unsigned xb_ld(unsigned* p)              { return __hip_atomic_load(p, __ATOMIC_RELAXED, __HIP_MEMORY_SCOPE_AGENT); }
__device__ __forceinline__ unsigned xb_add(unsigned* p, unsigned v) { return __hip_atomic_fetch_add(p, v, __ATOMIC_RELAXED, __HIP_MEMORY_SCOPE_AGENT); }
__device__ __forceinline__ unsigned xb_xcc_id() { return (unsigned)__builtin_amdgcn_s_getreg((3 << 11) | 20) & 0xFu; }
#define XB_SPIN(cond, bar) do { unsigned _sp = 0; while (cond) { __builtin_amdgcn_s_sleep(1); \
    if ((++_sp & 255u) == 0u) { if (xb_ld(&(bar)[XB_TMO])) break; if (_sp > XB_SPIN_CAP) { atomicAdd(&(bar)[XB_TMO], 1u); break; } } } } while (0)

struct XcdBarrier {
    unsigned* bar; unsigned x;
    volatile LAS unsigned* st;
};
__device__ __forceinline__ XcdBarrier xcd_barrier_post(unsigned* bar, volatile LAS unsigned* st) {
    XcdBarrier b; b.bar = bar; b.x = xb_xcc_id(); b.st = st;
    if (threadIdx.x == 0) (void)xb_add(&bar[XB_XCNT(b.x)], 1u);
    return b;
}
__device__ __forceinline__ void xcd_barrier_complete(unsigned* bar, unsigned x, unsigned& nloc, unsigned& nx) {
    const unsigned G = gridDim.x * gridDim.y * gridDim.z;
    unsigned sum, cnt, mine, sp = 0u;
    for (;;) {
        sum = 0u; cnt = 0u; mine = 0u;
#pragma unroll
        for (unsigned j = 0; j < 16; ++j) { const unsigned c = xb_ld(&bar[XB_XCNT(j)]); sum += c; cnt += (c > 0u) ? 1u : 0u; mine = (j == x) ? c : mine; }
        if (sum == G) break;
        __builtin_amdgcn_s_sleep(1);
        if ((++sp & 255u) == 0u) { if (xb_ld(&bar[XB_TMO])) break; if (sp > XB_SPIN_CAP) { atomicAdd(&bar[XB_TMO], 1u); break; } }
    }
    nloc = mine > 0u ? mine : 1u; nx = cnt > 0u ? cnt : 1u;
}
__device__ __forceinline__ void xcd_barrier(const XcdBarrier& b) {
    asm volatile("s_waitcnt vmcnt(0)" ::: "memory");
    __syncthreads();
    if (threadIdx.x == 0) {
        unsigned* bar = b.bar;
        __builtin_amdgcn_s_waitcnt(0);
        unsigned nloc = b.st[0], nx = b.st[1];
        if (nloc == 0u) { xcd_barrier_complete(bar, b.x, nloc, nx); b.st[0] = nloc; b.st[1] = nx; }
        const unsigned old = xb_add(&bar[XB_XSUB(b.x)], 1u);
        const unsigned gen = old / nloc;
        if (old + 1u == (gen + 1u) * nloc) {
            __builtin_amdgcn_fence(__ATOMIC_RELEASE, "agent");
            asm volatile("s_waitcnt vmcnt(0)" ::: "memory");
            const unsigned og = xb_add(&bar[XB_TOP], 1u);
            const unsigned tg = og / nx;
            if (og + 1u == (tg + 1u) * nx) xb_add(&bar[XB_TOPGEN], 1u);
            else XB_SPIN(xb_ld(&bar[XB_TOPGEN]) == tg, bar);
            __builtin_amdgcn_fence(__ATOMIC_ACQUIRE, "agent");
            xb_add(&bar[XB_XGEN(b.x)], 1u);
            asm volatile("s_waitcnt vmcnt(0)" ::: "memory");
        } else {
            XB_SPIN(xb_ld(&bar[XB_XGEN(b.x)]) == gen, bar);
            __builtin_amdgcn_fence(__ATOMIC_ACQUIRE, "agent");
            asm volatile("s_waitcnt vmcnt(0)" ::: "memory");
        }
    }
    __syncthreads();
}

constexpr int NWAVES = 8, NTHREADS = 512;
struct Args { const float* in[19]; float* out; unsigned char* ws; int ph_lo, ph_hi; };
enum { I_X = 0, I_META, I_MIXNW, I_WIN, I_CONVW, I_ALOG, I_DTB, I_GDNNW, I_SBQNW, I_SBKNW, I_SBONW, I_WOUT, I_FFNNW, I_RW, I_RB, I_WGU, I_BGU, I_WD, I_BD };

#define LDS_WAIT() asm volatile("s_waitcnt lgkmcnt(0)" ::: "memory")
#define LDS_BARRIER() do { asm volatile("s_waitcnt lgkmcnt(0)" ::: "memory"); __builtin_amdgcn_s_barrier(); asm volatile("" ::: "memory"); } while (0)
#define VM_WAIT() asm volatile("s_waitcnt vmcnt(0)" ::: "memory")
constexpr int WLS = 2052;

__device__ __forceinline__ void dot16(const f32x4 (&v)[8], const LAS float* wl, int lane, float (&s)[16]) {
#pragma unroll
    for (int c = 0; c < 16; ++c) { float a = 0.f;
#pragma unroll
        for (int j = 0; j < 8; ++j) { const f32x4 w = *(const LAS f32x4*)(wl + c * WLS + 4 * lane + 256 * j); a += (v[j].x * w.x + v[j].y * w.y) + (v[j].z * w.z + v[j].w * w.w); }
        s[c] = wave_sum(a); }
}

template <int NR> __device__ __forceinline__ void dot8xN(const f32x4 (&v)[NR][8], const LAS float* wl, int lane, float (&out)[NR][8]) {
#pragma unroll
    for (int c = 0; c < 8; ++c) { float a[NR];
#pragma unroll
        for (int k = 0; k < NR; ++k) a[k] = 0.f;
#pragma unroll
        for (int j = 0; j < 8; ++j) { const f32x4 w = *(const LAS f32x4*)(wl + c * WLS + 4 * lane + 256 * j);
#pragma unroll
            for (int k = 0; k < NR; ++k) a[k] += (v[k][j].x * w.x + v[k][j].y * w.y) + (v[k][j].z * w.z + v[k][j].w * w.w); }
#pragma unroll
        for (int k = 0; k < NR; ++k) out[k][c] = wave_sum(a[k]); }
}
__device__ __forceinline__ void stage_w16(LAS float* wl, const float* base, int ld, int coloff, int tid) {
    f32x4 v[16];
#pragma unroll
    for (int i = 0; i < 16; ++i) { const int idx = tid + i * NTHREADS, k = idx >> 2, q = idx & 3; v[i] = *(const f32x4*)(base + (size_t)k * ld + coloff + 4 * q); }
#pragma unroll
    for (int i = 0; i < 16; ++i) { const int idx = tid + i * NTHREADS, k = idx >> 2, q = idx & 3;
        wl[(4 * q + 0) * WLS + k] = v[i].x; wl[(4 * q + 1) * WLS + k] = v[i].y; wl[(4 * q + 2) * WLS + k] = v[i].z; wl[(4 * q + 3) * WLS + k] = v[i].w; }
}

constexpr int XROW = 1040;
constexpr int XBUF = 64 * XROW;
constexpr int P5_LG = 2 * XBUF, P5_RS = P5_LG + 64 * 33 * 4, P5_WN = P5_RS + 512, P5_SSP = 65536;
__device__ __forceinline__ void p0_beta_g(float braw, float araw, float alog, float dtb, float& beta, float& g) {
    beta = 1.0f / (1.0f + expf(-braw));
    const float xa = araw + dtb; const float sp = fmaxf(xa, 0.f) + log1pf(expf(-fabsf(xa)));
    g = -expf(alog) * sp;
}
__device__ __forceinline__ void p0_rows(const Args& a, LAS unsigned char* lds, int G, int c, int tid) {
    const float* x = a.in[I_X]; const float* meta = a.in[I_META]; const float* nw = a.in[I_MIXNW]; const float* win = a.in[I_WIN];
    bf16_t* HN = (bf16_t*)(a.ws + WS_HN); float* BETA = (float*)(a.ws + WS_BETA); float* GG = (float*)(a.ws + WS_G);
    LAS float* ba = (LAS float*)(lds + P5_LG);
    LAS float* rs = (LAS float*)(lds + P5_RS);
    for (int blk = c; blk < NREAL / 64; blk += G) {
        asm volatile("" : "+v"(tid));
        const int wv = __builtin_amdgcn_readfirstlane(tid >> 6), lane = tid & 63, i16 = lane & 15, kq = lane >> 4;
        __syncthreads();
        const char* xg = (const char*)(x + (size_t)blk * 64 * DM) + lane * 16;
        const int rowbase = (blk * 64 / SEQ) * LSEQ + NMETA + (blk * 64) % SEQ;
#define P0_DMA(ch, b) do { _Pragma("unroll") for (int _r = 0; _r < 8; ++_r) \
        __builtin_amdgcn_global_load_lds((const unsigned*)(xg + (size_t)(wv * 8 + _r) * (DM * 4) + (ch) * 1024), (LAS unsigned*)(lds + (b) * XBUF + (wv * 8 + _r) * XROW), 16, 0, 0); } while (0)
        P0_DMA(0, 0); P0_DMA(1, 1);
        float Bv[8][8];
        unsigned kob = (unsigned)(32 * wv + 8 * kq) * 4u, lob = (unsigned)((32 * wv + 8 * kq) * NPROJ_SRC + 4096 + i16) * 4u; asm volatile("" : "+v"(kob), "+v"(lob));
        f32x4 w4[8][2];
        { float raw[8][8];
#pragma unroll
            for (int ch = 0; ch < 8; ++ch) {
#pragma unroll
                for (int q = 0; q < 2; ++q) w4[ch][q] = *(const f32x4*)((const char*)nw + (kob + (unsigned)((256 * ch + 4 * q) * 4)));
#pragma unroll
                for (int j = 0; j < 8; ++j) raw[ch][j] = *(const float*)((const char*)win + (lob + (unsigned)((256 * ch + j) * NPROJ_SRC * 4))); }
            __builtin_amdgcn_sched_barrier(0);
#pragma unroll
            for (int ch = 0; ch < 8; ++ch)
#pragma unroll
                for (int j = 0; j < 8; ++j) Bv[ch][j] = raw[ch][j] * w4[ch][j >> 2][j & 3];
            __builtin_amdgcn_sched_barrier(0); }
        f32x4 acc[4]; float ss[4];
#pragma unroll
        for (int rb = 0; rb < 4; ++rb) { acc[rb] = (f32x4){0.f, 0.f, 0.f, 0.f}; ss[rb] = 0.f; }
        asm volatile("s_waitcnt vmcnt(0)" ::: "memory");
#pragma unroll
        for (int ch = 0; ch < 8; ++ch) {
            if (ch == 7) asm volatile("s_waitcnt vmcnt(8)" ::: "memory"); else if (ch >= 1) asm volatile("s_waitcnt vmcnt(16)" ::: "memory");
            __builtin_amdgcn_s_barrier();
            const LAS unsigned char* xb = lds + (ch & 1) * XBUF + i16 * XROW + (32 * wv + 8 * kq) * 4;
            f32x4 av[4][2];
#pragma unroll
            for (int rb = 0; rb < 4; ++rb) { av[rb][0] = *(const LAS f32x4*)(xb + rb * 16 * XROW); av[rb][1] = *(const LAS f32x4*)(xb + rb * 16 * XROW + 16); }
            asm volatile("s_waitcnt lgkmcnt(0)" ::: "memory");
            __builtin_amdgcn_s_barrier();
            if (ch + 2 < 8) P0_DMA(ch + 2, ch & 1);
            __builtin_amdgcn_sched_barrier(0);
#pragma unroll
            for (int rb = 0; rb < 4; ++rb) { const f32x4 y0 = av[rb][0] * w4[ch][0], y1 = av[rb][1] * w4[ch][1];
                u32x4 ov; ov.x = cvt_pk_bf16(y0.x, y0.y); ov.y = cvt_pk_bf16(y0.z, y0.w); ov.z = cvt_pk_bf16(y1.x, y1.y); ov.w = cvt_pk_bf16(y1.z, y1.w);
                *(u32x4*)(HN + (size_t)(rowbase + 16 * rb + i16) * DM + 256 * ch + 32 * wv + 8 * kq) = ov; }
            __builtin_amdgcn_sched_barrier(0);
#pragma unroll
            for (int j = 0; j < 8; ++j)
#pragma unroll
                for (int rb = 0; rb < 4; ++rb) { const float xv = av[rb][j >> 2][j & 3];
                    ss[rb] += xv * xv; acc[rb] = __builtin_amdgcn_mfma_f32_16x16x4f32(xv, Bv[ch][j], acc[rb], 0, 0, 0); }
            __builtin_amdgcn_sched_barrier(0);
        }
#undef P0_DMA
        __builtin_amdgcn_s_barrier();
        { LAS float* red = (LAS float*)lds; LAS float* ssp = (LAS float*)(lds + 32768);
#pragma unroll
            for (int rb = 0; rb < 4; ++rb) {
#pragma unroll
                for (int v = 0; v < 4; ++v) red[(wv * 64 + 16 * rb + 4 * kq + v) * 16 + i16] = acc[rb][v];
                ssp[(wv * 4 + kq) * 64 + 16 * rb + i16] = ss[rb]; }
            __syncthreads();
            if (tid < 64) { float s2 = 0.f;
#pragma unroll
                for (int q = 0; q < 32; ++q) s2 += ssp[q * 64 + tid];
                const float rstd = 1.0f / sqrtf(s2 * (1.0f / DM) + NORM_EPS); rs[tid] = rstd; ((float*)(a.ws + WS_RSTD))[rowbase + tid] = rstd; }
            { const int t = tid >> 3, hh = tid & 7; float sb = 0.f, sa = 0.f;
#pragma unroll
                for (int w2 = 0; w2 < 8; ++w2) { sb += red[(w2 * 64 + t) * 16 + hh]; sa += red[(w2 * 64 + t) * 16 + 8 + hh]; }
                ba[t * 17 + hh] = sb; ba[t * 17 + 8 + hh] = sa; } }
        __syncthreads();
        { const int t = tid >> 3, hh = tid & 7; const float rstd = rs[t]; float beta, g;
            p0_beta_g(ba[t * 17 + hh] * rstd, ba[t * 17 + 8 + hh] * rstd, a.in[I_ALOG][hh], a.in[I_DTB][hh], beta, g);
            const int gr = blk * 64 + t, b = gr / SEQ, row = b * LSEQ + NMETA + (gr - b * SEQ);
            BETA[(size_t)row * 8 + hh] = beta; GG[(size_t)row * 8 + hh] = g; }
    }
    { asm volatile("" : "+v"(tid)); const int wv = __builtin_amdgcn_readfirstlane(tid >> 6), lane = tid & 63;
        const int t0m = (G >= 32) ? (((c & 7) >= 2 && (c & 7) < 6 && (c >> 3) < 4) ? 4 * (c >> 3) + (c & 7) - 2 : NMETA) : c, tsm = (G >= 32) ? NMETA : G;
        if (wv == 7) for (int t = t0m; t < NMETA; t += tsm) {
            f32x4 v[8]; float ssm = 0.f;
#pragma unroll
            for (int j = 0; j < 8; ++j) { v[j] = *((const f32x4*)(meta + (size_t)t * DM) + lane + 64 * j); ssm += (v[j].x * v[j].x + v[j].y * v[j].y) + (v[j].z * v[j].z + v[j].w * v[j].w); }
            const float rstd = 1.0f / sqrtf(wave_sum(ssm) * (1.0f / DM) + NORM_EPS);
            GAS unsigned long long* o8 = (GAS unsigned long long*)(HN + (size_t)t * DM) + lane;
            float dsum[16];
#pragma unroll
            for (int n = 0; n < 16; ++n) dsum[n] = 0.f;
#pragma unroll
            for (int j = 0; j < 8; ++j) { const f32x4 y = v[j] * rstd * *((const f32x4*)nw + lane + 64 * j);
                o8[64 * j] = (unsigned long long)cvt_pk_bf16(y.x, y.y) | ((unsigned long long)cvt_pk_bf16(y.z, y.w) << 32);
#pragma unroll
                for (int kk = 0; kk < 4; ++kk) { const float* wr = win + (size_t)(4 * lane + 256 * j + kk) * NPROJ_SRC + 4096;
#pragma unroll
                    for (int q = 0; q < 4; ++q) { const f32x4 w = *(const f32x4*)(wr + 4 * q);
                        dsum[4 * q + 0] += y[kk] * w.x; dsum[4 * q + 1] += y[kk] * w.y; dsum[4 * q + 2] += y[kk] * w.z; dsum[4 * q + 3] += y[kk] * w.w; } } }
            float mine_b = 0.f, mine_a = 0.f; const int hh = lane & 7;
#pragma unroll
            for (int n = 0; n < 8; ++n) { const float sb = wave_sum(dsum[n]), sa = wave_sum(dsum[8 + n]); mine_b = (hh == n) ? sb : mine_b; mine_a = (hh == n) ? sa : mine_a; }
            if (lane < 32) { float beta, g; p0_beta_g(mine_b, mine_a, a.in[I_ALOG][hh], a.in[I_DTB][hh], beta, g);
                const int row = (lane >> 3) * LSEQ + t; BETA[(size_t)row * 8 + hh] = beta; GG[(size_t)row * 8 + hh] = g; } } }
    __syncthreads();
}

constexpr int CVT_STR = 132;
template <int MODE  >
__device__ __forceinline__ void cvt_tile(const float* W, int ldw, int K, bf16_t* out, int kb, int nt, LAS unsigned char* T, int lane) {
    const int r0 = nt * 64;
    int c0;
    if (MODE == 0) c0 = r0;
    else if (MODE == 1) c0 = r0 < 4096 ? r0 : r0 + 16;
    else { const int pn = r0 >> 8, rr = r0 & 255; c0 = rr < 128 ? 128 * pn + rr : 2048 + 128 * pn + (rr - 128); }
    const int kq = lane >> 4, nl = lane & 15;
    const float* src = W + (size_t)(kb * 64 + 2 * kq) * ldw + c0 + 4 * nl;
    f32x4 v[8][2];
#pragma unroll
    for (int i = 0; i < 8; ++i)
#pragma unroll
        for (int j = 0; j < 2; ++j) v[i][j] = *(const f32x4*)(src + (size_t)(8 * i + j) * ldw);
    LAS unsigned char* tw = T + (4 * nl) * CVT_STR + 4 * kq;
#pragma unroll
    for (int i = 0; i < 8; ++i)
#pragma unroll
        for (int q = 0; q < 4; ++q) *(LAS unsigned*)(tw + q * CVT_STR + 16 * i) = cvt_pk_bf16(v[i][0][q], v[i][1][q]);
    LDS_WAIT();
    const int rn = lane >> 3, cc = lane & 7;
    const LAS unsigned char* tr = T + rn * CVT_STR + 16 * cc;
    bf16_t* dst = out + (size_t)(r0 + rn) * K + kb * 64 + 8 * cc;
#pragma unroll
    for (int j = 0; j < 8; ++j) { u32x4 w; const LAS unsigned* p = (const LAS unsigned*)(tr + 8 * j * CVT_STR); w.x = p[0]; w.y = p[1]; w.z = p[2]; w.w = p[3];
        *(u32x4*)(dst + (size_t)(8 * j) * K) = w; }
    LDS_WAIT();
}
constexpr float W8_SCALE = 64.0f;
template <int MODE, int NLD = 8>
__device__ __forceinline__ void cvt_tile_fp8(const float* W, int ldw, int K, unsigned char* out, int kb, int nt, LAS unsigned char* T, int lane) {
    const int r0 = nt * 64;
    int c0;
    if (MODE == 0) c0 = r0;
    else { const int pn = r0 >> 8, rr = r0 & 255; c0 = rr < 128 ? 128 * pn + rr : 2048 + 128 * pn + (rr - 128); }
    const int kq = lane >> 4, nl = lane & 15;
    LAS unsigned char* tw = T + (4 * nl) * CVT_STR + 4 * kq;
    const float* src = W + (size_t)(kb * 128 + 4 * kq) * ldw + c0 + 4 * nl;
#pragma unroll
    for (int i0 = 0; i0 < 8; i0 += NLD) {
        f32x4 v[NLD][4];
#pragma unroll
        for (int i = 0; i < NLD; ++i)
#pragma unroll
            for (int j = 0; j < 4; ++j) v[i][j] = *(const f32x4*)(src + (size_t)(16 * (i0 + i) + j) * ldw);
#pragma unroll
        for (int i = 0; i < NLD; ++i)
#pragma unroll
            for (int q = 0; q < 4; ++q) *(LAS unsigned*)(tw + q * CVT_STR + 16 * (i0 + i)) =
                pk4_fp8(v[i][0][q] * W8_SCALE, v[i][1][q] * W8_SCALE, v[i][2][q] * W8_SCALE, v[i][3][q] * W8_SCALE);
    }
    LDS_WAIT();
    const int rn = lane >> 3, cc = lane & 7;
    const LAS unsigned char* tr = T + rn * CVT_STR + 16 * cc;
    unsigned char* dst = out + (size_t)(r0 + rn) * K + kb * 128 + 16 * cc;
#pragma unroll
    for (int j = 0; j < 8; ++j) { u32x4 w; const LAS unsigned* p = (const LAS unsigned*)(tr + 8 * j * CVT_STR); w.x = p[0]; w.y = p[1]; w.z = p[2]; w.w = p[3];
        *(u32x4*)(dst + (size_t)(8 * j) * K) = w; }
    LDS_WAIT();
}
__device__ __forceinline__ void p0_weights(const Args& a, LAS unsigned char* lds, int vcu, int G, int wave, int lane) {
    constexpr int I_IN = 32 * 14, I_OUT = 32 * 4;
    constexpr int NITEMS = I_IN + I_OUT;
    LAS unsigned char* T = lds + wave * (64 * CVT_STR);
    for (int it = vcu; it < NITEMS; it += G) {
        int r = it;
        if (r < I_IN) { cvt_tile<1>(a.in[I_WIN], NPROJ_SRC, DM, (bf16_t*)(a.ws + WS_WIN), r / 14, (r % 14) * 8 + wave, T, lane); continue; } r -= I_IN;
        cvt_tile<0>(a.in[I_WOUT], DM, DM, (bf16_t*)(a.ws + WS_WOUT), r / 4, (r % 4) * 8 + wave, T, lane);
    }
}
constexpr int MOE_I_GU = 8 * 4, MOE_I_D = 4 * 4, MOE_ITEMS = NEXP * (MOE_I_GU + MOE_I_D);
template <int NLD = 8> __device__ __forceinline__ void moe_weights_queue(const Args& a, LAS unsigned char* lds, LAS int* qslot, int tid, int wave, int lane, int limit) {
    unsigned* ctr = (unsigned*)(a.ws + WS_CTL) + CW_CVTQ;
    LAS unsigned char* T = lds + wave * (64 * CVT_STR);
    for (;;) {
        __syncthreads();
        if (tid == 0) { int v = (int)__hip_atomic_load(ctr, __ATOMIC_RELAXED, __HIP_MEMORY_SCOPE_AGENT); v = (v < limit) ? (int)atomicAdd(ctr, 1u) : MOE_ITEMS; *qslot = v; }
        __syncthreads();
        const int it = *(volatile LAS int*)qslot;
        if (it >= MOE_ITEMS) break;
        if (it < NEXP * MOE_I_GU) { const int e = it / MOE_I_GU, q = it % MOE_I_GU, ng = q & 7, kq = q >> 3;
#pragma unroll 1
            for (int kb = kq * 4; kb < kq * 4 + 4; ++kb)
                cvt_tile_fp8<2, NLD>(a.in[I_WGU] + (size_t)e * DM * 2 * DE, 2 * DE, DM, a.ws + WS_WGU + (size_t)e * 2 * DE * DM, kb, ng * 8 + wave, T, lane);
        } else { const int r = it - NEXP * MOE_I_GU, e = r / MOE_I_D, q = r % MOE_I_D, ng = q & 3, kq = q >> 2;
#pragma unroll 1
            for (int kb = kq * 4; kb < kq * 4 + 4; ++kb)
                cvt_tile_fp8<0, NLD>(a.in[I_WD] + (size_t)e * DE * DM, DM, DE, a.ws + WS_WD + (size_t)e * DM * DE, kb, ng * 8 + wave, T, lane);
        }
    }
}

__device__ __forceinline__ void p2_qknorm(const Args& a, int gw, int NGW, int lane) {
    const bf16_t* P = (const bf16_t*)(a.ws + WS_P); bf16_t* QN = (bf16_t*)(a.ws + WS_QN); bf16_t* KN = (bf16_t*)(a.ws + WS_KN);
    const float QS = 0.08838834764831845f * 1.4426950408889634f;
    const int cs = lane & 15, hq = lane >> 4;
    float qw[8], kw[8];
#pragma unroll
    for (int i = 0; i < 8; ++i) { qw[i] = a.in[I_SBQNW][8 * cs + i] * QS; kw[i] = a.in[I_SBKNW][8 * cs + i]; }
    constexpr int QB_ = 8, NIT = NTOK * 4;
    for (int it0 = gw; it0 < NIT; it0 += QB_ * NGW) {
        u32x4 w[QB_];
#pragma unroll
        for (int k = 0; k < QB_; ++k) { const int it = it0 + k * NGW; w[k] = (u32x4){0u, 0u, 0u, 0u};
            if (it < NIT) { const int which = it & 1, half = (it >> 1) & 1, row = it >> 2; w[k] = *(const u32x4*)(P + (size_t)row * NPROJ + (which ? PC_SBK : PC_SBQ) + half * 512 + 8 * lane); } }
#pragma unroll
        for (int k = 0; k < QB_; ++k) { const int it = it0 + k * NGW;
            if (it < NIT) { const int which = it & 1, half = (it >> 1) & 1, row = it >> 2; const int b = row / LSEQ, t = row - b * LSEQ, h = 4 * half + hq;
                float v[8]; v[0] = bf_lo(w[k].x); v[1] = bf_hi(w[k].x); v[2] = bf_lo(w[k].y); v[3] = bf_hi(w[k].y); v[4] = bf_lo(w[k].z); v[5] = bf_hi(w[k].z); v[6] = bf_lo(w[k].w); v[7] = bf_hi(w[k].w);
                float ss = 0.f;
#pragma unroll
                for (int i = 0; i < 8; ++i) ss += v[i] * v[i];
                const float rstd = __builtin_amdgcn_rsqf(row16_sum(ss) * (1.0f / HD) + NORM_EPS);
                float o[8];
#pragma unroll
                for (int i = 0; i < 8; ++i) o[i] = v[i] * rstd * (which ? kw[i] : qw[i]);
                u32x4 ov; ov.x = cvt_pk_bf16(o[0], o[1]); ov.y = cvt_pk_bf16(o[2], o[3]); ov.z = cvt_pk_bf16(o[4], o[5]); ov.w = cvt_pk_bf16(o[6], o[7]);
                *(u32x4*)((which ? KN : QN) + ((size_t)(b * NHEAD + h) * LROW + t) * HD + 8 * cs) = ov; } }
    }
}

__device__ __forceinline__ bf16x8 sba_pack8(const f32x16& p, int base) {
    u32x4 w; w.x = cvt_pk_bf16(p[base + 0], p[base + 1]); w.y = cvt_pk_bf16(p[base + 2], p[base + 3]); w.z = cvt_pk_bf16(p[base + 4], p[base + 5]); w.w = cvt_pk_bf16(p[base + 6], p[base + 7]);
    return __builtin_bit_cast(bf16x8, w);
}

namespace gdn {
constexpr int NCH = 65;
constexpr int IMG_W = 0, IMG_QG = 16384, IMG_KDT = 32768, IMG_AT = 49152, IMG_BYTES = 57344, IMG_U = 57344, CH_BYTES = 73728;
constexpr int L_LT = 0, L_GC = 19456, L_BE = 19712, L_QB = 19968, L_KB = 37376, L_VB = 54784, L_IMG = 72192;
__device__ __forceinline__ int afrag_off(int row, int k, int nks) {
    const int rt = row >> 5, rr = row & 31, ks = k >> 4, kk = k & 15, hi = (kk >> 2) & 1, sl = (kk & 3) + 4 * (kk >> 3);
    return ((rt * nks + ks) * 64 + rr + 32 * hi) * 16 + sl * 2;
}
__device__ __forceinline__ int ufrag_off(int i, int c) {
    const int cg = c >> 5, col = c & 31, rt = i >> 5, ii = i & 31, hi = (ii >> 2) & 1, r = (ii & 3) + 4 * (ii >> 3);
    return (((cg * 2 + rt) * 2 + (r >> 3)) * 64 + col + 32 * hi) * 8 + (r & 7);
}
__device__ __forceinline__ int crow(int r, int hi) { return (r & 3) + 8 * (r >> 2) + 4 * hi; }
__device__ __forceinline__ bf16_t f2bf(float f) { return (bf16_t)(cvt_pk_bf16(f, 0.f) & 0xffffu); }

__device__ __forceinline__ void prefetch_rows(const Args& a, int item, int lane, int wave, unsigned (&xwp)[33], float (&gbp)[2]) {
    if (item >= 32 * NCH) return;
    const int bh = item / NCH, c = item - bh * NCH, b = bh >> 3, h = bh & 7, tbase = 64 * c - 48;
    const bf16_t* P = (const bf16_t*)(a.ws + WS_P) + (size_t)b * LSEQ * NPROJ;
#pragma unroll
    for (int j = 0; j < 11; ++j) { const int t = tbase + 8 * wave - 3 + j;
#pragma unroll
        for (int w3 = 0; w3 < 3; ++w3) { unsigned u = 0u; if (t >= 0) u = *(const unsigned*)(P + (size_t)t * NPROJ + w3 * 1024 + h * HD + 2 * lane); xwp[j * 3 + w3] = u; } }
    if (wave == 0) { const int t = tbase + lane; float g = 0.f, be = 0.f;
        if (t >= 0) { g = ((const float*)(a.ws + WS_G))[((size_t)b * LSEQ + t) * 8 + h]; be = ((const float*)(a.ws + WS_BETA))[((size_t)b * LSEQ + t) * 8 + h]; }
        gbp[0] = g; gbp[1] = be; }
}
__device__ __forceinline__ void precompute(const Args& a, LAS unsigned char* lds, int item, int tid, int lane, int wave, unsigned (&xwp)[33], float (&gbp)[2], volatile LAS int* nslot, int nclaim) {
    asm volatile("" : "+v"(tid), "+v"(lane), "+s"(wave));
    const int bh = item / NCH, c = item - bh * NCH, b = bh >> 3, h = bh & 7;
    const bf16_t* P = (const bf16_t*)(a.ws + WS_P) + (size_t)b * LSEQ * NPROJ;
    const float* BETA = (const float*)(a.ws + WS_BETA) + (size_t)b * LSEQ * 8; const float* GG = (const float*)(a.ws + WS_G) + (size_t)b * LSEQ * 8;
    unsigned char* dst = a.ws + WS_GCH + (size_t)item * CH_BYTES;
    LAS float* GC = (LAS float*)(lds + L_GC); LAS float* BE = (LAS float*)(lds + L_BE); LAS float* LT = (LAS float*)(lds + L_LT);
    LAS float* EG = (LAS float*)(lds + L_IMG + CH_BYTES); LAS float* EGL = EG + 64;
    const int tbase = 64 * c - 48;
    if (wave == 0) {
        float g = gbp[0], be = gbp[1];
        g += dpp_get<0x111, 0xF>(g); g += dpp_get<0x112, 0xF>(g); g += dpp_get<0x114, 0xF>(g); g += dpp_get<0x118, 0xF>(g);
        g += dpp_get<0x142, 0xA>(g); g += dpp_get<0x143, 0xC>(g);
        GC[lane] = g; BE[lane] = be;
        { const float g63 = __builtin_bit_cast(float, __builtin_amdgcn_readlane(__builtin_bit_cast(int, g), 63)); EG[lane] = __expf(g); EGL[lane] = __expf(g63 - g); }
        if (lane == 63) ((float*)(a.ws + WS_GL))[item] = expf(g);
    }
    {
        f32x2 cw[3][4];
#pragma unroll
        for (int w3 = 0; w3 < 3; ++w3)
#pragma unroll
            for (int tap = 0; tap < 4; ++tap) cw[w3][tap] = *(const f32x2*)(a.in[I_CONVW] + tap * 3072 + w3 * 1024 + h * HD + 2 * lane);
        f32x2 xw[3][11];
#pragma unroll
        for (int j = 0; j < 11; ++j)
#pragma unroll
            for (int w3 = 0; w3 < 3; ++w3) { const unsigned u = xwp[j * 3 + w3]; xw[w3][j] = (f32x2){bf_lo(u), bf_hi(u)}; }
#pragma unroll
        for (int rr = 0; rr < 8; ++rr) { const int i = 8 * wave + rr; f32x2 y[3];
#pragma unroll
            for (int w3 = 0; w3 < 3; ++w3) { f32x2 acc = cw[w3][0] * xw[w3][rr] + cw[w3][1] * xw[w3][rr + 1] + cw[w3][2] * xw[w3][rr + 2] + cw[w3][3] * xw[w3][rr + 3];
                acc.x = acc.x * __builtin_amdgcn_rcpf(1.0f + __expf(-acc.x)); acc.y = acc.y * __builtin_amdgcn_rcpf(1.0f + __expf(-acc.y)); y[w3] = acc; }
            const float rq = 0.08838834764831845f * __builtin_amdgcn_rsqf(wave_sum(y[0].x * y[0].x + y[0].y * y[0].y) + NORM_EPS);
            const float rk = __builtin_amdgcn_rsqf(wave_sum(y[1].x * y[1].x + y[1].y * y[1].y) + NORM_EPS);
            *(LAS unsigned*)(lds + L_QB + i * 272 + 4 * lane) = cvt_pk_bf16(y[0].x * rq, y[0].y * rq);
            *(LAS unsigned*)(lds + L_KB + i * 272 + 4 * lane) = cvt_pk_bf16(y[1].x * rk, y[1].y * rk);
            *(LAS unsigned*)(lds + L_VB + i * 272 + 4 * lane) = cvt_pk_bf16(y[2].x, y[2].y); }
    }
    __syncthreads();
    {
        const int prod = wave >> 2, ti = (wave >> 1) & 1, tj = wave & 1, r32 = lane & 31, hi = lane >> 5;
        if (tj <= ti) {
            f32x16 acc;
#pragma unroll
            for (int r = 0; r < 16; ++r) acc[r] = 0.f;
            const LAS unsigned char* Ab = lds + (prod ? L_QB : L_KB) + (32 * ti + r32) * 272 + hi * 16;
            const LAS unsigned char* Bb = lds + L_KB + (32 * tj + r32) * 272 + hi * 16;
#pragma unroll
            for (int ks = 0; ks < 8; ++ks) acc = __builtin_amdgcn_mfma_f32_32x32x16_bf16(*(const LAS bf16x8*)(Ab + ks * 32), *(const LAS bf16x8*)(Bb + ks * 32), acc, 0, 0, 0);
            const int j = 32 * tj + r32; const float gj = GC[j];
#pragma unroll
            for (int r = 0; r < 16; ++r) { const int i = 32 * ti + crow(r, hi); const float dec = __expf(GC[i] - gj);
                if (prod == 0) LT[j * 76 + (i & 1) * 36 + (i >> 1)] = (j < i) ? acc[r] * BE[i] * dec : 0.f;
                else *(LAS bf16_t*)(lds + L_IMG + IMG_AT + afrag_off(i, j, 4)) = f2bf((j <= i) ? acc[r] * dec : 0.f); }
        }
    }
    if (tid == 0) *nslot = nclaim;
    __syncthreads();
    gdn::prefetch_rows(a, *nslot, lane, wave, xwp, gbp);
    {
        const float gl = GC[63];
#pragma unroll
        for (int n2 = 0; n2 < 2; ++n2) {
            const int t2 = tid + NTHREADS * n2, g = t2 >> 6, i = t2 & 63, ks = g >> 1, hh = g & 1; const float e = EG[i];
            const LAS unsigned char* qp = lds + L_QB + i * 272 + (16 * ks + 4 * hh) * 2;
            const u32x2 lo = *(const LAS u32x2*)qp, up = *(const LAS u32x2*)(qp + 16);
            u32x4 w; w.x = cvt_pk_bf16(bf_lo(lo.x) * e, bf_hi(lo.x) * e); w.y = cvt_pk_bf16(bf_lo(lo.y) * e, bf_hi(lo.y) * e);
            w.z = cvt_pk_bf16(bf_lo(up.x) * e, bf_hi(up.x) * e); w.w = cvt_pk_bf16(bf_lo(up.y) * e, bf_hi(up.y) * e);
            *(LAS u32x4*)(lds + L_IMG + IMG_QG + (((i >> 5) * 8 + ks) * 64 + (i & 31) + 32 * hh) * 16) = w; }
#pragma unroll
        for (int n2 = 0; n2 < 2; ++n2) {
            const int t2 = tid + NTHREADS * n2, dk = t2 & 127, g = t2 >> 7, ks = g >> 1, hh = g & 1, ib = 16 * ks + 4 * hh;
            float v[8];
#pragma unroll
            for (int j = 0; j < 4; ++j) {
                v[j] = bf2f(*(const LAS bf16_t*)(lds + L_KB + (ib + j) * 272 + dk * 2)) * EGL[ib + j];
                v[4 + j] = bf2f(*(const LAS bf16_t*)(lds + L_KB + (ib + 8 + j) * 272 + dk * 2)) * EGL[ib + 8 + j]; }
            u32x4 w; w.x = cvt_pk_bf16(v[0], v[1]); w.y = cvt_pk_bf16(v[2], v[3]); w.z = cvt_pk_bf16(v[4], v[5]); w.w = cvt_pk_bf16(v[6], v[7]);
            *(LAS u32x4*)(lds + L_IMG + IMG_KDT + (((dk >> 5) * 4 + ks) * 64 + (dk & 31) + 32 * hh) * 16) = w; }
    }
    {
        float x[32];
        const int cidx = tid >> 1, p = tid & 1, cc = cidx & 127; const bool isv = cidx < 128;
        const LAS unsigned char* src = lds + (isv ? L_VB : L_KB) + cc * 2 + p * 272;
        const LAS float* BEp = BE + p; const LAS float* EGp = EG + p; const LAS float* LTp = LT + p * 36;
#pragma unroll
        for (int r8 = 0; r8 < 32; r8 += 8) {
#pragma unroll
            for (int q = 0; q < 8; ++q) { const int r = r8 + q; const float v = bf2f(*(const LAS bf16_t*)(src + r * 544)); x[r] = v * BEp[2 * r] * (isv ? 1.0f : EGp[2 * r]); }
            asm volatile("" ::: "memory"); }
        f32x4 la[8], lb[8];
#define LT_LOAD(dst, j) do { _Pragma("unroll") for (int _c = ((((j) >> 1) + ((j) & 1)) >> 2); _c < 8; ++_c) dst[_c] = *(const LAS f32x4*)(LTp + (j) * 76 + 4 * _c); } while (0)
#define LT_APPLY(src_, j) do { const float _t = x[(j) >> 1]; const float _s = dpp_get<0xB1, 0xF>(_t); const float xj = (p == ((j) & 1)) ? _t : _s; \
        _Pragma("unroll") for (int _r = ((j) >> 1) + ((j) & 1); _r < 32; ++_r) x[_r] -= src_[_r >> 2][_r & 3] * xj; } while (0)
        LT_LOAD(la, 0);
#pragma unroll
        for (int jj = 0; jj < 31; ++jj) {
            LT_LOAD(lb, 2 * jj + 1); asm volatile("" ::: "memory"); LT_APPLY(la, 2 * jj);
            LT_LOAD(la, 2 * jj + 2); asm volatile("" ::: "memory"); LT_APPLY(lb, 2 * jj + 1);
        }
        LT_APPLY(la, 62);
#undef LT_LOAD
#undef LT_APPLY
        if (isv) {
            LAS unsigned char* ub = lds + L_IMG + IMG_U + (((cc >> 5) * 4 * 64) + (cc & 31)) * 16 + 2 * p;
#pragma unroll
            for (int r = 0; r < 32; ++r) { const int rt = r >> 4, hi = (r >> 1) & 1, rr = 2 * (r & 1) + 4 * ((r >> 2) & 3);
                *(LAS bf16_t*)(ub + (((rt * 2 + (rr >> 3)) * 64 + 32 * hi) * 8 + (rr & 7)) * 2) = f2bf(x[r]); }
        } else {
            const int ks = cc >> 4, kk = cc & 15, hi = (kk >> 2) & 1, sl = (kk & 3) + 4 * (kk >> 3);
            LAS unsigned char* wb = lds + L_IMG + IMG_W + (ks * 64 + 32 * hi) * 16 + sl * 2 + 16 * p;
#pragma unroll
            for (int r = 0; r < 32; ++r) *(LAS bf16_t*)(wb + ((r >> 4) * 8 * 64 + ((2 * r) & 31)) * 16) = f2bf(-x[r]);
        }
    }
    __syncthreads();
    for (int q = tid; q < CH_BYTES / 16; q += NTHREADS) *(u32x4*)(dst + (size_t)q * 16) = *(const LAS u32x4*)(lds + L_IMG + q * 16);
}

constexpr int OB_OFF = 2 * IMG_BYTES, OB_STR = 272, OB_BYTES = 64 * OB_STR;
__device__ __forceinline__ void gated_load_z(const Args& a, u32x4 (&zw)[4], int b, int h, int cc, int w4, int lane) {
    const bf16_t* P = (const bf16_t*)(a.ws + WS_P);
    const int s = 64 * (cc - 1) + 16 * w4 + (lane >> 2);
    const u32x4* zp = (const u32x4*)(P + ((size_t)b * LSEQ + NMETA + s) * NPROJ + PC_Z + h * HD + 32 * (lane & 3));
#pragma unroll
    for (int q = 0; q < 4; ++q) zw[q] = zp[q];
}
__device__ __forceinline__ float silu_f(float z) { return z * __builtin_amdgcn_rcpf(1.0f + __expf(-z)); }
__device__ __forceinline__ void gated_rows(const Args& a, const LAS unsigned char* ob, const u32x4 (&zw)[4], int b, int h, int cc, int w4, int lane, const f32x4 (&nwv)[8]) {
    bf16_t* MIX = (bf16_t*)(a.ws + WS_MIX);
    const int row = lane >> 2, qd = lane & 3, s = 64 * (cc - 1) + 16 * w4 + row;
    u32x4 ov[4]; float ss = 0.f;
#pragma unroll
    for (int q = 0; q < 4; ++q) { ov[q] = *(const LAS u32x4*)(ob + (16 * w4 + row) * OB_STR + qd * 64 + q * 16);
#pragma unroll
        for (int e = 0; e < 4; ++e) { const float lo = bf_lo(ov[q][e]), hi = bf_hi(ov[q][e]); ss += lo * lo + hi * hi; } }
    ss = quad_sum(ss);
    const float rstd = __builtin_amdgcn_rsqf(ss * (1.0f / HD) + NORM_EPS);
    u32x4* dst = (u32x4*)(MIX + ((size_t)b * SEQ + s) * DM + h * HD + 32 * qd);
#pragma unroll
    for (int q = 0; q < 4; ++q) { u32x4 w;
#pragma unroll
        for (int e = 0; e < 4; ++e) { const f32x4 nv = nwv[2 * q + (e >> 1)];
            const float n0 = (e & 1) ? nv.z : nv.x, n1 = (e & 1) ? nv.w : nv.y;
            w[e] = cvt_pk_bf16(bf_lo(ov[q][e]) * rstd * n0 * silu_f(bf_lo(zw[q][e])), bf_hi(ov[q][e]) * rstd * n1 * silu_f(bf_hi(zw[q][e]))); }
        dst[q] = w; }
}

__device__ __forceinline__ void scan(const Args& a, LAS unsigned char* lds, int bh, int tid, int lane, int wave) {
    const int b = bh >> 3, h = bh & 7, col = lane & 31, hi = lane >> 5, cg = wave;
    const unsigned char* src = a.ws + WS_GCH + (size_t)bh * NCH * CH_BYTES;
    const float* GL = (const float*)(a.ws + WS_GL) + bh * NCH;
    __syncthreads();
    const unsigned dvoff = (unsigned)(wave * 1024 + lane * 16), uvoff = (unsigned)(lane * 16);
#define GDN_DMA(ch, buf) do { const unsigned char* _sp = src + (size_t)(ch) * CH_BYTES; _Pragma("unroll") for (int _f = 0; _f < 7; ++_f) { \
        __builtin_amdgcn_global_load_lds((const unsigned*)(_sp + _f * 8192 + dvoff), (LAS unsigned*)(lds + (buf) * IMG_BYTES + wave * 1024 + _f * 8192), 16, 0, 0); } } while (0)
    GDN_DMA(0, 0);
#define GDN_STEP_END(vm) do { asm volatile("s_waitcnt vmcnt(" #vm ")" ::: "memory"); asm volatile("s_waitcnt lgkmcnt(0)" ::: "memory"); __builtin_amdgcn_s_barrier(); asm volatile("" ::: "memory"); } while (0)
    if (wave < 4) {
        f32x16 st[4]; bf16x8 Sb[8]; u32x4 ureg[4]; float gl;
#pragma unroll
        for (int t4 = 0; t4 < 4; ++t4)
#pragma unroll
            for (int r = 0; r < 16; ++r) st[t4][r] = 0.f;
#pragma unroll
        for (int ks = 0; ks < 8; ++ks) Sb[ks] = (bf16x8){0, 0, 0, 0, 0, 0, 0, 0};
#pragma unroll
        for (int q = 0; q < 4; ++q) ureg[q] = *(const u32x4*)(src + IMG_U + cg * 4096 + q * 1024 + uvoff);
        gl = GL[0];
        GDN_STEP_END(0);
        for (int c = 0; c < NCH; ++c) {
            const LAS unsigned char* img = lds + (c & 1) * IMG_BYTES + lane * 16;
            asm volatile("" : "+v"(ureg[0]), "+v"(ureg[1]), "+v"(ureg[2]), "+v"(ureg[3]), "+v"(gl));
            if (c + 1 < NCH) GDN_DMA(c + 1, (c + 1) & 1);
            f32x16 vn[2]; const float glc = gl;
#pragma unroll
            for (int rt = 0; rt < 2; ++rt)
#pragma unroll
                for (int rh = 0; rh < 2; ++rh) { const u32x4 w = ureg[rt * 2 + rh];
                    vn[rt][8 * rh + 0] = bf_lo(w.x); vn[rt][8 * rh + 1] = bf_hi(w.x); vn[rt][8 * rh + 2] = bf_lo(w.y); vn[rt][8 * rh + 3] = bf_hi(w.y);
                    vn[rt][8 * rh + 4] = bf_lo(w.z); vn[rt][8 * rh + 5] = bf_hi(w.z); vn[rt][8 * rh + 6] = bf_lo(w.w); vn[rt][8 * rh + 7] = bf_hi(w.w); }
            asm volatile("" ::: "memory");
            if (c + 1 < NCH) {
#pragma unroll
                for (int q = 0; q < 4; ++q) ureg[q] = *(const u32x4*)(src + (size_t)(c + 1) * CH_BYTES + IMG_U + cg * 4096 + q * 1024 + uvoff);
                gl = GL[c + 1]; }
#pragma unroll
            for (int rt = 0; rt < 2; ++rt) { __builtin_amdgcn_sched_barrier(0);
#pragma unroll
                for (int ks = 0; ks < 8; ++ks) vn[rt] = __builtin_amdgcn_mfma_f32_32x32x16_bf16(*(const LAS bf16x8*)(img + IMG_W + (rt * 8 + ks) * 1024), Sb[ks], vn[rt], 0, 0, 0); }
            __builtin_amdgcn_sched_barrier(0);
            bf16x8 vb[4];
#pragma unroll
            for (int ks = 0; ks < 4; ++ks) vb[ks] = sba_pack8(vn[ks >> 1], 8 * (ks & 1));
            LAS unsigned char* obw = lds + OB_OFF + (c & 1) * OB_BYTES + (32 * cg + col) * 2;
#pragma unroll
            for (int rt = 0; rt < 2; ++rt) { f32x16 o; __builtin_amdgcn_sched_barrier(0);
#pragma unroll
                for (int r = 0; r < 16; ++r) o[r] = 0.f;
#pragma unroll
                for (int ks = 0; ks < 8; ++ks) o = __builtin_amdgcn_mfma_f32_32x32x16_bf16(*(const LAS bf16x8*)(img + IMG_QG + (rt * 8 + ks) * 1024), Sb[ks], o, 0, 0, 0);
#pragma unroll
                for (int ks = 0; ks < 2 * (rt + 1); ++ks) o = __builtin_amdgcn_mfma_f32_32x32x16_bf16(*(const LAS bf16x8*)(img + IMG_AT + (rt * 4 + ks) * 1024), vb[ks], o, 0, 0, 0);
                if (c >= 1) {
#pragma unroll
                    for (int r = 0; r < 16; ++r) *(LAS bf16_t*)(obw + (32 * rt + crow(r, hi)) * OB_STR) = f2bf(o[r]); }
            }
#pragma unroll
            for (int t4 = 0; t4 < 4; ++t4) { __builtin_amdgcn_sched_barrier(0);
#pragma unroll
                for (int r = 0; r < 16; ++r) st[t4][r] *= glc;
#pragma unroll
                for (int ks = 0; ks < 4; ++ks) st[t4] = __builtin_amdgcn_mfma_f32_32x32x16_bf16(*(const LAS bf16x8*)(img + IMG_KDT + (t4 * 4 + ks) * 1024), vb[ks], st[t4], 0, 0, 0);
                Sb[2 * t4] = sba_pack8(st[t4], 0); Sb[2 * t4 + 1] = sba_pack8(st[t4], 8); }
            if (c + 1 < NCH) GDN_STEP_END(5); else GDN_STEP_END(0);
        }
    } else {
        u32x4 zA[4], zB[4]; f32x4 nwv[8];
#pragma unroll
        for (int q = 0; q < 4; ++q) { zA[q] = (u32x4){0u, 0u, 0u, 0u}; zB[q] = (u32x4){0u, 0u, 0u, 0u}; }
#pragma unroll
        for (int q = 0; q < 8; ++q) nwv[q] = *(const f32x4*)(a.in[I_GDNNW] + 32 * (lane & 3) + 4 * q);
        GDN_STEP_END(0);
        for (int c = 0; c < NCH; ++c) {
#pragma unroll
            for (int q = 0; q < 4; ++q) asm volatile("" : "+v"(zA[q]), "+v"(zB[q]));
            if (c + 1 < NCH) GDN_DMA(c + 1, (c + 1) & 1);
            if (c >= 1) { if (c & 1) gated_load_z(a, zA, b, h, c, wave - 4, lane); else gated_load_z(a, zB, b, h, c, wave - 4, lane); }
            asm volatile("" ::: "memory");
            if (c >= 2) { if (c & 1) gated_rows(a, lds + OB_OFF + ((c - 1) & 1) * OB_BYTES, zB, b, h, c - 1, wave - 4, lane, nwv);
                          else gated_rows(a, lds + OB_OFF + ((c - 1) & 1) * OB_BYTES, zA, b, h, c - 1, wave - 4, lane, nwv); }
            if (c >= 2) GDN_STEP_END(4); else GDN_STEP_END(0);
        }
        gated_rows(a, lds + OB_OFF + ((NCH - 1) & 1) * OB_BYTES, zB, b, h, NCH - 1, wave - 4, lane, nwv);
    }
#undef GDN_STEP_END
#undef GDN_DMA
}
}

namespace sba {
#define KSWZ(row, colB) ((row) * 256 + ((colB) ^ (((row) & 7) << 4)))
__device__ __forceinline__ int v_st(int k, int c) { const int kk = (k & ~0xC) | ((k & 4) << 1) | ((k & 8) >> 1); return ((kk >> 3) * 4 + (c >> 5)) * 512 + ((kk & 7) * 32 + (c & 31)) * 2; }
__device__ __forceinline__ int v_rd_base(int lane) { return ((lane & 3) << 3) | (((lane >> 2) & 3) << 6) | (((lane >> 4) & 1) << 5) | (((lane >> 5) & 1) << 8); }
constexpr int v_rd_off(int d0, int ks, int half) { return d0 * 512 + ks * 4096 + half * 2048; }
template <int OFF> __device__ __forceinline__ s16x4 tr_read(int vb) { s16x4 r; asm volatile("ds_read_b64_tr_b16 %0, %1 offset:%2" : "=&v"(r) : "v"(vb), "i"(OFF) : "memory"); return r; }
template <int D0> __device__ __forceinline__ void pv_one(f32x16& od, int vb, bf16x8 pa0, bf16x8 pa1, bf16x8 pa2, bf16x8 pa3) {
    const s16x4 l0 = tr_read<v_rd_off(D0, 0, 0)>(vb), h0 = tr_read<v_rd_off(D0, 0, 1)>(vb), l1 = tr_read<v_rd_off(D0, 1, 0)>(vb), h1 = tr_read<v_rd_off(D0, 1, 1)>(vb);
    const s16x4 l2 = tr_read<v_rd_off(D0, 2, 0)>(vb), h2 = tr_read<v_rd_off(D0, 2, 1)>(vb), l3 = tr_read<v_rd_off(D0, 3, 0)>(vb), h3 = tr_read<v_rd_off(D0, 3, 1)>(vb);
    asm volatile("s_waitcnt lgkmcnt(0)" ::: "memory"); __builtin_amdgcn_sched_barrier(0);
#define PK(L, H) (bf16x8){L[0], L[1], L[2], L[3], H[0], H[1], H[2], H[3]}
    od = __builtin_amdgcn_mfma_f32_32x32x16_bf16(pa0, PK(l0, h0), od, 0, 0, 0);
    od = __builtin_amdgcn_mfma_f32_32x32x16_bf16(pa1, PK(l1, h1), od, 0, 0, 0);
    od = __builtin_amdgcn_mfma_f32_32x32x16_bf16(pa2, PK(l2, h2), od, 0, 0, 0);
    od = __builtin_amdgcn_mfma_f32_32x32x16_bf16(pa3, PK(l3, h3), od, 0, 0, 0);
#undef PK
}
__device__ __forceinline__ int crow(int r, int hi) { return (r & 3) + 8 * (r >> 2) + 4 * hi; }
__device__ __forceinline__ int swap34(int k) { return (k & ~0x18) | ((k & 8) << 1) | ((k & 16) >> 1); }
__device__ __forceinline__ bf16x8 pack8(const f32x16& p, int base) {
    u32x4 w; w.x = cvt_pk_bf16(p[base + 0], p[base + 1]); w.y = cvt_pk_bf16(p[base + 2], p[base + 3]); w.z = cvt_pk_bf16(p[base + 4], p[base + 5]); w.w = cvt_pk_bf16(p[base + 6], p[base + 7]);
    return __builtin_bit_cast(bf16x8, w);
}
constexpr float SB_EXIT = 160.0f;

__device__ __forceinline__ void unit(const Args& a, LAS unsigned char* lds, volatile LAS int* done_cnt, int b, int h, int qb, int tid, int lane, int wid) {
    const bf16_t* QN = (const bf16_t*)(a.ws + WS_QN) + (size_t)(b * NHEAD + h) * LROW * HD;
    const bf16_t* KN = (const bf16_t*)(a.ws + WS_KN) + (size_t)(b * NHEAD + h) * LROW * HD;
    const bf16_t* Vp = (const bf16_t*)(a.ws + WS_P) + (size_t)b * LSEQ * NPROJ + PC_SBV + h * HD;
    bf16_t* MIX = (bf16_t*)(a.ws + WS_MIX);
    const int r32 = lane & 31, hi = lane >> 5;
    LAS unsigned char* K_lds = lds; LAS unsigned char* V_lds = lds + 16384;
    const int tq0 = NMETA + 256 * qb + 32 * wid, tq = tq0 + r32;
    __syncthreads();
    if (tid == 0) *done_cnt = 0;
    bf16x8 qr[8];
#pragma unroll
    for (int d0 = 0; d0 < 8; ++d0) qr[d0] = *(const bf16x8*)(QN + (size_t)tq * HD + d0 * 16 + hi * 8);
    const int sr = tid >> 4, sc = (tid & 15) * 8;
    const int vst0 = v_st(swap34(sr), sc), vst1 = v_st(32 + swap34(sr), sc);
    const int kst0 = KSWZ(sr, sc * 2), kst1 = KSWZ(32 + sr, sc * 2);
    const int vb0 = (int)(unsigned)(unsigned long)V_lds + v_rd_base(lane);
    const int prow = (r32 & 3) + 4 * (r32 >> 3) + 16 * ((r32 >> 2) & 1);
    f32x16 o[4];
#pragma unroll
    for (int d = 0; d < 4; ++d)
#pragma unroll
        for (int r = 0; r < 16; ++r) o[d][r] = 0.f;
    float carry = 0.f; bool flagged = false;
    bf16x8 ks0, ks1, vs0, vs1;
#define SBA_LOAD(kk) do { const int _k0 = 64 * (kk); ks0 = *(const bf16x8*)(KN + (size_t)(_k0 + sr) * HD + sc); ks1 = *(const bf16x8*)(KN + (size_t)(_k0 + 32 + sr) * HD + sc); \
        vs0 = *(const bf16x8*)(Vp + (size_t)(_k0 + sr) * NPROJ + sc); vs1 = *(const bf16x8*)(Vp + (size_t)(_k0 + 32 + sr) * NPROJ + sc); } while (0)
    SBA_LOAD(4 * qb + 4);
    for (int kt = 4 * qb + 4; kt >= 0; --kt) {
        const int k0 = 64 * kt;
        LDS_BARRIER();
        if (*done_cnt == NWAVES) break;
        *(LAS bf16x8*)(K_lds + kst0) = ks0; *(LAS bf16x8*)(K_lds + kst1) = ks1; *(LAS bf16x8*)(V_lds + vst0) = vs0; *(LAS bf16x8*)(V_lds + vst1) = vs1;
        if (kt > 0) SBA_LOAD(kt - 1);
        LDS_BARRIER();
        if (k0 >= tq0 + 32) continue;
        f32x16 p0, p1;
#pragma unroll
        for (int r = 0; r < 16; ++r) { p0[r] = 0.f; p1[r] = 0.f; }
#pragma unroll
        for (int d0 = 0; d0 < 8; ++d0) { const int cb = (d0 * 16 + hi * 8) * 2;
            const bf16x8 b0 = *(const LAS bf16x8*)(K_lds + KSWZ(prow, cb)), b1 = *(const LAS bf16x8*)(K_lds + KSWZ(32 + prow, cb));
            p0 = __builtin_amdgcn_mfma_f32_32x32x16_bf16(b0, qr[d0], p0, 0, 0, 0);
            p1 = __builtin_amdgcn_mfma_f32_32x32x16_bf16(b1, qr[d0], p1, 0, 0, 0); }
        const bool need_mask = (k0 + 63 >= tq0);
        f32x16 s0, s1; float t0 = 0.f, t1 = 0.f;
#pragma unroll
        for (int r = 0; r < 16; ++r) {
            float e0 = __builtin_amdgcn_exp2f(p0[r]), e1 = __builtin_amdgcn_exp2f(p1[r]);
            float q0 = __builtin_amdgcn_logf(1.0f + e0), q1 = __builtin_amdgcn_logf(1.0f + e1);
            if (need_mask) { const bool v0 = (k0 + 16 * hi + r) < tq, v1 = (k0 + 32 + 16 * hi + r) < tq; e0 = v0 ? e0 : 0.f; q0 = v0 ? q0 : 0.f; e1 = v1 ? e1 : 0.f; q1 = v1 ? q1 : 0.f; }
            p0[r] = e0; p1[r] = e1; s0[r] = q0; s1[r] = q1; t0 += q0; t1 += q1; }
        float t1lo, t1hi, t0lo, t0hi;
        { auto rr = __builtin_amdgcn_permlane32_swap(__float_as_uint(t1), __float_as_uint(t1), false, false); t1lo = __uint_as_float(rr[0]); t1hi = __uint_as_float(rr[1]); }
        { auto rr = __builtin_amdgcn_permlane32_swap(__float_as_uint(t0), __float_as_uint(t0), false, false); t0lo = __uint_as_float(rr[0]); t0hi = __uint_as_float(rr[1]); }
        float run1 = carry + (hi ? 0.f : t1hi), run0 = carry + (t1lo + t1hi) + (hi ? 0.f : t0hi);
#pragma unroll
        for (int r = 15; r >= 0; --r) { run1 += s1[r]; p1[r] = p1[r] * __builtin_amdgcn_exp2f(-run1); run0 += s0[r]; p0[r] = p0[r] * __builtin_amdgcn_exp2f(-run0); }
        carry += (t1lo + t1hi) + (t0lo + t0hi);
        const bf16x8 pa0 = pack8(p0, 0), pa1 = pack8(p0, 8), pa2 = pack8(p1, 0), pa3 = pack8(p1, 8);
        pv_one<0>(o[0], vb0, pa0, pa1, pa2, pa3); pv_one<1>(o[1], vb0, pa0, pa1, pa2, pa3); pv_one<2>(o[2], vb0, pa0, pa1, pa2, pa3); pv_one<3>(o[3], vb0, pa0, pa1, pa2, pa3);
        if (!flagged && __all(carry >= SB_EXIT)) { flagged = true; if (lane == 0) (void)__hip_atomic_fetch_add((LAS int*)done_cnt, 1, __ATOMIC_RELAXED, __HIP_MEMORY_SCOPE_WORKGROUP); }
    }
#undef SBA_LOAD
    const float* onw = a.in[I_SBONW];
    float wv[4];
#pragma unroll
    for (int d0 = 0; d0 < 4; ++d0) wv[d0] = onw[32 * d0 + r32];
    LAS unsigned char* stg = lds + 32768 + wid * 8704;
#pragma unroll
    for (int r = 0; r < 16; ++r) {
        float ss = (o[0][r] * o[0][r] + o[1][r] * o[1][r]) + (o[2][r] * o[2][r] + o[3][r] * o[3][r]);
        ss = row16_sum(ss);
        { const auto pr = __builtin_amdgcn_permlane16_swap(__float_as_uint(ss), __float_as_uint(ss), false, false); ss = __uint_as_float(pr[0]) + __uint_as_float(pr[1]); }
        const float rstd = __builtin_amdgcn_rsqf(ss * (1.0f / HD) + NORM_EPS);
        LAS bf16_t* dl = (LAS bf16_t*)(stg + crow(r, hi) * 272) + r32;
#pragma unroll
        for (int d0 = 0; d0 < 4; ++d0) dl[32 * d0] = (bf16_t)(cvt_pk_bf16(o[d0][r] * rstd * wv[d0], 0.f) & 0xffffu);
    }
    asm volatile("s_waitcnt lgkmcnt(0)" ::: "memory");
    {
        const size_t tokbase = (size_t)b * SEQ + (tq0 - NMETA);
#pragma unroll
        for (int i = 0; i < 8; ++i) { const int idx = lane + 64 * i, row = idx >> 4, pc = idx & 15;
            *(u32x4*)(MIX + (tokbase + row) * DM + 1024 + h * HD + 8 * pc) = *(const LAS u32x4*)(stg + row * 272 + 16 * pc); }
    }
}
}

__device__ __forceinline__ void p5_router(const Args& a, LAS unsigned char* lds, int G, int c, int tid) {
    LAS float* lg = (LAS float*)(lds + P5_LG);
    LAS float* rs = (LAS float*)(lds + P5_RS);
    LAS int* misc = (LAS int*)(lds + MISC_OFF);
    const float* H1 = a.out; const float* rw = a.in[I_RW]; const float* rb = a.in[I_RB]; const float* wnp = a.in[I_FFNNW];
    unsigned char* HN2 = a.ws + WS_HN;
    int* RE = (int*)(a.ws + WS_RE); int* RP = (int*)(a.ws + WS_RP); float* RG = (float*)(a.ws + WS_RG); int* LIST = (int*)(a.ws + WS_LIST);
    unsigned* ecnt = (unsigned*)(a.ws + WS_CTL) + CW_ECNT;
    for (int blk = c; blk < NREAL / 64; blk += G) {
        asm volatile("" : "+v"(tid));
        const int wv = __builtin_amdgcn_readfirstlane(tid >> 6), lane = tid & 63, i32 = lane & 31, kh = lane >> 5;
        __syncthreads();
        const char* xg = (const char*)(H1 + (size_t)blk * 64 * DM) + lane * 16;
#define P5_DMA(ch, b) do { _Pragma("unroll") for (int _r = 0; _r < 8; ++_r) \
        __builtin_amdgcn_global_load_lds((const unsigned*)(xg + (size_t)(wv * 8 + _r) * (DM * 4) + (ch) * 1024), (LAS unsigned*)(lds + (b) * XBUF + (wv * 8 + _r) * XROW), 16, 0, 0); } while (0)
        P5_DMA(0, 0); P5_DMA(1, 1);
        *(LAS f32x4*)(lds + P5_WN + tid * 16) = *((const f32x4*)wnp + tid);
        float Bv[8][16];
        unsigned kob = (unsigned)(32 * wv + 16 * kh) * 4u, lob = (unsigned)((32 * wv + 16 * kh) * NEXP + i32) * 4u; asm volatile("" : "+v"(kob), "+v"(lob));
#pragma unroll
        for (int g2 = 0; g2 < 2; ++g2) { float raw[4][16]; f32x4 w4[4][4];
#pragma unroll
            for (int c4 = 0; c4 < 4; ++c4) { const int ch = g2 * 4 + c4;
#pragma unroll
                for (int q = 0; q < 4; ++q) w4[c4][q] = *(const f32x4*)((const char*)wnp + (kob + (unsigned)((256 * ch + 4 * q) * 4)));
#pragma unroll
                for (int j = 0; j < 16; ++j) raw[c4][j] = *(const float*)((const char*)rw + (lob + (unsigned)((256 * ch + j) * NEXP * 4))); }
            __builtin_amdgcn_sched_barrier(0);
#pragma unroll
            for (int c4 = 0; c4 < 4; ++c4)
#pragma unroll
                for (int j = 0; j < 16; ++j) Bv[g2 * 4 + c4][j] = raw[c4][j] * w4[c4][j >> 2][j & 3];
            __builtin_amdgcn_sched_barrier(0); }
        f32x16 acc0, acc1; float ss0 = 0.f, ss1 = 0.f;
#pragma unroll
        for (int v = 0; v < 16; ++v) { acc0[v] = 0.f; acc1[v] = 0.f; }
        asm volatile("s_waitcnt vmcnt(0)" ::: "memory");
#pragma unroll
        for (int ch = 0; ch < 8; ++ch) {
            if (ch == 7) asm volatile("s_waitcnt vmcnt(4)" ::: "memory"); else if (ch >= 1) asm volatile("s_waitcnt vmcnt(12)" ::: "memory");
            __builtin_amdgcn_s_barrier();
            const LAS unsigned char* xb = lds + (ch & 1) * XBUF + i32 * XROW + (32 * wv + 16 * kh) * 4;
            f32x4 a0[4], a1[4], wq[4];
#pragma unroll
            for (int q = 0; q < 4; ++q) { a0[q] = *(const LAS f32x4*)(xb + 16 * q); a1[q] = *(const LAS f32x4*)(xb + 32 * XROW + 16 * q); wq[q] = *(const LAS f32x4*)(lds + P5_WN + (256 * ch + 32 * wv + 16 * kh + 4 * q) * 4); }
            asm volatile("s_waitcnt lgkmcnt(0)" ::: "memory");
            __builtin_amdgcn_s_barrier();
            if (ch + 2 < 8) P5_DMA(ch + 2, ch & 1);
            __builtin_amdgcn_sched_barrier(0);
            { u32x4 o0, o1;
#pragma unroll
                for (int q = 0; q < 4; ++q) { const f32x4 y0 = a0[q] * wq[q], y1 = a1[q] * wq[q]; o0[q] = pk4_fp8(y0.x, y0.y, y0.z, y0.w); o1[q] = pk4_fp8(y1.x, y1.y, y1.z, y1.w); }
                unsigned char* dst = HN2 + ((size_t)blk * 64 + i32) * DM + 256 * ch + 32 * wv + 16 * kh;
                *(u32x4*)dst = o0; *(u32x4*)(dst + (size_t)32 * DM) = o1; }
            __builtin_amdgcn_sched_barrier(0);
#pragma unroll
            for (int q = 0; q < 4; ++q)
#pragma unroll
                for (int jj = 0; jj < 4; ++jj) { const float x0 = a0[q][jj], x1 = a1[q][jj], bw = Bv[ch][4 * q + jj];
                    ss0 += x0 * x0; ss1 += x1 * x1;
                    acc0 = __builtin_amdgcn_mfma_f32_32x32x2f32(x0, bw, acc0, 0, 0, 0); acc1 = __builtin_amdgcn_mfma_f32_32x32x2f32(x1, bw, acc1, 0, 0, 0); }
            __builtin_amdgcn_sched_barrier(0);
        }
#undef P5_DMA
        { LAS float* red = (LAS float*)lds; LAS float* ssp = (LAS float*)(lds + P5_SSP);
#pragma unroll
            for (int v = 0; v < 16; ++v) { const int t = 8 * (v >> 2) + 4 * kh + (v & 3); red[(wv * 64 + t) * 32 + i32] = acc0[v]; red[(wv * 64 + 32 + t) * 32 + i32] = acc1[v]; }
            ssp[(wv * 2 + kh) * 64 + i32] = ss0; ssp[(wv * 2 + kh) * 64 + 32 + i32] = ss1;
            __syncthreads();
            { const int t = tid >> 3, e4 = tid & 7; f32x4 sacc = *(const LAS f32x4*)(red + t * 32 + 4 * e4);
#pragma unroll
                for (int w2 = 1; w2 < 8; ++w2) sacc += *(const LAS f32x4*)(red + (w2 * 64 + t) * 32 + 4 * e4);
                lg[t * 33 + 4 * e4 + 0] = sacc.x; lg[t * 33 + 4 * e4 + 1] = sacc.y; lg[t * 33 + 4 * e4 + 2] = sacc.z; lg[t * 33 + 4 * e4 + 3] = sacc.w; }
            if (tid < 64) { float ss = 0.f;
#pragma unroll
                for (int q = 0; q < 16; ++q) ss += ssp[q * 64 + tid];
                const float rstd = 1.0f / sqrtf(ss * (1.0f / DM) + NORM_EPS); rs[tid] = rstd; ((float*)(a.ws + WS_RSTD))[blk * 64 + tid] = rstd; }
            if (tid < 32) misc[40 + tid] = 0; }
        __syncthreads();
        __syncthreads();
        int ek[4] = {0, 0, 0, 0}, rk[4] = {0, 0, 0, 0}; float gk[4] = {0.f, 0.f, 0.f, 0.f};
        if (tid < 64) {
            float v[32];
            const float rstd = rs[tid];
#pragma unroll
            for (int e = 0; e < 32; ++e) v[e] = lg[tid * 33 + e] * rstd + rb[e];
            float val[4];
#pragma unroll
            for (int k = 0; k < 4; ++k) { float best = -3.0e38f; int bi = 0;
#pragma unroll
                for (int e = 0; e < 32; ++e) { const bool gt = v[e] > best; best = gt ? v[e] : best; bi = gt ? e : bi; }
#pragma unroll
                for (int e = 0; e < 32; ++e) v[e] = (e == bi) ? -3.0e38f : v[e];
                ek[k] = bi; val[k] = best; }
            float den = 0.f;
#pragma unroll
            for (int k = 0; k < 4; ++k) { gk[k] = expf(val[k] - val[0]); den += gk[k]; }
#pragma unroll
            for (int k = 0; k < 4; ++k) { gk[k] = gk[k] / den; rk[k] = __hip_atomic_fetch_add(&misc[40 + ek[k]], 1, __ATOMIC_RELAXED, __HIP_MEMORY_SCOPE_WORKGROUP); }
        }
        __syncthreads();
        if (tid < 32) { const int cnt = misc[40 + tid]; misc[72 + tid] = cnt ? (int)atomicAdd(&ecnt[tid], (unsigned)cnt) : 0; }
        __syncthreads();
        if (tid < 64) { const int tok = blk * 64 + tid; const int lent = (int)(((__float_as_uint(rs[tid]) + 0x2000u) & 0xffffc000u) | (unsigned)tok);
#pragma unroll
            for (int k = 0; k < 4; ++k) { const int pos = misc[72 + ek[k]] + rk[k]; LIST[(size_t)ek[k] * NREAL + pos] = lent; RE[tok * 4 + k] = ek[k]; RP[tok * 4 + k] = pos; RG[tok * 4 + k] = gk[k]; } }
    }
    __syncthreads();
}

__device__ __forceinline__ int moe_setup(const Args& a, LAS int* misc, int tid) {
    const unsigned* ecnt = (const unsigned*)(a.ws + WS_CTL) + CW_ECNT;
    __syncthreads();
    if (tid < NEXP) misc[104 + tid] = (int)__hip_atomic_load(ecnt + tid, __ATOMIC_RELAXED, __HIP_MEMORY_SCOPE_AGENT);
    __syncthreads();
    if (tid == 0) { int acc = 0;
        for (int e = 0; e < NEXP; ++e) { misc[e] = acc; acc += (misc[104 + e] + 255) >> 8; }
        misc[32] = acc; }
    __syncthreads();
    return misc[32];
}

__device__ __forceinline__ void p8_combine(const Args& a, const LAS int* misc, int gw, int NGW, int lane) {
    const int* RE = (const int*)(a.ws + WS_RE); const int* RP = (const int*)(a.ws + WS_RP); const float* RG = (const float*)(a.ws + WS_RG);
    const unsigned char* Y = a.ws + WS_Y; float* out = a.out;
    typedef int i32x4 __attribute__((ext_vector_type(4)));
    i32x4 e4 = {0, 0, 0, 0}, p4 = {0, 0, 0, 0}; f32x4 g4 = {0.f, 0.f, 0.f, 0.f};
    if (gw < NREAL) { e4 = *(const i32x4*)(RE + gw * 4); p4 = *(const i32x4*)(RP + gw * 4); g4 = *(const f32x4*)(RG + gw * 4); }
#define P8_LOAD(ACC, YY, ROW, SLOT, H) do { const int _col = 16 * lane + 1024 * (H); \
        _Pragma("unroll") for (int _q = 0; _q < 4; ++_q) ACC[_q] = *(const f32x4*)(out + (size_t)(ROW) * DM + _col + 4 * _q); \
        _Pragma("unroll") for (int _k = 0; _k < 4; ++_k) YY[_k] = *(const u32x4*)(Y + SLOT[_k] * DM + _col); } while (0)
#define P8_COMB(ACC, YY, ROW, G, H) do { const int _col = 16 * lane + 1024 * (H); \
        _Pragma("unroll") for (int _k = 0; _k < 4; ++_k) { const float _g = G[_k] * (1.0f / pg8::Y8_SCALE); \
            _Pragma("unroll") for (int _q = 0; _q < 4; ++_q) { const f32x2 lo = __builtin_amdgcn_cvt_pk_f32_fp8((int)YY[_k][_q], false), hi = __builtin_amdgcn_cvt_pk_f32_fp8((int)YY[_k][_q], true); \
                ACC[_q].x += _g * lo.x; ACC[_q].y += _g * lo.y; ACC[_q].z += _g * hi.x; ACC[_q].w += _g * hi.y; } } \
        _Pragma("unroll") for (int _q = 0; _q < 4; ++_q) *(f32x4*)(out + (size_t)(ROW) * DM + _col + 4 * _q) = ACC[_q]; } while (0)
    size_t slot[4]; float g[4];
    f32x4 accA[4], accB[4]; u32x4 yA[4], yB[4];
    if (gw < NREAL) {
#pragma unroll
        for (int k = 0; k < 4; ++k) { slot[k] = (size_t)misc[e4[k]] * 256 + p4[k]; g[k] = g4[k]; }
        P8_LOAD(accA, yA, gw, slot, 0); }
    for (int row = gw; row < NREAL; row += NGW) {
        const int nrow = row + NGW;
        if (nrow < NREAL) { e4 = *(const i32x4*)(RE + nrow * 4); p4 = *(const i32x4*)(RP + nrow * 4); g4 = *(const f32x4*)(RG + nrow * 4); }
        P8_LOAD(accB, yB, row, slot, 1);
        P8_COMB(accA, yA, row, g, 0);
        float gc[4];
#pragma unroll
        for (int k = 0; k < 4; ++k) gc[k] = g[k];
        if (nrow < NREAL) {
#pragma unroll
            for (int k = 0; k < 4; ++k) { slot[k] = (size_t)misc[e4[k]] * 256 + p4[k]; g[k] = g4[k]; }
            P8_LOAD(accA, yA, nrow, slot, 0); }
        P8_COMB(accB, yB, row, gc, 1);
    }
#undef P8_LOAD
#undef P8_COMB
}

__device__ __forceinline__ void p1_meta_rows(const Args& a, LAS unsigned char* lds, int bx, int G, int tid, int wave, int lane) {
    const bf16_t* HN = (const bf16_t*)(a.ws + WS_HN); const bf16_t* WT = (const bf16_t*)(a.ws + WS_WIN); bf16_t* P = (bf16_t*)(a.ws + WS_P);
    for (int q = tid; q < NMETA * DM * 2 / 16; q += NTHREADS) *(LAS u32x4*)(lds + q * 16) = *(const u32x4*)((const unsigned char*)HN + (size_t)q * 16);
    __syncthreads();
    for (int col = bx + G * wave; col < NPROJ; col += G * NWAVES) {
        u32x4 w[4]; int lane_o = lane; asm volatile("" : "+v"(lane_o));
#pragma unroll
        for (int j = 0; j < 4; ++j) w[j] = *(const u32x4*)(WT + (size_t)col * DM + 8 * lane + 512 * j);
        float v = 0.f;
#pragma unroll 1
        for (int t = 0; t < NMETA; ++t) { float s = 0.f;
#pragma unroll
            for (int j = 0; j < 4; ++j) { const u32x4 x = *(const LAS u32x4*)(lds + t * (DM * 2) + (8 * lane_o + 512 * j) * 2);
                s += bf_lo(x.x) * bf_lo(w[j].x) + bf_hi(x.x) * bf_hi(w[j].x) + bf_lo(x.y) * bf_lo(w[j].y) + bf_hi(x.y) * bf_hi(w[j].y)
                   + bf_lo(x.z) * bf_lo(w[j].z) + bf_hi(x.z) * bf_hi(w[j].z) + bf_lo(x.w) * bf_lo(w[j].w) + bf_hi(x.w) * bf_hi(w[j].w); }
            s = wave_sum(s);
            v = ((lane & 15) == t) ? s : v; }
        P[((size_t)(lane >> 4) * LSEQ + (lane & 15)) * NPROJ + col] = gdn::f2bf(v);
    }
    __syncthreads();
}

constexpr int NPH = 9;
__global__ void __launch_bounds__(NTHREADS, 2) hymba_fwd(Args args) {
    extern __shared__ __attribute__((aligned(16))) unsigned char lds_raw[];
    LAS unsigned char* lds = (LAS unsigned char*)lds_raw;
    LAS int* misc = (LAS int*)(lds + MISC_OFF);
    const int tid = threadIdx.x, lane = tid & 63, wave = __builtin_amdgcn_readfirstlane(tid >> 6);
    const int G = gridDim.x, bx = blockIdx.x;
    const int vcu = (G % 8 == 0) ? (bx % 8) * (G / 8) + bx / 8 : bx;
    const int gw = vcu * NWAVES + wave, NGW = G * NWAVES;
    unsigned* ctl = (unsigned*)(args.ws + WS_CTL);
    for (int u = tid; u < 256; u += NTHREADS) misc[u] = 0;
    __syncthreads();
    XcdBarrier bar; bar.bar = ctl + CW_BAR; bar.x = 0; bar.st = nullptr;
    const int lo = args.ph_lo, hi = args.ph_hi;
    constexpr int CVT_LIMIT_P2 = MOE_ITEMS * 35 / 100;
    if (hi - lo > 1) bar = xcd_barrier_post(ctl + CW_BAR, (volatile LAS unsigned*)(misc + 200));
#define IN(k) (lo <= (k) && (k) < hi)
#define SEAM(k) do { if (IN(k) && IN((k) + 1)) xcd_barrier(bar); } while (0)

    if (IN(0)) { p0_rows(args, lds, G, bx, tid); p0_weights(args, lds, vcu, G, wave, lane); }
    SEAM(0);
    if (IN(1)) {
        p1_meta_rows(args, lds, bx, G, tid, wave, lane);
        pg8::PlainOrder S; S.init(NREAL, NPROJ, DM, args.ws + WS_WIN, G, bx); S.meta = 1;
        pg8::EpiBf16 E{(bf16_t*)(args.ws + WS_P), NPROJ, 1, nullptr, (const float*)(args.ws + WS_RSTD)};
        pg8::gemm_phase<pg8::EpiBf16, pg8::PlainOrder, true, true>(lds, (const char*)(args.ws + WS_HN), DM * 2, S, E);
    }
    SEAM(1);
    if (IN(2)) {
        p2_qknorm(args, gw, NGW, lane);
        const bool roleB = (G >= 128) && (bx >= G - G / 8 * 3);
        if (roleB) moe_weights_queue<CVT_NLD_P2>(args, lds, misc + 212, tid, wave, lane, CVT_LIMIT_P2);
        unsigned xwp[33]; float gbp[2] = {0.f, 0.f};
        __syncthreads();
        if (tid == 0) misc[213] = (int)atomicAdd(ctl + CW_PREQ, 1u);
        __syncthreads();
        int it = *(volatile LAS int*)(misc + 213);
        gdn::prefetch_rows(args, it, lane, wave, xwp, gbp);
        while (it < 32 * gdn::NCH) {
            const int nclaim = (tid == 0) ? (int)atomicAdd(ctl + CW_PREQ, 1u) : 0;
            gdn::precompute(args, lds, it, tid, lane, wave, xwp, gbp, (volatile LAS int*)(misc + 215), nclaim);
            it = *(volatile LAS int*)(misc + 215);
        }
        if (!roleB) moe_weights_queue<CVT_NLD_P2>(args, lds, misc + 212, tid, wave, lane, CVT_LIMIT_P2);
    }
    SEAM(2);
    if (IN(3)) {
        const int NG = (G >= 64) ? 32 : 0;
        if (bx < 32 || NG == 0) { for (int it = bx; it < 32; it += G) gdn::scan(args, lds, it, tid, lane, wave); }
        if (bx >= NG) { for (int u = bx - NG; u < 512; u += G - NG) sba::unit(args, lds, (volatile LAS int*)(misc + 210), u >> 7, (u >> 4) & 7, u & 15, tid, lane, wave); }
        moe_weights_queue(args, lds, misc + 212, tid, wave, lane, MOE_ITEMS);
    }
    SEAM(3);
    if (IN(4)) {
        pg8::PlainOrder S; S.init(NREAL, DM, DM, args.ws + WS_WOUT, G, bx);
        pg8::EpiResF32 E{args.in[I_X], args.out, DM};
        pg8::gemm_phase<pg8::EpiResF32, pg8::PlainOrder, true, true>(lds, (const char*)(args.ws + WS_MIX), DM * 2, S, E);
    }
    SEAM(4);
    if (IN(5)) p5_router(args, lds, G, bx, tid);
    SEAM(5);
    if (IN(6)) {
        {
        const int mt = moe_setup(args, misc, tid);
        pg8::MoeOrder<true> S; S.tpre = misc; S.tok = (const LAS int*)(lds + TOK_OFF); S.nN = 16; S.nwg = mt * 16; S.G = G; S.c = bx;
        S.Bt = (const char*)(args.ws + WS_WGU); S.estride = (size_t)2 * DE * DM; S.K2 = DM;
        const int* LIST = (const int*)(args.ws + WS_LIST);
        S.ud = misc + 140; S.fill_units(misc + 140, tid);
        __syncthreads();
        for (int idx = tid; idx < TOK_CAP * 256; idx += NTHREADS) { pg8::Unit u; if (!S.next(idx >> 8, u)) break;
            const int r = (u.pm - misc[u.e]) * 256 + (idx & 255); int ent = 0;
            if (r < misc[104 + u.e]) ent = LIST[(size_t)u.e * NREAL + r];
            ((LAS int*)(lds + TOK_OFF))[idx] = ent; }
        __syncthreads();
        pg8::EpiSwiGLU E{args.ws + WS_ACT, args.in[I_BGU], (const LAS int*)(lds + TOK_OFF)};
        pg8::gemm_phase<pg8::EpiSwiGLU, pg8::MoeOrder<true>, true, true, true>(lds, (const char*)(args.ws + WS_HN), DM, S, E);
        }
    }
    pg8::MoeOrder<false> S7;
    if (IN(7)) {
        const int mt = IN(6) ? misc[32] : moe_setup(args, misc, tid);
        S7.tpre = misc; S7.tok = nullptr; S7.nN = 8; S7.nwg = mt * 8; S7.G = G; S7.c = bx;
        S7.Bt = (const char*)(args.ws + WS_WD); S7.estride = (size_t)DM * DE; S7.K2 = DE;
        __syncthreads();
        S7.ud = misc + 140; S7.fill_units(misc + 140, tid);
    }
    SEAM(6);
    if (IN(7)) {
        __syncthreads();
        pg8::EpiFp8Bias E{args.ws + WS_Y, DM, args.in[I_BD]};
        pg8::gemm_phase<pg8::EpiFp8Bias, pg8::MoeOrder<false>, true, true, true>(lds, (const char*)(args.ws + WS_ACT), DE, S7, E);
    }
    SEAM(7);
    if (IN(8)) { if (!IN(7)) (void)moe_setup(args, misc, tid); p8_combine(args, misc, gw, NGW, lane); }
#undef IN
#undef SEAM
}

extern "C" void kernel_launch(void* const* d_in, const int* in_sizes, int n_in, void* d_out, int out_size, void* d_ws, size_t ws_size, hipStream_t stream) {
    static int grid = 0;
    if (grid == 0) {
        if (n_in != 19 || out_size != NREAL * DM || ws_size < WS_END) { fprintf(stderr, "kernel_launch: unexpected shapes (n_in %d out %d ws %zu need %zu)\n", n_in, out_size, ws_size, (size_t)WS_END); grid = -1; return; }
        int dev = 0, cus = 0, per_cu = 0;
        if (hipGetDevice(&dev) != hipSuccess || hipDeviceGetAttribute(&cus, hipDeviceAttributeMultiprocessorCount, dev) != hipSuccess) { grid = -1; return; }
        if (hipFuncSetAttribute((const void*)hymba_fwd, hipFuncAttributeMaxDynamicSharedMemorySize, LDS_BYTES) != hipSuccess) { fprintf(stderr, "kernel_launch: hipFuncSetAttribute failed\n"); grid = -1; return; }
        if (hipOccupancyMaxActiveBlocksPerMultiprocessor(&per_cu, (const void*)hymba_fwd, NTHREADS, LDS_BYTES) != hipSuccess || per_cu < 1) { fprintf(stderr, "kernel_launch: occupancy query says %d\n", per_cu); grid = -1; return; }
        (void)hipGetLastError();
        grid = cus;
    }
    if (grid < 0) return;
    (void)hipMemsetAsync((char*)d_ws + WS_CTL, 0, CTL_ZERO_BYTES, stream);
    Args a{};
    for (int i = 0; i < 19; ++i) a.in[i] = (const float*)d_in[i];
    a.out = (float*)d_out; a.ws = (unsigned char*)d_ws;
#if MK_N_LAUNCHES == 1
    a.ph_lo = 0; a.ph_hi = NPH;
    hipLaunchKernelGGL(hymba_fwd, dim3(grid), dim3(NTHREADS), LDS_BYTES, stream, a);
#else
    for (int p = 0; p < NPH; ++p) { a.ph_lo = p; a.ph_hi = p + 1; hipLaunchKernelGGL(hymba_fwd, dim3(grid), dim3(NTHREADS), LDS_BYTES, stream, a); }
#endif
    const hipError_t le = hipPeekAtLastError();
    if (le != hipSuccess) fprintf(stderr, "kernel_launch: launch failed: %s\n", hipGetErrorName(le));
}
```
